# Optimizing an MI355X kernel written in HIP

```python
import math
import jax
import jax.numpy as jnp
from jax import lax
import numpy as np

D_MODEL = 1024
BATCH = 8
SEQ = 2048
DEPTH = 4

N_HEADS = 16
HEAD_DIM = D_MODEL // N_HEADS
Q_BLOCK = 128
N_MIXERS = 3
DILATED_PAIRS = ((128, 1), (512, 4), (2048, 16))
N_DIL_GROUPS = len(DILATED_PAIRS)
N_REL_BUCKETS = 32
REL_MAX_DISTANCE = 2048
D_FF = 7 * D_MODEL // 2
N_EXPERTS = 8
TOP_K = 2
RMS_EPS = 1e-6
NEG_INF = -1e30
N_SB_LAYERS = (DEPTH + 2) // 3
N_DIL_LAYERS = (DEPTH + 1) // 3
N_FOX_LAYERS = DEPTH // 3
N_DENSE_LAYERS = (DEPTH + 1) // 2
N_MOE_LAYERS = DEPTH // 2

kernel_name = 'hybrid_stickbreak_dilated_fox_moe_trunk'


def rmsnorm(x, g):
    xf = x.astype(jnp.float32)
    inv = lax.rsqrt(jnp.mean(xf * xf, axis=-1, keepdims=True) + RMS_EPS)
    return (xf * inv).astype(x.dtype) * g


def split_heads(t):
    return t.reshape(t.shape[:-1] + (N_HEADS, HEAD_DIM))


def merge_heads(t):
    return t.reshape(t.shape[:-2] + (N_HEADS * HEAD_DIM,))


def query_blocks(t):
    b, s = t.shape[:2]
    t = t.reshape((b, s // Q_BLOCK, Q_BLOCK) + t.shape[2:])
    return jnp.moveaxis(t, 1, 0)


def unblock(t):
    t = jnp.moveaxis(t, 0, 1)
    return t.reshape((t.shape[0], t.shape[1] * t.shape[2]) + t.shape[3:])


def stick_breaking_attention(q, k, v):
    s = q.shape[1]
    scale = 1.0 / math.sqrt(HEAD_DIM)
    kpos = jnp.arange(s, dtype=jnp.int32)
    starts = jnp.arange(s // Q_BLOCK, dtype=jnp.int32) * Q_BLOCK

    def one_block(args):
        q_blk, start = args
        z = jnp.einsum('bqhd,bkhd->bhqk', q_blk, k, preferred_element_type=jnp.float32) * scale
        qpos = start + jnp.arange(Q_BLOCK, dtype=jnp.int32)
        strict = kpos[None, :] < qpos[:, None]
        log_keep = jnp.where(strict, jax.nn.log_sigmoid(-z), 0.0)
        log_remain = lax.cumsum(log_keep, axis=3, reverse=True) - log_keep
        w = jnp.where(strict, jnp.exp(jax.nn.log_sigmoid(z) + log_remain), 0.0)
        return jnp.einsum('bhqk,bkhd->bqhd', w.astype(v.dtype), v)

    return unblock(lax.map(one_block, (query_blocks(q), starts)))


def stick_breaking_mixer(h, w_qkv, w_o):
    q, k, v = jnp.split(h @ w_qkv, 3, axis=-1)
    o = stick_breaking_attention(split_heads(q), split_heads(k), split_heads(v))
    return merge_heads(o) @ w_o


def t5_causal_bucket(distance):
    max_exact = N_REL_BUCKETS // 2
    d = jnp.maximum(distance, 1).astype(jnp.float32)
    log_b = max_exact + (jnp.log(d / max_exact) / math.log(REL_MAX_DISTANCE / max_exact)
                         * (N_REL_BUCKETS - max_exact)).astype(jnp.int32)
    log_b = jnp.minimum(log_b, N_REL_BUCKETS - 1)
    return jnp.where(distance < max_exact, distance, log_b)


def to_residue_classes(t, dil, l_pad):
    b, s = t.shape[:2]
    t = jnp.moveaxis(t.reshape((b, s // dil, dil) + t.shape[2:]), 2, 1)
    return jnp.pad(t, ((0, 0), (0, 0), (0, l_pad - s // dil)) + ((0, 0),) * (t.ndim - 3))


def from_residue_classes(t, seq):
    b, dil = t.shape[:2]
    rest = t.shape[4:]
    t = t.reshape((b, dil, -1) + rest)[:, :, : seq // dil]
    return jnp.moveaxis(t, 1, 2).reshape((b, seq) + rest)


def dilated_branch(q, k, v, rel_bias, window, dil):
    b, s = q.shape[:2]
    span = window // dil
    l_sub = s // dil
    nb = -(-l_sub // Q_BLOCK)
    l_pad = nb * Q_BLOCK
    scale = 1.0 / math.sqrt(HEAD_DIM)

    def blk(t):
        return to_residue_classes(t, dil, l_pad).reshape((b, dil, nb, Q_BLOCK, N_HEADS, HEAD_DIM))

    def band(t):
        t = blk(t)
        prev = jnp.pad(t, ((0, 0), (0, 0), (1, 0), (0, 0), (0, 0), (0, 0)))[:, :, :-1]
        return jnp.concatenate([prev, t], axis=3)

    qb, kb, vb = blk(q), band(k), band(v)
    qi = jnp.arange(Q_BLOCK, dtype=jnp.int32)
    kj = jnp.arange(2 * Q_BLOCK, dtype=jnp.int32)
    delta = qi[:, None] + Q_BLOCK - kj[None, :]
    blocks = jnp.arange(nb, dtype=jnp.int32)
    key_exists = (blocks[:, None] - 1) * Q_BLOCK + kj[None, :] >= 0
    mask = ((delta >= 0) & (delta <= span))[None] & key_exists[:, None, :]
    bias = jnp.moveaxis(rel_bias[t5_causal_bucket(jnp.maximum(delta, 0) * dil)], -1, 0)
    logits = (jnp.einsum('brnqhd,brnkhd->brnhqk', qb, kb, preferred_element_type=jnp.float32) * scale
              + bias.astype(jnp.float32))
    logits = jnp.where(mask[None, None, :, None], logits, NEG_INF)
    m = jnp.max(logits, axis=-1)
    p = jnp.exp(logits - m[..., None])
    l = jnp.sum(p, axis=-1)
    acc = jnp.einsum('brnhqk,brnkhd->brnqhd', p, vb, preferred_element_type=jnp.float32)
    m = jnp.moveaxis(m, 3, 4)
    l = jnp.moveaxis(l, 3, 4)
    return (from_residue_classes(acc, s), from_residue_classes(m, s), from_residue_classes(l, s))


def dilated_mixer(h, w_in, q_norm, k_norm, rel_bias, w_o):
    proj = h @ w_in
    v = split_heads(proj[..., 2 * N_DIL_GROUPS * D_MODEL:])
    accs, ms, ls = [], [], []
    for g, (window, dil) in enumerate(DILATED_PAIRS):
        q = rmsnorm(split_heads(proj[..., (2 * g) * D_MODEL:(2 * g + 1) * D_MODEL]), q_norm[g])
        k = rmsnorm(split_heads(proj[..., (2 * g + 1) * D_MODEL:(2 * g + 2) * D_MODEL]), k_norm[g])
        acc, m, l = dilated_branch(q, k, v, rel_bias, window, dil)
        accs.append(acc)
        ms.append(m)
        ls.append(l)
    m_all = jnp.stack(ms)
    wts = jnp.exp(m_all - jnp.max(m_all, axis=0, keepdims=True))
    num = jnp.sum(wts[..., None] * jnp.stack(accs), axis=0)
    den = jnp.sum(wts * jnp.stack(ls), axis=0)
    o = (num / den[..., None]).astype(h.dtype)
    return merge_heads(o) @ w_o


def forgetting_attention(q, k, v, log_f):
    s = q.shape[1]
    scale = 1.0 / math.sqrt(HEAD_DIM)
    kpos = jnp.arange(s, dtype=jnp.int32)
    starts = jnp.arange(s // Q_BLOCK, dtype=jnp.int32) * Q_BLOCK
    cum = lax.cumsum(log_f, axis=1)
    cum_keys = jnp.moveaxis(cum, 1, 2)

    def one_block(args):
        q_blk, cum_q, start = args
        logits = jnp.einsum('bqhd,bkhd->bhqk', q_blk, k, preferred_element_type=jnp.float32) * scale
        decay = jnp.moveaxis(cum_q, 1, 2)[..., :, None] - cum_keys[:, :, None, :]
        qpos = start + jnp.arange(Q_BLOCK, dtype=jnp.int32)
        causal = kpos[None, :] <= qpos[:, None]
        p = jax.nn.softmax(jnp.where(causal, logits + decay, NEG_INF), axis=-1)
        return jnp.einsum('bhqk,bkhd->bqhd', p.astype(v.dtype), v)

    return unblock(lax.map(one_block, (query_blocks(q), query_blocks(cum), starts)))


def forgetting_mixer(h, w_in, b_f, q_norm, k_norm, w_o):
    proj = h @ w_in
    q = rmsnorm(split_heads(proj[..., :D_MODEL]), q_norm)
    k = rmsnorm(split_heads(proj[..., D_MODEL:2 * D_MODEL]), k_norm)
    v = split_heads(proj[..., 2 * D_MODEL:3 * D_MODEL])
    log_f = jax.nn.log_sigmoid((proj[..., 3 * D_MODEL:] + b_f).astype(jnp.float32))
    o = forgetting_attention(q, k, v, log_f)
    return merge_heads(o) @ w_o


def swiglu(h, w_gate, w_up, w_down):
    return (jax.nn.silu(h @ w_gate) * (h @ w_up)) @ w_down


def moe_swiglu(h, router, w_gate, w_up, w_down):
    logits = (h @ router).astype(jnp.float32)
    top_logits, top_idx = lax.top_k(logits, TOP_K)
    gates = jax.nn.softmax(top_logits, axis=-1)
    combine = jnp.einsum('bske,bsk->bse', jax.nn.one_hot(top_idx, N_EXPERTS, dtype=jnp.float32), gates)
    y = jnp.zeros_like(h)
    for e in range(N_EXPERTS):
        y = y + combine[..., e:e + 1].astype(h.dtype) * swiglu(h, w_gate[e], w_up[e], w_down[e])
    return y


def setup_inputs(seed: int = 0) -> dict:
    key = jax.random.key(seed)
    ks = jax.random.split(key, 24)
    f32 = jnp.float32

    def w(k, shape, fan_in):
        return jax.random.normal(k, shape, f32) * fan_in ** -0.5

    def gain(k, shape):
        return 1.0 + 0.1 * jax.random.normal(k, shape, f32)

    return {
        'x': jax.random.normal(ks[0], (BATCH, SEQ, D_MODEL), f32),
        'sb_w_qkv': w(ks[1], (N_SB_LAYERS, D_MODEL, 3 * D_MODEL), D_MODEL),
        'sb_w_o': w(ks[2], (N_SB_LAYERS, D_MODEL, D_MODEL), D_MODEL),
        'dil_w_in': w(ks[3], (N_DIL_LAYERS, D_MODEL, (2 * N_DIL_GROUPS + 1) * D_MODEL), D_MODEL),
        'dil_q_norm': gain(ks[4], (N_DIL_LAYERS, N_DIL_GROUPS, HEAD_DIM)),
        'dil_k_norm': gain(ks[5], (N_DIL_LAYERS, N_DIL_GROUPS, HEAD_DIM)),
        'dil_w_o': w(ks[6], (N_DIL_LAYERS, D_MODEL, D_MODEL), D_MODEL),
        'fox_w_in': w(ks[7], (N_FOX_LAYERS, D_MODEL, 3 * D_MODEL + N_HEADS), D_MODEL),
        'fox_b_f': 2.0 + 0.5 * jax.random.normal(ks[8], (N_FOX_LAYERS, N_HEADS), f32),
        'fox_q_norm': gain(ks[9], (N_FOX_LAYERS, HEAD_DIM)),
        'fox_k_norm': gain(ks[10], (N_FOX_LAYERS, HEAD_DIM)),
        'fox_w_o': w(ks[11], (N_FOX_LAYERS, D_MODEL, D_MODEL), D_MODEL),
        'rel_bias': 0.5 * jax.random.normal(ks[12], (N_REL_BUCKETS, N_HEADS), f32),
        'attn_norm': gain(ks[13], (DEPTH, D_MODEL)),
        'ffn_norm': gain(ks[14], (DEPTH, D_MODEL)),
        'mlp_w_gate': w(ks[15], (N_DENSE_LAYERS, D_MODEL, D_FF), D_MODEL),
        'mlp_w_up': w(ks[16], (N_DENSE_LAYERS, D_MODEL, D_FF), D_MODEL),
        'mlp_w_down': w(ks[17], (N_DENSE_LAYERS, D_FF, D_MODEL), D_FF),
        'moe_router': w(ks[18], (N_MOE_LAYERS, D_MODEL, N_EXPERTS), D_MODEL),
        'moe_w_gate': w(ks[19], (N_MOE_LAYERS, N_EXPERTS, D_MODEL, D_FF), D_MODEL),
        'moe_w_up': w(ks[20], (N_MOE_LAYERS, N_EXPERTS, D_MODEL, D_FF), D_MODEL),
        'moe_w_down': w(ks[21], (N_MOE_LAYERS, N_EXPERTS, D_FF, D_MODEL), D_FF),
    }


def reference(x, sb_w_qkv, sb_w_o, dil_w_in, dil_q_norm, dil_k_norm, dil_w_o,
              fox_w_in, fox_b_f, fox_q_norm, fox_k_norm, fox_w_o, rel_bias,
              attn_norm, ffn_norm, mlp_w_gate, mlp_w_up, mlp_w_down,
              moe_router, moe_w_gate, moe_w_up, moe_w_down):
    for i in range(DEPTH):
        h = rmsnorm(x, attn_norm[i])
        kind = i % N_MIXERS
        j = i // N_MIXERS
        if kind == 0:
            mix = stick_breaking_mixer(h, sb_w_qkv[j], sb_w_o[j])
        elif kind == 1:
            mix = dilated_mixer(h, dil_w_in[j], dil_q_norm[j], dil_k_norm[j], rel_bias, dil_w_o[j])
        else:
            mix = forgetting_mixer(h, fox_w_in[j], fox_b_f[j], fox_q_norm[j], fox_k_norm[j], fox_w_o[j])
        x = x + mix
        h = rmsnorm(x, ffn_norm[i])
        f = i // 2
        if i % 2 == 0:
            x = x + swiglu(h, mlp_w_gate[f], mlp_w_up[f], mlp_w_down[f])
        else:
            x = x + moe_swiglu(h, moe_router[f], moe_w_gate[f], moe_w_up[f], moe_w_down[f])
    return x
```

```cpp
#include <hip/hip_runtime.h>
#include <cstdio>
#include <cstdint>

#ifndef MK_MULTI
#define MK_MULTI 0
#endif

constexpr int BATCH = 8, SEQ = 2048, DM = 1024, NH = 16, HD = 64, FF = 3584, NE = 8;
constexpr int M = BATCH * SEQ;
constexpr float RMS_EPS = 1e-6f;
constexpr float LOG2E = 1.4426950408889634f;
constexpr float C2 = 0.125f * LOG2E;
constexpr int NWAVES = 8, NTHR = 512;
constexpr int LCAP = 16384;
constexpr int MAXROWS = 34816;

constexpr size_t MiB = 1u << 20;
constexpr size_t WS_CTL = 0, CTL_ZERO_BYTES = 1 * MiB;
constexpr size_t WS_MISC = 1 * MiB;
constexpr size_t WS_H = 6 * MiB;
constexpr size_t WS_R1 = 38 * MiB;
constexpr size_t WS_R2 = 278 * MiB;
constexpr size_t WS_END = 414 * MiB;
constexpr size_t PLANE = (size_t)M * DM;
constexpr size_t MS_LIST = 0;
constexpr size_t MS_GW = 1 * MiB;
constexpr size_t MS_TOK = 2 * MiB;
constexpr size_t MS_LOGF = 2 * MiB + 256 * 1024;
constexpr size_t MS_CUM = 3 * MiB + 256 * 1024;
constexpr int CW_BAR = 4096;
constexpr int CW_CNT = 64;

#define GAS __attribute__((address_space(1)))
#define LAS __attribute__((address_space(3)))
typedef unsigned short bf16;
typedef unsigned v4u __attribute__((ext_vector_type(4)));
typedef unsigned v2u __attribute__((ext_vector_type(2)));
typedef float f32x4 __attribute__((ext_vector_type(4)));
typedef float f32x2 __attribute__((ext_vector_type(2)));
typedef GAS unsigned gu32;
#define RLX_AGENT __ATOMIC_RELAXED, __HIP_MEMORY_SCOPE_AGENT
__device__ __forceinline__ unsigned f2bf(float f) { unsigned u = __builtin_bit_cast(unsigned, f); return (u + 0x7fffu + ((u >> 16) & 1u)) >> 16; }
__device__ __forceinline__ unsigned pk2(float lo, float hi) { return f2bf(lo) | (f2bf(hi) << 16); }
__device__ __forceinline__ float bflo(unsigned u) { return __builtin_bit_cast(float, u << 16); }
__device__ __forceinline__ float bfhi(unsigned u) { return __builtin_bit_cast(float, u & 0xffff0000u); }

#define XB_TMO      128
#define XB_XCNT(j)  (256  + 64 * (j))
#define XB_XSUB(j)  (1280 + 64 * (j))
#define XB_XGEN(j)  (2304 + 64 * (j))
#define XB_TOP      3328
#define XB_TOPGEN   3392
#define XCD_BAR_WORDS 3456
#define XB_SPIN_CAP (1u << 22)
__device__ __forceinline__ unsigned xb_ld(unsigned* p)              { return __hip_atomic_load(p, __ATOMIC_RELAXED, __HIP_MEMORY_SCOPE_AGENT); }
__device__ __forceinline__ unsigned xb_add(unsigned* p, unsigned v) { return __hip_atomic_fetch_add(p, v, __ATOMIC_RELAXED, __HIP_MEMORY_SCOPE_AGENT); }
__device__ __forceinline__ unsigned xb_xcc_id() { return (unsigned)__builtin_amdgcn_s_getreg((3 << 11) | 20) & 0xFu; }
#define XB_SPIN(cond, bar) do { unsigned _sp = 0; while (cond) { __builtin_amdgcn_s_sleep(1); \
    if ((++_sp & 255u) == 0u) { if (xb_ld(&(bar)[XB_TMO])) break; if (_sp > XB_SPIN_CAP) { atomicAdd(&(bar)[XB_TMO], 1u); break; } } } } while (0)
struct XcdBarrier { unsigned* bar; unsigned x; volatile LAS unsigned* st; };
__device__ __forceinline__ XcdBarrier xcd_barrier_post(unsigned* bar, volatile LAS unsigned* st) {
    XcdBarrier b; b.bar = bar; b.x = xb_xcc_id(); b.st = st;
    if (threadIdx.x == 0) (void)xb_add(&bar[XB_XCNT(b.x)], 1u);
    return b;
}
__device__ __forceinline__ void xcd_barrier_complete(unsigned* bar, unsigned x, unsigned& nloc, unsigned& nx) {
    const unsigned G = gridDim.x * gridDim.y * gridDim.z;
    unsigned sum, cnt, mine, sp = 0u;
    for (;;) {
        sum = 0u; cnt = 0u; mine = 0u;
#pragma unroll
        for (unsigned j = 0; j < 16; ++j) { const unsigned c = xb_ld(&bar[XB_XCNT(j)]); sum += c; cnt += (c > 0u) ? 1u : 0u; mine = (j == x) ? c : mine; }
        if (sum == G) break;
        __builtin_amdgcn_s_sleep(1);
        if ((++sp & 255u) == 0u) { if (xb_ld(&bar[XB_TMO])) break; if (sp > XB_SPIN_CAP) { atomicAdd(&bar[XB_TMO], 1u); break; } }
    }
    nloc = mine > 0u ? mine : 1u; nx = cnt > 0u ? cnt : 1u;
}
__device__ __forceinline__ void xcd_barrier(const XcdBarrier& b) {
    asm volatile("s_waitcnt vmcnt(0)" ::: "memory");
    __syncthreads();
    if (threadIdx.x == 0) {
        unsigned* bar = b.bar;
        __builtin_amdgcn_s_waitcnt(0);
        unsigned nloc = b.st[0], nx = b.st[1];
        if (nloc == 0u) { xcd_barrier_complete(bar, b.x, nloc, nx); b.st[0] = nloc; b.st[1] = nx; }
        const unsigned old = xb_add(&bar[XB_XSUB(b.x)], 1u);
        const unsigned gen = old / nloc;
        if (old + 1u == (gen + 1u) * nloc) {
            __builtin_amdgcn_fence(__ATOMIC_RELEASE, "agent");
            asm volatile("s_waitcnt vmcnt(0)" ::: "memory");
            const unsigned og = xb_add(&bar[XB_TOP], 1u);
            const unsigned tg = og / nx;
            if (og + 1u == (tg + 1u) * nx) xb_add(&bar[XB_TOPGEN], 1u);
            else XB_SPIN(xb_ld(&bar[XB_TOPGEN]) == tg, bar);
            __builtin_amdgcn_fence(__ATOMIC_ACQUIRE, "agent");
            xb_add(&bar[XB_XGEN(b.x)], 1u);
            asm volatile("s_waitcnt vmcnt(0)" ::: "memory");
        } else {
            XB_SPIN(xb_ld(&bar[XB_XGEN(b.x)]) == gen, bar);
            __builtin_amdgcn_fence(__ATOMIC_ACQUIRE, "agent");
            asm volatile("s_waitcnt vmcnt(0)" ::: "memory");
        }
    }
    __syncthreads();
}

constexpr int LDS_BYTES = 147456;
constexpr int MISC_OFF = 131072 + 320;
struct Frame {
    LAS unsigned char* lds;
    int tid, lane, wave, G;
    unsigned char* ws; gu32* ctl;
    float* out;
};
__device__ __forceinline__ float wave_sum(float v) {
#pragma unroll
    for (int o = 1; o < 64; o <<= 1) v += __shfl_xor(v, o);
    return v;
}

constexpr int PTR_OFF = 131072 + 512;
__device__ __forceinline__ const float* inp_ptr(Frame& F, int k) {
    const LAS unsigned* t = (const LAS unsigned*)(F.lds + PTR_OFF) + 2 * k;
    const unsigned lo = __builtin_amdgcn_readfirstlane(t[0]), hi = __builtin_amdgcn_readfirstlane(t[1]);
    return (const float*)(((unsigned long long)hi << 32) | lo);
}
#define INP(k) inp_ptr(F, (k))
__device__ __forceinline__ bool relaunder(Frame& F) { int t_ = threadIdx.x; asm volatile("" : "+v"(t_)); F.tid = t_; F.lane = t_ & 63; F.wave = __builtin_amdgcn_readfirstlane(t_ >> 6); return true; }
__device__ __forceinline__ void moe_bases(Frame& F, int f, int (&tb)[NE + 1]) {
    int acc = 0;
#pragma unroll
    for (int e = 0; e < NE; ++e) { tb[e] = acc; const int c = (int)__hip_atomic_load(F.ctl + CW_CNT + f * 64 + e, RLX_AGENT); acc += (c + 255) >> 8; }
    tb[NE] = acc;
}

template <int FLAGS>
__device__ __forceinline__ void norm_phase(Frame& F, const float* xin, float* xout, const float* gain, bf16* H, int fprev, int f,
                                           const float* Wf  , const float* bf  , const float* Wr  ) {
    const float* Y = (const float*)(F.ws + WS_R2);
    const int* tok_prev = (const int*)(F.ws + WS_MISC + MS_TOK) + (size_t)fprev * M * 2;
    float* lgf = (float*)(F.ws + WS_MISC + MS_LOGF);
    LAS int* sel = (LAS int*)F.lds;
    LAS float* sg = (LAS float*)(F.lds + 512);
    LAS int* lpos = (LAS int*)(F.lds + 1024);
    LAS int* gb = (LAS int*)(F.lds + 1536);
    int tb[NE + 1];
    if (FLAGS & 1) moe_bases(F, fprev, tb);
    for (int chunk = blockIdx.x; chunk < M / 64; chunk += F.G) {
        for (int i = 0; i < 8; ++i) {
            const int m = chunk * 64 + F.wave * 8 + i;
            const GAS f32x4* xr = (const GAS f32x4*)(xin + (size_t)m * DM) + F.lane;
            f32x4 v[4];
#pragma unroll
            for (int j = 0; j < 4; ++j) v[j] = xr[64 * j];
            if (FLAGS & 1) {
                const int s0 = tok_prev[m * 2], s1 = tok_prev[m * 2 + 1];
                int r0 = 0, r1 = 0;
#pragma unroll
                for (int e = 0; e < NE; ++e) { if ((s0 >> 14) == e) r0 = tb[e] * 256 + (s0 & 16383); if ((s1 >> 14) == e) r1 = tb[e] * 256 + (s1 & 16383); }
                const GAS f32x4* y0 = (const GAS f32x4*)(Y + (size_t)r0 * DM) + F.lane;
                const GAS f32x4* y1 = (const GAS f32x4*)(Y + (size_t)r1 * DM) + F.lane;
#pragma unroll
                for (int j = 0; j < 4; ++j) { v[j] = v[j] + y0[64 * j] + y1[64 * j]; ((GAS f32x4*)(xout + (size_t)m * DM) + F.lane)[64 * j] = v[j]; }
            }
            float s = 0.f;
#pragma unroll
            for (int j = 0; j < 4; ++j) s += (v[j].x * v[j].x + v[j].y * v[j].y) + (v[j].z * v[j].z + v[j].w * v[j].w);
            const float inv = 1.0f / sqrtf(wave_sum(s) * (1.f / DM) + RMS_EPS);
#pragma unroll
            for (int j = 0; j < 4; ++j) { const f32x4 g = ((const GAS f32x4*)gain + F.lane)[64 * j]; v[j] = v[j] * inv * g; }
            if (H) {
                GAS unsigned long long* o8 = (GAS unsigned long long*)(H + (size_t)m * DM) + F.lane;
#pragma unroll
                for (int j = 0; j < 4; ++j) o8[64 * j] = (unsigned long long)pk2(v[j].x, v[j].y) | ((unsigned long long)pk2(v[j].z, v[j].w) << 32);
            }
            if (FLAGS & 2) {
                float part[16];
#pragma unroll
                for (int c = 0; c < 16; ++c) part[c] = 0.f;
#pragma unroll
                for (int j = 0; j < 4; ++j)
#pragma unroll
                    for (int q = 0; q < 4; ++q) { const int k = 4 * (F.lane + 64 * j) + q; const float hv = v[j][q];
                        const GAS f32x4* wr = (const GAS f32x4*)(Wf + (size_t)k * 3088 + 3072);
#pragma unroll
                        for (int c4 = 0; c4 < 4; ++c4) { const f32x4 w = wr[c4]; part[c4 * 4 + 0] += hv * w.x; part[c4 * 4 + 1] += hv * w.y; part[c4 * 4 + 2] += hv * w.z; part[c4 * 4 + 3] += hv * w.w; } }
                float mine = 0.f;
#pragma unroll
                for (int c = 0; c < 16; ++c) { const float t = wave_sum(part[c]); if (F.lane == c) mine = t; }
                if (F.lane < 16) { const float z = mine + bf[F.lane];
                    const float ls = fminf(z, 0.f) - log1pf(expf(-fabsf(z))); lgf[(size_t)m * 16 + F.lane] = ls * LOG2E; }
            }
            if (FLAGS & 4) {
                float part[8];
#pragma unroll
                for (int c = 0; c < 8; ++c) part[c] = 0.f;
#pragma unroll
                for (int j = 0; j < 4; ++j)
#pragma unroll
                    for (int q = 0; q < 4; ++q) { const int k = 4 * (F.lane + 64 * j) + q; const float hv = v[j][q];
                        const GAS f32x4* wr = (const GAS f32x4*)(Wr + (size_t)k * 8);
                        const f32x4 w0 = wr[0], w1 = wr[1];
                        part[0] += hv * w0.x; part[1] += hv * w0.y; part[2] += hv * w0.z; part[3] += hv * w0.w;
                        part[4] += hv * w1.x; part[5] += hv * w1.y; part[6] += hv * w1.z; part[7] += hv * w1.w; }
                float lg[8];
#pragma unroll
                for (int c = 0; c < 8; ++c) lg[c] = wave_sum(part[c]);
                int e0 = 0; float l0 = lg[0];
#pragma unroll
                for (int c = 1; c < 8; ++c) if (lg[c] > l0) { l0 = lg[c]; e0 = c; }
                int e1 = -1; float l1 = -INFINITY;
#pragma unroll
                for (int c = 0; c < 8; ++c) if (c != e0 && lg[c] > l1) { l1 = lg[c]; e1 = c; }
                const float g0 = 1.0f / (1.0f + expf(l1 - l0)), g1 = 1.0f - g0;
                if (F.lane == 0) { const int r = F.wave * 8 + i; sel[r * 2] = e0; sel[r * 2 + 1] = e1; sg[r * 2] = g0; sg[r * 2 + 1] = g1; }
            }
        }
        if (FLAGS & 4) {
            int* list = (int*)(F.ws + WS_MISC + MS_LIST) + (size_t)f * NE * LCAP;
            float* gw = (float*)(F.ws + WS_MISC + MS_GW) + (size_t)f * NE * LCAP;
            int* tok = (int*)(F.ws + WS_MISC + MS_TOK) + (size_t)f * M * 2;
            __syncthreads();
            if (F.tid == 0) {
                int lc[8];
#pragma unroll
                for (int e = 0; e < 8; ++e) lc[e] = 0;
                for (int q = 0; q < 128; ++q) { const int e = sel[q]; int p = 0;
#pragma unroll
                    for (int c = 0; c < 8; ++c) if (c == e) { p = lc[c]; lc[c] = p + 1; }
                    lpos[q] = p; }
#pragma unroll
                for (int e = 0; e < 8; ++e) gb[e] = (int)__hip_atomic_fetch_add(F.ctl + CW_CNT + f * 64 + e, (unsigned)lc[e], RLX_AGENT);
            }
            __syncthreads();
            if (F.tid < 128) { const int q = F.tid, row = chunk * 64 + (q >> 1), e = sel[q], pos = gb[e] + lpos[q];
                list[e * LCAP + pos] = row; gw[e * LCAP + pos] = sg[q]; tok[row * 2 + (q & 1)] = e * LCAP + pos; }
            __syncthreads();
        }
    }
}

__device__ __forceinline__ void final_combine(Frame& F, int f) {
    const float* Y = (const float*)(F.ws + WS_R2);
    const int* tok = (const int*)(F.ws + WS_MISC + MS_TOK) + (size_t)f * M * 2;
    int tb[NE + 1]; moe_bases(F, f, tb);
    for (int m = blockIdx.x * NWAVES + F.wave; m < M; m += F.G * NWAVES) {
        const int s0 = tok[m * 2], s1 = tok[m * 2 + 1]; int r0 = 0, r1 = 0;
#pragma unroll
        for (int e = 0; e < NE; ++e) { if ((s0 >> 14) == e) r0 = tb[e] * 256 + (s0 & 16383); if ((s1 >> 14) == e) r1 = tb[e] * 256 + (s1 & 16383); }
        GAS f32x4* xr = (GAS f32x4*)(F.out + (size_t)m * DM) + F.lane;
        const GAS f32x4* y0 = (const GAS f32x4*)(Y + (size_t)r0 * DM) + F.lane;
        const GAS f32x4* y1 = (const GAS f32x4*)(Y + (size_t)r1 * DM) + F.lane;
#pragma unroll
        for (int j = 0; j < 4; ++j) xr[64 * j] = xr[64 * j] + y0[64 * j] + y1[64 * j];
    }
}

__device__ __forceinline__ void cumsum_phase(Frame& F) {
    const float* logf = (const float*)(F.ws + WS_MISC + MS_LOGF);
    float* cum = (float*)(F.ws + WS_MISC + MS_CUM);
    const int gw = blockIdx.x * NWAVES + F.wave;
    if (gw < BATCH * NH) {
        const int b = gw >> 4, h = gw & 15;
        float v[32]; float s = 0.f;
#pragma unroll
        for (int i = 0; i < 32; ++i) { v[i] = logf[((size_t)b * SEQ + F.lane * 32 + i) * 16 + h]; s += v[i]; }
        float incl = s;
#pragma unroll
        for (int o = 1; o < 64; o <<= 1) { const float t = __shfl_up(incl, o); if (F.lane >= o) incl += t; }
        float run = incl - s;
#pragma unroll
        for (int i = 0; i < 32; ++i) { run += v[i]; cum[((size_t)b * SEQ + F.lane * 32 + i) * 16 + h] = run; }
    }
}

enum { EPI_PLANES = 0, EPI_RESID = 1, EPI_SWIGLU = 2, EPI_MOEDOWN = 3 };
struct SgP { const bf16* A; int lda; const int* rowidx; int Mrows; const float* W0; const float* W1; int ldw; int K; int N;
             bf16* outb; int ldo; float scale0; const float* base; float* outf; const float* gwv; };
template <int EPI>
__device__ __forceinline__ void sgemm(Frame& F, const SgP& p) {
    LAS float* As = (LAS float*)F.lds;
    LAS float* Bs0 = As + 16 * 132;
    LAS float* Bs1 = Bs0 + 16 * 128;
    const int tid = F.tid, ty = tid >> 4, tx = tid & 15;
    const int lrow = tid >> 2, lkq = (tid & 3) * 4;
    const int bk = tid >> 5, bn = (tid & 31) * 4;
    const int ntn = p.N / 128, ntiles = (p.Mrows / 128) * ntn;
    for (int tile = blockIdx.x; tile < ntiles; tile += F.G) {
        const int tm = tile / ntn, tn = tile % ntn;
        const int arow = p.rowidx ? p.rowidx[tm * 128 + lrow] : tm * 128 + lrow;
        const bf16* ap = p.A + (size_t)arow * p.lda + lkq;
        const float* bp0 = p.W0 + (size_t)bk * p.ldw + tn * 128 + bn;
        const float* bp1 = (EPI == EPI_SWIGLU) ? p.W1 + (size_t)bk * p.ldw + tn * 128 + bn : nullptr;
        f32x2 acc0[4][4], acc1[4][4];
#pragma unroll
        for (int i = 0; i < 4; ++i)
#pragma unroll
            for (int j = 0; j < 4; ++j) { acc0[i][j] = (f32x2){0.f, 0.f}; acc1[i][j] = (f32x2){0.f, 0.f}; }
        for (int k0 = 0; k0 < p.K; k0 += 16) {
            const v2u av = *(const GAS v2u*)(ap + k0);
            const f32x4 b0 = *(const GAS f32x4*)(bp0 + (size_t)k0 * p.ldw);
            f32x4 b1 = (f32x4){0.f, 0.f, 0.f, 0.f};
            if (EPI == EPI_SWIGLU) b1 = *(const GAS f32x4*)(bp1 + (size_t)k0 * p.ldw);
            __syncthreads();
            As[(lkq + 0) * 132 + lrow] = bflo(av.x); As[(lkq + 1) * 132 + lrow] = bfhi(av.x);
            As[(lkq + 2) * 132 + lrow] = bflo(av.y); As[(lkq + 3) * 132 + lrow] = bfhi(av.y);
            *(LAS f32x4*)(Bs0 + bk * 128 + bn) = b0;
            if (EPI == EPI_SWIGLU) *(LAS f32x4*)(Bs1 + bk * 128 + bn) = b1;
            __syncthreads();
#pragma unroll 2
            for (int k = 0; k < 16; ++k) {
                const f32x4 a = *(const LAS f32x4*)(As + k * 132 + ty * 4);
                const f32x4 bA = *(const LAS f32x4*)(Bs0 + k * 128 + tx * 8), bB = *(const LAS f32x4*)(Bs0 + k * 128 + tx * 8 + 4);
                const f32x2 bv[4] = {(f32x2){bA.x, bA.y}, (f32x2){bA.z, bA.w}, (f32x2){bB.x, bB.y}, (f32x2){bB.z, bB.w}};
#pragma unroll
                for (int i = 0; i < 4; ++i) {
#pragma unroll
                    for (int j = 0; j < 4; ++j) acc0[i][j] += a[i] * bv[j]; }
                if (EPI == EPI_SWIGLU) {
                    const f32x4 cA = *(const LAS f32x4*)(Bs1 + k * 128 + tx * 8), cB = *(const LAS f32x4*)(Bs1 + k * 128 + tx * 8 + 4);
                    const f32x2 cv[4] = {(f32x2){cA.x, cA.y}, (f32x2){cA.z, cA.w}, (f32x2){cB.x, cB.y}, (f32x2){cB.z, cB.w}};
#pragma unroll
                    for (int i = 0; i < 4; ++i) {
#pragma unroll
                        for (int j = 0; j < 4; ++j) acc1[i][j] += a[i] * cv[j]; }
                }
                __builtin_amdgcn_sched_barrier(0);
            }
        }
        const int c0 = tn * 128 + tx * 8;
#pragma unroll
        for (int i = 0; i < 4; ++i) {
            const int r = tm * 128 + ty * 4 + i;
            if (EPI == EPI_PLANES) {
                const int pl = c0 >> 10, cc = c0 & 1023; const float sc = (pl == 0) ? p.scale0 : 1.f;
                v4u w; w.x = pk2(acc0[i][0].x * sc, acc0[i][0].y * sc); w.y = pk2(acc0[i][1].x * sc, acc0[i][1].y * sc); w.z = pk2(acc0[i][2].x * sc, acc0[i][2].y * sc); w.w = pk2(acc0[i][3].x * sc, acc0[i][3].y * sc);
                *(GAS v4u*)(p.outb + (size_t)pl * PLANE + (size_t)r * DM + cc) = w;
            } else if (EPI == EPI_RESID) {
                const GAS f32x4* bp = (const GAS f32x4*)(p.base + (size_t)r * DM + c0); GAS f32x4* op = (GAS f32x4*)(p.outf + (size_t)r * DM + c0);
                const f32x4 x0 = bp[0], x1 = bp[1];
                op[0] = x0 + (f32x4){acc0[i][0].x, acc0[i][0].y, acc0[i][1].x, acc0[i][1].y}; op[1] = x1 + (f32x4){acc0[i][2].x, acc0[i][2].y, acc0[i][3].x, acc0[i][3].y};
            } else if (EPI == EPI_SWIGLU) {
                float o[8];
#pragma unroll
                for (int j = 0; j < 8; ++j) { const float g = acc0[i][j >> 1][j & 1], uu = acc1[i][j >> 1][j & 1]; o[j] = g / (1.0f + __expf(-g)) * uu; }
                v4u w; w.x = pk2(o[0], o[1]); w.y = pk2(o[2], o[3]); w.z = pk2(o[4], o[5]); w.w = pk2(o[6], o[7]);
                *(GAS v4u*)(p.outb + (size_t)r * p.ldo + c0) = w;
            } else {
                const float g = p.gwv[r]; GAS f32x4* op = (GAS f32x4*)(p.outf + (size_t)r * DM + c0);
                op[0] = (f32x4){acc0[i][0].x * g, acc0[i][0].y * g, acc0[i][1].x * g, acc0[i][1].y * g}; op[1] = (f32x4){acc0[i][2].x * g, acc0[i][2].y * g, acc0[i][3].x * g, acc0[i][3].y * g};
            }
        }
    }
}

__device__ __forceinline__ void qknorm_plane(Frame& F, bf16* plane, const float* gain, float mul) {
    const int nth = F.G * NTHR;
    for (int idx = blockIdx.x * NTHR + F.tid; idx < M * NH; idx += nth) {
        GAS v4u* p = (GAS v4u*)(plane + (size_t)idx * 64);
        v4u w[8]; float ss = 0.f;
#pragma unroll
        for (int c = 0; c < 8; ++c) { w[c] = p[c];
#pragma unroll
            for (int q = 0; q < 4; ++q) { const float a = bflo(w[c][q]), b = bfhi(w[c][q]); ss += a * a + b * b; } }
        const float inv = 1.0f / sqrtf(ss * (1.f / 64.f) + RMS_EPS) * mul;
#pragma unroll
        for (int c = 0; c < 8; ++c) { v4u o;
#pragma unroll
            for (int q = 0; q < 4; ++q) { const float a = bflo(w[c][q]) * inv * gain[c * 8 + 2 * q], b = bfhi(w[c][q]) * inv * gain[c * 8 + 2 * q + 1]; o[q] = pk2(a, b); }
            p[c] = o; }
    }
}

template <int MODE>
__device__ __forceinline__ void attn_simple_causal(Frame& F, const bf16* Qp, const bf16* Kp, const bf16* Vp, bf16* O, const float* cum) {
    LAS float* Ks = (LAS float*)F.lds;
    LAS float* Vs = Ks + 4096;
    LAS float* kb = Vs + 4096;
    for (int u = blockIdx.x; u < BATCH * NH * 4; u += F.G) {
        const int qblk = (u & 1) ? 3 - ((u >> 1) & 1) : ((u >> 1) & 1) * 1;
        const int bh = u >> 2, b = bh >> 4, h = bh & 15;
        const int t = qblk * 512 + F.tid;
        const size_t rowbase = (size_t)b * SEQ;
        float q[64], acc[64];
        { const GAS v4u* qp = (const GAS v4u*)(Qp + (rowbase + t) * DM + h * 64);
#pragma unroll
          for (int c = 0; c < 8; ++c) { const v4u w = qp[c];
#pragma unroll
              for (int k = 0; k < 4; ++k) { q[c * 8 + 2 * k] = bflo(w[k]); q[c * 8 + 2 * k + 1] = bfhi(w[k]); } } }
#pragma unroll
        for (int d = 0; d < 64; ++d) acc[d] = 0.f;
        float P = 1.f, mrun = -INFINITY, lrun = 0.f;
        const int ntile = 8 * (qblk + 1);
        for (int it = 0; it < ntile; ++it) {
            const int tile = (MODE == 0) ? ntile - 1 - it : it;
            __syncthreads();
            { const int key = F.tid >> 3, ch = F.tid & 7;
              const v4u kw = *(const GAS v4u*)(Kp + (rowbase + tile * 64 + key) * DM + h * 64 + ch * 8);
              const v4u vw = *(const GAS v4u*)(Vp + (rowbase + tile * 64 + key) * DM + h * 64 + ch * 8);
#pragma unroll
              for (int k = 0; k < 4; ++k) { Ks[key * 64 + ch * 8 + 2 * k] = bflo(kw[k]); Ks[key * 64 + ch * 8 + 2 * k + 1] = bfhi(kw[k]);
                                            Vs[key * 64 + ch * 8 + 2 * k] = bflo(vw[k]); Vs[key * 64 + ch * 8 + 2 * k + 1] = bfhi(vw[k]); }
              if (MODE == 2 && F.tid < 64) kb[F.tid] = -cum[(rowbase + tile * 64 + F.tid) * 16 + h]; }
            __syncthreads();
            for (int jj = 0; jj < 64; ++jj) {
                const int j = (MODE == 0) ? 63 - jj : jj; const int s = tile * 64 + j;
                float z = 0.f;
#pragma unroll
                for (int d4 = 0; d4 < 16; ++d4) { const f32x4 kv = *(const LAS f32x4*)(Ks + j * 64 + d4 * 4); z += q[d4 * 4] * kv.x + q[d4 * 4 + 1] * kv.y + q[d4 * 4 + 2] * kv.z + q[d4 * 4 + 3] * kv.w; }
                if (MODE == 0) {
                    const bool valid = s < t;
                    const float e = __builtin_amdgcn_exp2f(fminf(z, 100.f));
                    float r = 1.0f / (1.0f + e); float beta = 1.0f - r;
                    if (!valid) { r = 1.f; beta = 0.f; }
                    const float w = beta * P; P *= r;
#pragma unroll
                    for (int d4 = 0; d4 < 16; ++d4) { const f32x4 vv = *(const LAS f32x4*)(Vs + j * 64 + d4 * 4); acc[d4 * 4] += w * vv.x; acc[d4 * 4 + 1] += w * vv.y; acc[d4 * 4 + 2] += w * vv.z; acc[d4 * 4 + 3] += w * vv.w; }
                } else {
                    const bool valid = s <= t;
                    const float x = valid ? z + kb[j] : -INFINITY;
                    const float mn = fmaxf(mrun, x);
                    const float a = __builtin_amdgcn_exp2f(mrun - mn), pw = __builtin_amdgcn_exp2f(x - mn);
                    lrun = lrun * a + pw; mrun = mn;
#pragma unroll
                    for (int d4 = 0; d4 < 16; ++d4) { const f32x4 vv = *(const LAS f32x4*)(Vs + j * 64 + d4 * 4);
                        acc[d4 * 4] = acc[d4 * 4] * a + pw * vv.x; acc[d4 * 4 + 1] = acc[d4 * 4 + 1] * a + pw * vv.y; acc[d4 * 4 + 2] = acc[d4 * 4 + 2] * a + pw * vv.z; acc[d4 * 4 + 3] = acc[d4 * 4 + 3] * a + pw * vv.w; }
                }
            }
        }
        const float fin = (MODE == 0) ? 1.f : 1.0f / lrun;
        GAS v4u* op = (GAS v4u*)(O + (rowbase + t) * DM + h * 64);
#pragma unroll
        for (int c = 0; c < 8; ++c) { v4u w;
#pragma unroll
            for (int k = 0; k < 4; ++k) w[k] = pk2(acc[c * 8 + 2 * k] * fin, acc[c * 8 + 2 * k + 1] * fin);
            op[c] = w; }
    }
}

__device__ __forceinline__ int t5_bucket(int dist) {
    if (dist < 16) return dist;
    const float d = (float)dist;
    int lb = 16 + (int)(logf(d / 16.0f) / logf(128.0f) * 16.0f);
    return lb < 31 ? lb : 31;
}
__device__ __forceinline__ void attn_simple_dil(Frame& F, const bf16* PROJ, bf16* O, const float* rel_bias) {
    LAS float* tbl = (LAS float*)F.lds;
    for (int u = blockIdx.x; u < BATCH * NH * 4; u += F.G) {
        const int qblk = u & 3, bh = u >> 2, b = bh >> 4, h = bh & 15;
        const int t = qblk * 512 + F.tid;
        const size_t rowbase = (size_t)b * SEQ;
        __syncthreads();
        for (int i = F.tid; i < 3 * 129; i += NTHR) { const int g = i / 129, dl = i % 129, dil = (g == 0) ? 1 : (g == 1) ? 4 : 16;
            tbl[g * 132 + dl] = rel_bias[t5_bucket(dl * dil) * 16 + h] * LOG2E; }
        __syncthreads();
        float acc[64];
#pragma unroll
        for (int d = 0; d < 64; ++d) acc[d] = 0.f;
        float mrun = -INFINITY, lrun = 0.f;
        for (int g = 0; g < 3; ++g) {
            const int dil = (g == 0) ? 1 : (g == 1) ? 4 : 16;
            const bf16* Qg = PROJ + (size_t)(2 * g) * PLANE; const bf16* Kg = PROJ + (size_t)(2 * g + 1) * PLANE; const bf16* Vg = PROJ + (size_t)6 * PLANE;
            float q[64];
            { const GAS v4u* qp = (const GAS v4u*)(Qg + (rowbase + t) * DM + h * 64);
#pragma unroll
              for (int c = 0; c < 8; ++c) { const v4u w = qp[c];
#pragma unroll
                  for (int k = 0; k < 4; ++k) { q[c * 8 + 2 * k] = bflo(w[k]); q[c * 8 + 2 * k + 1] = bfhi(w[k]); } } }
            for (int dl = 0; dl <= 128; ++dl) {
                const int s = t - dl * dil; const bool valid = s >= 0; const int sc = valid ? s : 0;
                const GAS v4u* kp = (const GAS v4u*)(Kg + (rowbase + sc) * DM + h * 64);
                float z = 0.f;
#pragma unroll
                for (int c = 0; c < 8; ++c) { const v4u w = kp[c];
#pragma unroll
                    for (int k = 0; k < 4; ++k) z += q[c * 8 + 2 * k] * bflo(w[k]) + q[c * 8 + 2 * k + 1] * bfhi(w[k]); }
                const float x = valid ? z + tbl[g * 132 + dl] : -INFINITY;
                const float mn = fmaxf(mrun, x);
                const float a = __builtin_amdgcn_exp2f(mrun - mn), pw = __builtin_amdgcn_exp2f(x - mn);
                lrun = lrun * a + pw; mrun = mn;
                const GAS v4u* vp = (const GAS v4u*)(Vg + (rowbase + sc) * DM + h * 64);
#pragma unroll
                for (int c = 0; c < 8; ++c) { const v4u w = vp[c];
#pragma unroll
                    for (int k = 0; k < 4; ++k) { acc[c * 8 + 2 * k] = acc[c * 8 + 2 * k] * a + pw * bflo(w[k]); acc[c * 8 + 2 * k + 1] = acc[c * 8 + 2 * k + 1] * a + pw * bfhi(w[k]); } }
            }
        }
        const float fin = 1.0f / lrun;
        GAS v4u* op = (GAS v4u*)(O + (rowbase + t) * DM + h * 64);
#pragma unroll
        for (int c = 0; c < 8; ++c) { v4u w;
#pragma unroll
            for (int k = 0; k < 4; ++k) w[k] = pk2(acc[c * 8 + 2 * k] * fin, acc[c * 8 + 2 * k + 1] * fin);
            op[c] = w; }
    }
}

__device__ __forceinline__ void moe_gu_simple(Frame& F, int f, const bf16* H, bf16* ACT) {
    const int* list = (const int*)(F.ws + WS_MISC + MS_LIST) + (size_t)f * NE * LCAP;
    int base = 0;
    for (int e = 0; e < NE; ++e) {
        const int c = (int)__hip_atomic_load(F.ctl + CW_CNT + f * 64 + e, RLX_AGENT); const int nt = (c + 255) >> 8;
        if (nt) {
            SgP p{}; p.A = H; p.lda = DM; p.rowidx = list + e * LCAP; p.Mrows = nt * 256;
            p.W0 = INP(19) + ((size_t)f * NE + e) * DM * FF; p.W1 = INP(20) + ((size_t)f * NE + e) * DM * FF; p.ldw = FF; p.K = DM; p.N = FF;
            p.outb = ACT + (size_t)base * 256 * FF; p.ldo = FF;
            sgemm<EPI_SWIGLU>(F, p);
        }
        base += nt;
    }
}
__device__ __forceinline__ void moe_down_simple(Frame& F, int f, const bf16* ACT, float* Y) {
    const float* gw = (const float*)(F.ws + WS_MISC + MS_GW) + (size_t)f * NE * LCAP;
    int base = 0;
    for (int e = 0; e < NE; ++e) {
        const int c = (int)__hip_atomic_load(F.ctl + CW_CNT + f * 64 + e, RLX_AGENT); const int nt = (c + 255) >> 8;
        if (nt) {
            SgP p{}; p.A = ACT + (size_t)base * 256 * FF; p.lda = FF; p.rowidx = nullptr; p.Mrows = nt * 256;
            p.W0 = INP(21) + ((size_t)f * NE + e) * FF * DM; p.ldw = DM; p.K = FF; p.N = DM;
            p.outf = Y + (size_t)base * 256 * DM; p.gwv = gw + e * LCAP;
            sgemm<EPI_MOEDOWN>(F, p);
        }
        base += nt;
    }
}

struct Args { const float* in[22]; float* out; unsigned char* ws; int ph_lo, ph_hi; };
constexpr int N_PHASES = 32;

__global__ void __launch_bounds__(NTHR, 2) trunk_fwd(Args args) {
    extern __shared__ __attribute__((aligned(16))) unsigned char lds[];
    Frame F;
    F.lds = (LAS unsigned char*)lds;
    F.tid = threadIdx.x; F.lane = F.tid & 63; F.wave = __builtin_amdgcn_readfirstlane(F.tid >> 6); F.G = gridDim.x;
    F.ws = args.ws; F.ctl = (gu32*)(args.ws + WS_CTL); F.out = args.out;
    if (F.tid == 0) {
#pragma unroll
        for (int i = 0; i < 22; ++i) ((LAS unsigned long long*)(F.lds + PTR_OFF))[i] = (unsigned long long)args.in[i];
    }
    volatile LAS unsigned* MISC = (volatile LAS unsigned*)(F.lds + MISC_OFF);
    if (F.tid < 32) MISC[F.tid] = 0u;
    __syncthreads();
    XcdBarrier bar; bar.bar = (unsigned*)(F.ctl + CW_BAR); bar.x = 0; bar.st = nullptr;
    const int lo = args.ph_lo, hi = args.ph_hi;
    if (hi - lo > 1) bar = xcd_barrier_post((unsigned*)(F.ctl + CW_BAR), MISC + 8);
#ifndef PHSEL
#define PHSEL 0xFFFFFFFFull
#endif
#define IN(k) (lo <= (k) && (k) < hi && ((PHSEL >> (k)) & 1ull) && relaunder(F))
#define SEAM(k) do { if (IN((k) + 1) && IN(k)) xcd_barrier(bar); } while (0)

    bf16* H = (bf16*)(F.ws + WS_H);
    bf16* PROJ = (bf16*)(F.ws + WS_R1);
    bf16* ACT = (bf16*)(F.ws + WS_R1);
    bf16* O = (bf16*)(F.ws + WS_R2);
    float* Y = (float*)(F.ws + WS_R2);
    float* X = F.out;
    const float* cum = (const float*)(F.ws + WS_MISC + MS_CUM);

    if (IN(0)) {
        unsigned* z = (unsigned*)(F.ws + WS_MISC + MS_LIST);
        for (int i = blockIdx.x * NTHR + F.tid; i < (int)(2 * MiB / 4); i += F.G * NTHR) z[i] = 0u;
        SEAM(0);
    }
    if (IN(1)) { norm_phase<0>(F, INP(0), nullptr, INP(13) + 0 * DM, H, 0, 0, nullptr, nullptr, nullptr); SEAM(1); }
    if (IN(2)) { SgP p{}; p.A = H; p.lda = DM; p.Mrows = M; p.W0 = INP(1); p.ldw = 3 * DM; p.K = DM; p.N = 3 * DM; p.outb = PROJ; p.scale0 = C2; sgemm<EPI_PLANES>(F, p); SEAM(2); }
    if (IN(3)) { attn_simple_causal<0>(F, PROJ, PROJ + PLANE, PROJ + 2 * PLANE, O, nullptr); SEAM(3); }
    if (IN(4)) { SgP p{}; p.A = O; p.lda = DM; p.Mrows = M; p.W0 = INP(2); p.ldw = DM; p.K = DM; p.N = DM; p.base = INP(0); p.outf = X; sgemm<EPI_RESID>(F, p); SEAM(4); }
    if (IN(5)) { norm_phase<0>(F, X, nullptr, INP(14) + 0 * DM, H, 0, 0, nullptr, nullptr, nullptr); SEAM(5); }
    if (IN(6)) { SgP p{}; p.A = H; p.lda = DM; p.Mrows = M; p.W0 = INP(15); p.W1 = INP(16); p.ldw = FF; p.K = DM; p.N = FF; p.outb = ACT; p.ldo = FF; sgemm<EPI_SWIGLU>(F, p); SEAM(6); }
    if (IN(7)) { SgP p{}; p.A = ACT; p.lda = FF; p.Mrows = M; p.W0 = INP(17); p.ldw = DM; p.K = FF; p.N = DM; p.base = X; p.outf = X; sgemm<EPI_RESID>(F, p); SEAM(7); }
    if (IN(8)) { norm_phase<0>(F, X, nullptr, INP(13) + 1 * DM, H, 0, 0, nullptr, nullptr, nullptr); SEAM(8); }
    if (IN(9)) { SgP p{}; p.A = H; p.lda = DM; p.Mrows = M; p.W0 = INP(3); p.ldw = 7 * DM; p.K = DM; p.N = 7 * DM; p.outb = PROJ; p.scale0 = 1.f; sgemm<EPI_PLANES>(F, p); SEAM(9); }
    if (IN(10)) {
        for (int g = 0; g < 3; ++g) { qknorm_plane(F, PROJ + (size_t)(2 * g) * PLANE, INP(4) + g * 64, C2); qknorm_plane(F, PROJ + (size_t)(2 * g + 1) * PLANE, INP(5) + g * 64, 1.f); }
        SEAM(10); }
    if (IN(11)) { attn_simple_dil(F, PROJ, O, INP(12)); SEAM(11); }
    if (IN(12)) { SgP p{}; p.A = O; p.lda = DM; p.Mrows = M; p.W0 = INP(6); p.ldw = DM; p.K = DM; p.N = DM; p.base = X; p.outf = X; sgemm<EPI_RESID>(F, p); SEAM(12); }
    if (IN(13)) { norm_phase<4>(F, X, nullptr, INP(14) + 1 * DM, H, 0, 0, nullptr, nullptr, INP(18) + 0 * DM * NE); SEAM(13); }
    if (IN(14)) { moe_gu_simple(F, 0, H, ACT); SEAM(14); }
    if (IN(15)) { moe_down_simple(F, 0, ACT, Y); SEAM(15); }
    if (IN(16)) { norm_phase<1 | 2>(F, X, X, INP(13) + 2 * DM, H, 0, 0, INP(7), INP(8), nullptr); SEAM(16); }
    if (IN(17)) { cumsum_phase(F);
        SgP p{}; p.A = H; p.lda = DM; p.Mrows = M; p.W0 = INP(7); p.ldw = 3088; p.K = DM; p.N = 3 * DM; p.outb = PROJ; p.scale0 = 1.f; sgemm<EPI_PLANES>(F, p); SEAM(17); }
    if (IN(18)) { qknorm_plane(F, PROJ, INP(9), C2); qknorm_plane(F, PROJ + PLANE, INP(10), 1.f); SEAM(18); }
    if (IN(19)) { attn_simple_causal<2>(F, PROJ, PROJ + PLANE, PROJ + 2 * PLANE, O, cum); SEAM(19); }
    if (IN(20)) { SgP p{}; p.A = O; p.lda = DM; p.Mrows = M; p.W0 = INP(11); p.ldw = DM; p.K = DM; p.N = DM; p.base = X; p.outf = X; sgemm<EPI_RESID>(F, p); SEAM(20); }
    if (IN(21)) { norm_phase<0>(F, X, nullptr, INP(14) + 2 * DM, H, 0, 0, nullptr, nullptr, nullptr); SEAM(21); }
    if (IN(22)) { SgP p{}; p.A = H; p.lda = DM; p.Mrows = M; p.W0 = INP(15) + (size_t)DM * FF; p.W1 = INP(16) + (size_t)DM * FF; p.ldw = FF; p.K = DM; p.N = FF; p.outb = ACT; p.ldo = FF; sgemm<EPI_SWIGLU>(F, p); SEAM(22); }
    if (IN(23)) { SgP p{}; p.A = ACT; p.lda = FF; p.Mrows = M; p.W0 = INP(17) + (size_t)FF * DM; p.ldw = DM; p.K = FF; p.N = DM; p.base = X; p.outf = X; sgemm<EPI_RESID>(F, p); SEAM(23); }
    if (IN(24)) { norm_phase<0>(F, X, nullptr, INP(13) + 3 * DM, H, 0, 0, nullptr, nullptr, nullptr); SEAM(24); }
    if (IN(25)) { SgP p{}; p.A = H; p.lda = DM; p.Mrows = M; p.W0 = INP(1) + (size_t)DM * 3 * DM; p.ldw = 3 * DM; p.K = DM; p.N = 3 * DM; p.outb = PROJ; p.scale0 = C2; sgemm<EPI_PLANES>(F, p); SEAM(25); }
    if (IN(26)) { attn_simple_causal<0>(F, PROJ, PROJ + PLANE, PROJ + 2 * PLANE, O, nullptr); SEAM(26); }
    if (IN(27)) { SgP p{}; p.A = O; p.lda = DM; p.Mrows = M; p.W0 = INP(2) + (size_t)DM * DM; p.ldw = DM; p.K = DM; p.N = DM; p.base = X; p.outf = X; sgemm<EPI_RESID>(F, p); SEAM(27); }
    if (IN(28)) { norm_phase<4>(F, X, nullptr, INP(14) + 3 * DM, H, 0, 1, nullptr, nullptr, INP(18) + 1 * DM * NE); SEAM(28); }
    if (IN(29)) { moe_gu_simple(F, 1, H, ACT); SEAM(29); }
    if (IN(30)) { moe_down_simple(F, 1, ACT, Y); SEAM(30); }
    if (IN(31)) { final_combine(F, 1); }
#undef IN
#undef SEAM
}

extern "C" void kernel_launch(void* const* d_in, const int* in_sizes, int n_in, void* d_out, int out_size, void* d_ws, size_t ws_size, hipStream_t stream) {
    static int grid = 0;
    if (grid == 0) {
        if (n_in != 22 || out_size != M * DM || ws_size < WS_END) { fprintf(stderr, "kernel_launch: unexpected shapes (n_in %d out %d ws %zu)\n", n_in, out_size, ws_size); grid = -1; return; }
        int dev = 0, cus = 0, per_cu = 0;
        if (hipGetDevice(&dev) != hipSuccess || hipDeviceGetAttribute(&cus, hipDeviceAttributeMultiprocessorCount, dev) != hipSuccess) { grid = -1; return; }
        if (hipFuncSetAttribute((const void*)trunk_fwd, hipFuncAttributeMaxDynamicSharedMemorySize, LDS_BYTES) != hipSuccess) { fprintf(stderr, "kernel_launch: hipFuncSetAttribute failed\n"); grid = -1; return; }
        if (hipOccupancyMaxActiveBlocksPerMultiprocessor(&per_cu, (const void*)trunk_fwd, NTHR, LDS_BYTES) != hipSuccess || per_cu < 1) fprintf(stderr, "kernel_launch: occupancy query says %d\n", per_cu);
        (void)hipGetLastError();
        grid = cus;
    }
    if (grid < 0) return;
    (void)hipMemsetAsync((char*)d_ws + WS_CTL, 0, CTL_ZERO_BYTES, stream);
    Args a{};
    for (int i = 0; i < 22; ++i) a.in[i] = (const float*)d_in[i];
    a.out = (float*)d_out; a.ws = (unsigned char*)d_ws;
#if MK_MULTI
    for (int p = 0; p < N_PHASES; ++p) { a.ph_lo = p; a.ph_hi = p + 1; hipLaunchKernelGGL(trunk_fwd, dim3(grid), dim3(NTHR), LDS_BYTES, stream, a); }
#else
    a.ph_lo = 0; a.ph_hi = N_PHASES;
    hipLaunchKernelGGL(trunk_fwd, dim3(grid), dim3(NTHR), LDS_BYTES, stream, a);
#endif
}
```

```cpp
#include <hip/hip_runtime.h>
#include <cstdio>
#include <cstdint>

#ifndef MK_MULTI
#define MK_MULTI 0
#endif

constexpr int BATCH = 8, SEQ = 2048, DM = 1024, NH = 16, HD = 64, FF = 3584, NE = 8;
constexpr int M = BATCH * SEQ;
constexpr float RMS_EPS = 1e-6f;
constexpr float LOG2E = 1.4426950408889634f;
constexpr float C2 = 0.125f * LOG2E;
constexpr int NWAVES = 8, NTHR = 512;
constexpr int LCAP = 16384;
constexpr int MAXROWS = 34816;

constexpr size_t MiB = 1u << 20;
constexpr size_t WS_CTL = 0, CTL_ZERO_BYTES = 1 * MiB;
constexpr size_t WS_MISC = 1 * MiB;
constexpr size_t WS_H = 6 * MiB;
constexpr size_t WS_R1 = 38 * MiB;
constexpr size_t WS_R2 = 278 * MiB;
constexpr size_t WS_W = 414 * MiB;
constexpr size_t WS_END = 832 * MiB;
constexpr size_t PLANE = (size_t)M * DM;
constexpr size_t WE_QKV = 0;
constexpr size_t WE_WO_SB = WE_QKV + 2ull * 3072 * 1024;
constexpr size_t WE_WO_DIL = WE_WO_SB + 2ull * 1024 * 1024;
constexpr size_t WE_WO_FOX = WE_WO_DIL + 1024ull * 1024;
constexpr size_t WE_IN_DIL = WE_WO_FOX + 1024ull * 1024;
constexpr size_t WE_IN_FOX = WE_IN_DIL + 7168ull * 1024;
constexpr size_t WE_GU = WE_IN_FOX + 3072ull * 1024;
constexpr size_t WE_D = WE_GU + 2ull * 7168 * 1024;
constexpr size_t WE_MGU = WE_D + 2ull * 1024 * 3584;
constexpr size_t WE_MD = WE_MGU + 16ull * 7168 * 1024;
constexpr size_t WE_END = WE_MD + 16ull * 1024 * 3584;
static_assert(WS_W + WE_END * 2 <= WS_END, "weight copies fit");
constexpr size_t MS_LIST = 0;
constexpr size_t MS_GW = 1 * MiB;
constexpr size_t MS_TOK = 2 * MiB;
constexpr size_t MS_LOGF = 2 * MiB + 256 * 1024;
constexpr size_t MS_CUM = 3 * MiB + 256 * 1024;
constexpr int CW_BAR = 4096;
constexpr int CW_CNT = 64;

#define GAS __attribute__((address_space(1)))
#define LAS __attribute__((address_space(3)))
typedef unsigned short bf16;
typedef unsigned v4u __attribute__((ext_vector_type(4)));
typedef unsigned v2u __attribute__((ext_vector_type(2)));
typedef float f32x4 __attribute__((ext_vector_type(4)));
typedef float f32x2 __attribute__((ext_vector_type(2)));
typedef GAS unsigned gu32;
#define RLX_AGENT __ATOMIC_RELAXED, __HIP_MEMORY_SCOPE_AGENT
__device__ __forceinline__ unsigned f2bf(float f) { unsigned u = __builtin_bit_cast(unsigned, f); return (u + 0x7fffu + ((u >> 16) & 1u)) >> 16; }
__device__ __forceinline__ unsigned pk2(float lo, float hi) { return f2bf(lo) | (f2bf(hi) << 16); }
__device__ __forceinline__ float bflo(unsigned u) { return __builtin_bit_cast(float, u << 16); }
__device__ __forceinline__ float bfhi(unsigned u) { return __builtin_bit_cast(float, u & 0xffff0000u); }

#define XB_TMO      128
#define XB_XCNT(j)  (256  + 64 * (j))
#define XB_XSUB(j)  (1280 + 64 * (j))
#define XB_XGEN(j)  (2304 + 64 * (j))
#define XB_TOP      3328
#define XB_TOPGEN   3392
#define XCD_BAR_WORDS 3456
#define XB_SPIN_CAP (1u << 22)
__device__ __forceinline__ unsigned xb_ld(unsigned* p)              { return __hip_atomic_load(p, __ATOMIC_RELAXED, __HIP_MEMORY_SCOPE_AGENT); }
__device__ __forceinline__ unsigned xb_add(unsigned* p, unsigned v) { return __hip_atomic_fetch_add(p, v, __ATOMIC_RELAXED, __HIP_MEMORY_SCOPE_AGENT); }
__device__ __forceinline__ unsigned xb_xcc_id() { return (unsigned)__builtin_amdgcn_s_getreg((3 << 11) | 20) & 0xFu; }
#define XB_SPIN(cond, bar) do { unsigned _sp = 0; while (cond) { __builtin_amdgcn_s_sleep(1); \
    if ((++_sp & 255u) == 0u) { if (xb_ld(&(bar)[XB_TMO])) break; if (_sp > XB_SPIN_CAP) { atomicAdd(&(bar)[XB_TMO], 1u); break; } } } } while (0)
struct XcdBarrier { unsigned* bar; unsigned x; volatile LAS unsigned* st; };
__device__ __forceinline__ XcdBarrier xcd_barrier_post(unsigned* bar, volatile LAS unsigned* st) {
    XcdBarrier b; b.bar = bar; b.x = xb_xcc_id(); b.st = st;
    if (threadIdx.x == 0) (void)xb_add(&bar[XB_XCNT(b.x)], 1u);
    return b;
}
__device__ __forceinline__ void xcd_barrier_complete(unsigned* bar, unsigned x, unsigned& nloc, unsigned& nx) {
    const unsigned G = gridDim.x * gridDim.y * gridDim.z;
    unsigned sum, cnt, mine, sp = 0u;
    for (;;) {
        sum = 0u; cnt = 0u; mine = 0u;
#pragma unroll
        for (unsigned j = 0; j < 16; ++j) { const unsigned c = xb_ld(&bar[XB_XCNT(j)]); sum += c; cnt += (c > 0u) ? 1u : 0u; mine = (j == x) ? c : mine; }
        if (sum == G) break;
        __builtin_amdgcn_s_sleep(1);
        if ((++sp & 255u) == 0u) { if (xb_ld(&bar[XB_TMO])) break; if (sp > XB_SPIN_CAP) { atomicAdd(&bar[XB_TMO], 1u); break; } }
    }
    nloc = mine > 0u ? mine : 1u; nx = cnt > 0u ? cnt : 1u;
}
__device__ __forceinline__ void xcd_barrier(const XcdBarrier& b) {
    asm volatile("s_waitcnt vmcnt(0)" ::: "memory");
    __syncthreads();
    if (threadIdx.x == 0) {
        unsigned* bar = b.bar;
        __builtin_amdgcn_s_waitcnt(0);
        unsigned nloc = b.st[0], nx = b.st[1];
        if (nloc == 0u) { xcd_barrier_complete(bar, b.x, nloc, nx); b.st[0] = nloc; b.st[1] = nx; }
        const unsigned old = xb_add(&bar[XB_XSUB(b.x)], 1u);
        const unsigned gen = old / nloc;
        if (old + 1u == (gen + 1u) * nloc) {
            __builtin_amdgcn_fence(__ATOMIC_RELEASE, "agent");
            asm volatile("s_waitcnt vmcnt(0)" ::: "memory");
            const unsigned og = xb_add(&bar[XB_TOP], 1u);
            const unsigned tg = og / nx;
            if (og + 1u == (tg + 1u) * nx) xb_add(&bar[XB_TOPGEN], 1u);
            else XB_SPIN(xb_ld(&bar[XB_TOPGEN]) == tg, bar);
            __builtin_amdgcn_fence(__ATOMIC_ACQUIRE, "agent");
            xb_add(&bar[XB_XGEN(b.x)], 1u);
            asm volatile("s_waitcnt vmcnt(0)" ::: "memory");
        } else {
            XB_SPIN(xb_ld(&bar[XB_XGEN(b.x)]) == gen, bar);
            __builtin_amdgcn_fence(__ATOMIC_ACQUIRE, "agent");
            asm volatile("s_waitcnt vmcnt(0)" ::: "memory");
        }
    }
    __syncthreads();
}

constexpr int LDS_BYTES = 147456;
constexpr int MISC_OFF = 131072 + 320;
struct Frame {
    LAS unsigned char* lds;
    int tid, lane, wave, G;
    unsigned char* ws; gu32* ctl;
    float* out;
};
__device__ __forceinline__ float wave_sum(float v) {
#pragma unroll
    for (int o = 1; o < 64; o <<= 1) v += __shfl_xor(v, o);
    return v;
}

constexpr int PTR_OFF = 131072 + 512;
__device__ __forceinline__ const float* inp_ptr(Frame& F, int k) {
    const LAS unsigned* t = (const LAS unsigned*)(F.lds + PTR_OFF) + 2 * k;
    const unsigned lo = __builtin_amdgcn_readfirstlane(t[0]), hi = __builtin_amdgcn_readfirstlane(t[1]);
    return (const float*)(((unsigned long long)hi << 32) | lo);
}
#define INP(k) inp_ptr(F, (k))
__device__ __forceinline__ bool relaunder(Frame& F) { int t_ = threadIdx.x; asm volatile("" : "+v"(t_)); F.tid = t_; F.lane = t_ & 63; F.wave = __builtin_amdgcn_readfirstlane(t_ >> 6); return true; }
namespace pg8 {
#define PG8_LAS __attribute__((address_space(3)))
typedef unsigned short bf16_t;
typedef short bf16x8 __attribute__((ext_vector_type(8)));
typedef unsigned u32x4 __attribute__((ext_vector_type(4)));
constexpr int BM = 256, BK = 64, HALF = 128, HTB = HALF * BK * 2, STAGE_BYTES = 8 * HTB, NXCD = 8, WGM = 8;
__host__ __device__ __forceinline__ int lds_byte(int r, int c) { const int st = (r >> 4) * 2 + (c >> 5), rr = r & 15, cc = c & 31, ob = rr * 64 + cc * 2; return st * 1024 + (ob ^ (((ob >> 9) & 1) << 5)); }
__host__ __device__ __forceinline__ void stage_rc(int b, int& R, int& C) { const int st = b / 1024, sb = b % 1024, swz = sb ^ (((sb >> 9) & 1) << 5); R = (st >> 1) * 16 + swz / 64; C = (st & 1) * 32 + (swz % 64) / 2; }
__host__ __device__ __forceinline__ int perm32(int rho) { const int n = rho >> 4, i = rho & 15; return 8 * (i >> 2) + 4 * n + (i & 3); }
struct Unit { int pm, pn, e, mt; };

struct DenseOrder {
    int nM, nN, nwg, G, c; const char* A; const char* Bt; size_t tstep;
    __device__ __forceinline__ void init(const bf16_t* A_, const bf16_t* Bt_, int M_, int N_, int K_, int G_, int c_) { nM = M_ / BM; nN = N_ / BM; nwg = nM * nN; G = G_; c = c_; A = (const char*)A_; Bt = (const char*)Bt_; tstep = (size_t)BM * K_ * 2; }
    __device__ __forceinline__ bool next(int i, Unit& u) const {
        const long L = (long)i * G + c; if (L >= nwg) return false;
        int wgid = (int)L; { const int q = nwg / NXCD, r = nwg % NXCD, xcd = wgid % NXCD, off = wgid / NXCD; wgid = (xcd < r ? xcd * (q + 1) : r * (q + 1) + (xcd - r) * q) + off; }
        const int nig = WGM * nN, gid = wgid / nig, fm = gid * WGM, gsz = (nM - fm) < WGM ? (nM - fm) : WGM;
        u.pm = fm + ((wgid % nig) % gsz); u.pn = (wgid % nig) / gsz; u.e = 0; u.mt = u.pm; return true;
    }
    __device__ __forceinline__ const char* a_base(const Unit& u) const { return A + (size_t)u.pm * tstep; }
    __device__ __forceinline__ const char* b_base(const Unit& u) const { return Bt + (size_t)u.pn * tstep; }
    __device__ __forceinline__ void a_voff(const Unit&, const int (&)[2], const int (&)[2], unsigned (&)[2][2]) const {}
};
struct MoeOrder {
    int t1, t2, t3, t4, t5, t6, t7, t8, nN, G, c, K; const char* A; const char* Bt; size_t tstepA, tstepB, estepB; const int* list; bool gather;
    __device__ __forceinline__ bool next(int i, Unit& u) const {
        const int L = i * G + c; if (L >= t8 * nN) return false;
        const int mt = L / nN; u.pm = mt; u.pn = L - mt * nN;
        const int e = (mt >= t1) + (mt >= t2) + (mt >= t3) + (mt >= t4) + (mt >= t5) + (mt >= t6) + (mt >= t7);
        const int tb = e == 0 ? 0 : e == 1 ? t1 : e == 2 ? t2 : e == 3 ? t3 : e == 4 ? t4 : e == 5 ? t5 : e == 6 ? t6 : t7;
        u.e = e; u.mt = mt - tb; return true;
    }
    __device__ __forceinline__ const char* a_base(const Unit& u) const { return gather ? A : A + (size_t)u.pm * tstepA; }
    __device__ __forceinline__ const char* b_base(const Unit& u) const { return Bt + (size_t)u.e * estepB + (size_t)u.pn * tstepB; }
    __device__ __forceinline__ void a_voff(const Unit& u, const int (&sR)[2], const int (&sC)[2], unsigned (&v)[2][2]) const {
        const int* lp = list + u.e * LCAP + u.mt * 256;
#pragma unroll
        for (int h = 0; h < 2; ++h)
#pragma unroll
            for (int i = 0; i < 2; ++i) v[h][i] = (unsigned)lp[h * 128 + sR[i]] * (unsigned)(K * 2) + (unsigned)(sC[i] * 2);
    }
};

__device__ __forceinline__ unsigned cvt_pk_bf16(float lo, float hi) { unsigned r; asm volatile("v_cvt_pk_bf16_f32 %0, %1, %2" : "=v"(r) : "v"(lo), "v"(hi)); return r; }

struct EpiPlanes {
    static constexpr bool PERM = true;
    bf16_t* O; float scale0;
    __device__ __forceinline__ void operator()(const f32x4 (&acc)[2][2][4][2], const Unit& u, int wr, int wc, int fr, int fq) const {
        const int plane = u.pn >> 2; const float sc = plane == 0 ? scale0 : 1.f;
        bf16_t* base = O + (size_t)plane * PLANE + (size_t)(u.pm * BM + wr * 64 + fr) * DM + (u.pn & 3) * 256 + wc * 32 + 8 * fq;
#pragma unroll
        for (int ai = 0; ai < 2; ++ai)
#pragma unroll
            for (int m = 0; m < 4; ++m) { bf16_t* rowp = base + (size_t)(ai * HALF + m * 16) * DM;
#pragma unroll
                for (int bj = 0; bj < 2; ++bj) { const f32x4 v0 = acc[ai][bj][m][0] * sc, v1 = acc[ai][bj][m][1] * sc;
                    u32x4 w; w.x = cvt_pk_bf16(v0[0], v0[1]); w.y = cvt_pk_bf16(v0[2], v0[3]); w.z = cvt_pk_bf16(v1[0], v1[1]); w.w = cvt_pk_bf16(v1[2], v1[3]);
                    *(u32x4*)(rowp + bj * HALF) = w; } }
    }
};
struct EpiQKNorm {
    static constexpr bool PERM = true;
    bf16_t* O; const float* qg; const float* kg; int vplane;
    __device__ __forceinline__ void operator()(const f32x4 (&acc)[2][2][4][2], const Unit& u, int wr, int wc, int fr, int fq) const {
        const int plane = u.pn >> 2; const bool isv = plane == vplane; const bool isq = !isv && ((plane & 1) == 0); const int grp = plane >> 1;
        const float* g = (isq ? qg : kg) + grp * 64 + 8 * fq;
        f32x4 gv[2][2];
#pragma unroll
        for (int bj = 0; bj < 2; ++bj)
#pragma unroll
            for (int n = 0; n < 2; ++n) gv[bj][n] = isv ? (f32x4){1.f, 1.f, 1.f, 1.f} : *(const f32x4*)(g + 32 * bj + 4 * n);
        const float mul = isq ? C2 : 1.f;
        bf16_t* base = O + (size_t)plane * PLANE + (size_t)(u.pm * BM + wr * 64 + fr) * DM + (u.pn & 3) * 256 + wc * 64 + 8 * fq;
#pragma unroll
        for (int ai = 0; ai < 2; ++ai)
#pragma unroll
            for (int m = 0; m < 4; ++m) { bf16_t* rowp = base + (size_t)(ai * HALF + m * 16) * DM;
                float ss = 0.f;
#pragma unroll
                for (int bj = 0; bj < 2; ++bj)
#pragma unroll
                    for (int n = 0; n < 2; ++n) { const f32x4 x = acc[ai][bj][m][n]; ss += (x[0] * x[0] + x[1] * x[1]) + (x[2] * x[2] + x[3] * x[3]); }
                ss += __shfl_xor(ss, 16); ss += __shfl_xor(ss, 32);
                const float inv = isv ? 1.f : mul / sqrtf(ss * (1.f / 64.f) + RMS_EPS);
#pragma unroll
                for (int bj = 0; bj < 2; ++bj) { const f32x4 v0 = acc[ai][bj][m][0] * inv * gv[bj][0], v1 = acc[ai][bj][m][1] * inv * gv[bj][1];
                    u32x4 w; w.x = cvt_pk_bf16(v0[0], v0[1]); w.y = cvt_pk_bf16(v0[2], v0[3]); w.z = cvt_pk_bf16(v1[0], v1[1]); w.w = cvt_pk_bf16(v1[2], v1[3]);
                    *(u32x4*)(rowp + bj * 32) = w; } }
    }
};
struct EpiSwiglu {
    static constexpr bool PERM = true;
    bf16_t* O;
    __device__ __forceinline__ void operator()(const f32x4 (&acc)[2][2][4][2], const Unit& u, int wr, int wc, int fr, int fq) const {
        bf16_t* base = O + (size_t)(u.pm * BM + wr * 64 + fr) * FF + u.pn * 128 + wc * 32 + 8 * fq;
#pragma unroll
        for (int ai = 0; ai < 2; ++ai)
#pragma unroll
            for (int m = 0; m < 4; ++m) { bf16_t* rowp = base + (size_t)(ai * HALF + m * 16) * FF;
                float o[8];
#pragma unroll
                for (int n = 0; n < 2; ++n)
#pragma unroll
                    for (int i = 0; i < 4; ++i) { const float g = acc[ai][0][m][n][i], uu = acc[ai][1][m][n][i];
                        o[n * 4 + i] = g * __builtin_amdgcn_rcpf(1.0f + __builtin_amdgcn_exp2f(-g * LOG2E)) * uu; }
                u32x4 w; w.x = cvt_pk_bf16(o[0], o[1]); w.y = cvt_pk_bf16(o[2], o[3]); w.z = cvt_pk_bf16(o[4], o[5]); w.w = cvt_pk_bf16(o[6], o[7]);
                *(u32x4*)rowp = w; }
    }
};
struct EpiResid {
    static constexpr bool PERM = false;
    const float* base; float* out;
    __device__ __forceinline__ void operator()(const f32x4 (&acc)[2][2][4][2], const Unit& u, int wr, int wc, int fr, int fq) const {
        const size_t off0 = (size_t)(u.pm * BM + wr * 64 + fr) * DM + u.pn * BM + wc * 32 + 4 * fq;
#pragma unroll
        for (int ai = 0; ai < 2; ++ai)
#pragma unroll
            for (int m = 0; m < 4; ++m) { const size_t off = off0 + (size_t)(ai * HALF + m * 16) * DM;
#pragma unroll
                for (int bj = 0; bj < 2; ++bj)
#pragma unroll
                    for (int n = 0; n < 2; ++n) { const f32x4 b = *(const f32x4*)(base + off + bj * HALF + n * 16); *(f32x4*)(out + off + bj * HALF + n * 16) = b + acc[ai][bj][m][n]; } }
    }
};
struct EpiMoeDown {
    static constexpr bool PERM = false;
    float* Y; const float* gw;
    __device__ __forceinline__ void operator()(const f32x4 (&acc)[2][2][4][2], const Unit& u, int wr, int wc, int fr, int fq) const {
        const size_t off0 = (size_t)(u.pm * BM + wr * 64 + fr) * DM + u.pn * BM + wc * 32 + 4 * fq;
        const float* gp = gw + u.e * LCAP + u.mt * 256 + wr * 64 + fr;
#pragma unroll
        for (int ai = 0; ai < 2; ++ai)
#pragma unroll
            for (int m = 0; m < 4; ++m) { const size_t off = off0 + (size_t)(ai * HALF + m * 16) * DM; const float g = gp[ai * HALF + m * 16];
#pragma unroll
                for (int bj = 0; bj < 2; ++bj)
#pragma unroll
                    for (int n = 0; n < 2; ++n) *(f32x4*)(Y + off + bj * HALF + n * 16) = acc[ai][bj][m][n] * g; }
    }
};

template <class Epi, class Sched, bool GATHER>
__device__ __forceinline__ void gemm_phase(PG8_LAS unsigned char* lds, const int K, const Sched& S, const Epi& E) {
    const int tid = threadIdx.x, wid = __builtin_amdgcn_readfirstlane(tid >> 6), lane = tid & 63, wr = wid >> 2, wc = wid & 3, fr = lane & 15, fq = lane >> 4;
    const int nt = K / BK;
    unsigned voffA[2], voffB[2]; int sR[2], sC[2];
#pragma unroll
    for (int i = 0; i < 2; ++i) { int R, C; stage_rc(tid * 16 + i * 8192, R, C); const int Rb = Epi::PERM ? ((R & ~31) + perm32(R & 31)) : R;
        voffA[i] = (unsigned)(R * K + C) * 2u; voffB[i] = (unsigned)(Rb * K + C) * 2u; sR[i] = R; sC[i] = C; }
    const size_t kstep = (size_t)(BK * 2);
    const size_t hstep = (size_t)HALF * K * 2;
    const unsigned ldsw = (unsigned)wid * 1024u;
    const int aoff = lds_byte(wr * 64 + fr, fq * 8), boff = lds_byte(wc * 32 + fr, fq * 8);
#define PG8_SA(b, h) (((b) * 2 + (h)) * HTB)
#define PG8_SB(b, h) ((4 + (b) * 2 + (h)) * HTB)
#define PG8_STAGE(bufoff, gbase, voff) do { _Pragma("unroll") for (int _i = 0; _i < 2; ++_i) \
        __builtin_amdgcn_global_load_lds((const unsigned*)((const char*)(gbase) + (voff)[_i]), (PG8_LAS unsigned*)(lds + (bufoff) + ldsw + _i * 8192), 16, 0, 0); } while (0)
#define PG8_STAGE_A(bufoff, p, h, VG) do { if (GATHER) { PG8_STAGE(bufoff, p, VG[h]); } else { PG8_STAGE(bufoff, (p) + ((h) ? hstep : 0), voffA); } } while (0)
#define PG8_LDA(dst, b, h) do { _Pragma("unroll") for (int m = 0; m < 4; ++m) _Pragma("unroll") for (int k = 0; k < 2; ++k) dst[m][k] = *(const PG8_LAS bf16x8*)(lds + PG8_SA(b, h) + aoff + m * 2048 + k * 1024); } while (0)
#define PG8_LDB(dst, b, h) do { _Pragma("unroll") for (int n = 0; n < 2; ++n) _Pragma("unroll") for (int k = 0; k < 2; ++k) dst[n][k] = *(const PG8_LAS bf16x8*)(lds + PG8_SB(b, h) + boff + n * 2048 + k * 1024); } while (0)
#define PG8_MMA(ai, bj, At, Bt) do { __builtin_amdgcn_s_setprio(1); _Pragma("unroll") for (int m = 0; m < 4; ++m) _Pragma("unroll") for (int n = 0; n < 2; ++n) _Pragma("unroll") for (int k = 0; k < 2; ++k) \
        acc[ai][bj][m][n] = __builtin_amdgcn_mfma_f32_16x16x32_bf16(Bt[n][k], At[m][k], acc[ai][bj][m][n], 0, 0, 0); __builtin_amdgcn_s_setprio(0); } while (0)
#define PG8_WAIT_V(n) asm volatile("s_waitcnt vmcnt(" #n ")" ::: "memory")
#define PG8_WAIT_L(n) asm volatile("s_waitcnt lgkmcnt(" #n ")" ::: "memory")
#define PG8_BAR __builtin_amdgcn_s_barrier()
#define PG8_SCHED __builtin_amdgcn_sched_barrier(0)
    Unit cur, nxt; int ui = 0;
    if (!S.next(0, cur)) return;
    f32x4 acc[2][2][4][2];
#pragma unroll
    for (int a = 0; a < 2; ++a)
#pragma unroll
        for (int b = 0; b < 2; ++b)
#pragma unroll
            for (int m = 0; m < 4; ++m)
#pragma unroll
                for (int n = 0; n < 2; ++n) acc[a][b][m][n] = (f32x4){0.f, 0.f, 0.f, 0.f};
    bf16x8 At[4][2], B0[2][2], B1[2][2];
    const char* cA = S.a_base(cur); const char* cB = S.b_base(cur);
    unsigned vc[2][2] = {{0u, 0u}, {0u, 0u}}, vn[2][2] = {{0u, 0u}, {0u, 0u}};
    if (GATHER) { S.a_voff(cur, sR, sC, vc); asm volatile("s_waitcnt vmcnt(0)" : "+v"(vc[0][0]), "+v"(vc[0][1]), "+v"(vc[1][0]), "+v"(vc[1][1]) :: "memory"); }
    PG8_STAGE(PG8_SB(0, 0), cB, voffB); PG8_STAGE(PG8_SB(0, 1), cB + hstep, voffB); PG8_STAGE_A(PG8_SA(0, 0), cA, 0, vc); PG8_STAGE_A(PG8_SA(0, 1), cA, 1, vc);
    if (wr == 1) PG8_BAR;
    PG8_WAIT_V(2); PG8_BAR;
    PG8_STAGE(PG8_SB(1, 0), cB + kstep, voffB); PG8_STAGE_A(PG8_SA(1, 0), cA + kstep, 0, vc); PG8_STAGE(PG8_SB(1, 1), cB + hstep + kstep, voffB);
    PG8_WAIT_V(6); PG8_BAR;
    for (;;) {
        const bool has_next = S.next(ui + 1, nxt);
        const char* nA = has_next ? S.a_base(nxt) : cA; const char* nB = has_next ? S.b_base(nxt) : cB;
        if (GATHER) {
            if (has_next) { S.a_voff(nxt, sR, sC, vn); asm volatile("s_waitcnt vmcnt(0)" : "+v"(vn[0][0]), "+v"(vn[0][1]), "+v"(vn[1][0]), "+v"(vn[1][1]) :: "memory"); }
            else { vn[0][0] = vc[0][0]; vn[0][1] = vc[0][1]; vn[1][0] = vc[1][0]; vn[1][1] = vc[1][1]; }
        }
        for (int t = 0; t < nt; t += 2) {
            const bool last = (t == nt - 2);
            const char* a1 = cA + (size_t)(t + 1) * kstep;
            const char* a2 = last ? nA : cA + (size_t)(t + 2) * kstep; const char* b2 = last ? nB : cB + (size_t)(t + 2) * kstep;
            const char* a3 = a2 + kstep; const char* b3 = b2 + kstep;
            unsigned v2[2][2];
#pragma unroll
            for (int h = 0; h < 2; ++h)
#pragma unroll
                for (int i = 0; i < 2; ++i) v2[h][i] = last ? vn[h][i] : vc[h][i];
            PG8_LDB(B0, 0, 0); PG8_LDB(B1, 0, 1); PG8_SCHED; PG8_LDA(At, 0, 0); PG8_STAGE_A(PG8_SA(1, 1), a1, 1, vc);
            PG8_WAIT_V(8); PG8_WAIT_L(0); PG8_BAR; PG8_MMA(0, 0, At, B0); PG8_MMA(0, 1, At, B1); PG8_BAR; PG8_SCHED;
            PG8_LDA(At, 0, 1); PG8_STAGE(PG8_SB(0, 0), b2, voffB); PG8_STAGE(PG8_SB(0, 1), b2 + hstep, voffB); PG8_STAGE_A(PG8_SA(0, 0), a2, 0, v2);
            PG8_WAIT_V(8); PG8_WAIT_L(0); PG8_BAR; PG8_MMA(1, 0, At, B0); PG8_MMA(1, 1, At, B1); PG8_BAR; PG8_SCHED;
            PG8_LDB(B0, 1, 0); PG8_LDB(B1, 1, 1); PG8_SCHED; PG8_LDA(At, 1, 0); PG8_STAGE_A(PG8_SA(0, 1), a2, 1, v2);
            PG8_WAIT_V(8); PG8_WAIT_L(0); PG8_BAR; PG8_MMA(0, 0, At, B0); PG8_MMA(0, 1, At, B1); PG8_BAR; PG8_SCHED;
            PG8_LDA(At, 1, 1); PG8_STAGE(PG8_SB(1, 0), b3, voffB); PG8_STAGE(PG8_SB(1, 1), b3 + hstep, voffB); PG8_STAGE_A(PG8_SA(1, 0), a3, 0, v2);
            PG8_WAIT_V(8); PG8_WAIT_L(0); PG8_BAR; PG8_MMA(1, 0, At, B0); PG8_MMA(1, 1, At, B1); PG8_BAR; PG8_SCHED;
        }
        if (wr == 0) PG8_BAR;
        E(acc, cur, wr, wc, fr, fq);
        if (!has_next) break;
#pragma unroll
        for (int a = 0; a < 2; ++a)
#pragma unroll
            for (int b = 0; b < 2; ++b)
#pragma unroll
                for (int m = 0; m < 4; ++m)
#pragma unroll
                    for (int n = 0; n < 2; ++n) acc[a][b][m][n] = (f32x4){0.f, 0.f, 0.f, 0.f};
        cur = nxt; cA = nA; cB = nB; ++ui;
        if (GATHER) { vc[0][0] = vn[0][0]; vc[0][1] = vn[0][1]; vc[1][0] = vn[1][0]; vc[1][1] = vn[1][1]; }
        if (wr == 1) PG8_BAR;
    }
    PG8_WAIT_V(0);
    PG8_BAR;
#undef PG8_SA
#undef PG8_SB
#undef PG8_STAGE
#undef PG8_STAGE_A
#undef PG8_LDA
#undef PG8_LDB
#undef PG8_MMA
#undef PG8_WAIT_V
#undef PG8_WAIT_L
#undef PG8_BAR
#undef PG8_SCHED
}
}

enum { CV_PLAIN = 0, CV_QKN = 1, CV_GATE = 2, CV_UP = 3 };
__device__ __forceinline__ int cv_dst_row(int mode, int n) {
    if (mode == CV_QKN) return (n & ~255) + 128 * ((n >> 5) & 1) + 32 * ((n >> 6) & 3) + (n & 31);
    if (mode == CV_GATE) return 256 * (n >> 7) + (n & 127);
    if (mode == CV_UP) return 256 * (n >> 7) + 128 + (n & 127);
    return n;
}
__device__ __forceinline__ void conv_item(const float* W, int ldw, int K, bf16* WT, int mode, LAS unsigned char* scr, int item, int nblk, int lane) {
    const int kb = item / nblk, nb = item - kb * nblk, k0 = 64 * kb, n0 = 64 * nb;
    const GAS float* src = (const GAS float*)(W + (size_t)k0 * ldw + n0 + lane);
#pragma unroll
    for (int kc = 0; kc < 8; ++kc) {
        float v[8];
#pragma unroll
        for (int j = 0; j < 8; ++j) v[j] = src[(size_t)(kc * 8 + j) * ldw];
        v4u w; w.x = pk2(v[0], v[1]); w.y = pk2(v[2], v[3]); w.z = pk2(v[4], v[5]); w.w = pk2(v[6], v[7]);
        *(LAS v4u*)(scr + lane * 144 + kc * 16) = w;
    }
    asm volatile("s_waitcnt lgkmcnt(0)" ::: "memory");
#pragma unroll
    for (int j = 0; j < 8; ++j) { const int n = 8 * j + (lane >> 3), ch = lane & 7;
        const v4u w = *(const LAS v4u*)(scr + n * 144 + ch * 16);
        *(GAS v4u*)(WT + (size_t)cv_dst_row(mode, n0 + n) * K + k0 + 8 * ch) = w; }
    asm volatile("s_waitcnt lgkmcnt(0)" ::: "memory");
}
__device__ __forceinline__ void conv_job(Frame& F, const float* W, int ldw, int K, int N, bf16* WT, int mode, int& rot) {
    LAS unsigned char* scr = F.lds + F.wave * 9216;
    const int nblk = N / 64, nitems = (K / 64) * nblk, NGW = F.G * NWAVES, gw = blockIdx.x * NWAVES + F.wave;
    int first = gw - (rot % NGW); if (first < 0) first += NGW;
    for (int it = first; it < nitems; it += NGW) conv_item(W, ldw, K, WT, mode, scr, it, nblk, F.lane);
    rot += nitems;
}
__device__ __forceinline__ void convert_weights(Frame& F) {
    bf16* WB = (bf16*)(F.ws + WS_W); int rot = 0;
    for (int j = 0; j < 2; ++j) conv_job(F, INP(1) + (size_t)j * DM * 3 * DM, 3 * DM, DM, 3 * DM, WB + WE_QKV + (size_t)j * 3 * DM * DM, CV_PLAIN, rot);
    for (int j = 0; j < 2; ++j) conv_job(F, INP(2) + (size_t)j * DM * DM, DM, DM, DM, WB + WE_WO_SB + (size_t)j * DM * DM, CV_PLAIN, rot);
    conv_job(F, INP(3), 7 * DM, DM, 7 * DM, WB + WE_IN_DIL, CV_QKN, rot);
    conv_job(F, INP(6), DM, DM, DM, WB + WE_WO_DIL, CV_PLAIN, rot);
    conv_job(F, INP(7), 3088, DM, 3 * DM, WB + WE_IN_FOX, CV_QKN, rot);
    conv_job(F, INP(11), DM, DM, DM, WB + WE_WO_FOX, CV_PLAIN, rot);
    for (int f = 0; f < 2; ++f) {
        conv_job(F, INP(15) + (size_t)f * DM * FF, FF, DM, FF, WB + WE_GU + (size_t)f * 2 * FF * DM, CV_GATE, rot);
        conv_job(F, INP(16) + (size_t)f * DM * FF, FF, DM, FF, WB + WE_GU + (size_t)f * 2 * FF * DM, CV_UP, rot);
        conv_job(F, INP(17) + (size_t)f * FF * DM, DM, FF, DM, WB + WE_D + (size_t)f * DM * FF, CV_PLAIN, rot);
    }
    for (int fe = 0; fe < 16; ++fe) {
        conv_job(F, INP(19) + (size_t)fe * DM * FF, FF, DM, FF, WB + WE_MGU + (size_t)fe * 2 * FF * DM, CV_GATE, rot);
        conv_job(F, INP(20) + (size_t)fe * DM * FF, FF, DM, FF, WB + WE_MGU + (size_t)fe * 2 * FF * DM, CV_UP, rot);
        conv_job(F, INP(21) + (size_t)fe * FF * DM, DM, FF, DM, WB + WE_MD + (size_t)fe * DM * FF, CV_PLAIN, rot);
    }
}

__device__ __forceinline__ void moe_bases(Frame& F, int f, int (&tb)[NE + 1]) {
    int acc = 0;
#pragma unroll
    for (int e = 0; e < NE; ++e) { tb[e] = acc; const int c = (int)__hip_atomic_load(F.ctl + CW_CNT + f * 64 + e, RLX_AGENT); acc += (c + 255) >> 8; }
    tb[NE] = acc;
}

template <int FLAGS>
__device__ __forceinline__ void norm_phase(Frame& F, const float* xin, float* xout, const float* gain, bf16* H, int fprev, int f,
                                           const float* Wf  , const float* bf  , const float* Wr  ) {
    const float* Y = (const float*)(F.ws + WS_R2);
    const int* tok_prev = (const int*)(F.ws + WS_MISC + MS_TOK) + (size_t)fprev * M * 2;
    float* lgf = (float*)(F.ws + WS_MISC + MS_LOGF);
    LAS int* sel = (LAS int*)F.lds;
    LAS float* sg = (LAS float*)(F.lds + 512);
    LAS int* lpos = (LAS int*)(F.lds + 1024);
    LAS int* gb = (LAS int*)(F.lds + 1536);
    int tb[NE + 1];
    if (FLAGS & 1) moe_bases(F, fprev, tb);
    for (int chunk = blockIdx.x; chunk < M / 64; chunk += F.G) {
        for (int i = 0; i < 8; ++i) {
            const int m = chunk * 64 + F.wave * 8 + i;
            const GAS f32x4* xr = (const GAS f32x4*)(xin + (size_t)m * DM) + F.lane;
            f32x4 v[4];
#pragma unroll
            for (int j = 0; j < 4; ++j) v[j] = xr[64 * j];
            if (FLAGS & 1) {
                const int s0 = tok_prev[m * 2], s1 = tok_prev[m * 2 + 1];
                int r0 = 0, r1 = 0;
#pragma unroll
                for (int e = 0; e < NE; ++e) { if ((s0 >> 14) == e) r0 = tb[e] * 256 + (s0 & 16383); if ((s1 >> 14) == e) r1 = tb[e] * 256 + (s1 & 16383); }
                const GAS f32x4* y0 = (const GAS f32x4*)(Y + (size_t)r0 * DM) + F.lane;
                const GAS f32x4* y1 = (const GAS f32x4*)(Y + (size_t)r1 * DM) + F.lane;
#pragma unroll
                for (int j = 0; j < 4; ++j) { v[j] = v[j] + y0[64 * j] + y1[64 * j]; ((GAS f32x4*)(xout + (size_t)m * DM) + F.lane)[64 * j] = v[j]; }
            }
            float s = 0.f;
#pragma unroll
            for (int j = 0; j < 4; ++j) s += (v[j].x * v[j].x + v[j].y * v[j].y) + (v[j].z * v[j].z + v[j].w * v[j].w);
            const float inv = 1.0f / sqrtf(wave_sum(s) * (1.f / DM) + RMS_EPS);
#pragma unroll
            for (int j = 0; j < 4; ++j) { const f32x4 g = ((const GAS f32x4*)gain + F.lane)[64 * j]; v[j] = v[j] * inv * g; }
            if (H) {
                GAS unsigned long long* o8 = (GAS unsigned long long*)(H + (size_t)m * DM) + F.lane;
#pragma unroll
                for (int j = 0; j < 4; ++j) o8[64 * j] = (unsigned long long)pk2(v[j].x, v[j].y) | ((unsigned long long)pk2(v[j].z, v[j].w) << 32);
            }
            if (FLAGS & 2) {
                float part[16];
#pragma unroll
                for (int c = 0; c < 16; ++c) part[c] = 0.f;
#pragma unroll
                for (int j = 0; j < 4; ++j)
#pragma unroll
                    for (int q = 0; q < 4; ++q) { const int k = 4 * (F.lane + 64 * j) + q; const float hv = v[j][q];
                        const GAS f32x4* wr = (const GAS f32x4*)(Wf + (size_t)k * 3088 + 3072);
#pragma unroll
                        for (int c4 = 0; c4 < 4; ++c4) { const f32x4 w = wr[c4]; part[c4 * 4 + 0] += hv * w.x; part[c4 * 4 + 1] += hv * w.y; part[c4 * 4 + 2] += hv * w.z; part[c4 * 4 + 3] += hv * w.w; } }
                float mine = 0.f;
#pragma unroll
                for (int c = 0; c < 16; ++c) { const float t = wave_sum(part[c]); if (F.lane == c) mine = t; }
                if (F.lane < 16) { const float z = mine + bf[F.lane];
                    const float ls = fminf(z, 0.f) - log1pf(expf(-fabsf(z))); lgf[(size_t)m * 16 + F.lane] = ls * LOG2E; }
            }
            if (FLAGS & 4) {
                float part[8];
#pragma unroll
                for (int c = 0; c < 8; ++c) part[c] = 0.f;
#pragma unroll
                for (int j = 0; j < 4; ++j)
#pragma unroll
                    for (int q = 0; q < 4; ++q) { const int k = 4 * (F.lane + 64 * j) + q; const float hv = v[j][q];
                        const GAS f32x4* wr = (const GAS f32x4*)(Wr + (size_t)k * 8);
                        const f32x4 w0 = wr[0], w1 = wr[1];
                        part[0] += hv * w0.x; part[1] += hv * w0.y; part[2] += hv * w0.z; part[3] += hv * w0.w;
                        part[4] += hv * w1.x; part[5] += hv * w1.y; part[6] += hv * w1.z; part[7] += hv * w1.w; }
                float lg[8];
#pragma unroll
                for (int c = 0; c < 8; ++c) lg[c] = wave_sum(part[c]);
                int e0 = 0; float l0 = lg[0];
#pragma unroll
                for (int c = 1; c < 8; ++c) if (lg[c] > l0) { l0 = lg[c]; e0 = c; }
                int e1 = -1; float l1 = -INFINITY;
#pragma unroll
                for (int c = 0; c < 8; ++c) if (c != e0 && lg[c] > l1) { l1 = lg[c]; e1 = c; }
                const float g0 = 1.0f / (1.0f + expf(l1 - l0)), g1 = 1.0f - g0;
                if (F.lane == 0) { const int r = F.wave * 8 + i; sel[r * 2] = e0; sel[r * 2 + 1] = e1; sg[r * 2] = g0; sg[r * 2 + 1] = g1; }
            }
        }
        if (FLAGS & 4) {
            int* list = (int*)(F.ws + WS_MISC + MS_LIST) + (size_t)f * NE * LCAP;
            float* gw = (float*)(F.ws + WS_MISC + MS_GW) + (size_t)f * NE * LCAP;
            int* tok = (int*)(F.ws + WS_MISC + MS_TOK) + (size_t)f * M * 2;
            __syncthreads();
            if (F.tid == 0) {
                int lc[8];
#pragma unroll
                for (int e = 0; e < 8; ++e) lc[e] = 0;
                for (int q = 0; q < 128; ++q) { const int e = sel[q]; int p = 0;
#pragma unroll
                    for (int c = 0; c < 8; ++c) if (c == e) { p = lc[c]; lc[c] = p + 1; }
                    lpos[q] = p; }
#pragma unroll
                for (int e = 0; e < 8; ++e) gb[e] = (int)__hip_atomic_fetch_add(F.ctl + CW_CNT + f * 64 + e, (unsigned)lc[e], RLX_AGENT);
            }
            __syncthreads();
            if (F.tid < 128) { const int q = F.tid, row = chunk * 64 + (q >> 1), e = sel[q], pos = gb[e] + lpos[q];
                list[e * LCAP + pos] = row; gw[e * LCAP + pos] = sg[q]; tok[row * 2 + (q & 1)] = e * LCAP + pos; }
            __syncthreads();
        }
    }
}

__device__ __forceinline__ void final_combine(Frame& F, int f) {
    const float* Y = (const float*)(F.ws + WS_R2);
    const int* tok = (const int*)(F.ws + WS_MISC + MS_TOK) + (size_t)f * M * 2;
    int tb[NE + 1]; moe_bases(F, f, tb);
    for (int m = blockIdx.x * NWAVES + F.wave; m < M; m += F.G * NWAVES) {
        const int s0 = tok[m * 2], s1 = tok[m * 2 + 1]; int r0 = 0, r1 = 0;
#pragma unroll
        for (int e = 0; e < NE; ++e) { if ((s0 >> 14) == e) r0 = tb[e] * 256 + (s0 & 16383); if ((s1 >> 14) == e) r1 = tb[e] * 256 + (s1 & 16383); }
        GAS f32x4* xr = (GAS f32x4*)(F.out + (size_t)m * DM) + F.lane;
        const GAS f32x4* y0 = (const GAS f32x4*)(Y + (size_t)r0 * DM) + F.lane;
        const GAS f32x4* y1 = (const GAS f32x4*)(Y + (size_t)r1 * DM) + F.lane;
#pragma unroll
        for (int j = 0; j < 4; ++j) xr[64 * j] = xr[64 * j] + y0[64 * j] + y1[64 * j];
    }
}

__device__ __forceinline__ void cumsum_phase(Frame& F) {
    const float* logf = (const float*)(F.ws + WS_MISC + MS_LOGF);
    float* cum = (float*)(F.ws + WS_MISC + MS_CUM);
    const int gw = blockIdx.x * NWAVES + F.wave;
    if (gw < BATCH * NH) {
        const int b = gw >> 4, h = gw & 15;
        float v[32]; float s = 0.f;
#pragma unroll
        for (int i = 0; i < 32; ++i) { v[i] = logf[((size_t)b * SEQ + F.lane * 32 + i) * 16 + h]; s += v[i]; }
        float incl = s;
#pragma unroll
        for (int o = 1; o < 64; o <<= 1) { const float t = __shfl_up(incl, o); if (F.lane >= o) incl += t; }
        float run = incl - s;
#pragma unroll
        for (int i = 0; i < 32; ++i) { run += v[i]; cum[((size_t)b * SEQ + F.lane * 32 + i) * 16 + h] = run; }
    }
}

enum { EPI_PLANES = 0, EPI_RESID = 1, EPI_SWIGLU = 2, EPI_MOEDOWN = 3 };
struct SgP { const bf16* A; int lda; const int* rowidx; int Mrows; const float* W0; const float* W1; int ldw; int K; int N;
             bf16* outb; int ldo; float scale0; const float* base; float* outf; const float* gwv; };
template <int EPI>
__device__ __forceinline__ void sgemm(Frame& F, const SgP& p) {
    LAS float* As = (LAS float*)F.lds;
    LAS float* Bs0 = As + 16 * 132;
    LAS float* Bs1 = Bs0 + 16 * 128;
    const int tid = F.tid, ty = tid >> 4, tx = tid & 15;
    const int lrow = tid >> 2, lkq = (tid & 3) * 4;
    const int bk = tid >> 5, bn = (tid & 31) * 4;
    const int ntn = p.N / 128, ntiles = (p.Mrows / 128) * ntn;
    for (int tile = blockIdx.x; tile < ntiles; tile += F.G) {
        const int tm = tile / ntn, tn = tile % ntn;
        const int arow = p.rowidx ? p.rowidx[tm * 128 + lrow] : tm * 128 + lrow;
        const bf16* ap = p.A + (size_t)arow * p.lda + lkq;
        const float* bp0 = p.W0 + (size_t)bk * p.ldw + tn * 128 + bn;
        const float* bp1 = (EPI == EPI_SWIGLU) ? p.W1 + (size_t)bk * p.ldw + tn * 128 + bn : nullptr;
        f32x2 acc0[4][4], acc1[4][4];
#pragma unroll
        for (int i = 0; i < 4; ++i)
#pragma unroll
            for (int j = 0; j < 4; ++j) { acc0[i][j] = (f32x2){0.f, 0.f}; acc1[i][j] = (f32x2){0.f, 0.f}; }
        for (int k0 = 0; k0 < p.K; k0 += 16) {
            const v2u av = *(const GAS v2u*)(ap + k0);
            const f32x4 b0 = *(const GAS f32x4*)(bp0 + (size_t)k0 * p.ldw);
            f32x4 b1 = (f32x4){0.f, 0.f, 0.f, 0.f};
            if (EPI == EPI_SWIGLU) b1 = *(const GAS f32x4*)(bp1 + (size_t)k0 * p.ldw);
            __syncthreads();
            As[(lkq + 0) * 132 + lrow] = bflo(av.x); As[(lkq + 1) * 132 + lrow] = bfhi(av.x);
            As[(lkq + 2) * 132 + lrow] = bflo(av.y); As[(lkq + 3) * 132 + lrow] = bfhi(av.y);
            *(LAS f32x4*)(Bs0 + bk * 128 + bn) = b0;
            if (EPI == EPI_SWIGLU) *(LAS f32x4*)(Bs1 + bk * 128 + bn) = b1;
            __syncthreads();
#pragma unroll 2
            for (int k = 0; k < 16; ++k) {
                const f32x4 a = *(const LAS f32x4*)(As + k * 132 + ty * 4);
                const f32x4 bA = *(const LAS f32x4*)(Bs0 + k * 128 + tx * 8), bB = *(const LAS f32x4*)(Bs0 + k * 128 + tx * 8 + 4);
                const f32x2 bv[4] = {(f32x2){bA.x, bA.y}, (f32x2){bA.z, bA.w}, (f32x2){bB.x, bB.y}, (f32x2){bB.z, bB.w}};
#pragma unroll
                for (int i = 0; i < 4; ++i) {
#pragma unroll
                    for (int j = 0; j < 4; ++j) acc0[i][j] += a[i] * bv[j]; }
                if (EPI == EPI_SWIGLU) {
                    const f32x4 cA = *(const LAS f32x4*)(Bs1 + k * 128 + tx * 8), cB = *(const LAS f32x4*)(Bs1 + k * 128 + tx * 8 + 4);
                    const f32x2 cv[4] = {(f32x2){cA.x, cA.y}, (f32x2){cA.z, cA.w}, (f32x2){cB.x, cB.y}, (f32x2){cB.z, cB.w}};
#pragma unroll
                    for (int i = 0; i < 4; ++i) {
#pragma unroll
                        for (int j = 0; j < 4; ++j) acc1[i][j] += a[i] * cv[j]; }
                }
                __builtin_amdgcn_sched_barrier(0);
            }
        }
        const int c0 = tn * 128 + tx * 8;
#pragma unroll
        for (int i = 0; i < 4; ++i) {
            const int r = tm * 128 + ty * 4 + i;
            if (EPI == EPI_PLANES) {
                const int pl = c0 >> 10, cc = c0 & 1023; const float sc = (pl == 0) ? p.scale0 : 1.f;
                v4u w; w.x = pk2(acc0[i][0].x * sc, acc0[i][0].y * sc); w.y = pk2(acc0[i][1].x * sc, acc0[i][1].y * sc); w.z = pk2(acc0[i][2].x * sc, acc0[i][2].y * sc); w.w = pk2(acc0[i][3].x * sc, acc0[i][3].y * sc);
                *(GAS v4u*)(p.outb + (size_t)pl * PLANE + (size_t)r * DM + cc) = w;
            } else if (EPI == EPI_RESID) {
                const GAS f32x4* bp = (const GAS f32x4*)(p.base + (size_t)r * DM + c0); GAS f32x4* op = (GAS f32x4*)(p.outf + (size_t)r * DM + c0);
                const f32x4 x0 = bp[0], x1 = bp[1];
                op[0] = x0 + (f32x4){acc0[i][0].x, acc0[i][0].y, acc0[i][1].x, acc0[i][1].y}; op[1] = x1 + (f32x4){acc0[i][2].x, acc0[i][2].y, acc0[i][3].x, acc0[i][3].y};
            } else if (EPI == EPI_SWIGLU) {
                float o[8];
#pragma unroll
                for (int j = 0; j < 8; ++j) { const float g = acc0[i][j >> 1][j & 1], uu = acc1[i][j >> 1][j & 1]; o[j] = g / (1.0f + __expf(-g)) * uu; }
                v4u w; w.x = pk2(o[0], o[1]); w.y = pk2(o[2], o[3]); w.z = pk2(o[4], o[5]); w.w = pk2(o[6], o[7]);
                *(GAS v4u*)(p.outb + (size_t)r * p.ldo + c0) = w;
            } else {
                const float g = p.gwv[r]; GAS f32x4* op = (GAS f32x4*)(p.outf + (size_t)r * DM + c0);
                op[0] = (f32x4){acc0[i][0].x * g, acc0[i][0].y * g, acc0[i][1].x * g, acc0[i][1].y * g}; op[1] = (f32x4){acc0[i][2].x * g, acc0[i][2].y * g, acc0[i][3].x * g, acc0[i][3].y * g};
            }
        }
    }
}

__device__ __forceinline__ void qknorm_plane(Frame& F, bf16* plane, const float* gain, float mul) {
    const int nth = F.G * NTHR;
    for (int idx = blockIdx.x * NTHR + F.tid; idx < M * NH; idx += nth) {
        GAS v4u* p = (GAS v4u*)(plane + (size_t)idx * 64);
        v4u w[8]; float ss = 0.f;
#pragma unroll
        for (int c = 0; c < 8; ++c) { w[c] = p[c];
#pragma unroll
            for (int q = 0; q < 4; ++q) { const float a = bflo(w[c][q]), b = bfhi(w[c][q]); ss += a * a + b * b; } }
        const float inv = 1.0f / sqrtf(ss * (1.f / 64.f) + RMS_EPS) * mul;
#pragma unroll
        for (int c = 0; c < 8; ++c) { v4u o;
#pragma unroll
            for (int q = 0; q < 4; ++q) { const float a = bflo(w[c][q]) * inv * gain[c * 8 + 2 * q], b = bfhi(w[c][q]) * inv * gain[c * 8 + 2 * q + 1]; o[q] = pk2(a, b); }
            p[c] = o; }
    }
}

template <int MODE>
__device__ __forceinline__ void attn_simple_causal(Frame& F, const bf16* Qp, const bf16* Kp, const bf16* Vp, bf16* O, const float* cum) {
    LAS float* Ks = (LAS float*)F.lds;
    LAS float* Vs = Ks + 4096;
    LAS float* kb = Vs + 4096;
    for (int u = blockIdx.x; u < BATCH * NH * 4; u += F.G) {
        const int qblk = (u & 1) ? 3 - ((u >> 1) & 1) : ((u >> 1) & 1) * 1;
        const int bh = u >> 2, b = bh >> 4, h = bh & 15;
        const int t = qblk * 512 + F.tid;
        const size_t rowbase = (size_t)b * SEQ;
        float q[64], acc[64];
        { const GAS v4u* qp = (const GAS v4u*)(Qp + (rowbase + t) * DM + h * 64);
#pragma unroll
          for (int c = 0; c < 8; ++c) { const v4u w = qp[c];
#pragma unroll
              for (int k = 0; k < 4; ++k) { q[c * 8 + 2 * k] = bflo(w[k]); q[c * 8 + 2 * k + 1] = bfhi(w[k]); } } }
#pragma unroll
        for (int d = 0; d < 64; ++d) acc[d] = 0.f;
        float P = 1.f, mrun = -INFINITY, lrun = 0.f;
        const int ntile = 8 * (qblk + 1);
        for (int it = 0; it < ntile; ++it) {
            const int tile = (MODE == 0) ? ntile - 1 - it : it;
            __syncthreads();
            { const int key = F.tid >> 3, ch = F.tid & 7;
              const v4u kw = *(const GAS v4u*)(Kp + (rowbase + tile * 64 + key) * DM + h * 64 + ch * 8);
              const v4u vw = *(const GAS v4u*)(Vp + (rowbase + tile * 64 + key) * DM + h * 64 + ch * 8);
#pragma unroll
              for (int k = 0; k < 4; ++k) { Ks[key * 64 + ch * 8 + 2 * k] = bflo(kw[k]); Ks[key * 64 + ch * 8 + 2 * k + 1] = bfhi(kw[k]);
                                            Vs[key * 64 + ch * 8 + 2 * k] = bflo(vw[k]); Vs[key * 64 + ch * 8 + 2 * k + 1] = bfhi(vw[k]); }
              if (MODE == 2 && F.tid < 64) kb[F.tid] = -cum[(rowbase + tile * 64 + F.tid) * 16 + h]; }
            __syncthreads();
            for (int jj = 0; jj < 64; ++jj) {
                const int j = (MODE == 0) ? 63 - jj : jj; const int s = tile * 64 + j;
                float z = 0.f;
#pragma unroll
                for (int d4 = 0; d4 < 16; ++d4) { const f32x4 kv = *(const LAS f32x4*)(Ks + j * 64 + d4 * 4); z += q[d4 * 4] * kv.x + q[d4 * 4 + 1] * kv.y + q[d4 * 4 + 2] * kv.z + q[d4 * 4 + 3] * kv.w; }
                if (MODE == 0) {
                    const bool valid = s < t;
                    const float e = __builtin_amdgcn_exp2f(fminf(z, 100.f));
                    float r = 1.0f / (1.0f + e); float beta = 1.0f - r;
                    if (!valid) { r = 1.f; beta = 0.f; }
                    const float w = beta * P; P *= r;
#pragma unroll
                    for (int d4 = 0; d4 < 16; ++d4) { const f32x4 vv = *(const LAS f32x4*)(Vs + j * 64 + d4 * 4); acc[d4 * 4] += w * vv.x; acc[d4 * 4 + 1] += w * vv.y; acc[d4 * 4 + 2] += w * vv.z; acc[d4 * 4 + 3] += w * vv.w; }
                } else {
                    const bool valid = s <= t;
                    const float x = valid ? z + kb[j] : -INFINITY;
                    const float mn = fmaxf(mrun, x);
                    const float a = __builtin_amdgcn_exp2f(mrun - mn), pw = __builtin_amdgcn_exp2f(x - mn);
                    lrun = lrun * a + pw; mrun = mn;
#pragma unroll
                    for (int d4 = 0; d4 < 16; ++d4) { const f32x4 vv = *(const LAS f32x4*)(Vs + j * 64 + d4 * 4);
                        acc[d4 * 4] = acc[d4 * 4] * a + pw * vv.x; acc[d4 * 4 + 1] = acc[d4 * 4 + 1] * a + pw * vv.y; acc[d4 * 4 + 2] = acc[d4 * 4 + 2] * a + pw * vv.z; acc[d4 * 4 + 3] = acc[d4 * 4 + 3] * a + pw * vv.w; }
                }
            }
        }
        const float fin = (MODE == 0) ? 1.f : 1.0f / lrun;
        GAS v4u* op = (GAS v4u*)(O + (rowbase + t) * DM + h * 64);
#pragma unroll
        for (int c = 0; c < 8; ++c) { v4u w;
#pragma unroll
            for (int k = 0; k < 4; ++k) w[k] = pk2(acc[c * 8 + 2 * k] * fin, acc[c * 8 + 2 * k + 1] * fin);
            op[c] = w; }
    }
}

__device__ __forceinline__ int t5_bucket(int dist) {
    if (dist < 16) return dist;
    const float d = (float)dist;
    int lb = 16 + (int)(logf(d / 16.0f) / logf(128.0f) * 16.0f);
    return lb < 31 ? lb : 31;
}
__device__ __forceinline__ void attn_simple_dil(Frame& F, const bf16* PROJ, bf16* O, const float* rel_bias) {
    LAS float* tbl = (LAS float*)F.lds;
    for (int u = blockIdx.x; u < BATCH * NH * 4; u += F.G) {
        const int qblk = u & 3, bh = u >> 2, b = bh >> 4, h = bh & 15;
        const int t = qblk * 512 + F.tid;
        const size_t rowbase = (size_t)b * SEQ;
        __syncthreads();
        for (int i = F.tid; i < 3 * 129; i += NTHR) { const int g = i / 129, dl = i % 129, dil = (g == 0) ? 1 : (g == 1) ? 4 : 16;
            tbl[g * 132 + dl] = rel_bias[t5_bucket(dl * dil) * 16 + h] * LOG2E; }
        __syncthreads();
        float acc[64];
#pragma unroll
        for (int d = 0; d < 64; ++d) acc[d] = 0.f;
        float mrun = -INFINITY, lrun = 0.f;
        for (int g = 0; g < 3; ++g) {
            const int dil = (g == 0) ? 1 : (g == 1) ? 4 : 16;
            const bf16* Qg = PROJ + (size_t)(2 * g) * PLANE; const bf16* Kg = PROJ + (size_t)(2 * g + 1) * PLANE; const bf16* Vg = PROJ + (size_t)6 * PLANE;
            float q[64];
            { const GAS v4u* qp = (const GAS v4u*)(Qg + (rowbase + t) * DM + h * 64);
#pragma unroll
              for (int c = 0; c < 8; ++c) { const v4u w = qp[c];
#pragma unroll
                  for (int k = 0; k < 4; ++k) { q[c * 8 + 2 * k] = bflo(w[k]); q[c * 8 + 2 * k + 1] = bfhi(w[k]); } } }
            for (int dl = 0; dl <= 128; ++dl) {
                const int s = t - dl * dil; const bool valid = s >= 0; const int sc = valid ? s : 0;
                const GAS v4u* kp = (const GAS v4u*)(Kg + (rowbase + sc) * DM + h * 64);
                float z = 0.f;
#pragma unroll
                for (int c = 0; c < 8; ++c) { const v4u w = kp[c];
#pragma unroll
                    for (int k = 0; k < 4; ++k) z += q[c * 8 + 2 * k] * bflo(w[k]) + q[c * 8 + 2 * k + 1] * bfhi(w[k]); }
                const float x = valid ? z + tbl[g * 132 + dl] : -INFINITY;
                const float mn = fmaxf(mrun, x);
                const float a = __builtin_amdgcn_exp2f(mrun - mn), pw = __builtin_amdgcn_exp2f(x - mn);
                lrun = lrun * a + pw; mrun = mn;
                const GAS v4u* vp = (const GAS v4u*)(Vg + (rowbase + sc) * DM + h * 64);
#pragma unroll
                for (int c = 0; c < 8; ++c) { const v4u w = vp[c];
#pragma unroll
                    for (int k = 0; k < 4; ++k) { acc[c * 8 + 2 * k] = acc[c * 8 + 2 * k] * a + pw * bflo(w[k]); acc[c * 8 + 2 * k + 1] = acc[c * 8 + 2 * k + 1] * a + pw * bfhi(w[k]); } }
            }
        }
        const float fin = 1.0f / lrun;
        GAS v4u* op = (GAS v4u*)(O + (rowbase + t) * DM + h * 64);
#pragma unroll
        for (int c = 0; c < 8; ++c) { v4u w;
#pragma unroll
            for (int k = 0; k < 4; ++k) w[k] = pk2(acc[c * 8 + 2 * k] * fin, acc[c * 8 + 2 * k + 1] * fin);
            op[c] = w; }
    }
}

__device__ __forceinline__ void moe_gu_simple(Frame& F, int f, const bf16* H, bf16* ACT) {
    const int* list = (const int*)(F.ws + WS_MISC + MS_LIST) + (size_t)f * NE * LCAP;
    int base = 0;
    for (int e = 0; e < NE; ++e) {
        const int c = (int)__hip_atomic_load(F.ctl + CW_CNT + f * 64 + e, RLX_AGENT); const int nt = (c + 255) >> 8;
        if (nt) {
            SgP p{}; p.A = H; p.lda = DM; p.rowidx = list + e * LCAP; p.Mrows = nt * 256;
            p.W0 = INP(19) + ((size_t)f * NE + e) * DM * FF; p.W1 = INP(20) + ((size_t)f * NE + e) * DM * FF; p.ldw = FF; p.K = DM; p.N = FF;
            p.outb = ACT + (size_t)base * 256 * FF; p.ldo = FF;
            sgemm<EPI_SWIGLU>(F, p);
        }
        base += nt;
    }
}
__device__ __forceinline__ void moe_down_simple(Frame& F, int f, const bf16* ACT, float* Y) {
    const float* gw = (const float*)(F.ws + WS_MISC + MS_GW) + (size_t)f * NE * LCAP;
    int base = 0;
    for (int e = 0; e < NE; ++e) {
        const int c = (int)__hip_atomic_load(F.ctl + CW_CNT + f * 64 + e, RLX_AGENT); const int nt = (c + 255) >> 8;
        if (nt) {
            SgP p{}; p.A = ACT + (size_t)base * 256 * FF; p.lda = FF; p.rowidx = nullptr; p.Mrows = nt * 256;
            p.W0 = INP(21) + ((size_t)f * NE + e) * FF * DM; p.ldw = DM; p.K = FF; p.N = DM;
            p.outf = Y + (size_t)base * 256 * DM; p.gwv = gw + e * LCAP;
            sgemm<EPI_MOEDOWN>(F, p);
        }
        base += nt;
    }
}


template <class Epi>
__device__ __forceinline__ void dense_gemm(Frame& F, const bf16* A, const bf16* Bt, int N, int K, const Epi& E) {
    pg8::DenseOrder S; S.init(A, Bt, M, N, K, F.G, (int)blockIdx.x);
    pg8::gemm_phase<Epi, pg8::DenseOrder, false>(F.lds, K, S, E);
}
__device__ __forceinline__ void moe_order_init(Frame& F, int f, pg8::MoeOrder& S) {
    int acc = 0, t[NE];
#pragma unroll
    for (int e = 0; e < NE; ++e) { const int c = (int)__hip_atomic_load(F.ctl + CW_CNT + f * 64 + e, RLX_AGENT); acc += (c + 255) >> 8; t[e] = acc; }
    S.t1 = t[0]; S.t2 = t[1]; S.t3 = t[2]; S.t4 = t[3]; S.t5 = t[4]; S.t6 = t[5]; S.t7 = t[6]; S.t8 = t[7];
    S.G = F.G; S.c = (int)blockIdx.x;
}
__device__ __forceinline__ void moe_gu_fast(Frame& F, int f, const bf16* H, bf16* ACT) {
    pg8::MoeOrder S; moe_order_init(F, f, S);
    S.nN = 2 * FF / 256; S.K = DM; S.A = (const char*)H; S.Bt = (const char*)((const bf16*)(F.ws + WS_W) + WE_MGU + (size_t)f * NE * 2 * FF * DM);
    S.tstepA = (size_t)256 * DM * 2; S.tstepB = (size_t)256 * DM * 2; S.estepB = (size_t)2 * FF * DM * 2;
    S.list = (const int*)(F.ws + WS_MISC + MS_LIST) + (size_t)f * NE * LCAP; S.gather = true;
    pg8::EpiSwiglu E{ACT};
    pg8::gemm_phase<pg8::EpiSwiglu, pg8::MoeOrder, true>(F.lds, DM, S, E);
}
__device__ __forceinline__ void moe_down_fast(Frame& F, int f, const bf16* ACT, float* Y) {
    pg8::MoeOrder S; moe_order_init(F, f, S);
    S.nN = DM / 256; S.K = FF; S.A = (const char*)ACT; S.Bt = (const char*)((const bf16*)(F.ws + WS_W) + WE_MD + (size_t)f * NE * DM * FF);
    S.tstepA = (size_t)256 * FF * 2; S.tstepB = (size_t)256 * FF * 2; S.estepB = (size_t)DM * FF * 2;
    S.list = nullptr; S.gather = false;
    pg8::EpiMoeDown E{Y, (const float*)(F.ws + WS_MISC + MS_GW) + (size_t)f * NE * LCAP};
    pg8::gemm_phase<pg8::EpiMoeDown, pg8::MoeOrder, false>(F.lds, FF, S, E);
}

struct Args { const float* in[22]; float* out; unsigned char* ws; int ph_lo, ph_hi; };
constexpr int N_PHASES = 32;

__global__ void __launch_bounds__(NTHR, 2) trunk_fwd(Args args) {
    extern __shared__ __attribute__((aligned(16))) unsigned char lds[];
    Frame F;
    F.lds = (LAS unsigned char*)lds;
    F.tid = threadIdx.x; F.lane = F.tid & 63; F.wave = __builtin_amdgcn_readfirstlane(F.tid >> 6); F.G = gridDim.x;
    F.ws = args.ws; F.ctl = (gu32*)(args.ws + WS_CTL); F.out = args.out;
    if (F.tid == 0) {
#pragma unroll
        for (int i = 0; i < 22; ++i) ((LAS unsigned long long*)(F.lds + PTR_OFF))[i] = (unsigned long long)args.in[i];
    }
    volatile LAS unsigned* MISC = (volatile LAS unsigned*)(F.lds + MISC_OFF);
    if (F.tid < 32) MISC[F.tid] = 0u;
    __syncthreads();
    XcdBarrier bar; bar.bar = (unsigned*)(F.ctl + CW_BAR); bar.x = 0; bar.st = nullptr;
    const int lo = args.ph_lo, hi = args.ph_hi;
    if (hi - lo > 1) bar = xcd_barrier_post((unsigned*)(F.ctl + CW_BAR), MISC + 8);
#ifndef PHSEL
#define PHSEL 0xFFFFFFFFull
#endif
#define IN(k) (lo <= (k) && (k) < hi && ((PHSEL >> (k)) & 1ull) && relaunder(F))
#define SEAM(k) do { if (IN((k) + 1) && IN(k)) xcd_barrier(bar); } while (0)

    bf16* H = (bf16*)(F.ws + WS_H);
    bf16* PROJ = (bf16*)(F.ws + WS_R1);
    bf16* ACT = (bf16*)(F.ws + WS_R1);
    bf16* O = (bf16*)(F.ws + WS_R2);
    float* Y = (float*)(F.ws + WS_R2);
    float* X = F.out;
    const float* cum = (const float*)(F.ws + WS_MISC + MS_CUM);

    const bf16* WB = (const bf16*)(F.ws + WS_W);
    if (IN(0)) {
        unsigned* z = (unsigned*)(F.ws + WS_MISC + MS_LIST);
        for (int i = blockIdx.x * NTHR + F.tid; i < (int)(2 * MiB / 4); i += F.G * NTHR) z[i] = 0u;
        convert_weights(F);
        SEAM(0);
    }
    if (IN(1)) { norm_phase<0>(F, INP(0), nullptr, INP(13) + 0 * DM, H, 0, 0, nullptr, nullptr, nullptr); SEAM(1); }
    if (IN(2)) { pg8::EpiPlanes E{PROJ, C2}; dense_gemm(F, H, WB + WE_QKV, 3 * DM, DM, E); SEAM(2); }
    if (IN(3)) { attn_simple_causal<0>(F, PROJ, PROJ + PLANE, PROJ + 2 * PLANE, O, nullptr); SEAM(3); }
    if (IN(4)) { pg8::EpiResid E{INP(0), X}; dense_gemm(F, O, WB + WE_WO_SB, DM, DM, E); SEAM(4); }
    if (IN(5)) { norm_phase<0>(F, X, nullptr, INP(14) + 0 * DM, H, 0, 0, nullptr, nullptr, nullptr); SEAM(5); }
    if (IN(6)) { pg8::EpiSwiglu E{ACT}; dense_gemm(F, H, WB + WE_GU, 2 * FF, DM, E); SEAM(6); }
    if (IN(7)) { pg8::EpiResid E{X, X}; dense_gemm(F, ACT, WB + WE_D, DM, FF, E); SEAM(7); }
    if (IN(8)) { norm_phase<0>(F, X, nullptr, INP(13) + 1 * DM, H, 0, 0, nullptr, nullptr, nullptr); SEAM(8); }
    if (IN(9)) { pg8::EpiQKNorm E{PROJ, INP(4), INP(5), 6}; dense_gemm(F, H, WB + WE_IN_DIL, 7 * DM, DM, E); SEAM(9); }
    if (IN(11)) { attn_simple_dil(F, PROJ, O, INP(12)); SEAM(11); }
    if (IN(12)) { pg8::EpiResid E{X, X}; dense_gemm(F, O, WB + WE_WO_DIL, DM, DM, E); SEAM(12); }
    if (IN(13)) { norm_phase<4>(F, X, nullptr, INP(14) + 1 * DM, H, 0, 0, nullptr, nullptr, INP(18) + 0 * DM * NE); SEAM(13); }
    if (IN(14)) { moe_gu_fast(F, 0, H, ACT); SEAM(14); }
    if (IN(15)) { moe_down_fast(F, 0, ACT, Y); SEAM(15); }
    if (IN(16)) { norm_phase<1 | 2>(F, X, X, INP(13) + 2 * DM, H, 0, 0, INP(7), INP(8), nullptr); SEAM(16); }
    if (IN(17)) { cumsum_phase(F); pg8::EpiQKNorm E{PROJ, INP(9), INP(10), 2}; dense_gemm(F, H, WB + WE_IN_FOX, 3 * DM, DM, E); SEAM(17); }
    if (IN(19)) { attn_simple_causal<2>(F, PROJ, PROJ + PLANE, PROJ + 2 * PLANE, O, cum); SEAM(19); }
    if (IN(20)) { pg8::EpiResid E{X, X}; dense_gemm(F, O, WB + WE_WO_FOX, DM, DM, E); SEAM(20); }
    if (IN(21)) { norm_phase<0>(F, X, nullptr, INP(14) + 2 * DM, H, 0, 0, nullptr, nullptr, nullptr); SEAM(21); }
    if (IN(22)) { pg8::EpiSwiglu E{ACT}; dense_gemm(F, H, WB + WE_GU + (size_t)2 * FF * DM, 2 * FF, DM, E); SEAM(22); }
    if (IN(23)) { pg8::EpiResid E{X, X}; dense_gemm(F, ACT, WB + WE_D + (size_t)DM * FF, DM, FF, E); SEAM(23); }
    if (IN(24)) { norm_phase<0>(F, X, nullptr, INP(13) + 3 * DM, H, 0, 0, nullptr, nullptr, nullptr); SEAM(24); }
    if (IN(25)) { pg8::EpiPlanes E{PROJ, C2}; dense_gemm(F, H, WB + WE_QKV + (size_t)3 * DM * DM, 3 * DM, DM, E); SEAM(25); }
    if (IN(26)) { attn_simple_causal<0>(F, PROJ, PROJ + PLANE, PROJ + 2 * PLANE, O, nullptr); SEAM(26); }
    if (IN(27)) { pg8::EpiResid E{X, X}; dense_gemm(F, O, WB + WE_WO_SB + (size_t)DM * DM, DM, DM, E); SEAM(27); }
    if (IN(28)) { norm_phase<4>(F, X, nullptr, INP(14) + 3 * DM, H, 0, 1, nullptr, nullptr, INP(18) + 1 * DM * NE); SEAM(28); }
    if (IN(29)) { moe_gu_fast(F, 1, H, ACT); SEAM(29); }
    if (IN(30)) { moe_down_fast(F, 1, ACT, Y); SEAM(30); }
    if (IN(31)) { final_combine(F, 1); }
#undef IN
#undef SEAM
}

extern "C" void kernel_launch(void* const* d_in, const int* in_sizes, int n_in, void* d_out, int out_size, void* d_ws, size_t ws_size, hipStream_t stream) {
    static int grid = 0;
    if (grid == 0) {
        if (n_in != 22 || out_size != M * DM || ws_size < WS_END) { fprintf(stderr, "kernel_launch: unexpected shapes (n_in %d out %d ws %zu)\n", n_in, out_size, ws_size); grid = -1; return; }
        int dev = 0, cus = 0, per_cu = 0;
        if (hipGetDevice(&dev) != hipSuccess || hipDeviceGetAttribute(&cus, hipDeviceAttributeMultiprocessorCount, dev) != hipSuccess) { grid = -1; return; }
        if (hipFuncSetAttribute((const void*)trunk_fwd, hipFuncAttributeMaxDynamicSharedMemorySize, LDS_BYTES) != hipSuccess) { fprintf(stderr, "kernel_launch: hipFuncSetAttribute failed\n"); grid = -1; return; }
        if (hipOccupancyMaxActiveBlocksPerMultiprocessor(&per_cu, (const void*)trunk_fwd, NTHR, LDS_BYTES) != hipSuccess || per_cu < 1) fprintf(stderr, "kernel_launch: occupancy query says %d\n", per_cu);
        (void)hipGetLastError();
        grid = cus;
    }
    if (grid < 0) return;
    (void)hipMemsetAsync((char*)d_ws + WS_CTL, 0, CTL_ZERO_BYTES, stream);
    Args a{};
    for (int i = 0; i < 22; ++i) a.in[i] = (const float*)d_in[i];
    a.out = (float*)d_out; a.ws = (unsigned char*)d_ws;
#if MK_MULTI
    for (int p = 0; p < N_PHASES; ++p) { a.ph_lo = p; a.ph_hi = p + 1; hipLaunchKernelGGL(trunk_fwd, dim3(grid), dim3(NTHR), LDS_BYTES, stream, a); }
#else
    a.ph_lo = 0; a.ph_hi = N_PHASES;
    hipLaunchKernelGGL(trunk_fwd, dim3(grid), dim3(NTHR), LDS_BYTES, stream, a);
#endif
}
```

```cpp
#include <hip/hip_runtime.h>
#include <cstdio>
#include <cstdint>

#ifndef MK_MULTI
#define MK_MULTI 0
#endif

constexpr int BATCH = 8, SEQ = 2048, DM = 1024, NH = 16, HD = 64, FF = 3584, NE = 8;
constexpr int M = BATCH * SEQ;
constexpr float RMS_EPS = 1e-6f;
constexpr float LOG2E = 1.4426950408889634f;
constexpr float C2 = 0.125f * LOG2E;
constexpr int NWAVES = 8, NTHR = 512;
constexpr int LCAP = 16384;
constexpr int MAXROWS = 34816;

constexpr size_t MiB = 1u << 20;
constexpr size_t WS_CTL = 0, CTL_ZERO_BYTES = 1 * MiB;
constexpr size_t WS_MISC = 1 * MiB;
constexpr size_t WS_H = 6 * MiB;
constexpr size_t WS_R1 = 38 * MiB;
constexpr size_t WS_R2 = 278 * MiB;
constexpr size_t WS_W = 414 * MiB;
constexpr size_t WS_END = 832 * MiB;
constexpr size_t PLANE = (size_t)M * DM;
constexpr size_t WE_QKV = 0;
constexpr size_t WE_WO_SB = WE_QKV + 2ull * 3072 * 1024;
constexpr size_t WE_WO_DIL = WE_WO_SB + 2ull * 1024 * 1024;
constexpr size_t WE_WO_FOX = WE_WO_DIL + 1024ull * 1024;
constexpr size_t WE_IN_DIL = WE_WO_FOX + 1024ull * 1024;
constexpr size_t WE_IN_FOX = WE_IN_DIL + 7168ull * 1024;
constexpr size_t WE_GU = WE_IN_FOX + 3072ull * 1024;
constexpr size_t WE_D = WE_GU + 2ull * 7168 * 1024;
constexpr size_t WE_MGU = WE_D + 2ull * 1024 * 3584;
constexpr size_t WE_MD = WE_MGU + 16ull * 7168 * 1024;
constexpr size_t WE_END = WE_MD + 16ull * 1024 * 3584;
static_assert(WS_W + WE_END * 2 <= WS_END, "weight copies fit");
constexpr size_t MS_LIST = 0;
constexpr size_t MS_GW = 1 * MiB;
constexpr size_t MS_TOK = 2 * MiB;
constexpr size_t MS_LOGF = 2 * MiB + 256 * 1024;
constexpr size_t MS_CUM = 3 * MiB + 256 * 1024;
constexpr int CW_BAR = 4096;
constexpr int CW_CNT = 64;

#define GAS __attribute__((address_space(1)))
#define LAS __attribute__((address_space(3)))
typedef unsigned short bf16;
typedef unsigned v4u __attribute__((ext_vector_type(4)));
typedef unsigned v2u __attribute__((ext_vector_type(2)));
typedef float f32x4 __attribute__((ext_vector_type(4)));
typedef float f32x2 __attribute__((ext_vector_type(2)));
typedef GAS unsigned gu32;
#define RLX_AGENT __ATOMIC_RELAXED, __HIP_MEMORY_SCOPE_AGENT
__device__ __forceinline__ unsigned f2bf(float f) { unsigned u = __builtin_bit_cast(unsigned, f); return (u + 0x7fffu + ((u >> 16) & 1u)) >> 16; }
__device__ __forceinline__ unsigned pk2(float lo, float hi) { return f2bf(lo) | (f2bf(hi) << 16); }
__device__ __forceinline__ float bflo(unsigned u) { return __builtin_bit_cast(float, u << 16); }
__device__ __forceinline__ float bfhi(unsigned u) { return __builtin_bit_cast(float, u & 0xffff0000u); }

#define XB_TMO      128
#define XB_XCNT(j)  (256  + 64 * (j))
#define XB_XSUB(j)  (1280 + 64 * (j))
#define XB_XGEN(j)  (2304 + 64 * (j))
#define XB_TOP      3328
#define XB_TOPGEN   3392
#define XCD_BAR_WORDS 3456
#define XB_SPIN_CAP (1u << 22)
__device__ __forceinline__ unsigned xb_ld(unsigned* p)              { return __hip_atomic_load(p, __ATOMIC_RELAXED, __HIP_MEMORY_SCOPE_AGENT); }
__device__ __forceinline__ unsigned xb_add(unsigned* p, unsigned v) { return __hip_atomic_fetch_add(p, v, __ATOMIC_RELAXED, __HIP_MEMORY_SCOPE_AGENT); }
__device__ __forceinline__ unsigned xb_xcc_id() { return (unsigned)__builtin_amdgcn_s_getreg((3 << 11) | 20) & 0xFu; }
#define XB_SPIN(cond, bar) do { unsigned _sp = 0; while (cond) { __builtin_amdgcn_s_sleep(1); \
    if ((++_sp & 255u) == 0u) { if (xb_ld(&(bar)[XB_TMO])) break; if (_sp > XB_SPIN_CAP) { atomicAdd(&(bar)[XB_TMO], 1u); break; } } } } while (0)
struct XcdBarrier { unsigned* bar; unsigned x; volatile LAS unsigned* st; };
__device__ __forceinline__ XcdBarrier xcd_barrier_post(unsigned* bar, volatile LAS unsigned* st) {
    XcdBarrier b; b.bar = bar; b.x = xb_xcc_id(); b.st = st;
    if (threadIdx.x == 0) (void)xb_add(&bar[XB_XCNT(b.x)], 1u);
    return b;
}
__device__ __forceinline__ void xcd_barrier_complete(unsigned* bar, unsigned x, unsigned& nloc, unsigned& nx) {
    const unsigned G = gridDim.x * gridDim.y * gridDim.z;
    unsigned sum, cnt, mine, sp = 0u;
    for (;;) {
        sum = 0u; cnt = 0u; mine = 0u;
#pragma unroll
        for (unsigned j = 0; j < 16; ++j) { const unsigned c = xb_ld(&bar[XB_XCNT(j)]); sum += c; cnt += (c > 0u) ? 1u : 0u; mine = (j == x) ? c : mine; }
        if (sum == G) break;
        __builtin_amdgcn_s_sleep(1);
        if ((++sp & 255u) == 0u) { if (xb_ld(&bar[XB_TMO])) break; if (sp > XB_SPIN_CAP) { atomicAdd(&bar[XB_TMO], 1u); break; } }
    }
    nloc = mine > 0u ? mine : 1u; nx = cnt > 0u ? cnt : 1u;
}
__device__ __forceinline__ void xcd_barrier(const XcdBarrier& b) {
    asm volatile("s_waitcnt vmcnt(0)" ::: "memory");
    __syncthreads();
    if (threadIdx.x == 0) {
        unsigned* bar = b.bar;
        __builtin_amdgcn_s_waitcnt(0);
        unsigned nloc = b.st[0], nx = b.st[1];
        if (nloc == 0u) { xcd_barrier_complete(bar, b.x, nloc, nx); b.st[0] = nloc; b.st[1] = nx; }
        const unsigned old = xb_add(&bar[XB_XSUB(b.x)], 1u);
        const unsigned gen = old / nloc;
        if (old + 1u == (gen + 1u) * nloc) {
            __builtin_amdgcn_fence(__ATOMIC_RELEASE, "agent");
            asm volatile("s_waitcnt vmcnt(0)" ::: "memory");
            const unsigned og = xb_add(&bar[XB_TOP], 1u);
            const unsigned tg = og / nx;
            if (og + 1u == (tg + 1u) * nx) xb_add(&bar[XB_TOPGEN], 1u);
            else XB_SPIN(xb_ld(&bar[XB_TOPGEN]) == tg, bar);
            __builtin_amdgcn_fence(__ATOMIC_ACQUIRE, "agent");
            xb_add(&bar[XB_XGEN(b.x)], 1u);
            asm volatile("s_waitcnt vmcnt(0)" ::: "memory");
        } else {
            XB_SPIN(xb_ld(&bar[XB_XGEN(b.x)]) == gen, bar);
            __builtin_amdgcn_fence(__ATOMIC_ACQUIRE, "agent");
            asm volatile("s_waitcnt vmcnt(0)" ::: "memory");
        }
    }
    __syncthreads();
}

constexpr int LDS_BYTES = 147456;
constexpr int MISC_OFF = 131072 + 320;
struct Frame {
    LAS unsigned char* lds;
    int tid, lane, wave, G;
    unsigned char* ws; gu32* ctl;
    float* out;
};
__device__ __forceinline__ float wave_sum(float v) {
#pragma unroll
    for (int o = 1; o < 64; o <<= 1) v += __shfl_xor(v, o);
    return v;
}

constexpr int PTR_OFF = 131072 + 512;
__device__ __forceinline__ const float* inp_ptr(Frame& F, int k) {
    const LAS unsigned* t = (const LAS unsigned*)(F.lds + PTR_OFF) + 2 * k;
    const unsigned lo = __builtin_amdgcn_readfirstlane(t[0]), hi = __builtin_amdgcn_readfirstlane(t[1]);
    return (const float*)(((unsigned long long)hi << 32) | lo);
}
#define INP(k) inp_ptr(F, (k))
__device__ __forceinline__ bool relaunder(Frame& F) { int t_ = threadIdx.x; asm volatile("" : "+v"(t_)); F.tid = t_; F.lane = t_ & 63; F.wave = __builtin_amdgcn_readfirstlane(t_ >> 6); return true; }
namespace pg8 {
#define PG8_LAS __attribute__((address_space(3)))
typedef unsigned short bf16_t;
typedef short bf16x8 __attribute__((ext_vector_type(8)));
typedef unsigned u32x4 __attribute__((ext_vector_type(4)));
constexpr int BM = 256, BK = 64, HALF = 128, HTB = HALF * BK * 2, STAGE_BYTES = 8 * HTB, NXCD = 8, WGM = 8;
__host__ __device__ __forceinline__ int lds_byte(int r, int c) { const int st = (r >> 4) * 2 + (c >> 5), rr = r & 15, cc = c & 31, ob = rr * 64 + cc * 2; return st * 1024 + (ob ^ (((ob >> 9) & 1) << 5)); }
__host__ __device__ __forceinline__ void stage_rc(int b, int& R, int& C) { const int st = b / 1024, sb = b % 1024, swz = sb ^ (((sb >> 9) & 1) << 5); R = (st >> 1) * 16 + swz / 64; C = (st & 1) * 32 + (swz % 64) / 2; }
__host__ __device__ __forceinline__ int perm32(int rho) { const int n = rho >> 4, i = rho & 15; return 8 * (i >> 2) + 4 * n + (i & 3); }
struct Unit { int pm, pn, e, mt; };

struct DenseOrder {
    int nM, nN, nwg, G, c; const char* A; const char* Bt; size_t tstep;
    __device__ __forceinline__ void init(const bf16_t* A_, const bf16_t* Bt_, int M_, int N_, int K_, int G_, int c_) { nM = M_ / BM; nN = N_ / BM; nwg = nM * nN; G = G_; c = c_; A = (const char*)A_; Bt = (const char*)Bt_; tstep = (size_t)BM * K_ * 2; }
    __device__ __forceinline__ bool next(int i, Unit& u) const {
        const long L = (long)i * G + c; if (L >= nwg) return false;
        int wgid = (int)L; { const int q = nwg / NXCD, r = nwg % NXCD, xcd = wgid % NXCD, off = wgid / NXCD; wgid = (xcd < r ? xcd * (q + 1) : r * (q + 1) + (xcd - r) * q) + off; }
        const int nig = WGM * nN, gid = wgid / nig, fm = gid * WGM, gsz = (nM - fm) < WGM ? (nM - fm) : WGM;
        u.pm = fm + ((wgid % nig) % gsz); u.pn = (wgid % nig) / gsz; u.e = 0; u.mt = u.pm; return true;
    }
    __device__ __forceinline__ const char* a_base(const Unit& u) const { return A + (size_t)u.pm * tstep; }
    __device__ __forceinline__ const char* b_base(const Unit& u) const { return Bt + (size_t)u.pn * tstep; }
    __device__ __forceinline__ void a_voff(const Unit&, const int (&)[2], const int (&)[2], unsigned (&)[2][2]) const {}
};
struct MoeOrder {
    int t1, t2, t3, t4, t5, t6, t7, t8, nN, G, c, K; const char* A; const char* Bt; size_t tstepA, tstepB, estepB; const int* list; bool gather;
    __device__ __forceinline__ bool next(int i, Unit& u) const {
        const int L = i * G + c; if (L >= t8 * nN) return false;
        const int mt = L / nN; u.pm = mt; u.pn = L - mt * nN;
        const int e = (mt >= t1) + (mt >= t2) + (mt >= t3) + (mt >= t4) + (mt >= t5) + (mt >= t6) + (mt >= t7);
        const int tb = e == 0 ? 0 : e == 1 ? t1 : e == 2 ? t2 : e == 3 ? t3 : e == 4 ? t4 : e == 5 ? t5 : e == 6 ? t6 : t7;
        u.e = e; u.mt = mt - tb; return true;
    }
    __device__ __forceinline__ const char* a_base(const Unit& u) const { return gather ? A : A + (size_t)u.pm * tstepA; }
    __device__ __forceinline__ const char* b_base(const Unit& u) const { return Bt + (size_t)u.e * estepB + (size_t)u.pn * tstepB; }
    __device__ __forceinline__ void a_voff(const Unit& u, const int (&sR)[2], const int (&sC)[2], unsigned (&v)[2][2]) const {
        const int* lp = list + u.e * LCAP + u.mt * 256;
#pragma unroll
        for (int h = 0; h < 2; ++h)
#pragma unroll
            for (int i = 0; i < 2; ++i) v[h][i] = (unsigned)lp[h * 128 + sR[i]] * (unsigned)(K * 2) + (unsigned)(sC[i] * 2);
    }
};

__device__ __forceinline__ unsigned cvt_pk_bf16(float lo, float hi) { unsigned r; asm volatile("v_cvt_pk_bf16_f32 %0, %1, %2" : "=v"(r) : "v"(lo), "v"(hi)); return r; }

struct EpiPlanes {
    static constexpr bool PERM = true;
    bf16_t* O; float scale0;
    __device__ __forceinline__ void operator()(const f32x4 (&acc)[2][2][4][2], const Unit& u, int wr, int wc, int fr, int fq) const {
        const int plane = u.pn >> 2; const float sc = plane == 0 ? scale0 : 1.f;
        bf16_t* base = O + (size_t)plane * PLANE + (size_t)(u.pm * BM + wr * 64 + fr) * DM + (u.pn & 3) * 256 + wc * 32 + 8 * fq;
#pragma unroll
        for (int ai = 0; ai < 2; ++ai)
#pragma unroll
            for (int m = 0; m < 4; ++m) { bf16_t* rowp = base + (size_t)(ai * HALF + m * 16) * DM;
#pragma unroll
                for (int bj = 0; bj < 2; ++bj) { const f32x4 v0 = acc[ai][bj][m][0] * sc, v1 = acc[ai][bj][m][1] * sc;
                    u32x4 w; w.x = cvt_pk_bf16(v0[0], v0[1]); w.y = cvt_pk_bf16(v0[2], v0[3]); w.z = cvt_pk_bf16(v1[0], v1[1]); w.w = cvt_pk_bf16(v1[2], v1[3]);
                    *(u32x4*)(rowp + bj * HALF) = w; } }
    }
};
struct EpiQKNorm {
    static constexpr bool PERM = true;
    bf16_t* O; const float* qg; const float* kg; int vplane;
    __device__ __forceinline__ void operator()(const f32x4 (&acc)[2][2][4][2], const Unit& u, int wr, int wc, int fr, int fq) const {
        const int plane = u.pn >> 2; const bool isv = plane == vplane; const bool isq = !isv && ((plane & 1) == 0); const int grp = plane >> 1;
        const float* g = (isq ? qg : kg) + grp * 64 + 8 * fq;
        f32x4 gv[2][2];
#pragma unroll
        for (int bj = 0; bj < 2; ++bj)
#pragma unroll
            for (int n = 0; n < 2; ++n) gv[bj][n] = isv ? (f32x4){1.f, 1.f, 1.f, 1.f} : *(const f32x4*)(g + 32 * bj + 4 * n);
        const float mul = isq ? C2 : 1.f;
        bf16_t* base = O + (size_t)plane * PLANE + (size_t)(u.pm * BM + wr * 64 + fr) * DM + (u.pn & 3) * 256 + wc * 64 + 8 * fq;
#pragma unroll
        for (int ai = 0; ai < 2; ++ai)
#pragma unroll
            for (int m = 0; m < 4; ++m) { bf16_t* rowp = base + (size_t)(ai * HALF + m * 16) * DM;
                float ss = 0.f;
#pragma unroll
                for (int bj = 0; bj < 2; ++bj)
#pragma unroll
                    for (int n = 0; n < 2; ++n) { const f32x4 x = acc[ai][bj][m][n]; ss += (x[0] * x[0] + x[1] * x[1]) + (x[2] * x[2] + x[3] * x[3]); }
                ss += __shfl_xor(ss, 16); ss += __shfl_xor(ss, 32);
                const float inv = isv ? 1.f : mul / sqrtf(ss * (1.f / 64.f) + RMS_EPS);
#pragma unroll
                for (int bj = 0; bj < 2; ++bj) { const f32x4 v0 = acc[ai][bj][m][0] * inv * gv[bj][0], v1 = acc[ai][bj][m][1] * inv * gv[bj][1];
                    u32x4 w; w.x = cvt_pk_bf16(v0[0], v0[1]); w.y = cvt_pk_bf16(v0[2], v0[3]); w.z = cvt_pk_bf16(v1[0], v1[1]); w.w = cvt_pk_bf16(v1[2], v1[3]);
                    *(u32x4*)(rowp + bj * 32) = w; } }
    }
};
struct EpiSwiglu {
    static constexpr bool PERM = true;
    bf16_t* O;
    __device__ __forceinline__ void operator()(const f32x4 (&acc)[2][2][4][2], const Unit& u, int wr, int wc, int fr, int fq) const {
        bf16_t* base = O + (size_t)(u.pm * BM + wr * 64 + fr) * FF + u.pn * 128 + wc * 32 + 8 * fq;
#pragma unroll
        for (int ai = 0; ai < 2; ++ai)
#pragma unroll
            for (int m = 0; m < 4; ++m) { bf16_t* rowp = base + (size_t)(ai * HALF + m * 16) * FF;
                float o[8];
#pragma unroll
                for (int n = 0; n < 2; ++n)
#pragma unroll
                    for (int i = 0; i < 4; ++i) { const float g = acc[ai][0][m][n][i], uu = acc[ai][1][m][n][i];
                        o[n * 4 + i] = g * __builtin_amdgcn_rcpf(1.0f + __builtin_amdgcn_exp2f(-g * LOG2E)) * uu; }
                u32x4 w; w.x = cvt_pk_bf16(o[0], o[1]); w.y = cvt_pk_bf16(o[2], o[3]); w.z = cvt_pk_bf16(o[4], o[5]); w.w = cvt_pk_bf16(o[6], o[7]);
                *(u32x4*)rowp = w; }
    }
};
struct EpiResid {
    static constexpr bool PERM = false;
    const float* base; float* out;
    __device__ __forceinline__ void operator()(const f32x4 (&acc)[2][2][4][2], const Unit& u, int wr, int wc, int fr, int fq) const {
        const size_t off0 = (size_t)(u.pm * BM + wr * 64 + fr) * DM + u.pn * BM + wc * 32 + 4 * fq;
#pragma unroll
        for (int ai = 0; ai < 2; ++ai)
#pragma unroll
            for (int m = 0; m < 4; ++m) { const size_t off = off0 + (size_t)(ai * HALF + m * 16) * DM;
#pragma unroll
                for (int bj = 0; bj < 2; ++bj)
#pragma unroll
                    for (int n = 0; n < 2; ++n) { const f32x4 b = *(const f32x4*)(base + off + bj * HALF + n * 16); *(f32x4*)(out + off + bj * HALF + n * 16) = b + acc[ai][bj][m][n]; } }
    }
};
struct EpiMoeDown {
    static constexpr bool PERM = false;
    float* Y; const float* gw;
    __device__ __forceinline__ void operator()(const f32x4 (&acc)[2][2][4][2], const Unit& u, int wr, int wc, int fr, int fq) const {
        const size_t off0 = (size_t)(u.pm * BM + wr * 64 + fr) * DM + u.pn * BM + wc * 32 + 4 * fq;
        const float* gp = gw + u.e * LCAP + u.mt * 256 + wr * 64 + fr;
#pragma unroll
        for (int ai = 0; ai < 2; ++ai)
#pragma unroll
            for (int m = 0; m < 4; ++m) { const size_t off = off0 + (size_t)(ai * HALF + m * 16) * DM; const float g = gp[ai * HALF + m * 16];
#pragma unroll
                for (int bj = 0; bj < 2; ++bj)
#pragma unroll
                    for (int n = 0; n < 2; ++n) *(f32x4*)(Y + off + bj * HALF + n * 16) = acc[ai][bj][m][n] * g; }
    }
};

template <class Epi, class Sched, bool GATHER>
__device__ __forceinline__ void gemm_phase(PG8_LAS unsigned char* lds, const int K, const Sched& S, const Epi& E) {
    const int tid = threadIdx.x, wid = __builtin_amdgcn_readfirstlane(tid >> 6), lane = tid & 63, wr = wid >> 2, wc = wid & 3, fr = lane & 15, fq = lane >> 4;
    const int nt = K / BK;
    unsigned voffA[2], voffB[2]; int sR[2], sC[2];
#pragma unroll
    for (int i = 0; i < 2; ++i) { int R, C; stage_rc(tid * 16 + i * 8192, R, C); const int Rb = Epi::PERM ? ((R & ~31) + perm32(R & 31)) : R;
        voffA[i] = (unsigned)(R * K + C) * 2u; voffB[i] = (unsigned)(Rb * K + C) * 2u; sR[i] = R; sC[i] = C; }
    const size_t kstep = (size_t)(BK * 2);
    const size_t hstep = (size_t)HALF * K * 2;
    const unsigned ldsw = (unsigned)wid * 1024u;
    const int aoff = lds_byte(wr * 64 + fr, fq * 8), boff = lds_byte(wc * 32 + fr, fq * 8);
#define PG8_SA(b, h) (((b) * 2 + (h)) * HTB)
#define PG8_SB(b, h) ((4 + (b) * 2 + (h)) * HTB)
#define PG8_STAGE(bufoff, gbase, voff) do { _Pragma("unroll") for (int _i = 0; _i < 2; ++_i) \
        __builtin_amdgcn_global_load_lds((const unsigned*)((const char*)(gbase) + (voff)[_i]), (PG8_LAS unsigned*)(lds + (bufoff) + ldsw + _i * 8192), 16, 0, 0); } while (0)
#define PG8_STAGE_A(bufoff, p, h, VG) do { if (GATHER) { PG8_STAGE(bufoff, p, VG[h]); } else { PG8_STAGE(bufoff, (p) + ((h) ? hstep : 0), voffA); } } while (0)
#define PG8_LDA(dst, b, h) do { _Pragma("unroll") for (int m = 0; m < 4; ++m) _Pragma("unroll") for (int k = 0; k < 2; ++k) dst[m][k] = *(const PG8_LAS bf16x8*)(lds + PG8_SA(b, h) + aoff + m * 2048 + k * 1024); } while (0)
#define PG8_LDB(dst, b, h) do { _Pragma("unroll") for (int n = 0; n < 2; ++n) _Pragma("unroll") for (int k = 0; k < 2; ++k) dst[n][k] = *(const PG8_LAS bf16x8*)(lds + PG8_SB(b, h) + boff + n * 2048 + k * 1024); } while (0)
#define PG8_MMA(ai, bj, At, Bt) do { __builtin_amdgcn_s_setprio(1); _Pragma("unroll") for (int m = 0; m < 4; ++m) _Pragma("unroll") for (int n = 0; n < 2; ++n) _Pragma("unroll") for (int k = 0; k < 2; ++k) \
        acc[ai][bj][m][n] = __builtin_amdgcn_mfma_f32_16x16x32_bf16(Bt[n][k], At[m][k], acc[ai][bj][m][n], 0, 0, 0); __builtin_amdgcn_s_setprio(0); } while (0)
#define PG8_WAIT_V(n) asm volatile("s_waitcnt vmcnt(" #n ")" ::: "memory")
#define PG8_WAIT_L(n) asm volatile("s_waitcnt lgkmcnt(" #n ")" ::: "memory")
#define PG8_BAR __builtin_amdgcn_s_barrier()
#define PG8_SCHED __builtin_amdgcn_sched_barrier(0)
    Unit cur, nxt; int ui = 0;
    if (!S.next(0, cur)) return;
    f32x4 acc[2][2][4][2];
#pragma unroll
    for (int a = 0; a < 2; ++a)
#pragma unroll
        for (int b = 0; b < 2; ++b)
#pragma unroll
            for (int m = 0; m < 4; ++m)
#pragma unroll
                for (int n = 0; n < 2; ++n) acc[a][b][m][n] = (f32x4){0.f, 0.f, 0.f, 0.f};
    bf16x8 At[4][2], B0[2][2], B1[2][2];
    const char* cA = S.a_base(cur); const char* cB = S.b_base(cur);
    unsigned vc[2][2] = {{0u, 0u}, {0u, 0u}}, vn[2][2] = {{0u, 0u}, {0u, 0u}};
    if (GATHER) { S.a_voff(cur, sR, sC, vc); asm volatile("s_waitcnt vmcnt(0)" : "+v"(vc[0][0]), "+v"(vc[0][1]), "+v"(vc[1][0]), "+v"(vc[1][1]) :: "memory"); }
    PG8_STAGE(PG8_SB(0, 0), cB, voffB); PG8_STAGE(PG8_SB(0, 1), cB + hstep, voffB); PG8_STAGE_A(PG8_SA(0, 0), cA, 0, vc); PG8_STAGE_A(PG8_SA(0, 1), cA, 1, vc);
    if (wr == 1) PG8_BAR;
    PG8_WAIT_V(2); PG8_BAR;
    PG8_STAGE(PG8_SB(1, 0), cB + kstep, voffB); PG8_STAGE_A(PG8_SA(1, 0), cA + kstep, 0, vc); PG8_STAGE(PG8_SB(1, 1), cB + hstep + kstep, voffB);
    PG8_WAIT_V(6); PG8_BAR;
    for (;;) {
        const bool has_next = S.next(ui + 1, nxt);
        const char* nA = has_next ? S.a_base(nxt) : cA; const char* nB = has_next ? S.b_base(nxt) : cB;
        if (GATHER) {
            if (has_next) { S.a_voff(nxt, sR, sC, vn); asm volatile("s_waitcnt vmcnt(0)" : "+v"(vn[0][0]), "+v"(vn[0][1]), "+v"(vn[1][0]), "+v"(vn[1][1]) :: "memory"); }
            else { vn[0][0] = vc[0][0]; vn[0][1] = vc[0][1]; vn[1][0] = vc[1][0]; vn[1][1] = vc[1][1]; }
        }
        for (int t = 0; t < nt; t += 2) {
            const bool last = (t == nt - 2);
            const char* a1 = cA + (size_t)(t + 1) * kstep;
            const char* a2 = last ? nA : cA + (size_t)(t + 2) * kstep; const char* b2 = last ? nB : cB + (size_t)(t + 2) * kstep;
            const char* a3 = a2 + kstep; const char* b3 = b2 + kstep;
            unsigned v2[2][2];
#pragma unroll
            for (int h = 0; h < 2; ++h)
#pragma unroll
                for (int i = 0; i < 2; ++i) v2[h][i] = last ? vn[h][i] : vc[h][i];
            PG8_LDB(B0, 0, 0); PG8_LDB(B1, 0, 1); PG8_SCHED; PG8_LDA(At, 0, 0); PG8_STAGE_A(PG8_SA(1, 1), a1, 1, vc);
            PG8_WAIT_V(8); PG8_WAIT_L(0); PG8_BAR; PG8_MMA(0, 0, At, B0); PG8_MMA(0, 1, At, B1); PG8_BAR; PG8_SCHED;
            PG8_LDA(At, 0, 1); PG8_STAGE(PG8_SB(0, 0), b2, voffB); PG8_STAGE(PG8_SB(0, 1), b2 + hstep, voffB); PG8_STAGE_A(PG8_SA(0, 0), a2, 0, v2);
            PG8_WAIT_V(8); PG8_WAIT_L(0); PG8_BAR; PG8_MMA(1, 0, At, B0); PG8_MMA(1, 1, At, B1); PG8_BAR; PG8_SCHED;
            PG8_LDB(B0, 1, 0); PG8_LDB(B1, 1, 1); PG8_SCHED; PG8_LDA(At, 1, 0); PG8_STAGE_A(PG8_SA(0, 1), a2, 1, v2);
            PG8_WAIT_V(8); PG8_WAIT_L(0); PG8_BAR; PG8_MMA(0, 0, At, B0); PG8_MMA(0, 1, At, B1); PG8_BAR; PG8_SCHED;
            PG8_LDA(At, 1, 1); PG8_STAGE(PG8_SB(1, 0), b3, voffB); PG8_STAGE(PG8_SB(1, 1), b3 + hstep, voffB); PG8_STAGE_A(PG8_SA(1, 0), a3, 0, v2);
            PG8_WAIT_V(8); PG8_WAIT_L(0); PG8_BAR; PG8_MMA(1, 0, At, B0); PG8_MMA(1, 1, At, B1); PG8_BAR; PG8_SCHED;
        }
        if (wr == 0) PG8_BAR;
        E(acc, cur, wr, wc, fr, fq);
        if (!has_next) break;
#pragma unroll
        for (int a = 0; a < 2; ++a)
#pragma unroll
            for (int b = 0; b < 2; ++b)
#pragma unroll
                for (int m = 0; m < 4; ++m)
#pragma unroll
                    for (int n = 0; n < 2; ++n) acc[a][b][m][n] = (f32x4){0.f, 0.f, 0.f, 0.f};
        cur = nxt; cA = nA; cB = nB; ++ui;
        if (GATHER) { vc[0][0] = vn[0][0]; vc[0][1] = vn[0][1]; vc[1][0] = vn[1][0]; vc[1][1] = vn[1][1]; }
        if (wr == 1) PG8_BAR;
    }
    PG8_WAIT_V(0);
    PG8_BAR;
#undef PG8_SA
#undef PG8_SB
#undef PG8_STAGE
#undef PG8_STAGE_A
#undef PG8_LDA
#undef PG8_LDB
#undef PG8_MMA
#undef PG8_WAIT_V
#undef PG8_WAIT_L
#undef PG8_BAR
#undef PG8_SCHED
}
}

namespace att {
typedef short bf16x8 __attribute__((ext_vector_type(8)));
typedef short s16x4 __attribute__((ext_vector_type(4)));
typedef float f32x16 __attribute__((ext_vector_type(16)));
typedef unsigned u32x4 __attribute__((ext_vector_type(4)));
typedef LAS char* lptr;
constexpr int SLOTB = 8192;
constexpr int L_K = 0, L_V = 3 * SLOTB, L_WS = 6 * SLOTB, L_OST = L_WS + 8 * 256, L_KB = L_OST + 8 * 4096, L_TBL = L_KB + 8192, L_FLG = L_TBL + 8192, L_END = L_FLG + 256;
static_assert(L_END <= 131072, "attention LDS map inside the ring region");
constexpr float THR = 8.0f;
__device__ __forceinline__ int crow(int r, int hi) { return (r & 3) + 8 * (r >> 2) + 4 * hi; }
__device__ __forceinline__ void glds16(const void* gsrc, unsigned lds_dst) { unsigned keep;
    asm volatile("s_mov_b32 %0, m0\n\ts_mov_b32 m0, %2\n\ts_nop 0\n\tglobal_load_lds_dwordx4 %1, off\n\ts_mov_b32 m0, %0" : "=&s"(keep) : "v"(gsrc), "s"(lds_dst) : "memory"); }
typedef float f32x2_t __attribute__((ext_vector_type(2))); typedef __bf16 bf16x2_t __attribute__((ext_vector_type(2)));
__device__ __forceinline__ unsigned cvtpk(float lo, float hi) { f32x2_t v = {lo, hi}; bf16x2_t b = __builtin_convertvector(v, bf16x2_t); return __builtin_bit_cast(unsigned, b); }
#define ATT_WAIT_BAR(N) asm volatile("s_waitcnt vmcnt(" #N ") lgkmcnt(0)\n\ts_barrier" ::: "memory")
__device__ __forceinline__ float other_half(float x, int hi) {
    auto rr = __builtin_amdgcn_permlane32_swap(__float_as_uint(x), __float_as_uint(x), false, false);
    return __uint_as_float(hi ? rr[0] : rr[1]);
}
__device__ __forceinline__ void qkt(f32x16& p0, f32x16& p1, lptr Kslot, const bf16x8* qr, int r32, int hi) {
    lptr kb = Kslot + hi * 1024 + r32 * 16;
    const f32x16 z = {};
#pragma unroll
    for (int d0 = 0; d0 < 4; ++d0) {
        const bf16x8 b0 = *(const LAS bf16x8*)(kb + d0 * 2048);
        const bf16x8 b1 = *(const LAS bf16x8*)(kb + d0 * 2048 + 512);
        if (d0 == 0) { p0 = __builtin_amdgcn_mfma_f32_32x32x16_bf16(b0, qr[0], z, 0, 0, 0); p1 = __builtin_amdgcn_mfma_f32_32x32x16_bf16(b1, qr[0], z, 0, 0, 0); }
        else { p0 = __builtin_amdgcn_mfma_f32_32x32x16_bf16(b0, qr[d0], p0, 0, 0, 0); p1 = __builtin_amdgcn_mfma_f32_32x32x16_bf16(b1, qr[d0], p1, 0, 0, 0); } }
}
__device__ __forceinline__ void pv(f32x16* o, int vb, bf16x8 pa0, bf16x8 pa1, bf16x8 pa2, bf16x8 pa3) {
#pragma unroll
    for (int d0 = 0; d0 < 2; ++d0) { s16x4 lo[4], hi[4];
#pragma unroll
        for (int ks = 0; ks < 4; ++ks) {
            asm volatile("ds_read_b64_tr_b16 %0,%1 offset:%c2" : "=&v"(lo[ks]) : "v"(vb), "i"(d0 * 4096 + ks * 1024) : "memory");
            asm volatile("ds_read_b64_tr_b16 %0,%1 offset:%c2" : "=&v"(hi[ks]) : "v"(vb), "i"(d0 * 4096 + ks * 1024 + 512) : "memory"); }
        asm volatile("s_waitcnt lgkmcnt(0)" ::: "memory"); __builtin_amdgcn_sched_barrier(0);
#define ATT_PK(k) (bf16x8){lo[k][0], lo[k][1], lo[k][2], lo[k][3], hi[k][0], hi[k][1], hi[k][2], hi[k][3]}
        o[d0] = __builtin_amdgcn_mfma_f32_32x32x16_bf16(pa0, ATT_PK(0), o[d0], 0, 0, 0);
        o[d0] = __builtin_amdgcn_mfma_f32_32x32x16_bf16(pa1, ATT_PK(1), o[d0], 0, 0, 0);
        o[d0] = __builtin_amdgcn_mfma_f32_32x32x16_bf16(pa2, ATT_PK(2), o[d0], 0, 0, 0);
        o[d0] = __builtin_amdgcn_mfma_f32_32x32x16_bf16(pa3, ATT_PK(3), o[d0], 0, 0, 0);
#undef ATT_PK
    }
}
__device__ __forceinline__ float rowmax32(const f32x16& p0, const f32x16& p1, int hi) {
    float a = fmaxf(p0[0], p1[0]);
#pragma unroll
    for (int r = 1; r < 16; ++r) a = fmaxf(a, fmaxf(p0[r], p1[r]));
    return fmaxf(a, other_half(a, hi));
}
__device__ __forceinline__ void store_o(const f32x16* o, const float* sc, lptr stgb, bf16* Ow, long rpitch, int lane, int r32, int hi) {
    LAS bf16* stg = (LAS bf16*)stgb;
#pragma unroll
    for (int r = 0; r < 16; ++r) { const int orow = crow(r, hi);
#pragma unroll
        for (int d0 = 0; d0 < 2; ++d0) stg[orow * 64 + d0 * 32 + r32] = (bf16)f2bf(o[d0][r] * sc[r]); }
    asm volatile("s_waitcnt lgkmcnt(0)" ::: "memory");
#pragma unroll
    for (int i = 0; i < 4; ++i) { const int row = i * 8 + (lane >> 3), ch = lane & 7; const u32x4 v = *(const LAS u32x4*)(stg + row * 64 + ch * 8); *(u32x4*)(Ow + (long)row * rpitch + ch * 8) = v; }
}

__device__ __forceinline__ void fox_unit(lptr shm, int b, int h, int qb, const bf16* Q, const bf16* K, const bf16* V, bf16* O, const float* cum) {
    const int tid = threadIdx.x, lane = tid & 63, r32 = lane & 31, hi = lane >> 5; const int wid = __builtin_amdgcn_readfirstlane(tid >> 6);
    const long rowbase = (long)b * SEQ; const int q0 = qb * 256;
    const bf16* Qw = Q + (rowbase + q0 + wid * 32) * DM + h * 64;
    const bf16* Kh = K + rowbase * DM + h * 64; const bf16* Vh = V + rowbase * DM + h * 64;
    const unsigned lds0 = (unsigned)(uintptr_t)shm;
    LAS float* wsf = (LAS float*)(shm + L_WS) + wid * 64;
    LAS float* kbl = (LAS float*)(shm + L_KB);
    for (int s = tid; s < q0 + 256; s += NTHR) kbl[s] = -cum[(rowbase + s) * 16 + h];
    bf16x8 qr[4];
#pragma unroll
    for (int d0 = 0; d0 < 4; ++d0) qr[d0] = *(const bf16x8*)(Qw + (long)r32 * DM + d0 * 16 + hi * 8);
    const int NT = (q0 + 256) / 64;
    const bf16* ksrc = Kh + (long)lane * DM + wid * 8;
    const bf16* vsrc = Vh + (long)(16 * (wid & 3) + (lane >> 2)) * DM + (wid >> 2) * 32 + (lane & 3) * 8;
    const unsigned kdst = lds0 + L_K + wid * 1024, vdst = lds0 + L_V + wid * 1024;
    const int vb0 = (int)(lds0 + L_V) + ((lane >> 4) & 1) * 32 + (lane & 3) * 8 + (4 * hi + ((lane & 15) >> 2)) * 64;
#define ATT_DMA(t, sl) do { glds16(ksrc + (long)(t) * 64 * DM, (unsigned)__builtin_amdgcn_readfirstlane(kdst + (sl) * SLOTB)); glds16(vsrc + (long)(t) * 64 * DM, (unsigned)__builtin_amdgcn_readfirstlane(vdst + (sl) * SLOTB)); } while (0)
    asm volatile("s_waitcnt vmcnt(0)" : "+v"(qr[0]), "+v"(qr[1]), "+v"(qr[2]), "+v"(qr[3]) :: "memory");
    ATT_DMA(0, 0); ATT_DMA(1, 1);
    float mref = -1e30f, lsum = 0.f; f32x16 o[2]; o[0] = f32x16{}; o[1] = f32x16{};
    const int qfirst = q0 + wid * 32, qpos = qfirst + r32;
    int slot = 0;
    for (int t = 0; t < NT; ++t) {
        if (t + 1 < NT) ATT_WAIT_BAR(2); else ATT_WAIT_BAR(0);
        if (t + 2 < NT) { const int s2 = slot >= 1 ? slot - 1 : 2; ATT_DMA(t + 2, s2); }
        if (64 * t <= qfirst + 31) {
            f32x16 p0, p1; qkt(p0, p1, shm + L_K + slot * SLOTB, qr, r32, hi);
#pragma unroll
            for (int g = 0; g < 4; ++g) { const f32x4 k0 = *(const LAS f32x4*)(kbl + 64 * t + 8 * g + 4 * hi), k1 = *(const LAS f32x4*)(kbl + 64 * t + 32 + 8 * g + 4 * hi);
#pragma unroll
                for (int i = 0; i < 4; ++i) { p0[4 * g + i] += k0[i]; p1[4 * g + i] += k1[i]; } }
            if (64 * t + 63 > qfirst) {
#pragma unroll
                for (int r = 0; r < 16; ++r) { const int kv = 64 * t + crow(r, hi); if (kv > qpos) p0[r] = -INFINITY; if (kv + 32 > qpos) p1[r] = -INFINITY; } }
            const float rm = rowmax32(p0, p1, hi);
            const bool fresh = mref <= -1e30f;
            const bool want = !fresh && (rm > mref + THR);
            if (fresh) mref = fmaxf(rm, -1e30f);
            if (__any(want)) {
                const float dl = want ? rm - mref : 0.f; mref += dl; const float f = __builtin_amdgcn_exp2f(-dl); lsum *= f;
                if (hi == 0) wsf[r32] = f;
                asm volatile("s_waitcnt lgkmcnt(0)" ::: "memory");
#pragma unroll
                for (int r = 0; r < 16; ++r) { const float fr = wsf[crow(r, hi)]; o[0][r] *= fr; o[1][r] *= fr; }
            }
            float sacc = 0.f;
#pragma unroll
            for (int r = 0; r < 16; ++r) { p0[r] = __builtin_amdgcn_exp2f(p0[r] - mref); p1[r] = __builtin_amdgcn_exp2f(p1[r] - mref); sacc += p0[r] + p1[r]; }
            lsum += sacc;
            u32x4 w0, w1, w2, w3;
#pragma unroll
            for (int j = 0; j < 4; ++j) { w0[j] = cvtpk(p0[2 * j], p0[2 * j + 1]); w1[j] = cvtpk(p0[8 + 2 * j], p0[8 + 2 * j + 1]); w2[j] = cvtpk(p1[2 * j], p1[2 * j + 1]); w3[j] = cvtpk(p1[8 + 2 * j], p1[8 + 2 * j + 1]); }
            pv(o, vb0 + slot * SLOTB, __builtin_bit_cast(bf16x8, w0), __builtin_bit_cast(bf16x8, w1), __builtin_bit_cast(bf16x8, w2), __builtin_bit_cast(bf16x8, w3));
        }
        slot = slot == 2 ? 0 : slot + 1;
    }
    lsum += other_half(lsum, hi);
    if (hi == 0) wsf[32 + r32] = lsum;
    asm volatile("s_waitcnt lgkmcnt(0)" ::: "memory");
    float rli[16];
#pragma unroll
    for (int r = 0; r < 16; ++r) rli[r] = __builtin_amdgcn_rcpf(wsf[32 + crow(r, hi)]);
    store_o(o, rli, shm + L_OST + wid * 4096, O + (rowbase + q0 + wid * 32) * DM + h * 64, DM, lane, r32, hi);
    asm volatile("s_waitcnt lgkmcnt(0)\n\ts_barrier" ::: "memory");
#undef ATT_DMA
}

__device__ __forceinline__ void sb_unit(lptr shm, int b, int h, int qb, const bf16* Q, const bf16* K, const bf16* V, bf16* O) {
    const int tid = threadIdx.x, lane = tid & 63, r32 = lane & 31, hi = lane >> 5; const int wid = __builtin_amdgcn_readfirstlane(tid >> 6);
    const long rowbase = (long)b * SEQ; const int q0 = qb * 256;
    const bf16* Qw = Q + (rowbase + q0 + wid * 32) * DM + h * 64;
    const bf16* Kh = K + rowbase * DM + h * 64; const bf16* Vh = V + rowbase * DM + h * 64;
    const unsigned lds0 = (unsigned)(uintptr_t)shm;
    LAS int* flg = (LAS int*)(shm + L_FLG);
    if (tid < 16) flg[tid] = 0;
    bf16x8 qr[4];
#pragma unroll
    for (int d0 = 0; d0 < 4; ++d0) qr[d0] = *(const bf16x8*)(Qw + (long)r32 * DM + d0 * 16 + hi * 8);
    const int NT = (q0 + 256) / 64;
    const bf16* ksrc = Kh + (long)lane * DM + wid * 8;
    const bf16* vsrc = Vh + (long)(16 * (wid & 3) + (lane >> 2)) * DM + (wid >> 2) * 32 + (lane & 3) * 8;
    const unsigned kdst = lds0 + L_K + wid * 1024, vdst = lds0 + L_V + wid * 1024;
    const int vb0 = (int)(lds0 + L_V) + ((lane >> 4) & 1) * 32 + (lane & 3) * 8 + (4 * hi + ((lane & 15) >> 2)) * 64;
#define ATT_DMA(T, sl) do { glds16(ksrc + (long)(T) * 64 * DM, (unsigned)__builtin_amdgcn_readfirstlane(kdst + (sl) * SLOTB)); glds16(vsrc + (long)(T) * 64 * DM, (unsigned)__builtin_amdgcn_readfirstlane(vdst + (sl) * SLOTB)); } while (0)
    asm volatile("s_waitcnt vmcnt(0)" : "+v"(qr[0]), "+v"(qr[1]), "+v"(qr[2]), "+v"(qr[3]) :: "memory");
    ATT_DMA(NT - 1, 0); ATT_DMA(NT - 2, 1);
    float carry = 1.0f; f32x16 o[2]; o[0] = f32x16{}; o[1] = f32x16{};
    const int qfirst = q0 + wid * 32, qpos = qfirst + r32;
    int slot = 0; int done = 0;
    for (int k = 0; k < NT; ++k) {
        const int T = NT - 1 - k;
        if (k + 1 < NT) ATT_WAIT_BAR(2); else ATT_WAIT_BAR(0);
        if (k > 0) { int all = 1;
#pragma unroll
            for (int w = 0; w < 8; ++w) all &= flg[((k - 1) & 1) * 8 + w];
            if (__builtin_amdgcn_readfirstlane(all)) break; }
        if (k + 2 < NT) { const int s2 = slot >= 1 ? slot - 1 : 2; ATT_DMA(T - 2, s2); }
        if (!done && 64 * T < qfirst + 31) {
            f32x16 p0, p1; qkt(p0, p1, shm + L_K + slot * SLOTB, qr, r32, hi);
            const bool diag = 64 * T + 63 >= qfirst;
            float ga[8];
#pragma unroll
            for (int a = 0; a < 8; ++a) {
                float rr[4];
#pragma unroll
                for (int i = 0; i < 4; ++i) { const int r = 4 * (a & 3) + i; const float z = (a < 4) ? p0[r] : p1[r];
                    const float e = __builtin_amdgcn_exp2f(fminf(z, 120.f)); float rv = __builtin_amdgcn_rcpf(1.0f + e);
                    if (diag) { const int kv = 64 * T + crow(r, hi) + ((a < 4) ? 0 : 32); if (kv >= qpos) rv = 1.0f; }
                    rr[i] = rv; if (a < 4) p0[r] = rv; else p1[r] = rv; }
                ga[a] = (rr[0] * rr[1]) * (rr[2] * rr[3]);
            }
            float oth[8], Ts[8];
#pragma unroll
            for (int a = 0; a < 8; ++a) oth[a] = other_half(ga[a], hi);
            float run = 1.0f;
#pragma unroll
            for (int a = 7; a >= 0; --a) { Ts[a] = run; run *= ga[a] * oth[a]; }
#pragma unroll
            for (int a = 0; a < 8; ++a) {
                float E = carry * Ts[a] * (hi ? 1.0f : oth[a]);
#pragma unroll
                for (int i = 3; i >= 0; --i) { const int r = 4 * (a & 3) + i; const float rv = (a < 4) ? p0[r] : p1[r]; const float w = (1.0f - rv) * E; E *= rv; if (a < 4) p0[r] = w; else p1[r] = w; }
            }
            carry *= run;
            u32x4 w0, w1, w2, w3;
#pragma unroll
            for (int j = 0; j < 4; ++j) { w0[j] = cvtpk(p0[2 * j], p0[2 * j + 1]); w1[j] = cvtpk(p0[8 + 2 * j], p0[8 + 2 * j + 1]); w2[j] = cvtpk(p1[2 * j], p1[2 * j + 1]); w3[j] = cvtpk(p1[8 + 2 * j], p1[8 + 2 * j + 1]); }
            pv(o, vb0 + slot * SLOTB, __builtin_bit_cast(bf16x8, w0), __builtin_bit_cast(bf16x8, w1), __builtin_bit_cast(bf16x8, w2), __builtin_bit_cast(bf16x8, w3));
            if (__all(carry < 1e-30f)) done = 1;
        }
        if (lane == 0) flg[(k & 1) * 8 + wid] = done;
        slot = slot == 2 ? 0 : slot + 1;
    }
    asm volatile("s_waitcnt vmcnt(0)" ::: "memory");
    float one[16];
#pragma unroll
    for (int r = 0; r < 16; ++r) one[r] = 1.0f;
    store_o(o, one, shm + L_OST + wid * 4096, O + (rowbase + q0 + wid * 32) * DM + h * 64, DM, lane, r32, hi);
    asm volatile("s_waitcnt lgkmcnt(0)\n\ts_barrier" ::: "memory");
#undef ATT_DMA
}

template <int MODE>
__device__ __forceinline__ void causal_phase(lptr shm, int G, const bf16* Q, const bf16* K, const bf16* V, bf16* O, const float* cum) {
    const int bx = blockIdx.x; const int vcu = (G % 8 == 0) ? (bx % 8) * (G / 8) + bx / 8 : bx;
    for (int u = vcu; u < BATCH * NH * 2; u += G) {
        const int bh = u >> 1, p = u & 1, b = bh >> 4, h = bh & 15;
#pragma unroll 1
        for (int i = 0; i < 4; ++i) {
            const int qb = (i == 0) ? 7 - p : (i == 1) ? 5 - p : (i == 2) ? 2 + p : p;
            if (MODE == 0) sb_unit(shm, b, h, qb, Q, K, V, O); else fox_unit(shm, b, h, qb, Q, K, V, O, cum);
        }
    }
}
}

enum { CV_PLAIN = 0, CV_QKN = 1, CV_GATE = 2, CV_UP = 3 };
__device__ __forceinline__ int cv_dst_row(int mode, int n) {
    if (mode == CV_QKN) return (n & ~255) + 128 * ((n >> 5) & 1) + 32 * ((n >> 6) & 3) + (n & 31);
    if (mode == CV_GATE) return 256 * (n >> 7) + (n & 127);
    if (mode == CV_UP) return 256 * (n >> 7) + 128 + (n & 127);
    return n;
}
__device__ __forceinline__ void conv_item(const float* W, int ldw, int K, bf16* WT, int mode, LAS unsigned char* scr, int item, int nblk, int lane) {
    const int kb = item / nblk, nb = item - kb * nblk, k0 = 64 * kb, n0 = 64 * nb;
    const GAS float* src = (const GAS float*)(W + (size_t)k0 * ldw + n0 + lane);
#pragma unroll
    for (int kc = 0; kc < 8; ++kc) {
        float v[8];
#pragma unroll
        for (int j = 0; j < 8; ++j) v[j] = src[(size_t)(kc * 8 + j) * ldw];
        v4u w; w.x = pk2(v[0], v[1]); w.y = pk2(v[2], v[3]); w.z = pk2(v[4], v[5]); w.w = pk2(v[6], v[7]);
        *(LAS v4u*)(scr + lane * 144 + kc * 16) = w;
    }
    asm volatile("s_waitcnt lgkmcnt(0)" ::: "memory");
#pragma unroll
    for (int j = 0; j < 8; ++j) { const int n = 8 * j + (lane >> 3), ch = lane & 7;
        const v4u w = *(const LAS v4u*)(scr + n * 144 + ch * 16);
        *(GAS v4u*)(WT + (size_t)cv_dst_row(mode, n0 + n) * K + k0 + 8 * ch) = w; }
    asm volatile("s_waitcnt lgkmcnt(0)" ::: "memory");
}
__device__ __forceinline__ void conv_job(Frame& F, const float* W, int ldw, int K, int N, bf16* WT, int mode, int& rot) {
    LAS unsigned char* scr = F.lds + F.wave * 9216;
    const int nblk = N / 64, nitems = (K / 64) * nblk, NGW = F.G * NWAVES, gw = blockIdx.x * NWAVES + F.wave;
    int first = gw - (rot % NGW); if (first < 0) first += NGW;
    for (int it = first; it < nitems; it += NGW) conv_item(W, ldw, K, WT, mode, scr, it, nblk, F.lane);
    rot += nitems;
}
__device__ __forceinline__ void convert_weights(Frame& F) {
    bf16* WB = (bf16*)(F.ws + WS_W); int rot = 0;
    for (int j = 0; j < 2; ++j) conv_job(F, INP(1) + (size_t)j * DM * 3 * DM, 3 * DM, DM, 3 * DM, WB + WE_QKV + (size_t)j * 3 * DM * DM, CV_PLAIN, rot);
    for (int j = 0; j < 2; ++j) conv_job(F, INP(2) + (size_t)j * DM * DM, DM, DM, DM, WB + WE_WO_SB + (size_t)j * DM * DM, CV_PLAIN, rot);
    conv_job(F, INP(3), 7 * DM, DM, 7 * DM, WB + WE_IN_DIL, CV_QKN, rot);
    conv_job(F, INP(6), DM, DM, DM, WB + WE_WO_DIL, CV_PLAIN, rot);
    conv_job(F, INP(7), 3088, DM, 3 * DM, WB + WE_IN_FOX, CV_QKN, rot);
    conv_job(F, INP(11), DM, DM, DM, WB + WE_WO_FOX, CV_PLAIN, rot);
    for (int f = 0; f < 2; ++f) {
        conv_job(F, INP(15) + (size_t)f * DM * FF, FF, DM, FF, WB + WE_GU + (size_t)f * 2 * FF * DM, CV_GATE, rot);
        conv_job(F, INP(16) + (size_t)f * DM * FF, FF, DM, FF, WB + WE_GU + (size_t)f * 2 * FF * DM, CV_UP, rot);
        conv_job(F, INP(17) + (size_t)f * FF * DM, DM, FF, DM, WB + WE_D + (size_t)f * DM * FF, CV_PLAIN, rot);
    }
    for (int fe = 0; fe < 16; ++fe) {
        conv_job(F, INP(19) + (size_t)fe * DM * FF, FF, DM, FF, WB + WE_MGU + (size_t)fe * 2 * FF * DM, CV_GATE, rot);
        conv_job(F, INP(20) + (size_t)fe * DM * FF, FF, DM, FF, WB + WE_MGU + (size_t)fe * 2 * FF * DM, CV_UP, rot);
        conv_job(F, INP(21) + (size_t)fe * FF * DM, DM, FF, DM, WB + WE_MD + (size_t)fe * DM * FF, CV_PLAIN, rot);
    }
}

__device__ __forceinline__ void moe_bases(Frame& F, int f, int (&tb)[NE + 1]) {
    int acc = 0;
#pragma unroll
    for (int e = 0; e < NE; ++e) { tb[e] = acc; const int c = (int)__hip_atomic_load(F.ctl + CW_CNT + f * 64 + e, RLX_AGENT); acc += (c + 255) >> 8; }
    tb[NE] = acc;
}

template <int FLAGS>
__device__ __forceinline__ void norm_phase(Frame& F, const float* xin, float* xout, const float* gain, bf16* H, int fprev, int f,
                                           const float* Wf  , const float* bf  , const float* Wr  ) {
    const float* Y = (const float*)(F.ws + WS_R2);
    const int* tok_prev = (const int*)(F.ws + WS_MISC + MS_TOK) + (size_t)fprev * M * 2;
    float* lgf = (float*)(F.ws + WS_MISC + MS_LOGF);
    LAS int* sel = (LAS int*)F.lds;
    LAS float* sg = (LAS float*)(F.lds + 512);
    LAS int* lpos = (LAS int*)(F.lds + 1024);
    LAS int* gb = (LAS int*)(F.lds + 1536);
    int tb[NE + 1];
    if (FLAGS & 1) moe_bases(F, fprev, tb);
    for (int chunk = blockIdx.x; chunk < M / 64; chunk += F.G) {
        for (int i = 0; i < 8; ++i) {
            const int m = chunk * 64 + F.wave * 8 + i;
            const GAS f32x4* xr = (const GAS f32x4*)(xin + (size_t)m * DM) + F.lane;
            f32x4 v[4];
#pragma unroll
            for (int j = 0; j < 4; ++j) v[j] = xr[64 * j];
            if (FLAGS & 1) {
                const int s0 = tok_prev[m * 2], s1 = tok_prev[m * 2 + 1];
                int r0 = 0, r1 = 0;
#pragma unroll
                for (int e = 0; e < NE; ++e) { if ((s0 >> 14) == e) r0 = tb[e] * 256 + (s0 & 16383); if ((s1 >> 14) == e) r1 = tb[e] * 256 + (s1 & 16383); }
                const GAS f32x4* y0 = (const GAS f32x4*)(Y + (size_t)r0 * DM) + F.lane;
                const GAS f32x4* y1 = (const GAS f32x4*)(Y + (size_t)r1 * DM) + F.lane;
#pragma unroll
                for (int j = 0; j < 4; ++j) { v[j] = v[j] + y0[64 * j] + y1[64 * j]; ((GAS f32x4*)(xout + (size_t)m * DM) + F.lane)[64 * j] = v[j]; }
            }
            float s = 0.f;
#pragma unroll
            for (int j = 0; j < 4; ++j) s += (v[j].x * v[j].x + v[j].y * v[j].y) + (v[j].z * v[j].z + v[j].w * v[j].w);
            const float inv = 1.0f / sqrtf(wave_sum(s) * (1.f / DM) + RMS_EPS);
#pragma unroll
            for (int j = 0; j < 4; ++j) { const f32x4 g = ((const GAS f32x4*)gain + F.lane)[64 * j]; v[j] = v[j] * inv * g; }
            if (H) {
                GAS unsigned long long* o8 = (GAS unsigned long long*)(H + (size_t)m * DM) + F.lane;
#pragma unroll
                for (int j = 0; j < 4; ++j) o8[64 * j] = (unsigned long long)pk2(v[j].x, v[j].y) | ((unsigned long long)pk2(v[j].z, v[j].w) << 32);
            }
            if (FLAGS & 2) {
                float part[16];
#pragma unroll
                for (int c = 0; c < 16; ++c) part[c] = 0.f;
#pragma unroll
                for (int j = 0; j < 4; ++j)
#pragma unroll
                    for (int q = 0; q < 4; ++q) { const int k = 4 * (F.lane + 64 * j) + q; const float hv = v[j][q];
                        const GAS f32x4* wr = (const GAS f32x4*)(Wf + (size_t)k * 3088 + 3072);
#pragma unroll
                        for (int c4 = 0; c4 < 4; ++c4) { const f32x4 w = wr[c4]; part[c4 * 4 + 0] += hv * w.x; part[c4 * 4 + 1] += hv * w.y; part[c4 * 4 + 2] += hv * w.z; part[c4 * 4 + 3] += hv * w.w; } }
                float mine = 0.f;
#pragma unroll
                for (int c = 0; c < 16; ++c) { const float t = wave_sum(part[c]); if (F.lane == c) mine = t; }
                if (F.lane < 16) { const float z = mine + bf[F.lane];
                    const float ls = fminf(z, 0.f) - log1pf(expf(-fabsf(z))); lgf[(size_t)m * 16 + F.lane] = ls * LOG2E; }
            }
            if (FLAGS & 4) {
                float part[8];
#pragma unroll
                for (int c = 0; c < 8; ++c) part[c] = 0.f;
#pragma unroll
                for (int j = 0; j < 4; ++j)
#pragma unroll
                    for (int q = 0; q < 4; ++q) { const int k = 4 * (F.lane + 64 * j) + q; const float hv = v[j][q];
                        const GAS f32x4* wr = (const GAS f32x4*)(Wr + (size_t)k * 8);
                        const f32x4 w0 = wr[0], w1 = wr[1];
                        part[0] += hv * w0.x; part[1] += hv * w0.y; part[2] += hv * w0.z; part[3] += hv * w0.w;
                        part[4] += hv * w1.x; part[5] += hv * w1.y; part[6] += hv * w1.z; part[7] += hv * w1.w; }
                float lg[8];
#pragma unroll
                for (int c = 0; c < 8; ++c) lg[c] = wave_sum(part[c]);
                int e0 = 0; float l0 = lg[0];
#pragma unroll
                for (int c = 1; c < 8; ++c) if (lg[c] > l0) { l0 = lg[c]; e0 = c; }
                int e1 = -1; float l1 = -INFINITY;
#pragma unroll
                for (int c = 0; c < 8; ++c) if (c != e0 && lg[c] > l1) { l1 = lg[c]; e1 = c; }
                const float g0 = 1.0f / (1.0f + expf(l1 - l0)), g1 = 1.0f - g0;
                if (F.lane == 0) { const int r = F.wave * 8 + i; sel[r * 2] = e0; sel[r * 2 + 1] = e1; sg[r * 2] = g0; sg[r * 2 + 1] = g1; }
            }
        }
        if (FLAGS & 4) {
            int* list = (int*)(F.ws + WS_MISC + MS_LIST) + (size_t)f * NE * LCAP;
            float* gw = (float*)(F.ws + WS_MISC + MS_GW) + (size_t)f * NE * LCAP;
            int* tok = (int*)(F.ws + WS_MISC + MS_TOK) + (size_t)f * M * 2;
            __syncthreads();
            if (F.tid == 0) {
                int lc[8];
#pragma unroll
                for (int e = 0; e < 8; ++e) lc[e] = 0;
                for (int q = 0; q < 128; ++q) { const int e = sel[q]; int p = 0;
#pragma unroll
                    for (int c = 0; c < 8; ++c) if (c == e) { p = lc[c]; lc[c] = p + 1; }
                    lpos[q] = p; }
#pragma unroll
                for (int e = 0; e < 8; ++e) gb[e] = (int)__hip_atomic_fetch_add(F.ctl + CW_CNT + f * 64 + e, (unsigned)lc[e], RLX_AGENT);
            }
            __syncthreads();
            if (F.tid < 128) { const int q = F.tid, row = chunk * 64 + (q >> 1), e = sel[q], pos = gb[e] + lpos[q];
                list[e * LCAP + pos] = row; gw[e * LCAP + pos] = sg[q]; tok[row * 2 + (q & 1)] = e * LCAP + pos; }
            __syncthreads();
        }
    }
}

__device__ __forceinline__ void final_combine(Frame& F, int f) {
    const float* Y = (const float*)(F.ws + WS_R2);
    const int* tok = (const int*)(F.ws + WS_MISC + MS_TOK) + (size_t)f * M * 2;
    int tb[NE + 1]; moe_bases(F, f, tb);
    for (int m = blockIdx.x * NWAVES + F.wave; m < M; m += F.G * NWAVES) {
        const int s0 = tok[m * 2], s1 = tok[m * 2 + 1]; int r0 = 0, r1 = 0;
#pragma unroll
        for (int e = 0; e < NE; ++e) { if ((s0 >> 14) == e) r0 = tb[e] * 256 + (s0 & 16383); if ((s1 >> 14) == e) r1 = tb[e] * 256 + (s1 & 16383); }
        GAS f32x4* xr = (GAS f32x4*)(F.out + (size_t)m * DM) + F.lane;
        const GAS f32x4* y0 = (const GAS f32x4*)(Y + (size_t)r0 * DM) + F.lane;
        const GAS f32x4* y1 = (const GAS f32x4*)(Y + (size_t)r1 * DM) + F.lane;
#pragma unroll
        for (int j = 0; j < 4; ++j) xr[64 * j] = xr[64 * j] + y0[64 * j] + y1[64 * j];
    }
}

__device__ __forceinline__ void cumsum_phase(Frame& F) {
    const float* logf = (const float*)(F.ws + WS_MISC + MS_LOGF);
    float* cum = (float*)(F.ws + WS_MISC + MS_CUM);
    const int gw = blockIdx.x * NWAVES + F.wave;
    if (gw < BATCH * NH) {
        const int b = gw >> 4, h = gw & 15;
        float v[32]; float s = 0.f;
#pragma unroll
        for (int i = 0; i < 32; ++i) { v[i] = logf[((size_t)b * SEQ + F.lane * 32 + i) * 16 + h]; s += v[i]; }
        float incl = s;
#pragma unroll
        for (int o = 1; o < 64; o <<= 1) { const float t = __shfl_up(incl, o); if (F.lane >= o) incl += t; }
        float run = incl - s;
#pragma unroll
        for (int i = 0; i < 32; ++i) { run += v[i]; cum[((size_t)b * SEQ + F.lane * 32 + i) * 16 + h] = run; }
    }
}

enum { EPI_PLANES = 0, EPI_RESID = 1, EPI_SWIGLU = 2, EPI_MOEDOWN = 3 };
struct SgP { const bf16* A; int lda; const int* rowidx; int Mrows; const float* W0; const float* W1; int ldw; int K; int N;
             bf16* outb; int ldo; float scale0; const float* base; float* outf; const float* gwv; };
template <int EPI>
__device__ __forceinline__ void sgemm(Frame& F, const SgP& p) {
    LAS float* As = (LAS float*)F.lds;
    LAS float* Bs0 = As + 16 * 132;
    LAS float* Bs1 = Bs0 + 16 * 128;
    const int tid = F.tid, ty = tid >> 4, tx = tid & 15;
    const int lrow = tid >> 2, lkq = (tid & 3) * 4;
    const int bk = tid >> 5, bn = (tid & 31) * 4;
    const int ntn = p.N / 128, ntiles = (p.Mrows / 128) * ntn;
    for (int tile = blockIdx.x; tile < ntiles; tile += F.G) {
        const int tm = tile / ntn, tn = tile % ntn;
        const int arow = p.rowidx ? p.rowidx[tm * 128 + lrow] : tm * 128 + lrow;
        const bf16* ap = p.A + (size_t)arow * p.lda + lkq;
        const float* bp0 = p.W0 + (size_t)bk * p.ldw + tn * 128 + bn;
        const float* bp1 = (EPI == EPI_SWIGLU) ? p.W1 + (size_t)bk * p.ldw + tn * 128 + bn : nullptr;
        f32x2 acc0[4][4], acc1[4][4];
#pragma unroll
        for (int i = 0; i < 4; ++i)
#pragma unroll
            for (int j = 0; j < 4; ++j) { acc0[i][j] = (f32x2){0.f, 0.f}; acc1[i][j] = (f32x2){0.f, 0.f}; }
        for (int k0 = 0; k0 < p.K; k0 += 16) {
            const v2u av = *(const GAS v2u*)(ap + k0);
            const f32x4 b0 = *(const GAS f32x4*)(bp0 + (size_t)k0 * p.ldw);
            f32x4 b1 = (f32x4){0.f, 0.f, 0.f, 0.f};
            if (EPI == EPI_SWIGLU) b1 = *(const GAS f32x4*)(bp1 + (size_t)k0 * p.ldw);
            __syncthreads();
            As[(lkq + 0) * 132 + lrow] = bflo(av.x); As[(lkq + 1) * 132 + lrow] = bfhi(av.x);
            As[(lkq + 2) * 132 + lrow] = bflo(av.y); As[(lkq + 3) * 132 + lrow] = bfhi(av.y);
            *(LAS f32x4*)(Bs0 + bk * 128 + bn) = b0;
            if (EPI == EPI_SWIGLU) *(LAS f32x4*)(Bs1 + bk * 128 + bn) = b1;
            __syncthreads();
#pragma unroll 2
            for (int k = 0; k < 16; ++k) {
                const f32x4 a = *(const LAS f32x4*)(As + k * 132 + ty * 4);
                const f32x4 bA = *(const LAS f32x4*)(Bs0 + k * 128 + tx * 8), bB = *(const LAS f32x4*)(Bs0 + k * 128 + tx * 8 + 4);
                const f32x2 bv[4] = {(f32x2){bA.x, bA.y}, (f32x2){bA.z, bA.w}, (f32x2){bB.x, bB.y}, (f32x2){bB.z, bB.w}};
#pragma unroll
                for (int i = 0; i < 4; ++i) {
#pragma unroll
                    for (int j = 0; j < 4; ++j) acc0[i][j] += a[i] * bv[j]; }
                if (EPI == EPI_SWIGLU) {
                    const f32x4 cA = *(const LAS f32x4*)(Bs1 + k * 128 + tx * 8), cB = *(const LAS f32x4*)(Bs1 + k * 128 + tx * 8 + 4);
                    const f32x2 cv[4] = {(f32x2){cA.x, cA.y}, (f32x2){cA.z, cA.w}, (f32x2){cB.x, cB.y}, (f32x2){cB.z, cB.w}};
#pragma unroll
                    for (int i = 0; i < 4; ++i) {
#pragma unroll
                        for (int j = 0; j < 4; ++j) acc1[i][j] += a[i] * cv[j]; }
                }
                __builtin_amdgcn_sched_barrier(0);
            }
        }
        const int c0 = tn * 128 + tx * 8;
#pragma unroll
        for (int i = 0; i < 4; ++i) {
            const int r = tm * 128 + ty * 4 + i;
            if (EPI == EPI_PLANES) {
                const int pl = c0 >> 10, cc = c0 & 1023; const float sc = (pl == 0) ? p.scale0 : 1.f;
                v4u w; w.x = pk2(acc0[i][0].x * sc, acc0[i][0].y * sc); w.y = pk2(acc0[i][1].x * sc, acc0[i][1].y * sc); w.z = pk2(acc0[i][2].x * sc, acc0[i][2].y * sc); w.w = pk2(acc0[i][3].x * sc, acc0[i][3].y * sc);
                *(GAS v4u*)(p.outb + (size_t)pl * PLANE + (size_t)r * DM + cc) = w;
            } else if (EPI == EPI_RESID) {
                const GAS f32x4* bp = (const GAS f32x4*)(p.base + (size_t)r * DM + c0); GAS f32x4* op = (GAS f32x4*)(p.outf + (size_t)r * DM + c0);
                const f32x4 x0 = bp[0], x1 = bp[1];
                op[0] = x0 + (f32x4){acc0[i][0].x, acc0[i][0].y, acc0[i][1].x, acc0[i][1].y}; op[1] = x1 + (f32x4){acc0[i][2].x, acc0[i][2].y, acc0[i][3].x, acc0[i][3].y};
            } else if (EPI == EPI_SWIGLU) {
                float o[8];
#pragma unroll
                for (int j = 0; j < 8; ++j) { const float g = acc0[i][j >> 1][j & 1], uu = acc1[i][j >> 1][j & 1]; o[j] = g / (1.0f + __expf(-g)) * uu; }
                v4u w; w.x = pk2(o[0], o[1]); w.y = pk2(o[2], o[3]); w.z = pk2(o[4], o[5]); w.w = pk2(o[6], o[7]);
                *(GAS v4u*)(p.outb + (size_t)r * p.ldo + c0) = w;
            } else {
                const float g = p.gwv[r]; GAS f32x4* op = (GAS f32x4*)(p.outf + (size_t)r * DM + c0);
                op[0] = (f32x4){acc0[i][0].x * g, acc0[i][0].y * g, acc0[i][1].x * g, acc0[i][1].y * g}; op[1] = (f32x4){acc0[i][2].x * g, acc0[i][2].y * g, acc0[i][3].x * g, acc0[i][3].y * g};
            }
        }
    }
}

__device__ __forceinline__ void qknorm_plane(Frame& F, bf16* plane, const float* gain, float mul) {
    const int nth = F.G * NTHR;
    for (int idx = blockIdx.x * NTHR + F.tid; idx < M * NH; idx += nth) {
        GAS v4u* p = (GAS v4u*)(plane + (size_t)idx * 64);
        v4u w[8]; float ss = 0.f;
#pragma unroll
        for (int c = 0; c < 8; ++c) { w[c] = p[c];
#pragma unroll
            for (int q = 0; q < 4; ++q) { const float a = bflo(w[c][q]), b = bfhi(w[c][q]); ss += a * a + b * b; } }
        const float inv = 1.0f / sqrtf(ss * (1.f / 64.f) + RMS_EPS) * mul;
#pragma unroll
        for (int c = 0; c < 8; ++c) { v4u o;
#pragma unroll
            for (int q = 0; q < 4; ++q) { const float a = bflo(w[c][q]) * inv * gain[c * 8 + 2 * q], b = bfhi(w[c][q]) * inv * gain[c * 8 + 2 * q + 1]; o[q] = pk2(a, b); }
            p[c] = o; }
    }
}

template <int MODE>
__device__ __forceinline__ void attn_simple_causal(Frame& F, const bf16* Qp, const bf16* Kp, const bf16* Vp, bf16* O, const float* cum) {
    LAS float* Ks = (LAS float*)F.lds;
    LAS float* Vs = Ks + 4096;
    LAS float* kb = Vs + 4096;
    for (int u = blockIdx.x; u < BATCH * NH * 4; u += F.G) {
        const int qblk = (u & 1) ? 3 - ((u >> 1) & 1) : ((u >> 1) & 1) * 1;
        const int bh = u >> 2, b = bh >> 4, h = bh & 15;
        const int t = qblk * 512 + F.tid;
        const size_t rowbase = (size_t)b * SEQ;
        float q[64], acc[64];
        { const GAS v4u* qp = (const GAS v4u*)(Qp + (rowbase + t) * DM + h * 64);
#pragma unroll
          for (int c = 0; c < 8; ++c) { const v4u w = qp[c];
#pragma unroll
              for (int k = 0; k < 4; ++k) { q[c * 8 + 2 * k] = bflo(w[k]); q[c * 8 + 2 * k + 1] = bfhi(w[k]); } } }
#pragma unroll
        for (int d = 0; d < 64; ++d) acc[d] = 0.f;
        float P = 1.f, mrun = -INFINITY, lrun = 0.f;
        const int ntile = 8 * (qblk + 1);
        for (int it = 0; it < ntile; ++it) {
            const int tile = (MODE == 0) ? ntile - 1 - it : it;
            __syncthreads();
            { const int key = F.tid >> 3, ch = F.tid & 7;
              const v4u kw = *(const GAS v4u*)(Kp + (rowbase + tile * 64 + key) * DM + h * 64 + ch * 8);
              const v4u vw = *(const GAS v4u*)(Vp + (rowbase + tile * 64 + key) * DM + h * 64 + ch * 8);
#pragma unroll
              for (int k = 0; k < 4; ++k) { Ks[key * 64 + ch * 8 + 2 * k] = bflo(kw[k]); Ks[key * 64 + ch * 8 + 2 * k + 1] = bfhi(kw[k]);
                                            Vs[key * 64 + ch * 8 + 2 * k] = bflo(vw[k]); Vs[key * 64 + ch * 8 + 2 * k + 1] = bfhi(vw[k]); }
              if (MODE == 2 && F.tid < 64) kb[F.tid] = -cum[(rowbase + tile * 64 + F.tid) * 16 + h]; }
            __syncthreads();
            for (int jj = 0; jj < 64; ++jj) {
                const int j = (MODE == 0) ? 63 - jj : jj; const int s = tile * 64 + j;
                float z = 0.f;
#pragma unroll
                for (int d4 = 0; d4 < 16; ++d4) { const f32x4 kv = *(const LAS f32x4*)(Ks + j * 64 + d4 * 4); z += q[d4 * 4] * kv.x + q[d4 * 4 + 1] * kv.y + q[d4 * 4 + 2] * kv.z + q[d4 * 4 + 3] * kv.w; }
                if (MODE == 0) {
                    const bool valid = s < t;
                    const float e = __builtin_amdgcn_exp2f(fminf(z, 100.f));
                    float r = 1.0f / (1.0f + e); float beta = 1.0f - r;
                    if (!valid) { r = 1.f; beta = 0.f; }
                    const float w = beta * P; P *= r;
#pragma unroll
                    for (int d4 = 0; d4 < 16; ++d4) { const f32x4 vv = *(const LAS f32x4*)(Vs + j * 64 + d4 * 4); acc[d4 * 4] += w * vv.x; acc[d4 * 4 + 1] += w * vv.y; acc[d4 * 4 + 2] += w * vv.z; acc[d4 * 4 + 3] += w * vv.w; }
                } else {
                    const bool valid = s <= t;
                    const float x = valid ? z + kb[j] : -INFINITY;
                    const float mn = fmaxf(mrun, x);
                    const float a = __builtin_amdgcn_exp2f(mrun - mn), pw = __builtin_amdgcn_exp2f(x - mn);
                    lrun = lrun * a + pw; mrun = mn;
#pragma unroll
                    for (int d4 = 0; d4 < 16; ++d4) { const f32x4 vv = *(const LAS f32x4*)(Vs + j * 64 + d4 * 4);
                        acc[d4 * 4] = acc[d4 * 4] * a + pw * vv.x; acc[d4 * 4 + 1] = acc[d4 * 4 + 1] * a + pw * vv.y; acc[d4 * 4 + 2] = acc[d4 * 4 + 2] * a + pw * vv.z; acc[d4 * 4 + 3] = acc[d4 * 4 + 3] * a + pw * vv.w; }
                }
            }
        }
        const float fin = (MODE == 0) ? 1.f : 1.0f / lrun;
        GAS v4u* op = (GAS v4u*)(O + (rowbase + t) * DM + h * 64);
#pragma unroll
        for (int c = 0; c < 8; ++c) { v4u w;
#pragma unroll
            for (int k = 0; k < 4; ++k) w[k] = pk2(acc[c * 8 + 2 * k] * fin, acc[c * 8 + 2 * k + 1] * fin);
            op[c] = w; }
    }
}

__device__ __forceinline__ int t5_bucket(int dist) {
    if (dist < 16) return dist;
    const float d = (float)dist;
    int lb = 16 + (int)(logf(d / 16.0f) / logf(128.0f) * 16.0f);
    return lb < 31 ? lb : 31;
}
__device__ __forceinline__ void attn_simple_dil(Frame& F, const bf16* PROJ, bf16* O, const float* rel_bias) {
    LAS float* tbl = (LAS float*)F.lds;
    for (int u = blockIdx.x; u < BATCH * NH * 4; u += F.G) {
        const int qblk = u & 3, bh = u >> 2, b = bh >> 4, h = bh & 15;
        const int t = qblk * 512 + F.tid;
        const size_t rowbase = (size_t)b * SEQ;
        __syncthreads();
        for (int i = F.tid; i < 3 * 129; i += NTHR) { const int g = i / 129, dl = i % 129, dil = (g == 0) ? 1 : (g == 1) ? 4 : 16;
            tbl[g * 132 + dl] = rel_bias[t5_bucket(dl * dil) * 16 + h] * LOG2E; }
        __syncthreads();
        float acc[64];
#pragma unroll
        for (int d = 0; d < 64; ++d) acc[d] = 0.f;
        float mrun = -INFINITY, lrun = 0.f;
        for (int g = 0; g < 3; ++g) {
            const int dil = (g == 0) ? 1 : (g == 1) ? 4 : 16;
            const bf16* Qg = PROJ + (size_t)(2 * g) * PLANE; const bf16* Kg = PROJ + (size_t)(2 * g + 1) * PLANE; const bf16* Vg = PROJ + (size_t)6 * PLANE;
            float q[64];
            { const GAS v4u* qp = (const GAS v4u*)(Qg + (rowbase + t) * DM + h * 64);
#pragma unroll
              for (int c = 0; c < 8; ++c) { const v4u w = qp[c];
#pragma unroll
                  for (int k = 0; k < 4; ++k) { q[c * 8 + 2 * k] = bflo(w[k]); q[c * 8 + 2 * k + 1] = bfhi(w[k]); } } }
            for (int dl = 0; dl <= 128; ++dl) {
                const int s = t - dl * dil; const bool valid = s >= 0; const int sc = valid ? s : 0;
                const GAS v4u* kp = (const GAS v4u*)(Kg + (rowbase + sc) * DM + h * 64);
                float z = 0.f;
#pragma unroll
                for (int c = 0; c < 8; ++c) { const v4u w = kp[c];
#pragma unroll
                    for (int k = 0; k < 4; ++k) z += q[c * 8 + 2 * k] * bflo(w[k]) + q[c * 8 + 2 * k + 1] * bfhi(w[k]); }
                const float x = valid ? z + tbl[g * 132 + dl] : -INFINITY;
                const float mn = fmaxf(mrun, x);
                const float a = __builtin_amdgcn_exp2f(mrun - mn), pw = __builtin_amdgcn_exp2f(x - mn);
                lrun = lrun * a + pw; mrun = mn;
                const GAS v4u* vp = (const GAS v4u*)(Vg + (rowbase + sc) * DM + h * 64);
#pragma unroll
                for (int c = 0; c < 8; ++c) { const v4u w = vp[c];
#pragma unroll
                    for (int k = 0; k < 4; ++k) { acc[c * 8 + 2 * k] = acc[c * 8 + 2 * k] * a + pw * bflo(w[k]); acc[c * 8 + 2 * k + 1] = acc[c * 8 + 2 * k + 1] * a + pw * bfhi(w[k]); } }
            }
        }
        const float fin = 1.0f / lrun;
        GAS v4u* op = (GAS v4u*)(O + (rowbase + t) * DM + h * 64);
#pragma unroll
        for (int c = 0; c < 8; ++c) { v4u w;
#pragma unroll
            for (int k = 0; k < 4; ++k) w[k] = pk2(acc[c * 8 + 2 * k] * fin, acc[c * 8 + 2 * k + 1] * fin);
            op[c] = w; }
    }
}

__device__ __forceinline__ void moe_gu_simple(Frame& F, int f, const bf16* H, bf16* ACT) {
    const int* list = (const int*)(F.ws + WS_MISC + MS_LIST) + (size_t)f * NE * LCAP;
    int base = 0;
    for (int e = 0; e < NE; ++e) {
        const int c = (int)__hip_atomic_load(F.ctl + CW_CNT + f * 64 + e, RLX_AGENT); const int nt = (c + 255) >> 8;
        if (nt) {
            SgP p{}; p.A = H; p.lda = DM; p.rowidx = list + e * LCAP; p.Mrows = nt * 256;
            p.W0 = INP(19) + ((size_t)f * NE + e) * DM * FF; p.W1 = INP(20) + ((size_t)f * NE + e) * DM * FF; p.ldw = FF; p.K = DM; p.N = FF;
            p.outb = ACT + (size_t)base * 256 * FF; p.ldo = FF;
            sgemm<EPI_SWIGLU>(F, p);
        }
        base += nt;
    }
}
__device__ __forceinline__ void moe_down_simple(Frame& F, int f, const bf16* ACT, float* Y) {
    const float* gw = (const float*)(F.ws + WS_MISC + MS_GW) + (size_t)f * NE * LCAP;
    int base = 0;
    for (int e = 0; e < NE; ++e) {
        const int c = (int)__hip_atomic_load(F.ctl + CW_CNT + f * 64 + e, RLX_AGENT); const int nt = (c + 255) >> 8;
        if (nt) {
            SgP p{}; p.A = ACT + (size_t)base * 256 * FF; p.lda = FF; p.rowidx = nullptr; p.Mrows = nt * 256;
            p.W0 = INP(21) + ((size_t)f * NE + e) * FF * DM; p.ldw = DM; p.K = FF; p.N = DM;
            p.outf = Y + (size_t)base * 256 * DM; p.gwv = gw + e * LCAP;
            sgemm<EPI_MOEDOWN>(F, p);
        }
        base += nt;
    }
}


template <class Epi>
__device__ __forceinline__ void dense_gemm(Frame& F, const bf16* A, const bf16* Bt, int N, int K, const Epi& E) {
    pg8::DenseOrder S; S.init(A, Bt, M, N, K, F.G, (int)blockIdx.x);
    pg8::gemm_phase<Epi, pg8::DenseOrder, false>(F.lds, K, S, E);
}
__device__ __forceinline__ void moe_order_init(Frame& F, int f, pg8::MoeOrder& S) {
    int acc = 0, t[NE];
#pragma unroll
    for (int e = 0; e < NE; ++e) { const int c = (int)__hip_atomic_load(F.ctl + CW_CNT + f * 64 + e, RLX_AGENT); acc += (c + 255) >> 8; t[e] = acc; }
    S.t1 = t[0]; S.t2 = t[1]; S.t3 = t[2]; S.t4 = t[3]; S.t5 = t[4]; S.t6 = t[5]; S.t7 = t[6]; S.t8 = t[7];
    S.G = F.G; S.c = (int)blockIdx.x;
}
__device__ __forceinline__ void moe_gu_fast(Frame& F, int f, const bf16* H, bf16* ACT) {
    pg8::MoeOrder S; moe_order_init(F, f, S);
    S.nN = 2 * FF / 256; S.K = DM; S.A = (const char*)H; S.Bt = (const char*)((const bf16*)(F.ws + WS_W) + WE_MGU + (size_t)f * NE * 2 * FF * DM);
    S.tstepA = (size_t)256 * DM * 2; S.tstepB = (size_t)256 * DM * 2; S.estepB = (size_t)2 * FF * DM * 2;
    S.list = (const int*)(F.ws + WS_MISC + MS_LIST) + (size_t)f * NE * LCAP; S.gather = true;
    pg8::EpiSwiglu E{ACT};
    pg8::gemm_phase<pg8::EpiSwiglu, pg8::MoeOrder, true>(F.lds, DM, S, E);
}
__device__ __forceinline__ void moe_down_fast(Frame& F, int f, const bf16* ACT, float* Y) {
    pg8::MoeOrder S; moe_order_init(F, f, S);
    S.nN = DM / 256; S.K = FF; S.A = (const char*)ACT; S.Bt = (const char*)((const bf16*)(F.ws + WS_W) + WE_MD + (size_t)f * NE * DM * FF);
    S.tstepA = (size_t)256 * FF * 2; S.tstepB = (size_t)256 * FF * 2; S.estepB = (size_t)DM * FF * 2;
    S.list = nullptr; S.gather = false;
    pg8::EpiMoeDown E{Y, (const float*)(F.ws + WS_MISC + MS_GW) + (size_t)f * NE * LCAP};
    pg8::gemm_phase<pg8::EpiMoeDown, pg8::MoeOrder, false>(F.lds, FF, S, E);
}

struct Args { const float* in[22]; float* out; unsigned char* ws; int ph_lo, ph_hi; };
constexpr int N_PHASES = 32;

__global__ void __launch_bounds__(NTHR, 2) trunk_fwd(Args args) {
    extern __shared__ __attribute__((aligned(16))) unsigned char lds[];
    Frame F;
    F.lds = (LAS unsigned char*)lds;
    F.tid = threadIdx.x; F.lane = F.tid & 63; F.wave = __builtin_amdgcn_readfirstlane(F.tid >> 6); F.G = gridDim.x;
    F.ws = args.ws; F.ctl = (gu32*)(args.ws + WS_CTL); F.out = args.out;
    if (F.tid == 0) {
#pragma unroll
        for (int i = 0; i < 22; ++i) ((LAS unsigned long long*)(F.lds + PTR_OFF))[i] = (unsigned long long)args.in[i];
    }
    volatile LAS unsigned* MISC = (volatile LAS unsigned*)(F.lds + MISC_OFF);
    if (F.tid < 32) MISC[F.tid] = 0u;
    __syncthreads();
    XcdBarrier bar; bar.bar = (unsigned*)(F.ctl + CW_BAR); bar.x = 0; bar.st = nullptr;
    const int lo = args.ph_lo, hi = args.ph_hi;
    if (hi - lo > 1) bar = xcd_barrier_post((unsigned*)(F.ctl + CW_BAR), MISC + 8);
#ifndef PHSEL
#define PHSEL 0xFFFFFFFFull
#endif
#define IN(k) (lo <= (k) && (k) < hi && ((PHSEL >> (k)) & 1ull) && relaunder(F))
#define SEAM(k) do { if (IN((k) + 1) && IN(k)) xcd_barrier(bar); } while (0)

    bf16* H = (bf16*)(F.ws + WS_H);
    bf16* PROJ = (bf16*)(F.ws + WS_R1);
    bf16* ACT = (bf16*)(F.ws + WS_R1);
    bf16* O = (bf16*)(F.ws + WS_R2);
    float* Y = (float*)(F.ws + WS_R2);
    float* X = F.out;
    const float* cum = (const float*)(F.ws + WS_MISC + MS_CUM);

    const bf16* WB = (const bf16*)(F.ws + WS_W);
    if (IN(0)) {
        unsigned* z = (unsigned*)(F.ws + WS_MISC + MS_LIST);
        for (int i = blockIdx.x * NTHR + F.tid; i < (int)(2 * MiB / 4); i += F.G * NTHR) z[i] = 0u;
        convert_weights(F);
        SEAM(0);
    }
    if (IN(1)) { norm_phase<0>(F, INP(0), nullptr, INP(13) + 0 * DM, H, 0, 0, nullptr, nullptr, nullptr); SEAM(1); }
    if (IN(2)) { pg8::EpiPlanes E{PROJ, C2}; dense_gemm(F, H, WB + WE_QKV, 3 * DM, DM, E); SEAM(2); }
    if (IN(3)) { att::causal_phase<0>((att::lptr)F.lds, F.G, PROJ, PROJ + PLANE, PROJ + 2 * PLANE, O, nullptr); SEAM(3); }
    if (IN(4)) { pg8::EpiResid E{INP(0), X}; dense_gemm(F, O, WB + WE_WO_SB, DM, DM, E); SEAM(4); }
    if (IN(5)) { norm_phase<0>(F, X, nullptr, INP(14) + 0 * DM, H, 0, 0, nullptr, nullptr, nullptr); SEAM(5); }
    if (IN(6)) { pg8::EpiSwiglu E{ACT}; dense_gemm(F, H, WB + WE_GU, 2 * FF, DM, E); SEAM(6); }
    if (IN(7)) { pg8::EpiResid E{X, X}; dense_gemm(F, ACT, WB + WE_D, DM, FF, E); SEAM(7); }
    if (IN(8)) { norm_phase<0>(F, X, nullptr, INP(13) + 1 * DM, H, 0, 0, nullptr, nullptr, nullptr); SEAM(8); }
    if (IN(9)) { pg8::EpiQKNorm E{PROJ, INP(4), INP(5), 6}; dense_gemm(F, H, WB + WE_IN_DIL, 7 * DM, DM, E); SEAM(9); }
    if (IN(11)) { attn_simple_dil(F, PROJ, O, INP(12)); SEAM(11); }
    if (IN(12)) { pg8::EpiResid E{X, X}; dense_gemm(F, O, WB + WE_WO_DIL, DM, DM, E); SEAM(12); }
    if (IN(13)) { norm_phase<4>(F, X, nullptr, INP(14) + 1 * DM, H, 0, 0, nullptr, nullptr, INP(18) + 0 * DM * NE); SEAM(13); }
    if (IN(14)) { moe_gu_fast(F, 0, H, ACT); SEAM(14); }
    if (IN(15)) { moe_down_fast(F, 0, ACT, Y); SEAM(15); }
    if (IN(16)) { norm_phase<1 | 2>(F, X, X, INP(13) + 2 * DM, H, 0, 0, INP(7), INP(8), nullptr); SEAM(16); }
    if (IN(17)) { cumsum_phase(F); pg8::EpiQKNorm E{PROJ, INP(9), INP(10), 2}; dense_gemm(F, H, WB + WE_IN_FOX, 3 * DM, DM, E); SEAM(17); }
    if (IN(19)) { att::causal_phase<2>((att::lptr)F.lds, F.G, PROJ, PROJ + PLANE, PROJ + 2 * PLANE, O, cum); SEAM(19); }
    if (IN(20)) { pg8::EpiResid E{X, X}; dense_gemm(F, O, WB + WE_WO_FOX, DM, DM, E); SEAM(20); }
    if (IN(21)) { norm_phase<0>(F, X, nullptr, INP(14) + 2 * DM, H, 0, 0, nullptr, nullptr, nullptr); SEAM(21); }
    if (IN(22)) { pg8::EpiSwiglu E{ACT}; dense_gemm(F, H, WB + WE_GU + (size_t)2 * FF * DM, 2 * FF, DM, E); SEAM(22); }
    if (IN(23)) { pg8::EpiResid E{X, X}; dense_gemm(F, ACT, WB + WE_D + (size_t)DM * FF, DM, FF, E); SEAM(23); }
    if (IN(24)) { norm_phase<0>(F, X, nullptr, INP(13) + 3 * DM, H, 0, 0, nullptr, nullptr, nullptr); SEAM(24); }
    if (IN(25)) { pg8::EpiPlanes E{PROJ, C2}; dense_gemm(F, H, WB + WE_QKV + (size_t)3 * DM * DM, 3 * DM, DM, E); SEAM(25); }
    if (IN(26)) { att::causal_phase<0>((att::lptr)F.lds, F.G, PROJ, PROJ + PLANE, PROJ + 2 * PLANE, O, nullptr); SEAM(26); }
    if (IN(27)) { pg8::EpiResid E{X, X}; dense_gemm(F, O, WB + WE_WO_SB + (size_t)DM * DM, DM, DM, E); SEAM(27); }
    if (IN(28)) { norm_phase<4>(F, X, nullptr, INP(14) + 3 * DM, H, 0, 1, nullptr, nullptr, INP(18) + 1 * DM * NE); SEAM(28); }
    if (IN(29)) { moe_gu_fast(F, 1, H, ACT); SEAM(29); }
    if (IN(30)) { moe_down_fast(F, 1, ACT, Y); SEAM(30); }
    if (IN(31)) { final_combine(F, 1); }
#undef IN
#undef SEAM
}

extern "C" void kernel_launch(void* const* d_in, const int* in_sizes, int n_in, void* d_out, int out_size, void* d_ws, size_t ws_size, hipStream_t stream) {
    static int grid = 0;
    if (grid == 0) {
        if (n_in != 22 || out_size != M * DM || ws_size < WS_END) { fprintf(stderr, "kernel_launch: unexpected shapes (n_in %d out %d ws %zu)\n", n_in, out_size, ws_size); grid = -1; return; }
        int dev = 0, cus = 0, per_cu = 0;
        if (hipGetDevice(&dev) != hipSuccess || hipDeviceGetAttribute(&cus, hipDeviceAttributeMultiprocessorCount, dev) != hipSuccess) { grid = -1; return; }
        if (hipFuncSetAttribute((const void*)trunk_fwd, hipFuncAttributeMaxDynamicSharedMemorySize, LDS_BYTES) != hipSuccess) { fprintf(stderr, "kernel_launch: hipFuncSetAttribute failed\n"); grid = -1; return; }
        if (hipOccupancyMaxActiveBlocksPerMultiprocessor(&per_cu, (const void*)trunk_fwd, NTHR, LDS_BYTES) != hipSuccess || per_cu < 1) fprintf(stderr, "kernel_launch: occupancy query says %d\n", per_cu);
        (void)hipGetLastError();
        grid = cus;
    }
    if (grid < 0) return;
    (void)hipMemsetAsync((char*)d_ws + WS_CTL, 0, CTL_ZERO_BYTES, stream);
    Args a{};
    for (int i = 0; i < 22; ++i) a.in[i] = (const float*)d_in[i];
    a.out = (float*)d_out; a.ws = (unsigned char*)d_ws;
#if MK_MULTI
    for (int p = 0; p < N_PHASES; ++p) { a.ph_lo = p; a.ph_hi = p + 1; hipLaunchKernelGGL(trunk_fwd, dim3(grid), dim3(NTHR), LDS_BYTES, stream, a); }
#else
    a.ph_lo = 0; a.ph_hi = N_PHASES;
    hipLaunchKernelGGL(trunk_fwd, dim3(grid), dim3(NTHR), LDS_BYTES, stream, a);
#endif
}
```

```cpp
#include <hip/hip_runtime.h>
#include <cstdio>
#include <cstdint>

#ifndef MK_MULTI
#define MK_MULTI 0
#endif

constexpr int BATCH = 8, SEQ = 2048, DM = 1024, NH = 16, HD = 64, FF = 3584, NE = 8;
constexpr int M = BATCH * SEQ;
constexpr float RMS_EPS = 1e-6f;
constexpr float LOG2E = 1.4426950408889634f;
constexpr float C2 = 0.125f * LOG2E;
constexpr int NWAVES = 8, NTHR = 512;
constexpr int LCAP = 16384;
constexpr int MAXROWS = 34816;

constexpr size_t MiB = 1u << 20;
constexpr size_t WS_CTL = 0, CTL_ZERO_BYTES = 1 * MiB;
constexpr size_t WS_MISC = 1 * MiB;
constexpr size_t WS_H = 6 * MiB;
constexpr size_t WS_R1 = 38 * MiB;
constexpr size_t WS_R2 = 278 * MiB;
constexpr size_t WS_W = 414 * MiB;
constexpr size_t WS_END = 832 * MiB;
constexpr size_t PLANE = (size_t)M * DM;
constexpr size_t WE_QKV = 0;
constexpr size_t WE_WO_SB = WE_QKV + 2ull * 3072 * 1024;
constexpr size_t WE_WO_DIL = WE_WO_SB + 2ull * 1024 * 1024;
constexpr size_t WE_WO_FOX = WE_WO_DIL + 1024ull * 1024;
constexpr size_t WE_IN_DIL = WE_WO_FOX + 1024ull * 1024;
constexpr size_t WE_IN_FOX = WE_IN_DIL + 7168ull * 1024;
constexpr size_t WE_GU = WE_IN_FOX + 3072ull * 1024;
constexpr size_t WE_D = WE_GU + 2ull * 7168 * 1024;
constexpr size_t WE_MGU = WE_D + 2ull * 1024 * 3584;
constexpr size_t WE_MD = WE_MGU + 16ull * 7168 * 1024;
constexpr size_t WE_END = WE_MD + 16ull * 1024 * 3584;
static_assert(WS_W + WE_END * 2 <= WS_END, "weight copies fit");
constexpr size_t MS_LIST = 0;
constexpr size_t MS_GW = 1 * MiB;
constexpr size_t MS_TOK = 2 * MiB;
constexpr size_t MS_LOGF = 2 * MiB + 256 * 1024;
constexpr size_t MS_CUM = 3 * MiB + 256 * 1024;
constexpr int CW_BAR = 4096;
constexpr int CW_CNT = 64;

#define GAS __attribute__((address_space(1)))
#define LAS __attribute__((address_space(3)))
typedef unsigned short bf16;
typedef unsigned v4u __attribute__((ext_vector_type(4)));
typedef unsigned v2u __attribute__((ext_vector_type(2)));
typedef float f32x4 __attribute__((ext_vector_type(4)));
typedef float f32x2 __attribute__((ext_vector_type(2)));
typedef GAS unsigned gu32;
#define RLX_AGENT __ATOMIC_RELAXED, __HIP_MEMORY_SCOPE_AGENT
__device__ __forceinline__ unsigned f2bf(float f) { unsigned u = __builtin_bit_cast(unsigned, f); return (u + 0x7fffu + ((u >> 16) & 1u)) >> 16; }
__device__ __forceinline__ unsigned pk2(float lo, float hi) { return f2bf(lo) | (f2bf(hi) << 16); }
__device__ __forceinline__ float bflo(unsigned u) { return __builtin_bit_cast(float, u << 16); }
__device__ __forceinline__ float bfhi(unsigned u) { return __builtin_bit_cast(float, u & 0xffff0000u); }

#define XB_TMO      128
#define XB_XCNT(j)  (256  + 64 * (j))
#define XB_XSUB(j)  (1280 + 64 * (j))
#define XB_XGEN(j)  (2304 + 64 * (j))
#define XB_TOP      3328
#define XB_TOPGEN   3392
#define XCD_BAR_WORDS 3456
#define XB_SPIN_CAP (1u << 22)
__device__ __forceinline__ unsigned xb_ld(unsigned* p)              { return __hip_atomic_load(p, __ATOMIC_RELAXED, __HIP_MEMORY_SCOPE_AGENT); }
__device__ __forceinline__ unsigned xb_add(unsigned* p, unsigned v) { return __hip_atomic_fetch_add(p, v, __ATOMIC_RELAXED, __HIP_MEMORY_SCOPE_AGENT); }
__device__ __forceinline__ unsigned xb_xcc_id() { return (unsigned)__builtin_amdgcn_s_getreg((3 << 11) | 20) & 0xFu; }
#define XB_SPIN(cond, bar) do { unsigned _sp = 0; while (cond) { __builtin_amdgcn_s_sleep(1); \
    if ((++_sp & 255u) == 0u) { if (xb_ld(&(bar)[XB_TMO])) break; if (_sp > XB_SPIN_CAP) { atomicAdd(&(bar)[XB_TMO], 1u); break; } } } } while (0)
struct XcdBarrier { unsigned* bar; unsigned x; volatile LAS unsigned* st; };
__device__ __forceinline__ XcdBarrier xcd_barrier_post(unsigned* bar, volatile LAS unsigned* st) {
    XcdBarrier b; b.bar = bar; b.x = xb_xcc_id(); b.st = st;
    if (threadIdx.x == 0) (void)xb_add(&bar[XB_XCNT(b.x)], 1u);
    return b;
}
__device__ __forceinline__ void xcd_barrier_complete(unsigned* bar, unsigned x, unsigned& nloc, unsigned& nx) {
    const unsigned G = gridDim.x * gridDim.y * gridDim.z;
    unsigned sum, cnt, mine, sp = 0u;
    for (;;) {
        sum = 0u; cnt = 0u; mine = 0u;
#pragma unroll
        for (unsigned j = 0; j < 16; ++j) { const unsigned c = xb_ld(&bar[XB_XCNT(j)]); sum += c; cnt += (c > 0u) ? 1u : 0u; mine = (j == x) ? c : mine; }
        if (sum == G) break;
        __builtin_amdgcn_s_sleep(1);
        if ((++sp & 255u) == 0u) { if (xb_ld(&bar[XB_TMO])) break; if (sp > XB_SPIN_CAP) { atomicAdd(&bar[XB_TMO], 1u); break; } }
    }
    nloc = mine > 0u ? mine : 1u; nx = cnt > 0u ? cnt : 1u;
}
__device__ __forceinline__ void xcd_barrier(const XcdBarrier& b) {
    asm volatile("s_waitcnt vmcnt(0)" ::: "memory");
    __syncthreads();
    if (threadIdx.x == 0) {
        unsigned* bar = b.bar;
        __builtin_amdgcn_s_waitcnt(0);
        unsigned nloc = b.st[0], nx = b.st[1];
        if (nloc == 0u) { xcd_barrier_complete(bar, b.x, nloc, nx); b.st[0] = nloc; b.st[1] = nx; }
        const unsigned old = xb_add(&bar[XB_XSUB(b.x)], 1u);
        const unsigned gen = old / nloc;
        if (old + 1u == (gen + 1u) * nloc) {
            __builtin_amdgcn_fence(__ATOMIC_RELEASE, "agent");
            asm volatile("s_waitcnt vmcnt(0)" ::: "memory");
            const unsigned og = xb_add(&bar[XB_TOP], 1u);
            const unsigned tg = og / nx;
            if (og + 1u == (tg + 1u) * nx) xb_add(&bar[XB_TOPGEN], 1u);
            else XB_SPIN(xb_ld(&bar[XB_TOPGEN]) == tg, bar);
            __builtin_amdgcn_fence(__ATOMIC_ACQUIRE, "agent");
            xb_add(&bar[XB_XGEN(b.x)], 1u);
            asm volatile("s_waitcnt vmcnt(0)" ::: "memory");
        } else {
            XB_SPIN(xb_ld(&bar[XB_XGEN(b.x)]) == gen, bar);
            __builtin_amdgcn_fence(__ATOMIC_ACQUIRE, "agent");
            asm volatile("s_waitcnt vmcnt(0)" ::: "memory");
        }
    }
    __syncthreads();
}

constexpr int LDS_BYTES = 147456;
constexpr int MISC_OFF = 131072 + 320;
struct Frame {
    LAS unsigned char* lds;
    int tid, lane, wave, G;
    unsigned char* ws; gu32* ctl;
    float* out;
};
__device__ __forceinline__ float wave_sum(float v) {
#pragma unroll
    for (int o = 1; o < 64; o <<= 1) v += __shfl_xor(v, o);
    return v;
}

constexpr int PTR_OFF = 131072 + 512;
__device__ __forceinline__ const float* inp_ptr(Frame& F, int k) {
    const LAS unsigned* t = (const LAS unsigned*)(F.lds + PTR_OFF) + 2 * k;
    const unsigned lo = __builtin_amdgcn_readfirstlane(t[0]), hi = __builtin_amdgcn_readfirstlane(t[1]);
    return (const float*)(((unsigned long long)hi << 32) | lo);
}
#define INP(k) inp_ptr(F, (k))
__device__ __forceinline__ bool relaunder(Frame& F) { int t_ = threadIdx.x; asm volatile("" : "+v"(t_)); F.tid = t_; F.lane = t_ & 63; F.wave = __builtin_amdgcn_readfirstlane(t_ >> 6); return true; }
namespace pg8 {
#define PG8_LAS __attribute__((address_space(3)))
typedef unsigned short bf16_t;
typedef short bf16x8 __attribute__((ext_vector_type(8)));
typedef unsigned u32x4 __attribute__((ext_vector_type(4)));
constexpr int BM = 256, BK = 64, HALF = 128, HTB = HALF * BK * 2, STAGE_BYTES = 8 * HTB, NXCD = 8, WGM = 8;
__host__ __device__ __forceinline__ int lds_byte(int r, int c) { const int st = (r >> 4) * 2 + (c >> 5), rr = r & 15, cc = c & 31, ob = rr * 64 + cc * 2; return st * 1024 + (ob ^ (((ob >> 9) & 1) << 5)); }
__host__ __device__ __forceinline__ void stage_rc(int b, int& R, int& C) { const int st = b / 1024, sb = b % 1024, swz = sb ^ (((sb >> 9) & 1) << 5); R = (st >> 1) * 16 + swz / 64; C = (st & 1) * 32 + (swz % 64) / 2; }
__host__ __device__ __forceinline__ int perm32(int rho) { const int n = rho >> 4, i = rho & 15; return 8 * (i >> 2) + 4 * n + (i & 3); }
struct Unit { int pm, pn, e, mt; };

struct DenseOrder {
    int nM, nN, nwg, G, c; const char* A; const char* Bt; size_t tstep;
    __device__ __forceinline__ void init(const bf16_t* A_, const bf16_t* Bt_, int M_, int N_, int K_, int G_, int c_) { nM = M_ / BM; nN = N_ / BM; nwg = nM * nN; G = G_; c = c_; A = (const char*)A_; Bt = (const char*)Bt_; tstep = (size_t)BM * K_ * 2; }
    __device__ __forceinline__ bool next(int i, Unit& u) const {
        const long L = (long)i * G + c; if (L >= nwg) return false;
        int wgid = (int)L; { const int q = nwg / NXCD, r = nwg % NXCD, xcd = wgid % NXCD, off = wgid / NXCD; wgid = (xcd < r ? xcd * (q + 1) : r * (q + 1) + (xcd - r) * q) + off; }
        const int nig = WGM * nN, gid = wgid / nig, fm = gid * WGM, gsz = (nM - fm) < WGM ? (nM - fm) : WGM;
        u.pm = fm + ((wgid % nig) % gsz); u.pn = (wgid % nig) / gsz; u.e = 0; u.mt = u.pm; return true;
    }
    __device__ __forceinline__ const char* a_base(const Unit& u) const { return A + (size_t)u.pm * tstep; }
    __device__ __forceinline__ const char* b_base(const Unit& u) const { return Bt + (size_t)u.pn * tstep; }
    __device__ __forceinline__ void a_voff(const Unit&, const int (&)[2], const int (&)[2], unsigned (&)[2][2]) const {}
};
struct MoeOrder {
    int t1, t2, t3, t4, t5, t6, t7, t8, nN, G, c, K; const char* A; const char* Bt; size_t tstepA, tstepB, estepB; const int* list; bool gather;
    __device__ __forceinline__ bool next(int i, Unit& u) const {
        const int L = i * G + c; if (L >= t8 * nN) return false;
        const int mt = L / nN; u.pm = mt; u.pn = L - mt * nN;
        const int e = (mt >= t1) + (mt >= t2) + (mt >= t3) + (mt >= t4) + (mt >= t5) + (mt >= t6) + (mt >= t7);
        const int tb = e == 0 ? 0 : e == 1 ? t1 : e == 2 ? t2 : e == 3 ? t3 : e == 4 ? t4 : e == 5 ? t5 : e == 6 ? t6 : t7;
        u.e = e; u.mt = mt - tb; return true;
    }
    __device__ __forceinline__ const char* a_base(const Unit& u) const { return gather ? A : A + (size_t)u.pm * tstepA; }
    __device__ __forceinline__ const char* b_base(const Unit& u) const { return Bt + (size_t)u.e * estepB + (size_t)u.pn * tstepB; }
    __device__ __forceinline__ void a_voff(const Unit& u, const int (&sR)[2], const int (&sC)[2], unsigned (&v)[2][2]) const {
        const int* lp = list + u.e * LCAP + u.mt * 256;
#pragma unroll
        for (int h = 0; h < 2; ++h)
#pragma unroll
            for (int i = 0; i < 2; ++i) v[h][i] = (unsigned)lp[h * 128 + sR[i]] * (unsigned)(K * 2) + (unsigned)(sC[i] * 2);
    }
};

__device__ __forceinline__ unsigned cvt_pk_bf16(float lo, float hi) { unsigned r; asm volatile("v_cvt_pk_bf16_f32 %0, %1, %2" : "=v"(r) : "v"(lo), "v"(hi)); return r; }

struct EpiPlanes {
    static constexpr bool PERM = true;
    bf16_t* O; float scale0;
    __device__ __forceinline__ void operator()(const f32x4 (&acc)[2][2][4][2], const Unit& u, int wr, int wc, int fr, int fq) const {
        const int plane = u.pn >> 2; const float sc = plane == 0 ? scale0 : 1.f;
        bf16_t* base = O + (size_t)plane * PLANE + (size_t)(u.pm * BM + wr * 64 + fr) * DM + (u.pn & 3) * 256 + wc * 32 + 8 * fq;
#pragma unroll
        for (int ai = 0; ai < 2; ++ai)
#pragma unroll
            for (int m = 0; m < 4; ++m) { bf16_t* rowp = base + (size_t)(ai * HALF + m * 16) * DM;
#pragma unroll
                for (int bj = 0; bj < 2; ++bj) { const f32x4 v0 = acc[ai][bj][m][0] * sc, v1 = acc[ai][bj][m][1] * sc;
                    u32x4 w; w.x = cvt_pk_bf16(v0[0], v0[1]); w.y = cvt_pk_bf16(v0[2], v0[3]); w.z = cvt_pk_bf16(v1[0], v1[1]); w.w = cvt_pk_bf16(v1[2], v1[3]);
                    *(u32x4*)(rowp + bj * HALF) = w; } }
    }
};
struct EpiQKNorm {
    static constexpr bool PERM = true;
    bf16_t* O; const float* qg; const float* kg; int vplane;
    __device__ __forceinline__ void operator()(const f32x4 (&acc)[2][2][4][2], const Unit& u, int wr, int wc, int fr, int fq) const {
        const int plane = u.pn >> 2; const bool isv = plane == vplane; const bool isq = !isv && ((plane & 1) == 0); const int grp = plane >> 1;
        const float* g = (isq ? qg : kg) + grp * 64 + 8 * fq;
        f32x4 gv[2][2];
#pragma unroll
        for (int bj = 0; bj < 2; ++bj)
#pragma unroll
            for (int n = 0; n < 2; ++n) gv[bj][n] = isv ? (f32x4){1.f, 1.f, 1.f, 1.f} : *(const f32x4*)(g + 32 * bj + 4 * n);
        const float mul = isq ? C2 : 1.f;
        bf16_t* base = O + (size_t)plane * PLANE + (size_t)(u.pm * BM + wr * 64 + fr) * DM + (u.pn & 3) * 256 + wc * 64 + 8 * fq;
#pragma unroll
        for (int ai = 0; ai < 2; ++ai)
#pragma unroll
            for (int m = 0; m < 4; ++m) { bf16_t* rowp = base + (size_t)(ai * HALF + m * 16) * DM;
                float ss = 0.f;
#pragma unroll
                for (int bj = 0; bj < 2; ++bj)
#pragma unroll
                    for (int n = 0; n < 2; ++n) { const f32x4 x = acc[ai][bj][m][n]; ss += (x[0] * x[0] + x[1] * x[1]) + (x[2] * x[2] + x[3] * x[3]); }
                ss += __shfl_xor(ss, 16); ss += __shfl_xor(ss, 32);
                const float inv = isv ? 1.f : mul / sqrtf(ss * (1.f / 64.f) + RMS_EPS);
#pragma unroll
                for (int bj = 0; bj < 2; ++bj) { const f32x4 v0 = acc[ai][bj][m][0] * inv * gv[bj][0], v1 = acc[ai][bj][m][1] * inv * gv[bj][1];
                    u32x4 w; w.x = cvt_pk_bf16(v0[0], v0[1]); w.y = cvt_pk_bf16(v0[2], v0[3]); w.z = cvt_pk_bf16(v1[0], v1[1]); w.w = cvt_pk_bf16(v1[2], v1[3]);
                    *(u32x4*)(rowp + bj * 32) = w; } }
    }
};
struct EpiSwiglu {
    static constexpr bool PERM = true;
    bf16_t* O;
    __device__ __forceinline__ void operator()(const f32x4 (&acc)[2][2][4][2], const Unit& u, int wr, int wc, int fr, int fq) const {
        bf16_t* base = O + (size_t)(u.pm * BM + wr * 64 + fr) * FF + u.pn * 128 + wc * 32 + 8 * fq;
#pragma unroll
        for (int ai = 0; ai < 2; ++ai)
#pragma unroll
            for (int m = 0; m < 4; ++m) { bf16_t* rowp = base + (size_t)(ai * HALF + m * 16) * FF;
                float o[8];
#pragma unroll
                for (int n = 0; n < 2; ++n)
#pragma unroll
                    for (int i = 0; i < 4; ++i) { const float g = acc[ai][0][m][n][i], uu = acc[ai][1][m][n][i];
                        o[n * 4 + i] = g * __builtin_amdgcn_rcpf(1.0f + __builtin_amdgcn_exp2f(-g * LOG2E)) * uu; }
                u32x4 w; w.x = cvt_pk_bf16(o[0], o[1]); w.y = cvt_pk_bf16(o[2], o[3]); w.z = cvt_pk_bf16(o[4], o[5]); w.w = cvt_pk_bf16(o[6], o[7]);
                *(u32x4*)rowp = w; }
    }
};
struct EpiResid {
    static constexpr bool PERM = false;
    const float* base; float* out;
    __device__ __forceinline__ void operator()(const f32x4 (&acc)[2][2][4][2], const Unit& u, int wr, int wc, int fr, int fq) const {
        const size_t off0 = (size_t)(u.pm * BM + wr * 64 + fr) * DM + u.pn * BM + wc * 32 + 4 * fq;
#pragma unroll
        for (int ai = 0; ai < 2; ++ai)
#pragma unroll
            for (int m = 0; m < 4; ++m) { const size_t off = off0 + (size_t)(ai * HALF + m * 16) * DM;
#pragma unroll
                for (int bj = 0; bj < 2; ++bj)
#pragma unroll
                    for (int n = 0; n < 2; ++n) { const f32x4 b = *(const f32x4*)(base + off + bj * HALF + n * 16); *(f32x4*)(out + off + bj * HALF + n * 16) = b + acc[ai][bj][m][n]; } }
    }
};
struct EpiMoeDown {
    static constexpr bool PERM = false;
    float* Y; const float* gw;
    __device__ __forceinline__ void operator()(const f32x4 (&acc)[2][2][4][2], const Unit& u, int wr, int wc, int fr, int fq) const {
        const size_t off0 = (size_t)(u.pm * BM + wr * 64 + fr) * DM + u.pn * BM + wc * 32 + 4 * fq;
        const float* gp = gw + u.e * LCAP + u.mt * 256 + wr * 64 + fr;
#pragma unroll
        for (int ai = 0; ai < 2; ++ai)
#pragma unroll
            for (int m = 0; m < 4; ++m) { const size_t off = off0 + (size_t)(ai * HALF + m * 16) * DM; const float g = gp[ai * HALF + m * 16];
#pragma unroll
                for (int bj = 0; bj < 2; ++bj)
#pragma unroll
                    for (int n = 0; n < 2; ++n) *(f32x4*)(Y + off + bj * HALF + n * 16) = acc[ai][bj][m][n] * g; }
    }
};

template <class Epi, class Sched, bool GATHER>
__device__ __forceinline__ void gemm_phase(PG8_LAS unsigned char* lds, const int K, const Sched& S, const Epi& E) {
    const int tid = threadIdx.x, wid = __builtin_amdgcn_readfirstlane(tid >> 6), lane = tid & 63, wr = wid >> 2, wc = wid & 3, fr = lane & 15, fq = lane >> 4;
    const int nt = K / BK;
    unsigned voffA[2], voffB[2]; int sR[2], sC[2];
#pragma unroll
    for (int i = 0; i < 2; ++i) { int R, C; stage_rc(tid * 16 + i * 8192, R, C); const int Rb = Epi::PERM ? ((R & ~31) + perm32(R & 31)) : R;
        voffA[i] = (unsigned)(R * K + C) * 2u; voffB[i] = (unsigned)(Rb * K + C) * 2u; sR[i] = R; sC[i] = C; }
    const size_t kstep = (size_t)(BK * 2);
    const size_t hstep = (size_t)HALF * K * 2;
    const unsigned ldsw = (unsigned)wid * 1024u;
    const int aoff = lds_byte(wr * 64 + fr, fq * 8), boff = lds_byte(wc * 32 + fr, fq * 8);
#define PG8_SA(b, h) (((b) * 2 + (h)) * HTB)
#define PG8_SB(b, h) ((4 + (b) * 2 + (h)) * HTB)
#define PG8_STAGE(bufoff, gbase, voff) do { _Pragma("unroll") for (int _i = 0; _i < 2; ++_i) \
        __builtin_amdgcn_global_load_lds((const unsigned*)((const char*)(gbase) + (voff)[_i]), (PG8_LAS unsigned*)(lds + (bufoff) + ldsw + _i * 8192), 16, 0, 0); } while (0)
#define PG8_STAGE_A(bufoff, p, h, VG) do { if (GATHER) { PG8_STAGE(bufoff, p, VG[h]); } else { PG8_STAGE(bufoff, (p) + ((h) ? hstep : 0), voffA); } } while (0)
#define PG8_LDA(dst, b, h) do { _Pragma("unroll") for (int m = 0; m < 4; ++m) _Pragma("unroll") for (int k = 0; k < 2; ++k) dst[m][k] = *(const PG8_LAS bf16x8*)(lds + PG8_SA(b, h) + aoff + m * 2048 + k * 1024); } while (0)
#define PG8_LDB(dst, b, h) do { _Pragma("unroll") for (int n = 0; n < 2; ++n) _Pragma("unroll") for (int k = 0; k < 2; ++k) dst[n][k] = *(const PG8_LAS bf16x8*)(lds + PG8_SB(b, h) + boff + n * 2048 + k * 1024); } while (0)
#define PG8_MMA(ai, bj, At, Bt) do { __builtin_amdgcn_s_setprio(1); _Pragma("unroll") for (int m = 0; m < 4; ++m) _Pragma("unroll") for (int n = 0; n < 2; ++n) _Pragma("unroll") for (int k = 0; k < 2; ++k) \
        acc[ai][bj][m][n] = __builtin_amdgcn_mfma_f32_16x16x32_bf16(Bt[n][k], At[m][k], acc[ai][bj][m][n], 0, 0, 0); __builtin_amdgcn_s_setprio(0); } while (0)
#define PG8_WAIT_V(n) asm volatile("s_waitcnt vmcnt(" #n ")" ::: "memory")
#define PG8_WAIT_L(n) asm volatile("s_waitcnt lgkmcnt(" #n ")" ::: "memory")
#define PG8_BAR __builtin_amdgcn_s_barrier()
#define PG8_SCHED __builtin_amdgcn_sched_barrier(0)
    Unit cur, nxt; int ui = 0;
    if (!S.next(0, cur)) return;
    f32x4 acc[2][2][4][2];
#pragma unroll
    for (int a = 0; a < 2; ++a)
#pragma unroll
        for (int b = 0; b < 2; ++b)
#pragma unroll
            for (int m = 0; m < 4; ++m)
#pragma unroll
                for (int n = 0; n < 2; ++n) acc[a][b][m][n] = (f32x4){0.f, 0.f, 0.f, 0.f};
    bf16x8 At[4][2], B0[2][2], B1[2][2];
    const char* cA = S.a_base(cur); const char* cB = S.b_base(cur);
    unsigned vc[2][2] = {{0u, 0u}, {0u, 0u}}, vn[2][2] = {{0u, 0u}, {0u, 0u}};
    if (GATHER) { S.a_voff(cur, sR, sC, vc); asm volatile("s_waitcnt vmcnt(0)" : "+v"(vc[0][0]), "+v"(vc[0][1]), "+v"(vc[1][0]), "+v"(vc[1][1]) :: "memory"); }
    PG8_STAGE(PG8_SB(0, 0), cB, voffB); PG8_STAGE(PG8_SB(0, 1), cB + hstep, voffB); PG8_STAGE_A(PG8_SA(0, 0), cA, 0, vc); PG8_STAGE_A(PG8_SA(0, 1), cA, 1, vc);
    if (wr == 1) PG8_BAR;
    PG8_WAIT_V(2); PG8_BAR;
    PG8_STAGE(PG8_SB(1, 0), cB + kstep, voffB); PG8_STAGE_A(PG8_SA(1, 0), cA + kstep, 0, vc); PG8_STAGE(PG8_SB(1, 1), cB + hstep + kstep, voffB);
    PG8_WAIT_V(6); PG8_BAR;
    for (;;) {
        const bool has_next = S.next(ui + 1, nxt);
        const char* nA = has_next ? S.a_base(nxt) : cA; const char* nB = has_next ? S.b_base(nxt) : cB;
        if (GATHER) {
            if (has_next) { S.a_voff(nxt, sR, sC, vn); asm volatile("s_waitcnt vmcnt(0)" : "+v"(vn[0][0]), "+v"(vn[0][1]), "+v"(vn[1][0]), "+v"(vn[1][1]) :: "memory"); }
            else { vn[0][0] = vc[0][0]; vn[0][1] = vc[0][1]; vn[1][0] = vc[1][0]; vn[1][1] = vc[1][1]; }
        }
        for (int t = 0; t < nt; t += 2) {
            const bool last = (t == nt - 2);
            const char* a1 = cA + (size_t)(t + 1) * kstep;
            const char* a2 = last ? nA : cA + (size_t)(t + 2) * kstep; const char* b2 = last ? nB : cB + (size_t)(t + 2) * kstep;
            const char* a3 = a2 + kstep; const char* b3 = b2 + kstep;
            unsigned v2[2][2];
#pragma unroll
            for (int h = 0; h < 2; ++h)
#pragma unroll
                for (int i = 0; i < 2; ++i) v2[h][i] = last ? vn[h][i] : vc[h][i];
            PG8_LDB(B0, 0, 0); PG8_LDB(B1, 0, 1); PG8_SCHED; PG8_LDA(At, 0, 0); PG8_STAGE_A(PG8_SA(1, 1), a1, 1, vc);
            PG8_WAIT_V(8); PG8_WAIT_L(0); PG8_BAR; PG8_MMA(0, 0, At, B0); PG8_MMA(0, 1, At, B1); PG8_BAR; PG8_SCHED;
            PG8_LDA(At, 0, 1); PG8_STAGE(PG8_SB(0, 0), b2, voffB); PG8_STAGE(PG8_SB(0, 1), b2 + hstep, voffB); PG8_STAGE_A(PG8_SA(0, 0), a2, 0, v2);
            PG8_WAIT_V(8); PG8_WAIT_L(0); PG8_BAR; PG8_MMA(1, 0, At, B0); PG8_MMA(1, 1, At, B1); PG8_BAR; PG8_SCHED;
            PG8_LDB(B0, 1, 0); PG8_LDB(B1, 1, 1); PG8_SCHED; PG8_LDA(At, 1, 0); PG8_STAGE_A(PG8_SA(0, 1), a2, 1, v2);
            PG8_WAIT_V(8); PG8_WAIT_L(0); PG8_BAR; PG8_MMA(0, 0, At, B0); PG8_MMA(0, 1, At, B1); PG8_BAR; PG8_SCHED;
            PG8_LDA(At, 1, 1); PG8_STAGE(PG8_SB(1, 0), b3, voffB); PG8_STAGE(PG8_SB(1, 1), b3 + hstep, voffB); PG8_STAGE_A(PG8_SA(1, 0), a3, 0, v2);
            PG8_WAIT_V(8); PG8_WAIT_L(0); PG8_BAR; PG8_MMA(1, 0, At, B0); PG8_MMA(1, 1, At, B1); PG8_BAR; PG8_SCHED;
        }
        if (wr == 0) PG8_BAR;
        E(acc, cur, wr, wc, fr, fq);
        if (!has_next) break;
#pragma unroll
        for (int a = 0; a < 2; ++a)
#pragma unroll
            for (int b = 0; b < 2; ++b)
#pragma unroll
                for (int m = 0; m < 4; ++m)
#pragma unroll
                    for (int n = 0; n < 2; ++n) acc[a][b][m][n] = (f32x4){0.f, 0.f, 0.f, 0.f};
        cur = nxt; cA = nA; cB = nB; ++ui;
        if (GATHER) { vc[0][0] = vn[0][0]; vc[0][1] = vn[0][1]; vc[1][0] = vn[1][0]; vc[1][1] = vn[1][1]; }
        if (wr == 1) PG8_BAR;
    }
    PG8_WAIT_V(0);
    PG8_BAR;
#undef PG8_SA
#undef PG8_SB
#undef PG8_STAGE
#undef PG8_STAGE_A
#undef PG8_LDA
#undef PG8_LDB
#undef PG8_MMA
#undef PG8_WAIT_V
#undef PG8_WAIT_L
#undef PG8_BAR
#undef PG8_SCHED
}
}

namespace att {
typedef short bf16x8 __attribute__((ext_vector_type(8)));
typedef short s16x4 __attribute__((ext_vector_type(4)));
typedef float f32x16 __attribute__((ext_vector_type(16)));
typedef unsigned u32x4 __attribute__((ext_vector_type(4)));
typedef LAS char* lptr;
constexpr int SLOTB = 8192;
constexpr int L_K = 0, L_V = 3 * SLOTB, L_WS = 6 * SLOTB, L_OST = L_WS + 8 * 256, L_KB = L_OST + 8 * 4096, L_TBL = L_KB + 8192, L_FLG = L_TBL + 8192, L_END = L_FLG + 256;
static_assert(L_END <= 131072, "attention LDS map inside the ring region");
constexpr float THR = 8.0f;
__device__ __forceinline__ int crow(int r, int hi) { return (r & 3) + 8 * (r >> 2) + 4 * hi; }
__device__ __forceinline__ void glds16(const void* gsrc, unsigned lds_dst) { unsigned keep;
    asm volatile("s_mov_b32 %0, m0\n\ts_mov_b32 m0, %2\n\ts_nop 0\n\tglobal_load_lds_dwordx4 %1, off\n\ts_mov_b32 m0, %0" : "=&s"(keep) : "v"(gsrc), "s"(lds_dst) : "memory"); }
typedef float f32x2_t __attribute__((ext_vector_type(2))); typedef __bf16 bf16x2_t __attribute__((ext_vector_type(2)));
__device__ __forceinline__ unsigned cvtpk(float lo, float hi) { f32x2_t v = {lo, hi}; bf16x2_t b = __builtin_convertvector(v, bf16x2_t); return __builtin_bit_cast(unsigned, b); }
#define ATT_WAIT_BAR(N) asm volatile("s_waitcnt vmcnt(" #N ") lgkmcnt(0)\n\ts_barrier" ::: "memory")
__device__ __forceinline__ float other_half(float x, int hi) {
    auto rr = __builtin_amdgcn_permlane32_swap(__float_as_uint(x), __float_as_uint(x), false, false);
    return __uint_as_float(hi ? rr[0] : rr[1]);
}
__device__ __forceinline__ void qkt(f32x16& p0, f32x16& p1, lptr Kslot, const bf16x8* qr, int r32, int hi) {
    lptr kb = Kslot + hi * 1024 + r32 * 16;
    const f32x16 z = {};
#pragma unroll
    for (int d0 = 0; d0 < 4; ++d0) {
        const bf16x8 b0 = *(const LAS bf16x8*)(kb + d0 * 2048);
        const bf16x8 b1 = *(const LAS bf16x8*)(kb + d0 * 2048 + 512);
        if (d0 == 0) { p0 = __builtin_amdgcn_mfma_f32_32x32x16_bf16(b0, qr[0], z, 0, 0, 0); p1 = __builtin_amdgcn_mfma_f32_32x32x16_bf16(b1, qr[0], z, 0, 0, 0); }
        else { p0 = __builtin_amdgcn_mfma_f32_32x32x16_bf16(b0, qr[d0], p0, 0, 0, 0); p1 = __builtin_amdgcn_mfma_f32_32x32x16_bf16(b1, qr[d0], p1, 0, 0, 0); } }
}
__device__ __forceinline__ void pv(f32x16* o, int vb, bf16x8 pa0, bf16x8 pa1, bf16x8 pa2, bf16x8 pa3) {
#pragma unroll
    for (int d0 = 0; d0 < 2; ++d0) { s16x4 lo[4], hi[4];
#pragma unroll
        for (int ks = 0; ks < 4; ++ks) {
            asm volatile("ds_read_b64_tr_b16 %0,%1 offset:%c2" : "=&v"(lo[ks]) : "v"(vb), "i"(d0 * 4096 + ks * 1024) : "memory");
            asm volatile("ds_read_b64_tr_b16 %0,%1 offset:%c2" : "=&v"(hi[ks]) : "v"(vb), "i"(d0 * 4096 + ks * 1024 + 512) : "memory"); }
        asm volatile("s_waitcnt lgkmcnt(0)" ::: "memory"); __builtin_amdgcn_sched_barrier(0);
#define ATT_PK(k) (bf16x8){lo[k][0], lo[k][1], lo[k][2], lo[k][3], hi[k][0], hi[k][1], hi[k][2], hi[k][3]}
        o[d0] = __builtin_amdgcn_mfma_f32_32x32x16_bf16(pa0, ATT_PK(0), o[d0], 0, 0, 0);
        o[d0] = __builtin_amdgcn_mfma_f32_32x32x16_bf16(pa1, ATT_PK(1), o[d0], 0, 0, 0);
        o[d0] = __builtin_amdgcn_mfma_f32_32x32x16_bf16(pa2, ATT_PK(2), o[d0], 0, 0, 0);
        o[d0] = __builtin_amdgcn_mfma_f32_32x32x16_bf16(pa3, ATT_PK(3), o[d0], 0, 0, 0);
#undef ATT_PK
    }
}
__device__ __forceinline__ float rowmax32(const f32x16& p0, const f32x16& p1, int hi) {
    float a = fmaxf(p0[0], p1[0]);
#pragma unroll
    for (int r = 1; r < 16; ++r) a = fmaxf(a, fmaxf(p0[r], p1[r]));
    return fmaxf(a, other_half(a, hi));
}
__device__ __forceinline__ void store_o(const f32x16* o, const float* sc, lptr stgb, bf16* Ow, long rpitch, int lane, int r32, int hi) {
    LAS bf16* stg = (LAS bf16*)stgb;
#pragma unroll
    for (int r = 0; r < 16; ++r) { const int orow = crow(r, hi);
#pragma unroll
        for (int d0 = 0; d0 < 2; ++d0) stg[orow * 64 + d0 * 32 + r32] = (bf16)f2bf(o[d0][r] * sc[r]); }
    asm volatile("s_waitcnt lgkmcnt(0)" ::: "memory");
#pragma unroll
    for (int i = 0; i < 4; ++i) { const int row = i * 8 + (lane >> 3), ch = lane & 7; const u32x4 v = *(const LAS u32x4*)(stg + row * 64 + ch * 8); *(u32x4*)(Ow + (long)row * rpitch + ch * 8) = v; }
}

__device__ __forceinline__ void fox_unit(lptr shm, int b, int h, int qb, const bf16* Q, const bf16* K, const bf16* V, bf16* O, const float* cum) {
    const int tid = threadIdx.x, lane = tid & 63, r32 = lane & 31, hi = lane >> 5; const int wid = __builtin_amdgcn_readfirstlane(tid >> 6);
    const long rowbase = (long)b * SEQ; const int q0 = qb * 256;
    const bf16* Qw = Q + (rowbase + q0 + wid * 32) * DM + h * 64;
    const bf16* Kh = K + rowbase * DM + h * 64; const bf16* Vh = V + rowbase * DM + h * 64;
    const unsigned lds0 = (unsigned)(uintptr_t)shm;
    LAS float* wsf = (LAS float*)(shm + L_WS) + wid * 64;
    LAS float* kbl = (LAS float*)(shm + L_KB);
    for (int s = tid; s < q0 + 256; s += NTHR) kbl[s] = -cum[(rowbase + s) * 16 + h];
    bf16x8 qr[4];
#pragma unroll
    for (int d0 = 0; d0 < 4; ++d0) qr[d0] = *(const bf16x8*)(Qw + (long)r32 * DM + d0 * 16 + hi * 8);
    const int NT = (q0 + 256) / 64;
    const bf16* ksrc = Kh + (long)lane * DM + wid * 8;
    const bf16* vsrc = Vh + (long)(16 * (wid & 3) + (lane >> 2)) * DM + (wid >> 2) * 32 + (lane & 3) * 8;
    const unsigned kdst = lds0 + L_K + wid * 1024, vdst = lds0 + L_V + wid * 1024;
    const int vb0 = (int)(lds0 + L_V) + ((lane >> 4) & 1) * 32 + (lane & 3) * 8 + (4 * hi + ((lane & 15) >> 2)) * 64;
#define ATT_DMA(t, sl) do { glds16(ksrc + (long)(t) * 64 * DM, (unsigned)__builtin_amdgcn_readfirstlane(kdst + (sl) * SLOTB)); glds16(vsrc + (long)(t) * 64 * DM, (unsigned)__builtin_amdgcn_readfirstlane(vdst + (sl) * SLOTB)); } while (0)
    asm volatile("s_waitcnt vmcnt(0)" : "+v"(qr[0]), "+v"(qr[1]), "+v"(qr[2]), "+v"(qr[3]) :: "memory");
    ATT_DMA(0, 0); ATT_DMA(1, 1);
    float mref = -1e30f, lsum = 0.f; f32x16 o[2]; o[0] = f32x16{}; o[1] = f32x16{};
    const int qfirst = q0 + wid * 32, qpos = qfirst + r32;
    int slot = 0;
    for (int t = 0; t < NT; ++t) {
        if (t + 1 < NT) ATT_WAIT_BAR(2); else ATT_WAIT_BAR(0);
        if (t + 2 < NT) { const int s2 = slot >= 1 ? slot - 1 : 2; ATT_DMA(t + 2, s2); }
        if (64 * t <= qfirst + 31) {
            f32x16 p0, p1; qkt(p0, p1, shm + L_K + slot * SLOTB, qr, r32, hi);
#pragma unroll
            for (int g = 0; g < 4; ++g) { const f32x4 k0 = *(const LAS f32x4*)(kbl + 64 * t + 8 * g + 4 * hi), k1 = *(const LAS f32x4*)(kbl + 64 * t + 32 + 8 * g + 4 * hi);
#pragma unroll
                for (int i = 0; i < 4; ++i) { p0[4 * g + i] += k0[i]; p1[4 * g + i] += k1[i]; } }
            if (64 * t + 63 > qfirst) {
#pragma unroll
                for (int r = 0; r < 16; ++r) { const int kv = 64 * t + crow(r, hi); if (kv > qpos) p0[r] = -INFINITY; if (kv + 32 > qpos) p1[r] = -INFINITY; } }
            const float rm = rowmax32(p0, p1, hi);
            const bool fresh = mref <= -1e30f;
            const bool want = !fresh && (rm > mref + THR);
            if (fresh) mref = fmaxf(rm, -1e30f);
            if (__any(want)) {
                const float dl = want ? rm - mref : 0.f; mref += dl; const float f = __builtin_amdgcn_exp2f(-dl); lsum *= f;
                if (hi == 0) wsf[r32] = f;
                asm volatile("s_waitcnt lgkmcnt(0)" ::: "memory");
#pragma unroll
                for (int r = 0; r < 16; ++r) { const float fr = wsf[crow(r, hi)]; o[0][r] *= fr; o[1][r] *= fr; }
            }
            float sacc = 0.f;
#pragma unroll
            for (int r = 0; r < 16; ++r) { p0[r] = __builtin_amdgcn_exp2f(p0[r] - mref); p1[r] = __builtin_amdgcn_exp2f(p1[r] - mref); sacc += p0[r] + p1[r]; }
            lsum += sacc;
            u32x4 w0, w1, w2, w3;
#pragma unroll
            for (int j = 0; j < 4; ++j) { w0[j] = cvtpk(p0[2 * j], p0[2 * j + 1]); w1[j] = cvtpk(p0[8 + 2 * j], p0[8 + 2 * j + 1]); w2[j] = cvtpk(p1[2 * j], p1[2 * j + 1]); w3[j] = cvtpk(p1[8 + 2 * j], p1[8 + 2 * j + 1]); }
            pv(o, vb0 + slot * SLOTB, __builtin_bit_cast(bf16x8, w0), __builtin_bit_cast(bf16x8, w1), __builtin_bit_cast(bf16x8, w2), __builtin_bit_cast(bf16x8, w3));
        }
        slot = slot == 2 ? 0 : slot + 1;
    }
    lsum += other_half(lsum, hi);
    if (hi == 0) wsf[32 + r32] = lsum;
    asm volatile("s_waitcnt lgkmcnt(0)" ::: "memory");
    float rli[16];
#pragma unroll
    for (int r = 0; r < 16; ++r) rli[r] = __builtin_amdgcn_rcpf(wsf[32 + crow(r, hi)]);
    store_o(o, rli, shm + L_OST + wid * 4096, O + (rowbase + q0 + wid * 32) * DM + h * 64, DM, lane, r32, hi);
    asm volatile("s_waitcnt lgkmcnt(0)\n\ts_barrier" ::: "memory");
#undef ATT_DMA
}

__device__ __forceinline__ void sb_unit(lptr shm, int b, int h, int qb, const bf16* Q, const bf16* K, const bf16* V, bf16* O) {
    const int tid = threadIdx.x, lane = tid & 63, r32 = lane & 31, hi = lane >> 5; const int wid = __builtin_amdgcn_readfirstlane(tid >> 6);
    const long rowbase = (long)b * SEQ; const int q0 = qb * 256;
    const bf16* Qw = Q + (rowbase + q0 + wid * 32) * DM + h * 64;
    const bf16* Kh = K + rowbase * DM + h * 64; const bf16* Vh = V + rowbase * DM + h * 64;
    const unsigned lds0 = (unsigned)(uintptr_t)shm;
    LAS int* flg = (LAS int*)(shm + L_FLG);
    if (tid < 16) flg[tid] = 0;
    bf16x8 qr[4];
#pragma unroll
    for (int d0 = 0; d0 < 4; ++d0) qr[d0] = *(const bf16x8*)(Qw + (long)r32 * DM + d0 * 16 + hi * 8);
    const int NT = (q0 + 256) / 64;
    const bf16* ksrc = Kh + (long)lane * DM + wid * 8;
    const bf16* vsrc = Vh + (long)(16 * (wid & 3) + (lane >> 2)) * DM + (wid >> 2) * 32 + (lane & 3) * 8;
    const unsigned kdst = lds0 + L_K + wid * 1024, vdst = lds0 + L_V + wid * 1024;
    const int vb0 = (int)(lds0 + L_V) + ((lane >> 4) & 1) * 32 + (lane & 3) * 8 + (4 * hi + ((lane & 15) >> 2)) * 64;
#define ATT_DMA(T, sl) do { glds16(ksrc + (long)(T) * 64 * DM, (unsigned)__builtin_amdgcn_readfirstlane(kdst + (sl) * SLOTB)); glds16(vsrc + (long)(T) * 64 * DM, (unsigned)__builtin_amdgcn_readfirstlane(vdst + (sl) * SLOTB)); } while (0)
    asm volatile("s_waitcnt vmcnt(0)" : "+v"(qr[0]), "+v"(qr[1]), "+v"(qr[2]), "+v"(qr[3]) :: "memory");
    ATT_DMA(NT - 1, 0); ATT_DMA(NT - 2, 1);
    float carry = 1.0f; f32x16 o[2]; o[0] = f32x16{}; o[1] = f32x16{};
    const int qfirst = q0 + wid * 32, qpos = qfirst + r32;
    int slot = 0; int done = 0;
    for (int k = 0; k < NT; ++k) {
        const int T = NT - 1 - k;
        if (k + 1 < NT) ATT_WAIT_BAR(2); else ATT_WAIT_BAR(0);
        if (k > 0) { int all = 1;
#pragma unroll
            for (int w = 0; w < 8; ++w) all &= flg[((k - 1) & 1) * 8 + w];
            if (__builtin_amdgcn_readfirstlane(all)) break; }
        if (k + 2 < NT) { const int s2 = slot >= 1 ? slot - 1 : 2; ATT_DMA(T - 2, s2); }
        if (!done && 64 * T < qfirst + 31) {
            f32x16 p0, p1; qkt(p0, p1, shm + L_K + slot * SLOTB, qr, r32, hi);
            const bool diag = 64 * T + 63 >= qfirst;
            float ga[8];
#pragma unroll
            for (int a = 0; a < 8; ++a) {
                float rr[4];
#pragma unroll
                for (int i = 0; i < 4; ++i) { const int r = 4 * (a & 3) + i; const float z = (a < 4) ? p0[r] : p1[r];
                    const float e = __builtin_amdgcn_exp2f(fminf(z, 120.f)); float rv = __builtin_amdgcn_rcpf(1.0f + e);
                    if (diag) { const int kv = 64 * T + crow(r, hi) + ((a < 4) ? 0 : 32); if (kv >= qpos) rv = 1.0f; }
                    rr[i] = rv; if (a < 4) p0[r] = rv; else p1[r] = rv; }
                ga[a] = (rr[0] * rr[1]) * (rr[2] * rr[3]);
            }
            float oth[8], Ts[8];
#pragma unroll
            for (int a = 0; a < 8; ++a) oth[a] = other_half(ga[a], hi);
            float run = 1.0f;
#pragma unroll
            for (int a = 7; a >= 0; --a) { Ts[a] = run; run *= ga[a] * oth[a]; }
#pragma unroll
            for (int a = 0; a < 8; ++a) {
                float E = carry * Ts[a] * (hi ? 1.0f : oth[a]);
#pragma unroll
                for (int i = 3; i >= 0; --i) { const int r = 4 * (a & 3) + i; const float rv = (a < 4) ? p0[r] : p1[r]; const float w = (1.0f - rv) * E; E *= rv; if (a < 4) p0[r] = w; else p1[r] = w; }
            }
            carry *= run;
            u32x4 w0, w1, w2, w3;
#pragma unroll
            for (int j = 0; j < 4; ++j) { w0[j] = cvtpk(p0[2 * j], p0[2 * j + 1]); w1[j] = cvtpk(p0[8 + 2 * j], p0[8 + 2 * j + 1]); w2[j] = cvtpk(p1[2 * j], p1[2 * j + 1]); w3[j] = cvtpk(p1[8 + 2 * j], p1[8 + 2 * j + 1]); }
            pv(o, vb0 + slot * SLOTB, __builtin_bit_cast(bf16x8, w0), __builtin_bit_cast(bf16x8, w1), __builtin_bit_cast(bf16x8, w2), __builtin_bit_cast(bf16x8, w3));
            if (__all(carry < 1e-30f)) done = 1;
        }
        if (lane == 0) flg[(k & 1) * 8 + wid] = done;
        slot = slot == 2 ? 0 : slot + 1;
    }
    asm volatile("s_waitcnt vmcnt(0)" ::: "memory");
    float one[16];
#pragma unroll
    for (int r = 0; r < 16; ++r) one[r] = 1.0f;
    store_o(o, one, shm + L_OST + wid * 4096, O + (rowbase + q0 + wid * 32) * DM + h * 64, DM, lane, r32, hi);
    asm volatile("s_waitcnt lgkmcnt(0)\n\ts_barrier" ::: "memory");
#undef ATT_DMA
}

__device__ __forceinline__ void dil_unit(lptr shm, int b, int h, int g, int x, const bf16* PROJ, bf16* OG, float* ST) {
    const int tid = threadIdx.x, lane = tid & 63, r32 = lane & 31, hi = lane >> 5; const int wid = __builtin_amdgcn_readfirstlane(tid >> 6);
    const long rowbase = (long)b * SEQ;
    const int dil = (g == 0) ? 1 : (g == 1) ? 4 : 16;
    const int cls0 = (g == 0) ? 0 : (g == 1) ? (x >> 1) : 2 * x;
    const int i0 = (g == 0) ? 256 * x : (g == 1) ? 256 * (x & 1) : 0;
    const int clsw = cls0 + ((g == 2) ? (wid >> 2) : 0);
    const int qi0w = (g == 2) ? 32 * (wid & 3) : i0 + 32 * wid;
    const int t_lo = (g == 2) ? 0 : ((i0 >> 6) >= 2 ? (i0 >> 6) - 2 : 0);
    const int NT = (g == 2) ? 4 : ((i0 >> 6) + 4 - t_lo);
    const bf16* Qg = PROJ + (size_t)(2 * g) * PLANE; const bf16* Kg = PROJ + (size_t)(2 * g + 1) * PLANE; const bf16* Vg = PROJ + (size_t)6 * PLANE;
    const long dpitch = (long)dil * DM;
    const bf16* Qw = Qg + (rowbase + clsw + (long)qi0w * dil) * DM + h * 64;
    const bf16* Kh = Kg + rowbase * DM + h * 64; const bf16* Vh = Vg + rowbase * DM + h * 64;
    const unsigned lds0 = (unsigned)(uintptr_t)shm;
    LAS float* wsf = (LAS float*)(shm + L_WS) + wid * 64;
    LAS float* tbl = (LAS float*)(shm + L_TBL) + g * 640 + 256;
    bf16x8 qr[4];
#pragma unroll
    for (int d0 = 0; d0 < 4; ++d0) qr[d0] = *(const bf16x8*)(Qw + (long)r32 * dpitch + d0 * 16 + hi * 8);
    const bf16* ksrc = Kh + (long)lane * dpitch + wid * 8;
    const bf16* vsrc = Vh + (long)(16 * (wid & 3) + (lane >> 2)) * dpitch + (wid >> 2) * 32 + (lane & 3) * 8;
    const unsigned kdst = lds0 + L_K + wid * 1024, vdst = lds0 + L_V + wid * 1024;
    const int vb0 = (int)(lds0 + L_V) + ((lane >> 4) & 1) * 32 + (lane & 3) * 8 + (4 * hi + ((lane & 15) >> 2)) * 64;
#define DIL_TCLS(k) ((g == 2) ? cls0 + ((k) >> 1) : cls0)
#define DIL_KB(k) ((g == 2) ? 64 * ((k) & 1) : 64 * (t_lo + (k)))
#define ATT_DMA(k, sl) do { const long tok0_ = DIL_TCLS(k) + (long)DIL_KB(k) * dil; glds16(ksrc + tok0_ * DM, (unsigned)__builtin_amdgcn_readfirstlane(kdst + (sl) * SLOTB)); glds16(vsrc + tok0_ * DM, (unsigned)__builtin_amdgcn_readfirstlane(vdst + (sl) * SLOTB)); } while (0)
    asm volatile("s_waitcnt vmcnt(0)" : "+v"(qr[0]), "+v"(qr[1]), "+v"(qr[2]), "+v"(qr[3]) :: "memory");
    ATT_DMA(0, 0); ATT_DMA(1, 1);
    float mref = -1e30f, lsum = 0.f; f32x16 o[2]; o[0] = f32x16{}; o[1] = f32x16{};
    int slot = 0;
    for (int k = 0; k < NT; ++k) {
        if (k + 1 < NT) ATT_WAIT_BAR(2); else ATT_WAIT_BAR(0);
        if (k + 2 < NT) { const int s2 = slot >= 1 ? slot - 1 : 2; ATT_DMA(k + 2, s2); }
        const int kb = DIL_KB(k);
        if (DIL_TCLS(k) == clsw && kb <= qi0w + 31 && kb >= qi0w - 191) {
            f32x16 p0, p1; qkt(p0, p1, shm + L_K + slot * SLOTB, qr, r32, hi);
            const int dbase = qi0w + r32 - kb - 4 * hi;
#pragma unroll
            for (int r = 0; r < 16; ++r) { const int cr = (r & 3) + 8 * (r >> 2); p0[r] += tbl[dbase - cr]; p1[r] += tbl[dbase - cr - 32]; }
            const float rm = rowmax32(p0, p1, hi);
            const bool fresh = mref <= -1e30f;
            const bool want = !fresh && (rm > mref + THR);
            if (fresh) mref = fmaxf(rm, -1e30f);
            if (__any(want)) {
                const float dl = want ? rm - mref : 0.f; mref += dl; const float f = __builtin_amdgcn_exp2f(-dl); lsum *= f;
                if (hi == 0) wsf[r32] = f;
                asm volatile("s_waitcnt lgkmcnt(0)" ::: "memory");
#pragma unroll
                for (int r = 0; r < 16; ++r) { const float fr = wsf[crow(r, hi)]; o[0][r] *= fr; o[1][r] *= fr; }
            }
            float sacc = 0.f;
#pragma unroll
            for (int r = 0; r < 16; ++r) { p0[r] = __builtin_amdgcn_exp2f(p0[r] - mref); p1[r] = __builtin_amdgcn_exp2f(p1[r] - mref); sacc += p0[r] + p1[r]; }
            lsum += sacc;
            u32x4 w0, w1, w2, w3;
#pragma unroll
            for (int j = 0; j < 4; ++j) { w0[j] = cvtpk(p0[2 * j], p0[2 * j + 1]); w1[j] = cvtpk(p0[8 + 2 * j], p0[8 + 2 * j + 1]); w2[j] = cvtpk(p1[2 * j], p1[2 * j + 1]); w3[j] = cvtpk(p1[8 + 2 * j], p1[8 + 2 * j + 1]); }
            pv(o, vb0 + slot * SLOTB, __builtin_bit_cast(bf16x8, w0), __builtin_bit_cast(bf16x8, w1), __builtin_bit_cast(bf16x8, w2), __builtin_bit_cast(bf16x8, w3));
        }
        slot = slot == 2 ? 0 : slot + 1;
    }
    lsum += other_half(lsum, hi);
    if (hi == 0) { wsf[32 + r32] = lsum;
        const long tok = rowbase + clsw + (long)(qi0w + r32) * dil;
        *(f32x2*)(ST + ((size_t)g * M * NH + (size_t)tok * NH + h) * 2) = (f32x2){mref, lsum}; }
    asm volatile("s_waitcnt lgkmcnt(0)" ::: "memory");
    float rli[16];
#pragma unroll
    for (int r = 0; r < 16; ++r) rli[r] = __builtin_amdgcn_rcpf(wsf[32 + crow(r, hi)]);
    store_o(o, rli, shm + L_OST + wid * 4096, OG + (size_t)g * PLANE + (rowbase + clsw + (long)qi0w * dil) * DM + h * 64, dpitch, lane, r32, hi);
    asm volatile("s_waitcnt lgkmcnt(0)\n\ts_barrier" ::: "memory");
#undef ATT_DMA
#undef DIL_TCLS
#undef DIL_KB
}
__device__ __forceinline__ int t5_bucket_f(int dist) {
    if (dist < 16) return dist;
    int lb = 16 + (int)(logf((float)dist / 16.0f) / logf(128.0f) * 16.0f);
    return lb < 31 ? lb : 31;
}
__device__ __forceinline__ void dil_phase(lptr shm, int G, const bf16* PROJ, bf16* OG, float* ST, const float* rel_bias) {
    const int bx = blockIdx.x; const int vcu = (G % 8 == 0) ? (bx % 8) * (G / 8) + bx / 8 : bx;
    for (int u = vcu; u < BATCH * NH * 2; u += G) {
        const int bh = u >> 1, p = u & 1, b = bh >> 4, h = bh & 15;
        LAS float* tb = (LAS float*)(shm + L_TBL);
        for (int i = threadIdx.x; i < 3 * 640; i += NTHR) { const int gg = i / 640, dl = i - gg * 640 - 256; const int dil = (gg == 0) ? 1 : (gg == 1) ? 4 : 16;
            tb[i] = (dl >= 0 && dl <= 128) ? rel_bias[t5_bucket_f(dl * dil) * 16 + h] * LOG2E : -INFINITY; }
#pragma unroll 1
        for (int j = 0; j < 24; ++j) {
            const int g = j >> 3, x = j & 7;
            const int par = (g == 1) ? ((x >> 1) & 1) : (x & 1);
            if (par != p) continue;
            dil_unit(shm, b, h, g, x, PROJ, OG, ST);
        }
    }
}
__device__ __forceinline__ void dil_merge(int G, const bf16* OG, const float* ST, bf16* O) {
    for (int idx = blockIdx.x * NTHR + threadIdx.x; idx < M * NH; idx += G * NTHR) {
        const f32x2 s0 = *(const f32x2*)(ST + ((size_t)0 * M * NH + idx) * 2), s1 = *(const f32x2*)(ST + ((size_t)1 * M * NH + idx) * 2), s2 = *(const f32x2*)(ST + ((size_t)2 * M * NH + idx) * 2);
        const float mx = fmaxf(s0.x, fmaxf(s1.x, s2.x));
        float w0 = __builtin_amdgcn_exp2f(s0.x - mx) * s0.y, w1 = __builtin_amdgcn_exp2f(s1.x - mx) * s1.y, w2 = __builtin_amdgcn_exp2f(s2.x - mx) * s2.y;
        const float inv = 1.0f / (w0 + w1 + w2); w0 *= inv; w1 *= inv; w2 *= inv;
        const GAS v4u* a0 = (const GAS v4u*)(OG + (size_t)idx * 64); const GAS v4u* a1 = (const GAS v4u*)(OG + PLANE + (size_t)idx * 64); const GAS v4u* a2 = (const GAS v4u*)(OG + 2 * PLANE + (size_t)idx * 64);
        GAS v4u* op = (GAS v4u*)(O + (size_t)idx * 64);
#pragma unroll
        for (int c = 0; c < 8; ++c) { const v4u x0 = a0[c], x1 = a1[c], x2 = a2[c]; v4u r;
#pragma unroll
            for (int q = 0; q < 4; ++q) r[q] = pk2(w0 * bflo(x0[q]) + w1 * bflo(x1[q]) + w2 * bflo(x2[q]), w0 * bfhi(x0[q]) + w1 * bfhi(x1[q]) + w2 * bfhi(x2[q]));
            op[c] = r; }
    }
}

template <int MODE>
__device__ __forceinline__ void causal_phase(lptr shm, int G, const bf16* Q, const bf16* K, const bf16* V, bf16* O, const float* cum) {
    const int bx = blockIdx.x; const int vcu = (G % 8 == 0) ? (bx % 8) * (G / 8) + bx / 8 : bx;
    for (int u = vcu; u < BATCH * NH * 2; u += G) {
        const int bh = u >> 1, p = u & 1, b = bh >> 4, h = bh & 15;
#pragma unroll 1
        for (int i = 0; i < 4; ++i) {
            const int qb = (i == 0) ? 7 - p : (i == 1) ? 5 - p : (i == 2) ? 2 + p : p;
            if (MODE == 0) sb_unit(shm, b, h, qb, Q, K, V, O); else fox_unit(shm, b, h, qb, Q, K, V, O, cum);
        }
    }
}
}

enum { CV_PLAIN = 0, CV_QKN = 1, CV_GATE = 2, CV_UP = 3 };
__device__ __forceinline__ int cv_dst_row(int mode, int n) {
    if (mode == CV_QKN) return (n & ~255) + 128 * ((n >> 5) & 1) + 32 * ((n >> 6) & 3) + (n & 31);
    if (mode == CV_GATE) return 256 * (n >> 7) + (n & 127);
    if (mode == CV_UP) return 256 * (n >> 7) + 128 + (n & 127);
    return n;
}
__device__ __forceinline__ void conv_item(const float* W, int ldw, int K, bf16* WT, int mode, LAS unsigned char* scr, int item, int nblk, int lane) {
    const int kb = item / nblk, nb = item - kb * nblk, k0 = 64 * kb, n0 = 64 * nb;
    const GAS float* src = (const GAS float*)(W + (size_t)k0 * ldw + n0 + lane);
#pragma unroll
    for (int kc = 0; kc < 8; ++kc) {
        float v[8];
#pragma unroll
        for (int j = 0; j < 8; ++j) v[j] = src[(size_t)(kc * 8 + j) * ldw];
        v4u w; w.x = pk2(v[0], v[1]); w.y = pk2(v[2], v[3]); w.z = pk2(v[4], v[5]); w.w = pk2(v[6], v[7]);
        *(LAS v4u*)(scr + lane * 144 + kc * 16) = w;
    }
    asm volatile("s_waitcnt lgkmcnt(0)" ::: "memory");
#pragma unroll
    for (int j = 0; j < 8; ++j) { const int n = 8 * j + (lane >> 3), ch = lane & 7;
        const v4u w = *(const LAS v4u*)(scr + n * 144 + ch * 16);
        *(GAS v4u*)(WT + (size_t)cv_dst_row(mode, n0 + n) * K + k0 + 8 * ch) = w; }
    asm volatile("s_waitcnt lgkmcnt(0)" ::: "memory");
}
__device__ __forceinline__ void conv_job(Frame& F, const float* W, int ldw, int K, int N, bf16* WT, int mode, int& rot) {
    LAS unsigned char* scr = F.lds + F.wave * 9216;
    const int nblk = N / 64, nitems = (K / 64) * nblk, NGW = F.G * NWAVES, gw = blockIdx.x * NWAVES + F.wave;
    int first = gw - (rot % NGW); if (first < 0) first += NGW;
    for (int it = first; it < nitems; it += NGW) conv_item(W, ldw, K, WT, mode, scr, it, nblk, F.lane);
    rot += nitems;
}
__device__ __forceinline__ void convert_weights(Frame& F) {
    bf16* WB = (bf16*)(F.ws + WS_W); int rot = 0;
    for (int j = 0; j < 2; ++j) conv_job(F, INP(1) + (size_t)j * DM * 3 * DM, 3 * DM, DM, 3 * DM, WB + WE_QKV + (size_t)j * 3 * DM * DM, CV_PLAIN, rot);
    for (int j = 0; j < 2; ++j) conv_job(F, INP(2) + (size_t)j * DM * DM, DM, DM, DM, WB + WE_WO_SB + (size_t)j * DM * DM, CV_PLAIN, rot);
    conv_job(F, INP(3), 7 * DM, DM, 7 * DM, WB + WE_IN_DIL, CV_QKN, rot);
    conv_job(F, INP(6), DM, DM, DM, WB + WE_WO_DIL, CV_PLAIN, rot);
    conv_job(F, INP(7), 3088, DM, 3 * DM, WB + WE_IN_FOX, CV_QKN, rot);
    conv_job(F, INP(11), DM, DM, DM, WB + WE_WO_FOX, CV_PLAIN, rot);
    for (int f = 0; f < 2; ++f) {
        conv_job(F, INP(15) + (size_t)f * DM * FF, FF, DM, FF, WB + WE_GU + (size_t)f * 2 * FF * DM, CV_GATE, rot);
        conv_job(F, INP(16) + (size_t)f * DM * FF, FF, DM, FF, WB + WE_GU + (size_t)f * 2 * FF * DM, CV_UP, rot);
        conv_job(F, INP(17) + (size_t)f * FF * DM, DM, FF, DM, WB + WE_D + (size_t)f * DM * FF, CV_PLAIN, rot);
    }
    for (int fe = 0; fe < 16; ++fe) {
        conv_job(F, INP(19) + (size_t)fe * DM * FF, FF, DM, FF, WB + WE_MGU + (size_t)fe * 2 * FF * DM, CV_GATE, rot);
        conv_job(F, INP(20) + (size_t)fe * DM * FF, FF, DM, FF, WB + WE_MGU + (size_t)fe * 2 * FF * DM, CV_UP, rot);
        conv_job(F, INP(21) + (size_t)fe * FF * DM, DM, FF, DM, WB + WE_MD + (size_t)fe * DM * FF, CV_PLAIN, rot);
    }
}

__device__ __forceinline__ void moe_bases(Frame& F, int f, int (&tb)[NE + 1]) {
    int acc = 0;
#pragma unroll
    for (int e = 0; e < NE; ++e) { tb[e] = acc; const int c = (int)__hip_atomic_load(F.ctl + CW_CNT + f * 64 + e, RLX_AGENT); acc += (c + 255) >> 8; }
    tb[NE] = acc;
}

template <int FLAGS>
__device__ __forceinline__ void norm_phase(Frame& F, const float* xin, float* xout, const float* gain, bf16* H, int fprev, int f,
                                           const float* Wf  , const float* bf  , const float* Wr  ) {
    const float* Y = (const float*)(F.ws + WS_R2);
    const int* tok_prev = (const int*)(F.ws + WS_MISC + MS_TOK) + (size_t)fprev * M * 2;
    float* lgf = (float*)(F.ws + WS_MISC + MS_LOGF);
    LAS int* sel = (LAS int*)F.lds;
    LAS float* sg = (LAS float*)(F.lds + 512);
    LAS int* lpos = (LAS int*)(F.lds + 1024);
    LAS int* gb = (LAS int*)(F.lds + 1536);
    int tb[NE + 1];
    if (FLAGS & 1) moe_bases(F, fprev, tb);
    for (int chunk = blockIdx.x; chunk < M / 64; chunk += F.G) {
        for (int i = 0; i < 8; ++i) {
            const int m = chunk * 64 + F.wave * 8 + i;
            const GAS f32x4* xr = (const GAS f32x4*)(xin + (size_t)m * DM) + F.lane;
            f32x4 v[4];
#pragma unroll
            for (int j = 0; j < 4; ++j) v[j] = xr[64 * j];
            if (FLAGS & 1) {
                const int s0 = tok_prev[m * 2], s1 = tok_prev[m * 2 + 1];
                int r0 = 0, r1 = 0;
#pragma unroll
                for (int e = 0; e < NE; ++e) { if ((s0 >> 14) == e) r0 = tb[e] * 256 + (s0 & 16383); if ((s1 >> 14) == e) r1 = tb[e] * 256 + (s1 & 16383); }
                const GAS f32x4* y0 = (const GAS f32x4*)(Y + (size_t)r0 * DM) + F.lane;
                const GAS f32x4* y1 = (const GAS f32x4*)(Y + (size_t)r1 * DM) + F.lane;
#pragma unroll
                for (int j = 0; j < 4; ++j) { v[j] = v[j] + y0[64 * j] + y1[64 * j]; ((GAS f32x4*)(xout + (size_t)m * DM) + F.lane)[64 * j] = v[j]; }
            }
            float s = 0.f;
#pragma unroll
            for (int j = 0; j < 4; ++j) s += (v[j].x * v[j].x + v[j].y * v[j].y) + (v[j].z * v[j].z + v[j].w * v[j].w);
            const float inv = 1.0f / sqrtf(wave_sum(s) * (1.f / DM) + RMS_EPS);
#pragma unroll
            for (int j = 0; j < 4; ++j) { const f32x4 g = ((const GAS f32x4*)gain + F.lane)[64 * j]; v[j] = v[j] * inv * g; }
            if (H) {
                GAS unsigned long long* o8 = (GAS unsigned long long*)(H + (size_t)m * DM) + F.lane;
#pragma unroll
                for (int j = 0; j < 4; ++j) o8[64 * j] = (unsigned long long)pk2(v[j].x, v[j].y) | ((unsigned long long)pk2(v[j].z, v[j].w) << 32);
            }
            if (FLAGS & 2) {
                float part[16];
#pragma unroll
                for (int c = 0; c < 16; ++c) part[c] = 0.f;
#pragma unroll
                for (int j = 0; j < 4; ++j)
#pragma unroll
                    for (int q = 0; q < 4; ++q) { const int k = 4 * (F.lane + 64 * j) + q; const float hv = v[j][q];
                        const GAS f32x4* wr = (const GAS f32x4*)(Wf + (size_t)k * 3088 + 3072);
#pragma unroll
                        for (int c4 = 0; c4 < 4; ++c4) { const f32x4 w = wr[c4]; part[c4 * 4 + 0] += hv * w.x; part[c4 * 4 + 1] += hv * w.y; part[c4 * 4 + 2] += hv * w.z; part[c4 * 4 + 3] += hv * w.w; } }
                float mine = 0.f;
#pragma unroll
                for (int c = 0; c < 16; ++c) { const float t = wave_sum(part[c]); if (F.lane == c) mine = t; }
                if (F.lane < 16) { const float z = mine + bf[F.lane];
                    const float ls = fminf(z, 0.f) - log1pf(expf(-fabsf(z))); lgf[(size_t)m * 16 + F.lane] = ls * LOG2E; }
            }
            if (FLAGS & 4) {
                float part[8];
#pragma unroll
                for (int c = 0; c < 8; ++c) part[c] = 0.f;
#pragma unroll
                for (int j = 0; j < 4; ++j)
#pragma unroll
                    for (int q = 0; q < 4; ++q) { const int k = 4 * (F.lane + 64 * j) + q; const float hv = v[j][q];
                        const GAS f32x4* wr = (const GAS f32x4*)(Wr + (size_t)k * 8);
                        const f32x4 w0 = wr[0], w1 = wr[1];
                        part[0] += hv * w0.x; part[1] += hv * w0.y; part[2] += hv * w0.z; part[3] += hv * w0.w;
                        part[4] += hv * w1.x; part[5] += hv * w1.y; part[6] += hv * w1.z; part[7] += hv * w1.w; }
                float lg[8];
#pragma unroll
                for (int c = 0; c < 8; ++c) lg[c] = wave_sum(part[c]);
                int e0 = 0; float l0 = lg[0];
#pragma unroll
                for (int c = 1; c < 8; ++c) if (lg[c] > l0) { l0 = lg[c]; e0 = c; }
                int e1 = -1; float l1 = -INFINITY;
#pragma unroll
                for (int c = 0; c < 8; ++c) if (c != e0 && lg[c] > l1) { l1 = lg[c]; e1 = c; }
                const float g0 = 1.0f / (1.0f + expf(l1 - l0)), g1 = 1.0f - g0;
                if (F.lane == 0) { const int r = F.wave * 8 + i; sel[r * 2] = e0; sel[r * 2 + 1] = e1; sg[r * 2] = g0; sg[r * 2 + 1] = g1; }
            }
        }
        if (FLAGS & 4) {
            int* list = (int*)(F.ws + WS_MISC + MS_LIST) + (size_t)f * NE * LCAP;
            float* gw = (float*)(F.ws + WS_MISC + MS_GW) + (size_t)f * NE * LCAP;
            int* tok = (int*)(F.ws + WS_MISC + MS_TOK) + (size_t)f * M * 2;
            __syncthreads();
            if (F.tid == 0) {
                int lc[8];
#pragma unroll
                for (int e = 0; e < 8; ++e) lc[e] = 0;
                for (int q = 0; q < 128; ++q) { const int e = sel[q]; int p = 0;
#pragma unroll
                    for (int c = 0; c < 8; ++c) if (c == e) { p = lc[c]; lc[c] = p + 1; }
                    lpos[q] = p; }
#pragma unroll
                for (int e = 0; e < 8; ++e) gb[e] = (int)__hip_atomic_fetch_add(F.ctl + CW_CNT + f * 64 + e, (unsigned)lc[e], RLX_AGENT);
            }
            __syncthreads();
            if (F.tid < 128) { const int q = F.tid, row = chunk * 64 + (q >> 1), e = sel[q], pos = gb[e] + lpos[q];
                list[e * LCAP + pos] = row; gw[e * LCAP + pos] = sg[q]; tok[row * 2 + (q & 1)] = e * LCAP + pos; }
            __syncthreads();
        }
    }
}

__device__ __forceinline__ void final_combine(Frame& F, int f) {
    const float* Y = (const float*)(F.ws + WS_R2);
    const int* tok = (const int*)(F.ws + WS_MISC + MS_TOK) + (size_t)f * M * 2;
    int tb[NE + 1]; moe_bases(F, f, tb);
    for (int m = blockIdx.x * NWAVES + F.wave; m < M; m += F.G * NWAVES) {
        const int s0 = tok[m * 2], s1 = tok[m * 2 + 1]; int r0 = 0, r1 = 0;
#pragma unroll
        for (int e = 0; e < NE; ++e) { if ((s0 >> 14) == e) r0 = tb[e] * 256 + (s0 & 16383); if ((s1 >> 14) == e) r1 = tb[e] * 256 + (s1 & 16383); }
        GAS f32x4* xr = (GAS f32x4*)(F.out + (size_t)m * DM) + F.lane;
        const GAS f32x4* y0 = (const GAS f32x4*)(Y + (size_t)r0 * DM) + F.lane;
        const GAS f32x4* y1 = (const GAS f32x4*)(Y + (size_t)r1 * DM) + F.lane;
#pragma unroll
        for (int j = 0; j < 4; ++j) xr[64 * j] = xr[64 * j] + y0[64 * j] + y1[64 * j];
    }
}

__device__ __forceinline__ void cumsum_phase(Frame& F) {
    const float* logf = (const float*)(F.ws + WS_MISC + MS_LOGF);
    float* cum = (float*)(F.ws + WS_MISC + MS_CUM);
    const int gw = blockIdx.x * NWAVES + F.wave;
    if (gw < BATCH * NH) {
        const int b = gw >> 4, h = gw & 15;
        float v[32]; float s = 0.f;
#pragma unroll
        for (int i = 0; i < 32; ++i) { v[i] = logf[((size_t)b * SEQ + F.lane * 32 + i) * 16 + h]; s += v[i]; }
        float incl = s;
#pragma unroll
        for (int o = 1; o < 64; o <<= 1) { const float t = __shfl_up(incl, o); if (F.lane >= o) incl += t; }
        float run = incl - s;
#pragma unroll
        for (int i = 0; i < 32; ++i) { run += v[i]; cum[((size_t)b * SEQ + F.lane * 32 + i) * 16 + h] = run; }
    }
}

enum { EPI_PLANES = 0, EPI_RESID = 1, EPI_SWIGLU = 2, EPI_MOEDOWN = 3 };
struct SgP { const bf16* A; int lda; const int* rowidx; int Mrows; const float* W0; const float* W1; int ldw; int K; int N;
             bf16* outb; int ldo; float scale0; const float* base; float* outf; const float* gwv; };
template <int EPI>
__device__ __forceinline__ void sgemm(Frame& F, const SgP& p) {
    LAS float* As = (LAS float*)F.lds;
    LAS float* Bs0 = As + 16 * 132;
    LAS float* Bs1 = Bs0 + 16 * 128;
    const int tid = F.tid, ty = tid >> 4, tx = tid & 15;
    const int lrow = tid >> 2, lkq = (tid & 3) * 4;
    const int bk = tid >> 5, bn = (tid & 31) * 4;
    const int ntn = p.N / 128, ntiles = (p.Mrows / 128) * ntn;
    for (int tile = blockIdx.x; tile < ntiles; tile += F.G) {
        const int tm = tile / ntn, tn = tile % ntn;
        const int arow = p.rowidx ? p.rowidx[tm * 128 + lrow] : tm * 128 + lrow;
        const bf16* ap = p.A + (size_t)arow * p.lda + lkq;
        const float* bp0 = p.W0 + (size_t)bk * p.ldw + tn * 128 + bn;
        const float* bp1 = (EPI == EPI_SWIGLU) ? p.W1 + (size_t)bk * p.ldw + tn * 128 + bn : nullptr;
        f32x2 acc0[4][4], acc1[4][4];
#pragma unroll
        for (int i = 0; i < 4; ++i)
#pragma unroll
            for (int j = 0; j < 4; ++j) { acc0[i][j] = (f32x2){0.f, 0.f}; acc1[i][j] = (f32x2){0.f, 0.f}; }
        for (int k0 = 0; k0 < p.K; k0 += 16) {
            const v2u av = *(const GAS v2u*)(ap + k0);
            const f32x4 b0 = *(const GAS f32x4*)(bp0 + (size_t)k0 * p.ldw);
            f32x4 b1 = (f32x4){0.f, 0.f, 0.f, 0.f};
            if (EPI == EPI_SWIGLU) b1 = *(const GAS f32x4*)(bp1 + (size_t)k0 * p.ldw);
            __syncthreads();
            As[(lkq + 0) * 132 + lrow] = bflo(av.x); As[(lkq + 1) * 132 + lrow] = bfhi(av.x);
            As[(lkq + 2) * 132 + lrow] = bflo(av.y); As[(lkq + 3) * 132 + lrow] = bfhi(av.y);
            *(LAS f32x4*)(Bs0 + bk * 128 + bn) = b0;
            if (EPI == EPI_SWIGLU) *(LAS f32x4*)(Bs1 + bk * 128 + bn) = b1;
            __syncthreads();
#pragma unroll 2
            for (int k = 0; k < 16; ++k) {
                const f32x4 a = *(const LAS f32x4*)(As + k * 132 + ty * 4);
                const f32x4 bA = *(const LAS f32x4*)(Bs0 + k * 128 + tx * 8), bB = *(const LAS f32x4*)(Bs0 + k * 128 + tx * 8 + 4);
                const f32x2 bv[4] = {(f32x2){bA.x, bA.y}, (f32x2){bA.z, bA.w}, (f32x2){bB.x, bB.y}, (f32x2){bB.z, bB.w}};
#pragma unroll
                for (int i = 0; i < 4; ++i) {
#pragma unroll
                    for (int j = 0; j < 4; ++j) acc0[i][j] += a[i] * bv[j]; }
                if (EPI == EPI_SWIGLU) {
                    const f32x4 cA = *(const LAS f32x4*)(Bs1 + k * 128 + tx * 8), cB = *(const LAS f32x4*)(Bs1 + k * 128 + tx * 8 + 4);
                    const f32x2 cv[4] = {(f32x2){cA.x, cA.y}, (f32x2){cA.z, cA.w}, (f32x2){cB.x, cB.y}, (f32x2){cB.z, cB.w}};
#pragma unroll
                    for (int i = 0; i < 4; ++i) {
#pragma unroll
                        for (int j = 0; j < 4; ++j) acc1[i][j] += a[i] * cv[j]; }
                }
                __builtin_amdgcn_sched_barrier(0);
            }
        }
        const int c0 = tn * 128 + tx * 8;
#pragma unroll
        for (int i = 0; i < 4; ++i) {
            const int r = tm * 128 + ty * 4 + i;
            if (EPI == EPI_PLANES) {
                const int pl = c0 >> 10, cc = c0 & 1023; const float sc = (pl == 0) ? p.scale0 : 1.f;
                v4u w; w.x = pk2(acc0[i][0].x * sc, acc0[i][0].y * sc); w.y = pk2(acc0[i][1].x * sc, acc0[i][1].y * sc); w.z = pk2(acc0[i][2].x * sc, acc0[i][2].y * sc); w.w = pk2(acc0[i][3].x * sc, acc0[i][3].y * sc);
                *(GAS v4u*)(p.outb + (size_t)pl * PLANE + (size_t)r * DM + cc) = w;
            } else if (EPI == EPI_RESID) {
                const GAS f32x4* bp = (const GAS f32x4*)(p.base + (size_t)r * DM + c0); GAS f32x4* op = (GAS f32x4*)(p.outf + (size_t)r * DM + c0);
                const f32x4 x0 = bp[0], x1 = bp[1];
                op[0] = x0 + (f32x4){acc0[i][0].x, acc0[i][0].y, acc0[i][1].x, acc0[i][1].y}; op[1] = x1 + (f32x4){acc0[i][2].x, acc0[i][2].y, acc0[i][3].x, acc0[i][3].y};
            } else if (EPI == EPI_SWIGLU) {
                float o[8];
#pragma unroll
                for (int j = 0; j < 8; ++j) { const float g = acc0[i][j >> 1][j & 1], uu = acc1[i][j >> 1][j & 1]; o[j] = g / (1.0f + __expf(-g)) * uu; }
                v4u w; w.x = pk2(o[0], o[1]); w.y = pk2(o[2], o[3]); w.z = pk2(o[4], o[5]); w.w = pk2(o[6], o[7]);
                *(GAS v4u*)(p.outb + (size_t)r * p.ldo + c0) = w;
            } else {
                const float g = p.gwv[r]; GAS f32x4* op = (GAS f32x4*)(p.outf + (size_t)r * DM + c0);
                op[0] = (f32x4){acc0[i][0].x * g, acc0[i][0].y * g, acc0[i][1].x * g, acc0[i][1].y * g}; op[1] = (f32x4){acc0[i][2].x * g, acc0[i][2].y * g, acc0[i][3].x * g, acc0[i][3].y * g};
            }
        }
    }
}

__device__ __forceinline__ void qknorm_plane(Frame& F, bf16* plane, const float* gain, float mul) {
    const int nth = F.G * NTHR;
    for (int idx = blockIdx.x * NTHR + F.tid; idx < M * NH; idx += nth) {
        GAS v4u* p = (GAS v4u*)(plane + (size_t)idx * 64);
        v4u w[8]; float ss = 0.f;
#pragma unroll
        for (int c = 0; c < 8; ++c) { w[c] = p[c];
#pragma unroll
            for (int q = 0; q < 4; ++q) { const float a = bflo(w[c][q]), b = bfhi(w[c][q]); ss += a * a + b * b; } }
        const float inv = 1.0f / sqrtf(ss * (1.f / 64.f) + RMS_EPS) * mul;
#pragma unroll
        for (int c = 0; c < 8; ++c) { v4u o;
#pragma unroll
            for (int q = 0; q < 4; ++q) { const float a = bflo(w[c][q]) * inv * gain[c * 8 + 2 * q], b = bfhi(w[c][q]) * inv * gain[c * 8 + 2 * q + 1]; o[q] = pk2(a, b); }
            p[c] = o; }
    }
}

template <int MODE>
__device__ __forceinline__ void attn_simple_causal(Frame& F, const bf16* Qp, const bf16* Kp, const bf16* Vp, bf16* O, const float* cum) {
    LAS float* Ks = (LAS float*)F.lds;
    LAS float* Vs = Ks + 4096;
    LAS float* kb = Vs + 4096;
    for (int u = blockIdx.x; u < BATCH * NH * 4; u += F.G) {
        const int qblk = (u & 1) ? 3 - ((u >> 1) & 1) : ((u >> 1) & 1) * 1;
        const int bh = u >> 2, b = bh >> 4, h = bh & 15;
        const int t = qblk * 512 + F.tid;
        const size_t rowbase = (size_t)b * SEQ;
        float q[64], acc[64];
        { const GAS v4u* qp = (const GAS v4u*)(Qp + (rowbase + t) * DM + h * 64);
#pragma unroll
          for (int c = 0; c < 8; ++c) { const v4u w = qp[c];
#pragma unroll
              for (int k = 0; k < 4; ++k) { q[c * 8 + 2 * k] = bflo(w[k]); q[c * 8 + 2 * k + 1] = bfhi(w[k]); } } }
#pragma unroll
        for (int d = 0; d < 64; ++d) acc[d] = 0.f;
        float P = 1.f, mrun = -INFINITY, lrun = 0.f;
        const int ntile = 8 * (qblk + 1);
        for (int it = 0; it < ntile; ++it) {
            const int tile = (MODE == 0) ? ntile - 1 - it : it;
            __syncthreads();
            { const int key = F.tid >> 3, ch = F.tid & 7;
              const v4u kw = *(const GAS v4u*)(Kp + (rowbase + tile * 64 + key) * DM + h * 64 + ch * 8);
              const v4u vw = *(const GAS v4u*)(Vp + (rowbase + tile * 64 + key) * DM + h * 64 + ch * 8);
#pragma unroll
              for (int k = 0; k < 4; ++k) { Ks[key * 64 + ch * 8 + 2 * k] = bflo(kw[k]); Ks[key * 64 + ch * 8 + 2 * k + 1] = bfhi(kw[k]);
                                            Vs[key * 64 + ch * 8 + 2 * k] = bflo(vw[k]); Vs[key * 64 + ch * 8 + 2 * k + 1] = bfhi(vw[k]); }
              if (MODE == 2 && F.tid < 64) kb[F.tid] = -cum[(rowbase + tile * 64 + F.tid) * 16 + h]; }
            __syncthreads();
            for (int jj = 0; jj < 64; ++jj) {
                const int j = (MODE == 0) ? 63 - jj : jj; const int s = tile * 64 + j;
                float z = 0.f;
#pragma unroll
                for (int d4 = 0; d4 < 16; ++d4) { const f32x4 kv = *(const LAS f32x4*)(Ks + j * 64 + d4 * 4); z += q[d4 * 4] * kv.x + q[d4 * 4 + 1] * kv.y + q[d4 * 4 + 2] * kv.z + q[d4 * 4 + 3] * kv.w; }
                if (MODE == 0) {
                    const bool valid = s < t;
                    const float e = __builtin_amdgcn_exp2f(fminf(z, 100.f));
                    float r = 1.0f / (1.0f + e); float beta = 1.0f - r;
                    if (!valid) { r = 1.f; beta = 0.f; }
                    const float w = beta * P; P *= r;
#pragma unroll
                    for (int d4 = 0; d4 < 16; ++d4) { const f32x4 vv = *(const LAS f32x4*)(Vs + j * 64 + d4 * 4); acc[d4 * 4] += w * vv.x; acc[d4 * 4 + 1] += w * vv.y; acc[d4 * 4 + 2] += w * vv.z; acc[d4 * 4 + 3] += w * vv.w; }
                } else {
                    const bool valid = s <= t;
                    const float x = valid ? z + kb[j] : -INFINITY;
                    const float mn = fmaxf(mrun, x);
                    const float a = __builtin_amdgcn_exp2f(mrun - mn), pw = __builtin_amdgcn_exp2f(x - mn);
                    lrun = lrun * a + pw; mrun = mn;
#pragma unroll
                    for (int d4 = 0; d4 < 16; ++d4) { const f32x4 vv = *(const LAS f32x4*)(Vs + j * 64 + d4 * 4);
                        acc[d4 * 4] = acc[d4 * 4] * a + pw * vv.x; acc[d4 * 4 + 1] = acc[d4 * 4 + 1] * a + pw * vv.y; acc[d4 * 4 + 2] = acc[d4 * 4 + 2] * a + pw * vv.z; acc[d4 * 4 + 3] = acc[d4 * 4 + 3] * a + pw * vv.w; }
                }
            }
        }
        const float fin = (MODE == 0) ? 1.f : 1.0f / lrun;
        GAS v4u* op = (GAS v4u*)(O + (rowbase + t) * DM + h * 64);
#pragma unroll
        for (int c = 0; c < 8; ++c) { v4u w;
#pragma unroll
            for (int k = 0; k < 4; ++k) w[k] = pk2(acc[c * 8 + 2 * k] * fin, acc[c * 8 + 2 * k + 1] * fin);
            op[c] = w; }
    }
}

__device__ __forceinline__ int t5_bucket(int dist) {
    if (dist < 16) return dist;
    const float d = (float)dist;
    int lb = 16 + (int)(logf(d / 16.0f) / logf(128.0f) * 16.0f);
    return lb < 31 ? lb : 31;
}
__device__ __forceinline__ void attn_simple_dil(Frame& F, const bf16* PROJ, bf16* O, const float* rel_bias) {
    LAS float* tbl = (LAS float*)F.lds;
    for (int u = blockIdx.x; u < BATCH * NH * 4; u += F.G) {
        const int qblk = u & 3, bh = u >> 2, b = bh >> 4, h = bh & 15;
        const int t = qblk * 512 + F.tid;
        const size_t rowbase = (size_t)b * SEQ;
        __syncthreads();
        for (int i = F.tid; i < 3 * 129; i += NTHR) { const int g = i / 129, dl = i % 129, dil = (g == 0) ? 1 : (g == 1) ? 4 : 16;
            tbl[g * 132 + dl] = rel_bias[t5_bucket(dl * dil) * 16 + h] * LOG2E; }
        __syncthreads();
        float acc[64];
#pragma unroll
        for (int d = 0; d < 64; ++d) acc[d] = 0.f;
        float mrun = -INFINITY, lrun = 0.f;
        for (int g = 0; g < 3; ++g) {
            const int dil = (g == 0) ? 1 : (g == 1) ? 4 : 16;
            const bf16* Qg = PROJ + (size_t)(2 * g) * PLANE; const bf16* Kg = PROJ + (size_t)(2 * g + 1) * PLANE; const bf16* Vg = PROJ + (size_t)6 * PLANE;
            float q[64];
            { const GAS v4u* qp = (const GAS v4u*)(Qg + (rowbase + t) * DM + h * 64);
#pragma unroll
              for (int c = 0; c < 8; ++c) { const v4u w = qp[c];
#pragma unroll
                  for (int k = 0; k < 4; ++k) { q[c * 8 + 2 * k] = bflo(w[k]); q[c * 8 + 2 * k + 1] = bfhi(w[k]); } } }
            for (int dl = 0; dl <= 128; ++dl) {
                const int s = t - dl * dil; const bool valid = s >= 0; const int sc = valid ? s : 0;
                const GAS v4u* kp = (const GAS v4u*)(Kg + (rowbase + sc) * DM + h * 64);
                float z = 0.f;
#pragma unroll
                for (int c = 0; c < 8; ++c) { const v4u w = kp[c];
#pragma unroll
                    for (int k = 0; k < 4; ++k) z += q[c * 8 + 2 * k] * bflo(w[k]) + q[c * 8 + 2 * k + 1] * bfhi(w[k]); }
                const float x = valid ? z + tbl[g * 132 + dl] : -INFINITY;
                const float mn = fmaxf(mrun, x);
                const float a = __builtin_amdgcn_exp2f(mrun - mn), pw = __builtin_amdgcn_exp2f(x - mn);
                lrun = lrun * a + pw; mrun = mn;
                const GAS v4u* vp = (const GAS v4u*)(Vg + (rowbase + sc) * DM + h * 64);
#pragma unroll
                for (int c = 0; c < 8; ++c) { const v4u w = vp[c];
#pragma unroll
                    for (int k = 0; k < 4; ++k) { acc[c * 8 + 2 * k] = acc[c * 8 + 2 * k] * a + pw * bflo(w[k]); acc[c * 8 + 2 * k + 1] = acc[c * 8 + 2 * k + 1] * a + pw * bfhi(w[k]); } }
            }
        }
        const float fin = 1.0f / lrun;
        GAS v4u* op = (GAS v4u*)(O + (rowbase + t) * DM + h * 64);
#pragma unroll
        for (int c = 0; c < 8; ++c) { v4u w;
#pragma unroll
            for (int k = 0; k < 4; ++k) w[k] = pk2(acc[c * 8 + 2 * k] * fin, acc[c * 8 + 2 * k + 1] * fin);
            op[c] = w; }
    }
}

__device__ __forceinline__ void moe_gu_simple(Frame& F, int f, const bf16* H, bf16* ACT) {
    const int* list = (const int*)(F.ws + WS_MISC + MS_LIST) + (size_t)f * NE * LCAP;
    int base = 0;
    for (int e = 0; e < NE; ++e) {
        const int c = (int)__hip_atomic_load(F.ctl + CW_CNT + f * 64 + e, RLX_AGENT); const int nt = (c + 255) >> 8;
        if (nt) {
            SgP p{}; p.A = H; p.lda = DM; p.rowidx = list + e * LCAP; p.Mrows = nt * 256;
            p.W0 = INP(19) + ((size_t)f * NE + e) * DM * FF; p.W1 = INP(20) + ((size_t)f * NE + e) * DM * FF; p.ldw = FF; p.K = DM; p.N = FF;
            p.outb = ACT + (size_t)base * 256 * FF; p.ldo = FF;
            sgemm<EPI_SWIGLU>(F, p);
        }
        base += nt;
    }
}
__device__ __forceinline__ void moe_down_simple(Frame& F, int f, const bf16* ACT, float* Y) {
    const float* gw = (const float*)(F.ws + WS_MISC + MS_GW) + (size_t)f * NE * LCAP;
    int base = 0;
    for (int e = 0; e < NE; ++e) {
        const int c = (int)__hip_atomic_load(F.ctl + CW_CNT + f * 64 + e, RLX_AGENT); const int nt = (c + 255) >> 8;
        if (nt) {
            SgP p{}; p.A = ACT + (size_t)base * 256 * FF; p.lda = FF; p.rowidx = nullptr; p.Mrows = nt * 256;
            p.W0 = INP(21) + ((size_t)f * NE + e) * FF * DM; p.ldw = DM; p.K = FF; p.N = DM;
            p.outf = Y + (size_t)base * 256 * DM; p.gwv = gw + e * LCAP;
            sgemm<EPI_MOEDOWN>(F, p);
        }
        base += nt;
    }
}


template <class Epi>
__device__ __forceinline__ void dense_gemm(Frame& F, const bf16* A, const bf16* Bt, int N, int K, const Epi& E) {
    pg8::DenseOrder S; S.init(A, Bt, M, N, K, F.G, (int)blockIdx.x);
    pg8::gemm_phase<Epi, pg8::DenseOrder, false>(F.lds, K, S, E);
}
__device__ __forceinline__ void moe_order_init(Frame& F, int f, pg8::MoeOrder& S) {
    int acc = 0, t[NE];
#pragma unroll
    for (int e = 0; e < NE; ++e) { const int c = (int)__hip_atomic_load(F.ctl + CW_CNT + f * 64 + e, RLX_AGENT); acc += (c + 255) >> 8; t[e] = acc; }
    S.t1 = t[0]; S.t2 = t[1]; S.t3 = t[2]; S.t4 = t[3]; S.t5 = t[4]; S.t6 = t[5]; S.t7 = t[6]; S.t8 = t[7];
    S.G = F.G; S.c = (int)blockIdx.x;
}
__device__ __forceinline__ void moe_gu_fast(Frame& F, int f, const bf16* H, bf16* ACT) {
    pg8::MoeOrder S; moe_order_init(F, f, S);
    S.nN = 2 * FF / 256; S.K = DM; S.A = (const char*)H; S.Bt = (const char*)((const bf16*)(F.ws + WS_W) + WE_MGU + (size_t)f * NE * 2 * FF * DM);
    S.tstepA = (size_t)256 * DM * 2; S.tstepB = (size_t)256 * DM * 2; S.estepB = (size_t)2 * FF * DM * 2;
    S.list = (const int*)(F.ws + WS_MISC + MS_LIST) + (size_t)f * NE * LCAP; S.gather = true;
    pg8::EpiSwiglu E{ACT};
    pg8::gemm_phase<pg8::EpiSwiglu, pg8::MoeOrder, true>(F.lds, DM, S, E);
}
__device__ __forceinline__ void moe_down_fast(Frame& F, int f, const bf16* ACT, float* Y) {
    pg8::MoeOrder S; moe_order_init(F, f, S);
    S.nN = DM / 256; S.K = FF; S.A = (const char*)ACT; S.Bt = (const char*)((const bf16*)(F.ws + WS_W) + WE_MD + (size_t)f * NE * DM * FF);
    S.tstepA = (size_t)256 * FF * 2; S.tstepB = (size_t)256 * FF * 2; S.estepB = (size_t)DM * FF * 2;
    S.list = nullptr; S.gather = false;
    pg8::EpiMoeDown E{Y, (const float*)(F.ws + WS_MISC + MS_GW) + (size_t)f * NE * LCAP};
    pg8::gemm_phase<pg8::EpiMoeDown, pg8::MoeOrder, false>(F.lds, FF, S, E);
}

struct Args { const float* in[22]; float* out; unsigned char* ws; int ph_lo, ph_hi; };
constexpr int N_PHASES = 32;

__global__ void __launch_bounds__(NTHR, 2) trunk_fwd(Args args) {
    extern __shared__ __attribute__((aligned(16))) unsigned char lds[];
    Frame F;
    F.lds = (LAS unsigned char*)lds;
    F.tid = threadIdx.x; F.lane = F.tid & 63; F.wave = __builtin_amdgcn_readfirstlane(F.tid >> 6); F.G = gridDim.x;
    F.ws = args.ws; F.ctl = (gu32*)(args.ws + WS_CTL); F.out = args.out;
    if (F.tid == 0) {
#pragma unroll
        for (int i = 0; i < 22; ++i) ((LAS unsigned long long*)(F.lds + PTR_OFF))[i] = (unsigned long long)args.in[i];
    }
    volatile LAS unsigned* MISC = (volatile LAS unsigned*)(F.lds + MISC_OFF);
    if (F.tid < 32) MISC[F.tid] = 0u;
    __syncthreads();
    XcdBarrier bar; bar.bar = (unsigned*)(F.ctl + CW_BAR); bar.x = 0; bar.st = nullptr;
    const int lo = args.ph_lo, hi = args.ph_hi;
    if (hi - lo > 1) bar = xcd_barrier_post((unsigned*)(F.ctl + CW_BAR), MISC + 8);
#ifndef PHSEL
#define PHSEL 0xFFFFFFFFull
#endif
#define IN(k) (lo <= (k) && (k) < hi && ((PHSEL >> (k)) & 1ull) && relaunder(F))
#define SEAM(k) do { if (IN((k) + 1) && IN(k)) xcd_barrier(bar); } while (0)

    bf16* H = (bf16*)(F.ws + WS_H);
    bf16* PROJ = (bf16*)(F.ws + WS_R1);
    bf16* ACT = (bf16*)(F.ws + WS_R1);
    bf16* O = (bf16*)(F.ws + WS_R2);
    float* Y = (float*)(F.ws + WS_R2);
    bf16* OG = (bf16*)(F.ws + WS_R2 + 32 * MiB);
    float* ST = (float*)(F.ws + WS_R2 + 128 * MiB);
    float* X = F.out;
    const float* cum = (const float*)(F.ws + WS_MISC + MS_CUM);

    const bf16* WB = (const bf16*)(F.ws + WS_W);
    if (IN(0)) {
        unsigned* z = (unsigned*)(F.ws + WS_MISC + MS_LIST);
        for (int i = blockIdx.x * NTHR + F.tid; i < (int)(2 * MiB / 4); i += F.G * NTHR) z[i] = 0u;
        convert_weights(F);
        SEAM(0);
    }
    if (IN(1)) { norm_phase<0>(F, INP(0), nullptr, INP(13) + 0 * DM, H, 0, 0, nullptr, nullptr, nullptr); SEAM(1); }
    if (IN(2)) { pg8::EpiPlanes E{PROJ, C2}; dense_gemm(F, H, WB + WE_QKV, 3 * DM, DM, E); SEAM(2); }
    if (IN(3)) { att::causal_phase<0>((att::lptr)F.lds, F.G, PROJ, PROJ + PLANE, PROJ + 2 * PLANE, O, nullptr); SEAM(3); }
    if (IN(4)) { pg8::EpiResid E{INP(0), X}; dense_gemm(F, O, WB + WE_WO_SB, DM, DM, E); SEAM(4); }
    if (IN(5)) { norm_phase<0>(F, X, nullptr, INP(14) + 0 * DM, H, 0, 0, nullptr, nullptr, nullptr); SEAM(5); }
    if (IN(6)) { pg8::EpiSwiglu E{ACT}; dense_gemm(F, H, WB + WE_GU, 2 * FF, DM, E); SEAM(6); }
    if (IN(7)) { pg8::EpiResid E{X, X}; dense_gemm(F, ACT, WB + WE_D, DM, FF, E); SEAM(7); }
    if (IN(8)) { norm_phase<0>(F, X, nullptr, INP(13) + 1 * DM, H, 0, 0, nullptr, nullptr, nullptr); SEAM(8); }
    if (IN(9)) { pg8::EpiQKNorm E{PROJ, INP(4), INP(5), 6}; dense_gemm(F, H, WB + WE_IN_DIL, 7 * DM, DM, E); SEAM(9); }
    if (IN(10)) { att::dil_phase((att::lptr)F.lds, F.G, PROJ, OG, ST, INP(12)); SEAM(10); }
    if (IN(11)) { att::dil_merge(F.G, OG, ST, O); SEAM(11); }
    if (IN(12)) { pg8::EpiResid E{X, X}; dense_gemm(F, O, WB + WE_WO_DIL, DM, DM, E); SEAM(12); }
    if (IN(13)) { norm_phase<4>(F, X, nullptr, INP(14) + 1 * DM, H, 0, 0, nullptr, nullptr, INP(18) + 0 * DM * NE); SEAM(13); }
    if (IN(14)) { moe_gu_fast(F, 0, H, ACT); SEAM(14); }
    if (IN(15)) { moe_down_fast(F, 0, ACT, Y); SEAM(15); }
    if (IN(16)) { norm_phase<1 | 2>(F, X, X, INP(13) + 2 * DM, H, 0, 0, INP(7), INP(8), nullptr); SEAM(16); }
    if (IN(17)) { cumsum_phase(F); pg8::EpiQKNorm E{PROJ, INP(9), INP(10), 2}; dense_gemm(F, H, WB + WE_IN_FOX, 3 * DM, DM, E); SEAM(17); }
    if (IN(19)) { att::causal_phase<2>((att::lptr)F.lds, F.G, PROJ, PROJ + PLANE, PROJ + 2 * PLANE, O, cum); SEAM(19); }
    if (IN(20)) { pg8::EpiResid E{X, X}; dense_gemm(F, O, WB + WE_WO_FOX, DM, DM, E); SEAM(20); }
    if (IN(21)) { norm_phase<0>(F, X, nullptr, INP(14) + 2 * DM, H, 0, 0, nullptr, nullptr, nullptr); SEAM(21); }
    if (IN(22)) { pg8::EpiSwiglu E{ACT}; dense_gemm(F, H, WB + WE_GU + (size_t)2 * FF * DM, 2 * FF, DM, E); SEAM(22); }
    if (IN(23)) { pg8::EpiResid E{X, X}; dense_gemm(F, ACT, WB + WE_D + (size_t)DM * FF, DM, FF, E); SEAM(23); }
    if (IN(24)) { norm_phase<0>(F, X, nullptr, INP(13) + 3 * DM, H, 0, 0, nullptr, nullptr, nullptr); SEAM(24); }
    if (IN(25)) { pg8::EpiPlanes E{PROJ, C2}; dense_gemm(F, H, WB + WE_QKV + (size_t)3 * DM * DM, 3 * DM, DM, E); SEAM(25); }
    if (IN(26)) { att::causal_phase<0>((att::lptr)F.lds, F.G, PROJ, PROJ + PLANE, PROJ + 2 * PLANE, O, nullptr); SEAM(26); }
    if (IN(27)) { pg8::EpiResid E{X, X}; dense_gemm(F, O, WB + WE_WO_SB + (size_t)DM * DM, DM, DM, E); SEAM(27); }
    if (IN(28)) { norm_phase<4>(F, X, nullptr, INP(14) + 3 * DM, H, 0, 1, nullptr, nullptr, INP(18) + 1 * DM * NE); SEAM(28); }
    if (IN(29)) { moe_gu_fast(F, 1, H, ACT); SEAM(29); }
    if (IN(30)) { moe_down_fast(F, 1, ACT, Y); SEAM(30); }
    if (IN(31)) { final_combine(F, 1); }
#undef IN
#undef SEAM
}

extern "C" void kernel_launch(void* const* d_in, const int* in_sizes, int n_in, void* d_out, int out_size, void* d_ws, size_t ws_size, hipStream_t stream) {
    static int grid = 0;
    if (grid == 0) {
        if (n_in != 22 || out_size != M * DM || ws_size < WS_END) { fprintf(stderr, "kernel_launch: unexpected shapes (n_in %d out %d ws %zu)\n", n_in, out_size, ws_size); grid = -1; return; }
        int dev = 0, cus = 0, per_cu = 0;
        if (hipGetDevice(&dev) != hipSuccess || hipDeviceGetAttribute(&cus, hipDeviceAttributeMultiprocessorCount, dev) != hipSuccess) { grid = -1; return; }
        if (hipFuncSetAttribute((const void*)trunk_fwd, hipFuncAttributeMaxDynamicSharedMemorySize, LDS_BYTES) != hipSuccess) { fprintf(stderr, "kernel_launch: hipFuncSetAttribute failed\n"); grid = -1; return; }
        if (hipOccupancyMaxActiveBlocksPerMultiprocessor(&per_cu, (const void*)trunk_fwd, NTHR, LDS_BYTES) != hipSuccess || per_cu < 1) fprintf(stderr, "kernel_launch: occupancy query says %d\n", per_cu);
        (void)hipGetLastError();
        grid = cus;
    }
    if (grid < 0) return;
    (void)hipMemsetAsync((char*)d_ws + WS_CTL, 0, CTL_ZERO_BYTES, stream);
    Args a{};
    for (int i = 0; i < 22; ++i) a.in[i] = (const float*)d_in[i];
    a.out = (float*)d_out; a.ws = (unsigned char*)d_ws;
#if MK_MULTI
    for (int p = 0; p < N_PHASES; ++p) { a.ph_lo = p; a.ph_hi = p + 1; hipLaunchKernelGGL(trunk_fwd, dim3(grid), dim3(NTHR), LDS_BYTES, stream, a); }
#else
    a.ph_lo = 0; a.ph_hi = N_PHASES;
    hipLaunchKernelGGL(trunk_fwd, dim3(grid), dim3(NTHR), LDS_BYTES, stream, a);
#endif
}
```

```cpp
#include <hip/hip_runtime.h>
#include <cstdio>
#include <cstdint>

#ifndef MK_MULTI
#define MK_MULTI 0
#endif

constexpr int BATCH = 8, SEQ = 2048, DM = 1024, NH = 16, HD = 64, FF = 3584, NE = 8;
constexpr int M = BATCH * SEQ;
constexpr float RMS_EPS = 1e-6f;
constexpr float LOG2E = 1.4426950408889634f;
constexpr float C2 = 0.125f * LOG2E;
constexpr int NWAVES = 8, NTHR = 512;
constexpr int LCAP = 16384;
constexpr int MAXROWS = 34816;
constexpr bool MOE_SPLITK = true;
constexpr int SPLIT_ROW0 = 32768, SPLIT_ROWS = MAXROWS - SPLIT_ROW0;

constexpr size_t MiB = 1u << 20;
constexpr size_t WS_CTL = 0, CTL_ZERO_BYTES = 1 * MiB;
constexpr size_t WS_MISC = 1 * MiB;
constexpr size_t WS_H = 6 * MiB;
constexpr size_t WS_R1 = 38 * MiB;
constexpr size_t WS_R2 = 278 * MiB;
constexpr size_t WS_W = 414 * MiB;
constexpr size_t WS_END = 832 * MiB;
constexpr size_t PLANE = (size_t)M * DM;
constexpr size_t WE_QKV = 0;
constexpr size_t WE_WO_SB = WE_QKV + 2ull * 3072 * 1024;
constexpr size_t WE_WO_DIL = WE_WO_SB + 2ull * 1024 * 1024;
constexpr size_t WE_WO_FOX = WE_WO_DIL + 1024ull * 1024;
constexpr size_t WE_IN_DIL = WE_WO_FOX + 1024ull * 1024;
constexpr size_t WE_IN_FOX = WE_IN_DIL + 7168ull * 1024;
constexpr size_t WE_GU = WE_IN_FOX + 3072ull * 1024;
constexpr size_t WE_D = WE_GU + 2ull * 7168 * 1024;
constexpr size_t WE_MGU = WE_D + 2ull * 1024 * 3584;
constexpr size_t WE_MD = WE_MGU + 16ull * 7168 * 1024;
constexpr size_t WE_END = WE_MD + 16ull * 1024 * 3584;
static_assert(WS_W + WE_END * 2 <= WS_END, "weight copies fit");
constexpr size_t MS_LIST = 0;
constexpr size_t MS_GW = 1 * MiB;
constexpr size_t MS_TOK = 2 * MiB;
constexpr size_t MS_LOGF = 2 * MiB + 256 * 1024;
constexpr size_t MS_CUM = 3 * MiB + 256 * 1024;
constexpr size_t MS_SEL = 4 * MiB + 256 * 1024;
constexpr size_t MS_SG = MS_SEL + 256 * 1024;
constexpr size_t MS_LC = MS_SG + 256 * 1024;
constexpr int CW_BAR = 4096;
constexpr int CW_CNT = 64;

#define GAS __attribute__((address_space(1)))
#define LAS __attribute__((address_space(3)))
typedef unsigned short bf16;
typedef unsigned v4u __attribute__((ext_vector_type(4)));
typedef unsigned v2u __attribute__((ext_vector_type(2)));
typedef float f32x4 __attribute__((ext_vector_type(4)));
typedef float f32x2 __attribute__((ext_vector_type(2)));
typedef GAS unsigned gu32;
#define RLX_AGENT __ATOMIC_RELAXED, __HIP_MEMORY_SCOPE_AGENT
__device__ __forceinline__ unsigned f2bf(float f) { unsigned u = __builtin_bit_cast(unsigned, f); return (u + 0x7fffu + ((u >> 16) & 1u)) >> 16; }
__device__ __forceinline__ unsigned pk2(float lo, float hi) { return f2bf(lo) | (f2bf(hi) << 16); }
__device__ __forceinline__ float bflo(unsigned u) { return __builtin_bit_cast(float, u << 16); }
__device__ __forceinline__ float bfhi(unsigned u) { return __builtin_bit_cast(float, u & 0xffff0000u); }

#define XB_TMO      128
#define XB_XCNT(j)  (256  + 64 * (j))
#define XB_XSUB(j)  (1280 + 64 * (j))
#define XB_XGEN(j)  (2304 + 64 * (j))
#define XB_TOP      3328
#define XB_TOPGEN   3392
#define XCD_BAR_WORDS 3456
#define XB_SPIN_CAP (1u << 22)
__device__ __forceinline__ unsigned xb_ld(unsigned* p)              { return __hip_atomic_load(p, __ATOMIC_RELAXED, __HIP_MEMORY_SCOPE_AGENT); }
__device__ __forceinline__ unsigned xb_add(unsigned* p, unsigned v) { return __hip_atomic_fetch_add(p, v, __ATOMIC_RELAXED, __HIP_MEMORY_SCOPE_AGENT); }
__device__ __forceinline__ unsigned xb_xcc_id() { return (unsigned)__builtin_amdgcn_s_getreg((3 << 11) | 20) & 0xFu; }
#define XB_SPIN(cond, bar) do { unsigned _sp = 0; while (cond) { __builtin_amdgcn_s_sleep(1); \
    if ((++_sp & 255u) == 0u) { if (xb_ld(&(bar)[XB_TMO])) break; if (_sp > XB_SPIN_CAP) { atomicAdd(&(bar)[XB_TMO], 1u); break; } } } } while (0)
struct XcdBarrier { unsigned* bar; unsigned x; volatile LAS unsigned* st; };
__device__ __forceinline__ XcdBarrier xcd_barrier_post(unsigned* bar, volatile LAS unsigned* st) {
    XcdBarrier b; b.bar = bar; b.x = xb_xcc_id(); b.st = st;
    if (threadIdx.x == 0) (void)xb_add(&bar[XB_XCNT(b.x)], 1u);
    return b;
}
__device__ __forceinline__ void xcd_barrier_complete(unsigned* bar, unsigned x, unsigned& nloc, unsigned& nx) {
    const unsigned G = gridDim.x * gridDim.y * gridDim.z;
    unsigned sum, cnt, mine, sp = 0u;
    for (;;) {
        sum = 0u; cnt = 0u; mine = 0u;
#pragma unroll
        for (unsigned j = 0; j < 16; ++j) { const unsigned c = xb_ld(&bar[XB_XCNT(j)]); sum += c; cnt += (c > 0u) ? 1u : 0u; mine = (j == x) ? c : mine; }
        if (sum == G) break;
        __builtin_amdgcn_s_sleep(1);
        if ((++sp & 255u) == 0u) { if (xb_ld(&bar[XB_TMO])) break; if (sp > XB_SPIN_CAP) { atomicAdd(&bar[XB_TMO], 1u); break; } }
    }
    nloc = mine > 0u ? mine : 1u; nx = cnt > 0u ? cnt : 1u;
}
__device__ __forceinline__ void xcd_barrier(const XcdBarrier& b) {
    asm volatile("s_waitcnt vmcnt(0)" ::: "memory");
    __syncthreads();
    if (threadIdx.x == 0) {
        unsigned* bar = b.bar;
        __builtin_amdgcn_s_waitcnt(0);
        unsigned nloc = b.st[0], nx = b.st[1];
        if (nloc == 0u) { xcd_barrier_complete(bar, b.x, nloc, nx); b.st[0] = nloc; b.st[1] = nx; }
        const unsigned old = xb_add(&bar[XB_XSUB(b.x)], 1u);
        const unsigned gen = old / nloc;
        if (old + 1u == (gen + 1u) * nloc) {
            __builtin_amdgcn_fence(__ATOMIC_RELEASE, "agent");
            asm volatile("s_waitcnt vmcnt(0)" ::: "memory");
            const unsigned og = xb_add(&bar[XB_TOP], 1u);
            const unsigned tg = og / nx;
            if (og + 1u == (tg + 1u) * nx) xb_add(&bar[XB_TOPGEN], 1u);
            else XB_SPIN(xb_ld(&bar[XB_TOPGEN]) == tg, bar);
            __builtin_amdgcn_fence(__ATOMIC_ACQUIRE, "agent");
            xb_add(&bar[XB_XGEN(b.x)], 1u);
            asm volatile("s_waitcnt vmcnt(0)" ::: "memory");
        } else {
            XB_SPIN(xb_ld(&bar[XB_XGEN(b.x)]) == gen, bar);
            __builtin_amdgcn_fence(__ATOMIC_ACQUIRE, "agent");
            asm volatile("s_waitcnt vmcnt(0)" ::: "memory");
        }
    }
    __syncthreads();
}

constexpr int LDS_BYTES = 147456;
constexpr int MISC_OFF = 131072 + 320;
struct Frame {
    LAS unsigned char* lds;
    int tid, lane, wave, G;
    unsigned char* ws; gu32* ctl;
    float* out;
};
__device__ __forceinline__ float wave_sum(float v) {
#pragma unroll
    for (int o = 1; o < 64; o <<= 1) v += __shfl_xor(v, o);
    return v;
}

constexpr int PTR_OFF = 131072 + 512;
__device__ __forceinline__ const float* inp_ptr(Frame& F, int k) {
    const LAS unsigned* t = (const LAS unsigned*)(F.lds + PTR_OFF) + 2 * k;
    const unsigned lo = __builtin_amdgcn_readfirstlane(t[0]), hi = __builtin_amdgcn_readfirstlane(t[1]);
    return (const float*)(((unsigned long long)hi << 32) | lo);
}
#define INP(k) inp_ptr(F, (k))
__device__ __forceinline__ bool relaunder(Frame& F) { int t_ = threadIdx.x; asm volatile("" : "+v"(t_)); F.tid = t_; F.lane = t_ & 63; F.wave = __builtin_amdgcn_readfirstlane(t_ >> 6); return true; }
namespace pg8 {
#define PG8_LAS __attribute__((address_space(3)))
typedef unsigned short bf16_t;
typedef short bf16x8 __attribute__((ext_vector_type(8)));
typedef unsigned u32x4 __attribute__((ext_vector_type(4)));
constexpr int BM = 256, BK = 64, HALF = 128, HTB = HALF * BK * 2, STAGE_BYTES = 8 * HTB, NXCD = 8, WGM = 8;
__host__ __device__ __forceinline__ int lds_byte(int r, int c) { const int st = (r >> 4) * 2 + (c >> 5), rr = r & 15, cc = c & 31, ob = rr * 64 + cc * 2; return st * 1024 + (ob ^ (((ob >> 9) & 1) << 5)); }
__host__ __device__ __forceinline__ void stage_rc(int b, int& R, int& C) { const int st = b / 1024, sb = b % 1024, swz = sb ^ (((sb >> 9) & 1) << 5); R = (st >> 1) * 16 + swz / 64; C = (st & 1) * 32 + (swz % 64) / 2; }
__host__ __device__ __forceinline__ int perm32(int rho) { const int n = rho >> 4, i = rho & 15; return 8 * (i >> 2) + 4 * n + (i & 3); }
struct Unit { int pm, pn, e, mt, nt, koff, kq; };

struct DenseOrder {
    int nM, nN, nwg, G, c, ntk; const char* A; const char* Bt; size_t tstep;
    __device__ __forceinline__ void init(const bf16_t* A_, const bf16_t* Bt_, int M_, int N_, int K_, int G_, int c_) { nM = M_ / BM; nN = N_ / BM; nwg = nM * nN; G = G_; c = c_; ntk = K_ / BK; A = (const char*)A_; Bt = (const char*)Bt_; tstep = (size_t)BM * K_ * 2; }
    __device__ __forceinline__ bool next(int i, Unit& u) const {
        const long L = (long)i * G + c; if (L >= nwg) return false;
        int wgid = (int)L; { const int q = nwg / NXCD, r = nwg % NXCD, xcd = wgid % NXCD, off = wgid / NXCD; wgid = (xcd < r ? xcd * (q + 1) : r * (q + 1) + (xcd - r) * q) + off; }
        const int nig = WGM * nN, gid = wgid / nig, fm = gid * WGM, gsz = (nM - fm) < WGM ? (nM - fm) : WGM;
        u.pm = fm + ((wgid % nig) % gsz); u.pn = (wgid % nig) / gsz; u.e = 0; u.mt = u.pm; u.nt = ntk; u.koff = 0; u.kq = -1; return true;
    }
    __device__ __forceinline__ const char* a_base(const Unit& u) const { return A + (size_t)u.pm * tstep; }
    __device__ __forceinline__ const char* b_base(const Unit& u) const { return Bt + (size_t)u.pn * tstep; }
    __device__ __forceinline__ void a_voff(const Unit&, const int (&)[2], const int (&)[2], unsigned (&)[2][2]) const {}
};
struct MoeOrder {
    int t1, t2, t3, t4, t5, t6, t7, t8, nN, G, c, K; const char* A; const char* Bt; size_t tstepA, tstepB, estepB; const int* list; bool gather; int splitk;
    __device__ __forceinline__ bool next(int i, Unit& u) const {
        const int X = i * G + c, U = t8 * nN; int L = X; u.nt = K / BK; u.koff = 0; u.kq = -1;
        if (splitk) { const int nfull = (U / G) * G;
            if (X >= nfull) { const int q = X - nfull; if (q >= splitk * (U - nfull)) return false; L = nfull + q / splitk; u.kq = q % splitk; u.nt = K / BK / splitk; u.koff = u.kq * (K / splitk) * 2; } }
        else if (X >= U) return false;
        const int mt = L / nN; u.pm = mt; u.pn = L - mt * nN;
        const int e = (mt >= t1) + (mt >= t2) + (mt >= t3) + (mt >= t4) + (mt >= t5) + (mt >= t6) + (mt >= t7);
        const int tb = e == 0 ? 0 : e == 1 ? t1 : e == 2 ? t2 : e == 3 ? t3 : e == 4 ? t4 : e == 5 ? t5 : e == 6 ? t6 : t7;
        u.e = e; u.mt = mt - tb; return true;
    }
    __device__ __forceinline__ const char* a_base(const Unit& u) const { return (gather ? A : A + (size_t)u.pm * tstepA) + u.koff; }
    __device__ __forceinline__ const char* b_base(const Unit& u) const { return Bt + (size_t)u.e * estepB + (size_t)u.pn * tstepB + u.koff; }
    __device__ __forceinline__ void a_voff(const Unit& u, const int (&sR)[2], const int (&sC)[2], unsigned (&v)[2][2]) const {
        const int* lp = list + u.e * LCAP + u.mt * 256;
#pragma unroll
        for (int h = 0; h < 2; ++h)
#pragma unroll
            for (int i = 0; i < 2; ++i) v[h][i] = (unsigned)lp[h * 128 + sR[i]] * (unsigned)(K * 2) + (unsigned)(sC[i] * 2);
    }
};

__device__ __forceinline__ unsigned cvt_pk_bf16(float lo, float hi) { unsigned r; asm volatile("v_cvt_pk_bf16_f32 %0, %1, %2" : "=v"(r) : "v"(lo), "v"(hi)); return r; }

struct EpiPlanes {
    static constexpr bool PERM = true;
    bf16_t* O; float scale0;
    __device__ __forceinline__ void operator()(const f32x4 (&acc)[2][2][4][2], const Unit& u, int wr, int wc, int fr, int fq) const {
        const int plane = u.pn >> 2; const float sc = plane == 0 ? scale0 : 1.f;
        bf16_t* base = O + (size_t)plane * PLANE + (size_t)(u.pm * BM + wr * 64 + fr) * DM + (u.pn & 3) * 256 + wc * 32 + 8 * fq;
#pragma unroll
        for (int ai = 0; ai < 2; ++ai)
#pragma unroll
            for (int m = 0; m < 4; ++m) { bf16_t* rowp = base + (size_t)(ai * HALF + m * 16) * DM;
#pragma unroll
                for (int bj = 0; bj < 2; ++bj) { const f32x4 v0 = acc[ai][bj][m][0] * sc, v1 = acc[ai][bj][m][1] * sc;
                    u32x4 w; w.x = cvt_pk_bf16(v0[0], v0[1]); w.y = cvt_pk_bf16(v0[2], v0[3]); w.z = cvt_pk_bf16(v1[0], v1[1]); w.w = cvt_pk_bf16(v1[2], v1[3]);
                    *(u32x4*)(rowp + bj * HALF) = w; } }
    }
};
struct EpiQKNorm {
    static constexpr bool PERM = true;
    bf16_t* O; const float* qg; const float* kg; int vplane;
    __device__ __forceinline__ void operator()(const f32x4 (&acc)[2][2][4][2], const Unit& u, int wr, int wc, int fr, int fq) const {
        const int plane = u.pn >> 2; const bool isv = plane == vplane; const bool isq = !isv && ((plane & 1) == 0); const int grp = plane >> 1;
        const float* g = (isq ? qg : kg) + grp * 64 + 8 * fq;
        f32x4 gv[2][2];
#pragma unroll
        for (int bj = 0; bj < 2; ++bj)
#pragma unroll
            for (int n = 0; n < 2; ++n) gv[bj][n] = isv ? (f32x4){1.f, 1.f, 1.f, 1.f} : *(const f32x4*)(g + 32 * bj + 4 * n);
        const float mul = isq ? C2 : 1.f;
        bf16_t* base = O + (size_t)plane * PLANE + (size_t)(u.pm * BM + wr * 64 + fr) * DM + (u.pn & 3) * 256 + wc * 64 + 8 * fq;
#pragma unroll
        for (int ai = 0; ai < 2; ++ai)
#pragma unroll
            for (int m = 0; m < 4; ++m) { bf16_t* rowp = base + (size_t)(ai * HALF + m * 16) * DM;
                float ss = 0.f;
#pragma unroll
                for (int bj = 0; bj < 2; ++bj)
#pragma unroll
                    for (int n = 0; n < 2; ++n) { const f32x4 x = acc[ai][bj][m][n]; ss += (x[0] * x[0] + x[1] * x[1]) + (x[2] * x[2] + x[3] * x[3]); }
                ss += __shfl_xor(ss, 16); ss += __shfl_xor(ss, 32);
                const float inv = isv ? 1.f : mul / sqrtf(ss * (1.f / 64.f) + RMS_EPS);
#pragma unroll
                for (int bj = 0; bj < 2; ++bj) { const f32x4 v0 = acc[ai][bj][m][0] * inv * gv[bj][0], v1 = acc[ai][bj][m][1] * inv * gv[bj][1];
                    u32x4 w; w.x = cvt_pk_bf16(v0[0], v0[1]); w.y = cvt_pk_bf16(v0[2], v0[3]); w.z = cvt_pk_bf16(v1[0], v1[1]); w.w = cvt_pk_bf16(v1[2], v1[3]);
                    *(u32x4*)(rowp + bj * 32) = w; } }
    }
};
struct EpiSwiglu {
    static constexpr bool PERM = true;
    bf16_t* O;
    __device__ __forceinline__ void operator()(const f32x4 (&acc)[2][2][4][2], const Unit& u, int wr, int wc, int fr, int fq) const {
        bf16_t* base = O + (size_t)(u.pm * BM + wr * 64 + fr) * FF + u.pn * 128 + wc * 32 + 8 * fq;
#pragma unroll
        for (int ai = 0; ai < 2; ++ai)
#pragma unroll
            for (int m = 0; m < 4; ++m) { bf16_t* rowp = base + (size_t)(ai * HALF + m * 16) * FF;
                float o[8];
#pragma unroll
                for (int n = 0; n < 2; ++n)
#pragma unroll
                    for (int i = 0; i < 4; ++i) { const float g = acc[ai][0][m][n][i], uu = acc[ai][1][m][n][i];
                        o[n * 4 + i] = g * __builtin_amdgcn_rcpf(1.0f + __builtin_amdgcn_exp2f(-g * LOG2E)) * uu; }
                u32x4 w; w.x = cvt_pk_bf16(o[0], o[1]); w.y = cvt_pk_bf16(o[2], o[3]); w.z = cvt_pk_bf16(o[4], o[5]); w.w = cvt_pk_bf16(o[6], o[7]);
                *(u32x4*)rowp = w; }
    }
};
struct EpiResid {
    static constexpr bool PERM = false;
    const float* base; float* out;
    __device__ __forceinline__ void operator()(const f32x4 (&acc)[2][2][4][2], const Unit& u, int wr, int wc, int fr, int fq) const {
        const size_t off0 = (size_t)(u.pm * BM + wr * 64 + fr) * DM + u.pn * BM + wc * 32 + 4 * fq;
#pragma unroll
        for (int ai = 0; ai < 2; ++ai)
#pragma unroll
            for (int m = 0; m < 4; ++m) { const size_t off = off0 + (size_t)(ai * HALF + m * 16) * DM;
#pragma unroll
                for (int bj = 0; bj < 2; ++bj)
#pragma unroll
                    for (int n = 0; n < 2; ++n) { const f32x4 b = *(const f32x4*)(base + off + bj * HALF + n * 16); *(f32x4*)(out + off + bj * HALF + n * 16) = b + acc[ai][bj][m][n]; } }
    }
};
struct EpiMoeDown {
    static constexpr bool PERM = true;
    bf16_t* Y; const float* gw; bf16_t* P;
    __device__ __forceinline__ void operator()(const f32x4 (&acc)[2][2][4][2], const Unit& u, int wr, int wc, int fr, int fq) const {
        bf16_t* base = (u.kq < 0 ? Y + (size_t)(u.pm * BM) * DM : P + ((size_t)u.kq * SPLIT_ROWS + (size_t)(u.pm * BM - SPLIT_ROW0)) * DM) + (size_t)(wr * 64 + fr) * DM + u.pn * BM + wc * 32 + 8 * fq;
        const float* gp = gw + u.e * LCAP + u.mt * 256 + wr * 64 + fr;
#pragma unroll
        for (int ai = 0; ai < 2; ++ai)
#pragma unroll
            for (int m = 0; m < 4; ++m) { bf16_t* rowp = base + (size_t)(ai * HALF + m * 16) * DM; const float g = gp[ai * HALF + m * 16];
#pragma unroll
                for (int bj = 0; bj < 2; ++bj) { const f32x4 v0 = acc[ai][bj][m][0] * g, v1 = acc[ai][bj][m][1] * g;
                    u32x4 w; w.x = cvt_pk_bf16(v0[0], v0[1]); w.y = cvt_pk_bf16(v0[2], v0[3]); w.z = cvt_pk_bf16(v1[0], v1[1]); w.w = cvt_pk_bf16(v1[2], v1[3]);
                    *(u32x4*)(rowp + bj * HALF) = w; } }
    }
};

template <class Epi, class Sched, bool GATHER>
__device__ __forceinline__ void gemm_phase(PG8_LAS unsigned char* lds, const int K, const Sched& S, const Epi& E) {
    const int tid = threadIdx.x, wid = __builtin_amdgcn_readfirstlane(tid >> 6), lane = tid & 63, wr = wid >> 2, wc = wid & 3, fr = lane & 15, fq = lane >> 4;
    unsigned voffA[2], voffB[2]; int sR[2], sC[2];
#pragma unroll
    for (int i = 0; i < 2; ++i) { int R, C; stage_rc(tid * 16 + i * 8192, R, C); const int Rb = Epi::PERM ? ((R & ~31) + perm32(R & 31)) : R;
        voffA[i] = (unsigned)(R * K + C) * 2u; voffB[i] = (unsigned)(Rb * K + C) * 2u; sR[i] = R; sC[i] = C; }
    const size_t kstep = (size_t)(BK * 2);
    const size_t hstep = (size_t)HALF * K * 2;
    const unsigned ldsw = (unsigned)wid * 1024u;
    const int aoff = lds_byte(wr * 64 + fr, fq * 8), boff = lds_byte(wc * 32 + fr, fq * 8);
#define PG8_SA(b, h) (((b) * 2 + (h)) * HTB)
#define PG8_SB(b, h) ((4 + (b) * 2 + (h)) * HTB)
#define PG8_STAGE(bufoff, gbase, voff) do { _Pragma("unroll") for (int _i = 0; _i < 2; ++_i) \
        __builtin_amdgcn_global_load_lds((const unsigned*)((const char*)(gbase) + (voff)[_i]), (PG8_LAS unsigned*)(lds + (bufoff) + ldsw + _i * 8192), 16, 0, 0); } while (0)
#define PG8_STAGE_A(bufoff, p, h, VG) do { if (GATHER) { PG8_STAGE(bufoff, p, VG[h]); } else { PG8_STAGE(bufoff, (p) + ((h) ? hstep : 0), voffA); } } while (0)
#define PG8_LDA(dst, b, h) do { _Pragma("unroll") for (int m = 0; m < 4; ++m) _Pragma("unroll") for (int k = 0; k < 2; ++k) dst[m][k] = *(const PG8_LAS bf16x8*)(lds + PG8_SA(b, h) + aoff + m * 2048 + k * 1024); } while (0)
#define PG8_LDB(dst, b, h) do { _Pragma("unroll") for (int n = 0; n < 2; ++n) _Pragma("unroll") for (int k = 0; k < 2; ++k) dst[n][k] = *(const PG8_LAS bf16x8*)(lds + PG8_SB(b, h) + boff + n * 2048 + k * 1024); } while (0)
#define PG8_MMA(ai, bj, At, Bt) do { __builtin_amdgcn_s_setprio(1); _Pragma("unroll") for (int m = 0; m < 4; ++m) _Pragma("unroll") for (int n = 0; n < 2; ++n) _Pragma("unroll") for (int k = 0; k < 2; ++k) \
        acc[ai][bj][m][n] = __builtin_amdgcn_mfma_f32_16x16x32_bf16(Bt[n][k], At[m][k], acc[ai][bj][m][n], 0, 0, 0); __builtin_amdgcn_s_setprio(0); } while (0)
#define PG8_WAIT_V(n) asm volatile("s_waitcnt vmcnt(" #n ")" ::: "memory")
#define PG8_WAIT_L(n) asm volatile("s_waitcnt lgkmcnt(" #n ")" ::: "memory")
#define PG8_BAR __builtin_amdgcn_s_barrier()
#define PG8_SCHED __builtin_amdgcn_sched_barrier(0)
    Unit cur, nxt; int ui = 0;
    if (!S.next(0, cur)) return;
    f32x4 acc[2][2][4][2];
#pragma unroll
    for (int a = 0; a < 2; ++a)
#pragma unroll
        for (int b = 0; b < 2; ++b)
#pragma unroll
            for (int m = 0; m < 4; ++m)
#pragma unroll
                for (int n = 0; n < 2; ++n) acc[a][b][m][n] = (f32x4){0.f, 0.f, 0.f, 0.f};
    bf16x8 At[4][2], B0[2][2], B1[2][2];
    const char* cA = S.a_base(cur); const char* cB = S.b_base(cur);
    unsigned vc[2][2] = {{0u, 0u}, {0u, 0u}}, vn[2][2] = {{0u, 0u}, {0u, 0u}};
    if (GATHER) { S.a_voff(cur, sR, sC, vc); asm volatile("s_waitcnt vmcnt(0)" : "+v"(vc[0][0]), "+v"(vc[0][1]), "+v"(vc[1][0]), "+v"(vc[1][1]) :: "memory"); }
    PG8_STAGE(PG8_SB(0, 0), cB, voffB); PG8_STAGE(PG8_SB(0, 1), cB + hstep, voffB); PG8_STAGE_A(PG8_SA(0, 0), cA, 0, vc); PG8_STAGE_A(PG8_SA(0, 1), cA, 1, vc);
    if (wr == 1) PG8_BAR;
    PG8_WAIT_V(2); PG8_BAR;
    PG8_STAGE(PG8_SB(1, 0), cB + kstep, voffB); PG8_STAGE_A(PG8_SA(1, 0), cA + kstep, 0, vc); PG8_STAGE(PG8_SB(1, 1), cB + hstep + kstep, voffB);
    PG8_WAIT_V(6); PG8_BAR;
    for (;;) {
        const bool has_next = S.next(ui + 1, nxt);
        const char* nA = has_next ? S.a_base(nxt) : cA; const char* nB = has_next ? S.b_base(nxt) : cB;
        if (GATHER) {
            if (has_next) { S.a_voff(nxt, sR, sC, vn); asm volatile("s_waitcnt vmcnt(0)" : "+v"(vn[0][0]), "+v"(vn[0][1]), "+v"(vn[1][0]), "+v"(vn[1][1]) :: "memory"); }
            else { vn[0][0] = vc[0][0]; vn[0][1] = vc[0][1]; vn[1][0] = vc[1][0]; vn[1][1] = vc[1][1]; }
        }
        const int nt = cur.nt;
        for (int t = 0; t < nt; t += 2) {
            const bool last = (t == nt - 2);
            const char* a1 = cA + (size_t)(t + 1) * kstep;
            const char* a2 = last ? nA : cA + (size_t)(t + 2) * kstep; const char* b2 = last ? nB : cB + (size_t)(t + 2) * kstep;
            const char* a3 = a2 + kstep; const char* b3 = b2 + kstep;
            unsigned v2[2][2];
#pragma unroll
            for (int h = 0; h < 2; ++h)
#pragma unroll
                for (int i = 0; i < 2; ++i) v2[h][i] = last ? vn[h][i] : vc[h][i];
            PG8_LDB(B0, 0, 0); PG8_LDB(B1, 0, 1); PG8_SCHED; PG8_LDA(At, 0, 0); PG8_STAGE_A(PG8_SA(1, 1), a1, 1, vc);
            PG8_WAIT_V(8); PG8_WAIT_L(0); PG8_BAR; PG8_MMA(0, 0, At, B0); PG8_MMA(0, 1, At, B1); PG8_BAR; PG8_SCHED;
            PG8_LDA(At, 0, 1); PG8_STAGE(PG8_SB(0, 0), b2, voffB); PG8_STAGE(PG8_SB(0, 1), b2 + hstep, voffB); PG8_STAGE_A(PG8_SA(0, 0), a2, 0, v2);
            PG8_WAIT_V(8); PG8_WAIT_L(0); PG8_BAR; PG8_MMA(1, 0, At, B0); PG8_MMA(1, 1, At, B1); PG8_BAR; PG8_SCHED;
            PG8_LDB(B0, 1, 0); PG8_LDB(B1, 1, 1); PG8_SCHED; PG8_LDA(At, 1, 0); PG8_STAGE_A(PG8_SA(0, 1), a2, 1, v2);
            PG8_WAIT_V(8); PG8_WAIT_L(0); PG8_BAR; PG8_MMA(0, 0, At, B0); PG8_MMA(0, 1, At, B1); PG8_BAR; PG8_SCHED;
            PG8_LDA(At, 1, 1); PG8_STAGE(PG8_SB(1, 0), b3, voffB); PG8_STAGE(PG8_SB(1, 1), b3 + hstep, voffB); PG8_STAGE_A(PG8_SA(1, 0), a3, 0, v2);
            PG8_WAIT_V(8); PG8_WAIT_L(0); PG8_BAR; PG8_MMA(1, 0, At, B0); PG8_MMA(1, 1, At, B1); PG8_BAR; PG8_SCHED;
        }
        if (wr == 0) PG8_BAR;
        E(acc, cur, wr, wc, fr, fq);
        if (!has_next) break;
#pragma unroll
        for (int a = 0; a < 2; ++a)
#pragma unroll
            for (int b = 0; b < 2; ++b)
#pragma unroll
                for (int m = 0; m < 4; ++m)
#pragma unroll
                    for (int n = 0; n < 2; ++n) acc[a][b][m][n] = (f32x4){0.f, 0.f, 0.f, 0.f};
        cur = nxt; cA = nA; cB = nB; ++ui;
        if (GATHER) { vc[0][0] = vn[0][0]; vc[0][1] = vn[0][1]; vc[1][0] = vn[1][0]; vc[1][1] = vn[1][1]; }
        if (wr == 1) PG8_BAR;
    }
    PG8_WAIT_V(0);
    PG8_BAR;
#undef PG8_SA
#undef PG8_SB
#undef PG8_STAGE
#undef PG8_STAGE_A
#undef PG8_LDA
#undef PG8_LDB
#undef PG8_MMA
#undef PG8_WAIT_V
#undef PG8_WAIT_L
#undef PG8_BAR
#undef PG8_SCHED
}
}

namespace att {
typedef short bf16x8 __attribute__((ext_vector_type(8)));
typedef short s16x4 __attribute__((ext_vector_type(4)));
typedef float f32x16 __attribute__((ext_vector_type(16)));
typedef unsigned u32x4 __attribute__((ext_vector_type(4)));
typedef LAS char* lptr;
constexpr int SLOTB = 8192;
constexpr int L_K = 0, L_V = 3 * SLOTB, L_WS = 6 * SLOTB, L_OST = L_WS + 8 * 256, L_KB = L_OST + 8 * 4096, L_TBL = L_KB + 8192, L_FLG = L_TBL + 8192, L_END = L_FLG + 256;
static_assert(L_END <= 131072, "attention LDS map inside the ring region");
constexpr float THR = 8.0f;
__device__ __forceinline__ int crow(int r, int hi) { return (r & 3) + 8 * (r >> 2) + 4 * hi; }
__device__ __forceinline__ void glds16(const void* gsrc, unsigned lds_dst) { unsigned keep;
    asm volatile("s_mov_b32 %0, m0\n\ts_mov_b32 m0, %2\n\ts_nop 0\n\tglobal_load_lds_dwordx4 %1, off\n\ts_mov_b32 m0, %0" : "=&s"(keep) : "v"(gsrc), "s"(lds_dst) : "memory"); }
typedef float f32x2_t __attribute__((ext_vector_type(2))); typedef __bf16 bf16x2_t __attribute__((ext_vector_type(2)));
__device__ __forceinline__ unsigned cvtpk(float lo, float hi) { f32x2_t v = {lo, hi}; bf16x2_t b = __builtin_convertvector(v, bf16x2_t); return __builtin_bit_cast(unsigned, b); }
#define ATT_WAIT_BAR(N) asm volatile("s_waitcnt vmcnt(" #N ") lgkmcnt(0)\n\ts_barrier" ::: "memory")
__device__ __forceinline__ float other_half(float x, int hi) {
    auto rr = __builtin_amdgcn_permlane32_swap(__float_as_uint(x), __float_as_uint(x), false, false);
    return __uint_as_float(hi ? rr[0] : rr[1]);
}
__device__ __forceinline__ void qkt(f32x16& p0, f32x16& p1, lptr Kslot, const bf16x8* qr, int r32, int hi) {
    lptr kb = Kslot + hi * 1024 + r32 * 16;
    const f32x16 z = {};
#pragma unroll
    for (int d0 = 0; d0 < 4; ++d0) {
        const bf16x8 b0 = *(const LAS bf16x8*)(kb + d0 * 2048);
        const bf16x8 b1 = *(const LAS bf16x8*)(kb + d0 * 2048 + 512);
        if (d0 == 0) { p0 = __builtin_amdgcn_mfma_f32_32x32x16_bf16(b0, qr[0], z, 0, 0, 0); p1 = __builtin_amdgcn_mfma_f32_32x32x16_bf16(b1, qr[0], z, 0, 0, 0); }
        else { p0 = __builtin_amdgcn_mfma_f32_32x32x16_bf16(b0, qr[d0], p0, 0, 0, 0); p1 = __builtin_amdgcn_mfma_f32_32x32x16_bf16(b1, qr[d0], p1, 0, 0, 0); } }
}
__device__ __forceinline__ void pv(f32x16* o, int vb, bf16x8 pa0, bf16x8 pa1, bf16x8 pa2, bf16x8 pa3) {
#pragma unroll
    for (int d0 = 0; d0 < 2; ++d0) { s16x4 lo[4], hi[4];
#pragma unroll
        for (int ks = 0; ks < 4; ++ks) {
            asm volatile("ds_read_b64_tr_b16 %0,%1 offset:%c2" : "=&v"(lo[ks]) : "v"(vb), "i"(d0 * 4096 + ks * 1024) : "memory");
            asm volatile("ds_read_b64_tr_b16 %0,%1 offset:%c2" : "=&v"(hi[ks]) : "v"(vb), "i"(d0 * 4096 + ks * 1024 + 512) : "memory"); }
        asm volatile("s_waitcnt lgkmcnt(0)" ::: "memory"); __builtin_amdgcn_sched_barrier(0);
#define ATT_PK(k) (bf16x8){lo[k][0], lo[k][1], lo[k][2], lo[k][3], hi[k][0], hi[k][1], hi[k][2], hi[k][3]}
        o[d0] = __builtin_amdgcn_mfma_f32_32x32x16_bf16(pa0, ATT_PK(0), o[d0], 0, 0, 0);
        o[d0] = __builtin_amdgcn_mfma_f32_32x32x16_bf16(pa1, ATT_PK(1), o[d0], 0, 0, 0);
        o[d0] = __builtin_amdgcn_mfma_f32_32x32x16_bf16(pa2, ATT_PK(2), o[d0], 0, 0, 0);
        o[d0] = __builtin_amdgcn_mfma_f32_32x32x16_bf16(pa3, ATT_PK(3), o[d0], 0, 0, 0);
#undef ATT_PK
    }
}
__device__ __forceinline__ float rowmax32(const f32x16& p0, const f32x16& p1, int hi) {
    float a = fmaxf(p0[0], p1[0]);
#pragma unroll
    for (int r = 1; r < 16; ++r) a = fmaxf(a, fmaxf(p0[r], p1[r]));
    return fmaxf(a, other_half(a, hi));
}
__device__ __forceinline__ void store_o(const f32x16* o, const float* sc, lptr stgb, bf16* Ow, long rpitch, int lane, int r32, int hi) {
    LAS bf16* stg = (LAS bf16*)stgb;
#pragma unroll
    for (int r = 0; r < 16; ++r) { const int orow = crow(r, hi);
#pragma unroll
        for (int d0 = 0; d0 < 2; ++d0) stg[orow * 64 + d0 * 32 + r32] = (bf16)f2bf(o[d0][r] * sc[r]); }
    asm volatile("s_waitcnt lgkmcnt(0)" ::: "memory");
#pragma unroll
    for (int i = 0; i < 4; ++i) { const int row = i * 8 + (lane >> 3), ch = lane & 7; const u32x4 v = *(const LAS u32x4*)(stg + row * 64 + ch * 8); *(u32x4*)(Ow + (long)row * rpitch + ch * 8) = v; }
}

__device__ __forceinline__ void fox_unit(lptr shm, int b, int h, int qb, const bf16* Q, const bf16* K, const bf16* V, bf16* O, const float* cum) {
    const int tid = threadIdx.x, lane = tid & 63, r32 = lane & 31, hi = lane >> 5; const int wid = __builtin_amdgcn_readfirstlane(tid >> 6);
    const long rowbase = (long)b * SEQ; const int q0 = qb * 256;
    const bf16* Qw = Q + (rowbase + q0 + wid * 32) * DM + h * 64;
    const bf16* Kh = K + rowbase * DM + h * 64; const bf16* Vh = V + rowbase * DM + h * 64;
    const unsigned lds0 = (unsigned)(uintptr_t)shm;
    LAS float* wsf = (LAS float*)(shm + L_WS) + wid * 64;
    LAS float* kbl = (LAS float*)(shm + L_KB);
    for (int s = tid; s < q0 + 256; s += NTHR) kbl[s] = -cum[(rowbase + s) * 16 + h];
    bf16x8 qr[4];
#pragma unroll
    for (int d0 = 0; d0 < 4; ++d0) qr[d0] = *(const bf16x8*)(Qw + (long)r32 * DM + d0 * 16 + hi * 8);
    const int NT = (q0 + 256) / 64;
    const bf16* ksrc = Kh + (long)lane * DM + wid * 8;
    const bf16* vsrc = Vh + (long)(16 * (wid & 3) + (lane >> 2)) * DM + (wid >> 2) * 32 + (lane & 3) * 8;
    const unsigned kdst = lds0 + L_K + wid * 1024, vdst = lds0 + L_V + wid * 1024;
    const int vb0 = (int)(lds0 + L_V) + ((lane >> 4) & 1) * 32 + (lane & 3) * 8 + (4 * hi + ((lane & 15) >> 2)) * 64;
#define ATT_DMA(t, sl) do { glds16(ksrc + (long)(t) * 64 * DM, (unsigned)__builtin_amdgcn_readfirstlane(kdst + (sl) * SLOTB)); glds16(vsrc + (long)(t) * 64 * DM, (unsigned)__builtin_amdgcn_readfirstlane(vdst + (sl) * SLOTB)); } while (0)
    asm volatile("s_waitcnt vmcnt(0)" : "+v"(qr[0]), "+v"(qr[1]), "+v"(qr[2]), "+v"(qr[3]) :: "memory");
    ATT_DMA(0, 0); ATT_DMA(1, 1);
    float mref = -1e30f, lsum = 0.f; f32x16 o[2]; o[0] = f32x16{}; o[1] = f32x16{};
    const int qfirst = q0 + wid * 32, qpos = qfirst + r32;
    int slot = 0;
    for (int t = 0; t < NT; ++t) {
        if (t + 1 < NT) ATT_WAIT_BAR(2); else ATT_WAIT_BAR(0);
        if (t + 2 < NT) { const int s2 = slot >= 1 ? slot - 1 : 2; ATT_DMA(t + 2, s2); }
        if (64 * t <= qfirst + 31) {
            f32x16 p0, p1; qkt(p0, p1, shm + L_K + slot * SLOTB, qr, r32, hi);
#pragma unroll
            for (int g = 0; g < 4; ++g) { const f32x4 k0 = *(const LAS f32x4*)(kbl + 64 * t + 8 * g + 4 * hi), k1 = *(const LAS f32x4*)(kbl + 64 * t + 32 + 8 * g + 4 * hi);
#pragma unroll
                for (int i = 0; i < 4; ++i) { p0[4 * g + i] += k0[i]; p1[4 * g + i] += k1[i]; } }
            if (64 * t + 63 > qfirst) {
#pragma unroll
                for (int r = 0; r < 16; ++r) { const int kv = 64 * t + crow(r, hi); if (kv > qpos) p0[r] = -INFINITY; if (kv + 32 > qpos) p1[r] = -INFINITY; } }
            const float rm = rowmax32(p0, p1, hi);
            const bool fresh = mref <= -1e30f;
            const bool want = !fresh && (rm > mref + THR);
            if (fresh) mref = fmaxf(rm, -1e30f);
            if (__any(want)) {
                const float dl = want ? rm - mref : 0.f; mref += dl; const float f = __builtin_amdgcn_exp2f(-dl); lsum *= f;
                if (hi == 0) wsf[r32] = f;
                asm volatile("s_waitcnt lgkmcnt(0)" ::: "memory");
#pragma unroll
                for (int r = 0; r < 16; ++r) { const float fr = wsf[crow(r, hi)]; o[0][r] *= fr; o[1][r] *= fr; }
            }
            float sacc = 0.f;
#pragma unroll
            for (int r = 0; r < 16; ++r) { p0[r] = __builtin_amdgcn_exp2f(p0[r] - mref); p1[r] = __builtin_amdgcn_exp2f(p1[r] - mref); sacc += p0[r] + p1[r]; }
            lsum += sacc;
            u32x4 w0, w1, w2, w3;
#pragma unroll
            for (int j = 0; j < 4; ++j) { w0[j] = cvtpk(p0[2 * j], p0[2 * j + 1]); w1[j] = cvtpk(p0[8 + 2 * j], p0[8 + 2 * j + 1]); w2[j] = cvtpk(p1[2 * j], p1[2 * j + 1]); w3[j] = cvtpk(p1[8 + 2 * j], p1[8 + 2 * j + 1]); }
            pv(o, vb0 + slot * SLOTB, __builtin_bit_cast(bf16x8, w0), __builtin_bit_cast(bf16x8, w1), __builtin_bit_cast(bf16x8, w2), __builtin_bit_cast(bf16x8, w3));
        }
        slot = slot == 2 ? 0 : slot + 1;
    }
    lsum += other_half(lsum, hi);
    if (hi == 0) wsf[32 + r32] = lsum;
    asm volatile("s_waitcnt lgkmcnt(0)" ::: "memory");
    float rli[16];
#pragma unroll
    for (int r = 0; r < 16; ++r) rli[r] = __builtin_amdgcn_rcpf(wsf[32 + crow(r, hi)]);
    store_o(o, rli, shm + L_OST + wid * 4096, O + (rowbase + q0 + wid * 32) * DM + h * 64, DM, lane, r32, hi);
    asm volatile("s_waitcnt lgkmcnt(0)\n\ts_barrier" ::: "memory");
#undef ATT_DMA
}

__device__ __forceinline__ void sb_unit(lptr shm, int b, int h, int qb, const bf16* Q, const bf16* K, const bf16* V, bf16* O) {
    const int tid = threadIdx.x, lane = tid & 63, r32 = lane & 31, hi = lane >> 5; const int wid = __builtin_amdgcn_readfirstlane(tid >> 6);
    const long rowbase = (long)b * SEQ; const int q0 = qb * 256;
    const bf16* Qw = Q + (rowbase + q0 + wid * 32) * DM + h * 64;
    const bf16* Kh = K + rowbase * DM + h * 64; const bf16* Vh = V + rowbase * DM + h * 64;
    const unsigned lds0 = (unsigned)(uintptr_t)shm;
    LAS int* flg = (LAS int*)(shm + L_FLG);
    if (tid < 16) flg[tid] = 0;
    bf16x8 qr[4];
#pragma unroll
    for (int d0 = 0; d0 < 4; ++d0) qr[d0] = *(const bf16x8*)(Qw + (long)r32 * DM + d0 * 16 + hi * 8);
    const int NT = (q0 + 256) / 64;
    const bf16* ksrc = Kh + (long)lane * DM + wid * 8;
    const bf16* vsrc = Vh + (long)(16 * (wid & 3) + (lane >> 2)) * DM + (wid >> 2) * 32 + (lane & 3) * 8;
    const unsigned kdst = lds0 + L_K + wid * 1024, vdst = lds0 + L_V + wid * 1024;
    const int vb0 = (int)(lds0 + L_V) + ((lane >> 4) & 1) * 32 + (lane & 3) * 8 + (4 * hi + ((lane & 15) >> 2)) * 64;
#define ATT_DMA(T, sl) do { glds16(ksrc + (long)(T) * 64 * DM, (unsigned)__builtin_amdgcn_readfirstlane(kdst + (sl) * SLOTB)); glds16(vsrc + (long)(T) * 64 * DM, (unsigned)__builtin_amdgcn_readfirstlane(vdst + (sl) * SLOTB)); } while (0)
    asm volatile("s_waitcnt vmcnt(0)" : "+v"(qr[0]), "+v"(qr[1]), "+v"(qr[2]), "+v"(qr[3]) :: "memory");
    ATT_DMA(NT - 1, 0); ATT_DMA(NT - 2, 1);
    float carry = 1.0f; f32x16 o[2]; o[0] = f32x16{}; o[1] = f32x16{};
    const int qfirst = q0 + wid * 32, qpos = qfirst + r32;
    int slot = 0; int done = 0;
    for (int k = 0; k < NT; ++k) {
        const int T = NT - 1 - k;
        if (k + 1 < NT) ATT_WAIT_BAR(2); else ATT_WAIT_BAR(0);
        if (k > 0) { int all = 1;
#pragma unroll
            for (int w = 0; w < 8; ++w) all &= flg[((k - 1) & 1) * 8 + w];
            if (__builtin_amdgcn_readfirstlane(all)) break; }
        if (k + 2 < NT) { const int s2 = slot >= 1 ? slot - 1 : 2; ATT_DMA(T - 2, s2); }
        if (!done && 64 * T < qfirst + 31) {
            f32x16 p0, p1; qkt(p0, p1, shm + L_K + slot * SLOTB, qr, r32, hi);
            const bool diag = 64 * T + 63 >= qfirst;
            float ga[8];
#pragma unroll
            for (int a = 0; a < 8; ++a) {
                float rr[4];
#pragma unroll
                for (int i = 0; i < 4; ++i) { const int r = 4 * (a & 3) + i; const float z = (a < 4) ? p0[r] : p1[r];
                    const float e = __builtin_amdgcn_exp2f(fminf(z, 120.f)); float rv = __builtin_amdgcn_rcpf(1.0f + e);
                    if (diag) { const int kv = 64 * T + crow(r, hi) + ((a < 4) ? 0 : 32); if (kv >= qpos) rv = 1.0f; }
                    rr[i] = rv; if (a < 4) p0[r] = rv; else p1[r] = rv; }
                ga[a] = (rr[0] * rr[1]) * (rr[2] * rr[3]);
            }
            float oth[8], Ts[8];
#pragma unroll
            for (int a = 0; a < 8; ++a) oth[a] = other_half(ga[a], hi);
            float run = 1.0f;
#pragma unroll
            for (int a = 7; a >= 0; --a) { Ts[a] = run; run *= ga[a] * oth[a]; }
#pragma unroll
            for (int a = 0; a < 8; ++a) {
                float E = carry * Ts[a] * (hi ? 1.0f : oth[a]);
#pragma unroll
                for (int i = 3; i >= 0; --i) { const int r = 4 * (a & 3) + i; const float rv = (a < 4) ? p0[r] : p1[r]; const float w = (1.0f - rv) * E; E *= rv; if (a < 4) p0[r] = w; else p1[r] = w; }
            }
            carry *= run;
            u32x4 w0, w1, w2, w3;
#pragma unroll
            for (int j = 0; j < 4; ++j) { w0[j] = cvtpk(p0[2 * j], p0[2 * j + 1]); w1[j] = cvtpk(p0[8 + 2 * j], p0[8 + 2 * j + 1]); w2[j] = cvtpk(p1[2 * j], p1[2 * j + 1]); w3[j] = cvtpk(p1[8 + 2 * j], p1[8 + 2 * j + 1]); }
            pv(o, vb0 + slot * SLOTB, __builtin_bit_cast(bf16x8, w0), __builtin_bit_cast(bf16x8, w1), __builtin_bit_cast(bf16x8, w2), __builtin_bit_cast(bf16x8, w3));
            if (__all(carry < 1e-30f)) done = 1;
        }
        if (lane == 0) flg[(k & 1) * 8 + wid] = done;
        slot = slot == 2 ? 0 : slot + 1;
    }
    asm volatile("s_waitcnt vmcnt(0)" ::: "memory");
    float one[16];
#pragma unroll
    for (int r = 0; r < 16; ++r) one[r] = 1.0f;
    store_o(o, one, shm + L_OST + wid * 4096, O + (rowbase + q0 + wid * 32) * DM + h * 64, DM, lane, r32, hi);
    asm volatile("s_waitcnt lgkmcnt(0)\n\ts_barrier" ::: "memory");
#undef ATT_DMA
}

__device__ __forceinline__ void dil_unit(lptr shm, int b, int h, int g, int x, const bf16* PROJ, bf16* OG, float* ST) {
    const int tid = threadIdx.x, lane = tid & 63, r32 = lane & 31, hi = lane >> 5; const int wid = __builtin_amdgcn_readfirstlane(tid >> 6);
    const long rowbase = (long)b * SEQ;
    const int dil = (g == 0) ? 1 : (g == 1) ? 4 : 16;
    const int cls0 = (g == 0) ? 0 : (g == 1) ? (x >> 1) : 2 * x;
    const int i0 = (g == 0) ? 256 * x : (g == 1) ? 256 * (x & 1) : 0;
    const int clsw = cls0 + ((g == 2) ? (wid >> 2) : 0);
    const int qi0w = (g == 2) ? 32 * (wid & 3) : i0 + 32 * wid;
    const int t_lo = (g == 2) ? 0 : ((i0 >> 6) >= 2 ? (i0 >> 6) - 2 : 0);
    const int NT = (g == 2) ? 4 : ((i0 >> 6) + 4 - t_lo);
    const bf16* Qg = PROJ + (size_t)(2 * g) * PLANE; const bf16* Kg = PROJ + (size_t)(2 * g + 1) * PLANE; const bf16* Vg = PROJ + (size_t)6 * PLANE;
    const long dpitch = (long)dil * DM;
    const bf16* Qw = Qg + (rowbase + clsw + (long)qi0w * dil) * DM + h * 64;
    const bf16* Kh = Kg + rowbase * DM + h * 64; const bf16* Vh = Vg + rowbase * DM + h * 64;
    const unsigned lds0 = (unsigned)(uintptr_t)shm;
    LAS float* wsf = (LAS float*)(shm + L_WS) + wid * 64;
    LAS float* tbl = (LAS float*)(shm + L_TBL) + g * 640 + 256;
    bf16x8 qr[4];
#pragma unroll
    for (int d0 = 0; d0 < 4; ++d0) qr[d0] = *(const bf16x8*)(Qw + (long)r32 * dpitch + d0 * 16 + hi * 8);
    const bf16* ksrc = Kh + (long)lane * dpitch + wid * 8;
    const bf16* vsrc = Vh + (long)(16 * (wid & 3) + (lane >> 2)) * dpitch + (wid >> 2) * 32 + (lane & 3) * 8;
    const unsigned kdst = lds0 + L_K + wid * 1024, vdst = lds0 + L_V + wid * 1024;
    const int vb0 = (int)(lds0 + L_V) + ((lane >> 4) & 1) * 32 + (lane & 3) * 8 + (4 * hi + ((lane & 15) >> 2)) * 64;
#define DIL_TCLS(k) ((g == 2) ? cls0 + ((k) >> 1) : cls0)
#define DIL_KB(k) ((g == 2) ? 64 * ((k) & 1) : 64 * (t_lo + (k)))
#define ATT_DMA(k, sl) do { const long tok0_ = DIL_TCLS(k) + (long)DIL_KB(k) * dil; glds16(ksrc + tok0_ * DM, (unsigned)__builtin_amdgcn_readfirstlane(kdst + (sl) * SLOTB)); glds16(vsrc + tok0_ * DM, (unsigned)__builtin_amdgcn_readfirstlane(vdst + (sl) * SLOTB)); } while (0)
    asm volatile("s_waitcnt vmcnt(0)" : "+v"(qr[0]), "+v"(qr[1]), "+v"(qr[2]), "+v"(qr[3]) :: "memory");
    ATT_DMA(0, 0); ATT_DMA(1, 1);
    float mref = -1e30f, lsum = 0.f; f32x16 o[2]; o[0] = f32x16{}; o[1] = f32x16{};
    int slot = 0;
    for (int k = 0; k < NT; ++k) {
        if (k + 1 < NT) ATT_WAIT_BAR(2); else ATT_WAIT_BAR(0);
        if (k + 2 < NT) { const int s2 = slot >= 1 ? slot - 1 : 2; ATT_DMA(k + 2, s2); }
        const int kb = DIL_KB(k);
        if (DIL_TCLS(k) == clsw && kb <= qi0w + 31 && kb >= qi0w - 191) {
            f32x16 p0, p1; qkt(p0, p1, shm + L_K + slot * SLOTB, qr, r32, hi);
            const int dbase = qi0w + r32 - kb - 4 * hi;
#pragma unroll
            for (int r = 0; r < 16; ++r) { const int cr = (r & 3) + 8 * (r >> 2); p0[r] += tbl[dbase - cr]; p1[r] += tbl[dbase - cr - 32]; }
            const float rm = rowmax32(p0, p1, hi);
            const bool fresh = mref <= -1e30f;
            const bool want = !fresh && (rm > mref + THR);
            if (fresh) mref = fmaxf(rm, -1e30f);
            if (__any(want)) {
                const float dl = want ? rm - mref : 0.f; mref += dl; const float f = __builtin_amdgcn_exp2f(-dl); lsum *= f;
                if (hi == 0) wsf[r32] = f;
                asm volatile("s_waitcnt lgkmcnt(0)" ::: "memory");
#pragma unroll
                for (int r = 0; r < 16; ++r) { const float fr = wsf[crow(r, hi)]; o[0][r] *= fr; o[1][r] *= fr; }
            }
            float sacc = 0.f;
#pragma unroll
            for (int r = 0; r < 16; ++r) { p0[r] = __builtin_amdgcn_exp2f(p0[r] - mref); p1[r] = __builtin_amdgcn_exp2f(p1[r] - mref); sacc += p0[r] + p1[r]; }
            lsum += sacc;
            u32x4 w0, w1, w2, w3;
#pragma unroll
            for (int j = 0; j < 4; ++j) { w0[j] = cvtpk(p0[2 * j], p0[2 * j + 1]); w1[j] = cvtpk(p0[8 + 2 * j], p0[8 + 2 * j + 1]); w2[j] = cvtpk(p1[2 * j], p1[2 * j + 1]); w3[j] = cvtpk(p1[8 + 2 * j], p1[8 + 2 * j + 1]); }
            pv(o, vb0 + slot * SLOTB, __builtin_bit_cast(bf16x8, w0), __builtin_bit_cast(bf16x8, w1), __builtin_bit_cast(bf16x8, w2), __builtin_bit_cast(bf16x8, w3));
        }
        slot = slot == 2 ? 0 : slot + 1;
    }
    lsum += other_half(lsum, hi);
    if (hi == 0) { wsf[32 + r32] = lsum;
        const long tok = rowbase + clsw + (long)(qi0w + r32) * dil;
        *(f32x2*)(ST + ((size_t)g * M * NH + (size_t)tok * NH + h) * 2) = (f32x2){mref, lsum}; }
    asm volatile("s_waitcnt lgkmcnt(0)" ::: "memory");
    float rli[16];
#pragma unroll
    for (int r = 0; r < 16; ++r) rli[r] = __builtin_amdgcn_rcpf(wsf[32 + crow(r, hi)]);
    store_o(o, rli, shm + L_OST + wid * 4096, OG + (size_t)g * PLANE + (rowbase + clsw + (long)qi0w * dil) * DM + h * 64, dpitch, lane, r32, hi);
    asm volatile("s_waitcnt lgkmcnt(0)\n\ts_barrier" ::: "memory");
#undef ATT_DMA
#undef DIL_TCLS
#undef DIL_KB
}
__device__ __forceinline__ int t5_bucket_f(int dist) {
    if (dist < 16) return dist;
    int lb = 16 + (int)(logf((float)dist / 16.0f) / logf(128.0f) * 16.0f);
    return lb < 31 ? lb : 31;
}
__device__ __forceinline__ void dil_phase(lptr shm, int G, const bf16* PROJ, bf16* OG, float* ST, const float* rel_bias) {
    const int bx = blockIdx.x; const int vcu = (G % 8 == 0) ? (bx % 8) * (G / 8) + bx / 8 : bx;
    for (int u = vcu; u < BATCH * NH * 2; u += G) {
        const int bh = u >> 1, p = u & 1, b = bh >> 4, h = bh & 15;
        LAS float* tb = (LAS float*)(shm + L_TBL);
        for (int i = threadIdx.x; i < 3 * 640; i += NTHR) { const int gg = i / 640, dl = i - gg * 640 - 256; const int dil = (gg == 0) ? 1 : (gg == 1) ? 4 : 16;
            tb[i] = (dl >= 0 && dl <= 128) ? rel_bias[t5_bucket_f(dl * dil) * 16 + h] * LOG2E : -INFINITY; }
#pragma unroll 1
        for (int j = 0; j < 24; ++j) {
            const int g = j >> 3, x = j & 7;
            const int par = (g == 1) ? ((x >> 1) & 1) : (x & 1);
            if (par != p) continue;
            dil_unit(shm, b, h, g, x, PROJ, OG, ST);
        }
    }
}
__device__ __forceinline__ void dil_merge(int G, const bf16* OG, const float* ST, bf16* O) {
    for (int idx = blockIdx.x * NTHR + threadIdx.x; idx < M * NH; idx += G * NTHR) {
        const f32x2 s0 = *(const f32x2*)(ST + ((size_t)0 * M * NH + idx) * 2), s1 = *(const f32x2*)(ST + ((size_t)1 * M * NH + idx) * 2), s2 = *(const f32x2*)(ST + ((size_t)2 * M * NH + idx) * 2);
        const float mx = fmaxf(s0.x, fmaxf(s1.x, s2.x));
        float w0 = __builtin_amdgcn_exp2f(s0.x - mx) * s0.y, w1 = __builtin_amdgcn_exp2f(s1.x - mx) * s1.y, w2 = __builtin_amdgcn_exp2f(s2.x - mx) * s2.y;
        const float inv = 1.0f / (w0 + w1 + w2); w0 *= inv; w1 *= inv; w2 *= inv;
        const GAS v4u* a0 = (const GAS v4u*)(OG + (size_t)idx * 64); const GAS v4u* a1 = (const GAS v4u*)(OG + PLANE + (size_t)idx * 64); const GAS v4u* a2 = (const GAS v4u*)(OG + 2 * PLANE + (size_t)idx * 64);
        GAS v4u* op = (GAS v4u*)(O + (size_t)idx * 64);
#pragma unroll
        for (int c = 0; c < 8; ++c) { const v4u x0 = a0[c], x1 = a1[c], x2 = a2[c]; v4u r;
#pragma unroll
            for (int q = 0; q < 4; ++q) r[q] = pk2(w0 * bflo(x0[q]) + w1 * bflo(x1[q]) + w2 * bflo(x2[q]), w0 * bfhi(x0[q]) + w1 * bfhi(x1[q]) + w2 * bfhi(x2[q]));
            op[c] = r; }
    }
}

template <int MODE>
__device__ __forceinline__ void causal_phase(lptr shm, int G, const bf16* Q, const bf16* K, const bf16* V, bf16* O, const float* cum) {
    const int bx = blockIdx.x; const int vcu = (G % 8 == 0) ? (bx % 8) * (G / 8) + bx / 8 : bx;
    for (int u = vcu; u < BATCH * NH * 2; u += G) {
        const int bh = u >> 1, p = u & 1, b = bh >> 4, h = bh & 15;
#pragma unroll 1
        for (int i = 0; i < 4; ++i) {
            const int qb = (i == 0) ? 7 - p : (i == 1) ? 5 - p : (i == 2) ? 2 + p : p;
            if (MODE == 0) sb_unit(shm, b, h, qb, Q, K, V, O); else fox_unit(shm, b, h, qb, Q, K, V, O, cum);
        }
    }
}
}

enum { CV_PLAIN = 0, CV_QKN = 1, CV_GATE = 2, CV_UP = 3 };
__device__ __forceinline__ int cv_dst_row(int mode, int n) {
    if (mode == CV_QKN) return (n & ~255) + 128 * ((n >> 5) & 1) + 32 * ((n >> 6) & 3) + (n & 31);
    if (mode == CV_GATE) return 256 * (n >> 7) + (n & 127);
    if (mode == CV_UP) return 256 * (n >> 7) + 128 + (n & 127);
    return n;
}
__device__ __forceinline__ void conv_item(const float* W, int ldw, int K, bf16* WT, int mode, LAS unsigned char* scr, int item, int nblk, int lane) {
    const int kb = item / nblk, nb = item - kb * nblk, k0 = 64 * kb, n0 = 64 * nb;
    const GAS float* src = (const GAS float*)(W + (size_t)k0 * ldw + n0 + lane);
#pragma unroll
    for (int kc = 0; kc < 8; ++kc) {
        float v[8];
#pragma unroll
        for (int j = 0; j < 8; ++j) v[j] = src[(size_t)(kc * 8 + j) * ldw];
        v4u w; w.x = pk2(v[0], v[1]); w.y = pk2(v[2], v[3]); w.z = pk2(v[4], v[5]); w.w = pk2(v[6], v[7]);
        *(LAS v4u*)(scr + lane * 144 + kc * 16) = w;
    }
    asm volatile("s_waitcnt lgkmcnt(0)" ::: "memory");
#pragma unroll
    for (int j = 0; j < 8; ++j) { const int n = 8 * j + (lane >> 3), ch = lane & 7;
        const v4u w = *(const LAS v4u*)(scr + n * 144 + ch * 16);
        *(GAS v4u*)(WT + (size_t)cv_dst_row(mode, n0 + n) * K + k0 + 8 * ch) = w; }
    asm volatile("s_waitcnt lgkmcnt(0)" ::: "memory");
}
__device__ __forceinline__ void conv_job(Frame& F, const float* W, int ldw, int K, int N, bf16* WT, int mode, int& rot) {
    LAS unsigned char* scr = F.lds + F.wave * 9216;
    const int nblk = N / 64, nitems = (K / 64) * nblk, NGW = F.G * NWAVES, gw = blockIdx.x * NWAVES + F.wave;
    int first = gw - (rot % NGW); if (first < 0) first += NGW;
    for (int it = first; it < nitems; it += NGW) conv_item(W, ldw, K, WT, mode, scr, it, nblk, F.lane);
    rot += nitems;
}
__device__ __forceinline__ void convert_weights(Frame& F) {
    bf16* WB = (bf16*)(F.ws + WS_W); int rot = 0;
    for (int j = 0; j < 2; ++j) conv_job(F, INP(1) + (size_t)j * DM * 3 * DM, 3 * DM, DM, 3 * DM, WB + WE_QKV + (size_t)j * 3 * DM * DM, CV_PLAIN, rot);
    for (int j = 0; j < 2; ++j) conv_job(F, INP(2) + (size_t)j * DM * DM, DM, DM, DM, WB + WE_WO_SB + (size_t)j * DM * DM, CV_PLAIN, rot);
    conv_job(F, INP(3), 7 * DM, DM, 7 * DM, WB + WE_IN_DIL, CV_QKN, rot);
    conv_job(F, INP(6), DM, DM, DM, WB + WE_WO_DIL, CV_PLAIN, rot);
    conv_job(F, INP(7), 3088, DM, 3 * DM, WB + WE_IN_FOX, CV_QKN, rot);
    conv_job(F, INP(11), DM, DM, DM, WB + WE_WO_FOX, CV_PLAIN, rot);
    for (int f = 0; f < 2; ++f) {
        conv_job(F, INP(15) + (size_t)f * DM * FF, FF, DM, FF, WB + WE_GU + (size_t)f * 2 * FF * DM, CV_GATE, rot);
        conv_job(F, INP(16) + (size_t)f * DM * FF, FF, DM, FF, WB + WE_GU + (size_t)f * 2 * FF * DM, CV_UP, rot);
        conv_job(F, INP(17) + (size_t)f * FF * DM, DM, FF, DM, WB + WE_D + (size_t)f * DM * FF, CV_PLAIN, rot);
    }
    for (int fe = 0; fe < 16; ++fe) {
        conv_job(F, INP(19) + (size_t)fe * DM * FF, FF, DM, FF, WB + WE_MGU + (size_t)fe * 2 * FF * DM, CV_GATE, rot);
        conv_job(F, INP(20) + (size_t)fe * DM * FF, FF, DM, FF, WB + WE_MGU + (size_t)fe * 2 * FF * DM, CV_UP, rot);
        conv_job(F, INP(21) + (size_t)fe * FF * DM, DM, FF, DM, WB + WE_MD + (size_t)fe * DM * FF, CV_PLAIN, rot);
    }
}

__device__ __forceinline__ int moe_cnt(Frame& F, int f, int e) {
    const unsigned long long w = __hip_atomic_load((GAS unsigned long long*)(F.ctl + CW_CNT + f * 64 + 16 * (e >> 2)), RLX_AGENT);
    return (int)((w >> (16 * (e & 3))) & 0xffffull);
}
__device__ __forceinline__ f32x4 moe_yrow(Frame& F, int r, int q4) {
    const bf16* Y = (const bf16*)(F.ws + WS_R2); const bf16* P = (const bf16*)(F.ws + WS_R2 + 72 * MiB);
    if (r < SPLIT_ROW0 || F.G != 256 || !MOE_SPLITK) { const v2u a = ((const GAS v2u*)(Y + (size_t)r * DM))[q4]; return (f32x4){bflo(a.x), bfhi(a.x), bflo(a.y), bfhi(a.y)}; }
    f32x4 s = (f32x4){0.f, 0.f, 0.f, 0.f};
#pragma unroll
    for (int k = 0; k < 4; ++k) { const v2u a = ((const GAS v2u*)(P + ((size_t)k * SPLIT_ROWS + (size_t)(r - SPLIT_ROW0)) * DM))[q4]; s = s + (f32x4){bflo(a.x), bfhi(a.x), bflo(a.y), bfhi(a.y)}; }
    return s;
}
__device__ __forceinline__ void moe_bases(Frame& F, int f, int (&tb)[NE + 1]) {
    int acc = 0;
#pragma unroll
    for (int e = 0; e < NE; ++e) { tb[e] = acc; const int c = moe_cnt(F, f, e); acc += (c + 255) >> 8; }
    tb[NE] = acc;
}

template <int NC>
__device__ __forceinline__ float wave_reduce_cols(float (&part)[NC], int lane) {
#pragma unroll
    for (int st = 0, n = NC / 2; n >= 1; ++st, n >>= 1) {
        const bool up = (lane >> st) & 1;
#pragma unroll
        for (int i = 0; i < n; ++i) { const float keep = up ? part[i + n] : part[i], send = up ? part[i] : part[i + n]; part[i] = keep + __shfl_xor(send, 1 << st); }
    }
    float v = part[0];
#pragma unroll
    for (int o = NC; o < 64; o <<= 1) v += __shfl_xor(v, o);
    return v;
}
template <int NC> __device__ __forceinline__ int lane_of_col(int c) {
    int l = 0;
#pragma unroll
    for (int st = 0, n = NC / 2; n >= 1; ++st, n >>= 1) { if (c & n) l |= 1 << st; }
    return l;
}
template <int FLAGS>
__device__ __forceinline__ void norm_phase(Frame& F, const float* xin, float* xout, const float* gain, bf16* H, int fprev, int f,
                                           const float* Wf  , const float* bf  , const float* Wr  ) {
    constexpr int NC = (FLAGS & 2) ? 16 : (FLAGS & 4) ? 8 : 0;
    const bf16* Y = (const bf16*)(F.ws + WS_R2);
    const int* tok_prev = (const int*)(F.ws + WS_MISC + MS_TOK) + (size_t)fprev * M * 2;
    float* lgf = (float*)(F.ws + WS_MISC + MS_LOGF);
    LAS int* sel = (LAS int*)F.lds;
    LAS float* sg = (LAS float*)(F.lds + 512);
    LAS int* gb = (LAS int*)(F.lds + 1536);
    LAS f32x4* WL = (LAS f32x4*)(F.lds + 4096);
    int tb[NE + 1];
    if (FLAGS & 1) moe_bases(F, fprev, tb);
    if (NC) {
        const float* Wsrc = (FLAGS & 2) ? Wf + 3072 : Wr; const int ldw = (FLAGS & 2) ? 3088 : 8;
        for (int idx = F.tid; idx < 16 * (NC / 4) * 64; idx += NTHR) {
            const int ln = idx & 63, cq = (idx >> 6) % (NC / 4), jq = idx / (64 * (NC / 4)), k = 4 * (ln + 64 * (jq >> 2)) + (jq & 3);
            WL[idx] = *(const GAS f32x4*)(Wsrc + (size_t)k * ldw + 4 * cq) * gain[k];
        }
        __syncthreads();
    }
    for (int chunk = blockIdx.x; chunk < M / 64; chunk += F.G) {
        for (int i = 0; i < 8; ++i) {
            const int m = chunk * 64 + F.wave * 8 + i;
            int ln = F.lane; asm volatile("" : "+v"(ln));
            const GAS f32x4* xr = (const GAS f32x4*)(xin + (size_t)m * DM) + ln;
            f32x4 v[4];
#pragma unroll
            for (int j = 0; j < 4; ++j) v[j] = xr[64 * j];
            if (FLAGS & 1) {
                const int s0 = tok_prev[m * 2], s1 = tok_prev[m * 2 + 1];
                int r0 = 0, r1 = 0;
#pragma unroll
                for (int e = 0; e < NE; ++e) { if ((s0 >> 14) == e) r0 = tb[e] * 256 + (s0 & 16383); if ((s1 >> 14) == e) r1 = tb[e] * 256 + (s1 & 16383); }
#pragma unroll
                for (int j = 0; j < 4; ++j) { v[j] = v[j] + moe_yrow(F, r0, ln + 64 * j) + moe_yrow(F, r1, ln + 64 * j);
                    ((GAS f32x4*)(xout + (size_t)m * DM) + ln)[64 * j] = v[j]; }
            }
            float s = 0.f;
#pragma unroll
            for (int j = 0; j < 4; ++j) s += (v[j].x * v[j].x + v[j].y * v[j].y) + (v[j].z * v[j].z + v[j].w * v[j].w);
            const float inv = 1.0f / sqrtf(wave_sum(s) * (1.f / DM) + RMS_EPS);
            float colv = 0.f;
            if (NC) {
                float part[NC ? NC : 1];
#pragma unroll
                for (int c = 0; c < NC; ++c) part[c] = 0.f;
                const int woff = ln;
#pragma unroll
                for (int j = 0; j < 4; ++j) {
#pragma unroll
                    for (int q = 0; q < 4; ++q) { const float xv = v[j][q];
#pragma unroll
                        for (int cq = 0; cq < NC / 4; ++cq) { const f32x4 w = WL[((j * 4 + q) * (NC / 4) + cq) * 64 + woff];
                            part[cq * 4 + 0] += xv * w.x; part[cq * 4 + 1] += xv * w.y; part[cq * 4 + 2] += xv * w.z; part[cq * 4 + 3] += xv * w.w; }
                        if ((q & 1) == 1) asm volatile("" ::: "memory"); } }
                colv = wave_reduce_cols<NC ? NC : 2>(reinterpret_cast<float (&)[NC ? NC : 2]>(part), ln) * inv;
            }
            if (H) {
                GAS unsigned long long* o8 = (GAS unsigned long long*)(H + (size_t)m * DM) + ln;
#pragma unroll
                for (int j = 0; j < 4; ++j) { const f32x4 g = ((const GAS f32x4*)gain + ln)[64 * j]; const f32x4 hv = v[j] * inv * g;
                    o8[64 * j] = (unsigned long long)pk2(hv.x, hv.y) | ((unsigned long long)pk2(hv.z, hv.w) << 32); }
            }
            if (FLAGS & 2) {
                if (ln < 16) { const int l = ln; const int c = ((l & 1) << 3) | ((l & 2) << 1) | ((l & 4) >> 1) | ((l & 8) >> 3);
                    const float z = colv + bf[c]; const float ls = fminf(z, 0.f) - log1pf(expf(-fabsf(z))); lgf[(size_t)m * 16 + c] = ls * LOG2E; }
            }
            if (FLAGS & 4) {
                float lg[8];
#pragma unroll
                for (int c = 0; c < 8; ++c) lg[c] = __builtin_bit_cast(float, __builtin_amdgcn_readlane(__builtin_bit_cast(int, colv), lane_of_col<8>(c)));
                int e0 = 0; float l0 = lg[0];
#pragma unroll
                for (int c = 1; c < 8; ++c) if (lg[c] > l0) { l0 = lg[c]; e0 = c; }
                int e1 = -1; float l1 = -INFINITY;
#pragma unroll
                for (int c = 0; c < 8; ++c) if (c != e0 && lg[c] > l1) { l1 = lg[c]; e1 = c; }
                const float g0 = 1.0f / (1.0f + expf(l1 - l0)), g1 = 1.0f - g0;
                if (ln == 0) { const int r = F.wave * 8 + i; sel[r * 2] = e0; sel[r * 2 + 1] = e1; sg[r * 2] = g0; sg[r * 2 + 1] = g1; }
            }
        }
        if (FLAGS & 4) {
            int* selg = (int*)(F.ws + WS_MISC + MS_SEL) + (size_t)f * M * 2;
            float* sgg = (float*)(F.ws + WS_MISC + MS_SG) + (size_t)f * M * 2;
            int* lcn = (int*)(F.ws + WS_MISC + MS_LC) + (size_t)f * 256 * 8;
            __syncthreads();
            if (F.tid < 128) { selg[chunk * 128 + F.tid] = sel[F.tid]; sgg[chunk * 128 + F.tid] = sg[F.tid]; }
            if (F.tid >= 128 && F.tid < 136) { const int e = F.tid - 128; int c = 0;
                for (int q = 0; q < 128; ++q) c += (sel[q] == e) ? 1 : 0;
                lcn[chunk * 8 + e] = c; }
            __syncthreads();
        }
    }
}

__device__ __forceinline__ void moe_finalize(Frame& F, int f) {
    const int* selg = (const int*)(F.ws + WS_MISC + MS_SEL) + (size_t)f * M * 2;
    const float* sgg = (const float*)(F.ws + WS_MISC + MS_SG) + (size_t)f * M * 2;
    const int* lcn = (const int*)(F.ws + WS_MISC + MS_LC) + (size_t)f * 256 * 8;
    int* list = (int*)(F.ws + WS_MISC + MS_LIST) + (size_t)f * NE * LCAP;
    float* gw = (float*)(F.ws + WS_MISC + MS_GW) + (size_t)f * NE * LCAP;
    int* tok = (int*)(F.ws + WS_MISC + MS_TOK) + (size_t)f * M * 2;
    LAS int* arr = (LAS int*)F.lds;
    LAS int* sel = (LAS int*)(F.lds + 8192);
    LAS int* pb = (LAS int*)(F.lds + 8192 + 512);
    LAS int* pt = (LAS int*)(F.lds + 8192 + 1536);
    LAS int* base = (LAS int*)(F.lds + 8192 + 2560);
    LAS int* tot = (LAS int*)(F.lds + 8192 + 2592);
    for (int chunk = blockIdx.x; chunk < M / 64; chunk += F.G) {
        if (F.tid < 256) { const v4u a = *(const GAS v4u*)(lcn + F.tid * 8), b = *(const GAS v4u*)(lcn + F.tid * 8 + 4);
            *(LAS v4u*)(arr + F.tid * 8) = a; *(LAS v4u*)(arr + F.tid * 8 + 4) = b; }
        if (F.tid < 128) sel[F.tid] = selg[chunk * 128 + F.tid];
        __syncthreads();
        if (F.tid < 256) { const int e = F.tid & 7, seg = F.tid >> 3; int b = 0, t = 0;
#pragma unroll
            for (int i = 0; i < 8; ++i) { const int c = seg * 8 + i; const int v = arr[c * 8 + e]; t += v; b += (c < chunk) ? v : 0; }
            pb[seg * 8 + e] = b; pt[seg * 8 + e] = t; }
        __syncthreads();
        if (F.tid < 8) { int b = 0, t = 0;
            for (int sgm = 0; sgm < 32; ++sgm) { b += pb[sgm * 8 + F.tid]; t += pt[sgm * 8 + F.tid]; }
            base[F.tid] = b; tot[F.tid] = t; }
        __syncthreads();
        if (F.tid < 128) { const int mye = sel[F.tid]; int lp = 0;
            for (int q = 0; q < 128; ++q) lp += (q < F.tid && sel[q] == mye) ? 1 : 0;
            const int q = F.tid, row = chunk * 64 + (q >> 1), pos = base[mye] + lp;
            list[mye * LCAP + pos] = row; gw[mye * LCAP + pos] = sgg[chunk * 128 + q]; tok[row * 2 + (q & 1)] = mye * LCAP + pos; }
        if (chunk == 0 && F.tid < 2) { unsigned long long w = 0ull;
#pragma unroll
            for (int i = 0; i < 4; ++i) w |= (unsigned long long)(unsigned)tot[4 * F.tid + i] << (16 * i);
            __hip_atomic_store((GAS unsigned long long*)(F.ctl + CW_CNT + f * 64 + 16 * F.tid), w, RLX_AGENT); }
        __syncthreads();
    }
}

__device__ __forceinline__ void final_combine(Frame& F, int f) {
    const bf16* Y = (const bf16*)(F.ws + WS_R2);
    const int* tok = (const int*)(F.ws + WS_MISC + MS_TOK) + (size_t)f * M * 2;
    int tb[NE + 1]; moe_bases(F, f, tb);
    for (int m = blockIdx.x * NWAVES + F.wave; m < M; m += F.G * NWAVES) {
        const int s0 = tok[m * 2], s1 = tok[m * 2 + 1]; int r0 = 0, r1 = 0;
#pragma unroll
        for (int e = 0; e < NE; ++e) { if ((s0 >> 14) == e) r0 = tb[e] * 256 + (s0 & 16383); if ((s1 >> 14) == e) r1 = tb[e] * 256 + (s1 & 16383); }
        GAS f32x4* xr = (GAS f32x4*)(F.out + (size_t)m * DM) + F.lane;
#pragma unroll
        for (int j = 0; j < 4; ++j) xr[64 * j] = xr[64 * j] + moe_yrow(F, r0, F.lane + 64 * j) + moe_yrow(F, r1, F.lane + 64 * j);
    }
}

__device__ __forceinline__ void cumsum_phase(Frame& F) {
    const float* logf = (const float*)(F.ws + WS_MISC + MS_LOGF);
    float* cum = (float*)(F.ws + WS_MISC + MS_CUM);
    const int gw = blockIdx.x * NWAVES + F.wave;
    if (gw < BATCH * NH) {
        const int b = gw >> 4, h = gw & 15;
        float v[32]; float s = 0.f;
#pragma unroll
        for (int i = 0; i < 32; ++i) { v[i] = logf[((size_t)b * SEQ + F.lane * 32 + i) * 16 + h]; s += v[i]; }
        float incl = s;
#pragma unroll
        for (int o = 1; o < 64; o <<= 1) { const float t = __shfl_up(incl, o); if (F.lane >= o) incl += t; }
        float run = incl - s;
#pragma unroll
        for (int i = 0; i < 32; ++i) { run += v[i]; cum[((size_t)b * SEQ + F.lane * 32 + i) * 16 + h] = run; }
    }
}

enum { EPI_PLANES = 0, EPI_RESID = 1, EPI_SWIGLU = 2, EPI_MOEDOWN = 3 };
struct SgP { const bf16* A; int lda; const int* rowidx; int Mrows; const float* W0; const float* W1; int ldw; int K; int N;
             bf16* outb; int ldo; float scale0; const float* base; float* outf; const float* gwv; };
template <int EPI>
__device__ __forceinline__ void sgemm(Frame& F, const SgP& p) {
    LAS float* As = (LAS float*)F.lds;
    LAS float* Bs0 = As + 16 * 132;
    LAS float* Bs1 = Bs0 + 16 * 128;
    const int tid = F.tid, ty = tid >> 4, tx = tid & 15;
    const int lrow = tid >> 2, lkq = (tid & 3) * 4;
    const int bk = tid >> 5, bn = (tid & 31) * 4;
    const int ntn = p.N / 128, ntiles = (p.Mrows / 128) * ntn;
    for (int tile = blockIdx.x; tile < ntiles; tile += F.G) {
        const int tm = tile / ntn, tn = tile % ntn;
        const int arow = p.rowidx ? p.rowidx[tm * 128 + lrow] : tm * 128 + lrow;
        const bf16* ap = p.A + (size_t)arow * p.lda + lkq;
        const float* bp0 = p.W0 + (size_t)bk * p.ldw + tn * 128 + bn;
        const float* bp1 = (EPI == EPI_SWIGLU) ? p.W1 + (size_t)bk * p.ldw + tn * 128 + bn : nullptr;
        f32x2 acc0[4][4], acc1[4][4];
#pragma unroll
        for (int i = 0; i < 4; ++i)
#pragma unroll
            for (int j = 0; j < 4; ++j) { acc0[i][j] = (f32x2){0.f, 0.f}; acc1[i][j] = (f32x2){0.f, 0.f}; }
        for (int k0 = 0; k0 < p.K; k0 += 16) {
            const v2u av = *(const GAS v2u*)(ap + k0);
            const f32x4 b0 = *(const GAS f32x4*)(bp0 + (size_t)k0 * p.ldw);
            f32x4 b1 = (f32x4){0.f, 0.f, 0.f, 0.f};
            if (EPI == EPI_SWIGLU) b1 = *(const GAS f32x4*)(bp1 + (size_t)k0 * p.ldw);
            __syncthreads();
            As[(lkq + 0) * 132 + lrow] = bflo(av.x); As[(lkq + 1) * 132 + lrow] = bfhi(av.x);
            As[(lkq + 2) * 132 + lrow] = bflo(av.y); As[(lkq + 3) * 132 + lrow] = bfhi(av.y);
            *(LAS f32x4*)(Bs0 + bk * 128 + bn) = b0;
            if (EPI == EPI_SWIGLU) *(LAS f32x4*)(Bs1 + bk * 128 + bn) = b1;
            __syncthreads();
#pragma unroll 2
            for (int k = 0; k < 16; ++k) {
                const f32x4 a = *(const LAS f32x4*)(As + k * 132 + ty * 4);
                const f32x4 bA = *(const LAS f32x4*)(Bs0 + k * 128 + tx * 8), bB = *(const LAS f32x4*)(Bs0 + k * 128 + tx * 8 + 4);
                const f32x2 bv[4] = {(f32x2){bA.x, bA.y}, (f32x2){bA.z, bA.w}, (f32x2){bB.x, bB.y}, (f32x2){bB.z, bB.w}};
#pragma unroll
                for (int i = 0; i < 4; ++i) {
#pragma unroll
                    for (int j = 0; j < 4; ++j) acc0[i][j] += a[i] * bv[j]; }
                if (EPI == EPI_SWIGLU) {
                    const f32x4 cA = *(const LAS f32x4*)(Bs1 + k * 128 + tx * 8), cB = *(const LAS f32x4*)(Bs1 + k * 128 + tx * 8 + 4);
                    const f32x2 cv[4] = {(f32x2){cA.x, cA.y}, (f32x2){cA.z, cA.w}, (f32x2){cB.x, cB.y}, (f32x2){cB.z, cB.w}};
#pragma unroll
                    for (int i = 0; i < 4; ++i) {
#pragma unroll
                        for (int j = 0; j < 4; ++j) acc1[i][j] += a[i] * cv[j]; }
                }
                __builtin_amdgcn_sched_barrier(0);
            }
        }
        const int c0 = tn * 128 + tx * 8;
#pragma unroll
        for (int i = 0; i < 4; ++i) {
            const int r = tm * 128 + ty * 4 + i;
            if (EPI == EPI_PLANES) {
                const int pl = c0 >> 10, cc = c0 & 1023; const float sc = (pl == 0) ? p.scale0 : 1.f;
                v4u w; w.x = pk2(acc0[i][0].x * sc, acc0[i][0].y * sc); w.y = pk2(acc0[i][1].x * sc, acc0[i][1].y * sc); w.z = pk2(acc0[i][2].x * sc, acc0[i][2].y * sc); w.w = pk2(acc0[i][3].x * sc, acc0[i][3].y * sc);
                *(GAS v4u*)(p.outb + (size_t)pl * PLANE + (size_t)r * DM + cc) = w;
            } else if (EPI == EPI_RESID) {
                const GAS f32x4* bp = (const GAS f32x4*)(p.base + (size_t)r * DM + c0); GAS f32x4* op = (GAS f32x4*)(p.outf + (size_t)r * DM + c0);
                const f32x4 x0 = bp[0], x1 = bp[1];
                op[0] = x0 + (f32x4){acc0[i][0].x, acc0[i][0].y, acc0[i][1].x, acc0[i][1].y}; op[1] = x1 + (f32x4){acc0[i][2].x, acc0[i][2].y, acc0[i][3].x, acc0[i][3].y};
            } else if (EPI == EPI_SWIGLU) {
                float o[8];
#pragma unroll
                for (int j = 0; j < 8; ++j) { const float g = acc0[i][j >> 1][j & 1], uu = acc1[i][j >> 1][j & 1]; o[j] = g / (1.0f + __expf(-g)) * uu; }
                v4u w; w.x = pk2(o[0], o[1]); w.y = pk2(o[2], o[3]); w.z = pk2(o[4], o[5]); w.w = pk2(o[6], o[7]);
                *(GAS v4u*)(p.outb + (size_t)r * p.ldo + c0) = w;
            } else {
                const float g = p.gwv[r]; GAS f32x4* op = (GAS f32x4*)(p.outf + (size_t)r * DM + c0);
                op[0] = (f32x4){acc0[i][0].x * g, acc0[i][0].y * g, acc0[i][1].x * g, acc0[i][1].y * g}; op[1] = (f32x4){acc0[i][2].x * g, acc0[i][2].y * g, acc0[i][3].x * g, acc0[i][3].y * g};
            }
        }
    }
}

__device__ __forceinline__ void qknorm_plane(Frame& F, bf16* plane, const float* gain, float mul) {
    const int nth = F.G * NTHR;
    for (int idx = blockIdx.x * NTHR + F.tid; idx < M * NH; idx += nth) {
        GAS v4u* p = (GAS v4u*)(plane + (size_t)idx * 64);
        v4u w[8]; float ss = 0.f;
#pragma unroll
        for (int c = 0; c < 8; ++c) { w[c] = p[c];
#pragma unroll
            for (int q = 0; q < 4; ++q) { const float a = bflo(w[c][q]), b = bfhi(w[c][q]); ss += a * a + b * b; } }
        const float inv = 1.0f / sqrtf(ss * (1.f / 64.f) + RMS_EPS) * mul;
#pragma unroll
        for (int c = 0; c < 8; ++c) { v4u o;
#pragma unroll
            for (int q = 0; q < 4; ++q) { const float a = bflo(w[c][q]) * inv * gain[c * 8 + 2 * q], b = bfhi(w[c][q]) * inv * gain[c * 8 + 2 * q + 1]; o[q] = pk2(a, b); }
            p[c] = o; }
    }
}

template <int MODE>
__device__ __forceinline__ void attn_simple_causal(Frame& F, const bf16* Qp, const bf16* Kp, const bf16* Vp, bf16* O, const float* cum) {
    LAS float* Ks = (LAS float*)F.lds;
    LAS float* Vs = Ks + 4096;
    LAS float* kb = Vs + 4096;
    for (int u = blockIdx.x; u < BATCH * NH * 4; u += F.G) {
        const int qblk = (u & 1) ? 3 - ((u >> 1) & 1) : ((u >> 1) & 1) * 1;
        const int bh = u >> 2, b = bh >> 4, h = bh & 15;
        const int t = qblk * 512 + F.tid;
        const size_t rowbase = (size_t)b * SEQ;
        float q[64], acc[64];
        { const GAS v4u* qp = (const GAS v4u*)(Qp + (rowbase + t) * DM + h * 64);
#pragma unroll
          for (int c = 0; c < 8; ++c) { const v4u w = qp[c];
#pragma unroll
              for (int k = 0; k < 4; ++k) { q[c * 8 + 2 * k] = bflo(w[k]); q[c * 8 + 2 * k + 1] = bfhi(w[k]); } } }
#pragma unroll
        for (int d = 0; d < 64; ++d) acc[d] = 0.f;
        float P = 1.f, mrun = -INFINITY, lrun = 0.f;
        const int ntile = 8 * (qblk + 1);
        for (int it = 0; it < ntile; ++it) {
            const int tile = (MODE == 0) ? ntile - 1 - it : it;
            __syncthreads();
            { const int key = F.tid >> 3, ch = F.tid & 7;
              const v4u kw = *(const GAS v4u*)(Kp + (rowbase + tile * 64 + key) * DM + h * 64 + ch * 8);
              const v4u vw = *(const GAS v4u*)(Vp + (rowbase + tile * 64 + key) * DM + h * 64 + ch * 8);
#pragma unroll
              for (int k = 0; k < 4; ++k) { Ks[key * 64 + ch * 8 + 2 * k] = bflo(kw[k]); Ks[key * 64 + ch * 8 + 2 * k + 1] = bfhi(kw[k]);
                                            Vs[key * 64 + ch * 8 + 2 * k] = bflo(vw[k]); Vs[key * 64 + ch * 8 + 2 * k + 1] = bfhi(vw[k]); }
              if (MODE == 2 && F.tid < 64) kb[F.tid] = -cum[(rowbase + tile * 64 + F.tid) * 16 + h]; }
            __syncthreads();
            for (int jj = 0; jj < 64; ++jj) {
                const int j = (MODE == 0) ? 63 - jj : jj; const int s = tile * 64 + j;
                float z = 0.f;
#pragma unroll
                for (int d4 = 0; d4 < 16; ++d4) { const f32x4 kv = *(const LAS f32x4*)(Ks + j * 64 + d4 * 4); z += q[d4 * 4] * kv.x + q[d4 * 4 + 1] * kv.y + q[d4 * 4 + 2] * kv.z + q[d4 * 4 + 3] * kv.w; }
                if (MODE == 0) {
                    const bool valid = s < t;
                    const float e = __builtin_amdgcn_exp2f(fminf(z, 100.f));
                    float r = 1.0f / (1.0f + e); float beta = 1.0f - r;
                    if (!valid) { r = 1.f; beta = 0.f; }
                    const float w = beta * P; P *= r;
#pragma unroll
                    for (int d4 = 0; d4 < 16; ++d4) { const f32x4 vv = *(const LAS f32x4*)(Vs + j * 64 + d4 * 4); acc[d4 * 4] += w * vv.x; acc[d4 * 4 + 1] += w * vv.y; acc[d4 * 4 + 2] += w * vv.z; acc[d4 * 4 + 3] += w * vv.w; }
                } else {
                    const bool valid = s <= t;
                    const float x = valid ? z + kb[j] : -INFINITY;
                    const float mn = fmaxf(mrun, x);
                    const float a = __builtin_amdgcn_exp2f(mrun - mn), pw = __builtin_amdgcn_exp2f(x - mn);
                    lrun = lrun * a + pw; mrun = mn;
#pragma unroll
                    for (int d4 = 0; d4 < 16; ++d4) { const f32x4 vv = *(const LAS f32x4*)(Vs + j * 64 + d4 * 4);
                        acc[d4 * 4] = acc[d4 * 4] * a + pw * vv.x; acc[d4 * 4 + 1] = acc[d4 * 4 + 1] * a + pw * vv.y; acc[d4 * 4 + 2] = acc[d4 * 4 + 2] * a + pw * vv.z; acc[d4 * 4 + 3] = acc[d4 * 4 + 3] * a + pw * vv.w; }
                }
            }
        }
        const float fin = (MODE == 0) ? 1.f : 1.0f / lrun;
        GAS v4u* op = (GAS v4u*)(O + (rowbase + t) * DM + h * 64);
#pragma unroll
        for (int c = 0; c < 8; ++c) { v4u w;
#pragma unroll
            for (int k = 0; k < 4; ++k) w[k] = pk2(acc[c * 8 + 2 * k] * fin, acc[c * 8 + 2 * k + 1] * fin);
            op[c] = w; }
    }
}

__device__ __forceinline__ int t5_bucket(int dist) {
    if (dist < 16) return dist;
    const float d = (float)dist;
    int lb = 16 + (int)(logf(d / 16.0f) / logf(128.0f) * 16.0f);
    return lb < 31 ? lb : 31;
}
__device__ __forceinline__ void attn_simple_dil(Frame& F, const bf16* PROJ, bf16* O, const float* rel_bias) {
    LAS float* tbl = (LAS float*)F.lds;
    for (int u = blockIdx.x; u < BATCH * NH * 4; u += F.G) {
        const int qblk = u & 3, bh = u >> 2, b = bh >> 4, h = bh & 15;
        const int t = qblk * 512 + F.tid;
        const size_t rowbase = (size_t)b * SEQ;
        __syncthreads();
        for (int i = F.tid; i < 3 * 129; i += NTHR) { const int g = i / 129, dl = i % 129, dil = (g == 0) ? 1 : (g == 1) ? 4 : 16;
            tbl[g * 132 + dl] = rel_bias[t5_bucket(dl * dil) * 16 + h] * LOG2E; }
        __syncthreads();
        float acc[64];
#pragma unroll
        for (int d = 0; d < 64; ++d) acc[d] = 0.f;
        float mrun = -INFINITY, lrun = 0.f;
        for (int g = 0; g < 3; ++g) {
            const int dil = (g == 0) ? 1 : (g == 1) ? 4 : 16;
            const bf16* Qg = PROJ + (size_t)(2 * g) * PLANE; const bf16* Kg = PROJ + (size_t)(2 * g + 1) * PLANE; const bf16* Vg = PROJ + (size_t)6 * PLANE;
            float q[64];
            { const GAS v4u* qp = (const GAS v4u*)(Qg + (rowbase + t) * DM + h * 64);
#pragma unroll
              for (int c = 0; c < 8; ++c) { const v4u w = qp[c];
#pragma unroll
                  for (int k = 0; k < 4; ++k) { q[c * 8 + 2 * k] = bflo(w[k]); q[c * 8 + 2 * k + 1] = bfhi(w[k]); } } }
            for (int dl = 0; dl <= 128; ++dl) {
                const int s = t - dl * dil; const bool valid = s >= 0; const int sc = valid ? s : 0;
                const GAS v4u* kp = (const GAS v4u*)(Kg + (rowbase + sc) * DM + h * 64);
                float z = 0.f;
#pragma unroll
                for (int c = 0; c < 8; ++c) { const v4u w = kp[c];
#pragma unroll
                    for (int k = 0; k < 4; ++k) z += q[c * 8 + 2 * k] * bflo(w[k]) + q[c * 8 + 2 * k + 1] * bfhi(w[k]); }
                const float x = valid ? z + tbl[g * 132 + dl] : -INFINITY;
                const float mn = fmaxf(mrun, x);
                const float a = __builtin_amdgcn_exp2f(mrun - mn), pw = __builtin_amdgcn_exp2f(x - mn);
                lrun = lrun * a + pw; mrun = mn;
                const GAS v4u* vp = (const GAS v4u*)(Vg + (rowbase + sc) * DM + h * 64);
#pragma unroll
                for (int c = 0; c < 8; ++c) { const v4u w = vp[c];
#pragma unroll
                    for (int k = 0; k < 4; ++k) { acc[c * 8 + 2 * k] = acc[c * 8 + 2 * k] * a + pw * bflo(w[k]); acc[c * 8 + 2 * k + 1] = acc[c * 8 + 2 * k + 1] * a + pw * bfhi(w[k]); } }
            }
        }
        const float fin = 1.0f / lrun;
        GAS v4u* op = (GAS v4u*)(O + (rowbase + t) * DM + h * 64);
#pragma unroll
        for (int c = 0; c < 8; ++c) { v4u w;
#pragma unroll
            for (int k = 0; k < 4; ++k) w[k] = pk2(acc[c * 8 + 2 * k] * fin, acc[c * 8 + 2 * k + 1] * fin);
            op[c] = w; }
    }
}

__device__ __forceinline__ void moe_gu_simple(Frame& F, int f, const bf16* H, bf16* ACT) {
    const int* list = (const int*)(F.ws + WS_MISC + MS_LIST) + (size_t)f * NE * LCAP;
    int base = 0;
    for (int e = 0; e < NE; ++e) {
        const int c = moe_cnt(F, f, e); const int nt = (c + 255) >> 8;
        if (nt) {
            SgP p{}; p.A = H; p.lda = DM; p.rowidx = list + e * LCAP; p.Mrows = nt * 256;
            p.W0 = INP(19) + ((size_t)f * NE + e) * DM * FF; p.W1 = INP(20) + ((size_t)f * NE + e) * DM * FF; p.ldw = FF; p.K = DM; p.N = FF;
            p.outb = ACT + (size_t)base * 256 * FF; p.ldo = FF;
            sgemm<EPI_SWIGLU>(F, p);
        }
        base += nt;
    }
}
__device__ __forceinline__ void moe_down_simple(Frame& F, int f, const bf16* ACT, float* Y) {
    const float* gw = (const float*)(F.ws + WS_MISC + MS_GW) + (size_t)f * NE * LCAP;
    int base = 0;
    for (int e = 0; e < NE; ++e) {
        const int c = moe_cnt(F, f, e); const int nt = (c + 255) >> 8;
        if (nt) {
            SgP p{}; p.A = ACT + (size_t)base * 256 * FF; p.lda = FF; p.rowidx = nullptr; p.Mrows = nt * 256;
            p.W0 = INP(21) + ((size_t)f * NE + e) * FF * DM; p.ldw = DM; p.K = FF; p.N = DM;
            p.outf = Y + (size_t)base * 256 * DM; p.gwv = gw + e * LCAP;
            sgemm<EPI_MOEDOWN>(F, p);
        }
        base += nt;
    }
}


template <class Epi>
__device__ __forceinline__ void dense_gemm(Frame& F, const bf16* A, const bf16* Bt, int N, int K, const Epi& E) {
    pg8::DenseOrder S; S.init(A, Bt, M, N, K, F.G, (int)blockIdx.x);
    pg8::gemm_phase<Epi, pg8::DenseOrder, false>(F.lds, K, S, E);
}
__device__ __forceinline__ void moe_order_init(Frame& F, int f, pg8::MoeOrder& S) {
    int acc = 0, t[NE];
#pragma unroll
    for (int e = 0; e < NE; ++e) { const int c = moe_cnt(F, f, e); acc += (c + 255) >> 8; t[e] = acc; }
    S.t1 = t[0]; S.t2 = t[1]; S.t3 = t[2]; S.t4 = t[3]; S.t5 = t[4]; S.t6 = t[5]; S.t7 = t[6]; S.t8 = t[7];
    S.G = F.G; S.c = (int)blockIdx.x;
}
__device__ __forceinline__ void moe_gu_fast(Frame& F, int f, const bf16* H, bf16* ACT) {
    pg8::MoeOrder S; moe_order_init(F, f, S);
    S.nN = 2 * FF / 256; S.K = DM; S.A = (const char*)H; S.Bt = (const char*)((const bf16*)(F.ws + WS_W) + WE_MGU + (size_t)f * NE * 2 * FF * DM);
    S.tstepA = (size_t)256 * DM * 2; S.tstepB = (size_t)256 * DM * 2; S.estepB = (size_t)2 * FF * DM * 2;
    S.list = (const int*)(F.ws + WS_MISC + MS_LIST) + (size_t)f * NE * LCAP; S.gather = true; S.splitk = 0;
    pg8::EpiSwiglu E{ACT};
    pg8::gemm_phase<pg8::EpiSwiglu, pg8::MoeOrder, true>(F.lds, DM, S, E);
}
__device__ __forceinline__ void moe_down_fast(Frame& F, int f, const bf16* ACT, bf16* Y) {
    pg8::MoeOrder S; moe_order_init(F, f, S);
    S.nN = DM / 256; S.K = FF; S.A = (const char*)ACT; S.Bt = (const char*)((const bf16*)(F.ws + WS_W) + WE_MD + (size_t)f * NE * DM * FF);
    S.tstepA = (size_t)256 * FF * 2; S.tstepB = (size_t)256 * FF * 2; S.estepB = (size_t)DM * FF * 2;
    S.list = nullptr; S.gather = false; S.splitk = (MOE_SPLITK && F.G == 256) ? 4 : 0;
    pg8::EpiMoeDown E{Y, (const float*)(F.ws + WS_MISC + MS_GW) + (size_t)f * NE * LCAP, (bf16*)(F.ws + WS_R2 + 72 * MiB)};
    pg8::gemm_phase<pg8::EpiMoeDown, pg8::MoeOrder, false>(F.lds, FF, S, E);
}

struct Args { const float* in[22]; float* out; unsigned char* ws; int ph_lo, ph_hi; };
constexpr int N_PHASES = 33;

__global__ void __launch_bounds__(NTHR, 2) trunk_fwd(Args args) {
    extern __shared__ __attribute__((aligned(16))) unsigned char lds[];
    Frame F;
    F.lds = (LAS unsigned char*)lds;
    F.tid = threadIdx.x; F.lane = F.tid & 63; F.wave = __builtin_amdgcn_readfirstlane(F.tid >> 6); F.G = gridDim.x;
    F.ws = args.ws; F.ctl = (gu32*)(args.ws + WS_CTL); F.out = args.out;
    if (F.tid == 0) {
#pragma unroll
        for (int i = 0; i < 22; ++i) ((LAS unsigned long long*)(F.lds + PTR_OFF))[i] = (unsigned long long)args.in[i];
    }
    volatile LAS unsigned* MISC = (volatile LAS unsigned*)(F.lds + MISC_OFF);
    if (F.tid < 32) MISC[F.tid] = 0u;
    __syncthreads();
    XcdBarrier bar; bar.bar = (unsigned*)(F.ctl + CW_BAR); bar.x = 0; bar.st = nullptr;
    const int lo = args.ph_lo, hi = args.ph_hi;
    if (hi - lo > 1) bar = xcd_barrier_post((unsigned*)(F.ctl + CW_BAR), MISC + 8);
#ifndef PHSEL
#define PHSEL 0xFFFFFFFFFFFFFFFFull
#endif
#define IN(k) (lo <= (k) && (k) < hi && ((PHSEL >> (k)) & 1ull) && relaunder(F))
#define SEAM(k) do { if (IN((k) + 1) && IN(k)) xcd_barrier(bar); } while (0)
#ifndef DUPMASK
#define DUPMASK 0ull
#endif
#define DUP(k) (((DUPMASK >> (k)) & 1ull) != 0ull)

    bf16* H = (bf16*)(F.ws + WS_H);
    bf16* PROJ = (bf16*)(F.ws + WS_R1);
    bf16* ACT = (bf16*)(F.ws + WS_R1);
    bf16* O = (bf16*)(F.ws + WS_R2);
    bf16* Y = (bf16*)(F.ws + WS_R2);
    bf16* OG = (bf16*)(F.ws + WS_R2 + 32 * MiB);
    float* ST = (float*)(F.ws + WS_R2 + 128 * MiB);
    float* X = F.out;
    float* DUMMY = (float*)(F.ws + WS_R2 + 32 * MiB);
    const float* cum = (const float*)(F.ws + WS_MISC + MS_CUM);

    const bf16* WB = (const bf16*)(F.ws + WS_W);
    enum { PH_BASE = __COUNTER__ + 1 };
#define PHASE(...) { constexpr int k_ = __COUNTER__ - PH_BASE; if (IN(k_)) { __VA_ARGS__; if (DUP(k_)) { xcd_barrier(bar); __VA_ARGS__; } SEAM(k_); } }
    PHASE({ unsigned* z = (unsigned*)(F.ws + WS_MISC + MS_LIST);
            for (int i = blockIdx.x * NTHR + F.tid; i < (int)(2 * MiB / 4); i += F.G * NTHR) z[i] = 0u;
            convert_weights(F); })
    PHASE(norm_phase<0>(F, INP(0), nullptr, INP(13) + 0 * DM, H, 0, 0, nullptr, nullptr, nullptr))
    PHASE({ pg8::EpiPlanes E{PROJ, C2}; dense_gemm(F, H, WB + WE_QKV, 3 * DM, DM, E); })
    PHASE(att::causal_phase<0>((att::lptr)F.lds, F.G, PROJ, PROJ + PLANE, PROJ + 2 * PLANE, O, nullptr))
    PHASE({ pg8::EpiResid E{INP(0), X}; dense_gemm(F, O, WB + WE_WO_SB, DM, DM, E); })
    PHASE(norm_phase<0>(F, X, nullptr, INP(14) + 0 * DM, H, 0, 0, nullptr, nullptr, nullptr))
    PHASE({ pg8::EpiSwiglu E{ACT}; dense_gemm(F, H, WB + WE_GU, 2 * FF, DM, E); })
    PHASE({ pg8::EpiResid E{X, X}; dense_gemm(F, ACT, WB + WE_D, DM, FF, E); })
    PHASE(norm_phase<0>(F, X, nullptr, INP(13) + 1 * DM, H, 0, 0, nullptr, nullptr, nullptr))
    PHASE({ pg8::EpiQKNorm E{PROJ, INP(4), INP(5), 6}; dense_gemm(F, H, WB + WE_IN_DIL, 7 * DM, DM, E); })
    PHASE(att::dil_phase((att::lptr)F.lds, F.G, PROJ, OG, ST, INP(12)))
    PHASE(att::dil_merge(F.G, OG, ST, O))
    PHASE({ pg8::EpiResid E{X, X}; dense_gemm(F, O, WB + WE_WO_DIL, DM, DM, E); })
    PHASE(norm_phase<4>(F, X, nullptr, INP(14) + 1 * DM, H, 0, 0, nullptr, nullptr, INP(18) + 0 * DM * NE))
    PHASE(moe_finalize(F, 0))
    PHASE(moe_gu_fast(F, 0, H, ACT))
    PHASE(moe_down_fast(F, 0, ACT, Y))
    PHASE(norm_phase<1 | 2>(F, X, X, INP(13) + 2 * DM, H, 0, 0, INP(7), INP(8), nullptr))
    PHASE({ cumsum_phase(F); pg8::EpiQKNorm E{PROJ, INP(9), INP(10), 2}; dense_gemm(F, H, WB + WE_IN_FOX, 3 * DM, DM, E); })
    PHASE(att::causal_phase<2>((att::lptr)F.lds, F.G, PROJ, PROJ + PLANE, PROJ + 2 * PLANE, O, cum))
    PHASE({ pg8::EpiResid E{X, X}; dense_gemm(F, O, WB + WE_WO_FOX, DM, DM, E); })
    PHASE(norm_phase<0>(F, X, nullptr, INP(14) + 2 * DM, H, 0, 0, nullptr, nullptr, nullptr))
    PHASE({ pg8::EpiSwiglu E{ACT}; dense_gemm(F, H, WB + WE_GU + (size_t)2 * FF * DM, 2 * FF, DM, E); })
    PHASE({ pg8::EpiResid E{X, X}; dense_gemm(F, ACT, WB + WE_D + (size_t)DM * FF, DM, FF, E); })
    PHASE(norm_phase<0>(F, X, nullptr, INP(13) + 3 * DM, H, 0, 0, nullptr, nullptr, nullptr))
    PHASE({ pg8::EpiPlanes E{PROJ, C2}; dense_gemm(F, H, WB + WE_QKV + (size_t)3 * DM * DM, 3 * DM, DM, E); })
    PHASE(att::causal_phase<0>((att::lptr)F.lds, F.G, PROJ, PROJ + PLANE, PROJ + 2 * PLANE, O, nullptr))
    PHASE({ pg8::EpiResid E{X, X}; dense_gemm(F, O, WB + WE_WO_SB + (size_t)DM * DM, DM, DM, E); })
    PHASE(norm_phase<4>(F, X, nullptr, INP(14) + 3 * DM, H, 0, 1, nullptr, nullptr, INP(18) + 1 * DM * NE))
    PHASE(moe_finalize(F, 1))
    PHASE(moe_gu_fast(F, 1, H, ACT))
    PHASE(moe_down_fast(F, 1, ACT, Y))
    PHASE(final_combine(F, 1))
    static_assert(__COUNTER__ - PH_BASE == N_PHASES, "N_PHASES must equal the number of PHASE() sites");
#undef PHASE
#undef IN
#undef SEAM
}

extern "C" void kernel_launch(void* const* d_in, const int* in_sizes, int n_in, void* d_out, int out_size, void* d_ws, size_t ws_size, hipStream_t stream) {
    static int grid = 0;
    if (grid == 0) {
        if (n_in != 22 || out_size != M * DM || ws_size < WS_END) { fprintf(stderr, "kernel_launch: unexpected shapes (n_in %d out %d ws %zu)\n", n_in, out_size, ws_size); grid = -1; return; }
        int dev = 0, cus = 0, per_cu = 0;
        if (hipGetDevice(&dev) != hipSuccess || hipDeviceGetAttribute(&cus, hipDeviceAttributeMultiprocessorCount, dev) != hipSuccess) { grid = -1; return; }
        if (hipFuncSetAttribute((const void*)trunk_fwd, hipFuncAttributeMaxDynamicSharedMemorySize, LDS_BYTES) != hipSuccess) { fprintf(stderr, "kernel_launch: hipFuncSetAttribute failed\n"); grid = -1; return; }
        if (hipOccupancyMaxActiveBlocksPerMultiprocessor(&per_cu, (const void*)trunk_fwd, NTHR, LDS_BYTES) != hipSuccess || per_cu < 1) fprintf(stderr, "kernel_launch: occupancy query says %d\n", per_cu);
        (void)hipGetLastError();
        grid = cus;
    }
    if (grid < 0) return;
    (void)hipMemsetAsync((char*)d_ws + WS_CTL, 0, CTL_ZERO_BYTES, stream);
    Args a{};
    for (int i = 0; i < 22; ++i) a.in[i] = (const float*)d_in[i];
    a.out = (float*)d_out; a.ws = (unsigned char*)d_ws;
#if MK_MULTI
    for (int p = 0; p < N_PHASES; ++p) { a.ph_lo = p; a.ph_hi = p + 1; hipLaunchKernelGGL(trunk_fwd, dim3(grid), dim3(NTHR), LDS_BYTES, stream, a); }
#else
    a.ph_lo = 0; a.ph_hi = N_PHASES;
    hipLaunchKernelGGL(trunk_fwd, dim3(grid), dim3(NTHR), LDS_BYTES, stream, a);
#endif
}
```

```cpp
#include <hip/hip_runtime.h>
#include <cstdio>
#include <cstdint>

#ifndef MK_MULTI
#define MK_MULTI 0
#endif

constexpr int BATCH = 8, SEQ = 2048, DM = 1024, NH = 16, HD = 64, FF = 3584, NE = 8;
constexpr int M = BATCH * SEQ;
constexpr float RMS_EPS = 1e-6f;
constexpr float LOG2E = 1.4426950408889634f;
constexpr float C2 = 0.125f * LOG2E;
constexpr int NWAVES = 8, NTHR = 512;
constexpr int LCAP = 16384;
constexpr int MAXROWS = 34816;
constexpr bool MOE_SPLITK = true;
constexpr int SPLIT_ROW0 = 32768, SPLIT_ROWS = MAXROWS - SPLIT_ROW0;

constexpr size_t MiB = 1u << 20;
constexpr size_t WS_CTL = 0, CTL_ZERO_BYTES = 1 * MiB;
constexpr size_t WS_MISC = 1 * MiB;
constexpr size_t WS_H = 6 * MiB;
constexpr size_t WS_R1 = 38 * MiB;
constexpr size_t WS_R2 = 278 * MiB;
constexpr size_t WS_W = 414 * MiB;
constexpr size_t WS_END = 832 * MiB;
constexpr size_t PLANE = (size_t)M * DM;
constexpr size_t WE_QKV = 0;
constexpr size_t WE_WO_SB = WE_QKV + 2ull * 3072 * 1024;
constexpr size_t WE_WO_DIL = WE_WO_SB + 2ull * 1024 * 1024;
constexpr size_t WE_WO_FOX = WE_WO_DIL + 1024ull * 1024;
constexpr size_t WE_IN_DIL = WE_WO_FOX + 1024ull * 1024;
constexpr size_t WE_IN_FOX = WE_IN_DIL + 7168ull * 1024;
constexpr size_t WE_GU = WE_IN_FOX + 3072ull * 1024;
constexpr size_t WE_D = WE_GU + 2ull * 7168 * 1024;
constexpr size_t WE_MGU = WE_D + 2ull * 1024 * 3584;
constexpr size_t WE_MD = WE_MGU + 16ull * 7168 * 1024;
constexpr size_t WE_END = WE_MD + 16ull * 1024 * 3584;
static_assert(WS_W + WE_END * 2 <= WS_END, "weight copies fit");
constexpr size_t MS_LIST = 0;
constexpr size_t MS_GW = 1 * MiB;
constexpr size_t MS_TOK = 2 * MiB;
constexpr size_t MS_LOGF = 2 * MiB + 256 * 1024;
constexpr size_t MS_CUM = 3 * MiB + 256 * 1024;
constexpr size_t MS_SEL = 4 * MiB + 256 * 1024;
constexpr size_t MS_SG = MS_SEL + 256 * 1024;
constexpr size_t MS_LC = MS_SG + 256 * 1024;
constexpr int CW_BAR = 4096;
constexpr int CW_CNT = 64;

#define GAS __attribute__((address_space(1)))
#define LAS __attribute__((address_space(3)))
typedef unsigned short bf16;
typedef unsigned v4u __attribute__((ext_vector_type(4)));
typedef unsigned v2u __attribute__((ext_vector_type(2)));
typedef float f32x4 __attribute__((ext_vector_type(4)));
typedef float f32x2 __attribute__((ext_vector_type(2)));
typedef GAS unsigned gu32;
#define RLX_AGENT __ATOMIC_RELAXED, __HIP_MEMORY_SCOPE_AGENT
__device__ __forceinline__ unsigned f2bf(float f) { unsigned u = __builtin_bit_cast(unsigned, f); return (u + 0x7fffu + ((u >> 16) & 1u)) >> 16; }
__device__ __forceinline__ unsigned pk2(float lo, float hi) { return f2bf(lo) | (f2bf(hi) << 16); }
__device__ __forceinline__ float bflo(unsigned u) { return __builtin_bit_cast(float, u << 16); }
__device__ __forceinline__ float bfhi(unsigned u) { return __builtin_bit_cast(float, u & 0xffff0000u); }

#define XB_TMO      128
#define XB_XCNT(j)  (256  + 64 * (j))
#define XB_XSUB(j)  (1280 + 64 * (j))
#define XB_XGEN(j)  (2304 + 64 * (j))
#define XB_TOP      3328
#define XB_TOPGEN   3392
#define XCD_BAR_WORDS 3456
#define XB_SPIN_CAP (1u << 22)
__device__ __forceinline__ unsigned xb_ld(unsigned* p)              { return __hip_atomic_load(p, __ATOMIC_RELAXED, __HIP_MEMORY_SCOPE_AGENT); }
__device__ __forceinline__ unsigned xb_add(unsigned* p, unsigned v) { return __hip_atomic_fetch_add(p, v, __ATOMIC_RELAXED, __HIP_MEMORY_SCOPE_AGENT); }
__device__ __forceinline__ unsigned xb_xcc_id() { return (unsigned)__builtin_amdgcn_s_getreg((3 << 11) | 20) & 0xFu; }
#define XB_SPIN(cond, bar) do { unsigned _sp = 0; while (cond) { __builtin_amdgcn_s_sleep(1); \
    if ((++_sp & 255u) == 0u) { if (xb_ld(&(bar)[XB_TMO])) break; if (_sp > XB_SPIN_CAP) { atomicAdd(&(bar)[XB_TMO], 1u); break; } } } } while (0)
struct XcdBarrier { unsigned* bar; unsigned x; volatile LAS unsigned* st; };
__device__ __forceinline__ XcdBarrier xcd_barrier_post(unsigned* bar, volatile LAS unsigned* st) {
    XcdBarrier b; b.bar = bar; b.x = xb_xcc_id(); b.st = st;
    if (threadIdx.x == 0) (void)xb_add(&bar[XB_XCNT(b.x)], 1u);
    return b;
}
__device__ __forceinline__ void xcd_barrier_complete(unsigned* bar, unsigned x, unsigned& nloc, unsigned& nx) {
    const unsigned G = gridDim.x * gridDim.y * gridDim.z;
    unsigned sum, cnt, mine, sp = 0u;
    for (;;) {
        sum = 0u; cnt = 0u; mine = 0u;
#pragma unroll
        for (unsigned j = 0; j < 16; ++j) { const unsigned c = xb_ld(&bar[XB_XCNT(j)]); sum += c; cnt += (c > 0u) ? 1u : 0u; mine = (j == x) ? c : mine; }
        if (sum == G) break;
        __builtin_amdgcn_s_sleep(1);
        if ((++sp & 255u) == 0u) { if (xb_ld(&bar[XB_TMO])) break; if (sp > XB_SPIN_CAP) { atomicAdd(&bar[XB_TMO], 1u); break; } }
    }
    nloc = mine > 0u ? mine : 1u; nx = cnt > 0u ? cnt : 1u;
}
__device__ __forceinline__ void xcd_barrier(const XcdBarrier& b) {
    asm volatile("s_waitcnt vmcnt(0)" ::: "memory");
    __syncthreads();
    if (threadIdx.x == 0) {
        unsigned* bar = b.bar;
        __builtin_amdgcn_s_waitcnt(0);
        unsigned nloc = b.st[0], nx = b.st[1];
        if (nloc == 0u) { xcd_barrier_complete(bar, b.x, nloc, nx); b.st[0] = nloc; b.st[1] = nx; }
        const unsigned old = xb_add(&bar[XB_XSUB(b.x)], 1u);
        const unsigned gen = old / nloc;
        if (old + 1u == (gen + 1u) * nloc) {
            __builtin_amdgcn_fence(__ATOMIC_RELEASE, "agent");
            asm volatile("s_waitcnt vmcnt(0)" ::: "memory");
            const unsigned og = xb_add(&bar[XB_TOP], 1u);
            const unsigned tg = og / nx;
            if (og + 1u == (tg + 1u) * nx) xb_add(&bar[XB_TOPGEN], 1u);
            else XB_SPIN(xb_ld(&bar[XB_TOPGEN]) == tg, bar);
            __builtin_amdgcn_fence(__ATOMIC_ACQUIRE, "agent");
            xb_add(&bar[XB_XGEN(b.x)], 1u);
            asm volatile("s_waitcnt vmcnt(0)" ::: "memory");
        } else {
            XB_SPIN(xb_ld(&bar[XB_XGEN(b.x)]) == gen, bar);
            __builtin_amdgcn_fence(__ATOMIC_ACQUIRE, "agent");
            asm volatile("s_waitcnt vmcnt(0)" ::: "memory");
        }
    }
    __syncthreads();
}

constexpr int LDS_BYTES = 147456;
constexpr int ATT_LDS_MAX = 143360;
constexpr int MISC_OFF = ATT_LDS_MAX + 64;
struct Frame {
    LAS unsigned char* lds;
    int tid, lane, wave, G;
    unsigned char* ws; gu32* ctl;
    float* out;
};
__device__ __forceinline__ float wave_sum(float v) {
#pragma unroll
    for (int o = 1; o < 64; o <<= 1) v += __shfl_xor(v, o);
    return v;
}

constexpr int PTR_OFF = ATT_LDS_MAX + 512;
__device__ __forceinline__ const float* inp_ptr(Frame& F, int k) {
    const LAS unsigned* t = (const LAS unsigned*)(F.lds + PTR_OFF) + 2 * k;
    const unsigned lo = __builtin_amdgcn_readfirstlane(t[0]), hi = __builtin_amdgcn_readfirstlane(t[1]);
    return (const float*)(((unsigned long long)hi << 32) | lo);
}
#define INP(k) inp_ptr(F, (k))
__device__ __forceinline__ bool relaunder(Frame& F) { int t_ = threadIdx.x; asm volatile("" : "+v"(t_)); F.tid = t_; F.lane = t_ & 63; F.wave = __builtin_amdgcn_readfirstlane(t_ >> 6); return true; }
namespace pg8 {
#define PG8_LAS __attribute__((address_space(3)))
typedef unsigned short bf16_t;
typedef short bf16x8 __attribute__((ext_vector_type(8)));
typedef unsigned u32x4 __attribute__((ext_vector_type(4)));
constexpr int BM = 256, BK = 64, HALF = 128, HTB = HALF * BK * 2, STAGE_BYTES = 8 * HTB, NXCD = 8, WGM = 8;
__host__ __device__ __forceinline__ int lds_byte(int r, int c) { const int st = (r >> 4) * 2 + (c >> 5), rr = r & 15, cc = c & 31, ob = rr * 64 + cc * 2; return st * 1024 + (ob ^ (((ob >> 9) & 1) << 5)); }
__host__ __device__ __forceinline__ void stage_rc(int b, int& R, int& C) { const int st = b / 1024, sb = b % 1024, swz = sb ^ (((sb >> 9) & 1) << 5); R = (st >> 1) * 16 + swz / 64; C = (st & 1) * 32 + (swz % 64) / 2; }
__host__ __device__ __forceinline__ int perm32(int rho) { const int n = rho >> 4, i = rho & 15; return 8 * (i >> 2) + 4 * n + (i & 3); }
struct Unit { int pm, pn, e, mt, nt, koff, kq; };

struct DenseOrder {
    int nM, nN, nwg, G, c, ntk; const char* A; const char* Bt; size_t tstep;
    __device__ __forceinline__ void init(const bf16_t* A_, const bf16_t* Bt_, int M_, int N_, int K_, int G_, int c_) { nM = M_ / BM; nN = N_ / BM; nwg = nM * nN; G = G_; c = c_; ntk = K_ / BK; A = (const char*)A_; Bt = (const char*)Bt_; tstep = (size_t)BM * K_ * 2; }
    __device__ __forceinline__ bool next(int i, Unit& u) const {
        const long L = (long)i * G + c; if (L >= nwg) return false;
        int wgid = (int)L; { const int q = nwg / NXCD, r = nwg % NXCD, xcd = wgid % NXCD, off = wgid / NXCD; wgid = (xcd < r ? xcd * (q + 1) : r * (q + 1) + (xcd - r) * q) + off; }
        const int nig = WGM * nN, gid = wgid / nig, fm = gid * WGM, gsz = (nM - fm) < WGM ? (nM - fm) : WGM;
        u.pm = fm + ((wgid % nig) % gsz); u.pn = (wgid % nig) / gsz; u.e = 0; u.mt = u.pm; u.nt = ntk; u.koff = 0; u.kq = -1; return true;
    }
    __device__ __forceinline__ const char* a_base(const Unit& u) const { return A + (size_t)u.pm * tstep; }
    __device__ __forceinline__ const char* b_base(const Unit& u) const { return Bt + (size_t)u.pn * tstep; }
    __device__ __forceinline__ void a_voff(const Unit&, const int (&)[2], const int (&)[2], unsigned (&)[2][2]) const {}
};
struct MoeOrder {
    int t1, t2, t3, t4, t5, t6, t7, t8, nN, G, c, K; const char* A; const char* Bt; size_t tstepA, tstepB, estepB; const int* list; bool gather; int splitk;
    __device__ __forceinline__ bool next(int i, Unit& u) const {
        const int X = i * G + c, U = t8 * nN; int L = X; u.nt = K / BK; u.koff = 0; u.kq = -1;
        if (splitk) { const int nfull = (U / G) * G;
            if (X >= nfull) { const int q = X - nfull; if (q >= splitk * (U - nfull)) return false; L = nfull + q / splitk; u.kq = q % splitk; u.nt = K / BK / splitk; u.koff = u.kq * (K / splitk) * 2; } }
        else if (X >= U) return false;
        const int mt = L / nN; u.pm = mt; u.pn = L - mt * nN;
        const int e = (mt >= t1) + (mt >= t2) + (mt >= t3) + (mt >= t4) + (mt >= t5) + (mt >= t6) + (mt >= t7);
        const int tb = e == 0 ? 0 : e == 1 ? t1 : e == 2 ? t2 : e == 3 ? t3 : e == 4 ? t4 : e == 5 ? t5 : e == 6 ? t6 : t7;
        u.e = e; u.mt = mt - tb; return true;
    }
    __device__ __forceinline__ const char* a_base(const Unit& u) const { return (gather ? A : A + (size_t)u.pm * tstepA) + u.koff; }
    __device__ __forceinline__ const char* b_base(const Unit& u) const { return Bt + (size_t)u.e * estepB + (size_t)u.pn * tstepB + u.koff; }
    __device__ __forceinline__ void a_voff(const Unit& u, const int (&sR)[2], const int (&sC)[2], unsigned (&v)[2][2]) const {
        const int* lp = list + u.e * LCAP + u.mt * 256;
#pragma unroll
        for (int h = 0; h < 2; ++h)
#pragma unroll
            for (int i = 0; i < 2; ++i) v[h][i] = (unsigned)lp[h * 128 + sR[i]] * (unsigned)(K * 2) + (unsigned)(sC[i] * 2);
    }
};

__device__ __forceinline__ unsigned cvt_pk_bf16(float lo, float hi) { unsigned r; asm volatile("v_cvt_pk_bf16_f32 %0, %1, %2" : "=v"(r) : "v"(lo), "v"(hi)); return r; }

struct EpiPlanes {
    static constexpr bool PERM = true;
    bf16_t* O; float scale0;
    __device__ __forceinline__ void operator()(const f32x4 (&acc)[2][2][4][2], const Unit& u, int wr, int wc, int fr, int fq) const {
        const int plane = u.pn >> 2; const float sc = plane == 0 ? scale0 : 1.f;
        bf16_t* base = O + (size_t)plane * PLANE + (size_t)(u.pm * BM + wr * 64 + fr) * DM + (u.pn & 3) * 256 + wc * 32 + 8 * fq;
#pragma unroll
        for (int ai = 0; ai < 2; ++ai)
#pragma unroll
            for (int m = 0; m < 4; ++m) { bf16_t* rowp = base + (size_t)(ai * HALF + m * 16) * DM;
#pragma unroll
                for (int bj = 0; bj < 2; ++bj) { const f32x4 v0 = acc[ai][bj][m][0] * sc, v1 = acc[ai][bj][m][1] * sc;
                    u32x4 w; w.x = cvt_pk_bf16(v0[0], v0[1]); w.y = cvt_pk_bf16(v0[2], v0[3]); w.z = cvt_pk_bf16(v1[0], v1[1]); w.w = cvt_pk_bf16(v1[2], v1[3]);
                    *(u32x4*)(rowp + bj * HALF) = w; } }
    }
};
struct EpiQKNorm {
    static constexpr bool PERM = true;
    bf16_t* O; const float* qg; const float* kg; int vplane;
    __device__ __forceinline__ void operator()(const f32x4 (&acc)[2][2][4][2], const Unit& u, int wr, int wc, int fr, int fq) const {
        const int plane = u.pn >> 2; const bool isv = plane == vplane; const bool isq = !isv && ((plane & 1) == 0); const int grp = plane >> 1;
        const float* g = (isq ? qg : kg) + grp * 64 + 8 * fq;
        f32x4 gv[2][2];
#pragma unroll
        for (int bj = 0; bj < 2; ++bj)
#pragma unroll
            for (int n = 0; n < 2; ++n) gv[bj][n] = isv ? (f32x4){1.f, 1.f, 1.f, 1.f} : *(const f32x4*)(g + 32 * bj + 4 * n);
        const float mul = isq ? C2 : 1.f;
        bf16_t* base = O + (size_t)plane * PLANE + (size_t)(u.pm * BM + wr * 64 + fr) * DM + (u.pn & 3) * 256 + wc * 64 + 8 * fq;
#pragma unroll
        for (int ai = 0; ai < 2; ++ai)
#pragma unroll
            for (int m = 0; m < 4; ++m) { bf16_t* rowp = base + (size_t)(ai * HALF + m * 16) * DM;
                float ss = 0.f;
#pragma unroll
                for (int bj = 0; bj < 2; ++bj)
#pragma unroll
                    for (int n = 0; n < 2; ++n) { const f32x4 x = acc[ai][bj][m][n]; ss += (x[0] * x[0] + x[1] * x[1]) + (x[2] * x[2] + x[3] * x[3]); }
                ss += __shfl_xor(ss, 16); ss += __shfl_xor(ss, 32);
                const float inv = isv ? 1.f : mul / sqrtf(ss * (1.f / 64.f) + RMS_EPS);
#pragma unroll
                for (int bj = 0; bj < 2; ++bj) { const f32x4 v0 = acc[ai][bj][m][0] * inv * gv[bj][0], v1 = acc[ai][bj][m][1] * inv * gv[bj][1];
                    u32x4 w; w.x = cvt_pk_bf16(v0[0], v0[1]); w.y = cvt_pk_bf16(v0[2], v0[3]); w.z = cvt_pk_bf16(v1[0], v1[1]); w.w = cvt_pk_bf16(v1[2], v1[3]);
                    *(u32x4*)(rowp + bj * 32) = w; } }
    }
};
struct EpiSwiglu {
    static constexpr bool PERM = true;
    bf16_t* O;
    __device__ __forceinline__ void operator()(const f32x4 (&acc)[2][2][4][2], const Unit& u, int wr, int wc, int fr, int fq) const {
        bf16_t* base = O + (size_t)(u.pm * BM + wr * 64 + fr) * FF + u.pn * 128 + wc * 32 + 8 * fq;
#pragma unroll
        for (int ai = 0; ai < 2; ++ai)
#pragma unroll
            for (int m = 0; m < 4; ++m) { bf16_t* rowp = base + (size_t)(ai * HALF + m * 16) * FF;
                float o[8];
#pragma unroll
                for (int n = 0; n < 2; ++n)
#pragma unroll
                    for (int i = 0; i < 4; ++i) { const float g = acc[ai][0][m][n][i], uu = acc[ai][1][m][n][i];
                        o[n * 4 + i] = g * __builtin_amdgcn_rcpf(1.0f + __builtin_amdgcn_exp2f(-g * LOG2E)) * uu; }
                u32x4 w; w.x = cvt_pk_bf16(o[0], o[1]); w.y = cvt_pk_bf16(o[2], o[3]); w.z = cvt_pk_bf16(o[4], o[5]); w.w = cvt_pk_bf16(o[6], o[7]);
                *(u32x4*)rowp = w; }
    }
};
struct EpiResid {
    static constexpr bool PERM = false;
    const float* base; float* out;
    __device__ __forceinline__ void operator()(const f32x4 (&acc)[2][2][4][2], const Unit& u, int wr, int wc, int fr, int fq) const {
        const size_t off0 = (size_t)(u.pm * BM + wr * 64 + fr) * DM + u.pn * BM + wc * 32 + 4 * fq;
#pragma unroll
        for (int ai = 0; ai < 2; ++ai)
#pragma unroll
            for (int m = 0; m < 4; ++m) { const size_t off = off0 + (size_t)(ai * HALF + m * 16) * DM;
#pragma unroll
                for (int bj = 0; bj < 2; ++bj)
#pragma unroll
                    for (int n = 0; n < 2; ++n) { const f32x4 b = *(const f32x4*)(base + off + bj * HALF + n * 16); *(f32x4*)(out + off + bj * HALF + n * 16) = b + acc[ai][bj][m][n]; } }
    }
};
struct EpiMoeDown {
    static constexpr bool PERM = true;
    bf16_t* Y; const float* gw; bf16_t* P;
    __device__ __forceinline__ void operator()(const f32x4 (&acc)[2][2][4][2], const Unit& u, int wr, int wc, int fr, int fq) const {
        bf16_t* base = (u.kq < 0 ? Y + (size_t)(u.pm * BM) * DM : P + ((size_t)u.kq * SPLIT_ROWS + (size_t)(u.pm * BM - SPLIT_ROW0)) * DM) + (size_t)(wr * 64 + fr) * DM + u.pn * BM + wc * 32 + 8 * fq;
        const float* gp = gw + u.e * LCAP + u.mt * 256 + wr * 64 + fr;
#pragma unroll
        for (int ai = 0; ai < 2; ++ai)
#pragma unroll
            for (int m = 0; m < 4; ++m) { bf16_t* rowp = base + (size_t)(ai * HALF + m * 16) * DM; const float g = gp[ai * HALF + m * 16];
#pragma unroll
                for (int bj = 0; bj < 2; ++bj) { const f32x4 v0 = acc[ai][bj][m][0] * g, v1 = acc[ai][bj][m][1] * g;
                    u32x4 w; w.x = cvt_pk_bf16(v0[0], v0[1]); w.y = cvt_pk_bf16(v0[2], v0[3]); w.z = cvt_pk_bf16(v1[0], v1[1]); w.w = cvt_pk_bf16(v1[2], v1[3]);
                    *(u32x4*)(rowp + bj * HALF) = w; } }
    }
};

template <class Epi, class Sched, bool GATHER>
__device__ __forceinline__ void gemm_phase(PG8_LAS unsigned char* lds, const int K, const Sched& S, const Epi& E) {
    const int tid = threadIdx.x, wid = __builtin_amdgcn_readfirstlane(tid >> 6), lane = tid & 63, wr = wid >> 2, wc = wid & 3, fr = lane & 15, fq = lane >> 4;
    unsigned voffA[2], voffB[2]; int sR[2], sC[2];
#pragma unroll
    for (int i = 0; i < 2; ++i) { int R, C; stage_rc(tid * 16 + i * 8192, R, C); const int Rb = Epi::PERM ? ((R & ~31) + perm32(R & 31)) : R;
        voffA[i] = (unsigned)(R * K + C) * 2u; voffB[i] = (unsigned)(Rb * K + C) * 2u; sR[i] = R; sC[i] = C; }
    const size_t kstep = (size_t)(BK * 2);
    const size_t hstep = (size_t)HALF * K * 2;
    const unsigned ldsw = (unsigned)wid * 1024u;
    const int aoff = lds_byte(wr * 64 + fr, fq * 8), boff = lds_byte(wc * 32 + fr, fq * 8);
#define PG8_SA(b, h) (((b) * 2 + (h)) * HTB)
#define PG8_SB(b, h) ((4 + (b) * 2 + (h)) * HTB)
#define PG8_STAGE(bufoff, gbase, voff) do { _Pragma("unroll") for (int _i = 0; _i < 2; ++_i) \
        __builtin_amdgcn_global_load_lds((const unsigned*)((const char*)(gbase) + (voff)[_i]), (PG8_LAS unsigned*)(lds + (bufoff) + ldsw + _i * 8192), 16, 0, 0); } while (0)
#define PG8_STAGE_A(bufoff, p, h, VG) do { if (GATHER) { PG8_STAGE(bufoff, p, VG[h]); } else { PG8_STAGE(bufoff, (p) + ((h) ? hstep : 0), voffA); } } while (0)
#define PG8_LDA(dst, b, h) do { _Pragma("unroll") for (int m = 0; m < 4; ++m) _Pragma("unroll") for (int k = 0; k < 2; ++k) dst[m][k] = *(const PG8_LAS bf16x8*)(lds + PG8_SA(b, h) + aoff + m * 2048 + k * 1024); } while (0)
#define PG8_LDB(dst, b, h) do { _Pragma("unroll") for (int n = 0; n < 2; ++n) _Pragma("unroll") for (int k = 0; k < 2; ++k) dst[n][k] = *(const PG8_LAS bf16x8*)(lds + PG8_SB(b, h) + boff + n * 2048 + k * 1024); } while (0)
#define PG8_MMA(ai, bj, At, Bt) do { __builtin_amdgcn_s_setprio(1); _Pragma("unroll") for (int m = 0; m < 4; ++m) _Pragma("unroll") for (int n = 0; n < 2; ++n) _Pragma("unroll") for (int k = 0; k < 2; ++k) \
        acc[ai][bj][m][n] = __builtin_amdgcn_mfma_f32_16x16x32_bf16(Bt[n][k], At[m][k], acc[ai][bj][m][n], 0, 0, 0); __builtin_amdgcn_s_setprio(0); } while (0)
#define PG8_WAIT_V(n) asm volatile("s_waitcnt vmcnt(" #n ")" ::: "memory")
#define PG8_WAIT_L(n) asm volatile("s_waitcnt lgkmcnt(" #n ")" ::: "memory")
#define PG8_BAR __builtin_amdgcn_s_barrier()
#define PG8_SCHED __builtin_amdgcn_sched_barrier(0)
    Unit cur, nxt; int ui = 0;
    if (!S.next(0, cur)) return;
    f32x4 acc[2][2][4][2];
#pragma unroll
    for (int a = 0; a < 2; ++a)
#pragma unroll
        for (int b = 0; b < 2; ++b)
#pragma unroll
            for (int m = 0; m < 4; ++m)
#pragma unroll
                for (int n = 0; n < 2; ++n) acc[a][b][m][n] = (f32x4){0.f, 0.f, 0.f, 0.f};
    bf16x8 At[4][2], B0[2][2], B1[2][2];
    const char* cA = S.a_base(cur); const char* cB = S.b_base(cur);
    unsigned vc[2][2] = {{0u, 0u}, {0u, 0u}}, vn[2][2] = {{0u, 0u}, {0u, 0u}};
    if (GATHER) { S.a_voff(cur, sR, sC, vc); asm volatile("s_waitcnt vmcnt(0)" : "+v"(vc[0][0]), "+v"(vc[0][1]), "+v"(vc[1][0]), "+v"(vc[1][1]) :: "memory"); }
    PG8_STAGE(PG8_SB(0, 0), cB, voffB); PG8_STAGE(PG8_SB(0, 1), cB + hstep, voffB); PG8_STAGE_A(PG8_SA(0, 0), cA, 0, vc); PG8_STAGE_A(PG8_SA(0, 1), cA, 1, vc);
    if (wr == 1) PG8_BAR;
    PG8_WAIT_V(2); PG8_BAR;
    PG8_STAGE(PG8_SB(1, 0), cB + kstep, voffB); PG8_STAGE_A(PG8_SA(1, 0), cA + kstep, 0, vc); PG8_STAGE(PG8_SB(1, 1), cB + hstep + kstep, voffB);
    PG8_WAIT_V(6); PG8_BAR;
    for (;;) {
        const bool has_next = S.next(ui + 1, nxt);
        const char* nA = has_next ? S.a_base(nxt) : cA; const char* nB = has_next ? S.b_base(nxt) : cB;
        if (GATHER) {
            if (has_next) { S.a_voff(nxt, sR, sC, vn); asm volatile("s_waitcnt vmcnt(0)" : "+v"(vn[0][0]), "+v"(vn[0][1]), "+v"(vn[1][0]), "+v"(vn[1][1]) :: "memory"); }
            else { vn[0][0] = vc[0][0]; vn[0][1] = vc[0][1]; vn[1][0] = vc[1][0]; vn[1][1] = vc[1][1]; }
        }
        const int nt = cur.nt;
        for (int t = 0; t < nt; t += 2) {
            const bool last = (t == nt - 2);
            const char* a1 = cA + (size_t)(t + 1) * kstep;
            const char* a2 = last ? nA : cA + (size_t)(t + 2) * kstep; const char* b2 = last ? nB : cB + (size_t)(t + 2) * kstep;
            const char* a3 = a2 + kstep; const char* b3 = b2 + kstep;
            unsigned v2[2][2];
#pragma unroll
            for (int h = 0; h < 2; ++h)
#pragma unroll
                for (int i = 0; i < 2; ++i) v2[h][i] = last ? vn[h][i] : vc[h][i];
            PG8_LDB(B0, 0, 0); PG8_LDB(B1, 0, 1); PG8_SCHED; PG8_LDA(At, 0, 0); PG8_STAGE_A(PG8_SA(1, 1), a1, 1, vc);
            PG8_WAIT_V(8); PG8_WAIT_L(0); PG8_BAR; PG8_MMA(0, 0, At, B0); PG8_MMA(0, 1, At, B1); PG8_BAR; PG8_SCHED;
            PG8_LDA(At, 0, 1); PG8_STAGE(PG8_SB(0, 0), b2, voffB); PG8_STAGE(PG8_SB(0, 1), b2 + hstep, voffB); PG8_STAGE_A(PG8_SA(0, 0), a2, 0, v2);
            PG8_WAIT_V(8); PG8_WAIT_L(0); PG8_BAR; PG8_MMA(1, 0, At, B0); PG8_MMA(1, 1, At, B1); PG8_BAR; PG8_SCHED;
            PG8_LDB(B0, 1, 0); PG8_LDB(B1, 1, 1); PG8_SCHED; PG8_LDA(At, 1, 0); PG8_STAGE_A(PG8_SA(0, 1), a2, 1, v2);
            PG8_WAIT_V(8); PG8_WAIT_L(0); PG8_BAR; PG8_MMA(0, 0, At, B0); PG8_MMA(0, 1, At, B1); PG8_BAR; PG8_SCHED;
            PG8_LDA(At, 1, 1); PG8_STAGE(PG8_SB(1, 0), b3, voffB); PG8_STAGE(PG8_SB(1, 1), b3 + hstep, voffB); PG8_STAGE_A(PG8_SA(1, 0), a3, 0, v2);
            PG8_WAIT_V(8); PG8_WAIT_L(0); PG8_BAR; PG8_MMA(1, 0, At, B0); PG8_MMA(1, 1, At, B1); PG8_BAR; PG8_SCHED;
        }
        if (wr == 0) PG8_BAR;
        E(acc, cur, wr, wc, fr, fq);
        if (!has_next) break;
#pragma unroll
        for (int a = 0; a < 2; ++a)
#pragma unroll
            for (int b = 0; b < 2; ++b)
#pragma unroll
                for (int m = 0; m < 4; ++m)
#pragma unroll
                    for (int n = 0; n < 2; ++n) acc[a][b][m][n] = (f32x4){0.f, 0.f, 0.f, 0.f};
        cur = nxt; cA = nA; cB = nB; ++ui;
        if (GATHER) { vc[0][0] = vn[0][0]; vc[0][1] = vn[0][1]; vc[1][0] = vn[1][0]; vc[1][1] = vn[1][1]; }
        if (wr == 1) PG8_BAR;
    }
    PG8_WAIT_V(0);
    PG8_BAR;
#undef PG8_SA
#undef PG8_SB
#undef PG8_STAGE
#undef PG8_STAGE_A
#undef PG8_LDA
#undef PG8_LDB
#undef PG8_MMA
#undef PG8_WAIT_V
#undef PG8_WAIT_L
#undef PG8_BAR
#undef PG8_SCHED
}
}

namespace att {
typedef short bf16x8 __attribute__((ext_vector_type(8)));
typedef short s16x4 __attribute__((ext_vector_type(4)));
typedef float f32x16 __attribute__((ext_vector_type(16)));
typedef unsigned u32x4 __attribute__((ext_vector_type(4)));
typedef LAS char* lptr;
constexpr int SLOTB = 8192, NSLOT = 6, AHEAD = 4;
constexpr int L_K = 0, L_V = NSLOT * SLOTB, L_WS = 2 * NSLOT * SLOTB, L_OST = L_WS + 8 * 256, L_KB = L_OST + 8 * 4096, L_FLG = L_KB + 8192, L_END = L_FLG + 256;
static_assert(L_END <= ATT_LDS_MAX, "attention LDS map");
constexpr float THR = 8.0f;
__device__ __forceinline__ int crow(int r, int hi) { return (r & 3) + 8 * (r >> 2) + 4 * hi; }
__device__ __forceinline__ void glds16(const void* gsrc, unsigned lds_dst) { unsigned keep;
    asm volatile("s_mov_b32 %0, m0\n\ts_mov_b32 m0, %2\n\ts_nop 0\n\tglobal_load_lds_dwordx4 %1, off\n\ts_mov_b32 m0, %0" : "=&s"(keep) : "v"(gsrc), "s"(lds_dst) : "memory"); }
typedef float f32x2_t __attribute__((ext_vector_type(2))); typedef __bf16 bf16x2_t __attribute__((ext_vector_type(2)));
__device__ __forceinline__ unsigned cvtpk(float lo, float hi) { f32x2_t v = {lo, hi}; bf16x2_t b = __builtin_convertvector(v, bf16x2_t); return __builtin_bit_cast(unsigned, b); }
__device__ __forceinline__ float max3f(float a, float b, float c) { return __builtin_fmaxf(__builtin_fmaxf(a, b), c); }
__device__ __forceinline__ void wait_bar(int n) {
    if (n >= 6) asm volatile("s_waitcnt vmcnt(6) lgkmcnt(0)\n\ts_barrier" ::: "memory");
    else if (n >= 4) asm volatile("s_waitcnt vmcnt(4) lgkmcnt(0)\n\ts_barrier" ::: "memory");
    else if (n >= 2) asm volatile("s_waitcnt vmcnt(2) lgkmcnt(0)\n\ts_barrier" ::: "memory");
    else asm volatile("s_waitcnt vmcnt(0) lgkmcnt(0)\n\ts_barrier" ::: "memory");
}
__device__ __forceinline__ float other_half(float x, int hi) {
    auto rr = __builtin_amdgcn_permlane32_swap(__float_as_uint(x), __float_as_uint(x), false, false);
    return __uint_as_float(hi ? rr[0] : rr[1]);
}
__device__ __forceinline__ void qkt(f32x16& p0, f32x16& p1, lptr Kslot, const bf16x8* qr, const f32x16& c0, const f32x16& c1, int r32, int hi) {
    lptr kb = Kslot + hi * 1024 + r32 * 16;
#pragma unroll
    for (int d0 = 0; d0 < 4; ++d0) {
        const bf16x8 b0 = *(const LAS bf16x8*)(kb + d0 * 2048);
        const bf16x8 b1 = *(const LAS bf16x8*)(kb + d0 * 2048 + 512);
        if (d0 == 0) { p0 = __builtin_amdgcn_mfma_f32_32x32x16_bf16(b0, qr[0], c0, 0, 0, 0); p1 = __builtin_amdgcn_mfma_f32_32x32x16_bf16(b1, qr[0], c1, 0, 0, 0); }
        else { p0 = __builtin_amdgcn_mfma_f32_32x32x16_bf16(b0, qr[d0], p0, 0, 0, 0); p1 = __builtin_amdgcn_mfma_f32_32x32x16_bf16(b1, qr[d0], p1, 0, 0, 0); } }
}
__device__ __forceinline__ void pv(f32x16* o, int vb, bf16x8 pa0, bf16x8 pa1, bf16x8 pa2, bf16x8 pa3) {
#pragma unroll
    for (int d0 = 0; d0 < 2; ++d0) { s16x4 lo[4], hi[4];
#pragma unroll
        for (int ks = 0; ks < 4; ++ks) {
            asm volatile("ds_read_b64_tr_b16 %0,%1 offset:%c2" : "=&v"(lo[ks]) : "v"(vb), "i"(d0 * 4096 + ks * 1024) : "memory");
            asm volatile("ds_read_b64_tr_b16 %0,%1 offset:%c2" : "=&v"(hi[ks]) : "v"(vb), "i"(d0 * 4096 + ks * 1024 + 512) : "memory"); }
        asm volatile("s_waitcnt lgkmcnt(0)" ::: "memory"); __builtin_amdgcn_sched_barrier(0);
#define ATT_PK(k) (bf16x8){lo[k][0], lo[k][1], lo[k][2], lo[k][3], hi[k][0], hi[k][1], hi[k][2], hi[k][3]}
        o[d0] = __builtin_amdgcn_mfma_f32_32x32x16_bf16(pa0, ATT_PK(0), o[d0], 0, 0, 0);
        o[d0] = __builtin_amdgcn_mfma_f32_32x32x16_bf16(pa1, ATT_PK(1), o[d0], 0, 0, 0);
        o[d0] = __builtin_amdgcn_mfma_f32_32x32x16_bf16(pa2, ATT_PK(2), o[d0], 0, 0, 0);
        o[d0] = __builtin_amdgcn_mfma_f32_32x32x16_bf16(pa3, ATT_PK(3), o[d0], 0, 0, 0);
#undef ATT_PK
    }
}
__device__ __forceinline__ void pack_pv(f32x16* o, int vb, const f32x16& p0, const f32x16& p1) {
    u32x4 w0, w1, w2, w3;
#pragma unroll
    for (int j = 0; j < 4; ++j) { w0[j] = cvtpk(p0[2 * j], p0[2 * j + 1]); w1[j] = cvtpk(p0[8 + 2 * j], p0[8 + 2 * j + 1]); w2[j] = cvtpk(p1[2 * j], p1[2 * j + 1]); w3[j] = cvtpk(p1[8 + 2 * j], p1[8 + 2 * j + 1]); }
    pv(o, vb, __builtin_bit_cast(bf16x8, w0), __builtin_bit_cast(bf16x8, w1), __builtin_bit_cast(bf16x8, w2), __builtin_bit_cast(bf16x8, w3));
}
__device__ __forceinline__ float rowmax32(const f32x16& p0, const f32x16& p1, int hi) {
    float a = max3f(p0[0], p0[1], p1[0]), b = max3f(p0[2], p0[3], p1[1]); a = max3f(a, p1[2], p1[3]);
#pragma unroll
    for (int r = 4; r < 16; r += 4) { a = max3f(a, p0[r], p0[r + 1]); b = max3f(b, p0[r + 2], p0[r + 3]); a = max3f(a, p1[r], p1[r + 1]); b = max3f(b, p1[r + 2], p1[r + 3]); }
    a = fmaxf(a, b);
    return fmaxf(a, other_half(a, hi));
}
__device__ __forceinline__ void store_o(const f32x16* o, const float* sc, lptr stgb, bf16* Ow, long rpitch, int lane, int r32, int hi) {
    LAS bf16* stg = (LAS bf16*)stgb;
#pragma unroll
    for (int r = 0; r < 16; ++r) { const int orow = crow(r, hi);
#pragma unroll
        for (int d0 = 0; d0 < 2; ++d0) stg[orow * 64 + d0 * 32 + r32] = (bf16)f2bf(o[d0][r] * sc[r]); }
    asm volatile("s_waitcnt lgkmcnt(0)" ::: "memory");
#pragma unroll
    for (int i = 0; i < 4; ++i) { const int row = i * 8 + (lane >> 3), ch = lane & 7; const u32x4 v = *(const LAS u32x4*)(stg + row * 64 + ch * 8); *(u32x4*)(Ow + (long)row * rpitch + ch * 8) = v; }
}
__device__ __forceinline__ void softmax_step(f32x16& p0, f32x16& p1, float& mref, float& lsum, f32x16* o, LAS float* wsf, int r32, int hi) {
    const float rm = rowmax32(p0, p1, hi);
    const bool fresh = mref <= -1e30f;
    const bool want = !fresh && (rm > mref + THR);
    if (fresh) mref = fmaxf(rm, -1e30f);
    if (__any(want)) {
        const float dl = want ? rm - mref : 0.f; mref += dl; const float f = __builtin_amdgcn_exp2f(-dl); lsum *= f;
        if (hi == 0) wsf[r32] = f;
        asm volatile("s_waitcnt lgkmcnt(0)" ::: "memory");
#pragma unroll
        for (int r = 0; r < 16; ++r) { const float fr = wsf[crow(r, hi)]; o[0][r] *= fr; o[1][r] *= fr; }
    }
    float sa = 0.f, sb = 0.f;
#pragma unroll
    for (int r = 0; r < 16; ++r) { p0[r] = __builtin_amdgcn_exp2f(p0[r] - mref); p1[r] = __builtin_amdgcn_exp2f(p1[r] - mref); sa += p0[r]; sb += p1[r]; }
    lsum += sa + sb;
}

struct WaveCtx { int lane, r32, hi, wid; unsigned lds0; int vb0; lptr shm; };
struct UnitD { int NT; int b, h, qb, g, x; };

template <int MODE> struct CausalMode {
    const bf16* Q; const bf16* K; const bf16* V; bf16* O; int b, h, p;
    float carry, mref, lsum; int done;
    __device__ __forceinline__ int units() const { return 4; }
    __device__ __forceinline__ void desc(int j, UnitD& d) const { d.b = b; d.h = h; d.qb = (j == 0) ? 7 - p : (j == 1) ? 5 - p : (j == 2) ? 2 + p : p; d.NT = 4 * (d.qb + 1); d.g = 0; d.x = 0; }
    __device__ __forceinline__ int tile_of(const UnitD& d, int k) const { return MODE == 0 ? d.NT - 1 - k : k; }
    __device__ __forceinline__ void q_load(const UnitD& d, const WaveCtx& w, bf16x8 (&q)[4]) const {
        const bf16* Qw = Q + ((long)d.b * SEQ + d.qb * 256 + w.wid * 32 + w.r32) * DM + d.h * 64 + w.hi * 8;
#pragma unroll
        for (int d0 = 0; d0 < 4; ++d0) q[d0] = *(const bf16x8*)(Qw + d0 * 16);
    }
    __device__ __forceinline__ void dma(const UnitD& d, int k, int slot, const WaveCtx& w) const {
        const long row0 = (long)d.b * SEQ + 64 * tile_of(d, k);
        glds16(K + (row0 + w.lane) * DM + d.h * 64 + w.wid * 8, (unsigned)__builtin_amdgcn_readfirstlane(w.lds0 + L_K + slot * SLOTB + w.wid * 1024));
        glds16(V + (row0 + 16 * (w.wid & 3) + (w.lane >> 2)) * DM + d.h * 64 + (w.wid >> 2) * 32 + (w.lane & 3) * 8, (unsigned)__builtin_amdgcn_readfirstlane(w.lds0 + L_V + slot * SLOTB + w.wid * 1024));
    }
    __device__ __forceinline__ void begin(const UnitD&, const WaveCtx&) { carry = 1.0f; mref = -1e30f; lsum = 0.f; done = 0; }
    __device__ __forceinline__ int wave_done() const { return done; }
    __device__ __forceinline__ void compute(const UnitD& d, int k, int slot, const WaveCtx& w, const bf16x8* qr, f32x16* o) {
        const int T = tile_of(d, k), qfirst = d.qb * 256 + w.wid * 32, qpos = qfirst + w.r32;
        if (MODE == 0) {
            if (done || 64 * T >= qfirst + 31) return;
            f32x16 p0, p1; const f32x16 z = {}; qkt(p0, p1, w.shm + L_K + slot * SLOTB, qr, z, z, w.r32, w.hi);
            const bool diag = 64 * T + 63 >= qfirst;
            float ga[8];
#pragma unroll
            for (int a = 0; a < 8; ++a) {
                float rr[4];
#pragma unroll
                for (int i = 0; i < 4; ++i) { const int r = 4 * (a & 3) + i; const float zz = (a < 4) ? p0[r] : p1[r];
                    const float e = __builtin_amdgcn_exp2f(fminf(zz, 120.f)); float rv = __builtin_amdgcn_rcpf(1.0f + e);
                    if (diag) { const int kv = 64 * T + crow(r, w.hi) + ((a < 4) ? 0 : 32); if (kv >= qpos) rv = 1.0f; }
                    rr[i] = rv; if (a < 4) p0[r] = rv; else p1[r] = rv; }
                ga[a] = (rr[0] * rr[1]) * (rr[2] * rr[3]);
            }
            float oth[8], Ts[8];
#pragma unroll
            for (int a = 0; a < 8; ++a) oth[a] = other_half(ga[a], w.hi);
            float run = 1.0f;
#pragma unroll
            for (int a = 7; a >= 0; --a) { Ts[a] = run; run *= ga[a] * oth[a]; }
#pragma unroll
            for (int a = 0; a < 8; ++a) {
                float E = carry * Ts[a] * (w.hi ? 1.0f : oth[a]);
#pragma unroll
                for (int i = 3; i >= 0; --i) { const int r = 4 * (a & 3) + i; const float rv = (a < 4) ? p0[r] : p1[r]; const float wt = (1.0f - rv) * E; E *= rv; if (a < 4) p0[r] = wt; else p1[r] = wt; }
            }
            carry *= run;
            pack_pv(o, w.vb0 + slot * SLOTB, p0, p1);
            if (__all(carry < 1e-30f)) done = 1;
        } else {
            if (64 * T > qfirst + 31) return;
            LAS float* kbl = (LAS float*)(w.shm + L_KB);
            f32x16 c0, c1;
#pragma unroll
            for (int g = 0; g < 4; ++g) { const f32x4 k0 = *(const LAS f32x4*)(kbl + 64 * T + 8 * g + 4 * w.hi), k1 = *(const LAS f32x4*)(kbl + 64 * T + 32 + 8 * g + 4 * w.hi);
#pragma unroll
                for (int i = 0; i < 4; ++i) { c0[4 * g + i] = k0[i]; c1[4 * g + i] = k1[i]; } }
            f32x16 p0, p1; qkt(p0, p1, w.shm + L_K + slot * SLOTB, qr, c0, c1, w.r32, w.hi);
            if (64 * T + 63 > qfirst) {
#pragma unroll
                for (int r = 0; r < 16; ++r) { const int kv = 64 * T + crow(r, w.hi); if (kv > qpos) p0[r] = -INFINITY; if (kv + 32 > qpos) p1[r] = -INFINITY; } }
            softmax_step(p0, p1, mref, lsum, o, (LAS float*)(w.shm + L_WS) + w.wid * 64, w.r32, w.hi);
            pack_pv(o, w.vb0 + slot * SLOTB, p0, p1);
        }
    }
    __device__ __forceinline__ void finish(const UnitD& d, const WaveCtx& w, const f32x16* o) {
        LAS float* wsf = (LAS float*)(w.shm + L_WS) + w.wid * 64;
        float sc[16];
        if (MODE == 0) {
#pragma unroll
            for (int r = 0; r < 16; ++r) sc[r] = 1.0f;
        } else {
            float lt = lsum + other_half(lsum, w.hi);
            if (w.hi == 0) wsf[32 + w.r32] = lt;
            asm volatile("s_waitcnt lgkmcnt(0)" ::: "memory");
#pragma unroll
            for (int r = 0; r < 16; ++r) sc[r] = __builtin_amdgcn_rcpf(wsf[32 + crow(r, w.hi)]);
        }
        store_o(o, sc, w.shm + L_OST + w.wid * 4096, O + ((long)d.b * SEQ + d.qb * 256 + w.wid * 32) * DM + d.h * 64, DM, w.lane, w.r32, w.hi);
    }
};

struct DilMode {
    const bf16* PROJ; bf16* OG; float* ST; int b, h, p;
    float mref, lsum;
    __device__ __forceinline__ int units() const { return 12; }
    __device__ __forceinline__ void desc(int j, UnitD& d) const {
        const int g = j >> 2, i = j & 3; d.g = g; d.b = b; d.h = h; d.qb = 0;
        d.x = (g == 1) ? ((2 * (i >> 1) + p) << 1) + (i & 1) : 2 * i + p;
        const int i0 = (g == 0) ? 256 * d.x : (g == 1) ? 256 * (d.x & 1) : 0;
        d.NT = (g == 2) ? 4 : ((i0 >> 6) + 4 - t_lo(g, i0));
    }
    static __device__ __forceinline__ int t_lo(int g, int i0) { return (g == 2) ? 0 : ((i0 >> 6) >= 2 ? (i0 >> 6) - 2 : 0); }
    static __device__ __forceinline__ int dil_of(int g) { return (g == 0) ? 1 : (g == 1) ? 4 : 16; }
    static __device__ __forceinline__ int cls0_of(int g, int x) { return (g == 0) ? 0 : (g == 1) ? (x >> 1) : 2 * x; }
    static __device__ __forceinline__ int i0_of(int g, int x) { return (g == 0) ? 256 * x : (g == 1) ? 256 * (x & 1) : 0; }
    static __device__ __forceinline__ int tcls(int g, int x, int k) { return cls0_of(g, x) + ((g == 2) ? (k >> 1) : 0); }
    static __device__ __forceinline__ int kbase(int g, int x, int k) { return (g == 2) ? 64 * (k & 1) : 64 * (t_lo(g, i0_of(g, x)) + k); }
    __device__ __forceinline__ void q_load(const UnitD& d, const WaveCtx& w, bf16x8 (&q)[4]) const {
        const int dil = dil_of(d.g), clsw = cls0_of(d.g, d.x) + ((d.g == 2) ? (w.wid >> 2) : 0), qi0w = (d.g == 2) ? 32 * (w.wid & 3) : i0_of(d.g, d.x) + 32 * w.wid;
        const bf16* Qw = PROJ + (size_t)(2 * d.g) * PLANE + ((long)d.b * SEQ + clsw + (long)(qi0w + w.r32) * dil) * DM + d.h * 64 + w.hi * 8;
#pragma unroll
        for (int d0 = 0; d0 < 4; ++d0) q[d0] = *(const bf16x8*)(Qw + d0 * 16);
    }
    __device__ __forceinline__ void dma(const UnitD& d, int k, int slot, const WaveCtx& w) const {
        const int dil = dil_of(d.g); const long tok0 = (long)d.b * SEQ + tcls(d.g, d.x, k) + (long)kbase(d.g, d.x, k) * dil;
        glds16(PROJ + (size_t)(2 * d.g + 1) * PLANE + (tok0 + (long)w.lane * dil) * DM + d.h * 64 + w.wid * 8, (unsigned)__builtin_amdgcn_readfirstlane(w.lds0 + L_K + slot * SLOTB + w.wid * 1024));
        glds16(PROJ + (size_t)6 * PLANE + (tok0 + (long)(16 * (w.wid & 3) + (w.lane >> 2)) * dil) * DM + d.h * 64 + (w.wid >> 2) * 32 + (w.lane & 3) * 8, (unsigned)__builtin_amdgcn_readfirstlane(w.lds0 + L_V + slot * SLOTB + w.wid * 1024));
    }
    __device__ __forceinline__ void begin(const UnitD&, const WaveCtx&) { mref = -1e30f; lsum = 0.f; }
    __device__ __forceinline__ int wave_done() const { return 0; }
    __device__ __forceinline__ void compute(const UnitD& d, int k, int slot, const WaveCtx& w, const bf16x8* qr, f32x16* o) {
        const int clsw = cls0_of(d.g, d.x) + ((d.g == 2) ? (w.wid >> 2) : 0), qi0w = (d.g == 2) ? 32 * (w.wid & 3) : i0_of(d.g, d.x) + 32 * w.wid;
        const int kb = kbase(d.g, d.x, k);
        if (tcls(d.g, d.x, k) != clsw || kb > qi0w + 31 || kb < qi0w - 191) return;
        LAS float* tbl = (LAS float*)(w.shm + L_KB) + d.g * 640 + 256;
        const int dbase = qi0w + w.r32 - kb - 4 * w.hi;
        f32x16 c0, c1;
#pragma unroll
        for (int r = 0; r < 16; ++r) { const int cr = (r & 3) + 8 * (r >> 2); c0[r] = tbl[dbase - cr]; c1[r] = tbl[dbase - cr - 32]; }
        f32x16 p0, p1; qkt(p0, p1, w.shm + L_K + slot * SLOTB, qr, c0, c1, w.r32, w.hi);
        softmax_step(p0, p1, mref, lsum, o, (LAS float*)(w.shm + L_WS) + w.wid * 64, w.r32, w.hi);
        pack_pv(o, w.vb0 + slot * SLOTB, p0, p1);
    }
    __device__ __forceinline__ void finish(const UnitD& d, const WaveCtx& w, const f32x16* o) {
        const int dil = dil_of(d.g), clsw = cls0_of(d.g, d.x) + ((d.g == 2) ? (w.wid >> 2) : 0), qi0w = (d.g == 2) ? 32 * (w.wid & 3) : i0_of(d.g, d.x) + 32 * w.wid;
        LAS float* wsf = (LAS float*)(w.shm + L_WS) + w.wid * 64;
        const float lt = lsum + other_half(lsum, w.hi);
        if (w.hi == 0) { wsf[32 + w.r32] = lt;
            const long tok = (long)d.b * SEQ + clsw + (long)(qi0w + w.r32) * dil;
            *(f32x2*)(ST + ((size_t)d.g * M * NH + (size_t)tok * NH + d.h) * 2) = (f32x2){mref, lt}; }
        asm volatile("s_waitcnt lgkmcnt(0)" ::: "memory");
        float sc[16];
#pragma unroll
        for (int r = 0; r < 16; ++r) sc[r] = __builtin_amdgcn_rcpf(wsf[32 + crow(r, w.hi)]);
        store_o(o, sc, w.shm + L_OST + w.wid * 4096, OG + (size_t)d.g * PLANE + ((long)d.b * SEQ + clsw + (long)qi0w * dil) * DM + d.h * 64, (long)dil * DM, w.lane, w.r32, w.hi);
    }
};

template <class Mode, bool EARLY_EXIT>
__device__ __forceinline__ void stream_units(Mode& Mo, const WaveCtx& w) {
    LAS int* flg = (LAS int*)(w.shm + L_FLG);
    const int nun = Mo.units();
    int pj = 0, pk = 0, pseq = 0, cseq = 0;
    UnitD pd; Mo.desc(0, pd);
    bf16x8 qn[4];
    asm volatile("s_waitcnt vmcnt(0)" ::: "memory");
#define ATT_PRODUCE() do { if (pj < nun) { if (pk == 0) Mo.q_load(pd, w, qn); Mo.dma(pd, pk, pseq % NSLOT, w); ++pseq; if (++pk == pd.NT) { pk = 0; if (++pj < nun) Mo.desc(pj, pd); } } } while (0)
#pragma unroll 1
    for (int i = 0; i < AHEAD; ++i) ATT_PRODUCE();
#pragma unroll 1
    for (int cj = 0; cj < nun; ++cj) {
        UnitD d; Mo.desc(cj, d);
        bf16x8 qr[4];
        f32x16 o[2]; o[0] = f32x16{}; o[1] = f32x16{};
        Mo.begin(d, w);
        const int useq0 = cseq;
#pragma unroll 1
        while (pseq - cseq < AHEAD && pj < nun) ATT_PRODUCE();
#pragma unroll 1
        for (int ck = 0; ck < d.NT; ++ck) {
            wait_bar(2 * (pseq - cseq - 1));
            if (ck == 0) { asm volatile("" : "+v"(qn[0]), "+v"(qn[1]), "+v"(qn[2]), "+v"(qn[3])); qr[0] = qn[0]; qr[1] = qn[1]; qr[2] = qn[2]; qr[3] = qn[3]; }
            if (EARLY_EXIT && ck > 0) { int all = 1;
#pragma unroll
                for (int x = 0; x < 8; ++x) all &= (flg[((ck - 1) & 1) * 8 + x] == cj + 1) ? 1 : 0;
                if (__builtin_amdgcn_readfirstlane(all)) {
                    const int uend = useq0 + d.NT;
                    if (pj == cj) { pk = 0; if (++pj < nun) Mo.desc(pj, pd); }
                    cseq = uend < pseq ? uend : pseq;
                    break; } }
            if (pseq - cseq < AHEAD) ATT_PRODUCE();
            Mo.compute(d, ck, cseq % NSLOT, w, qr, o);
            if (EARLY_EXIT && w.lane == 0) flg[(ck & 1) * 8 + w.wid] = Mo.wave_done() ? cj + 1 : 0;
            ++cseq;
        }
        Mo.finish(d, w, o);
    }
    asm volatile("s_waitcnt vmcnt(0) lgkmcnt(0)\n\ts_barrier" ::: "memory");
#undef ATT_PRODUCE
}
__device__ __forceinline__ WaveCtx make_ctx(lptr shm) {
    WaveCtx w; const int tid = threadIdx.x; w.lane = tid & 63; w.r32 = w.lane & 31; w.hi = w.lane >> 5; w.wid = __builtin_amdgcn_readfirstlane(tid >> 6);
    w.shm = shm; w.lds0 = (unsigned)(uintptr_t)shm;
    w.vb0 = (int)(w.lds0 + L_V) + ((w.lane >> 4) & 1) * 32 + (w.lane & 3) * 8 + (4 * w.hi + ((w.lane & 15) >> 2)) * 64;
    return w;
}
template <int MODE>
__device__ __forceinline__ void causal_phase(lptr shm, int G, const bf16* Q, const bf16* K, const bf16* V, bf16* O, const float* cum) {
    const int bx = blockIdx.x; const int vcu = (G % 8 == 0) ? (bx % 8) * (G / 8) + bx / 8 : bx;
    const WaveCtx w = make_ctx(shm);
    for (int u = vcu; u < BATCH * NH * 2; u += G) {
        CausalMode<MODE> Mo; Mo.Q = Q; Mo.K = K; Mo.V = V; Mo.O = O; Mo.b = u >> 5; Mo.h = (u >> 1) & 15; Mo.p = u & 1;
        if (MODE == 2) { LAS float* kbl = (LAS float*)(shm + L_KB);
            for (int s = threadIdx.x; s < SEQ; s += NTHR) kbl[s] = -cum[((long)Mo.b * SEQ + s) * 16 + Mo.h]; }
        stream_units<CausalMode<MODE>, MODE == 0>(Mo, w);
    }
}
__device__ __forceinline__ int t5_bucket_f(int dist) {
    if (dist < 16) return dist;
    int lb = 16 + (int)(logf((float)dist / 16.0f) / logf(128.0f) * 16.0f);
    return lb < 31 ? lb : 31;
}
__device__ __forceinline__ void dil_phase(lptr shm, int G, const bf16* PROJ, bf16* OG, float* ST, const float* rel_bias) {
    const int bx = blockIdx.x; const int vcu = (G % 8 == 0) ? (bx % 8) * (G / 8) + bx / 8 : bx;
    const WaveCtx w = make_ctx(shm);
    for (int u = vcu; u < BATCH * NH * 2; u += G) {
        DilMode Mo; Mo.PROJ = PROJ; Mo.OG = OG; Mo.ST = ST; Mo.b = u >> 5; Mo.h = (u >> 1) & 15; Mo.p = u & 1;
        LAS float* tb = (LAS float*)(shm + L_KB);
        for (int i = threadIdx.x; i < 3 * 640; i += NTHR) { const int gg = i / 640, dl = i - gg * 640 - 256; const int dil = (gg == 0) ? 1 : (gg == 1) ? 4 : 16;
            tb[i] = (dl >= 0 && dl <= 128) ? rel_bias[t5_bucket_f(dl * dil) * 16 + Mo.h] * LOG2E : -INFINITY; }
        stream_units<DilMode, false>(Mo, w);
    }
}
__device__ __forceinline__ void dil_merge(int G, const bf16* OG, const float* ST, bf16* O) {
    for (int idx = blockIdx.x * NTHR + threadIdx.x; idx < M * NH; idx += G * NTHR) {
        const f32x2 s0 = *(const f32x2*)(ST + ((size_t)0 * M * NH + idx) * 2), s1 = *(const f32x2*)(ST + ((size_t)1 * M * NH + idx) * 2), s2 = *(const f32x2*)(ST + ((size_t)2 * M * NH + idx) * 2);
        const float mx = fmaxf(s0.x, fmaxf(s1.x, s2.x));
        float w0 = __builtin_amdgcn_exp2f(s0.x - mx) * s0.y, w1 = __builtin_amdgcn_exp2f(s1.x - mx) * s1.y, w2 = __builtin_amdgcn_exp2f(s2.x - mx) * s2.y;
        const float inv = 1.0f / (w0 + w1 + w2); w0 *= inv; w1 *= inv; w2 *= inv;
        const GAS v4u* a0 = (const GAS v4u*)(OG + (size_t)idx * 64); const GAS v4u* a1 = (const GAS v4u*)(OG + PLANE + (size_t)idx * 64); const GAS v4u* a2 = (const GAS v4u*)(OG + 2 * PLANE + (size_t)idx * 64);
        GAS v4u* op = (GAS v4u*)(O + (size_t)idx * 64);
#pragma unroll
        for (int c = 0; c < 8; ++c) { const v4u x0 = a0[c], x1 = a1[c], x2 = a2[c]; v4u r;
#pragma unroll
            for (int q = 0; q < 4; ++q) r[q] = pk2(w0 * bflo(x0[q]) + w1 * bflo(x1[q]) + w2 * bflo(x2[q]), w0 * bfhi(x0[q]) + w1 * bfhi(x1[q]) + w2 * bfhi(x2[q]));
            op[c] = r; }
    }
}
}

enum { CV_PLAIN = 0, CV_QKN = 1, CV_GATE = 2, CV_UP = 3 };
__device__ __forceinline__ int cv_dst_row(int mode, int n) {
    if (mode == CV_QKN) return (n & ~255) + 128 * ((n >> 5) & 1) + 32 * ((n >> 6) & 3) + (n & 31);
    if (mode == CV_GATE) return 256 * (n >> 7) + (n & 127);
    if (mode == CV_UP) return 256 * (n >> 7) + 128 + (n & 127);
    return n;
}
__device__ __forceinline__ void conv_item(const float* W, int ldw, int K, bf16* WT, int mode, LAS unsigned char* scr, int item, int nblk, int lane) {
    const int kb = item / nblk, nb = item - kb * nblk, k0 = 64 * kb, n0 = 64 * nb;
    const GAS float* src = (const GAS float*)(W + (size_t)k0 * ldw + n0 + lane);
#pragma unroll
    for (int kc = 0; kc < 8; ++kc) {
        float v[8];
#pragma unroll
        for (int j = 0; j < 8; ++j) v[j] = src[(size_t)(kc * 8 + j) * ldw];
        v4u w; w.x = pk2(v[0], v[1]); w.y = pk2(v[2], v[3]); w.z = pk2(v[4], v[5]); w.w = pk2(v[6], v[7]);
        *(LAS v4u*)(scr + lane * 144 + kc * 16) = w;
    }
    asm volatile("s_waitcnt lgkmcnt(0)" ::: "memory");
#pragma unroll
    for (int j = 0; j < 8; ++j) { const int n = 8 * j + (lane >> 3), ch = lane & 7;
        const v4u w = *(const LAS v4u*)(scr + n * 144 + ch * 16);
        *(GAS v4u*)(WT + (size_t)cv_dst_row(mode, n0 + n) * K + k0 + 8 * ch) = w; }
    asm volatile("s_waitcnt lgkmcnt(0)" ::: "memory");
}
__device__ __forceinline__ void conv_job(Frame& F, const float* W, int ldw, int K, int N, bf16* WT, int mode, int& rot) {
    LAS unsigned char* scr = F.lds + F.wave * 9216;
    const int nblk = N / 64, nitems = (K / 64) * nblk, NGW = F.G * NWAVES, gw = blockIdx.x * NWAVES + F.wave;
    int first = gw - (rot % NGW); if (first < 0) first += NGW;
    for (int it = first; it < nitems; it += NGW) conv_item(W, ldw, K, WT, mode, scr, it, nblk, F.lane);
    rot += nitems;
}
__device__ __forceinline__ void convert_weights(Frame& F) {
    bf16* WB = (bf16*)(F.ws + WS_W); int rot = 0;
    for (int j = 0; j < 2; ++j) conv_job(F, INP(1) + (size_t)j * DM * 3 * DM, 3 * DM, DM, 3 * DM, WB + WE_QKV + (size_t)j * 3 * DM * DM, CV_PLAIN, rot);
    for (int j = 0; j < 2; ++j) conv_job(F, INP(2) + (size_t)j * DM * DM, DM, DM, DM, WB + WE_WO_SB + (size_t)j * DM * DM, CV_PLAIN, rot);
    conv_job(F, INP(3), 7 * DM, DM, 7 * DM, WB + WE_IN_DIL, CV_QKN, rot);
    conv_job(F, INP(6), DM, DM, DM, WB + WE_WO_DIL, CV_PLAIN, rot);
    conv_job(F, INP(7), 3088, DM, 3 * DM, WB + WE_IN_FOX, CV_QKN, rot);
    conv_job(F, INP(11), DM, DM, DM, WB + WE_WO_FOX, CV_PLAIN, rot);
    for (int f = 0; f < 2; ++f) {
        conv_job(F, INP(15) + (size_t)f * DM * FF, FF, DM, FF, WB + WE_GU + (size_t)f * 2 * FF * DM, CV_GATE, rot);
        conv_job(F, INP(16) + (size_t)f * DM * FF, FF, DM, FF, WB + WE_GU + (size_t)f * 2 * FF * DM, CV_UP, rot);
        conv_job(F, INP(17) + (size_t)f * FF * DM, DM, FF, DM, WB + WE_D + (size_t)f * DM * FF, CV_PLAIN, rot);
    }
    for (int fe = 0; fe < 16; ++fe) {
        conv_job(F, INP(19) + (size_t)fe * DM * FF, FF, DM, FF, WB + WE_MGU + (size_t)fe * 2 * FF * DM, CV_GATE, rot);
        conv_job(F, INP(20) + (size_t)fe * DM * FF, FF, DM, FF, WB + WE_MGU + (size_t)fe * 2 * FF * DM, CV_UP, rot);
        conv_job(F, INP(21) + (size_t)fe * FF * DM, DM, FF, DM, WB + WE_MD + (size_t)fe * DM * FF, CV_PLAIN, rot);
    }
}

__device__ __forceinline__ int moe_cnt(Frame& F, int f, int e) {
    const unsigned long long w = __hip_atomic_load((GAS unsigned long long*)(F.ctl + CW_CNT + f * 64 + 16 * (e >> 2)), RLX_AGENT);
    return (int)((w >> (16 * (e & 3))) & 0xffffull);
}
__device__ __forceinline__ f32x4 moe_yrow(Frame& F, int r, int q4) {
    const bf16* Y = (const bf16*)(F.ws + WS_R2); const bf16* P = (const bf16*)(F.ws + WS_R2 + 72 * MiB);
    if (r < SPLIT_ROW0 || F.G != 256 || !MOE_SPLITK) { const v2u a = ((const GAS v2u*)(Y + (size_t)r * DM))[q4]; return (f32x4){bflo(a.x), bfhi(a.x), bflo(a.y), bfhi(a.y)}; }
    f32x4 s = (f32x4){0.f, 0.f, 0.f, 0.f};
#pragma unroll
    for (int k = 0; k < 4; ++k) { const v2u a = ((const GAS v2u*)(P + ((size_t)k * SPLIT_ROWS + (size_t)(r - SPLIT_ROW0)) * DM))[q4]; s = s + (f32x4){bflo(a.x), bfhi(a.x), bflo(a.y), bfhi(a.y)}; }
    return s;
}
__device__ __forceinline__ void moe_bases(Frame& F, int f, int (&tb)[NE + 1]) {
    int acc = 0;
#pragma unroll
    for (int e = 0; e < NE; ++e) { tb[e] = acc; const int c = moe_cnt(F, f, e); acc += (c + 255) >> 8; }
    tb[NE] = acc;
}

template <int NC>
__device__ __forceinline__ float wave_reduce_cols(float (&part)[NC], int lane) {
#pragma unroll
    for (int st = 0, n = NC / 2; n >= 1; ++st, n >>= 1) {
        const bool up = (lane >> st) & 1;
#pragma unroll
        for (int i = 0; i < n; ++i) { const float keep = up ? part[i + n] : part[i], send = up ? part[i] : part[i + n]; part[i] = keep + __shfl_xor(send, 1 << st); }
    }
    float v = part[0];
#pragma unroll
    for (int o = NC; o < 64; o <<= 1) v += __shfl_xor(v, o);
    return v;
}
template <int NC> __device__ __forceinline__ int lane_of_col(int c) {
    int l = 0;
#pragma unroll
    for (int st = 0, n = NC / 2; n >= 1; ++st, n >>= 1) { if (c & n) l |= 1 << st; }
    return l;
}
template <int FLAGS>
__device__ __forceinline__ void norm_phase(Frame& F, const float* xin, float* xout, const float* gain, bf16* H, int fprev, int f,
                                           const float* Wf  , const float* bf  , const float* Wr  ) {
    constexpr int NC = (FLAGS & 2) ? 16 : (FLAGS & 4) ? 8 : 0;
    const bf16* Y = (const bf16*)(F.ws + WS_R2);
    const int* tok_prev = (const int*)(F.ws + WS_MISC + MS_TOK) + (size_t)fprev * M * 2;
    float* lgf = (float*)(F.ws + WS_MISC + MS_LOGF);
    LAS int* sel = (LAS int*)F.lds;
    LAS float* sg = (LAS float*)(F.lds + 512);
    LAS int* gb = (LAS int*)(F.lds + 1536);
    LAS f32x4* WL = (LAS f32x4*)(F.lds + 4096);
    int tb[NE + 1];
    if (FLAGS & 1) moe_bases(F, fprev, tb);
    if (NC) {
        const float* Wsrc = (FLAGS & 2) ? Wf + 3072 : Wr; const int ldw = (FLAGS & 2) ? 3088 : 8;
        for (int idx = F.tid; idx < 16 * (NC / 4) * 64; idx += NTHR) {
            const int ln = idx & 63, cq = (idx >> 6) % (NC / 4), jq = idx / (64 * (NC / 4)), k = 4 * (ln + 64 * (jq >> 2)) + (jq & 3);
            WL[idx] = *(const GAS f32x4*)(Wsrc + (size_t)k * ldw + 4 * cq) * gain[k];
        }
        __syncthreads();
    }
    for (int chunk = blockIdx.x; chunk < M / 64; chunk += F.G) {
        for (int i = 0; i < 8; ++i) {
            const int m = chunk * 64 + F.wave * 8 + i;
            int ln = F.lane; asm volatile("" : "+v"(ln));
            const GAS f32x4* xr = (const GAS f32x4*)(xin + (size_t)m * DM) + ln;
            f32x4 v[4];
#pragma unroll
            for (int j = 0; j < 4; ++j) v[j] = xr[64 * j];
            if (FLAGS & 1) {
                const int s0 = tok_prev[m * 2], s1 = tok_prev[m * 2 + 1];
                int r0 = 0, r1 = 0;
#pragma unroll
                for (int e = 0; e < NE; ++e) { if ((s0 >> 14) == e) r0 = tb[e] * 256 + (s0 & 16383); if ((s1 >> 14) == e) r1 = tb[e] * 256 + (s1 & 16383); }
#pragma unroll
                for (int j = 0; j < 4; ++j) { v[j] = v[j] + moe_yrow(F, r0, ln + 64 * j) + moe_yrow(F, r1, ln + 64 * j);
                    ((GAS f32x4*)(xout + (size_t)m * DM) + ln)[64 * j] = v[j]; }
            }
            float s = 0.f;
#pragma unroll
            for (int j = 0; j < 4; ++j) s += (v[j].x * v[j].x + v[j].y * v[j].y) + (v[j].z * v[j].z + v[j].w * v[j].w);
            const float inv = 1.0f / sqrtf(wave_sum(s) * (1.f / DM) + RMS_EPS);
            float colv = 0.f;
            if (NC) {
                float part[NC ? NC : 1];
#pragma unroll
                for (int c = 0; c < NC; ++c) part[c] = 0.f;
                const int woff = ln;
#pragma unroll
                for (int j = 0; j < 4; ++j) {
#pragma unroll
                    for (int q = 0; q < 4; ++q) { const float xv = v[j][q];
#pragma unroll
                        for (int cq = 0; cq < NC / 4; ++cq) { const f32x4 w = WL[((j * 4 + q) * (NC / 4) + cq) * 64 + woff];
                            part[cq * 4 + 0] += xv * w.x; part[cq * 4 + 1] += xv * w.y; part[cq * 4 + 2] += xv * w.z; part[cq * 4 + 3] += xv * w.w; }
                        if ((q & 1) == 1) asm volatile("" ::: "memory"); } }
                colv = wave_reduce_cols<NC ? NC : 2>(reinterpret_cast<float (&)[NC ? NC : 2]>(part), ln) * inv;
            }
            if (H) {
                GAS unsigned long long* o8 = (GAS unsigned long long*)(H + (size_t)m * DM) + ln;
#pragma unroll
                for (int j = 0; j < 4; ++j) { const f32x4 g = ((const GAS f32x4*)gain + ln)[64 * j]; const f32x4 hv = v[j] * inv * g;
                    o8[64 * j] = (unsigned long long)pk2(hv.x, hv.y) | ((unsigned long long)pk2(hv.z, hv.w) << 32); }
            }
            if (FLAGS & 2) {
                if (ln < 16) { const int l = ln; const int c = ((l & 1) << 3) | ((l & 2) << 1) | ((l & 4) >> 1) | ((l & 8) >> 3);
                    const float z = colv + bf[c]; const float ls = fminf(z, 0.f) - log1pf(expf(-fabsf(z))); lgf[(size_t)m * 16 + c] = ls * LOG2E; }
            }
            if (FLAGS & 4) {
                float lg[8];
#pragma unroll
                for (int c = 0; c < 8; ++c) lg[c] = __builtin_bit_cast(float, __builtin_amdgcn_readlane(__builtin_bit_cast(int, colv), lane_of_col<8>(c)));
                int e0 = 0; float l0 = lg[0];
#pragma unroll
                for (int c = 1; c < 8; ++c) if (lg[c] > l0) { l0 = lg[c]; e0 = c; }
                int e1 = -1; float l1 = -INFINITY;
#pragma unroll
                for (int c = 0; c < 8; ++c) if (c != e0 && lg[c] > l1) { l1 = lg[c]; e1 = c; }
                const float g0 = 1.0f / (1.0f + expf(l1 - l0)), g1 = 1.0f - g0;
                if (ln == 0) { const int r = F.wave * 8 + i; sel[r * 2] = e0; sel[r * 2 + 1] = e1; sg[r * 2] = g0; sg[r * 2 + 1] = g1; }
            }
        }
        if (FLAGS & 4) {
            int* selg = (int*)(F.ws + WS_MISC + MS_SEL) + (size_t)f * M * 2;
            float* sgg = (float*)(F.ws + WS_MISC + MS_SG) + (size_t)f * M * 2;
            int* lcn = (int*)(F.ws + WS_MISC + MS_LC) + (size_t)f * 256 * 8;
            __syncthreads();
            if (F.tid < 128) { selg[chunk * 128 + F.tid] = sel[F.tid]; sgg[chunk * 128 + F.tid] = sg[F.tid]; }
            if (F.tid >= 128 && F.tid < 136) { const int e = F.tid - 128; int c = 0;
                for (int q = 0; q < 128; ++q) c += (sel[q] == e) ? 1 : 0;
                lcn[chunk * 8 + e] = c; }
            __syncthreads();
        }
    }
}

__device__ __forceinline__ void moe_finalize(Frame& F, int f) {
    const int* selg = (const int*)(F.ws + WS_MISC + MS_SEL) + (size_t)f * M * 2;
    const float* sgg = (const float*)(F.ws + WS_MISC + MS_SG) + (size_t)f * M * 2;
    const int* lcn = (const int*)(F.ws + WS_MISC + MS_LC) + (size_t)f * 256 * 8;
    int* list = (int*)(F.ws + WS_MISC + MS_LIST) + (size_t)f * NE * LCAP;
    float* gw = (float*)(F.ws + WS_MISC + MS_GW) + (size_t)f * NE * LCAP;
    int* tok = (int*)(F.ws + WS_MISC + MS_TOK) + (size_t)f * M * 2;
    LAS int* arr = (LAS int*)F.lds;
    LAS int* sel = (LAS int*)(F.lds + 8192);
    LAS int* pb = (LAS int*)(F.lds + 8192 + 512);
    LAS int* pt = (LAS int*)(F.lds + 8192 + 1536);
    LAS int* base = (LAS int*)(F.lds + 8192 + 2560);
    LAS int* tot = (LAS int*)(F.lds + 8192 + 2592);
    for (int chunk = blockIdx.x; chunk < M / 64; chunk += F.G) {
        if (F.tid < 256) { const v4u a = *(const GAS v4u*)(lcn + F.tid * 8), b = *(const GAS v4u*)(lcn + F.tid * 8 + 4);
            *(LAS v4u*)(arr + F.tid * 8) = a; *(LAS v4u*)(arr + F.tid * 8 + 4) = b; }
        if (F.tid < 128) sel[F.tid] = selg[chunk * 128 + F.tid];
        __syncthreads();
        if (F.tid < 256) { const int e = F.tid & 7, seg = F.tid >> 3; int b = 0, t = 0;
#pragma unroll
            for (int i = 0; i < 8; ++i) { const int c = seg * 8 + i; const int v = arr[c * 8 + e]; t += v; b += (c < chunk) ? v : 0; }
            pb[seg * 8 + e] = b; pt[seg * 8 + e] = t; }
        __syncthreads();
        if (F.tid < 8) { int b = 0, t = 0;
            for (int sgm = 0; sgm < 32; ++sgm) { b += pb[sgm * 8 + F.tid]; t += pt[sgm * 8 + F.tid]; }
            base[F.tid] = b; tot[F.tid] = t; }
        __syncthreads();
        if (F.tid < 128) { const int mye = sel[F.tid]; int lp = 0;
            for (int q = 0; q < 128; ++q) lp += (q < F.tid && sel[q] == mye) ? 1 : 0;
            const int q = F.tid, row = chunk * 64 + (q >> 1), pos = base[mye] + lp;
            list[mye * LCAP + pos] = row; gw[mye * LCAP + pos] = sgg[chunk * 128 + q]; tok[row * 2 + (q & 1)] = mye * LCAP + pos; }
        if (chunk == 0 && F.tid < 2) { unsigned long long w = 0ull;
#pragma unroll
            for (int i = 0; i < 4; ++i) w |= (unsigned long long)(unsigned)tot[4 * F.tid + i] << (16 * i);
            __hip_atomic_store((GAS unsigned long long*)(F.ctl + CW_CNT + f * 64 + 16 * F.tid), w, RLX_AGENT); }
        __syncthreads();
    }
}

__device__ __forceinline__ void final_combine(Frame& F, int f) {
    const bf16* Y = (const bf16*)(F.ws + WS_R2);
    const int* tok = (const int*)(F.ws + WS_MISC + MS_TOK) + (size_t)f * M * 2;
    int tb[NE + 1]; moe_bases(F, f, tb);
    for (int m = blockIdx.x * NWAVES + F.wave; m < M; m += F.G * NWAVES) {
        const int s0 = tok[m * 2], s1 = tok[m * 2 + 1]; int r0 = 0, r1 = 0;
#pragma unroll
        for (int e = 0; e < NE; ++e) { if ((s0 >> 14) == e) r0 = tb[e] * 256 + (s0 & 16383); if ((s1 >> 14) == e) r1 = tb[e] * 256 + (s1 & 16383); }
        GAS f32x4* xr = (GAS f32x4*)(F.out + (size_t)m * DM) + F.lane;
#pragma unroll
        for (int j = 0; j < 4; ++j) xr[64 * j] = xr[64 * j] + moe_yrow(F, r0, F.lane + 64 * j) + moe_yrow(F, r1, F.lane + 64 * j);
    }
}

__device__ __forceinline__ void cumsum_phase(Frame& F) {
    const float* logf = (const float*)(F.ws + WS_MISC + MS_LOGF);
    float* cum = (float*)(F.ws + WS_MISC + MS_CUM);
    const int gw = blockIdx.x * NWAVES + F.wave;
    if (gw < BATCH * NH) {
        const int b = gw >> 4, h = gw & 15;
        float v[32]; float s = 0.f;
#pragma unroll
        for (int i = 0; i < 32; ++i) { v[i] = logf[((size_t)b * SEQ + F.lane * 32 + i) * 16 + h]; s += v[i]; }
        float incl = s;
#pragma unroll
        for (int o = 1; o < 64; o <<= 1) { const float t = __shfl_up(incl, o); if (F.lane >= o) incl += t; }
        float run = incl - s;
#pragma unroll
        for (int i = 0; i < 32; ++i) { run += v[i]; cum[((size_t)b * SEQ + F.lane * 32 + i) * 16 + h] = run; }
    }
}

enum { EPI_PLANES = 0, EPI_RESID = 1, EPI_SWIGLU = 2, EPI_MOEDOWN = 3 };
struct SgP { const bf16* A; int lda; const int* rowidx; int Mrows; const float* W0; const float* W1; int ldw; int K; int N;
             bf16* outb; int ldo; float scale0; const float* base; float* outf; const float* gwv; };
template <int EPI>
__device__ __forceinline__ void sgemm(Frame& F, const SgP& p) {
    LAS float* As = (LAS float*)F.lds;
    LAS float* Bs0 = As + 16 * 132;
    LAS float* Bs1 = Bs0 + 16 * 128;
    const int tid = F.tid, ty = tid >> 4, tx = tid & 15;
    const int lrow = tid >> 2, lkq = (tid & 3) * 4;
    const int bk = tid >> 5, bn = (tid & 31) * 4;
    const int ntn = p.N / 128, ntiles = (p.Mrows / 128) * ntn;
    for (int tile = blockIdx.x; tile < ntiles; tile += F.G) {
        const int tm = tile / ntn, tn = tile % ntn;
        const int arow = p.rowidx ? p.rowidx[tm * 128 + lrow] : tm * 128 + lrow;
        const bf16* ap = p.A + (size_t)arow * p.lda + lkq;
        const float* bp0 = p.W0 + (size_t)bk * p.ldw + tn * 128 + bn;
        const float* bp1 = (EPI == EPI_SWIGLU) ? p.W1 + (size_t)bk * p.ldw + tn * 128 + bn : nullptr;
        f32x2 acc0[4][4], acc1[4][4];
#pragma unroll
        for (int i = 0; i < 4; ++i)
#pragma unroll
            for (int j = 0; j < 4; ++j) { acc0[i][j] = (f32x2){0.f, 0.f}; acc1[i][j] = (f32x2){0.f, 0.f}; }
        for (int k0 = 0; k0 < p.K; k0 += 16) {
            const v2u av = *(const GAS v2u*)(ap + k0);
            const f32x4 b0 = *(const GAS f32x4*)(bp0 + (size_t)k0 * p.ldw);
            f32x4 b1 = (f32x4){0.f, 0.f, 0.f, 0.f};
            if (EPI == EPI_SWIGLU) b1 = *(const GAS f32x4*)(bp1 + (size_t)k0 * p.ldw);
            __syncthreads();
            As[(lkq + 0) * 132 + lrow] = bflo(av.x); As[(lkq + 1) * 132 + lrow] = bfhi(av.x);
            As[(lkq + 2) * 132 + lrow] = bflo(av.y); As[(lkq + 3) * 132 + lrow] = bfhi(av.y);
            *(LAS f32x4*)(Bs0 + bk * 128 + bn) = b0;
            if (EPI == EPI_SWIGLU) *(LAS f32x4*)(Bs1 + bk * 128 + bn) = b1;
            __syncthreads();
#pragma unroll 2
            for (int k = 0; k < 16; ++k) {
                const f32x4 a = *(const LAS f32x4*)(As + k * 132 + ty * 4);
                const f32x4 bA = *(const LAS f32x4*)(Bs0 + k * 128 + tx * 8), bB = *(const LAS f32x4*)(Bs0 + k * 128 + tx * 8 + 4);
                const f32x2 bv[4] = {(f32x2){bA.x, bA.y}, (f32x2){bA.z, bA.w}, (f32x2){bB.x, bB.y}, (f32x2){bB.z, bB.w}};
#pragma unroll
                for (int i = 0; i < 4; ++i) {
#pragma unroll
                    for (int j = 0; j < 4; ++j) acc0[i][j] += a[i] * bv[j]; }
                if (EPI == EPI_SWIGLU) {
                    const f32x4 cA = *(const LAS f32x4*)(Bs1 + k * 128 + tx * 8), cB = *(const LAS f32x4*)(Bs1 + k * 128 + tx * 8 + 4);
                    const f32x2 cv[4] = {(f32x2){cA.x, cA.y}, (f32x2){cA.z, cA.w}, (f32x2){cB.x, cB.y}, (f32x2){cB.z, cB.w}};
#pragma unroll
                    for (int i = 0; i < 4; ++i) {
#pragma unroll
                        for (int j = 0; j < 4; ++j) acc1[i][j] += a[i] * cv[j]; }
                }
                __builtin_amdgcn_sched_barrier(0);
            }
        }
        const int c0 = tn * 128 + tx * 8;
#pragma unroll
        for (int i = 0; i < 4; ++i) {
            const int r = tm * 128 + ty * 4 + i;
            if (EPI == EPI_PLANES) {
                const int pl = c0 >> 10, cc = c0 & 1023; const float sc = (pl == 0) ? p.scale0 : 1.f;
                v4u w; w.x = pk2(acc0[i][0].x * sc, acc0[i][0].y * sc); w.y = pk2(acc0[i][1].x * sc, acc0[i][1].y * sc); w.z = pk2(acc0[i][2].x * sc, acc0[i][2].y * sc); w.w = pk2(acc0[i][3].x * sc, acc0[i][3].y * sc);
                *(GAS v4u*)(p.outb + (size_t)pl * PLANE + (size_t)r * DM + cc) = w;
            } else if (EPI == EPI_RESID) {
                const GAS f32x4* bp = (const GAS f32x4*)(p.base + (size_t)r * DM + c0); GAS f32x4* op = (GAS f32x4*)(p.outf + (size_t)r * DM + c0);
                const f32x4 x0 = bp[0], x1 = bp[1];
                op[0] = x0 + (f32x4){acc0[i][0].x, acc0[i][0].y, acc0[i][1].x, acc0[i][1].y}; op[1] = x1 + (f32x4){acc0[i][2].x, acc0[i][2].y, acc0[i][3].x, acc0[i][3].y};
            } else if (EPI == EPI_SWIGLU) {
                float o[8];
#pragma unroll
                for (int j = 0; j < 8; ++j) { const float g = acc0[i][j >> 1][j & 1], uu = acc1[i][j >> 1][j & 1]; o[j] = g / (1.0f + __expf(-g)) * uu; }
                v4u w; w.x = pk2(o[0], o[1]); w.y = pk2(o[2], o[3]); w.z = pk2(o[4], o[5]); w.w = pk2(o[6], o[7]);
                *(GAS v4u*)(p.outb + (size_t)r * p.ldo + c0) = w;
            } else {
                const float g = p.gwv[r]; GAS f32x4* op = (GAS f32x4*)(p.outf + (size_t)r * DM + c0);
                op[0] = (f32x4){acc0[i][0].x * g, acc0[i][0].y * g, acc0[i][1].x * g, acc0[i][1].y * g}; op[1] = (f32x4){acc0[i][2].x * g, acc0[i][2].y * g, acc0[i][3].x * g, acc0[i][3].y * g};
            }
        }
    }
}

__device__ __forceinline__ void qknorm_plane(Frame& F, bf16* plane, const float* gain, float mul) {
    const int nth = F.G * NTHR;
    for (int idx = blockIdx.x * NTHR + F.tid; idx < M * NH; idx += nth) {
        GAS v4u* p = (GAS v4u*)(plane + (size_t)idx * 64);
        v4u w[8]; float ss = 0.f;
#pragma unroll
        for (int c = 0; c < 8; ++c) { w[c] = p[c];
#pragma unroll
            for (int q = 0; q < 4; ++q) { const float a = bflo(w[c][q]), b = bfhi(w[c][q]); ss += a * a + b * b; } }
        const float inv = 1.0f / sqrtf(ss * (1.f / 64.f) + RMS_EPS) * mul;
#pragma unroll
        for (int c = 0; c < 8; ++c) { v4u o;
#pragma unroll
            for (int q = 0; q < 4; ++q) { const float a = bflo(w[c][q]) * inv * gain[c * 8 + 2 * q], b = bfhi(w[c][q]) * inv * gain[c * 8 + 2 * q + 1]; o[q] = pk2(a, b); }
            p[c] = o; }
    }
}

template <int MODE>
__device__ __forceinline__ void attn_simple_causal(Frame& F, const bf16* Qp, const bf16* Kp, const bf16* Vp, bf16* O, const float* cum) {
    LAS float* Ks = (LAS float*)F.lds;
    LAS float* Vs = Ks + 4096;
    LAS float* kb = Vs + 4096;
    for (int u = blockIdx.x; u < BATCH * NH * 4; u += F.G) {
        const int qblk = (u & 1) ? 3 - ((u >> 1) & 1) : ((u >> 1) & 1) * 1;
        const int bh = u >> 2, b = bh >> 4, h = bh & 15;
        const int t = qblk * 512 + F.tid;
        const size_t rowbase = (size_t)b * SEQ;
        float q[64], acc[64];
        { const GAS v4u* qp = (const GAS v4u*)(Qp + (rowbase + t) * DM + h * 64);
#pragma unroll
          for (int c = 0; c < 8; ++c) { const v4u w = qp[c];
#pragma unroll
              for (int k = 0; k < 4; ++k) { q[c * 8 + 2 * k] = bflo(w[k]); q[c * 8 + 2 * k + 1] = bfhi(w[k]); } } }
#pragma unroll
        for (int d = 0; d < 64; ++d) acc[d] = 0.f;
        float P = 1.f, mrun = -INFINITY, lrun = 0.f;
        const int ntile = 8 * (qblk + 1);
        for (int it = 0; it < ntile; ++it) {
            const int tile = (MODE == 0) ? ntile - 1 - it : it;
            __syncthreads();
            { const int key = F.tid >> 3, ch = F.tid & 7;
              const v4u kw = *(const GAS v4u*)(Kp + (rowbase + tile * 64 + key) * DM + h * 64 + ch * 8);
              const v4u vw = *(const GAS v4u*)(Vp + (rowbase + tile * 64 + key) * DM + h * 64 + ch * 8);
#pragma unroll
              for (int k = 0; k < 4; ++k) { Ks[key * 64 + ch * 8 + 2 * k] = bflo(kw[k]); Ks[key * 64 + ch * 8 + 2 * k + 1] = bfhi(kw[k]);
                                            Vs[key * 64 + ch * 8 + 2 * k] = bflo(vw[k]); Vs[key * 64 + ch * 8 + 2 * k + 1] = bfhi(vw[k]); }
              if (MODE == 2 && F.tid < 64) kb[F.tid] = -cum[(rowbase + tile * 64 + F.tid) * 16 + h]; }
            __syncthreads();
            for (int jj = 0; jj < 64; ++jj) {
                const int j = (MODE == 0) ? 63 - jj : jj; const int s = tile * 64 + j;
                float z = 0.f;
#pragma unroll
                for (int d4 = 0; d4 < 16; ++d4) { const f32x4 kv = *(const LAS f32x4*)(Ks + j * 64 + d4 * 4); z += q[d4 * 4] * kv.x + q[d4 * 4 + 1] * kv.y + q[d4 * 4 + 2] * kv.z + q[d4 * 4 + 3] * kv.w; }
                if (MODE == 0) {
                    const bool valid = s < t;
                    const float e = __builtin_amdgcn_exp2f(fminf(z, 100.f));
                    float r = 1.0f / (1.0f + e); float beta = 1.0f - r;
                    if (!valid) { r = 1.f; beta = 0.f; }
                    const float w = beta * P; P *= r;
#pragma unroll
                    for (int d4 = 0; d4 < 16; ++d4) { const f32x4 vv = *(const LAS f32x4*)(Vs + j * 64 + d4 * 4); acc[d4 * 4] += w * vv.x; acc[d4 * 4 + 1] += w * vv.y; acc[d4 * 4 + 2] += w * vv.z; acc[d4 * 4 + 3] += w * vv.w; }
                } else {
                    const bool valid = s <= t;
                    const float x = valid ? z + kb[j] : -INFINITY;
                    const float mn = fmaxf(mrun, x);
                    const float a = __builtin_amdgcn_exp2f(mrun - mn), pw = __builtin_amdgcn_exp2f(x - mn);
                    lrun = lrun * a + pw; mrun = mn;
#pragma unroll
                    for (int d4 = 0; d4 < 16; ++d4) { const f32x4 vv = *(const LAS f32x4*)(Vs + j * 64 + d4 * 4);
                        acc[d4 * 4] = acc[d4 * 4] * a + pw * vv.x; acc[d4 * 4 + 1] = acc[d4 * 4 + 1] * a + pw * vv.y; acc[d4 * 4 + 2] = acc[d4 * 4 + 2] * a + pw * vv.z; acc[d4 * 4 + 3] = acc[d4 * 4 + 3] * a + pw * vv.w; }
                }
            }
        }
        const float fin = (MODE == 0) ? 1.f : 1.0f / lrun;
        GAS v4u* op = (GAS v4u*)(O + (rowbase + t) * DM + h * 64);
#pragma unroll
        for (int c = 0; c < 8; ++c) { v4u w;
#pragma unroll
            for (int k = 0; k < 4; ++k) w[k] = pk2(acc[c * 8 + 2 * k] * fin, acc[c * 8 + 2 * k + 1] * fin);
            op[c] = w; }
    }
}

__device__ __forceinline__ int t5_bucket(int dist) {
    if (dist < 16) return dist;
    const float d = (float)dist;
    int lb = 16 + (int)(logf(d / 16.0f) / logf(128.0f) * 16.0f);
    return lb < 31 ? lb : 31;
}
__device__ __forceinline__ void attn_simple_dil(Frame& F, const bf16* PROJ, bf16* O, const float* rel_bias) {
    LAS float* tbl = (LAS float*)F.lds;
    for (int u = blockIdx.x; u < BATCH * NH * 4; u += F.G) {
        const int qblk = u & 3, bh = u >> 2, b = bh >> 4, h = bh & 15;
        const int t = qblk * 512 + F.tid;
        const size_t rowbase = (size_t)b * SEQ;
        __syncthreads();
        for (int i = F.tid; i < 3 * 129; i += NTHR) { const int g = i / 129, dl = i % 129, dil = (g == 0) ? 1 : (g == 1) ? 4 : 16;
            tbl[g * 132 + dl] = rel_bias[t5_bucket(dl * dil) * 16 + h] * LOG2E; }
        __syncthreads();
        float acc[64];
#pragma unroll
        for (int d = 0; d < 64; ++d) acc[d] = 0.f;
        float mrun = -INFINITY, lrun = 0.f;
        for (int g = 0; g < 3; ++g) {
            const int dil = (g == 0) ? 1 : (g == 1) ? 4 : 16;
            const bf16* Qg = PROJ + (size_t)(2 * g) * PLANE; const bf16* Kg = PROJ + (size_t)(2 * g + 1) * PLANE; const bf16* Vg = PROJ + (size_t)6 * PLANE;
            float q[64];
            { const GAS v4u* qp = (const GAS v4u*)(Qg + (rowbase + t) * DM + h * 64);
#pragma unroll
              for (int c = 0; c < 8; ++c) { const v4u w = qp[c];
#pragma unroll
                  for (int k = 0; k < 4; ++k) { q[c * 8 + 2 * k] = bflo(w[k]); q[c * 8 + 2 * k + 1] = bfhi(w[k]); } } }
            for (int dl = 0; dl <= 128; ++dl) {
                const int s = t - dl * dil; const bool valid = s >= 0; const int sc = valid ? s : 0;
                const GAS v4u* kp = (const GAS v4u*)(Kg + (rowbase + sc) * DM + h * 64);
                float z = 0.f;
#pragma unroll
                for (int c = 0; c < 8; ++c) { const v4u w = kp[c];
#pragma unroll
                    for (int k = 0; k < 4; ++k) z += q[c * 8 + 2 * k] * bflo(w[k]) + q[c * 8 + 2 * k + 1] * bfhi(w[k]); }
                const float x = valid ? z + tbl[g * 132 + dl] : -INFINITY;
                const float mn = fmaxf(mrun, x);
                const float a = __builtin_amdgcn_exp2f(mrun - mn), pw = __builtin_amdgcn_exp2f(x - mn);
                lrun = lrun * a + pw; mrun = mn;
                const GAS v4u* vp = (const GAS v4u*)(Vg + (rowbase + sc) * DM + h * 64);
#pragma unroll
                for (int c = 0; c < 8; ++c) { const v4u w = vp[c];
#pragma unroll
                    for (int k = 0; k < 4; ++k) { acc[c * 8 + 2 * k] = acc[c * 8 + 2 * k] * a + pw * bflo(w[k]); acc[c * 8 + 2 * k + 1] = acc[c * 8 + 2 * k + 1] * a + pw * bfhi(w[k]); } }
            }
        }
        const float fin = 1.0f / lrun;
        GAS v4u* op = (GAS v4u*)(O + (rowbase + t) * DM + h * 64);
#pragma unroll
        for (int c = 0; c < 8; ++c) { v4u w;
#pragma unroll
            for (int k = 0; k < 4; ++k) w[k] = pk2(acc[c * 8 + 2 * k] * fin, acc[c * 8 + 2 * k + 1] * fin);
            op[c] = w; }
    }
}

__device__ __forceinline__ void moe_gu_simple(Frame& F, int f, const bf16* H, bf16* ACT) {
    const int* list = (const int*)(F.ws + WS_MISC + MS_LIST) + (size_t)f * NE * LCAP;
    int base = 0;
    for (int e = 0; e < NE; ++e) {
        const int c = moe_cnt(F, f, e); const int nt = (c + 255) >> 8;
        if (nt) {
            SgP p{}; p.A = H; p.lda = DM; p.rowidx = list + e * LCAP; p.Mrows = nt * 256;
            p.W0 = INP(19) + ((size_t)f * NE + e) * DM * FF; p.W1 = INP(20) + ((size_t)f * NE + e) * DM * FF; p.ldw = FF; p.K = DM; p.N = FF;
            p.outb = ACT + (size_t)base * 256 * FF; p.ldo = FF;
            sgemm<EPI_SWIGLU>(F, p);
        }
        base += nt;
    }
}
__device__ __forceinline__ void moe_down_simple(Frame& F, int f, const bf16* ACT, float* Y) {
    const float* gw = (const float*)(F.ws + WS_MISC + MS_GW) + (size_t)f * NE * LCAP;
    int base = 0;
    for (int e = 0; e < NE; ++e) {
        const int c = moe_cnt(F, f, e); const int nt = (c + 255) >> 8;
        if (nt) {
            SgP p{}; p.A = ACT + (size_t)base * 256 * FF; p.lda = FF; p.rowidx = nullptr; p.Mrows = nt * 256;
            p.W0 = INP(21) + ((size_t)f * NE + e) * FF * DM; p.ldw = DM; p.K = FF; p.N = DM;
            p.outf = Y + (size_t)base * 256 * DM; p.gwv = gw + e * LCAP;
            sgemm<EPI_MOEDOWN>(F, p);
        }
        base += nt;
    }
}


template <class Epi>
__device__ __forceinline__ void dense_gemm(Frame& F, const bf16* A, const bf16* Bt, int N, int K, const Epi& E) {
    pg8::DenseOrder S; S.init(A, Bt, M, N, K, F.G, (int)blockIdx.x);
    pg8::gemm_phase<Epi, pg8::DenseOrder, false>(F.lds, K, S, E);
}
__device__ __forceinline__ void moe_order_init(Frame& F, int f, pg8::MoeOrder& S) {
    int acc = 0, t[NE];
#pragma unroll
    for (int e = 0; e < NE; ++e) { const int c = moe_cnt(F, f, e); acc += (c + 255) >> 8; t[e] = acc; }
    S.t1 = t[0]; S.t2 = t[1]; S.t3 = t[2]; S.t4 = t[3]; S.t5 = t[4]; S.t6 = t[5]; S.t7 = t[6]; S.t8 = t[7];
    S.G = F.G; S.c = (int)blockIdx.x;
}
__device__ __forceinline__ void moe_gu_fast(Frame& F, int f, const bf16* H, bf16* ACT) {
    pg8::MoeOrder S; moe_order_init(F, f, S);
    S.nN = 2 * FF / 256; S.K = DM; S.A = (const char*)H; S.Bt = (const char*)((const bf16*)(F.ws + WS_W) + WE_MGU + (size_t)f * NE * 2 * FF * DM);
    S.tstepA = (size_t)256 * DM * 2; S.tstepB = (size_t)256 * DM * 2; S.estepB = (size_t)2 * FF * DM * 2;
    S.list = (const int*)(F.ws + WS_MISC + MS_LIST) + (size_t)f * NE * LCAP; S.gather = true; S.splitk = 0;
    pg8::EpiSwiglu E{ACT};
    pg8::gemm_phase<pg8::EpiSwiglu, pg8::MoeOrder, true>(F.lds, DM, S, E);
}
__device__ __forceinline__ void moe_down_fast(Frame& F, int f, const bf16* ACT, bf16* Y) {
    pg8::MoeOrder S; moe_order_init(F, f, S);
    S.nN = DM / 256; S.K = FF; S.A = (const char*)ACT; S.Bt = (const char*)((const bf16*)(F.ws + WS_W) + WE_MD + (size_t)f * NE * DM * FF);
    S.tstepA = (size_t)256 * FF * 2; S.tstepB = (size_t)256 * FF * 2; S.estepB = (size_t)DM * FF * 2;
    S.list = nullptr; S.gather = false; S.splitk = (MOE_SPLITK && F.G == 256) ? 4 : 0;
    pg8::EpiMoeDown E{Y, (const float*)(F.ws + WS_MISC + MS_GW) + (size_t)f * NE * LCAP, (bf16*)(F.ws + WS_R2 + 72 * MiB)};
    pg8::gemm_phase<pg8::EpiMoeDown, pg8::MoeOrder, false>(F.lds, FF, S, E);
}

struct Args { const float* in[22]; float* out; unsigned char* ws; int ph_lo, ph_hi; };
constexpr int N_PHASES = 33;

__global__ void __launch_bounds__(NTHR, 2) trunk_fwd(Args args) {
    extern __shared__ __attribute__((aligned(16))) unsigned char lds[];
    Frame F;
    F.lds = (LAS unsigned char*)lds;
    F.tid = threadIdx.x; F.lane = F.tid & 63; F.wave = __builtin_amdgcn_readfirstlane(F.tid >> 6); F.G = gridDim.x;
    F.ws = args.ws; F.ctl = (gu32*)(args.ws + WS_CTL); F.out = args.out;
    if (F.tid == 0) {
#pragma unroll
        for (int i = 0; i < 22; ++i) ((LAS unsigned long long*)(F.lds + PTR_OFF))[i] = (unsigned long long)args.in[i];
    }
    volatile LAS unsigned* MISC = (volatile LAS unsigned*)(F.lds + MISC_OFF);
    if (F.tid < 32) MISC[F.tid] = 0u;
    __syncthreads();
    XcdBarrier bar; bar.bar = (unsigned*)(F.ctl + CW_BAR); bar.x = 0; bar.st = nullptr;
    const int lo = args.ph_lo, hi = args.ph_hi;
    if (hi - lo > 1) bar = xcd_barrier_post((unsigned*)(F.ctl + CW_BAR), MISC + 8);
#ifndef PHSEL
#define PHSEL 0xFFFFFFFFFFFFFFFFull
#endif
#define IN(k) (lo <= (k) && (k) < hi && ((PHSEL >> (k)) & 1ull) && relaunder(F))
#define SEAM(k) do { if (IN((k) + 1) && IN(k)) xcd_barrier(bar); } while (0)
#ifndef DUPMASK
#define DUPMASK 0ull
#endif
#define DUP(k) (((DUPMASK >> (k)) & 1ull) != 0ull)

    bf16* H = (bf16*)(F.ws + WS_H);
    bf16* PROJ = (bf16*)(F.ws + WS_R1);
    bf16* ACT = (bf16*)(F.ws + WS_R1);
    bf16* O = (bf16*)(F.ws + WS_R2);
    bf16* Y = (bf16*)(F.ws + WS_R2);
    bf16* OG = (bf16*)(F.ws + WS_R2 + 32 * MiB);
    float* ST = (float*)(F.ws + WS_R2 + 128 * MiB);
    float* X = F.out;
    float* DUMMY = (float*)(F.ws + WS_R2 + 32 * MiB);
    const float* cum = (const float*)(F.ws + WS_MISC + MS_CUM);

    const bf16* WB = (const bf16*)(F.ws + WS_W);
    enum { PH_BASE = __COUNTER__ + 1 };
#define PHASE(...) { constexpr int k_ = __COUNTER__ - PH_BASE; if (IN(k_)) { __VA_ARGS__; if (DUP(k_)) { xcd_barrier(bar); __VA_ARGS__; } SEAM(k_); } }
    PHASE({ unsigned* z = (unsigned*)(F.ws + WS_MISC + MS_LIST);
            for (int i = blockIdx.x * NTHR + F.tid; i < (int)(2 * MiB / 4); i += F.G * NTHR) z[i] = 0u;
            convert_weights(F); })
    PHASE(norm_phase<0>(F, INP(0), nullptr, INP(13) + 0 * DM, H, 0, 0, nullptr, nullptr, nullptr))
    PHASE({ pg8::EpiPlanes E{PROJ, C2}; dense_gemm(F, H, WB + WE_QKV, 3 * DM, DM, E); })
    PHASE(att::causal_phase<0>((att::lptr)F.lds, F.G, PROJ, PROJ + PLANE, PROJ + 2 * PLANE, O, nullptr))
    PHASE({ pg8::EpiResid E{INP(0), X}; dense_gemm(F, O, WB + WE_WO_SB, DM, DM, E); })
    PHASE(norm_phase<0>(F, X, nullptr, INP(14) + 0 * DM, H, 0, 0, nullptr, nullptr, nullptr))
    PHASE({ pg8::EpiSwiglu E{ACT}; dense_gemm(F, H, WB + WE_GU, 2 * FF, DM, E); })
    PHASE({ pg8::EpiResid E{X, X}; dense_gemm(F, ACT, WB + WE_D, DM, FF, E); })
    PHASE(norm_phase<0>(F, X, nullptr, INP(13) + 1 * DM, H, 0, 0, nullptr, nullptr, nullptr))
    PHASE({ pg8::EpiQKNorm E{PROJ, INP(4), INP(5), 6}; dense_gemm(F, H, WB + WE_IN_DIL, 7 * DM, DM, E); })
    PHASE(att::dil_phase((att::lptr)F.lds, F.G, PROJ, OG, ST, INP(12)))
    PHASE(att::dil_merge(F.G, OG, ST, O))
    PHASE({ pg8::EpiResid E{X, X}; dense_gemm(F, O, WB + WE_WO_DIL, DM, DM, E); })
    PHASE(norm_phase<4>(F, X, nullptr, INP(14) + 1 * DM, H, 0, 0, nullptr, nullptr, INP(18) + 0 * DM * NE))
    PHASE(moe_finalize(F, 0))
    PHASE(moe_gu_fast(F, 0, H, ACT))
    PHASE(moe_down_fast(F, 0, ACT, Y))
    PHASE(norm_phase<1 | 2>(F, X, X, INP(13) + 2 * DM, H, 0, 0, INP(7), INP(8), nullptr))
    PHASE({ cumsum_phase(F); pg8::EpiQKNorm E{PROJ, INP(9), INP(10), 2}; dense_gemm(F, H, WB + WE_IN_FOX, 3 * DM, DM, E); })
    PHASE(att::causal_phase<2>((att::lptr)F.lds, F.G, PROJ, PROJ + PLANE, PROJ + 2 * PLANE, O, cum))
    PHASE({ pg8::EpiResid E{X, X}; dense_gemm(F, O, WB + WE_WO_FOX, DM, DM, E); })
    PHASE(norm_phase<0>(F, X, nullptr, INP(14) + 2 * DM, H, 0, 0, nullptr, nullptr, nullptr))
    PHASE({ pg8::EpiSwiglu E{ACT}; dense_gemm(F, H, WB + WE_GU + (size_t)2 * FF * DM, 2 * FF, DM, E); })
    PHASE({ pg8::EpiResid E{X, X}; dense_gemm(F, ACT, WB + WE_D + (size_t)DM * FF, DM, FF, E); })
    PHASE(norm_phase<0>(F, X, nullptr, INP(13) + 3 * DM, H, 0, 0, nullptr, nullptr, nullptr))
    PHASE({ pg8::EpiPlanes E{PROJ, C2}; dense_gemm(F, H, WB + WE_QKV + (size_t)3 * DM * DM, 3 * DM, DM, E); })
    PHASE(att::causal_phase<0>((att::lptr)F.lds, F.G, PROJ, PROJ + PLANE, PROJ + 2 * PLANE, O, nullptr))
    PHASE({ pg8::EpiResid E{X, X}; dense_gemm(F, O, WB + WE_WO_SB + (size_t)DM * DM, DM, DM, E); })
    PHASE(norm_phase<4>(F, X, nullptr, INP(14) + 3 * DM, H, 0, 1, nullptr, nullptr, INP(18) + 1 * DM * NE))
    PHASE(moe_finalize(F, 1))
    PHASE(moe_gu_fast(F, 1, H, ACT))
    PHASE(moe_down_fast(F, 1, ACT, Y))
    PHASE(final_combine(F, 1))
    static_assert(__COUNTER__ - PH_BASE == N_PHASES, "N_PHASES must equal the number of PHASE() sites");
#undef PHASE
#undef IN
#undef SEAM
}

extern "C" void kernel_launch(void* const* d_in, const int* in_sizes, int n_in, void* d_out, int out_size, void* d_ws, size_t ws_size, hipStream_t stream) {
    static int grid = 0;
    if (grid == 0) {
        if (n_in != 22 || out_size != M * DM || ws_size < WS_END) { fprintf(stderr, "kernel_launch: unexpected shapes (n_in %d out %d ws %zu)\n", n_in, out_size, ws_size); grid = -1; return; }
        int dev = 0, cus = 0, per_cu = 0;
        if (hipGetDevice(&dev) != hipSuccess || hipDeviceGetAttribute(&cus, hipDeviceAttributeMultiprocessorCount, dev) != hipSuccess) { grid = -1; return; }
        if (hipFuncSetAttribute((const void*)trunk_fwd, hipFuncAttributeMaxDynamicSharedMemorySize, LDS_BYTES) != hipSuccess) { fprintf(stderr, "kernel_launch: hipFuncSetAttribute failed\n"); grid = -1; return; }
        if (hipOccupancyMaxActiveBlocksPerMultiprocessor(&per_cu, (const void*)trunk_fwd, NTHR, LDS_BYTES) != hipSuccess || per_cu < 1) fprintf(stderr, "kernel_launch: occupancy query says %d\n", per_cu);
        (void)hipGetLastError();
        grid = cus;
    }
    if (grid < 0) return;
    (void)hipMemsetAsync((char*)d_ws + WS_CTL, 0, CTL_ZERO_BYTES, stream);
    Args a{};
    for (int i = 0; i < 22; ++i) a.in[i] = (const float*)d_in[i];
    a.out = (float*)d_out; a.ws = (unsigned char*)d_ws;
#if MK_MULTI
    for (int p = 0; p < N_PHASES; ++p) { a.ph_lo = p; a.ph_hi = p + 1; hipLaunchKernelGGL(trunk_fwd, dim3(grid), dim3(NTHR), LDS_BYTES, stream, a); }
#else
    a.ph_lo = 0; a.ph_hi = N_PHASES;
    hipLaunchKernelGGL(trunk_fwd, dim3(grid), dim3(NTHR), LDS_BYTES, stream, a);
#endif
}
```

```cpp
#include <hip/hip_runtime.h>
#include <cstdio>
#include <cstdint>

#ifndef MK_MULTI
#define MK_MULTI 0
#endif

constexpr int BATCH = 8, SEQ = 2048, DM = 1024, NH = 16, HD = 64, FF = 3584, NE = 8;
constexpr int M = BATCH * SEQ;
constexpr float RMS_EPS = 1e-6f;
constexpr float LOG2E = 1.4426950408889634f;
constexpr float C2 = 0.125f * LOG2E;
constexpr int NWAVES = 8, NTHR = 512;
constexpr int LCAP = 16384;
constexpr int MAXROWS = 34816;
constexpr bool MOE_SPLITK = true;
constexpr bool MOE_FP8 = true;
constexpr float W8S = 32.0f, A8S = 4.0f;
constexpr int MOE_NSPLIT = MOE_FP8 ? 2 : 4;
constexpr int SPLIT_ROW0 = 32768, SPLIT_ROWS = MAXROWS - SPLIT_ROW0;

constexpr size_t MiB = 1u << 20;
constexpr size_t WS_CTL = 0, CTL_ZERO_BYTES = 1 * MiB;
constexpr size_t WS_MISC = 1 * MiB;
constexpr size_t WS_H = 6 * MiB;
constexpr size_t WS_R1 = 38 * MiB;
constexpr size_t WS_R2 = 278 * MiB;
constexpr size_t WS_W = 414 * MiB;
constexpr size_t WS_END = 832 * MiB;
constexpr size_t PLANE = (size_t)M * DM;
constexpr size_t WE_QKV = 0;
constexpr size_t WE_WO_SB = WE_QKV + 2ull * 3072 * 1024;
constexpr size_t WE_WO_DIL = WE_WO_SB + 2ull * 1024 * 1024;
constexpr size_t WE_WO_FOX = WE_WO_DIL + 1024ull * 1024;
constexpr size_t WE_IN_DIL = WE_WO_FOX + 1024ull * 1024;
constexpr size_t WE_IN_FOX = WE_IN_DIL + 7168ull * 1024;
constexpr size_t WE_GU = WE_IN_FOX + 3072ull * 1024;
constexpr size_t WE_D = WE_GU + 2ull * 7168 * 1024;
constexpr size_t WE_MGU = WE_D + 2ull * 1024 * 3584;
constexpr size_t WE_MD = WE_MGU + 16ull * 7168 * 1024;
constexpr size_t WE_END = WE_MD + 16ull * 1024 * 3584;
static_assert(WS_W + WE_END * 2 <= WS_END, "weight copies fit");
constexpr size_t MS_LIST = 0;
constexpr size_t MS_GW = 1 * MiB;
constexpr size_t MS_TOK = 2 * MiB;
constexpr size_t MS_LOGF = 2 * MiB + 256 * 1024;
constexpr size_t MS_CUM = 3 * MiB + 256 * 1024;
constexpr size_t MS_SEL = 4 * MiB + 256 * 1024;
constexpr size_t MS_SG = MS_SEL + 256 * 1024;
constexpr size_t MS_LC = MS_SG + 256 * 1024;
constexpr int CW_BAR = 4096;
constexpr int CW_CNT = 64;

#define GAS __attribute__((address_space(1)))
#define LAS __attribute__((address_space(3)))
typedef unsigned short bf16;
typedef unsigned v4u __attribute__((ext_vector_type(4)));
typedef unsigned v2u __attribute__((ext_vector_type(2)));
typedef float f32x4 __attribute__((ext_vector_type(4)));
typedef float f32x2 __attribute__((ext_vector_type(2)));
typedef GAS unsigned gu32;
#define RLX_AGENT __ATOMIC_RELAXED, __HIP_MEMORY_SCOPE_AGENT
__device__ __forceinline__ unsigned f2bf(float f) { unsigned u = __builtin_bit_cast(unsigned, f); return (u + 0x7fffu + ((u >> 16) & 1u)) >> 16; }
__device__ __forceinline__ unsigned pk2(float lo, float hi) { return f2bf(lo) | (f2bf(hi) << 16); }
__device__ __forceinline__ float bflo(unsigned u) { return __builtin_bit_cast(float, u << 16); }
__device__ __forceinline__ float bfhi(unsigned u) { return __builtin_bit_cast(float, u & 0xffff0000u); }

#define XB_TMO      128
#define XB_XCNT(j)  (256  + 64 * (j))
#define XB_XSUB(j)  (1280 + 64 * (j))
#define XB_XGEN(j)  (2304 + 64 * (j))
#define XB_TOP      3328
#define XB_TOPGEN   3392
#define XCD_BAR_WORDS 3456
#define XB_SPIN_CAP (1u << 22)
__device__ __forceinline__ unsigned xb_ld(unsigned* p)              { return __hip_atomic_load(p, __ATOMIC_RELAXED, __HIP_MEMORY_SCOPE_AGENT); }
__device__ __forceinline__ unsigned xb_add(unsigned* p, unsigned v) { return __hip_atomic_fetch_add(p, v, __ATOMIC_RELAXED, __HIP_MEMORY_SCOPE_AGENT); }
__device__ __forceinline__ unsigned xb_xcc_id() { return (unsigned)__builtin_amdgcn_s_getreg((3 << 11) | 20) & 0xFu; }
#define XB_SPIN(cond, bar) do { unsigned _sp = 0; while (cond) { __builtin_amdgcn_s_sleep(1); \
    if ((++_sp & 255u) == 0u) { if (xb_ld(&(bar)[XB_TMO])) break; if (_sp > XB_SPIN_CAP) { atomicAdd(&(bar)[XB_TMO], 1u); break; } } } } while (0)
struct XcdBarrier { unsigned* bar; unsigned x; volatile LAS unsigned* st; };
__device__ __forceinline__ XcdBarrier xcd_barrier_post(unsigned* bar, volatile LAS unsigned* st) {
    XcdBarrier b; b.bar = bar; b.x = xb_xcc_id(); b.st = st;
    if (threadIdx.x == 0) (void)xb_add(&bar[XB_XCNT(b.x)], 1u);
    return b;
}
__device__ __forceinline__ void xcd_barrier_complete(unsigned* bar, unsigned x, unsigned& nloc, unsigned& nx) {
    const unsigned G = gridDim.x * gridDim.y * gridDim.z;
    unsigned sum, cnt, mine, sp = 0u;
    for (;;) {
        sum = 0u; cnt = 0u; mine = 0u;
#pragma unroll
        for (unsigned j = 0; j < 16; ++j) { const unsigned c = xb_ld(&bar[XB_XCNT(j)]); sum += c; cnt += (c > 0u) ? 1u : 0u; mine = (j == x) ? c : mine; }
        if (sum == G) break;
        __builtin_amdgcn_s_sleep(1);
        if ((++sp & 255u) == 0u) { if (xb_ld(&bar[XB_TMO])) break; if (sp > XB_SPIN_CAP) { atomicAdd(&bar[XB_TMO], 1u); break; } }
    }
    nloc = mine > 0u ? mine : 1u; nx = cnt > 0u ? cnt : 1u;
}
__device__ __forceinline__ void xcd_barrier(const XcdBarrier& b) {
    asm volatile("s_waitcnt vmcnt(0)" ::: "memory");
    __syncthreads();
    if (threadIdx.x == 0) {
        unsigned* bar = b.bar;
        __builtin_amdgcn_s_waitcnt(0);
        unsigned nloc = b.st[0], nx = b.st[1];
        if (nloc == 0u) { xcd_barrier_complete(bar, b.x, nloc, nx); b.st[0] = nloc; b.st[1] = nx; }
        const unsigned old = xb_add(&bar[XB_XSUB(b.x)], 1u);
        const unsigned gen = old / nloc;
        if (old + 1u == (gen + 1u) * nloc) {
            __builtin_amdgcn_fence(__ATOMIC_RELEASE, "agent");
            asm volatile("s_waitcnt vmcnt(0)" ::: "memory");
            const unsigned og = xb_add(&bar[XB_TOP], 1u);
            const unsigned tg = og / nx;
            if (og + 1u == (tg + 1u) * nx) xb_add(&bar[XB_TOPGEN], 1u);
            else XB_SPIN(xb_ld(&bar[XB_TOPGEN]) == tg, bar);
            __builtin_amdgcn_fence(__ATOMIC_ACQUIRE, "agent");
            xb_add(&bar[XB_XGEN(b.x)], 1u);
            asm volatile("s_waitcnt vmcnt(0)" ::: "memory");
        } else {
            XB_SPIN(xb_ld(&bar[XB_XGEN(b.x)]) == gen, bar);
            __builtin_amdgcn_fence(__ATOMIC_ACQUIRE, "agent");
            asm volatile("s_waitcnt vmcnt(0)" ::: "memory");
        }
    }
    __syncthreads();
}

constexpr int LDS_BYTES = 147456;
constexpr int ATT_LDS_MAX = 143360;
constexpr int MISC_OFF = ATT_LDS_MAX + 64;
struct Frame {
    LAS unsigned char* lds;
    int tid, lane, wave, G;
    unsigned char* ws; gu32* ctl;
    float* out;
};
__device__ __forceinline__ float wave_sum(float v) {
#pragma unroll
    for (int o = 1; o < 64; o <<= 1) v += __shfl_xor(v, o);
    return v;
}

constexpr int PTR_OFF = ATT_LDS_MAX + 512;
__device__ __forceinline__ const float* inp_ptr(Frame& F, int k) {
    const LAS unsigned* t = (const LAS unsigned*)(F.lds + PTR_OFF) + 2 * k;
    const unsigned lo = __builtin_amdgcn_readfirstlane(t[0]), hi = __builtin_amdgcn_readfirstlane(t[1]);
    return (const float*)(((unsigned long long)hi << 32) | lo);
}
#define INP(k) inp_ptr(F, (k))
__device__ __forceinline__ bool relaunder(Frame& F) { int t_ = threadIdx.x; asm volatile("" : "+v"(t_)); F.tid = t_; F.lane = t_ & 63; F.wave = __builtin_amdgcn_readfirstlane(t_ >> 6); return true; }
namespace pg8 {
#define PG8_LAS __attribute__((address_space(3)))
typedef unsigned short bf16_t;
typedef short bf16x8 __attribute__((ext_vector_type(8)));
typedef unsigned u32x4 __attribute__((ext_vector_type(4)));
constexpr int BM = 256, BK = 64, HALF = 128, HTB = HALF * BK * 2, STAGE_BYTES = 8 * HTB, NXCD = 8, WGM = 8;
__host__ __device__ __forceinline__ int lds_byte(int r, int c) { const int st = (r >> 4) * 2 + (c >> 5), rr = r & 15, cc = c & 31, ob = rr * 64 + cc * 2; return st * 1024 + (ob ^ (((ob >> 9) & 1) << 5)); }
__host__ __device__ __forceinline__ void stage_rc(int b, int& R, int& C) { const int st = b / 1024, sb = b % 1024, swz = sb ^ (((sb >> 9) & 1) << 5); R = (st >> 1) * 16 + swz / 64; C = (st & 1) * 32 + (swz % 64) / 2; }
__host__ __device__ __forceinline__ int perm32(int rho) { const int n = rho >> 4, i = rho & 15; return 8 * (i >> 2) + 4 * n + (i & 3); }
struct Unit { int pm, pn, e, mt, nt, koff, kq; };

struct DenseOrder {
    int nM, nN, nwg, G, c, ntk; const char* A; const char* Bt; size_t tstep;
    __device__ __forceinline__ void init(const bf16_t* A_, const bf16_t* Bt_, int M_, int N_, int K_, int G_, int c_) { nM = M_ / BM; nN = N_ / BM; nwg = nM * nN; G = G_; c = c_; ntk = K_ / BK; A = (const char*)A_; Bt = (const char*)Bt_; tstep = (size_t)BM * K_ * 2; }
    __device__ __forceinline__ bool next(int i, Unit& u) const {
        const long L = (long)i * G + c; if (L >= nwg) return false;
        int wgid = (int)L; { const int q = nwg / NXCD, r = nwg % NXCD, xcd = wgid % NXCD, off = wgid / NXCD; wgid = (xcd < r ? xcd * (q + 1) : r * (q + 1) + (xcd - r) * q) + off; }
        const int nig = WGM * nN, gid = wgid / nig, fm = gid * WGM, gsz = (nM - fm) < WGM ? (nM - fm) : WGM;
        u.pm = fm + ((wgid % nig) % gsz); u.pn = (wgid % nig) / gsz; u.e = 0; u.mt = u.pm; u.nt = ntk; u.koff = 0; u.kq = -1; return true;
    }
    __device__ __forceinline__ const char* a_base(const Unit& u) const { return A + (size_t)u.pm * tstep; }
    __device__ __forceinline__ const char* b_base(const Unit& u) const { return Bt + (size_t)u.pn * tstep; }
    __device__ __forceinline__ void a_voff(const Unit&, const int (&)[2], const int (&)[2], unsigned (&)[2][2]) const {}
};
struct MoeOrder {
    int t1, t2, t3, t4, t5, t6, t7, t8, nN, G, c, K; const char* A; const char* Bt; size_t tstepA, tstepB, estepB; const int* list; bool gather; int splitk;
    __device__ __forceinline__ bool next(int i, Unit& u) const {
        const int X = i * G + c, U = t8 * nN; int L = X; u.nt = K / BK; u.koff = 0; u.kq = -1;
        if (splitk) { const int nfull = (U / G) * G;
            if (X >= nfull) { const int q = X - nfull; if (q >= splitk * (U - nfull)) return false; L = nfull + q / splitk; u.kq = q % splitk; u.nt = K / BK / splitk; u.koff = u.kq * (K / splitk) * 2; } }
        else if (X >= U) return false;
        const int mt = L / nN; u.pm = mt; u.pn = L - mt * nN;
        const int e = (mt >= t1) + (mt >= t2) + (mt >= t3) + (mt >= t4) + (mt >= t5) + (mt >= t6) + (mt >= t7);
        const int tb = e == 0 ? 0 : e == 1 ? t1 : e == 2 ? t2 : e == 3 ? t3 : e == 4 ? t4 : e == 5 ? t5 : e == 6 ? t6 : t7;
        u.e = e; u.mt = mt - tb; return true;
    }
    __device__ __forceinline__ const char* a_base(const Unit& u) const { return (gather ? A : A + (size_t)u.pm * tstepA) + u.koff; }
    __device__ __forceinline__ const char* b_base(const Unit& u) const { return Bt + (size_t)u.e * estepB + (size_t)u.pn * tstepB + u.koff; }
    __device__ __forceinline__ void a_voff(const Unit& u, const int (&sR)[2], const int (&sC)[2], unsigned (&v)[2][2]) const {
        const int* lp = list + u.e * LCAP + u.mt * 256;
#pragma unroll
        for (int h = 0; h < 2; ++h)
#pragma unroll
            for (int i = 0; i < 2; ++i) v[h][i] = (unsigned)lp[h * 128 + sR[i]] * (unsigned)(K * 2) + (unsigned)(sC[i] * 2);
    }
};

typedef int v8i32 __attribute__((ext_vector_type(8)));
typedef int v4i32 __attribute__((ext_vector_type(4)));
__device__ __forceinline__ v8i32 cat8(bf16x8 a, bf16x8 b) { const v4i32 x = __builtin_bit_cast(v4i32, a), y = __builtin_bit_cast(v4i32, b); return (v8i32){x[0], x[1], x[2], x[3], y[0], y[1], y[2], y[3]}; }
__device__ __forceinline__ unsigned cvt4_fp8(float a, float b, float c, float d) { int w = 0; w = __builtin_amdgcn_cvt_pk_fp8_f32(a, b, w, false); w = __builtin_amdgcn_cvt_pk_fp8_f32(c, d, w, true); return (unsigned)w; }
__device__ __forceinline__ const char* uniptr(const char* p) { const unsigned long long v = (unsigned long long)p; const unsigned lo = __builtin_amdgcn_readfirstlane((unsigned)v), hi = __builtin_amdgcn_readfirstlane((unsigned)(v >> 32)); return (const char*)(((unsigned long long)hi << 32) | lo); }
__device__ __forceinline__ void glds16_s(const char* sbase, unsigned voff, unsigned lds_dst) { unsigned keep;
    asm volatile("s_mov_b32 %0, m0\n\ts_mov_b32 m0, %3\n\ts_nop 0\n\tglobal_load_lds_dwordx4 %2, %1\n\ts_mov_b32 m0, %0" : "=&s"(keep) : "s"(sbase), "v"(voff), "s"(lds_dst) : "memory"); }
__device__ __forceinline__ unsigned cvt_pk_bf16(float lo, float hi) { unsigned r; asm volatile("v_cvt_pk_bf16_f32 %0, %1, %2" : "=v"(r) : "v"(lo), "v"(hi)); return r; }

struct EpiPlanes {
    static constexpr bool PERM = true;
    bf16_t* O; float scale0;
    __device__ __forceinline__ void operator()(const f32x4 (&acc)[2][2][4][2], const Unit& u, int wr, int wc, int fr, int fq) const {
        const int plane = u.pn >> 2; const float sc = plane == 0 ? scale0 : 1.f;
        bf16_t* base = O + (size_t)plane * PLANE + (size_t)(u.pm * BM + wr * 64 + fr) * DM + (u.pn & 3) * 256 + wc * 32 + 8 * fq;
#pragma unroll
        for (int ai = 0; ai < 2; ++ai)
#pragma unroll
            for (int m = 0; m < 4; ++m) { bf16_t* rowp = base + (size_t)(ai * HALF + m * 16) * DM;
#pragma unroll
                for (int bj = 0; bj < 2; ++bj) { const f32x4 v0 = acc[ai][bj][m][0] * sc, v1 = acc[ai][bj][m][1] * sc;
                    u32x4 w; w.x = cvt_pk_bf16(v0[0], v0[1]); w.y = cvt_pk_bf16(v0[2], v0[3]); w.z = cvt_pk_bf16(v1[0], v1[1]); w.w = cvt_pk_bf16(v1[2], v1[3]);
                    *(u32x4*)(rowp + bj * HALF) = w; } }
    }
};
struct EpiQKNorm {
    static constexpr bool PERM = true;
    bf16_t* O; const float* qg; const float* kg; int vplane;
    __device__ __forceinline__ void operator()(const f32x4 (&acc)[2][2][4][2], const Unit& u, int wr, int wc, int fr, int fq) const {
        const int plane = u.pn >> 2; const bool isv = plane == vplane; const bool isq = !isv && ((plane & 1) == 0); const int grp = plane >> 1;
        const float* g = (isq ? qg : kg) + grp * 64 + 8 * fq;
        f32x4 gv[2][2];
#pragma unroll
        for (int bj = 0; bj < 2; ++bj)
#pragma unroll
            for (int n = 0; n < 2; ++n) gv[bj][n] = isv ? (f32x4){1.f, 1.f, 1.f, 1.f} : *(const f32x4*)(g + 32 * bj + 4 * n);
        const float mul = isq ? C2 : 1.f;
        bf16_t* base = O + (size_t)plane * PLANE + (size_t)(u.pm * BM + wr * 64 + fr) * DM + (u.pn & 3) * 256 + wc * 64 + 8 * fq;
#pragma unroll
        for (int ai = 0; ai < 2; ++ai)
#pragma unroll
            for (int m = 0; m < 4; ++m) { bf16_t* rowp = base + (size_t)(ai * HALF + m * 16) * DM;
                float ss = 0.f;
#pragma unroll
                for (int bj = 0; bj < 2; ++bj)
#pragma unroll
                    for (int n = 0; n < 2; ++n) { const f32x4 x = acc[ai][bj][m][n]; ss += (x[0] * x[0] + x[1] * x[1]) + (x[2] * x[2] + x[3] * x[3]); }
                ss += __shfl_xor(ss, 16); ss += __shfl_xor(ss, 32);
                const float inv = isv ? 1.f : mul / sqrtf(ss * (1.f / 64.f) + RMS_EPS);
#pragma unroll
                for (int bj = 0; bj < 2; ++bj) { const f32x4 v0 = acc[ai][bj][m][0] * inv * gv[bj][0], v1 = acc[ai][bj][m][1] * inv * gv[bj][1];
                    u32x4 w; w.x = cvt_pk_bf16(v0[0], v0[1]); w.y = cvt_pk_bf16(v0[2], v0[3]); w.z = cvt_pk_bf16(v1[0], v1[1]); w.w = cvt_pk_bf16(v1[2], v1[3]);
                    *(u32x4*)(rowp + bj * 32) = w; } }
    }
};
struct EpiSwiglu {
    static constexpr bool PERM = true;
    bf16_t* O;
    __device__ __forceinline__ void operator()(const f32x4 (&acc)[2][2][4][2], const Unit& u, int wr, int wc, int fr, int fq) const {
        bf16_t* base = O + (size_t)(u.pm * BM + wr * 64 + fr) * FF + u.pn * 128 + wc * 32 + 8 * fq;
#pragma unroll
        for (int ai = 0; ai < 2; ++ai)
#pragma unroll
            for (int m = 0; m < 4; ++m) { bf16_t* rowp = base + (size_t)(ai * HALF + m * 16) * FF;
                float o[8];
#pragma unroll
                for (int n = 0; n < 2; ++n)
#pragma unroll
                    for (int i = 0; i < 4; ++i) { const float g = acc[ai][0][m][n][i], uu = acc[ai][1][m][n][i];
                        o[n * 4 + i] = g * __builtin_amdgcn_rcpf(1.0f + __builtin_amdgcn_exp2f(-g * LOG2E)) * uu; }
                u32x4 w; w.x = cvt_pk_bf16(o[0], o[1]); w.y = cvt_pk_bf16(o[2], o[3]); w.z = cvt_pk_bf16(o[4], o[5]); w.w = cvt_pk_bf16(o[6], o[7]);
                *(u32x4*)rowp = w; }
    }
};
struct EpiSwigluF8 {
    static constexpr bool PERM = true;
    unsigned char* O;
    __device__ __forceinline__ void operator()(const f32x4 (&acc)[2][2][4][2], const Unit& u, int wr, int wc, int fr, int fq) const {
        unsigned char* base = O + (size_t)(u.pm * BM + wr * 64 + fr) * FF + u.pn * 128 + wc * 32 + 8 * fq;
#pragma unroll
        for (int ai = 0; ai < 2; ++ai)
#pragma unroll
            for (int m = 0; m < 4; ++m) { unsigned char* rowp = base + (size_t)(ai * HALF + m * 16) * FF;
                float o[8];
#pragma unroll
                for (int n = 0; n < 2; ++n)
#pragma unroll
                    for (int i = 0; i < 4; ++i) { const float g = acc[ai][0][m][n][i] * (1.0f / W8S), uu = acc[ai][1][m][n][i] * (A8S / W8S);
                        o[n * 4 + i] = g * __builtin_amdgcn_rcpf(1.0f + __builtin_amdgcn_exp2f(-g * LOG2E)) * uu; }
                v2u w; w.x = cvt4_fp8(o[0], o[1], o[2], o[3]); w.y = cvt4_fp8(o[4], o[5], o[6], o[7]);
                *(v2u*)rowp = w; }
    }
};
struct EpiResid {
    static constexpr bool PERM = false;
    const float* base; float* out;
    __device__ __forceinline__ void operator()(const f32x4 (&acc)[2][2][4][2], const Unit& u, int wr, int wc, int fr, int fq) const {
        const size_t off0 = (size_t)(u.pm * BM + wr * 64 + fr) * DM + u.pn * BM + wc * 32 + 4 * fq;
#pragma unroll
        for (int ai = 0; ai < 2; ++ai)
#pragma unroll
            for (int m = 0; m < 4; ++m) { const size_t off = off0 + (size_t)(ai * HALF + m * 16) * DM;
#pragma unroll
                for (int bj = 0; bj < 2; ++bj)
#pragma unroll
                    for (int n = 0; n < 2; ++n) { const f32x4 b = *(const f32x4*)(base + off + bj * HALF + n * 16); *(f32x4*)(out + off + bj * HALF + n * 16) = b + acc[ai][bj][m][n]; } }
    }
};
struct EpiMoeDown {
    static constexpr bool PERM = true;
    bf16_t* Y; const float* gw; bf16_t* P; float oscale;
    __device__ __forceinline__ void operator()(const f32x4 (&acc)[2][2][4][2], const Unit& u, int wr, int wc, int fr, int fq) const {
        bf16_t* base = (u.kq < 0 ? Y + (size_t)(u.pm * BM) * DM : P + ((size_t)u.kq * SPLIT_ROWS + (size_t)(u.pm * BM - SPLIT_ROW0)) * DM) + (size_t)(wr * 64 + fr) * DM + u.pn * BM + wc * 32 + 8 * fq;
        const float* gp = gw + u.e * LCAP + u.mt * 256 + wr * 64 + fr;
#pragma unroll
        for (int ai = 0; ai < 2; ++ai)
#pragma unroll
            for (int m = 0; m < 4; ++m) { bf16_t* rowp = base + (size_t)(ai * HALF + m * 16) * DM; const float g = gp[ai * HALF + m * 16] * oscale;
#pragma unroll
                for (int bj = 0; bj < 2; ++bj) { const f32x4 v0 = acc[ai][bj][m][0] * g, v1 = acc[ai][bj][m][1] * g;
                    u32x4 w; w.x = cvt_pk_bf16(v0[0], v0[1]); w.y = cvt_pk_bf16(v0[2], v0[3]); w.z = cvt_pk_bf16(v1[0], v1[1]); w.w = cvt_pk_bf16(v1[2], v1[3]);
                    *(u32x4*)(rowp + bj * HALF) = w; } }
    }
};

template <class Epi, class Sched, bool GATHER, bool FP8 = false>
__device__ __forceinline__ void gemm_phase(PG8_LAS unsigned char* lds, const int K, const Sched& S, const Epi& E) {
    const int tid = threadIdx.x, wid = __builtin_amdgcn_readfirstlane(tid >> 6), lane = tid & 63, wr = wid >> 2, wc = wid & 3, fr = lane & 15, fq = lane >> 4;
    unsigned voffA[2], voffB[2]; int sR[2], sC[2];
#pragma unroll
    for (int i = 0; i < 2; ++i) { int R, C; stage_rc(tid * 16 + i * 8192, R, C); const int Rb = Epi::PERM ? ((R & ~31) + perm32(R & 31)) : R;
        voffA[i] = (unsigned)(R * K + C) * 2u; voffB[i] = (unsigned)(Rb * K + C) * 2u; sR[i] = R; sC[i] = C; }
    const size_t kstep = (size_t)(BK * 2);
    const size_t hstep = (size_t)HALF * K * 2;
    const unsigned ldsw = (unsigned)wid * 1024u, lds0 = (unsigned)(uintptr_t)lds;
    const int aoff = FP8 ? lds_byte(wr * 64 + fr, fq * 16) : lds_byte(wr * 64 + fr, fq * 8), boff = FP8 ? lds_byte(wc * 32 + fr, fq * 16) : lds_byte(wc * 32 + fr, fq * 8);

#define PG8_SA(b, h) (((b) * 2 + (h)) * HTB)
#define PG8_SB(b, h) ((4 + (b) * 2 + (h)) * HTB)
#define PG8_STAGE(bufoff, gbase, voff) do { const char* gb_ = uniptr((const char*)(gbase)); _Pragma("unroll") for (int _i = 0; _i < 2; ++_i) \
        glds16_s(gb_, (voff)[_i], (unsigned)__builtin_amdgcn_readfirstlane(lds0 + (unsigned)(bufoff) + ldsw + (unsigned)(_i * 8192))); } while (0)
#define PG8_STAGE_A(bufoff, p, h, VG) do { if (GATHER) { PG8_STAGE(bufoff, p, VG[h]); } else { PG8_STAGE(bufoff, (p) + ((h) ? hstep : 0), voffA); } } while (0)
#define PG8_LDA(dst, b, h) do { _Pragma("unroll") for (int m = 0; m < 4; ++m) { if constexpr (FP8) { const v4i32 x_ = *(const PG8_LAS v4i32*)(lds + PG8_SA(b, h) + aoff + m * 2048), y_ = *(const PG8_LAS v4i32*)(lds + PG8_SA(b, h) + aoff + m * 2048 + 16); dst##8[m] = __builtin_shufflevector(x_, y_, 0, 1, 2, 3, 4, 5, 6, 7); } \
        else { _Pragma("unroll") for (int k = 0; k < 2; ++k) dst[m][k] = *(const PG8_LAS bf16x8*)(lds + PG8_SA(b, h) + aoff + m * 2048 + k * 1024); } } } while (0)
#define PG8_LDB(dst, b, h) do { _Pragma("unroll") for (int n = 0; n < 2; ++n) { if constexpr (FP8) { const v4i32 x_ = *(const PG8_LAS v4i32*)(lds + PG8_SB(b, h) + boff + n * 2048), y_ = *(const PG8_LAS v4i32*)(lds + PG8_SB(b, h) + boff + n * 2048 + 16); dst##8[n] = __builtin_shufflevector(x_, y_, 0, 1, 2, 3, 4, 5, 6, 7); } \
        else { _Pragma("unroll") for (int k = 0; k < 2; ++k) dst[n][k] = *(const PG8_LAS bf16x8*)(lds + PG8_SB(b, h) + boff + n * 2048 + k * 1024); } } } while (0)
#define PG8_MMA(ai, bj, At, Bt) do { __builtin_amdgcn_s_setprio(1); _Pragma("unroll") for (int m = 0; m < 4; ++m) _Pragma("unroll") for (int n = 0; n < 2; ++n) { \
        if constexpr (FP8) asm volatile("v_mfma_scale_f32_16x16x128_f8f6f4 %0, %1, %2, %0, %3, %3 op_sel_hi:[0,0,0]" : "+v"(acc[ai][bj][m][n]) : "v"(Bt##8[n]), "v"(At##8[m]), "v"(sc8));   \
        else { _Pragma("unroll") for (int k = 0; k < 2; ++k) acc[ai][bj][m][n] = __builtin_amdgcn_mfma_f32_16x16x32_bf16(Bt[n][k], At[m][k], acc[ai][bj][m][n], 0, 0, 0); } } \
        __builtin_amdgcn_s_setprio(0); } while (0)
#define PG8_WAIT_V(n) asm volatile("s_waitcnt vmcnt(" #n ")" ::: "memory")
#define PG8_WAIT_L(n) asm volatile("s_waitcnt lgkmcnt(" #n ")" ::: "memory")
#define PG8_BAR __builtin_amdgcn_s_barrier()
#define PG8_SCHED __builtin_amdgcn_sched_barrier(0)
    Unit cur, nxt; int ui = 0;
    if (!S.next(0, cur)) return;
    f32x4 acc[2][2][4][2];
#pragma unroll
    for (int a = 0; a < 2; ++a)
#pragma unroll
        for (int b = 0; b < 2; ++b)
#pragma unroll
            for (int m = 0; m < 4; ++m)
#pragma unroll
                for (int n = 0; n < 2; ++n) acc[a][b][m][n] = (f32x4){0.f, 0.f, 0.f, 0.f};
    bf16x8 At[4][2], B0[2][2], B1[2][2];
    v8i32 At8[4], B08[2], B18[2];
    int sc8 = 0x7F7F7F7F; asm volatile("" : "+v"(sc8));
    const char* cA = S.a_base(cur); const char* cB = S.b_base(cur);
    unsigned vc[2][2] = {{0u, 0u}, {0u, 0u}}, vn[2][2] = {{0u, 0u}, {0u, 0u}};
    if (GATHER) { S.a_voff(cur, sR, sC, vc); asm volatile("s_waitcnt vmcnt(0)" : "+v"(vc[0][0]), "+v"(vc[0][1]), "+v"(vc[1][0]), "+v"(vc[1][1]) :: "memory"); }
    PG8_STAGE(PG8_SB(0, 0), cB, voffB); PG8_STAGE(PG8_SB(0, 1), cB + hstep, voffB); PG8_STAGE_A(PG8_SA(0, 0), cA, 0, vc); PG8_STAGE_A(PG8_SA(0, 1), cA, 1, vc);
    if (wr == 1) PG8_BAR;
    PG8_WAIT_V(2); PG8_BAR;
    PG8_STAGE(PG8_SB(1, 0), cB + kstep, voffB); PG8_STAGE_A(PG8_SA(1, 0), cA + kstep, 0, vc); PG8_STAGE(PG8_SB(1, 1), cB + hstep + kstep, voffB);
    PG8_WAIT_V(6); PG8_BAR;
    for (;;) {
        const bool has_next = S.next(ui + 1, nxt);
        const char* nA = has_next ? S.a_base(nxt) : cA; const char* nB = has_next ? S.b_base(nxt) : cB;
        if (GATHER) {
            if (has_next) { S.a_voff(nxt, sR, sC, vn); asm volatile("s_waitcnt vmcnt(0)" : "+v"(vn[0][0]), "+v"(vn[0][1]), "+v"(vn[1][0]), "+v"(vn[1][1]) :: "memory"); }
            else { vn[0][0] = vc[0][0]; vn[0][1] = vc[0][1]; vn[1][0] = vc[1][0]; vn[1][1] = vc[1][1]; }
        }
        const int nt = cur.nt;
        for (int t = 0; t < nt; t += 2) {
            const bool last = (t == nt - 2);
            const char* a1 = cA + (size_t)(t + 1) * kstep;
            const char* a2 = last ? nA : cA + (size_t)(t + 2) * kstep; const char* b2 = last ? nB : cB + (size_t)(t + 2) * kstep;
            const char* a3 = a2 + kstep; const char* b3 = b2 + kstep;
            unsigned v2[2][2];
#pragma unroll
            for (int h = 0; h < 2; ++h)
#pragma unroll
                for (int i = 0; i < 2; ++i) v2[h][i] = last ? vn[h][i] : vc[h][i];
            PG8_LDB(B0, 0, 0); PG8_LDB(B1, 0, 1); PG8_SCHED; PG8_LDA(At, 0, 0); PG8_STAGE_A(PG8_SA(1, 1), a1, 1, vc);
            PG8_WAIT_V(8); PG8_WAIT_L(0); PG8_BAR; PG8_MMA(0, 0, At, B0); PG8_MMA(0, 1, At, B1); PG8_BAR; PG8_SCHED;
            PG8_LDA(At, 0, 1); PG8_STAGE(PG8_SB(0, 0), b2, voffB); PG8_STAGE(PG8_SB(0, 1), b2 + hstep, voffB); PG8_STAGE_A(PG8_SA(0, 0), a2, 0, v2);
            PG8_WAIT_V(8); PG8_WAIT_L(0); PG8_BAR; PG8_MMA(1, 0, At, B0); PG8_MMA(1, 1, At, B1); PG8_BAR; PG8_SCHED;
            PG8_LDB(B0, 1, 0); PG8_LDB(B1, 1, 1); PG8_SCHED; PG8_LDA(At, 1, 0); PG8_STAGE_A(PG8_SA(0, 1), a2, 1, v2);
            PG8_WAIT_V(8); PG8_WAIT_L(0); PG8_BAR; PG8_MMA(0, 0, At, B0); PG8_MMA(0, 1, At, B1); PG8_BAR; PG8_SCHED;
            PG8_LDA(At, 1, 1); PG8_STAGE(PG8_SB(1, 0), b3, voffB); PG8_STAGE(PG8_SB(1, 1), b3 + hstep, voffB); PG8_STAGE_A(PG8_SA(1, 0), a3, 0, v2);
            PG8_WAIT_V(8); PG8_WAIT_L(0); PG8_BAR; PG8_MMA(1, 0, At, B0); PG8_MMA(1, 1, At, B1); PG8_BAR; PG8_SCHED;
        }
        if (wr == 0) PG8_BAR;
        if constexpr (FP8) asm volatile("s_nop 15\n\ts_nop 15" ::: "memory");
        { int fr_ = fr, fq_ = fq; asm volatile("" : "+v"(fr_), "+v"(fq_)); E(acc, cur, wr, wc, fr_, fq_); }
        if (!has_next) break;
#pragma unroll
        for (int a = 0; a < 2; ++a)
#pragma unroll
            for (int b = 0; b < 2; ++b)
#pragma unroll
                for (int m = 0; m < 4; ++m)
#pragma unroll
                    for (int n = 0; n < 2; ++n) acc[a][b][m][n] = (f32x4){0.f, 0.f, 0.f, 0.f};
        cur = nxt; cA = nA; cB = nB; ++ui;
        if (GATHER) { vc[0][0] = vn[0][0]; vc[0][1] = vn[0][1]; vc[1][0] = vn[1][0]; vc[1][1] = vn[1][1]; }
        if (wr == 1) PG8_BAR;
    }
    PG8_WAIT_V(0);
    PG8_BAR;
#undef PG8_SA
#undef PG8_SB
#undef PG8_STAGE
#undef PG8_STAGE_A
#undef PG8_LDA
#undef PG8_LDB
#undef PG8_MMA
#undef PG8_WAIT_V
#undef PG8_WAIT_L
#undef PG8_BAR
#undef PG8_SCHED
}
}

namespace att {
typedef short bf16x8 __attribute__((ext_vector_type(8)));
typedef short s16x4 __attribute__((ext_vector_type(4)));
typedef float f32x16 __attribute__((ext_vector_type(16)));
typedef unsigned u32x4 __attribute__((ext_vector_type(4)));
typedef LAS char* lptr;
constexpr int SLOTB = 8192, NSLOT = 6, AHEAD = 4;
constexpr int L_K = 0, L_V = NSLOT * SLOTB, L_WS = 2 * NSLOT * SLOTB, L_OST = L_WS + 8 * 256, L_KB = L_OST + 8 * 4096, L_FLG = L_KB + 8192, L_END = L_FLG + 256;
static_assert(L_END <= ATT_LDS_MAX, "attention LDS map");
constexpr float THR = 8.0f;
__device__ __forceinline__ int crow(int r, int hi) { return (r & 3) + 8 * (r >> 2) + 4 * hi; }
__device__ __forceinline__ void glds16(const void* gsrc, unsigned lds_dst) { unsigned keep;
    asm volatile("s_mov_b32 %0, m0\n\ts_mov_b32 m0, %2\n\ts_nop 0\n\tglobal_load_lds_dwordx4 %1, off\n\ts_mov_b32 m0, %0" : "=&s"(keep) : "v"(gsrc), "s"(lds_dst) : "memory"); }
typedef float f32x2_t __attribute__((ext_vector_type(2))); typedef __bf16 bf16x2_t __attribute__((ext_vector_type(2)));
__device__ __forceinline__ unsigned cvtpk(float lo, float hi) { f32x2_t v = {lo, hi}; bf16x2_t b = __builtin_convertvector(v, bf16x2_t); return __builtin_bit_cast(unsigned, b); }
__device__ __forceinline__ bf16x8 gload16(const void* p) { bf16x8 v; asm volatile("global_load_dwordx4 %0, %1, off" : "=v"(v) : "v"(p) : "memory"); return v; }
__device__ __forceinline__ float max3f(float a, float b, float c) { return __builtin_fmaxf(__builtin_fmaxf(a, b), c); }
__device__ __forceinline__ void wait_bar(int n) {
    if (n >= 6) asm volatile("s_waitcnt vmcnt(6) lgkmcnt(0)\n\ts_barrier" ::: "memory");
    else if (n >= 4) asm volatile("s_waitcnt vmcnt(4) lgkmcnt(0)\n\ts_barrier" ::: "memory");
    else if (n >= 2) asm volatile("s_waitcnt vmcnt(2) lgkmcnt(0)\n\ts_barrier" ::: "memory");
    else asm volatile("s_waitcnt vmcnt(0) lgkmcnt(0)\n\ts_barrier" ::: "memory");
}
__device__ __forceinline__ float other_half(float x, int hi) {
    auto rr = __builtin_amdgcn_permlane32_swap(__float_as_uint(x), __float_as_uint(x), false, false);
    return __uint_as_float(hi ? rr[0] : rr[1]);
}
__device__ __forceinline__ void qkt(f32x16& p0, f32x16& p1, lptr Kslot, const bf16x8* qr, const f32x16& c0, const f32x16& c1, int r32, int hi) {
    lptr kb = Kslot + hi * 1024 + r32 * 16;
#pragma unroll
    for (int d0 = 0; d0 < 4; ++d0) {
        const bf16x8 b0 = *(const LAS bf16x8*)(kb + d0 * 2048);
        const bf16x8 b1 = *(const LAS bf16x8*)(kb + d0 * 2048 + 512);
        if (d0 == 0) { p0 = __builtin_amdgcn_mfma_f32_32x32x16_bf16(b0, qr[0], c0, 0, 0, 0); p1 = __builtin_amdgcn_mfma_f32_32x32x16_bf16(b1, qr[0], c1, 0, 0, 0); }
        else { p0 = __builtin_amdgcn_mfma_f32_32x32x16_bf16(b0, qr[d0], p0, 0, 0, 0); p1 = __builtin_amdgcn_mfma_f32_32x32x16_bf16(b1, qr[d0], p1, 0, 0, 0); } }
}
__device__ __forceinline__ void pv(f32x16* o, int vb, bf16x8 pa0, bf16x8 pa1, bf16x8 pa2, bf16x8 pa3) {
#pragma unroll
    for (int d0 = 0; d0 < 2; ++d0) { s16x4 lo[4], hi[4];
#pragma unroll
        for (int ks = 0; ks < 4; ++ks) {
            asm volatile("ds_read_b64_tr_b16 %0,%1 offset:%c2" : "=&v"(lo[ks]) : "v"(vb), "i"(d0 * 4096 + ks * 1024) : "memory");
            asm volatile("ds_read_b64_tr_b16 %0,%1 offset:%c2" : "=&v"(hi[ks]) : "v"(vb), "i"(d0 * 4096 + ks * 1024 + 512) : "memory"); }
        asm volatile("s_waitcnt lgkmcnt(0)" ::: "memory"); __builtin_amdgcn_sched_barrier(0);
#define ATT_PK(k) (bf16x8){lo[k][0], lo[k][1], lo[k][2], lo[k][3], hi[k][0], hi[k][1], hi[k][2], hi[k][3]}
        o[d0] = __builtin_amdgcn_mfma_f32_32x32x16_bf16(pa0, ATT_PK(0), o[d0], 0, 0, 0);
        o[d0] = __builtin_amdgcn_mfma_f32_32x32x16_bf16(pa1, ATT_PK(1), o[d0], 0, 0, 0);
        o[d0] = __builtin_amdgcn_mfma_f32_32x32x16_bf16(pa2, ATT_PK(2), o[d0], 0, 0, 0);
        o[d0] = __builtin_amdgcn_mfma_f32_32x32x16_bf16(pa3, ATT_PK(3), o[d0], 0, 0, 0);
#undef ATT_PK
    }
}
__device__ __forceinline__ void pack_pv(f32x16* o, int vb, const f32x16& p0, const f32x16& p1) {
    u32x4 w0, w1, w2, w3;
#pragma unroll
    for (int j = 0; j < 4; ++j) { w0[j] = cvtpk(p0[2 * j], p0[2 * j + 1]); w1[j] = cvtpk(p0[8 + 2 * j], p0[8 + 2 * j + 1]); w2[j] = cvtpk(p1[2 * j], p1[2 * j + 1]); w3[j] = cvtpk(p1[8 + 2 * j], p1[8 + 2 * j + 1]); }
    pv(o, vb, __builtin_bit_cast(bf16x8, w0), __builtin_bit_cast(bf16x8, w1), __builtin_bit_cast(bf16x8, w2), __builtin_bit_cast(bf16x8, w3));
}
__device__ __forceinline__ float rowmax32(const f32x16& p0, const f32x16& p1, int hi) {
    float a = max3f(p0[0], p0[1], p1[0]), b = max3f(p0[2], p0[3], p1[1]); a = max3f(a, p1[2], p1[3]);
#pragma unroll
    for (int r = 4; r < 16; r += 4) { a = max3f(a, p0[r], p0[r + 1]); b = max3f(b, p0[r + 2], p0[r + 3]); a = max3f(a, p1[r], p1[r + 1]); b = max3f(b, p1[r + 2], p1[r + 3]); }
    a = fmaxf(a, b);
    return fmaxf(a, other_half(a, hi));
}
__device__ __forceinline__ void store_o(const f32x16* o, const float* sc, lptr stgb, bf16* Ow, long rpitch, int lane, int r32, int hi) {
    LAS bf16* stg = (LAS bf16*)stgb;
#pragma unroll
    for (int r = 0; r < 16; ++r) { const int orow = crow(r, hi);
#pragma unroll
        for (int d0 = 0; d0 < 2; ++d0) stg[orow * 64 + d0 * 32 + r32] = (bf16)f2bf(o[d0][r] * sc[r]); }
    asm volatile("s_waitcnt lgkmcnt(0)" ::: "memory");
#pragma unroll
    for (int i = 0; i < 4; ++i) { const int row = i * 8 + (lane >> 3), ch = lane & 7; const u32x4 v = *(const LAS u32x4*)(stg + row * 64 + ch * 8); *(u32x4*)(Ow + (long)row * rpitch + ch * 8) = v; }
}
__device__ __forceinline__ void softmax_step(f32x16& p0, f32x16& p1, float& mref, float& lsum, f32x16* o, LAS float* wsf, int r32, int hi) {
    const float rm = rowmax32(p0, p1, hi);
    const bool fresh = mref <= -1e30f;
    const bool want = !fresh && (rm > mref + THR);
    if (fresh) mref = fmaxf(rm, -1e30f);
    if (__any(want)) {
        const float dl = want ? rm - mref : 0.f; mref += dl; const float f = __builtin_amdgcn_exp2f(-dl); lsum *= f;
        if (hi == 0) wsf[r32] = f;
        asm volatile("s_waitcnt lgkmcnt(0)" ::: "memory");
#pragma unroll
        for (int r = 0; r < 16; ++r) { const float fr = wsf[crow(r, hi)]; o[0][r] *= fr; o[1][r] *= fr; }
    }
    float sa = 0.f, sb = 0.f;
#pragma unroll
    for (int r = 0; r < 16; ++r) { p0[r] = __builtin_amdgcn_exp2f(p0[r] - mref); p1[r] = __builtin_amdgcn_exp2f(p1[r] - mref); sa += p0[r]; sb += p1[r]; }
    lsum += sa + sb;
}

struct WaveCtx { int lane, r32, hi, wid; unsigned lds0; int vb0; lptr shm; };
struct UnitD { int NT; int b, h, qb, g, x; };

template <int MODE> struct CausalMode {
    const bf16* Q; const bf16* K; const bf16* V; bf16* O; int b, h, p;
    float carry, mref, lsum; int done;
    __device__ __forceinline__ int units() const { return 4; }
    __device__ __forceinline__ void desc(int j, UnitD& d) const { d.b = b; d.h = h; d.qb = (j == 0) ? 7 - p : (j == 1) ? 5 - p : (j == 2) ? 2 + p : p; d.NT = 4 * (d.qb + 1); d.g = 0; d.x = 0; }
    __device__ __forceinline__ int tile_of(const UnitD& d, int k) const { return MODE == 0 ? d.NT - 1 - k : k; }
    __device__ __forceinline__ void q_load(const UnitD& d, const WaveCtx& w, bf16x8 (&q)[4]) const {
        const bf16* Qw = Q + ((long)d.b * SEQ + d.qb * 256 + w.wid * 32 + w.r32) * DM + d.h * 64 + w.hi * 8;
#pragma unroll
        for (int d0 = 0; d0 < 4; ++d0) q[d0] = gload16(Qw + d0 * 16);
    }
    __device__ __forceinline__ void dma(const UnitD& d, int k, int slot, const WaveCtx& w) const {
        const long row0 = (long)d.b * SEQ + 64 * tile_of(d, k);
        glds16(K + (row0 + w.lane) * DM + d.h * 64 + w.wid * 8, (unsigned)__builtin_amdgcn_readfirstlane(w.lds0 + L_K + slot * SLOTB + w.wid * 1024));
        glds16(V + (row0 + 16 * (w.wid & 3) + (w.lane >> 2)) * DM + d.h * 64 + (w.wid >> 2) * 32 + (w.lane & 3) * 8, (unsigned)__builtin_amdgcn_readfirstlane(w.lds0 + L_V + slot * SLOTB + w.wid * 1024));
    }
    __device__ __forceinline__ void begin(const UnitD&, const WaveCtx&) { carry = 1.0f; mref = -1e30f; lsum = 0.f; done = 0; }
    __device__ __forceinline__ int wave_done() const { return done; }
    __device__ __forceinline__ void compute(const UnitD& d, int k, int slot, const WaveCtx& w, const bf16x8* qr, f32x16* o) {
        const int T = tile_of(d, k), qfirst = d.qb * 256 + w.wid * 32, qpos = qfirst + w.r32;
        if (MODE == 0) {
            if (done || 64 * T >= qfirst + 31) return;
            f32x16 p0, p1; const f32x16 z = {}; qkt(p0, p1, w.shm + L_K + slot * SLOTB, qr, z, z, w.r32, w.hi);
            const bool diag = 64 * T + 63 >= qfirst;
            float ga[8];
#pragma unroll
            for (int a = 0; a < 8; ++a) {
                float rr[4];
#pragma unroll
                for (int i = 0; i < 4; ++i) { const int r = 4 * (a & 3) + i; const float zz = (a < 4) ? p0[r] : p1[r];
                    const float e = __builtin_amdgcn_exp2f(fminf(zz, 120.f)); float rv = __builtin_amdgcn_rcpf(1.0f + e);
                    if (diag) { const int kv = 64 * T + crow(r, w.hi) + ((a < 4) ? 0 : 32); if (kv >= qpos) rv = 1.0f; }
                    rr[i] = rv; if (a < 4) p0[r] = rv; else p1[r] = rv; }
                ga[a] = (rr[0] * rr[1]) * (rr[2] * rr[3]);
            }
            float oth[8], Ts[8];
#pragma unroll
            for (int a = 0; a < 8; ++a) oth[a] = other_half(ga[a], w.hi);
            float run = 1.0f;
#pragma unroll
            for (int a = 7; a >= 0; --a) { Ts[a] = run; run *= ga[a] * oth[a]; }
#pragma unroll
            for (int a = 0; a < 8; ++a) {
                float E = carry * Ts[a] * (w.hi ? 1.0f : oth[a]);
#pragma unroll
                for (int i = 3; i >= 0; --i) { const int r = 4 * (a & 3) + i; const float rv = (a < 4) ? p0[r] : p1[r]; const float wt = (1.0f - rv) * E; E *= rv; if (a < 4) p0[r] = wt; else p1[r] = wt; }
            }
            carry *= run;
            pack_pv(o, w.vb0 + slot * SLOTB, p0, p1);
            if (__all(carry < 1e-30f)) done = 1;
        } else {
            if (64 * T > qfirst + 31) return;
            LAS float* kbl = (LAS float*)(w.shm + L_KB);
            f32x16 c0, c1;
#pragma unroll
            for (int g = 0; g < 4; ++g) { const f32x4 k0 = *(const LAS f32x4*)(kbl + 64 * T + 8 * g + 4 * w.hi), k1 = *(const LAS f32x4*)(kbl + 64 * T + 32 + 8 * g + 4 * w.hi);
#pragma unroll
                for (int i = 0; i < 4; ++i) { c0[4 * g + i] = k0[i]; c1[4 * g + i] = k1[i]; } }
            f32x16 p0, p1; qkt(p0, p1, w.shm + L_K + slot * SLOTB, qr, c0, c1, w.r32, w.hi);
            if (64 * T + 63 > qfirst) {
#pragma unroll
                for (int r = 0; r < 16; ++r) { const int kv = 64 * T + crow(r, w.hi); if (kv > qpos) p0[r] = -INFINITY; if (kv + 32 > qpos) p1[r] = -INFINITY; } }
            softmax_step(p0, p1, mref, lsum, o, (LAS float*)(w.shm + L_WS) + w.wid * 64, w.r32, w.hi);
            pack_pv(o, w.vb0 + slot * SLOTB, p0, p1);
        }
    }
    __device__ __forceinline__ void finish(const UnitD& d, const WaveCtx& w, const f32x16* o) {
        LAS float* wsf = (LAS float*)(w.shm + L_WS) + w.wid * 64;
        float sc[16];
        if (MODE == 0) {
#pragma unroll
            for (int r = 0; r < 16; ++r) sc[r] = 1.0f;
        } else {
            float lt = lsum + other_half(lsum, w.hi);
            if (w.hi == 0) wsf[32 + w.r32] = lt;
            asm volatile("s_waitcnt lgkmcnt(0)" ::: "memory");
#pragma unroll
            for (int r = 0; r < 16; ++r) sc[r] = __builtin_amdgcn_rcpf(wsf[32 + crow(r, w.hi)]);
        }
        store_o(o, sc, w.shm + L_OST + w.wid * 4096, O + ((long)d.b * SEQ + d.qb * 256 + w.wid * 32) * DM + d.h * 64, DM, w.lane, w.r32, w.hi);
    }
};

struct DilMode {
    const bf16* PROJ; bf16* OG; float* ST; int b, h, p;
    float mref, lsum;
    __device__ __forceinline__ int units() const { return 12; }
    __device__ __forceinline__ void desc(int j, UnitD& d) const {
        const int g = j >> 2, i = j & 3; d.g = g; d.b = b; d.h = h; d.qb = 0;
        d.x = (g == 1) ? ((2 * (i >> 1) + p) << 1) + (i & 1) : 2 * i + p;
        const int i0 = (g == 0) ? 256 * d.x : (g == 1) ? 256 * (d.x & 1) : 0;
        d.NT = (g == 2) ? 4 : ((i0 >> 6) + 4 - t_lo(g, i0));
    }
    static __device__ __forceinline__ int t_lo(int g, int i0) { return (g == 2) ? 0 : ((i0 >> 6) >= 2 ? (i0 >> 6) - 2 : 0); }
    static __device__ __forceinline__ int dil_of(int g) { return (g == 0) ? 1 : (g == 1) ? 4 : 16; }
    static __device__ __forceinline__ int cls0_of(int g, int x) { return (g == 0) ? 0 : (g == 1) ? (x >> 1) : 2 * x; }
    static __device__ __forceinline__ int i0_of(int g, int x) { return (g == 0) ? 256 * x : (g == 1) ? 256 * (x & 1) : 0; }
    static __device__ __forceinline__ int tcls(int g, int x, int k) { return cls0_of(g, x) + ((g == 2) ? (k >> 1) : 0); }
    static __device__ __forceinline__ int kbase(int g, int x, int k) { return (g == 2) ? 64 * (k & 1) : 64 * (t_lo(g, i0_of(g, x)) + k); }
    __device__ __forceinline__ void q_load(const UnitD& d, const WaveCtx& w, bf16x8 (&q)[4]) const {
        const int dil = dil_of(d.g), clsw = cls0_of(d.g, d.x) + ((d.g == 2) ? (w.wid >> 2) : 0), qi0w = (d.g == 2) ? 32 * (w.wid & 3) : i0_of(d.g, d.x) + 32 * w.wid;
        const bf16* Qw = PROJ + (size_t)(2 * d.g) * PLANE + ((long)d.b * SEQ + clsw + (long)(qi0w + w.r32) * dil) * DM + d.h * 64 + w.hi * 8;
#pragma unroll
        for (int d0 = 0; d0 < 4; ++d0) q[d0] = gload16(Qw + d0 * 16);
    }
    __device__ __forceinline__ void dma(const UnitD& d, int k, int slot, const WaveCtx& w) const {
        const int dil = dil_of(d.g); const long tok0 = (long)d.b * SEQ + tcls(d.g, d.x, k) + (long)kbase(d.g, d.x, k) * dil;
        glds16(PROJ + (size_t)(2 * d.g + 1) * PLANE + (tok0 + (long)w.lane * dil) * DM + d.h * 64 + w.wid * 8, (unsigned)__builtin_amdgcn_readfirstlane(w.lds0 + L_K + slot * SLOTB + w.wid * 1024));
        glds16(PROJ + (size_t)6 * PLANE + (tok0 + (long)(16 * (w.wid & 3) + (w.lane >> 2)) * dil) * DM + d.h * 64 + (w.wid >> 2) * 32 + (w.lane & 3) * 8, (unsigned)__builtin_amdgcn_readfirstlane(w.lds0 + L_V + slot * SLOTB + w.wid * 1024));
    }
    __device__ __forceinline__ void begin(const UnitD&, const WaveCtx&) { mref = -1e30f; lsum = 0.f; }
    __device__ __forceinline__ int wave_done() const { return 0; }
    __device__ __forceinline__ void compute(const UnitD& d, int k, int slot, const WaveCtx& w, const bf16x8* qr, f32x16* o) {
        const int clsw = cls0_of(d.g, d.x) + ((d.g == 2) ? (w.wid >> 2) : 0), qi0w = (d.g == 2) ? 32 * (w.wid & 3) : i0_of(d.g, d.x) + 32 * w.wid;
        const int kb = kbase(d.g, d.x, k);
        if (tcls(d.g, d.x, k) != clsw || kb > qi0w + 31 || kb < qi0w - 191) return;
        LAS float* tbl = (LAS float*)(w.shm + L_KB) + d.g * 640 + 256;
        const int dbase = qi0w + w.r32 - kb - 4 * w.hi;
        f32x16 c0, c1;
#pragma unroll
        for (int r = 0; r < 16; ++r) { const int cr = (r & 3) + 8 * (r >> 2); c0[r] = tbl[dbase - cr]; c1[r] = tbl[dbase - cr - 32]; }
        f32x16 p0, p1; qkt(p0, p1, w.shm + L_K + slot * SLOTB, qr, c0, c1, w.r32, w.hi);
        softmax_step(p0, p1, mref, lsum, o, (LAS float*)(w.shm + L_WS) + w.wid * 64, w.r32, w.hi);
        pack_pv(o, w.vb0 + slot * SLOTB, p0, p1);
    }
    __device__ __forceinline__ void finish(const UnitD& d, const WaveCtx& w, const f32x16* o) {
        const int dil = dil_of(d.g), clsw = cls0_of(d.g, d.x) + ((d.g == 2) ? (w.wid >> 2) : 0), qi0w = (d.g == 2) ? 32 * (w.wid & 3) : i0_of(d.g, d.x) + 32 * w.wid;
        LAS float* wsf = (LAS float*)(w.shm + L_WS) + w.wid * 64;
        const float lt = lsum + other_half(lsum, w.hi);
        if (w.hi == 0) { wsf[32 + w.r32] = lt;
            const long tok = (long)d.b * SEQ + clsw + (long)(qi0w + w.r32) * dil;
            *(f32x2*)(ST + ((size_t)d.g * M * NH + (size_t)tok * NH + d.h) * 2) = (f32x2){mref, lt}; }
        asm volatile("s_waitcnt lgkmcnt(0)" ::: "memory");
        float sc[16];
#pragma unroll
        for (int r = 0; r < 16; ++r) sc[r] = __builtin_amdgcn_rcpf(wsf[32 + crow(r, w.hi)]);
        store_o(o, sc, w.shm + L_OST + w.wid * 4096, OG + (size_t)d.g * PLANE + ((long)d.b * SEQ + clsw + (long)qi0w * dil) * DM + d.h * 64, (long)dil * DM, w.lane, w.r32, w.hi);
    }
};

template <class Mode, bool EARLY_EXIT>
__device__ __forceinline__ void stream_units(Mode& Mo, const WaveCtx& w) {
    LAS int* flg = (LAS int*)(w.shm + L_FLG);
    const int nun = Mo.units();
    int pj = 0, pk = 0, pseq = 0, cseq = 0;
    UnitD pd; Mo.desc(0, pd);
    bf16x8 qn[4];
    if (EARLY_EXIT && w.wid == 0 && w.lane < 4) flg[w.lane] = 0;
    asm volatile("s_waitcnt vmcnt(0)" ::: "memory");
#define ATT_PRODUCE() do { if (pj < nun) { if (pk == 0) Mo.q_load(pd, w, qn); Mo.dma(pd, pk, pseq % NSLOT, w); ++pseq; if (++pk == pd.NT) { pk = 0; if (++pj < nun) Mo.desc(pj, pd); } } } while (0)
#pragma unroll 1
    for (int i = 0; i < AHEAD; ++i) ATT_PRODUCE();
#pragma unroll 1
    for (int cj = 0; cj < nun; ++cj) {
        UnitD d; Mo.desc(cj, d);
        bf16x8 qr[4];
        f32x16 o[2]; o[0] = f32x16{}; o[1] = f32x16{};
        Mo.begin(d, w);
        const int useq0 = cseq;
        int rep = 0;
#pragma unroll 1
        while (pseq - cseq < AHEAD && pj < nun) ATT_PRODUCE();
#pragma unroll 1
        for (int ck = 0; ck < d.NT; ++ck) {
            wait_bar(2 * (pseq - cseq - 1));
            if (ck == 0) { asm volatile("" : "+v"(qn[0]), "+v"(qn[1]), "+v"(qn[2]), "+v"(qn[3])); qr[0] = qn[0]; qr[1] = qn[1]; qr[2] = qn[2]; qr[3] = qn[3]; }
            if (EARLY_EXIT && ck == 1 && w.wid == 0 && w.lane < 2) flg[((cj + 1) & 1) * 2 + w.lane] = 0;
            if (EARLY_EXIT && ck > 0) {
                if (__builtin_amdgcn_readfirstlane(flg[(cj & 1) * 2 + ((ck - 1) & 1)]) == 8) {
                    const int uend = useq0 + d.NT;
                    if (pj == cj) { pk = 0; if (++pj < nun) Mo.desc(pj, pd); }
                    cseq = uend < pseq ? uend : pseq;
                    break; } }
            if (pseq - cseq < AHEAD) ATT_PRODUCE();
            Mo.compute(d, ck, cseq % NSLOT, w, qr, o);
            if (EARLY_EXIT && Mo.wave_done() && rep < 2) { if (w.lane == 0) __hip_atomic_fetch_add(&flg[(cj & 1) * 2 + (ck & 1)], 1, __ATOMIC_RELAXED, __HIP_MEMORY_SCOPE_WORKGROUP); ++rep; }
            ++cseq;
        }
        Mo.finish(d, w, o);
    }
    asm volatile("s_waitcnt vmcnt(0) lgkmcnt(0)\n\ts_barrier" ::: "memory");
#undef ATT_PRODUCE
}
__device__ __forceinline__ WaveCtx make_ctx(lptr shm) {
    WaveCtx w; const int tid = threadIdx.x; w.lane = tid & 63; w.r32 = w.lane & 31; w.hi = w.lane >> 5; w.wid = __builtin_amdgcn_readfirstlane(tid >> 6);
    w.shm = shm; w.lds0 = (unsigned)(uintptr_t)shm;
    w.vb0 = (int)(w.lds0 + L_V) + ((w.lane >> 4) & 1) * 32 + (w.lane & 3) * 8 + (4 * w.hi + ((w.lane & 15) >> 2)) * 64;
    return w;
}
template <int MODE>
__device__ __forceinline__ void causal_phase(lptr shm, int G, const bf16* Q, const bf16* K, const bf16* V, bf16* O, const float* cum) {
    const int bx = blockIdx.x; const int vcu = (G % 8 == 0) ? (bx % 8) * (G / 8) + bx / 8 : bx;
    const WaveCtx w = make_ctx(shm);
    for (int u = vcu; u < BATCH * NH * 2; u += G) {
        CausalMode<MODE> Mo; Mo.Q = Q; Mo.K = K; Mo.V = V; Mo.O = O; Mo.b = u >> 5; Mo.h = (u >> 1) & 15; Mo.p = u & 1;
        if (MODE == 2) { LAS float* kbl = (LAS float*)(shm + L_KB);
            for (int s = threadIdx.x; s < SEQ; s += NTHR) kbl[s] = -cum[((long)Mo.b * SEQ + s) * 16 + Mo.h]; }
        stream_units<CausalMode<MODE>, MODE == 0>(Mo, w);
    }
}
__device__ __forceinline__ int t5_bucket_f(int dist) {
    if (dist < 16) return dist;
    int lb = 16 + (int)(logf((float)dist / 16.0f) / logf(128.0f) * 16.0f);
    return lb < 31 ? lb : 31;
}
__device__ __forceinline__ void dil_phase(lptr shm, int G, const bf16* PROJ, bf16* OG, float* ST, const float* rel_bias) {
    const int bx = blockIdx.x; const int vcu = (G % 8 == 0) ? (bx % 8) * (G / 8) + bx / 8 : bx;
    const WaveCtx w = make_ctx(shm);
    for (int u = vcu; u < BATCH * NH * 2; u += G) {
        DilMode Mo; Mo.PROJ = PROJ; Mo.OG = OG; Mo.ST = ST; Mo.b = u >> 5; Mo.h = (u >> 1) & 15; Mo.p = u & 1;
        LAS float* tb = (LAS float*)(shm + L_KB);
        for (int i = threadIdx.x; i < 3 * 640; i += NTHR) { const int gg = i / 640, dl = i - gg * 640 - 256; const int dil = (gg == 0) ? 1 : (gg == 1) ? 4 : 16;
            tb[i] = (dl >= 0 && dl <= 128) ? rel_bias[t5_bucket_f(dl * dil) * 16 + Mo.h] * LOG2E : -INFINITY; }
        stream_units<DilMode, false>(Mo, w);
    }
}
__device__ __forceinline__ void dil_merge(int G, const bf16* OG, const float* ST, bf16* O) {
    for (int idx = blockIdx.x * NTHR + threadIdx.x; idx < M * NH; idx += G * NTHR) {
        const f32x2 s0 = *(const f32x2*)(ST + ((size_t)0 * M * NH + idx) * 2), s1 = *(const f32x2*)(ST + ((size_t)1 * M * NH + idx) * 2), s2 = *(const f32x2*)(ST + ((size_t)2 * M * NH + idx) * 2);
        const float mx = fmaxf(s0.x, fmaxf(s1.x, s2.x));
        float w0 = __builtin_amdgcn_exp2f(s0.x - mx) * s0.y, w1 = __builtin_amdgcn_exp2f(s1.x - mx) * s1.y, w2 = __builtin_amdgcn_exp2f(s2.x - mx) * s2.y;
        const float inv = 1.0f / (w0 + w1 + w2); w0 *= inv; w1 *= inv; w2 *= inv;
        const GAS v4u* a0 = (const GAS v4u*)(OG + (size_t)idx * 64); const GAS v4u* a1 = (const GAS v4u*)(OG + PLANE + (size_t)idx * 64); const GAS v4u* a2 = (const GAS v4u*)(OG + 2 * PLANE + (size_t)idx * 64);
        GAS v4u* op = (GAS v4u*)(O + (size_t)idx * 64);
#pragma unroll
        for (int c = 0; c < 8; ++c) { const v4u x0 = a0[c], x1 = a1[c], x2 = a2[c]; v4u r;
#pragma unroll
            for (int q = 0; q < 4; ++q) r[q] = pk2(w0 * bflo(x0[q]) + w1 * bflo(x1[q]) + w2 * bflo(x2[q]), w0 * bfhi(x0[q]) + w1 * bfhi(x1[q]) + w2 * bfhi(x2[q]));
            op[c] = r; }
    }
}
}

enum { CV_PLAIN = 0, CV_QKN = 1, CV_GATE = 2, CV_UP = 3 };
__device__ __forceinline__ int cv_dst_row(int mode, int n) {
    if (mode == CV_QKN) return (n & ~255) + 128 * ((n >> 5) & 1) + 32 * ((n >> 6) & 3) + (n & 31);
    if (mode == CV_GATE) return 256 * (n >> 7) + (n & 127);
    if (mode == CV_UP) return 256 * (n >> 7) + 128 + (n & 127);
    return n;
}
__device__ __forceinline__ void conv_item(const float* W, int ldw, int K, bf16* WT, int mode, LAS unsigned char* scr, int item, int nblk, int lane) {
    const int kb = item / nblk, nb = item - kb * nblk, k0 = 64 * kb, n0 = 64 * nb;
    const GAS float* src = (const GAS float*)(W + (size_t)k0 * ldw + n0 + lane);
#pragma unroll
    for (int kc = 0; kc < 8; ++kc) {
        float v[8];
#pragma unroll
        for (int j = 0; j < 8; ++j) v[j] = src[(size_t)(kc * 8 + j) * ldw];
        v4u w; w.x = pk2(v[0], v[1]); w.y = pk2(v[2], v[3]); w.z = pk2(v[4], v[5]); w.w = pk2(v[6], v[7]);
        *(LAS v4u*)(scr + lane * 144 + kc * 16) = w;
    }
    asm volatile("s_waitcnt lgkmcnt(0)" ::: "memory");
#pragma unroll
    for (int j = 0; j < 8; ++j) { const int n = 8 * j + (lane >> 3), ch = lane & 7;
        const v4u w = *(const LAS v4u*)(scr + n * 144 + ch * 16);
        *(GAS v4u*)(WT + (size_t)cv_dst_row(mode, n0 + n) * K + k0 + 8 * ch) = w; }
    asm volatile("s_waitcnt lgkmcnt(0)" ::: "memory");
}
__device__ __forceinline__ void conv_item8(const float* W, int ldw, int K, unsigned char* WT8, int mode, LAS unsigned char* scr, int item, int nblk, int lane) {
    const int kb = item / nblk, nb = item - kb * nblk, k0 = 64 * kb, n0 = 64 * nb;
    const GAS float* src = (const GAS float*)(W + (size_t)k0 * ldw + n0 + lane);
#pragma unroll
    for (int kc = 0; kc < 8; ++kc) {
        float v[8];
#pragma unroll
        for (int j = 0; j < 8; ++j) v[j] = src[(size_t)(kc * 8 + j) * ldw] * W8S;
        v2u w; w.x = pg8::cvt4_fp8(v[0], v[1], v[2], v[3]); w.y = pg8::cvt4_fp8(v[4], v[5], v[6], v[7]);
        *(LAS v2u*)(scr + lane * 80 + kc * 8) = w;
    }
    asm volatile("s_waitcnt lgkmcnt(0)" ::: "memory");
#pragma unroll
    for (int j = 0; j < 4; ++j) { const int n = 16 * j + (lane >> 2), ch = lane & 3;
        const v4u w = *(const LAS v4u*)(scr + n * 80 + ch * 16);
        *(GAS v4u*)(WT8 + (size_t)cv_dst_row(mode, n0 + n) * K + k0 + 16 * ch) = w; }
    asm volatile("s_waitcnt lgkmcnt(0)" ::: "memory");
}
__device__ __forceinline__ void conv_job8(Frame& F, const float* W, int ldw, int K, int N, unsigned char* WT8, int mode, int& rot) {
    LAS unsigned char* scr = F.lds + F.wave * 9216;
    const int nblk = N / 64, nitems = (K / 64) * nblk, NGW = F.G * NWAVES, gw = blockIdx.x * NWAVES + F.wave;
    int first = gw - (rot % NGW); if (first < 0) first += NGW;
    for (int it = first; it < nitems; it += NGW) conv_item8(W, ldw, K, WT8, mode, scr, it, nblk, F.lane);
    rot += nitems;
}
__device__ __forceinline__ void conv_job(Frame& F, const float* W, int ldw, int K, int N, bf16* WT, int mode, int& rot) {
    LAS unsigned char* scr = F.lds + F.wave * 9216;
    const int nblk = N / 64, nitems = (K / 64) * nblk, NGW = F.G * NWAVES, gw = blockIdx.x * NWAVES + F.wave;
    int first = gw - (rot % NGW); if (first < 0) first += NGW;
    for (int it = first; it < nitems; it += NGW) conv_item(W, ldw, K, WT, mode, scr, it, nblk, F.lane);
    rot += nitems;
}
__device__ __forceinline__ void convert_weights(Frame& F) {
    bf16* WB = (bf16*)(F.ws + WS_W); int rot = 0;
    for (int j = 0; j < 2; ++j) conv_job(F, INP(1) + (size_t)j * DM * 3 * DM, 3 * DM, DM, 3 * DM, WB + WE_QKV + (size_t)j * 3 * DM * DM, CV_PLAIN, rot);
    for (int j = 0; j < 2; ++j) conv_job(F, INP(2) + (size_t)j * DM * DM, DM, DM, DM, WB + WE_WO_SB + (size_t)j * DM * DM, CV_PLAIN, rot);
    conv_job(F, INP(3), 7 * DM, DM, 7 * DM, WB + WE_IN_DIL, CV_QKN, rot);
    conv_job(F, INP(6), DM, DM, DM, WB + WE_WO_DIL, CV_PLAIN, rot);
    conv_job(F, INP(7), 3088, DM, 3 * DM, WB + WE_IN_FOX, CV_QKN, rot);
    conv_job(F, INP(11), DM, DM, DM, WB + WE_WO_FOX, CV_PLAIN, rot);
    for (int f = 0; f < 2; ++f) {
        conv_job(F, INP(15) + (size_t)f * DM * FF, FF, DM, FF, WB + WE_GU + (size_t)f * 2 * FF * DM, CV_GATE, rot);
        conv_job(F, INP(16) + (size_t)f * DM * FF, FF, DM, FF, WB + WE_GU + (size_t)f * 2 * FF * DM, CV_UP, rot);
        conv_job(F, INP(17) + (size_t)f * FF * DM, DM, FF, DM, WB + WE_D + (size_t)f * DM * FF, CV_PLAIN, rot);
    }
    for (int fe = 0; fe < 16; ++fe) {
        if (MOE_FP8) {
            conv_job8(F, INP(19) + (size_t)fe * DM * FF, FF, DM, FF, (unsigned char*)(WB + WE_MGU) + (size_t)fe * 2 * FF * DM, CV_GATE, rot);
            conv_job8(F, INP(20) + (size_t)fe * DM * FF, FF, DM, FF, (unsigned char*)(WB + WE_MGU) + (size_t)fe * 2 * FF * DM, CV_UP, rot);
            conv_job8(F, INP(21) + (size_t)fe * FF * DM, DM, FF, DM, (unsigned char*)(WB + WE_MD) + (size_t)fe * DM * FF, CV_PLAIN, rot);
        } else {
            conv_job(F, INP(19) + (size_t)fe * DM * FF, FF, DM, FF, WB + WE_MGU + (size_t)fe * 2 * FF * DM, CV_GATE, rot);
            conv_job(F, INP(20) + (size_t)fe * DM * FF, FF, DM, FF, WB + WE_MGU + (size_t)fe * 2 * FF * DM, CV_UP, rot);
            conv_job(F, INP(21) + (size_t)fe * FF * DM, DM, FF, DM, WB + WE_MD + (size_t)fe * DM * FF, CV_PLAIN, rot);
        }
    }
}

__device__ __forceinline__ int moe_cnt(Frame& F, int f, int e) {
    const unsigned long long w = __hip_atomic_load((GAS unsigned long long*)(F.ctl + CW_CNT + f * 64 + 16 * (e >> 2)), RLX_AGENT);
    return (int)((w >> (16 * (e & 3))) & 0xffffull);
}
__device__ __forceinline__ f32x4 moe_yrow(Frame& F, int r, int q4) {
    const bf16* Y = (const bf16*)(F.ws + WS_R2); const bf16* P = (const bf16*)(F.ws + WS_R2 + 72 * MiB);
    if (r < SPLIT_ROW0 || F.G != 256 || !MOE_SPLITK) { const v2u a = ((const GAS v2u*)(Y + (size_t)r * DM))[q4]; return (f32x4){bflo(a.x), bfhi(a.x), bflo(a.y), bfhi(a.y)}; }
    f32x4 s = (f32x4){0.f, 0.f, 0.f, 0.f};
#pragma unroll
    for (int k = 0; k < MOE_NSPLIT; ++k) { const v2u a = ((const GAS v2u*)(P + ((size_t)k * SPLIT_ROWS + (size_t)(r - SPLIT_ROW0)) * DM))[q4]; s = s + (f32x4){bflo(a.x), bfhi(a.x), bflo(a.y), bfhi(a.y)}; }
    return s;
}
__device__ __forceinline__ void moe_bases(Frame& F, int f, int (&tb)[NE + 1]) {
    int acc = 0;
#pragma unroll
    for (int e = 0; e < NE; ++e) { tb[e] = acc; const int c = moe_cnt(F, f, e); acc += (c + 255) >> 8; }
    tb[NE] = acc;
}

template <int NC>
__device__ __forceinline__ float wave_reduce_cols(float (&part)[NC], int lane) {
#pragma unroll
    for (int st = 0, n = NC / 2; n >= 1; ++st, n >>= 1) {
        const bool up = (lane >> st) & 1;
#pragma unroll
        for (int i = 0; i < n; ++i) { const float keep = up ? part[i + n] : part[i], send = up ? part[i] : part[i + n]; part[i] = keep + __shfl_xor(send, 1 << st); }
    }
    float v = part[0];
#pragma unroll
    for (int o = NC; o < 64; o <<= 1) v += __shfl_xor(v, o);
    return v;
}
template <int NC> __device__ __forceinline__ int lane_of_col(int c) {
    int l = 0;
#pragma unroll
    for (int st = 0, n = NC / 2; n >= 1; ++st, n >>= 1) { if (c & n) l |= 1 << st; }
    return l;
}
template <int FLAGS>
__device__ __forceinline__ void norm_phase(Frame& F, const float* xin, float* xout, const float* gain, bf16* H, int fprev, int f,
                                           const float* Wf  , const float* bf  , const float* Wr  ) {
    constexpr int NC = (FLAGS & 2) ? 16 : (FLAGS & 4) ? 8 : 0;
    const bf16* Y = (const bf16*)(F.ws + WS_R2);
    const int* tok_prev = (const int*)(F.ws + WS_MISC + MS_TOK) + (size_t)fprev * M * 2;
    float* lgf = (float*)(F.ws + WS_MISC + MS_LOGF);
    LAS int* sel = (LAS int*)F.lds;
    LAS float* sg = (LAS float*)(F.lds + 512);
    LAS int* gb = (LAS int*)(F.lds + 1536);
    LAS f32x4* WL = (LAS f32x4*)(F.lds + 4096);
    int tb[NE + 1];
    if (FLAGS & 1) moe_bases(F, fprev, tb);
    if (NC) {
        const float* Wsrc = (FLAGS & 2) ? Wf + 3072 : Wr; const int ldw = (FLAGS & 2) ? 3088 : 8;
        for (int idx = F.tid; idx < 16 * (NC / 4) * 64; idx += NTHR) {
            const int ln = idx & 63, cq = (idx >> 6) % (NC / 4), jq = idx / (64 * (NC / 4)), k = 4 * (ln + 64 * (jq >> 2)) + (jq & 3);
            WL[idx] = *(const GAS f32x4*)(Wsrc + (size_t)k * ldw + 4 * cq) * gain[k];
        }
        __syncthreads();
    }
    for (int chunk = blockIdx.x; chunk < M / 64; chunk += F.G) {
        for (int i = 0; i < 8; ++i) {
            const int m = chunk * 64 + F.wave * 8 + i;
            int ln = F.lane; asm volatile("" : "+v"(ln));
            const GAS f32x4* xr = (const GAS f32x4*)(xin + (size_t)m * DM) + ln;
            f32x4 v[4];
#pragma unroll
            for (int j = 0; j < 4; ++j) v[j] = xr[64 * j];
            if (FLAGS & 1) {
                const int s0 = tok_prev[m * 2], s1 = tok_prev[m * 2 + 1];
                int r0 = 0, r1 = 0;
#pragma unroll
                for (int e = 0; e < NE; ++e) { if ((s0 >> 14) == e) r0 = tb[e] * 256 + (s0 & 16383); if ((s1 >> 14) == e) r1 = tb[e] * 256 + (s1 & 16383); }
#pragma unroll
                for (int j = 0; j < 4; ++j) { v[j] = v[j] + moe_yrow(F, r0, ln + 64 * j) + moe_yrow(F, r1, ln + 64 * j);
                    ((GAS f32x4*)(xout + (size_t)m * DM) + ln)[64 * j] = v[j]; }
            }
            float s = 0.f;
#pragma unroll
            for (int j = 0; j < 4; ++j) s += (v[j].x * v[j].x + v[j].y * v[j].y) + (v[j].z * v[j].z + v[j].w * v[j].w);
            const float inv = 1.0f / sqrtf(wave_sum(s) * (1.f / DM) + RMS_EPS);
            float colv = 0.f;
            if (NC) {
                float part[NC ? NC : 1];
#pragma unroll
                for (int c = 0; c < NC; ++c) part[c] = 0.f;
                const int woff = ln;
#pragma unroll
                for (int j = 0; j < 4; ++j) {
#pragma unroll
                    for (int q = 0; q < 4; ++q) { const float xv = v[j][q];
#pragma unroll
                        for (int cq = 0; cq < NC / 4; ++cq) { const f32x4 w = WL[((j * 4 + q) * (NC / 4) + cq) * 64 + woff];
                            part[cq * 4 + 0] += xv * w.x; part[cq * 4 + 1] += xv * w.y; part[cq * 4 + 2] += xv * w.z; part[cq * 4 + 3] += xv * w.w; }
                        if ((q & 1) == 1) asm volatile("" ::: "memory"); } }
                colv = wave_reduce_cols<NC ? NC : 2>(reinterpret_cast<float (&)[NC ? NC : 2]>(part), ln) * inv;
            }
            if (H) {
                GAS unsigned long long* o8 = (GAS unsigned long long*)(H + (size_t)m * DM) + ln;
                GAS unsigned* h8 = (GAS unsigned*)(F.ws + WS_R2 + 104 * MiB + (size_t)m * DM) + ln;
#pragma unroll
                for (int j = 0; j < 4; ++j) { const f32x4 g = ((const GAS f32x4*)gain + ln)[64 * j]; const f32x4 hv = v[j] * inv * g;
                    if ((FLAGS & 4) && MOE_FP8) h8[64 * j] = pg8::cvt4_fp8(hv.x, hv.y, hv.z, hv.w);
                    else o8[64 * j] = (unsigned long long)pk2(hv.x, hv.y) | ((unsigned long long)pk2(hv.z, hv.w) << 32); }
            }
            if (FLAGS & 2) {
                if (ln < 16) { const int l = ln; const int c = ((l & 1) << 3) | ((l & 2) << 1) | ((l & 4) >> 1) | ((l & 8) >> 3);
                    const float z = colv + bf[c]; const float ls = fminf(z, 0.f) - log1pf(expf(-fabsf(z))); lgf[(size_t)m * 16 + c] = ls * LOG2E; }
            }
            if (FLAGS & 4) {
                float lg[8];
#pragma unroll
                for (int c = 0; c < 8; ++c) lg[c] = __builtin_bit_cast(float, __builtin_amdgcn_readlane(__builtin_bit_cast(int, colv), lane_of_col<8>(c)));
                int e0 = 0; float l0 = lg[0];
#pragma unroll
                for (int c = 1; c < 8; ++c) if (lg[c] > l0) { l0 = lg[c]; e0 = c; }
                int e1 = -1; float l1 = -INFINITY;
#pragma unroll
                for (int c = 0; c < 8; ++c) if (c != e0 && lg[c] > l1) { l1 = lg[c]; e1 = c; }
                const float g0 = 1.0f / (1.0f + expf(l1 - l0)), g1 = 1.0f - g0;
                if (ln == 0) { const int r = F.wave * 8 + i; sel[r * 2] = e0; sel[r * 2 + 1] = e1; sg[r * 2] = g0; sg[r * 2 + 1] = g1; }
            }
        }
        if (FLAGS & 4) {
            int* selg = (int*)(F.ws + WS_MISC + MS_SEL) + (size_t)f * M * 2;
            float* sgg = (float*)(F.ws + WS_MISC + MS_SG) + (size_t)f * M * 2;
            int* lcn = (int*)(F.ws + WS_MISC + MS_LC) + (size_t)f * 256 * 8;
            __syncthreads();
            if (F.tid < 128) { selg[chunk * 128 + F.tid] = sel[F.tid]; sgg[chunk * 128 + F.tid] = sg[F.tid]; }
            if (F.tid >= 128 && F.tid < 136) { const int e = F.tid - 128; int c = 0;
                for (int q = 0; q < 128; ++q) c += (sel[q] == e) ? 1 : 0;
                lcn[chunk * 8 + e] = c; }
            __syncthreads();
        }
    }
}

__device__ __forceinline__ void moe_finalize(Frame& F, int f) {
    const int* selg = (const int*)(F.ws + WS_MISC + MS_SEL) + (size_t)f * M * 2;
    const float* sgg = (const float*)(F.ws + WS_MISC + MS_SG) + (size_t)f * M * 2;
    const int* lcn = (const int*)(F.ws + WS_MISC + MS_LC) + (size_t)f * 256 * 8;
    int* list = (int*)(F.ws + WS_MISC + MS_LIST) + (size_t)f * NE * LCAP;
    float* gw = (float*)(F.ws + WS_MISC + MS_GW) + (size_t)f * NE * LCAP;
    int* tok = (int*)(F.ws + WS_MISC + MS_TOK) + (size_t)f * M * 2;
    LAS int* arr = (LAS int*)F.lds;
    LAS int* sel = (LAS int*)(F.lds + 8192);
    LAS int* pb = (LAS int*)(F.lds + 8192 + 512);
    LAS int* pt = (LAS int*)(F.lds + 8192 + 1536);
    LAS int* base = (LAS int*)(F.lds + 8192 + 2560);
    LAS int* tot = (LAS int*)(F.lds + 8192 + 2592);
    for (int chunk = blockIdx.x; chunk < M / 64; chunk += F.G) {
        if (F.tid < 256) { const v4u a = *(const GAS v4u*)(lcn + F.tid * 8), b = *(const GAS v4u*)(lcn + F.tid * 8 + 4);
            *(LAS v4u*)(arr + F.tid * 8) = a; *(LAS v4u*)(arr + F.tid * 8 + 4) = b; }
        if (F.tid < 128) sel[F.tid] = selg[chunk * 128 + F.tid];
        __syncthreads();
        if (F.tid < 256) { const int e = F.tid & 7, seg = F.tid >> 3; int b = 0, t = 0;
#pragma unroll
            for (int i = 0; i < 8; ++i) { const int c = seg * 8 + i; const int v = arr[c * 8 + e]; t += v; b += (c < chunk) ? v : 0; }
            pb[seg * 8 + e] = b; pt[seg * 8 + e] = t; }
        __syncthreads();
        if (F.tid < 8) { int b = 0, t = 0;
            for (int sgm = 0; sgm < 32; ++sgm) { b += pb[sgm * 8 + F.tid]; t += pt[sgm * 8 + F.tid]; }
            base[F.tid] = b; tot[F.tid] = t; }
        __syncthreads();
        if (F.tid < 128) { const int mye = sel[F.tid]; int lp = 0;
            for (int q = 0; q < 128; ++q) lp += (q < F.tid && sel[q] == mye) ? 1 : 0;
            const int q = F.tid, row = chunk * 64 + (q >> 1), pos = base[mye] + lp;
            list[mye * LCAP + pos] = row; gw[mye * LCAP + pos] = sgg[chunk * 128 + q]; tok[row * 2 + (q & 1)] = mye * LCAP + pos; }
        if (chunk == 0 && F.tid < 2) { unsigned long long w = 0ull;
#pragma unroll
            for (int i = 0; i < 4; ++i) w |= (unsigned long long)(unsigned)tot[4 * F.tid + i] << (16 * i);
            __hip_atomic_store((GAS unsigned long long*)(F.ctl + CW_CNT + f * 64 + 16 * F.tid), w, RLX_AGENT); }
        __syncthreads();
    }
}

__device__ __forceinline__ void final_combine(Frame& F, int f) {
    const bf16* Y = (const bf16*)(F.ws + WS_R2);
    const int* tok = (const int*)(F.ws + WS_MISC + MS_TOK) + (size_t)f * M * 2;
    int tb[NE + 1]; moe_bases(F, f, tb);
    for (int m = blockIdx.x * NWAVES + F.wave; m < M; m += F.G * NWAVES) {
        const int s0 = tok[m * 2], s1 = tok[m * 2 + 1]; int r0 = 0, r1 = 0;
#pragma unroll
        for (int e = 0; e < NE; ++e) { if ((s0 >> 14) == e) r0 = tb[e] * 256 + (s0 & 16383); if ((s1 >> 14) == e) r1 = tb[e] * 256 + (s1 & 16383); }
        GAS f32x4* xr = (GAS f32x4*)(F.out + (size_t)m * DM) + F.lane;
#pragma unroll
        for (int j = 0; j < 4; ++j) xr[64 * j] = xr[64 * j] + moe_yrow(F, r0, F.lane + 64 * j) + moe_yrow(F, r1, F.lane + 64 * j);
    }
}

__device__ __forceinline__ void cumsum_phase(Frame& F) {
    const float* logf = (const float*)(F.ws + WS_MISC + MS_LOGF);
    float* cum = (float*)(F.ws + WS_MISC + MS_CUM);
    const int gw = blockIdx.x * NWAVES + F.wave;
    if (gw < BATCH * NH) {
        const int b = gw >> 4, h = gw & 15;
        float v[32]; float s = 0.f;
#pragma unroll
        for (int i = 0; i < 32; ++i) { v[i] = logf[((size_t)b * SEQ + F.lane * 32 + i) * 16 + h]; s += v[i]; }
        float incl = s;
#pragma unroll
        for (int o = 1; o < 64; o <<= 1) { const float t = __shfl_up(incl, o); if (F.lane >= o) incl += t; }
        float run = incl - s;
#pragma unroll
        for (int i = 0; i < 32; ++i) { run += v[i]; cum[((size_t)b * SEQ + F.lane * 32 + i) * 16 + h] = run; }
    }
}

enum { EPI_PLANES = 0, EPI_RESID = 1, EPI_SWIGLU = 2, EPI_MOEDOWN = 3 };
struct SgP { const bf16* A; int lda; const int* rowidx; int Mrows; const float* W0; const float* W1; int ldw; int K; int N;
             bf16* outb; int ldo; float scale0; const float* base; float* outf; const float* gwv; };
template <int EPI>
__device__ __forceinline__ void sgemm(Frame& F, const SgP& p) {
    LAS float* As = (LAS float*)F.lds;
    LAS float* Bs0 = As + 16 * 132;
    LAS float* Bs1 = Bs0 + 16 * 128;
    const int tid = F.tid, ty = tid >> 4, tx = tid & 15;
    const int lrow = tid >> 2, lkq = (tid & 3) * 4;
    const int bk = tid >> 5, bn = (tid & 31) * 4;
    const int ntn = p.N / 128, ntiles = (p.Mrows / 128) * ntn;
    for (int tile = blockIdx.x; tile < ntiles; tile += F.G) {
        const int tm = tile / ntn, tn = tile % ntn;
        const int arow = p.rowidx ? p.rowidx[tm * 128 + lrow] : tm * 128 + lrow;
        const bf16* ap = p.A + (size_t)arow * p.lda + lkq;
        const float* bp0 = p.W0 + (size_t)bk * p.ldw + tn * 128 + bn;
        const float* bp1 = (EPI == EPI_SWIGLU) ? p.W1 + (size_t)bk * p.ldw + tn * 128 + bn : nullptr;
        f32x2 acc0[4][4], acc1[4][4];
#pragma unroll
        for (int i = 0; i < 4; ++i)
#pragma unroll
            for (int j = 0; j < 4; ++j) { acc0[i][j] = (f32x2){0.f, 0.f}; acc1[i][j] = (f32x2){0.f, 0.f}; }
        for (int k0 = 0; k0 < p.K; k0 += 16) {
            const v2u av = *(const GAS v2u*)(ap + k0);
            const f32x4 b0 = *(const GAS f32x4*)(bp0 + (size_t)k0 * p.ldw);
            f32x4 b1 = (f32x4){0.f, 0.f, 0.f, 0.f};
            if (EPI == EPI_SWIGLU) b1 = *(const GAS f32x4*)(bp1 + (size_t)k0 * p.ldw);
            __syncthreads();
            As[(lkq + 0) * 132 + lrow] = bflo(av.x); As[(lkq + 1) * 132 + lrow] = bfhi(av.x);
            As[(lkq + 2) * 132 + lrow] = bflo(av.y); As[(lkq + 3) * 132 + lrow] = bfhi(av.y);
            *(LAS f32x4*)(Bs0 + bk * 128 + bn) = b0;
            if (EPI == EPI_SWIGLU) *(LAS f32x4*)(Bs1 + bk * 128 + bn) = b1;
            __syncthreads();
#pragma unroll 2
            for (int k = 0; k < 16; ++k) {
                const f32x4 a = *(const LAS f32x4*)(As + k * 132 + ty * 4);
                const f32x4 bA = *(const LAS f32x4*)(Bs0 + k * 128 + tx * 8), bB = *(const LAS f32x4*)(Bs0 + k * 128 + tx * 8 + 4);
                const f32x2 bv[4] = {(f32x2){bA.x, bA.y}, (f32x2){bA.z, bA.w}, (f32x2){bB.x, bB.y}, (f32x2){bB.z, bB.w}};
#pragma unroll
                for (int i = 0; i < 4; ++i) {
#pragma unroll
                    for (int j = 0; j < 4; ++j) acc0[i][j] += a[i] * bv[j]; }
                if (EPI == EPI_SWIGLU) {
                    const f32x4 cA = *(const LAS f32x4*)(Bs1 + k * 128 + tx * 8), cB = *(const LAS f32x4*)(Bs1 + k * 128 + tx * 8 + 4);
                    const f32x2 cv[4] = {(f32x2){cA.x, cA.y}, (f32x2){cA.z, cA.w}, (f32x2){cB.x, cB.y}, (f32x2){cB.z, cB.w}};
#pragma unroll
                    for (int i = 0; i < 4; ++i) {
#pragma unroll
                        for (int j = 0; j < 4; ++j) acc1[i][j] += a[i] * cv[j]; }
                }
                __builtin_amdgcn_sched_barrier(0);
            }
        }
        const int c0 = tn * 128 + tx * 8;
#pragma unroll
        for (int i = 0; i < 4; ++i) {
            const int r = tm * 128 + ty * 4 + i;
            if (EPI == EPI_PLANES) {
                const int pl = c0 >> 10, cc = c0 & 1023; const float sc = (pl == 0) ? p.scale0 : 1.f;
                v4u w; w.x = pk2(acc0[i][0].x * sc, acc0[i][0].y * sc); w.y = pk2(acc0[i][1].x * sc, acc0[i][1].y * sc); w.z = pk2(acc0[i][2].x * sc, acc0[i][2].y * sc); w.w = pk2(acc0[i][3].x * sc, acc0[i][3].y * sc);
                *(GAS v4u*)(p.outb + (size_t)pl * PLANE + (size_t)r * DM + cc) = w;
            } else if (EPI == EPI_RESID) {
                const GAS f32x4* bp = (const GAS f32x4*)(p.base + (size_t)r * DM + c0); GAS f32x4* op = (GAS f32x4*)(p.outf + (size_t)r * DM + c0);
                const f32x4 x0 = bp[0], x1 = bp[1];
                op[0] = x0 + (f32x4){acc0[i][0].x, acc0[i][0].y, acc0[i][1].x, acc0[i][1].y}; op[1] = x1 + (f32x4){acc0[i][2].x, acc0[i][2].y, acc0[i][3].x, acc0[i][3].y};
            } else if (EPI == EPI_SWIGLU) {
                float o[8];
#pragma unroll
                for (int j = 0; j < 8; ++j) { const float g = acc0[i][j >> 1][j & 1], uu = acc1[i][j >> 1][j & 1]; o[j] = g / (1.0f + __expf(-g)) * uu; }
                v4u w; w.x = pk2(o[0], o[1]); w.y = pk2(o[2], o[3]); w.z = pk2(o[4], o[5]); w.w = pk2(o[6], o[7]);
                *(GAS v4u*)(p.outb + (size_t)r * p.ldo + c0) = w;
            } else {
                const float g = p.gwv[r]; GAS f32x4* op = (GAS f32x4*)(p.outf + (size_t)r * DM + c0);
                op[0] = (f32x4){acc0[i][0].x * g, acc0[i][0].y * g, acc0[i][1].x * g, acc0[i][1].y * g}; op[1] = (f32x4){acc0[i][2].x * g, acc0[i][2].y * g, acc0[i][3].x * g, acc0[i][3].y * g};
            }
        }
    }
}

__device__ __forceinline__ void qknorm_plane(Frame& F, bf16* plane, const float* gain, float mul) {
    const int nth = F.G * NTHR;
    for (int idx = blockIdx.x * NTHR + F.tid; idx < M * NH; idx += nth) {
        GAS v4u* p = (GAS v4u*)(plane + (size_t)idx * 64);
        v4u w[8]; float ss = 0.f;
#pragma unroll
        for (int c = 0; c < 8; ++c) { w[c] = p[c];
#pragma unroll
            for (int q = 0; q < 4; ++q) { const float a = bflo(w[c][q]), b = bfhi(w[c][q]); ss += a * a + b * b; } }
        const float inv = 1.0f / sqrtf(ss * (1.f / 64.f) + RMS_EPS) * mul;
#pragma unroll
        for (int c = 0; c < 8; ++c) { v4u o;
#pragma unroll
            for (int q = 0; q < 4; ++q) { const float a = bflo(w[c][q]) * inv * gain[c * 8 + 2 * q], b = bfhi(w[c][q]) * inv * gain[c * 8 + 2 * q + 1]; o[q] = pk2(a, b); }
            p[c] = o; }
    }
}

template <int MODE>
__device__ __forceinline__ void attn_simple_causal(Frame& F, const bf16* Qp, const bf16* Kp, const bf16* Vp, bf16* O, const float* cum) {
    LAS float* Ks = (LAS float*)F.lds;
    LAS float* Vs = Ks + 4096;
    LAS float* kb = Vs + 4096;
    for (int u = blockIdx.x; u < BATCH * NH * 4; u += F.G) {
        const int qblk = (u & 1) ? 3 - ((u >> 1) & 1) : ((u >> 1) & 1) * 1;
        const int bh = u >> 2, b = bh >> 4, h = bh & 15;
        const int t = qblk * 512 + F.tid;
        const size_t rowbase = (size_t)b * SEQ;
        float q[64], acc[64];
        { const GAS v4u* qp = (const GAS v4u*)(Qp + (rowbase + t) * DM + h * 64);
#pragma unroll
          for (int c = 0; c < 8; ++c) { const v4u w = qp[c];
#pragma unroll
              for (int k = 0; k < 4; ++k) { q[c * 8 + 2 * k] = bflo(w[k]); q[c * 8 + 2 * k + 1] = bfhi(w[k]); } } }
#pragma unroll
        for (int d = 0; d < 64; ++d) acc[d] = 0.f;
        float P = 1.f, mrun = -INFINITY, lrun = 0.f;
        const int ntile = 8 * (qblk + 1);
        for (int it = 0; it < ntile; ++it) {
            const int tile = (MODE == 0) ? ntile - 1 - it : it;
            __syncthreads();
            { const int key = F.tid >> 3, ch = F.tid & 7;
              const v4u kw = *(const GAS v4u*)(Kp + (rowbase + tile * 64 + key) * DM + h * 64 + ch * 8);
              const v4u vw = *(const GAS v4u*)(Vp + (rowbase + tile * 64 + key) * DM + h * 64 + ch * 8);
#pragma unroll
              for (int k = 0; k < 4; ++k) { Ks[key * 64 + ch * 8 + 2 * k] = bflo(kw[k]); Ks[key * 64 + ch * 8 + 2 * k + 1] = bfhi(kw[k]);
                                            Vs[key * 64 + ch * 8 + 2 * k] = bflo(vw[k]); Vs[key * 64 + ch * 8 + 2 * k + 1] = bfhi(vw[k]); }
              if (MODE == 2 && F.tid < 64) kb[F.tid] = -cum[(rowbase + tile * 64 + F.tid) * 16 + h]; }
            __syncthreads();
            for (int jj = 0; jj < 64; ++jj) {
                const int j = (MODE == 0) ? 63 - jj : jj; const int s = tile * 64 + j;
                float z = 0.f;
#pragma unroll
                for (int d4 = 0; d4 < 16; ++d4) { const f32x4 kv = *(const LAS f32x4*)(Ks + j * 64 + d4 * 4); z += q[d4 * 4] * kv.x + q[d4 * 4 + 1] * kv.y + q[d4 * 4 + 2] * kv.z + q[d4 * 4 + 3] * kv.w; }
                if (MODE == 0) {
                    const bool valid = s < t;
                    const float e = __builtin_amdgcn_exp2f(fminf(z, 100.f));
                    float r = 1.0f / (1.0f + e); float beta = 1.0f - r;
                    if (!valid) { r = 1.f; beta = 0.f; }
                    const float w = beta * P; P *= r;
#pragma unroll
                    for (int d4 = 0; d4 < 16; ++d4) { const f32x4 vv = *(const LAS f32x4*)(Vs + j * 64 + d4 * 4); acc[d4 * 4] += w * vv.x; acc[d4 * 4 + 1] += w * vv.y; acc[d4 * 4 + 2] += w * vv.z; acc[d4 * 4 + 3] += w * vv.w; }
                } else {
                    const bool valid = s <= t;
                    const float x = valid ? z + kb[j] : -INFINITY;
                    const float mn = fmaxf(mrun, x);
                    const float a = __builtin_amdgcn_exp2f(mrun - mn), pw = __builtin_amdgcn_exp2f(x - mn);
                    lrun = lrun * a + pw; mrun = mn;
#pragma unroll
                    for (int d4 = 0; d4 < 16; ++d4) { const f32x4 vv = *(const LAS f32x4*)(Vs + j * 64 + d4 * 4);
                        acc[d4 * 4] = acc[d4 * 4] * a + pw * vv.x; acc[d4 * 4 + 1] = acc[d4 * 4 + 1] * a + pw * vv.y; acc[d4 * 4 + 2] = acc[d4 * 4 + 2] * a + pw * vv.z; acc[d4 * 4 + 3] = acc[d4 * 4 + 3] * a + pw * vv.w; }
                }
            }
        }
        const float fin = (MODE == 0) ? 1.f : 1.0f / lrun;
        GAS v4u* op = (GAS v4u*)(O + (rowbase + t) * DM + h * 64);
#pragma unroll
        for (int c = 0; c < 8; ++c) { v4u w;
#pragma unroll
            for (int k = 0; k < 4; ++k) w[k] = pk2(acc[c * 8 + 2 * k] * fin, acc[c * 8 + 2 * k + 1] * fin);
            op[c] = w; }
    }
}

__device__ __forceinline__ int t5_bucket(int dist) {
    if (dist < 16) return dist;
    const float d = (float)dist;
    int lb = 16 + (int)(logf(d / 16.0f) / logf(128.0f) * 16.0f);
    return lb < 31 ? lb : 31;
}
__device__ __forceinline__ void attn_simple_dil(Frame& F, const bf16* PROJ, bf16* O, const float* rel_bias) {
    LAS float* tbl = (LAS float*)F.lds;
    for (int u = blockIdx.x; u < BATCH * NH * 4; u += F.G) {
        const int qblk = u & 3, bh = u >> 2, b = bh >> 4, h = bh & 15;
        const int t = qblk * 512 + F.tid;
        const size_t rowbase = (size_t)b * SEQ;
        __syncthreads();
        for (int i = F.tid; i < 3 * 129; i += NTHR) { const int g = i / 129, dl = i % 129, dil = (g == 0) ? 1 : (g == 1) ? 4 : 16;
            tbl[g * 132 + dl] = rel_bias[t5_bucket(dl * dil) * 16 + h] * LOG2E; }
        __syncthreads();
        float acc[64];
#pragma unroll
        for (int d = 0; d < 64; ++d) acc[d] = 0.f;
        float mrun = -INFINITY, lrun = 0.f;
        for (int g = 0; g < 3; ++g) {
            const int dil = (g == 0) ? 1 : (g == 1) ? 4 : 16;
            const bf16* Qg = PROJ + (size_t)(2 * g) * PLANE; const bf16* Kg = PROJ + (size_t)(2 * g + 1) * PLANE; const bf16* Vg = PROJ + (size_t)6 * PLANE;
            float q[64];
            { const GAS v4u* qp = (const GAS v4u*)(Qg + (rowbase + t) * DM + h * 64);
#pragma unroll
              for (int c = 0; c < 8; ++c) { const v4u w = qp[c];
#pragma unroll
                  for (int k = 0; k < 4; ++k) { q[c * 8 + 2 * k] = bflo(w[k]); q[c * 8 + 2 * k + 1] = bfhi(w[k]); } } }
            for (int dl = 0; dl <= 128; ++dl) {
                const int s = t - dl * dil; const bool valid = s >= 0; const int sc = valid ? s : 0;
                const GAS v4u* kp = (const GAS v4u*)(Kg + (rowbase + sc) * DM + h * 64);
                float z = 0.f;
#pragma unroll
                for (int c = 0; c < 8; ++c) { const v4u w = kp[c];
#pragma unroll
                    for (int k = 0; k < 4; ++k) z += q[c * 8 + 2 * k] * bflo(w[k]) + q[c * 8 + 2 * k + 1] * bfhi(w[k]); }
                const float x = valid ? z + tbl[g * 132 + dl] : -INFINITY;
                const float mn = fmaxf(mrun, x);
                const float a = __builtin_amdgcn_exp2f(mrun - mn), pw = __builtin_amdgcn_exp2f(x - mn);
                lrun = lrun * a + pw; mrun = mn;
                const GAS v4u* vp = (const GAS v4u*)(Vg + (rowbase + sc) * DM + h * 64);
#pragma unroll
                for (int c = 0; c < 8; ++c) { const v4u w = vp[c];
#pragma unroll
                    for (int k = 0; k < 4; ++k) { acc[c * 8 + 2 * k] = acc[c * 8 + 2 * k] * a + pw * bflo(w[k]); acc[c * 8 + 2 * k + 1] = acc[c * 8 + 2 * k + 1] * a + pw * bfhi(w[k]); } }
            }
        }
        const float fin = 1.0f / lrun;
        GAS v4u* op = (GAS v4u*)(O + (rowbase + t) * DM + h * 64);
#pragma unroll
        for (int c = 0; c < 8; ++c) { v4u w;
#pragma unroll
            for (int k = 0; k < 4; ++k) w[k] = pk2(acc[c * 8 + 2 * k] * fin, acc[c * 8 + 2 * k + 1] * fin);
            op[c] = w; }
    }
}

__device__ __forceinline__ void moe_gu_simple(Frame& F, int f, const bf16* H, bf16* ACT) {
    const int* list = (const int*)(F.ws + WS_MISC + MS_LIST) + (size_t)f * NE * LCAP;
    int base = 0;
    for (int e = 0; e < NE; ++e) {
        const int c = moe_cnt(F, f, e); const int nt = (c + 255) >> 8;
        if (nt) {
            SgP p{}; p.A = H; p.lda = DM; p.rowidx = list + e * LCAP; p.Mrows = nt * 256;
            p.W0 = INP(19) + ((size_t)f * NE + e) * DM * FF; p.W1 = INP(20) + ((size_t)f * NE + e) * DM * FF; p.ldw = FF; p.K = DM; p.N = FF;
            p.outb = ACT + (size_t)base * 256 * FF; p.ldo = FF;
            sgemm<EPI_SWIGLU>(F, p);
        }
        base += nt;
    }
}
__device__ __forceinline__ void moe_down_simple(Frame& F, int f, const bf16* ACT, float* Y) {
    const float* gw = (const float*)(F.ws + WS_MISC + MS_GW) + (size_t)f * NE * LCAP;
    int base = 0;
    for (int e = 0; e < NE; ++e) {
        const int c = moe_cnt(F, f, e); const int nt = (c + 255) >> 8;
        if (nt) {
            SgP p{}; p.A = ACT + (size_t)base * 256 * FF; p.lda = FF; p.rowidx = nullptr; p.Mrows = nt * 256;
            p.W0 = INP(21) + ((size_t)f * NE + e) * FF * DM; p.ldw = DM; p.K = FF; p.N = DM;
            p.outf = Y + (size_t)base * 256 * DM; p.gwv = gw + e * LCAP;
            sgemm<EPI_MOEDOWN>(F, p);
        }
        base += nt;
    }
}


template <class Epi>
__device__ __forceinline__ void dense_gemm(Frame& F, const bf16* A, const bf16* Bt, int N, int K, const Epi& E) {
    pg8::DenseOrder S; S.init(A, Bt, M, N, K, F.G, (int)blockIdx.x);
    pg8::gemm_phase<Epi, pg8::DenseOrder, false>(F.lds, K, S, E);
}
__device__ __forceinline__ void moe_order_init(Frame& F, int f, pg8::MoeOrder& S) {
    int acc = 0, t[NE];
#pragma unroll
    for (int e = 0; e < NE; ++e) { const int c = moe_cnt(F, f, e); acc += (c + 255) >> 8; t[e] = acc; }
    S.t1 = t[0]; S.t2 = t[1]; S.t3 = t[2]; S.t4 = t[3]; S.t5 = t[4]; S.t6 = t[5]; S.t7 = t[6]; S.t8 = t[7];
    S.G = F.G; S.c = (int)blockIdx.x;
}
__device__ __forceinline__ void moe_gu_fast(Frame& F, int f, const bf16* H, bf16* ACT) {
    pg8::MoeOrder S; moe_order_init(F, f, S);
    S.list = (const int*)(F.ws + WS_MISC + MS_LIST) + (size_t)f * NE * LCAP; S.gather = true; S.splitk = 0; S.nN = 2 * FF / 256;
    if (MOE_FP8) {
        S.K = DM / 2; S.A = (const char*)(F.ws + WS_R2 + 104 * MiB); S.Bt = (const char*)((const bf16*)(F.ws + WS_W) + WE_MGU) + (size_t)f * NE * 2 * FF * DM;
        S.tstepA = (size_t)256 * DM; S.tstepB = (size_t)256 * DM; S.estepB = (size_t)2 * FF * DM;
        pg8::EpiSwigluF8 E{(unsigned char*)ACT};
        pg8::gemm_phase<pg8::EpiSwigluF8, pg8::MoeOrder, true, true>(F.lds, DM / 2, S, E);
    } else {
        S.K = DM; S.A = (const char*)H; S.Bt = (const char*)((const bf16*)(F.ws + WS_W) + WE_MGU + (size_t)f * NE * 2 * FF * DM);
        S.tstepA = (size_t)256 * DM * 2; S.tstepB = (size_t)256 * DM * 2; S.estepB = (size_t)2 * FF * DM * 2;
        pg8::EpiSwiglu E{ACT};
        pg8::gemm_phase<pg8::EpiSwiglu, pg8::MoeOrder, true>(F.lds, DM, S, E);
    }
}
__device__ __forceinline__ void moe_down_fast(Frame& F, int f, const bf16* ACT, bf16* Y) {
    pg8::MoeOrder S; moe_order_init(F, f, S);
    S.nN = DM / 256; S.list = nullptr; S.gather = false; S.splitk = (MOE_SPLITK && F.G == 256) ? MOE_NSPLIT : 0;
    const float* gwp = (const float*)(F.ws + WS_MISC + MS_GW) + (size_t)f * NE * LCAP; bf16* P = (bf16*)(F.ws + WS_R2 + 72 * MiB);
    if (MOE_FP8) {
        S.K = FF / 2; S.A = (const char*)ACT; S.Bt = (const char*)((const bf16*)(F.ws + WS_W) + WE_MD) + (size_t)f * NE * DM * FF;
        S.tstepA = (size_t)256 * FF; S.tstepB = (size_t)256 * FF; S.estepB = (size_t)DM * FF;
        pg8::EpiMoeDown E{Y, gwp, P, 1.0f / (W8S * A8S)};
        pg8::gemm_phase<pg8::EpiMoeDown, pg8::MoeOrder, false, true>(F.lds, FF / 2, S, E);
    } else {
        S.K = FF; S.A = (const char*)ACT; S.Bt = (const char*)((const bf16*)(F.ws + WS_W) + WE_MD + (size_t)f * NE * DM * FF);
        S.tstepA = (size_t)256 * FF * 2; S.tstepB = (size_t)256 * FF * 2; S.estepB = (size_t)DM * FF * 2;
        pg8::EpiMoeDown E{Y, gwp, P, 1.0f};
        pg8::gemm_phase<pg8::EpiMoeDown, pg8::MoeOrder, false>(F.lds, FF, S, E);
    }
}

struct Args { const float* in[22]; float* out; unsigned char* ws; int ph_lo, ph_hi; };
constexpr int N_PHASES = 33;

__global__ void __launch_bounds__(NTHR, 2) trunk_fwd(Args args) {
    extern __shared__ __attribute__((aligned(16))) unsigned char lds[];
    Frame F;
    F.lds = (LAS unsigned char*)lds;
    F.tid = threadIdx.x; F.lane = F.tid & 63; F.wave = __builtin_amdgcn_readfirstlane(F.tid >> 6); F.G = gridDim.x;
    F.ws = args.ws; F.ctl = (gu32*)(args.ws + WS_CTL); F.out = args.out;
    if (F.tid == 0) {
#pragma unroll
        for (int i = 0; i < 22; ++i) ((LAS unsigned long long*)(F.lds + PTR_OFF))[i] = (unsigned long long)args.in[i];
    }
    volatile LAS unsigned* MISC = (volatile LAS unsigned*)(F.lds + MISC_OFF);
    if (F.tid < 32) MISC[F.tid] = 0u;
    __syncthreads();
    XcdBarrier bar; bar.bar = (unsigned*)(F.ctl + CW_BAR); bar.x = 0; bar.st = nullptr;
    const int lo = args.ph_lo, hi = args.ph_hi;
    if (hi - lo > 1) bar = xcd_barrier_post((unsigned*)(F.ctl + CW_BAR), MISC + 8);
#ifndef PHSEL
#define PHSEL 0xFFFFFFFFFFFFFFFFull
#endif
#define IN(k) (lo <= (k) && (k) < hi && ((PHSEL >> (k)) & 1ull) && relaunder(F))
#define SEAM(k) do { if (IN((k) + 1) && IN(k)) xcd_barrier(bar); } while (0)
#ifndef DUPMASK
#define DUPMASK 0ull
#endif
#define DUP(k) (((DUPMASK >> (k)) & 1ull) != 0ull)

    bf16* H = (bf16*)(F.ws + WS_H);
    bf16* PROJ = (bf16*)(F.ws + WS_R1);
    bf16* ACT = (bf16*)(F.ws + WS_R1);
    bf16* O = (bf16*)(F.ws + WS_R2);
    bf16* Y = (bf16*)(F.ws + WS_R2);
    bf16* OG = (bf16*)(F.ws + WS_R2 + 32 * MiB);
    float* ST = (float*)(F.ws + WS_R2 + 128 * MiB);
    float* X = F.out;
    float* DUMMY = (float*)(F.ws + WS_R2 + 32 * MiB);
    const float* cum = (const float*)(F.ws + WS_MISC + MS_CUM);

    const bf16* WB = (const bf16*)(F.ws + WS_W);
    enum { PH_BASE = __COUNTER__ + 1 };
#define PHASE(...) { constexpr int k_ = __COUNTER__ - PH_BASE; if (IN(k_)) { __VA_ARGS__; if (DUP(k_)) { xcd_barrier(bar); __VA_ARGS__; } SEAM(k_); } }
    PHASE({ unsigned* z = (unsigned*)(F.ws + WS_MISC + MS_LIST);
            for (int i = blockIdx.x * NTHR + F.tid; i < (int)(2 * MiB / 4); i += F.G * NTHR) z[i] = 0u;
            convert_weights(F); })
    PHASE(norm_phase<0>(F, INP(0), nullptr, INP(13) + 0 * DM, H, 0, 0, nullptr, nullptr, nullptr))
    PHASE({ pg8::EpiPlanes E{PROJ, C2}; dense_gemm(F, H, WB + WE_QKV, 3 * DM, DM, E); })
    PHASE(att::causal_phase<0>((att::lptr)F.lds, F.G, PROJ, PROJ + PLANE, PROJ + 2 * PLANE, O, nullptr))
    PHASE({ pg8::EpiResid E{INP(0), X}; dense_gemm(F, O, WB + WE_WO_SB, DM, DM, E); })
    PHASE(norm_phase<0>(F, X, nullptr, INP(14) + 0 * DM, H, 0, 0, nullptr, nullptr, nullptr))
    PHASE({ pg8::EpiSwiglu E{ACT}; dense_gemm(F, H, WB + WE_GU, 2 * FF, DM, E); })
    PHASE({ pg8::EpiResid E{X, X}; dense_gemm(F, ACT, WB + WE_D, DM, FF, E); })
    PHASE(norm_phase<0>(F, X, nullptr, INP(13) + 1 * DM, H, 0, 0, nullptr, nullptr, nullptr))
    PHASE({ pg8::EpiQKNorm E{PROJ, INP(4), INP(5), 6}; dense_gemm(F, H, WB + WE_IN_DIL, 7 * DM, DM, E); })
    PHASE(att::dil_phase((att::lptr)F.lds, F.G, PROJ, OG, ST, INP(12)))
    PHASE(att::dil_merge(F.G, OG, ST, O))
    PHASE({ pg8::EpiResid E{X, X}; dense_gemm(F, O, WB + WE_WO_DIL, DM, DM, E); })
    PHASE(norm_phase<4>(F, X, nullptr, INP(14) + 1 * DM, H, 0, 0, nullptr, nullptr, INP(18) + 0 * DM * NE))
    PHASE(moe_finalize(F, 0))
    PHASE(moe_gu_fast(F, 0, H, ACT))
    PHASE(moe_down_fast(F, 0, ACT, Y))
    PHASE(norm_phase<1 | 2>(F, X, X, INP(13) + 2 * DM, H, 0, 0, INP(7), INP(8), nullptr))
    PHASE({ cumsum_phase(F); pg8::EpiQKNorm E{PROJ, INP(9), INP(10), 2}; dense_gemm(F, H, WB + WE_IN_FOX, 3 * DM, DM, E); })
    PHASE(att::causal_phase<2>((att::lptr)F.lds, F.G, PROJ, PROJ + PLANE, PROJ + 2 * PLANE, O, cum))
    PHASE({ pg8::EpiResid E{X, X}; dense_gemm(F, O, WB + WE_WO_FOX, DM, DM, E); })
    PHASE(norm_phase<0>(F, X, nullptr, INP(14) + 2 * DM, H, 0, 0, nullptr, nullptr, nullptr))
    PHASE({ pg8::EpiSwiglu E{ACT}; dense_gemm(F, H, WB + WE_GU + (size_t)2 * FF * DM, 2 * FF, DM, E); })
    PHASE({ pg8::EpiResid E{X, X}; dense_gemm(F, ACT, WB + WE_D + (size_t)DM * FF, DM, FF, E); })
    PHASE(norm_phase<0>(F, X, nullptr, INP(13) + 3 * DM, H, 0, 0, nullptr, nullptr, nullptr))
    PHASE({ pg8::EpiPlanes E{PROJ, C2}; dense_gemm(F, H, WB + WE_QKV + (size_t)3 * DM * DM, 3 * DM, DM, E); })
    PHASE(att::causal_phase<0>((att::lptr)F.lds, F.G, PROJ, PROJ + PLANE, PROJ + 2 * PLANE, O, nullptr))
    PHASE({ pg8::EpiResid E{X, X}; dense_gemm(F, O, WB + WE_WO_SB + (size_t)DM * DM, DM, DM, E); })
    PHASE(norm_phase<4>(F, X, nullptr, INP(14) + 3 * DM, H, 0, 1, nullptr, nullptr, INP(18) + 1 * DM * NE))
    PHASE(moe_finalize(F, 1))
    PHASE(moe_gu_fast(F, 1, H, ACT))
    PHASE(moe_down_fast(F, 1, ACT, Y))
    PHASE(final_combine(F, 1))
    static_assert(__COUNTER__ - PH_BASE == N_PHASES, "N_PHASES must equal the number of PHASE() sites");
#undef PHASE
#undef IN
#undef SEAM
}

extern "C" void kernel_launch(void* const* d_in, const int* in_sizes, int n_in, void* d_out, int out_size, void* d_ws, size_t ws_size, hipStream_t stream) {
    static int grid = 0;
    if (grid == 0) {
        if (n_in != 22 || out_size != M * DM || ws_size < WS_END) { fprintf(stderr, "kernel_launch: unexpected shapes (n_in %d out %d ws %zu)\n", n_in, out_size, ws_size); grid = -1; return; }
        int dev = 0, cus = 0, per_cu = 0;
        if (hipGetDevice(&dev) != hipSuccess || hipDeviceGetAttribute(&cus, hipDeviceAttributeMultiprocessorCount, dev) != hipSuccess) { grid = -1; return; }
        if (hipFuncSetAttribute((const void*)trunk_fwd, hipFuncAttributeMaxDynamicSharedMemorySize, LDS_BYTES) != hipSuccess) { fprintf(stderr, "kernel_launch: hipFuncSetAttribute failed\n"); grid = -1; return; }
        if (hipOccupancyMaxActiveBlocksPerMultiprocessor(&per_cu, (const void*)trunk_fwd, NTHR, LDS_BYTES) != hipSuccess || per_cu < 1) fprintf(stderr, "kernel_launch: occupancy query says %d\n", per_cu);
        (void)hipGetLastError();
        grid = cus;
    }
    if (grid < 0) return;
    (void)hipMemsetAsync((char*)d_ws + WS_CTL, 0, CTL_ZERO_BYTES, stream);
    Args a{};
    for (int i = 0; i < 22; ++i) a.in[i] = (const float*)d_in[i];
    a.out = (float*)d_out; a.ws = (unsigned char*)d_ws;
#if MK_MULTI
    for (int p = 0; p < N_PHASES; ++p) { a.ph_lo = p; a.ph_hi = p + 1; hipLaunchKernelGGL(trunk_fwd, dim3(grid), dim3(NTHR), LDS_BYTES, stream, a); }
#else
    a.ph_lo = 0; a.ph_hi = N_PHASES;
    hipLaunchKernelGGL(trunk_fwd, dim3(grid), dim3(NTHR), LDS_BYTES, stream, a);
#endif
}
```

```cpp
#include <hip/hip_runtime.h>
#include <cstdio>
#include <cstdint>

#ifndef MK_MULTI
#define MK_MULTI 0
#endif

constexpr int BATCH = 8, SEQ = 2048, DM = 1024, NH = 16, HD = 64, FF = 3584, NE = 8;
constexpr int M = BATCH * SEQ;
constexpr float RMS_EPS = 1e-6f;
constexpr float LOG2E = 1.4426950408889634f;
constexpr float C2 = 0.125f * LOG2E;
constexpr int NWAVES = 8, NTHR = 512;
constexpr int LCAP = 16384;
constexpr int MAXROWS = 34816;
constexpr bool MOE_SPLITK = true;
constexpr bool MOE_FP8 = true;
constexpr bool DENSE_FP8_L0 = false, DENSE_FP8_L2 = true;
constexpr float W8S = 32.0f, A8S = 4.0f;
constexpr int MOE_NSPLIT = MOE_FP8 ? 2 : 4;
constexpr int SPLIT_ROW0 = 32768, SPLIT_ROWS = MAXROWS - SPLIT_ROW0;

constexpr size_t MiB = 1u << 20;
constexpr size_t WS_CTL = 0, CTL_ZERO_BYTES = 1 * MiB;
constexpr size_t WS_MISC = 1 * MiB;
constexpr size_t WS_H = 6 * MiB;
constexpr size_t WS_R1 = 38 * MiB;
constexpr size_t WS_R2 = 278 * MiB;
constexpr size_t WS_W = 414 * MiB;
constexpr size_t WS_END = 832 * MiB;
constexpr size_t PLANE = (size_t)M * DM;
constexpr size_t WE_QKV = 0;
constexpr size_t WE_WO_SB = WE_QKV + 2ull * 3072 * 1024;
constexpr size_t WE_WO_DIL = WE_WO_SB + 2ull * 1024 * 1024;
constexpr size_t WE_WO_FOX = WE_WO_DIL + 1024ull * 1024;
constexpr size_t WE_IN_DIL = WE_WO_FOX + 1024ull * 1024;
constexpr size_t WE_IN_FOX = WE_IN_DIL + 7168ull * 1024;
constexpr size_t WE_GU = WE_IN_FOX + 3072ull * 1024;
constexpr size_t WE_D = WE_GU + 2ull * 7168 * 1024;
constexpr size_t WE_MGU = WE_D + 2ull * 1024 * 3584;
constexpr size_t WE_MD = WE_MGU + 16ull * 7168 * 1024;
constexpr size_t WE_END = WE_MD + 16ull * 1024 * 3584;
static_assert(WS_W + WE_END * 2 <= WS_END, "weight copies fit");
constexpr size_t MS_LIST = 0;
constexpr size_t MS_GW = 1 * MiB;
constexpr size_t MS_TOK = 2 * MiB;
constexpr size_t MS_LOGF = 2 * MiB + 256 * 1024;
constexpr size_t MS_CUM = 3 * MiB + 256 * 1024;
constexpr size_t MS_SEL = 4 * MiB + 256 * 1024;
constexpr size_t MS_SG = MS_SEL + 256 * 1024;
constexpr size_t MS_LC = MS_SG + 256 * 1024;
constexpr int CW_BAR = 4096;
constexpr int CW_CNT = 64;

#define GAS __attribute__((address_space(1)))
#define LAS __attribute__((address_space(3)))
typedef unsigned short bf16;
typedef unsigned v4u __attribute__((ext_vector_type(4)));
typedef unsigned v2u __attribute__((ext_vector_type(2)));
typedef float f32x4 __attribute__((ext_vector_type(4)));
typedef float f32x2 __attribute__((ext_vector_type(2)));
typedef GAS unsigned gu32;
#define RLX_AGENT __ATOMIC_RELAXED, __HIP_MEMORY_SCOPE_AGENT
__device__ __forceinline__ unsigned f2bf(float f) { unsigned u = __builtin_bit_cast(unsigned, f); return (u + 0x7fffu + ((u >> 16) & 1u)) >> 16; }
__device__ __forceinline__ unsigned pk2(float lo, float hi) { return f2bf(lo) | (f2bf(hi) << 16); }
__device__ __forceinline__ float bflo(unsigned u) { return __builtin_bit_cast(float, u << 16); }
__device__ __forceinline__ float bfhi(unsigned u) { return __builtin_bit_cast(float, u & 0xffff0000u); }

#define XB_TMO      128
#define XB_XCNT(j)  (256  + 64 * (j))
#define XB_XSUB(j)  (1280 + 64 * (j))
#define XB_XGEN(j)  (2304 + 64 * (j))
#define XB_TOP      3328
#define XB_TOPGEN   3392
#define XCD_BAR_WORDS 3456
#define XB_SPIN_CAP (1u << 22)
__device__ __forceinline__ unsigned xb_ld(unsigned* p)              { return __hip_atomic_load(p, __ATOMIC_RELAXED, __HIP_MEMORY_SCOPE_AGENT); }
__device__ __forceinline__ unsigned xb_add(unsigned* p, unsigned v) { return __hip_atomic_fetch_add(p, v, __ATOMIC_RELAXED, __HIP_MEMORY_SCOPE_AGENT); }
__device__ __forceinline__ unsigned xb_xcc_id() { return (unsigned)__builtin_amdgcn_s_getreg((3 << 11) | 20) & 0xFu; }
#define XB_SPIN(cond, bar) do { unsigned _sp = 0; while (cond) { __builtin_amdgcn_s_sleep(1); \
    if ((++_sp & 255u) == 0u) { if (xb_ld(&(bar)[XB_TMO])) break; if (_sp > XB_SPIN_CAP) { atomicAdd(&(bar)[XB_TMO], 1u); break; } } } } while (0)
struct XcdBarrier { unsigned* bar; unsigned x; volatile LAS unsigned* st; };
__device__ __forceinline__ XcdBarrier xcd_barrier_post(unsigned* bar, volatile LAS unsigned* st) {
    XcdBarrier b; b.bar = bar; b.x = xb_xcc_id(); b.st = st;
    if (threadIdx.x == 0) (void)xb_add(&bar[XB_XCNT(b.x)], 1u);
    return b;
}
__device__ __forceinline__ void xcd_barrier_complete(unsigned* bar, unsigned x, unsigned& nloc, unsigned& nx) {
    const unsigned G = gridDim.x * gridDim.y * gridDim.z;
    unsigned sum, cnt, mine, sp = 0u;
    for (;;) {
        sum = 0u; cnt = 0u; mine = 0u;
#pragma unroll
        for (unsigned j = 0; j < 16; ++j) { const unsigned c = xb_ld(&bar[XB_XCNT(j)]); sum += c; cnt += (c > 0u) ? 1u : 0u; mine = (j == x) ? c : mine; }
        if (sum == G) break;
        __builtin_amdgcn_s_sleep(1);
        if ((++sp & 255u) == 0u) { if (xb_ld(&bar[XB_TMO])) break; if (sp > XB_SPIN_CAP) { atomicAdd(&bar[XB_TMO], 1u); break; } }
    }
    nloc = mine > 0u ? mine : 1u; nx = cnt > 0u ? cnt : 1u;
}
__device__ __forceinline__ void xcd_barrier(const XcdBarrier& b) {
    asm volatile("s_waitcnt vmcnt(0)" ::: "memory");
    __syncthreads();
    if (threadIdx.x == 0) {
        unsigned* bar = b.bar;
        __builtin_amdgcn_s_waitcnt(0);
        unsigned nloc = b.st[0], nx = b.st[1];
        if (nloc == 0u) { xcd_barrier_complete(bar, b.x, nloc, nx); b.st[0] = nloc; b.st[1] = nx; }
        const unsigned old = xb_add(&bar[XB_XSUB(b.x)], 1u);
        const unsigned gen = old / nloc;
        if (old + 1u == (gen + 1u) * nloc) {
            __builtin_amdgcn_fence(__ATOMIC_RELEASE, "agent");
            asm volatile("s_waitcnt vmcnt(0)" ::: "memory");
            const unsigned og = xb_add(&bar[XB_TOP], 1u);
            const unsigned tg = og / nx;
            if (og + 1u == (tg + 1u) * nx) xb_add(&bar[XB_TOPGEN], 1u);
            else XB_SPIN(xb_ld(&bar[XB_TOPGEN]) == tg, bar);
            __builtin_amdgcn_fence(__ATOMIC_ACQUIRE, "agent");
            xb_add(&bar[XB_XGEN(b.x)], 1u);
            asm volatile("s_waitcnt vmcnt(0)" ::: "memory");
        } else {
            XB_SPIN(xb_ld(&bar[XB_XGEN(b.x)]) == gen, bar);
            __builtin_amdgcn_fence(__ATOMIC_ACQUIRE, "agent");
            asm volatile("s_waitcnt vmcnt(0)" ::: "memory");
        }
    }
    __syncthreads();
}

constexpr int LDS_BYTES = 147456;
constexpr int ATT_LDS_MAX = 143360;
constexpr int MISC_OFF = ATT_LDS_MAX + 64;
struct Frame {
    LAS unsigned char* lds;
    int tid, lane, wave, G;
    unsigned char* ws; gu32* ctl;
    float* out;
};
__device__ __forceinline__ float wave_sum(float v) {
#pragma unroll
    for (int o = 1; o < 64; o <<= 1) v += __shfl_xor(v, o);
    return v;
}

constexpr int PTR_OFF = ATT_LDS_MAX + 512;
__device__ __forceinline__ const float* inp_ptr(Frame& F, int k) {
    const LAS unsigned* t = (const LAS unsigned*)(F.lds + PTR_OFF) + 2 * k;
    const unsigned lo = __builtin_amdgcn_readfirstlane(t[0]), hi = __builtin_amdgcn_readfirstlane(t[1]);
    return (const float*)(((unsigned long long)hi << 32) | lo);
}
#define INP(k) inp_ptr(F, (k))
__device__ __forceinline__ bool relaunder(Frame& F) { int t_ = threadIdx.x; asm volatile("" : "+v"(t_)); F.tid = t_; F.lane = t_ & 63; F.wave = __builtin_amdgcn_readfirstlane(t_ >> 6); return true; }
namespace pg8 {
#define PG8_LAS __attribute__((address_space(3)))
typedef unsigned short bf16_t;
typedef short bf16x8 __attribute__((ext_vector_type(8)));
typedef unsigned u32x4 __attribute__((ext_vector_type(4)));
constexpr int BM = 256, BK = 64, HALF = 128, HTB = HALF * BK * 2, STAGE_BYTES = 8 * HTB, NXCD = 8, WGM = 8;
__host__ __device__ __forceinline__ int lds_byte(int r, int c) { const int st = (r >> 4) * 2 + (c >> 5), rr = r & 15, cc = c & 31, ob = rr * 64 + cc * 2; return st * 1024 + (ob ^ (((ob >> 9) & 1) << 5)); }
__host__ __device__ __forceinline__ void stage_rc(int b, int& R, int& C) { const int st = b / 1024, sb = b % 1024, swz = sb ^ (((sb >> 9) & 1) << 5); R = (st >> 1) * 16 + swz / 64; C = (st & 1) * 32 + (swz % 64) / 2; }
__host__ __device__ __forceinline__ int perm32(int rho) { const int n = rho >> 4, i = rho & 15; return 8 * (i >> 2) + 4 * n + (i & 3); }
struct Unit { int pm, pn, e, mt, nt, koff, kq; };

struct DenseOrder {
    int nM, nN, nwg, G, c, ntk; const char* A; const char* Bt; size_t tstep;
    __device__ __forceinline__ void init(const bf16_t* A_, const bf16_t* Bt_, int M_, int N_, int K_, int G_, int c_) { nM = M_ / BM; nN = N_ / BM; nwg = nM * nN; G = G_; c = c_; ntk = K_ / BK; A = (const char*)A_; Bt = (const char*)Bt_; tstep = (size_t)BM * K_ * 2; }
    __device__ __forceinline__ bool next(int i, Unit& u) const {
        const long L = (long)i * G + c; if (L >= nwg) return false;
        int wgid = (int)L; { const int q = nwg / NXCD, r = nwg % NXCD, xcd = wgid % NXCD, off = wgid / NXCD; wgid = (xcd < r ? xcd * (q + 1) : r * (q + 1) + (xcd - r) * q) + off; }
        const int nig = WGM * nN, gid = wgid / nig, fm = gid * WGM, gsz = (nM - fm) < WGM ? (nM - fm) : WGM;
        u.pm = fm + ((wgid % nig) % gsz); u.pn = (wgid % nig) / gsz; u.e = 0; u.mt = u.pm; u.nt = ntk; u.koff = 0; u.kq = -1; return true;
    }
    __device__ __forceinline__ const char* a_base(const Unit& u) const { return A + (size_t)u.pm * tstep; }
    __device__ __forceinline__ const char* b_base(const Unit& u) const { return Bt + (size_t)u.pn * tstep; }
    __device__ __forceinline__ void a_voff(const Unit&, const int (&)[2], const int (&)[2], unsigned (&)[2][2]) const {}
};
struct MoeOrder {
    int t1, t2, t3, t4, t5, t6, t7, t8, nN, G, c, K; const char* A; const char* Bt; size_t tstepA, tstepB, estepB; const int* list; bool gather; int splitk;
    __device__ __forceinline__ bool next(int i, Unit& u) const {
        const int X = i * G + c, U = t8 * nN; int L = X; u.nt = K / BK; u.koff = 0; u.kq = -1;
        if (splitk) { const int nfull = (U / G) * G;
            if (X >= nfull) { const int q = X - nfull; if (q >= splitk * (U - nfull)) return false; L = nfull + q / splitk; u.kq = q % splitk; u.nt = K / BK / splitk; u.koff = u.kq * (K / splitk) * 2; } }
        else if (X >= U) return false;
        const int mt = L / nN; u.pm = mt; u.pn = L - mt * nN;
        const int e = (mt >= t1) + (mt >= t2) + (mt >= t3) + (mt >= t4) + (mt >= t5) + (mt >= t6) + (mt >= t7);
        const int tb = e == 0 ? 0 : e == 1 ? t1 : e == 2 ? t2 : e == 3 ? t3 : e == 4 ? t4 : e == 5 ? t5 : e == 6 ? t6 : t7;
        u.e = e; u.mt = mt - tb; return true;
    }
    __device__ __forceinline__ const char* a_base(const Unit& u) const { return (gather ? A : A + (size_t)u.pm * tstepA) + u.koff; }
    __device__ __forceinline__ const char* b_base(const Unit& u) const { return Bt + (size_t)u.e * estepB + (size_t)u.pn * tstepB + u.koff; }
    __device__ __forceinline__ void a_voff(const Unit& u, const int (&sR)[2], const int (&sC)[2], unsigned (&v)[2][2]) const {
        const int* lp = list + u.e * LCAP + u.mt * 256;
#pragma unroll
        for (int h = 0; h < 2; ++h)
#pragma unroll
            for (int i = 0; i < 2; ++i) v[h][i] = (unsigned)lp[h * 128 + sR[i]] * (unsigned)(K * 2) + (unsigned)(sC[i] * 2);
    }
};

typedef int v8i32 __attribute__((ext_vector_type(8)));
typedef int v4i32 __attribute__((ext_vector_type(4)));
__device__ __forceinline__ v8i32 cat8(bf16x8 a, bf16x8 b) { const v4i32 x = __builtin_bit_cast(v4i32, a), y = __builtin_bit_cast(v4i32, b); return (v8i32){x[0], x[1], x[2], x[3], y[0], y[1], y[2], y[3]}; }
__device__ __forceinline__ unsigned cvt4_fp8(float a, float b, float c, float d) { int w = 0; w = __builtin_amdgcn_cvt_pk_fp8_f32(a, b, w, false); w = __builtin_amdgcn_cvt_pk_fp8_f32(c, d, w, true); return (unsigned)w; }
__device__ __forceinline__ const char* uniptr(const char* p) { const unsigned long long v = (unsigned long long)p; const unsigned lo = __builtin_amdgcn_readfirstlane((unsigned)v), hi = __builtin_amdgcn_readfirstlane((unsigned)(v >> 32)); return (const char*)(((unsigned long long)hi << 32) | lo); }
__device__ __forceinline__ void glds16_s(const char* sbase, unsigned voff, unsigned lds_dst) { unsigned keep;
    asm volatile("s_mov_b32 %0, m0\n\ts_mov_b32 m0, %3\n\ts_nop 0\n\tglobal_load_lds_dwordx4 %2, %1\n\ts_mov_b32 m0, %0" : "=&s"(keep) : "s"(sbase), "v"(voff), "s"(lds_dst) : "memory"); }
__device__ __forceinline__ unsigned cvt_pk_bf16(float lo, float hi) { unsigned r; asm volatile("v_cvt_pk_bf16_f32 %0, %1, %2" : "=v"(r) : "v"(lo), "v"(hi)); return r; }

struct EpiPlanes {
    static constexpr bool PERM = true;
    bf16_t* O; float scale0;
    __device__ __forceinline__ void operator()(const f32x4 (&acc)[2][2][4][2], const Unit& u, int wr, int wc, int fr, int fq) const {
        const int plane = u.pn >> 2; const float sc = plane == 0 ? scale0 : 1.f;
        bf16_t* base = O + (size_t)plane * PLANE + (size_t)(u.pm * BM + wr * 64 + fr) * DM + (u.pn & 3) * 256 + wc * 32 + 8 * fq;
#pragma unroll
        for (int ai = 0; ai < 2; ++ai)
#pragma unroll
            for (int m = 0; m < 4; ++m) { bf16_t* rowp = base + (size_t)(ai * HALF + m * 16) * DM;
#pragma unroll
                for (int bj = 0; bj < 2; ++bj) { const f32x4 v0 = acc[ai][bj][m][0] * sc, v1 = acc[ai][bj][m][1] * sc;
                    u32x4 w; w.x = cvt_pk_bf16(v0[0], v0[1]); w.y = cvt_pk_bf16(v0[2], v0[3]); w.z = cvt_pk_bf16(v1[0], v1[1]); w.w = cvt_pk_bf16(v1[2], v1[3]);
                    *(u32x4*)(rowp + bj * HALF) = w; } }
    }
};
struct EpiQKNorm {
    static constexpr bool PERM = true;
    bf16_t* O; const float* qg; const float* kg; int vplane;
    __device__ __forceinline__ void operator()(const f32x4 (&acc)[2][2][4][2], const Unit& u, int wr, int wc, int fr, int fq) const {
        const int plane = u.pn >> 2; const bool isv = plane == vplane; const bool isq = !isv && ((plane & 1) == 0); const int grp = plane >> 1;
        const float* g = (isq ? qg : kg) + grp * 64 + 8 * fq;
        f32x4 gv[2][2];
#pragma unroll
        for (int bj = 0; bj < 2; ++bj)
#pragma unroll
            for (int n = 0; n < 2; ++n) gv[bj][n] = isv ? (f32x4){1.f, 1.f, 1.f, 1.f} : *(const f32x4*)(g + 32 * bj + 4 * n);
        const float mul = isq ? C2 : 1.f;
        bf16_t* base = O + (size_t)plane * PLANE + (size_t)(u.pm * BM + wr * 64 + fr) * DM + (u.pn & 3) * 256 + wc * 64 + 8 * fq;
#pragma unroll
        for (int ai = 0; ai < 2; ++ai)
#pragma unroll
            for (int m = 0; m < 4; ++m) { bf16_t* rowp = base + (size_t)(ai * HALF + m * 16) * DM;
                float ss = 0.f;
#pragma unroll
                for (int bj = 0; bj < 2; ++bj)
#pragma unroll
                    for (int n = 0; n < 2; ++n) { const f32x4 x = acc[ai][bj][m][n]; ss += (x[0] * x[0] + x[1] * x[1]) + (x[2] * x[2] + x[3] * x[3]); }
                ss += __shfl_xor(ss, 16); ss += __shfl_xor(ss, 32);
                const float inv = isv ? 1.f : mul / sqrtf(ss * (1.f / 64.f) + RMS_EPS);
#pragma unroll
                for (int bj = 0; bj < 2; ++bj) { const f32x4 v0 = acc[ai][bj][m][0] * inv * gv[bj][0], v1 = acc[ai][bj][m][1] * inv * gv[bj][1];
                    u32x4 w; w.x = cvt_pk_bf16(v0[0], v0[1]); w.y = cvt_pk_bf16(v0[2], v0[3]); w.z = cvt_pk_bf16(v1[0], v1[1]); w.w = cvt_pk_bf16(v1[2], v1[3]);
                    *(u32x4*)(rowp + bj * 32) = w; } }
    }
};
struct EpiSwiglu {
    static constexpr bool PERM = true;
    bf16_t* O;
    __device__ __forceinline__ void operator()(const f32x4 (&acc)[2][2][4][2], const Unit& u, int wr, int wc, int fr, int fq) const {
        bf16_t* base = O + (size_t)(u.pm * BM + wr * 64 + fr) * FF + u.pn * 128 + wc * 32 + 8 * fq;
#pragma unroll
        for (int ai = 0; ai < 2; ++ai)
#pragma unroll
            for (int m = 0; m < 4; ++m) { bf16_t* rowp = base + (size_t)(ai * HALF + m * 16) * FF;
                float o[8];
#pragma unroll
                for (int n = 0; n < 2; ++n)
#pragma unroll
                    for (int i = 0; i < 4; ++i) { const float g = acc[ai][0][m][n][i], uu = acc[ai][1][m][n][i];
                        o[n * 4 + i] = g * __builtin_amdgcn_rcpf(1.0f + __builtin_amdgcn_exp2f(-g * LOG2E)) * uu; }
                u32x4 w; w.x = cvt_pk_bf16(o[0], o[1]); w.y = cvt_pk_bf16(o[2], o[3]); w.z = cvt_pk_bf16(o[4], o[5]); w.w = cvt_pk_bf16(o[6], o[7]);
                *(u32x4*)rowp = w; }
    }
};
struct EpiSwigluF8 {
    static constexpr bool PERM = true;
    unsigned char* O;
    __device__ __forceinline__ void operator()(const f32x4 (&acc)[2][2][4][2], const Unit& u, int wr, int wc, int fr, int fq) const {
        unsigned char* base = O + (size_t)(u.pm * BM + wr * 64 + fr) * FF + u.pn * 128 + wc * 32 + 8 * fq;
#pragma unroll
        for (int ai = 0; ai < 2; ++ai)
#pragma unroll
            for (int m = 0; m < 4; ++m) { unsigned char* rowp = base + (size_t)(ai * HALF + m * 16) * FF;
                float o[8];
#pragma unroll
                for (int n = 0; n < 2; ++n)
#pragma unroll
                    for (int i = 0; i < 4; ++i) { const float g = acc[ai][0][m][n][i] * (1.0f / W8S), uu = acc[ai][1][m][n][i] * (A8S / W8S);
                        o[n * 4 + i] = g * __builtin_amdgcn_rcpf(1.0f + __builtin_amdgcn_exp2f(-g * LOG2E)) * uu; }
                v2u w; w.x = cvt4_fp8(o[0], o[1], o[2], o[3]); w.y = cvt4_fp8(o[4], o[5], o[6], o[7]);
                *(v2u*)rowp = w; }
    }
};
struct EpiResid {
    static constexpr bool PERM = false;
    const float* base; float* out; float oscale;
    __device__ __forceinline__ void operator()(const f32x4 (&acc)[2][2][4][2], const Unit& u, int wr, int wc, int fr, int fq) const {
        const size_t off0 = (size_t)(u.pm * BM + wr * 64 + fr) * DM + u.pn * BM + wc * 32 + 4 * fq;
#pragma unroll
        for (int ai = 0; ai < 2; ++ai)
#pragma unroll
            for (int m = 0; m < 4; ++m) { const size_t off = off0 + (size_t)(ai * HALF + m * 16) * DM;
#pragma unroll
                for (int bj = 0; bj < 2; ++bj)
#pragma unroll
                    for (int n = 0; n < 2; ++n) { const f32x4 b = *(const f32x4*)(base + off + bj * HALF + n * 16); *(f32x4*)(out + off + bj * HALF + n * 16) = b + acc[ai][bj][m][n] * oscale; } }
    }
};
struct EpiMoeDown {
    static constexpr bool PERM = true;
    bf16_t* Y; const float* gw; bf16_t* P; float oscale;
    __device__ __forceinline__ void operator()(const f32x4 (&acc)[2][2][4][2], const Unit& u, int wr, int wc, int fr, int fq) const {
        bf16_t* base = (u.kq < 0 ? Y + (size_t)(u.pm * BM) * DM : P + ((size_t)u.kq * SPLIT_ROWS + (size_t)(u.pm * BM - SPLIT_ROW0)) * DM) + (size_t)(wr * 64 + fr) * DM + u.pn * BM + wc * 32 + 8 * fq;
        const float* gp = gw + u.e * LCAP + u.mt * 256 + wr * 64 + fr;
#pragma unroll
        for (int ai = 0; ai < 2; ++ai)
#pragma unroll
            for (int m = 0; m < 4; ++m) { bf16_t* rowp = base + (size_t)(ai * HALF + m * 16) * DM; const float g = gp[ai * HALF + m * 16] * oscale;
#pragma unroll
                for (int bj = 0; bj < 2; ++bj) { const f32x4 v0 = acc[ai][bj][m][0] * g, v1 = acc[ai][bj][m][1] * g;
                    u32x4 w; w.x = cvt_pk_bf16(v0[0], v0[1]); w.y = cvt_pk_bf16(v0[2], v0[3]); w.z = cvt_pk_bf16(v1[0], v1[1]); w.w = cvt_pk_bf16(v1[2], v1[3]);
                    *(u32x4*)(rowp + bj * HALF) = w; } }
    }
};

template <class Epi, class Sched, bool GATHER, bool FP8 = false>
__device__ __forceinline__ void gemm_phase(PG8_LAS unsigned char* lds, const int K, const Sched& S, const Epi& E) {
    const int tid = threadIdx.x, wid = __builtin_amdgcn_readfirstlane(tid >> 6), lane = tid & 63, wr = wid >> 2, wc = wid & 3, fr = lane & 15, fq = lane >> 4;
    unsigned voffA[2], voffB[2]; int sR[2], sC[2];
#pragma unroll
    for (int i = 0; i < 2; ++i) { int R, C; stage_rc(tid * 16 + i * 8192, R, C); const int Rb = Epi::PERM ? ((R & ~31) + perm32(R & 31)) : R;
        voffA[i] = (unsigned)(R * K + C) * 2u; voffB[i] = (unsigned)(Rb * K + C) * 2u; sR[i] = R; sC[i] = C; }
    const size_t kstep = (size_t)(BK * 2);
    const size_t hstep = (size_t)HALF * K * 2;
    const unsigned ldsw = (unsigned)wid * 1024u, lds0 = (unsigned)(uintptr_t)lds;
    const int aoff = FP8 ? lds_byte(wr * 64 + fr, fq * 16) : lds_byte(wr * 64 + fr, fq * 8), boff = FP8 ? lds_byte(wc * 32 + fr, fq * 16) : lds_byte(wc * 32 + fr, fq * 8);

#define PG8_SA(b, h) (((b) * 2 + (h)) * HTB)
#define PG8_SB(b, h) ((4 + (b) * 2 + (h)) * HTB)
#define PG8_STAGE(bufoff, gbase, voff) do { const char* gb_ = uniptr((const char*)(gbase)); _Pragma("unroll") for (int _i = 0; _i < 2; ++_i) \
        glds16_s(gb_, (voff)[_i], (unsigned)__builtin_amdgcn_readfirstlane(lds0 + (unsigned)(bufoff) + ldsw + (unsigned)(_i * 8192))); } while (0)
#define PG8_STAGE_A(bufoff, p, h, VG) do { if (GATHER) { PG8_STAGE(bufoff, p, VG[h]); } else { PG8_STAGE(bufoff, (p) + ((h) ? hstep : 0), voffA); } } while (0)
#define PG8_LDA(dst, b, h) do { _Pragma("unroll") for (int m = 0; m < 4; ++m) { if constexpr (FP8) { const v4i32 x_ = *(const PG8_LAS v4i32*)(lds + PG8_SA(b, h) + aoff + m * 2048), y_ = *(const PG8_LAS v4i32*)(lds + PG8_SA(b, h) + aoff + m * 2048 + 16); dst##8[m] = __builtin_shufflevector(x_, y_, 0, 1, 2, 3, 4, 5, 6, 7); } \
        else { _Pragma("unroll") for (int k = 0; k < 2; ++k) dst[m][k] = *(const PG8_LAS bf16x8*)(lds + PG8_SA(b, h) + aoff + m * 2048 + k * 1024); } } } while (0)
#define PG8_LDB(dst, b, h) do { _Pragma("unroll") for (int n = 0; n < 2; ++n) { if constexpr (FP8) { const v4i32 x_ = *(const PG8_LAS v4i32*)(lds + PG8_SB(b, h) + boff + n * 2048), y_ = *(const PG8_LAS v4i32*)(lds + PG8_SB(b, h) + boff + n * 2048 + 16); dst##8[n] = __builtin_shufflevector(x_, y_, 0, 1, 2, 3, 4, 5, 6, 7); } \
        else { _Pragma("unroll") for (int k = 0; k < 2; ++k) dst[n][k] = *(const PG8_LAS bf16x8*)(lds + PG8_SB(b, h) + boff + n * 2048 + k * 1024); } } } while (0)
#define PG8_MMA(ai, bj, At, Bt) do { __builtin_amdgcn_s_setprio(1); _Pragma("unroll") for (int m = 0; m < 4; ++m) _Pragma("unroll") for (int n = 0; n < 2; ++n) { \
        if constexpr (FP8) asm volatile("v_mfma_scale_f32_16x16x128_f8f6f4 %0, %1, %2, %0, %3, %3 op_sel_hi:[0,0,0]" : "+v"(acc[ai][bj][m][n]) : "v"(Bt##8[n]), "v"(At##8[m]), "v"(sc8));   \
        else { _Pragma("unroll") for (int k = 0; k < 2; ++k) acc[ai][bj][m][n] = __builtin_amdgcn_mfma_f32_16x16x32_bf16(Bt[n][k], At[m][k], acc[ai][bj][m][n], 0, 0, 0); } } \
        __builtin_amdgcn_s_setprio(0); } while (0)
#define PG8_WAIT_V(n) asm volatile("s_waitcnt vmcnt(" #n ")" ::: "memory")
#define PG8_WAIT_L(n) asm volatile("s_waitcnt lgkmcnt(" #n ")" ::: "memory")
#define PG8_BAR __builtin_amdgcn_s_barrier()
#define PG8_SCHED __builtin_amdgcn_sched_barrier(0)
    Unit cur, nxt; int ui = 0;
    if (!S.next(0, cur)) return;
    f32x4 acc[2][2][4][2];
#pragma unroll
    for (int a = 0; a < 2; ++a)
#pragma unroll
        for (int b = 0; b < 2; ++b)
#pragma unroll
            for (int m = 0; m < 4; ++m)
#pragma unroll
                for (int n = 0; n < 2; ++n) acc[a][b][m][n] = (f32x4){0.f, 0.f, 0.f, 0.f};
    bf16x8 At[4][2], B0[2][2], B1[2][2];
    v8i32 At8[4], B08[2], B18[2];
    int sc8 = 0x7F7F7F7F; asm volatile("" : "+v"(sc8));
    const char* cA = S.a_base(cur); const char* cB = S.b_base(cur);
    unsigned vc[2][2] = {{0u, 0u}, {0u, 0u}}, vn[2][2] = {{0u, 0u}, {0u, 0u}};
    if (GATHER) { S.a_voff(cur, sR, sC, vc); asm volatile("s_waitcnt vmcnt(0)" : "+v"(vc[0][0]), "+v"(vc[0][1]), "+v"(vc[1][0]), "+v"(vc[1][1]) :: "memory"); }
    PG8_STAGE(PG8_SB(0, 0), cB, voffB); PG8_STAGE(PG8_SB(0, 1), cB + hstep, voffB); PG8_STAGE_A(PG8_SA(0, 0), cA, 0, vc); PG8_STAGE_A(PG8_SA(0, 1), cA, 1, vc);
    if (wr == 1) PG8_BAR;
    PG8_WAIT_V(2); PG8_BAR;
    PG8_STAGE(PG8_SB(1, 0), cB + kstep, voffB); PG8_STAGE_A(PG8_SA(1, 0), cA + kstep, 0, vc); PG8_STAGE(PG8_SB(1, 1), cB + hstep + kstep, voffB);
    PG8_WAIT_V(6); PG8_BAR;
    for (;;) {
        const bool has_next = S.next(ui + 1, nxt);
        const char* nA = has_next ? S.a_base(nxt) : cA; const char* nB = has_next ? S.b_base(nxt) : cB;
        if (GATHER) {
            if (has_next) { S.a_voff(nxt, sR, sC, vn); asm volatile("s_waitcnt vmcnt(0)" : "+v"(vn[0][0]), "+v"(vn[0][1]), "+v"(vn[1][0]), "+v"(vn[1][1]) :: "memory"); }
            else { vn[0][0] = vc[0][0]; vn[0][1] = vc[0][1]; vn[1][0] = vc[1][0]; vn[1][1] = vc[1][1]; }
        }
        const int nt = cur.nt;
        for (int t = 0; t < nt; t += 2) {
            const bool last = (t == nt - 2);
            const char* a1 = cA + (size_t)(t + 1) * kstep;
            const char* a2 = last ? nA : cA + (size_t)(t + 2) * kstep; const char* b2 = last ? nB : cB + (size_t)(t + 2) * kstep;
            const char* a3 = a2 + kstep; const char* b3 = b2 + kstep;
            unsigned v2[2][2];
#pragma unroll
            for (int h = 0; h < 2; ++h)
#pragma unroll
                for (int i = 0; i < 2; ++i) v2[h][i] = last ? vn[h][i] : vc[h][i];
            PG8_LDB(B0, 0, 0); PG8_LDB(B1, 0, 1); PG8_SCHED; PG8_LDA(At, 0, 0); PG8_STAGE_A(PG8_SA(1, 1), a1, 1, vc);
            PG8_WAIT_V(8); PG8_WAIT_L(0); PG8_BAR; PG8_MMA(0, 0, At, B0); PG8_MMA(0, 1, At, B1); PG8_BAR; PG8_SCHED;
            PG8_LDA(At, 0, 1); PG8_STAGE(PG8_SB(0, 0), b2, voffB); PG8_STAGE(PG8_SB(0, 1), b2 + hstep, voffB); PG8_STAGE_A(PG8_SA(0, 0), a2, 0, v2);
            PG8_WAIT_V(8); PG8_WAIT_L(0); PG8_BAR; PG8_MMA(1, 0, At, B0); PG8_MMA(1, 1, At, B1); PG8_BAR; PG8_SCHED;
            PG8_LDB(B0, 1, 0); PG8_LDB(B1, 1, 1); PG8_SCHED; PG8_LDA(At, 1, 0); PG8_STAGE_A(PG8_SA(0, 1), a2, 1, v2);
            PG8_WAIT_V(8); PG8_WAIT_L(0); PG8_BAR; PG8_MMA(0, 0, At, B0); PG8_MMA(0, 1, At, B1); PG8_BAR; PG8_SCHED;
            PG8_LDA(At, 1, 1); PG8_STAGE(PG8_SB(1, 0), b3, voffB); PG8_STAGE(PG8_SB(1, 1), b3 + hstep, voffB); PG8_STAGE_A(PG8_SA(1, 0), a3, 0, v2);
            PG8_WAIT_V(8); PG8_WAIT_L(0); PG8_BAR; PG8_MMA(1, 0, At, B0); PG8_MMA(1, 1, At, B1); PG8_BAR; PG8_SCHED;
        }
        if (wr == 0) PG8_BAR;
        if constexpr (FP8) asm volatile("s_nop 15\n\ts_nop 15" ::: "memory");
        { int fr_ = fr, fq_ = fq; asm volatile("" : "+v"(fr_), "+v"(fq_)); E(acc, cur, wr, wc, fr_, fq_); }
        if (!has_next) break;
#pragma unroll
        for (int a = 0; a < 2; ++a)
#pragma unroll
            for (int b = 0; b < 2; ++b)
#pragma unroll
                for (int m = 0; m < 4; ++m)
#pragma unroll
                    for (int n = 0; n < 2; ++n) acc[a][b][m][n] = (f32x4){0.f, 0.f, 0.f, 0.f};
        cur = nxt; cA = nA; cB = nB; ++ui;
        if (GATHER) { vc[0][0] = vn[0][0]; vc[0][1] = vn[0][1]; vc[1][0] = vn[1][0]; vc[1][1] = vn[1][1]; }
        if (wr == 1) PG8_BAR;
    }
    PG8_WAIT_V(0);
    PG8_BAR;
#undef PG8_SA
#undef PG8_SB
#undef PG8_STAGE
#undef PG8_STAGE_A
#undef PG8_LDA
#undef PG8_LDB
#undef PG8_MMA
#undef PG8_WAIT_V
#undef PG8_WAIT_L
#undef PG8_BAR
#undef PG8_SCHED
}
}

namespace att {
typedef short bf16x8 __attribute__((ext_vector_type(8)));
typedef short s16x4 __attribute__((ext_vector_type(4)));
typedef float f32x16 __attribute__((ext_vector_type(16)));
typedef unsigned u32x4 __attribute__((ext_vector_type(4)));
typedef LAS char* lptr;
constexpr int SLOTB = 8192, NSLOT = 6, AHEAD = 4;
constexpr int L_K = 0, L_V = NSLOT * SLOTB, L_WS = 2 * NSLOT * SLOTB, L_OST = L_WS + 8 * 256, L_KB = L_OST + 8 * 4096, L_FLG = L_KB + 8192, L_END = L_FLG + 256;
static_assert(L_END <= ATT_LDS_MAX, "attention LDS map");
constexpr float THR = 8.0f;
__device__ __forceinline__ int crow(int r, int hi) { return (r & 3) + 8 * (r >> 2) + 4 * hi; }
__device__ __forceinline__ void glds16(const void* gsrc, unsigned lds_dst) { unsigned keep;
    asm volatile("s_mov_b32 %0, m0\n\ts_mov_b32 m0, %2\n\ts_nop 0\n\tglobal_load_lds_dwordx4 %1, off\n\ts_mov_b32 m0, %0" : "=&s"(keep) : "v"(gsrc), "s"(lds_dst) : "memory"); }
typedef float f32x2_t __attribute__((ext_vector_type(2))); typedef __bf16 bf16x2_t __attribute__((ext_vector_type(2)));
__device__ __forceinline__ unsigned cvtpk(float lo, float hi) { f32x2_t v = {lo, hi}; bf16x2_t b = __builtin_convertvector(v, bf16x2_t); return __builtin_bit_cast(unsigned, b); }
__device__ __forceinline__ bf16x8 gload16(const void* p) { bf16x8 v; asm volatile("global_load_dwordx4 %0, %1, off" : "=v"(v) : "v"(p) : "memory"); return v; }
__device__ __forceinline__ float max3f(float a, float b, float c) { return __builtin_fmaxf(__builtin_fmaxf(a, b), c); }
__device__ __forceinline__ void wait_bar(int n) {
    if (n >= 6) asm volatile("s_waitcnt vmcnt(6) lgkmcnt(0)\n\ts_barrier" ::: "memory");
    else if (n >= 4) asm volatile("s_waitcnt vmcnt(4) lgkmcnt(0)\n\ts_barrier" ::: "memory");
    else if (n >= 2) asm volatile("s_waitcnt vmcnt(2) lgkmcnt(0)\n\ts_barrier" ::: "memory");
    else asm volatile("s_waitcnt vmcnt(0) lgkmcnt(0)\n\ts_barrier" ::: "memory");
}
__device__ __forceinline__ float other_half(float x, int hi) {
    auto rr = __builtin_amdgcn_permlane32_swap(__float_as_uint(x), __float_as_uint(x), false, false);
    return __uint_as_float(hi ? rr[0] : rr[1]);
}
__device__ __forceinline__ void qkt(f32x16& p0, f32x16& p1, lptr Kslot, const bf16x8* qr, const f32x16& c0, const f32x16& c1, int r32, int hi) {
    lptr kb = Kslot + hi * 1024 + r32 * 16;
#pragma unroll
    for (int d0 = 0; d0 < 4; ++d0) {
        const bf16x8 b0 = *(const LAS bf16x8*)(kb + d0 * 2048);
        const bf16x8 b1 = *(const LAS bf16x8*)(kb + d0 * 2048 + 512);
        if (d0 == 0) { p0 = __builtin_amdgcn_mfma_f32_32x32x16_bf16(b0, qr[0], c0, 0, 0, 0); p1 = __builtin_amdgcn_mfma_f32_32x32x16_bf16(b1, qr[0], c1, 0, 0, 0); }
        else { p0 = __builtin_amdgcn_mfma_f32_32x32x16_bf16(b0, qr[d0], p0, 0, 0, 0); p1 = __builtin_amdgcn_mfma_f32_32x32x16_bf16(b1, qr[d0], p1, 0, 0, 0); } }
}
__device__ __forceinline__ void pv(f32x16* o, int vb, bf16x8 pa0, bf16x8 pa1, bf16x8 pa2, bf16x8 pa3) {
#pragma unroll
    for (int d0 = 0; d0 < 2; ++d0) { s16x4 lo[4], hi[4];
#pragma unroll
        for (int ks = 0; ks < 4; ++ks) {
            asm volatile("ds_read_b64_tr_b16 %0,%1 offset:%c2" : "=&v"(lo[ks]) : "v"(vb), "i"(d0 * 4096 + ks * 1024) : "memory");
            asm volatile("ds_read_b64_tr_b16 %0,%1 offset:%c2" : "=&v"(hi[ks]) : "v"(vb), "i"(d0 * 4096 + ks * 1024 + 512) : "memory"); }
        asm volatile("s_waitcnt lgkmcnt(0)" ::: "memory"); __builtin_amdgcn_sched_barrier(0);
#define ATT_PK(k) (bf16x8){lo[k][0], lo[k][1], lo[k][2], lo[k][3], hi[k][0], hi[k][1], hi[k][2], hi[k][3]}
        o[d0] = __builtin_amdgcn_mfma_f32_32x32x16_bf16(pa0, ATT_PK(0), o[d0], 0, 0, 0);
        o[d0] = __builtin_amdgcn_mfma_f32_32x32x16_bf16(pa1, ATT_PK(1), o[d0], 0, 0, 0);
        o[d0] = __builtin_amdgcn_mfma_f32_32x32x16_bf16(pa2, ATT_PK(2), o[d0], 0, 0, 0);
        o[d0] = __builtin_amdgcn_mfma_f32_32x32x16_bf16(pa3, ATT_PK(3), o[d0], 0, 0, 0);
#undef ATT_PK
    }
}
__device__ __forceinline__ void pack_pv(f32x16* o, int vb, const f32x16& p0, const f32x16& p1) {
    u32x4 w0, w1, w2, w3;
#pragma unroll
    for (int j = 0; j < 4; ++j) { w0[j] = cvtpk(p0[2 * j], p0[2 * j + 1]); w1[j] = cvtpk(p0[8 + 2 * j], p0[8 + 2 * j + 1]); w2[j] = cvtpk(p1[2 * j], p1[2 * j + 1]); w3[j] = cvtpk(p1[8 + 2 * j], p1[8 + 2 * j + 1]); }
    pv(o, vb, __builtin_bit_cast(bf16x8, w0), __builtin_bit_cast(bf16x8, w1), __builtin_bit_cast(bf16x8, w2), __builtin_bit_cast(bf16x8, w3));
}
__device__ __forceinline__ float rowmax32(const f32x16& p0, const f32x16& p1, int hi) {
    float a = max3f(p0[0], p0[1], p1[0]), b = max3f(p0[2], p0[3], p1[1]); a = max3f(a, p1[2], p1[3]);
#pragma unroll
    for (int r = 4; r < 16; r += 4) { a = max3f(a, p0[r], p0[r + 1]); b = max3f(b, p0[r + 2], p0[r + 3]); a = max3f(a, p1[r], p1[r + 1]); b = max3f(b, p1[r + 2], p1[r + 3]); }
    a = fmaxf(a, b);
    return fmaxf(a, other_half(a, hi));
}
__device__ __forceinline__ void store_o(const f32x16* o, const float* sc, lptr stgb, bf16* Ow, long rpitch, int lane, int r32, int hi) {
    LAS bf16* stg = (LAS bf16*)stgb;
#pragma unroll
    for (int r = 0; r < 16; ++r) { const int orow = crow(r, hi);
#pragma unroll
        for (int d0 = 0; d0 < 2; ++d0) stg[orow * 64 + d0 * 32 + r32] = (bf16)f2bf(o[d0][r] * sc[r]); }
    asm volatile("s_waitcnt lgkmcnt(0)" ::: "memory");
#pragma unroll
    for (int i = 0; i < 4; ++i) { const int row = i * 8 + (lane >> 3), ch = lane & 7; const u32x4 v = *(const LAS u32x4*)(stg + row * 64 + ch * 8); *(u32x4*)(Ow + (long)row * rpitch + ch * 8) = v; }
}
__device__ __forceinline__ void softmax_step(f32x16& p0, f32x16& p1, float& mref, float& lsum, f32x16* o, LAS float* wsf, int r32, int hi) {
    const float rm = rowmax32(p0, p1, hi);
    const bool fresh = mref <= -1e30f;
    const bool want = !fresh && (rm > mref + THR);
    if (fresh) mref = fmaxf(rm, -1e30f);
    if (__any(want)) {
        const float dl = want ? rm - mref : 0.f; mref += dl; const float f = __builtin_amdgcn_exp2f(-dl); lsum *= f;
        if (hi == 0) wsf[r32] = f;
        asm volatile("s_waitcnt lgkmcnt(0)" ::: "memory");
#pragma unroll
        for (int r = 0; r < 16; ++r) { const float fr = wsf[crow(r, hi)]; o[0][r] *= fr; o[1][r] *= fr; }
    }
    float sa = 0.f, sb = 0.f;
#pragma unroll
    for (int r = 0; r < 16; ++r) { p0[r] = __builtin_amdgcn_exp2f(p0[r] - mref); p1[r] = __builtin_amdgcn_exp2f(p1[r] - mref); sa += p0[r]; sb += p1[r]; }
    lsum += sa + sb;
}

struct WaveCtx { int lane, r32, hi, wid; unsigned lds0; int vb0; lptr shm; };
struct UnitD { int NT; int b, h, qb, g, x; };

template <int MODE> struct CausalMode {
    const bf16* Q; const bf16* K; const bf16* V; bf16* O; int b, h, p;
    float carry, mref, lsum; int done;
    __device__ __forceinline__ int units() const { return 4; }
    __device__ __forceinline__ void desc(int j, UnitD& d) const { d.b = b; d.h = h; d.qb = (j == 0) ? 7 - p : (j == 1) ? 5 - p : (j == 2) ? 2 + p : p; d.NT = 4 * (d.qb + 1); d.g = 0; d.x = 0; }
    __device__ __forceinline__ int tile_of(const UnitD& d, int k) const { return MODE == 0 ? d.NT - 1 - k : k; }
    __device__ __forceinline__ void q_load(const UnitD& d, const WaveCtx& w, bf16x8 (&q)[4]) const {
        const bf16* Qw = Q + ((long)d.b * SEQ + d.qb * 256 + w.wid * 32 + w.r32) * DM + d.h * 64 + w.hi * 8;
#pragma unroll
        for (int d0 = 0; d0 < 4; ++d0) q[d0] = gload16(Qw + d0 * 16);
    }
    __device__ __forceinline__ void dma(const UnitD& d, int k, int slot, const WaveCtx& w) const {
        const long row0 = (long)d.b * SEQ + 64 * tile_of(d, k);
        glds16(K + (row0 + w.lane) * DM + d.h * 64 + w.wid * 8, (unsigned)__builtin_amdgcn_readfirstlane(w.lds0 + L_K + slot * SLOTB + w.wid * 1024));
        glds16(V + (row0 + 16 * (w.wid & 3) + (w.lane >> 2)) * DM + d.h * 64 + (w.wid >> 2) * 32 + (w.lane & 3) * 8, (unsigned)__builtin_amdgcn_readfirstlane(w.lds0 + L_V + slot * SLOTB + w.wid * 1024));
    }
    __device__ __forceinline__ void begin(const UnitD&, const WaveCtx&) { carry = 1.0f; mref = -1e30f; lsum = 0.f; done = 0; }
    __device__ __forceinline__ int wave_done() const { return done; }
    __device__ __forceinline__ void compute(const UnitD& d, int k, int slot, const WaveCtx& w, const bf16x8* qr, f32x16* o) {
        const int T = tile_of(d, k), qfirst = d.qb * 256 + w.wid * 32, qpos = qfirst + w.r32;
        if (MODE == 0) {
            if (done || 64 * T >= qfirst + 31) return;
            f32x16 p0, p1; const f32x16 z = {}; qkt(p0, p1, w.shm + L_K + slot * SLOTB, qr, z, z, w.r32, w.hi);
            const bool diag = 64 * T + 63 >= qfirst;
            float ga[8];
#pragma unroll
            for (int a = 0; a < 8; ++a) {
                float rr[4];
#pragma unroll
                for (int i = 0; i < 4; ++i) { const int r = 4 * (a & 3) + i; const float zz = (a < 4) ? p0[r] : p1[r];
                    const float e = __builtin_amdgcn_exp2f(fminf(zz, 120.f)); float rv = __builtin_amdgcn_rcpf(1.0f + e);
                    if (diag) { const int kv = 64 * T + crow(r, w.hi) + ((a < 4) ? 0 : 32); if (kv >= qpos) rv = 1.0f; }
                    rr[i] = rv; if (a < 4) p0[r] = rv; else p1[r] = rv; }
                ga[a] = (rr[0] * rr[1]) * (rr[2] * rr[3]);
            }
            float oth[8], Ts[8];
#pragma unroll
            for (int a = 0; a < 8; ++a) oth[a] = other_half(ga[a], w.hi);
            float run = 1.0f;
#pragma unroll
            for (int a = 7; a >= 0; --a) { Ts[a] = run; run *= ga[a] * oth[a]; }
#pragma unroll
            for (int a = 0; a < 8; ++a) {
                float E = carry * Ts[a] * (w.hi ? 1.0f : oth[a]);
#pragma unroll
                for (int i = 3; i >= 0; --i) { const int r = 4 * (a & 3) + i; const float rv = (a < 4) ? p0[r] : p1[r]; const float wt = (1.0f - rv) * E; E *= rv; if (a < 4) p0[r] = wt; else p1[r] = wt; }
            }
            carry *= run;
            pack_pv(o, w.vb0 + slot * SLOTB, p0, p1);
            if (__all(carry < 1e-30f)) done = 1;
        } else {
            if (64 * T > qfirst + 31) return;
            LAS float* kbl = (LAS float*)(w.shm + L_KB);
            f32x16 c0, c1;
#pragma unroll
            for (int g = 0; g < 4; ++g) { const f32x4 k0 = *(const LAS f32x4*)(kbl + 64 * T + 8 * g + 4 * w.hi), k1 = *(const LAS f32x4*)(kbl + 64 * T + 32 + 8 * g + 4 * w.hi);
#pragma unroll
                for (int i = 0; i < 4; ++i) { c0[4 * g + i] = k0[i]; c1[4 * g + i] = k1[i]; } }
            f32x16 p0, p1; qkt(p0, p1, w.shm + L_K + slot * SLOTB, qr, c0, c1, w.r32, w.hi);
            if (64 * T + 63 > qfirst) {
#pragma unroll
                for (int r = 0; r < 16; ++r) { const int kv = 64 * T + crow(r, w.hi); if (kv > qpos) p0[r] = -INFINITY; if (kv + 32 > qpos) p1[r] = -INFINITY; } }
            softmax_step(p0, p1, mref, lsum, o, (LAS float*)(w.shm + L_WS) + w.wid * 64, w.r32, w.hi);
            pack_pv(o, w.vb0 + slot * SLOTB, p0, p1);
        }
    }
    __device__ __forceinline__ void finish(const UnitD& d, const WaveCtx& w, const f32x16* o) {
        LAS float* wsf = (LAS float*)(w.shm + L_WS) + w.wid * 64;
        float sc[16];
        if (MODE == 0) {
#pragma unroll
            for (int r = 0; r < 16; ++r) sc[r] = 1.0f;
        } else {
            float lt = lsum + other_half(lsum, w.hi);
            if (w.hi == 0) wsf[32 + w.r32] = lt;
            asm volatile("s_waitcnt lgkmcnt(0)" ::: "memory");
#pragma unroll
            for (int r = 0; r < 16; ++r) sc[r] = __builtin_amdgcn_rcpf(wsf[32 + crow(r, w.hi)]);
        }
        store_o(o, sc, w.shm + L_OST + w.wid * 4096, O + ((long)d.b * SEQ + d.qb * 256 + w.wid * 32) * DM + d.h * 64, DM, w.lane, w.r32, w.hi);
    }
};

struct DilMode {
    const bf16* PROJ; bf16* OG; float* ST; int b, h, p;
    float mref, lsum;
    __device__ __forceinline__ int units() const { return 12; }
    __device__ __forceinline__ void desc(int j, UnitD& d) const {
        const int g = j >> 2, i = j & 3; d.g = g; d.b = b; d.h = h; d.qb = 0;
        d.x = (g == 1) ? ((2 * (i >> 1) + p) << 1) + (i & 1) : 2 * i + p;
        const int i0 = (g == 0) ? 256 * d.x : (g == 1) ? 256 * (d.x & 1) : 0;
        d.NT = (g == 2) ? 4 : ((i0 >> 6) + 4 - t_lo(g, i0));
    }
    static __device__ __forceinline__ int t_lo(int g, int i0) { return (g == 2) ? 0 : ((i0 >> 6) >= 2 ? (i0 >> 6) - 2 : 0); }
    static __device__ __forceinline__ int dil_of(int g) { return (g == 0) ? 1 : (g == 1) ? 4 : 16; }
    static __device__ __forceinline__ int cls0_of(int g, int x) { return (g == 0) ? 0 : (g == 1) ? (x >> 1) : 2 * x; }
    static __device__ __forceinline__ int i0_of(int g, int x) { return (g == 0) ? 256 * x : (g == 1) ? 256 * (x & 1) : 0; }
    static __device__ __forceinline__ int tcls(int g, int x, int k) { return cls0_of(g, x) + ((g == 2) ? (k >> 1) : 0); }
    static __device__ __forceinline__ int kbase(int g, int x, int k) { return (g == 2) ? 64 * (k & 1) : 64 * (t_lo(g, i0_of(g, x)) + k); }
    __device__ __forceinline__ void q_load(const UnitD& d, const WaveCtx& w, bf16x8 (&q)[4]) const {
        const int dil = dil_of(d.g), clsw = cls0_of(d.g, d.x) + ((d.g == 2) ? (w.wid >> 2) : 0), qi0w = (d.g == 2) ? 32 * (w.wid & 3) : i0_of(d.g, d.x) + 32 * w.wid;
        const bf16* Qw = PROJ + (size_t)(2 * d.g) * PLANE + ((long)d.b * SEQ + clsw + (long)(qi0w + w.r32) * dil) * DM + d.h * 64 + w.hi * 8;
#pragma unroll
        for (int d0 = 0; d0 < 4; ++d0) q[d0] = gload16(Qw + d0 * 16);
    }
    __device__ __forceinline__ void dma(const UnitD& d, int k, int slot, const WaveCtx& w) const {
        const int dil = dil_of(d.g); const long tok0 = (long)d.b * SEQ + tcls(d.g, d.x, k) + (long)kbase(d.g, d.x, k) * dil;
        glds16(PROJ + (size_t)(2 * d.g + 1) * PLANE + (tok0 + (long)w.lane * dil) * DM + d.h * 64 + w.wid * 8, (unsigned)__builtin_amdgcn_readfirstlane(w.lds0 + L_K + slot * SLOTB + w.wid * 1024));
        glds16(PROJ + (size_t)6 * PLANE + (tok0 + (long)(16 * (w.wid & 3) + (w.lane >> 2)) * dil) * DM + d.h * 64 + (w.wid >> 2) * 32 + (w.lane & 3) * 8, (unsigned)__builtin_amdgcn_readfirstlane(w.lds0 + L_V + slot * SLOTB + w.wid * 1024));
    }
    __device__ __forceinline__ void begin(const UnitD&, const WaveCtx&) { mref = -1e30f; lsum = 0.f; }
    __device__ __forceinline__ int wave_done() const { return 0; }
    __device__ __forceinline__ void compute(const UnitD& d, int k, int slot, const WaveCtx& w, const bf16x8* qr, f32x16* o) {
        const int clsw = cls0_of(d.g, d.x) + ((d.g == 2) ? (w.wid >> 2) : 0), qi0w = (d.g == 2) ? 32 * (w.wid & 3) : i0_of(d.g, d.x) + 32 * w.wid;
        const int kb = kbase(d.g, d.x, k);
        if (tcls(d.g, d.x, k) != clsw || kb > qi0w + 31 || kb < qi0w - 191) return;
        LAS float* tbl = (LAS float*)(w.shm + L_KB) + d.g * 640 + 256;
        const int dbase = qi0w + w.r32 - kb - 4 * w.hi;
        f32x16 c0, c1;
#pragma unroll
        for (int r = 0; r < 16; ++r) { const int cr = (r & 3) + 8 * (r >> 2); c0[r] = tbl[dbase - cr]; c1[r] = tbl[dbase - cr - 32]; }
        f32x16 p0, p1; qkt(p0, p1, w.shm + L_K + slot * SLOTB, qr, c0, c1, w.r32, w.hi);
        softmax_step(p0, p1, mref, lsum, o, (LAS float*)(w.shm + L_WS) + w.wid * 64, w.r32, w.hi);
        pack_pv(o, w.vb0 + slot * SLOTB, p0, p1);
    }
    __device__ __forceinline__ void finish(const UnitD& d, const WaveCtx& w, const f32x16* o) {
        const int dil = dil_of(d.g), clsw = cls0_of(d.g, d.x) + ((d.g == 2) ? (w.wid >> 2) : 0), qi0w = (d.g == 2) ? 32 * (w.wid & 3) : i0_of(d.g, d.x) + 32 * w.wid;
        LAS float* wsf = (LAS float*)(w.shm + L_WS) + w.wid * 64;
        const float lt = lsum + other_half(lsum, w.hi);
        if (w.hi == 0) { wsf[32 + w.r32] = lt;
            const long tok = (long)d.b * SEQ + clsw + (long)(qi0w + w.r32) * dil;
            *(f32x2*)(ST + ((size_t)d.g * M * NH + (size_t)tok * NH + d.h) * 2) = (f32x2){mref, lt}; }
        asm volatile("s_waitcnt lgkmcnt(0)" ::: "memory");
        float sc[16];
#pragma unroll
        for (int r = 0; r < 16; ++r) sc[r] = __builtin_amdgcn_rcpf(wsf[32 + crow(r, w.hi)]);
        store_o(o, sc, w.shm + L_OST + w.wid * 4096, OG + (size_t)d.g * PLANE + ((long)d.b * SEQ + clsw + (long)qi0w * dil) * DM + d.h * 64, (long)dil * DM, w.lane, w.r32, w.hi);
    }
};

template <class Mode, bool EARLY_EXIT>
__device__ __forceinline__ void stream_units(Mode& Mo, const WaveCtx& w) {
    LAS int* flg = (LAS int*)(w.shm + L_FLG);
    const int nun = Mo.units();
    int pj = 0, pk = 0, pseq = 0, cseq = 0;
    UnitD pd; Mo.desc(0, pd);
    bf16x8 qn[4];
    if (EARLY_EXIT && w.wid == 0 && w.lane < 4) flg[w.lane] = 0;
    asm volatile("s_waitcnt vmcnt(0)" ::: "memory");
#define ATT_PRODUCE() do { if (pj < nun) { if (pk == 0) Mo.q_load(pd, w, qn); Mo.dma(pd, pk, pseq % NSLOT, w); ++pseq; if (++pk == pd.NT) { pk = 0; if (++pj < nun) Mo.desc(pj, pd); } } } while (0)
#pragma unroll 1
    for (int i = 0; i < AHEAD; ++i) ATT_PRODUCE();
#pragma unroll 1
    for (int cj = 0; cj < nun; ++cj) {
        UnitD d; Mo.desc(cj, d);
        bf16x8 qr[4];
        f32x16 o[2]; o[0] = f32x16{}; o[1] = f32x16{};
        Mo.begin(d, w);
        const int useq0 = cseq;
        int rep = 0;
#pragma unroll 1
        while (pseq - cseq < AHEAD && pj < nun) ATT_PRODUCE();
#pragma unroll 1
        for (int ck = 0; ck < d.NT; ++ck) {
            wait_bar(2 * (pseq - cseq - 1));
            if (ck == 0) { asm volatile("" : "+v"(qn[0]), "+v"(qn[1]), "+v"(qn[2]), "+v"(qn[3])); qr[0] = qn[0]; qr[1] = qn[1]; qr[2] = qn[2]; qr[3] = qn[3]; }
            if (EARLY_EXIT && ck == 1 && w.wid == 0 && w.lane < 2) flg[((cj + 1) & 1) * 2 + w.lane] = 0;
            if (EARLY_EXIT && ck > 0) {
                if (__builtin_amdgcn_readfirstlane(flg[(cj & 1) * 2 + ((ck - 1) & 1)]) == 8) {
                    const int uend = useq0 + d.NT;
                    if (pj == cj) { pk = 0; if (++pj < nun) Mo.desc(pj, pd); }
                    cseq = uend < pseq ? uend : pseq;
                    break; } }
            if (pseq - cseq < AHEAD) ATT_PRODUCE();
            Mo.compute(d, ck, cseq % NSLOT, w, qr, o);
            if (EARLY_EXIT && Mo.wave_done() && rep < 2) { if (w.lane == 0) __hip_atomic_fetch_add(&flg[(cj & 1) * 2 + (ck & 1)], 1, __ATOMIC_RELAXED, __HIP_MEMORY_SCOPE_WORKGROUP); ++rep; }
            ++cseq;
        }
        Mo.finish(d, w, o);
    }
    asm volatile("s_waitcnt vmcnt(0) lgkmcnt(0)\n\ts_barrier" ::: "memory");
#undef ATT_PRODUCE
}
__device__ __forceinline__ WaveCtx make_ctx(lptr shm) {
    WaveCtx w; const int tid = threadIdx.x; w.lane = tid & 63; w.r32 = w.lane & 31; w.hi = w.lane >> 5; w.wid = __builtin_amdgcn_readfirstlane(tid >> 6);
    w.shm = shm; w.lds0 = (unsigned)(uintptr_t)shm;
    w.vb0 = (int)(w.lds0 + L_V) + ((w.lane >> 4) & 1) * 32 + (w.lane & 3) * 8 + (4 * w.hi + ((w.lane & 15) >> 2)) * 64;
    return w;
}
template <int MODE>
__device__ __forceinline__ void causal_phase(lptr shm, int G, const bf16* Q, const bf16* K, const bf16* V, bf16* O, const float* cum) {
    const int bx = blockIdx.x; const int vcu = (G % 8 == 0) ? (bx % 8) * (G / 8) + bx / 8 : bx;
    const WaveCtx w = make_ctx(shm);
    for (int u = vcu; u < BATCH * NH * 2; u += G) {
        CausalMode<MODE> Mo; Mo.Q = Q; Mo.K = K; Mo.V = V; Mo.O = O; Mo.b = u >> 5; Mo.h = (u >> 1) & 15; Mo.p = u & 1;
        if (MODE == 2) { LAS float* kbl = (LAS float*)(shm + L_KB);
            for (int s = threadIdx.x; s < SEQ; s += NTHR) kbl[s] = -cum[((long)Mo.b * SEQ + s) * 16 + Mo.h]; }
        stream_units<CausalMode<MODE>, MODE == 0>(Mo, w);
    }
}
__device__ __forceinline__ int t5_bucket_f(int dist) {
    if (dist < 16) return dist;
    int lb = 16 + (int)(logf((float)dist / 16.0f) / logf(128.0f) * 16.0f);
    return lb < 31 ? lb : 31;
}
__device__ __forceinline__ void dil_phase(lptr shm, int G, const bf16* PROJ, bf16* OG, float* ST, const float* rel_bias) {
    const int bx = blockIdx.x; const int vcu = (G % 8 == 0) ? (bx % 8) * (G / 8) + bx / 8 : bx;
    const WaveCtx w = make_ctx(shm);
    for (int u = vcu; u < BATCH * NH * 2; u += G) {
        DilMode Mo; Mo.PROJ = PROJ; Mo.OG = OG; Mo.ST = ST; Mo.b = u >> 5; Mo.h = (u >> 1) & 15; Mo.p = u & 1;
        LAS float* tb = (LAS float*)(shm + L_KB);
        for (int i = threadIdx.x; i < 3 * 640; i += NTHR) { const int gg = i / 640, dl = i - gg * 640 - 256; const int dil = (gg == 0) ? 1 : (gg == 1) ? 4 : 16;
            tb[i] = (dl >= 0 && dl <= 128) ? rel_bias[t5_bucket_f(dl * dil) * 16 + Mo.h] * LOG2E : -INFINITY; }
        stream_units<DilMode, false>(Mo, w);
    }
}
__device__ __forceinline__ void dil_merge(int G, const bf16* OG, const float* ST, bf16* O) {
    for (int idx = blockIdx.x * NTHR + threadIdx.x; idx < M * NH; idx += G * NTHR) {
        const f32x2 s0 = *(const f32x2*)(ST + ((size_t)0 * M * NH + idx) * 2), s1 = *(const f32x2*)(ST + ((size_t)1 * M * NH + idx) * 2), s2 = *(const f32x2*)(ST + ((size_t)2 * M * NH + idx) * 2);
        const float mx = fmaxf(s0.x, fmaxf(s1.x, s2.x));
        float w0 = __builtin_amdgcn_exp2f(s0.x - mx) * s0.y, w1 = __builtin_amdgcn_exp2f(s1.x - mx) * s1.y, w2 = __builtin_amdgcn_exp2f(s2.x - mx) * s2.y;
        const float inv = 1.0f / (w0 + w1 + w2); w0 *= inv; w1 *= inv; w2 *= inv;
        const GAS v4u* a0 = (const GAS v4u*)(OG + (size_t)idx * 64); const GAS v4u* a1 = (const GAS v4u*)(OG + PLANE + (size_t)idx * 64); const GAS v4u* a2 = (const GAS v4u*)(OG + 2 * PLANE + (size_t)idx * 64);
        GAS v4u* op = (GAS v4u*)(O + (size_t)idx * 64);
#pragma unroll
        for (int c = 0; c < 8; ++c) { const v4u x0 = a0[c], x1 = a1[c], x2 = a2[c]; v4u r;
#pragma unroll
            for (int q = 0; q < 4; ++q) r[q] = pk2(w0 * bflo(x0[q]) + w1 * bflo(x1[q]) + w2 * bflo(x2[q]), w0 * bfhi(x0[q]) + w1 * bfhi(x1[q]) + w2 * bfhi(x2[q]));
            op[c] = r; }
    }
}
}

enum { CV_PLAIN = 0, CV_QKN = 1, CV_GATE = 2, CV_UP = 3 };
__device__ __forceinline__ int cv_dst_row(int mode, int n) {
    if (mode == CV_QKN) return (n & ~255) + 128 * ((n >> 5) & 1) + 32 * ((n >> 6) & 3) + (n & 31);
    if (mode == CV_GATE) return 256 * (n >> 7) + (n & 127);
    if (mode == CV_UP) return 256 * (n >> 7) + 128 + (n & 127);
    return n;
}
__device__ __forceinline__ void conv_item(const float* W, int ldw, int K, bf16* WT, int mode, LAS unsigned char* scr, int item, int nblk, int lane) {
    const int kb = item / nblk, nb = item - kb * nblk, k0 = 64 * kb, n0 = 64 * nb;
    const GAS float* src = (const GAS float*)(W + (size_t)k0 * ldw + n0 + lane);
#pragma unroll
    for (int kc = 0; kc < 8; ++kc) {
        float v[8];
#pragma unroll
        for (int j = 0; j < 8; ++j) v[j] = src[(size_t)(kc * 8 + j) * ldw];
        v4u w; w.x = pk2(v[0], v[1]); w.y = pk2(v[2], v[3]); w.z = pk2(v[4], v[5]); w.w = pk2(v[6], v[7]);
        *(LAS v4u*)(scr + lane * 144 + kc * 16) = w;
    }
    asm volatile("s_waitcnt lgkmcnt(0)" ::: "memory");
#pragma unroll
    for (int j = 0; j < 8; ++j) { const int n = 8 * j + (lane >> 3), ch = lane & 7;
        const v4u w = *(const LAS v4u*)(scr + n * 144 + ch * 16);
        *(GAS v4u*)(WT + (size_t)cv_dst_row(mode, n0 + n) * K + k0 + 8 * ch) = w; }
    asm volatile("s_waitcnt lgkmcnt(0)" ::: "memory");
}
__device__ __forceinline__ void conv_item8(const float* W, int ldw, int K, unsigned char* WT8, int mode, LAS unsigned char* scr, int item, int nblk, int lane) {
    const int kb = item / nblk, nb = item - kb * nblk, k0 = 64 * kb, n0 = 64 * nb;
    const GAS float* src = (const GAS float*)(W + (size_t)k0 * ldw + n0 + lane);
#pragma unroll
    for (int kc = 0; kc < 8; ++kc) {
        float v[8];
#pragma unroll
        for (int j = 0; j < 8; ++j) v[j] = src[(size_t)(kc * 8 + j) * ldw] * W8S;
        v2u w; w.x = pg8::cvt4_fp8(v[0], v[1], v[2], v[3]); w.y = pg8::cvt4_fp8(v[4], v[5], v[6], v[7]);
        *(LAS v2u*)(scr + lane * 80 + kc * 8) = w;
    }
    asm volatile("s_waitcnt lgkmcnt(0)" ::: "memory");
#pragma unroll
    for (int j = 0; j < 4; ++j) { const int n = 16 * j + (lane >> 2), ch = lane & 3;
        const v4u w = *(const LAS v4u*)(scr + n * 80 + ch * 16);
        *(GAS v4u*)(WT8 + (size_t)cv_dst_row(mode, n0 + n) * K + k0 + 16 * ch) = w; }
    asm volatile("s_waitcnt lgkmcnt(0)" ::: "memory");
}
__device__ __forceinline__ void conv_job8(Frame& F, const float* W, int ldw, int K, int N, unsigned char* WT8, int mode, int& rot) {
    LAS unsigned char* scr = F.lds + F.wave * 9216;
    const int nblk = N / 64, nitems = (K / 64) * nblk, NGW = F.G * NWAVES, gw = blockIdx.x * NWAVES + F.wave;
    int first = gw - (rot % NGW); if (first < 0) first += NGW;
    for (int it = first; it < nitems; it += NGW) conv_item8(W, ldw, K, WT8, mode, scr, it, nblk, F.lane);
    rot += nitems;
}
__device__ __forceinline__ void conv_job(Frame& F, const float* W, int ldw, int K, int N, bf16* WT, int mode, int& rot) {
    LAS unsigned char* scr = F.lds + F.wave * 9216;
    const int nblk = N / 64, nitems = (K / 64) * nblk, NGW = F.G * NWAVES, gw = blockIdx.x * NWAVES + F.wave;
    int first = gw - (rot % NGW); if (first < 0) first += NGW;
    for (int it = first; it < nitems; it += NGW) conv_item(W, ldw, K, WT, mode, scr, it, nblk, F.lane);
    rot += nitems;
}
__device__ __forceinline__ void convert_weights(Frame& F) {
    bf16* WB = (bf16*)(F.ws + WS_W); int rot = 0;
    for (int j = 0; j < 2; ++j) conv_job(F, INP(1) + (size_t)j * DM * 3 * DM, 3 * DM, DM, 3 * DM, WB + WE_QKV + (size_t)j * 3 * DM * DM, CV_PLAIN, rot);
    for (int j = 0; j < 2; ++j) conv_job(F, INP(2) + (size_t)j * DM * DM, DM, DM, DM, WB + WE_WO_SB + (size_t)j * DM * DM, CV_PLAIN, rot);
    conv_job(F, INP(3), 7 * DM, DM, 7 * DM, WB + WE_IN_DIL, CV_QKN, rot);
    conv_job(F, INP(6), DM, DM, DM, WB + WE_WO_DIL, CV_PLAIN, rot);
    conv_job(F, INP(7), 3088, DM, 3 * DM, WB + WE_IN_FOX, CV_QKN, rot);
    conv_job(F, INP(11), DM, DM, DM, WB + WE_WO_FOX, CV_PLAIN, rot);
    for (int f = 0; f < 2; ++f) {
        if (f == 0 ? DENSE_FP8_L0 : DENSE_FP8_L2) {
            conv_job8(F, INP(15) + (size_t)f * DM * FF, FF, DM, FF, (unsigned char*)(WB + WE_GU + (size_t)f * 2 * FF * DM), CV_GATE, rot);
            conv_job8(F, INP(16) + (size_t)f * DM * FF, FF, DM, FF, (unsigned char*)(WB + WE_GU + (size_t)f * 2 * FF * DM), CV_UP, rot);
            conv_job8(F, INP(17) + (size_t)f * FF * DM, DM, FF, DM, (unsigned char*)(WB + WE_D + (size_t)f * DM * FF), CV_PLAIN, rot);
        } else {
            conv_job(F, INP(15) + (size_t)f * DM * FF, FF, DM, FF, WB + WE_GU + (size_t)f * 2 * FF * DM, CV_GATE, rot);
            conv_job(F, INP(16) + (size_t)f * DM * FF, FF, DM, FF, WB + WE_GU + (size_t)f * 2 * FF * DM, CV_UP, rot);
            conv_job(F, INP(17) + (size_t)f * FF * DM, DM, FF, DM, WB + WE_D + (size_t)f * DM * FF, CV_PLAIN, rot);
        }
    }
    for (int fe = 0; fe < 16; ++fe) {
        if (MOE_FP8) {
            conv_job8(F, INP(19) + (size_t)fe * DM * FF, FF, DM, FF, (unsigned char*)(WB + WE_MGU) + (size_t)fe * 2 * FF * DM, CV_GATE, rot);
            conv_job8(F, INP(20) + (size_t)fe * DM * FF, FF, DM, FF, (unsigned char*)(WB + WE_MGU) + (size_t)fe * 2 * FF * DM, CV_UP, rot);
            conv_job8(F, INP(21) + (size_t)fe * FF * DM, DM, FF, DM, (unsigned char*)(WB + WE_MD) + (size_t)fe * DM * FF, CV_PLAIN, rot);
        } else {
            conv_job(F, INP(19) + (size_t)fe * DM * FF, FF, DM, FF, WB + WE_MGU + (size_t)fe * 2 * FF * DM, CV_GATE, rot);
            conv_job(F, INP(20) + (size_t)fe * DM * FF, FF, DM, FF, WB + WE_MGU + (size_t)fe * 2 * FF * DM, CV_UP, rot);
            conv_job(F, INP(21) + (size_t)fe * FF * DM, DM, FF, DM, WB + WE_MD + (size_t)fe * DM * FF, CV_PLAIN, rot);
        }
    }
}

__device__ __forceinline__ int moe_cnt(Frame& F, int f, int e) {
    const unsigned long long w = __hip_atomic_load((GAS unsigned long long*)(F.ctl + CW_CNT + f * 64 + 16 * (e >> 2)), RLX_AGENT);
    return (int)((w >> (16 * (e & 3))) & 0xffffull);
}
__device__ __forceinline__ f32x4 moe_yrow(Frame& F, int r, int q4) {
    const bf16* Y = (const bf16*)(F.ws + WS_R2); const bf16* P = (const bf16*)(F.ws + WS_R2 + 72 * MiB);
    if (r < SPLIT_ROW0 || F.G != 256 || !MOE_SPLITK) { const v2u a = ((const GAS v2u*)(Y + (size_t)r * DM))[q4]; return (f32x4){bflo(a.x), bfhi(a.x), bflo(a.y), bfhi(a.y)}; }
    f32x4 s = (f32x4){0.f, 0.f, 0.f, 0.f};
#pragma unroll
    for (int k = 0; k < MOE_NSPLIT; ++k) { const v2u a = ((const GAS v2u*)(P + ((size_t)k * SPLIT_ROWS + (size_t)(r - SPLIT_ROW0)) * DM))[q4]; s = s + (f32x4){bflo(a.x), bfhi(a.x), bflo(a.y), bfhi(a.y)}; }
    return s;
}
__device__ __forceinline__ void moe_bases(Frame& F, int f, int (&tb)[NE + 1]) {
    int acc = 0;
#pragma unroll
    for (int e = 0; e < NE; ++e) { tb[e] = acc; const int c = moe_cnt(F, f, e); acc += (c + 255) >> 8; }
    tb[NE] = acc;
}

template <int NC>
__device__ __forceinline__ float wave_reduce_cols(float (&part)[NC], int lane) {
#pragma unroll
    for (int st = 0, n = NC / 2; n >= 1; ++st, n >>= 1) {
        const bool up = (lane >> st) & 1;
#pragma unroll
        for (int i = 0; i < n; ++i) { const float keep = up ? part[i + n] : part[i], send = up ? part[i] : part[i + n]; part[i] = keep + __shfl_xor(send, 1 << st); }
    }
    float v = part[0];
#pragma unroll
    for (int o = NC; o < 64; o <<= 1) v += __shfl_xor(v, o);
    return v;
}
template <int NC> __device__ __forceinline__ int lane_of_col(int c) {
    int l = 0;
#pragma unroll
    for (int st = 0, n = NC / 2; n >= 1; ++st, n >>= 1) { if (c & n) l |= 1 << st; }
    return l;
}
template <int FLAGS>
__device__ __forceinline__ void norm_phase(Frame& F, const float* xin, float* xout, const float* gain, bf16* H, int fprev, int f,
                                           const float* Wf  , const float* bf  , const float* Wr  ) {
    constexpr int NC = (FLAGS & 2) ? 16 : (FLAGS & 4) ? 8 : 0;
    const bf16* Y = (const bf16*)(F.ws + WS_R2);
    const int* tok_prev = (const int*)(F.ws + WS_MISC + MS_TOK) + (size_t)fprev * M * 2;
    float* lgf = (float*)(F.ws + WS_MISC + MS_LOGF);
    LAS int* sel = (LAS int*)F.lds;
    LAS float* sg = (LAS float*)(F.lds + 512);
    LAS int* gb = (LAS int*)(F.lds + 1536);
    LAS f32x4* WL = (LAS f32x4*)(F.lds + 4096);
    int tb[NE + 1];
    if (FLAGS & 1) moe_bases(F, fprev, tb);
    if (NC) {
        const float* Wsrc = (FLAGS & 2) ? Wf + 3072 : Wr; const int ldw = (FLAGS & 2) ? 3088 : 8;
        for (int idx = F.tid; idx < 16 * (NC / 4) * 64; idx += NTHR) {
            const int ln = idx & 63, cq = (idx >> 6) % (NC / 4), jq = idx / (64 * (NC / 4)), k = 4 * (ln + 64 * (jq >> 2)) + (jq & 3);
            WL[idx] = *(const GAS f32x4*)(Wsrc + (size_t)k * ldw + 4 * cq) * gain[k];
        }
        __syncthreads();
    }
    for (int chunk = blockIdx.x; chunk < M / 64; chunk += F.G) {
        for (int i = 0; i < 8; ++i) {
            const int m = chunk * 64 + F.wave * 8 + i;
            int ln = F.lane; asm volatile("" : "+v"(ln));
            const GAS f32x4* xr = (const GAS f32x4*)(xin + (size_t)m * DM) + ln;
            f32x4 v[4];
#pragma unroll
            for (int j = 0; j < 4; ++j) v[j] = xr[64 * j];
            if (FLAGS & 1) {
                const int s0 = tok_prev[m * 2], s1 = tok_prev[m * 2 + 1];
                int r0 = 0, r1 = 0;
#pragma unroll
                for (int e = 0; e < NE; ++e) { if ((s0 >> 14) == e) r0 = tb[e] * 256 + (s0 & 16383); if ((s1 >> 14) == e) r1 = tb[e] * 256 + (s1 & 16383); }
#pragma unroll
                for (int j = 0; j < 4; ++j) { v[j] = v[j] + moe_yrow(F, r0, ln + 64 * j) + moe_yrow(F, r1, ln + 64 * j);
                    ((GAS f32x4*)(xout + (size_t)m * DM) + ln)[64 * j] = v[j]; }
            }
            float s = 0.f;
#pragma unroll
            for (int j = 0; j < 4; ++j) s += (v[j].x * v[j].x + v[j].y * v[j].y) + (v[j].z * v[j].z + v[j].w * v[j].w);
            const float inv = 1.0f / sqrtf(wave_sum(s) * (1.f / DM) + RMS_EPS);
            float colv = 0.f;
            if (NC) {
                float part[NC ? NC : 1];
#pragma unroll
                for (int c = 0; c < NC; ++c) part[c] = 0.f;
                const int woff = ln;
#pragma unroll
                for (int j = 0; j < 4; ++j) {
#pragma unroll
                    for (int q = 0; q < 4; ++q) { const float xv = v[j][q];
#pragma unroll
                        for (int cq = 0; cq < NC / 4; ++cq) { const f32x4 w = WL[((j * 4 + q) * (NC / 4) + cq) * 64 + woff];
                            part[cq * 4 + 0] += xv * w.x; part[cq * 4 + 1] += xv * w.y; part[cq * 4 + 2] += xv * w.z; part[cq * 4 + 3] += xv * w.w; }
                        if ((q & 1) == 1) asm volatile("" ::: "memory"); } }
                colv = wave_reduce_cols<NC ? NC : 2>(reinterpret_cast<float (&)[NC ? NC : 2]>(part), ln) * inv;
            }
            if (H) {
                GAS unsigned long long* o8 = (GAS unsigned long long*)(H + (size_t)m * DM) + ln;
                GAS unsigned* h8 = (GAS unsigned*)(F.ws + WS_R2 + 104 * MiB + (size_t)m * DM) + ln;
#pragma unroll
                for (int j = 0; j < 4; ++j) { const f32x4 g = ((const GAS f32x4*)gain + ln)[64 * j]; const f32x4 hv = v[j] * inv * g;
                    if (((FLAGS & 4) && MOE_FP8) || (FLAGS & 8)) h8[64 * j] = pg8::cvt4_fp8(hv.x, hv.y, hv.z, hv.w);
                    else o8[64 * j] = (unsigned long long)pk2(hv.x, hv.y) | ((unsigned long long)pk2(hv.z, hv.w) << 32); }
            }
            if (FLAGS & 2) {
                if (ln < 16) { const int l = ln; const int c = ((l & 1) << 3) | ((l & 2) << 1) | ((l & 4) >> 1) | ((l & 8) >> 3);
                    const float z = colv + bf[c]; const float ls = fminf(z, 0.f) - log1pf(expf(-fabsf(z))); lgf[(size_t)m * 16 + c] = ls * LOG2E; }
            }
            if (FLAGS & 4) {
                float lg[8];
#pragma unroll
                for (int c = 0; c < 8; ++c) lg[c] = __builtin_bit_cast(float, __builtin_amdgcn_readlane(__builtin_bit_cast(int, colv), lane_of_col<8>(c)));
                int e0 = 0; float l0 = lg[0];
#pragma unroll
                for (int c = 1; c < 8; ++c) if (lg[c] > l0) { l0 = lg[c]; e0 = c; }
                int e1 = -1; float l1 = -INFINITY;
#pragma unroll
                for (int c = 0; c < 8; ++c) if (c != e0 && lg[c] > l1) { l1 = lg[c]; e1 = c; }
                const float g0 = 1.0f / (1.0f + expf(l1 - l0)), g1 = 1.0f - g0;
                if (ln == 0) { const int r = F.wave * 8 + i; sel[r * 2] = e0; sel[r * 2 + 1] = e1; sg[r * 2] = g0; sg[r * 2 + 1] = g1; }
            }
        }
        if (FLAGS & 4) {
            int* selg = (int*)(F.ws + WS_MISC + MS_SEL) + (size_t)f * M * 2;
            float* sgg = (float*)(F.ws + WS_MISC + MS_SG) + (size_t)f * M * 2;
            int* lcn = (int*)(F.ws + WS_MISC + MS_LC) + (size_t)f * 256 * 8;
            __syncthreads();
            if (F.tid < 128) { selg[chunk * 128 + F.tid] = sel[F.tid]; sgg[chunk * 128 + F.tid] = sg[F.tid]; }
            if (F.tid >= 128 && F.tid < 136) { const int e = F.tid - 128; int c = 0;
                for (int q = 0; q < 128; ++q) c += (sel[q] == e) ? 1 : 0;
                lcn[chunk * 8 + e] = c; }
            __syncthreads();
        }
    }
}

__device__ __forceinline__ void moe_finalize(Frame& F, int f) {
    const int* selg = (const int*)(F.ws + WS_MISC + MS_SEL) + (size_t)f * M * 2;
    const float* sgg = (const float*)(F.ws + WS_MISC + MS_SG) + (size_t)f * M * 2;
    const int* lcn = (const int*)(F.ws + WS_MISC + MS_LC) + (size_t)f * 256 * 8;
    int* list = (int*)(F.ws + WS_MISC + MS_LIST) + (size_t)f * NE * LCAP;
    float* gw = (float*)(F.ws + WS_MISC + MS_GW) + (size_t)f * NE * LCAP;
    int* tok = (int*)(F.ws + WS_MISC + MS_TOK) + (size_t)f * M * 2;
    LAS int* arr = (LAS int*)F.lds;
    LAS int* sel = (LAS int*)(F.lds + 8192);
    LAS int* pb = (LAS int*)(F.lds + 8192 + 512);
    LAS int* pt = (LAS int*)(F.lds + 8192 + 1536);
    LAS int* base = (LAS int*)(F.lds + 8192 + 2560);
    LAS int* tot = (LAS int*)(F.lds + 8192 + 2592);
    for (int chunk = blockIdx.x; chunk < M / 64; chunk += F.G) {
        if (F.tid < 256) { const v4u a = *(const GAS v4u*)(lcn + F.tid * 8), b = *(const GAS v4u*)(lcn + F.tid * 8 + 4);
            *(LAS v4u*)(arr + F.tid * 8) = a; *(LAS v4u*)(arr + F.tid * 8 + 4) = b; }
        if (F.tid < 128) sel[F.tid] = selg[chunk * 128 + F.tid];
        __syncthreads();
        if (F.tid < 256) { const int e = F.tid & 7, seg = F.tid >> 3; int b = 0, t = 0;
#pragma unroll
            for (int i = 0; i < 8; ++i) { const int c = seg * 8 + i; const int v = arr[c * 8 + e]; t += v; b += (c < chunk) ? v : 0; }
            pb[seg * 8 + e] = b; pt[seg * 8 + e] = t; }
        __syncthreads();
        if (F.tid < 8) { int b = 0, t = 0;
            for (int sgm = 0; sgm < 32; ++sgm) { b += pb[sgm * 8 + F.tid]; t += pt[sgm * 8 + F.tid]; }
            base[F.tid] = b; tot[F.tid] = t; }
        __syncthreads();
        if (F.tid < 128) { const int mye = sel[F.tid]; int lp = 0;
            for (int q = 0; q < 128; ++q) lp += (q < F.tid && sel[q] == mye) ? 1 : 0;
            const int q = F.tid, row = chunk * 64 + (q >> 1), pos = base[mye] + lp;
            list[mye * LCAP + pos] = row; gw[mye * LCAP + pos] = sgg[chunk * 128 + q]; tok[row * 2 + (q & 1)] = mye * LCAP + pos; }
        if (chunk == 0 && F.tid < 2) { unsigned long long w = 0ull;
#pragma unroll
            for (int i = 0; i < 4; ++i) w |= (unsigned long long)(unsigned)tot[4 * F.tid + i] << (16 * i);
            __hip_atomic_store((GAS unsigned long long*)(F.ctl + CW_CNT + f * 64 + 16 * F.tid), w, RLX_AGENT); }
        __syncthreads();
    }
}

__device__ __forceinline__ void final_combine(Frame& F, int f) {
    const bf16* Y = (const bf16*)(F.ws + WS_R2);
    const int* tok = (const int*)(F.ws + WS_MISC + MS_TOK) + (size_t)f * M * 2;
    int tb[NE + 1]; moe_bases(F, f, tb);
    for (int m = blockIdx.x * NWAVES + F.wave; m < M; m += F.G * NWAVES) {
        const int s0 = tok[m * 2], s1 = tok[m * 2 + 1]; int r0 = 0, r1 = 0;
#pragma unroll
        for (int e = 0; e < NE; ++e) { if ((s0 >> 14) == e) r0 = tb[e] * 256 + (s0 & 16383); if ((s1 >> 14) == e) r1 = tb[e] * 256 + (s1 & 16383); }
        GAS f32x4* xr = (GAS f32x4*)(F.out + (size_t)m * DM) + F.lane;
#pragma unroll
        for (int j = 0; j < 4; ++j) xr[64 * j] = xr[64 * j] + moe_yrow(F, r0, F.lane + 64 * j) + moe_yrow(F, r1, F.lane + 64 * j);
    }
}

__device__ __forceinline__ void cumsum_phase(Frame& F) {
    const float* logf = (const float*)(F.ws + WS_MISC + MS_LOGF);
    float* cum = (float*)(F.ws + WS_MISC + MS_CUM);
    const int gw = blockIdx.x * NWAVES + F.wave;
    if (gw < BATCH * NH) {
        const int b = gw >> 4, h = gw & 15;
        float v[32]; float s = 0.f;
#pragma unroll
        for (int i = 0; i < 32; ++i) { v[i] = logf[((size_t)b * SEQ + F.lane * 32 + i) * 16 + h]; s += v[i]; }
        float incl = s;
#pragma unroll
        for (int o = 1; o < 64; o <<= 1) { const float t = __shfl_up(incl, o); if (F.lane >= o) incl += t; }
        float run = incl - s;
#pragma unroll
        for (int i = 0; i < 32; ++i) { run += v[i]; cum[((size_t)b * SEQ + F.lane * 32 + i) * 16 + h] = run; }
    }
}

enum { EPI_PLANES = 0, EPI_RESID = 1, EPI_SWIGLU = 2, EPI_MOEDOWN = 3 };
struct SgP { const bf16* A; int lda; const int* rowidx; int Mrows; const float* W0; const float* W1; int ldw; int K; int N;
             bf16* outb; int ldo; float scale0; const float* base; float* outf; const float* gwv; };
template <int EPI>
__device__ __forceinline__ void sgemm(Frame& F, const SgP& p) {
    LAS float* As = (LAS float*)F.lds;
    LAS float* Bs0 = As + 16 * 132;
    LAS float* Bs1 = Bs0 + 16 * 128;
    const int tid = F.tid, ty = tid >> 4, tx = tid & 15;
    const int lrow = tid >> 2, lkq = (tid & 3) * 4;
    const int bk = tid >> 5, bn = (tid & 31) * 4;
    const int ntn = p.N / 128, ntiles = (p.Mrows / 128) * ntn;
    for (int tile = blockIdx.x; tile < ntiles; tile += F.G) {
        const int tm = tile / ntn, tn = tile % ntn;
        const int arow = p.rowidx ? p.rowidx[tm * 128 + lrow] : tm * 128 + lrow;
        const bf16* ap = p.A + (size_t)arow * p.lda + lkq;
        const float* bp0 = p.W0 + (size_t)bk * p.ldw + tn * 128 + bn;
        const float* bp1 = (EPI == EPI_SWIGLU) ? p.W1 + (size_t)bk * p.ldw + tn * 128 + bn : nullptr;
        f32x2 acc0[4][4], acc1[4][4];
#pragma unroll
        for (int i = 0; i < 4; ++i)
#pragma unroll
            for (int j = 0; j < 4; ++j) { acc0[i][j] = (f32x2){0.f, 0.f}; acc1[i][j] = (f32x2){0.f, 0.f}; }
        for (int k0 = 0; k0 < p.K; k0 += 16) {
            const v2u av = *(const GAS v2u*)(ap + k0);
            const f32x4 b0 = *(const GAS f32x4*)(bp0 + (size_t)k0 * p.ldw);
            f32x4 b1 = (f32x4){0.f, 0.f, 0.f, 0.f};
            if (EPI == EPI_SWIGLU) b1 = *(const GAS f32x4*)(bp1 + (size_t)k0 * p.ldw);
            __syncthreads();
            As[(lkq + 0) * 132 + lrow] = bflo(av.x); As[(lkq + 1) * 132 + lrow] = bfhi(av.x);
            As[(lkq + 2) * 132 + lrow] = bflo(av.y); As[(lkq + 3) * 132 + lrow] = bfhi(av.y);
            *(LAS f32x4*)(Bs0 + bk * 128 + bn) = b0;
            if (EPI == EPI_SWIGLU) *(LAS f32x4*)(Bs1 + bk * 128 + bn) = b1;
            __syncthreads();
#pragma unroll 2
            for (int k = 0; k < 16; ++k) {
                const f32x4 a = *(const LAS f32x4*)(As + k * 132 + ty * 4);
                const f32x4 bA = *(const LAS f32x4*)(Bs0 + k * 128 + tx * 8), bB = *(const LAS f32x4*)(Bs0 + k * 128 + tx * 8 + 4);
                const f32x2 bv[4] = {(f32x2){bA.x, bA.y}, (f32x2){bA.z, bA.w}, (f32x2){bB.x, bB.y}, (f32x2){bB.z, bB.w}};
#pragma unroll
                for (int i = 0; i < 4; ++i) {
#pragma unroll
                    for (int j = 0; j < 4; ++j) acc0[i][j] += a[i] * bv[j]; }
                if (EPI == EPI_SWIGLU) {
                    const f32x4 cA = *(const LAS f32x4*)(Bs1 + k * 128 + tx * 8), cB = *(const LAS f32x4*)(Bs1 + k * 128 + tx * 8 + 4);
                    const f32x2 cv[4] = {(f32x2){cA.x, cA.y}, (f32x2){cA.z, cA.w}, (f32x2){cB.x, cB.y}, (f32x2){cB.z, cB.w}};
#pragma unroll
                    for (int i = 0; i < 4; ++i) {
#pragma unroll
                        for (int j = 0; j < 4; ++j) acc1[i][j] += a[i] * cv[j]; }
                }
                __builtin_amdgcn_sched_barrier(0);
            }
        }
        const int c0 = tn * 128 + tx * 8;
#pragma unroll
        for (int i = 0; i < 4; ++i) {
            const int r = tm * 128 + ty * 4 + i;
            if (EPI == EPI_PLANES) {
                const int pl = c0 >> 10, cc = c0 & 1023; const float sc = (pl == 0) ? p.scale0 : 1.f;
                v4u w; w.x = pk2(acc0[i][0].x * sc, acc0[i][0].y * sc); w.y = pk2(acc0[i][1].x * sc, acc0[i][1].y * sc); w.z = pk2(acc0[i][2].x * sc, acc0[i][2].y * sc); w.w = pk2(acc0[i][3].x * sc, acc0[i][3].y * sc);
                *(GAS v4u*)(p.outb + (size_t)pl * PLANE + (size_t)r * DM + cc) = w;
            } else if (EPI == EPI_RESID) {
                const GAS f32x4* bp = (const GAS f32x4*)(p.base + (size_t)r * DM + c0); GAS f32x4* op = (GAS f32x4*)(p.outf + (size_t)r * DM + c0);
                const f32x4 x0 = bp[0], x1 = bp[1];
                op[0] = x0 + (f32x4){acc0[i][0].x, acc0[i][0].y, acc0[i][1].x, acc0[i][1].y}; op[1] = x1 + (f32x4){acc0[i][2].x, acc0[i][2].y, acc0[i][3].x, acc0[i][3].y};
            } else if (EPI == EPI_SWIGLU) {
                float o[8];
#pragma unroll
                for (int j = 0; j < 8; ++j) { const float g = acc0[i][j >> 1][j & 1], uu = acc1[i][j >> 1][j & 1]; o[j] = g / (1.0f + __expf(-g)) * uu; }
                v4u w; w.x = pk2(o[0], o[1]); w.y = pk2(o[2], o[3]); w.z = pk2(o[4], o[5]); w.w = pk2(o[6], o[7]);
                *(GAS v4u*)(p.outb + (size_t)r * p.ldo + c0) = w;
            } else {
                const float g = p.gwv[r]; GAS f32x4* op = (GAS f32x4*)(p.outf + (size_t)r * DM + c0);
                op[0] = (f32x4){acc0[i][0].x * g, acc0[i][0].y * g, acc0[i][1].x * g, acc0[i][1].y * g}; op[1] = (f32x4){acc0[i][2].x * g, acc0[i][2].y * g, acc0[i][3].x * g, acc0[i][3].y * g};
            }
        }
    }
}

__device__ __forceinline__ void qknorm_plane(Frame& F, bf16* plane, const float* gain, float mul) {
    const int nth = F.G * NTHR;
    for (int idx = blockIdx.x * NTHR + F.tid; idx < M * NH; idx += nth) {
        GAS v4u* p = (GAS v4u*)(plane + (size_t)idx * 64);
        v4u w[8]; float ss = 0.f;
#pragma unroll
        for (int c = 0; c < 8; ++c) { w[c] = p[c];
#pragma unroll
            for (int q = 0; q < 4; ++q) { const float a = bflo(w[c][q]), b = bfhi(w[c][q]); ss += a * a + b * b; } }
        const float inv = 1.0f / sqrtf(ss * (1.f / 64.f) + RMS_EPS) * mul;
#pragma unroll
        for (int c = 0; c < 8; ++c) { v4u o;
#pragma unroll
            for (int q = 0; q < 4; ++q) { const float a = bflo(w[c][q]) * inv * gain[c * 8 + 2 * q], b = bfhi(w[c][q]) * inv * gain[c * 8 + 2 * q + 1]; o[q] = pk2(a, b); }
            p[c] = o; }
    }
}

template <int MODE>
__device__ __forceinline__ void attn_simple_causal(Frame& F, const bf16* Qp, const bf16* Kp, const bf16* Vp, bf16* O, const float* cum) {
    LAS float* Ks = (LAS float*)F.lds;
    LAS float* Vs = Ks + 4096;
    LAS float* kb = Vs + 4096;
    for (int u = blockIdx.x; u < BATCH * NH * 4; u += F.G) {
        const int qblk = (u & 1) ? 3 - ((u >> 1) & 1) : ((u >> 1) & 1) * 1;
        const int bh = u >> 2, b = bh >> 4, h = bh & 15;
        const int t = qblk * 512 + F.tid;
        const size_t rowbase = (size_t)b * SEQ;
        float q[64], acc[64];
        { const GAS v4u* qp = (const GAS v4u*)(Qp + (rowbase + t) * DM + h * 64);
#pragma unroll
          for (int c = 0; c < 8; ++c) { const v4u w = qp[c];
#pragma unroll
              for (int k = 0; k < 4; ++k) { q[c * 8 + 2 * k] = bflo(w[k]); q[c * 8 + 2 * k + 1] = bfhi(w[k]); } } }
#pragma unroll
        for (int d = 0; d < 64; ++d) acc[d] = 0.f;
        float P = 1.f, mrun = -INFINITY, lrun = 0.f;
        const int ntile = 8 * (qblk + 1);
        for (int it = 0; it < ntile; ++it) {
            const int tile = (MODE == 0) ? ntile - 1 - it : it;
            __syncthreads();
            { const int key = F.tid >> 3, ch = F.tid & 7;
              const v4u kw = *(const GAS v4u*)(Kp + (rowbase + tile * 64 + key) * DM + h * 64 + ch * 8);
              const v4u vw = *(const GAS v4u*)(Vp + (rowbase + tile * 64 + key) * DM + h * 64 + ch * 8);
#pragma unroll
              for (int k = 0; k < 4; ++k) { Ks[key * 64 + ch * 8 + 2 * k] = bflo(kw[k]); Ks[key * 64 + ch * 8 + 2 * k + 1] = bfhi(kw[k]);
                                            Vs[key * 64 + ch * 8 + 2 * k] = bflo(vw[k]); Vs[key * 64 + ch * 8 + 2 * k + 1] = bfhi(vw[k]); }
              if (MODE == 2 && F.tid < 64) kb[F.tid] = -cum[(rowbase + tile * 64 + F.tid) * 16 + h]; }
            __syncthreads();
            for (int jj = 0; jj < 64; ++jj) {
                const int j = (MODE == 0) ? 63 - jj : jj; const int s = tile * 64 + j;
                float z = 0.f;
#pragma unroll
                for (int d4 = 0; d4 < 16; ++d4) { const f32x4 kv = *(const LAS f32x4*)(Ks + j * 64 + d4 * 4); z += q[d4 * 4] * kv.x + q[d4 * 4 + 1] * kv.y + q[d4 * 4 + 2] * kv.z + q[d4 * 4 + 3] * kv.w; }
                if (MODE == 0) {
                    const bool valid = s < t;
                    const float e = __builtin_amdgcn_exp2f(fminf(z, 100.f));
                    float r = 1.0f / (1.0f + e); float beta = 1.0f - r;
                    if (!valid) { r = 1.f; beta = 0.f; }
                    const float w = beta * P; P *= r;
#pragma unroll
                    for (int d4 = 0; d4 < 16; ++d4) { const f32x4 vv = *(const LAS f32x4*)(Vs + j * 64 + d4 * 4); acc[d4 * 4] += w * vv.x; acc[d4 * 4 + 1] += w * vv.y; acc[d4 * 4 + 2] += w * vv.z; acc[d4 * 4 + 3] += w * vv.w; }
                } else {
                    const bool valid = s <= t;
                    const float x = valid ? z + kb[j] : -INFINITY;
                    const float mn = fmaxf(mrun, x);
                    const float a = __builtin_amdgcn_exp2f(mrun - mn), pw = __builtin_amdgcn_exp2f(x - mn);
                    lrun = lrun * a + pw; mrun = mn;
#pragma unroll
                    for (int d4 = 0; d4 < 16; ++d4) { const f32x4 vv = *(const LAS f32x4*)(Vs + j * 64 + d4 * 4);
                        acc[d4 * 4] = acc[d4 * 4] * a + pw * vv.x; acc[d4 * 4 + 1] = acc[d4 * 4 + 1] * a + pw * vv.y; acc[d4 * 4 + 2] = acc[d4 * 4 + 2] * a + pw * vv.z; acc[d4 * 4 + 3] = acc[d4 * 4 + 3] * a + pw * vv.w; }
                }
            }
        }
        const float fin = (MODE == 0) ? 1.f : 1.0f / lrun;
        GAS v4u* op = (GAS v4u*)(O + (rowbase + t) * DM + h * 64);
#pragma unroll
        for (int c = 0; c < 8; ++c) { v4u w;
#pragma unroll
            for (int k = 0; k < 4; ++k) w[k] = pk2(acc[c * 8 + 2 * k] * fin, acc[c * 8 + 2 * k + 1] * fin);
            op[c] = w; }
    }
}

__device__ __forceinline__ int t5_bucket(int dist) {
    if (dist < 16) return dist;
    const float d = (float)dist;
    int lb = 16 + (int)(logf(d / 16.0f) / logf(128.0f) * 16.0f);
    return lb < 31 ? lb : 31;
}
__device__ __forceinline__ void attn_simple_dil(Frame& F, const bf16* PROJ, bf16* O, const float* rel_bias) {
    LAS float* tbl = (LAS float*)F.lds;
    for (int u = blockIdx.x; u < BATCH * NH * 4; u += F.G) {
        const int qblk = u & 3, bh = u >> 2, b = bh >> 4, h = bh & 15;
        const int t = qblk * 512 + F.tid;
        const size_t rowbase = (size_t)b * SEQ;
        __syncthreads();
        for (int i = F.tid; i < 3 * 129; i += NTHR) { const int g = i / 129, dl = i % 129, dil = (g == 0) ? 1 : (g == 1) ? 4 : 16;
            tbl[g * 132 + dl] = rel_bias[t5_bucket(dl * dil) * 16 + h] * LOG2E; }
        __syncthreads();
        float acc[64];
#pragma unroll
        for (int d = 0; d < 64; ++d) acc[d] = 0.f;
        float mrun = -INFINITY, lrun = 0.f;
        for (int g = 0; g < 3; ++g) {
            const int dil = (g == 0) ? 1 : (g == 1) ? 4 : 16;
            const bf16* Qg = PROJ + (size_t)(2 * g) * PLANE; const bf16* Kg = PROJ + (size_t)(2 * g + 1) * PLANE; const bf16* Vg = PROJ + (size_t)6 * PLANE;
            float q[64];
            { const GAS v4u* qp = (const GAS v4u*)(Qg + (rowbase + t) * DM + h * 64);
#pragma unroll
              for (int c = 0; c < 8; ++c) { const v4u w = qp[c];
#pragma unroll
                  for (int k = 0; k < 4; ++k) { q[c * 8 + 2 * k] = bflo(w[k]); q[c * 8 + 2 * k + 1] = bfhi(w[k]); } } }
            for (int dl = 0; dl <= 128; ++dl) {
                const int s = t - dl * dil; const bool valid = s >= 0; const int sc = valid ? s : 0;
                const GAS v4u* kp = (const GAS v4u*)(Kg + (rowbase + sc) * DM + h * 64);
                float z = 0.f;
#pragma unroll
                for (int c = 0; c < 8; ++c) { const v4u w = kp[c];
#pragma unroll
                    for (int k = 0; k < 4; ++k) z += q[c * 8 + 2 * k] * bflo(w[k]) + q[c * 8 + 2 * k + 1] * bfhi(w[k]); }
                const float x = valid ? z + tbl[g * 132 + dl] : -INFINITY;
                const float mn = fmaxf(mrun, x);
                const float a = __builtin_amdgcn_exp2f(mrun - mn), pw = __builtin_amdgcn_exp2f(x - mn);
                lrun = lrun * a + pw; mrun = mn;
                const GAS v4u* vp = (const GAS v4u*)(Vg + (rowbase + sc) * DM + h * 64);
#pragma unroll
                for (int c = 0; c < 8; ++c) { const v4u w = vp[c];
#pragma unroll
                    for (int k = 0; k < 4; ++k) { acc[c * 8 + 2 * k] = acc[c * 8 + 2 * k] * a + pw * bflo(w[k]); acc[c * 8 + 2 * k + 1] = acc[c * 8 + 2 * k + 1] * a + pw * bfhi(w[k]); } }
            }
        }
        const float fin = 1.0f / lrun;
        GAS v4u* op = (GAS v4u*)(O + (rowbase + t) * DM + h * 64);
#pragma unroll
        for (int c = 0; c < 8; ++c) { v4u w;
#pragma unroll
            for (int k = 0; k < 4; ++k) w[k] = pk2(acc[c * 8 + 2 * k] * fin, acc[c * 8 + 2 * k + 1] * fin);
            op[c] = w; }
    }
}

__device__ __forceinline__ void moe_gu_simple(Frame& F, int f, const bf16* H, bf16* ACT) {
    const int* list = (const int*)(F.ws + WS_MISC + MS_LIST) + (size_t)f * NE * LCAP;
    int base = 0;
    for (int e = 0; e < NE; ++e) {
        const int c = moe_cnt(F, f, e); const int nt = (c + 255) >> 8;
        if (nt) {
            SgP p{}; p.A = H; p.lda = DM; p.rowidx = list + e * LCAP; p.Mrows = nt * 256;
            p.W0 = INP(19) + ((size_t)f * NE + e) * DM * FF; p.W1 = INP(20) + ((size_t)f * NE + e) * DM * FF; p.ldw = FF; p.K = DM; p.N = FF;
            p.outb = ACT + (size_t)base * 256 * FF; p.ldo = FF;
            sgemm<EPI_SWIGLU>(F, p);
        }
        base += nt;
    }
}
__device__ __forceinline__ void moe_down_simple(Frame& F, int f, const bf16* ACT, float* Y) {
    const float* gw = (const float*)(F.ws + WS_MISC + MS_GW) + (size_t)f * NE * LCAP;
    int base = 0;
    for (int e = 0; e < NE; ++e) {
        const int c = moe_cnt(F, f, e); const int nt = (c + 255) >> 8;
        if (nt) {
            SgP p{}; p.A = ACT + (size_t)base * 256 * FF; p.lda = FF; p.rowidx = nullptr; p.Mrows = nt * 256;
            p.W0 = INP(21) + ((size_t)f * NE + e) * FF * DM; p.ldw = DM; p.K = FF; p.N = DM;
            p.outf = Y + (size_t)base * 256 * DM; p.gwv = gw + e * LCAP;
            sgemm<EPI_MOEDOWN>(F, p);
        }
        base += nt;
    }
}


template <class Epi, bool FP8 = false>
__device__ __forceinline__ void dense_gemm(Frame& F, const bf16* A, const bf16* Bt, int N, int K, const Epi& E) {
    pg8::DenseOrder S; S.init(A, Bt, M, N, K, F.G, (int)blockIdx.x);
    pg8::gemm_phase<Epi, pg8::DenseOrder, false, FP8>(F.lds, K, S, E);
}
__device__ __forceinline__ void moe_order_init(Frame& F, int f, pg8::MoeOrder& S) {
    int acc = 0, t[NE];
#pragma unroll
    for (int e = 0; e < NE; ++e) { const int c = moe_cnt(F, f, e); acc += (c + 255) >> 8; t[e] = acc; }
    S.t1 = t[0]; S.t2 = t[1]; S.t3 = t[2]; S.t4 = t[3]; S.t5 = t[4]; S.t6 = t[5]; S.t7 = t[6]; S.t8 = t[7];
    S.G = F.G; S.c = (int)blockIdx.x;
}
__device__ __forceinline__ void moe_gu_fast(Frame& F, int f, const bf16* H, bf16* ACT) {
    pg8::MoeOrder S; moe_order_init(F, f, S);
    S.list = (const int*)(F.ws + WS_MISC + MS_LIST) + (size_t)f * NE * LCAP; S.gather = true; S.splitk = 0; S.nN = 2 * FF / 256;
    if (MOE_FP8) {
        S.K = DM / 2; S.A = (const char*)(F.ws + WS_R2 + 104 * MiB); S.Bt = (const char*)((const bf16*)(F.ws + WS_W) + WE_MGU) + (size_t)f * NE * 2 * FF * DM;
        S.tstepA = (size_t)256 * DM; S.tstepB = (size_t)256 * DM; S.estepB = (size_t)2 * FF * DM;
        pg8::EpiSwigluF8 E{(unsigned char*)ACT};
        pg8::gemm_phase<pg8::EpiSwigluF8, pg8::MoeOrder, true, true>(F.lds, DM / 2, S, E);
    } else {
        S.K = DM; S.A = (const char*)H; S.Bt = (const char*)((const bf16*)(F.ws + WS_W) + WE_MGU + (size_t)f * NE * 2 * FF * DM);
        S.tstepA = (size_t)256 * DM * 2; S.tstepB = (size_t)256 * DM * 2; S.estepB = (size_t)2 * FF * DM * 2;
        pg8::EpiSwiglu E{ACT};
        pg8::gemm_phase<pg8::EpiSwiglu, pg8::MoeOrder, true>(F.lds, DM, S, E);
    }
}
__device__ __forceinline__ void moe_down_fast(Frame& F, int f, const bf16* ACT, bf16* Y) {
    pg8::MoeOrder S; moe_order_init(F, f, S);
    S.nN = DM / 256; S.list = nullptr; S.gather = false; S.splitk = (MOE_SPLITK && F.G == 256) ? MOE_NSPLIT : 0;
    const float* gwp = (const float*)(F.ws + WS_MISC + MS_GW) + (size_t)f * NE * LCAP; bf16* P = (bf16*)(F.ws + WS_R2 + 72 * MiB);
    if (MOE_FP8) {
        S.K = FF / 2; S.A = (const char*)ACT; S.Bt = (const char*)((const bf16*)(F.ws + WS_W) + WE_MD) + (size_t)f * NE * DM * FF;
        S.tstepA = (size_t)256 * FF; S.tstepB = (size_t)256 * FF; S.estepB = (size_t)DM * FF;
        pg8::EpiMoeDown E{Y, gwp, P, 1.0f / (W8S * A8S)};
        pg8::gemm_phase<pg8::EpiMoeDown, pg8::MoeOrder, false, true>(F.lds, FF / 2, S, E);
    } else {
        S.K = FF; S.A = (const char*)ACT; S.Bt = (const char*)((const bf16*)(F.ws + WS_W) + WE_MD + (size_t)f * NE * DM * FF);
        S.tstepA = (size_t)256 * FF * 2; S.tstepB = (size_t)256 * FF * 2; S.estepB = (size_t)DM * FF * 2;
        pg8::EpiMoeDown E{Y, gwp, P, 1.0f};
        pg8::gemm_phase<pg8::EpiMoeDown, pg8::MoeOrder, false>(F.lds, FF, S, E);
    }
}

struct Args { const float* in[22]; float* out; unsigned char* ws; int ph_lo, ph_hi; };
constexpr int N_PHASES = 33;

__global__ void __launch_bounds__(NTHR, 2) trunk_fwd(Args args) {
    extern __shared__ __attribute__((aligned(16))) unsigned char lds[];
    Frame F;
    F.lds = (LAS unsigned char*)lds;
    F.tid = threadIdx.x; F.lane = F.tid & 63; F.wave = __builtin_amdgcn_readfirstlane(F.tid >> 6); F.G = gridDim.x;
    F.ws = args.ws; F.ctl = (gu32*)(args.ws + WS_CTL); F.out = args.out;
    if (F.tid == 0) {
#pragma unroll
        for (int i = 0; i < 22; ++i) ((LAS unsigned long long*)(F.lds + PTR_OFF))[i] = (unsigned long long)args.in[i];
    }
    volatile LAS unsigned* MISC = (volatile LAS unsigned*)(F.lds + MISC_OFF);
    if (F.tid < 32) MISC[F.tid] = 0u;
    __syncthreads();
    XcdBarrier bar; bar.bar = (unsigned*)(F.ctl + CW_BAR); bar.x = 0; bar.st = nullptr;
    const int lo = args.ph_lo, hi = args.ph_hi;
    if (hi - lo > 1) bar = xcd_barrier_post((unsigned*)(F.ctl + CW_BAR), MISC + 8);
#ifndef PHSEL
#define PHSEL 0xFFFFFFFFFFFFFFFFull
#endif
#define IN(k) (lo <= (k) && (k) < hi && ((PHSEL >> (k)) & 1ull) && relaunder(F))
#define SEAM(k) do { if (IN((k) + 1) && IN(k)) xcd_barrier(bar); } while (0)
#ifndef DUPMASK
#define DUPMASK 0ull
#endif
#define DUP(k) (((DUPMASK >> (k)) & 1ull) != 0ull)

    bf16* H = (bf16*)(F.ws + WS_H);
    bf16* PROJ = (bf16*)(F.ws + WS_R1);
    bf16* ACT = (bf16*)(F.ws + WS_R1);
    bf16* O = (bf16*)(F.ws + WS_R2);
    bf16* Y = (bf16*)(F.ws + WS_R2);
    bf16* OG = (bf16*)(F.ws + WS_R2 + 32 * MiB);
    float* ST = (float*)(F.ws + WS_R2 + 128 * MiB);
    float* X = F.out;
    const bf16* H8 = (const bf16*)(F.ws + WS_R2 + 104 * MiB);
    float* DUMMY = (float*)(F.ws + WS_R2 + 32 * MiB);
    const float* cum = (const float*)(F.ws + WS_MISC + MS_CUM);

    const bf16* WB = (const bf16*)(F.ws + WS_W);
    enum { PH_BASE = __COUNTER__ + 1 };
#define PHASE(...) { constexpr int k_ = __COUNTER__ - PH_BASE; if (IN(k_)) { __VA_ARGS__; if (DUP(k_)) { xcd_barrier(bar); __VA_ARGS__; } SEAM(k_); } }
    PHASE({ unsigned* z = (unsigned*)(F.ws + WS_MISC + MS_LIST);
            for (int i = blockIdx.x * NTHR + F.tid; i < (int)(2 * MiB / 4); i += F.G * NTHR) z[i] = 0u;
            convert_weights(F); })
    PHASE(norm_phase<0>(F, INP(0), nullptr, INP(13) + 0 * DM, H, 0, 0, nullptr, nullptr, nullptr))
    PHASE({ pg8::EpiPlanes E{PROJ, C2}; dense_gemm(F, H, WB + WE_QKV, 3 * DM, DM, E); })
    PHASE(att::causal_phase<0>((att::lptr)F.lds, F.G, PROJ, PROJ + PLANE, PROJ + 2 * PLANE, O, nullptr))
    PHASE({ pg8::EpiResid E{INP(0), X, 1.0f}; dense_gemm(F, O, WB + WE_WO_SB, DM, DM, E); })
    PHASE(norm_phase<DENSE_FP8_L0 ? 8 : 0>(F, X, nullptr, INP(14) + 0 * DM, H, 0, 0, nullptr, nullptr, nullptr))
    PHASE({ if (DENSE_FP8_L0) { pg8::EpiSwigluF8 E{(unsigned char*)ACT}; dense_gemm<pg8::EpiSwigluF8, true>(F, H8, (const bf16*)((const unsigned char*)(WB + WE_GU)), 2 * FF, DM / 2, E); }
            else { pg8::EpiSwiglu E{ACT}; dense_gemm(F, H, WB + WE_GU, 2 * FF, DM, E); } })
    PHASE({ if (DENSE_FP8_L0) { pg8::EpiResid E{X, X, 1.0f / (W8S * A8S)}; dense_gemm<pg8::EpiResid, true>(F, ACT, (const bf16*)((const unsigned char*)(WB + WE_D)), DM, FF / 2, E); }
            else { pg8::EpiResid E{X, X, 1.0f}; dense_gemm(F, ACT, WB + WE_D, DM, FF, E); } })
    PHASE(norm_phase<0>(F, X, nullptr, INP(13) + 1 * DM, H, 0, 0, nullptr, nullptr, nullptr))
    PHASE({ pg8::EpiQKNorm E{PROJ, INP(4), INP(5), 6}; dense_gemm(F, H, WB + WE_IN_DIL, 7 * DM, DM, E); })
    PHASE(att::dil_phase((att::lptr)F.lds, F.G, PROJ, OG, ST, INP(12)))
    PHASE(att::dil_merge(F.G, OG, ST, O))
    PHASE({ pg8::EpiResid E{X, X, 1.0f}; dense_gemm(F, O, WB + WE_WO_DIL, DM, DM, E); })
    PHASE(norm_phase<4>(F, X, nullptr, INP(14) + 1 * DM, H, 0, 0, nullptr, nullptr, INP(18) + 0 * DM * NE))
    PHASE(moe_finalize(F, 0))
    PHASE(moe_gu_fast(F, 0, H, ACT))
    PHASE(moe_down_fast(F, 0, ACT, Y))
    PHASE(norm_phase<1 | 2>(F, X, X, INP(13) + 2 * DM, H, 0, 0, INP(7), INP(8), nullptr))
    PHASE({ cumsum_phase(F); pg8::EpiQKNorm E{PROJ, INP(9), INP(10), 2}; dense_gemm(F, H, WB + WE_IN_FOX, 3 * DM, DM, E); })
    PHASE(att::causal_phase<2>((att::lptr)F.lds, F.G, PROJ, PROJ + PLANE, PROJ + 2 * PLANE, O, cum))
    PHASE({ pg8::EpiResid E{X, X, 1.0f}; dense_gemm(F, O, WB + WE_WO_FOX, DM, DM, E); })
    PHASE(norm_phase<DENSE_FP8_L2 ? 8 : 0>(F, X, nullptr, INP(14) + 2 * DM, H, 0, 0, nullptr, nullptr, nullptr))
    PHASE({ if (DENSE_FP8_L2) { pg8::EpiSwigluF8 E{(unsigned char*)ACT}; dense_gemm<pg8::EpiSwigluF8, true>(F, H8, WB + WE_GU + (size_t)2 * FF * DM, 2 * FF, DM / 2, E); }
            else { pg8::EpiSwiglu E{ACT}; dense_gemm(F, H, WB + WE_GU + (size_t)2 * FF * DM, 2 * FF, DM, E); } })
    PHASE({ if (DENSE_FP8_L2) { pg8::EpiResid E{X, X, 1.0f / (W8S * A8S)}; dense_gemm<pg8::EpiResid, true>(F, ACT, WB + WE_D + (size_t)DM * FF, DM, FF / 2, E); }
            else { pg8::EpiResid E{X, X, 1.0f}; dense_gemm(F, ACT, WB + WE_D + (size_t)DM * FF, DM, FF, E); } })
    PHASE(norm_phase<0>(F, X, nullptr, INP(13) + 3 * DM, H, 0, 0, nullptr, nullptr, nullptr))
    PHASE({ pg8::EpiPlanes E{PROJ, C2}; dense_gemm(F, H, WB + WE_QKV + (size_t)3 * DM * DM, 3 * DM, DM, E); })
    PHASE(att::causal_phase<0>((att::lptr)F.lds, F.G, PROJ, PROJ + PLANE, PROJ + 2 * PLANE, O, nullptr))
    PHASE({ pg8::EpiResid E{X, X, 1.0f}; dense_gemm(F, O, WB + WE_WO_SB + (size_t)DM * DM, DM, DM, E); })
    PHASE(norm_phase<4>(F, X, nullptr, INP(14) + 3 * DM, H, 0, 1, nullptr, nullptr, INP(18) + 1 * DM * NE))
    PHASE(moe_finalize(F, 1))
    PHASE(moe_gu_fast(F, 1, H, ACT))
    PHASE(moe_down_fast(F, 1, ACT, Y))
    PHASE(final_combine(F, 1))
    static_assert(__COUNTER__ - PH_BASE == N_PHASES, "N_PHASES must equal the number of PHASE() sites");
#undef PHASE
#undef IN
#undef SEAM
}

extern "C" void kernel_launch(void* const* d_in, const int* in_sizes, int n_in, void* d_out, int out_size, void* d_ws, size_t ws_size, hipStream_t stream) {
    static int grid = 0;
    if (grid == 0) {
        if (n_in != 22 || out_size != M * DM || ws_size < WS_END) { fprintf(stderr, "kernel_launch: unexpected shapes (n_in %d out %d ws %zu)\n", n_in, out_size, ws_size); grid = -1; return; }
        int dev = 0, cus = 0, per_cu = 0;
        if (hipGetDevice(&dev) != hipSuccess || hipDeviceGetAttribute(&cus, hipDeviceAttributeMultiprocessorCount, dev) != hipSuccess) { grid = -1; return; }
        if (hipFuncSetAttribute((const void*)trunk_fwd, hipFuncAttributeMaxDynamicSharedMemorySize, LDS_BYTES) != hipSuccess) { fprintf(stderr, "kernel_launch: hipFuncSetAttribute failed\n"); grid = -1; return; }
        if (hipOccupancyMaxActiveBlocksPerMultiprocessor(&per_cu, (const void*)trunk_fwd, NTHR, LDS_BYTES) != hipSuccess || per_cu < 1) fprintf(stderr, "kernel_launch: occupancy query says %d\n", per_cu);
        (void)hipGetLastError();
        grid = cus;
    }
    if (grid < 0) return;
    (void)hipMemsetAsync((char*)d_ws + WS_CTL, 0, CTL_ZERO_BYTES, stream);
    Args a{};
    for (int i = 0; i < 22; ++i) a.in[i] = (const float*)d_in[i];
    a.out = (float*)d_out; a.ws = (unsigned char*)d_ws;
#if MK_MULTI
    for (int p = 0; p < N_PHASES; ++p) { a.ph_lo = p; a.ph_hi = p + 1; hipLaunchKernelGGL(trunk_fwd, dim3(grid), dim3(NTHR), LDS_BYTES, stream, a); }
#else
    a.ph_lo = 0; a.ph_hi = N_PHASES;
    hipLaunchKernelGGL(trunk_fwd, dim3(grid), dim3(NTHR), LDS_BYTES, stream, a);
#endif
}
```

```cpp
#include <hip/hip_runtime.h>
#include <cstdio>
#include <cstdint>

#ifndef MK_MULTI
#define MK_MULTI 0
#endif

constexpr int BATCH = 8, SEQ = 2048, DM = 1024, NH = 16, HD = 64, FF = 3584, NE = 8;
constexpr int M = BATCH * SEQ;
constexpr float RMS_EPS = 1e-6f;
constexpr float LOG2E = 1.4426950408889634f;
constexpr float C2 = 0.125f * LOG2E;
constexpr int NWAVES = 8, NTHR = 512;
constexpr int LCAP = 16384;
constexpr int MAXROWS = 34816;
constexpr bool MOE_SPLITK = true;
constexpr bool MOE_FP8 = true;
constexpr bool DENSE_FP8_L0 = false, DENSE_FP8_L2 = true;
constexpr float W8S = 32.0f, A8S = 4.0f;
constexpr int MOE_NSPLIT = MOE_FP8 ? 2 : 4;
constexpr int SPLIT_ROW0 = 32768, SPLIT_ROWS = MAXROWS - SPLIT_ROW0;

constexpr size_t MiB = 1u << 20;
constexpr size_t WS_CTL = 0, CTL_ZERO_BYTES = 1 * MiB;
constexpr size_t WS_MISC = 1 * MiB;
constexpr size_t WS_H = 6 * MiB;
constexpr size_t WS_R1 = 38 * MiB;
constexpr size_t WS_R2 = 278 * MiB;
constexpr size_t WS_W = 414 * MiB;
constexpr size_t WS_END = 832 * MiB;
constexpr size_t PLANE = (size_t)M * DM;
constexpr size_t WE_QKV = 0;
constexpr size_t WE_WO_SB = WE_QKV + 2ull * 3072 * 1024;
constexpr size_t WE_WO_DIL = WE_WO_SB + 2ull * 1024 * 1024;
constexpr size_t WE_WO_FOX = WE_WO_DIL + 1024ull * 1024;
constexpr size_t WE_IN_DIL = WE_WO_FOX + 1024ull * 1024;
constexpr size_t WE_IN_FOX = WE_IN_DIL + 7168ull * 1024;
constexpr size_t WE_GU = WE_IN_FOX + 3072ull * 1024;
constexpr size_t WE_D = WE_GU + 2ull * 7168 * 1024;
constexpr size_t WE_MGU = WE_D + 2ull * 1024 * 3584;
constexpr size_t WE_MD = WE_MGU + 16ull * 7168 * 1024;
constexpr size_t WE_END = WE_MD + 16ull * 1024 * 3584;
static_assert(WS_W + WE_END * 2 <= WS_END, "weight copies fit");
constexpr size_t MS_LIST = 0;
constexpr size_t MS_GW = 1 * MiB;
constexpr size_t MS_TOK = 2 * MiB;
constexpr size_t MS_LOGF = 2 * MiB + 256 * 1024;
constexpr size_t MS_CUM = 3 * MiB + 256 * 1024;
constexpr size_t MS_SEL = 4 * MiB + 256 * 1024;
constexpr size_t MS_SG = MS_SEL + 256 * 1024;
constexpr size_t MS_LC = MS_SG + 256 * 1024;
constexpr int CW_BAR = 4096;
constexpr int CW_CNT = 64;

#define GAS __attribute__((address_space(1)))
#define LAS __attribute__((address_space(3)))
typedef unsigned short bf16;
typedef unsigned v4u __attribute__((ext_vector_type(4)));
typedef unsigned v2u __attribute__((ext_vector_type(2)));
typedef float f32x4 __attribute__((ext_vector_type(4)));
typedef float f32x2 __attribute__((ext_vector_type(2)));
typedef GAS unsigned gu32;
#define RLX_AGENT __ATOMIC_RELAXED, __HIP_MEMORY_SCOPE_AGENT
__device__ __forceinline__ unsigned f2bf(float f) { unsigned u = __builtin_bit_cast(unsigned, f); return (u + 0x7fffu + ((u >> 16) & 1u)) >> 16; }
__device__ __forceinline__ unsigned pk2(float lo, float hi) { return f2bf(lo) | (f2bf(hi) << 16); }
__device__ __forceinline__ float bflo(unsigned u) { return __builtin_bit_cast(float, u << 16); }
__device__ __forceinline__ float bfhi(unsigned u) { return __builtin_bit_cast(float, u & 0xffff0000u); }

#define XB_TMO      128
#define XB_XCNT(j)  (256  + 64 * (j))
#define XB_XSUB(j)  (1280 + 64 * (j))
#define XB_XGEN(j)  (2304 + 64 * (j))
#define XB_TOP      3328
#define XB_TOPGEN   3392
#define XCD_BAR_WORDS 3456
#define XB_SPIN_CAP (1u << 22)
__device__ __forceinline__ unsigned xb_ld(unsigned* p)              { return __hip_atomic_load(p, __ATOMIC_RELAXED, __HIP_MEMORY_SCOPE_AGENT); }
__device__ __forceinline__ unsigned xb_add(unsigned* p, unsigned v) { return __hip_atomic_fetch_add(p, v, __ATOMIC_RELAXED, __HIP_MEMORY_SCOPE_AGENT); }
__device__ __forceinline__ unsigned xb_xcc_id() { return (unsigned)__builtin_amdgcn_s_getreg((3 << 11) | 20) & 0xFu; }
#define XB_SPIN(cond, bar) do { unsigned _sp = 0; while (cond) { __builtin_amdgcn_s_sleep(1); \
    if ((++_sp & 255u) == 0u) { if (xb_ld(&(bar)[XB_TMO])) break; if (_sp > XB_SPIN_CAP) { atomicAdd(&(bar)[XB_TMO], 1u); break; } } } } while (0)
struct XcdBarrier { unsigned* bar; unsigned x; volatile LAS unsigned* st; };
__device__ __forceinline__ XcdBarrier xcd_barrier_post(unsigned* bar, volatile LAS unsigned* st) {
    XcdBarrier b; b.bar = bar; b.x = xb_xcc_id(); b.st = st;
    if (threadIdx.x == 0) (void)xb_add(&bar[XB_XCNT(b.x)], 1u);
    return b;
}
__device__ __forceinline__ void xcd_barrier_complete(unsigned* bar, unsigned x, unsigned& nloc, unsigned& nx) {
    const unsigned G = gridDim.x * gridDim.y * gridDim.z;
    unsigned sum, cnt, mine, sp = 0u;
    for (;;) {
        sum = 0u; cnt = 0u; mine = 0u;
#pragma unroll
        for (unsigned j = 0; j < 16; ++j) { const unsigned c = xb_ld(&bar[XB_XCNT(j)]); sum += c; cnt += (c > 0u) ? 1u : 0u; mine = (j == x) ? c : mine; }
        if (sum == G) break;
        __builtin_amdgcn_s_sleep(1);
        if ((++sp & 255u) == 0u) { if (xb_ld(&bar[XB_TMO])) break; if (sp > XB_SPIN_CAP) { atomicAdd(&bar[XB_TMO], 1u); break; } }
    }
    nloc = mine > 0u ? mine : 1u; nx = cnt > 0u ? cnt : 1u;
}
__device__ __forceinline__ void xcd_barrier(const XcdBarrier& b) {
    asm volatile("s_waitcnt vmcnt(0)" ::: "memory");
    __syncthreads();
    if (threadIdx.x == 0) {
        unsigned* bar = b.bar;
        __builtin_amdgcn_s_waitcnt(0);
        unsigned nloc = b.st[0], nx = b.st[1];
        if (nloc == 0u) { xcd_barrier_complete(bar, b.x, nloc, nx); b.st[0] = nloc; b.st[1] = nx; }
        const unsigned old = xb_add(&bar[XB_XSUB(b.x)], 1u);
        const unsigned gen = old / nloc;
        if (old + 1u == (gen + 1u) * nloc) {
            __builtin_amdgcn_fence(__ATOMIC_RELEASE, "agent");
            asm volatile("s_waitcnt vmcnt(0)" ::: "memory");
            const unsigned og = xb_add(&bar[XB_TOP], 1u);
            const unsigned tg = og / nx;
            if (og + 1u == (tg + 1u) * nx) xb_add(&bar[XB_TOPGEN], 1u);
            else XB_SPIN(xb_ld(&bar[XB_TOPGEN]) == tg, bar);
            __builtin_amdgcn_fence(__ATOMIC_ACQUIRE, "agent");
            xb_add(&bar[XB_XGEN(b.x)], 1u);
            asm volatile("s_waitcnt vmcnt(0)" ::: "memory");
        } else {
            XB_SPIN(xb_ld(&bar[XB_XGEN(b.x)]) == gen, bar);
            __builtin_amdgcn_fence(__ATOMIC_ACQUIRE, "agent");
            asm volatile("s_waitcnt vmcnt(0)" ::: "memory");
        }
    }
    __syncthreads();
}

constexpr int LDS_BYTES = 147456;
constexpr int ATT_LDS_MAX = 143360;
constexpr int MISC_OFF = ATT_LDS_MAX + 64;
struct Frame {
    LAS unsigned char* lds;
    int tid, lane, wave, G;
    unsigned char* ws; gu32* ctl;
    float* out;
};
__device__ __forceinline__ float wave_sum(float v) {
#pragma unroll
    for (int o = 1; o < 64; o <<= 1) v += __shfl_xor(v, o);
    return v;
}

constexpr int PTR_OFF = ATT_LDS_MAX + 512;
__device__ __forceinline__ const float* inp_ptr(Frame& F, int k) {
    const LAS unsigned* t = (const LAS unsigned*)(F.lds + PTR_OFF) + 2 * k;
    const unsigned lo = __builtin_amdgcn_readfirstlane(t[0]), hi = __builtin_amdgcn_readfirstlane(t[1]);
    return (const float*)(((unsigned long long)hi << 32) | lo);
}
#define INP(k) inp_ptr(F, (k))
__device__ __forceinline__ bool relaunder(Frame& F) { int t_ = threadIdx.x; asm volatile("" : "+v"(t_)); F.tid = t_; F.lane = t_ & 63; F.wave = __builtin_amdgcn_readfirstlane(t_ >> 6); return true; }
namespace pg8 {
#define PG8_LAS __attribute__((address_space(3)))
typedef unsigned short bf16_t;
typedef short bf16x8 __attribute__((ext_vector_type(8)));
typedef unsigned u32x4 __attribute__((ext_vector_type(4)));
constexpr int BM = 256, BK = 64, HALF = 128, HTB = HALF * BK * 2, STAGE_BYTES = 8 * HTB, NXCD = 8, WGM = 8;
__host__ __device__ __forceinline__ int lds_byte(int r, int c) { const int st = (r >> 4) * 2 + (c >> 5), rr = r & 15, cc = c & 31, ob = rr * 64 + cc * 2; return st * 1024 + (ob ^ (((ob >> 9) & 1) << 5)); }
__host__ __device__ __forceinline__ void stage_rc(int b, int& R, int& C) { const int st = b / 1024, sb = b % 1024, swz = sb ^ (((sb >> 9) & 1) << 5); R = (st >> 1) * 16 + swz / 64; C = (st & 1) * 32 + (swz % 64) / 2; }
__host__ __device__ __forceinline__ int perm32(int rho) { const int n = rho >> 4, i = rho & 15; return 8 * (i >> 2) + 4 * n + (i & 3); }
struct Unit { int pm, pn, e, mt, nt, koff, kq; };

struct DenseOrder {
    int nM, nN, nwg, G, c, ntk; const char* A; const char* Bt; size_t tstep;
    __device__ __forceinline__ void init(const bf16_t* A_, const bf16_t* Bt_, int M_, int N_, int K_, int G_, int c_) { nM = M_ / BM; nN = N_ / BM; nwg = nM * nN; G = G_; c = c_; ntk = K_ / BK; A = (const char*)A_; Bt = (const char*)Bt_; tstep = (size_t)BM * K_ * 2; }
    __device__ __forceinline__ bool next(int i, Unit& u) const {
        const long L = (long)i * G + c; if (L >= nwg) return false;
        int wgid = (int)L; { const int q = nwg / NXCD, r = nwg % NXCD, xcd = wgid % NXCD, off = wgid / NXCD; wgid = (xcd < r ? xcd * (q + 1) : r * (q + 1) + (xcd - r) * q) + off; }
        const int nig = WGM * nN, gid = wgid / nig, fm = gid * WGM, gsz = (nM - fm) < WGM ? (nM - fm) : WGM;
        u.pm = fm + ((wgid % nig) % gsz); u.pn = (wgid % nig) / gsz; u.e = 0; u.mt = u.pm; u.nt = ntk; u.koff = 0; u.kq = -1; return true;
    }
    __device__ __forceinline__ const char* a_base(const Unit& u) const { return A + (size_t)u.pm * tstep; }
    __device__ __forceinline__ const char* b_base(const Unit& u) const { return Bt + (size_t)u.pn * tstep; }
    __device__ __forceinline__ void a_voff(const Unit&, const int (&)[2], const int (&)[2], unsigned (&)[2][2]) const {}
};
struct MoeOrder {
    int t1, t2, t3, t4, t5, t6, t7, t8, nN, G, c, K; const char* A; const char* Bt; size_t tstepA, tstepB, estepB; const int* list; bool gather; int splitk;
    __device__ __forceinline__ bool next(int i, Unit& u) const {
        const int X = i * G + c, U = t8 * nN; int L = X; u.nt = K / BK; u.koff = 0; u.kq = -1;
        if (splitk) { const int nfull = (U / G) * G;
            if (X >= nfull) { const int q = X - nfull; if (q >= splitk * (U - nfull)) return false; L = nfull + q / splitk; u.kq = q % splitk; u.nt = K / BK / splitk; u.koff = u.kq * (K / splitk) * 2; } }
        else if (X >= U) return false;
        const int mt = L / nN; u.pm = mt; u.pn = L - mt * nN;
        const int e = (mt >= t1) + (mt >= t2) + (mt >= t3) + (mt >= t4) + (mt >= t5) + (mt >= t6) + (mt >= t7);
        const int tb = e == 0 ? 0 : e == 1 ? t1 : e == 2 ? t2 : e == 3 ? t3 : e == 4 ? t4 : e == 5 ? t5 : e == 6 ? t6 : t7;
        u.e = e; u.mt = mt - tb; return true;
    }
    __device__ __forceinline__ const char* a_base(const Unit& u) const { return (gather ? A : A + (size_t)u.pm * tstepA) + u.koff; }
    __device__ __forceinline__ const char* b_base(const Unit& u) const { return Bt + (size_t)u.e * estepB + (size_t)u.pn * tstepB + u.koff; }
    __device__ __forceinline__ void a_voff(const Unit& u, const int (&sR)[2], const int (&sC)[2], unsigned (&v)[2][2]) const {
        const int* lp = list + u.e * LCAP + u.mt * 256;
#pragma unroll
        for (int h = 0; h < 2; ++h)
#pragma unroll
            for (int i = 0; i < 2; ++i) v[h][i] = (unsigned)lp[h * 128 + sR[i]] * (unsigned)(K * 2) + (unsigned)(sC[i] * 2);
    }
};

typedef int v8i32 __attribute__((ext_vector_type(8)));
typedef int v4i32 __attribute__((ext_vector_type(4)));
__device__ __forceinline__ v8i32 cat8(bf16x8 a, bf16x8 b) { const v4i32 x = __builtin_bit_cast(v4i32, a), y = __builtin_bit_cast(v4i32, b); return (v8i32){x[0], x[1], x[2], x[3], y[0], y[1], y[2], y[3]}; }
__device__ __forceinline__ unsigned cvt4_fp8(float a, float b, float c, float d) { int w = 0; w = __builtin_amdgcn_cvt_pk_fp8_f32(a, b, w, false); w = __builtin_amdgcn_cvt_pk_fp8_f32(c, d, w, true); return (unsigned)w; }
__device__ __forceinline__ const char* uniptr(const char* p) { const unsigned long long v = (unsigned long long)p; const unsigned lo = __builtin_amdgcn_readfirstlane((unsigned)v), hi = __builtin_amdgcn_readfirstlane((unsigned)(v >> 32)); return (const char*)(((unsigned long long)hi << 32) | lo); }
__device__ __forceinline__ void glds16_s(const char* sbase, unsigned voff, unsigned lds_dst) { unsigned keep;
    asm volatile("s_mov_b32 %0, m0\n\ts_mov_b32 m0, %3\n\ts_nop 0\n\tglobal_load_lds_dwordx4 %2, %1\n\ts_mov_b32 m0, %0" : "=&s"(keep) : "s"(sbase), "v"(voff), "s"(lds_dst) : "memory"); }
__device__ __forceinline__ unsigned cvt_pk_bf16(float lo, float hi) { unsigned r; asm volatile("v_cvt_pk_bf16_f32 %0, %1, %2" : "=v"(r) : "v"(lo), "v"(hi)); return r; }

struct EpiPlanes {
    static constexpr bool PERM = true;
    bf16_t* O; float scale0;
    __device__ __forceinline__ void operator()(const f32x4 (&acc)[2][2][4][2], const Unit& u, int wr, int wc, int fr, int fq) const {
        const int plane = u.pn >> 2; const float sc = plane == 0 ? scale0 : 1.f;
        bf16_t* base = O + (size_t)plane * PLANE + (size_t)(u.pm * BM + wr * 64 + fr) * DM + (u.pn & 3) * 256 + wc * 32 + 8 * fq;
#pragma unroll
        for (int ai = 0; ai < 2; ++ai)
#pragma unroll
            for (int m = 0; m < 4; ++m) { bf16_t* rowp = base + (size_t)(ai * HALF + m * 16) * DM;
#pragma unroll
                for (int bj = 0; bj < 2; ++bj) { const f32x4 v0 = acc[ai][bj][m][0] * sc, v1 = acc[ai][bj][m][1] * sc;
                    u32x4 w; w.x = cvt_pk_bf16(v0[0], v0[1]); w.y = cvt_pk_bf16(v0[2], v0[3]); w.z = cvt_pk_bf16(v1[0], v1[1]); w.w = cvt_pk_bf16(v1[2], v1[3]);
                    *(u32x4*)(rowp + bj * HALF) = w; } }
    }
};
struct EpiQKNorm {
    static constexpr bool PERM = true;
    bf16_t* O; const float* qg; const float* kg; int vplane;
    __device__ __forceinline__ void operator()(const f32x4 (&acc)[2][2][4][2], const Unit& u, int wr, int wc, int fr, int fq) const {
        const int plane = u.pn >> 2; const bool isv = plane == vplane; const bool isq = !isv && ((plane & 1) == 0); const int grp = plane >> 1;
        const float* g = (isq ? qg : kg) + grp * 64 + 8 * fq;
        f32x4 gv[2][2];
#pragma unroll
        for (int bj = 0; bj < 2; ++bj)
#pragma unroll
            for (int n = 0; n < 2; ++n) gv[bj][n] = isv ? (f32x4){1.f, 1.f, 1.f, 1.f} : *(const f32x4*)(g + 32 * bj + 4 * n);
        const float mul = isq ? C2 : 1.f;
        bf16_t* base = O + (size_t)plane * PLANE + (size_t)(u.pm * BM + wr * 64 + fr) * DM + (u.pn & 3) * 256 + wc * 64 + 8 * fq;
#pragma unroll
        for (int ai = 0; ai < 2; ++ai)
#pragma unroll
            for (int m = 0; m < 4; ++m) { bf16_t* rowp = base + (size_t)(ai * HALF + m * 16) * DM;
                float ss = 0.f;
#pragma unroll
                for (int bj = 0; bj < 2; ++bj)
#pragma unroll
                    for (int n = 0; n < 2; ++n) { const f32x4 x = acc[ai][bj][m][n]; ss += (x[0] * x[0] + x[1] * x[1]) + (x[2] * x[2] + x[3] * x[3]); }
                ss += __shfl_xor(ss, 16); ss += __shfl_xor(ss, 32);
                const float inv = isv ? 1.f : mul / sqrtf(ss * (1.f / 64.f) + RMS_EPS);
#pragma unroll
                for (int bj = 0; bj < 2; ++bj) { const f32x4 v0 = acc[ai][bj][m][0] * inv * gv[bj][0], v1 = acc[ai][bj][m][1] * inv * gv[bj][1];
                    u32x4 w; w.x = cvt_pk_bf16(v0[0], v0[1]); w.y = cvt_pk_bf16(v0[2], v0[3]); w.z = cvt_pk_bf16(v1[0], v1[1]); w.w = cvt_pk_bf16(v1[2], v1[3]);
                    *(u32x4*)(rowp + bj * 32) = w; } }
    }
};
struct EpiSwiglu {
    static constexpr bool PERM = true;
    bf16_t* O;
    __device__ __forceinline__ void operator()(const f32x4 (&acc)[2][2][4][2], const Unit& u, int wr, int wc, int fr, int fq) const {
        bf16_t* base = O + (size_t)(u.pm * BM + wr * 64 + fr) * FF + u.pn * 128 + wc * 32 + 8 * fq;
#pragma unroll
        for (int ai = 0; ai < 2; ++ai)
#pragma unroll
            for (int m = 0; m < 4; ++m) { bf16_t* rowp = base + (size_t)(ai * HALF + m * 16) * FF;
                float o[8];
#pragma unroll
                for (int n = 0; n < 2; ++n)
#pragma unroll
                    for (int i = 0; i < 4; ++i) { const float g = acc[ai][0][m][n][i], uu = acc[ai][1][m][n][i];
                        o[n * 4 + i] = g * __builtin_amdgcn_rcpf(1.0f + __builtin_amdgcn_exp2f(-g * LOG2E)) * uu; }
                u32x4 w; w.x = cvt_pk_bf16(o[0], o[1]); w.y = cvt_pk_bf16(o[2], o[3]); w.z = cvt_pk_bf16(o[4], o[5]); w.w = cvt_pk_bf16(o[6], o[7]);
                *(u32x4*)rowp = w; }
    }
};
struct EpiSwigluF8 {
    static constexpr bool PERM = true;
    unsigned char* O;
    __device__ __forceinline__ void operator()(const f32x4 (&acc)[2][2][4][2], const Unit& u, int wr, int wc, int fr, int fq) const {
        unsigned char* base = O + (size_t)(u.pm * BM + wr * 64 + fr) * FF + u.pn * 128 + wc * 32 + 8 * fq;
#pragma unroll
        for (int ai = 0; ai < 2; ++ai)
#pragma unroll
            for (int m = 0; m < 4; ++m) { unsigned char* rowp = base + (size_t)(ai * HALF + m * 16) * FF;
                float o[8];
#pragma unroll
                for (int n = 0; n < 2; ++n)
#pragma unroll
                    for (int i = 0; i < 4; ++i) { const float g = acc[ai][0][m][n][i] * (1.0f / W8S), uu = acc[ai][1][m][n][i] * (A8S / W8S);
                        o[n * 4 + i] = g * __builtin_amdgcn_rcpf(1.0f + __builtin_amdgcn_exp2f(-g * LOG2E)) * uu; }
                v2u w; w.x = cvt4_fp8(o[0], o[1], o[2], o[3]); w.y = cvt4_fp8(o[4], o[5], o[6], o[7]);
                *(v2u*)rowp = w; }
    }
};
struct EpiResid {
    static constexpr bool PERM = false;
    const float* base; float* out; float oscale;
    __device__ __forceinline__ void operator()(const f32x4 (&acc)[2][2][4][2], const Unit& u, int wr, int wc, int fr, int fq) const {
        const size_t off0 = (size_t)(u.pm * BM + wr * 64 + fr) * DM + u.pn * BM + wc * 32 + 4 * fq;
#pragma unroll
        for (int ai = 0; ai < 2; ++ai)
#pragma unroll
            for (int m = 0; m < 4; ++m) { const size_t off = off0 + (size_t)(ai * HALF + m * 16) * DM;
#pragma unroll
                for (int bj = 0; bj < 2; ++bj)
#pragma unroll
                    for (int n = 0; n < 2; ++n) { const f32x4 b = *(const f32x4*)(base + off + bj * HALF + n * 16); *(f32x4*)(out + off + bj * HALF + n * 16) = b + acc[ai][bj][m][n] * oscale; } }
    }
};
struct EpiMoeDown {
    static constexpr bool PERM = true;
    bf16_t* Y; const float* gw; bf16_t* P; float oscale;
    __device__ __forceinline__ void operator()(const f32x4 (&acc)[2][2][4][2], const Unit& u, int wr, int wc, int fr, int fq) const {
        bf16_t* base = (u.kq < 0 ? Y + (size_t)(u.pm * BM) * DM : P + ((size_t)u.kq * SPLIT_ROWS + (size_t)(u.pm * BM - SPLIT_ROW0)) * DM) + (size_t)(wr * 64 + fr) * DM + u.pn * BM + wc * 32 + 8 * fq;
        const float* gp = gw + u.e * LCAP + u.mt * 256 + wr * 64 + fr;
#pragma unroll
        for (int ai = 0; ai < 2; ++ai)
#pragma unroll
            for (int m = 0; m < 4; ++m) { bf16_t* rowp = base + (size_t)(ai * HALF + m * 16) * DM; const float g = gp[ai * HALF + m * 16] * oscale;
#pragma unroll
                for (int bj = 0; bj < 2; ++bj) { const f32x4 v0 = acc[ai][bj][m][0] * g, v1 = acc[ai][bj][m][1] * g;
                    u32x4 w; w.x = cvt_pk_bf16(v0[0], v0[1]); w.y = cvt_pk_bf16(v0[2], v0[3]); w.z = cvt_pk_bf16(v1[0], v1[1]); w.w = cvt_pk_bf16(v1[2], v1[3]);
                    *(u32x4*)(rowp + bj * HALF) = w; } }
    }
};

template <class Epi, class Sched, bool GATHER, bool FP8 = false>
__device__ __forceinline__ void gemm_phase(PG8_LAS unsigned char* lds, const int K, const Sched& S, const Epi& E) {
    const int tid = threadIdx.x, wid = __builtin_amdgcn_readfirstlane(tid >> 6), lane = tid & 63, wr = wid >> 2, wc = wid & 3, fr = lane & 15, fq = lane >> 4;
    unsigned voffA[2], voffB[2]; int sR[2], sC[2];
#pragma unroll
    for (int i = 0; i < 2; ++i) { int R, C; stage_rc(tid * 16 + i * 8192, R, C); const int Rb = Epi::PERM ? ((R & ~31) + perm32(R & 31)) : R;
        voffA[i] = (unsigned)(R * K + C) * 2u; voffB[i] = (unsigned)(Rb * K + C) * 2u; sR[i] = R; sC[i] = C; }
    const size_t kstep = (size_t)(BK * 2);
    const size_t hstep = (size_t)HALF * K * 2;
    const unsigned ldsw = (unsigned)wid * 1024u, lds0 = (unsigned)(uintptr_t)lds;
    const int aoff = FP8 ? lds_byte(wr * 64 + fr, fq * 16) : lds_byte(wr * 64 + fr, fq * 8), boff = FP8 ? lds_byte(wc * 32 + fr, fq * 16) : lds_byte(wc * 32 + fr, fq * 8);

#define PG8_SA(b, h) (((b) * 2 + (h)) * HTB)
#define PG8_SB(b, h) ((4 + (b) * 2 + (h)) * HTB)
#define PG8_STAGE(bufoff, gbase, voff) do { const char* gb_ = uniptr((const char*)(gbase)); _Pragma("unroll") for (int _i = 0; _i < 2; ++_i) \
        glds16_s(gb_, (voff)[_i], (unsigned)__builtin_amdgcn_readfirstlane(lds0 + (unsigned)(bufoff) + ldsw + (unsigned)(_i * 8192))); } while (0)
#define PG8_STAGE_A(bufoff, p, h, VG) do { if (GATHER) { PG8_STAGE(bufoff, p, VG[h]); } else { PG8_STAGE(bufoff, (p) + ((h) ? hstep : 0), voffA); } } while (0)
#define PG8_LDA(dst, b, h) do { _Pragma("unroll") for (int m = 0; m < 4; ++m) { if constexpr (FP8) { const v4i32 x_ = *(const PG8_LAS v4i32*)(lds + PG8_SA(b, h) + aoff + m * 2048), y_ = *(const PG8_LAS v4i32*)(lds + PG8_SA(b, h) + aoff + m * 2048 + 16); dst##8[m] = __builtin_shufflevector(x_, y_, 0, 1, 2, 3, 4, 5, 6, 7); } \
        else { _Pragma("unroll") for (int k = 0; k < 2; ++k) dst[m][k] = *(const PG8_LAS bf16x8*)(lds + PG8_SA(b, h) + aoff + m * 2048 + k * 1024); } } } while (0)
#define PG8_LDB(dst, b, h) do { _Pragma("unroll") for (int n = 0; n < 2; ++n) { if constexpr (FP8) { const v4i32 x_ = *(const PG8_LAS v4i32*)(lds + PG8_SB(b, h) + boff + n * 2048), y_ = *(const PG8_LAS v4i32*)(lds + PG8_SB(b, h) + boff + n * 2048 + 16); dst##8[n] = __builtin_shufflevector(x_, y_, 0, 1, 2, 3, 4, 5, 6, 7); } \
        else { _Pragma("unroll") for (int k = 0; k < 2; ++k) dst[n][k] = *(const PG8_LAS bf16x8*)(lds + PG8_SB(b, h) + boff + n * 2048 + k * 1024); } } } while (0)
#define PG8_MMA(ai, bj, At, Bt) do { __builtin_amdgcn_s_setprio(1); _Pragma("unroll") for (int m = 0; m < 4; ++m) _Pragma("unroll") for (int n = 0; n < 2; ++n) { \
        if constexpr (FP8) asm volatile("v_mfma_scale_f32_16x16x128_f8f6f4 %0, %1, %2, %0, %3, %3 op_sel_hi:[0,0,0]" : "+v"(acc[ai][bj][m][n]) : "v"(Bt##8[n]), "v"(At##8[m]), "v"(sc8));   \
        else { _Pragma("unroll") for (int k = 0; k < 2; ++k) acc[ai][bj][m][n] = __builtin_amdgcn_mfma_f32_16x16x32_bf16(Bt[n][k], At[m][k], acc[ai][bj][m][n], 0, 0, 0); } } \
        __builtin_amdgcn_s_setprio(0); } while (0)
#define PG8_WAIT_V(n) asm volatile("s_waitcnt vmcnt(" #n ")" ::: "memory")
#define PG8_WAIT_L(n) asm volatile("s_waitcnt lgkmcnt(" #n ")" ::: "memory")
#define PG8_BAR __builtin_amdgcn_s_barrier()
#define PG8_SCHED __builtin_amdgcn_sched_barrier(0)
    Unit cur, nxt; int ui = 0;
    if (!S.next(0, cur)) return;
    f32x4 acc[2][2][4][2];
#pragma unroll
    for (int a = 0; a < 2; ++a)
#pragma unroll
        for (int b = 0; b < 2; ++b)
#pragma unroll
            for (int m = 0; m < 4; ++m)
#pragma unroll
                for (int n = 0; n < 2; ++n) acc[a][b][m][n] = (f32x4){0.f, 0.f, 0.f, 0.f};
    bf16x8 At[4][2], B0[2][2], B1[2][2];
    v8i32 At8[4], B08[2], B18[2];
    int sc8 = 0x7F7F7F7F; asm volatile("" : "+v"(sc8));
    const char* cA = S.a_base(cur); const char* cB = S.b_base(cur);
    unsigned vc[2][2] = {{0u, 0u}, {0u, 0u}}, vn[2][2] = {{0u, 0u}, {0u, 0u}};
    if (GATHER) { S.a_voff(cur, sR, sC, vc); asm volatile("s_waitcnt vmcnt(0)" : "+v"(vc[0][0]), "+v"(vc[0][1]), "+v"(vc[1][0]), "+v"(vc[1][1]) :: "memory"); }
    PG8_STAGE(PG8_SB(0, 0), cB, voffB); PG8_STAGE(PG8_SB(0, 1), cB + hstep, voffB); PG8_STAGE_A(PG8_SA(0, 0), cA, 0, vc); PG8_STAGE_A(PG8_SA(0, 1), cA, 1, vc);
    if (wr == 1) PG8_BAR;
    PG8_WAIT_V(2); PG8_BAR;
    PG8_STAGE(PG8_SB(1, 0), cB + kstep, voffB); PG8_STAGE_A(PG8_SA(1, 0), cA + kstep, 0, vc); PG8_STAGE(PG8_SB(1, 1), cB + hstep + kstep, voffB);
    PG8_WAIT_V(6); PG8_BAR;
    for (;;) {
        const bool has_next = S.next(ui + 1, nxt);
        const char* nA = has_next ? S.a_base(nxt) : cA; const char* nB = has_next ? S.b_base(nxt) : cB;
        if (GATHER) {
            if (has_next) { S.a_voff(nxt, sR, sC, vn); asm volatile("s_waitcnt vmcnt(0)" : "+v"(vn[0][0]), "+v"(vn[0][1]), "+v"(vn[1][0]), "+v"(vn[1][1]) :: "memory"); }
            else { vn[0][0] = vc[0][0]; vn[0][1] = vc[0][1]; vn[1][0] = vc[1][0]; vn[1][1] = vc[1][1]; }
        }
        const int nt = cur.nt;
        for (int t = 0; t < nt; t += 2) {
            const bool last = (t == nt - 2);
            const char* a1 = cA + (size_t)(t + 1) * kstep;
            const char* a2 = last ? nA : cA + (size_t)(t + 2) * kstep; const char* b2 = last ? nB : cB + (size_t)(t + 2) * kstep;
            const char* a3 = a2 + kstep; const char* b3 = b2 + kstep;
            unsigned v2[2][2];
#pragma unroll
            for (int h = 0; h < 2; ++h)
#pragma unroll
                for (int i = 0; i < 2; ++i) v2[h][i] = last ? vn[h][i] : vc[h][i];
            PG8_LDB(B0, 0, 0); PG8_LDB(B1, 0, 1); PG8_SCHED; PG8_LDA(At, 0, 0); PG8_STAGE_A(PG8_SA(1, 1), a1, 1, vc);
            PG8_WAIT_V(8); PG8_WAIT_L(0); PG8_BAR; PG8_MMA(0, 0, At, B0); PG8_MMA(0, 1, At, B1); PG8_BAR; PG8_SCHED;
            PG8_LDA(At, 0, 1); PG8_STAGE(PG8_SB(0, 0), b2, voffB); PG8_STAGE(PG8_SB(0, 1), b2 + hstep, voffB); PG8_STAGE_A(PG8_SA(0, 0), a2, 0, v2);
            PG8_WAIT_V(8); PG8_WAIT_L(0); PG8_BAR; PG8_MMA(1, 0, At, B0); PG8_MMA(1, 1, At, B1); PG8_BAR; PG8_SCHED;
            PG8_LDB(B0, 1, 0); PG8_LDB(B1, 1, 1); PG8_SCHED; PG8_LDA(At, 1, 0); PG8_STAGE_A(PG8_SA(0, 1), a2, 1, v2);
            PG8_WAIT_V(8); PG8_WAIT_L(0); PG8_BAR; PG8_MMA(0, 0, At, B0); PG8_MMA(0, 1, At, B1); PG8_BAR; PG8_SCHED;
            PG8_LDA(At, 1, 1); PG8_STAGE(PG8_SB(1, 0), b3, voffB); PG8_STAGE(PG8_SB(1, 1), b3 + hstep, voffB); PG8_STAGE_A(PG8_SA(1, 0), a3, 0, v2);
            PG8_WAIT_V(8); PG8_WAIT_L(0); PG8_BAR; PG8_MMA(1, 0, At, B0); PG8_MMA(1, 1, At, B1); PG8_BAR; PG8_SCHED;
        }
        if (wr == 0) PG8_BAR;
        if constexpr (FP8) asm volatile("s_nop 15\n\ts_nop 15" ::: "memory");
        { int fr_ = fr, fq_ = fq; asm volatile("" : "+v"(fr_), "+v"(fq_)); E(acc, cur, wr, wc, fr_, fq_); }
        if (!has_next) break;
#pragma unroll
        for (int a = 0; a < 2; ++a)
#pragma unroll
            for (int b = 0; b < 2; ++b)
#pragma unroll
                for (int m = 0; m < 4; ++m)
#pragma unroll
                    for (int n = 0; n < 2; ++n) acc[a][b][m][n] = (f32x4){0.f, 0.f, 0.f, 0.f};
        cur = nxt; cA = nA; cB = nB; ++ui;
        if (GATHER) { vc[0][0] = vn[0][0]; vc[0][1] = vn[0][1]; vc[1][0] = vn[1][0]; vc[1][1] = vn[1][1]; }
        if (wr == 1) PG8_BAR;
    }
    PG8_WAIT_V(0);
    PG8_BAR;
#undef PG8_SA
#undef PG8_SB
#undef PG8_STAGE
#undef PG8_STAGE_A
#undef PG8_LDA
#undef PG8_LDB
#undef PG8_MMA
#undef PG8_WAIT_V
#undef PG8_WAIT_L
#undef PG8_BAR
#undef PG8_SCHED
}
}

namespace att {
typedef short bf16x8 __attribute__((ext_vector_type(8)));
typedef short s16x4 __attribute__((ext_vector_type(4)));
typedef float f32x16 __attribute__((ext_vector_type(16)));
typedef unsigned u32x4 __attribute__((ext_vector_type(4)));
typedef LAS char* lptr;
constexpr int SLOTB = 8192, NSLOT = 6, AHEAD = 4;
constexpr int L_K = 0, L_V = NSLOT * SLOTB, L_WS = 2 * NSLOT * SLOTB, L_OST = L_WS + 8 * 256, L_KB = L_OST + 8 * 4096, L_FLG = L_KB + 8192, L_END = L_FLG + 256;
static_assert(L_END <= ATT_LDS_MAX, "attention LDS map");
constexpr float THR = 8.0f;
__device__ __forceinline__ int crow(int r, int hi) { return (r & 3) + 8 * (r >> 2) + 4 * hi; }
__device__ __forceinline__ void glds16(const void* gsrc, unsigned lds_dst) { unsigned keep;
    asm volatile("s_mov_b32 %0, m0\n\ts_mov_b32 m0, %2\n\ts_nop 0\n\tglobal_load_lds_dwordx4 %1, off\n\ts_mov_b32 m0, %0" : "=&s"(keep) : "v"(gsrc), "s"(lds_dst) : "memory"); }
typedef float f32x2_t __attribute__((ext_vector_type(2))); typedef __bf16 bf16x2_t __attribute__((ext_vector_type(2)));
__device__ __forceinline__ unsigned cvtpk(float lo, float hi) { f32x2_t v = {lo, hi}; bf16x2_t b = __builtin_convertvector(v, bf16x2_t); return __builtin_bit_cast(unsigned, b); }
__device__ __forceinline__ bf16x8 gload16(const void* p) { bf16x8 v; asm volatile("global_load_dwordx4 %0, %1, off" : "=v"(v) : "v"(p) : "memory"); return v; }
__device__ __forceinline__ float max3f(float a, float b, float c) { return __builtin_fmaxf(__builtin_fmaxf(a, b), c); }
__device__ __forceinline__ void wait_bar(int n) {
    if (n >= 6) asm volatile("s_waitcnt vmcnt(6) lgkmcnt(0)\n\ts_barrier" ::: "memory");
    else if (n >= 4) asm volatile("s_waitcnt vmcnt(4) lgkmcnt(0)\n\ts_barrier" ::: "memory");
    else if (n >= 2) asm volatile("s_waitcnt vmcnt(2) lgkmcnt(0)\n\ts_barrier" ::: "memory");
    else asm volatile("s_waitcnt vmcnt(0) lgkmcnt(0)\n\ts_barrier" ::: "memory");
}
__device__ __forceinline__ float other_half(float x, int hi) {
    auto rr = __builtin_amdgcn_permlane32_swap(__float_as_uint(x), __float_as_uint(x), false, false);
    return __uint_as_float(hi ? rr[0] : rr[1]);
}
__device__ __forceinline__ void qkt(f32x16& p0, f32x16& p1, lptr Kslot, const bf16x8* qr, const f32x16& c0, const f32x16& c1, int r32, int hi) {
    lptr kb = Kslot + hi * 1024 + r32 * 16;
#pragma unroll
    for (int d0 = 0; d0 < 4; ++d0) {
        const bf16x8 b0 = *(const LAS bf16x8*)(kb + d0 * 2048);
        const bf16x8 b1 = *(const LAS bf16x8*)(kb + d0 * 2048 + 512);
        if (d0 == 0) { p0 = __builtin_amdgcn_mfma_f32_32x32x16_bf16(b0, qr[0], c0, 0, 0, 0); p1 = __builtin_amdgcn_mfma_f32_32x32x16_bf16(b1, qr[0], c1, 0, 0, 0); }
        else { p0 = __builtin_amdgcn_mfma_f32_32x32x16_bf16(b0, qr[d0], p0, 0, 0, 0); p1 = __builtin_amdgcn_mfma_f32_32x32x16_bf16(b1, qr[d0], p1, 0, 0, 0); } }
}
__device__ __forceinline__ void pv(f32x16* o, int vb, bf16x8 pa0, bf16x8 pa1, bf16x8 pa2, bf16x8 pa3) {
#pragma unroll
    for (int d0 = 0; d0 < 2; ++d0) { s16x4 lo[4], hi[4];
#pragma unroll
        for (int ks = 0; ks < 4; ++ks) {
            asm volatile("ds_read_b64_tr_b16 %0,%1 offset:%c2" : "=&v"(lo[ks]) : "v"(vb), "i"(d0 * 4096 + ks * 1024) : "memory");
            asm volatile("ds_read_b64_tr_b16 %0,%1 offset:%c2" : "=&v"(hi[ks]) : "v"(vb), "i"(d0 * 4096 + ks * 1024 + 512) : "memory"); }
        asm volatile("s_waitcnt lgkmcnt(0)" ::: "memory"); __builtin_amdgcn_sched_barrier(0);
#define ATT_PK(k) (bf16x8){lo[k][0], lo[k][1], lo[k][2], lo[k][3], hi[k][0], hi[k][1], hi[k][2], hi[k][3]}
        o[d0] = __builtin_amdgcn_mfma_f32_32x32x16_bf16(pa0, ATT_PK(0), o[d0], 0, 0, 0);
        o[d0] = __builtin_amdgcn_mfma_f32_32x32x16_bf16(pa1, ATT_PK(1), o[d0], 0, 0, 0);
        o[d0] = __builtin_amdgcn_mfma_f32_32x32x16_bf16(pa2, ATT_PK(2), o[d0], 0, 0, 0);
        o[d0] = __builtin_amdgcn_mfma_f32_32x32x16_bf16(pa3, ATT_PK(3), o[d0], 0, 0, 0);
#undef ATT_PK
    }
}
__device__ __forceinline__ void pack_pv(f32x16* o, int vb, const f32x16& p0, const f32x16& p1) {
    u32x4 w0, w1, w2, w3;
#pragma unroll
    for (int j = 0; j < 4; ++j) { w0[j] = cvtpk(p0[2 * j], p0[2 * j + 1]); w1[j] = cvtpk(p0[8 + 2 * j], p0[8 + 2 * j + 1]); w2[j] = cvtpk(p1[2 * j], p1[2 * j + 1]); w3[j] = cvtpk(p1[8 + 2 * j], p1[8 + 2 * j + 1]); }
    pv(o, vb, __builtin_bit_cast(bf16x8, w0), __builtin_bit_cast(bf16x8, w1), __builtin_bit_cast(bf16x8, w2), __builtin_bit_cast(bf16x8, w3));
}
__device__ __forceinline__ float rowmax32(const f32x16& p0, const f32x16& p1, int hi) {
    float a = max3f(p0[0], p0[1], p1[0]), b = max3f(p0[2], p0[3], p1[1]); a = max3f(a, p1[2], p1[3]);
#pragma unroll
    for (int r = 4; r < 16; r += 4) { a = max3f(a, p0[r], p0[r + 1]); b = max3f(b, p0[r + 2], p0[r + 3]); a = max3f(a, p1[r], p1[r + 1]); b = max3f(b, p1[r + 2], p1[r + 3]); }
    a = fmaxf(a, b);
    return fmaxf(a, other_half(a, hi));
}
__device__ __forceinline__ void store_o(const f32x16* o, const float* sc, lptr stgb, bf16* Ow, long rpitch, int lane, int r32, int hi) {
    LAS bf16* stg = (LAS bf16*)stgb;
#pragma unroll
    for (int r = 0; r < 16; ++r) { const int orow = crow(r, hi);
#pragma unroll
        for (int d0 = 0; d0 < 2; ++d0) stg[orow * 64 + d0 * 32 + r32] = (bf16)f2bf(o[d0][r] * sc[r]); }
    asm volatile("s_waitcnt lgkmcnt(0)" ::: "memory");
#pragma unroll
    for (int i = 0; i < 4; ++i) { const int row = i * 8 + (lane >> 3), ch = lane & 7; const u32x4 v = *(const LAS u32x4*)(stg + row * 64 + ch * 8); *(u32x4*)(Ow + (long)row * rpitch + ch * 8) = v; }
}
__device__ __forceinline__ void softmax_step(f32x16& p0, f32x16& p1, float& mref, float& lsum, f32x16* o, LAS float* wsf, int r32, int hi) {
    const float rm = rowmax32(p0, p1, hi);
    const bool fresh = mref <= -1e30f;
    const bool want = !fresh && (rm > mref + THR);
    if (fresh) mref = fmaxf(rm, -1e30f);
    if (__any(want)) {
        const float dl = want ? rm - mref : 0.f; mref += dl; const float f = __builtin_amdgcn_exp2f(-dl); lsum *= f;
        if (hi == 0) wsf[r32] = f;
        asm volatile("s_waitcnt lgkmcnt(0)" ::: "memory");
#pragma unroll
        for (int r = 0; r < 16; ++r) { const float fr = wsf[crow(r, hi)]; o[0][r] *= fr; o[1][r] *= fr; }
    }
    float sa = 0.f, sb = 0.f;
#pragma unroll
    for (int r = 0; r < 16; ++r) { p0[r] = __builtin_amdgcn_exp2f(p0[r] - mref); p1[r] = __builtin_amdgcn_exp2f(p1[r] - mref); sa += p0[r]; sb += p1[r]; }
    lsum += sa + sb;
}

struct WaveCtx { int lane, r32, hi, wid; unsigned lds0; int vb0; lptr shm; };
struct UnitD { int NT; int b, h, qb, g, x; };

template <int MODE> struct CausalMode {
    const bf16* Q; const bf16* K; const bf16* V; bf16* O; int b, h, p;
    float carry, mref, lsum; int done;
    __device__ __forceinline__ int units() const { return 4; }
    __device__ __forceinline__ void desc(int j, UnitD& d) const { d.b = b; d.h = h; d.qb = (j == 0) ? 7 - p : (j == 1) ? 5 - p : (j == 2) ? 2 + p : p; d.NT = 4 * (d.qb + 1); d.g = 0; d.x = 0; }
    __device__ __forceinline__ int tile_of(const UnitD& d, int k) const { return MODE == 0 ? d.NT - 1 - k : k; }
    __device__ __forceinline__ void q_load(const UnitD& d, const WaveCtx& w, bf16x8 (&q)[4]) const {
        const bf16* Qw = Q + ((long)d.b * SEQ + d.qb * 256 + w.wid * 32 + w.r32) * DM + d.h * 64 + w.hi * 8;
#pragma unroll
        for (int d0 = 0; d0 < 4; ++d0) q[d0] = gload16(Qw + d0 * 16);
    }
    __device__ __forceinline__ void dma(const UnitD& d, int k, int slot, const WaveCtx& w) const {
        const long row0 = (long)d.b * SEQ + 64 * tile_of(d, k);
        glds16(K + (row0 + w.lane) * DM + d.h * 64 + w.wid * 8, (unsigned)__builtin_amdgcn_readfirstlane(w.lds0 + L_K + slot * SLOTB + w.wid * 1024));
        glds16(V + (row0 + 16 * (w.wid & 3) + (w.lane >> 2)) * DM + d.h * 64 + (w.wid >> 2) * 32 + (w.lane & 3) * 8, (unsigned)__builtin_amdgcn_readfirstlane(w.lds0 + L_V + slot * SLOTB + w.wid * 1024));
    }
    __device__ __forceinline__ void begin(const UnitD&, const WaveCtx&) { carry = 1.0f; mref = -1e30f; lsum = 0.f; done = 0; }
    __device__ __forceinline__ int wave_done() const { return done; }
    __device__ __forceinline__ void compute(const UnitD& d, int k, int slot, const WaveCtx& w, const bf16x8* qr, f32x16* o) {
        const int T = tile_of(d, k), qfirst = d.qb * 256 + w.wid * 32, qpos = qfirst + w.r32;
        if (MODE == 0) {
            if (done || 64 * T >= qfirst + 31) return;
            f32x16 p0, p1; const f32x16 z = {}; qkt(p0, p1, w.shm + L_K + slot * SLOTB, qr, z, z, w.r32, w.hi);
            const bool diag = 64 * T + 63 >= qfirst;
            float ga[8];
#pragma unroll
            for (int a = 0; a < 8; ++a) {
                float rr[4];
#pragma unroll
                for (int i = 0; i < 4; ++i) { const int r = 4 * (a & 3) + i; const float zz = (a < 4) ? p0[r] : p1[r];
                    const float e = __builtin_amdgcn_exp2f(fminf(zz, 120.f)); float rv = __builtin_amdgcn_rcpf(1.0f + e);
                    if (diag) { const int kv = 64 * T + crow(r, w.hi) + ((a < 4) ? 0 : 32); if (kv >= qpos) rv = 1.0f; }
                    rr[i] = rv; if (a < 4) p0[r] = rv; else p1[r] = rv; }
                ga[a] = (rr[0] * rr[1]) * (rr[2] * rr[3]);
            }
            float oth[8], Ts[8];
#pragma unroll
            for (int a = 0; a < 8; ++a) oth[a] = other_half(ga[a], w.hi);
            float run = 1.0f;
#pragma unroll
            for (int a = 7; a >= 0; --a) { Ts[a] = run; run *= ga[a] * oth[a]; }
#pragma unroll
            for (int a = 0; a < 8; ++a) {
                float E = carry * Ts[a] * (w.hi ? 1.0f : oth[a]);
#pragma unroll
                for (int i = 3; i >= 0; --i) { const int r = 4 * (a & 3) + i; const float rv = (a < 4) ? p0[r] : p1[r]; const float wt = (1.0f - rv) * E; E *= rv; if (a < 4) p0[r] = wt; else p1[r] = wt; }
            }
            carry *= run;
            pack_pv(o, w.vb0 + slot * SLOTB, p0, p1);
            if (__all(carry < 1e-30f)) done = 1;
        } else {
            if (64 * T > qfirst + 31) return;
            LAS float* kbl = (LAS float*)(w.shm + L_KB);
            f32x16 c0, c1;
#pragma unroll
            for (int g = 0; g < 4; ++g) { const f32x4 k0 = *(const LAS f32x4*)(kbl + 64 * T + 8 * g + 4 * w.hi), k1 = *(const LAS f32x4*)(kbl + 64 * T + 32 + 8 * g + 4 * w.hi);
#pragma unroll
                for (int i = 0; i < 4; ++i) { c0[4 * g + i] = k0[i]; c1[4 * g + i] = k1[i]; } }
            f32x16 p0, p1; qkt(p0, p1, w.shm + L_K + slot * SLOTB, qr, c0, c1, w.r32, w.hi);
            if (64 * T + 63 > qfirst) {
#pragma unroll
                for (int r = 0; r < 16; ++r) { const int kv = 64 * T + crow(r, w.hi); if (kv > qpos) p0[r] = -INFINITY; if (kv + 32 > qpos) p1[r] = -INFINITY; } }
            softmax_step(p0, p1, mref, lsum, o, (LAS float*)(w.shm + L_WS) + w.wid * 64, w.r32, w.hi);
            pack_pv(o, w.vb0 + slot * SLOTB, p0, p1);
        }
    }
    __device__ __forceinline__ void finish(const UnitD& d, const WaveCtx& w, const f32x16* o) {
        LAS float* wsf = (LAS float*)(w.shm + L_WS) + w.wid * 64;
        float sc[16];
        if (MODE == 0) {
#pragma unroll
            for (int r = 0; r < 16; ++r) sc[r] = 1.0f;
        } else {
            float lt = lsum + other_half(lsum, w.hi);
            if (w.hi == 0) wsf[32 + w.r32] = lt;
            asm volatile("s_waitcnt lgkmcnt(0)" ::: "memory");
#pragma unroll
            for (int r = 0; r < 16; ++r) sc[r] = __builtin_amdgcn_rcpf(wsf[32 + crow(r, w.hi)]);
        }
        store_o(o, sc, w.shm + L_OST + w.wid * 4096, O + ((long)d.b * SEQ + d.qb * 256 + w.wid * 32) * DM + d.h * 64, DM, w.lane, w.r32, w.hi);
    }
};

struct DilMode {
    const bf16* PROJ; bf16* OG; float* ST; int b, h, p;
    float mref, lsum;
    __device__ __forceinline__ int units() const { return 12; }
    __device__ __forceinline__ void desc(int j, UnitD& d) const {
        const int g = j >> 2, i = j & 3; d.g = g; d.b = b; d.h = h; d.qb = 0;
        d.x = (g == 1) ? ((2 * (i >> 1) + p) << 1) + (i & 1) : 2 * i + p;
        const int i0 = (g == 0) ? 256 * d.x : (g == 1) ? 256 * (d.x & 1) : 0;
        d.NT = (g == 2) ? 4 : ((i0 >> 6) + 4 - t_lo(g, i0));
    }
    static __device__ __forceinline__ int t_lo(int g, int i0) { return (g == 2) ? 0 : ((i0 >> 6) >= 2 ? (i0 >> 6) - 2 : 0); }
    static __device__ __forceinline__ int dil_of(int g) { return (g == 0) ? 1 : (g == 1) ? 4 : 16; }
    static __device__ __forceinline__ int cls0_of(int g, int x) { return (g == 0) ? 0 : (g == 1) ? (x >> 1) : 2 * x; }
    static __device__ __forceinline__ int i0_of(int g, int x) { return (g == 0) ? 256 * x : (g == 1) ? 256 * (x & 1) : 0; }
    static __device__ __forceinline__ int tcls(int g, int x, int k) { return cls0_of(g, x) + ((g == 2) ? (k >> 1) : 0); }
    static __device__ __forceinline__ int kbase(int g, int x, int k) { return (g == 2) ? 64 * (k & 1) : 64 * (t_lo(g, i0_of(g, x)) + k); }
    __device__ __forceinline__ void q_load(const UnitD& d, const WaveCtx& w, bf16x8 (&q)[4]) const {
        const int dil = dil_of(d.g), clsw = cls0_of(d.g, d.x) + ((d.g == 2) ? (w.wid >> 2) : 0), qi0w = (d.g == 2) ? 32 * (w.wid & 3) : i0_of(d.g, d.x) + 32 * w.wid;
        const bf16* Qw = PROJ + (size_t)(2 * d.g) * PLANE + ((long)d.b * SEQ + clsw + (long)(qi0w + w.r32) * dil) * DM + d.h * 64 + w.hi * 8;
#pragma unroll
        for (int d0 = 0; d0 < 4; ++d0) q[d0] = gload16(Qw + d0 * 16);
    }
    __device__ __forceinline__ void dma(const UnitD& d, int k, int slot, const WaveCtx& w) const {
        const int dil = dil_of(d.g); const long tok0 = (long)d.b * SEQ + tcls(d.g, d.x, k) + (long)kbase(d.g, d.x, k) * dil;
        glds16(PROJ + (size_t)(2 * d.g + 1) * PLANE + (tok0 + (long)w.lane * dil) * DM + d.h * 64 + w.wid * 8, (unsigned)__builtin_amdgcn_readfirstlane(w.lds0 + L_K + slot * SLOTB + w.wid * 1024));
        glds16(PROJ + (size_t)6 * PLANE + (tok0 + (long)(16 * (w.wid & 3) + (w.lane >> 2)) * dil) * DM + d.h * 64 + (w.wid >> 2) * 32 + (w.lane & 3) * 8, (unsigned)__builtin_amdgcn_readfirstlane(w.lds0 + L_V + slot * SLOTB + w.wid * 1024));
    }
    __device__ __forceinline__ void begin(const UnitD&, const WaveCtx&) { mref = -1e30f; lsum = 0.f; }
    __device__ __forceinline__ int wave_done() const { return 0; }
    __device__ __forceinline__ void compute(const UnitD& d, int k, int slot, const WaveCtx& w, const bf16x8* qr, f32x16* o) {
        const int clsw = cls0_of(d.g, d.x) + ((d.g == 2) ? (w.wid >> 2) : 0), qi0w = (d.g == 2) ? 32 * (w.wid & 3) : i0_of(d.g, d.x) + 32 * w.wid;
        const int kb = kbase(d.g, d.x, k);
        if (tcls(d.g, d.x, k) != clsw || kb > qi0w + 31 || kb < qi0w - 191) return;
        LAS float* tbl = (LAS float*)(w.shm + L_KB) + d.g * 640 + 256;
        const int dbase = qi0w + w.r32 - kb - 4 * w.hi;
        f32x16 c0, c1;
#pragma unroll
        for (int r = 0; r < 16; ++r) { const int cr = (r & 3) + 8 * (r >> 2); c0[r] = tbl[dbase - cr]; c1[r] = tbl[dbase - cr - 32]; }
        f32x16 p0, p1; qkt(p0, p1, w.shm + L_K + slot * SLOTB, qr, c0, c1, w.r32, w.hi);
        softmax_step(p0, p1, mref, lsum, o, (LAS float*)(w.shm + L_WS) + w.wid * 64, w.r32, w.hi);
        pack_pv(o, w.vb0 + slot * SLOTB, p0, p1);
    }
    __device__ __forceinline__ void finish(const UnitD& d, const WaveCtx& w, const f32x16* o) {
        const int dil = dil_of(d.g), clsw = cls0_of(d.g, d.x) + ((d.g == 2) ? (w.wid >> 2) : 0), qi0w = (d.g == 2) ? 32 * (w.wid & 3) : i0_of(d.g, d.x) + 32 * w.wid;
        LAS float* wsf = (LAS float*)(w.shm + L_WS) + w.wid * 64;
        const float lt = lsum + other_half(lsum, w.hi);
        if (w.hi == 0) { wsf[32 + w.r32] = lt;
            const long tok = (long)d.b * SEQ + clsw + (long)(qi0w + w.r32) * dil;
            *(f32x2*)(ST + ((size_t)d.g * M * NH + (size_t)tok * NH + d.h) * 2) = (f32x2){mref, lt}; }
        asm volatile("s_waitcnt lgkmcnt(0)" ::: "memory");
        float sc[16];
#pragma unroll
        for (int r = 0; r < 16; ++r) sc[r] = __builtin_amdgcn_rcpf(wsf[32 + crow(r, w.hi)]);
        store_o(o, sc, w.shm + L_OST + w.wid * 4096, OG + (size_t)d.g * PLANE + ((long)d.b * SEQ + clsw + (long)qi0w * dil) * DM + d.h * 64, (long)dil * DM, w.lane, w.r32, w.hi);
    }
};

template <class Mode, bool EARLY_EXIT>
__device__ __forceinline__ void stream_units(Mode& Mo, const WaveCtx& w) {
    LAS int* flg = (LAS int*)(w.shm + L_FLG);
    const int nun = Mo.units();
    int pj = 0, pk = 0, pseq = 0, cseq = 0;
    UnitD pd; Mo.desc(0, pd);
    bf16x8 qn[4];
    if (EARLY_EXIT && w.wid == 0 && w.lane < 4) flg[w.lane] = 0;
    asm volatile("s_waitcnt vmcnt(0)" ::: "memory");
#define ATT_PRODUCE() do { if (pj < nun) { if (pk == 0) Mo.q_load(pd, w, qn); Mo.dma(pd, pk, pseq % NSLOT, w); ++pseq; if (++pk == pd.NT) { pk = 0; if (++pj < nun) Mo.desc(pj, pd); } } } while (0)
#pragma unroll 1
    for (int i = 0; i < AHEAD; ++i) ATT_PRODUCE();
#pragma unroll 1
    for (int cj = 0; cj < nun; ++cj) {
        UnitD d; Mo.desc(cj, d);
        bf16x8 qr[4];
        f32x16 o[2]; o[0] = f32x16{}; o[1] = f32x16{};
        Mo.begin(d, w);
        const int useq0 = cseq;
        int rep = 0;
#pragma unroll 1
        while (pseq - cseq < AHEAD && pj < nun) ATT_PRODUCE();
#pragma unroll 1
        for (int ck = 0; ck < d.NT; ++ck) {
            wait_bar(2 * (pseq - cseq - 1));
            if (ck == 0) { asm volatile("" : "+v"(qn[0]), "+v"(qn[1]), "+v"(qn[2]), "+v"(qn[3])); qr[0] = qn[0]; qr[1] = qn[1]; qr[2] = qn[2]; qr[3] = qn[3]; }
            if (EARLY_EXIT && ck == 1 && w.wid == 0 && w.lane < 2) flg[((cj + 1) & 1) * 2 + w.lane] = 0;
            if (EARLY_EXIT && ck > 0) {
                if (__builtin_amdgcn_readfirstlane(flg[(cj & 1) * 2 + ((ck - 1) & 1)]) == 8) {
                    const int uend = useq0 + d.NT;
                    if (pj == cj) { pk = 0; if (++pj < nun) Mo.desc(pj, pd); }
                    cseq = uend < pseq ? uend : pseq;
                    break; } }
            if (pseq - cseq < AHEAD) ATT_PRODUCE();
            Mo.compute(d, ck, cseq % NSLOT, w, qr, o);
            if (EARLY_EXIT && Mo.wave_done() && rep < 2) { if (w.lane == 0) __hip_atomic_fetch_add(&flg[(cj & 1) * 2 + (ck & 1)], 1, __ATOMIC_RELAXED, __HIP_MEMORY_SCOPE_WORKGROUP); ++rep; }
            ++cseq;
        }
        Mo.finish(d, w, o);
    }
    asm volatile("s_waitcnt vmcnt(0) lgkmcnt(0)\n\ts_barrier" ::: "memory");
#undef ATT_PRODUCE
}
__device__ __forceinline__ WaveCtx make_ctx(lptr shm) {
    WaveCtx w; const int tid = threadIdx.x; w.lane = tid & 63; w.r32 = w.lane & 31; w.hi = w.lane >> 5; w.wid = __builtin_amdgcn_readfirstlane(tid >> 6);
    w.shm = shm; w.lds0 = (unsigned)(uintptr_t)shm;
    w.vb0 = (int)(w.lds0 + L_V) + ((w.lane >> 4) & 1) * 32 + (w.lane & 3) * 8 + (4 * w.hi + ((w.lane & 15) >> 2)) * 64;
    return w;
}
template <int MODE>
__device__ __forceinline__ void causal_phase(lptr shm, int G, const bf16* Q, const bf16* K, const bf16* V, bf16* O, const float* cum) {
    const int bx = blockIdx.x; const int vcu = (G % 8 == 0) ? (bx % 8) * (G / 8) + bx / 8 : bx;
    const WaveCtx w = make_ctx(shm);
    for (int u = vcu; u < BATCH * NH * 2; u += G) {
        CausalMode<MODE> Mo; Mo.Q = Q; Mo.K = K; Mo.V = V; Mo.O = O; Mo.b = u >> 5; Mo.h = (u >> 1) & 15; Mo.p = u & 1;
        if (MODE == 2) { LAS float* kbl = (LAS float*)(shm + L_KB);
            for (int s = threadIdx.x; s < SEQ; s += NTHR) kbl[s] = -cum[((long)Mo.b * SEQ + s) * 16 + Mo.h]; }
        stream_units<CausalMode<MODE>, MODE == 0>(Mo, w);
    }
}
__device__ __forceinline__ int t5_bucket_f(int dist) {
    if (dist < 16) return dist;
    int lb = 16 + (int)(logf((float)dist / 16.0f) / logf(128.0f) * 16.0f);
    return lb < 31 ? lb : 31;
}
__device__ __forceinline__ void dil_phase(lptr shm, int G, const bf16* PROJ, bf16* OG, float* ST, const float* rel_bias) {
    const int bx = blockIdx.x; const int vcu = (G % 8 == 0) ? (bx % 8) * (G / 8) + bx / 8 : bx;
    const WaveCtx w = make_ctx(shm);
    for (int u = vcu; u < BATCH * NH * 2; u += G) {
        DilMode Mo; Mo.PROJ = PROJ; Mo.OG = OG; Mo.ST = ST; Mo.b = u >> 5; Mo.h = (u >> 1) & 15; Mo.p = u & 1;
        LAS float* tb = (LAS float*)(shm + L_KB);
        for (int i = threadIdx.x; i < 3 * 640; i += NTHR) { const int gg = i / 640, dl = i - gg * 640 - 256; const int dil = (gg == 0) ? 1 : (gg == 1) ? 4 : 16;
            tb[i] = (dl >= 0 && dl <= 128) ? rel_bias[t5_bucket_f(dl * dil) * 16 + Mo.h] * LOG2E : -INFINITY; }
        stream_units<DilMode, false>(Mo, w);
    }
}
__device__ __forceinline__ void dil_merge(int G, const bf16* OG, const float* ST, bf16* O) {
    for (int idx = blockIdx.x * NTHR + threadIdx.x; idx < M * NH; idx += G * NTHR) {
        const f32x2 s0 = *(const f32x2*)(ST + ((size_t)0 * M * NH + idx) * 2), s1 = *(const f32x2*)(ST + ((size_t)1 * M * NH + idx) * 2), s2 = *(const f32x2*)(ST + ((size_t)2 * M * NH + idx) * 2);
        const float mx = fmaxf(s0.x, fmaxf(s1.x, s2.x));
        float w0 = __builtin_amdgcn_exp2f(s0.x - mx) * s0.y, w1 = __builtin_amdgcn_exp2f(s1.x - mx) * s1.y, w2 = __builtin_amdgcn_exp2f(s2.x - mx) * s2.y;
        const float inv = 1.0f / (w0 + w1 + w2); w0 *= inv; w1 *= inv; w2 *= inv;
        const GAS v4u* a0 = (const GAS v4u*)(OG + (size_t)idx * 64); const GAS v4u* a1 = (const GAS v4u*)(OG + PLANE + (size_t)idx * 64); const GAS v4u* a2 = (const GAS v4u*)(OG + 2 * PLANE + (size_t)idx * 64);
        GAS v4u* op = (GAS v4u*)(O + (size_t)idx * 64);
#pragma unroll
        for (int c = 0; c < 8; ++c) { const v4u x0 = a0[c], x1 = a1[c], x2 = a2[c]; v4u r;
#pragma unroll
            for (int q = 0; q < 4; ++q) r[q] = pk2(w0 * bflo(x0[q]) + w1 * bflo(x1[q]) + w2 * bflo(x2[q]), w0 * bfhi(x0[q]) + w1 * bfhi(x1[q]) + w2 * bfhi(x2[q]));
            op[c] = r; }
    }
}
}

enum { CV_PLAIN = 0, CV_QKN = 1, CV_GATE = 2, CV_UP = 3 };
__device__ __forceinline__ int cv_dst_row(int mode, int n) {
    if (mode == CV_QKN) return (n & ~255) + 128 * ((n >> 5) & 1) + 32 * ((n >> 6) & 3) + (n & 31);
    if (mode == CV_GATE) return 256 * (n >> 7) + (n & 127);
    if (mode == CV_UP) return 256 * (n >> 7) + 128 + (n & 127);
    return n;
}
__device__ __forceinline__ void conv_item(const float* W, int ldw, int K, bf16* WT, int mode, LAS unsigned char* scr, int item, int nblk, int lane) {
    const int kb = item / nblk, nb = item - kb * nblk, k0 = 64 * kb, n0 = 64 * nb;
    const GAS float* src = (const GAS float*)(W + (size_t)k0 * ldw + n0 + lane);
#pragma unroll
    for (int kc = 0; kc < 8; ++kc) {
        float v[8];
#pragma unroll
        for (int j = 0; j < 8; ++j) v[j] = src[(size_t)(kc * 8 + j) * ldw];
        v4u w; w.x = pk2(v[0], v[1]); w.y = pk2(v[2], v[3]); w.z = pk2(v[4], v[5]); w.w = pk2(v[6], v[7]);
        *(LAS v4u*)(scr + lane * 144 + kc * 16) = w;
    }
    asm volatile("s_waitcnt lgkmcnt(0)" ::: "memory");
#pragma unroll
    for (int j = 0; j < 8; ++j) { const int n = 8 * j + (lane >> 3), ch = lane & 7;
        const v4u w = *(const LAS v4u*)(scr + n * 144 + ch * 16);
        *(GAS v4u*)(WT + (size_t)cv_dst_row(mode, n0 + n) * K + k0 + 8 * ch) = w; }
    asm volatile("s_waitcnt lgkmcnt(0)" ::: "memory");
}
__device__ __forceinline__ void conv_item8(const float* W, int ldw, int K, unsigned char* WT8, int mode, LAS unsigned char* scr, int item, int nblk, int lane) {
    const int kb = item / nblk, nb = item - kb * nblk, k0 = 128 * kb, n0 = 64 * nb;
    const GAS float* src = (const GAS float*)(W + (size_t)k0 * ldw + n0 + lane);
#pragma unroll 4
    for (int kc = 0; kc < 16; ++kc) {
        float v[8];
#pragma unroll
        for (int j = 0; j < 8; ++j) v[j] = src[(size_t)(kc * 8 + j) * ldw] * W8S;
        v2u w; w.x = pg8::cvt4_fp8(v[0], v[1], v[2], v[3]); w.y = pg8::cvt4_fp8(v[4], v[5], v[6], v[7]);
        *(LAS v2u*)(scr + lane * 144 + kc * 8) = w;
    }
    asm volatile("s_waitcnt lgkmcnt(0)" ::: "memory");
#pragma unroll
    for (int j = 0; j < 8; ++j) { const int n = 8 * j + (lane >> 3), ch = lane & 7;
        const v4u w = *(const LAS v4u*)(scr + n * 144 + ch * 16);
        *(GAS v4u*)(WT8 + (size_t)cv_dst_row(mode, n0 + n) * K + k0 + 16 * ch) = w; }
    asm volatile("s_waitcnt lgkmcnt(0)" ::: "memory");
}
__device__ __forceinline__ void conv_job8(Frame& F, const float* W, int ldw, int K, int N, unsigned char* WT8, int mode, int& rot) {
    LAS unsigned char* scr = F.lds + F.wave * 9216;
    const int nblk = N / 64, nitems = (K / 128) * nblk, NGW = F.G * NWAVES, gw = blockIdx.x * NWAVES + F.wave;
    int first = gw - (rot % NGW); if (first < 0) first += NGW;
    for (int it = first; it < nitems; it += NGW) conv_item8(W, ldw, K, WT8, mode, scr, it, nblk, F.lane);
    rot += nitems;
}
__device__ __forceinline__ void conv_job(Frame& F, const float* W, int ldw, int K, int N, bf16* WT, int mode, int& rot) {
    LAS unsigned char* scr = F.lds + F.wave * 9216;
    const int nblk = N / 64, nitems = (K / 64) * nblk, NGW = F.G * NWAVES, gw = blockIdx.x * NWAVES + F.wave;
    int first = gw - (rot % NGW); if (first < 0) first += NGW;
    for (int it = first; it < nitems; it += NGW) conv_item(W, ldw, K, WT, mode, scr, it, nblk, F.lane);
    rot += nitems;
}
__device__ __forceinline__ void convert_weights(Frame& F) {
    bf16* WB = (bf16*)(F.ws + WS_W); int rot = 0;
    for (int j = 0; j < 2; ++j) conv_job(F, INP(1) + (size_t)j * DM * 3 * DM, 3 * DM, DM, 3 * DM, WB + WE_QKV + (size_t)j * 3 * DM * DM, CV_PLAIN, rot);
    for (int j = 0; j < 2; ++j) conv_job(F, INP(2) + (size_t)j * DM * DM, DM, DM, DM, WB + WE_WO_SB + (size_t)j * DM * DM, CV_PLAIN, rot);
    conv_job(F, INP(3), 7 * DM, DM, 7 * DM, WB + WE_IN_DIL, CV_QKN, rot);
    conv_job(F, INP(6), DM, DM, DM, WB + WE_WO_DIL, CV_PLAIN, rot);
    conv_job(F, INP(7), 3088, DM, 3 * DM, WB + WE_IN_FOX, CV_QKN, rot);
    conv_job(F, INP(11), DM, DM, DM, WB + WE_WO_FOX, CV_PLAIN, rot);
    for (int f = 0; f < 2; ++f) {
        if (f == 0 ? DENSE_FP8_L0 : DENSE_FP8_L2) {
            conv_job8(F, INP(15) + (size_t)f * DM * FF, FF, DM, FF, (unsigned char*)(WB + WE_GU + (size_t)f * 2 * FF * DM), CV_GATE, rot);
            conv_job8(F, INP(16) + (size_t)f * DM * FF, FF, DM, FF, (unsigned char*)(WB + WE_GU + (size_t)f * 2 * FF * DM), CV_UP, rot);
            conv_job8(F, INP(17) + (size_t)f * FF * DM, DM, FF, DM, (unsigned char*)(WB + WE_D + (size_t)f * DM * FF), CV_PLAIN, rot);
        } else {
            conv_job(F, INP(15) + (size_t)f * DM * FF, FF, DM, FF, WB + WE_GU + (size_t)f * 2 * FF * DM, CV_GATE, rot);
            conv_job(F, INP(16) + (size_t)f * DM * FF, FF, DM, FF, WB + WE_GU + (size_t)f * 2 * FF * DM, CV_UP, rot);
            conv_job(F, INP(17) + (size_t)f * FF * DM, DM, FF, DM, WB + WE_D + (size_t)f * DM * FF, CV_PLAIN, rot);
        }
    }
    for (int fe = 0; fe < 16; ++fe) {
        if (MOE_FP8) {
            conv_job8(F, INP(19) + (size_t)fe * DM * FF, FF, DM, FF, (unsigned char*)(WB + WE_MGU) + (size_t)fe * 2 * FF * DM, CV_GATE, rot);
            conv_job8(F, INP(20) + (size_t)fe * DM * FF, FF, DM, FF, (unsigned char*)(WB + WE_MGU) + (size_t)fe * 2 * FF * DM, CV_UP, rot);
            conv_job8(F, INP(21) + (size_t)fe * FF * DM, DM, FF, DM, (unsigned char*)(WB + WE_MD) + (size_t)fe * DM * FF, CV_PLAIN, rot);
        } else {
            conv_job(F, INP(19) + (size_t)fe * DM * FF, FF, DM, FF, WB + WE_MGU + (size_t)fe * 2 * FF * DM, CV_GATE, rot);
            conv_job(F, INP(20) + (size_t)fe * DM * FF, FF, DM, FF, WB + WE_MGU + (size_t)fe * 2 * FF * DM, CV_UP, rot);
            conv_job(F, INP(21) + (size_t)fe * FF * DM, DM, FF, DM, WB + WE_MD + (size_t)fe * DM * FF, CV_PLAIN, rot);
        }
    }
}

__device__ __forceinline__ int moe_cnt(Frame& F, int f, int e) {
    const unsigned long long w = __hip_atomic_load((GAS unsigned long long*)(F.ctl + CW_CNT + f * 64 + 16 * (e >> 2)), RLX_AGENT);
    return (int)((w >> (16 * (e & 3))) & 0xffffull);
}
__device__ __forceinline__ f32x4 moe_yrow(Frame& F, int r, int q4) {
    const bf16* Y = (const bf16*)(F.ws + WS_R2); const bf16* P = (const bf16*)(F.ws + WS_R2 + 72 * MiB);
    if (r < SPLIT_ROW0 || F.G != 256 || !MOE_SPLITK) { const v2u a = ((const GAS v2u*)(Y + (size_t)r * DM))[q4]; return (f32x4){bflo(a.x), bfhi(a.x), bflo(a.y), bfhi(a.y)}; }
    f32x4 s = (f32x4){0.f, 0.f, 0.f, 0.f};
#pragma unroll
    for (int k = 0; k < MOE_NSPLIT; ++k) { const v2u a = ((const GAS v2u*)(P + ((size_t)k * SPLIT_ROWS + (size_t)(r - SPLIT_ROW0)) * DM))[q4]; s = s + (f32x4){bflo(a.x), bfhi(a.x), bflo(a.y), bfhi(a.y)}; }
    return s;
}
__device__ __forceinline__ void moe_bases(Frame& F, int f, int (&tb)[NE + 1]) {
    int acc = 0;
#pragma unroll
    for (int e = 0; e < NE; ++e) { tb[e] = acc; const int c = moe_cnt(F, f, e); acc += (c + 255) >> 8; }
    tb[NE] = acc;
}

template <int NC>
__device__ __forceinline__ float wave_reduce_cols(float (&part)[NC], int lane) {
#pragma unroll
    for (int st = 0, n = NC / 2; n >= 1; ++st, n >>= 1) {
        const bool up = (lane >> st) & 1;
#pragma unroll
        for (int i = 0; i < n; ++i) { const float keep = up ? part[i + n] : part[i], send = up ? part[i] : part[i + n]; part[i] = keep + __shfl_xor(send, 1 << st); }
    }
    float v = part[0];
#pragma unroll
    for (int o = NC; o < 64; o <<= 1) v += __shfl_xor(v, o);
    return v;
}
template <int NC> __device__ __forceinline__ int lane_of_col(int c) {
    int l = 0;
#pragma unroll
    for (int st = 0, n = NC / 2; n >= 1; ++st, n >>= 1) { if (c & n) l |= 1 << st; }
    return l;
}
template <int FLAGS>
__device__ __forceinline__ void norm_phase(Frame& F, const float* xin, float* xout, const float* gain, bf16* H, int fprev, int f,
                                           const float* Wf  , const float* bf  , const float* Wr  ) {
    constexpr int NC = (FLAGS & 2) ? 16 : (FLAGS & 4) ? 8 : 0;
    const bf16* Y = (const bf16*)(F.ws + WS_R2);
    const int* tok_prev = (const int*)(F.ws + WS_MISC + MS_TOK) + (size_t)fprev * M * 2;
    float* lgf = (float*)(F.ws + WS_MISC + MS_LOGF);
    LAS int* sel = (LAS int*)F.lds;
    LAS float* sg = (LAS float*)(F.lds + 512);
    LAS int* gb = (LAS int*)(F.lds + 1536);
    LAS f32x4* WL = (LAS f32x4*)(F.lds + 4096);
    int tb[NE + 1];
    if (FLAGS & 1) moe_bases(F, fprev, tb);
    if (NC) {
        const float* Wsrc = (FLAGS & 2) ? Wf + 3072 : Wr; const int ldw = (FLAGS & 2) ? 3088 : 8;
        for (int idx = F.tid; idx < 16 * (NC / 4) * 64; idx += NTHR) {
            const int ln = idx & 63, cq = (idx >> 6) % (NC / 4), jq = idx / (64 * (NC / 4)), k = 4 * (ln + 64 * (jq >> 2)) + (jq & 3);
            WL[idx] = *(const GAS f32x4*)(Wsrc + (size_t)k * ldw + 4 * cq) * gain[k];
        }
        __syncthreads();
    }
    for (int chunk = blockIdx.x; chunk < M / 64; chunk += F.G) {
        for (int i = 0; i < 8; ++i) {
            const int m = chunk * 64 + F.wave * 8 + i;
            int ln = F.lane; asm volatile("" : "+v"(ln));
            const GAS f32x4* xr = (const GAS f32x4*)(xin + (size_t)m * DM) + ln;
            f32x4 v[4];
#pragma unroll
            for (int j = 0; j < 4; ++j) v[j] = xr[64 * j];
            if (FLAGS & 1) {
                const int s0 = tok_prev[m * 2], s1 = tok_prev[m * 2 + 1];
                int r0 = 0, r1 = 0;
#pragma unroll
                for (int e = 0; e < NE; ++e) { if ((s0 >> 14) == e) r0 = tb[e] * 256 + (s0 & 16383); if ((s1 >> 14) == e) r1 = tb[e] * 256 + (s1 & 16383); }
#pragma unroll
                for (int j = 0; j < 4; ++j) { v[j] = v[j] + moe_yrow(F, r0, ln + 64 * j) + moe_yrow(F, r1, ln + 64 * j);
                    ((GAS f32x4*)(xout + (size_t)m * DM) + ln)[64 * j] = v[j]; }
            }
            float s = 0.f;
#pragma unroll
            for (int j = 0; j < 4; ++j) s += (v[j].x * v[j].x + v[j].y * v[j].y) + (v[j].z * v[j].z + v[j].w * v[j].w);
            const float inv = 1.0f / sqrtf(wave_sum(s) * (1.f / DM) + RMS_EPS);
            float colv = 0.f;
            if (NC) {
                float part[NC ? NC : 1];
#pragma unroll
                for (int c = 0; c < NC; ++c) part[c] = 0.f;
                const int woff = ln;
#pragma unroll
                for (int j = 0; j < 4; ++j) {
#pragma unroll
                    for (int q = 0; q < 4; ++q) { const float xv = v[j][q];
#pragma unroll
                        for (int cq = 0; cq < NC / 4; ++cq) { const f32x4 w = WL[((j * 4 + q) * (NC / 4) + cq) * 64 + woff];
                            part[cq * 4 + 0] += xv * w.x; part[cq * 4 + 1] += xv * w.y; part[cq * 4 + 2] += xv * w.z; part[cq * 4 + 3] += xv * w.w; }
                        if ((q & 1) == 1) asm volatile("" ::: "memory"); } }
                colv = wave_reduce_cols<NC ? NC : 2>(reinterpret_cast<float (&)[NC ? NC : 2]>(part), ln) * inv;
            }
            if (H) {
                GAS unsigned long long* o8 = (GAS unsigned long long*)(H + (size_t)m * DM) + ln;
                GAS unsigned* h8 = (GAS unsigned*)(F.ws + WS_R2 + 104 * MiB + (size_t)m * DM) + ln;
#pragma unroll
                for (int j = 0; j < 4; ++j) { const f32x4 g = ((const GAS f32x4*)gain + ln)[64 * j]; const f32x4 hv = v[j] * inv * g;
                    if (((FLAGS & 4) && MOE_FP8) || (FLAGS & 8)) h8[64 * j] = pg8::cvt4_fp8(hv.x, hv.y, hv.z, hv.w);
                    else o8[64 * j] = (unsigned long long)pk2(hv.x, hv.y) | ((unsigned long long)pk2(hv.z, hv.w) << 32); }
            }
            if (FLAGS & 2) {
                if (ln < 16) { const int l = ln; const int c = ((l & 1) << 3) | ((l & 2) << 1) | ((l & 4) >> 1) | ((l & 8) >> 3);
                    const float z = colv + bf[c]; const float ls = fminf(z, 0.f) - log1pf(expf(-fabsf(z))); lgf[(size_t)m * 16 + c] = ls * LOG2E; }
            }
            if (FLAGS & 4) {
                float lg[8];
#pragma unroll
                for (int c = 0; c < 8; ++c) lg[c] = __builtin_bit_cast(float, __builtin_amdgcn_readlane(__builtin_bit_cast(int, colv), lane_of_col<8>(c)));
                int e0 = 0; float l0 = lg[0];
#pragma unroll
                for (int c = 1; c < 8; ++c) if (lg[c] > l0) { l0 = lg[c]; e0 = c; }
                int e1 = -1; float l1 = -INFINITY;
#pragma unroll
                for (int c = 0; c < 8; ++c) if (c != e0 && lg[c] > l1) { l1 = lg[c]; e1 = c; }
                const float g0 = 1.0f / (1.0f + expf(l1 - l0)), g1 = 1.0f - g0;
                if (ln == 0) { const int r = F.wave * 8 + i; sel[r * 2] = e0; sel[r * 2 + 1] = e1; sg[r * 2] = g0; sg[r * 2 + 1] = g1; }
            }
        }
        if (FLAGS & 4) {
            int* selg = (int*)(F.ws + WS_MISC + MS_SEL) + (size_t)f * M * 2;
            float* sgg = (float*)(F.ws + WS_MISC + MS_SG) + (size_t)f * M * 2;
            int* lcn = (int*)(F.ws + WS_MISC + MS_LC) + (size_t)f * 256 * 8;
            __syncthreads();
            if (F.tid < 128) { selg[chunk * 128 + F.tid] = sel[F.tid]; sgg[chunk * 128 + F.tid] = sg[F.tid]; }
            if (F.tid >= 128 && F.tid < 136) { const int e = F.tid - 128; int c = 0;
                for (int q = 0; q < 128; ++q) c += (sel[q] == e) ? 1 : 0;
                lcn[chunk * 8 + e] = c; }
            __syncthreads();
        }
    }
}

__device__ __forceinline__ void moe_finalize(Frame& F, int f) {
    const int* selg = (const int*)(F.ws + WS_MISC + MS_SEL) + (size_t)f * M * 2;
    const float* sgg = (const float*)(F.ws + WS_MISC + MS_SG) + (size_t)f * M * 2;
    const int* lcn = (const int*)(F.ws + WS_MISC + MS_LC) + (size_t)f * 256 * 8;
    int* list = (int*)(F.ws + WS_MISC + MS_LIST) + (size_t)f * NE * LCAP;
    float* gw = (float*)(F.ws + WS_MISC + MS_GW) + (size_t)f * NE * LCAP;
    int* tok = (int*)(F.ws + WS_MISC + MS_TOK) + (size_t)f * M * 2;
    LAS int* arr = (LAS int*)F.lds;
    LAS int* sel = (LAS int*)(F.lds + 8192);
    LAS int* pb = (LAS int*)(F.lds + 8192 + 512);
    LAS int* pt = (LAS int*)(F.lds + 8192 + 1536);
    LAS int* base = (LAS int*)(F.lds + 8192 + 2560);
    LAS int* tot = (LAS int*)(F.lds + 8192 + 2592);
    for (int chunk = blockIdx.x; chunk < M / 64; chunk += F.G) {
        if (F.tid < 256) { const v4u a = *(const GAS v4u*)(lcn + F.tid * 8), b = *(const GAS v4u*)(lcn + F.tid * 8 + 4);
            *(LAS v4u*)(arr + F.tid * 8) = a; *(LAS v4u*)(arr + F.tid * 8 + 4) = b; }
        if (F.tid < 128) sel[F.tid] = selg[chunk * 128 + F.tid];
        __syncthreads();
        if (F.tid < 256) { const int e = F.tid & 7, seg = F.tid >> 3; int b = 0, t = 0;
#pragma unroll
            for (int i = 0; i < 8; ++i) { const int c = seg * 8 + i; const int v = arr[c * 8 + e]; t += v; b += (c < chunk) ? v : 0; }
            pb[seg * 8 + e] = b; pt[seg * 8 + e] = t; }
        __syncthreads();
        if (F.tid < 8) { int b = 0, t = 0;
            for (int sgm = 0; sgm < 32; ++sgm) { b += pb[sgm * 8 + F.tid]; t += pt[sgm * 8 + F.tid]; }
            base[F.tid] = b; tot[F.tid] = t; }
        __syncthreads();
        if (F.tid < 128) { const int mye = sel[F.tid]; int lp = 0;
            for (int q = 0; q < 128; ++q) lp += (q < F.tid && sel[q] == mye) ? 1 : 0;
            const int q = F.tid, row = chunk * 64 + (q >> 1), pos = base[mye] + lp;
            list[mye * LCAP + pos] = row; gw[mye * LCAP + pos] = sgg[chunk * 128 + q]; tok[row * 2 + (q & 1)] = mye * LCAP + pos; }
        if (chunk == 0 && F.tid < 2) { unsigned long long w = 0ull;
#pragma unroll
            for (int i = 0; i < 4; ++i) w |= (unsigned long long)(unsigned)tot[4 * F.tid + i] << (16 * i);
            __hip_atomic_store((GAS unsigned long long*)(F.ctl + CW_CNT + f * 64 + 16 * F.tid), w, RLX_AGENT); }
        __syncthreads();
    }
}

__device__ __forceinline__ void final_combine(Frame& F, int f) {
    const bf16* Y = (const bf16*)(F.ws + WS_R2);
    const int* tok = (const int*)(F.ws + WS_MISC + MS_TOK) + (size_t)f * M * 2;
    int tb[NE + 1]; moe_bases(F, f, tb);
    for (int m = blockIdx.x * NWAVES + F.wave; m < M; m += F.G * NWAVES) {
        const int s0 = tok[m * 2], s1 = tok[m * 2 + 1]; int r0 = 0, r1 = 0;
#pragma unroll
        for (int e = 0; e < NE; ++e) { if ((s0 >> 14) == e) r0 = tb[e] * 256 + (s0 & 16383); if ((s1 >> 14) == e) r1 = tb[e] * 256 + (s1 & 16383); }
        GAS f32x4* xr = (GAS f32x4*)(F.out + (size_t)m * DM) + F.lane;
#pragma unroll
        for (int j = 0; j < 4; ++j) xr[64 * j] = xr[64 * j] + moe_yrow(F, r0, F.lane + 64 * j) + moe_yrow(F, r1, F.lane + 64 * j);
    }
}

__device__ __forceinline__ void cumsum_phase(Frame& F) {
    const float* logf = (const float*)(F.ws + WS_MISC + MS_LOGF);
    float* cum = (float*)(F.ws + WS_MISC + MS_CUM);
    const int gw = blockIdx.x * NWAVES + F.wave;
    if (gw < BATCH * NH) {
        const int b = gw >> 4, h = gw & 15;
        float v[32]; float s = 0.f;
#pragma unroll
        for (int i = 0; i < 32; ++i) { v[i] = logf[((size_t)b * SEQ + F.lane * 32 + i) * 16 + h]; s += v[i]; }
        float incl = s;
#pragma unroll
        for (int o = 1; o < 64; o <<= 1) { const float t = __shfl_up(incl, o); if (F.lane >= o) incl += t; }
        float run = incl - s;
#pragma unroll
        for (int i = 0; i < 32; ++i) { run += v[i]; cum[((size_t)b * SEQ + F.lane * 32 + i) * 16 + h] = run; }
    }
}

enum { EPI_PLANES = 0, EPI_RESID = 1, EPI_SWIGLU = 2, EPI_MOEDOWN = 3 };
struct SgP { const bf16* A; int lda; const int* rowidx; int Mrows; const float* W0; const float* W1; int ldw; int K; int N;
             bf16* outb; int ldo; float scale0; const float* base; float* outf; const float* gwv; };
template <int EPI>
__device__ __forceinline__ void sgemm(Frame& F, const SgP& p) {
    LAS float* As = (LAS float*)F.lds;
    LAS float* Bs0 = As + 16 * 132;
    LAS float* Bs1 = Bs0 + 16 * 128;
    const int tid = F.tid, ty = tid >> 4, tx = tid & 15;
    const int lrow = tid >> 2, lkq = (tid & 3) * 4;
    const int bk = tid >> 5, bn = (tid & 31) * 4;
    const int ntn = p.N / 128, ntiles = (p.Mrows / 128) * ntn;
    for (int tile = blockIdx.x; tile < ntiles; tile += F.G) {
        const int tm = tile / ntn, tn = tile % ntn;
        const int arow = p.rowidx ? p.rowidx[tm * 128 + lrow] : tm * 128 + lrow;
        const bf16* ap = p.A + (size_t)arow * p.lda + lkq;
        const float* bp0 = p.W0 + (size_t)bk * p.ldw + tn * 128 + bn;
        const float* bp1 = (EPI == EPI_SWIGLU) ? p.W1 + (size_t)bk * p.ldw + tn * 128 + bn : nullptr;
        f32x2 acc0[4][4], acc1[4][4];
#pragma unroll
        for (int i = 0; i < 4; ++i)
#pragma unroll
            for (int j = 0; j < 4; ++j) { acc0[i][j] = (f32x2){0.f, 0.f}; acc1[i][j] = (f32x2){0.f, 0.f}; }
        for (int k0 = 0; k0 < p.K; k0 += 16) {
            const v2u av = *(const GAS v2u*)(ap + k0);
            const f32x4 b0 = *(const GAS f32x4*)(bp0 + (size_t)k0 * p.ldw);
            f32x4 b1 = (f32x4){0.f, 0.f, 0.f, 0.f};
            if (EPI == EPI_SWIGLU) b1 = *(const GAS f32x4*)(bp1 + (size_t)k0 * p.ldw);
            __syncthreads();
            As[(lkq + 0) * 132 + lrow] = bflo(av.x); As[(lkq + 1) * 132 + lrow] = bfhi(av.x);
            As[(lkq + 2) * 132 + lrow] = bflo(av.y); As[(lkq + 3) * 132 + lrow] = bfhi(av.y);
            *(LAS f32x4*)(Bs0 + bk * 128 + bn) = b0;
            if (EPI == EPI_SWIGLU) *(LAS f32x4*)(Bs1 + bk * 128 + bn) = b1;
            __syncthreads();
#pragma unroll 2
            for (int k = 0; k < 16; ++k) {
                const f32x4 a = *(const LAS f32x4*)(As + k * 132 + ty * 4);
                const f32x4 bA = *(const LAS f32x4*)(Bs0 + k * 128 + tx * 8), bB = *(const LAS f32x4*)(Bs0 + k * 128 + tx * 8 + 4);
                const f32x2 bv[4] = {(f32x2){bA.x, bA.y}, (f32x2){bA.z, bA.w}, (f32x2){bB.x, bB.y}, (f32x2){bB.z, bB.w}};
#pragma unroll
                for (int i = 0; i < 4; ++i) {
#pragma unroll
                    for (int j = 0; j < 4; ++j) acc0[i][j] += a[i] * bv[j]; }
                if (EPI == EPI_SWIGLU) {
                    const f32x4 cA = *(const LAS f32x4*)(Bs1 + k * 128 + tx * 8), cB = *(const LAS f32x4*)(Bs1 + k * 128 + tx * 8 + 4);
                    const f32x2 cv[4] = {(f32x2){cA.x, cA.y}, (f32x2){cA.z, cA.w}, (f32x2){cB.x, cB.y}, (f32x2){cB.z, cB.w}};
#pragma unroll
                    for (int i = 0; i < 4; ++i) {
#pragma unroll
                        for (int j = 0; j < 4; ++j) acc1[i][j] += a[i] * cv[j]; }
                }
                __builtin_amdgcn_sched_barrier(0);
            }
        }
        const int c0 = tn * 128 + tx * 8;
#pragma unroll
        for (int i = 0; i < 4; ++i) {
            const int r = tm * 128 + ty * 4 + i;
            if (EPI == EPI_PLANES) {
                const int pl = c0 >> 10, cc = c0 & 1023; const float sc = (pl == 0) ? p.scale0 : 1.f;
                v4u w; w.x = pk2(acc0[i][0].x * sc, acc0[i][0].y * sc); w.y = pk2(acc0[i][1].x * sc, acc0[i][1].y * sc); w.z = pk2(acc0[i][2].x * sc, acc0[i][2].y * sc); w.w = pk2(acc0[i][3].x * sc, acc0[i][3].y * sc);
                *(GAS v4u*)(p.outb + (size_t)pl * PLANE + (size_t)r * DM + cc) = w;
            } else if (EPI == EPI_RESID) {
                const GAS f32x4* bp = (const GAS f32x4*)(p.base + (size_t)r * DM + c0); GAS f32x4* op = (GAS f32x4*)(p.outf + (size_t)r * DM + c0);
                const f32x4 x0 = bp[0], x1 = bp[1];
                op[0] = x0 + (f32x4){acc0[i][0].x, acc0[i][0].y, acc0[i][1].x, acc0[i][1].y}; op[1] = x1 + (f32x4){acc0[i][2].x, acc0[i][2].y, acc0[i][3].x, acc0[i][3].y};
            } else if (EPI == EPI_SWIGLU) {
                float o[8];
#pragma unroll
                for (int j = 0; j < 8; ++j) { const float g = acc0[i][j >> 1][j & 1], uu = acc1[i][j >> 1][j & 1]; o[j] = g / (1.0f + __expf(-g)) * uu; }
                v4u w; w.x = pk2(o[0], o[1]); w.y = pk2(o[2], o[3]); w.z = pk2(o[4], o[5]); w.w = pk2(o[6], o[7]);
                *(GAS v4u*)(p.outb + (size_t)r * p.ldo + c0) = w;
            } else {
                const float g = p.gwv[r]; GAS f32x4* op = (GAS f32x4*)(p.outf + (size_t)r * DM + c0);
                op[0] = (f32x4){acc0[i][0].x * g, acc0[i][0].y * g, acc0[i][1].x * g, acc0[i][1].y * g}; op[1] = (f32x4){acc0[i][2].x * g, acc0[i][2].y * g, acc0[i][3].x * g, acc0[i][3].y * g};
            }
        }
    }
}

__device__ __forceinline__ void qknorm_plane(Frame& F, bf16* plane, const float* gain, float mul) {
    const int nth = F.G * NTHR;
    for (int idx = blockIdx.x * NTHR + F.tid; idx < M * NH; idx += nth) {
        GAS v4u* p = (GAS v4u*)(plane + (size_t)idx * 64);
        v4u w[8]; float ss = 0.f;
#pragma unroll
        for (int c = 0; c < 8; ++c) { w[c] = p[c];
#pragma unroll
            for (int q = 0; q < 4; ++q) { const float a = bflo(w[c][q]), b = bfhi(w[c][q]); ss += a * a + b * b; } }
        const float inv = 1.0f / sqrtf(ss * (1.f / 64.f) + RMS_EPS) * mul;
#pragma unroll
        for (int c = 0; c < 8; ++c) { v4u o;
#pragma unroll
            for (int q = 0; q < 4; ++q) { const float a = bflo(w[c][q]) * inv * gain[c * 8 + 2 * q], b = bfhi(w[c][q]) * inv * gain[c * 8 + 2 * q + 1]; o[q] = pk2(a, b); }
            p[c] = o; }
    }
}

template <int MODE>
__device__ __forceinline__ void attn_simple_causal(Frame& F, const bf16* Qp, const bf16* Kp, const bf16* Vp, bf16* O, const float* cum) {
    LAS float* Ks = (LAS float*)F.lds;
    LAS float* Vs = Ks + 4096;
    LAS float* kb = Vs + 4096;
    for (int u = blockIdx.x; u < BATCH * NH * 4; u += F.G) {
        const int qblk = (u & 1) ? 3 - ((u >> 1) & 1) : ((u >> 1) & 1) * 1;
        const int bh = u >> 2, b = bh >> 4, h = bh & 15;
        const int t = qblk * 512 + F.tid;
        const size_t rowbase = (size_t)b * SEQ;
        float q[64], acc[64];
        { const GAS v4u* qp = (const GAS v4u*)(Qp + (rowbase + t) * DM + h * 64);
#pragma unroll
          for (int c = 0; c < 8; ++c) { const v4u w = qp[c];
#pragma unroll
              for (int k = 0; k < 4; ++k) { q[c * 8 + 2 * k] = bflo(w[k]); q[c * 8 + 2 * k + 1] = bfhi(w[k]); } } }
#pragma unroll
        for (int d = 0; d < 64; ++d) acc[d] = 0.f;
        float P = 1.f, mrun = -INFINITY, lrun = 0.f;
        const int ntile = 8 * (qblk + 1);
        for (int it = 0; it < ntile; ++it) {
            const int tile = (MODE == 0) ? ntile - 1 - it : it;
            __syncthreads();
            { const int key = F.tid >> 3, ch = F.tid & 7;
              const v4u kw = *(const GAS v4u*)(Kp + (rowbase + tile * 64 + key) * DM + h * 64 + ch * 8);
              const v4u vw = *(const GAS v4u*)(Vp + (rowbase + tile * 64 + key) * DM + h * 64 + ch * 8);
#pragma unroll
              for (int k = 0; k < 4; ++k) { Ks[key * 64 + ch * 8 + 2 * k] = bflo(kw[k]); Ks[key * 64 + ch * 8 + 2 * k + 1] = bfhi(kw[k]);
                                            Vs[key * 64 + ch * 8 + 2 * k] = bflo(vw[k]); Vs[key * 64 + ch * 8 + 2 * k + 1] = bfhi(vw[k]); }
              if (MODE == 2 && F.tid < 64) kb[F.tid] = -cum[(rowbase + tile * 64 + F.tid) * 16 + h]; }
            __syncthreads();
            for (int jj = 0; jj < 64; ++jj) {
                const int j = (MODE == 0) ? 63 - jj : jj; const int s = tile * 64 + j;
                float z = 0.f;
#pragma unroll
                for (int d4 = 0; d4 < 16; ++d4) { const f32x4 kv = *(const LAS f32x4*)(Ks + j * 64 + d4 * 4); z += q[d4 * 4] * kv.x + q[d4 * 4 + 1] * kv.y + q[d4 * 4 + 2] * kv.z + q[d4 * 4 + 3] * kv.w; }
                if (MODE == 0) {
                    const bool valid = s < t;
                    const float e = __builtin_amdgcn_exp2f(fminf(z, 100.f));
                    float r = 1.0f / (1.0f + e); float beta = 1.0f - r;
                    if (!valid) { r = 1.f; beta = 0.f; }
                    const float w = beta * P; P *= r;
#pragma unroll
                    for (int d4 = 0; d4 < 16; ++d4) { const f32x4 vv = *(const LAS f32x4*)(Vs + j * 64 + d4 * 4); acc[d4 * 4] += w * vv.x; acc[d4 * 4 + 1] += w * vv.y; acc[d4 * 4 + 2] += w * vv.z; acc[d4 * 4 + 3] += w * vv.w; }
                } else {
                    const bool valid = s <= t;
                    const float x = valid ? z + kb[j] : -INFINITY;
                    const float mn = fmaxf(mrun, x);
                    const float a = __builtin_amdgcn_exp2f(mrun - mn), pw = __builtin_amdgcn_exp2f(x - mn);
                    lrun = lrun * a + pw; mrun = mn;
#pragma unroll
                    for (int d4 = 0; d4 < 16; ++d4) { const f32x4 vv = *(const LAS f32x4*)(Vs + j * 64 + d4 * 4);
                        acc[d4 * 4] = acc[d4 * 4] * a + pw * vv.x; acc[d4 * 4 + 1] = acc[d4 * 4 + 1] * a + pw * vv.y; acc[d4 * 4 + 2] = acc[d4 * 4 + 2] * a + pw * vv.z; acc[d4 * 4 + 3] = acc[d4 * 4 + 3] * a + pw * vv.w; }
                }
            }
        }
        const float fin = (MODE == 0) ? 1.f : 1.0f / lrun;
        GAS v4u* op = (GAS v4u*)(O + (rowbase + t) * DM + h * 64);
#pragma unroll
        for (int c = 0; c < 8; ++c) { v4u w;
#pragma unroll
            for (int k = 0; k < 4; ++k) w[k] = pk2(acc[c * 8 + 2 * k] * fin, acc[c * 8 + 2 * k + 1] * fin);
            op[c] = w; }
    }
}

__device__ __forceinline__ int t5_bucket(int dist) {
    if (dist < 16) return dist;
    const float d = (float)dist;
    int lb = 16 + (int)(logf(d / 16.0f) / logf(128.0f) * 16.0f);
    return lb < 31 ? lb : 31;
}
__device__ __forceinline__ void attn_simple_dil(Frame& F, const bf16* PROJ, bf16* O, const float* rel_bias) {
    LAS float* tbl = (LAS float*)F.lds;
    for (int u = blockIdx.x; u < BATCH * NH * 4; u += F.G) {
        const int qblk = u & 3, bh = u >> 2, b = bh >> 4, h = bh & 15;
        const int t = qblk * 512 + F.tid;
        const size_t rowbase = (size_t)b * SEQ;
        __syncthreads();
        for (int i = F.tid; i < 3 * 129; i += NTHR) { const int g = i / 129, dl = i % 129, dil = (g == 0) ? 1 : (g == 1) ? 4 : 16;
            tbl[g * 132 + dl] = rel_bias[t5_bucket(dl * dil) * 16 + h] * LOG2E; }
        __syncthreads();
        float acc[64];
#pragma unroll
        for (int d = 0; d < 64; ++d) acc[d] = 0.f;
        float mrun = -INFINITY, lrun = 0.f;
        for (int g = 0; g < 3; ++g) {
            const int dil = (g == 0) ? 1 : (g == 1) ? 4 : 16;
            const bf16* Qg = PROJ + (size_t)(2 * g) * PLANE; const bf16* Kg = PROJ + (size_t)(2 * g + 1) * PLANE; const bf16* Vg = PROJ + (size_t)6 * PLANE;
            float q[64];
            { const GAS v4u* qp = (const GAS v4u*)(Qg + (rowbase + t) * DM + h * 64);
#pragma unroll
              for (int c = 0; c < 8; ++c) { const v4u w = qp[c];
#pragma unroll
                  for (int k = 0; k < 4; ++k) { q[c * 8 + 2 * k] = bflo(w[k]); q[c * 8 + 2 * k + 1] = bfhi(w[k]); } } }
            for (int dl = 0; dl <= 128; ++dl) {
                const int s = t - dl * dil; const bool valid = s >= 0; const int sc = valid ? s : 0;
                const GAS v4u* kp = (const GAS v4u*)(Kg + (rowbase + sc) * DM + h * 64);
                float z = 0.f;
#pragma unroll
                for (int c = 0; c < 8; ++c) { const v4u w = kp[c];
#pragma unroll
                    for (int k = 0; k < 4; ++k) z += q[c * 8 + 2 * k] * bflo(w[k]) + q[c * 8 + 2 * k + 1] * bfhi(w[k]); }
                const float x = valid ? z + tbl[g * 132 + dl] : -INFINITY;
                const float mn = fmaxf(mrun, x);
                const float a = __builtin_amdgcn_exp2f(mrun - mn), pw = __builtin_amdgcn_exp2f(x - mn);
                lrun = lrun * a + pw; mrun = mn;
                const GAS v4u* vp = (const GAS v4u*)(Vg + (rowbase + sc) * DM + h * 64);
#pragma unroll
                for (int c = 0; c < 8; ++c) { const v4u w = vp[c];
#pragma unroll
                    for (int k = 0; k < 4; ++k) { acc[c * 8 + 2 * k] = acc[c * 8 + 2 * k] * a + pw * bflo(w[k]); acc[c * 8 + 2 * k + 1] = acc[c * 8 + 2 * k + 1] * a + pw * bfhi(w[k]); } }
            }
        }
        const float fin = 1.0f / lrun;
        GAS v4u* op = (GAS v4u*)(O + (rowbase + t) * DM + h * 64);
#pragma unroll
        for (int c = 0; c < 8; ++c) { v4u w;
#pragma unroll
            for (int k = 0; k < 4; ++k) w[k] = pk2(acc[c * 8 + 2 * k] * fin, acc[c * 8 + 2 * k + 1] * fin);
            op[c] = w; }
    }
}

__device__ __forceinline__ void moe_gu_simple(Frame& F, int f, const bf16* H, bf16* ACT) {
    const int* list = (const int*)(F.ws + WS_MISC + MS_LIST) + (size_t)f * NE * LCAP;
    int base = 0;
    for (int e = 0; e < NE; ++e) {
        const int c = moe_cnt(F, f, e); const int nt = (c + 255) >> 8;
        if (nt) {
            SgP p{}; p.A = H; p.lda = DM; p.rowidx = list + e * LCAP; p.Mrows = nt * 256;
            p.W0 = INP(19) + ((size_t)f * NE + e) * DM * FF; p.W1 = INP(20) + ((size_t)f * NE + e) * DM * FF; p.ldw = FF; p.K = DM; p.N = FF;
            p.outb = ACT + (size_t)base * 256 * FF; p.ldo = FF;
            sgemm<EPI_SWIGLU>(F, p);
        }
        base += nt;
    }
}
__device__ __forceinline__ void moe_down_simple(Frame& F, int f, const bf16* ACT, float* Y) {
    const float* gw = (const float*)(F.ws + WS_MISC + MS_GW) + (size_t)f * NE * LCAP;
    int base = 0;
    for (int e = 0; e < NE; ++e) {
        const int c = moe_cnt(F, f, e); const int nt = (c + 255) >> 8;
        if (nt) {
            SgP p{}; p.A = ACT + (size_t)base * 256 * FF; p.lda = FF; p.rowidx = nullptr; p.Mrows = nt * 256;
            p.W0 = INP(21) + ((size_t)f * NE + e) * FF * DM; p.ldw = DM; p.K = FF; p.N = DM;
            p.outf = Y + (size_t)base * 256 * DM; p.gwv = gw + e * LCAP;
            sgemm<EPI_MOEDOWN>(F, p);
        }
        base += nt;
    }
}


template <class Epi, bool FP8 = false>
__device__ __forceinline__ void dense_gemm(Frame& F, const bf16* A, const bf16* Bt, int N, int K, const Epi& E) {
    pg8::DenseOrder S; S.init(A, Bt, M, N, K, F.G, (int)blockIdx.x);
    pg8::gemm_phase<Epi, pg8::DenseOrder, false, FP8>(F.lds, K, S, E);
}
__device__ __forceinline__ void moe_order_init(Frame& F, int f, pg8::MoeOrder& S) {
    int acc = 0, t[NE];
#pragma unroll
    for (int e = 0; e < NE; ++e) { const int c = moe_cnt(F, f, e); acc += (c + 255) >> 8; t[e] = acc; }
    S.t1 = t[0]; S.t2 = t[1]; S.t3 = t[2]; S.t4 = t[3]; S.t5 = t[4]; S.t6 = t[5]; S.t7 = t[6]; S.t8 = t[7];
    S.G = F.G; S.c = (int)blockIdx.x;
}
__device__ __forceinline__ void moe_gu_fast(Frame& F, int f, const bf16* H, bf16* ACT) {
    pg8::MoeOrder S; moe_order_init(F, f, S);
    S.list = (const int*)(F.ws + WS_MISC + MS_LIST) + (size_t)f * NE * LCAP; S.gather = true; S.splitk = 0; S.nN = 2 * FF / 256;
    if (MOE_FP8) {
        S.K = DM / 2; S.A = (const char*)(F.ws + WS_R2 + 104 * MiB); S.Bt = (const char*)((const bf16*)(F.ws + WS_W) + WE_MGU) + (size_t)f * NE * 2 * FF * DM;
        S.tstepA = (size_t)256 * DM; S.tstepB = (size_t)256 * DM; S.estepB = (size_t)2 * FF * DM;
        pg8::EpiSwigluF8 E{(unsigned char*)ACT};
        pg8::gemm_phase<pg8::EpiSwigluF8, pg8::MoeOrder, true, true>(F.lds, DM / 2, S, E);
    } else {
        S.K = DM; S.A = (const char*)H; S.Bt = (const char*)((const bf16*)(F.ws + WS_W) + WE_MGU + (size_t)f * NE * 2 * FF * DM);
        S.tstepA = (size_t)256 * DM * 2; S.tstepB = (size_t)256 * DM * 2; S.estepB = (size_t)2 * FF * DM * 2;
        pg8::EpiSwiglu E{ACT};
        pg8::gemm_phase<pg8::EpiSwiglu, pg8::MoeOrder, true>(F.lds, DM, S, E);
    }
}
__device__ __forceinline__ void moe_down_fast(Frame& F, int f, const bf16* ACT, bf16* Y) {
    pg8::MoeOrder S; moe_order_init(F, f, S);
    S.nN = DM / 256; S.list = nullptr; S.gather = false; S.splitk = (MOE_SPLITK && F.G == 256) ? MOE_NSPLIT : 0;
    const float* gwp = (const float*)(F.ws + WS_MISC + MS_GW) + (size_t)f * NE * LCAP; bf16* P = (bf16*)(F.ws + WS_R2 + 72 * MiB);
    if (MOE_FP8) {
        S.K = FF / 2; S.A = (const char*)ACT; S.Bt = (const char*)((const bf16*)(F.ws + WS_W) + WE_MD) + (size_t)f * NE * DM * FF;
        S.tstepA = (size_t)256 * FF; S.tstepB = (size_t)256 * FF; S.estepB = (size_t)DM * FF;
        pg8::EpiMoeDown E{Y, gwp, P, 1.0f / (W8S * A8S)};
        pg8::gemm_phase<pg8::EpiMoeDown, pg8::MoeOrder, false, true>(F.lds, FF / 2, S, E);
    } else {
        S.K = FF; S.A = (const char*)ACT; S.Bt = (const char*)((const bf16*)(F.ws + WS_W) + WE_MD + (size_t)f * NE * DM * FF);
        S.tstepA = (size_t)256 * FF * 2; S.tstepB = (size_t)256 * FF * 2; S.estepB = (size_t)DM * FF * 2;
        pg8::EpiMoeDown E{Y, gwp, P, 1.0f};
        pg8::gemm_phase<pg8::EpiMoeDown, pg8::MoeOrder, false>(F.lds, FF, S, E);
    }
}

struct Args { const float* in[22]; float* out; unsigned char* ws; int ph_lo, ph_hi; };
constexpr int N_PHASES = 33;

__global__ void __launch_bounds__(NTHR, 2) trunk_fwd(Args args) {
    extern __shared__ __attribute__((aligned(16))) unsigned char lds[];
    Frame F;
    F.lds = (LAS unsigned char*)lds;
    F.tid = threadIdx.x; F.lane = F.tid & 63; F.wave = __builtin_amdgcn_readfirstlane(F.tid >> 6); F.G = gridDim.x;
    F.ws = args.ws; F.ctl = (gu32*)(args.ws + WS_CTL); F.out = args.out;
    if (F.tid == 0) {
#pragma unroll
        for (int i = 0; i < 22; ++i) ((LAS unsigned long long*)(F.lds + PTR_OFF))[i] = (unsigned long long)args.in[i];
    }
    volatile LAS unsigned* MISC = (volatile LAS unsigned*)(F.lds + MISC_OFF);
    if (F.tid < 32) MISC[F.tid] = 0u;
    __syncthreads();
    XcdBarrier bar; bar.bar = (unsigned*)(F.ctl + CW_BAR); bar.x = 0; bar.st = nullptr;
    const int lo = args.ph_lo, hi = args.ph_hi;
    if (hi - lo > 1) bar = xcd_barrier_post((unsigned*)(F.ctl + CW_BAR), MISC + 8);
#ifndef PHSEL
#define PHSEL 0xFFFFFFFFFFFFFFFFull
#endif
#define IN(k) (lo <= (k) && (k) < hi && ((PHSEL >> (k)) & 1ull) && relaunder(F))
#define SEAM(k) do { if (IN((k) + 1) && IN(k)) xcd_barrier(bar); } while (0)
#ifndef DUPMASK
#define DUPMASK 0ull
#endif
#define DUP(k) (((DUPMASK >> (k)) & 1ull) != 0ull)

    bf16* H = (bf16*)(F.ws + WS_H);
    bf16* PROJ = (bf16*)(F.ws + WS_R1);
    bf16* ACT = (bf16*)(F.ws + WS_R1);
    bf16* O = (bf16*)(F.ws + WS_R2);
    bf16* Y = (bf16*)(F.ws + WS_R2);
    bf16* OG = (bf16*)(F.ws + WS_R2 + 32 * MiB);
    float* ST = (float*)(F.ws + WS_R2 + 128 * MiB);
    float* X = F.out;
    const bf16* H8 = (const bf16*)(F.ws + WS_R2 + 104 * MiB);
    float* DUMMY = (float*)(F.ws + WS_R2 + 32 * MiB);
    const float* cum = (const float*)(F.ws + WS_MISC + MS_CUM);

    const bf16* WB = (const bf16*)(F.ws + WS_W);
    enum { PH_BASE = __COUNTER__ + 1 };
#define PHASE(...) { constexpr int k_ = __COUNTER__ - PH_BASE; if (IN(k_)) { __VA_ARGS__; if (DUP(k_)) { xcd_barrier(bar); __VA_ARGS__; } SEAM(k_); } }
    PHASE({ unsigned* z = (unsigned*)(F.ws + WS_MISC + MS_LIST);
            for (int i = blockIdx.x * NTHR + F.tid; i < (int)(2 * MiB / 4); i += F.G * NTHR) z[i] = 0u;
            convert_weights(F); })
    PHASE(norm_phase<0>(F, INP(0), nullptr, INP(13) + 0 * DM, H, 0, 0, nullptr, nullptr, nullptr))
    PHASE({ pg8::EpiPlanes E{PROJ, C2}; dense_gemm(F, H, WB + WE_QKV, 3 * DM, DM, E); })
    PHASE(att::causal_phase<0>((att::lptr)F.lds, F.G, PROJ, PROJ + PLANE, PROJ + 2 * PLANE, O, nullptr))
    PHASE({ pg8::EpiResid E{INP(0), X, 1.0f}; dense_gemm(F, O, WB + WE_WO_SB, DM, DM, E); })
    PHASE(norm_phase<DENSE_FP8_L0 ? 8 : 0>(F, X, nullptr, INP(14) + 0 * DM, H, 0, 0, nullptr, nullptr, nullptr))
    PHASE({ if (DENSE_FP8_L0) { pg8::EpiSwigluF8 E{(unsigned char*)ACT}; dense_gemm<pg8::EpiSwigluF8, true>(F, H8, (const bf16*)((const unsigned char*)(WB + WE_GU)), 2 * FF, DM / 2, E); }
            else { pg8::EpiSwiglu E{ACT}; dense_gemm(F, H, WB + WE_GU, 2 * FF, DM, E); } })
    PHASE({ if (DENSE_FP8_L0) { pg8::EpiResid E{X, X, 1.0f / (W8S * A8S)}; dense_gemm<pg8::EpiResid, true>(F, ACT, (const bf16*)((const unsigned char*)(WB + WE_D)), DM, FF / 2, E); }
            else { pg8::EpiResid E{X, X, 1.0f}; dense_gemm(F, ACT, WB + WE_D, DM, FF, E); } })
    PHASE(norm_phase<0>(F, X, nullptr, INP(13) + 1 * DM, H, 0, 0, nullptr, nullptr, nullptr))
    PHASE({ pg8::EpiQKNorm E{PROJ, INP(4), INP(5), 6}; dense_gemm(F, H, WB + WE_IN_DIL, 7 * DM, DM, E); })
    PHASE(att::dil_phase((att::lptr)F.lds, F.G, PROJ, OG, ST, INP(12)))
    PHASE(att::dil_merge(F.G, OG, ST, O))
    PHASE({ pg8::EpiResid E{X, X, 1.0f}; dense_gemm(F, O, WB + WE_WO_DIL, DM, DM, E); })
    PHASE(norm_phase<4>(F, X, nullptr, INP(14) + 1 * DM, H, 0, 0, nullptr, nullptr, INP(18) + 0 * DM * NE))
    PHASE(moe_finalize(F, 0))
    PHASE(moe_gu_fast(F, 0, H, ACT))
    PHASE(moe_down_fast(F, 0, ACT, Y))
    PHASE(norm_phase<1 | 2>(F, X, X, INP(13) + 2 * DM, H, 0, 0, INP(7), INP(8), nullptr))
    PHASE({ cumsum_phase(F); pg8::EpiQKNorm E{PROJ, INP(9), INP(10), 2}; dense_gemm(F, H, WB + WE_IN_FOX, 3 * DM, DM, E); })
    PHASE(att::causal_phase<2>((att::lptr)F.lds, F.G, PROJ, PROJ + PLANE, PROJ + 2 * PLANE, O, cum))
    PHASE({ pg8::EpiResid E{X, X, 1.0f}; dense_gemm(F, O, WB + WE_WO_FOX, DM, DM, E); })
    PHASE(norm_phase<DENSE_FP8_L2 ? 8 : 0>(F, X, nullptr, INP(14) + 2 * DM, H, 0, 0, nullptr, nullptr, nullptr))
    PHASE({ if (DENSE_FP8_L2) { pg8::EpiSwigluF8 E{(unsigned char*)ACT}; dense_gemm<pg8::EpiSwigluF8, true>(F, H8, WB + WE_GU + (size_t)2 * FF * DM, 2 * FF, DM / 2, E); }
            else { pg8::EpiSwiglu E{ACT}; dense_gemm(F, H, WB + WE_GU + (size_t)2 * FF * DM, 2 * FF, DM, E); } })
    PHASE({ if (DENSE_FP8_L2) { pg8::EpiResid E{X, X, 1.0f / (W8S * A8S)}; dense_gemm<pg8::EpiResid, true>(F, ACT, WB + WE_D + (size_t)DM * FF, DM, FF / 2, E); }
            else { pg8::EpiResid E{X, X, 1.0f}; dense_gemm(F, ACT, WB + WE_D + (size_t)DM * FF, DM, FF, E); } })
    PHASE(norm_phase<0>(F, X, nullptr, INP(13) + 3 * DM, H, 0, 0, nullptr, nullptr, nullptr))
    PHASE({ pg8::EpiPlanes E{PROJ, C2}; dense_gemm(F, H, WB + WE_QKV + (size_t)3 * DM * DM, 3 * DM, DM, E); })
    PHASE(att::causal_phase<0>((att::lptr)F.lds, F.G, PROJ, PROJ + PLANE, PROJ + 2 * PLANE, O, nullptr))
    PHASE({ pg8::EpiResid E{X, X, 1.0f}; dense_gemm(F, O, WB + WE_WO_SB + (size_t)DM * DM, DM, DM, E); })
    PHASE(norm_phase<4>(F, X, nullptr, INP(14) + 3 * DM, H, 0, 1, nullptr, nullptr, INP(18) + 1 * DM * NE))
    PHASE(moe_finalize(F, 1))
    PHASE(moe_gu_fast(F, 1, H, ACT))
    PHASE(moe_down_fast(F, 1, ACT, Y))
    PHASE(final_combine(F, 1))
    static_assert(__COUNTER__ - PH_BASE == N_PHASES, "N_PHASES must equal the number of PHASE() sites");
#undef PHASE
#undef IN
#undef SEAM
}

extern "C" void kernel_launch(void* const* d_in, const int* in_sizes, int n_in, void* d_out, int out_size, void* d_ws, size_t ws_size, hipStream_t stream) {
    static int grid = 0;
    if (grid == 0) {
        if (n_in != 22 || out_size != M * DM || ws_size < WS_END) { fprintf(stderr, "kernel_launch: unexpected shapes (n_in %d out %d ws %zu)\n", n_in, out_size, ws_size); grid = -1; return; }
        int dev = 0, cus = 0, per_cu = 0;
        if (hipGetDevice(&dev) != hipSuccess || hipDeviceGetAttribute(&cus, hipDeviceAttributeMultiprocessorCount, dev) != hipSuccess) { grid = -1; return; }
        if (hipFuncSetAttribute((const void*)trunk_fwd, hipFuncAttributeMaxDynamicSharedMemorySize, LDS_BYTES) != hipSuccess) { fprintf(stderr, "kernel_launch: hipFuncSetAttribute failed\n"); grid = -1; return; }
        if (hipOccupancyMaxActiveBlocksPerMultiprocessor(&per_cu, (const void*)trunk_fwd, NTHR, LDS_BYTES) != hipSuccess || per_cu < 1) fprintf(stderr, "kernel_launch: occupancy query says %d\n", per_cu);
        (void)hipGetLastError();
        grid = cus;
    }
    if (grid < 0) return;
    (void)hipMemsetAsync((char*)d_ws + WS_CTL, 0, CTL_ZERO_BYTES, stream);
    Args a{};
    for (int i = 0; i < 22; ++i) a.in[i] = (const float*)d_in[i];
    a.out = (float*)d_out; a.ws = (unsigned char*)d_ws;
#if MK_MULTI
    for (int p = 0; p < N_PHASES; ++p) { a.ph_lo = p; a.ph_hi = p + 1; hipLaunchKernelGGL(trunk_fwd, dim3(grid), dim3(NTHR), LDS_BYTES, stream, a); }
#else
    a.ph_lo = 0; a.ph_hi = N_PHASES;
    hipLaunchKernelGGL(trunk_fwd, dim3(grid), dim3(NTHR), LDS_BYTES, stream, a);
#endif
}
```

```cpp
#include <hip/hip_runtime.h>
#include <cstdio>
#include <cstdint>

#ifndef MK_MULTI
#define MK_MULTI 0
#endif

constexpr int BATCH = 8, SEQ = 2048, DM = 1024, NH = 16, HD = 64, FF = 3584, NE = 8;
constexpr int M = BATCH * SEQ;
constexpr float RMS_EPS = 1e-6f;
constexpr float LOG2E = 1.4426950408889634f;
constexpr float C2 = 0.125f * LOG2E;
constexpr int NWAVES = 8, NTHR = 512;
constexpr int LCAP = 16384;
constexpr int MAXROWS = 34816;
constexpr bool MOE_SPLITK = true;
constexpr bool MOE_FP8 = true;
constexpr bool FOXIN_FP8 = true;
constexpr bool QKV3_FP8 = true;
constexpr bool DENSE_FP8_L0 = false, DENSE_FP8_L2 = true;
constexpr float W8S = 32.0f, A8S = 4.0f;
constexpr int MOE_NSPLIT = MOE_FP8 ? 2 : 4;
constexpr int SPLIT_ROW0 = 32768, SPLIT_ROWS = MAXROWS - SPLIT_ROW0;

constexpr size_t MiB = 1u << 20;
constexpr size_t WS_CTL = 0, CTL_ZERO_BYTES = 1 * MiB;
constexpr size_t WS_MISC = 1 * MiB;
constexpr size_t WS_H = 6 * MiB;
constexpr size_t WS_R1 = 38 * MiB;
constexpr size_t WS_R2 = 278 * MiB;
constexpr size_t WS_W = 414 * MiB;
constexpr size_t WS_END = 832 * MiB;
constexpr size_t PLANE = (size_t)M * DM;
constexpr size_t WE_QKV = 0;
constexpr size_t WE_WO_SB = WE_QKV + 2ull * 3072 * 1024;
constexpr size_t WE_WO_DIL = WE_WO_SB + 2ull * 1024 * 1024;
constexpr size_t WE_WO_FOX = WE_WO_DIL + 1024ull * 1024;
constexpr size_t WE_IN_DIL = WE_WO_FOX + 1024ull * 1024;
constexpr size_t WE_IN_FOX = WE_IN_DIL + 7168ull * 1024;
constexpr size_t WE_GU = WE_IN_FOX + 3072ull * 1024;
constexpr size_t WE_D = WE_GU + 2ull * 7168 * 1024;
constexpr size_t WE_MGU = WE_D + 2ull * 1024 * 3584;
constexpr size_t WE_MD = WE_MGU + 16ull * 7168 * 1024;
constexpr size_t WE_END = WE_MD + 16ull * 1024 * 3584;
static_assert(WS_W + WE_END * 2 <= WS_END, "weight copies fit");
constexpr size_t MS_LIST = 0;
constexpr size_t MS_GW = 1 * MiB;
constexpr size_t MS_TOK = 2 * MiB;
constexpr size_t MS_LOGF = 2 * MiB + 256 * 1024;
constexpr size_t MS_CUM = 3 * MiB + 256 * 1024;
constexpr size_t MS_SEL = 4 * MiB + 256 * 1024;
constexpr size_t MS_SG = MS_SEL + 256 * 1024;
constexpr size_t MS_LC = MS_SG + 256 * 1024;
constexpr int CW_BAR = 4096;
constexpr int CW_CNT = 64;

#define GAS __attribute__((address_space(1)))
#define LAS __attribute__((address_space(3)))
typedef unsigned short bf16;
typedef unsigned v4u __attribute__((ext_vector_type(4)));
typedef unsigned v2u __attribute__((ext_vector_type(2)));
typedef float f32x4 __attribute__((ext_vector_type(4)));
typedef float f32x2 __attribute__((ext_vector_type(2)));
typedef GAS unsigned gu32;
#define RLX_AGENT __ATOMIC_RELAXED, __HIP_MEMORY_SCOPE_AGENT
__device__ __forceinline__ unsigned f2bf(float f) { unsigned u = __builtin_bit_cast(unsigned, f); return (u + 0x7fffu + ((u >> 16) & 1u)) >> 16; }
__device__ __forceinline__ unsigned pk2(float lo, float hi) { return f2bf(lo) | (f2bf(hi) << 16); }
__device__ __forceinline__ float bflo(unsigned u) { return __builtin_bit_cast(float, u << 16); }
__device__ __forceinline__ float bfhi(unsigned u) { return __builtin_bit_cast(float, u & 0xffff0000u); }

#define XB_TMO      128
#define XB_XCNT(j)  (256  + 64 * (j))
#define XB_XSUB(j)  (1280 + 64 * (j))
#define XB_XGEN(j)  (2304 + 64 * (j))
#define XB_TOP      3328
#define XB_TOPGEN   3392
#define XCD_BAR_WORDS 3456
#define XB_SPIN_CAP (1u << 22)
__device__ __forceinline__ unsigned xb_ld(unsigned* p)              { return __hip_atomic_load(p, __ATOMIC_RELAXED, __HIP_MEMORY_SCOPE_AGENT); }
__device__ __forceinline__ unsigned xb_add(unsigned* p, unsigned v) { return __hip_atomic_fetch_add(p, v, __ATOMIC_RELAXED, __HIP_MEMORY_SCOPE_AGENT); }
__device__ __forceinline__ unsigned xb_xcc_id() { return (unsigned)__builtin_amdgcn_s_getreg((3 << 11) | 20) & 0xFu; }
#define XB_SPIN(cond, bar) do { unsigned _sp = 0; while (cond) { __builtin_amdgcn_s_sleep(1); \
    if ((++_sp & 255u) == 0u) { if (xb_ld(&(bar)[XB_TMO])) break; if (_sp > XB_SPIN_CAP) { atomicAdd(&(bar)[XB_TMO], 1u); break; } } } } while (0)
struct XcdBarrier { unsigned* bar; unsigned x; volatile LAS unsigned* st; };
__device__ __forceinline__ XcdBarrier xcd_barrier_post(unsigned* bar, volatile LAS unsigned* st) {
    XcdBarrier b; b.bar = bar; b.x = xb_xcc_id(); b.st = st;
    if (threadIdx.x == 0) (void)xb_add(&bar[XB_XCNT(b.x)], 1u);
    return b;
}
__device__ __forceinline__ void xcd_barrier_complete(unsigned* bar, unsigned x, unsigned& nloc, unsigned& nx) {
    const unsigned G = gridDim.x * gridDim.y * gridDim.z;
    unsigned sum, cnt, mine, sp = 0u;
    for (;;) {
        sum = 0u; cnt = 0u; mine = 0u;
#pragma unroll
        for (unsigned j = 0; j < 16; ++j) { const unsigned c = xb_ld(&bar[XB_XCNT(j)]); sum += c; cnt += (c > 0u) ? 1u : 0u; mine = (j == x) ? c : mine; }
        if (sum == G) break;
        __builtin_amdgcn_s_sleep(1);
        if ((++sp & 255u) == 0u) { if (xb_ld(&bar[XB_TMO])) break; if (sp > XB_SPIN_CAP) { atomicAdd(&bar[XB_TMO], 1u); break; } }
    }
    nloc = mine > 0u ? mine : 1u; nx = cnt > 0u ? cnt : 1u;
}
__device__ __forceinline__ void xcd_barrier(const XcdBarrier& b) {
    asm volatile("s_waitcnt vmcnt(0)" ::: "memory");
    __syncthreads();
    if (threadIdx.x == 0) {
        unsigned* bar = b.bar;
        __builtin_amdgcn_s_waitcnt(0);
        unsigned nloc = b.st[0], nx = b.st[1];
        if (nloc == 0u) { xcd_barrier_complete(bar, b.x, nloc, nx); b.st[0] = nloc; b.st[1] = nx; }
        const unsigned old = xb_add(&bar[XB_XSUB(b.x)], 1u);
        const unsigned gen = old / nloc;
        if (old + 1u == (gen + 1u) * nloc) {
            __builtin_amdgcn_fence(__ATOMIC_RELEASE, "agent");
            asm volatile("s_waitcnt vmcnt(0)" ::: "memory");
            const unsigned og = xb_add(&bar[XB_TOP], 1u);
            const unsigned tg = og / nx;
            if (og + 1u == (tg + 1u) * nx) xb_add(&bar[XB_TOPGEN], 1u);
            else XB_SPIN(xb_ld(&bar[XB_TOPGEN]) == tg, bar);
            __builtin_amdgcn_fence(__ATOMIC_ACQUIRE, "agent");
            xb_add(&bar[XB_XGEN(b.x)], 1u);
            asm volatile("s_waitcnt vmcnt(0)" ::: "memory");
        } else {
            XB_SPIN(xb_ld(&bar[XB_XGEN(b.x)]) == gen, bar);
            __builtin_amdgcn_fence(__ATOMIC_ACQUIRE, "agent");
            asm volatile("s_waitcnt vmcnt(0)" ::: "memory");
        }
    }
    __syncthreads();
}

constexpr int LDS_BYTES = 147456;
constexpr int ATT_LDS_MAX = 143360;
constexpr int MISC_OFF = ATT_LDS_MAX + 64;
struct Frame {
    LAS unsigned char* lds;
    int tid, lane, wave, G;
    unsigned char* ws; gu32* ctl;
    float* out;
};
__device__ __forceinline__ float wave_sum(float v) {
#pragma unroll
    for (int o = 1; o < 64; o <<= 1) v += __shfl_xor(v, o);
    return v;
}

constexpr int PTR_OFF = ATT_LDS_MAX + 512;
__device__ __forceinline__ const float* inp_ptr(Frame& F, int k) {
    const LAS unsigned* t = (const LAS unsigned*)(F.lds + PTR_OFF) + 2 * k;
    const unsigned lo = __builtin_amdgcn_readfirstlane(t[0]), hi = __builtin_amdgcn_readfirstlane(t[1]);
    return (const float*)(((unsigned long long)hi << 32) | lo);
}
#define INP(k) inp_ptr(F, (k))
__device__ __forceinline__ bool relaunder(Frame& F) { int t_ = threadIdx.x; asm volatile("" : "+v"(t_)); F.tid = t_; F.lane = t_ & 63; F.wave = __builtin_amdgcn_readfirstlane(t_ >> 6); return true; }
namespace pg8 {
#define PG8_LAS __attribute__((address_space(3)))
typedef unsigned short bf16_t;
typedef short bf16x8 __attribute__((ext_vector_type(8)));
typedef unsigned u32x4 __attribute__((ext_vector_type(4)));
constexpr int BM = 256, BK = 64, HALF = 128, HTB = HALF * BK * 2, STAGE_BYTES = 8 * HTB, NXCD = 8, WGM = 8;
__host__ __device__ __forceinline__ int lds_byte(int r, int c) { const int st = (r >> 4) * 2 + (c >> 5), rr = r & 15, cc = c & 31, ob = rr * 64 + cc * 2; return st * 1024 + (ob ^ (((ob >> 9) & 1) << 5)); }
__host__ __device__ __forceinline__ void stage_rc(int b, int& R, int& C) { const int st = b / 1024, sb = b % 1024, swz = sb ^ (((sb >> 9) & 1) << 5); R = (st >> 1) * 16 + swz / 64; C = (st & 1) * 32 + (swz % 64) / 2; }
__host__ __device__ __forceinline__ int perm32(int rho) { const int n = rho >> 4, i = rho & 15; return 8 * (i >> 2) + 4 * n + (i & 3); }
struct Unit { int pm, pn, e, mt, nt, koff, kq; };

struct DenseOrder {
    int nM, nN, nwg, G, c, ntk; const char* A; const char* Bt; size_t tstep;
    __device__ __forceinline__ void init(const bf16_t* A_, const bf16_t* Bt_, int M_, int N_, int K_, int G_, int c_) { nM = M_ / BM; nN = N_ / BM; nwg = nM * nN; G = G_; c = c_; ntk = K_ / BK; A = (const char*)A_; Bt = (const char*)Bt_; tstep = (size_t)BM * K_ * 2; }
    __device__ __forceinline__ bool next(int i, Unit& u) const {
        const long L = (long)i * G + c; if (L >= nwg) return false;
        int wgid = (int)L; { const int q = nwg / NXCD, r = nwg % NXCD, xcd = wgid % NXCD, off = wgid / NXCD; wgid = (xcd < r ? xcd * (q + 1) : r * (q + 1) + (xcd - r) * q) + off; }
        const int nig = WGM * nN, gid = wgid / nig, fm = gid * WGM, gsz = (nM - fm) < WGM ? (nM - fm) : WGM;
        u.pm = fm + ((wgid % nig) % gsz); u.pn = (wgid % nig) / gsz; u.e = 0; u.mt = u.pm; u.nt = ntk; u.koff = 0; u.kq = -1; return true;
    }
    __device__ __forceinline__ const char* a_base(const Unit& u) const { return A + (size_t)u.pm * tstep; }
    __device__ __forceinline__ const char* b_base(const Unit& u) const { return Bt + (size_t)u.pn * tstep; }
    __device__ __forceinline__ void a_voff(const Unit&, const int (&)[2], const int (&)[2], unsigned (&)[2][2]) const {}
};
struct MoeOrder {
    int t1, t2, t3, t4, t5, t6, t7, t8, nN, G, c, K; const char* A; const char* Bt; size_t tstepA, tstepB, estepB; const int* list; bool gather; int splitk;
    __device__ __forceinline__ bool next(int i, Unit& u) const {
        const int X = i * G + c, U = t8 * nN; int L = X; u.nt = K / BK; u.koff = 0; u.kq = -1;
        if (splitk) { const int nfull = (U / G) * G;
            if (X >= nfull) { const int q = X - nfull; if (q >= splitk * (U - nfull)) return false; L = nfull + q / splitk; u.kq = q % splitk; u.nt = K / BK / splitk; u.koff = u.kq * (K / splitk) * 2; } }
        else if (X >= U) return false;
        const int mt = L / nN; u.pm = mt; u.pn = L - mt * nN;
        const int e = (mt >= t1) + (mt >= t2) + (mt >= t3) + (mt >= t4) + (mt >= t5) + (mt >= t6) + (mt >= t7);
        const int tb = e == 0 ? 0 : e == 1 ? t1 : e == 2 ? t2 : e == 3 ? t3 : e == 4 ? t4 : e == 5 ? t5 : e == 6 ? t6 : t7;
        u.e = e; u.mt = mt - tb; return true;
    }
    __device__ __forceinline__ const char* a_base(const Unit& u) const { return (gather ? A : A + (size_t)u.pm * tstepA) + u.koff; }
    __device__ __forceinline__ const char* b_base(const Unit& u) const { return Bt + (size_t)u.e * estepB + (size_t)u.pn * tstepB + u.koff; }
    __device__ __forceinline__ void a_voff(const Unit& u, const int (&sR)[2], const int (&sC)[2], unsigned (&v)[2][2]) const {
        const int* lp = list + u.e * LCAP + u.mt * 256;
#pragma unroll
        for (int h = 0; h < 2; ++h)
#pragma unroll
            for (int i = 0; i < 2; ++i) v[h][i] = (unsigned)lp[h * 128 + sR[i]] * (unsigned)(K * 2) + (unsigned)(sC[i] * 2);
    }
};

typedef int v8i32 __attribute__((ext_vector_type(8)));
typedef int v4i32 __attribute__((ext_vector_type(4)));
__device__ __forceinline__ v8i32 cat8(bf16x8 a, bf16x8 b) { const v4i32 x = __builtin_bit_cast(v4i32, a), y = __builtin_bit_cast(v4i32, b); return (v8i32){x[0], x[1], x[2], x[3], y[0], y[1], y[2], y[3]}; }
__device__ __forceinline__ unsigned cvt4_fp8(float a, float b, float c, float d) { int w = 0; w = __builtin_amdgcn_cvt_pk_fp8_f32(a, b, w, false); w = __builtin_amdgcn_cvt_pk_fp8_f32(c, d, w, true); return (unsigned)w; }
__device__ __forceinline__ const char* uniptr(const char* p) { const unsigned long long v = (unsigned long long)p; const unsigned lo = __builtin_amdgcn_readfirstlane((unsigned)v), hi = __builtin_amdgcn_readfirstlane((unsigned)(v >> 32)); return (const char*)(((unsigned long long)hi << 32) | lo); }
__device__ __forceinline__ void glds16_s(const char* sbase, unsigned voff, unsigned lds_dst) { unsigned keep;
    asm volatile("s_mov_b32 %0, m0\n\ts_mov_b32 m0, %3\n\ts_nop 0\n\tglobal_load_lds_dwordx4 %2, %1\n\ts_mov_b32 m0, %0" : "=&s"(keep) : "s"(sbase), "v"(voff), "s"(lds_dst) : "memory"); }
__device__ __forceinline__ unsigned cvt_pk_bf16(float lo, float hi) { unsigned r; asm volatile("v_cvt_pk_bf16_f32 %0, %1, %2" : "=v"(r) : "v"(lo), "v"(hi)); return r; }

struct EpiPlanes {
    static constexpr bool PERM = true;
    bf16_t* O; float scale0; float oscale;
    __device__ __forceinline__ void operator()(const f32x4 (&acc)[2][2][4][2], const Unit& u, int wr, int wc, int fr, int fq) const {
        const int plane = u.pn >> 2; const float sc = (plane == 0 ? scale0 : 1.f) * oscale;
        bf16_t* base = O + (size_t)plane * PLANE + (size_t)(u.pm * BM + wr * 64 + fr) * DM + (u.pn & 3) * 256 + wc * 32 + 8 * fq;
#pragma unroll
        for (int ai = 0; ai < 2; ++ai)
#pragma unroll
            for (int m = 0; m < 4; ++m) { bf16_t* rowp = base + (size_t)(ai * HALF + m * 16) * DM;
#pragma unroll
                for (int bj = 0; bj < 2; ++bj) { const f32x4 v0 = acc[ai][bj][m][0] * sc, v1 = acc[ai][bj][m][1] * sc;
                    u32x4 w; w.x = cvt_pk_bf16(v0[0], v0[1]); w.y = cvt_pk_bf16(v0[2], v0[3]); w.z = cvt_pk_bf16(v1[0], v1[1]); w.w = cvt_pk_bf16(v1[2], v1[3]);
                    *(u32x4*)(rowp + bj * HALF) = w; } }
    }
};
struct EpiQKNorm {
    static constexpr bool PERM = true;
    bf16_t* O; const float* qg; const float* kg; int vplane; float iscale;
    __device__ __forceinline__ void operator()(const f32x4 (&acc)[2][2][4][2], const Unit& u, int wr, int wc, int fr, int fq) const {
        const int plane = u.pn >> 2; const bool isv = plane == vplane; const bool isq = !isv && ((plane & 1) == 0); const int grp = plane >> 1;
        const float* g = (isq ? qg : kg) + grp * 64 + 8 * fq;
        f32x4 gv[2][2];
#pragma unroll
        for (int bj = 0; bj < 2; ++bj)
#pragma unroll
            for (int n = 0; n < 2; ++n) gv[bj][n] = isv ? (f32x4){1.f, 1.f, 1.f, 1.f} : *(const f32x4*)(g + 32 * bj + 4 * n);
        const float mul = isq ? C2 : 1.f;
        bf16_t* base = O + (size_t)plane * PLANE + (size_t)(u.pm * BM + wr * 64 + fr) * DM + (u.pn & 3) * 256 + wc * 64 + 8 * fq;
#pragma unroll
        for (int ai = 0; ai < 2; ++ai)
#pragma unroll
            for (int m = 0; m < 4; ++m) { bf16_t* rowp = base + (size_t)(ai * HALF + m * 16) * DM;
                float ss = 0.f;
#pragma unroll
                for (int bj = 0; bj < 2; ++bj)
#pragma unroll
                    for (int n = 0; n < 2; ++n) { const f32x4 x = acc[ai][bj][m][n] * iscale; ss += (x[0] * x[0] + x[1] * x[1]) + (x[2] * x[2] + x[3] * x[3]); }
                ss += __shfl_xor(ss, 16); ss += __shfl_xor(ss, 32);
                const float inv = (isv ? 1.f : mul * __builtin_amdgcn_rsqf(ss * (1.f / 64.f) + RMS_EPS)) * iscale;
#pragma unroll
                for (int bj = 0; bj < 2; ++bj) { const f32x4 v0 = acc[ai][bj][m][0] * inv * gv[bj][0], v1 = acc[ai][bj][m][1] * inv * gv[bj][1];
                    u32x4 w; w.x = cvt_pk_bf16(v0[0], v0[1]); w.y = cvt_pk_bf16(v0[2], v0[3]); w.z = cvt_pk_bf16(v1[0], v1[1]); w.w = cvt_pk_bf16(v1[2], v1[3]);
                    *(u32x4*)(rowp + bj * 32) = w; } }
    }
};
struct EpiSwiglu {
    static constexpr bool PERM = true;
    bf16_t* O;
    __device__ __forceinline__ void operator()(const f32x4 (&acc)[2][2][4][2], const Unit& u, int wr, int wc, int fr, int fq) const {
        bf16_t* base = O + (size_t)(u.pm * BM + wr * 64 + fr) * FF + u.pn * 128 + wc * 32 + 8 * fq;
#pragma unroll
        for (int ai = 0; ai < 2; ++ai)
#pragma unroll
            for (int m = 0; m < 4; ++m) { bf16_t* rowp = base + (size_t)(ai * HALF + m * 16) * FF;
                float o[8];
#pragma unroll
                for (int n = 0; n < 2; ++n)
#pragma unroll
                    for (int i = 0; i < 4; ++i) { const float g = acc[ai][0][m][n][i], uu = acc[ai][1][m][n][i];
                        o[n * 4 + i] = g * __builtin_amdgcn_rcpf(1.0f + __builtin_amdgcn_exp2f(-g * LOG2E)) * uu; }
                u32x4 w; w.x = cvt_pk_bf16(o[0], o[1]); w.y = cvt_pk_bf16(o[2], o[3]); w.z = cvt_pk_bf16(o[4], o[5]); w.w = cvt_pk_bf16(o[6], o[7]);
                *(u32x4*)rowp = w; }
    }
};
struct EpiSwigluF8 {
    static constexpr bool PERM = true;
    unsigned char* O;
    __device__ __forceinline__ void operator()(const f32x4 (&acc)[2][2][4][2], const Unit& u, int wr, int wc, int fr, int fq) const {
        unsigned char* base = O + (size_t)(u.pm * BM + wr * 64 + fr) * FF + u.pn * 128 + wc * 32 + 8 * fq;
#pragma unroll
        for (int ai = 0; ai < 2; ++ai)
#pragma unroll
            for (int m = 0; m < 4; ++m) { unsigned char* rowp = base + (size_t)(ai * HALF + m * 16) * FF;
                float o[8];
#pragma unroll
                for (int n = 0; n < 2; ++n)
#pragma unroll
                    for (int i = 0; i < 4; ++i) { const float g = acc[ai][0][m][n][i] * (1.0f / W8S), uu = acc[ai][1][m][n][i] * (A8S / W8S);
                        o[n * 4 + i] = g * __builtin_amdgcn_rcpf(1.0f + __builtin_amdgcn_exp2f(-g * LOG2E)) * uu; }
                v2u w; w.x = cvt4_fp8(o[0], o[1], o[2], o[3]); w.y = cvt4_fp8(o[4], o[5], o[6], o[7]);
                *(v2u*)rowp = w; }
    }
};
struct EpiResid {
    static constexpr bool PERM = false;
    const float* base; float* out; float oscale;
    __device__ __forceinline__ void operator()(const f32x4 (&acc)[2][2][4][2], const Unit& u, int wr, int wc, int fr, int fq) const {
        const size_t off0 = (size_t)(u.pm * BM + wr * 64 + fr) * DM + u.pn * BM + wc * 32 + 4 * fq;
#pragma unroll
        for (int ai = 0; ai < 2; ++ai)
#pragma unroll
            for (int m = 0; m < 4; ++m) { const size_t off = off0 + (size_t)(ai * HALF + m * 16) * DM;
#pragma unroll
                for (int bj = 0; bj < 2; ++bj)
#pragma unroll
                    for (int n = 0; n < 2; ++n) { const f32x4 b = *(const f32x4*)(base + off + bj * HALF + n * 16); *(f32x4*)(out + off + bj * HALF + n * 16) = b + acc[ai][bj][m][n] * oscale; } }
    }
};
struct EpiMoeDown {
    static constexpr bool PERM = true;
    bf16_t* Y; const float* gw; bf16_t* P; float oscale;
    __device__ __forceinline__ void operator()(const f32x4 (&acc)[2][2][4][2], const Unit& u, int wr, int wc, int fr, int fq) const {
        bf16_t* base = (u.kq < 0 ? Y + (size_t)(u.pm * BM) * DM : P + ((size_t)u.kq * SPLIT_ROWS + (size_t)(u.pm * BM - SPLIT_ROW0)) * DM) + (size_t)(wr * 64 + fr) * DM + u.pn * BM + wc * 32 + 8 * fq;
        const float* gp = gw + u.e * LCAP + u.mt * 256 + wr * 64 + fr;
#pragma unroll
        for (int ai = 0; ai < 2; ++ai)
#pragma unroll
            for (int m = 0; m < 4; ++m) { bf16_t* rowp = base + (size_t)(ai * HALF + m * 16) * DM; const float g = gp[ai * HALF + m * 16] * oscale;
#pragma unroll
                for (int bj = 0; bj < 2; ++bj) { const f32x4 v0 = acc[ai][bj][m][0] * g, v1 = acc[ai][bj][m][1] * g;
                    u32x4 w; w.x = cvt_pk_bf16(v0[0], v0[1]); w.y = cvt_pk_bf16(v0[2], v0[3]); w.z = cvt_pk_bf16(v1[0], v1[1]); w.w = cvt_pk_bf16(v1[2], v1[3]);
                    *(u32x4*)(rowp + bj * HALF) = w; } }
    }
};

template <class Epi, class Sched, bool GATHER, bool FP8 = false>
__device__ __forceinline__ void gemm_phase(PG8_LAS unsigned char* lds, const int K, const Sched& S, const Epi& E) {
    const int tid = threadIdx.x, wid = __builtin_amdgcn_readfirstlane(tid >> 6), lane = tid & 63, wr = wid >> 2, wc = wid & 3, fr = lane & 15, fq = lane >> 4;
    unsigned voffA[2], voffB[2]; int sR[2], sC[2];
#pragma unroll
    for (int i = 0; i < 2; ++i) { int R, C; stage_rc(tid * 16 + i * 8192, R, C); const int Rb = Epi::PERM ? ((R & ~31) + perm32(R & 31)) : R;
        voffA[i] = (unsigned)(R * K + C) * 2u; voffB[i] = (unsigned)(Rb * K + C) * 2u; sR[i] = R; sC[i] = C; }
    const size_t kstep = (size_t)(BK * 2);
    const size_t hstep = (size_t)HALF * K * 2;
    const unsigned ldsw = (unsigned)wid * 1024u, lds0 = (unsigned)(uintptr_t)lds;
    const int aoff = FP8 ? lds_byte(wr * 64 + fr, fq * 16) : lds_byte(wr * 64 + fr, fq * 8), boff = FP8 ? lds_byte(wc * 32 + fr, fq * 16) : lds_byte(wc * 32 + fr, fq * 8);

#define PG8_SA(b, h) (((b) * 2 + (h)) * HTB)
#define PG8_SB(b, h) ((4 + (b) * 2 + (h)) * HTB)
#define PG8_STAGE(bufoff, gbase, voff) do { const char* gb_ = uniptr((const char*)(gbase)); _Pragma("unroll") for (int _i = 0; _i < 2; ++_i) \
        glds16_s(gb_, (voff)[_i], (unsigned)__builtin_amdgcn_readfirstlane(lds0 + (unsigned)(bufoff) + ldsw + (unsigned)(_i * 8192))); } while (0)
#define PG8_STAGE_A(bufoff, p, h, VG) do { if (GATHER) { PG8_STAGE(bufoff, p, VG[h]); } else { PG8_STAGE(bufoff, (p) + ((h) ? hstep : 0), voffA); } } while (0)
#define PG8_LDA(dst, b, h) do { _Pragma("unroll") for (int m = 0; m < 4; ++m) { if constexpr (FP8) { const v4i32 x_ = *(const PG8_LAS v4i32*)(lds + PG8_SA(b, h) + aoff + m * 2048), y_ = *(const PG8_LAS v4i32*)(lds + PG8_SA(b, h) + aoff + m * 2048 + 16); dst##8[m] = __builtin_shufflevector(x_, y_, 0, 1, 2, 3, 4, 5, 6, 7); } \
        else { _Pragma("unroll") for (int k = 0; k < 2; ++k) dst[m][k] = *(const PG8_LAS bf16x8*)(lds + PG8_SA(b, h) + aoff + m * 2048 + k * 1024); } } } while (0)
#define PG8_LDB(dst, b, h) do { _Pragma("unroll") for (int n = 0; n < 2; ++n) { if constexpr (FP8) { const v4i32 x_ = *(const PG8_LAS v4i32*)(lds + PG8_SB(b, h) + boff + n * 2048), y_ = *(const PG8_LAS v4i32*)(lds + PG8_SB(b, h) + boff + n * 2048 + 16); dst##8[n] = __builtin_shufflevector(x_, y_, 0, 1, 2, 3, 4, 5, 6, 7); } \
        else { _Pragma("unroll") for (int k = 0; k < 2; ++k) dst[n][k] = *(const PG8_LAS bf16x8*)(lds + PG8_SB(b, h) + boff + n * 2048 + k * 1024); } } } while (0)
#define PG8_MMA(ai, bj, At, Bt) do { __builtin_amdgcn_s_setprio(1); _Pragma("unroll") for (int m = 0; m < 4; ++m) _Pragma("unroll") for (int n = 0; n < 2; ++n) { \
        if constexpr (FP8) asm volatile("v_mfma_scale_f32_16x16x128_f8f6f4 %0, %1, %2, %0, %3, %3 op_sel_hi:[0,0,0]" : "+v"(acc[ai][bj][m][n]) : "v"(Bt##8[n]), "v"(At##8[m]), "v"(sc8));   \
        else { _Pragma("unroll") for (int k = 0; k < 2; ++k) acc[ai][bj][m][n] = __builtin_amdgcn_mfma_f32_16x16x32_bf16(Bt[n][k], At[m][k], acc[ai][bj][m][n], 0, 0, 0); } } \
        __builtin_amdgcn_s_setprio(0); } while (0)
#define PG8_WAIT_V(n) asm volatile("s_waitcnt vmcnt(" #n ")" ::: "memory")
#define PG8_WAIT_L(n) asm volatile("s_waitcnt lgkmcnt(" #n ")" ::: "memory")
#define PG8_BAR __builtin_amdgcn_s_barrier()
#define PG8_SCHED __builtin_amdgcn_sched_barrier(0)
    Unit cur, nxt; int ui = 0;
    if (!S.next(0, cur)) return;
    f32x4 acc[2][2][4][2];
#pragma unroll
    for (int a = 0; a < 2; ++a)
#pragma unroll
        for (int b = 0; b < 2; ++b)
#pragma unroll
            for (int m = 0; m < 4; ++m)
#pragma unroll
                for (int n = 0; n < 2; ++n) acc[a][b][m][n] = (f32x4){0.f, 0.f, 0.f, 0.f};
    bf16x8 At[4][2], B0[2][2], B1[2][2];
    v8i32 At8[4], B08[2], B18[2];
    int sc8 = 0x7F7F7F7F; asm volatile("" : "+v"(sc8));
    const char* cA = S.a_base(cur); const char* cB = S.b_base(cur);
    unsigned vc[2][2] = {{0u, 0u}, {0u, 0u}}, vn[2][2] = {{0u, 0u}, {0u, 0u}};
    if (GATHER) { S.a_voff(cur, sR, sC, vc); asm volatile("s_waitcnt vmcnt(0)" : "+v"(vc[0][0]), "+v"(vc[0][1]), "+v"(vc[1][0]), "+v"(vc[1][1]) :: "memory"); }
    PG8_STAGE(PG8_SB(0, 0), cB, voffB); PG8_STAGE(PG8_SB(0, 1), cB + hstep, voffB); PG8_STAGE_A(PG8_SA(0, 0), cA, 0, vc); PG8_STAGE_A(PG8_SA(0, 1), cA, 1, vc);
    if (wr == 1) PG8_BAR;
    PG8_WAIT_V(2); PG8_BAR;
    PG8_STAGE(PG8_SB(1, 0), cB + kstep, voffB); PG8_STAGE_A(PG8_SA(1, 0), cA + kstep, 0, vc); PG8_STAGE(PG8_SB(1, 1), cB + hstep + kstep, voffB);
    PG8_WAIT_V(6); PG8_BAR;
    for (;;) {
        const bool has_next = S.next(ui + 1, nxt);
        const char* nA = has_next ? S.a_base(nxt) : cA; const char* nB = has_next ? S.b_base(nxt) : cB;
        if (GATHER) {
            if (has_next) { S.a_voff(nxt, sR, sC, vn); asm volatile("s_waitcnt vmcnt(0)" : "+v"(vn[0][0]), "+v"(vn[0][1]), "+v"(vn[1][0]), "+v"(vn[1][1]) :: "memory"); }
            else { vn[0][0] = vc[0][0]; vn[0][1] = vc[0][1]; vn[1][0] = vc[1][0]; vn[1][1] = vc[1][1]; }
        }
        const int nt = cur.nt;
        for (int t = 0; t < nt; t += 2) {
            const bool last = (t == nt - 2);
            const char* a1 = cA + (size_t)(t + 1) * kstep;
            const char* a2 = last ? nA : cA + (size_t)(t + 2) * kstep; const char* b2 = last ? nB : cB + (size_t)(t + 2) * kstep;
            const char* a3 = a2 + kstep; const char* b3 = b2 + kstep;
            unsigned v2[2][2];
#pragma unroll
            for (int h = 0; h < 2; ++h)
#pragma unroll
                for (int i = 0; i < 2; ++i) v2[h][i] = last ? vn[h][i] : vc[h][i];
            PG8_LDB(B0, 0, 0); PG8_LDB(B1, 0, 1); PG8_SCHED; PG8_LDA(At, 0, 0); PG8_STAGE_A(PG8_SA(1, 1), a1, 1, vc);
            PG8_WAIT_V(8); PG8_WAIT_L(0); PG8_BAR; PG8_MMA(0, 0, At, B0); PG8_MMA(0, 1, At, B1); PG8_BAR; PG8_SCHED;
            PG8_LDA(At, 0, 1); PG8_STAGE(PG8_SB(0, 0), b2, voffB); PG8_STAGE(PG8_SB(0, 1), b2 + hstep, voffB); PG8_STAGE_A(PG8_SA(0, 0), a2, 0, v2);
            PG8_WAIT_V(8); PG8_WAIT_L(0); PG8_BAR; PG8_MMA(1, 0, At, B0); PG8_MMA(1, 1, At, B1); PG8_BAR; PG8_SCHED;
            PG8_LDB(B0, 1, 0); PG8_LDB(B1, 1, 1); PG8_SCHED; PG8_LDA(At, 1, 0); PG8_STAGE_A(PG8_SA(0, 1), a2, 1, v2);
            PG8_WAIT_V(8); PG8_WAIT_L(0); PG8_BAR; PG8_MMA(0, 0, At, B0); PG8_MMA(0, 1, At, B1); PG8_BAR; PG8_SCHED;
            PG8_LDA(At, 1, 1); PG8_STAGE(PG8_SB(1, 0), b3, voffB); PG8_STAGE(PG8_SB(1, 1), b3 + hstep, voffB); PG8_STAGE_A(PG8_SA(1, 0), a3, 0, v2);
            PG8_WAIT_V(8); PG8_WAIT_L(0); PG8_BAR; PG8_MMA(1, 0, At, B0); PG8_MMA(1, 1, At, B1); PG8_BAR; PG8_SCHED;
        }
        if (wr == 0) PG8_BAR;
        if constexpr (FP8) asm volatile("s_nop 15\n\ts_nop 15" ::: "memory");
        { int fr_ = fr, fq_ = fq; asm volatile("" : "+v"(fr_), "+v"(fq_)); E(acc, cur, wr, wc, fr_, fq_); }
        if (!has_next) break;
#pragma unroll
        for (int a = 0; a < 2; ++a)
#pragma unroll
            for (int b = 0; b < 2; ++b)
#pragma unroll
                for (int m = 0; m < 4; ++m)
#pragma unroll
                    for (int n = 0; n < 2; ++n) acc[a][b][m][n] = (f32x4){0.f, 0.f, 0.f, 0.f};
        cur = nxt; cA = nA; cB = nB; ++ui;
        if (GATHER) { vc[0][0] = vn[0][0]; vc[0][1] = vn[0][1]; vc[1][0] = vn[1][0]; vc[1][1] = vn[1][1]; }
        if (wr == 1) PG8_BAR;
    }
    PG8_WAIT_V(0);
    PG8_BAR;
#undef PG8_SA
#undef PG8_SB
#undef PG8_STAGE
#undef PG8_STAGE_A
#undef PG8_LDA
#undef PG8_LDB
#undef PG8_MMA
#undef PG8_WAIT_V
#undef PG8_WAIT_L
#undef PG8_BAR
#undef PG8_SCHED
}
}

namespace att {
typedef short bf16x8 __attribute__((ext_vector_type(8)));
typedef short s16x4 __attribute__((ext_vector_type(4)));
typedef float f32x16 __attribute__((ext_vector_type(16)));
typedef unsigned u32x4 __attribute__((ext_vector_type(4)));
typedef LAS char* lptr;
constexpr int SLOTB = 8192, NSLOT = 6, AHEAD = 4;
constexpr int L_K = 0, L_V = NSLOT * SLOTB, L_WS = 2 * NSLOT * SLOTB, L_OST = L_WS + 8 * 256, L_KB = L_OST + 8 * 4096, L_FLG = L_KB + 8192, L_END = L_FLG + 256;
static_assert(L_END <= ATT_LDS_MAX, "attention LDS map");
constexpr float THR = 8.0f;
__device__ __forceinline__ int crow(int r, int hi) { return (r & 3) + 8 * (r >> 2) + 4 * hi; }
__device__ __forceinline__ void glds16(const void* gsrc, unsigned lds_dst) { unsigned keep;
    asm volatile("s_mov_b32 %0, m0\n\ts_mov_b32 m0, %2\n\ts_nop 0\n\tglobal_load_lds_dwordx4 %1, off\n\ts_mov_b32 m0, %0" : "=&s"(keep) : "v"(gsrc), "s"(lds_dst) : "memory"); }
typedef float f32x2_t __attribute__((ext_vector_type(2))); typedef __bf16 bf16x2_t __attribute__((ext_vector_type(2)));
__device__ __forceinline__ unsigned cvtpk(float lo, float hi) { f32x2_t v = {lo, hi}; bf16x2_t b = __builtin_convertvector(v, bf16x2_t); return __builtin_bit_cast(unsigned, b); }
__device__ __forceinline__ bf16x8 gload16(const void* p) { bf16x8 v; asm volatile("global_load_dwordx4 %0, %1, off" : "=v"(v) : "v"(p) : "memory"); return v; }
__device__ __forceinline__ float max3f(float a, float b, float c) { return __builtin_fmaxf(__builtin_fmaxf(a, b), c); }
__device__ __forceinline__ void wait_bar(int n) {
    if (n >= 6) asm volatile("s_waitcnt vmcnt(6) lgkmcnt(0)\n\ts_barrier" ::: "memory");
    else if (n >= 4) asm volatile("s_waitcnt vmcnt(4) lgkmcnt(0)\n\ts_barrier" ::: "memory");
    else if (n >= 2) asm volatile("s_waitcnt vmcnt(2) lgkmcnt(0)\n\ts_barrier" ::: "memory");
    else asm volatile("s_waitcnt vmcnt(0) lgkmcnt(0)\n\ts_barrier" ::: "memory");
}
__device__ __forceinline__ float other_half(float x, int hi) {
    auto rr = __builtin_amdgcn_permlane32_swap(__float_as_uint(x), __float_as_uint(x), false, false);
    return __uint_as_float(hi ? rr[0] : rr[1]);
}
__device__ __forceinline__ void qkt(f32x16& p0, f32x16& p1, lptr Kslot, const bf16x8* qr, const f32x16& c0, const f32x16& c1, int r32, int hi) {
    lptr kb = Kslot + hi * 1024 + r32 * 16;
#pragma unroll
    for (int d0 = 0; d0 < 4; ++d0) {
        const bf16x8 b0 = *(const LAS bf16x8*)(kb + d0 * 2048);
        const bf16x8 b1 = *(const LAS bf16x8*)(kb + d0 * 2048 + 512);
        if (d0 == 0) { p0 = __builtin_amdgcn_mfma_f32_32x32x16_bf16(b0, qr[0], c0, 0, 0, 0); p1 = __builtin_amdgcn_mfma_f32_32x32x16_bf16(b1, qr[0], c1, 0, 0, 0); }
        else { p0 = __builtin_amdgcn_mfma_f32_32x32x16_bf16(b0, qr[d0], p0, 0, 0, 0); p1 = __builtin_amdgcn_mfma_f32_32x32x16_bf16(b1, qr[d0], p1, 0, 0, 0); } }
}
__device__ __forceinline__ void pv(f32x16* o, int vb, bf16x8 pa0, bf16x8 pa1, bf16x8 pa2, bf16x8 pa3) {
#pragma unroll
    for (int d0 = 0; d0 < 2; ++d0) { s16x4 lo[4], hi[4];
#pragma unroll
        for (int ks = 0; ks < 4; ++ks) {
            asm volatile("ds_read_b64_tr_b16 %0,%1 offset:%c2" : "=&v"(lo[ks]) : "v"(vb), "i"(d0 * 4096 + ks * 1024) : "memory");
            asm volatile("ds_read_b64_tr_b16 %0,%1 offset:%c2" : "=&v"(hi[ks]) : "v"(vb), "i"(d0 * 4096 + ks * 1024 + 512) : "memory"); }
        asm volatile("s_waitcnt lgkmcnt(0)" ::: "memory"); __builtin_amdgcn_sched_barrier(0);
#define ATT_PK(k) (bf16x8){lo[k][0], lo[k][1], lo[k][2], lo[k][3], hi[k][0], hi[k][1], hi[k][2], hi[k][3]}
        o[d0] = __builtin_amdgcn_mfma_f32_32x32x16_bf16(pa0, ATT_PK(0), o[d0], 0, 0, 0);
        o[d0] = __builtin_amdgcn_mfma_f32_32x32x16_bf16(pa1, ATT_PK(1), o[d0], 0, 0, 0);
        o[d0] = __builtin_amdgcn_mfma_f32_32x32x16_bf16(pa2, ATT_PK(2), o[d0], 0, 0, 0);
        o[d0] = __builtin_amdgcn_mfma_f32_32x32x16_bf16(pa3, ATT_PK(3), o[d0], 0, 0, 0);
#undef ATT_PK
    }
}
__device__ __forceinline__ void pack_pv(f32x16* o, int vb, const f32x16& p0, const f32x16& p1) {
    u32x4 w0, w1, w2, w3;
#pragma unroll
    for (int j = 0; j < 4; ++j) { w0[j] = cvtpk(p0[2 * j], p0[2 * j + 1]); w1[j] = cvtpk(p0[8 + 2 * j], p0[8 + 2 * j + 1]); w2[j] = cvtpk(p1[2 * j], p1[2 * j + 1]); w3[j] = cvtpk(p1[8 + 2 * j], p1[8 + 2 * j + 1]); }
    pv(o, vb, __builtin_bit_cast(bf16x8, w0), __builtin_bit_cast(bf16x8, w1), __builtin_bit_cast(bf16x8, w2), __builtin_bit_cast(bf16x8, w3));
}
__device__ __forceinline__ float rowmax32(const f32x16& p0, const f32x16& p1, int hi) {
    float a = max3f(p0[0], p0[1], p1[0]), b = max3f(p0[2], p0[3], p1[1]); a = max3f(a, p1[2], p1[3]);
#pragma unroll
    for (int r = 4; r < 16; r += 4) { a = max3f(a, p0[r], p0[r + 1]); b = max3f(b, p0[r + 2], p0[r + 3]); a = max3f(a, p1[r], p1[r + 1]); b = max3f(b, p1[r + 2], p1[r + 3]); }
    a = fmaxf(a, b);
    return fmaxf(a, other_half(a, hi));
}
__device__ __forceinline__ void store_o(const f32x16* o, const float* sc, lptr stgb, bf16* Ow, long rpitch, int lane, int r32, int hi) {
    LAS bf16* stg = (LAS bf16*)stgb;
#pragma unroll
    for (int r = 0; r < 16; ++r) { const int orow = crow(r, hi);
#pragma unroll
        for (int d0 = 0; d0 < 2; ++d0) stg[orow * 64 + d0 * 32 + r32] = (bf16)f2bf(o[d0][r] * sc[r]); }
    asm volatile("s_waitcnt lgkmcnt(0)" ::: "memory");
#pragma unroll
    for (int i = 0; i < 4; ++i) { const int row = i * 8 + (lane >> 3), ch = lane & 7; const u32x4 v = *(const LAS u32x4*)(stg + row * 64 + ch * 8); *(u32x4*)(Ow + (long)row * rpitch + ch * 8) = v; }
}
__device__ __forceinline__ void softmax_step(f32x16& p0, f32x16& p1, float& mref, float& lsum, f32x16* o, LAS float* wsf, int r32, int hi) {
    const float rm = rowmax32(p0, p1, hi);
    const bool fresh = mref <= -1e30f;
    const bool want = !fresh && (rm > mref + THR);
    if (fresh) mref = fmaxf(rm, -1e30f);
    if (__any(want)) {
        const float dl = want ? rm - mref : 0.f; mref += dl; const float f = __builtin_amdgcn_exp2f(-dl); lsum *= f;
        if (hi == 0) wsf[r32] = f;
        asm volatile("s_waitcnt lgkmcnt(0)" ::: "memory");
#pragma unroll
        for (int r = 0; r < 16; ++r) { const float fr = wsf[crow(r, hi)]; o[0][r] *= fr; o[1][r] *= fr; }
    }
    float sa = 0.f, sb = 0.f;
#pragma unroll
    for (int r = 0; r < 16; ++r) { p0[r] = __builtin_amdgcn_exp2f(p0[r] - mref); p1[r] = __builtin_amdgcn_exp2f(p1[r] - mref); sa += p0[r]; sb += p1[r]; }
    lsum += sa + sb;
}

struct WaveCtx { int lane, r32, hi, wid; unsigned lds0; int vb0; lptr shm; };
struct UnitD { int NT; int b, h, qb, g, x; };

template <int MODE> struct CausalMode {
    const bf16* Q; const bf16* K; const bf16* V; bf16* O; int b, h, p;
    float carry, mref, lsum; int done;
    __device__ __forceinline__ int units() const { return 4; }
    __device__ __forceinline__ void desc(int j, UnitD& d) const { d.b = b; d.h = h; d.qb = (j == 0) ? 7 - p : (j == 1) ? 5 - p : (j == 2) ? 2 + p : p; d.NT = 4 * (d.qb + 1); d.g = 0; d.x = 0; }
    __device__ __forceinline__ int tile_of(const UnitD& d, int k) const { return MODE == 0 ? d.NT - 1 - k : k; }
    __device__ __forceinline__ void q_load(const UnitD& d, const WaveCtx& w, bf16x8 (&q)[4]) const {
        const bf16* Qw = Q + ((long)d.b * SEQ + d.qb * 256 + w.wid * 32 + w.r32) * DM + d.h * 64 + w.hi * 8;
#pragma unroll
        for (int d0 = 0; d0 < 4; ++d0) q[d0] = gload16(Qw + d0 * 16);
    }
    __device__ __forceinline__ void dma(const UnitD& d, int k, int slot, const WaveCtx& w) const {
        const long row0 = (long)d.b * SEQ + 64 * tile_of(d, k);
        glds16(K + (row0 + w.lane) * DM + d.h * 64 + w.wid * 8, (unsigned)__builtin_amdgcn_readfirstlane(w.lds0 + L_K + slot * SLOTB + w.wid * 1024));
        glds16(V + (row0 + 16 * (w.wid & 3) + (w.lane >> 2)) * DM + d.h * 64 + (w.wid >> 2) * 32 + (w.lane & 3) * 8, (unsigned)__builtin_amdgcn_readfirstlane(w.lds0 + L_V + slot * SLOTB + w.wid * 1024));
    }
    __device__ __forceinline__ void begin(const UnitD&, const WaveCtx&) { carry = 1.0f; mref = -1e30f; lsum = 0.f; done = 0; }
    __device__ __forceinline__ int wave_done() const { return done; }
    __device__ __forceinline__ void compute(const UnitD& d, int k, int slot, const WaveCtx& w, const bf16x8* qr, f32x16* o) {
        const int T = tile_of(d, k), qfirst = d.qb * 256 + w.wid * 32, qpos = qfirst + w.r32;
        if (MODE == 0) {
            if (done || 64 * T >= qfirst + 31) return;
            f32x16 p0, p1; const f32x16 z = {}; qkt(p0, p1, w.shm + L_K + slot * SLOTB, qr, z, z, w.r32, w.hi);
            const bool diag = 64 * T + 63 >= qfirst;
            float ga[8];
#pragma unroll
            for (int a = 0; a < 8; ++a) {
                float rr[4];
#pragma unroll
                for (int i = 0; i < 4; ++i) { const int r = 4 * (a & 3) + i; const float zz = (a < 4) ? p0[r] : p1[r];
                    const float e = __builtin_amdgcn_exp2f(fminf(zz, 120.f)); float rv = __builtin_amdgcn_rcpf(1.0f + e);
                    if (diag) { const int kv = 64 * T + crow(r, w.hi) + ((a < 4) ? 0 : 32); if (kv >= qpos) rv = 1.0f; }
                    rr[i] = rv; if (a < 4) p0[r] = rv; else p1[r] = rv; }
                ga[a] = (rr[0] * rr[1]) * (rr[2] * rr[3]);
            }
            float oth[8], Ts[8];
#pragma unroll
            for (int a = 0; a < 8; ++a) oth[a] = other_half(ga[a], w.hi);
            float run = 1.0f;
#pragma unroll
            for (int a = 7; a >= 0; --a) { Ts[a] = run; run *= ga[a] * oth[a]; }
#pragma unroll
            for (int a = 0; a < 8; ++a) {
                float E = carry * Ts[a] * (w.hi ? 1.0f : oth[a]);
#pragma unroll
                for (int i = 3; i >= 0; --i) { const int r = 4 * (a & 3) + i; const float rv = (a < 4) ? p0[r] : p1[r]; const float wt = (1.0f - rv) * E; E *= rv; if (a < 4) p0[r] = wt; else p1[r] = wt; }
            }
            carry *= run;
            pack_pv(o, w.vb0 + slot * SLOTB, p0, p1);
            if (__all(carry < 1e-30f)) done = 1;
        } else {
            if (64 * T > qfirst + 31) return;
            LAS float* kbl = (LAS float*)(w.shm + L_KB);
            f32x16 c0, c1;
#pragma unroll
            for (int g = 0; g < 4; ++g) { const f32x4 k0 = *(const LAS f32x4*)(kbl + 64 * T + 8 * g + 4 * w.hi), k1 = *(const LAS f32x4*)(kbl + 64 * T + 32 + 8 * g + 4 * w.hi);
#pragma unroll
                for (int i = 0; i < 4; ++i) { c0[4 * g + i] = k0[i]; c1[4 * g + i] = k1[i]; } }
            f32x16 p0, p1; qkt(p0, p1, w.shm + L_K + slot * SLOTB, qr, c0, c1, w.r32, w.hi);
            if (64 * T + 63 > qfirst) {
#pragma unroll
                for (int r = 0; r < 16; ++r) { const int kv = 64 * T + crow(r, w.hi); if (kv > qpos) p0[r] = -INFINITY; if (kv + 32 > qpos) p1[r] = -INFINITY; } }
            softmax_step(p0, p1, mref, lsum, o, (LAS float*)(w.shm + L_WS) + w.wid * 64, w.r32, w.hi);
            pack_pv(o, w.vb0 + slot * SLOTB, p0, p1);
        }
    }
    __device__ __forceinline__ void finish(const UnitD& d, const WaveCtx& w, const f32x16* o) {
        LAS float* wsf = (LAS float*)(w.shm + L_WS) + w.wid * 64;
        float sc[16];
        if (MODE == 0) {
#pragma unroll
            for (int r = 0; r < 16; ++r) sc[r] = 1.0f;
        } else {
            float lt = lsum + other_half(lsum, w.hi);
            if (w.hi == 0) wsf[32 + w.r32] = lt;
            asm volatile("s_waitcnt lgkmcnt(0)" ::: "memory");
#pragma unroll
            for (int r = 0; r < 16; ++r) sc[r] = __builtin_amdgcn_rcpf(wsf[32 + crow(r, w.hi)]);
        }
        store_o(o, sc, w.shm + L_OST + w.wid * 4096, O + ((long)d.b * SEQ + d.qb * 256 + w.wid * 32) * DM + d.h * 64, DM, w.lane, w.r32, w.hi);
    }
};

struct DilMode {
    const bf16* PROJ; bf16* OG; float* ST; int b, h, p;
    float mref, lsum;
    __device__ __forceinline__ int units() const { return 12; }
    __device__ __forceinline__ void desc(int j, UnitD& d) const {
        const int g = j >> 2, i = j & 3; d.g = g; d.b = b; d.h = h; d.qb = 0;
        d.x = (g == 1) ? ((2 * (i >> 1) + p) << 1) + (i & 1) : 2 * i + p;
        const int i0 = (g == 0) ? 256 * d.x : (g == 1) ? 256 * (d.x & 1) : 0;
        d.NT = (g == 2) ? 4 : ((i0 >> 6) + 4 - t_lo(g, i0));
    }
    static __device__ __forceinline__ int t_lo(int g, int i0) { return (g == 2) ? 0 : ((i0 >> 6) >= 2 ? (i0 >> 6) - 2 : 0); }
    static __device__ __forceinline__ int dil_of(int g) { return (g == 0) ? 1 : (g == 1) ? 4 : 16; }
    static __device__ __forceinline__ int cls0_of(int g, int x) { return (g == 0) ? 0 : (g == 1) ? (x >> 1) : 2 * x; }
    static __device__ __forceinline__ int i0_of(int g, int x) { return (g == 0) ? 256 * x : (g == 1) ? 256 * (x & 1) : 0; }
    static __device__ __forceinline__ int tcls(int g, int x, int k) { return cls0_of(g, x) + ((g == 2) ? (k >> 1) : 0); }
    static __device__ __forceinline__ int kbase(int g, int x, int k) { return (g == 2) ? 64 * (k & 1) : 64 * (t_lo(g, i0_of(g, x)) + k); }
    __device__ __forceinline__ void q_load(const UnitD& d, const WaveCtx& w, bf16x8 (&q)[4]) const {
        const int dil = dil_of(d.g), clsw = cls0_of(d.g, d.x) + ((d.g == 2) ? (w.wid >> 2) : 0), qi0w = (d.g == 2) ? 32 * (w.wid & 3) : i0_of(d.g, d.x) + 32 * w.wid;
        const bf16* Qw = PROJ + (size_t)(2 * d.g) * PLANE + ((long)d.b * SEQ + clsw + (long)(qi0w + w.r32) * dil) * DM + d.h * 64 + w.hi * 8;
#pragma unroll
        for (int d0 = 0; d0 < 4; ++d0) q[d0] = gload16(Qw + d0 * 16);
    }
    __device__ __forceinline__ void dma(const UnitD& d, int k, int slot, const WaveCtx& w) const {
        const int dil = dil_of(d.g); const long tok0 = (long)d.b * SEQ + tcls(d.g, d.x, k) + (long)kbase(d.g, d.x, k) * dil;
        glds16(PROJ + (size_t)(2 * d.g + 1) * PLANE + (tok0 + (long)w.lane * dil) * DM + d.h * 64 + w.wid * 8, (unsigned)__builtin_amdgcn_readfirstlane(w.lds0 + L_K + slot * SLOTB + w.wid * 1024));
        glds16(PROJ + (size_t)6 * PLANE + (tok0 + (long)(16 * (w.wid & 3) + (w.lane >> 2)) * dil) * DM + d.h * 64 + (w.wid >> 2) * 32 + (w.lane & 3) * 8, (unsigned)__builtin_amdgcn_readfirstlane(w.lds0 + L_V + slot * SLOTB + w.wid * 1024));
    }
    __device__ __forceinline__ void begin(const UnitD&, const WaveCtx&) { mref = -1e30f; lsum = 0.f; }
    __device__ __forceinline__ int wave_done() const { return 0; }
    __device__ __forceinline__ void compute(const UnitD& d, int k, int slot, const WaveCtx& w, const bf16x8* qr, f32x16* o) {
        const int clsw = cls0_of(d.g, d.x) + ((d.g == 2) ? (w.wid >> 2) : 0), qi0w = (d.g == 2) ? 32 * (w.wid & 3) : i0_of(d.g, d.x) + 32 * w.wid;
        const int kb = kbase(d.g, d.x, k);
        if (tcls(d.g, d.x, k) != clsw || kb > qi0w + 31 || kb < qi0w - 191) return;
        LAS float* tbl = (LAS float*)(w.shm + L_KB) + d.g * 640 + 256;
        const int dbase = qi0w + w.r32 - kb - 4 * w.hi;
        f32x16 c0, c1;
#pragma unroll
        for (int r = 0; r < 16; ++r) { const int cr = (r & 3) + 8 * (r >> 2); c0[r] = tbl[dbase - cr]; c1[r] = tbl[dbase - cr - 32]; }
        f32x16 p0, p1; qkt(p0, p1, w.shm + L_K + slot * SLOTB, qr, c0, c1, w.r32, w.hi);
        softmax_step(p0, p1, mref, lsum, o, (LAS float*)(w.shm + L_WS) + w.wid * 64, w.r32, w.hi);
        pack_pv(o, w.vb0 + slot * SLOTB, p0, p1);
    }
    __device__ __forceinline__ void finish(const UnitD& d, const WaveCtx& w, const f32x16* o) {
        const int dil = dil_of(d.g), clsw = cls0_of(d.g, d.x) + ((d.g == 2) ? (w.wid >> 2) : 0), qi0w = (d.g == 2) ? 32 * (w.wid & 3) : i0_of(d.g, d.x) + 32 * w.wid;
        LAS float* wsf = (LAS float*)(w.shm + L_WS) + w.wid * 64;
        const float lt = lsum + other_half(lsum, w.hi);
        if (w.hi == 0) { wsf[32 + w.r32] = lt;
            const long tok = (long)d.b * SEQ + clsw + (long)(qi0w + w.r32) * dil;
            *(f32x2*)(ST + ((size_t)d.g * M * NH + (size_t)tok * NH + d.h) * 2) = (f32x2){mref, lt}; }
        asm volatile("s_waitcnt lgkmcnt(0)" ::: "memory");
        float sc[16];
#pragma unroll
        for (int r = 0; r < 16; ++r) sc[r] = __builtin_amdgcn_rcpf(wsf[32 + crow(r, w.hi)]);
        store_o(o, sc, w.shm + L_OST + w.wid * 4096, OG + (size_t)d.g * PLANE + ((long)d.b * SEQ + clsw + (long)qi0w * dil) * DM + d.h * 64, (long)dil * DM, w.lane, w.r32, w.hi);
    }
};

template <class Mode, bool EARLY_EXIT>
__device__ __forceinline__ void stream_units(Mode& Mo, const WaveCtx& w) {
    LAS int* flg = (LAS int*)(w.shm + L_FLG);
    const int nun = Mo.units();
    int pj = 0, pk = 0, pseq = 0, cseq = 0;
    UnitD pd; Mo.desc(0, pd);
    bf16x8 qn[4];
    if (EARLY_EXIT && w.wid == 0 && w.lane < 4) flg[w.lane] = 0;
    asm volatile("s_waitcnt vmcnt(0)" ::: "memory");
#define ATT_PRODUCE() do { if (pj < nun) { if (pk == 0) Mo.q_load(pd, w, qn); Mo.dma(pd, pk, pseq % NSLOT, w); ++pseq; if (++pk == pd.NT) { pk = 0; if (++pj < nun) Mo.desc(pj, pd); } } } while (0)
#pragma unroll 1
    for (int i = 0; i < AHEAD; ++i) ATT_PRODUCE();
#pragma unroll 1
    for (int cj = 0; cj < nun; ++cj) {
        UnitD d; Mo.desc(cj, d);
        bf16x8 qr[4];
        f32x16 o[2]; o[0] = f32x16{}; o[1] = f32x16{};
        Mo.begin(d, w);
        const int useq0 = cseq;
        int rep = 0;
#pragma unroll 1
        while (pseq - cseq < AHEAD && pj < nun) ATT_PRODUCE();
#pragma unroll 1
        for (int ck = 0; ck < d.NT; ++ck) {
            wait_bar(2 * (pseq - cseq - 1));
            if (ck == 0) { asm volatile("" : "+v"(qn[0]), "+v"(qn[1]), "+v"(qn[2]), "+v"(qn[3])); qr[0] = qn[0]; qr[1] = qn[1]; qr[2] = qn[2]; qr[3] = qn[3]; }
            if (EARLY_EXIT && ck == 1 && w.wid == 0 && w.lane < 2) flg[((cj + 1) & 1) * 2 + w.lane] = 0;
            if (EARLY_EXIT && ck > 0) {
                if (__builtin_amdgcn_readfirstlane(flg[(cj & 1) * 2 + ((ck - 1) & 1)]) == 8) {
                    const int uend = useq0 + d.NT;
                    if (pj == cj) { pk = 0; if (++pj < nun) Mo.desc(pj, pd); }
                    cseq = uend < pseq ? uend : pseq;
                    break; } }
            if (pseq - cseq < AHEAD) ATT_PRODUCE();
            Mo.compute(d, ck, cseq % NSLOT, w, qr, o);
            if (EARLY_EXIT && Mo.wave_done() && rep < 2) { if (w.lane == 0) __hip_atomic_fetch_add(&flg[(cj & 1) * 2 + (ck & 1)], 1, __ATOMIC_RELAXED, __HIP_MEMORY_SCOPE_WORKGROUP); ++rep; }
            ++cseq;
        }
        Mo.finish(d, w, o);
    }
    asm volatile("s_waitcnt vmcnt(0) lgkmcnt(0)\n\ts_barrier" ::: "memory");
#undef ATT_PRODUCE
}
__device__ __forceinline__ WaveCtx make_ctx(lptr shm) {
    WaveCtx w; const int tid = threadIdx.x; w.lane = tid & 63; w.r32 = w.lane & 31; w.hi = w.lane >> 5; w.wid = __builtin_amdgcn_readfirstlane(tid >> 6);
    w.shm = shm; w.lds0 = (unsigned)(uintptr_t)shm;
    w.vb0 = (int)(w.lds0 + L_V) + ((w.lane >> 4) & 1) * 32 + (w.lane & 3) * 8 + (4 * w.hi + ((w.lane & 15) >> 2)) * 64;
    return w;
}
template <int MODE>
__device__ __forceinline__ void causal_phase(lptr shm, int G, const bf16* Q, const bf16* K, const bf16* V, bf16* O, const float* cum) {
    const int bx = blockIdx.x; const int vcu = (G % 8 == 0) ? (bx % 8) * (G / 8) + bx / 8 : bx;
    const WaveCtx w = make_ctx(shm);
    for (int u = vcu; u < BATCH * NH * 2; u += G) {
        CausalMode<MODE> Mo; Mo.Q = Q; Mo.K = K; Mo.V = V; Mo.O = O; Mo.b = u >> 5; Mo.h = (u >> 1) & 15; Mo.p = u & 1;
        if (MODE == 2) {
            LAS float* kbl = (LAS float*)(shm + L_KB); LAS float* wtot = (LAS float*)(shm + L_FLG + 64);
            const int t4 = threadIdx.x * 4; float v0, v1, v2, v3;
            { const float* lp = cum + ((long)Mo.b * SEQ + t4) * 16 + Mo.h; v0 = lp[0]; v1 = lp[16]; v2 = lp[32]; v3 = lp[48]; }
            v1 += v0; v2 += v1; v3 += v2;
            float incl = v3;
#pragma unroll
            for (int o = 1; o < 64; o <<= 1) { const float t = __shfl_up(incl, o); if (w.lane >= o) incl += t; }
            if (w.lane == 63) wtot[w.wid] = incl;
            __syncthreads();
            float off = incl - v3;
#pragma unroll
            for (int x = 0; x < 8; ++x) off += (x < w.wid) ? wtot[x] : 0.f;
            *(LAS f32x4*)(kbl + t4) = (f32x4){-(off + v0), -(off + v1), -(off + v2), -(off + v3)};
        }
        stream_units<CausalMode<MODE>, MODE == 0>(Mo, w);
    }
}
__device__ __forceinline__ int t5_bucket_f(int dist) {
    if (dist < 16) return dist;
    int lb = 16 + (int)(logf((float)dist / 16.0f) / logf(128.0f) * 16.0f);
    return lb < 31 ? lb : 31;
}
__device__ __forceinline__ void dil_phase(lptr shm, int G, const bf16* PROJ, bf16* OG, float* ST, const float* rel_bias) {
    const int bx = blockIdx.x; const int vcu = (G % 8 == 0) ? (bx % 8) * (G / 8) + bx / 8 : bx;
    const WaveCtx w = make_ctx(shm);
    for (int u = vcu; u < BATCH * NH * 2; u += G) {
        DilMode Mo; Mo.PROJ = PROJ; Mo.OG = OG; Mo.ST = ST; Mo.b = u >> 5; Mo.h = (u >> 1) & 15; Mo.p = u & 1;
        LAS float* tb = (LAS float*)(shm + L_KB);
        for (int i = threadIdx.x; i < 3 * 640; i += NTHR) { const int gg = i / 640, dl = i - gg * 640 - 256; const int dil = (gg == 0) ? 1 : (gg == 1) ? 4 : 16;
            tb[i] = (dl >= 0 && dl <= 128) ? rel_bias[t5_bucket_f(dl * dil) * 16 + Mo.h] * LOG2E : -INFINITY; }
        stream_units<DilMode, false>(Mo, w);
    }
}
__device__ __forceinline__ void dil_merge(int G, const bf16* OG, const float* ST, bf16* O) {
    for (int idx = blockIdx.x * NTHR + threadIdx.x; idx < M * NH; idx += G * NTHR) {
        const f32x2 s0 = *(const f32x2*)(ST + ((size_t)0 * M * NH + idx) * 2), s1 = *(const f32x2*)(ST + ((size_t)1 * M * NH + idx) * 2), s2 = *(const f32x2*)(ST + ((size_t)2 * M * NH + idx) * 2);
        const float mx = fmaxf(s0.x, fmaxf(s1.x, s2.x));
        float w0 = __builtin_amdgcn_exp2f(s0.x - mx) * s0.y, w1 = __builtin_amdgcn_exp2f(s1.x - mx) * s1.y, w2 = __builtin_amdgcn_exp2f(s2.x - mx) * s2.y;
        const float inv = 1.0f / (w0 + w1 + w2); w0 *= inv; w1 *= inv; w2 *= inv;
        const GAS v4u* a0 = (const GAS v4u*)(OG + (size_t)idx * 64); const GAS v4u* a1 = (const GAS v4u*)(OG + PLANE + (size_t)idx * 64); const GAS v4u* a2 = (const GAS v4u*)(OG + 2 * PLANE + (size_t)idx * 64);
        GAS v4u* op = (GAS v4u*)(O + (size_t)idx * 64);
#pragma unroll
        for (int c = 0; c < 8; ++c) { const v4u x0 = a0[c], x1 = a1[c], x2 = a2[c]; v4u r;
#pragma unroll
            for (int q = 0; q < 4; ++q) r[q] = pk2(w0 * bflo(x0[q]) + w1 * bflo(x1[q]) + w2 * bflo(x2[q]), w0 * bfhi(x0[q]) + w1 * bfhi(x1[q]) + w2 * bfhi(x2[q]));
            op[c] = r; }
    }
}
}

enum { CV_PLAIN = 0, CV_QKN = 1, CV_GATE = 2, CV_UP = 3 };
__device__ __forceinline__ int cv_dst_row(int mode, int n) {
    if (mode == CV_QKN) return (n & ~255) + 128 * ((n >> 5) & 1) + 32 * ((n >> 6) & 3) + (n & 31);
    if (mode == CV_GATE) return 256 * (n >> 7) + (n & 127);
    if (mode == CV_UP) return 256 * (n >> 7) + 128 + (n & 127);
    return n;
}
__device__ __forceinline__ void conv_item(const float* W, int ldw, int K, bf16* WT, int mode, LAS unsigned char* scr, int item, int nblk, int lane) {
    const int kb = item / nblk, nb = item - kb * nblk, k0 = 64 * kb, n0 = 64 * nb;
    const GAS float* src = (const GAS float*)(W + (size_t)k0 * ldw + n0 + lane);
#pragma unroll
    for (int kc = 0; kc < 8; ++kc) {
        float v[8];
#pragma unroll
        for (int j = 0; j < 8; ++j) v[j] = src[(size_t)(kc * 8 + j) * ldw];
        v4u w; w.x = pk2(v[0], v[1]); w.y = pk2(v[2], v[3]); w.z = pk2(v[4], v[5]); w.w = pk2(v[6], v[7]);
        *(LAS v4u*)(scr + lane * 144 + kc * 16) = w;
    }
    asm volatile("s_waitcnt lgkmcnt(0)" ::: "memory");
#pragma unroll
    for (int j = 0; j < 8; ++j) { const int n = 8 * j + (lane >> 3), ch = lane & 7;
        const v4u w = *(const LAS v4u*)(scr + n * 144 + ch * 16);
        *(GAS v4u*)(WT + (size_t)cv_dst_row(mode, n0 + n) * K + k0 + 8 * ch) = w; }
    asm volatile("s_waitcnt lgkmcnt(0)" ::: "memory");
}
__device__ __forceinline__ void conv_item8(const float* W, int ldw, int K, unsigned char* WT8, int mode, LAS unsigned char* scr, int item, int nblk, int lane) {
    const int kb = item / nblk, nb = item - kb * nblk, k0 = 128 * kb, n0 = 64 * nb;
    const GAS float* src = (const GAS float*)(W + (size_t)k0 * ldw + n0 + lane);
#pragma unroll 4
    for (int kc = 0; kc < 16; ++kc) {
        float v[8];
#pragma unroll
        for (int j = 0; j < 8; ++j) v[j] = src[(size_t)(kc * 8 + j) * ldw] * W8S;
        v2u w; w.x = pg8::cvt4_fp8(v[0], v[1], v[2], v[3]); w.y = pg8::cvt4_fp8(v[4], v[5], v[6], v[7]);
        *(LAS v2u*)(scr + lane * 144 + kc * 8) = w;
    }
    asm volatile("s_waitcnt lgkmcnt(0)" ::: "memory");
#pragma unroll
    for (int j = 0; j < 8; ++j) { const int n = 8 * j + (lane >> 3), ch = lane & 7;
        const v4u w = *(const LAS v4u*)(scr + n * 144 + ch * 16);
        *(GAS v4u*)(WT8 + (size_t)cv_dst_row(mode, n0 + n) * K + k0 + 16 * ch) = w; }
    asm volatile("s_waitcnt lgkmcnt(0)" ::: "memory");
}
__device__ __forceinline__ void conv_job8(Frame& F, const float* W, int ldw, int K, int N, unsigned char* WT8, int mode, int& rot) {
    LAS unsigned char* scr = F.lds + F.wave * 9216;
    const int nblk = N / 64, nitems = (K / 128) * nblk, NGW = F.G * NWAVES, gw = blockIdx.x * NWAVES + F.wave;
    int first = gw - (rot % NGW); if (first < 0) first += NGW;
    for (int it = first; it < nitems; it += NGW) conv_item8(W, ldw, K, WT8, mode, scr, it, nblk, F.lane);
    rot += nitems;
}
__device__ __forceinline__ void conv_job(Frame& F, const float* W, int ldw, int K, int N, bf16* WT, int mode, int& rot) {
    LAS unsigned char* scr = F.lds + F.wave * 9216;
    const int nblk = N / 64, nitems = (K / 64) * nblk, NGW = F.G * NWAVES, gw = blockIdx.x * NWAVES + F.wave;
    int first = gw - (rot % NGW); if (first < 0) first += NGW;
    for (int it = first; it < nitems; it += NGW) conv_item(W, ldw, K, WT, mode, scr, it, nblk, F.lane);
    rot += nitems;
}
__device__ __forceinline__ void convert_weights(Frame& F) {
    bf16* WB = (bf16*)(F.ws + WS_W); int rot = 0;
    for (int j = 0; j < 2; ++j) { if (j == 1 && QKV3_FP8) conv_job8(F, INP(1) + (size_t)j * DM * 3 * DM, 3 * DM, DM, 3 * DM, (unsigned char*)(WB + WE_QKV + (size_t)j * 3 * DM * DM), CV_PLAIN, rot);
        else conv_job(F, INP(1) + (size_t)j * DM * 3 * DM, 3 * DM, DM, 3 * DM, WB + WE_QKV + (size_t)j * 3 * DM * DM, CV_PLAIN, rot); }
    for (int j = 0; j < 2; ++j) conv_job(F, INP(2) + (size_t)j * DM * DM, DM, DM, DM, WB + WE_WO_SB + (size_t)j * DM * DM, CV_PLAIN, rot);
    conv_job(F, INP(3), 7 * DM, DM, 7 * DM, WB + WE_IN_DIL, CV_QKN, rot);
    conv_job(F, INP(6), DM, DM, DM, WB + WE_WO_DIL, CV_PLAIN, rot);
    if (FOXIN_FP8) conv_job8(F, INP(7), 3088, DM, 3 * DM, (unsigned char*)(WB + WE_IN_FOX), CV_QKN, rot); else conv_job(F, INP(7), 3088, DM, 3 * DM, WB + WE_IN_FOX, CV_QKN, rot);
    conv_job(F, INP(11), DM, DM, DM, WB + WE_WO_FOX, CV_PLAIN, rot);
    for (int f = 0; f < 2; ++f) {
        if (f == 0 ? DENSE_FP8_L0 : DENSE_FP8_L2) {
            conv_job8(F, INP(15) + (size_t)f * DM * FF, FF, DM, FF, (unsigned char*)(WB + WE_GU + (size_t)f * 2 * FF * DM), CV_GATE, rot);
            conv_job8(F, INP(16) + (size_t)f * DM * FF, FF, DM, FF, (unsigned char*)(WB + WE_GU + (size_t)f * 2 * FF * DM), CV_UP, rot);
            conv_job8(F, INP(17) + (size_t)f * FF * DM, DM, FF, DM, (unsigned char*)(WB + WE_D + (size_t)f * DM * FF), CV_PLAIN, rot);
        } else {
            conv_job(F, INP(15) + (size_t)f * DM * FF, FF, DM, FF, WB + WE_GU + (size_t)f * 2 * FF * DM, CV_GATE, rot);
            conv_job(F, INP(16) + (size_t)f * DM * FF, FF, DM, FF, WB + WE_GU + (size_t)f * 2 * FF * DM, CV_UP, rot);
            conv_job(F, INP(17) + (size_t)f * FF * DM, DM, FF, DM, WB + WE_D + (size_t)f * DM * FF, CV_PLAIN, rot);
        }
    }
    for (int fe = 0; fe < 16; ++fe) {
        if (MOE_FP8) {
            conv_job8(F, INP(19) + (size_t)fe * DM * FF, FF, DM, FF, (unsigned char*)(WB + WE_MGU) + (size_t)fe * 2 * FF * DM, CV_GATE, rot);
            conv_job8(F, INP(20) + (size_t)fe * DM * FF, FF, DM, FF, (unsigned char*)(WB + WE_MGU) + (size_t)fe * 2 * FF * DM, CV_UP, rot);
            conv_job8(F, INP(21) + (size_t)fe * FF * DM, DM, FF, DM, (unsigned char*)(WB + WE_MD) + (size_t)fe * DM * FF, CV_PLAIN, rot);
        } else {
            conv_job(F, INP(19) + (size_t)fe * DM * FF, FF, DM, FF, WB + WE_MGU + (size_t)fe * 2 * FF * DM, CV_GATE, rot);
            conv_job(F, INP(20) + (size_t)fe * DM * FF, FF, DM, FF, WB + WE_MGU + (size_t)fe * 2 * FF * DM, CV_UP, rot);
            conv_job(F, INP(21) + (size_t)fe * FF * DM, DM, FF, DM, WB + WE_MD + (size_t)fe * DM * FF, CV_PLAIN, rot);
        }
    }
}

__device__ __forceinline__ int moe_cnt(Frame& F, int f, int e) {
    const unsigned long long w = __hip_atomic_load((GAS unsigned long long*)(F.ctl + CW_CNT + f * 64 + 16 * (e >> 2)), RLX_AGENT);
    return (int)((w >> (16 * (e & 3))) & 0xffffull);
}
__device__ __forceinline__ f32x4 moe_yrow(Frame& F, int r, int q4) {
    const bf16* Y = (const bf16*)(F.ws + WS_R2); const bf16* P = (const bf16*)(F.ws + WS_R2 + 72 * MiB);
    if (r < SPLIT_ROW0 || F.G != 256 || !MOE_SPLITK) { const v2u a = ((const GAS v2u*)(Y + (size_t)r * DM))[q4]; return (f32x4){bflo(a.x), bfhi(a.x), bflo(a.y), bfhi(a.y)}; }
    f32x4 s = (f32x4){0.f, 0.f, 0.f, 0.f};
#pragma unroll
    for (int k = 0; k < MOE_NSPLIT; ++k) { const v2u a = ((const GAS v2u*)(P + ((size_t)k * SPLIT_ROWS + (size_t)(r - SPLIT_ROW0)) * DM))[q4]; s = s + (f32x4){bflo(a.x), bfhi(a.x), bflo(a.y), bfhi(a.y)}; }
    return s;
}
__device__ __forceinline__ void moe_bases(Frame& F, int f, int (&tb)[NE + 1]) {
    int acc = 0;
#pragma unroll
    for (int e = 0; e < NE; ++e) { tb[e] = acc; const int c = moe_cnt(F, f, e); acc += (c + 255) >> 8; }
    tb[NE] = acc;
}

template <int NC>
__device__ __forceinline__ float wave_reduce_cols(float (&part)[NC], int lane) {
#pragma unroll
    for (int st = 0, n = NC / 2; n >= 1; ++st, n >>= 1) {
        const bool up = (lane >> st) & 1;
#pragma unroll
        for (int i = 0; i < n; ++i) { const float keep = up ? part[i + n] : part[i], send = up ? part[i] : part[i + n]; part[i] = keep + __shfl_xor(send, 1 << st); }
    }
    float v = part[0];
#pragma unroll
    for (int o = NC; o < 64; o <<= 1) v += __shfl_xor(v, o);
    return v;
}
template <int NC> __device__ __forceinline__ int lane_of_col(int c) {
    int l = 0;
#pragma unroll
    for (int st = 0, n = NC / 2; n >= 1; ++st, n >>= 1) { if (c & n) l |= 1 << st; }
    return l;
}
template <int FLAGS>
__device__ __forceinline__ void norm_phase(Frame& F, const float* xin, float* xout, const float* gain, bf16* H, int fprev, int f,
                                           const float* Wf  , const float* bf  , const float* Wr  ) {
    constexpr int NC = (FLAGS & 2) ? 16 : (FLAGS & 4) ? 8 : 0;
    const bf16* Y = (const bf16*)(F.ws + WS_R2);
    const int* tok_prev = (const int*)(F.ws + WS_MISC + MS_TOK) + (size_t)fprev * M * 2;
    float* lgf = (float*)(F.ws + WS_MISC + MS_LOGF);
    LAS int* sel = (LAS int*)F.lds;
    LAS float* sg = (LAS float*)(F.lds + 512);
    LAS int* gb = (LAS int*)(F.lds + 1536);
    LAS f32x4* WL = (LAS f32x4*)(F.lds + 4096);
    int tb[NE + 1];
    if (FLAGS & 1) moe_bases(F, fprev, tb);
    if (NC) {
        const float* Wsrc = (FLAGS & 2) ? Wf + 3072 : Wr; const int ldw = (FLAGS & 2) ? 3088 : 8;
        for (int idx = F.tid; idx < 16 * (NC / 4) * 64; idx += NTHR) {
            const int ln = idx & 63, cq = (idx >> 6) % (NC / 4), jq = idx / (64 * (NC / 4)), k = 4 * (ln + 64 * (jq >> 2)) + (jq & 3);
            WL[idx] = *(const GAS f32x4*)(Wsrc + (size_t)k * ldw + 4 * cq) * gain[k];
        }
        __syncthreads();
    }
    for (int chunk = blockIdx.x; chunk < M / 64; chunk += F.G) {
        for (int i = 0; i < 8; ++i) {
            const int m = chunk * 64 + F.wave * 8 + i;
            int ln = F.lane; asm volatile("" : "+v"(ln));
            const GAS f32x4* xr = (const GAS f32x4*)(xin + (size_t)m * DM) + ln;
            f32x4 v[4];
#pragma unroll
            for (int j = 0; j < 4; ++j) v[j] = xr[64 * j];
            if (FLAGS & 1) {
                const int s0 = tok_prev[m * 2], s1 = tok_prev[m * 2 + 1];
                int r0 = 0, r1 = 0;
#pragma unroll
                for (int e = 0; e < NE; ++e) { if ((s0 >> 14) == e) r0 = tb[e] * 256 + (s0 & 16383); if ((s1 >> 14) == e) r1 = tb[e] * 256 + (s1 & 16383); }
#pragma unroll
                for (int j = 0; j < 4; ++j) { v[j] = v[j] + moe_yrow(F, r0, ln + 64 * j) + moe_yrow(F, r1, ln + 64 * j);
                    ((GAS f32x4*)(xout + (size_t)m * DM) + ln)[64 * j] = v[j]; }
            }
            float s = 0.f;
#pragma unroll
            for (int j = 0; j < 4; ++j) s += (v[j].x * v[j].x + v[j].y * v[j].y) + (v[j].z * v[j].z + v[j].w * v[j].w);
            const float inv = 1.0f / sqrtf(wave_sum(s) * (1.f / DM) + RMS_EPS);
            float colv = 0.f;
            if (NC) {
                float part[NC ? NC : 1];
#pragma unroll
                for (int c = 0; c < NC; ++c) part[c] = 0.f;
                const int woff = ln;
#pragma unroll
                for (int j = 0; j < 4; ++j) {
#pragma unroll
                    for (int q = 0; q < 4; ++q) { const float xv = v[j][q];
#pragma unroll
                        for (int cq = 0; cq < NC / 4; ++cq) { const f32x4 w = WL[((j * 4 + q) * (NC / 4) + cq) * 64 + woff];
                            part[cq * 4 + 0] += xv * w.x; part[cq * 4 + 1] += xv * w.y; part[cq * 4 + 2] += xv * w.z; part[cq * 4 + 3] += xv * w.w; }
                        if ((q & 1) == 1) asm volatile("" ::: "memory"); } }
                colv = wave_reduce_cols<NC ? NC : 2>(reinterpret_cast<float (&)[NC ? NC : 2]>(part), ln) * inv;
            }
            if (H) {
                GAS unsigned long long* o8 = (GAS unsigned long long*)(H + (size_t)m * DM) + ln;
                GAS unsigned* h8 = (GAS unsigned*)(F.ws + WS_R2 + 104 * MiB + (size_t)m * DM) + ln;
#pragma unroll
                for (int j = 0; j < 4; ++j) { const f32x4 g = ((const GAS f32x4*)gain + ln)[64 * j]; const f32x4 hv = v[j] * inv * g;
                    if (((FLAGS & 4) && MOE_FP8) || (FLAGS & 8)) h8[64 * j] = pg8::cvt4_fp8(hv.x, hv.y, hv.z, hv.w);
                    else o8[64 * j] = (unsigned long long)pk2(hv.x, hv.y) | ((unsigned long long)pk2(hv.z, hv.w) << 32); }
            }
            if (FLAGS & 2) {
                if (ln < 16) { const int l = ln; const int c = ((l & 1) << 3) | ((l & 2) << 1) | ((l & 4) >> 1) | ((l & 8) >> 3);
                    const float z = colv + bf[c]; const float ls = fminf(z, 0.f) - log1pf(expf(-fabsf(z))); lgf[(size_t)m * 16 + c] = ls * LOG2E; }
            }
            if (FLAGS & 4) {
                float lg[8];
#pragma unroll
                for (int c = 0; c < 8; ++c) lg[c] = __builtin_bit_cast(float, __builtin_amdgcn_readlane(__builtin_bit_cast(int, colv), lane_of_col<8>(c)));
                int e0 = 0; float l0 = lg[0];
#pragma unroll
                for (int c = 1; c < 8; ++c) if (lg[c] > l0) { l0 = lg[c]; e0 = c; }
                int e1 = -1; float l1 = -INFINITY;
#pragma unroll
                for (int c = 0; c < 8; ++c) if (c != e0 && lg[c] > l1) { l1 = lg[c]; e1 = c; }
                const float g0 = 1.0f / (1.0f + expf(l1 - l0)), g1 = 1.0f - g0;
                if (ln == 0) { const int r = F.wave * 8 + i; sel[r * 2] = e0; sel[r * 2 + 1] = e1; sg[r * 2] = g0; sg[r * 2 + 1] = g1; }
            }
        }
        if (FLAGS & 4) {
            int* selg = (int*)(F.ws + WS_MISC + MS_SEL) + (size_t)f * M * 2;
            float* sgg = (float*)(F.ws + WS_MISC + MS_SG) + (size_t)f * M * 2;
            int* lcn = (int*)(F.ws + WS_MISC + MS_LC) + (size_t)f * 256 * 8;
            __syncthreads();
            if (F.tid < 128) { selg[chunk * 128 + F.tid] = sel[F.tid]; sgg[chunk * 128 + F.tid] = sg[F.tid]; }
            if (F.tid >= 128 && F.tid < 136) { const int e = F.tid - 128; int c = 0;
                for (int q = 0; q < 128; ++q) c += (sel[q] == e) ? 1 : 0;
                lcn[chunk * 8 + e] = c; }
            __syncthreads();
        }
    }
}

__device__ __forceinline__ void moe_finalize(Frame& F, int f) {
    const int* selg = (const int*)(F.ws + WS_MISC + MS_SEL) + (size_t)f * M * 2;
    const float* sgg = (const float*)(F.ws + WS_MISC + MS_SG) + (size_t)f * M * 2;
    const int* lcn = (const int*)(F.ws + WS_MISC + MS_LC) + (size_t)f * 256 * 8;
    int* list = (int*)(F.ws + WS_MISC + MS_LIST) + (size_t)f * NE * LCAP;
    float* gw = (float*)(F.ws + WS_MISC + MS_GW) + (size_t)f * NE * LCAP;
    int* tok = (int*)(F.ws + WS_MISC + MS_TOK) + (size_t)f * M * 2;
    LAS int* arr = (LAS int*)F.lds;
    LAS int* sel = (LAS int*)(F.lds + 8192);
    LAS int* pb = (LAS int*)(F.lds + 8192 + 512);
    LAS int* pt = (LAS int*)(F.lds + 8192 + 1536);
    LAS int* base = (LAS int*)(F.lds + 8192 + 2560);
    LAS int* tot = (LAS int*)(F.lds + 8192 + 2592);
    for (int chunk = blockIdx.x; chunk < M / 64; chunk += F.G) {
        if (F.tid < 256) { const v4u a = *(const GAS v4u*)(lcn + F.tid * 8), b = *(const GAS v4u*)(lcn + F.tid * 8 + 4);
            *(LAS v4u*)(arr + F.tid * 8) = a; *(LAS v4u*)(arr + F.tid * 8 + 4) = b; }
        if (F.tid < 128) sel[F.tid] = selg[chunk * 128 + F.tid];
        __syncthreads();
        if (F.tid < 256) { const int e = F.tid & 7, seg = F.tid >> 3; int b = 0, t = 0;
#pragma unroll
            for (int i = 0; i < 8; ++i) { const int c = seg * 8 + i; const int v = arr[c * 8 + e]; t += v; b += (c < chunk) ? v : 0; }
            pb[seg * 8 + e] = b; pt[seg * 8 + e] = t; }
        __syncthreads();
        if (F.tid < 8) { int b = 0, t = 0;
            for (int sgm = 0; sgm < 32; ++sgm) { b += pb[sgm * 8 + F.tid]; t += pt[sgm * 8 + F.tid]; }
            base[F.tid] = b; tot[F.tid] = t; }
        __syncthreads();
        if (F.tid < 128) { const int mye = sel[F.tid]; int lp = 0;
            for (int q = 0; q < 128; ++q) lp += (q < F.tid && sel[q] == mye) ? 1 : 0;
            const int q = F.tid, row = chunk * 64 + (q >> 1), pos = base[mye] + lp;
            list[mye * LCAP + pos] = row; gw[mye * LCAP + pos] = sgg[chunk * 128 + q]; tok[row * 2 + (q & 1)] = mye * LCAP + pos; }
        if (chunk == 0 && F.tid < 2) { unsigned long long w = 0ull;
#pragma unroll
            for (int i = 0; i < 4; ++i) w |= (unsigned long long)(unsigned)tot[4 * F.tid + i] << (16 * i);
            __hip_atomic_store((GAS unsigned long long*)(F.ctl + CW_CNT + f * 64 + 16 * F.tid), w, RLX_AGENT); }
        __syncthreads();
    }
}

__device__ __forceinline__ void final_combine(Frame& F, int f) {
    const bf16* Y = (const bf16*)(F.ws + WS_R2);
    const int* tok = (const int*)(F.ws + WS_MISC + MS_TOK) + (size_t)f * M * 2;
    int tb[NE + 1]; moe_bases(F, f, tb);
    for (int m = blockIdx.x * NWAVES + F.wave; m < M; m += F.G * NWAVES) {
        const int s0 = tok[m * 2], s1 = tok[m * 2 + 1]; int r0 = 0, r1 = 0;
#pragma unroll
        for (int e = 0; e < NE; ++e) { if ((s0 >> 14) == e) r0 = tb[e] * 256 + (s0 & 16383); if ((s1 >> 14) == e) r1 = tb[e] * 256 + (s1 & 16383); }
        GAS f32x4* xr = (GAS f32x4*)(F.out + (size_t)m * DM) + F.lane;
#pragma unroll
        for (int j = 0; j < 4; ++j) xr[64 * j] = xr[64 * j] + moe_yrow(F, r0, F.lane + 64 * j) + moe_yrow(F, r1, F.lane + 64 * j);
    }
}

__device__ __forceinline__ void cumsum_phase(Frame& F) {
    const float* logf = (const float*)(F.ws + WS_MISC + MS_LOGF);
    float* cum = (float*)(F.ws + WS_MISC + MS_CUM);
    const int gw = blockIdx.x * NWAVES + F.wave;
    if (gw < BATCH * NH) {
        const int b = gw >> 4, h = gw & 15;
        float v[32]; float s = 0.f;
#pragma unroll
        for (int i = 0; i < 32; ++i) { v[i] = logf[((size_t)b * SEQ + F.lane * 32 + i) * 16 + h]; s += v[i]; }
        float incl = s;
#pragma unroll
        for (int o = 1; o < 64; o <<= 1) { const float t = __shfl_up(incl, o); if (F.lane >= o) incl += t; }
        float run = incl - s;
#pragma unroll
        for (int i = 0; i < 32; ++i) { run += v[i]; cum[((size_t)b * SEQ + F.lane * 32 + i) * 16 + h] = run; }
    }
}

enum { EPI_PLANES = 0, EPI_RESID = 1, EPI_SWIGLU = 2, EPI_MOEDOWN = 3 };
struct SgP { const bf16* A; int lda; const int* rowidx; int Mrows; const float* W0; const float* W1; int ldw; int K; int N;
             bf16* outb; int ldo; float scale0; const float* base; float* outf; const float* gwv; };
template <int EPI>
__device__ __forceinline__ void sgemm(Frame& F, const SgP& p) {
    LAS float* As = (LAS float*)F.lds;
    LAS float* Bs0 = As + 16 * 132;
    LAS float* Bs1 = Bs0 + 16 * 128;
    const int tid = F.tid, ty = tid >> 4, tx = tid & 15;
    const int lrow = tid >> 2, lkq = (tid & 3) * 4;
    const int bk = tid >> 5, bn = (tid & 31) * 4;
    const int ntn = p.N / 128, ntiles = (p.Mrows / 128) * ntn;
    for (int tile = blockIdx.x; tile < ntiles; tile += F.G) {
        const int tm = tile / ntn, tn = tile % ntn;
        const int arow = p.rowidx ? p.rowidx[tm * 128 + lrow] : tm * 128 + lrow;
        const bf16* ap = p.A + (size_t)arow * p.lda + lkq;
        const float* bp0 = p.W0 + (size_t)bk * p.ldw + tn * 128 + bn;
        const float* bp1 = (EPI == EPI_SWIGLU) ? p.W1 + (size_t)bk * p.ldw + tn * 128 + bn : nullptr;
        f32x2 acc0[4][4], acc1[4][4];
#pragma unroll
        for (int i = 0; i < 4; ++i)
#pragma unroll
            for (int j = 0; j < 4; ++j) { acc0[i][j] = (f32x2){0.f, 0.f}; acc1[i][j] = (f32x2){0.f, 0.f}; }
        for (int k0 = 0; k0 < p.K; k0 += 16) {
            const v2u av = *(const GAS v2u*)(ap + k0);
            const f32x4 b0 = *(const GAS f32x4*)(bp0 + (size_t)k0 * p.ldw);
            f32x4 b1 = (f32x4){0.f, 0.f, 0.f, 0.f};
            if (EPI == EPI_SWIGLU) b1 = *(const GAS f32x4*)(bp1 + (size_t)k0 * p.ldw);
            __syncthreads();
            As[(lkq + 0) * 132 + lrow] = bflo(av.x); As[(lkq + 1) * 132 + lrow] = bfhi(av.x);
            As[(lkq + 2) * 132 + lrow] = bflo(av.y); As[(lkq + 3) * 132 + lrow] = bfhi(av.y);
            *(LAS f32x4*)(Bs0 + bk * 128 + bn) = b0;
            if (EPI == EPI_SWIGLU) *(LAS f32x4*)(Bs1 + bk * 128 + bn) = b1;
            __syncthreads();
#pragma unroll 2
            for (int k = 0; k < 16; ++k) {
                const f32x4 a = *(const LAS f32x4*)(As + k * 132 + ty * 4);
                const f32x4 bA = *(const LAS f32x4*)(Bs0 + k * 128 + tx * 8), bB = *(const LAS f32x4*)(Bs0 + k * 128 + tx * 8 + 4);
                const f32x2 bv[4] = {(f32x2){bA.x, bA.y}, (f32x2){bA.z, bA.w}, (f32x2){bB.x, bB.y}, (f32x2){bB.z, bB.w}};
#pragma unroll
                for (int i = 0; i < 4; ++i) {
#pragma unroll
                    for (int j = 0; j < 4; ++j) acc0[i][j] += a[i] * bv[j]; }
                if (EPI == EPI_SWIGLU) {
                    const f32x4 cA = *(const LAS f32x4*)(Bs1 + k * 128 + tx * 8), cB = *(const LAS f32x4*)(Bs1 + k * 128 + tx * 8 + 4);
                    const f32x2 cv[4] = {(f32x2){cA.x, cA.y}, (f32x2){cA.z, cA.w}, (f32x2){cB.x, cB.y}, (f32x2){cB.z, cB.w}};
#pragma unroll
                    for (int i = 0; i < 4; ++i) {
#pragma unroll
                        for (int j = 0; j < 4; ++j) acc1[i][j] += a[i] * cv[j]; }
                }
                __builtin_amdgcn_sched_barrier(0);
            }
        }
        const int c0 = tn * 128 + tx * 8;
#pragma unroll
        for (int i = 0; i < 4; ++i) {
            const int r = tm * 128 + ty * 4 + i;
            if (EPI == EPI_PLANES) {
                const int pl = c0 >> 10, cc = c0 & 1023; const float sc = (pl == 0) ? p.scale0 : 1.f;
                v4u w; w.x = pk2(acc0[i][0].x * sc, acc0[i][0].y * sc); w.y = pk2(acc0[i][1].x * sc, acc0[i][1].y * sc); w.z = pk2(acc0[i][2].x * sc, acc0[i][2].y * sc); w.w = pk2(acc0[i][3].x * sc, acc0[i][3].y * sc);
                *(GAS v4u*)(p.outb + (size_t)pl * PLANE + (size_t)r * DM + cc) = w;
            } else if (EPI == EPI_RESID) {
                const GAS f32x4* bp = (const GAS f32x4*)(p.base + (size_t)r * DM + c0); GAS f32x4* op = (GAS f32x4*)(p.outf + (size_t)r * DM + c0);
                const f32x4 x0 = bp[0], x1 = bp[1];
                op[0] = x0 + (f32x4){acc0[i][0].x, acc0[i][0].y, acc0[i][1].x, acc0[i][1].y}; op[1] = x1 + (f32x4){acc0[i][2].x, acc0[i][2].y, acc0[i][3].x, acc0[i][3].y};
            } else if (EPI == EPI_SWIGLU) {
                float o[8];
#pragma unroll
                for (int j = 0; j < 8; ++j) { const float g = acc0[i][j >> 1][j & 1], uu = acc1[i][j >> 1][j & 1]; o[j] = g / (1.0f + __expf(-g)) * uu; }
                v4u w; w.x = pk2(o[0], o[1]); w.y = pk2(o[2], o[3]); w.z = pk2(o[4], o[5]); w.w = pk2(o[6], o[7]);
                *(GAS v4u*)(p.outb + (size_t)r * p.ldo + c0) = w;
            } else {
                const float g = p.gwv[r]; GAS f32x4* op = (GAS f32x4*)(p.outf + (size_t)r * DM + c0);
                op[0] = (f32x4){acc0[i][0].x * g, acc0[i][0].y * g, acc0[i][1].x * g, acc0[i][1].y * g}; op[1] = (f32x4){acc0[i][2].x * g, acc0[i][2].y * g, acc0[i][3].x * g, acc0[i][3].y * g};
            }
        }
    }
}

__device__ __forceinline__ void qknorm_plane(Frame& F, bf16* plane, const float* gain, float mul) {
    const int nth = F.G * NTHR;
    for (int idx = blockIdx.x * NTHR + F.tid; idx < M * NH; idx += nth) {
        GAS v4u* p = (GAS v4u*)(plane + (size_t)idx * 64);
        v4u w[8]; float ss = 0.f;
#pragma unroll
        for (int c = 0; c < 8; ++c) { w[c] = p[c];
#pragma unroll
            for (int q = 0; q < 4; ++q) { const float a = bflo(w[c][q]), b = bfhi(w[c][q]); ss += a * a + b * b; } }
        const float inv = 1.0f / sqrtf(ss * (1.f / 64.f) + RMS_EPS) * mul;
#pragma unroll
        for (int c = 0; c < 8; ++c) { v4u o;
#pragma unroll
            for (int q = 0; q < 4; ++q) { const float a = bflo(w[c][q]) * inv * gain[c * 8 + 2 * q], b = bfhi(w[c][q]) * inv * gain[c * 8 + 2 * q + 1]; o[q] = pk2(a, b); }
            p[c] = o; }
    }
}

template <int MODE>
__device__ __forceinline__ void attn_simple_causal(Frame& F, const bf16* Qp, const bf16* Kp, const bf16* Vp, bf16* O, const float* cum) {
    LAS float* Ks = (LAS float*)F.lds;
    LAS float* Vs = Ks + 4096;
    LAS float* kb = Vs + 4096;
    for (int u = blockIdx.x; u < BATCH * NH * 4; u += F.G) {
        const int qblk = (u & 1) ? 3 - ((u >> 1) & 1) : ((u >> 1) & 1) * 1;
        const int bh = u >> 2, b = bh >> 4, h = bh & 15;
        const int t = qblk * 512 + F.tid;
        const size_t rowbase = (size_t)b * SEQ;
        float q[64], acc[64];
        { const GAS v4u* qp = (const GAS v4u*)(Qp + (rowbase + t) * DM + h * 64);
#pragma unroll
          for (int c = 0; c < 8; ++c) { const v4u w = qp[c];
#pragma unroll
              for (int k = 0; k < 4; ++k) { q[c * 8 + 2 * k] = bflo(w[k]); q[c * 8 + 2 * k + 1] = bfhi(w[k]); } } }
#pragma unroll
        for (int d = 0; d < 64; ++d) acc[d] = 0.f;
        float P = 1.f, mrun = -INFINITY, lrun = 0.f;
        const int ntile = 8 * (qblk + 1);
        for (int it = 0; it < ntile; ++it) {
            const int tile = (MODE == 0) ? ntile - 1 - it : it;
            __syncthreads();
            { const int key = F.tid >> 3, ch = F.tid & 7;
              const v4u kw = *(const GAS v4u*)(Kp + (rowbase + tile * 64 + key) * DM + h * 64 + ch * 8);
              const v4u vw = *(const GAS v4u*)(Vp + (rowbase + tile * 64 + key) * DM + h * 64 + ch * 8);
#pragma unroll
              for (int k = 0; k < 4; ++k) { Ks[key * 64 + ch * 8 + 2 * k] = bflo(kw[k]); Ks[key * 64 + ch * 8 + 2 * k + 1] = bfhi(kw[k]);
                                            Vs[key * 64 + ch * 8 + 2 * k] = bflo(vw[k]); Vs[key * 64 + ch * 8 + 2 * k + 1] = bfhi(vw[k]); }
              if (MODE == 2 && F.tid < 64) kb[F.tid] = -cum[(rowbase + tile * 64 + F.tid) * 16 + h]; }
            __syncthreads();
            for (int jj = 0; jj < 64; ++jj) {
                const int j = (MODE == 0) ? 63 - jj : jj; const int s = tile * 64 + j;
                float z = 0.f;
#pragma unroll
                for (int d4 = 0; d4 < 16; ++d4) { const f32x4 kv = *(const LAS f32x4*)(Ks + j * 64 + d4 * 4); z += q[d4 * 4] * kv.x + q[d4 * 4 + 1] * kv.y + q[d4 * 4 + 2] * kv.z + q[d4 * 4 + 3] * kv.w; }
                if (MODE == 0) {
                    const bool valid = s < t;
                    const float e = __builtin_amdgcn_exp2f(fminf(z, 100.f));
                    float r = 1.0f / (1.0f + e); float beta = 1.0f - r;
                    if (!valid) { r = 1.f; beta = 0.f; }
                    const float w = beta * P; P *= r;
#pragma unroll
                    for (int d4 = 0; d4 < 16; ++d4) { const f32x4 vv = *(const LAS f32x4*)(Vs + j * 64 + d4 * 4); acc[d4 * 4] += w * vv.x; acc[d4 * 4 + 1] += w * vv.y; acc[d4 * 4 + 2] += w * vv.z; acc[d4 * 4 + 3] += w * vv.w; }
                } else {
                    const bool valid = s <= t;
                    const float x = valid ? z + kb[j] : -INFINITY;
                    const float mn = fmaxf(mrun, x);
                    const float a = __builtin_amdgcn_exp2f(mrun - mn), pw = __builtin_amdgcn_exp2f(x - mn);
                    lrun = lrun * a + pw; mrun = mn;
#pragma unroll
                    for (int d4 = 0; d4 < 16; ++d4) { const f32x4 vv = *(const LAS f32x4*)(Vs + j * 64 + d4 * 4);
                        acc[d4 * 4] = acc[d4 * 4] * a + pw * vv.x; acc[d4 * 4 + 1] = acc[d4 * 4 + 1] * a + pw * vv.y; acc[d4 * 4 + 2] = acc[d4 * 4 + 2] * a + pw * vv.z; acc[d4 * 4 + 3] = acc[d4 * 4 + 3] * a + pw * vv.w; }
                }
            }
        }
        const float fin = (MODE == 0) ? 1.f : 1.0f / lrun;
        GAS v4u* op = (GAS v4u*)(O + (rowbase + t) * DM + h * 64);
#pragma unroll
        for (int c = 0; c < 8; ++c) { v4u w;
#pragma unroll
            for (int k = 0; k < 4; ++k) w[k] = pk2(acc[c * 8 + 2 * k] * fin, acc[c * 8 + 2 * k + 1] * fin);
            op[c] = w; }
    }
}

__device__ __forceinline__ int t5_bucket(int dist) {
    if (dist < 16) return dist;
    const float d = (float)dist;
    int lb = 16 + (int)(logf(d / 16.0f) / logf(128.0f) * 16.0f);
    return lb < 31 ? lb : 31;
}
__device__ __forceinline__ void attn_simple_dil(Frame& F, const bf16* PROJ, bf16* O, const float* rel_bias) {
    LAS float* tbl = (LAS float*)F.lds;
    for (int u = blockIdx.x; u < BATCH * NH * 4; u += F.G) {
        const int qblk = u & 3, bh = u >> 2, b = bh >> 4, h = bh & 15;
        const int t = qblk * 512 + F.tid;
        const size_t rowbase = (size_t)b * SEQ;
        __syncthreads();
        for (int i = F.tid; i < 3 * 129; i += NTHR) { const int g = i / 129, dl = i % 129, dil = (g == 0) ? 1 : (g == 1) ? 4 : 16;
            tbl[g * 132 + dl] = rel_bias[t5_bucket(dl * dil) * 16 + h] * LOG2E; }
        __syncthreads();
        float acc[64];
#pragma unroll
        for (int d = 0; d < 64; ++d) acc[d] = 0.f;
        float mrun = -INFINITY, lrun = 0.f;
        for (int g = 0; g < 3; ++g) {
            const int dil = (g == 0) ? 1 : (g == 1) ? 4 : 16;
            const bf16* Qg = PROJ + (size_t)(2 * g) * PLANE; const bf16* Kg = PROJ + (size_t)(2 * g + 1) * PLANE; const bf16* Vg = PROJ + (size_t)6 * PLANE;
            float q[64];
            { const GAS v4u* qp = (const GAS v4u*)(Qg + (rowbase + t) * DM + h * 64);
#pragma unroll
              for (int c = 0; c < 8; ++c) { const v4u w = qp[c];
#pragma unroll
                  for (int k = 0; k < 4; ++k) { q[c * 8 + 2 * k] = bflo(w[k]); q[c * 8 + 2 * k + 1] = bfhi(w[k]); } } }
            for (int dl = 0; dl <= 128; ++dl) {
                const int s = t - dl * dil; const bool valid = s >= 0; const int sc = valid ? s : 0;
                const GAS v4u* kp = (const GAS v4u*)(Kg + (rowbase + sc) * DM + h * 64);
                float z = 0.f;
#pragma unroll
                for (int c = 0; c < 8; ++c) { const v4u w = kp[c];
#pragma unroll
                    for (int k = 0; k < 4; ++k) z += q[c * 8 + 2 * k] * bflo(w[k]) + q[c * 8 + 2 * k + 1] * bfhi(w[k]); }
                const float x = valid ? z + tbl[g * 132 + dl] : -INFINITY;
                const float mn = fmaxf(mrun, x);
                const float a = __builtin_amdgcn_exp2f(mrun - mn), pw = __builtin_amdgcn_exp2f(x - mn);
                lrun = lrun * a + pw; mrun = mn;
                const GAS v4u* vp = (const GAS v4u*)(Vg + (rowbase + sc) * DM + h * 64);
#pragma unroll
                for (int c = 0; c < 8; ++c) { const v4u w = vp[c];
#pragma unroll
                    for (int k = 0; k < 4; ++k) { acc[c * 8 + 2 * k] = acc[c * 8 + 2 * k] * a + pw * bflo(w[k]); acc[c * 8 + 2 * k + 1] = acc[c * 8 + 2 * k + 1] * a + pw * bfhi(w[k]); } }
            }
        }
        const float fin = 1.0f / lrun;
        GAS v4u* op = (GAS v4u*)(O + (rowbase + t) * DM + h * 64);
#pragma unroll
        for (int c = 0; c < 8; ++c) { v4u w;
#pragma unroll
            for (int k = 0; k < 4; ++k) w[k] = pk2(acc[c * 8 + 2 * k] * fin, acc[c * 8 + 2 * k + 1] * fin);
            op[c] = w; }
    }
}

__device__ __forceinline__ void moe_gu_simple(Frame& F, int f, const bf16* H, bf16* ACT) {
    const int* list = (const int*)(F.ws + WS_MISC + MS_LIST) + (size_t)f * NE * LCAP;
    int base = 0;
    for (int e = 0; e < NE; ++e) {
        const int c = moe_cnt(F, f, e); const int nt = (c + 255) >> 8;
        if (nt) {
            SgP p{}; p.A = H; p.lda = DM; p.rowidx = list + e * LCAP; p.Mrows = nt * 256;
            p.W0 = INP(19) + ((size_t)f * NE + e) * DM * FF; p.W1 = INP(20) + ((size_t)f * NE + e) * DM * FF; p.ldw = FF; p.K = DM; p.N = FF;
            p.outb = ACT + (size_t)base * 256 * FF; p.ldo = FF;
            sgemm<EPI_SWIGLU>(F, p);
        }
        base += nt;
    }
}
__device__ __forceinline__ void moe_down_simple(Frame& F, int f, const bf16* ACT, float* Y) {
    const float* gw = (const float*)(F.ws + WS_MISC + MS_GW) + (size_t)f * NE * LCAP;
    int base = 0;
    for (int e = 0; e < NE; ++e) {
        const int c = moe_cnt(F, f, e); const int nt = (c + 255) >> 8;
        if (nt) {
            SgP p{}; p.A = ACT + (size_t)base * 256 * FF; p.lda = FF; p.rowidx = nullptr; p.Mrows = nt * 256;
            p.W0 = INP(21) + ((size_t)f * NE + e) * FF * DM; p.ldw = DM; p.K = FF; p.N = DM;
            p.outf = Y + (size_t)base * 256 * DM; p.gwv = gw + e * LCAP;
            sgemm<EPI_MOEDOWN>(F, p);
        }
        base += nt;
    }
}


template <class Epi, bool FP8 = false>
__device__ __forceinline__ void dense_gemm(Frame& F, const bf16* A, const bf16* Bt, int N, int K, const Epi& E) {
    pg8::DenseOrder S; S.init(A, Bt, M, N, K, F.G, (int)blockIdx.x);
    pg8::gemm_phase<Epi, pg8::DenseOrder, false, FP8>(F.lds, K, S, E);
}
__device__ __forceinline__ void moe_order_init(Frame& F, int f, pg8::MoeOrder& S) {
    int acc = 0, t[NE];
#pragma unroll
    for (int e = 0; e < NE; ++e) { const int c = moe_cnt(F, f, e); acc += (c + 255) >> 8; t[e] = acc; }
    S.t1 = t[0]; S.t2 = t[1]; S.t3 = t[2]; S.t4 = t[3]; S.t5 = t[4]; S.t6 = t[5]; S.t7 = t[6]; S.t8 = t[7];
    S.G = F.G; S.c = (int)blockIdx.x;
}
__device__ __forceinline__ void moe_gu_fast(Frame& F, int f, const bf16* H, bf16* ACT) {
    pg8::MoeOrder S; moe_order_init(F, f, S);
    S.list = (const int*)(F.ws + WS_MISC + MS_LIST) + (size_t)f * NE * LCAP; S.gather = true; S.splitk = 0; S.nN = 2 * FF / 256;
    if (MOE_FP8) {
        S.K = DM / 2; S.A = (const char*)(F.ws + WS_R2 + 104 * MiB); S.Bt = (const char*)((const bf16*)(F.ws + WS_W) + WE_MGU) + (size_t)f * NE * 2 * FF * DM;
        S.tstepA = (size_t)256 * DM; S.tstepB = (size_t)256 * DM; S.estepB = (size_t)2 * FF * DM;
        pg8::EpiSwigluF8 E{(unsigned char*)ACT};
        pg8::gemm_phase<pg8::EpiSwigluF8, pg8::MoeOrder, true, true>(F.lds, DM / 2, S, E);
    } else {
        S.K = DM; S.A = (const char*)H; S.Bt = (const char*)((const bf16*)(F.ws + WS_W) + WE_MGU + (size_t)f * NE * 2 * FF * DM);
        S.tstepA = (size_t)256 * DM * 2; S.tstepB = (size_t)256 * DM * 2; S.estepB = (size_t)2 * FF * DM * 2;
        pg8::EpiSwiglu E{ACT};
        pg8::gemm_phase<pg8::EpiSwiglu, pg8::MoeOrder, true>(F.lds, DM, S, E);
    }
}
__device__ __forceinline__ void moe_down_fast(Frame& F, int f, const bf16* ACT, bf16* Y) {
    pg8::MoeOrder S; moe_order_init(F, f, S);
    S.nN = DM / 256; S.list = nullptr; S.gather = false; S.splitk = (MOE_SPLITK && F.G == 256) ? MOE_NSPLIT : 0;
    const float* gwp = (const float*)(F.ws + WS_MISC + MS_GW) + (size_t)f * NE * LCAP; bf16* P = (bf16*)(F.ws + WS_R2 + 72 * MiB);
    if (MOE_FP8) {
        S.K = FF / 2; S.A = (const char*)ACT; S.Bt = (const char*)((const bf16*)(F.ws + WS_W) + WE_MD) + (size_t)f * NE * DM * FF;
        S.tstepA = (size_t)256 * FF; S.tstepB = (size_t)256 * FF; S.estepB = (size_t)DM * FF;
        pg8::EpiMoeDown E{Y, gwp, P, 1.0f / (W8S * A8S)};
        pg8::gemm_phase<pg8::EpiMoeDown, pg8::MoeOrder, false, true>(F.lds, FF / 2, S, E);
    } else {
        S.K = FF; S.A = (const char*)ACT; S.Bt = (const char*)((const bf16*)(F.ws + WS_W) + WE_MD + (size_t)f * NE * DM * FF);
        S.tstepA = (size_t)256 * FF * 2; S.tstepB = (size_t)256 * FF * 2; S.estepB = (size_t)DM * FF * 2;
        pg8::EpiMoeDown E{Y, gwp, P, 1.0f};
        pg8::gemm_phase<pg8::EpiMoeDown, pg8::MoeOrder, false>(F.lds, FF, S, E);
    }
}

struct Args { const float* in[22]; float* out; unsigned char* ws; int ph_lo, ph_hi; };
constexpr int N_PHASES = 32;

__global__ void __launch_bounds__(NTHR, 2) trunk_fwd(Args args) {
    extern __shared__ __attribute__((aligned(16))) unsigned char lds[];
    Frame F;
    F.lds = (LAS unsigned char*)lds;
    F.tid = threadIdx.x; F.lane = F.tid & 63; F.wave = __builtin_amdgcn_readfirstlane(F.tid >> 6); F.G = gridDim.x;
    F.ws = args.ws; F.ctl = (gu32*)(args.ws + WS_CTL); F.out = args.out;
    if (F.tid == 0) {
#pragma unroll
        for (int i = 0; i < 22; ++i) ((LAS unsigned long long*)(F.lds + PTR_OFF))[i] = (unsigned long long)args.in[i];
    }
    volatile LAS unsigned* MISC = (volatile LAS unsigned*)(F.lds + MISC_OFF);
    if (F.tid < 32) MISC[F.tid] = 0u;
    __syncthreads();
    XcdBarrier bar; bar.bar = (unsigned*)(F.ctl + CW_BAR); bar.x = 0; bar.st = nullptr;
    const int lo = args.ph_lo, hi = args.ph_hi;
    if (hi - lo > 1) bar = xcd_barrier_post((unsigned*)(F.ctl + CW_BAR), MISC + 8);
#ifndef PHSEL
#define PHSEL 0xFFFFFFFFFFFFFFFFull
#endif
#define IN(k) (lo <= (k) && (k) < hi && ((PHSEL >> (k)) & 1ull) && relaunder(F))
#define SEAM(k) do { if (IN((k) + 1) && IN(k)) xcd_barrier(bar); } while (0)
#ifndef DUPMASK
#define DUPMASK 0ull
#endif
#define DUP(k) (((DUPMASK >> (k)) & 1ull) != 0ull)

    bf16* H = (bf16*)(F.ws + WS_H);
    bf16* PROJ = (bf16*)(F.ws + WS_R1);
    bf16* ACT = (bf16*)(F.ws + WS_R1);
    bf16* O = (bf16*)(F.ws + WS_R2);
    bf16* Y = (bf16*)(F.ws + WS_R2);
    bf16* OG = (bf16*)(F.ws + WS_R2 + 32 * MiB);
    float* ST = (float*)(F.ws + WS_R2 + 128 * MiB);
    float* X = F.out;
    const bf16* H8 = (const bf16*)(F.ws + WS_R2 + 104 * MiB);
    float* DUMMY = (float*)(F.ws + WS_R2 + 32 * MiB);
    const float* cum = (const float*)(F.ws + WS_MISC + MS_LOGF);

    const bf16* WB = (const bf16*)(F.ws + WS_W);
    enum { PH_BASE = __COUNTER__ + 1 };
#define PHASE(...) { constexpr int k_ = __COUNTER__ - PH_BASE; if (IN(k_)) { __VA_ARGS__; if (DUP(k_)) { xcd_barrier(bar); __VA_ARGS__; } SEAM(k_); } }
    PHASE({ unsigned* z = (unsigned*)(F.ws + WS_MISC + MS_LIST);
            for (int i = blockIdx.x * NTHR + F.tid; i < (int)(2 * MiB / 4); i += F.G * NTHR) z[i] = 0u;
            convert_weights(F);
            __syncthreads();
            norm_phase<0>(F, INP(0), nullptr, INP(13) + 0 * DM, H, 0, 0, nullptr, nullptr, nullptr); })
    PHASE({ pg8::EpiPlanes E{PROJ, C2, 1.0f}; dense_gemm(F, H, WB + WE_QKV, 3 * DM, DM, E); })
    PHASE(att::causal_phase<0>((att::lptr)F.lds, F.G, PROJ, PROJ + PLANE, PROJ + 2 * PLANE, O, nullptr))
    PHASE({ pg8::EpiResid E{INP(0), X, 1.0f}; dense_gemm(F, O, WB + WE_WO_SB, DM, DM, E); })
    PHASE(norm_phase<DENSE_FP8_L0 ? 8 : 0>(F, X, nullptr, INP(14) + 0 * DM, H, 0, 0, nullptr, nullptr, nullptr))
    PHASE({ if (DENSE_FP8_L0) { pg8::EpiSwigluF8 E{(unsigned char*)ACT}; dense_gemm<pg8::EpiSwigluF8, true>(F, H8, (const bf16*)((const unsigned char*)(WB + WE_GU)), 2 * FF, DM / 2, E); }
            else { pg8::EpiSwiglu E{ACT}; dense_gemm(F, H, WB + WE_GU, 2 * FF, DM, E); } })
    PHASE({ if (DENSE_FP8_L0) { pg8::EpiResid E{X, X, 1.0f / (W8S * A8S)}; dense_gemm<pg8::EpiResid, true>(F, ACT, (const bf16*)((const unsigned char*)(WB + WE_D)), DM, FF / 2, E); }
            else { pg8::EpiResid E{X, X, 1.0f}; dense_gemm(F, ACT, WB + WE_D, DM, FF, E); } })
    PHASE(norm_phase<0>(F, X, nullptr, INP(13) + 1 * DM, H, 0, 0, nullptr, nullptr, nullptr))
    PHASE({ pg8::EpiQKNorm E{PROJ, INP(4), INP(5), 6, 1.0f}; dense_gemm(F, H, WB + WE_IN_DIL, 7 * DM, DM, E); })
    PHASE(att::dil_phase((att::lptr)F.lds, F.G, PROJ, OG, ST, INP(12)))
    PHASE(att::dil_merge(F.G, OG, ST, O))
    PHASE({ pg8::EpiResid E{X, X, 1.0f}; dense_gemm(F, O, WB + WE_WO_DIL, DM, DM, E); })
    PHASE(norm_phase<4>(F, X, nullptr, INP(14) + 1 * DM, H, 0, 0, nullptr, nullptr, INP(18) + 0 * DM * NE))
    PHASE(moe_finalize(F, 0))
    PHASE(moe_gu_fast(F, 0, H, ACT))
    PHASE(moe_down_fast(F, 0, ACT, Y))
    PHASE(norm_phase<1 | 2 | (FOXIN_FP8 ? 8 : 0)>(F, X, X, INP(13) + 2 * DM, H, 0, 0, INP(7), INP(8), nullptr))
    PHASE({ if (FOXIN_FP8) { pg8::EpiQKNorm E{PROJ, INP(9), INP(10), 2, 1.0f / W8S}; dense_gemm<pg8::EpiQKNorm, true>(F, H8, WB + WE_IN_FOX, 3 * DM, DM / 2, E); }
            else { pg8::EpiQKNorm E{PROJ, INP(9), INP(10), 2, 1.0f}; dense_gemm(F, H, WB + WE_IN_FOX, 3 * DM, DM, E); } })
    PHASE(att::causal_phase<2>((att::lptr)F.lds, F.G, PROJ, PROJ + PLANE, PROJ + 2 * PLANE, O, cum))
    PHASE({ pg8::EpiResid E{X, X, 1.0f}; dense_gemm(F, O, WB + WE_WO_FOX, DM, DM, E); })
    PHASE(norm_phase<DENSE_FP8_L2 ? 8 : 0>(F, X, nullptr, INP(14) + 2 * DM, H, 0, 0, nullptr, nullptr, nullptr))
    PHASE({ if (DENSE_FP8_L2) { pg8::EpiSwigluF8 E{(unsigned char*)ACT}; dense_gemm<pg8::EpiSwigluF8, true>(F, H8, WB + WE_GU + (size_t)2 * FF * DM, 2 * FF, DM / 2, E); }
            else { pg8::EpiSwiglu E{ACT}; dense_gemm(F, H, WB + WE_GU + (size_t)2 * FF * DM, 2 * FF, DM, E); } })
    PHASE({ if (DENSE_FP8_L2) { pg8::EpiResid E{X, X, 1.0f / (W8S * A8S)}; dense_gemm<pg8::EpiResid, true>(F, ACT, WB + WE_D + (size_t)DM * FF, DM, FF / 2, E); }
            else { pg8::EpiResid E{X, X, 1.0f}; dense_gemm(F, ACT, WB + WE_D + (size_t)DM * FF, DM, FF, E); } })
    PHASE(norm_phase<QKV3_FP8 ? 8 : 0>(F, X, nullptr, INP(13) + 3 * DM, H, 0, 0, nullptr, nullptr, nullptr))
    PHASE({ if (QKV3_FP8) { pg8::EpiPlanes E{PROJ, C2, 1.0f / W8S}; dense_gemm<pg8::EpiPlanes, true>(F, H8, WB + WE_QKV + (size_t)3 * DM * DM, 3 * DM, DM / 2, E); }
            else { pg8::EpiPlanes E{PROJ, C2, 1.0f}; dense_gemm(F, H, WB + WE_QKV + (size_t)3 * DM * DM, 3 * DM, DM, E); } })
    PHASE(att::causal_phase<0>((att::lptr)F.lds, F.G, PROJ, PROJ + PLANE, PROJ + 2 * PLANE, O, nullptr))
    PHASE({ pg8::EpiResid E{X, X, 1.0f}; dense_gemm(F, O, WB + WE_WO_SB + (size_t)DM * DM, DM, DM, E); })
    PHASE(norm_phase<4>(F, X, nullptr, INP(14) + 3 * DM, H, 0, 1, nullptr, nullptr, INP(18) + 1 * DM * NE))
    PHASE(moe_finalize(F, 1))
    PHASE(moe_gu_fast(F, 1, H, ACT))
    PHASE(moe_down_fast(F, 1, ACT, Y))
    PHASE(final_combine(F, 1))
    static_assert(__COUNTER__ - PH_BASE == N_PHASES, "N_PHASES must equal the number of PHASE() sites");
#undef PHASE
#undef IN
#undef SEAM
}

extern "C" void kernel_launch(void* const* d_in, const int* in_sizes, int n_in, void* d_out, int out_size, void* d_ws, size_t ws_size, hipStream_t stream) {
    static int grid = 0;
    if (grid == 0) {
        if (n_in != 22 || out_size != M * DM || ws_size < WS_END) { fprintf(stderr, "kernel_launch: unexpected shapes (n_in %d out %d ws %zu)\n", n_in, out_size, ws_size); grid = -1; return; }
        int dev = 0, cus = 0, per_cu = 0;
        if (hipGetDevice(&dev) != hipSuccess || hipDeviceGetAttribute(&cus, hipDeviceAttributeMultiprocessorCount, dev) != hipSuccess) { grid = -1; return; }
        if (hipFuncSetAttribute((const void*)trunk_fwd, hipFuncAttributeMaxDynamicSharedMemorySize, LDS_BYTES) != hipSuccess) { fprintf(stderr, "kernel_launch: hipFuncSetAttribute failed\n"); grid = -1; return; }
        if (hipOccupancyMaxActiveBlocksPerMultiprocessor(&per_cu, (const void*)trunk_fwd, NTHR, LDS_BYTES) != hipSuccess || per_cu < 1) fprintf(stderr, "kernel_launch: occupancy query says %d\n", per_cu);
        (void)hipGetLastError();
        grid = cus;
    }
    if (grid < 0) return;
    (void)hipMemsetAsync((char*)d_ws + WS_CTL, 0, CTL_ZERO_BYTES, stream);
    Args a{};
    for (int i = 0; i < 22; ++i) a.in[i] = (const float*)d_in[i];
    a.out = (float*)d_out; a.ws = (unsigned char*)d_ws;
#if MK_MULTI
    for (int p = 0; p < N_PHASES; ++p) { a.ph_lo = p; a.ph_hi = p + 1; hipLaunchKernelGGL(trunk_fwd, dim3(grid), dim3(NTHR), LDS_BYTES, stream, a); }
#else
    a.ph_lo = 0; a.ph_hi = N_PHASES;
    hipLaunchKernelGGL(trunk_fwd, dim3(grid), dim3(NTHR), LDS_BYTES, stream, a);
#endif
}
```

```cpp
#include <hip/hip_runtime.h>
#include <cstdio>
#include <cstdint>

#ifndef MK_MULTI
#define MK_MULTI 0
#endif

constexpr int BATCH = 8, SEQ = 2048, DM = 1024, NH = 16, HD = 64, FF = 3584, NE = 8;
constexpr int M = BATCH * SEQ;
constexpr float RMS_EPS = 1e-6f;
constexpr float LOG2E = 1.4426950408889634f;
constexpr float C2 = 0.125f * LOG2E;
constexpr int NWAVES = 8, NTHR = 512;
constexpr int LCAP = 16384;
constexpr int MAXROWS = 34816;
constexpr bool MOE_SPLITK = true;
constexpr bool MOE_FP8 = true;
constexpr bool DILIN_FP8 = true;
constexpr bool FOXIN_FP8 = true;
constexpr bool QKV3_FP8 = true;
constexpr bool DENSE_FP8_L0 = false, DENSE_FP8_L2 = true;
constexpr float W8S = 32.0f, A8S = 4.0f;
constexpr int MOE_NSPLIT = MOE_FP8 ? 2 : 4;
constexpr int SPLIT_ROW0 = 32768, SPLIT_ROWS = MAXROWS - SPLIT_ROW0;

constexpr size_t MiB = 1u << 20;
constexpr size_t WS_CTL = 0, CTL_ZERO_BYTES = 1 * MiB;
constexpr size_t WS_MISC = 1 * MiB;
constexpr size_t WS_H = 6 * MiB;
constexpr size_t WS_R1 = 38 * MiB;
constexpr size_t WS_R2 = 278 * MiB;
constexpr size_t WS_W = 414 * MiB;
constexpr size_t WS_END = 832 * MiB;
constexpr size_t PLANE = (size_t)M * DM;
constexpr size_t WE_QKV = 0;
constexpr size_t WE_WO_SB = WE_QKV + 2ull * 3072 * 1024;
constexpr size_t WE_WO_DIL = WE_WO_SB + 2ull * 1024 * 1024;
constexpr size_t WE_WO_FOX = WE_WO_DIL + 1024ull * 1024;
constexpr size_t WE_IN_DIL = WE_WO_FOX + 1024ull * 1024;
constexpr size_t WE_IN_FOX = WE_IN_DIL + 7168ull * 1024;
constexpr size_t WE_GU = WE_IN_FOX + 3072ull * 1024;
constexpr size_t WE_D = WE_GU + 2ull * 7168 * 1024;
constexpr size_t WE_MGU = WE_D + 2ull * 1024 * 3584;
constexpr size_t WE_MD = WE_MGU + 16ull * 7168 * 1024;
constexpr size_t WE_END = WE_MD + 16ull * 1024 * 3584;
static_assert(WS_W + WE_END * 2 <= WS_END, "weight copies fit");
constexpr size_t MS_LIST = 0;
constexpr size_t MS_GW = 1 * MiB;
constexpr size_t MS_TOK = 2 * MiB;
constexpr size_t MS_LOGF = 2 * MiB + 256 * 1024;
constexpr size_t MS_CUM = 3 * MiB + 256 * 1024;
constexpr size_t MS_SEL = 4 * MiB + 256 * 1024;
constexpr size_t MS_SG = MS_SEL + 256 * 1024;
constexpr size_t MS_LC = MS_SG + 256 * 1024;
constexpr int CW_BAR = 4096;
constexpr int CW_CNT = 64;

#define GAS __attribute__((address_space(1)))
#define LAS __attribute__((address_space(3)))
typedef unsigned short bf16;
typedef unsigned v4u __attribute__((ext_vector_type(4)));
typedef unsigned v2u __attribute__((ext_vector_type(2)));
typedef float f32x4 __attribute__((ext_vector_type(4)));
typedef float f32x2 __attribute__((ext_vector_type(2)));
typedef GAS unsigned gu32;
#define RLX_AGENT __ATOMIC_RELAXED, __HIP_MEMORY_SCOPE_AGENT
__device__ __forceinline__ unsigned f2bf(float f) { unsigned u = __builtin_bit_cast(unsigned, f); return (u + 0x7fffu + ((u >> 16) & 1u)) >> 16; }
__device__ __forceinline__ unsigned pk2(float lo, float hi) { return f2bf(lo) | (f2bf(hi) << 16); }
__device__ __forceinline__ float bflo(unsigned u) { return __builtin_bit_cast(float, u << 16); }
__device__ __forceinline__ float bfhi(unsigned u) { return __builtin_bit_cast(float, u & 0xffff0000u); }

#define XB_TMO      128
#define XB_XCNT(j)  (256  + 64 * (j))
#define XB_XSUB(j)  (1280 + 64 * (j))
#define XB_XGEN(j)  (2304 + 64 * (j))
#define XB_TOP      3328
#define XB_TOPGEN   3392
#define XCD_BAR_WORDS 3456
#define XB_SPIN_CAP (1u << 22)
__device__ __forceinline__ unsigned xb_ld(unsigned* p)              { return __hip_atomic_load(p, __ATOMIC_RELAXED, __HIP_MEMORY_SCOPE_AGENT); }
__device__ __forceinline__ unsigned xb_add(unsigned* p, unsigned v) { return __hip_atomic_fetch_add(p, v, __ATOMIC_RELAXED, __HIP_MEMORY_SCOPE_AGENT); }
__device__ __forceinline__ unsigned xb_xcc_id() { return (unsigned)__builtin_amdgcn_s_getreg((3 << 11) | 20) & 0xFu; }
#define XB_SPIN(cond, bar) do { unsigned _sp = 0; while (cond) { __builtin_amdgcn_s_sleep(1); \
    if ((++_sp & 255u) == 0u) { if (xb_ld(&(bar)[XB_TMO])) break; if (_sp > XB_SPIN_CAP) { atomicAdd(&(bar)[XB_TMO], 1u); break; } } } } while (0)
struct XcdBarrier { unsigned* bar; unsigned x; volatile LAS unsigned* st; };
__device__ __forceinline__ XcdBarrier xcd_barrier_post(unsigned* bar, volatile LAS unsigned* st) {
    XcdBarrier b; b.bar = bar; b.x = xb_xcc_id(); b.st = st;
    if (threadIdx.x == 0) (void)xb_add(&bar[XB_XCNT(b.x)], 1u);
    return b;
}
__device__ __forceinline__ void xcd_barrier_complete(unsigned* bar, unsigned x, unsigned& nloc, unsigned& nx) {
    const unsigned G = gridDim.x * gridDim.y * gridDim.z;
    unsigned sum, cnt, mine, sp = 0u;
    for (;;) {
        sum = 0u; cnt = 0u; mine = 0u;
#pragma unroll
        for (unsigned j = 0; j < 16; ++j) { const unsigned c = xb_ld(&bar[XB_XCNT(j)]); sum += c; cnt += (c > 0u) ? 1u : 0u; mine = (j == x) ? c : mine; }
        if (sum == G) break;
        __builtin_amdgcn_s_sleep(1);
        if ((++sp & 255u) == 0u) { if (xb_ld(&bar[XB_TMO])) break; if (sp > XB_SPIN_CAP) { atomicAdd(&bar[XB_TMO], 1u); break; } }
    }
    nloc = mine > 0u ? mine : 1u; nx = cnt > 0u ? cnt : 1u;
}
__device__ __forceinline__ void xcd_barrier(const XcdBarrier& b) {
    asm volatile("s_waitcnt vmcnt(0)" ::: "memory");
    __syncthreads();
    if (threadIdx.x == 0) {
        unsigned* bar = b.bar;
        __builtin_amdgcn_s_waitcnt(0);
        unsigned nloc = b.st[0], nx = b.st[1];
        if (nloc == 0u) { xcd_barrier_complete(bar, b.x, nloc, nx); b.st[0] = nloc; b.st[1] = nx; }
        const unsigned old = xb_add(&bar[XB_XSUB(b.x)], 1u);
        const unsigned gen = old / nloc;
        if (old + 1u == (gen + 1u) * nloc) {
            __builtin_amdgcn_fence(__ATOMIC_RELEASE, "agent");
            asm volatile("s_waitcnt vmcnt(0)" ::: "memory");
            const unsigned og = xb_add(&bar[XB_TOP], 1u);
            const unsigned tg = og / nx;
            if (og + 1u == (tg + 1u) * nx) xb_add(&bar[XB_TOPGEN], 1u);
            else XB_SPIN(xb_ld(&bar[XB_TOPGEN]) == tg, bar);
            __builtin_amdgcn_fence(__ATOMIC_ACQUIRE, "agent");
            xb_add(&bar[XB_XGEN(b.x)], 1u);
            asm volatile("s_waitcnt vmcnt(0)" ::: "memory");
        } else {
            XB_SPIN(xb_ld(&bar[XB_XGEN(b.x)]) == gen, bar);
            __builtin_amdgcn_fence(__ATOMIC_ACQUIRE, "agent");
            asm volatile("s_waitcnt vmcnt(0)" ::: "memory");
        }
    }
    __syncthreads();
}

constexpr int LDS_BYTES = 147456;
constexpr int ATT_LDS_MAX = 143360;
constexpr int MISC_OFF = ATT_LDS_MAX + 64;
struct Frame {
    LAS unsigned char* lds;
    int tid, lane, wave, G;
    unsigned char* ws; gu32* ctl;
    float* out;
};
__device__ __forceinline__ float wave_sum(float v) {
#pragma unroll
    for (int o = 1; o < 64; o <<= 1) v += __shfl_xor(v, o);
    return v;
}

constexpr int PTR_OFF = ATT_LDS_MAX + 512;
__device__ __forceinline__ const float* inp_ptr(Frame& F, int k) {
    const LAS unsigned* t = (const LAS unsigned*)(F.lds + PTR_OFF) + 2 * k;
    const unsigned lo = __builtin_amdgcn_readfirstlane(t[0]), hi = __builtin_amdgcn_readfirstlane(t[1]);
    return (const float*)(((unsigned long long)hi << 32) | lo);
}
#define INP(k) inp_ptr(F, (k))
__device__ __forceinline__ bool relaunder(Frame& F) { int t_ = threadIdx.x; asm volatile("" : "+v"(t_)); F.tid = t_; F.lane = t_ & 63; F.wave = __builtin_amdgcn_readfirstlane(t_ >> 6); return true; }
namespace pg8 {
#define PG8_LAS __attribute__((address_space(3)))
typedef unsigned short bf16_t;
typedef short bf16x8 __attribute__((ext_vector_type(8)));
typedef unsigned u32x4 __attribute__((ext_vector_type(4)));
constexpr int BM = 256, BK = 64, HALF = 128, HTB = HALF * BK * 2, STAGE_BYTES = 8 * HTB, NXCD = 8, WGM = 8;
__host__ __device__ __forceinline__ int lds_byte(int r, int c) { const int st = (r >> 4) * 2 + (c >> 5), rr = r & 15, cc = c & 31, ob = rr * 64 + cc * 2; return st * 1024 + (ob ^ (((ob >> 9) & 1) << 5)); }
__host__ __device__ __forceinline__ void stage_rc(int b, int& R, int& C) { const int st = b / 1024, sb = b % 1024, swz = sb ^ (((sb >> 9) & 1) << 5); R = (st >> 1) * 16 + swz / 64; C = (st & 1) * 32 + (swz % 64) / 2; }
__host__ __device__ __forceinline__ int perm32(int rho) { const int n = rho >> 4, i = rho & 15; return 8 * (i >> 2) + 4 * n + (i & 3); }
struct Unit { int pm, pn, e, mt, nt, koff, kq; };

struct DenseOrder {
    int nM, nN, nwg, G, c, ntk; const char* A; const char* Bt; size_t tstep;
    __device__ __forceinline__ void init(const bf16_t* A_, const bf16_t* Bt_, int M_, int N_, int K_, int G_, int c_) { nM = M_ / BM; nN = N_ / BM; nwg = nM * nN; G = G_; c = c_; ntk = K_ / BK; A = (const char*)A_; Bt = (const char*)Bt_; tstep = (size_t)BM * K_ * 2; }
    __device__ __forceinline__ bool next(int i, Unit& u) const {
        const long L = (long)i * G + c; if (L >= nwg) return false;
        int wgid = (int)L; { const int q = nwg / NXCD, r = nwg % NXCD, xcd = wgid % NXCD, off = wgid / NXCD; wgid = (xcd < r ? xcd * (q + 1) : r * (q + 1) + (xcd - r) * q) + off; }
        const int nig = WGM * nN, gid = wgid / nig, fm = gid * WGM, gsz = (nM - fm) < WGM ? (nM - fm) : WGM;
        u.pm = fm + ((wgid % nig) % gsz); u.pn = (wgid % nig) / gsz; u.e = 0; u.mt = u.pm; u.nt = ntk; u.koff = 0; u.kq = -1; return true;
    }
    __device__ __forceinline__ const char* a_base(const Unit& u) const { return A + (size_t)u.pm * tstep; }
    __device__ __forceinline__ const char* b_base(const Unit& u) const { return Bt + (size_t)u.pn * tstep; }
    __device__ __forceinline__ void a_voff(const Unit&, const int (&)[2], const int (&)[2], unsigned (&)[2][2]) const {}
};
struct MoeOrder {
    int t1, t2, t3, t4, t5, t6, t7, t8, nN, G, c, K; const char* A; const char* Bt; size_t tstepA, tstepB, estepB; const int* list; bool gather; int splitk;
    __device__ __forceinline__ bool next(int i, Unit& u) const {
        const int X = i * G + c, U = t8 * nN; int L = X; u.nt = K / BK; u.koff = 0; u.kq = -1;
        if (splitk) { const int nfull = (U / G) * G;
            if (X >= nfull) { const int q = X - nfull; if (q >= splitk * (U - nfull)) return false; L = nfull + q / splitk; u.kq = q % splitk; u.nt = K / BK / splitk; u.koff = u.kq * (K / splitk) * 2; } }
        else if (X >= U) return false;
        const int mt = L / nN; u.pm = mt; u.pn = L - mt * nN;
        const int e = (mt >= t1) + (mt >= t2) + (mt >= t3) + (mt >= t4) + (mt >= t5) + (mt >= t6) + (mt >= t7);
        const int tb = e == 0 ? 0 : e == 1 ? t1 : e == 2 ? t2 : e == 3 ? t3 : e == 4 ? t4 : e == 5 ? t5 : e == 6 ? t6 : t7;
        u.e = e; u.mt = mt - tb; return true;
    }
    __device__ __forceinline__ const char* a_base(const Unit& u) const { return (gather ? A : A + (size_t)u.pm * tstepA) + u.koff; }
    __device__ __forceinline__ const char* b_base(const Unit& u) const { return Bt + (size_t)u.e * estepB + (size_t)u.pn * tstepB + u.koff; }
    __device__ __forceinline__ void a_voff(const Unit& u, const int (&sR)[2], const int (&sC)[2], unsigned (&v)[2][2]) const {
        const int* lp = list + u.e * LCAP + u.mt * 256;
#pragma unroll
        for (int h = 0; h < 2; ++h)
#pragma unroll
            for (int i = 0; i < 2; ++i) v[h][i] = (unsigned)lp[h * 128 + sR[i]] * (unsigned)(K * 2) + (unsigned)(sC[i] * 2);
    }
};

typedef int v8i32 __attribute__((ext_vector_type(8)));
typedef int v4i32 __attribute__((ext_vector_type(4)));
__device__ __forceinline__ v8i32 cat8(bf16x8 a, bf16x8 b) { const v4i32 x = __builtin_bit_cast(v4i32, a), y = __builtin_bit_cast(v4i32, b); return (v8i32){x[0], x[1], x[2], x[3], y[0], y[1], y[2], y[3]}; }
__device__ __forceinline__ unsigned cvt4_fp8(float a, float b, float c, float d) { int w = 0; w = __builtin_amdgcn_cvt_pk_fp8_f32(a, b, w, false); w = __builtin_amdgcn_cvt_pk_fp8_f32(c, d, w, true); return (unsigned)w; }
__device__ __forceinline__ const char* uniptr(const char* p) { const unsigned long long v = (unsigned long long)p; const unsigned lo = __builtin_amdgcn_readfirstlane((unsigned)v), hi = __builtin_amdgcn_readfirstlane((unsigned)(v >> 32)); return (const char*)(((unsigned long long)hi << 32) | lo); }
__device__ __forceinline__ void glds16_s(const char* sbase, unsigned voff, unsigned lds_dst) { unsigned keep;
    asm volatile("s_mov_b32 %0, m0\n\ts_mov_b32 m0, %3\n\ts_nop 0\n\tglobal_load_lds_dwordx4 %2, %1\n\ts_mov_b32 m0, %0" : "=&s"(keep) : "s"(sbase), "v"(voff), "s"(lds_dst) : "memory"); }
__device__ __forceinline__ unsigned cvt_pk_bf16(float lo, float hi) { unsigned r; asm volatile("v_cvt_pk_bf16_f32 %0, %1, %2" : "=v"(r) : "v"(lo), "v"(hi)); return r; }

struct EpiPlanes {
    static constexpr bool PERM = true;
    bf16_t* O; float scale0; float oscale;
    __device__ __forceinline__ void operator()(const f32x4 (&acc)[2][2][4][2], const Unit& u, int wr, int wc, int fr, int fq) const {
        const int plane = u.pn >> 2; const float sc = (plane == 0 ? scale0 : 1.f) * oscale;
        bf16_t* base = O + (size_t)plane * PLANE + (size_t)(u.pm * BM + wr * 64 + fr) * DM + (u.pn & 3) * 256 + wc * 32 + 8 * fq;
#pragma unroll
        for (int ai = 0; ai < 2; ++ai)
#pragma unroll
            for (int m = 0; m < 4; ++m) { bf16_t* rowp = base + (size_t)(ai * HALF + m * 16) * DM;
#pragma unroll
                for (int bj = 0; bj < 2; ++bj) { const f32x4 v0 = acc[ai][bj][m][0] * sc, v1 = acc[ai][bj][m][1] * sc;
                    u32x4 w; w.x = cvt_pk_bf16(v0[0], v0[1]); w.y = cvt_pk_bf16(v0[2], v0[3]); w.z = cvt_pk_bf16(v1[0], v1[1]); w.w = cvt_pk_bf16(v1[2], v1[3]);
                    *(u32x4*)(rowp + bj * HALF) = w; } }
    }
};
struct EpiQKNorm {
    static constexpr bool PERM = true;
    bf16_t* O; const float* qg; const float* kg; int vplane; float iscale;
    __device__ __forceinline__ void operator()(const f32x4 (&acc)[2][2][4][2], const Unit& u, int wr, int wc, int fr, int fq) const {
        const int plane = u.pn >> 2; const bool isv = plane == vplane; const bool isq = !isv && ((plane & 1) == 0); const int grp = plane >> 1;
        const float* g = (isq ? qg : kg) + grp * 64 + 8 * fq;
        f32x4 gv[2][2];
#pragma unroll
        for (int bj = 0; bj < 2; ++bj)
#pragma unroll
            for (int n = 0; n < 2; ++n) gv[bj][n] = isv ? (f32x4){1.f, 1.f, 1.f, 1.f} : *(const f32x4*)(g + 32 * bj + 4 * n);
        const float mul = isq ? C2 : 1.f;
        bf16_t* base = O + (size_t)plane * PLANE + (size_t)(u.pm * BM + wr * 64 + fr) * DM + (u.pn & 3) * 256 + wc * 64 + 8 * fq;
#pragma unroll
        for (int ai = 0; ai < 2; ++ai)
#pragma unroll
            for (int m = 0; m < 4; ++m) { bf16_t* rowp = base + (size_t)(ai * HALF + m * 16) * DM;
                float ss = 0.f;
#pragma unroll
                for (int bj = 0; bj < 2; ++bj)
#pragma unroll
                    for (int n = 0; n < 2; ++n) { const f32x4 x = acc[ai][bj][m][n] * iscale; ss += (x[0] * x[0] + x[1] * x[1]) + (x[2] * x[2] + x[3] * x[3]); }
                ss += __shfl_xor(ss, 16); ss += __shfl_xor(ss, 32);
                const float inv = (isv ? 1.f : mul * __builtin_amdgcn_rsqf(ss * (1.f / 64.f) + RMS_EPS)) * iscale;
#pragma unroll
                for (int bj = 0; bj < 2; ++bj) { const f32x4 v0 = acc[ai][bj][m][0] * inv * gv[bj][0], v1 = acc[ai][bj][m][1] * inv * gv[bj][1];
                    u32x4 w; w.x = cvt_pk_bf16(v0[0], v0[1]); w.y = cvt_pk_bf16(v0[2], v0[3]); w.z = cvt_pk_bf16(v1[0], v1[1]); w.w = cvt_pk_bf16(v1[2], v1[3]);
                    *(u32x4*)(rowp + bj * 32) = w; } }
    }
};
struct EpiSwiglu {
    static constexpr bool PERM = true;
    bf16_t* O;
    __device__ __forceinline__ void operator()(const f32x4 (&acc)[2][2][4][2], const Unit& u, int wr, int wc, int fr, int fq) const {
        bf16_t* base = O + (size_t)(u.pm * BM + wr * 64 + fr) * FF + u.pn * 128 + wc * 32 + 8 * fq;
#pragma unroll
        for (int ai = 0; ai < 2; ++ai)
#pragma unroll
            for (int m = 0; m < 4; ++m) { bf16_t* rowp = base + (size_t)(ai * HALF + m * 16) * FF;
                float o[8];
#pragma unroll
                for (int n = 0; n < 2; ++n)
#pragma unroll
                    for (int i = 0; i < 4; ++i) { const float g = acc[ai][0][m][n][i], uu = acc[ai][1][m][n][i];
                        o[n * 4 + i] = g * __builtin_amdgcn_rcpf(1.0f + __builtin_amdgcn_exp2f(-g * LOG2E)) * uu; }
                u32x4 w; w.x = cvt_pk_bf16(o[0], o[1]); w.y = cvt_pk_bf16(o[2], o[3]); w.z = cvt_pk_bf16(o[4], o[5]); w.w = cvt_pk_bf16(o[6], o[7]);
                *(u32x4*)rowp = w; }
    }
};
struct EpiSwigluF8 {
    static constexpr bool PERM = true;
    unsigned char* O;
    __device__ __forceinline__ void operator()(const f32x4 (&acc)[2][2][4][2], const Unit& u, int wr, int wc, int fr, int fq) const {
        unsigned char* base = O + (size_t)(u.pm * BM + wr * 64 + fr) * FF + u.pn * 128 + wc * 32 + 8 * fq;
#pragma unroll
        for (int ai = 0; ai < 2; ++ai)
#pragma unroll
            for (int m = 0; m < 4; ++m) { unsigned char* rowp = base + (size_t)(ai * HALF + m * 16) * FF;
                float o[8];
#pragma unroll
                for (int n = 0; n < 2; ++n)
#pragma unroll
                    for (int i = 0; i < 4; ++i) { const float g = acc[ai][0][m][n][i] * (1.0f / W8S), uu = acc[ai][1][m][n][i] * (A8S / W8S);
                        o[n * 4 + i] = g * __builtin_amdgcn_rcpf(1.0f + __builtin_amdgcn_exp2f(-g * LOG2E)) * uu; }
                v2u w; w.x = cvt4_fp8(o[0], o[1], o[2], o[3]); w.y = cvt4_fp8(o[4], o[5], o[6], o[7]);
                *(v2u*)rowp = w; }
    }
};
struct EpiResid {
    static constexpr bool PERM = false;
    const float* base; float* out; float oscale;
    __device__ __forceinline__ void operator()(const f32x4 (&acc)[2][2][4][2], const Unit& u, int wr, int wc, int fr, int fq) const {
        const size_t off0 = (size_t)(u.pm * BM + wr * 64 + fr) * DM + u.pn * BM + wc * 32 + 4 * fq;
#pragma unroll
        for (int ai = 0; ai < 2; ++ai)
#pragma unroll
            for (int m = 0; m < 4; ++m) { const size_t off = off0 + (size_t)(ai * HALF + m * 16) * DM;
#pragma unroll
                for (int bj = 0; bj < 2; ++bj)
#pragma unroll
                    for (int n = 0; n < 2; ++n) { const f32x4 b = *(const f32x4*)(base + off + bj * HALF + n * 16); *(f32x4*)(out + off + bj * HALF + n * 16) = b + acc[ai][bj][m][n] * oscale; } }
    }
};
struct EpiMoeDown {
    static constexpr bool PERM = true;
    bf16_t* Y; const float* gw; bf16_t* P; float oscale;
    __device__ __forceinline__ void operator()(const f32x4 (&acc)[2][2][4][2], const Unit& u, int wr, int wc, int fr, int fq) const {
        bf16_t* base = (u.kq < 0 ? Y + (size_t)(u.pm * BM) * DM : P + ((size_t)u.kq * SPLIT_ROWS + (size_t)(u.pm * BM - SPLIT_ROW0)) * DM) + (size_t)(wr * 64 + fr) * DM + u.pn * BM + wc * 32 + 8 * fq;
        const float* gp = gw + u.e * LCAP + u.mt * 256 + wr * 64 + fr;
#pragma unroll
        for (int ai = 0; ai < 2; ++ai)
#pragma unroll
            for (int m = 0; m < 4; ++m) { bf16_t* rowp = base + (size_t)(ai * HALF + m * 16) * DM; const float g = gp[ai * HALF + m * 16] * oscale;
#pragma unroll
                for (int bj = 0; bj < 2; ++bj) { const f32x4 v0 = acc[ai][bj][m][0] * g, v1 = acc[ai][bj][m][1] * g;
                    u32x4 w; w.x = cvt_pk_bf16(v0[0], v0[1]); w.y = cvt_pk_bf16(v0[2], v0[3]); w.z = cvt_pk_bf16(v1[0], v1[1]); w.w = cvt_pk_bf16(v1[2], v1[3]);
                    *(u32x4*)(rowp + bj * HALF) = w; } }
    }
};

template <class Epi, class Sched, bool GATHER, bool FP8 = false>
__device__ __forceinline__ void gemm_phase(PG8_LAS unsigned char* lds, const int K, const Sched& S, const Epi& E) {
    const int tid = threadIdx.x, wid = __builtin_amdgcn_readfirstlane(tid >> 6), lane = tid & 63, wr = wid >> 2, wc = wid & 3, fr = lane & 15, fq = lane >> 4;
    unsigned voffA[2], voffB[2]; int sR[2], sC[2];
#pragma unroll
    for (int i = 0; i < 2; ++i) { int R, C; stage_rc(tid * 16 + i * 8192, R, C); const int Rb = Epi::PERM ? ((R & ~31) + perm32(R & 31)) : R;
        voffA[i] = (unsigned)(R * K + C) * 2u; voffB[i] = (unsigned)(Rb * K + C) * 2u; sR[i] = R; sC[i] = C; }
    const size_t kstep = (size_t)(BK * 2);
    const size_t hstep = (size_t)HALF * K * 2;
    const unsigned ldsw = (unsigned)wid * 1024u, lds0 = (unsigned)(uintptr_t)lds;
    const int aoff = FP8 ? lds_byte(wr * 64 + fr, fq * 16) : lds_byte(wr * 64 + fr, fq * 8), boff = FP8 ? lds_byte(wc * 32 + fr, fq * 16) : lds_byte(wc * 32 + fr, fq * 8);

#define PG8_SA(b, h) (((b) * 2 + (h)) * HTB)
#define PG8_SB(b, h) ((4 + (b) * 2 + (h)) * HTB)
#define PG8_STAGE(bufoff, gbase, voff) do { const char* gb_ = uniptr((const char*)(gbase)); _Pragma("unroll") for (int _i = 0; _i < 2; ++_i) \
        glds16_s(gb_, (voff)[_i], (unsigned)__builtin_amdgcn_readfirstlane(lds0 + (unsigned)(bufoff) + ldsw + (unsigned)(_i * 8192))); } while (0)
#define PG8_STAGE_A(bufoff, p, h, VG) do { if (GATHER) { PG8_STAGE(bufoff, p, VG[h]); } else { PG8_STAGE(bufoff, (p) + ((h) ? hstep : 0), voffA); } } while (0)
#define PG8_LDA(dst, b, h) do { _Pragma("unroll") for (int m = 0; m < 4; ++m) { if constexpr (FP8) { const v4i32 x_ = *(const PG8_LAS v4i32*)(lds + PG8_SA(b, h) + aoff + m * 2048), y_ = *(const PG8_LAS v4i32*)(lds + PG8_SA(b, h) + aoff + m * 2048 + 16); dst##8[m] = __builtin_shufflevector(x_, y_, 0, 1, 2, 3, 4, 5, 6, 7); } \
        else { _Pragma("unroll") for (int k = 0; k < 2; ++k) dst[m][k] = *(const PG8_LAS bf16x8*)(lds + PG8_SA(b, h) + aoff + m * 2048 + k * 1024); } } } while (0)
#define PG8_LDB(dst, b, h) do { _Pragma("unroll") for (int n = 0; n < 2; ++n) { if constexpr (FP8) { const v4i32 x_ = *(const PG8_LAS v4i32*)(lds + PG8_SB(b, h) + boff + n * 2048), y_ = *(const PG8_LAS v4i32*)(lds + PG8_SB(b, h) + boff + n * 2048 + 16); dst##8[n] = __builtin_shufflevector(x_, y_, 0, 1, 2, 3, 4, 5, 6, 7); } \
        else { _Pragma("unroll") for (int k = 0; k < 2; ++k) dst[n][k] = *(const PG8_LAS bf16x8*)(lds + PG8_SB(b, h) + boff + n * 2048 + k * 1024); } } } while (0)
#define PG8_MMA(ai, bj, At, Bt) do { __builtin_amdgcn_s_setprio(1); _Pragma("unroll") for (int m = 0; m < 4; ++m) _Pragma("unroll") for (int n = 0; n < 2; ++n) { \
        if constexpr (FP8) asm volatile("v_mfma_scale_f32_16x16x128_f8f6f4 %0, %1, %2, %0, %3, %3 op_sel_hi:[0,0,0]" : "+v"(acc[ai][bj][m][n]) : "v"(Bt##8[n]), "v"(At##8[m]), "v"(sc8));   \
        else { _Pragma("unroll") for (int k = 0; k < 2; ++k) acc[ai][bj][m][n] = __builtin_amdgcn_mfma_f32_16x16x32_bf16(Bt[n][k], At[m][k], acc[ai][bj][m][n], 0, 0, 0); } } \
        __builtin_amdgcn_s_setprio(0); } while (0)
#define PG8_WAIT_V(n) asm volatile("s_waitcnt vmcnt(" #n ")" ::: "memory")
#define PG8_WAIT_L(n) asm volatile("s_waitcnt lgkmcnt(" #n ")" ::: "memory")
#define PG8_BAR __builtin_amdgcn_s_barrier()
#define PG8_SCHED __builtin_amdgcn_sched_barrier(0)
    Unit cur, nxt; int ui = 0;
    if (!S.next(0, cur)) return;
    f32x4 acc[2][2][4][2];
#pragma unroll
    for (int a = 0; a < 2; ++a)
#pragma unroll
        for (int b = 0; b < 2; ++b)
#pragma unroll
            for (int m = 0; m < 4; ++m)
#pragma unroll
                for (int n = 0; n < 2; ++n) acc[a][b][m][n] = (f32x4){0.f, 0.f, 0.f, 0.f};
    bf16x8 At[4][2], B0[2][2], B1[2][2];
    v8i32 At8[4], B08[2], B18[2];
    int sc8 = 0x7F7F7F7F; asm volatile("" : "+v"(sc8));
    const char* cA = S.a_base(cur); const char* cB = S.b_base(cur);
    unsigned vc[2][2] = {{0u, 0u}, {0u, 0u}}, vn[2][2] = {{0u, 0u}, {0u, 0u}};
    if (GATHER) { S.a_voff(cur, sR, sC, vc); asm volatile("s_waitcnt vmcnt(0)" : "+v"(vc[0][0]), "+v"(vc[0][1]), "+v"(vc[1][0]), "+v"(vc[1][1]) :: "memory"); }
    PG8_STAGE(PG8_SB(0, 0), cB, voffB); PG8_STAGE(PG8_SB(0, 1), cB + hstep, voffB); PG8_STAGE_A(PG8_SA(0, 0), cA, 0, vc); PG8_STAGE_A(PG8_SA(0, 1), cA, 1, vc);
    if (wr == 1) PG8_BAR;
    PG8_WAIT_V(2); PG8_BAR;
    PG8_STAGE(PG8_SB(1, 0), cB + kstep, voffB); PG8_STAGE_A(PG8_SA(1, 0), cA + kstep, 0, vc); PG8_STAGE(PG8_SB(1, 1), cB + hstep + kstep, voffB);
    PG8_WAIT_V(6); PG8_BAR;
    for (;;) {
        const bool has_next = S.next(ui + 1, nxt);
        const char* nA = has_next ? S.a_base(nxt) : cA; const char* nB = has_next ? S.b_base(nxt) : cB;
        if (GATHER) {
            if (has_next) { S.a_voff(nxt, sR, sC, vn); asm volatile("s_waitcnt vmcnt(0)" : "+v"(vn[0][0]), "+v"(vn[0][1]), "+v"(vn[1][0]), "+v"(vn[1][1]) :: "memory"); }
            else { vn[0][0] = vc[0][0]; vn[0][1] = vc[0][1]; vn[1][0] = vc[1][0]; vn[1][1] = vc[1][1]; }
        }
        const int nt = cur.nt;
        for (int t = 0; t < nt; t += 2) {
            const bool last = (t == nt - 2);
            const char* a1 = cA + (size_t)(t + 1) * kstep;
            const char* a2 = last ? nA : cA + (size_t)(t + 2) * kstep; const char* b2 = last ? nB : cB + (size_t)(t + 2) * kstep;
            const char* a3 = a2 + kstep; const char* b3 = b2 + kstep;
            unsigned v2[2][2];
#pragma unroll
            for (int h = 0; h < 2; ++h)
#pragma unroll
                for (int i = 0; i < 2; ++i) v2[h][i] = last ? vn[h][i] : vc[h][i];
            PG8_LDB(B0, 0, 0); PG8_LDB(B1, 0, 1); PG8_SCHED; PG8_LDA(At, 0, 0); PG8_STAGE_A(PG8_SA(1, 1), a1, 1, vc);
            PG8_WAIT_V(8); PG8_WAIT_L(0); PG8_BAR; PG8_MMA(0, 0, At, B0); PG8_MMA(0, 1, At, B1); PG8_BAR; PG8_SCHED;
            PG8_LDA(At, 0, 1); PG8_STAGE(PG8_SB(0, 0), b2, voffB); PG8_STAGE(PG8_SB(0, 1), b2 + hstep, voffB); PG8_STAGE_A(PG8_SA(0, 0), a2, 0, v2);
            PG8_WAIT_V(8); PG8_WAIT_L(0); PG8_BAR; PG8_MMA(1, 0, At, B0); PG8_MMA(1, 1, At, B1); PG8_BAR; PG8_SCHED;
            PG8_LDB(B0, 1, 0); PG8_LDB(B1, 1, 1); PG8_SCHED; PG8_LDA(At, 1, 0); PG8_STAGE_A(PG8_SA(0, 1), a2, 1, v2);
            PG8_WAIT_V(8); PG8_WAIT_L(0); PG8_BAR; PG8_MMA(0, 0, At, B0); PG8_MMA(0, 1, At, B1); PG8_BAR; PG8_SCHED;
            PG8_LDA(At, 1, 1); PG8_STAGE(PG8_SB(1, 0), b3, voffB); PG8_STAGE(PG8_SB(1, 1), b3 + hstep, voffB); PG8_STAGE_A(PG8_SA(1, 0), a3, 0, v2);
            PG8_WAIT_V(8); PG8_WAIT_L(0); PG8_BAR; PG8_MMA(1, 0, At, B0); PG8_MMA(1, 1, At, B1); PG8_BAR; PG8_SCHED;
        }
        if (wr == 0) PG8_BAR;
        if constexpr (FP8) asm volatile("s_nop 15\n\ts_nop 15" ::: "memory");
        { int fr_ = fr, fq_ = fq; asm volatile("" : "+v"(fr_), "+v"(fq_)); E(acc, cur, wr, wc, fr_, fq_); }
        if (!has_next) break;
#pragma unroll
        for (int a = 0; a < 2; ++a)
#pragma unroll
            for (int b = 0; b < 2; ++b)
#pragma unroll
                for (int m = 0; m < 4; ++m)
#pragma unroll
                    for (int n = 0; n < 2; ++n) acc[a][b][m][n] = (f32x4){0.f, 0.f, 0.f, 0.f};
        cur = nxt; cA = nA; cB = nB; ++ui;
        if (GATHER) { vc[0][0] = vn[0][0]; vc[0][1] = vn[0][1]; vc[1][0] = vn[1][0]; vc[1][1] = vn[1][1]; }
        if (wr == 1) PG8_BAR;
    }
    PG8_WAIT_V(0);
    PG8_BAR;
#undef PG8_SA
#undef PG8_SB
#undef PG8_STAGE
#undef PG8_STAGE_A
#undef PG8_LDA
#undef PG8_LDB
#undef PG8_MMA
#undef PG8_WAIT_V
#undef PG8_WAIT_L
#undef PG8_BAR
#undef PG8_SCHED
}
}

namespace att {
typedef short bf16x8 __attribute__((ext_vector_type(8)));
typedef short s16x4 __attribute__((ext_vector_type(4)));
typedef float f32x16 __attribute__((ext_vector_type(16)));
typedef unsigned u32x4 __attribute__((ext_vector_type(4)));
typedef LAS char* lptr;
constexpr int SLOTB = 8192, NSLOT = 6, AHEAD = 4;
constexpr int L_K = 0, L_V = NSLOT * SLOTB, L_WS = 2 * NSLOT * SLOTB, L_OST = L_WS + 8 * 256, L_KB = L_OST + 8 * 4096, L_FLG = L_KB + 8192, L_END = L_FLG + 256;
static_assert(L_END <= ATT_LDS_MAX, "attention LDS map");
constexpr float THR = 8.0f;
__device__ __forceinline__ int crow(int r, int hi) { return (r & 3) + 8 * (r >> 2) + 4 * hi; }
__device__ __forceinline__ void glds16(const void* gsrc, unsigned lds_dst) { unsigned keep;
    asm volatile("s_mov_b32 %0, m0\n\ts_mov_b32 m0, %2\n\ts_nop 0\n\tglobal_load_lds_dwordx4 %1, off\n\ts_mov_b32 m0, %0" : "=&s"(keep) : "v"(gsrc), "s"(lds_dst) : "memory"); }
typedef float f32x2_t __attribute__((ext_vector_type(2))); typedef __bf16 bf16x2_t __attribute__((ext_vector_type(2)));
__device__ __forceinline__ unsigned cvtpk(float lo, float hi) { f32x2_t v = {lo, hi}; bf16x2_t b = __builtin_convertvector(v, bf16x2_t); return __builtin_bit_cast(unsigned, b); }
__device__ __forceinline__ bf16x8 gload16(const void* p) { bf16x8 v; asm volatile("global_load_dwordx4 %0, %1, off" : "=v"(v) : "v"(p) : "memory"); return v; }
__device__ __forceinline__ float max3f(float a, float b, float c) { return __builtin_fmaxf(__builtin_fmaxf(a, b), c); }
__device__ __forceinline__ void wait_bar(int n) {
    if (n >= 6) asm volatile("s_waitcnt vmcnt(6) lgkmcnt(0)\n\ts_barrier" ::: "memory");
    else if (n >= 4) asm volatile("s_waitcnt vmcnt(4) lgkmcnt(0)\n\ts_barrier" ::: "memory");
    else if (n >= 2) asm volatile("s_waitcnt vmcnt(2) lgkmcnt(0)\n\ts_barrier" ::: "memory");
    else asm volatile("s_waitcnt vmcnt(0) lgkmcnt(0)\n\ts_barrier" ::: "memory");
}
__device__ __forceinline__ float other_half(float x, int hi) {
    auto rr = __builtin_amdgcn_permlane32_swap(__float_as_uint(x), __float_as_uint(x), false, false);
    return __uint_as_float(hi ? rr[0] : rr[1]);
}
__device__ __forceinline__ void qkt(f32x16& p0, f32x16& p1, lptr Kslot, const bf16x8* qr, const f32x16& c0, const f32x16& c1, int r32, int hi) {
    lptr kb = Kslot + hi * 1024 + r32 * 16;
#pragma unroll
    for (int d0 = 0; d0 < 4; ++d0) {
        const bf16x8 b0 = *(const LAS bf16x8*)(kb + d0 * 2048);
        const bf16x8 b1 = *(const LAS bf16x8*)(kb + d0 * 2048 + 512);
        if (d0 == 0) { p0 = __builtin_amdgcn_mfma_f32_32x32x16_bf16(b0, qr[0], c0, 0, 0, 0); p1 = __builtin_amdgcn_mfma_f32_32x32x16_bf16(b1, qr[0], c1, 0, 0, 0); }
        else { p0 = __builtin_amdgcn_mfma_f32_32x32x16_bf16(b0, qr[d0], p0, 0, 0, 0); p1 = __builtin_amdgcn_mfma_f32_32x32x16_bf16(b1, qr[d0], p1, 0, 0, 0); } }
}
__device__ __forceinline__ void pv(f32x16* o, int vb, bf16x8 pa0, bf16x8 pa1, bf16x8 pa2, bf16x8 pa3) {
#pragma unroll
    for (int d0 = 0; d0 < 2; ++d0) { s16x4 lo[4], hi[4];
#pragma unroll
        for (int ks = 0; ks < 4; ++ks) {
            asm volatile("ds_read_b64_tr_b16 %0,%1 offset:%c2" : "=&v"(lo[ks]) : "v"(vb), "i"(d0 * 4096 + ks * 1024) : "memory");
            asm volatile("ds_read_b64_tr_b16 %0,%1 offset:%c2" : "=&v"(hi[ks]) : "v"(vb), "i"(d0 * 4096 + ks * 1024 + 512) : "memory"); }
        asm volatile("s_waitcnt lgkmcnt(0)" ::: "memory"); __builtin_amdgcn_sched_barrier(0);
#define ATT_PK(k) (bf16x8){lo[k][0], lo[k][1], lo[k][2], lo[k][3], hi[k][0], hi[k][1], hi[k][2], hi[k][3]}
        o[d0] = __builtin_amdgcn_mfma_f32_32x32x16_bf16(pa0, ATT_PK(0), o[d0], 0, 0, 0);
        o[d0] = __builtin_amdgcn_mfma_f32_32x32x16_bf16(pa1, ATT_PK(1), o[d0], 0, 0, 0);
        o[d0] = __builtin_amdgcn_mfma_f32_32x32x16_bf16(pa2, ATT_PK(2), o[d0], 0, 0, 0);
        o[d0] = __builtin_amdgcn_mfma_f32_32x32x16_bf16(pa3, ATT_PK(3), o[d0], 0, 0, 0);
#undef ATT_PK
    }
}
__device__ __forceinline__ void pack_pv(f32x16* o, int vb, const f32x16& p0, const f32x16& p1) {
    u32x4 w0, w1, w2, w3;
#pragma unroll
    for (int j = 0; j < 4; ++j) { w0[j] = cvtpk(p0[2 * j], p0[2 * j + 1]); w1[j] = cvtpk(p0[8 + 2 * j], p0[8 + 2 * j + 1]); w2[j] = cvtpk(p1[2 * j], p1[2 * j + 1]); w3[j] = cvtpk(p1[8 + 2 * j], p1[8 + 2 * j + 1]); }
    pv(o, vb, __builtin_bit_cast(bf16x8, w0), __builtin_bit_cast(bf16x8, w1), __builtin_bit_cast(bf16x8, w2), __builtin_bit_cast(bf16x8, w3));
}
__device__ __forceinline__ float rowmax32(const f32x16& p0, const f32x16& p1, int hi) {
    float a = max3f(p0[0], p0[1], p1[0]), b = max3f(p0[2], p0[3], p1[1]); a = max3f(a, p1[2], p1[3]);
#pragma unroll
    for (int r = 4; r < 16; r += 4) { a = max3f(a, p0[r], p0[r + 1]); b = max3f(b, p0[r + 2], p0[r + 3]); a = max3f(a, p1[r], p1[r + 1]); b = max3f(b, p1[r + 2], p1[r + 3]); }
    a = fmaxf(a, b);
    return fmaxf(a, other_half(a, hi));
}
__device__ __forceinline__ void store_o(const f32x16* o, const float* sc, lptr stgb, bf16* Ow, long rpitch, int lane, int r32, int hi) {
    LAS bf16* stg = (LAS bf16*)stgb;
#pragma unroll
    for (int r = 0; r < 16; ++r) { const int orow = crow(r, hi);
#pragma unroll
        for (int d0 = 0; d0 < 2; ++d0) stg[orow * 64 + d0 * 32 + r32] = (bf16)f2bf(o[d0][r] * sc[r]); }
    asm volatile("s_waitcnt lgkmcnt(0)" ::: "memory");
#pragma unroll
    for (int i = 0; i < 4; ++i) { const int row = i * 8 + (lane >> 3), ch = lane & 7; const u32x4 v = *(const LAS u32x4*)(stg + row * 64 + ch * 8); *(u32x4*)(Ow + (long)row * rpitch + ch * 8) = v; }
}
__device__ __forceinline__ void softmax_step(f32x16& p0, f32x16& p1, float& mref, float& lsum, f32x16* o, LAS float* wsf, int r32, int hi) {
    const float rm = rowmax32(p0, p1, hi);
    const bool fresh = mref <= -1e30f;
    const bool want = !fresh && (rm > mref + THR);
    if (fresh) mref = fmaxf(rm, -1e30f);
    if (__any(want)) {
        const float dl = want ? rm - mref : 0.f; mref += dl; const float f = __builtin_amdgcn_exp2f(-dl); lsum *= f;
        if (hi == 0) wsf[r32] = f;
        asm volatile("s_waitcnt lgkmcnt(0)" ::: "memory");
#pragma unroll
        for (int r = 0; r < 16; ++r) { const float fr = wsf[crow(r, hi)]; o[0][r] *= fr; o[1][r] *= fr; }
    }
    float sa = 0.f, sb = 0.f;
#pragma unroll
    for (int r = 0; r < 16; ++r) { p0[r] = __builtin_amdgcn_exp2f(p0[r] - mref); p1[r] = __builtin_amdgcn_exp2f(p1[r] - mref); sa += p0[r]; sb += p1[r]; }
    lsum += sa + sb;
}

struct WaveCtx { int lane, r32, hi, wid; unsigned lds0; int vb0; lptr shm; };
struct UnitD { int NT; int b, h, qb, g, x; };

template <int MODE> struct CausalMode {
    const bf16* Q; const bf16* K; const bf16* V; bf16* O; int b, h, p;
    float carry, mref, lsum; int done;
    __device__ __forceinline__ int units() const { return 4; }
    __device__ __forceinline__ void desc(int j, UnitD& d) const { d.b = b; d.h = h; d.qb = (j == 0) ? 7 - p : (j == 1) ? 5 - p : (j == 2) ? 2 + p : p; d.NT = 4 * (d.qb + 1); d.g = 0; d.x = 0; }
    __device__ __forceinline__ int tile_of(const UnitD& d, int k) const { return MODE == 0 ? d.NT - 1 - k : k; }
    __device__ __forceinline__ void q_load(const UnitD& d, const WaveCtx& w, bf16x8 (&q)[4]) const {
        const bf16* Qw = Q + ((long)d.b * SEQ + d.qb * 256 + w.wid * 32 + w.r32) * DM + d.h * 64 + w.hi * 8;
#pragma unroll
        for (int d0 = 0; d0 < 4; ++d0) q[d0] = gload16(Qw + d0 * 16);
    }
    __device__ __forceinline__ void dma(const UnitD& d, int k, int slot, const WaveCtx& w) const {
        const long row0 = (long)d.b * SEQ + 64 * tile_of(d, k);
        glds16(K + (row0 + w.lane) * DM + d.h * 64 + w.wid * 8, (unsigned)__builtin_amdgcn_readfirstlane(w.lds0 + L_K + slot * SLOTB + w.wid * 1024));
        glds16(V + (row0 + 16 * (w.wid & 3) + (w.lane >> 2)) * DM + d.h * 64 + (w.wid >> 2) * 32 + (w.lane & 3) * 8, (unsigned)__builtin_amdgcn_readfirstlane(w.lds0 + L_V + slot * SLOTB + w.wid * 1024));
    }
    __device__ __forceinline__ void begin(const UnitD&, const WaveCtx&) { carry = 1.0f; mref = -1e30f; lsum = 0.f; done = 0; }
    __device__ __forceinline__ int wave_done() const { return done; }
    __device__ __forceinline__ void compute(const UnitD& d, int k, int slot, const WaveCtx& w, const bf16x8* qr, f32x16* o) {
        const int T = tile_of(d, k), qfirst = d.qb * 256 + w.wid * 32, qpos = qfirst + w.r32;
        if (MODE == 0) {
            if (done || 64 * T >= qfirst + 31) return;
            f32x16 p0, p1; const f32x16 z = {}; qkt(p0, p1, w.shm + L_K + slot * SLOTB, qr, z, z, w.r32, w.hi);
            const bool diag = 64 * T + 63 >= qfirst;
            float ga[8];
#pragma unroll
            for (int a = 0; a < 8; ++a) {
                float rr[4];
#pragma unroll
                for (int i = 0; i < 4; ++i) { const int r = 4 * (a & 3) + i; const float zz = (a < 4) ? p0[r] : p1[r];
                    const float e = __builtin_amdgcn_exp2f(fminf(zz, 120.f)); float rv = __builtin_amdgcn_rcpf(1.0f + e);
                    if (diag) { const int kv = 64 * T + crow(r, w.hi) + ((a < 4) ? 0 : 32); if (kv >= qpos) rv = 1.0f; }
                    rr[i] = rv; if (a < 4) p0[r] = rv; else p1[r] = rv; }
                ga[a] = (rr[0] * rr[1]) * (rr[2] * rr[3]);
            }
            float oth[8], Ts[8];
#pragma unroll
            for (int a = 0; a < 8; ++a) oth[a] = other_half(ga[a], w.hi);
            float run = 1.0f;
#pragma unroll
            for (int a = 7; a >= 0; --a) { Ts[a] = run; run *= ga[a] * oth[a]; }
#pragma unroll
            for (int a = 0; a < 8; ++a) {
                float E = carry * Ts[a] * (w.hi ? 1.0f : oth[a]);
#pragma unroll
                for (int i = 3; i >= 0; --i) { const int r = 4 * (a & 3) + i; const float rv = (a < 4) ? p0[r] : p1[r]; const float wt = (1.0f - rv) * E; E *= rv; if (a < 4) p0[r] = wt; else p1[r] = wt; }
            }
            carry *= run;
            pack_pv(o, w.vb0 + slot * SLOTB, p0, p1);
            if (__all(carry < 1e-30f)) done = 1;
        } else {
            if (64 * T > qfirst + 31) return;
            LAS float* kbl = (LAS float*)(w.shm + L_KB);
            f32x16 c0, c1;
#pragma unroll
            for (int g = 0; g < 4; ++g) { const f32x4 k0 = *(const LAS f32x4*)(kbl + 64 * T + 8 * g + 4 * w.hi), k1 = *(const LAS f32x4*)(kbl + 64 * T + 32 + 8 * g + 4 * w.hi);
#pragma unroll
                for (int i = 0; i < 4; ++i) { c0[4 * g + i] = k0[i]; c1[4 * g + i] = k1[i]; } }
            f32x16 p0, p1; qkt(p0, p1, w.shm + L_K + slot * SLOTB, qr, c0, c1, w.r32, w.hi);
            if (64 * T + 63 > qfirst) {
#pragma unroll
                for (int r = 0; r < 16; ++r) { const int kv = 64 * T + crow(r, w.hi); if (kv > qpos) p0[r] = -INFINITY; if (kv + 32 > qpos) p1[r] = -INFINITY; } }
            softmax_step(p0, p1, mref, lsum, o, (LAS float*)(w.shm + L_WS) + w.wid * 64, w.r32, w.hi);
            pack_pv(o, w.vb0 + slot * SLOTB, p0, p1);
        }
    }
    __device__ __forceinline__ void finish(const UnitD& d, const WaveCtx& w, const f32x16* o) {
        LAS float* wsf = (LAS float*)(w.shm + L_WS) + w.wid * 64;
        float sc[16];
        if (MODE == 0) {
#pragma unroll
            for (int r = 0; r < 16; ++r) sc[r] = 1.0f;
        } else {
            float lt = lsum + other_half(lsum, w.hi);
            if (w.hi == 0) wsf[32 + w.r32] = lt;
            asm volatile("s_waitcnt lgkmcnt(0)" ::: "memory");
#pragma unroll
            for (int r = 0; r < 16; ++r) sc[r] = __builtin_amdgcn_rcpf(wsf[32 + crow(r, w.hi)]);
        }
        store_o(o, sc, w.shm + L_OST + w.wid * 4096, O + ((long)d.b * SEQ + d.qb * 256 + w.wid * 32) * DM + d.h * 64, DM, w.lane, w.r32, w.hi);
    }
};

struct DilMode {
    const bf16* PROJ; bf16* OG; float* ST; int b, h, p;
    float mref, lsum;
    __device__ __forceinline__ int units() const { return 12; }
    __device__ __forceinline__ void desc(int j, UnitD& d) const {
        const int g = j >> 2, i = j & 3; d.g = g; d.b = b; d.h = h; d.qb = 0;
        d.x = (g == 1) ? ((2 * (i >> 1) + p) << 1) + (i & 1) : 2 * i + p;
        const int i0 = (g == 0) ? 256 * d.x : (g == 1) ? 256 * (d.x & 1) : 0;
        d.NT = (g == 2) ? 4 : ((i0 >> 6) + 4 - t_lo(g, i0));
    }
    static __device__ __forceinline__ int t_lo(int g, int i0) { return (g == 2) ? 0 : ((i0 >> 6) >= 2 ? (i0 >> 6) - 2 : 0); }
    static __device__ __forceinline__ int dil_of(int g) { return (g == 0) ? 1 : (g == 1) ? 4 : 16; }
    static __device__ __forceinline__ int cls0_of(int g, int x) { return (g == 0) ? 0 : (g == 1) ? (x >> 1) : 2 * x; }
    static __device__ __forceinline__ int i0_of(int g, int x) { return (g == 0) ? 256 * x : (g == 1) ? 256 * (x & 1) : 0; }
    static __device__ __forceinline__ int tcls(int g, int x, int k) { return cls0_of(g, x) + ((g == 2) ? (k >> 1) : 0); }
    static __device__ __forceinline__ int kbase(int g, int x, int k) { return (g == 2) ? 64 * (k & 1) : 64 * (t_lo(g, i0_of(g, x)) + k); }
    __device__ __forceinline__ void q_load(const UnitD& d, const WaveCtx& w, bf16x8 (&q)[4]) const {
        const int dil = dil_of(d.g), clsw = cls0_of(d.g, d.x) + ((d.g == 2) ? (w.wid >> 2) : 0), qi0w = (d.g == 2) ? 32 * (w.wid & 3) : i0_of(d.g, d.x) + 32 * w.wid;
        const bf16* Qw = PROJ + (size_t)(2 * d.g) * PLANE + ((long)d.b * SEQ + clsw + (long)(qi0w + w.r32) * dil) * DM + d.h * 64 + w.hi * 8;
#pragma unroll
        for (int d0 = 0; d0 < 4; ++d0) q[d0] = gload16(Qw + d0 * 16);
    }
    __device__ __forceinline__ void dma(const UnitD& d, int k, int slot, const WaveCtx& w) const {
        const int dil = dil_of(d.g); const long tok0 = (long)d.b * SEQ + tcls(d.g, d.x, k) + (long)kbase(d.g, d.x, k) * dil;
        glds16(PROJ + (size_t)(2 * d.g + 1) * PLANE + (tok0 + (long)w.lane * dil) * DM + d.h * 64 + w.wid * 8, (unsigned)__builtin_amdgcn_readfirstlane(w.lds0 + L_K + slot * SLOTB + w.wid * 1024));
        glds16(PROJ + (size_t)6 * PLANE + (tok0 + (long)(16 * (w.wid & 3) + (w.lane >> 2)) * dil) * DM + d.h * 64 + (w.wid >> 2) * 32 + (w.lane & 3) * 8, (unsigned)__builtin_amdgcn_readfirstlane(w.lds0 + L_V + slot * SLOTB + w.wid * 1024));
    }
    __device__ __forceinline__ void begin(const UnitD&, const WaveCtx&) { mref = -1e30f; lsum = 0.f; }
    __device__ __forceinline__ int wave_done() const { return 0; }
    __device__ __forceinline__ void compute(const UnitD& d, int k, int slot, const WaveCtx& w, const bf16x8* qr, f32x16* o) {
        const int clsw = cls0_of(d.g, d.x) + ((d.g == 2) ? (w.wid >> 2) : 0), qi0w = (d.g == 2) ? 32 * (w.wid & 3) : i0_of(d.g, d.x) + 32 * w.wid;
        const int kb = kbase(d.g, d.x, k);
        if (tcls(d.g, d.x, k) != clsw || kb > qi0w + 31 || kb < qi0w - 191) return;
        LAS float* tbl = (LAS float*)(w.shm + L_KB) + d.g * 640 + 256;
        const int dbase = qi0w + w.r32 - kb - 4 * w.hi;
        f32x16 c0, c1;
#pragma unroll
        for (int r = 0; r < 16; ++r) { const int cr = (r & 3) + 8 * (r >> 2); c0[r] = tbl[dbase - cr]; c1[r] = tbl[dbase - cr - 32]; }
        f32x16 p0, p1; qkt(p0, p1, w.shm + L_K + slot * SLOTB, qr, c0, c1, w.r32, w.hi);
        softmax_step(p0, p1, mref, lsum, o, (LAS float*)(w.shm + L_WS) + w.wid * 64, w.r32, w.hi);
        pack_pv(o, w.vb0 + slot * SLOTB, p0, p1);
    }
    __device__ __forceinline__ void finish(const UnitD& d, const WaveCtx& w, const f32x16* o) {
        const int dil = dil_of(d.g), clsw = cls0_of(d.g, d.x) + ((d.g == 2) ? (w.wid >> 2) : 0), qi0w = (d.g == 2) ? 32 * (w.wid & 3) : i0_of(d.g, d.x) + 32 * w.wid;
        LAS float* wsf = (LAS float*)(w.shm + L_WS) + w.wid * 64;
        const float lt = lsum + other_half(lsum, w.hi);
        if (w.hi == 0) { wsf[32 + w.r32] = lt;
            const long tok = (long)d.b * SEQ + clsw + (long)(qi0w + w.r32) * dil;
            *(f32x2*)(ST + ((size_t)d.g * M * NH + (size_t)tok * NH + d.h) * 2) = (f32x2){mref, lt}; }
        asm volatile("s_waitcnt lgkmcnt(0)" ::: "memory");
        float sc[16];
#pragma unroll
        for (int r = 0; r < 16; ++r) sc[r] = __builtin_amdgcn_rcpf(wsf[32 + crow(r, w.hi)]);
        store_o(o, sc, w.shm + L_OST + w.wid * 4096, OG + (size_t)d.g * PLANE + ((long)d.b * SEQ + clsw + (long)qi0w * dil) * DM + d.h * 64, (long)dil * DM, w.lane, w.r32, w.hi);
    }
};

template <class Mode, bool EARLY_EXIT>
__device__ __forceinline__ void stream_units(Mode& Mo, const WaveCtx& w) {
    LAS int* flg = (LAS int*)(w.shm + L_FLG);
    const int nun = Mo.units();
    int pj = 0, pk = 0, pseq = 0, cseq = 0;
    UnitD pd; Mo.desc(0, pd);
    bf16x8 qn[4];
    if (EARLY_EXIT && w.wid == 0 && w.lane < 4) flg[w.lane] = 0;
    asm volatile("s_waitcnt vmcnt(0)" ::: "memory");
#define ATT_PRODUCE() do { if (pj < nun) { if (pk == 0) Mo.q_load(pd, w, qn); Mo.dma(pd, pk, pseq % NSLOT, w); ++pseq; if (++pk == pd.NT) { pk = 0; if (++pj < nun) Mo.desc(pj, pd); } } } while (0)
#pragma unroll 1
    for (int i = 0; i < AHEAD; ++i) ATT_PRODUCE();
#pragma unroll 1
    for (int cj = 0; cj < nun; ++cj) {
        UnitD d; Mo.desc(cj, d);
        bf16x8 qr[4];
        f32x16 o[2]; o[0] = f32x16{}; o[1] = f32x16{};
        Mo.begin(d, w);
        const int useq0 = cseq;
        int rep = 0;
#pragma unroll 1
        while (pseq - cseq < AHEAD && pj < nun) ATT_PRODUCE();
#pragma unroll 1
        for (int ck = 0; ck < d.NT; ++ck) {
            wait_bar(2 * (pseq - cseq - 1));
            if (ck == 0) { asm volatile("" : "+v"(qn[0]), "+v"(qn[1]), "+v"(qn[2]), "+v"(qn[3])); qr[0] = qn[0]; qr[1] = qn[1]; qr[2] = qn[2]; qr[3] = qn[3]; }
            if (EARLY_EXIT && ck == 1 && w.wid == 0 && w.lane < 2) flg[((cj + 1) & 1) * 2 + w.lane] = 0;
            if (EARLY_EXIT && ck > 0) {
                if (__builtin_amdgcn_readfirstlane(flg[(cj & 1) * 2 + ((ck - 1) & 1)]) == 8) {
                    const int uend = useq0 + d.NT;
                    if (pj == cj) { pk = 0; if (++pj < nun) Mo.desc(pj, pd); }
                    cseq = uend < pseq ? uend : pseq;
                    break; } }
            if (pseq - cseq < AHEAD) ATT_PRODUCE();
            Mo.compute(d, ck, cseq % NSLOT, w, qr, o);
            if (EARLY_EXIT && Mo.wave_done() && rep < 2) { if (w.lane == 0) __hip_atomic_fetch_add(&flg[(cj & 1) * 2 + (ck & 1)], 1, __ATOMIC_RELAXED, __HIP_MEMORY_SCOPE_WORKGROUP); ++rep; }
            ++cseq;
        }
        Mo.finish(d, w, o);
    }
    asm volatile("s_waitcnt vmcnt(0) lgkmcnt(0)\n\ts_barrier" ::: "memory");
#undef ATT_PRODUCE
}
__device__ __forceinline__ WaveCtx make_ctx(lptr shm) {
    WaveCtx w; const int tid = threadIdx.x; w.lane = tid & 63; w.r32 = w.lane & 31; w.hi = w.lane >> 5; w.wid = __builtin_amdgcn_readfirstlane(tid >> 6);
    w.shm = shm; w.lds0 = (unsigned)(uintptr_t)shm;
    w.vb0 = (int)(w.lds0 + L_V) + ((w.lane >> 4) & 1) * 32 + (w.lane & 3) * 8 + (4 * w.hi + ((w.lane & 15) >> 2)) * 64;
    return w;
}
template <int MODE>
__device__ __forceinline__ void causal_phase(lptr shm, int G, const bf16* Q, const bf16* K, const bf16* V, bf16* O, const float* cum) {
    const int bx = blockIdx.x; const int vcu = (G % 8 == 0) ? (bx % 8) * (G / 8) + bx / 8 : bx;
    const WaveCtx w = make_ctx(shm);
    for (int u = vcu; u < BATCH * NH * 2; u += G) {
        CausalMode<MODE> Mo; Mo.Q = Q; Mo.K = K; Mo.V = V; Mo.O = O; Mo.b = u >> 5; Mo.h = (u >> 1) & 15; Mo.p = u & 1;
        if (MODE == 2) {
            LAS float* kbl = (LAS float*)(shm + L_KB); LAS float* wtot = (LAS float*)(shm + L_FLG + 64);
            const int t4 = threadIdx.x * 4; float v0, v1, v2, v3;
            { const float* lp = cum + ((long)Mo.b * SEQ + t4) * 16 + Mo.h; v0 = lp[0]; v1 = lp[16]; v2 = lp[32]; v3 = lp[48]; }
            v1 += v0; v2 += v1; v3 += v2;
            float incl = v3;
#pragma unroll
            for (int o = 1; o < 64; o <<= 1) { const float t = __shfl_up(incl, o); if (w.lane >= o) incl += t; }
            if (w.lane == 63) wtot[w.wid] = incl;
            __syncthreads();
            float off = incl - v3;
#pragma unroll
            for (int x = 0; x < 8; ++x) off += (x < w.wid) ? wtot[x] : 0.f;
            *(LAS f32x4*)(kbl + t4) = (f32x4){-(off + v0), -(off + v1), -(off + v2), -(off + v3)};
        }
        stream_units<CausalMode<MODE>, MODE == 0>(Mo, w);
    }
}
__device__ __forceinline__ int t5_bucket_f(int dist) {
    if (dist < 16) return dist;
    int lb = 16 + (int)(logf((float)dist / 16.0f) / logf(128.0f) * 16.0f);
    return lb < 31 ? lb : 31;
}
__device__ __forceinline__ void dil_phase(lptr shm, int G, const bf16* PROJ, bf16* OG, float* ST, const float* rel_bias) {
    const int bx = blockIdx.x; const int vcu = (G % 8 == 0) ? (bx % 8) * (G / 8) + bx / 8 : bx;
    const WaveCtx w = make_ctx(shm);
    for (int u = vcu; u < BATCH * NH * 2; u += G) {
        DilMode Mo; Mo.PROJ = PROJ; Mo.OG = OG; Mo.ST = ST; Mo.b = u >> 5; Mo.h = (u >> 1) & 15; Mo.p = u & 1;
        LAS float* tb = (LAS float*)(shm + L_KB);
        for (int i = threadIdx.x; i < 3 * 640; i += NTHR) { const int gg = i / 640, dl = i - gg * 640 - 256; const int dil = (gg == 0) ? 1 : (gg == 1) ? 4 : 16;
            tb[i] = (dl >= 0 && dl <= 128) ? rel_bias[t5_bucket_f(dl * dil) * 16 + Mo.h] * LOG2E : -INFINITY; }
        stream_units<DilMode, false>(Mo, w);
    }
}
__device__ __forceinline__ void dil_merge(int G, const bf16* OG, const float* ST, bf16* O) {
    for (int idx = blockIdx.x * NTHR + threadIdx.x; idx < M * NH; idx += G * NTHR) {
        const f32x2 s0 = *(const f32x2*)(ST + ((size_t)0 * M * NH + idx) * 2), s1 = *(const f32x2*)(ST + ((size_t)1 * M * NH + idx) * 2), s2 = *(const f32x2*)(ST + ((size_t)2 * M * NH + idx) * 2);
        const float mx = fmaxf(s0.x, fmaxf(s1.x, s2.x));
        float w0 = __builtin_amdgcn_exp2f(s0.x - mx) * s0.y, w1 = __builtin_amdgcn_exp2f(s1.x - mx) * s1.y, w2 = __builtin_amdgcn_exp2f(s2.x - mx) * s2.y;
        const float inv = 1.0f / (w0 + w1 + w2); w0 *= inv; w1 *= inv; w2 *= inv;
        const GAS v4u* a0 = (const GAS v4u*)(OG + (size_t)idx * 64); const GAS v4u* a1 = (const GAS v4u*)(OG + PLANE + (size_t)idx * 64); const GAS v4u* a2 = (const GAS v4u*)(OG + 2 * PLANE + (size_t)idx * 64);
        GAS v4u* op = (GAS v4u*)(O + (size_t)idx * 64);
#pragma unroll
        for (int c = 0; c < 8; ++c) { const v4u x0 = a0[c], x1 = a1[c], x2 = a2[c]; v4u r;
#pragma unroll
            for (int q = 0; q < 4; ++q) r[q] = pk2(w0 * bflo(x0[q]) + w1 * bflo(x1[q]) + w2 * bflo(x2[q]), w0 * bfhi(x0[q]) + w1 * bfhi(x1[q]) + w2 * bfhi(x2[q]));
            op[c] = r; }
    }
}
}

enum { CV_PLAIN = 0, CV_QKN = 1, CV_GATE = 2, CV_UP = 3 };
__device__ __forceinline__ int cv_dst_row(int mode, int n) {
    if (mode == CV_QKN) return (n & ~255) + 128 * ((n >> 5) & 1) + 32 * ((n >> 6) & 3) + (n & 31);
    if (mode == CV_GATE) return 256 * (n >> 7) + (n & 127);
    if (mode == CV_UP) return 256 * (n >> 7) + 128 + (n & 127);
    return n;
}
__device__ __forceinline__ void conv_item(const float* W, int ldw, int K, bf16* WT, int mode, LAS unsigned char* scr, int item, int nblk, int lane) {
    const int kb = item / nblk, nb = item - kb * nblk, k0 = 64 * kb, n0 = 64 * nb;
    const GAS float* src = (const GAS float*)(W + (size_t)k0 * ldw + n0 + lane);
#pragma unroll
    for (int kc = 0; kc < 8; ++kc) {
        float v[8];
#pragma unroll
        for (int j = 0; j < 8; ++j) v[j] = src[(size_t)(kc * 8 + j) * ldw];
        v4u w; w.x = pk2(v[0], v[1]); w.y = pk2(v[2], v[3]); w.z = pk2(v[4], v[5]); w.w = pk2(v[6], v[7]);
        *(LAS v4u*)(scr + lane * 144 + kc * 16) = w;
    }
    asm volatile("s_waitcnt lgkmcnt(0)" ::: "memory");
#pragma unroll
    for (int j = 0; j < 8; ++j) { const int n = 8 * j + (lane >> 3), ch = lane & 7;
        const v4u w = *(const LAS v4u*)(scr + n * 144 + ch * 16);
        *(GAS v4u*)(WT + (size_t)cv_dst_row(mode, n0 + n) * K + k0 + 8 * ch) = w; }
    asm volatile("s_waitcnt lgkmcnt(0)" ::: "memory");
}
__device__ __forceinline__ void conv_item8(const float* W, int ldw, int K, unsigned char* WT8, int mode, LAS unsigned char* scr, int item, int nblk, int lane) {
    const int kb = item / nblk, nb = item - kb * nblk, k0 = 128 * kb, n0 = 64 * nb;
    const GAS float* src = (const GAS float*)(W + (size_t)k0 * ldw + n0 + lane);
#pragma unroll 4
    for (int kc = 0; kc < 16; ++kc) {
        float v[8];
#pragma unroll
        for (int j = 0; j < 8; ++j) v[j] = src[(size_t)(kc * 8 + j) * ldw] * W8S;
        v2u w; w.x = pg8::cvt4_fp8(v[0], v[1], v[2], v[3]); w.y = pg8::cvt4_fp8(v[4], v[5], v[6], v[7]);
        *(LAS v2u*)(scr + lane * 144 + kc * 8) = w;
    }
    asm volatile("s_waitcnt lgkmcnt(0)" ::: "memory");
#pragma unroll
    for (int j = 0; j < 8; ++j) { const int n = 8 * j + (lane >> 3), ch = lane & 7;
        const v4u w = *(const LAS v4u*)(scr + n * 144 + ch * 16);
        *(GAS v4u*)(WT8 + (size_t)cv_dst_row(mode, n0 + n) * K + k0 + 16 * ch) = w; }
    asm volatile("s_waitcnt lgkmcnt(0)" ::: "memory");
}
__device__ __forceinline__ void conv_job8(Frame& F, const float* W, int ldw, int K, int N, unsigned char* WT8, int mode, int& rot) {
    LAS unsigned char* scr = F.lds + F.wave * 9216;
    const int nblk = N / 64, nitems = (K / 128) * nblk, NGW = F.G * NWAVES, gw = blockIdx.x * NWAVES + F.wave;
    int first = gw - (rot % NGW); if (first < 0) first += NGW;
    for (int it = first; it < nitems; it += NGW) conv_item8(W, ldw, K, WT8, mode, scr, it, nblk, F.lane);
    rot += nitems;
}
__device__ __forceinline__ void conv_job(Frame& F, const float* W, int ldw, int K, int N, bf16* WT, int mode, int& rot) {
    LAS unsigned char* scr = F.lds + F.wave * 9216;
    const int nblk = N / 64, nitems = (K / 64) * nblk, NGW = F.G * NWAVES, gw = blockIdx.x * NWAVES + F.wave;
    int first = gw - (rot % NGW); if (first < 0) first += NGW;
    for (int it = first; it < nitems; it += NGW) conv_item(W, ldw, K, WT, mode, scr, it, nblk, F.lane);
    rot += nitems;
}
__device__ __forceinline__ void convert_weights(Frame& F) {
    bf16* WB = (bf16*)(F.ws + WS_W); int rot = 0;
    for (int j = 0; j < 2; ++j) { if (j == 1 && QKV3_FP8) conv_job8(F, INP(1) + (size_t)j * DM * 3 * DM, 3 * DM, DM, 3 * DM, (unsigned char*)(WB + WE_QKV + (size_t)j * 3 * DM * DM), CV_PLAIN, rot);
        else conv_job(F, INP(1) + (size_t)j * DM * 3 * DM, 3 * DM, DM, 3 * DM, WB + WE_QKV + (size_t)j * 3 * DM * DM, CV_PLAIN, rot); }
    for (int j = 0; j < 2; ++j) conv_job(F, INP(2) + (size_t)j * DM * DM, DM, DM, DM, WB + WE_WO_SB + (size_t)j * DM * DM, CV_PLAIN, rot);
    if (DILIN_FP8) conv_job8(F, INP(3), 7 * DM, DM, 7 * DM, (unsigned char*)(WB + WE_IN_DIL), CV_QKN, rot); else conv_job(F, INP(3), 7 * DM, DM, 7 * DM, WB + WE_IN_DIL, CV_QKN, rot);
    conv_job(F, INP(6), DM, DM, DM, WB + WE_WO_DIL, CV_PLAIN, rot);
    if (FOXIN_FP8) conv_job8(F, INP(7), 3088, DM, 3 * DM, (unsigned char*)(WB + WE_IN_FOX), CV_QKN, rot); else conv_job(F, INP(7), 3088, DM, 3 * DM, WB + WE_IN_FOX, CV_QKN, rot);
    conv_job(F, INP(11), DM, DM, DM, WB + WE_WO_FOX, CV_PLAIN, rot);
    for (int f = 0; f < 2; ++f) {
        if (f == 0 ? DENSE_FP8_L0 : DENSE_FP8_L2) {
            conv_job8(F, INP(15) + (size_t)f * DM * FF, FF, DM, FF, (unsigned char*)(WB + WE_GU + (size_t)f * 2 * FF * DM), CV_GATE, rot);
            conv_job8(F, INP(16) + (size_t)f * DM * FF, FF, DM, FF, (unsigned char*)(WB + WE_GU + (size_t)f * 2 * FF * DM), CV_UP, rot);
            conv_job8(F, INP(17) + (size_t)f * FF * DM, DM, FF, DM, (unsigned char*)(WB + WE_D + (size_t)f * DM * FF), CV_PLAIN, rot);
        } else {
            conv_job(F, INP(15) + (size_t)f * DM * FF, FF, DM, FF, WB + WE_GU + (size_t)f * 2 * FF * DM, CV_GATE, rot);
            conv_job(F, INP(16) + (size_t)f * DM * FF, FF, DM, FF, WB + WE_GU + (size_t)f * 2 * FF * DM, CV_UP, rot);
            conv_job(F, INP(17) + (size_t)f * FF * DM, DM, FF, DM, WB + WE_D + (size_t)f * DM * FF, CV_PLAIN, rot);
        }
    }
    for (int fe = 0; fe < 16; ++fe) {
        if (MOE_FP8) {
            conv_job8(F, INP(19) + (size_t)fe * DM * FF, FF, DM, FF, (unsigned char*)(WB + WE_MGU) + (size_t)fe * 2 * FF * DM, CV_GATE, rot);
            conv_job8(F, INP(20) + (size_t)fe * DM * FF, FF, DM, FF, (unsigned char*)(WB + WE_MGU) + (size_t)fe * 2 * FF * DM, CV_UP, rot);
            conv_job8(F, INP(21) + (size_t)fe * FF * DM, DM, FF, DM, (unsigned char*)(WB + WE_MD) + (size_t)fe * DM * FF, CV_PLAIN, rot);
        } else {
            conv_job(F, INP(19) + (size_t)fe * DM * FF, FF, DM, FF, WB + WE_MGU + (size_t)fe * 2 * FF * DM, CV_GATE, rot);
            conv_job(F, INP(20) + (size_t)fe * DM * FF, FF, DM, FF, WB + WE_MGU + (size_t)fe * 2 * FF * DM, CV_UP, rot);
            conv_job(F, INP(21) + (size_t)fe * FF * DM, DM, FF, DM, WB + WE_MD + (size_t)fe * DM * FF, CV_PLAIN, rot);
        }
    }
}

__device__ __forceinline__ int moe_cnt(Frame& F, int f, int e) {
    const unsigned long long w = __hip_atomic_load((GAS unsigned long long*)(F.ctl + CW_CNT + f * 64 + 16 * (e >> 2)), RLX_AGENT);
    return (int)((w >> (16 * (e & 3))) & 0xffffull);
}
__device__ __forceinline__ f32x4 moe_yrow(Frame& F, int r, int q4) {
    const bf16* Y = (const bf16*)(F.ws + WS_R2); const bf16* P = (const bf16*)(F.ws + WS_R2 + 72 * MiB);
    if (r < SPLIT_ROW0 || F.G != 256 || !MOE_SPLITK) { const v2u a = ((const GAS v2u*)(Y + (size_t)r * DM))[q4]; return (f32x4){bflo(a.x), bfhi(a.x), bflo(a.y), bfhi(a.y)}; }
    f32x4 s = (f32x4){0.f, 0.f, 0.f, 0.f};
#pragma unroll
    for (int k = 0; k < MOE_NSPLIT; ++k) { const v2u a = ((const GAS v2u*)(P + ((size_t)k * SPLIT_ROWS + (size_t)(r - SPLIT_ROW0)) * DM))[q4]; s = s + (f32x4){bflo(a.x), bfhi(a.x), bflo(a.y), bfhi(a.y)}; }
    return s;
}
__device__ __forceinline__ void moe_bases(Frame& F, int f, int (&tb)[NE + 1]) {
    int acc = 0;
#pragma unroll
    for (int e = 0; e < NE; ++e) { tb[e] = acc; const int c = moe_cnt(F, f, e); acc += (c + 255) >> 8; }
    tb[NE] = acc;
}

template <int NC>
__device__ __forceinline__ float wave_reduce_cols(float (&part)[NC], int lane) {
#pragma unroll
    for (int st = 0, n = NC / 2; n >= 1; ++st, n >>= 1) {
        const bool up = (lane >> st) & 1;
#pragma unroll
        for (int i = 0; i < n; ++i) { const float keep = up ? part[i + n] : part[i], send = up ? part[i] : part[i + n]; part[i] = keep + __shfl_xor(send, 1 << st); }
    }
    float v = part[0];
#pragma unroll
    for (int o = NC; o < 64; o <<= 1) v += __shfl_xor(v, o);
    return v;
}
template <int NC> __device__ __forceinline__ int lane_of_col(int c) {
    int l = 0;
#pragma unroll
    for (int st = 0, n = NC / 2; n >= 1; ++st, n >>= 1) { if (c & n) l |= 1 << st; }
    return l;
}
template <int FLAGS>
__device__ __forceinline__ void norm_phase(Frame& F, const float* xin, float* xout, const float* gain, bf16* H, int fprev, int f,
                                           const float* Wf  , const float* bf  , const float* Wr  ) {
    constexpr int NC = (FLAGS & 2) ? 16 : (FLAGS & 4) ? 8 : 0;
    const bf16* Y = (const bf16*)(F.ws + WS_R2);
    const int* tok_prev = (const int*)(F.ws + WS_MISC + MS_TOK) + (size_t)fprev * M * 2;
    float* lgf = (float*)(F.ws + WS_MISC + MS_LOGF);
    LAS int* sel = (LAS int*)F.lds;
    LAS float* sg = (LAS float*)(F.lds + 512);
    LAS int* gb = (LAS int*)(F.lds + 1536);
    LAS f32x4* WL = (LAS f32x4*)(F.lds + 4096);
    int tb[NE + 1];
    if (FLAGS & 1) moe_bases(F, fprev, tb);
    if (NC) {
        const float* Wsrc = (FLAGS & 2) ? Wf + 3072 : Wr; const int ldw = (FLAGS & 2) ? 3088 : 8;
        for (int idx = F.tid; idx < 16 * (NC / 4) * 64; idx += NTHR) {
            const int ln = idx & 63, cq = (idx >> 6) % (NC / 4), jq = idx / (64 * (NC / 4)), k = 4 * (ln + 64 * (jq >> 2)) + (jq & 3);
            WL[idx] = *(const GAS f32x4*)(Wsrc + (size_t)k * ldw + 4 * cq) * gain[k];
        }
        __syncthreads();
    }
    for (int chunk = blockIdx.x; chunk < M / 64; chunk += F.G) {
        for (int i = 0; i < 8; ++i) {
            const int m = chunk * 64 + F.wave * 8 + i;
            int ln = F.lane; asm volatile("" : "+v"(ln));
            const GAS f32x4* xr = (const GAS f32x4*)(xin + (size_t)m * DM) + ln;
            f32x4 v[4];
#pragma unroll
            for (int j = 0; j < 4; ++j) v[j] = xr[64 * j];
            if (FLAGS & 1) {
                const int s0 = tok_prev[m * 2], s1 = tok_prev[m * 2 + 1];
                int r0 = 0, r1 = 0;
#pragma unroll
                for (int e = 0; e < NE; ++e) { if ((s0 >> 14) == e) r0 = tb[e] * 256 + (s0 & 16383); if ((s1 >> 14) == e) r1 = tb[e] * 256 + (s1 & 16383); }
#pragma unroll
                for (int j = 0; j < 4; ++j) { v[j] = v[j] + moe_yrow(F, r0, ln + 64 * j) + moe_yrow(F, r1, ln + 64 * j);
                    ((GAS f32x4*)(xout + (size_t)m * DM) + ln)[64 * j] = v[j]; }
            }
            float s = 0.f;
#pragma unroll
            for (int j = 0; j < 4; ++j) s += (v[j].x * v[j].x + v[j].y * v[j].y) + (v[j].z * v[j].z + v[j].w * v[j].w);
            const float inv = 1.0f / sqrtf(wave_sum(s) * (1.f / DM) + RMS_EPS);
            float colv = 0.f;
            if (NC) {
                float part[NC ? NC : 1];
#pragma unroll
                for (int c = 0; c < NC; ++c) part[c] = 0.f;
                const int woff = ln;
#pragma unroll
                for (int j = 0; j < 4; ++j) {
#pragma unroll
                    for (int q = 0; q < 4; ++q) { const float xv = v[j][q];
#pragma unroll
                        for (int cq = 0; cq < NC / 4; ++cq) { const f32x4 w = WL[((j * 4 + q) * (NC / 4) + cq) * 64 + woff];
                            part[cq * 4 + 0] += xv * w.x; part[cq * 4 + 1] += xv * w.y; part[cq * 4 + 2] += xv * w.z; part[cq * 4 + 3] += xv * w.w; }
                        if ((q & 1) == 1) asm volatile("" ::: "memory"); } }
                colv = wave_reduce_cols<NC ? NC : 2>(reinterpret_cast<float (&)[NC ? NC : 2]>(part), ln) * inv;
            }
            if (H) {
                GAS unsigned long long* o8 = (GAS unsigned long long*)(H + (size_t)m * DM) + ln;
                GAS unsigned* h8 = (GAS unsigned*)(F.ws + WS_R2 + 104 * MiB + (size_t)m * DM) + ln;
#pragma unroll
                for (int j = 0; j < 4; ++j) { const f32x4 g = ((const GAS f32x4*)gain + ln)[64 * j]; const f32x4 hv = v[j] * inv * g;
                    if (((FLAGS & 4) && MOE_FP8) || (FLAGS & 8)) h8[64 * j] = pg8::cvt4_fp8(hv.x, hv.y, hv.z, hv.w);
                    else o8[64 * j] = (unsigned long long)pk2(hv.x, hv.y) | ((unsigned long long)pk2(hv.z, hv.w) << 32); }
            }
            if (FLAGS & 2) {
                if (ln < 16) { const int l = ln; const int c = ((l & 1) << 3) | ((l & 2) << 1) | ((l & 4) >> 1) | ((l & 8) >> 3);
                    const float z = colv + bf[c]; const float ls = fminf(z, 0.f) - log1pf(expf(-fabsf(z))); lgf[(size_t)m * 16 + c] = ls * LOG2E; }
            }
            if (FLAGS & 4) {
                float lg[8];
#pragma unroll
                for (int c = 0; c < 8; ++c) lg[c] = __builtin_bit_cast(float, __builtin_amdgcn_readlane(__builtin_bit_cast(int, colv), lane_of_col<8>(c)));
                int e0 = 0; float l0 = lg[0];
#pragma unroll
                for (int c = 1; c < 8; ++c) if (lg[c] > l0) { l0 = lg[c]; e0 = c; }
                int e1 = -1; float l1 = -INFINITY;
#pragma unroll
                for (int c = 0; c < 8; ++c) if (c != e0 && lg[c] > l1) { l1 = lg[c]; e1 = c; }
                const float g0 = 1.0f / (1.0f + expf(l1 - l0)), g1 = 1.0f - g0;
                if (ln == 0) { const int r = F.wave * 8 + i; sel[r * 2] = e0; sel[r * 2 + 1] = e1; sg[r * 2] = g0; sg[r * 2 + 1] = g1; }
            }
        }
        if (FLAGS & 4) {
            int* selg = (int*)(F.ws + WS_MISC + MS_SEL) + (size_t)f * M * 2;
            float* sgg = (float*)(F.ws + WS_MISC + MS_SG) + (size_t)f * M * 2;
            int* lcn = (int*)(F.ws + WS_MISC + MS_LC) + (size_t)f * 256 * 8;
            __syncthreads();
            if (F.tid < 128) { selg[chunk * 128 + F.tid] = sel[F.tid]; sgg[chunk * 128 + F.tid] = sg[F.tid]; }
            if (F.tid >= 128 && F.tid < 136) { const int e = F.tid - 128; int c = 0;
                for (int q = 0; q < 128; ++q) c += (sel[q] == e) ? 1 : 0;
                lcn[chunk * 8 + e] = c; }
            __syncthreads();
        }
    }
}

__device__ __forceinline__ void moe_finalize(Frame& F, int f) {
    const int* selg = (const int*)(F.ws + WS_MISC + MS_SEL) + (size_t)f * M * 2;
    const float* sgg = (const float*)(F.ws + WS_MISC + MS_SG) + (size_t)f * M * 2;
    const int* lcn = (const int*)(F.ws + WS_MISC + MS_LC) + (size_t)f * 256 * 8;
    int* list = (int*)(F.ws + WS_MISC + MS_LIST) + (size_t)f * NE * LCAP;
    float* gw = (float*)(F.ws + WS_MISC + MS_GW) + (size_t)f * NE * LCAP;
    int* tok = (int*)(F.ws + WS_MISC + MS_TOK) + (size_t)f * M * 2;
    LAS int* arr = (LAS int*)F.lds;
    LAS int* sel = (LAS int*)(F.lds + 8192);
    LAS int* pb = (LAS int*)(F.lds + 8192 + 512);
    LAS int* pt = (LAS int*)(F.lds + 8192 + 1536);
    LAS int* base = (LAS int*)(F.lds + 8192 + 2560);
    LAS int* tot = (LAS int*)(F.lds + 8192 + 2592);
    for (int chunk = blockIdx.x; chunk < M / 64; chunk += F.G) {
        if (F.tid < 256) { const v4u a = *(const GAS v4u*)(lcn + F.tid * 8), b = *(const GAS v4u*)(lcn + F.tid * 8 + 4);
            *(LAS v4u*)(arr + F.tid * 8) = a; *(LAS v4u*)(arr + F.tid * 8 + 4) = b; }
        if (F.tid < 128) sel[F.tid] = selg[chunk * 128 + F.tid];
        __syncthreads();
        if (F.tid < 256) { const int e = F.tid & 7, seg = F.tid >> 3; int b = 0, t = 0;
#pragma unroll
            for (int i = 0; i < 8; ++i) { const int c = seg * 8 + i; const int v = arr[c * 8 + e]; t += v; b += (c < chunk) ? v : 0; }
            pb[seg * 8 + e] = b; pt[seg * 8 + e] = t; }
        __syncthreads();
        if (F.tid < 8) { int b = 0, t = 0;
            for (int sgm = 0; sgm < 32; ++sgm) { b += pb[sgm * 8 + F.tid]; t += pt[sgm * 8 + F.tid]; }
            base[F.tid] = b; tot[F.tid] = t; }
        __syncthreads();
        if (F.tid < 128) { const int mye = sel[F.tid]; int lp = 0;
            for (int q = 0; q < 128; ++q) lp += (q < F.tid && sel[q] == mye) ? 1 : 0;
            const int q = F.tid, row = chunk * 64 + (q >> 1), pos = base[mye] + lp;
            list[mye * LCAP + pos] = row; gw[mye * LCAP + pos] = sgg[chunk * 128 + q]; tok[row * 2 + (q & 1)] = mye * LCAP + pos; }
        if (chunk == 0 && F.tid < 2) { unsigned long long w = 0ull;
#pragma unroll
            for (int i = 0; i < 4; ++i) w |= (unsigned long long)(unsigned)tot[4 * F.tid + i] << (16 * i);
            __hip_atomic_store((GAS unsigned long long*)(F.ctl + CW_CNT + f * 64 + 16 * F.tid), w, RLX_AGENT); }
        __syncthreads();
    }
}

__device__ __forceinline__ void final_combine(Frame& F, int f) {
    const bf16* Y = (const bf16*)(F.ws + WS_R2);
    const int* tok = (const int*)(F.ws + WS_MISC + MS_TOK) + (size_t)f * M * 2;
    int tb[NE + 1]; moe_bases(F, f, tb);
    for (int m = blockIdx.x * NWAVES + F.wave; m < M; m += F.G * NWAVES) {
        const int s0 = tok[m * 2], s1 = tok[m * 2 + 1]; int r0 = 0, r1 = 0;
#pragma unroll
        for (int e = 0; e < NE; ++e) { if ((s0 >> 14) == e) r0 = tb[e] * 256 + (s0 & 16383); if ((s1 >> 14) == e) r1 = tb[e] * 256 + (s1 & 16383); }
        GAS f32x4* xr = (GAS f32x4*)(F.out + (size_t)m * DM) + F.lane;
#pragma unroll
        for (int j = 0; j < 4; ++j) xr[64 * j] = xr[64 * j] + moe_yrow(F, r0, F.lane + 64 * j) + moe_yrow(F, r1, F.lane + 64 * j);
    }
}

__device__ __forceinline__ void cumsum_phase(Frame& F) {
    const float* logf = (const float*)(F.ws + WS_MISC + MS_LOGF);
    float* cum = (float*)(F.ws + WS_MISC + MS_CUM);
    const int gw = blockIdx.x * NWAVES + F.wave;
    if (gw < BATCH * NH) {
        const int b = gw >> 4, h = gw & 15;
        float v[32]; float s = 0.f;
#pragma unroll
        for (int i = 0; i < 32; ++i) { v[i] = logf[((size_t)b * SEQ + F.lane * 32 + i) * 16 + h]; s += v[i]; }
        float incl = s;
#pragma unroll
        for (int o = 1; o < 64; o <<= 1) { const float t = __shfl_up(incl, o); if (F.lane >= o) incl += t; }
        float run = incl - s;
#pragma unroll
        for (int i = 0; i < 32; ++i) { run += v[i]; cum[((size_t)b * SEQ + F.lane * 32 + i) * 16 + h] = run; }
    }
}

enum { EPI_PLANES = 0, EPI_RESID = 1, EPI_SWIGLU = 2, EPI_MOEDOWN = 3 };
struct SgP { const bf16* A; int lda; const int* rowidx; int Mrows; const float* W0; const float* W1; int ldw; int K; int N;
             bf16* outb; int ldo; float scale0; const float* base; float* outf; const float* gwv; };
template <int EPI>
__device__ __forceinline__ void sgemm(Frame& F, const SgP& p) {
    LAS float* As = (LAS float*)F.lds;
    LAS float* Bs0 = As + 16 * 132;
    LAS float* Bs1 = Bs0 + 16 * 128;
    const int tid = F.tid, ty = tid >> 4, tx = tid & 15;
    const int lrow = tid >> 2, lkq = (tid & 3) * 4;
    const int bk = tid >> 5, bn = (tid & 31) * 4;
    const int ntn = p.N / 128, ntiles = (p.Mrows / 128) * ntn;
    for (int tile = blockIdx.x; tile < ntiles; tile += F.G) {
        const int tm = tile / ntn, tn = tile % ntn;
        const int arow = p.rowidx ? p.rowidx[tm * 128 + lrow] : tm * 128 + lrow;
        const bf16* ap = p.A + (size_t)arow * p.lda + lkq;
        const float* bp0 = p.W0 + (size_t)bk * p.ldw + tn * 128 + bn;
        const float* bp1 = (EPI == EPI_SWIGLU) ? p.W1 + (size_t)bk * p.ldw + tn * 128 + bn : nullptr;
        f32x2 acc0[4][4], acc1[4][4];
#pragma unroll
        for (int i = 0; i < 4; ++i)
#pragma unroll
            for (int j = 0; j < 4; ++j) { acc0[i][j] = (f32x2){0.f, 0.f}; acc1[i][j] = (f32x2){0.f, 0.f}; }
        for (int k0 = 0; k0 < p.K; k0 += 16) {
            const v2u av = *(const GAS v2u*)(ap + k0);
            const f32x4 b0 = *(const GAS f32x4*)(bp0 + (size_t)k0 * p.ldw);
            f32x4 b1 = (f32x4){0.f, 0.f, 0.f, 0.f};
            if (EPI == EPI_SWIGLU) b1 = *(const GAS f32x4*)(bp1 + (size_t)k0 * p.ldw);
            __syncthreads();
            As[(lkq + 0) * 132 + lrow] = bflo(av.x); As[(lkq + 1) * 132 + lrow] = bfhi(av.x);
            As[(lkq + 2) * 132 + lrow] = bflo(av.y); As[(lkq + 3) * 132 + lrow] = bfhi(av.y);
            *(LAS f32x4*)(Bs0 + bk * 128 + bn) = b0;
            if (EPI == EPI_SWIGLU) *(LAS f32x4*)(Bs1 + bk * 128 + bn) = b1;
            __syncthreads();
#pragma unroll 2
            for (int k = 0; k < 16; ++k) {
                const f32x4 a = *(const LAS f32x4*)(As + k * 132 + ty * 4);
                const f32x4 bA = *(const LAS f32x4*)(Bs0 + k * 128 + tx * 8), bB = *(const LAS f32x4*)(Bs0 + k * 128 + tx * 8 + 4);
                const f32x2 bv[4] = {(f32x2){bA.x, bA.y}, (f32x2){bA.z, bA.w}, (f32x2){bB.x, bB.y}, (f32x2){bB.z, bB.w}};
#pragma unroll
                for (int i = 0; i < 4; ++i) {
#pragma unroll
                    for (int j = 0; j < 4; ++j) acc0[i][j] += a[i] * bv[j]; }
                if (EPI == EPI_SWIGLU) {
                    const f32x4 cA = *(const LAS f32x4*)(Bs1 + k * 128 + tx * 8), cB = *(const LAS f32x4*)(Bs1 + k * 128 + tx * 8 + 4);
                    const f32x2 cv[4] = {(f32x2){cA.x, cA.y}, (f32x2){cA.z, cA.w}, (f32x2){cB.x, cB.y}, (f32x2){cB.z, cB.w}};
#pragma unroll
                    for (int i = 0; i < 4; ++i) {
#pragma unroll
                        for (int j = 0; j < 4; ++j) acc1[i][j] += a[i] * cv[j]; }
                }
                __builtin_amdgcn_sched_barrier(0);
            }
        }
        const int c0 = tn * 128 + tx * 8;
#pragma unroll
        for (int i = 0; i < 4; ++i) {
            const int r = tm * 128 + ty * 4 + i;
            if (EPI == EPI_PLANES) {
                const int pl = c0 >> 10, cc = c0 & 1023; const float sc = (pl == 0) ? p.scale0 : 1.f;
                v4u w; w.x = pk2(acc0[i][0].x * sc, acc0[i][0].y * sc); w.y = pk2(acc0[i][1].x * sc, acc0[i][1].y * sc); w.z = pk2(acc0[i][2].x * sc, acc0[i][2].y * sc); w.w = pk2(acc0[i][3].x * sc, acc0[i][3].y * sc);
                *(GAS v4u*)(p.outb + (size_t)pl * PLANE + (size_t)r * DM + cc) = w;
            } else if (EPI == EPI_RESID) {
                const GAS f32x4* bp = (const GAS f32x4*)(p.base + (size_t)r * DM + c0); GAS f32x4* op = (GAS f32x4*)(p.outf + (size_t)r * DM + c0);
                const f32x4 x0 = bp[0], x1 = bp[1];
                op[0] = x0 + (f32x4){acc0[i][0].x, acc0[i][0].y, acc0[i][1].x, acc0[i][1].y}; op[1] = x1 + (f32x4){acc0[i][2].x, acc0[i][2].y, acc0[i][3].x, acc0[i][3].y};
            } else if (EPI == EPI_SWIGLU) {
                float o[8];
#pragma unroll
                for (int j = 0; j < 8; ++j) { const float g = acc0[i][j >> 1][j & 1], uu = acc1[i][j >> 1][j & 1]; o[j] = g / (1.0f + __expf(-g)) * uu; }
                v4u w; w.x = pk2(o[0], o[1]); w.y = pk2(o[2], o[3]); w.z = pk2(o[4], o[5]); w.w = pk2(o[6], o[7]);
                *(GAS v4u*)(p.outb + (size_t)r * p.ldo + c0) = w;
            } else {
                const float g = p.gwv[r]; GAS f32x4* op = (GAS f32x4*)(p.outf + (size_t)r * DM + c0);
                op[0] = (f32x4){acc0[i][0].x * g, acc0[i][0].y * g, acc0[i][1].x * g, acc0[i][1].y * g}; op[1] = (f32x4){acc0[i][2].x * g, acc0[i][2].y * g, acc0[i][3].x * g, acc0[i][3].y * g};
            }
        }
    }
}

__device__ __forceinline__ void qknorm_plane(Frame& F, bf16* plane, const float* gain, float mul) {
    const int nth = F.G * NTHR;
    for (int idx = blockIdx.x * NTHR + F.tid; idx < M * NH; idx += nth) {
        GAS v4u* p = (GAS v4u*)(plane + (size_t)idx * 64);
        v4u w[8]; float ss = 0.f;
#pragma unroll
        for (int c = 0; c < 8; ++c) { w[c] = p[c];
#pragma unroll
            for (int q = 0; q < 4; ++q) { const float a = bflo(w[c][q]), b = bfhi(w[c][q]); ss += a * a + b * b; } }
        const float inv = 1.0f / sqrtf(ss * (1.f / 64.f) + RMS_EPS) * mul;
#pragma unroll
        for (int c = 0; c < 8; ++c) { v4u o;
#pragma unroll
            for (int q = 0; q < 4; ++q) { const float a = bflo(w[c][q]) * inv * gain[c * 8 + 2 * q], b = bfhi(w[c][q]) * inv * gain[c * 8 + 2 * q + 1]; o[q] = pk2(a, b); }
            p[c] = o; }
    }
}

template <int MODE>
__device__ __forceinline__ void attn_simple_causal(Frame& F, const bf16* Qp, const bf16* Kp, const bf16* Vp, bf16* O, const float* cum) {
    LAS float* Ks = (LAS float*)F.lds;
    LAS float* Vs = Ks + 4096;
    LAS float* kb = Vs + 4096;
    for (int u = blockIdx.x; u < BATCH * NH * 4; u += F.G) {
        const int qblk = (u & 1) ? 3 - ((u >> 1) & 1) : ((u >> 1) & 1) * 1;
        const int bh = u >> 2, b = bh >> 4, h = bh & 15;
        const int t = qblk * 512 + F.tid;
        const size_t rowbase = (size_t)b * SEQ;
        float q[64], acc[64];
        { const GAS v4u* qp = (const GAS v4u*)(Qp + (rowbase + t) * DM + h * 64);
#pragma unroll
          for (int c = 0; c < 8; ++c) { const v4u w = qp[c];
#pragma unroll
              for (int k = 0; k < 4; ++k) { q[c * 8 + 2 * k] = bflo(w[k]); q[c * 8 + 2 * k + 1] = bfhi(w[k]); } } }
#pragma unroll
        for (int d = 0; d < 64; ++d) acc[d] = 0.f;
        float P = 1.f, mrun = -INFINITY, lrun = 0.f;
        const int ntile = 8 * (qblk + 1);
        for (int it = 0; it < ntile; ++it) {
            const int tile = (MODE == 0) ? ntile - 1 - it : it;
            __syncthreads();
            { const int key = F.tid >> 3, ch = F.tid & 7;
              const v4u kw = *(const GAS v4u*)(Kp + (rowbase + tile * 64 + key) * DM + h * 64 + ch * 8);
              const v4u vw = *(const GAS v4u*)(Vp + (rowbase + tile * 64 + key) * DM + h * 64 + ch * 8);
#pragma unroll
              for (int k = 0; k < 4; ++k) { Ks[key * 64 + ch * 8 + 2 * k] = bflo(kw[k]); Ks[key * 64 + ch * 8 + 2 * k + 1] = bfhi(kw[k]);
                                            Vs[key * 64 + ch * 8 + 2 * k] = bflo(vw[k]); Vs[key * 64 + ch * 8 + 2 * k + 1] = bfhi(vw[k]); }
              if (MODE == 2 && F.tid < 64) kb[F.tid] = -cum[(rowbase + tile * 64 + F.tid) * 16 + h]; }
            __syncthreads();
            for (int jj = 0; jj < 64; ++jj) {
                const int j = (MODE == 0) ? 63 - jj : jj; const int s = tile * 64 + j;
                float z = 0.f;
#pragma unroll
                for (int d4 = 0; d4 < 16; ++d4) { const f32x4 kv = *(const LAS f32x4*)(Ks + j * 64 + d4 * 4); z += q[d4 * 4] * kv.x + q[d4 * 4 + 1] * kv.y + q[d4 * 4 + 2] * kv.z + q[d4 * 4 + 3] * kv.w; }
                if (MODE == 0) {
                    const bool valid = s < t;
                    const float e = __builtin_amdgcn_exp2f(fminf(z, 100.f));
                    float r = 1.0f / (1.0f + e); float beta = 1.0f - r;
                    if (!valid) { r = 1.f; beta = 0.f; }
                    const float w = beta * P; P *= r;
#pragma unroll
                    for (int d4 = 0; d4 < 16; ++d4) { const f32x4 vv = *(const LAS f32x4*)(Vs + j * 64 + d4 * 4); acc[d4 * 4] += w * vv.x; acc[d4 * 4 + 1] += w * vv.y; acc[d4 * 4 + 2] += w * vv.z; acc[d4 * 4 + 3] += w * vv.w; }
                } else {
                    const bool valid = s <= t;
                    const float x = valid ? z + kb[j] : -INFINITY;
                    const float mn = fmaxf(mrun, x);
                    const float a = __builtin_amdgcn_exp2f(mrun - mn), pw = __builtin_amdgcn_exp2f(x - mn);
                    lrun = lrun * a + pw; mrun = mn;
#pragma unroll
                    for (int d4 = 0; d4 < 16; ++d4) { const f32x4 vv = *(const LAS f32x4*)(Vs + j * 64 + d4 * 4);
                        acc[d4 * 4] = acc[d4 * 4] * a + pw * vv.x; acc[d4 * 4 + 1] = acc[d4 * 4 + 1] * a + pw * vv.y; acc[d4 * 4 + 2] = acc[d4 * 4 + 2] * a + pw * vv.z; acc[d4 * 4 + 3] = acc[d4 * 4 + 3] * a + pw * vv.w; }
                }
            }
        }
        const float fin = (MODE == 0) ? 1.f : 1.0f / lrun;
        GAS v4u* op = (GAS v4u*)(O + (rowbase + t) * DM + h * 64);
#pragma unroll
        for (int c = 0; c < 8; ++c) { v4u w;
#pragma unroll
            for (int k = 0; k < 4; ++k) w[k] = pk2(acc[c * 8 + 2 * k] * fin, acc[c * 8 + 2 * k + 1] * fin);
            op[c] = w; }
    }
}

__device__ __forceinline__ int t5_bucket(int dist) {
    if (dist < 16) return dist;
    const float d = (float)dist;
    int lb = 16 + (int)(logf(d / 16.0f) / logf(128.0f) * 16.0f);
    return lb < 31 ? lb : 31;
}
__device__ __forceinline__ void attn_simple_dil(Frame& F, const bf16* PROJ, bf16* O, const float* rel_bias) {
    LAS float* tbl = (LAS float*)F.lds;
    for (int u = blockIdx.x; u < BATCH * NH * 4; u += F.G) {
        const int qblk = u & 3, bh = u >> 2, b = bh >> 4, h = bh & 15;
        const int t = qblk * 512 + F.tid;
        const size_t rowbase = (size_t)b * SEQ;
        __syncthreads();
        for (int i = F.tid; i < 3 * 129; i += NTHR) { const int g = i / 129, dl = i % 129, dil = (g == 0) ? 1 : (g == 1) ? 4 : 16;
            tbl[g * 132 + dl] = rel_bias[t5_bucket(dl * dil) * 16 + h] * LOG2E; }
        __syncthreads();
        float acc[64];
#pragma unroll
        for (int d = 0; d < 64; ++d) acc[d] = 0.f;
        float mrun = -INFINITY, lrun = 0.f;
        for (int g = 0; g < 3; ++g) {
            const int dil = (g == 0) ? 1 : (g == 1) ? 4 : 16;
            const bf16* Qg = PROJ + (size_t)(2 * g) * PLANE; const bf16* Kg = PROJ + (size_t)(2 * g + 1) * PLANE; const bf16* Vg = PROJ + (size_t)6 * PLANE;
            float q[64];
            { const GAS v4u* qp = (const GAS v4u*)(Qg + (rowbase + t) * DM + h * 64);
#pragma unroll
              for (int c = 0; c < 8; ++c) { const v4u w = qp[c];
#pragma unroll
                  for (int k = 0; k < 4; ++k) { q[c * 8 + 2 * k] = bflo(w[k]); q[c * 8 + 2 * k + 1] = bfhi(w[k]); } } }
            for (int dl = 0; dl <= 128; ++dl) {
                const int s = t - dl * dil; const bool valid = s >= 0; const int sc = valid ? s : 0;
                const GAS v4u* kp = (const GAS v4u*)(Kg + (rowbase + sc) * DM + h * 64);
                float z = 0.f;
#pragma unroll
                for (int c = 0; c < 8; ++c) { const v4u w = kp[c];
#pragma unroll
                    for (int k = 0; k < 4; ++k) z += q[c * 8 + 2 * k] * bflo(w[k]) + q[c * 8 + 2 * k + 1] * bfhi(w[k]); }
                const float x = valid ? z + tbl[g * 132 + dl] : -INFINITY;
                const float mn = fmaxf(mrun, x);
                const float a = __builtin_amdgcn_exp2f(mrun - mn), pw = __builtin_amdgcn_exp2f(x - mn);
                lrun = lrun * a + pw; mrun = mn;
                const GAS v4u* vp = (const GAS v4u*)(Vg + (rowbase + sc) * DM + h * 64);
#pragma unroll
                for (int c = 0; c < 8; ++c) { const v4u w = vp[c];
#pragma unroll
                    for (int k = 0; k < 4; ++k) { acc[c * 8 + 2 * k] = acc[c * 8 + 2 * k] * a + pw * bflo(w[k]); acc[c * 8 + 2 * k + 1] = acc[c * 8 + 2 * k + 1] * a + pw * bfhi(w[k]); } }
            }
        }
        const float fin = 1.0f / lrun;
        GAS v4u* op = (GAS v4u*)(O + (rowbase + t) * DM + h * 64);
#pragma unroll
        for (int c = 0; c < 8; ++c) { v4u w;
#pragma unroll
            for (int k = 0; k < 4; ++k) w[k] = pk2(acc[c * 8 + 2 * k] * fin, acc[c * 8 + 2 * k + 1] * fin);
            op[c] = w; }
    }
}

__device__ __forceinline__ void moe_gu_simple(Frame& F, int f, const bf16* H, bf16* ACT) {
    const int* list = (const int*)(F.ws + WS_MISC + MS_LIST) + (size_t)f * NE * LCAP;
    int base = 0;
    for (int e = 0; e < NE; ++e) {
        const int c = moe_cnt(F, f, e); const int nt = (c + 255) >> 8;
        if (nt) {
            SgP p{}; p.A = H; p.lda = DM; p.rowidx = list + e * LCAP; p.Mrows = nt * 256;
            p.W0 = INP(19) + ((size_t)f * NE + e) * DM * FF; p.W1 = INP(20) + ((size_t)f * NE + e) * DM * FF; p.ldw = FF; p.K = DM; p.N = FF;
            p.outb = ACT + (size_t)base * 256 * FF; p.ldo = FF;
            sgemm<EPI_SWIGLU>(F, p);
        }
        base += nt;
    }
}
__device__ __forceinline__ void moe_down_simple(Frame& F, int f, const bf16* ACT, float* Y) {
    const float* gw = (const float*)(F.ws + WS_MISC + MS_GW) + (size_t)f * NE * LCAP;
    int base = 0;
    for (int e = 0; e < NE; ++e) {
        const int c = moe_cnt(F, f, e); const int nt = (c + 255) >> 8;
        if (nt) {
            SgP p{}; p.A = ACT + (size_t)base * 256 * FF; p.lda = FF; p.rowidx = nullptr; p.Mrows = nt * 256;
            p.W0 = INP(21) + ((size_t)f * NE + e) * FF * DM; p.ldw = DM; p.K = FF; p.N = DM;
            p.outf = Y + (size_t)base * 256 * DM; p.gwv = gw + e * LCAP;
            sgemm<EPI_MOEDOWN>(F, p);
        }
        base += nt;
    }
}


template <class Epi, bool FP8 = false>
__device__ __forceinline__ void dense_gemm(Frame& F, const bf16* A, const bf16* Bt, int N, int K, const Epi& E) {
    pg8::DenseOrder S; S.init(A, Bt, M, N, K, F.G, (int)blockIdx.x);
    pg8::gemm_phase<Epi, pg8::DenseOrder, false, FP8>(F.lds, K, S, E);
}
__device__ __forceinline__ void moe_order_init(Frame& F, int f, pg8::MoeOrder& S) {
    int acc = 0, t[NE];
#pragma unroll
    for (int e = 0; e < NE; ++e) { const int c = moe_cnt(F, f, e); acc += (c + 255) >> 8; t[e] = acc; }
    S.t1 = t[0]; S.t2 = t[1]; S.t3 = t[2]; S.t4 = t[3]; S.t5 = t[4]; S.t6 = t[5]; S.t7 = t[6]; S.t8 = t[7];
    S.G = F.G; S.c = (int)blockIdx.x;
}
__device__ __forceinline__ void moe_gu_fast(Frame& F, int f, const bf16* H, bf16* ACT) {
    pg8::MoeOrder S; moe_order_init(F, f, S);
    S.list = (const int*)(F.ws + WS_MISC + MS_LIST) + (size_t)f * NE * LCAP; S.gather = true; S.splitk = 0; S.nN = 2 * FF / 256;
    if (MOE_FP8) {
        S.K = DM / 2; S.A = (const char*)(F.ws + WS_R2 + 104 * MiB); S.Bt = (const char*)((const bf16*)(F.ws + WS_W) + WE_MGU) + (size_t)f * NE * 2 * FF * DM;
        S.tstepA = (size_t)256 * DM; S.tstepB = (size_t)256 * DM; S.estepB = (size_t)2 * FF * DM;
        pg8::EpiSwigluF8 E{(unsigned char*)ACT};
        pg8::gemm_phase<pg8::EpiSwigluF8, pg8::MoeOrder, true, true>(F.lds, DM / 2, S, E);
    } else {
        S.K = DM; S.A = (const char*)H; S.Bt = (const char*)((const bf16*)(F.ws + WS_W) + WE_MGU + (size_t)f * NE * 2 * FF * DM);
        S.tstepA = (size_t)256 * DM * 2; S.tstepB = (size_t)256 * DM * 2; S.estepB = (size_t)2 * FF * DM * 2;
        pg8::EpiSwiglu E{ACT};
        pg8::gemm_phase<pg8::EpiSwiglu, pg8::MoeOrder, true>(F.lds, DM, S, E);
    }
}
__device__ __forceinline__ void moe_down_fast(Frame& F, int f, const bf16* ACT, bf16* Y) {
    pg8::MoeOrder S; moe_order_init(F, f, S);
    S.nN = DM / 256; S.list = nullptr; S.gather = false; S.splitk = (MOE_SPLITK && F.G == 256) ? MOE_NSPLIT : 0;
    const float* gwp = (const float*)(F.ws + WS_MISC + MS_GW) + (size_t)f * NE * LCAP; bf16* P = (bf16*)(F.ws + WS_R2 + 72 * MiB);
    if (MOE_FP8) {
        S.K = FF / 2; S.A = (const char*)ACT; S.Bt = (const char*)((const bf16*)(F.ws + WS_W) + WE_MD) + (size_t)f * NE * DM * FF;
        S.tstepA = (size_t)256 * FF; S.tstepB = (size_t)256 * FF; S.estepB = (size_t)DM * FF;
        pg8::EpiMoeDown E{Y, gwp, P, 1.0f / (W8S * A8S)};
        pg8::gemm_phase<pg8::EpiMoeDown, pg8::MoeOrder, false, true>(F.lds, FF / 2, S, E);
    } else {
        S.K = FF; S.A = (const char*)ACT; S.Bt = (const char*)((const bf16*)(F.ws + WS_W) + WE_MD + (size_t)f * NE * DM * FF);
        S.tstepA = (size_t)256 * FF * 2; S.tstepB = (size_t)256 * FF * 2; S.estepB = (size_t)DM * FF * 2;
        pg8::EpiMoeDown E{Y, gwp, P, 1.0f};
        pg8::gemm_phase<pg8::EpiMoeDown, pg8::MoeOrder, false>(F.lds, FF, S, E);
    }
}

struct Args { const float* in[22]; float* out; unsigned char* ws; int ph_lo, ph_hi; };
constexpr int N_PHASES = 32;

__global__ void __launch_bounds__(NTHR, 2) trunk_fwd(Args args) {
    extern __shared__ __attribute__((aligned(16))) unsigned char lds[];
    Frame F;
    F.lds = (LAS unsigned char*)lds;
    F.tid = threadIdx.x; F.lane = F.tid & 63; F.wave = __builtin_amdgcn_readfirstlane(F.tid >> 6); F.G = gridDim.x;
    F.ws = args.ws; F.ctl = (gu32*)(args.ws + WS_CTL); F.out = args.out;
    if (F.tid == 0) {
#pragma unroll
        for (int i = 0; i < 22; ++i) ((LAS unsigned long long*)(F.lds + PTR_OFF))[i] = (unsigned long long)args.in[i];
    }
    volatile LAS unsigned* MISC = (volatile LAS unsigned*)(F.lds + MISC_OFF);
    if (F.tid < 32) MISC[F.tid] = 0u;
    __syncthreads();
    XcdBarrier bar; bar.bar = (unsigned*)(F.ctl + CW_BAR); bar.x = 0; bar.st = nullptr;
    const int lo = args.ph_lo, hi = args.ph_hi;
    if (hi - lo > 1) bar = xcd_barrier_post((unsigned*)(F.ctl + CW_BAR), MISC + 8);
#ifndef PHSEL
#define PHSEL 0xFFFFFFFFFFFFFFFFull
#endif
#define IN(k) (lo <= (k) && (k) < hi && ((PHSEL >> (k)) & 1ull) && relaunder(F))
#define SEAM(k) do { if (IN((k) + 1) && IN(k)) xcd_barrier(bar); } while (0)
#ifndef DUPMASK
#define DUPMASK 0ull
#endif
#define DUP(k) (((DUPMASK >> (k)) & 1ull) != 0ull)

    bf16* H = (bf16*)(F.ws + WS_H);
    bf16* PROJ = (bf16*)(F.ws + WS_R1);
    bf16* ACT = (bf16*)(F.ws + WS_R1);
    bf16* O = (bf16*)(F.ws + WS_R2);
    bf16* Y = (bf16*)(F.ws + WS_R2);
    bf16* OG = (bf16*)(F.ws + WS_R2 + 32 * MiB);
    float* ST = (float*)(F.ws + WS_R2 + 128 * MiB);
    float* X = F.out;
    const bf16* H8 = (const bf16*)(F.ws + WS_R2 + 104 * MiB);
    float* DUMMY = (float*)(F.ws + WS_R2 + 32 * MiB);
    const float* cum = (const float*)(F.ws + WS_MISC + MS_LOGF);

    const bf16* WB = (const bf16*)(F.ws + WS_W);
    enum { PH_BASE = __COUNTER__ + 1 };
#define PHASE(...) { constexpr int k_ = __COUNTER__ - PH_BASE; if (IN(k_)) { __VA_ARGS__; if (DUP(k_)) { xcd_barrier(bar); __VA_ARGS__; } SEAM(k_); } }
    PHASE({ unsigned* z = (unsigned*)(F.ws + WS_MISC + MS_LIST);
            for (int i = blockIdx.x * NTHR + F.tid; i < (int)(2 * MiB / 4); i += F.G * NTHR) z[i] = 0u;
            convert_weights(F);
            __syncthreads();
            norm_phase<0>(F, INP(0), nullptr, INP(13) + 0 * DM, H, 0, 0, nullptr, nullptr, nullptr); })
    PHASE({ pg8::EpiPlanes E{PROJ, C2, 1.0f}; dense_gemm(F, H, WB + WE_QKV, 3 * DM, DM, E); })
    PHASE(att::causal_phase<0>((att::lptr)F.lds, F.G, PROJ, PROJ + PLANE, PROJ + 2 * PLANE, O, nullptr))
    PHASE({ pg8::EpiResid E{INP(0), X, 1.0f}; dense_gemm(F, O, WB + WE_WO_SB, DM, DM, E); })
    PHASE(norm_phase<DENSE_FP8_L0 ? 8 : 0>(F, X, nullptr, INP(14) + 0 * DM, H, 0, 0, nullptr, nullptr, nullptr))
    PHASE({ if (DENSE_FP8_L0) { pg8::EpiSwigluF8 E{(unsigned char*)ACT}; dense_gemm<pg8::EpiSwigluF8, true>(F, H8, (const bf16*)((const unsigned char*)(WB + WE_GU)), 2 * FF, DM / 2, E); }
            else { pg8::EpiSwiglu E{ACT}; dense_gemm(F, H, WB + WE_GU, 2 * FF, DM, E); } })
    PHASE({ if (DENSE_FP8_L0) { pg8::EpiResid E{X, X, 1.0f / (W8S * A8S)}; dense_gemm<pg8::EpiResid, true>(F, ACT, (const bf16*)((const unsigned char*)(WB + WE_D)), DM, FF / 2, E); }
            else { pg8::EpiResid E{X, X, 1.0f}; dense_gemm(F, ACT, WB + WE_D, DM, FF, E); } })
    PHASE(norm_phase<DILIN_FP8 ? 8 : 0>(F, X, nullptr, INP(13) + 1 * DM, H, 0, 0, nullptr, nullptr, nullptr))
    PHASE({ if (DILIN_FP8) { pg8::EpiQKNorm E{PROJ, INP(4), INP(5), 6, 1.0f / W8S}; dense_gemm<pg8::EpiQKNorm, true>(F, H8, WB + WE_IN_DIL, 7 * DM, DM / 2, E); }
            else { pg8::EpiQKNorm E{PROJ, INP(4), INP(5), 6, 1.0f}; dense_gemm(F, H, WB + WE_IN_DIL, 7 * DM, DM, E); } })
    PHASE(att::dil_phase((att::lptr)F.lds, F.G, PROJ, OG, ST, INP(12)))
    PHASE(att::dil_merge(F.G, OG, ST, O))
    PHASE({ pg8::EpiResid E{X, X, 1.0f}; dense_gemm(F, O, WB + WE_WO_DIL, DM, DM, E); })
    PHASE(norm_phase<4>(F, X, nullptr, INP(14) + 1 * DM, H, 0, 0, nullptr, nullptr, INP(18) + 0 * DM * NE))
    PHASE(moe_finalize(F, 0))
    PHASE(moe_gu_fast(F, 0, H, ACT))
    PHASE(moe_down_fast(F, 0, ACT, Y))
    PHASE(norm_phase<1 | 2 | (FOXIN_FP8 ? 8 : 0)>(F, X, X, INP(13) + 2 * DM, H, 0, 0, INP(7), INP(8), nullptr))
    PHASE({ if (FOXIN_FP8) { pg8::EpiQKNorm E{PROJ, INP(9), INP(10), 2, 1.0f / W8S}; dense_gemm<pg8::EpiQKNorm, true>(F, H8, WB + WE_IN_FOX, 3 * DM, DM / 2, E); }
            else { pg8::EpiQKNorm E{PROJ, INP(9), INP(10), 2, 1.0f}; dense_gemm(F, H, WB + WE_IN_FOX, 3 * DM, DM, E); } })
    PHASE(att::causal_phase<2>((att::lptr)F.lds, F.G, PROJ, PROJ + PLANE, PROJ + 2 * PLANE, O, cum))
    PHASE({ pg8::EpiResid E{X, X, 1.0f}; dense_gemm(F, O, WB + WE_WO_FOX, DM, DM, E); })
    PHASE(norm_phase<DENSE_FP8_L2 ? 8 : 0>(F, X, nullptr, INP(14) + 2 * DM, H, 0, 0, nullptr, nullptr, nullptr))
    PHASE({ if (DENSE_FP8_L2) { pg8::EpiSwigluF8 E{(unsigned char*)ACT}; dense_gemm<pg8::EpiSwigluF8, true>(F, H8, WB + WE_GU + (size_t)2 * FF * DM, 2 * FF, DM / 2, E); }
            else { pg8::EpiSwiglu E{ACT}; dense_gemm(F, H, WB + WE_GU + (size_t)2 * FF * DM, 2 * FF, DM, E); } })
    PHASE({ if (DENSE_FP8_L2) { pg8::EpiResid E{X, X, 1.0f / (W8S * A8S)}; dense_gemm<pg8::EpiResid, true>(F, ACT, WB + WE_D + (size_t)DM * FF, DM, FF / 2, E); }
            else { pg8::EpiResid E{X, X, 1.0f}; dense_gemm(F, ACT, WB + WE_D + (size_t)DM * FF, DM, FF, E); } })
    PHASE(norm_phase<QKV3_FP8 ? 8 : 0>(F, X, nullptr, INP(13) + 3 * DM, H, 0, 0, nullptr, nullptr, nullptr))
    PHASE({ if (QKV3_FP8) { pg8::EpiPlanes E{PROJ, C2, 1.0f / W8S}; dense_gemm<pg8::EpiPlanes, true>(F, H8, WB + WE_QKV + (size_t)3 * DM * DM, 3 * DM, DM / 2, E); }
            else { pg8::EpiPlanes E{PROJ, C2, 1.0f}; dense_gemm(F, H, WB + WE_QKV + (size_t)3 * DM * DM, 3 * DM, DM, E); } })
    PHASE(att::causal_phase<0>((att::lptr)F.lds, F.G, PROJ, PROJ + PLANE, PROJ + 2 * PLANE, O, nullptr))
    PHASE({ pg8::EpiResid E{X, X, 1.0f}; dense_gemm(F, O, WB + WE_WO_SB + (size_t)DM * DM, DM, DM, E); })
    PHASE(norm_phase<4>(F, X, nullptr, INP(14) + 3 * DM, H, 0, 1, nullptr, nullptr, INP(18) + 1 * DM * NE))
    PHASE(moe_finalize(F, 1))
    PHASE(moe_gu_fast(F, 1, H, ACT))
    PHASE(moe_down_fast(F, 1, ACT, Y))
    PHASE(final_combine(F, 1))
    static_assert(__COUNTER__ - PH_BASE == N_PHASES, "N_PHASES must equal the number of PHASE() sites");
#undef PHASE
#undef IN
#undef SEAM
}

extern "C" void kernel_launch(void* const* d_in, const int* in_sizes, int n_in, void* d_out, int out_size, void* d_ws, size_t ws_size, hipStream_t stream) {
    static int grid = 0;
    if (grid == 0) {
        if (n_in != 22 || out_size != M * DM || ws_size < WS_END) { fprintf(stderr, "kernel_launch: unexpected shapes (n_in %d out %d ws %zu)\n", n_in, out_size, ws_size); grid = -1; return; }
        int dev = 0, cus = 0, per_cu = 0;
        if (hipGetDevice(&dev) != hipSuccess || hipDeviceGetAttribute(&cus, hipDeviceAttributeMultiprocessorCount, dev) != hipSuccess) { grid = -1; return; }
        if (hipFuncSetAttribute((const void*)trunk_fwd, hipFuncAttributeMaxDynamicSharedMemorySize, LDS_BYTES) != hipSuccess) { fprintf(stderr, "kernel_launch: hipFuncSetAttribute failed\n"); grid = -1; return; }
        if (hipOccupancyMaxActiveBlocksPerMultiprocessor(&per_cu, (const void*)trunk_fwd, NTHR, LDS_BYTES) != hipSuccess || per_cu < 1) fprintf(stderr, "kernel_launch: occupancy query says %d\n", per_cu);
        (void)hipGetLastError();
        grid = cus;
    }
    if (grid < 0) return;
    (void)hipMemsetAsync((char*)d_ws + WS_CTL, 0, CTL_ZERO_BYTES, stream);
    Args a{};
    for (int i = 0; i < 22; ++i) a.in[i] = (const float*)d_in[i];
    a.out = (float*)d_out; a.ws = (unsigned char*)d_ws;
#if MK_MULTI
    for (int p = 0; p < N_PHASES; ++p) { a.ph_lo = p; a.ph_hi = p + 1; hipLaunchKernelGGL(trunk_fwd, dim3(grid), dim3(NTHR), LDS_BYTES, stream, a); }
#else
    a.ph_lo = 0; a.ph_hi = N_PHASES;
    hipLaunchKernelGGL(trunk_fwd, dim3(grid), dim3(NTHR), LDS_BYTES, stream, a);
#endif
}
```

```cpp
#include <hip/hip_runtime.h>
#include <cstdio>
#include <cstdint>

#ifndef MK_MULTI
#define MK_MULTI 0
#endif

constexpr int BATCH = 8, SEQ = 2048, DM = 1024, NH = 16, HD = 64, FF = 3584, NE = 8;
constexpr int M = BATCH * SEQ;
constexpr float RMS_EPS = 1e-6f;
constexpr float LOG2E = 1.4426950408889634f;
constexpr float C2 = 0.125f * LOG2E;
constexpr int NWAVES = 8, NTHR = 512;
constexpr int LCAP = 16384;
constexpr int MAXROWS = 34816;
constexpr bool MOE_SPLITK = true;
constexpr bool MOE_FP8 = true;
constexpr bool DILIN_FP8 = true;
constexpr bool FOXIN_FP8 = true;
constexpr bool QKV3_FP8 = true;
constexpr bool DENSE_FP8_L0 = false, DENSE_FP8_L2 = true;
constexpr float W8S = 32.0f, A8S = 4.0f;
constexpr int MOE_NSPLIT = MOE_FP8 ? 2 : 4;
constexpr int SPLIT_ROW0 = 32768, SPLIT_ROWS = MAXROWS - SPLIT_ROW0;

constexpr size_t MiB = 1u << 20;
constexpr size_t WS_CTL = 0, CTL_ZERO_BYTES = 1 * MiB;
constexpr size_t WS_MISC = 1 * MiB;
constexpr size_t WS_H = 6 * MiB;
constexpr size_t WS_R1 = 38 * MiB;
constexpr size_t WS_R2 = 278 * MiB;
constexpr size_t WS_W = 414 * MiB;
constexpr size_t WS_XB = 832 * MiB;
constexpr size_t WS_END = 864 * MiB;
constexpr size_t PLANE = (size_t)M * DM;
constexpr size_t WE_QKV = 0;
constexpr size_t WE_WO_SB = WE_QKV + 2ull * 3072 * 1024;
constexpr size_t WE_WO_DIL = WE_WO_SB + 2ull * 1024 * 1024;
constexpr size_t WE_WO_FOX = WE_WO_DIL + 1024ull * 1024;
constexpr size_t WE_IN_DIL = WE_WO_FOX + 1024ull * 1024;
constexpr size_t WE_IN_FOX = WE_IN_DIL + 7168ull * 1024;
constexpr size_t WE_GU = WE_IN_FOX + 3072ull * 1024;
constexpr size_t WE_D = WE_GU + 2ull * 7168 * 1024;
constexpr size_t WE_MGU = WE_D + 2ull * 1024 * 3584;
constexpr size_t WE_MD = WE_MGU + 16ull * 7168 * 1024;
constexpr size_t WE_END = WE_MD + 16ull * 1024 * 3584;
static_assert(WS_W + WE_END * 2 <= WS_END, "weight copies fit");
constexpr size_t MS_LIST = 0;
constexpr size_t MS_GW = 1 * MiB;
constexpr size_t MS_TOK = 2 * MiB;
constexpr size_t MS_LOGF = 2 * MiB + 256 * 1024;
constexpr size_t MS_CUM = 3 * MiB + 256 * 1024;
constexpr size_t MS_SEL = 4 * MiB + 256 * 1024;
constexpr size_t MS_SG = MS_SEL + 256 * 1024;
constexpr size_t MS_LC = MS_SG + 256 * 1024;
constexpr int CW_BAR = 4096;
constexpr int CW_PANEL = 1024;
constexpr bool MOE_Y_FP8 = true;
constexpr float Y8S = 16.0f;
constexpr bool WO_FP8 = true;
constexpr int CW_CVQ = 2048;
constexpr int CW_CNT = 64;

#define GAS __attribute__((address_space(1)))
#define LAS __attribute__((address_space(3)))
typedef unsigned short bf16;
typedef unsigned v4u __attribute__((ext_vector_type(4)));
typedef unsigned v2u __attribute__((ext_vector_type(2)));
typedef float f32x4 __attribute__((ext_vector_type(4)));
typedef float f32x2 __attribute__((ext_vector_type(2)));
typedef GAS unsigned gu32;
#define RLX_AGENT __ATOMIC_RELAXED, __HIP_MEMORY_SCOPE_AGENT
__device__ __forceinline__ unsigned f2bf(float f) { unsigned u = __builtin_bit_cast(unsigned, f); return (u + 0x7fffu + ((u >> 16) & 1u)) >> 16; }
__device__ __forceinline__ unsigned pk2(float lo, float hi) { return f2bf(lo) | (f2bf(hi) << 16); }
__device__ __forceinline__ float bflo(unsigned u) { return __builtin_bit_cast(float, u << 16); }
__device__ __forceinline__ float bfhi(unsigned u) { return __builtin_bit_cast(float, u & 0xffff0000u); }

#define XB_TMO      128
#define XB_XCNT(j)  (256  + 64 * (j))
#define XB_XSUB(j)  (1280 + 64 * (j))
#define XB_XGEN(j)  (2304 + 64 * (j))
#define XB_TOP      3328
#define XB_TOPGEN   3392
#define XCD_BAR_WORDS 3456
#define XB_SPIN_CAP (1u << 22)
__device__ __forceinline__ unsigned xb_ld(unsigned* p)              { return __hip_atomic_load(p, __ATOMIC_RELAXED, __HIP_MEMORY_SCOPE_AGENT); }
__device__ __forceinline__ unsigned xb_add(unsigned* p, unsigned v) { return __hip_atomic_fetch_add(p, v, __ATOMIC_RELAXED, __HIP_MEMORY_SCOPE_AGENT); }
__device__ __forceinline__ unsigned xb_xcc_id() { return (unsigned)__builtin_amdgcn_s_getreg((3 << 11) | 20) & 0xFu; }
#define XB_SPIN(cond, bar) do { unsigned _sp = 0; while (cond) { __builtin_amdgcn_s_sleep(1); \
    if ((++_sp & 255u) == 0u) { if (xb_ld(&(bar)[XB_TMO])) break; if (_sp > XB_SPIN_CAP) { atomicAdd(&(bar)[XB_TMO], 1u); break; } } } } while (0)
struct XcdBarrier { unsigned* bar; unsigned x; volatile LAS unsigned* st; };
__device__ __forceinline__ XcdBarrier xcd_barrier_post(unsigned* bar, volatile LAS unsigned* st) {
    XcdBarrier b; b.bar = bar; b.x = xb_xcc_id(); b.st = st;
    if (threadIdx.x == 0) (void)xb_add(&bar[XB_XCNT(b.x)], 1u);
    return b;
}
__device__ __forceinline__ void xcd_barrier_complete(unsigned* bar, unsigned x, unsigned& nloc, unsigned& nx) {
    const unsigned G = gridDim.x * gridDim.y * gridDim.z;
    unsigned sum, cnt, mine, sp = 0u;
    for (;;) {
        sum = 0u; cnt = 0u; mine = 0u;
#pragma unroll
        for (unsigned j = 0; j < 16; ++j) { const unsigned c = xb_ld(&bar[XB_XCNT(j)]); sum += c; cnt += (c > 0u) ? 1u : 0u; mine = (j == x) ? c : mine; }
        if (sum == G) break;
        __builtin_amdgcn_s_sleep(1);
        if ((++sp & 255u) == 0u) { if (xb_ld(&bar[XB_TMO])) break; if (sp > XB_SPIN_CAP) { atomicAdd(&bar[XB_TMO], 1u); break; } }
    }
    nloc = mine > 0u ? mine : 1u; nx = cnt > 0u ? cnt : 1u;
}
__device__ __forceinline__ void xcd_barrier(const XcdBarrier& b) {
    asm volatile("s_waitcnt vmcnt(0)" ::: "memory");
    __syncthreads();
    if (threadIdx.x == 0) {
        unsigned* bar = b.bar;
        __builtin_amdgcn_s_waitcnt(0);
        unsigned nloc = b.st[0], nx = b.st[1];
        if (nloc == 0u) { xcd_barrier_complete(bar, b.x, nloc, nx); b.st[0] = nloc; b.st[1] = nx; }
        const unsigned old = xb_add(&bar[XB_XSUB(b.x)], 1u);
        const unsigned gen = old / nloc;
        if (old + 1u == (gen + 1u) * nloc) {
            __builtin_amdgcn_fence(__ATOMIC_RELEASE, "agent");
            asm volatile("s_waitcnt vmcnt(0)" ::: "memory");
            const unsigned og = xb_add(&bar[XB_TOP], 1u);
            const unsigned tg = og / nx;
            if (og + 1u == (tg + 1u) * nx) xb_add(&bar[XB_TOPGEN], 1u);
            else XB_SPIN(xb_ld(&bar[XB_TOPGEN]) == tg, bar);
            xb_add(&bar[XB_XGEN(b.x)], 1u);
            __builtin_amdgcn_fence(__ATOMIC_ACQUIRE, "agent");
            asm volatile("s_waitcnt vmcnt(0)" ::: "memory");
        } else {
            XB_SPIN(xb_ld(&bar[XB_XGEN(b.x)]) == gen, bar);
            __builtin_amdgcn_fence(__ATOMIC_ACQUIRE, "agent");
            asm volatile("s_waitcnt vmcnt(0)" ::: "memory");
        }
    }
    __syncthreads();
}

constexpr int LDS_BYTES = 147456;
constexpr int ATT_LDS_MAX = 143360;
constexpr int MISC_OFF = ATT_LDS_MAX + 64;
struct Frame {
    LAS unsigned char* lds;
    int tid, lane, wave, G;
    unsigned char* ws; gu32* ctl;
    float* out;
};
__device__ __forceinline__ float wave_sum(float v) {
#pragma unroll
    for (int o = 1; o < 64; o <<= 1) v += __shfl_xor(v, o);
    return v;
}

constexpr int PTR_OFF = ATT_LDS_MAX + 512;
__device__ __forceinline__ const float* inp_ptr(Frame& F, int k) {
    const LAS unsigned* t = (const LAS unsigned*)(F.lds + PTR_OFF) + 2 * k;
    const unsigned lo = __builtin_amdgcn_readfirstlane(t[0]), hi = __builtin_amdgcn_readfirstlane(t[1]);
    return (const float*)(((unsigned long long)hi << 32) | lo);
}
#define INP(k) inp_ptr(F, (k))
__device__ __forceinline__ bool relaunder(Frame& F) { int t_ = threadIdx.x; asm volatile("" : "+v"(t_)); F.tid = t_; F.lane = t_ & 63; F.wave = __builtin_amdgcn_readfirstlane(t_ >> 6); return true; }
namespace pg8 {
#define PG8_LAS __attribute__((address_space(3)))
typedef unsigned short bf16_t;
typedef short bf16x8 __attribute__((ext_vector_type(8)));
typedef unsigned u32x4 __attribute__((ext_vector_type(4)));
constexpr int BM = 256, BK = 64, HALF = 128, HTB = HALF * BK * 2, STAGE_BYTES = 8 * HTB, NXCD = 8, WGM = 8;
__host__ __device__ __forceinline__ int lds_byte(int r, int c) { const int st = (r >> 4) * 2 + (c >> 5), rr = r & 15, cc = c & 31, ob = rr * 64 + cc * 2; return st * 1024 + (ob ^ (((ob >> 9) & 1) << 5)); }
__host__ __device__ __forceinline__ void stage_rc(int b, int& R, int& C) { const int st = b / 1024, sb = b % 1024, swz = sb ^ (((sb >> 9) & 1) << 5); R = (st >> 1) * 16 + swz / 64; C = (st & 1) * 32 + (swz % 64) / 2; }
__host__ __device__ __forceinline__ int perm32(int rho) { const int n = rho >> 4, i = rho & 15; return 8 * (i >> 2) + 4 * n + (i & 3); }
struct Unit { int pm, pn, e, mt, nt, koff, kq; };

struct DenseOrder {
    int nM, nN, nwg, G, c, ntk; const char* A; const char* Bt; size_t tstep;
    __device__ __forceinline__ void init(const bf16_t* A_, const bf16_t* Bt_, int M_, int N_, int K_, int G_, int c_) { nM = M_ / BM; nN = N_ / BM; nwg = nM * nN; G = G_; c = c_; ntk = K_ / BK; A = (const char*)A_; Bt = (const char*)Bt_; tstep = (size_t)BM * K_ * 2; }
    __device__ __forceinline__ bool next(int i, Unit& u) const {
        const long L = (long)i * G + c; if (L >= nwg) return false;
        int wgid = (int)L; { const int q = nwg / NXCD, r = nwg % NXCD, xcd = wgid % NXCD, off = wgid / NXCD; wgid = (xcd < r ? xcd * (q + 1) : r * (q + 1) + (xcd - r) * q) + off; }
        const int nig = WGM * nN, gid = wgid / nig, fm = gid * WGM, gsz = (nM - fm) < WGM ? (nM - fm) : WGM;
        u.pm = fm + ((wgid % nig) % gsz); u.pn = (wgid % nig) / gsz; u.e = 0; u.mt = u.pm; u.nt = ntk; u.koff = 0; u.kq = -1; return true;
    }
    __device__ __forceinline__ const char* a_base(const Unit& u) const { return A + (size_t)u.pm * tstep; }
    __device__ __forceinline__ const char* b_base(const Unit& u) const { return Bt + (size_t)u.pn * tstep; }
    __device__ __forceinline__ void a_voff(const Unit&, const int (&)[2], const int (&)[2], unsigned (&)[2][2]) const {}
};
struct MoeOrder {
    int t1, t2, t3, t4, t5, t6, t7, t8, nN, G, c, K; const char* A; const char* Bt; size_t tstepA, tstepB, estepB; const int* list; bool gather; int splitk; bool xcdperm;
    __device__ __forceinline__ bool next(int i, Unit& u) const {
        const int X = i * G + c, U = t8 * nN; int L = X; u.nt = K / BK; u.koff = 0; u.kq = -1;
        if (splitk) { const int nfull = (U / G) * G;
            if (X >= nfull) { const int q = X - nfull; if (q >= splitk * (U - nfull)) return false; L = nfull + q / splitk; u.kq = q % splitk; u.nt = K / BK / splitk; u.koff = u.kq * (K / splitk) * 2; } }
        else if (X >= U) return false;
        if (xcdperm && u.kq < 0) {
            const int rnd = L / G, q = L - rnd * G, j = q >> 3, x = q & 7; L = rnd * G + (((j >> 2) * 8 + x) << 2) + (j & 3); }
        const int mt = L / nN; u.pm = mt; u.pn = L - mt * nN;
        const int e = (mt >= t1) + (mt >= t2) + (mt >= t3) + (mt >= t4) + (mt >= t5) + (mt >= t6) + (mt >= t7);
        const int tb = e == 0 ? 0 : e == 1 ? t1 : e == 2 ? t2 : e == 3 ? t3 : e == 4 ? t4 : e == 5 ? t5 : e == 6 ? t6 : t7;
        u.e = e; u.mt = mt - tb; return true;
    }
    __device__ __forceinline__ const char* a_base(const Unit& u) const { return (gather ? A : A + (size_t)u.pm * tstepA) + u.koff; }
    __device__ __forceinline__ const char* b_base(const Unit& u) const { return Bt + (size_t)u.e * estepB + (size_t)u.pn * tstepB + u.koff; }
    __device__ __forceinline__ void a_voff(const Unit& u, const int (&sR)[2], const int (&sC)[2], unsigned (&v)[2][2]) const {
        const int* lp = list + u.e * LCAP + u.mt * 256;
#pragma unroll
        for (int h = 0; h < 2; ++h)
#pragma unroll
            for (int i = 0; i < 2; ++i) v[h][i] = (unsigned)lp[h * 128 + sR[i]] * (unsigned)(K * 2) + (unsigned)(sC[i] * 2);
    }
};

typedef int v8i32 __attribute__((ext_vector_type(8)));
typedef int v4i32 __attribute__((ext_vector_type(4)));
__device__ __forceinline__ v8i32 cat8(bf16x8 a, bf16x8 b) { const v4i32 x = __builtin_bit_cast(v4i32, a), y = __builtin_bit_cast(v4i32, b); return (v8i32){x[0], x[1], x[2], x[3], y[0], y[1], y[2], y[3]}; }
__device__ __forceinline__ unsigned cvt4_fp8(float a, float b, float c, float d) { int w = 0; w = __builtin_amdgcn_cvt_pk_fp8_f32(a, b, w, false); w = __builtin_amdgcn_cvt_pk_fp8_f32(c, d, w, true); return (unsigned)w; }
__device__ __forceinline__ const char* uniptr(const char* p) { const unsigned long long v = (unsigned long long)p; const unsigned lo = __builtin_amdgcn_readfirstlane((unsigned)v), hi = __builtin_amdgcn_readfirstlane((unsigned)(v >> 32)); return (const char*)(((unsigned long long)hi << 32) | lo); }
__device__ __forceinline__ void glds16_s(const char* sbase, unsigned voff, unsigned lds_dst) { unsigned keep;
    asm volatile("s_mov_b32 %0, m0\n\ts_mov_b32 m0, %3\n\ts_nop 0\n\tglobal_load_lds_dwordx4 %2, %1\n\ts_mov_b32 m0, %0" : "=&s"(keep) : "s"(sbase), "v"(voff), "s"(lds_dst) : "memory"); }
__device__ __forceinline__ unsigned cvt_pk_bf16(float lo, float hi) { unsigned r; asm volatile("v_cvt_pk_bf16_f32 %0, %1, %2" : "=v"(r) : "v"(lo), "v"(hi)); return r; }

struct EpiPlanes {
    static constexpr bool PERM = true;
    bf16_t* O; float scale0; float oscale;
    __device__ __forceinline__ void operator()(const f32x4 (&acc)[2][2][4][2], const Unit& u, int wr, int wc, int fr, int fq) const {
        const int plane = u.pn >> 2; const float sc = (plane == 0 ? scale0 : 1.f) * oscale;
        bf16_t* base = O + (size_t)plane * PLANE + (size_t)(u.pm * BM + wr * 64 + fr) * DM + (u.pn & 3) * 256 + wc * 32 + 8 * fq;
#pragma unroll
        for (int ai = 0; ai < 2; ++ai)
#pragma unroll
            for (int m = 0; m < 4; ++m) { bf16_t* rowp = base + (size_t)(ai * HALF + m * 16) * DM;
#pragma unroll
                for (int bj = 0; bj < 2; ++bj) { const f32x4 v0 = acc[ai][bj][m][0] * sc, v1 = acc[ai][bj][m][1] * sc;
                    u32x4 w; w.x = cvt_pk_bf16(v0[0], v0[1]); w.y = cvt_pk_bf16(v0[2], v0[3]); w.z = cvt_pk_bf16(v1[0], v1[1]); w.w = cvt_pk_bf16(v1[2], v1[3]);
                    *(u32x4*)(rowp + bj * HALF) = w; } }
    }
};
struct EpiQKNorm {
    static constexpr bool PERM = true;
    bf16_t* O; const float* qg; const float* kg; int vplane; float iscale;
    __device__ __forceinline__ void operator()(const f32x4 (&acc)[2][2][4][2], const Unit& u, int wr, int wc, int fr, int fq) const {
        const int plane = u.pn >> 2; const bool isv = plane == vplane; const bool isq = !isv && ((plane & 1) == 0); const int grp = plane >> 1;
        const float* g = (isq ? qg : kg) + grp * 64 + 8 * fq;
        f32x4 gv[2][2];
#pragma unroll
        for (int bj = 0; bj < 2; ++bj)
#pragma unroll
            for (int n = 0; n < 2; ++n) gv[bj][n] = isv ? (f32x4){1.f, 1.f, 1.f, 1.f} : *(const f32x4*)(g + 32 * bj + 4 * n);
        const float mul = isq ? C2 : 1.f;
        bf16_t* base = O + (size_t)plane * PLANE + (size_t)(u.pm * BM + wr * 64 + fr) * DM + (u.pn & 3) * 256 + wc * 64 + 8 * fq;
#pragma unroll
        for (int ai = 0; ai < 2; ++ai)
#pragma unroll
            for (int m = 0; m < 4; ++m) { bf16_t* rowp = base + (size_t)(ai * HALF + m * 16) * DM;
                float ss = 0.f;
#pragma unroll
                for (int bj = 0; bj < 2; ++bj)
#pragma unroll
                    for (int n = 0; n < 2; ++n) { const f32x4 x = acc[ai][bj][m][n] * iscale; ss += (x[0] * x[0] + x[1] * x[1]) + (x[2] * x[2] + x[3] * x[3]); }
                ss += __shfl_xor(ss, 16); ss += __shfl_xor(ss, 32);
                const float inv = (isv ? 1.f : mul * __builtin_amdgcn_rsqf(ss * (1.f / 64.f) + RMS_EPS)) * iscale;
#pragma unroll
                for (int bj = 0; bj < 2; ++bj) { const f32x4 v0 = acc[ai][bj][m][0] * inv * gv[bj][0], v1 = acc[ai][bj][m][1] * inv * gv[bj][1];
                    u32x4 w; w.x = cvt_pk_bf16(v0[0], v0[1]); w.y = cvt_pk_bf16(v0[2], v0[3]); w.z = cvt_pk_bf16(v1[0], v1[1]); w.w = cvt_pk_bf16(v1[2], v1[3]);
                    *(u32x4*)(rowp + bj * 32) = w; } }
    }
};
struct EpiSwiglu {
    static constexpr bool PERM = true;
    bf16_t* O;
    __device__ __forceinline__ void operator()(const f32x4 (&acc)[2][2][4][2], const Unit& u, int wr, int wc, int fr, int fq) const {
        bf16_t* base = O + (size_t)(u.pm * BM + wr * 64 + fr) * FF + u.pn * 128 + wc * 32 + 8 * fq;
#pragma unroll
        for (int ai = 0; ai < 2; ++ai)
#pragma unroll
            for (int m = 0; m < 4; ++m) { bf16_t* rowp = base + (size_t)(ai * HALF + m * 16) * FF;
                f32x2 o[4];
#pragma unroll
                for (int n = 0; n < 2; ++n)
#pragma unroll
                    for (int hh = 0; hh < 2; ++hh) { const f32x2 ga = {acc[ai][0][m][n][2 * hh], acc[ai][0][m][n][2 * hh + 1]}, ua = {acc[ai][1][m][n][2 * hh], acc[ai][1][m][n][2 * hh + 1]};
                        const f32x2 m1 = ga * (-LOG2E); f32x2 e; e.x = __builtin_amdgcn_exp2f(m1.x); e.y = __builtin_amdgcn_exp2f(m1.y);
                        const f32x2 sden = e + 1.0f; f32x2 r; r.x = __builtin_amdgcn_rcpf(sden.x); r.y = __builtin_amdgcn_rcpf(sden.y);
                        o[n * 2 + hh] = (ga * ua) * r; }
                u32x4 w; w.x = cvt_pk_bf16(o[0].x, o[0].y); w.y = cvt_pk_bf16(o[1].x, o[1].y); w.z = cvt_pk_bf16(o[2].x, o[2].y); w.w = cvt_pk_bf16(o[3].x, o[3].y);
                *(u32x4*)rowp = w; }
    }
};
struct EpiSwigluF8 {
    static constexpr bool PERM = true;
    unsigned char* O;
    __device__ __forceinline__ void operator()(const f32x4 (&acc)[2][2][4][2], const Unit& u, int wr, int wc, int fr, int fq) const {
        unsigned char* base = O + (size_t)(u.pm * BM + wr * 64 + fr) * FF + u.pn * 128 + wc * 32 + 8 * fq;
        constexpr float k1 = -LOG2E / W8S, ik2 = W8S * W8S / A8S;
#pragma unroll
        for (int ai = 0; ai < 2; ++ai)
#pragma unroll
            for (int m = 0; m < 4; ++m) { unsigned char* rowp = base + (size_t)(ai * HALF + m * 16) * FF;
                f32x2 o[4];
#pragma unroll
                for (int n = 0; n < 2; ++n)
#pragma unroll
                    for (int hh = 0; hh < 2; ++hh) { const f32x2 ga = {acc[ai][0][m][n][2 * hh], acc[ai][0][m][n][2 * hh + 1]}, ua = {acc[ai][1][m][n][2 * hh], acc[ai][1][m][n][2 * hh + 1]};
                        const f32x2 m1 = ga * k1; f32x2 e; e.x = __builtin_amdgcn_exp2f(m1.x); e.y = __builtin_amdgcn_exp2f(m1.y);
                        const f32x2 sden = e * ik2 + ik2; f32x2 r; r.x = __builtin_amdgcn_rcpf(sden.x); r.y = __builtin_amdgcn_rcpf(sden.y);
                        const f32x2 t = (ga * ua) * r; o[n * 2 + hh] = (f32x2){__builtin_amdgcn_fmed3f(t.x, -448.f, 448.f), __builtin_amdgcn_fmed3f(t.y, -448.f, 448.f)}; }
                v2u w; w.x = cvt4_fp8(o[0].x, o[0].y, o[1].x, o[1].y); w.y = cvt4_fp8(o[2].x, o[2].y, o[3].x, o[3].y);
                *(v2u*)rowp = w; }
    }
};
template <bool BASE_F32>
struct EpiResid {
    static constexpr bool PERM = true;
    const void* base; bf16_t* out; float oscale;
    __device__ __forceinline__ void operator()(const f32x4 (&acc)[2][2][4][2], const Unit& u, int wr, int wc, int fr, int fq) const {
        const size_t off0 = (size_t)(u.pm * BM + wr * 64 + fr) * DM + u.pn * BM + wc * 32 + 8 * fq;
#pragma unroll
        for (int ai = 0; ai < 2; ++ai)
#pragma unroll
            for (int m = 0; m < 4; ++m) { const size_t off = off0 + (size_t)(ai * HALF + m * 16) * DM;
#pragma unroll
                for (int bj = 0; bj < 2; ++bj) { f32x4 b0, b1;
                    if (BASE_F32) { b0 = *(const f32x4*)((const float*)base + off + bj * HALF); b1 = *(const f32x4*)((const float*)base + off + bj * HALF + 4); }
                    else { const u32x4 w = *(const u32x4*)((const bf16_t*)base + off + bj * HALF);
                        b0 = (f32x4){__builtin_bit_cast(float, w.x << 16), __builtin_bit_cast(float, w.x & 0xffff0000u), __builtin_bit_cast(float, w.y << 16), __builtin_bit_cast(float, w.y & 0xffff0000u)};
                        b1 = (f32x4){__builtin_bit_cast(float, w.z << 16), __builtin_bit_cast(float, w.z & 0xffff0000u), __builtin_bit_cast(float, w.w << 16), __builtin_bit_cast(float, w.w & 0xffff0000u)}; }
                    const f32x4 v0 = b0 + acc[ai][bj][m][0] * oscale, v1 = b1 + acc[ai][bj][m][1] * oscale;
                    u32x4 o; o.x = cvt_pk_bf16(v0[0], v0[1]); o.y = cvt_pk_bf16(v0[2], v0[3]); o.z = cvt_pk_bf16(v1[0], v1[1]); o.w = cvt_pk_bf16(v1[2], v1[3]);
                    *(u32x4*)(out + off + bj * HALF) = o; } }
    }
};
struct EpiMoeDown {
    static constexpr bool PERM = true;
    bf16_t* Y; const float* gw; bf16_t* P; float oscale;
    __device__ __forceinline__ void operator()(const f32x4 (&acc)[2][2][4][2], const Unit& u, int wr, int wc, int fr, int fq) const {
        const float* gp = gw + u.e * LCAP + u.mt * 256 + wr * 64 + fr;
        if (MOE_Y_FP8 && u.kq < 0) {
            unsigned char* base8 = (unsigned char*)Y + (size_t)(u.pm * BM + wr * 64 + fr) * DM + u.pn * BM + wc * 32 + 8 * fq;
#pragma unroll
            for (int ai = 0; ai < 2; ++ai)
#pragma unroll
                for (int m = 0; m < 4; ++m) { unsigned char* rowp = base8 + (size_t)(ai * HALF + m * 16) * DM; const float g = gp[ai * HALF + m * 16] * oscale * Y8S;
#pragma unroll
                    for (int bj = 0; bj < 2; ++bj) { f32x4 v0 = acc[ai][bj][m][0] * g, v1 = acc[ai][bj][m][1] * g;
#pragma unroll
                        for (int q = 0; q < 4; ++q) { v0[q] = __builtin_amdgcn_fmed3f(v0[q], -448.f, 448.f); v1[q] = __builtin_amdgcn_fmed3f(v1[q], -448.f, 448.f); }
                        v2u w; w.x = cvt4_fp8(v0[0], v0[1], v0[2], v0[3]); w.y = cvt4_fp8(v1[0], v1[1], v1[2], v1[3]);
                        *(v2u*)(rowp + bj * HALF) = w; } }
            return;
        }
        bf16_t* base = (u.kq < 0 ? Y + (size_t)(u.pm * BM) * DM : P + ((size_t)u.kq * SPLIT_ROWS + (size_t)(u.pm * BM - SPLIT_ROW0)) * DM) + (size_t)(wr * 64 + fr) * DM + u.pn * BM + wc * 32 + 8 * fq;
#pragma unroll
        for (int ai = 0; ai < 2; ++ai)
#pragma unroll
            for (int m = 0; m < 4; ++m) { bf16_t* rowp = base + (size_t)(ai * HALF + m * 16) * DM; const float g = gp[ai * HALF + m * 16] * oscale;
#pragma unroll
                for (int bj = 0; bj < 2; ++bj) { const f32x4 v0 = acc[ai][bj][m][0] * g, v1 = acc[ai][bj][m][1] * g;
                    u32x4 w; w.x = cvt_pk_bf16(v0[0], v0[1]); w.y = cvt_pk_bf16(v0[2], v0[3]); w.z = cvt_pk_bf16(v1[0], v1[1]); w.w = cvt_pk_bf16(v1[2], v1[3]);
                    *(u32x4*)(rowp + bj * HALF) = w; } }
    }
};

template <class Epi, class Sched, bool GATHER, bool FP8 = false>
__device__ __forceinline__ void gemm_phase(PG8_LAS unsigned char* lds, const int K, const Sched& S, const Epi& E) {
    const int tid = threadIdx.x, wid = __builtin_amdgcn_readfirstlane(tid >> 6), lane = tid & 63, wr = wid >> 2, wc = wid & 3, fr = lane & 15, fq = lane >> 4;
    unsigned voffA[2], voffB[2]; int sR[2], sC[2];
#pragma unroll
    for (int i = 0; i < 2; ++i) { int R, C; stage_rc(tid * 16 + i * 8192, R, C); const int Rb = Epi::PERM ? ((R & ~31) + perm32(R & 31)) : R;
        voffA[i] = (unsigned)(R * K + C) * 2u; voffB[i] = (unsigned)(Rb * K + C) * 2u; sR[i] = R; sC[i] = C; }
    const size_t kstep = (size_t)(BK * 2);
    const size_t hstep = (size_t)HALF * K * 2;
    const unsigned ldsw = (unsigned)wid * 1024u, lds0 = (unsigned)(uintptr_t)lds;
    const int aoff = lds_byte(wr * 64 + fr, fq * 8), boff = lds_byte(wc * 32 + fr, fq * 8);

#define PG8_SA(b, h) (((b) * 2 + (h)) * HTB)
#define PG8_SB(b, h) ((4 + (b) * 2 + (h)) * HTB)
#define PG8_STAGE(bufoff, gbase, voff) do { const char* gb_ = uniptr((const char*)(gbase)); _Pragma("unroll") for (int _i = 0; _i < 2; ++_i) \
        glds16_s(gb_, (voff)[_i], (unsigned)__builtin_amdgcn_readfirstlane(lds0 + (unsigned)(bufoff) + ldsw + (unsigned)(_i * 8192))); } while (0)
#define PG8_STAGE_A(bufoff, p, h, VG) do { if (GATHER) { PG8_STAGE(bufoff, p, VG[h]); } else { PG8_STAGE(bufoff, (p) + ((h) ? hstep : 0), voffA); } } while (0)
#define PG8_LDA(dst, b, h) do { _Pragma("unroll") for (int m = 0; m < 4; ++m) { if constexpr (FP8) { const v4i32 x_ = *(const PG8_LAS v4i32*)(lds + PG8_SA(b, h) + aoff + m * 2048), y_ = *(const PG8_LAS v4i32*)(lds + PG8_SA(b, h) + aoff + m * 2048 + 1024); dst##8[m] = __builtin_shufflevector(x_, y_, 0, 1, 2, 3, 4, 5, 6, 7); } \
        else { _Pragma("unroll") for (int k = 0; k < 2; ++k) dst[m][k] = *(const PG8_LAS bf16x8*)(lds + PG8_SA(b, h) + aoff + m * 2048 + k * 1024); } } } while (0)
#define PG8_LDB(dst, b, h) do { _Pragma("unroll") for (int n = 0; n < 2; ++n) { if constexpr (FP8) { const v4i32 x_ = *(const PG8_LAS v4i32*)(lds + PG8_SB(b, h) + boff + n * 2048), y_ = *(const PG8_LAS v4i32*)(lds + PG8_SB(b, h) + boff + n * 2048 + 1024); dst##8[n] = __builtin_shufflevector(x_, y_, 0, 1, 2, 3, 4, 5, 6, 7); } \
        else { _Pragma("unroll") for (int k = 0; k < 2; ++k) dst[n][k] = *(const PG8_LAS bf16x8*)(lds + PG8_SB(b, h) + boff + n * 2048 + k * 1024); } } } while (0)
#define PG8_MMA(ai, bj, At, Bt) do { __builtin_amdgcn_s_setprio(1); _Pragma("unroll") for (int m = 0; m < 4; ++m) _Pragma("unroll") for (int n = 0; n < 2; ++n) { \
        if constexpr (FP8) asm volatile("v_mfma_scale_f32_16x16x128_f8f6f4 %0, %1, %2, %0, %3, %3 op_sel_hi:[0,0,0]" : "+v"(acc[ai][bj][m][n]) : "v"(Bt##8[n]), "v"(At##8[m]), "v"(sc8));   \
        else { _Pragma("unroll") for (int k = 0; k < 2; ++k) acc[ai][bj][m][n] = __builtin_amdgcn_mfma_f32_16x16x32_bf16(Bt[n][k], At[m][k], acc[ai][bj][m][n], 0, 0, 0); } } \
        __builtin_amdgcn_s_setprio(0); } while (0)
#define PG8_WAIT_V(n) asm volatile("s_waitcnt vmcnt(" #n ")" ::: "memory")
#define PG8_WAIT_L(n) asm volatile("s_waitcnt lgkmcnt(" #n ")" ::: "memory")
#define PG8_BAR __builtin_amdgcn_s_barrier()
#define PG8_SCHED __builtin_amdgcn_sched_barrier(0)
    Unit cur, nxt; int ui = 0;
    if (!S.next(0, cur)) return;
    f32x4 acc[2][2][4][2];
#pragma unroll
    for (int a = 0; a < 2; ++a)
#pragma unroll
        for (int b = 0; b < 2; ++b)
#pragma unroll
            for (int m = 0; m < 4; ++m)
#pragma unroll
                for (int n = 0; n < 2; ++n) acc[a][b][m][n] = (f32x4){0.f, 0.f, 0.f, 0.f};
    bf16x8 At[4][2], B0[2][2], B1[2][2];
    v8i32 At8[4], B08[2], B18[2];
    int sc8 = 0x7F7F7F7F; asm volatile("" : "+v"(sc8));
    const char* cA = S.a_base(cur); const char* cB = S.b_base(cur);
    unsigned vc[2][2] = {{0u, 0u}, {0u, 0u}}, vn[2][2] = {{0u, 0u}, {0u, 0u}};
    if (GATHER) { S.a_voff(cur, sR, sC, vc); asm volatile("s_waitcnt vmcnt(0)" : "+v"(vc[0][0]), "+v"(vc[0][1]), "+v"(vc[1][0]), "+v"(vc[1][1]) :: "memory"); }
    PG8_STAGE(PG8_SB(0, 0), cB, voffB); PG8_STAGE(PG8_SB(0, 1), cB + hstep, voffB); PG8_STAGE_A(PG8_SA(0, 0), cA, 0, vc); PG8_STAGE_A(PG8_SA(0, 1), cA, 1, vc);
    if (wr == 1) PG8_BAR;
    PG8_WAIT_V(2); PG8_BAR;
    PG8_STAGE(PG8_SB(1, 0), cB + kstep, voffB); PG8_STAGE_A(PG8_SA(1, 0), cA + kstep, 0, vc); PG8_STAGE(PG8_SB(1, 1), cB + hstep + kstep, voffB);
    PG8_WAIT_V(6); PG8_BAR;
    for (;;) {
        const bool has_next = S.next(ui + 1, nxt);
        const char* nA = has_next ? S.a_base(nxt) : cA; const char* nB = has_next ? S.b_base(nxt) : cB;
        if (GATHER) {
            if (has_next) { S.a_voff(nxt, sR, sC, vn); asm volatile("s_waitcnt vmcnt(0)" : "+v"(vn[0][0]), "+v"(vn[0][1]), "+v"(vn[1][0]), "+v"(vn[1][1]) :: "memory"); }
            else { vn[0][0] = vc[0][0]; vn[0][1] = vc[0][1]; vn[1][0] = vc[1][0]; vn[1][1] = vc[1][1]; }
        }
        const int nt = cur.nt;
        for (int t = 0; t < nt; t += 2) {
            const bool last = (t == nt - 2);
            const char* a1 = cA + (size_t)(t + 1) * kstep;
            const char* a2 = last ? nA : cA + (size_t)(t + 2) * kstep; const char* b2 = last ? nB : cB + (size_t)(t + 2) * kstep;
            const char* a3 = a2 + kstep; const char* b3 = b2 + kstep;
            unsigned v2[2][2];
#pragma unroll
            for (int h = 0; h < 2; ++h)
#pragma unroll
                for (int i = 0; i < 2; ++i) v2[h][i] = last ? vn[h][i] : vc[h][i];
            PG8_LDB(B0, 0, 0); PG8_LDB(B1, 0, 1); PG8_SCHED; PG8_LDA(At, 0, 0); PG8_STAGE_A(PG8_SA(1, 1), a1, 1, vc);
            PG8_WAIT_V(8); PG8_WAIT_L(0); PG8_BAR; PG8_MMA(0, 0, At, B0); PG8_MMA(0, 1, At, B1); PG8_BAR; PG8_SCHED;
            PG8_LDA(At, 0, 1); PG8_STAGE(PG8_SB(0, 0), b2, voffB); PG8_STAGE(PG8_SB(0, 1), b2 + hstep, voffB); PG8_STAGE_A(PG8_SA(0, 0), a2, 0, v2);
            PG8_WAIT_V(8); PG8_WAIT_L(0); PG8_BAR; PG8_MMA(1, 0, At, B0); PG8_MMA(1, 1, At, B1); PG8_BAR; PG8_SCHED;
            PG8_LDB(B0, 1, 0); PG8_LDB(B1, 1, 1); PG8_SCHED; PG8_LDA(At, 1, 0); PG8_STAGE_A(PG8_SA(0, 1), a2, 1, v2);
            PG8_WAIT_V(8); PG8_WAIT_L(0); PG8_BAR; PG8_MMA(0, 0, At, B0); PG8_MMA(0, 1, At, B1); PG8_BAR; PG8_SCHED;
            PG8_LDA(At, 1, 1); PG8_STAGE(PG8_SB(1, 0), b3, voffB); PG8_STAGE(PG8_SB(1, 1), b3 + hstep, voffB); PG8_STAGE_A(PG8_SA(1, 0), a3, 0, v2);
            PG8_WAIT_V(8); PG8_WAIT_L(0); PG8_BAR; PG8_MMA(1, 0, At, B0); PG8_MMA(1, 1, At, B1); PG8_BAR; PG8_SCHED;
        }
        if (wr == 0) PG8_BAR;
        if constexpr (FP8) asm volatile("s_nop 15\n\ts_nop 15" ::: "memory");
        { int fr_ = fr, fq_ = fq; asm volatile("" : "+v"(fr_), "+v"(fq_)); E(acc, cur, wr, wc, fr_, fq_); }
        if (!has_next) break;
#pragma unroll
        for (int a = 0; a < 2; ++a)
#pragma unroll
            for (int b = 0; b < 2; ++b)
#pragma unroll
                for (int m = 0; m < 4; ++m)
#pragma unroll
                    for (int n = 0; n < 2; ++n) acc[a][b][m][n] = (f32x4){0.f, 0.f, 0.f, 0.f};
        cur = nxt; cA = nA; cB = nB; ++ui;
        if (GATHER) { vc[0][0] = vn[0][0]; vc[0][1] = vn[0][1]; vc[1][0] = vn[1][0]; vc[1][1] = vn[1][1]; }
        if (wr == 1) PG8_BAR;
    }
    PG8_WAIT_V(0);
    PG8_BAR;
#undef PG8_SA
#undef PG8_SB
#undef PG8_STAGE
#undef PG8_STAGE_A
#undef PG8_LDA
#undef PG8_LDB
#undef PG8_MMA
#undef PG8_WAIT_V
#undef PG8_WAIT_L
#undef PG8_BAR
#undef PG8_SCHED
}
}

namespace att {
typedef short bf16x8 __attribute__((ext_vector_type(8)));
typedef short s16x4 __attribute__((ext_vector_type(4)));
typedef float f32x16 __attribute__((ext_vector_type(16)));
typedef unsigned u32x4 __attribute__((ext_vector_type(4)));
typedef LAS char* lptr;
constexpr int SLOTB = 8192, NSLOT = 6, AHEAD = 4;
constexpr int L_K = 0, L_V = NSLOT * SLOTB, L_WS = 2 * NSLOT * SLOTB, L_OST = L_WS + 8 * 256, L_KB = L_OST + 8 * 4096, L_FLG = L_KB + 8192, L_END = L_FLG + 256;
static_assert(L_END <= ATT_LDS_MAX, "attention LDS map");
constexpr float THR = 8.0f;
__device__ __forceinline__ int crow(int r, int hi) { return (r & 3) + 8 * (r >> 2) + 4 * hi; }
__device__ __forceinline__ void glds16(const void* gsrc, unsigned lds_dst) { unsigned keep;
    asm volatile("s_mov_b32 %0, m0\n\ts_mov_b32 m0, %2\n\ts_nop 0\n\tglobal_load_lds_dwordx4 %1, off\n\ts_mov_b32 m0, %0" : "=&s"(keep) : "v"(gsrc), "s"(lds_dst) : "memory"); }
typedef float f32x2_t __attribute__((ext_vector_type(2))); typedef __bf16 bf16x2_t __attribute__((ext_vector_type(2)));
__device__ __forceinline__ unsigned cvtpk(float lo, float hi) { f32x2_t v = {lo, hi}; bf16x2_t b = __builtin_convertvector(v, bf16x2_t); return __builtin_bit_cast(unsigned, b); }
__device__ __forceinline__ bf16x8 gload16(const void* p) { bf16x8 v; asm volatile("global_load_dwordx4 %0, %1, off" : "=v"(v) : "v"(p) : "memory"); return v; }
__device__ __forceinline__ float max3f(float a, float b, float c) { return __builtin_fmaxf(__builtin_fmaxf(a, b), c); }
__device__ __forceinline__ void wait_bar(int n) {
    if (n >= 14) asm volatile("s_waitcnt vmcnt(14) lgkmcnt(0)\n\ts_barrier" ::: "memory");
    else if (n >= 12) asm volatile("s_waitcnt vmcnt(12) lgkmcnt(0)\n\ts_barrier" ::: "memory");
    else if (n >= 10) asm volatile("s_waitcnt vmcnt(10) lgkmcnt(0)\n\ts_barrier" ::: "memory");
    else if (n >= 8) asm volatile("s_waitcnt vmcnt(8) lgkmcnt(0)\n\ts_barrier" ::: "memory");
    else if (n >= 6) asm volatile("s_waitcnt vmcnt(6) lgkmcnt(0)\n\ts_barrier" ::: "memory");
    else if (n >= 4) asm volatile("s_waitcnt vmcnt(4) lgkmcnt(0)\n\ts_barrier" ::: "memory");
    else if (n >= 2) asm volatile("s_waitcnt vmcnt(2) lgkmcnt(0)\n\ts_barrier" ::: "memory");
    else asm volatile("s_waitcnt vmcnt(0) lgkmcnt(0)\n\ts_barrier" ::: "memory");
}
__device__ __forceinline__ float other_half(float x, int hi) {
    auto rr = __builtin_amdgcn_permlane32_swap(__float_as_uint(x), __float_as_uint(x), false, false);
    return __uint_as_float(hi ? rr[0] : rr[1]);
}
__device__ __forceinline__ void qkt(f32x16& p0, f32x16& p1, lptr Kslot, const bf16x8* qr, const f32x16& c0, const f32x16& c1, int r32, int hi) {
    lptr kb = Kslot + hi * 1024 + r32 * 16;
#pragma unroll
    for (int d0 = 0; d0 < 4; ++d0) {
        const bf16x8 b0 = *(const LAS bf16x8*)(kb + d0 * 2048);
        const bf16x8 b1 = *(const LAS bf16x8*)(kb + d0 * 2048 + 512);
        if (d0 == 0) { p0 = __builtin_amdgcn_mfma_f32_32x32x16_bf16(b0, qr[0], c0, 0, 0, 0); p1 = __builtin_amdgcn_mfma_f32_32x32x16_bf16(b1, qr[0], c1, 0, 0, 0); }
        else { p0 = __builtin_amdgcn_mfma_f32_32x32x16_bf16(b0, qr[d0], p0, 0, 0, 0); p1 = __builtin_amdgcn_mfma_f32_32x32x16_bf16(b1, qr[d0], p1, 0, 0, 0); } }
}
__device__ __forceinline__ void pv(f32x16* o, int vb, bf16x8 pa0, bf16x8 pa1, bf16x8 pa2, bf16x8 pa3) {
#pragma unroll
    for (int d0 = 0; d0 < 2; ++d0) { s16x4 lo[4], hi[4];
#pragma unroll
        for (int ks = 0; ks < 4; ++ks) {
            asm volatile("ds_read_b64_tr_b16 %0,%1 offset:%c2" : "=&v"(lo[ks]) : "v"(vb), "i"(d0 * 4096 + ks * 1024) : "memory");
            asm volatile("ds_read_b64_tr_b16 %0,%1 offset:%c2" : "=&v"(hi[ks]) : "v"(vb), "i"(d0 * 4096 + ks * 1024 + 512) : "memory"); }
        asm volatile("s_waitcnt lgkmcnt(0)" ::: "memory"); __builtin_amdgcn_sched_barrier(0);
#define ATT_PK(k) (bf16x8){lo[k][0], lo[k][1], lo[k][2], lo[k][3], hi[k][0], hi[k][1], hi[k][2], hi[k][3]}
        o[d0] = __builtin_amdgcn_mfma_f32_32x32x16_bf16(pa0, ATT_PK(0), o[d0], 0, 0, 0);
        o[d0] = __builtin_amdgcn_mfma_f32_32x32x16_bf16(pa1, ATT_PK(1), o[d0], 0, 0, 0);
        o[d0] = __builtin_amdgcn_mfma_f32_32x32x16_bf16(pa2, ATT_PK(2), o[d0], 0, 0, 0);
        o[d0] = __builtin_amdgcn_mfma_f32_32x32x16_bf16(pa3, ATT_PK(3), o[d0], 0, 0, 0);
#undef ATT_PK
    }
}
__device__ __forceinline__ void pack_pv(f32x16* o, int vb, const f32x16& p0, const f32x16& p1) {
    u32x4 w0, w1, w2, w3;
#pragma unroll
    for (int j = 0; j < 4; ++j) { w0[j] = cvtpk(p0[2 * j], p0[2 * j + 1]); w1[j] = cvtpk(p0[8 + 2 * j], p0[8 + 2 * j + 1]); w2[j] = cvtpk(p1[2 * j], p1[2 * j + 1]); w3[j] = cvtpk(p1[8 + 2 * j], p1[8 + 2 * j + 1]); }
    pv(o, vb, __builtin_bit_cast(bf16x8, w0), __builtin_bit_cast(bf16x8, w1), __builtin_bit_cast(bf16x8, w2), __builtin_bit_cast(bf16x8, w3));
}
__device__ __forceinline__ float rowmax32(const f32x16& p0, const f32x16& p1, int hi) {
    float a = max3f(p0[0], p0[1], p1[0]), b = max3f(p0[2], p0[3], p1[1]); a = max3f(a, p1[2], p1[3]);
#pragma unroll
    for (int r = 4; r < 16; r += 4) { a = max3f(a, p0[r], p0[r + 1]); b = max3f(b, p0[r + 2], p0[r + 3]); a = max3f(a, p1[r], p1[r + 1]); b = max3f(b, p1[r + 2], p1[r + 3]); }
    a = fmaxf(a, b);
    return fmaxf(a, other_half(a, hi));
}
__device__ __forceinline__ void store_o(const f32x16* o, const float* sc, lptr stgb, bf16* Ow, long rpitch, int lane, int r32, int hi) {
    LAS bf16* stg = (LAS bf16*)stgb;
#pragma unroll
    for (int r = 0; r < 16; ++r) { const int orow = crow(r, hi);
#pragma unroll
        for (int d0 = 0; d0 < 2; ++d0) stg[orow * 64 + d0 * 32 + r32] = (bf16)f2bf(o[d0][r] * sc[r]); }
    asm volatile("s_waitcnt lgkmcnt(0)" ::: "memory");
#pragma unroll
    for (int i = 0; i < 4; ++i) { const int row = i * 8 + (lane >> 3), ch = lane & 7; const u32x4 v = *(const LAS u32x4*)(stg + row * 64 + ch * 8); *(u32x4*)(Ow + (long)row * rpitch + ch * 8) = v; }
}
__device__ __forceinline__ void store_o8(const f32x16* o, const float* sc, lptr stgb, unsigned char* O8w, long rpitch, int lane, int r32, int hi) {
    LAS unsigned char* stg = (LAS unsigned char*)stgb;
#pragma unroll
    for (int r = 0; r < 16; ++r) { const int orow = crow(r, hi); const float s4 = sc[r] * (float)A8S;
        const int pk = __builtin_amdgcn_cvt_pk_fp8_f32(__builtin_amdgcn_fmed3f(o[0][r] * s4, -448.f, 448.f), __builtin_amdgcn_fmed3f(o[1][r] * s4, -448.f, 448.f), 0, false);
        stg[orow * 64 + r32] = (unsigned char)(pk & 0xff); stg[orow * 64 + 32 + r32] = (unsigned char)((pk >> 8) & 0xff); }
    asm volatile("s_waitcnt lgkmcnt(0)" ::: "memory");
#pragma unroll
    for (int i = 0; i < 2; ++i) { const int row = i * 16 + (lane >> 2), ch = lane & 3; const u32x4 v = *(const LAS u32x4*)(stg + row * 64 + ch * 16); *(u32x4*)(O8w + (long)row * rpitch + ch * 16) = v; }
}
__device__ __forceinline__ void softmax_step(f32x16& p0, f32x16& p1, float& mref, float& lsum, f32x16* o, LAS float* wsf, int r32, int hi) {
    const float rm = rowmax32(p0, p1, hi);
    const bool fresh = mref <= -1e30f;
    const bool want = !fresh && (rm > mref + THR);
    if (fresh) mref = fmaxf(rm, -1e30f);
    if (__any(want)) {
        const float dl = want ? rm - mref : 0.f; mref += dl; const float f = __builtin_amdgcn_exp2f(-dl); lsum *= f;
        if (hi == 0) wsf[r32] = f;
        asm volatile("s_waitcnt lgkmcnt(0)" ::: "memory");
#pragma unroll
        for (int r = 0; r < 16; ++r) { const float fr = wsf[crow(r, hi)]; o[0][r] *= fr; o[1][r] *= fr; }
    }
    float sa = 0.f, sb = 0.f;
#pragma unroll
    for (int r = 0; r < 16; ++r) { p0[r] = __builtin_amdgcn_exp2f(p0[r] - mref); p1[r] = __builtin_amdgcn_exp2f(p1[r] - mref); sa += p0[r]; sb += p1[r]; }
    lsum += sa + sb;
}

struct WaveCtx { int lane, r32, hi, wid; unsigned lds0; int vb0; lptr shm; };
struct UnitD { int NT; int b, h, qb, g, x; };

template <int MODE> struct CausalMode {
    const bf16* Q; const bf16* K; const bf16* V; bf16* O; int b, h, p; bool f8;
    float carry, mref, lsum; int done;
    __device__ __forceinline__ int units() const { return 4; }
    __device__ __forceinline__ int nstores() const { return f8 ? 2 : 4; }
    __device__ __forceinline__ void desc(int j, UnitD& d) const { d.b = b; d.h = h; d.qb = (j == 0) ? 7 - p : (j == 1) ? 5 - p : (j == 2) ? 2 + p : p; d.NT = 4 * (d.qb + 1); d.g = 0; d.x = 0; }
    __device__ __forceinline__ int tile_of(const UnitD& d, int k) const { return MODE == 0 ? d.NT - 1 - k : k; }
    __device__ __forceinline__ void q_load(const UnitD& d, const WaveCtx& w, bf16x8 (&q)[4]) const {
        const bf16* Qw = Q + ((long)d.b * SEQ + d.qb * 256 + w.wid * 32 + w.r32) * DM + d.h * 64 + w.hi * 8;
#pragma unroll
        for (int d0 = 0; d0 < 4; ++d0) q[d0] = gload16(Qw + d0 * 16);
    }
    __device__ __forceinline__ void dma(const UnitD& d, int k, int slot, const WaveCtx& w) const {
        const long row0 = (long)d.b * SEQ + 64 * tile_of(d, k);
        glds16(K + (row0 + w.lane) * DM + d.h * 64 + w.wid * 8, (unsigned)__builtin_amdgcn_readfirstlane(w.lds0 + L_K + slot * SLOTB + w.wid * 1024));
        glds16(V + (row0 + 16 * (w.wid & 3) + (w.lane >> 2)) * DM + d.h * 64 + (w.wid >> 2) * 32 + (w.lane & 3) * 8, (unsigned)__builtin_amdgcn_readfirstlane(w.lds0 + L_V + slot * SLOTB + w.wid * 1024));
    }
    __device__ __forceinline__ void begin(const UnitD&, const WaveCtx&) { carry = 1.0f; mref = -1e30f; lsum = 0.f; done = 0; }
    __device__ __forceinline__ int wave_done() const { return done; }
    __device__ __forceinline__ void compute(const UnitD& d, int k, int slot, const WaveCtx& w, const bf16x8* qr, f32x16* o) {
        const int T = tile_of(d, k), qfirst = d.qb * 256 + w.wid * 32, qpos = qfirst + w.r32;
        if (MODE == 0) {
            if (done || 64 * T >= qfirst + 31) return;
            f32x16 p0, p1; const f32x16 z = {}; qkt(p0, p1, w.shm + L_K + slot * SLOTB, qr, z, z, w.r32, w.hi);
            const bool diag = 64 * T + 63 >= qfirst;
            float ga[8];
#pragma unroll
            for (int a = 0; a < 8; ++a) {
                float rr[4];
#pragma unroll
                for (int i = 0; i < 4; ++i) { const int r = 4 * (a & 3) + i; const float zz = (a < 4) ? p0[r] : p1[r];
                    const float e = __builtin_amdgcn_exp2f(fminf(zz, 120.f)); float rv = __builtin_amdgcn_rcpf(1.0f + e);
                    if (diag) { const int kv = 64 * T + crow(r, w.hi) + ((a < 4) ? 0 : 32); if (kv >= qpos) rv = 1.0f; }
                    rr[i] = rv; if (a < 4) p0[r] = rv; else p1[r] = rv; }
                ga[a] = (rr[0] * rr[1]) * (rr[2] * rr[3]);
            }
            float oth[8], Ts[8];
#pragma unroll
            for (int a = 0; a < 8; ++a) oth[a] = other_half(ga[a], w.hi);
            float run = 1.0f;
#pragma unroll
            for (int a = 7; a >= 0; --a) { Ts[a] = run; run *= ga[a] * oth[a]; }
#pragma unroll
            for (int a = 0; a < 8; ++a) {
                float E = carry * Ts[a] * (w.hi ? 1.0f : oth[a]);
#pragma unroll
                for (int i = 3; i >= 0; --i) { const int r = 4 * (a & 3) + i; const float rv = (a < 4) ? p0[r] : p1[r]; const float wt = (1.0f - rv) * E; E *= rv; if (a < 4) p0[r] = wt; else p1[r] = wt; }
            }
            carry *= run;
            pack_pv(o, w.vb0 + slot * SLOTB, p0, p1);
            if (__all(carry < 1e-30f)) done = 1;
        } else {
            if (64 * T > qfirst + 31) return;
            LAS float* kbl = (LAS float*)(w.shm + L_KB);
            f32x16 c0, c1;
#pragma unroll
            for (int g = 0; g < 4; ++g) { const f32x4 k0 = *(const LAS f32x4*)(kbl + 64 * T + 8 * g + 4 * w.hi), k1 = *(const LAS f32x4*)(kbl + 64 * T + 32 + 8 * g + 4 * w.hi);
#pragma unroll
                for (int i = 0; i < 4; ++i) { c0[4 * g + i] = k0[i]; c1[4 * g + i] = k1[i]; } }
            f32x16 p0, p1; qkt(p0, p1, w.shm + L_K + slot * SLOTB, qr, c0, c1, w.r32, w.hi);
            if (64 * T + 63 > qfirst) {
#pragma unroll
                for (int r = 0; r < 16; ++r) { const int kv = 64 * T + crow(r, w.hi); if (kv > qpos) p0[r] = -INFINITY; if (kv + 32 > qpos) p1[r] = -INFINITY; } }
            softmax_step(p0, p1, mref, lsum, o, (LAS float*)(w.shm + L_WS) + w.wid * 64, w.r32, w.hi);
            pack_pv(o, w.vb0 + slot * SLOTB, p0, p1);
        }
    }
    __device__ __forceinline__ void finish(const UnitD& d, const WaveCtx& w, const f32x16* o) {
        LAS float* wsf = (LAS float*)(w.shm + L_WS) + w.wid * 64;
        float sc[16];
        if (MODE == 0) {
#pragma unroll
            for (int r = 0; r < 16; ++r) sc[r] = 1.0f;
        } else {
            float lt = lsum + other_half(lsum, w.hi);
            if (w.hi == 0) wsf[32 + w.r32] = lt;
            asm volatile("s_waitcnt lgkmcnt(0)" ::: "memory");
#pragma unroll
            for (int r = 0; r < 16; ++r) sc[r] = __builtin_amdgcn_rcpf(wsf[32 + crow(r, w.hi)]);
        }
        if (f8) store_o8(o, sc, w.shm + L_OST + w.wid * 4096, (unsigned char*)O + ((long)d.b * SEQ + d.qb * 256 + w.wid * 32) * DM + d.h * 64, DM, w.lane, w.r32, w.hi);
        else store_o(o, sc, w.shm + L_OST + w.wid * 4096, O + ((long)d.b * SEQ + d.qb * 256 + w.wid * 32) * DM + d.h * 64, DM, w.lane, w.r32, w.hi);
    }
};

struct DilMode {
    const bf16* PROJ; bf16* OG; float* ST; bf16* Of; int b, h, p, pass;
    float mref, lsum;
    __device__ __forceinline__ int units() const { return pass == 0 ? 8 : 4; }
    __device__ __forceinline__ int nstores() const { return 4; }
    __device__ __forceinline__ void desc(int j, UnitD& d) const {
        const int g = pass == 0 ? (j >> 2) : 2, i = j & 3; d.g = g; d.b = b; d.h = h; d.qb = 0;
        d.x = (g == 1) ? ((2 * (i >> 1) + p) << 1) + (i & 1) : 2 * i + p;
        const int i0 = (g == 0) ? 256 * d.x : (g == 1) ? 256 * (d.x & 1) : 0;
        d.NT = (g == 2) ? 4 : ((i0 >> 6) + 4 - t_lo(g, i0));
    }
    static __device__ __forceinline__ int t_lo(int g, int i0) { return (g == 2) ? 0 : ((i0 >> 6) >= 2 ? (i0 >> 6) - 2 : 0); }
    static __device__ __forceinline__ int dil_of(int g) { return (g == 0) ? 1 : (g == 1) ? 4 : 16; }
    static __device__ __forceinline__ int cls0_of(int g, int x) { return (g == 0) ? 0 : (g == 1) ? (x >> 1) : 2 * x; }
    static __device__ __forceinline__ int i0_of(int g, int x) { return (g == 0) ? 256 * x : (g == 1) ? 256 * (x & 1) : 0; }
    static __device__ __forceinline__ int tcls(int g, int x, int k) { return cls0_of(g, x) + ((g == 2) ? (k >> 1) : 0); }
    static __device__ __forceinline__ int kbase(int g, int x, int k) { return (g == 2) ? 64 * (k & 1) : 64 * (t_lo(g, i0_of(g, x)) + k); }
    __device__ __forceinline__ void q_load(const UnitD& d, const WaveCtx& w, bf16x8 (&q)[4]) const {
        const int dil = dil_of(d.g), clsw = cls0_of(d.g, d.x) + ((d.g == 2) ? (w.wid >> 2) : 0), qi0w = (d.g == 2) ? 32 * (w.wid & 3) : i0_of(d.g, d.x) + 32 * w.wid;
        const bf16* Qw = PROJ + (size_t)(2 * d.g) * PLANE + ((long)d.b * SEQ + clsw + (long)(qi0w + w.r32) * dil) * DM + d.h * 64 + w.hi * 8;
#pragma unroll
        for (int d0 = 0; d0 < 4; ++d0) q[d0] = gload16(Qw + d0 * 16);
    }
    __device__ __forceinline__ void dma(const UnitD& d, int k, int slot, const WaveCtx& w) const {
        const int dil = dil_of(d.g); const long tok0 = (long)d.b * SEQ + tcls(d.g, d.x, k) + (long)kbase(d.g, d.x, k) * dil;
        glds16(PROJ + (size_t)(2 * d.g + 1) * PLANE + (tok0 + (long)w.lane * dil) * DM + d.h * 64 + w.wid * 8, (unsigned)__builtin_amdgcn_readfirstlane(w.lds0 + L_K + slot * SLOTB + w.wid * 1024));
        glds16(PROJ + (size_t)6 * PLANE + (tok0 + (long)(16 * (w.wid & 3) + (w.lane >> 2)) * dil) * DM + d.h * 64 + (w.wid >> 2) * 32 + (w.lane & 3) * 8, (unsigned)__builtin_amdgcn_readfirstlane(w.lds0 + L_V + slot * SLOTB + w.wid * 1024));
    }
    __device__ __forceinline__ void begin(const UnitD&, const WaveCtx&) { mref = -1e30f; lsum = 0.f; }
    __device__ __forceinline__ int wave_done() const { return 0; }
    __device__ __forceinline__ void compute(const UnitD& d, int k, int slot, const WaveCtx& w, const bf16x8* qr, f32x16* o) {
        const int clsw = cls0_of(d.g, d.x) + ((d.g == 2) ? (w.wid >> 2) : 0), qi0w = (d.g == 2) ? 32 * (w.wid & 3) : i0_of(d.g, d.x) + 32 * w.wid;
        const int kb = kbase(d.g, d.x, k);
        if (tcls(d.g, d.x, k) != clsw || kb > qi0w + 31 || kb < qi0w - 191) return;
        LAS float* tbl = (LAS float*)(w.shm + L_KB) + d.g * 640 + 256;
        const int dbase = qi0w + w.r32 - kb - 4 * w.hi;
        f32x16 c0, c1;
#pragma unroll
        for (int r = 0; r < 16; ++r) { const int cr = (r & 3) + 8 * (r >> 2); c0[r] = tbl[dbase - cr]; c1[r] = tbl[dbase - cr - 32]; }
        f32x16 p0, p1; qkt(p0, p1, w.shm + L_K + slot * SLOTB, qr, c0, c1, w.r32, w.hi);
        softmax_step(p0, p1, mref, lsum, o, (LAS float*)(w.shm + L_WS) + w.wid * 64, w.r32, w.hi);
        pack_pv(o, w.vb0 + slot * SLOTB, p0, p1);
    }
    __device__ __forceinline__ void finish(const UnitD& d, const WaveCtx& w, const f32x16* o) {
        const int dil = dil_of(d.g), clsw = cls0_of(d.g, d.x) + ((d.g == 2) ? (w.wid >> 2) : 0), qi0w = (d.g == 2) ? 32 * (w.wid & 3) : i0_of(d.g, d.x) + 32 * w.wid;
        LAS float* wsf = (LAS float*)(w.shm + L_WS) + w.wid * 64;
        const float lt = lsum + other_half(lsum, w.hi);
        if (w.hi == 0) { wsf[32 + w.r32] = lt; wsf[w.r32] = mref;
            if (pass == 0) { const long tok = (long)d.b * SEQ + clsw + (long)(qi0w + w.r32) * dil;
                *(f32x2*)(ST + ((size_t)d.g * M * NH + (size_t)tok * NH + d.h) * 2) = (f32x2){mref, lt}; } }
        asm volatile("s_waitcnt lgkmcnt(0)" ::: "memory");
        float sc[16];
#pragma unroll
        for (int r = 0; r < 16; ++r) sc[r] = __builtin_amdgcn_rcpf(wsf[32 + crow(r, w.hi)]);
        if (pass == 0) { store_o(o, sc, w.shm + L_OST + w.wid * 4096, OG + (size_t)d.g * PLANE + ((long)d.b * SEQ + clsw + (long)qi0w * dil) * DM + d.h * 64, (long)dil * DM, w.lane, w.r32, w.hi); return; }
        LAS bf16* stg = (LAS bf16*)(w.shm + L_OST + w.wid * 4096);
#pragma unroll
        for (int r = 0; r < 16; ++r) { const int orow = crow(r, w.hi);
#pragma unroll
            for (int d0 = 0; d0 < 2; ++d0) stg[orow * 64 + d0 * 32 + w.r32] = (bf16)f2bf(o[d0][r] * sc[r]); }
        asm volatile("s_waitcnt lgkmcnt(0)" ::: "memory");
#pragma unroll
        for (int i = 0; i < 4; ++i) { const int row = i * 8 + (w.lane >> 3), ch = w.lane & 7;
            const long tok = (long)d.b * SEQ + clsw + (long)(qi0w + row) * dil;
            const f32x2 s0 = *(const f32x2*)(ST + ((size_t)0 * M * NH + (size_t)tok * NH + d.h) * 2), s1 = *(const f32x2*)(ST + ((size_t)1 * M * NH + (size_t)tok * NH + d.h) * 2);
            const float m2 = wsf[row], l2 = wsf[32 + row];
            const float mx = fmaxf(s0.x, fmaxf(s1.x, m2));
            float w0 = __builtin_amdgcn_exp2f(s0.x - mx) * s0.y, w1 = __builtin_amdgcn_exp2f(s1.x - mx) * s1.y, w2 = __builtin_amdgcn_exp2f(m2 - mx) * l2;
            const float inv = __builtin_amdgcn_rcpf(w0 + w1 + w2); w0 *= inv; w1 *= inv; w2 *= inv;
            const v4u x0 = *(const GAS v4u*)(OG + (size_t)tok * DM + d.h * 64 + ch * 8), x1 = *(const GAS v4u*)(OG + PLANE + (size_t)tok * DM + d.h * 64 + ch * 8);
            const v4u x2 = *(const LAS v4u*)(stg + row * 64 + ch * 8); v4u rr;
#pragma unroll
            for (int q = 0; q < 4; ++q) { const float lo = w0 * bflo(x0[q]) + w1 * bflo(x1[q]) + w2 * bflo(x2[q]), hi2 = w0 * bfhi(x0[q]) + w1 * bfhi(x1[q]) + w2 * bfhi(x2[q]);
                if (WO_FP8) rr[q] = (unsigned)__builtin_amdgcn_cvt_pk_fp8_f32(__builtin_amdgcn_fmed3f(lo * (float)A8S, -448.f, 448.f), __builtin_amdgcn_fmed3f(hi2 * (float)A8S, -448.f, 448.f), 0, false) & 0xffffu;
                else rr[q] = pk2(lo, hi2); }
            if (WO_FP8) *(GAS v2u*)((GAS unsigned char*)Of + (size_t)tok * DM + d.h * 64 + ch * 8) = (v2u){rr[0] | (rr[1] << 16), rr[2] | (rr[3] << 16)};
            else *(GAS v4u*)(Of + (size_t)tok * DM + d.h * 64 + ch * 8) = rr; }
    }
};

template <class Mode, bool EARLY_EXIT>
__device__ __forceinline__ void stream_units(Mode& Mo, const WaveCtx& w) {
    LAS int* flg = (LAS int*)(w.shm + L_FLG);
    const int nun = Mo.units();
    int pj = 0, pk = 0, pseq = 0, cseq = 0;
    int qmark = 0, smark = 0, scnt = 0;
    UnitD pd; Mo.desc(0, pd);
    bf16x8 qn[4];
    if (EARLY_EXIT && w.wid == 0 && w.lane < 4) flg[w.lane] = 0;
    asm volatile("s_waitcnt vmcnt(0)" ::: "memory");
#define ATT_PRODUCE() do { if (pj < nun) { if (pk == 0) { Mo.q_load(pd, w, qn); qmark = pseq; } Mo.dma(pd, pk, pseq % NSLOT, w); ++pseq; if (++pk == pd.NT) { pk = 0; if (++pj < nun) Mo.desc(pj, pd); } } } while (0)
#pragma unroll 1
    for (int i = 0; i < AHEAD; ++i) ATT_PRODUCE();
#pragma unroll 1
    for (int cj = 0; cj < nun; ++cj) {
        UnitD d; Mo.desc(cj, d);
        bf16x8 qr[4];
        f32x16 o[2]; o[0] = f32x16{}; o[1] = f32x16{};
        Mo.begin(d, w);
        const int useq0 = cseq;
        int rep = 0;
#pragma unroll 1
        while (pseq - cseq < AHEAD && pj < nun) ATT_PRODUCE();
#pragma unroll 1
        for (int ck = 0; ck < d.NT; ++ck) {
            wait_bar(2 * (pseq - cseq - 1) + (qmark > cseq ? 4 : 0) + (smark > cseq ? scnt : 0));
            if (ck == 0) { asm volatile("" : "+v"(qn[0]), "+v"(qn[1]), "+v"(qn[2]), "+v"(qn[3])); qr[0] = qn[0]; qr[1] = qn[1]; qr[2] = qn[2]; qr[3] = qn[3]; }
            if (EARLY_EXIT && ck == 1 && w.wid == 0 && w.lane < 2) flg[((cj + 1) & 1) * 2 + w.lane] = 0;
            if (EARLY_EXIT && ck > 0) {
                if (__builtin_amdgcn_readfirstlane(flg[(cj & 1) * 2 + ((ck - 1) & 1)]) == 8) {
                    const int uend = useq0 + d.NT;
                    if (pj == cj) { pk = 0; if (++pj < nun) Mo.desc(pj, pd); }
                    cseq = uend < pseq ? uend : pseq;
                    break; } }
            if (pseq - cseq < AHEAD) ATT_PRODUCE();
            Mo.compute(d, ck, cseq % NSLOT, w, qr, o);
            if (EARLY_EXIT && Mo.wave_done() && rep < 2) { if (w.lane == 0) __hip_atomic_fetch_add(&flg[(cj & 1) * 2 + (ck & 1)], 1, __ATOMIC_RELAXED, __HIP_MEMORY_SCOPE_WORKGROUP); ++rep; }
            ++cseq;
        }
        Mo.finish(d, w, o);
        smark = pseq; scnt = Mo.nstores();
    }
    asm volatile("s_waitcnt vmcnt(0) lgkmcnt(0)\n\ts_barrier" ::: "memory");
#undef ATT_PRODUCE
}
__device__ __forceinline__ WaveCtx make_ctx(lptr shm) {
    WaveCtx w; const int tid = threadIdx.x; w.lane = tid & 63; w.r32 = w.lane & 31; w.hi = w.lane >> 5; w.wid = __builtin_amdgcn_readfirstlane(tid >> 6);
    w.shm = shm; w.lds0 = (unsigned)(uintptr_t)shm;
    w.vb0 = (int)(w.lds0 + L_V) + ((w.lane >> 4) & 1) * 32 + (w.lane & 3) * 8 + (4 * w.hi + ((w.lane & 15) >> 2)) * 64;
    return w;
}
template <int MODE>
__device__ __forceinline__ void causal_phase(lptr shm, int G, const bf16* Q, const bf16* K, const bf16* V, bf16* O, const float* cum, bool f8) {
    const int bx = blockIdx.x; const int vcu = (G % 8 == 0) ? (bx % 8) * (G / 8) + bx / 8 : bx;
    const WaveCtx w = make_ctx(shm);
    for (int u = vcu; u < BATCH * NH * 2; u += G) {
        CausalMode<MODE> Mo; Mo.Q = Q; Mo.K = K; Mo.V = V; Mo.O = O; Mo.f8 = f8; Mo.b = u >> 5; Mo.h = (u >> 1) & 15; Mo.p = u & 1;
        if (MODE == 2) {
            LAS float* kbl = (LAS float*)(shm + L_KB); LAS float* wtot = (LAS float*)(shm + L_FLG + 64);
            const int t4 = threadIdx.x * 4; float v0, v1, v2, v3;
            { const float* lp = cum + ((long)Mo.b * SEQ + t4) * 16 + Mo.h; v0 = lp[0]; v1 = lp[16]; v2 = lp[32]; v3 = lp[48]; }
            v1 += v0; v2 += v1; v3 += v2;
            float incl = v3;
#pragma unroll
            for (int o = 1; o < 64; o <<= 1) { const float t = __shfl_up(incl, o); if (w.lane >= o) incl += t; }
            if (w.lane == 63) wtot[w.wid] = incl;
            __syncthreads();
            float off = incl - v3;
#pragma unroll
            for (int x = 0; x < 8; ++x) off += (x < w.wid) ? wtot[x] : 0.f;
            *(LAS f32x4*)(kbl + t4) = (f32x4){-(off + v0), -(off + v1), -(off + v2), -(off + v3)};
        }
        stream_units<CausalMode<MODE>, MODE == 0>(Mo, w);
    }
}
__device__ __forceinline__ int t5_bucket_f(int dist) {
    if (dist < 16) return dist;
    int lb = 16 + (int)(logf((float)dist / 16.0f) / logf(128.0f) * 16.0f);
    return lb < 31 ? lb : 31;
}
__device__ __forceinline__ void dil_phase(lptr shm, int G, const bf16* PROJ, bf16* OG, float* ST, const float* rel_bias, int pass, bf16* Of) {
    const int bx = blockIdx.x; const int vcu = (G % 8 == 0) ? (bx % 8) * (G / 8) + bx / 8 : bx;
    const WaveCtx w = make_ctx(shm);
    for (int u = vcu; u < BATCH * NH * 2; u += G) {
        DilMode Mo; Mo.PROJ = PROJ; Mo.OG = OG; Mo.ST = ST; Mo.Of = Of; Mo.pass = pass; Mo.b = u >> 5; Mo.h = (u >> 1) & 15; Mo.p = u & 1;
        LAS float* tb = (LAS float*)(shm + L_KB);
        for (int i = threadIdx.x; i < 3 * 640; i += NTHR) { const int gg = i / 640, dl = i - gg * 640 - 256; const int dil = (gg == 0) ? 1 : (gg == 1) ? 4 : 16;
            tb[i] = (dl >= 0 && dl <= 128) ? rel_bias[t5_bucket_f(dl * dil) * 16 + Mo.h] * LOG2E : -INFINITY; }
        stream_units<DilMode, false>(Mo, w);
    }
}
__device__ __forceinline__ void dil_merge(int G, const bf16* OG, const float* ST, bf16* O) {
    for (int idx = blockIdx.x * NTHR + threadIdx.x; idx < M * NH; idx += G * NTHR) {
        const f32x2 s0 = *(const f32x2*)(ST + ((size_t)0 * M * NH + idx) * 2), s1 = *(const f32x2*)(ST + ((size_t)1 * M * NH + idx) * 2), s2 = *(const f32x2*)(ST + ((size_t)2 * M * NH + idx) * 2);
        const float mx = fmaxf(s0.x, fmaxf(s1.x, s2.x));
        float w0 = __builtin_amdgcn_exp2f(s0.x - mx) * s0.y, w1 = __builtin_amdgcn_exp2f(s1.x - mx) * s1.y, w2 = __builtin_amdgcn_exp2f(s2.x - mx) * s2.y;
        const float inv = 1.0f / (w0 + w1 + w2); w0 *= inv; w1 *= inv; w2 *= inv;
        const GAS v4u* a0 = (const GAS v4u*)(OG + (size_t)idx * 64); const GAS v4u* a1 = (const GAS v4u*)(OG + PLANE + (size_t)idx * 64); const GAS v4u* a2 = (const GAS v4u*)(OG + 2 * PLANE + (size_t)idx * 64);
        GAS v4u* op = (GAS v4u*)(O + (size_t)idx * 64);
#pragma unroll
        for (int c = 0; c < 8; ++c) { const v4u x0 = a0[c], x1 = a1[c], x2 = a2[c]; v4u r;
#pragma unroll
            for (int q = 0; q < 4; ++q) r[q] = pk2(w0 * bflo(x0[q]) + w1 * bflo(x1[q]) + w2 * bflo(x2[q]), w0 * bfhi(x0[q]) + w1 * bfhi(x1[q]) + w2 * bfhi(x2[q]));
            op[c] = r; }
    }
}
}

enum { CV_PLAIN = 0, CV_QKN = 1, CV_GATE = 2, CV_UP = 3 };
__device__ __forceinline__ int cv_dst_row(int mode, int n) {
    if (mode == CV_QKN) return (n & ~255) + 128 * ((n >> 5) & 1) + 32 * ((n >> 6) & 3) + (n & 31);
    if (mode == CV_GATE) return 256 * (n >> 7) + (n & 127);
    if (mode == CV_UP) return 256 * (n >> 7) + 128 + (n & 127);
    return n;
}
__device__ __forceinline__ void conv_item(const float* W, int ldw, int K, bf16* WT, int mode, LAS unsigned char* scr, int item, int nblk, int lane) {
    const int kb = item / nblk, nb = item - kb * nblk, k0 = 64 * kb, n0 = 64 * nb;
    const GAS float* src = (const GAS float*)(W + (size_t)k0 * ldw + n0 + lane);
#pragma unroll
    for (int kc = 0; kc < 8; ++kc) {
        float v[8];
#pragma unroll
        for (int j = 0; j < 8; ++j) v[j] = src[(size_t)(kc * 8 + j) * ldw];
        v4u w; w.x = pk2(v[0], v[1]); w.y = pk2(v[2], v[3]); w.z = pk2(v[4], v[5]); w.w = pk2(v[6], v[7]);
        *(LAS v4u*)(scr + lane * 144 + kc * 16) = w;
    }
    asm volatile("s_waitcnt lgkmcnt(0)" ::: "memory");
#pragma unroll
    for (int j = 0; j < 8; ++j) { const int n = 8 * j + (lane >> 3), ch = lane & 7;
        const v4u w = *(const LAS v4u*)(scr + n * 144 + ch * 16);
        *(GAS v4u*)(WT + (size_t)cv_dst_row(mode, n0 + n) * K + k0 + 8 * ch) = w; }
    asm volatile("s_waitcnt lgkmcnt(0)" ::: "memory");
}
__device__ __forceinline__ void conv_item8(const float* W, int ldw, int K, unsigned char* WT8, int mode, LAS unsigned char* scr, int item, int nblk, int lane) {
    const int kb = item / nblk, nb = item - kb * nblk, k0 = 128 * kb, n0 = 64 * nb;
    const GAS float* src = (const GAS float*)(W + (size_t)k0 * ldw + n0 + lane);
#pragma unroll 4
    for (int kc = 0; kc < 16; ++kc) {
        float v[8];
#pragma unroll
        for (int j = 0; j < 8; ++j) v[j] = src[(size_t)(kc * 8 + j) * ldw] * W8S;
        v2u w; w.x = pg8::cvt4_fp8(v[0], v[1], v[2], v[3]); w.y = pg8::cvt4_fp8(v[4], v[5], v[6], v[7]);
        *(LAS v2u*)(scr + lane * 144 + kc * 8) = w;
    }
    asm volatile("s_waitcnt lgkmcnt(0)" ::: "memory");
#pragma unroll
    for (int j = 0; j < 8; ++j) { const int n = 8 * j + (lane >> 3), ch = lane & 7;
        const v4u w = *(const LAS v4u*)(scr + n * 144 + ch * 16);
        *(GAS v4u*)(WT8 + (size_t)cv_dst_row(mode, n0 + n) * K + k0 + 16 * ch) = w; }
    asm volatile("s_waitcnt lgkmcnt(0)" ::: "memory");
}
static_assert(MOE_FP8 && DILIN_FP8 && FOXIN_FP8 && QKV3_FP8 && DENSE_FP8_L2 && !DENSE_FP8_L0, "the conversion queue is laid out for this precision plan");
constexpr int CV_TOTAL = 28608;
static_assert(WO_FP8, "the conversion queue below holds e4m3 Wo weights for layers 1-3");
constexpr int cv_need(int p) {
    return p >= 24 ? 28608 : p >= 23 ? 25024 : p >= 21 ? 17856 : p >= 19 ? 17728 : p >= 18 ? 17344 : p >= 17 ? 16896 : p >= 16 ? 16000 : p >= 14 ? 15872 : p >= 12 ? 15488
         : p >= 11 ? 11904 : p >= 9 ? 4736 : p >= 6 ? 4608 : p >= 5 ? 3712 : p >= 4 ? 2816 : p >= 3 ? 1024 : p >= 1 ? 768 : 0;
}
__device__ __forceinline__ void cv_run_item(Frame& F, int idx) {
    LAS unsigned char* scr = F.lds + F.wave * 9216;
    unsigned char* WB8 = F.ws + WS_W;
    int inp, ldw, K, N, mode = CV_PLAIN, it; size_t soff = 0, doff; bool f8 = false;
    if (idx < 768)        { it = idx;         inp = 1;  ldw = 3 * DM; K = DM; N = 3 * DM; doff = WE_QKV * 2; }
    else if (idx < 1024)  { it = idx - 768;   inp = 2;  ldw = DM; K = DM; N = DM; doff = WE_WO_SB * 2; }
    else if (idx < 2816)  { const int l = idx - 1024, u = l >= 896; it = l - 896 * u; inp = 15 + u; ldw = FF; K = DM; N = FF; doff = WE_GU * 2; mode = u ? CV_UP : CV_GATE; }
    else if (idx < 3712)  { it = idx - 2816;  inp = 17; ldw = DM; K = FF; N = DM; doff = WE_D * 2; }
    else if (idx < 4608)  { it = idx - 3712;  inp = 3;  ldw = 7 * DM; K = DM; N = 7 * DM; doff = WE_IN_DIL * 2; mode = CV_QKN; f8 = true; }
    else if (idx < 4736)  { it = idx - 4608;  inp = 6;  ldw = DM; K = DM; N = DM; doff = WE_WO_DIL * 2; f8 = true; }
    else if (idx < 15872) {
        if (idx < 11904)      { const int l = idx - 4736, fe = l / 896, r = l - fe * 896, u = r >= 448; it = r - 448 * u; inp = 19 + u; ldw = FF; K = DM; N = FF; soff = (size_t)fe * DM * FF;
                                doff = WE_MGU * 2 + (size_t)fe * 2 * FF * DM; mode = u ? CV_UP : CV_GATE; f8 = true; }
        else if (idx < 15488) { const int l = idx - 11904, fe = l / 448; it = l - fe * 448; inp = 21; ldw = DM; K = FF; N = DM; soff = (size_t)fe * FF * DM; doff = WE_MD * 2 + (size_t)fe * DM * FF; f8 = true; }
        else                  { it = idx - 15488; inp = 7; ldw = 3088; K = DM; N = 3 * DM; doff = WE_IN_FOX * 2; mode = CV_QKN; f8 = true; }
    }
    else if (idx < 16000) { it = idx - 15872; inp = 11; ldw = DM; K = DM; N = DM; doff = WE_WO_FOX * 2; f8 = true; }
    else if (idx < 16896) { const int l = idx - 16000, u = l >= 448; it = l - 448 * u; inp = 15 + u; ldw = FF; K = DM; N = FF; soff = (size_t)DM * FF; doff = (WE_GU + (size_t)2 * FF * DM) * 2; mode = u ? CV_UP : CV_GATE; f8 = true; }
    else if (idx < 17344) { it = idx - 16896; inp = 17; ldw = DM; K = FF; N = DM; soff = (size_t)FF * DM; doff = (WE_D + (size_t)DM * FF) * 2; f8 = true; }
    else if (idx < 17728) { it = idx - 17344; inp = 1;  ldw = 3 * DM; K = DM; N = 3 * DM; soff = (size_t)DM * 3 * DM; doff = (WE_QKV + (size_t)3 * DM * DM) * 2; f8 = true; }
    else if (idx < 17856) { it = idx - 17728; inp = 2;  ldw = DM; K = DM; N = DM; soff = (size_t)DM * DM; doff = (WE_WO_SB + (size_t)DM * DM) * 2; f8 = true; }
    else if (idx < 25024) { const int l = idx - 17856, fe = 8 + l / 896, r = l - (fe - 8) * 896, u = r >= 448; it = r - 448 * u; inp = 19 + u; ldw = FF; K = DM; N = FF; soff = (size_t)fe * DM * FF;
                            doff = WE_MGU * 2 + (size_t)fe * 2 * FF * DM; mode = u ? CV_UP : CV_GATE; f8 = true; }
    else                  { const int l = idx - 25024, fe = 8 + l / 448; it = l - (fe - 8) * 448; inp = 21; ldw = DM; K = FF; N = DM; soff = (size_t)fe * FF * DM; doff = WE_MD * 2 + (size_t)fe * DM * FF; f8 = true; }
    const float* src = inp_ptr(F, inp) + soff;
    if (f8) conv_item8(src, ldw, K, WB8 + doff, mode, scr, it, N / 64, F.lane);
    else conv_item(src, ldw, K, (bf16*)(WB8 + doff), mode, scr, it, N / 64, F.lane);
}
__device__ __forceinline__ void cv_drain(Frame& F, int need) {
    if (need <= 0) return;
    volatile LAS int* cw = (volatile LAS int*)(F.lds + MISC_OFF) + 16;
    unsigned* nxt = (unsigned*)(F.ctl + CW_CVQ);
    asm volatile("s_waitcnt vmcnt(0)" ::: "memory");
    for (;;) {
        __syncthreads();
        if (F.tid == 0) { int b = -1; if ((int)xb_ld(nxt) < need) b = (int)xb_add(nxt, 8u); cw[0] = b; }
        __syncthreads();
        const int base = cw[0];
        if (base < 0) break;
        if (base + F.wave < CV_TOTAL) cv_run_item(F, base + F.wave);
    }
}
__device__ __forceinline__ void xcd_barrier_steal(const XcdBarrier& b, Frame& F) {
    asm volatile("s_waitcnt vmcnt(0)" ::: "memory");
    __syncthreads();
    volatile LAS int* cw = (volatile LAS int*)(F.lds + MISC_OFF) + 16;
    unsigned* bar = b.bar; unsigned* nxt = (unsigned*)(F.ctl + CW_CVQ);
    unsigned gen = 0u, tg = 0u; int role = 0;
    if (threadIdx.x == 0) {
        __builtin_amdgcn_s_waitcnt(0);
        unsigned nloc = b.st[0], nx = b.st[1];
        if (nloc == 0u) { xcd_barrier_complete(bar, b.x, nloc, nx); b.st[0] = nloc; b.st[1] = nx; }
        const unsigned old = xb_add(&bar[XB_XSUB(b.x)], 1u);
        gen = old / nloc;
        if (old + 1u == (gen + 1u) * nloc) {
            __builtin_amdgcn_fence(__ATOMIC_RELEASE, "agent");
            asm volatile("s_waitcnt vmcnt(0)" ::: "memory");
            const unsigned og = xb_add(&bar[XB_TOP], 1u);
            tg = og / nx;
            if (og + 1u == (tg + 1u) * nx) { xb_add(&bar[XB_TOPGEN], 1u); xb_add(&bar[XB_XGEN(b.x)], 1u); role = 0; }
            else role = 1;
        } else role = 2;
    }
    for (;;) {
        if (threadIdx.x == 0) {
            int rel = 1, base = -1;
            if (role == 1) { XB_SPIN(xb_ld(&bar[XB_TOPGEN]) == tg, bar); xb_add(&bar[XB_XGEN(b.x)], 1u); role = 0; }
            else if (role == 2) { if (xb_ld(&bar[XB_XGEN(b.x)]) == gen) rel = 0; }
            if (!rel) {
                if ((int)xb_ld(nxt) < CV_TOTAL) base = (int)xb_add(nxt, 8u);
                else { XB_SPIN(xb_ld(&bar[XB_XGEN(b.x)]) == gen, bar); rel = 1; }
            }
            cw[0] = rel; cw[1] = base;
        }
        __syncthreads();
        const int rel = cw[0], base = cw[1];
        __syncthreads();
        if (rel) break;
        if (base >= 0 && base + F.wave < CV_TOTAL) cv_run_item(F, base + F.wave);
    }
    if (threadIdx.x == 0) { __builtin_amdgcn_fence(__ATOMIC_ACQUIRE, "agent"); asm volatile("s_waitcnt vmcnt(0)" ::: "memory"); }
    __syncthreads();
}

__device__ __forceinline__ int moe_cnt(Frame& F, int f, int e) {
    const unsigned long long w = __hip_atomic_load((GAS unsigned long long*)(F.ctl + CW_CNT + f * 64 + 16 * (e >> 2)), RLX_AGENT);
    return (int)((w >> (16 * (e & 3))) & 0xffffull);
}
__device__ __forceinline__ f32x4 moe_yrow(Frame& F, int r, int q4) {
    const bf16* Y = (const bf16*)(F.ws + WS_R2); const bf16* P = (const bf16*)(F.ws + WS_R2 + 72 * MiB);
    if (r < SPLIT_ROW0 || F.G != 256 || !MOE_SPLITK) {
        if (MOE_Y_FP8) { const int a = ((const GAS int*)((const unsigned char*)Y + (size_t)r * DM))[q4]; const f32x2 lo = __builtin_amdgcn_cvt_pk_f32_fp8(a, false), hi = __builtin_amdgcn_cvt_pk_f32_fp8(a, true);
            return (f32x4){lo.x, lo.y, hi.x, hi.y} * (1.0f / Y8S); }
        const v2u a = ((const GAS v2u*)(Y + (size_t)r * DM))[q4]; return (f32x4){bflo(a.x), bfhi(a.x), bflo(a.y), bfhi(a.y)}; }
    f32x4 s = (f32x4){0.f, 0.f, 0.f, 0.f};
#pragma unroll
    for (int k = 0; k < MOE_NSPLIT; ++k) { const v2u a = ((const GAS v2u*)(P + ((size_t)k * SPLIT_ROWS + (size_t)(r - SPLIT_ROW0)) * DM))[q4]; s = s + (f32x4){bflo(a.x), bfhi(a.x), bflo(a.y), bfhi(a.y)}; }
    return s;
}
__device__ __forceinline__ void moe_bases(Frame& F, int f, int (&tb)[NE + 1]) {
    int acc = 0;
#pragma unroll
    for (int e = 0; e < NE; ++e) { tb[e] = acc; const int c = moe_cnt(F, f, e); acc += (c + 255) >> 8; }
    tb[NE] = acc;
}

template <int NC>
__device__ __forceinline__ float wave_reduce_cols(float (&part)[NC], int lane) {
#pragma unroll
    for (int st = 0, n = NC / 2; n >= 1; ++st, n >>= 1) {
        const bool up = (lane >> st) & 1;
#pragma unroll
        for (int i = 0; i < n; ++i) { const float keep = up ? part[i + n] : part[i], send = up ? part[i] : part[i + n]; part[i] = keep + __shfl_xor(send, 1 << st); }
    }
    float v = part[0];
#pragma unroll
    for (int o = NC; o < 64; o <<= 1) v += __shfl_xor(v, o);
    return v;
}
template <int NC> __device__ __forceinline__ int lane_of_col(int c) {
    int l = 0;
#pragma unroll
    for (int st = 0, n = NC / 2; n >= 1; ++st, n >>= 1) { if (c & n) l |= 1 << st; }
    return l;
}
__device__ __forceinline__ void panel_sync(Frame& F, const pg8::DenseOrder& S, unsigned* cnt) {
    if (F.tid == 0) {
        unsigned* bar = (unsigned*)(F.ctl + CW_BAR);
        const unsigned x = xb_xcc_id();
        bool mixed = false; pg8::Unit u;
        for (int i = 0; S.next(i, u); ++i) { unsigned w = 0u; XB_SPIN(((w = xb_ld(&cnt[u.pm])) & 15u) < 4u, bar); if (x >= 8u || ((w >> (4 + 3 * x)) & 7u) != 4u) mixed = true; }
        if (mixed) {
            __builtin_amdgcn_fence(__ATOMIC_RELEASE, "agent");
            asm volatile("s_waitcnt vmcnt(0)" ::: "memory");
            for (int i = 0; S.next(i, u); ++i) { const unsigned w = xb_ld(&cnt[u.pm]); if (x >= 8u || ((w >> (4 + 3 * x)) & 7u) != 4u) xb_add(&cnt[6 * 64 + u.pm], 1u); }
            for (int i = 0; S.next(i, u); ++i) { const unsigned w = xb_ld(&cnt[u.pm]); if (x >= 8u || ((w >> (4 + 3 * x)) & 7u) != 4u) XB_SPIN(xb_ld(&cnt[6 * 64 + u.pm]) < 4u, bar); }
        }
        __builtin_amdgcn_fence(__ATOMIC_ACQUIRE, "agent");
        asm volatile("s_waitcnt vmcnt(0)" ::: "memory");
    }
    __syncthreads();
}
template <int FLAGS>
__device__ __forceinline__ void norm_phase(Frame& F, const void* xin, void* xout, const float* gain, bf16* H, int fprev, int f,
                                           const float* Wf  , const float* bf  , const float* Wr  ,
                                           const pg8::DenseOrder* PS = nullptr, unsigned* pcnt = nullptr) {
    constexpr int NC = (FLAGS & 2) ? 16 : (FLAGS & 4) ? 8 : 0;
    const bf16* Y = (const bf16*)(F.ws + WS_R2);
    const int* tok_prev = (const int*)(F.ws + WS_MISC + MS_TOK) + (size_t)fprev * M * 2;
    float* lgf = (float*)(F.ws + WS_MISC + MS_LOGF);
    LAS int* sel = (LAS int*)F.lds;
    LAS float* sg = (LAS float*)(F.lds + 512);
    LAS int* gb = (LAS int*)(F.lds + 1536);
    LAS f32x4* WL = (LAS f32x4*)(F.lds + 4096);
    int tb[NE + 1];
    if (FLAGS & 1) moe_bases(F, fprev, tb);
    if (NC) {
        const float* Wsrc = (FLAGS & 2) ? Wf + 3072 : Wr; const int ldw = (FLAGS & 2) ? 3088 : 8;
        for (int idx = F.tid; idx < 16 * (NC / 4) * 64; idx += NTHR) {
            const int ln = idx & 63, cq = (idx >> 6) % (NC / 4), jq = idx / (64 * (NC / 4)), k = 4 * (ln + 64 * (jq >> 2)) + (jq & 3);
            WL[idx] = *(const GAS f32x4*)(Wsrc + (size_t)k * ldw + 4 * cq) * gain[k];
        }
        __syncthreads();
    }
    if (NC == 0 && !(FLAGS & 1)) {
        if (FLAGS & 64) panel_sync(F, *PS, pcnt);
        for (int it = 0;; ++it) {
            int chunk;
            if (FLAGS & 64) { pg8::Unit pu; if (!PS->next(it, pu)) break; chunk = pu.pm * 4 + pu.pn; }
            else { chunk = blockIdx.x + it * F.G; if (chunk >= M / 64) break; }
#pragma unroll 1
            for (int i = 0; i < 8; i += 4) {
                const int m0 = chunk * 64 + F.wave * 8 + i;
                int ln = F.lane; asm volatile("" : "+v"(ln));
                f32x4 v[4][4];
#pragma unroll
                for (int r = 0; r < 4; ++r) {
                    if (FLAGS & 16) { const GAS v2u* xr = (const GAS v2u*)((const bf16*)xin + (size_t)(m0 + r) * DM) + ln;
#pragma unroll
                        for (int j = 0; j < 4; ++j) { const v2u a = xr[64 * j]; v[r][j] = (f32x4){bflo(a.x), bfhi(a.x), bflo(a.y), bfhi(a.y)}; } }
                    else { const GAS f32x4* xr = (const GAS f32x4*)((const float*)xin + (size_t)(m0 + r) * DM) + ln;
#pragma unroll
                        for (int j = 0; j < 4; ++j) v[r][j] = xr[64 * j]; }
                }
                f32x4 g[4];
#pragma unroll
                for (int j = 0; j < 4; ++j) g[j] = ((const GAS f32x4*)gain + ln)[64 * j];
#pragma unroll
                for (int r = 0; r < 4; ++r) {
                    const int m = m0 + r;
                    if (FLAGS & 32) {
#pragma unroll
                        for (int j = 0; j < 4; ++j) ((GAS v2u*)((bf16*)xout + (size_t)m * DM) + ln)[64 * j] = (v2u){pk2(v[r][j].x, v[r][j].y), pk2(v[r][j].z, v[r][j].w)}; }
                    float s = 0.f;
#pragma unroll
                    for (int j = 0; j < 4; ++j) s += (v[r][j].x * v[r][j].x + v[r][j].y * v[r][j].y) + (v[r][j].z * v[r][j].z + v[r][j].w * v[r][j].w);
                    const float inv = 1.0f / sqrtf(wave_sum(s) * (1.f / DM) + RMS_EPS);
                    GAS unsigned long long* o8 = (GAS unsigned long long*)(H + (size_t)m * DM) + ln;
                    GAS unsigned* h8 = (GAS unsigned*)(F.ws + WS_R2 + 104 * MiB + (size_t)m * DM) + ln;
#pragma unroll
                    for (int j = 0; j < 4; ++j) { const f32x4 hv = v[r][j] * inv * g[j];
                        if (FLAGS & 8) h8[64 * j] = pg8::cvt4_fp8(hv.x, hv.y, hv.z, hv.w);
                        else o8[64 * j] = (unsigned long long)pk2(hv.x, hv.y) | ((unsigned long long)pk2(hv.z, hv.w) << 32); }
                }
            }
        }
        return;
    }
    if (FLAGS & 64) panel_sync(F, *PS, pcnt);
    for (int it = 0;; ++it) {
        int chunk;
        if (FLAGS & 64) { pg8::Unit pu; if (!PS->next(it, pu)) break; chunk = pu.pm * 4 + pu.pn; }
        else { chunk = blockIdx.x + it * F.G; if (chunk >= M / 64) break; }
        v2u nx[4];
        if (FLAGS & 16) { int l0 = F.lane; asm volatile("" : "+v"(l0)); const GAS v2u* xr = (const GAS v2u*)((const bf16*)xin + (size_t)(chunk * 64 + F.wave * 8) * DM) + l0;
#pragma unroll
            for (int j = 0; j < 4; ++j) nx[j] = xr[64 * j]; }
        for (int i = 0; i < 8; ++i) {
            const int m = chunk * 64 + F.wave * 8 + i;
            int ln = F.lane; asm volatile("" : "+v"(ln));
            f32x4 v[4];
            if (FLAGS & 16) {
#pragma unroll
                for (int j = 0; j < 4; ++j) { const v2u a = nx[j]; v[j] = (f32x4){bflo(a.x), bfhi(a.x), bflo(a.y), bfhi(a.y)}; }
                if (i < 7) { const GAS v2u* xr = (const GAS v2u*)((const bf16*)xin + (size_t)(m + 1) * DM) + ln;
#pragma unroll
                    for (int j = 0; j < 4; ++j) nx[j] = xr[64 * j]; } }
            else { const GAS f32x4* xr = (const GAS f32x4*)((const float*)xin + (size_t)m * DM) + ln;
#pragma unroll
                for (int j = 0; j < 4; ++j) v[j] = xr[64 * j]; }
            if (FLAGS & 1) {
                const int s0 = tok_prev[m * 2], s1 = tok_prev[m * 2 + 1];
                int r0 = 0, r1 = 0;
#pragma unroll
                for (int e = 0; e < NE; ++e) { if ((s0 >> 14) == e) r0 = tb[e] * 256 + (s0 & 16383); if ((s1 >> 14) == e) r1 = tb[e] * 256 + (s1 & 16383); }
#pragma unroll
                for (int j = 0; j < 4; ++j) { v[j] = v[j] + moe_yrow(F, r0, ln + 64 * j) + moe_yrow(F, r1, ln + 64 * j);
                    ((GAS v2u*)((bf16*)xout + (size_t)m * DM) + ln)[64 * j] = (v2u){pk2(v[j].x, v[j].y), pk2(v[j].z, v[j].w)}; }
            }
            if (FLAGS & 32) {
#pragma unroll
                for (int j = 0; j < 4; ++j) ((GAS v2u*)((bf16*)xout + (size_t)m * DM) + ln)[64 * j] = (v2u){pk2(v[j].x, v[j].y), pk2(v[j].z, v[j].w)}; }
            float s = 0.f;
#pragma unroll
            for (int j = 0; j < 4; ++j) s += (v[j].x * v[j].x + v[j].y * v[j].y) + (v[j].z * v[j].z + v[j].w * v[j].w);
            const float inv = 1.0f / sqrtf(wave_sum(s) * (1.f / DM) + RMS_EPS);
            float colv = 0.f;
            if (NC) {
                float part[NC ? NC : 1];
#pragma unroll
                for (int c = 0; c < NC; ++c) part[c] = 0.f;
                const int woff = ln;
#pragma unroll
                for (int j = 0; j < 4; ++j) {
#pragma unroll
                    for (int q = 0; q < 4; ++q) { const float xv = v[j][q];
#pragma unroll
                        for (int cq = 0; cq < NC / 4; ++cq) { const f32x4 w = WL[((j * 4 + q) * (NC / 4) + cq) * 64 + woff];
                            part[cq * 4 + 0] += xv * w.x; part[cq * 4 + 1] += xv * w.y; part[cq * 4 + 2] += xv * w.z; part[cq * 4 + 3] += xv * w.w; }
                        if ((q & 1) == 1) asm volatile("" ::: "memory"); } }
                colv = wave_reduce_cols<NC ? NC : 2>(reinterpret_cast<float (&)[NC ? NC : 2]>(part), ln) * inv;
            }
            if (H) {
                GAS unsigned long long* o8 = (GAS unsigned long long*)(H + (size_t)m * DM) + ln;
                GAS unsigned* h8 = (GAS unsigned*)(F.ws + WS_R2 + 104 * MiB + (size_t)m * DM) + ln;
#pragma unroll
                for (int j = 0; j < 4; ++j) { const f32x4 g = ((const GAS f32x4*)gain + ln)[64 * j]; const f32x4 hv = v[j] * inv * g;
                    if (((FLAGS & 4) && MOE_FP8) || (FLAGS & 8)) h8[64 * j] = pg8::cvt4_fp8(hv.x, hv.y, hv.z, hv.w);
                    else o8[64 * j] = (unsigned long long)pk2(hv.x, hv.y) | ((unsigned long long)pk2(hv.z, hv.w) << 32); }
            }
            if (FLAGS & 2) {
                if (ln < 16) { const int l = ln; const int c = ((l & 1) << 3) | ((l & 2) << 1) | ((l & 4) >> 1) | ((l & 8) >> 3);
                    const float z = colv + bf[c]; const float ls = fminf(z, 0.f) - log1pf(expf(-fabsf(z))); lgf[(size_t)m * 16 + c] = ls * LOG2E; }
            }
            if (FLAGS & 4) {
                float lg[8];
#pragma unroll
                for (int c = 0; c < 8; ++c) lg[c] = __builtin_bit_cast(float, __builtin_amdgcn_readlane(__builtin_bit_cast(int, colv), lane_of_col<8>(c)));
                int e0 = 0; float l0 = lg[0];
#pragma unroll
                for (int c = 1; c < 8; ++c) if (lg[c] > l0) { l0 = lg[c]; e0 = c; }
                int e1 = -1; float l1 = -INFINITY;
#pragma unroll
                for (int c = 0; c < 8; ++c) if (c != e0 && lg[c] > l1) { l1 = lg[c]; e1 = c; }
                const float g0 = 1.0f / (1.0f + expf(l1 - l0)), g1 = 1.0f - g0;
                if (ln == 0) { const int r = F.wave * 8 + i; sel[r * 2] = e0; sel[r * 2 + 1] = e1; sg[r * 2] = g0; sg[r * 2 + 1] = g1; }
            }
        }
        if (FLAGS & 4) {
            int* selg = (int*)(F.ws + WS_MISC + MS_SEL) + (size_t)f * M * 2;
            float* sgg = (float*)(F.ws + WS_MISC + MS_SG) + (size_t)f * M * 2;
            int* lcn = (int*)(F.ws + WS_MISC + MS_LC) + (size_t)f * 256 * 8;
            __syncthreads();
            if (F.tid < 128) { selg[chunk * 128 + F.tid] = sel[F.tid]; sgg[chunk * 128 + F.tid] = sg[F.tid]; }
            if (F.tid >= 128 && F.tid < 136) { const int e = F.tid - 128; int c = 0;
                for (int q = 0; q < 128; ++q) c += (sel[q] == e) ? 1 : 0;
                lcn[chunk * 8 + e] = c; }
            __syncthreads();
        }
    }
}

__device__ __forceinline__ void moe_finalize(Frame& F, int f) {
    const int* selg = (const int*)(F.ws + WS_MISC + MS_SEL) + (size_t)f * M * 2;
    const float* sgg = (const float*)(F.ws + WS_MISC + MS_SG) + (size_t)f * M * 2;
    const int* lcn = (const int*)(F.ws + WS_MISC + MS_LC) + (size_t)f * 256 * 8;
    int* list = (int*)(F.ws + WS_MISC + MS_LIST) + (size_t)f * NE * LCAP;
    float* gw = (float*)(F.ws + WS_MISC + MS_GW) + (size_t)f * NE * LCAP;
    int* tok = (int*)(F.ws + WS_MISC + MS_TOK) + (size_t)f * M * 2;
    LAS int* arr = (LAS int*)F.lds;
    LAS int* sel = (LAS int*)(F.lds + 8192);
    LAS int* pb = (LAS int*)(F.lds + 8192 + 512);
    LAS int* pt = (LAS int*)(F.lds + 8192 + 1536);
    LAS int* base = (LAS int*)(F.lds + 8192 + 2560);
    LAS int* tot = (LAS int*)(F.lds + 8192 + 2592);
    for (int chunk = blockIdx.x; chunk < M / 64; chunk += F.G) {
        if (F.tid < 256) { const v4u a = *(const GAS v4u*)(lcn + F.tid * 8), b = *(const GAS v4u*)(lcn + F.tid * 8 + 4);
            *(LAS v4u*)(arr + F.tid * 8) = a; *(LAS v4u*)(arr + F.tid * 8 + 4) = b; }
        if (F.tid < 128) sel[F.tid] = selg[chunk * 128 + F.tid];
        __syncthreads();
        if (F.tid < 256) { const int e = F.tid & 7, seg = F.tid >> 3; int b = 0, t = 0;
#pragma unroll
            for (int i = 0; i < 8; ++i) { const int c = seg * 8 + i; const int v = arr[c * 8 + e]; t += v; b += (c < chunk) ? v : 0; }
            pb[seg * 8 + e] = b; pt[seg * 8 + e] = t; }
        __syncthreads();
        if (F.tid < 8) { int b = 0, t = 0;
            for (int sgm = 0; sgm < 32; ++sgm) { b += pb[sgm * 8 + F.tid]; t += pt[sgm * 8 + F.tid]; }
            base[F.tid] = b; tot[F.tid] = t; }
        __syncthreads();
        if (F.tid < 128) { const int mye = sel[F.tid]; int lp = 0;
            for (int q = 0; q < 128; ++q) lp += (q < F.tid && sel[q] == mye) ? 1 : 0;
            const int q = F.tid, row = chunk * 64 + (q >> 1), pos = base[mye] + lp;
            list[mye * LCAP + pos] = row; gw[mye * LCAP + pos] = sgg[chunk * 128 + q]; tok[row * 2 + (q & 1)] = mye * LCAP + pos; }
        if (chunk == 0 && F.tid < 2) { unsigned long long w = 0ull;
#pragma unroll
            for (int i = 0; i < 4; ++i) w |= (unsigned long long)(unsigned)tot[4 * F.tid + i] << (16 * i);
            __hip_atomic_store((GAS unsigned long long*)(F.ctl + CW_CNT + f * 64 + 16 * F.tid), w, RLX_AGENT); }
        __syncthreads();
    }
}

__device__ __forceinline__ void final_combine(Frame& F, int f) {
    const bf16* Y = (const bf16*)(F.ws + WS_R2);
    const int* tok = (const int*)(F.ws + WS_MISC + MS_TOK) + (size_t)f * M * 2;
    int tb[NE + 1]; moe_bases(F, f, tb);
    for (int m = blockIdx.x * NWAVES + F.wave; m < M; m += F.G * NWAVES) {
        const int s0 = tok[m * 2], s1 = tok[m * 2 + 1]; int r0 = 0, r1 = 0;
#pragma unroll
        for (int e = 0; e < NE; ++e) { if ((s0 >> 14) == e) r0 = tb[e] * 256 + (s0 & 16383); if ((s1 >> 14) == e) r1 = tb[e] * 256 + (s1 & 16383); }
        GAS f32x4* xo = (GAS f32x4*)(F.out + (size_t)m * DM) + F.lane;
        const GAS v2u* xr = (const GAS v2u*)((const bf16*)(F.ws + WS_XB) + (size_t)m * DM) + F.lane;
#pragma unroll
        for (int j = 0; j < 4; ++j) { const v2u a = xr[64 * j]; xo[64 * j] = (f32x4){bflo(a.x), bfhi(a.x), bflo(a.y), bfhi(a.y)} + moe_yrow(F, r0, F.lane + 64 * j) + moe_yrow(F, r1, F.lane + 64 * j); }
    }
}

template <int NB> __device__ __forceinline__ void stagger_convert(Frame& F) {
    if ((((int)blockIdx.x >> 3) & 1) == 0) return;
    volatile LAS int* cw = (volatile LAS int*)(F.lds + MISC_OFF) + 16;
    unsigned* nxt = (unsigned*)(F.ctl + CW_CVQ);
    for (int r = 0; r < NB; ++r) {
        __syncthreads();
        if (F.tid == 0) { int b = -1; if ((int)xb_ld(nxt) < CV_TOTAL) b = (int)xb_add(nxt, 8u); cw[0] = b; }
        __syncthreads();
        const int base = cw[0];
        if (base < 0) break;
        if (base + F.wave < CV_TOTAL) cv_run_item(F, base + F.wave);
    }
    __syncthreads();
}
template <class Epi, bool FP8 = false>
__device__ __forceinline__ void dense_gemm(Frame& F, const bf16* A, const bf16* Bt, int N, int K, const Epi& E) {
    pg8::DenseOrder S; S.init(A, Bt, M, N, K, F.G, (int)blockIdx.x);
    pg8::gemm_phase<Epi, pg8::DenseOrder, false, FP8>(F.lds, K, S, E);
}
template <int NFLAGS, class Epi, bool FP8 = false>
__device__ __forceinline__ void resid_gemm_norm(Frame& F, int site, const bf16* A, const bf16* Bt, int K, const Epi& E, const void* X, const float* gain, bf16* H, int f, const float* Wr) {
    pg8::DenseOrder S; S.init(A, Bt, M, DM, K, F.G, (int)blockIdx.x);
    pg8::gemm_phase<Epi, pg8::DenseOrder, false, FP8>(F.lds, K, S, E);
    unsigned* cnt = (unsigned*)(F.ctl + CW_PANEL + site * 64);
    asm volatile("s_waitcnt vmcnt(0)" ::: "memory");
    __syncthreads();
    if (F.tid == 0) {
        const unsigned x = xb_xcc_id(); pg8::Unit u;
        for (int i = 0; S.next(i, u); ++i) xb_add(&cnt[u.pm], 1u + (x < 8u ? (1u << (4 + 3 * x)) : 0u));
    }
    norm_phase<NFLAGS | 16 | 64>(F, X, nullptr, gain, H, 0, f, nullptr, nullptr, Wr, &S, cnt);
}
__device__ __forceinline__ void moe_order_init(Frame& F, int f, pg8::MoeOrder& S) {
    int acc = 0, t[NE];
#pragma unroll
    for (int e = 0; e < NE; ++e) { const int c = moe_cnt(F, f, e); acc += (c + 255) >> 8; t[e] = acc; }
    S.t1 = t[0]; S.t2 = t[1]; S.t3 = t[2]; S.t4 = t[3]; S.t5 = t[4]; S.t6 = t[5]; S.t7 = t[6]; S.t8 = t[7];
    S.G = F.G; S.c = (int)blockIdx.x;
}
__device__ __forceinline__ void moe_gu_fast(Frame& F, int f, const bf16* H, bf16* ACT) {
    pg8::MoeOrder S; moe_order_init(F, f, S);
    S.list = (const int*)(F.ws + WS_MISC + MS_LIST) + (size_t)f * NE * LCAP; S.gather = true; S.splitk = 0; S.xcdperm = false; S.nN = 2 * FF / 256;
    if (MOE_FP8) {
        S.K = DM / 2; S.A = (const char*)(F.ws + WS_R2 + 104 * MiB); S.Bt = (const char*)((const bf16*)(F.ws + WS_W) + WE_MGU) + (size_t)f * NE * 2 * FF * DM;
        S.tstepA = (size_t)256 * DM; S.tstepB = (size_t)256 * DM; S.estepB = (size_t)2 * FF * DM;
        pg8::EpiSwigluF8 E{(unsigned char*)ACT};
        pg8::gemm_phase<pg8::EpiSwigluF8, pg8::MoeOrder, true, true>(F.lds, DM / 2, S, E);
    } else {
        S.K = DM; S.A = (const char*)H; S.Bt = (const char*)((const bf16*)(F.ws + WS_W) + WE_MGU + (size_t)f * NE * 2 * FF * DM);
        S.tstepA = (size_t)256 * DM * 2; S.tstepB = (size_t)256 * DM * 2; S.estepB = (size_t)2 * FF * DM * 2;
        pg8::EpiSwiglu E{ACT};
        pg8::gemm_phase<pg8::EpiSwiglu, pg8::MoeOrder, true>(F.lds, DM, S, E);
    }
}
__device__ __forceinline__ void moe_down_fast(Frame& F, int f, const bf16* ACT, bf16* Y) {
    pg8::MoeOrder S; moe_order_init(F, f, S);
    S.nN = DM / 256; S.list = nullptr; S.gather = false; S.xcdperm = (F.G == 256); S.splitk = (MOE_SPLITK && F.G == 256) ? MOE_NSPLIT : 0;
    const float* gwp = (const float*)(F.ws + WS_MISC + MS_GW) + (size_t)f * NE * LCAP; bf16* P = (bf16*)(F.ws + WS_R2 + 72 * MiB);
    if (MOE_FP8) {
        S.K = FF / 2; S.A = (const char*)ACT; S.Bt = (const char*)((const bf16*)(F.ws + WS_W) + WE_MD) + (size_t)f * NE * DM * FF;
        S.tstepA = (size_t)256 * FF; S.tstepB = (size_t)256 * FF; S.estepB = (size_t)DM * FF;
        pg8::EpiMoeDown E{Y, gwp, P, 1.0f / (W8S * A8S)};
        pg8::gemm_phase<pg8::EpiMoeDown, pg8::MoeOrder, false, true>(F.lds, FF / 2, S, E);
    } else {
        S.K = FF; S.A = (const char*)ACT; S.Bt = (const char*)((const bf16*)(F.ws + WS_W) + WE_MD + (size_t)f * NE * DM * FF);
        S.tstepA = (size_t)256 * FF * 2; S.tstepB = (size_t)256 * FF * 2; S.estepB = (size_t)DM * FF * 2;
        pg8::EpiMoeDown E{Y, gwp, P, 1.0f};
        pg8::gemm_phase<pg8::EpiMoeDown, pg8::MoeOrder, false>(F.lds, FF, S, E);
    }
}

struct Args { const float* in[22]; float* out; unsigned char* ws; int ph_lo, ph_hi; };
constexpr int N_PHASES = 26;

__global__ void __launch_bounds__(NTHR, 2) trunk_fwd(Args args) {
    extern __shared__ __attribute__((aligned(16))) unsigned char lds[];
    Frame F;
    F.lds = (LAS unsigned char*)lds;
    F.tid = threadIdx.x; F.lane = F.tid & 63; F.wave = __builtin_amdgcn_readfirstlane(F.tid >> 6); F.G = gridDim.x;
    F.ws = args.ws; F.ctl = (gu32*)(args.ws + WS_CTL); F.out = args.out;
    if (F.tid == 0) {
#pragma unroll
        for (int i = 0; i < 22; ++i) ((LAS unsigned long long*)(F.lds + PTR_OFF))[i] = (unsigned long long)args.in[i];
    }
    volatile LAS unsigned* MISC = (volatile LAS unsigned*)(F.lds + MISC_OFF);
    if (F.tid < 32) MISC[F.tid] = 0u;
    __syncthreads();
    XcdBarrier bar; bar.bar = (unsigned*)(F.ctl + CW_BAR); bar.x = 0; bar.st = nullptr;
    const int lo = args.ph_lo, hi = args.ph_hi;
    if (hi - lo > 1) bar = xcd_barrier_post((unsigned*)(F.ctl + CW_BAR), MISC + 8);
#ifndef PHSEL
#define PHSEL 0xFFFFFFFFFFFFFFFFull
#endif
#define IN(k) (lo <= (k) && (k) < hi && ((PHSEL >> (k)) & 1ull) && relaunder(F))
#define SEAM(k) do { if (IN((k) + 1) && IN(k)) xcd_barrier_steal(bar, F); } while (0)
#ifndef DUPMASK
#define DUPMASK 0ull
#endif
#define DUP(k) (((DUPMASK >> (k)) & 1ull) != 0ull)

    bf16* H = (bf16*)(F.ws + WS_H);
    bf16* PROJ = (bf16*)(F.ws + WS_R1);
    bf16* ACT = (bf16*)(F.ws + WS_R1);
    bf16* O = (bf16*)(F.ws + WS_R2);
    bf16* Y = (bf16*)(F.ws + WS_R2);
    bf16* OG = (bf16*)(F.ws + WS_R2 + 32 * MiB);
    float* ST = (float*)(F.ws + WS_R2 + 128 * MiB);
    bf16* X = (bf16*)(F.ws + WS_XB);
    const bf16* H8 = (const bf16*)(F.ws + WS_R2 + 104 * MiB);
    float* DUMMY = (float*)(F.ws + WS_R2 + 32 * MiB);
    const float* cum = (const float*)(F.ws + WS_MISC + MS_LOGF);

    const bf16* WB = (const bf16*)(F.ws + WS_W);
    enum { PH_BASE = __COUNTER__ + 1 };
#define PHASE(...) { constexpr int k_ = __COUNTER__ - PH_BASE; if (IN(k_)) { __VA_ARGS__; cv_drain(F, cv_need(k_ + 1)); SEAM(k_); } }
    PHASE({ unsigned* z = (unsigned*)(F.ws + WS_MISC + MS_LIST);
            for (int i = blockIdx.x * NTHR + F.tid; i < (int)(2 * MiB / 4); i += F.G * NTHR) z[i] = 0u;
            norm_phase<32>(F, INP(0), X, INP(13) + 0 * DM, H, 0, 0, nullptr, nullptr, nullptr); })
    PHASE({ stagger_convert<1>(F); pg8::EpiPlanes E{PROJ, C2, 1.0f}; dense_gemm(F, H, WB + WE_QKV, 3 * DM, DM, E); })
    PHASE(att::causal_phase<0>((att::lptr)F.lds, F.G, PROJ, PROJ + PLANE, PROJ + 2 * PLANE, O, nullptr, false))
    PHASE({ pg8::EpiResid<false> E{X, X, 1.0f}; resid_gemm_norm<(DENSE_FP8_L0 ? 8 : 0)>(F, 0, O, WB + WE_WO_SB, DM, E, X, INP(14) + 0 * DM, H, 0, nullptr); })
    PHASE({ stagger_convert<1>(F);
            if (DENSE_FP8_L0) { pg8::EpiSwigluF8 E{(unsigned char*)ACT}; dense_gemm<pg8::EpiSwigluF8, true>(F, H8, (const bf16*)((const unsigned char*)(WB + WE_GU)), 2 * FF, DM / 2, E); }
            else { pg8::EpiSwiglu E{ACT}; dense_gemm(F, H, WB + WE_GU, 2 * FF, DM, E); } })
    PHASE({ if (DENSE_FP8_L0) { pg8::EpiResid<false> E{X, X, 1.0f / (W8S * A8S)}; resid_gemm_norm<(DILIN_FP8 ? 8 : 0), pg8::EpiResid<false>, true>(F, 1, ACT, (const bf16*)((const unsigned char*)(WB + WE_D)), FF / 2, E, X, INP(13) + 1 * DM, H, 0, nullptr); }
            else { pg8::EpiResid<false> E{X, X, 1.0f}; resid_gemm_norm<(DILIN_FP8 ? 8 : 0)>(F, 1, ACT, WB + WE_D, FF, E, X, INP(13) + 1 * DM, H, 0, nullptr); } })
    PHASE({ stagger_convert<1>(F);
            if (DILIN_FP8) { pg8::EpiQKNorm E{PROJ, INP(4), INP(5), 6, 1.0f / W8S}; dense_gemm<pg8::EpiQKNorm, true>(F, H8, WB + WE_IN_DIL, 7 * DM, DM / 2, E); }
            else { pg8::EpiQKNorm E{PROJ, INP(4), INP(5), 6, 1.0f}; dense_gemm(F, H, WB + WE_IN_DIL, 7 * DM, DM, E); } })
    PHASE(att::dil_phase((att::lptr)F.lds, F.G, PROJ, OG, ST, INP(12), 0, O))
    PHASE(att::dil_phase((att::lptr)F.lds, F.G, PROJ, OG, ST, INP(12), 1, O))
    PHASE({ if (WO_FP8) { pg8::EpiResid<false> E{X, X, 1.0f / (W8S * A8S)}; resid_gemm_norm<4, pg8::EpiResid<false>, true>(F, 2, O, WB + WE_WO_DIL, DM / 2, E, X, INP(14) + 1 * DM, H, 0, INP(18) + 0 * DM * NE); }
            else { pg8::EpiResid<false> E{X, X, 1.0f}; resid_gemm_norm<4>(F, 2, O, WB + WE_WO_DIL, DM, E, X, INP(14) + 1 * DM, H, 0, INP(18) + 0 * DM * NE); } })
    PHASE(moe_finalize(F, 0))
    PHASE({ stagger_convert<1>(F); moe_gu_fast(F, 0, H, ACT); })
    PHASE(moe_down_fast(F, 0, ACT, Y))
    PHASE(norm_phase<(1 | 2 | (FOXIN_FP8 ? 8 : 0)) | 16>(F, X, X, INP(13) + 2 * DM, H, 0, 0, INP(7), INP(8), nullptr))
    PHASE({ stagger_convert<1>(F);
            if (FOXIN_FP8) { pg8::EpiQKNorm E{PROJ, INP(9), INP(10), 2, 1.0f / W8S}; dense_gemm<pg8::EpiQKNorm, true>(F, H8, WB + WE_IN_FOX, 3 * DM, DM / 2, E); }
            else { pg8::EpiQKNorm E{PROJ, INP(9), INP(10), 2, 1.0f}; dense_gemm(F, H, WB + WE_IN_FOX, 3 * DM, DM, E); } })
    PHASE(att::causal_phase<2>((att::lptr)F.lds, F.G, PROJ, PROJ + PLANE, PROJ + 2 * PLANE, O, cum, WO_FP8))
    PHASE({ if (WO_FP8) { pg8::EpiResid<false> E{X, X, 1.0f / (W8S * A8S)}; resid_gemm_norm<(DENSE_FP8_L2 ? 8 : 0), pg8::EpiResid<false>, true>(F, 3, O, WB + WE_WO_FOX, DM / 2, E, X, INP(14) + 2 * DM, H, 0, nullptr); }
            else { pg8::EpiResid<false> E{X, X, 1.0f}; resid_gemm_norm<(DENSE_FP8_L2 ? 8 : 0)>(F, 3, O, WB + WE_WO_FOX, DM, E, X, INP(14) + 2 * DM, H, 0, nullptr); } })
    PHASE({ stagger_convert<1>(F);
            if (DENSE_FP8_L2) { pg8::EpiSwigluF8 E{(unsigned char*)ACT}; dense_gemm<pg8::EpiSwigluF8, true>(F, H8, WB + WE_GU + (size_t)2 * FF * DM, 2 * FF, DM / 2, E); }
            else { pg8::EpiSwiglu E{ACT}; dense_gemm(F, H, WB + WE_GU + (size_t)2 * FF * DM, 2 * FF, DM, E); } })
    PHASE({ if (DENSE_FP8_L2) { pg8::EpiResid<false> E{X, X, 1.0f / (W8S * A8S)}; resid_gemm_norm<(QKV3_FP8 ? 8 : 0), pg8::EpiResid<false>, true>(F, 4, ACT, WB + WE_D + (size_t)DM * FF, FF / 2, E, X, INP(13) + 3 * DM, H, 0, nullptr); }
            else { pg8::EpiResid<false> E{X, X, 1.0f}; resid_gemm_norm<(QKV3_FP8 ? 8 : 0)>(F, 4, ACT, WB + WE_D + (size_t)DM * FF, FF, E, X, INP(13) + 3 * DM, H, 0, nullptr); } })
    PHASE({ stagger_convert<1>(F);
            if (QKV3_FP8) { pg8::EpiPlanes E{PROJ, C2, 1.0f / W8S}; dense_gemm<pg8::EpiPlanes, true>(F, H8, WB + WE_QKV + (size_t)3 * DM * DM, 3 * DM, DM / 2, E); }
            else { pg8::EpiPlanes E{PROJ, C2, 1.0f}; dense_gemm(F, H, WB + WE_QKV + (size_t)3 * DM * DM, 3 * DM, DM, E); } })
    PHASE(att::causal_phase<0>((att::lptr)F.lds, F.G, PROJ, PROJ + PLANE, PROJ + 2 * PLANE, O, nullptr, WO_FP8))
    PHASE({ if (WO_FP8) { pg8::EpiResid<false> E{X, X, 1.0f / (W8S * A8S)}; resid_gemm_norm<4, pg8::EpiResid<false>, true>(F, 5, O, WB + WE_WO_SB + (size_t)DM * DM, DM / 2, E, X, INP(14) + 3 * DM, H, 1, INP(18) + 1 * DM * NE); }
            else { pg8::EpiResid<false> E{X, X, 1.0f}; resid_gemm_norm<4>(F, 5, O, WB + WE_WO_SB + (size_t)DM * DM, DM, E, X, INP(14) + 3 * DM, H, 1, INP(18) + 1 * DM * NE); } })
    PHASE(moe_finalize(F, 1))
    PHASE({ stagger_convert<1>(F); moe_gu_fast(F, 1, H, ACT); })
    PHASE(moe_down_fast(F, 1, ACT, Y))
    PHASE(final_combine(F, 1))
    static_assert(__COUNTER__ - PH_BASE == N_PHASES, "N_PHASES must equal the number of PHASE() sites");
#undef PHASE
#undef IN
#undef SEAM
}

extern "C" void kernel_launch(void* const* d_in, const int* in_sizes, int n_in, void* d_out, int out_size, void* d_ws, size_t ws_size, hipStream_t stream) {
    static int grid = 0;
    if (grid == 0) {
        if (n_in != 22 || out_size != M * DM || ws_size < WS_END) { fprintf(stderr, "kernel_launch: unexpected shapes (n_in %d out %d ws %zu)\n", n_in, out_size, ws_size); grid = -1; return; }
        int dev = 0, cus = 0, per_cu = 0;
        if (hipGetDevice(&dev) != hipSuccess || hipDeviceGetAttribute(&cus, hipDeviceAttributeMultiprocessorCount, dev) != hipSuccess) { grid = -1; return; }
        if (hipFuncSetAttribute((const void*)trunk_fwd, hipFuncAttributeMaxDynamicSharedMemorySize, LDS_BYTES) != hipSuccess) { fprintf(stderr, "kernel_launch: hipFuncSetAttribute failed\n"); grid = -1; return; }
        if (hipOccupancyMaxActiveBlocksPerMultiprocessor(&per_cu, (const void*)trunk_fwd, NTHR, LDS_BYTES) != hipSuccess || per_cu < 1) fprintf(stderr, "kernel_launch: occupancy query says %d\n", per_cu);
        (void)hipGetLastError();
        grid = cus;
    }
    if (grid < 0) return;
    (void)hipMemsetAsync((char*)d_ws + WS_CTL, 0, CTL_ZERO_BYTES, stream);
    Args a{};
    for (int i = 0; i < 22; ++i) a.in[i] = (const float*)d_in[i];
    a.out = (float*)d_out; a.ws = (unsigned char*)d_ws;
#if MK_MULTI
    for (int p = 0; p < N_PHASES; ++p) { a.ph_lo = p; a.ph_hi = p + 1; hipLaunchKernelGGL(trunk_fwd, dim3(grid), dim3(NTHR), LDS_BYTES, stream, a); }
#else
    a.ph_lo = 0; a.ph_hi = N_PHASES;
    hipLaunchKernelGGL(trunk_fwd, dim3(grid), dim3(NTHR), LDS_BYTES, stream, a);
#endif
}
```

```cpp
#include <hip/hip_runtime.h>
#include <cstdio>
#include <cstdint>

#ifndef MK_MULTI
#define MK_MULTI 0
#endif

constexpr int BATCH = 8, SEQ = 2048, DM = 1024, NH = 16, HD = 64, FF = 3584, NE = 8;
constexpr int M = BATCH * SEQ;
constexpr float RMS_EPS = 1e-6f;
constexpr float LOG2E = 1.4426950408889634f;
constexpr float C2 = 0.125f * LOG2E;
constexpr int NWAVES = 8, NTHR = 512;
constexpr int LCAP = 16384;
constexpr int MAXROWS = 34816;
constexpr bool MOE_SPLITK = true;
constexpr bool MOE_FP8 = true;
constexpr bool DILIN_FP8 = true;
constexpr bool FOXIN_FP8 = true;
constexpr bool QKV3_FP8 = true;
constexpr bool DENSE_FP8_L0 = false, DENSE_FP8_L2 = true;
constexpr float W8S = 32.0f, A8S = 4.0f;
constexpr int MOE_NSPLIT = MOE_FP8 ? 2 : 4;
constexpr int SPLIT_ROW0 = 32768, SPLIT_ROWS = MAXROWS - SPLIT_ROW0;

constexpr size_t MiB = 1u << 20;
constexpr size_t WS_CTL = 0, CTL_ZERO_BYTES = 1 * MiB;
constexpr size_t WS_MISC = 1 * MiB;
constexpr size_t WS_H = 6 * MiB;
constexpr size_t WS_R1 = 38 * MiB;
constexpr size_t WS_R2 = 278 * MiB;
constexpr size_t WS_W = 414 * MiB;
constexpr size_t WS_XB = 832 * MiB;
constexpr size_t WS_END = 864 * MiB;
constexpr size_t PLANE = (size_t)M * DM;
constexpr size_t WE_QKV = 0;
constexpr size_t WE_WO_SB = WE_QKV + 2ull * 3072 * 1024;
constexpr size_t WE_WO_DIL = WE_WO_SB + 2ull * 1024 * 1024;
constexpr size_t WE_WO_FOX = WE_WO_DIL + 1024ull * 1024;
constexpr size_t WE_IN_DIL = WE_WO_FOX + 1024ull * 1024;
constexpr size_t WE_IN_FOX = WE_IN_DIL + 7168ull * 1024;
constexpr size_t WE_GU = WE_IN_FOX + 3072ull * 1024;
constexpr size_t WE_D = WE_GU + 2ull * 7168 * 1024;
constexpr size_t WE_MGU = WE_D + 2ull * 1024 * 3584;
constexpr size_t WE_MD = WE_MGU + 16ull * 7168 * 1024;
constexpr size_t WE_END = WE_MD + 16ull * 1024 * 3584;
static_assert(WS_W + WE_END * 2 <= WS_END, "weight copies fit");
constexpr size_t MS_LIST = 0;
constexpr size_t MS_GW = 1 * MiB;
constexpr size_t MS_TOK = 2 * MiB;
constexpr size_t MS_LOGF = 2 * MiB + 256 * 1024;
constexpr size_t MS_CUM = 3 * MiB + 256 * 1024;
constexpr size_t MS_SEL = 4 * MiB + 256 * 1024;
constexpr size_t MS_SG = MS_SEL + 256 * 1024;
constexpr size_t MS_LC = MS_SG + 256 * 1024;
constexpr int CW_BAR = 4096;
constexpr int CW_PANEL = 1024;
constexpr bool MOE_Y_FP8 = true;
constexpr float Y8S = 16.0f;
constexpr bool WO_FP8 = true;
constexpr int CW_CVQ = 2048;
constexpr int CW_CNT = 64;

#define GAS __attribute__((address_space(1)))
#define LAS __attribute__((address_space(3)))
typedef unsigned short bf16;
typedef unsigned v4u __attribute__((ext_vector_type(4)));
typedef unsigned v2u __attribute__((ext_vector_type(2)));
typedef float f32x4 __attribute__((ext_vector_type(4)));
typedef float f32x2 __attribute__((ext_vector_type(2)));
typedef GAS unsigned gu32;
#define RLX_AGENT __ATOMIC_RELAXED, __HIP_MEMORY_SCOPE_AGENT
__device__ __forceinline__ unsigned f2bf(float f) { unsigned u = __builtin_bit_cast(unsigned, f); return (u + 0x7fffu + ((u >> 16) & 1u)) >> 16; }
__device__ __forceinline__ unsigned pk2(float lo, float hi) { return f2bf(lo) | (f2bf(hi) << 16); }
__device__ __forceinline__ float bflo(unsigned u) { return __builtin_bit_cast(float, u << 16); }
__device__ __forceinline__ float bfhi(unsigned u) { return __builtin_bit_cast(float, u & 0xffff0000u); }

#define XB_TMO      128
#define XB_XCNT(j)  (256  + 64 * (j))
#define XB_XSUB(j)  (1280 + 64 * (j))
#define XB_XGEN(j)  (2304 + 64 * (j))
#define XB_TOP      3328
#define XB_TOPGEN   3392
#define XCD_BAR_WORDS 3456
#define XB_SPIN_CAP (1u << 22)
__device__ __forceinline__ unsigned xb_ld(unsigned* p)              { return __hip_atomic_load(p, __ATOMIC_RELAXED, __HIP_MEMORY_SCOPE_AGENT); }
__device__ __forceinline__ unsigned xb_add(unsigned* p, unsigned v) { return __hip_atomic_fetch_add(p, v, __ATOMIC_RELAXED, __HIP_MEMORY_SCOPE_AGENT); }
__device__ __forceinline__ unsigned xb_xcc_id() { return (unsigned)__builtin_amdgcn_s_getreg((3 << 11) | 20) & 0xFu; }
#define XB_SPIN(cond, bar) do { unsigned _sp = 0; while (cond) { __builtin_amdgcn_s_sleep(1); \
    if ((++_sp & 255u) == 0u) { if (xb_ld(&(bar)[XB_TMO])) break; if (_sp > XB_SPIN_CAP) { atomicAdd(&(bar)[XB_TMO], 1u); break; } } } } while (0)
struct XcdBarrier { unsigned* bar; unsigned x; volatile LAS unsigned* st; };
__device__ __forceinline__ XcdBarrier xcd_barrier_post(unsigned* bar, volatile LAS unsigned* st) {
    XcdBarrier b; b.bar = bar; b.x = xb_xcc_id(); b.st = st;
    if (threadIdx.x == 0) (void)xb_add(&bar[XB_XCNT(b.x)], 1u);
    return b;
}
__device__ __forceinline__ void xcd_barrier_complete(unsigned* bar, unsigned x, unsigned& nloc, unsigned& nx) {
    const unsigned G = gridDim.x * gridDim.y * gridDim.z;
    unsigned sum, cnt, mine, sp = 0u;
    for (;;) {
        sum = 0u; cnt = 0u; mine = 0u;
#pragma unroll
        for (unsigned j = 0; j < 16; ++j) { const unsigned c = xb_ld(&bar[XB_XCNT(j)]); sum += c; cnt += (c > 0u) ? 1u : 0u; mine = (j == x) ? c : mine; }
        if (sum == G) break;
        __builtin_amdgcn_s_sleep(1);
        if ((++sp & 255u) == 0u) { if (xb_ld(&bar[XB_TMO])) break; if (sp > XB_SPIN_CAP) { atomicAdd(&bar[XB_TMO], 1u); break; } }
    }
    nloc = mine > 0u ? mine : 1u; nx = cnt > 0u ? cnt : 1u;
}
__device__ __forceinline__ void xcd_barrier(const XcdBarrier& b) {
    asm volatile("s_waitcnt vmcnt(0)" ::: "memory");
    __syncthreads();
    if (threadIdx.x == 0) {
        unsigned* bar = b.bar;
        __builtin_amdgcn_s_waitcnt(0);
        unsigned nloc = b.st[0], nx = b.st[1];
        if (nloc == 0u) { xcd_barrier_complete(bar, b.x, nloc, nx); b.st[0] = nloc; b.st[1] = nx; }
        const unsigned old = xb_add(&bar[XB_XSUB(b.x)], 1u);
        const unsigned gen = old / nloc;
        if (old + 1u == (gen + 1u) * nloc) {
            __builtin_amdgcn_fence(__ATOMIC_RELEASE, "agent");
            asm volatile("s_waitcnt vmcnt(0)" ::: "memory");
            const unsigned og = xb_add(&bar[XB_TOP], 1u);
            const unsigned tg = og / nx;
            if (og + 1u == (tg + 1u) * nx) xb_add(&bar[XB_TOPGEN], 1u);
            else XB_SPIN(xb_ld(&bar[XB_TOPGEN]) == tg, bar);
            xb_add(&bar[XB_XGEN(b.x)], 1u);
            __builtin_amdgcn_fence(__ATOMIC_ACQUIRE, "agent");
            asm volatile("s_waitcnt vmcnt(0)" ::: "memory");
        } else {
            XB_SPIN(xb_ld(&bar[XB_XGEN(b.x)]) == gen, bar);
            __builtin_amdgcn_fence(__ATOMIC_ACQUIRE, "agent");
            asm volatile("s_waitcnt vmcnt(0)" ::: "memory");
        }
    }
    __syncthreads();
}

constexpr int LDS_BYTES = 147456;
constexpr int ATT_LDS_MAX = 143360;
constexpr int MISC_OFF = ATT_LDS_MAX + 64;
struct Frame {
    LAS unsigned char* lds;
    int tid, lane, wave, G;
    unsigned char* ws; gu32* ctl;
    float* out;
};
__device__ __forceinline__ float wave_sum(float v) {
#pragma unroll
    for (int o = 1; o < 64; o <<= 1) v += __shfl_xor(v, o);
    return v;
}

constexpr int PTR_OFF = ATT_LDS_MAX + 512;
__device__ __forceinline__ const float* inp_ptr(Frame& F, int k) {
    const LAS unsigned* t = (const LAS unsigned*)(F.lds + PTR_OFF) + 2 * k;
    const unsigned lo = __builtin_amdgcn_readfirstlane(t[0]), hi = __builtin_amdgcn_readfirstlane(t[1]);
    return (const float*)(((unsigned long long)hi << 32) | lo);
}
#define INP(k) inp_ptr(F, (k))
__device__ __forceinline__ bool relaunder(Frame& F) { int t_ = threadIdx.x; asm volatile("" : "+v"(t_)); F.tid = t_; F.lane = t_ & 63; F.wave = __builtin_amdgcn_readfirstlane(t_ >> 6); return true; }
namespace pg8 {
#define PG8_LAS __attribute__((address_space(3)))
typedef unsigned short bf16_t;
typedef short bf16x8 __attribute__((ext_vector_type(8)));
typedef unsigned u32x4 __attribute__((ext_vector_type(4)));
constexpr int BM = 256, BK = 64, HALF = 128, HTB = HALF * BK * 2, STAGE_BYTES = 8 * HTB, NXCD = 8, WGM = 8;
__host__ __device__ __forceinline__ int lds_byte(int r, int c) { const int st = (r >> 4) * 2 + (c >> 5), rr = r & 15, cc = c & 31, ob = rr * 64 + cc * 2; return st * 1024 + (ob ^ (((ob >> 9) & 1) << 5)); }
__host__ __device__ __forceinline__ void stage_rc(int b, int& R, int& C) { const int st = b / 1024, sb = b % 1024, swz = sb ^ (((sb >> 9) & 1) << 5); R = (st >> 1) * 16 + swz / 64; C = (st & 1) * 32 + (swz % 64) / 2; }
__host__ __device__ __forceinline__ int perm32(int rho) { const int n = rho >> 4, i = rho & 15; return 8 * (i >> 2) + 4 * n + (i & 3); }
struct Unit { int pm, pn, e, mt, nt, koff, kq; };

struct DenseOrder {
    int nM, nN, nwg, G, c, ntk; const char* A; const char* Bt; size_t tstep;
    __device__ __forceinline__ void init(const bf16_t* A_, const bf16_t* Bt_, int M_, int N_, int K_, int G_, int c_) { nM = M_ / BM; nN = N_ / BM; nwg = nM * nN; G = G_; c = c_; ntk = K_ / BK; A = (const char*)A_; Bt = (const char*)Bt_; tstep = (size_t)BM * K_ * 2; }
    __device__ __forceinline__ bool next(int i, Unit& u) const {
        const long L = (long)i * G + c; if (L >= nwg) return false;
        int wgid = (int)L; { const int q = nwg / NXCD, r = nwg % NXCD, xcd = wgid % NXCD, off = wgid / NXCD; wgid = (xcd < r ? xcd * (q + 1) : r * (q + 1) + (xcd - r) * q) + off; }
        const int nig = WGM * nN, gid = wgid / nig, fm = gid * WGM, gsz = (nM - fm) < WGM ? (nM - fm) : WGM;
        u.pm = fm + ((wgid % nig) % gsz); u.pn = (wgid % nig) / gsz; u.e = 0; u.mt = u.pm; u.nt = ntk; u.koff = 0; u.kq = -1; return true;
    }
    __device__ __forceinline__ const char* a_base(const Unit& u) const { return A + (size_t)u.pm * tstep; }
    __device__ __forceinline__ const char* b_base(const Unit& u) const { return Bt + (size_t)u.pn * tstep; }
    __device__ __forceinline__ void a_voff(const Unit&, const int (&)[2], const int (&)[2], unsigned (&)[2][2]) const {}
};
struct MoeOrder {
    int t1, t2, t3, t4, t5, t6, t7, t8, nN, G, c, K; const char* A; const char* Bt; size_t tstepA, tstepB, estepB; const int* list; bool gather; int splitk; bool xcdperm;
    __device__ __forceinline__ bool next(int i, Unit& u) const {
        const int X = i * G + c, U = t8 * nN; int L = X; u.nt = K / BK; u.koff = 0; u.kq = -1;
        if (splitk) { const int nfull = (U / G) * G;
            if (X >= nfull) { const int q = X - nfull; if (q >= splitk * (U - nfull)) return false; L = nfull + q / splitk; u.kq = q % splitk; u.nt = K / BK / splitk; u.koff = u.kq * (K / splitk) * 2; } }
        else if (X >= U) return false;
        if (xcdperm && u.kq < 0) {
            const int rnd = L / G, q = L - rnd * G, j = q >> 3, x = q & 7; L = rnd * G + (((j >> 2) * 8 + x) << 2) + (j & 3); }
        const int mt = L / nN; u.pm = mt; u.pn = L - mt * nN;
        const int e = (mt >= t1) + (mt >= t2) + (mt >= t3) + (mt >= t4) + (mt >= t5) + (mt >= t6) + (mt >= t7);
        const int tb = e == 0 ? 0 : e == 1 ? t1 : e == 2 ? t2 : e == 3 ? t3 : e == 4 ? t4 : e == 5 ? t5 : e == 6 ? t6 : t7;
        u.e = e; u.mt = mt - tb; return true;
    }
    __device__ __forceinline__ const char* a_base(const Unit& u) const { return (gather ? A : A + (size_t)u.pm * tstepA) + u.koff; }
    __device__ __forceinline__ const char* b_base(const Unit& u) const { return Bt + (size_t)u.e * estepB + (size_t)u.pn * tstepB + u.koff; }
    __device__ __forceinline__ void a_voff(const Unit& u, const int (&sR)[2], const int (&sC)[2], unsigned (&v)[2][2]) const {
        const int* lp = list + u.e * LCAP + u.mt * 256;
#pragma unroll
        for (int h = 0; h < 2; ++h)
#pragma unroll
            for (int i = 0; i < 2; ++i) v[h][i] = (unsigned)lp[h * 128 + sR[i]] * (unsigned)(K * 2) + (unsigned)(sC[i] * 2);
    }
};

typedef int v8i32 __attribute__((ext_vector_type(8)));
typedef int v4i32 __attribute__((ext_vector_type(4)));
__device__ __forceinline__ v8i32 cat8(bf16x8 a, bf16x8 b) { const v4i32 x = __builtin_bit_cast(v4i32, a), y = __builtin_bit_cast(v4i32, b); return (v8i32){x[0], x[1], x[2], x[3], y[0], y[1], y[2], y[3]}; }
__device__ __forceinline__ unsigned cvt4_fp8(float a, float b, float c, float d) { int w = 0; w = __builtin_amdgcn_cvt_pk_fp8_f32(a, b, w, false); w = __builtin_amdgcn_cvt_pk_fp8_f32(c, d, w, true); return (unsigned)w; }
__device__ __forceinline__ const char* uniptr(const char* p) { const unsigned long long v = (unsigned long long)p; const unsigned lo = __builtin_amdgcn_readfirstlane((unsigned)v), hi = __builtin_amdgcn_readfirstlane((unsigned)(v >> 32)); return (const char*)(((unsigned long long)hi << 32) | lo); }
__device__ __forceinline__ void glds16_s(const char* sbase, unsigned voff, unsigned lds_dst) { unsigned keep;
    asm volatile("s_mov_b32 %0, m0\n\ts_mov_b32 m0, %3\n\ts_nop 0\n\tglobal_load_lds_dwordx4 %2, %1\n\ts_mov_b32 m0, %0" : "=&s"(keep) : "s"(sbase), "v"(voff), "s"(lds_dst) : "memory"); }
__device__ __forceinline__ unsigned cvt_pk_bf16(float lo, float hi) { unsigned r; asm volatile("v_cvt_pk_bf16_f32 %0, %1, %2" : "=v"(r) : "v"(lo), "v"(hi)); return r; }

struct EpiPlanes {
    static constexpr bool PERM = true;
    bf16_t* O; float scale0; float oscale;
    __device__ __forceinline__ void operator()(const f32x4 (&acc)[2][2][4][2], const Unit& u, int wr, int wc, int fr, int fq) const {
        const int plane = u.pn >> 2; const float sc = (plane == 0 ? scale0 : 1.f) * oscale;
        bf16_t* base = O + (size_t)plane * PLANE + (size_t)(u.pm * BM + wr * 64 + fr) * DM + (u.pn & 3) * 256 + wc * 32 + 8 * fq;
#pragma unroll
        for (int ai = 0; ai < 2; ++ai)
#pragma unroll
            for (int m = 0; m < 4; ++m) { bf16_t* rowp = base + (size_t)(ai * HALF + m * 16) * DM;
#pragma unroll
                for (int bj = 0; bj < 2; ++bj) { const f32x4 v0 = acc[ai][bj][m][0] * sc, v1 = acc[ai][bj][m][1] * sc;
                    u32x4 w; w.x = cvt_pk_bf16(v0[0], v0[1]); w.y = cvt_pk_bf16(v0[2], v0[3]); w.z = cvt_pk_bf16(v1[0], v1[1]); w.w = cvt_pk_bf16(v1[2], v1[3]);
                    *(u32x4*)(rowp + bj * HALF) = w; } }
    }
};
struct EpiQKNorm {
    static constexpr bool PERM = true;
    bf16_t* O; const float* qg; const float* kg; int vplane; float iscale;
    __device__ __forceinline__ void operator()(const f32x4 (&acc)[2][2][4][2], const Unit& u, int wr, int wc, int fr, int fq) const {
        const int plane = u.pn >> 2; const bool isv = plane == vplane; const bool isq = !isv && ((plane & 1) == 0); const int grp = plane >> 1;
        const float* g = (isq ? qg : kg) + grp * 64 + 8 * fq;
        f32x4 gv[2][2];
#pragma unroll
        for (int bj = 0; bj < 2; ++bj)
#pragma unroll
            for (int n = 0; n < 2; ++n) gv[bj][n] = isv ? (f32x4){1.f, 1.f, 1.f, 1.f} : *(const f32x4*)(g + 32 * bj + 4 * n);
        const float mul = isq ? C2 : 1.f;
        bf16_t* base = O + (size_t)plane * PLANE + (size_t)(u.pm * BM + wr * 64 + fr) * DM + (u.pn & 3) * 256 + wc * 64 + 8 * fq;
#pragma unroll
        for (int ai = 0; ai < 2; ++ai)
#pragma unroll
            for (int m = 0; m < 4; ++m) { bf16_t* rowp = base + (size_t)(ai * HALF + m * 16) * DM;
                float ss = 0.f;
#pragma unroll
                for (int bj = 0; bj < 2; ++bj)
#pragma unroll
                    for (int n = 0; n < 2; ++n) { const f32x4 x = acc[ai][bj][m][n] * iscale; ss += (x[0] * x[0] + x[1] * x[1]) + (x[2] * x[2] + x[3] * x[3]); }
                ss += __shfl_xor(ss, 16); ss += __shfl_xor(ss, 32);
                const float inv = (isv ? 1.f : mul * __builtin_amdgcn_rsqf(ss * (1.f / 64.f) + RMS_EPS)) * iscale;
#pragma unroll
                for (int bj = 0; bj < 2; ++bj) { const f32x4 v0 = acc[ai][bj][m][0] * inv * gv[bj][0], v1 = acc[ai][bj][m][1] * inv * gv[bj][1];
                    u32x4 w; w.x = cvt_pk_bf16(v0[0], v0[1]); w.y = cvt_pk_bf16(v0[2], v0[3]); w.z = cvt_pk_bf16(v1[0], v1[1]); w.w = cvt_pk_bf16(v1[2], v1[3]);
                    *(u32x4*)(rowp + bj * 32) = w; } }
    }
};
struct EpiSwiglu {
    static constexpr bool PERM = true;
    bf16_t* O;
    __device__ __forceinline__ void operator()(const f32x4 (&acc)[2][2][4][2], const Unit& u, int wr, int wc, int fr, int fq) const {
        bf16_t* base = O + (size_t)(u.pm * BM + wr * 64 + fr) * FF + u.pn * 128 + wc * 32 + 8 * fq;
#pragma unroll
        for (int ai = 0; ai < 2; ++ai)
#pragma unroll
            for (int m = 0; m < 4; ++m) { bf16_t* rowp = base + (size_t)(ai * HALF + m * 16) * FF;
                f32x2 o[4];
#pragma unroll
                for (int n = 0; n < 2; ++n)
#pragma unroll
                    for (int hh = 0; hh < 2; ++hh) { const f32x2 ga = {acc[ai][0][m][n][2 * hh], acc[ai][0][m][n][2 * hh + 1]}, ua = {acc[ai][1][m][n][2 * hh], acc[ai][1][m][n][2 * hh + 1]};
                        const f32x2 m1 = ga * (-LOG2E); f32x2 e; e.x = __builtin_amdgcn_exp2f(m1.x); e.y = __builtin_amdgcn_exp2f(m1.y);
                        const f32x2 sden = e + 1.0f; f32x2 r; r.x = __builtin_amdgcn_rcpf(sden.x); r.y = __builtin_amdgcn_rcpf(sden.y);
                        o[n * 2 + hh] = (ga * ua) * r; }
                u32x4 w; w.x = cvt_pk_bf16(o[0].x, o[0].y); w.y = cvt_pk_bf16(o[1].x, o[1].y); w.z = cvt_pk_bf16(o[2].x, o[2].y); w.w = cvt_pk_bf16(o[3].x, o[3].y);
                *(u32x4*)rowp = w; }
    }
};
struct EpiSwigluF8 {
    static constexpr bool PERM = true;
    unsigned char* O;
    __device__ __forceinline__ void operator()(const f32x4 (&acc)[2][2][4][2], const Unit& u, int wr, int wc, int fr, int fq) const {
        unsigned char* base = O + (size_t)(u.pm * BM + wr * 64 + fr) * FF + u.pn * 128 + wc * 32 + 8 * fq;
        constexpr float k1 = -LOG2E / W8S, ik2 = W8S * W8S / A8S;
#pragma unroll
        for (int ai = 0; ai < 2; ++ai)
#pragma unroll
            for (int m = 0; m < 4; ++m) { unsigned char* rowp = base + (size_t)(ai * HALF + m * 16) * FF;
                f32x2 o[4];
#pragma unroll
                for (int n = 0; n < 2; ++n)
#pragma unroll
                    for (int hh = 0; hh < 2; ++hh) { const f32x2 ga = {acc[ai][0][m][n][2 * hh], acc[ai][0][m][n][2 * hh + 1]}, ua = {acc[ai][1][m][n][2 * hh], acc[ai][1][m][n][2 * hh + 1]};
                        const f32x2 m1 = ga * k1; f32x2 e; e.x = __builtin_amdgcn_exp2f(m1.x); e.y = __builtin_amdgcn_exp2f(m1.y);
                        const f32x2 sden = e * ik2 + ik2; f32x2 r; r.x = __builtin_amdgcn_rcpf(sden.x); r.y = __builtin_amdgcn_rcpf(sden.y);
                        const f32x2 t = (ga * ua) * r; o[n * 2 + hh] = (f32x2){__builtin_amdgcn_fmed3f(t.x, -448.f, 448.f), __builtin_amdgcn_fmed3f(t.y, -448.f, 448.f)}; }
                v2u w; w.x = cvt4_fp8(o[0].x, o[0].y, o[1].x, o[1].y); w.y = cvt4_fp8(o[2].x, o[2].y, o[3].x, o[3].y);
                *(v2u*)rowp = w; }
    }
};
template <bool BASE_F32>
struct EpiResid {
    static constexpr bool PERM = true;
    const void* base; bf16_t* out; float oscale;
    __device__ __forceinline__ void operator()(const f32x4 (&acc)[2][2][4][2], const Unit& u, int wr, int wc, int fr, int fq) const {
        const size_t off0 = (size_t)(u.pm * BM + wr * 64 + fr) * DM + u.pn * BM + wc * 32 + 8 * fq;
#pragma unroll
        for (int ai = 0; ai < 2; ++ai)
#pragma unroll
            for (int m = 0; m < 4; ++m) { const size_t off = off0 + (size_t)(ai * HALF + m * 16) * DM;
#pragma unroll
                for (int bj = 0; bj < 2; ++bj) { f32x4 b0, b1;
                    if (BASE_F32) { b0 = *(const f32x4*)((const float*)base + off + bj * HALF); b1 = *(const f32x4*)((const float*)base + off + bj * HALF + 4); }
                    else { const u32x4 w = *(const u32x4*)((const bf16_t*)base + off + bj * HALF);
                        b0 = (f32x4){__builtin_bit_cast(float, w.x << 16), __builtin_bit_cast(float, w.x & 0xffff0000u), __builtin_bit_cast(float, w.y << 16), __builtin_bit_cast(float, w.y & 0xffff0000u)};
                        b1 = (f32x4){__builtin_bit_cast(float, w.z << 16), __builtin_bit_cast(float, w.z & 0xffff0000u), __builtin_bit_cast(float, w.w << 16), __builtin_bit_cast(float, w.w & 0xffff0000u)}; }
                    const f32x4 v0 = b0 + acc[ai][bj][m][0] * oscale, v1 = b1 + acc[ai][bj][m][1] * oscale;
                    u32x4 o; o.x = cvt_pk_bf16(v0[0], v0[1]); o.y = cvt_pk_bf16(v0[2], v0[3]); o.z = cvt_pk_bf16(v1[0], v1[1]); o.w = cvt_pk_bf16(v1[2], v1[3]);
                    *(u32x4*)(out + off + bj * HALF) = o; } }
    }
};
struct EpiMoeDown {
    static constexpr bool PERM = true;
    bf16_t* Y; const float* gw; bf16_t* P; float oscale;
    __device__ __forceinline__ void operator()(const f32x4 (&acc)[2][2][4][2], const Unit& u, int wr, int wc, int fr, int fq) const {
        const float* gp = gw + u.e * LCAP + u.mt * 256 + wr * 64 + fr;
        if (MOE_Y_FP8 && u.kq < 0) {
            unsigned char* base8 = (unsigned char*)Y + (size_t)(u.pm * BM + wr * 64 + fr) * DM + u.pn * BM + wc * 32 + 8 * fq;
#pragma unroll
            for (int ai = 0; ai < 2; ++ai)
#pragma unroll
                for (int m = 0; m < 4; ++m) { unsigned char* rowp = base8 + (size_t)(ai * HALF + m * 16) * DM; const float g = gp[ai * HALF + m * 16] * oscale * Y8S;
#pragma unroll
                    for (int bj = 0; bj < 2; ++bj) { f32x4 v0 = acc[ai][bj][m][0] * g, v1 = acc[ai][bj][m][1] * g;
#pragma unroll
                        for (int q = 0; q < 4; ++q) { v0[q] = __builtin_amdgcn_fmed3f(v0[q], -448.f, 448.f); v1[q] = __builtin_amdgcn_fmed3f(v1[q], -448.f, 448.f); }
                        v2u w; w.x = cvt4_fp8(v0[0], v0[1], v0[2], v0[3]); w.y = cvt4_fp8(v1[0], v1[1], v1[2], v1[3]);
                        *(v2u*)(rowp + bj * HALF) = w; } }
            return;
        }
        bf16_t* base = (u.kq < 0 ? Y + (size_t)(u.pm * BM) * DM : P + ((size_t)u.kq * SPLIT_ROWS + (size_t)(u.pm * BM - SPLIT_ROW0)) * DM) + (size_t)(wr * 64 + fr) * DM + u.pn * BM + wc * 32 + 8 * fq;
#pragma unroll
        for (int ai = 0; ai < 2; ++ai)
#pragma unroll
            for (int m = 0; m < 4; ++m) { bf16_t* rowp = base + (size_t)(ai * HALF + m * 16) * DM; const float g = gp[ai * HALF + m * 16] * oscale;
#pragma unroll
                for (int bj = 0; bj < 2; ++bj) { const f32x4 v0 = acc[ai][bj][m][0] * g, v1 = acc[ai][bj][m][1] * g;
                    u32x4 w; w.x = cvt_pk_bf16(v0[0], v0[1]); w.y = cvt_pk_bf16(v0[2], v0[3]); w.z = cvt_pk_bf16(v1[0], v1[1]); w.w = cvt_pk_bf16(v1[2], v1[3]);
                    *(u32x4*)(rowp + bj * HALF) = w; } }
    }
};

template <class Epi, class Sched, bool GATHER, bool FP8 = false>
__device__ __forceinline__ void gemm_phase(PG8_LAS unsigned char* lds, const int K, const Sched& S, const Epi& E) {
    const int tid = threadIdx.x, wid = __builtin_amdgcn_readfirstlane(tid >> 6), lane = tid & 63, wr = wid >> 2, wc = wid & 3, fr = lane & 15, fq = lane >> 4;
    unsigned voffA[2], voffB[2]; int sR[2], sC[2];
#pragma unroll
    for (int i = 0; i < 2; ++i) { int R, C; stage_rc(tid * 16 + i * 8192, R, C); const int Rb = Epi::PERM ? ((R & ~31) + perm32(R & 31)) : R;
        voffA[i] = (unsigned)(R * K + C) * 2u; voffB[i] = (unsigned)(Rb * K + C) * 2u; sR[i] = R; sC[i] = C; }
    const size_t kstep = (size_t)(BK * 2);
    const size_t hstep = (size_t)HALF * K * 2;
    const unsigned ldsw = (unsigned)wid * 1024u, lds0 = (unsigned)(uintptr_t)lds;
    const int aoff = lds_byte(wr * 64 + fr, fq * 8), boff = lds_byte(wc * 32 + fr, fq * 8);

#define PG8_SA(b, h) (((b) * 2 + (h)) * HTB)
#define PG8_SB(b, h) ((4 + (b) * 2 + (h)) * HTB)
#define PG8_STAGE(bufoff, gbase, voff) do { const char* gb_ = uniptr((const char*)(gbase)); _Pragma("unroll") for (int _i = 0; _i < 2; ++_i) \
        glds16_s(gb_, (voff)[_i], (unsigned)__builtin_amdgcn_readfirstlane(lds0 + (unsigned)(bufoff) + ldsw + (unsigned)(_i * 8192))); } while (0)
#define PG8_STAGE_A(bufoff, p, h, VG) do { if (GATHER) { PG8_STAGE(bufoff, p, VG[h]); } else { PG8_STAGE(bufoff, (p) + ((h) ? hstep : 0), voffA); } } while (0)
#define PG8_LDA(dst, b, h) do { _Pragma("unroll") for (int m = 0; m < 4; ++m) { if constexpr (FP8) { const v4i32 x_ = *(const PG8_LAS v4i32*)(lds + PG8_SA(b, h) + aoff + m * 2048), y_ = *(const PG8_LAS v4i32*)(lds + PG8_SA(b, h) + aoff + m * 2048 + 1024); dst##8[m] = __builtin_shufflevector(x_, y_, 0, 1, 2, 3, 4, 5, 6, 7); } \
        else { _Pragma("unroll") for (int k = 0; k < 2; ++k) dst[m][k] = *(const PG8_LAS bf16x8*)(lds + PG8_SA(b, h) + aoff + m * 2048 + k * 1024); } } } while (0)
#define PG8_LDB(dst, b, h) do { _Pragma("unroll") for (int n = 0; n < 2; ++n) { if constexpr (FP8) { const v4i32 x_ = *(const PG8_LAS v4i32*)(lds + PG8_SB(b, h) + boff + n * 2048), y_ = *(const PG8_LAS v4i32*)(lds + PG8_SB(b, h) + boff + n * 2048 + 1024); dst##8[n] = __builtin_shufflevector(x_, y_, 0, 1, 2, 3, 4, 5, 6, 7); } \
        else { _Pragma("unroll") for (int k = 0; k < 2; ++k) dst[n][k] = *(const PG8_LAS bf16x8*)(lds + PG8_SB(b, h) + boff + n * 2048 + k * 1024); } } } while (0)
#define PG8_MMA(ai, bj, At, Bt) do { __builtin_amdgcn_s_setprio(1); _Pragma("unroll") for (int m = 0; m < 4; ++m) _Pragma("unroll") for (int n = 0; n < 2; ++n) { \
        if constexpr (FP8) asm volatile("v_mfma_scale_f32_16x16x128_f8f6f4 %0, %1, %2, %0, %3, %3 op_sel_hi:[0,0,0]" : "+v"(acc[ai][bj][m][n]) : "v"(Bt##8[n]), "v"(At##8[m]), "v"(sc8));   \
        else { _Pragma("unroll") for (int k = 0; k < 2; ++k) acc[ai][bj][m][n] = __builtin_amdgcn_mfma_f32_16x16x32_bf16(Bt[n][k], At[m][k], acc[ai][bj][m][n], 0, 0, 0); } } \
        __builtin_amdgcn_s_setprio(0); } while (0)
#define PG8_WAIT_V(n) asm volatile("s_waitcnt vmcnt(" #n ")" ::: "memory")
#define PG8_WAIT_L(n) asm volatile("s_waitcnt lgkmcnt(" #n ")" ::: "memory")
#define PG8_BAR __builtin_amdgcn_s_barrier()
#define PG8_SCHED __builtin_amdgcn_sched_barrier(0)
    Unit cur, nxt; int ui = 0;
    if (!S.next(0, cur)) return;
    f32x4 acc[2][2][4][2];
#pragma unroll
    for (int a = 0; a < 2; ++a)
#pragma unroll
        for (int b = 0; b < 2; ++b)
#pragma unroll
            for (int m = 0; m < 4; ++m)
#pragma unroll
                for (int n = 0; n < 2; ++n) acc[a][b][m][n] = (f32x4){0.f, 0.f, 0.f, 0.f};
    bf16x8 At[4][2], B0[2][2], B1[2][2];
    v8i32 At8[4], B08[2], B18[2];
    int sc8 = 0x7F7F7F7F; asm volatile("" : "+v"(sc8));
    const char* cA = S.a_base(cur); const char* cB = S.b_base(cur);
    unsigned vc[2][2] = {{0u, 0u}, {0u, 0u}}, vn[2][2] = {{0u, 0u}, {0u, 0u}};
    if (GATHER) { S.a_voff(cur, sR, sC, vc); asm volatile("s_waitcnt vmcnt(0)" : "+v"(vc[0][0]), "+v"(vc[0][1]), "+v"(vc[1][0]), "+v"(vc[1][1]) :: "memory"); }
    PG8_STAGE(PG8_SB(0, 0), cB, voffB); PG8_STAGE(PG8_SB(0, 1), cB + hstep, voffB); PG8_STAGE_A(PG8_SA(0, 0), cA, 0, vc); PG8_STAGE_A(PG8_SA(0, 1), cA, 1, vc);
    if (wr == 1) PG8_BAR;
    PG8_WAIT_V(2); PG8_BAR;
    PG8_STAGE(PG8_SB(1, 0), cB + kstep, voffB); PG8_STAGE_A(PG8_SA(1, 0), cA + kstep, 0, vc); PG8_STAGE(PG8_SB(1, 1), cB + hstep + kstep, voffB);
    PG8_WAIT_V(6); PG8_BAR;
    for (;;) {
        const bool has_next = S.next(ui + 1, nxt);
        const char* nA = has_next ? S.a_base(nxt) : cA; const char* nB = has_next ? S.b_base(nxt) : cB;
        if (GATHER) {
            if (has_next) { S.a_voff(nxt, sR, sC, vn); asm volatile("s_waitcnt vmcnt(0)" : "+v"(vn[0][0]), "+v"(vn[0][1]), "+v"(vn[1][0]), "+v"(vn[1][1]) :: "memory"); }
            else { vn[0][0] = vc[0][0]; vn[0][1] = vc[0][1]; vn[1][0] = vc[1][0]; vn[1][1] = vc[1][1]; }
        }
        const int nt = cur.nt;
        for (int t = 0; t < nt; t += 2) {
            const bool last = (t == nt - 2);
            const char* a1 = cA + (size_t)(t + 1) * kstep;
            const char* a2 = last ? nA : cA + (size_t)(t + 2) * kstep; const char* b2 = last ? nB : cB + (size_t)(t + 2) * kstep;
            const char* a3 = a2 + kstep; const char* b3 = b2 + kstep;
            unsigned v2[2][2];
#pragma unroll
            for (int h = 0; h < 2; ++h)
#pragma unroll
                for (int i = 0; i < 2; ++i) v2[h][i] = last ? vn[h][i] : vc[h][i];
            PG8_LDB(B0, 0, 0); PG8_LDB(B1, 0, 1); PG8_SCHED; PG8_LDA(At, 0, 0); PG8_STAGE_A(PG8_SA(1, 1), a1, 1, vc);
            PG8_WAIT_V(8); PG8_WAIT_L(0); PG8_BAR; PG8_MMA(0, 0, At, B0); PG8_MMA(0, 1, At, B1); PG8_BAR; PG8_SCHED;
            PG8_LDA(At, 0, 1); PG8_STAGE(PG8_SB(0, 0), b2, voffB); PG8_STAGE(PG8_SB(0, 1), b2 + hstep, voffB); PG8_STAGE_A(PG8_SA(0, 0), a2, 0, v2);
            PG8_WAIT_V(8); PG8_WAIT_L(0); PG8_BAR; PG8_MMA(1, 0, At, B0); PG8_MMA(1, 1, At, B1); PG8_BAR; PG8_SCHED;
            PG8_LDB(B0, 1, 0); PG8_LDB(B1, 1, 1); PG8_SCHED; PG8_LDA(At, 1, 0); PG8_STAGE_A(PG8_SA(0, 1), a2, 1, v2);
            PG8_WAIT_V(8); PG8_WAIT_L(0); PG8_BAR; PG8_MMA(0, 0, At, B0); PG8_MMA(0, 1, At, B1); PG8_BAR; PG8_SCHED;
            PG8_LDA(At, 1, 1); PG8_STAGE(PG8_SB(1, 0), b3, voffB); PG8_STAGE(PG8_SB(1, 1), b3 + hstep, voffB); PG8_STAGE_A(PG8_SA(1, 0), a3, 0, v2);
            PG8_WAIT_V(8); PG8_WAIT_L(0); PG8_BAR; PG8_MMA(1, 0, At, B0); PG8_MMA(1, 1, At, B1); PG8_BAR; PG8_SCHED;
        }
        if (wr == 0) PG8_BAR;
        if constexpr (FP8) asm volatile("s_nop 15\n\ts_nop 15" ::: "memory");
        { int fr_ = fr, fq_ = fq; asm volatile("" : "+v"(fr_), "+v"(fq_)); E(acc, cur, wr, wc, fr_, fq_); }
        if (!has_next) break;
#pragma unroll
        for (int a = 0; a < 2; ++a)
#pragma unroll
            for (int b = 0; b < 2; ++b)
#pragma unroll
                for (int m = 0; m < 4; ++m)
#pragma unroll
                    for (int n = 0; n < 2; ++n) acc[a][b][m][n] = (f32x4){0.f, 0.f, 0.f, 0.f};
        cur = nxt; cA = nA; cB = nB; ++ui;
        if (GATHER) { vc[0][0] = vn[0][0]; vc[0][1] = vn[0][1]; vc[1][0] = vn[1][0]; vc[1][1] = vn[1][1]; }
        if (wr == 1) PG8_BAR;
    }
    PG8_WAIT_V(0);
    PG8_BAR;
#undef PG8_SA
#undef PG8_SB
#undef PG8_STAGE
#undef PG8_STAGE_A
#undef PG8_LDA
#undef PG8_LDB
#undef PG8_MMA
#undef PG8_WAIT_V
#undef PG8_WAIT_L
#undef PG8_BAR
#undef PG8_SCHED
}
}

namespace att {
typedef short bf16x8 __attribute__((ext_vector_type(8)));
typedef short s16x4 __attribute__((ext_vector_type(4)));
typedef float f32x16 __attribute__((ext_vector_type(16)));
typedef unsigned u32x4 __attribute__((ext_vector_type(4)));
typedef LAS char* lptr;
constexpr int SLOTB = 8192, NSLOT = 6, AHEAD = 4;
constexpr int L_K = 0, L_V = NSLOT * SLOTB, L_WS = 2 * NSLOT * SLOTB, L_OST = L_WS + 8 * 256, L_KB = L_OST + 8 * 4096, L_FLG = L_KB + 8192, L_END = L_FLG + 256;
static_assert(L_END <= ATT_LDS_MAX, "attention LDS map");
constexpr float THR = 8.0f;
__device__ __forceinline__ int crow(int r, int hi) { return (r & 3) + 8 * (r >> 2) + 4 * hi; }
__device__ __forceinline__ void glds16(const void* gsrc, unsigned lds_dst) { unsigned keep;
    asm volatile("s_mov_b32 %0, m0\n\ts_mov_b32 m0, %2\n\ts_nop 0\n\tglobal_load_lds_dwordx4 %1, off\n\ts_mov_b32 m0, %0" : "=&s"(keep) : "v"(gsrc), "s"(lds_dst) : "memory"); }
typedef float f32x2_t __attribute__((ext_vector_type(2))); typedef __bf16 bf16x2_t __attribute__((ext_vector_type(2)));
__device__ __forceinline__ unsigned cvtpk(float lo, float hi) { f32x2_t v = {lo, hi}; bf16x2_t b = __builtin_convertvector(v, bf16x2_t); return __builtin_bit_cast(unsigned, b); }
__device__ __forceinline__ bf16x8 gload16(const void* p) { bf16x8 v; asm volatile("global_load_dwordx4 %0, %1, off" : "=v"(v) : "v"(p) : "memory"); return v; }
__device__ __forceinline__ float max3f(float a, float b, float c) { return __builtin_fmaxf(__builtin_fmaxf(a, b), c); }
__device__ __forceinline__ void wait_bar(int n) {
    if (n >= 6) asm volatile("s_waitcnt vmcnt(6) lgkmcnt(0)\n\ts_barrier" ::: "memory");
    else if (n >= 4) asm volatile("s_waitcnt vmcnt(4) lgkmcnt(0)\n\ts_barrier" ::: "memory");
    else if (n >= 2) asm volatile("s_waitcnt vmcnt(2) lgkmcnt(0)\n\ts_barrier" ::: "memory");
    else asm volatile("s_waitcnt vmcnt(0) lgkmcnt(0)\n\ts_barrier" ::: "memory");
}
__device__ __forceinline__ float other_half(float x, int hi) {
    auto rr = __builtin_amdgcn_permlane32_swap(__float_as_uint(x), __float_as_uint(x), false, false);
    return __uint_as_float(hi ? rr[0] : rr[1]);
}
__device__ __forceinline__ void qkt(f32x16& p0, f32x16& p1, lptr Kslot, const bf16x8* qr, const f32x16& c0, const f32x16& c1, int r32, int hi) {
    lptr kb = Kslot + hi * 1024 + r32 * 16;
#pragma unroll
    for (int d0 = 0; d0 < 4; ++d0) {
        const bf16x8 b0 = *(const LAS bf16x8*)(kb + d0 * 2048);
        const bf16x8 b1 = *(const LAS bf16x8*)(kb + d0 * 2048 + 512);
        if (d0 == 0) { p0 = __builtin_amdgcn_mfma_f32_32x32x16_bf16(b0, qr[0], c0, 0, 0, 0); p1 = __builtin_amdgcn_mfma_f32_32x32x16_bf16(b1, qr[0], c1, 0, 0, 0); }
        else { p0 = __builtin_amdgcn_mfma_f32_32x32x16_bf16(b0, qr[d0], p0, 0, 0, 0); p1 = __builtin_amdgcn_mfma_f32_32x32x16_bf16(b1, qr[d0], p1, 0, 0, 0); } }
}
__device__ __forceinline__ void pv(f32x16* o, int vb, bf16x8 pa0, bf16x8 pa1, bf16x8 pa2, bf16x8 pa3) {
#pragma unroll
    for (int d0 = 0; d0 < 2; ++d0) { s16x4 lo[4], hi[4];
#pragma unroll
        for (int ks = 0; ks < 4; ++ks) {
            asm volatile("ds_read_b64_tr_b16 %0,%1 offset:%c2" : "=&v"(lo[ks]) : "v"(vb), "i"(d0 * 4096 + ks * 1024) : "memory");
            asm volatile("ds_read_b64_tr_b16 %0,%1 offset:%c2" : "=&v"(hi[ks]) : "v"(vb), "i"(d0 * 4096 + ks * 1024 + 512) : "memory"); }
        asm volatile("s_waitcnt lgkmcnt(0)" ::: "memory"); __builtin_amdgcn_sched_barrier(0);
#define ATT_PK(k) (bf16x8){lo[k][0], lo[k][1], lo[k][2], lo[k][3], hi[k][0], hi[k][1], hi[k][2], hi[k][3]}
        o[d0] = __builtin_amdgcn_mfma_f32_32x32x16_bf16(pa0, ATT_PK(0), o[d0], 0, 0, 0);
        o[d0] = __builtin_amdgcn_mfma_f32_32x32x16_bf16(pa1, ATT_PK(1), o[d0], 0, 0, 0);
        o[d0] = __builtin_amdgcn_mfma_f32_32x32x16_bf16(pa2, ATT_PK(2), o[d0], 0, 0, 0);
        o[d0] = __builtin_amdgcn_mfma_f32_32x32x16_bf16(pa3, ATT_PK(3), o[d0], 0, 0, 0);
#undef ATT_PK
    }
}
__device__ __forceinline__ void pack_pv(f32x16* o, int vb, const f32x16& p0, const f32x16& p1) {
    u32x4 w0, w1, w2, w3;
#pragma unroll
    for (int j = 0; j < 4; ++j) { w0[j] = cvtpk(p0[2 * j], p0[2 * j + 1]); w1[j] = cvtpk(p0[8 + 2 * j], p0[8 + 2 * j + 1]); w2[j] = cvtpk(p1[2 * j], p1[2 * j + 1]); w3[j] = cvtpk(p1[8 + 2 * j], p1[8 + 2 * j + 1]); }
    pv(o, vb, __builtin_bit_cast(bf16x8, w0), __builtin_bit_cast(bf16x8, w1), __builtin_bit_cast(bf16x8, w2), __builtin_bit_cast(bf16x8, w3));
}
__device__ __forceinline__ float rowmax32(const f32x16& p0, const f32x16& p1, int hi) {
    float a = max3f(p0[0], p0[1], p1[0]), b = max3f(p0[2], p0[3], p1[1]); a = max3f(a, p1[2], p1[3]);
#pragma unroll
    for (int r = 4; r < 16; r += 4) { a = max3f(a, p0[r], p0[r + 1]); b = max3f(b, p0[r + 2], p0[r + 3]); a = max3f(a, p1[r], p1[r + 1]); b = max3f(b, p1[r + 2], p1[r + 3]); }
    a = fmaxf(a, b);
    return fmaxf(a, other_half(a, hi));
}
__device__ __forceinline__ void store_o(const f32x16* o, const float* sc, lptr stgb, bf16* Ow, long rpitch, int lane, int r32, int hi) {
    LAS bf16* stg = (LAS bf16*)stgb;
#pragma unroll
    for (int r = 0; r < 16; ++r) { const int orow = crow(r, hi);
#pragma unroll
        for (int d0 = 0; d0 < 2; ++d0) stg[orow * 64 + d0 * 32 + r32] = (bf16)f2bf(o[d0][r] * sc[r]); }
    asm volatile("s_waitcnt lgkmcnt(0)" ::: "memory");
#pragma unroll
    for (int i = 0; i < 4; ++i) { const int row = i * 8 + (lane >> 3), ch = lane & 7; const u32x4 v = *(const LAS u32x4*)(stg + row * 64 + ch * 8); *(u32x4*)(Ow + (long)row * rpitch + ch * 8) = v; }
}
__device__ __forceinline__ void store_o8(const f32x16* o, const float* sc, lptr stgb, unsigned char* O8w, long rpitch, int lane, int r32, int hi) {
    LAS unsigned char* stg = (LAS unsigned char*)stgb;
#pragma unroll
    for (int r = 0; r < 16; ++r) { const int orow = crow(r, hi); const float s4 = sc[r] * (float)A8S;
        const int pk = __builtin_amdgcn_cvt_pk_fp8_f32(__builtin_amdgcn_fmed3f(o[0][r] * s4, -448.f, 448.f), __builtin_amdgcn_fmed3f(o[1][r] * s4, -448.f, 448.f), 0, false);
        stg[orow * 64 + r32] = (unsigned char)(pk & 0xff); stg[orow * 64 + 32 + r32] = (unsigned char)((pk >> 8) & 0xff); }
    asm volatile("s_waitcnt lgkmcnt(0)" ::: "memory");
#pragma unroll
    for (int i = 0; i < 2; ++i) { const int row = i * 16 + (lane >> 2), ch = lane & 3; const u32x4 v = *(const LAS u32x4*)(stg + row * 64 + ch * 16); *(u32x4*)(O8w + (long)row * rpitch + ch * 16) = v; }
}
__device__ __forceinline__ void softmax_step(f32x16& p0, f32x16& p1, float& mref, float& lsum, f32x16* o, LAS float* wsf, int r32, int hi) {
    const float rm = rowmax32(p0, p1, hi);
    const bool fresh = mref <= -1e30f;
    const bool want = !fresh && (rm > mref + THR);
    if (fresh) mref = fmaxf(rm, -1e30f);
    if (__any(want)) {
        const float dl = want ? rm - mref : 0.f; mref += dl; const float f = __builtin_amdgcn_exp2f(-dl); lsum *= f;
        if (hi == 0) wsf[r32] = f;
        asm volatile("s_waitcnt lgkmcnt(0)" ::: "memory");
#pragma unroll
        for (int r = 0; r < 16; ++r) { const float fr = wsf[crow(r, hi)]; o[0][r] *= fr; o[1][r] *= fr; }
    }
    float sa = 0.f, sb = 0.f;
#pragma unroll
    for (int r = 0; r < 16; ++r) { p0[r] = __builtin_amdgcn_exp2f(p0[r] - mref); p1[r] = __builtin_amdgcn_exp2f(p1[r] - mref); sa += p0[r]; sb += p1[r]; }
    lsum += sa + sb;
}

struct WaveCtx { int lane, r32, hi, wid; unsigned lds0; int vb0; lptr shm; };
struct UnitD { int NT; int b, h, qb, g, x; };

template <int MODE> struct CausalMode {
    const bf16* Q; const bf16* K; const bf16* V; bf16* O; int b, h, p; bool f8;
    float carry, mref, lsum; int done;
    __device__ __forceinline__ int units() const { return 4; }
    __device__ __forceinline__ void desc(int j, UnitD& d) const { d.b = b; d.h = h; d.qb = (j == 0) ? 7 - p : (j == 1) ? 5 - p : (j == 2) ? 2 + p : p; d.NT = 4 * (d.qb + 1); d.g = 0; d.x = 0; }
    __device__ __forceinline__ int tile_of(const UnitD& d, int k) const { return MODE == 0 ? d.NT - 1 - k : k; }
    __device__ __forceinline__ void q_load(const UnitD& d, const WaveCtx& w, bf16x8 (&q)[4]) const {
        const bf16* Qw = Q + ((long)d.b * SEQ + d.qb * 256 + w.wid * 32 + w.r32) * DM + d.h * 64 + w.hi * 8;
#pragma unroll
        for (int d0 = 0; d0 < 4; ++d0) q[d0] = gload16(Qw + d0 * 16);
    }
    __device__ __forceinline__ void dma(const UnitD& d, int k, int slot, const WaveCtx& w) const {
        const long row0 = (long)d.b * SEQ + 64 * tile_of(d, k);
        glds16(K + (row0 + w.lane) * DM + d.h * 64 + w.wid * 8, (unsigned)__builtin_amdgcn_readfirstlane(w.lds0 + L_K + slot * SLOTB + w.wid * 1024));
        glds16(V + (row0 + 16 * (w.wid & 3) + (w.lane >> 2)) * DM + d.h * 64 + (w.wid >> 2) * 32 + (w.lane & 3) * 8, (unsigned)__builtin_amdgcn_readfirstlane(w.lds0 + L_V + slot * SLOTB + w.wid * 1024));
    }
    __device__ __forceinline__ void begin(const UnitD&, const WaveCtx&) { carry = 1.0f; mref = -1e30f; lsum = 0.f; done = 0; }
    __device__ __forceinline__ int wave_done() const { return done; }
    __device__ __forceinline__ void compute(const UnitD& d, int k, int slot, const WaveCtx& w, const bf16x8* qr, f32x16* o) {
        const int T = tile_of(d, k), qfirst = d.qb * 256 + w.wid * 32, qpos = qfirst + w.r32;
        if (MODE == 0) {
            if (done || 64 * T >= qfirst + 31) return;
            f32x16 p0, p1; const f32x16 z = {}; qkt(p0, p1, w.shm + L_K + slot * SLOTB, qr, z, z, w.r32, w.hi);
            const bool diag = 64 * T + 63 >= qfirst;
            float ga[8];
#pragma unroll
            for (int a = 0; a < 8; ++a) {
                float rr[4];
#pragma unroll
                for (int i = 0; i < 4; ++i) { const int r = 4 * (a & 3) + i; const float zz = (a < 4) ? p0[r] : p1[r];
                    const float e = __builtin_amdgcn_exp2f(fminf(zz, 120.f)); float rv = __builtin_amdgcn_rcpf(1.0f + e);
                    if (diag) { const int kv = 64 * T + crow(r, w.hi) + ((a < 4) ? 0 : 32); if (kv >= qpos) rv = 1.0f; }
                    rr[i] = rv; if (a < 4) p0[r] = rv; else p1[r] = rv; }
                ga[a] = (rr[0] * rr[1]) * (rr[2] * rr[3]);
            }
            float oth[8], Ts[8];
#pragma unroll
            for (int a = 0; a < 8; ++a) oth[a] = other_half(ga[a], w.hi);
            float run = 1.0f;
#pragma unroll
            for (int a = 7; a >= 0; --a) { Ts[a] = run; run *= ga[a] * oth[a]; }
#pragma unroll
            for (int a = 0; a < 8; ++a) {
                float E = carry * Ts[a] * (w.hi ? 1.0f : oth[a]);
#pragma unroll
                for (int i = 3; i >= 0; --i) { const int r = 4 * (a & 3) + i; const float rv = (a < 4) ? p0[r] : p1[r]; const float wt = (1.0f - rv) * E; E *= rv; if (a < 4) p0[r] = wt; else p1[r] = wt; }
            }
            carry *= run;
            pack_pv(o, w.vb0 + slot * SLOTB, p0, p1);
            if (__all(carry < 1e-30f)) done = 1;
        } else {
            if (64 * T > qfirst + 31) return;
            LAS float* kbl = (LAS float*)(w.shm + L_KB);
            f32x16 c0, c1;
#pragma unroll
            for (int g = 0; g < 4; ++g) { const f32x4 k0 = *(const LAS f32x4*)(kbl + 64 * T + 8 * g + 4 * w.hi), k1 = *(const LAS f32x4*)(kbl + 64 * T + 32 + 8 * g + 4 * w.hi);
#pragma unroll
                for (int i = 0; i < 4; ++i) { c0[4 * g + i] = k0[i]; c1[4 * g + i] = k1[i]; } }
            f32x16 p0, p1; qkt(p0, p1, w.shm + L_K + slot * SLOTB, qr, c0, c1, w.r32, w.hi);
            if (64 * T + 63 > qfirst) {
#pragma unroll
                for (int r = 0; r < 16; ++r) { const int kv = 64 * T + crow(r, w.hi); if (kv > qpos) p0[r] = -INFINITY; if (kv + 32 > qpos) p1[r] = -INFINITY; } }
            softmax_step(p0, p1, mref, lsum, o, (LAS float*)(w.shm + L_WS) + w.wid * 64, w.r32, w.hi);
            pack_pv(o, w.vb0 + slot * SLOTB, p0, p1);
        }
    }
    __device__ __forceinline__ void finish(const UnitD& d, const WaveCtx& w, const f32x16* o) {
        LAS float* wsf = (LAS float*)(w.shm + L_WS) + w.wid * 64;
        float sc[16];
        if (MODE == 0) {
#pragma unroll
            for (int r = 0; r < 16; ++r) sc[r] = 1.0f;
        } else {
            float lt = lsum + other_half(lsum, w.hi);
            if (w.hi == 0) wsf[32 + w.r32] = lt;
            asm volatile("s_waitcnt lgkmcnt(0)" ::: "memory");
#pragma unroll
            for (int r = 0; r < 16; ++r) sc[r] = __builtin_amdgcn_rcpf(wsf[32 + crow(r, w.hi)]);
        }
        if (f8) store_o8(o, sc, w.shm + L_OST + w.wid * 4096, (unsigned char*)O + ((long)d.b * SEQ + d.qb * 256 + w.wid * 32) * DM + d.h * 64, DM, w.lane, w.r32, w.hi);
        else store_o(o, sc, w.shm + L_OST + w.wid * 4096, O + ((long)d.b * SEQ + d.qb * 256 + w.wid * 32) * DM + d.h * 64, DM, w.lane, w.r32, w.hi);
    }
};

struct DilMode {
    const bf16* PROJ; bf16* OG; float* ST; bf16* Of; int b, h, p, pass;
    float mref, lsum;
    __device__ __forceinline__ int units() const { return pass == 0 ? 8 : 4; }
    __device__ __forceinline__ void desc(int j, UnitD& d) const {
        const int g = pass == 0 ? (j >> 2) : 2, i = j & 3; d.g = g; d.b = b; d.h = h; d.qb = 0;
        d.x = (g == 1) ? ((2 * (i >> 1) + p) << 1) + (i & 1) : 2 * i + p;
        const int i0 = (g == 0) ? 256 * d.x : (g == 1) ? 256 * (d.x & 1) : 0;
        d.NT = (g == 2) ? 4 : ((i0 >> 6) + 4 - t_lo(g, i0));
    }
    static __device__ __forceinline__ int t_lo(int g, int i0) { return (g == 2) ? 0 : ((i0 >> 6) >= 2 ? (i0 >> 6) - 2 : 0); }
    static __device__ __forceinline__ int dil_of(int g) { return (g == 0) ? 1 : (g == 1) ? 4 : 16; }
    static __device__ __forceinline__ int cls0_of(int g, int x) { return (g == 0) ? 0 : (g == 1) ? (x >> 1) : 2 * x; }
    static __device__ __forceinline__ int i0_of(int g, int x) { return (g == 0) ? 256 * x : (g == 1) ? 256 * (x & 1) : 0; }
    static __device__ __forceinline__ int tcls(int g, int x, int k) { return cls0_of(g, x) + ((g == 2) ? (k >> 1) : 0); }
    static __device__ __forceinline__ int kbase(int g, int x, int k) { return (g == 2) ? 64 * (k & 1) : 64 * (t_lo(g, i0_of(g, x)) + k); }
    __device__ __forceinline__ void q_load(const UnitD& d, const WaveCtx& w, bf16x8 (&q)[4]) const {
        const int dil = dil_of(d.g), clsw = cls0_of(d.g, d.x) + ((d.g == 2) ? (w.wid >> 2) : 0), qi0w = (d.g == 2) ? 32 * (w.wid & 3) : i0_of(d.g, d.x) + 32 * w.wid;
        const bf16* Qw = PROJ + (size_t)(2 * d.g) * PLANE + ((long)d.b * SEQ + clsw + (long)(qi0w + w.r32) * dil) * DM + d.h * 64 + w.hi * 8;
#pragma unroll
        for (int d0 = 0; d0 < 4; ++d0) q[d0] = gload16(Qw + d0 * 16);
    }
    __device__ __forceinline__ void dma(const UnitD& d, int k, int slot, const WaveCtx& w) const {
        const int dil = dil_of(d.g); const long tok0 = (long)d.b * SEQ + tcls(d.g, d.x, k) + (long)kbase(d.g, d.x, k) * dil;
        glds16(PROJ + (size_t)(2 * d.g + 1) * PLANE + (tok0 + (long)w.lane * dil) * DM + d.h * 64 + w.wid * 8, (unsigned)__builtin_amdgcn_readfirstlane(w.lds0 + L_K + slot * SLOTB + w.wid * 1024));
        glds16(PROJ + (size_t)6 * PLANE + (tok0 + (long)(16 * (w.wid & 3) + (w.lane >> 2)) * dil) * DM + d.h * 64 + (w.wid >> 2) * 32 + (w.lane & 3) * 8, (unsigned)__builtin_amdgcn_readfirstlane(w.lds0 + L_V + slot * SLOTB + w.wid * 1024));
    }
    __device__ __forceinline__ void begin(const UnitD&, const WaveCtx&) { mref = -1e30f; lsum = 0.f; }
    __device__ __forceinline__ int wave_done() const { return 0; }
    __device__ __forceinline__ void compute(const UnitD& d, int k, int slot, const WaveCtx& w, const bf16x8* qr, f32x16* o) {
        const int clsw = cls0_of(d.g, d.x) + ((d.g == 2) ? (w.wid >> 2) : 0), qi0w = (d.g == 2) ? 32 * (w.wid & 3) : i0_of(d.g, d.x) + 32 * w.wid;
        const int kb = kbase(d.g, d.x, k);
        if (tcls(d.g, d.x, k) != clsw || kb > qi0w + 31 || kb < qi0w - 191) return;
        LAS float* tbl = (LAS float*)(w.shm + L_KB) + d.g * 640 + 256;
        const int dbase = qi0w + w.r32 - kb - 4 * w.hi;
        f32x16 c0, c1;
#pragma unroll
        for (int r = 0; r < 16; ++r) { const int cr = (r & 3) + 8 * (r >> 2); c0[r] = tbl[dbase - cr]; c1[r] = tbl[dbase - cr - 32]; }
        f32x16 p0, p1; qkt(p0, p1, w.shm + L_K + slot * SLOTB, qr, c0, c1, w.r32, w.hi);
        softmax_step(p0, p1, mref, lsum, o, (LAS float*)(w.shm + L_WS) + w.wid * 64, w.r32, w.hi);
        pack_pv(o, w.vb0 + slot * SLOTB, p0, p1);
    }
    __device__ __forceinline__ void finish(const UnitD& d, const WaveCtx& w, const f32x16* o) {
        const int dil = dil_of(d.g), clsw = cls0_of(d.g, d.x) + ((d.g == 2) ? (w.wid >> 2) : 0), qi0w = (d.g == 2) ? 32 * (w.wid & 3) : i0_of(d.g, d.x) + 32 * w.wid;
        LAS float* wsf = (LAS float*)(w.shm + L_WS) + w.wid * 64;
        const float lt = lsum + other_half(lsum, w.hi);
        if (w.hi == 0) { wsf[32 + w.r32] = lt; wsf[w.r32] = mref;
            if (pass == 0) { const long tok = (long)d.b * SEQ + clsw + (long)(qi0w + w.r32) * dil;
                *(f32x2*)(ST + ((size_t)d.g * M * NH + (size_t)tok * NH + d.h) * 2) = (f32x2){mref, lt}; } }
        asm volatile("s_waitcnt lgkmcnt(0)" ::: "memory");
        float sc[16];
#pragma unroll
        for (int r = 0; r < 16; ++r) sc[r] = __builtin_amdgcn_rcpf(wsf[32 + crow(r, w.hi)]);
        if (pass == 0) { store_o(o, sc, w.shm + L_OST + w.wid * 4096, OG + (size_t)d.g * PLANE + ((long)d.b * SEQ + clsw + (long)qi0w * dil) * DM + d.h * 64, (long)dil * DM, w.lane, w.r32, w.hi); return; }
        LAS bf16* stg = (LAS bf16*)(w.shm + L_OST + w.wid * 4096);
#pragma unroll
        for (int r = 0; r < 16; ++r) { const int orow = crow(r, w.hi);
#pragma unroll
            for (int d0 = 0; d0 < 2; ++d0) stg[orow * 64 + d0 * 32 + w.r32] = (bf16)f2bf(o[d0][r] * sc[r]); }
        asm volatile("s_waitcnt lgkmcnt(0)" ::: "memory");
#pragma unroll
        for (int i = 0; i < 4; ++i) { const int row = i * 8 + (w.lane >> 3), ch = w.lane & 7;
            const long tok = (long)d.b * SEQ + clsw + (long)(qi0w + row) * dil;
            const f32x2 s0 = *(const f32x2*)(ST + ((size_t)0 * M * NH + (size_t)tok * NH + d.h) * 2), s1 = *(const f32x2*)(ST + ((size_t)1 * M * NH + (size_t)tok * NH + d.h) * 2);
            const float m2 = wsf[row], l2 = wsf[32 + row];
            const float mx = fmaxf(s0.x, fmaxf(s1.x, m2));
            float w0 = __builtin_amdgcn_exp2f(s0.x - mx) * s0.y, w1 = __builtin_amdgcn_exp2f(s1.x - mx) * s1.y, w2 = __builtin_amdgcn_exp2f(m2 - mx) * l2;
            const float inv = __builtin_amdgcn_rcpf(w0 + w1 + w2); w0 *= inv; w1 *= inv; w2 *= inv;
            const v4u x0 = *(const GAS v4u*)(OG + (size_t)tok * DM + d.h * 64 + ch * 8), x1 = *(const GAS v4u*)(OG + PLANE + (size_t)tok * DM + d.h * 64 + ch * 8);
            const v4u x2 = *(const LAS v4u*)(stg + row * 64 + ch * 8); v4u rr;
#pragma unroll
            for (int q = 0; q < 4; ++q) { const float lo = w0 * bflo(x0[q]) + w1 * bflo(x1[q]) + w2 * bflo(x2[q]), hi2 = w0 * bfhi(x0[q]) + w1 * bfhi(x1[q]) + w2 * bfhi(x2[q]);
                if (WO_FP8) rr[q] = (unsigned)__builtin_amdgcn_cvt_pk_fp8_f32(__builtin_amdgcn_fmed3f(lo * (float)A8S, -448.f, 448.f), __builtin_amdgcn_fmed3f(hi2 * (float)A8S, -448.f, 448.f), 0, false) & 0xffffu;
                else rr[q] = pk2(lo, hi2); }
            if (WO_FP8) *(GAS v2u*)((GAS unsigned char*)Of + (size_t)tok * DM + d.h * 64 + ch * 8) = (v2u){rr[0] | (rr[1] << 16), rr[2] | (rr[3] << 16)};
            else *(GAS v4u*)(Of + (size_t)tok * DM + d.h * 64 + ch * 8) = rr; }
    }
};

template <class Mode, bool EARLY_EXIT>
__device__ __forceinline__ void stream_units(Mode& Mo, const WaveCtx& w) {
    LAS int* flg = (LAS int*)(w.shm + L_FLG);
    const int nun = Mo.units();
    int pj = 0, pk = 0, pseq = 0, cseq = 0;
    UnitD pd; Mo.desc(0, pd);
    bf16x8 qn[4];
    if (EARLY_EXIT && w.wid == 0 && w.lane < 4) flg[w.lane] = 0;
    asm volatile("s_waitcnt vmcnt(0)" ::: "memory");
#define ATT_PRODUCE() do { if (pj < nun) { if (pk == 0) Mo.q_load(pd, w, qn); Mo.dma(pd, pk, pseq % NSLOT, w); ++pseq; if (++pk == pd.NT) { pk = 0; if (++pj < nun) Mo.desc(pj, pd); } } } while (0)
#pragma unroll 1
    for (int i = 0; i < AHEAD; ++i) ATT_PRODUCE();
#pragma unroll 1
    for (int cj = 0; cj < nun; ++cj) {
        UnitD d; Mo.desc(cj, d);
        bf16x8 qr[4];
        f32x16 o[2]; o[0] = f32x16{}; o[1] = f32x16{};
        Mo.begin(d, w);
        const int useq0 = cseq;
        int rep = 0;
#pragma unroll 1
        while (pseq - cseq < AHEAD && pj < nun) ATT_PRODUCE();
#pragma unroll 1
        for (int ck = 0; ck < d.NT; ++ck) {
            wait_bar(2 * (pseq - cseq - 1));
            if (ck == 0) { asm volatile("" : "+v"(qn[0]), "+v"(qn[1]), "+v"(qn[2]), "+v"(qn[3])); qr[0] = qn[0]; qr[1] = qn[1]; qr[2] = qn[2]; qr[3] = qn[3]; }
            if (EARLY_EXIT && ck == 1 && w.wid == 0 && w.lane < 2) flg[((cj + 1) & 1) * 2 + w.lane] = 0;
            if (EARLY_EXIT && ck > 0) {
                if (__builtin_amdgcn_readfirstlane(flg[(cj & 1) * 2 + ((ck - 1) & 1)]) == 8) {
                    const int uend = useq0 + d.NT;
                    if (pj == cj) { pk = 0; if (++pj < nun) Mo.desc(pj, pd); }
                    cseq = uend < pseq ? uend : pseq;
                    break; } }
            if (pseq - cseq < AHEAD) ATT_PRODUCE();
            Mo.compute(d, ck, cseq % NSLOT, w, qr, o);
            if (EARLY_EXIT && Mo.wave_done() && rep < 2) { if (w.lane == 0) __hip_atomic_fetch_add(&flg[(cj & 1) * 2 + (ck & 1)], 1, __ATOMIC_RELAXED, __HIP_MEMORY_SCOPE_WORKGROUP); ++rep; }
            ++cseq;
        }
        Mo.finish(d, w, o);
    }
    asm volatile("s_waitcnt vmcnt(0) lgkmcnt(0)\n\ts_barrier" ::: "memory");
#undef ATT_PRODUCE
}
__device__ __forceinline__ WaveCtx make_ctx(lptr shm) {
    WaveCtx w; const int tid = threadIdx.x; w.lane = tid & 63; w.r32 = w.lane & 31; w.hi = w.lane >> 5; w.wid = __builtin_amdgcn_readfirstlane(tid >> 6);
    w.shm = shm; w.lds0 = (unsigned)(uintptr_t)shm;
    w.vb0 = (int)(w.lds0 + L_V) + ((w.lane >> 4) & 1) * 32 + (w.lane & 3) * 8 + (4 * w.hi + ((w.lane & 15) >> 2)) * 64;
    return w;
}
template <int MODE>
__device__ __forceinline__ void causal_phase(lptr shm, int G, const bf16* Q, const bf16* K, const bf16* V, bf16* O, const float* cum, bool f8) {
    const int bx = blockIdx.x; const int vcu = (G % 8 == 0) ? (bx % 8) * (G / 8) + bx / 8 : bx;
    const WaveCtx w = make_ctx(shm);
    for (int u = vcu; u < BATCH * NH * 2; u += G) {
        CausalMode<MODE> Mo; Mo.Q = Q; Mo.K = K; Mo.V = V; Mo.O = O; Mo.f8 = f8; Mo.b = u >> 5; Mo.h = (u >> 1) & 15; Mo.p = u & 1;
        if (MODE == 2) {
            LAS float* kbl = (LAS float*)(shm + L_KB); LAS float* wtot = (LAS float*)(shm + L_FLG + 64);
            const int t4 = threadIdx.x * 4; float v0, v1, v2, v3;
            { const float* lp = cum + ((long)Mo.b * SEQ + t4) * 16 + Mo.h; v0 = lp[0]; v1 = lp[16]; v2 = lp[32]; v3 = lp[48]; }
            v1 += v0; v2 += v1; v3 += v2;
            float incl = v3;
#pragma unroll
            for (int o = 1; o < 64; o <<= 1) { const float t = __shfl_up(incl, o); if (w.lane >= o) incl += t; }
            if (w.lane == 63) wtot[w.wid] = incl;
            __syncthreads();
            float off = incl - v3;
#pragma unroll
            for (int x = 0; x < 8; ++x) off += (x < w.wid) ? wtot[x] : 0.f;
            *(LAS f32x4*)(kbl + t4) = (f32x4){-(off + v0), -(off + v1), -(off + v2), -(off + v3)};
        }
        stream_units<CausalMode<MODE>, MODE == 0>(Mo, w);
    }
}
__device__ __forceinline__ int t5_bucket_f(int dist) {
    if (dist < 16) return dist;
    int lb = 16 + (int)(logf((float)dist / 16.0f) / logf(128.0f) * 16.0f);
    return lb < 31 ? lb : 31;
}
__device__ __forceinline__ void dil_phase(lptr shm, int G, const bf16* PROJ, bf16* OG, float* ST, const float* rel_bias, int pass, bf16* Of) {
    const int bx = blockIdx.x; const int vcu = (G % 8 == 0) ? (bx % 8) * (G / 8) + bx / 8 : bx;
    const WaveCtx w = make_ctx(shm);
    for (int u = vcu; u < BATCH * NH * 2; u += G) {
        DilMode Mo; Mo.PROJ = PROJ; Mo.OG = OG; Mo.ST = ST; Mo.Of = Of; Mo.pass = pass; Mo.b = u >> 5; Mo.h = (u >> 1) & 15; Mo.p = u & 1;
        LAS float* tb = (LAS float*)(shm + L_KB);
        for (int i = threadIdx.x; i < 3 * 640; i += NTHR) { const int gg = i / 640, dl = i - gg * 640 - 256; const int dil = (gg == 0) ? 1 : (gg == 1) ? 4 : 16;
            tb[i] = (dl >= 0 && dl <= 128) ? rel_bias[t5_bucket_f(dl * dil) * 16 + Mo.h] * LOG2E : -INFINITY; }
        stream_units<DilMode, false>(Mo, w);
    }
}
__device__ __forceinline__ void dil_merge(int G, const bf16* OG, const float* ST, bf16* O) {
    for (int idx = blockIdx.x * NTHR + threadIdx.x; idx < M * NH; idx += G * NTHR) {
        const f32x2 s0 = *(const f32x2*)(ST + ((size_t)0 * M * NH + idx) * 2), s1 = *(const f32x2*)(ST + ((size_t)1 * M * NH + idx) * 2), s2 = *(const f32x2*)(ST + ((size_t)2 * M * NH + idx) * 2);
        const float mx = fmaxf(s0.x, fmaxf(s1.x, s2.x));
        float w0 = __builtin_amdgcn_exp2f(s0.x - mx) * s0.y, w1 = __builtin_amdgcn_exp2f(s1.x - mx) * s1.y, w2 = __builtin_amdgcn_exp2f(s2.x - mx) * s2.y;
        const float inv = 1.0f / (w0 + w1 + w2); w0 *= inv; w1 *= inv; w2 *= inv;
        const GAS v4u* a0 = (const GAS v4u*)(OG + (size_t)idx * 64); const GAS v4u* a1 = (const GAS v4u*)(OG + PLANE + (size_t)idx * 64); const GAS v4u* a2 = (const GAS v4u*)(OG + 2 * PLANE + (size_t)idx * 64);
        GAS v4u* op = (GAS v4u*)(O + (size_t)idx * 64);
#pragma unroll
        for (int c = 0; c < 8; ++c) { const v4u x0 = a0[c], x1 = a1[c], x2 = a2[c]; v4u r;
#pragma unroll
            for (int q = 0; q < 4; ++q) r[q] = pk2(w0 * bflo(x0[q]) + w1 * bflo(x1[q]) + w2 * bflo(x2[q]), w0 * bfhi(x0[q]) + w1 * bfhi(x1[q]) + w2 * bfhi(x2[q]));
            op[c] = r; }
    }
}
}

enum { CV_PLAIN = 0, CV_QKN = 1, CV_GATE = 2, CV_UP = 3 };
__device__ __forceinline__ int cv_dst_row(int mode, int n) {
    if (mode == CV_QKN) return (n & ~255) + 128 * ((n >> 5) & 1) + 32 * ((n >> 6) & 3) + (n & 31);
    if (mode == CV_GATE) return 256 * (n >> 7) + (n & 127);
    if (mode == CV_UP) return 256 * (n >> 7) + 128 + (n & 127);
    return n;
}
__device__ __forceinline__ void conv_item(const float* W, int ldw, int K, bf16* WT, int mode, LAS unsigned char* scr, int item, int nblk, int lane) {
    const int kb = item / nblk, nb = item - kb * nblk, k0 = 64 * kb, n0 = 64 * nb;
    const GAS float* src = (const GAS float*)(W + (size_t)k0 * ldw + n0 + lane);
#pragma unroll
    for (int kc = 0; kc < 8; ++kc) {
        float v[8];
#pragma unroll
        for (int j = 0; j < 8; ++j) v[j] = src[(size_t)(kc * 8 + j) * ldw];
        v4u w; w.x = pk2(v[0], v[1]); w.y = pk2(v[2], v[3]); w.z = pk2(v[4], v[5]); w.w = pk2(v[6], v[7]);
        *(LAS v4u*)(scr + lane * 144 + kc * 16) = w;
    }
    asm volatile("s_waitcnt lgkmcnt(0)" ::: "memory");
#pragma unroll
    for (int j = 0; j < 8; ++j) { const int n = 8 * j + (lane >> 3), ch = lane & 7;
        const v4u w = *(const LAS v4u*)(scr + n * 144 + ch * 16);
        *(GAS v4u*)(WT + (size_t)cv_dst_row(mode, n0 + n) * K + k0 + 8 * ch) = w; }
    asm volatile("s_waitcnt lgkmcnt(0)" ::: "memory");
}
__device__ __forceinline__ void conv_item8(const float* W, int ldw, int K, unsigned char* WT8, int mode, LAS unsigned char* scr, int item, int nblk, int lane) {
    const int kb = item / nblk, nb = item - kb * nblk, k0 = 128 * kb, n0 = 64 * nb;
    const GAS float* src = (const GAS float*)(W + (size_t)k0 * ldw + n0 + lane);
#pragma unroll 4
    for (int kc = 0; kc < 16; ++kc) {
        float v[8];
#pragma unroll
        for (int j = 0; j < 8; ++j) v[j] = src[(size_t)(kc * 8 + j) * ldw] * W8S;
        v2u w; w.x = pg8::cvt4_fp8(v[0], v[1], v[2], v[3]); w.y = pg8::cvt4_fp8(v[4], v[5], v[6], v[7]);
        *(LAS v2u*)(scr + lane * 144 + kc * 8) = w;
    }
    asm volatile("s_waitcnt lgkmcnt(0)" ::: "memory");
#pragma unroll
    for (int j = 0; j < 8; ++j) { const int n = 8 * j + (lane >> 3), ch = lane & 7;
        const v4u w = *(const LAS v4u*)(scr + n * 144 + ch * 16);
        *(GAS v4u*)(WT8 + (size_t)cv_dst_row(mode, n0 + n) * K + k0 + 16 * ch) = w; }
    asm volatile("s_waitcnt lgkmcnt(0)" ::: "memory");
}
static_assert(MOE_FP8 && DILIN_FP8 && FOXIN_FP8 && QKV3_FP8 && DENSE_FP8_L2 && !DENSE_FP8_L0, "the conversion queue is laid out for this precision plan");
constexpr int CV_TOTAL = 28608;
static_assert(WO_FP8, "the conversion queue below holds e4m3 Wo weights for layers 1-3");
constexpr int cv_need(int p) {
    return p >= 24 ? 28608 : p >= 23 ? 25024 : p >= 21 ? 17856 : p >= 19 ? 17728 : p >= 18 ? 17344 : p >= 17 ? 16896 : p >= 16 ? 16000 : p >= 14 ? 15872 : p >= 12 ? 15488
         : p >= 11 ? 11904 : p >= 9 ? 4736 : p >= 6 ? 4608 : p >= 5 ? 3712 : p >= 4 ? 2816 : p >= 3 ? 1024 : p >= 1 ? 768 : 0;
}
__device__ __forceinline__ void cv_run_item(Frame& F, int idx) {
    LAS unsigned char* scr = F.lds + F.wave * 9216;
    unsigned char* WB8 = F.ws + WS_W;
    int inp, ldw, K, N, mode = CV_PLAIN, it; size_t soff = 0, doff; bool f8 = false;
    if (idx < 768)        { it = idx;         inp = 1;  ldw = 3 * DM; K = DM; N = 3 * DM; doff = WE_QKV * 2; }
    else if (idx < 1024)  { it = idx - 768;   inp = 2;  ldw = DM; K = DM; N = DM; doff = WE_WO_SB * 2; }
    else if (idx < 2816)  { const int l = idx - 1024, u = l >= 896; it = l - 896 * u; inp = 15 + u; ldw = FF; K = DM; N = FF; doff = WE_GU * 2; mode = u ? CV_UP : CV_GATE; }
    else if (idx < 3712)  { it = idx - 2816;  inp = 17; ldw = DM; K = FF; N = DM; doff = WE_D * 2; }
    else if (idx < 4608)  { it = idx - 3712;  inp = 3;  ldw = 7 * DM; K = DM; N = 7 * DM; doff = WE_IN_DIL * 2; mode = CV_QKN; f8 = true; }
    else if (idx < 4736)  { it = idx - 4608;  inp = 6;  ldw = DM; K = DM; N = DM; doff = WE_WO_DIL * 2; f8 = true; }
    else if (idx < 15872) {
        if (idx < 11904)      { const int l = idx - 4736, fe = l / 896, r = l - fe * 896, u = r >= 448; it = r - 448 * u; inp = 19 + u; ldw = FF; K = DM; N = FF; soff = (size_t)fe * DM * FF;
                                doff = WE_MGU * 2 + (size_t)fe * 2 * FF * DM; mode = u ? CV_UP : CV_GATE; f8 = true; }
        else if (idx < 15488) { const int l = idx - 11904, fe = l / 448; it = l - fe * 448; inp = 21; ldw = DM; K = FF; N = DM; soff = (size_t)fe * FF * DM; doff = WE_MD * 2 + (size_t)fe * DM * FF; f8 = true; }
        else                  { it = idx - 15488; inp = 7; ldw = 3088; K = DM; N = 3 * DM; doff = WE_IN_FOX * 2; mode = CV_QKN; f8 = true; }
    }
    else if (idx < 16000) { it = idx - 15872; inp = 11; ldw = DM; K = DM; N = DM; doff = WE_WO_FOX * 2; f8 = true; }
    else if (idx < 16896) { const int l = idx - 16000, u = l >= 448; it = l - 448 * u; inp = 15 + u; ldw = FF; K = DM; N = FF; soff = (size_t)DM * FF; doff = (WE_GU + (size_t)2 * FF * DM) * 2; mode = u ? CV_UP : CV_GATE; f8 = true; }
    else if (idx < 17344) { it = idx - 16896; inp = 17; ldw = DM; K = FF; N = DM; soff = (size_t)FF * DM; doff = (WE_D + (size_t)DM * FF) * 2; f8 = true; }
    else if (idx < 17728) { it = idx - 17344; inp = 1;  ldw = 3 * DM; K = DM; N = 3 * DM; soff = (size_t)DM * 3 * DM; doff = (WE_QKV + (size_t)3 * DM * DM) * 2; f8 = true; }
    else if (idx < 17856) { it = idx - 17728; inp = 2;  ldw = DM; K = DM; N = DM; soff = (size_t)DM * DM; doff = (WE_WO_SB + (size_t)DM * DM) * 2; f8 = true; }
    else if (idx < 25024) { const int l = idx - 17856, fe = 8 + l / 896, r = l - (fe - 8) * 896, u = r >= 448; it = r - 448 * u; inp = 19 + u; ldw = FF; K = DM; N = FF; soff = (size_t)fe * DM * FF;
                            doff = WE_MGU * 2 + (size_t)fe * 2 * FF * DM; mode = u ? CV_UP : CV_GATE; f8 = true; }
    else                  { const int l = idx - 25024, fe = 8 + l / 448; it = l - (fe - 8) * 448; inp = 21; ldw = DM; K = FF; N = DM; soff = (size_t)fe * FF * DM; doff = WE_MD * 2 + (size_t)fe * DM * FF; f8 = true; }
    const float* src = inp_ptr(F, inp) + soff;
    if (f8) conv_item8(src, ldw, K, WB8 + doff, mode, scr, it, N / 64, F.lane);
    else conv_item(src, ldw, K, (bf16*)(WB8 + doff), mode, scr, it, N / 64, F.lane);
}
__device__ __forceinline__ void cv_drain(Frame& F, int need) {
    if (need <= 0) return;
    volatile LAS int* cw = (volatile LAS int*)(F.lds + MISC_OFF) + 16;
    unsigned* nxt = (unsigned*)(F.ctl + CW_CVQ);
    asm volatile("s_waitcnt vmcnt(0)" ::: "memory");
    for (;;) {
        __syncthreads();
        if (F.tid == 0) { int b = -1; if ((int)xb_ld(nxt) < need) b = (int)xb_add(nxt, 8u); cw[0] = b; }
        __syncthreads();
        const int base = cw[0];
        if (base < 0) break;
        if (base + F.wave < CV_TOTAL) cv_run_item(F, base + F.wave);
    }
}
__device__ __forceinline__ void xcd_barrier_steal(const XcdBarrier& b, Frame& F) {
    asm volatile("s_waitcnt vmcnt(0)" ::: "memory");
    __syncthreads();
    volatile LAS int* cw = (volatile LAS int*)(F.lds + MISC_OFF) + 16;
    unsigned* bar = b.bar; unsigned* nxt = (unsigned*)(F.ctl + CW_CVQ);
    unsigned gen = 0u, tg = 0u; int role = 0;
    if (threadIdx.x == 0) {
        __builtin_amdgcn_s_waitcnt(0);
        unsigned nloc = b.st[0], nx = b.st[1];
        if (nloc == 0u) { xcd_barrier_complete(bar, b.x, nloc, nx); b.st[0] = nloc; b.st[1] = nx; }
        const unsigned old = xb_add(&bar[XB_XSUB(b.x)], 1u);
        gen = old / nloc;
        if (old + 1u == (gen + 1u) * nloc) {
            __builtin_amdgcn_fence(__ATOMIC_RELEASE, "agent");
            asm volatile("s_waitcnt vmcnt(0)" ::: "memory");
            const unsigned og = xb_add(&bar[XB_TOP], 1u);
            tg = og / nx;
            if (og + 1u == (tg + 1u) * nx) { xb_add(&bar[XB_TOPGEN], 1u); xb_add(&bar[XB_XGEN(b.x)], 1u); role = 0; }
            else role = 1;
        } else { role = 2;
            const unsigned rank = old - gen * nloc;
            if (rank * 2u >= nloc && (rank & 3u) == 0u) { __builtin_amdgcn_fence(__ATOMIC_RELEASE, "agent"); asm volatile("s_waitcnt vmcnt(0)" ::: "memory"); } }
    }
    for (;;) {
        if (threadIdx.x == 0) {
            int rel = 1, base = -1;
            if (role == 1) { XB_SPIN(xb_ld(&bar[XB_TOPGEN]) == tg, bar); xb_add(&bar[XB_XGEN(b.x)], 1u); role = 0; }
            else if (role == 2) { if (xb_ld(&bar[XB_XGEN(b.x)]) == gen) rel = 0; }
            if (!rel) {
                if ((int)xb_ld(nxt) < CV_TOTAL) base = (int)xb_add(nxt, 8u);
                else { XB_SPIN(xb_ld(&bar[XB_XGEN(b.x)]) == gen, bar); rel = 1; }
            }
            cw[0] = rel; cw[1] = base;
        }
        __syncthreads();
        const int rel = cw[0], base = cw[1];
        __syncthreads();
        if (rel) break;
        if (base >= 0 && base + F.wave < CV_TOTAL) cv_run_item(F, base + F.wave);
    }
    if (threadIdx.x == 0) { __builtin_amdgcn_fence(__ATOMIC_ACQUIRE, "agent"); asm volatile("s_waitcnt vmcnt(0)" ::: "memory"); }
    __syncthreads();
}

__device__ __forceinline__ int moe_cnt(Frame& F, int f, int e) {
    const unsigned long long w = __hip_atomic_load((GAS unsigned long long*)(F.ctl + CW_CNT + f * 64 + 16 * (e >> 2)), RLX_AGENT);
    return (int)((w >> (16 * (e & 3))) & 0xffffull);
}
__device__ __forceinline__ f32x4 moe_yrow(Frame& F, int r, int q4) {
    const bf16* Y = (const bf16*)(F.ws + WS_R2); const bf16* P = (const bf16*)(F.ws + WS_R2 + 72 * MiB);
    if (r < SPLIT_ROW0 || F.G != 256 || !MOE_SPLITK) {
        if (MOE_Y_FP8) { const int a = ((const GAS int*)((const unsigned char*)Y + (size_t)r * DM))[q4]; const f32x2 lo = __builtin_amdgcn_cvt_pk_f32_fp8(a, false), hi = __builtin_amdgcn_cvt_pk_f32_fp8(a, true);
            return (f32x4){lo.x, lo.y, hi.x, hi.y} * (1.0f / Y8S); }
        const v2u a = ((const GAS v2u*)(Y + (size_t)r * DM))[q4]; return (f32x4){bflo(a.x), bfhi(a.x), bflo(a.y), bfhi(a.y)}; }
    f32x4 s = (f32x4){0.f, 0.f, 0.f, 0.f};
#pragma unroll
    for (int k = 0; k < MOE_NSPLIT; ++k) { const v2u a = ((const GAS v2u*)(P + ((size_t)k * SPLIT_ROWS + (size_t)(r - SPLIT_ROW0)) * DM))[q4]; s = s + (f32x4){bflo(a.x), bfhi(a.x), bflo(a.y), bfhi(a.y)}; }
    return s;
}
__device__ __forceinline__ void moe_bases(Frame& F, int f, int (&tb)[NE + 1]) {
    int acc = 0;
#pragma unroll
    for (int e = 0; e < NE; ++e) { tb[e] = acc; const int c = moe_cnt(F, f, e); acc += (c + 255) >> 8; }
    tb[NE] = acc;
}

template <int NC>
__device__ __forceinline__ float wave_reduce_cols(float (&part)[NC], int lane) {
#pragma unroll
    for (int st = 0, n = NC / 2; n >= 1; ++st, n >>= 1) {
        const bool up = (lane >> st) & 1;
#pragma unroll
        for (int i = 0; i < n; ++i) { const float keep = up ? part[i + n] : part[i], send = up ? part[i] : part[i + n]; part[i] = keep + __shfl_xor(send, 1 << st); }
    }
    float v = part[0];
#pragma unroll
    for (int o = NC; o < 64; o <<= 1) v += __shfl_xor(v, o);
    return v;
}
template <int NC> __device__ __forceinline__ int lane_of_col(int c) {
    int l = 0;
#pragma unroll
    for (int st = 0, n = NC / 2; n >= 1; ++st, n >>= 1) { if (c & n) l |= 1 << st; }
    return l;
}
__device__ __forceinline__ void panel_sync(Frame& F, const pg8::DenseOrder& S, unsigned* cnt) {
    if (F.tid == 0) {
        unsigned* bar = (unsigned*)(F.ctl + CW_BAR);
        const unsigned x = xb_xcc_id();
        bool mixed = false; pg8::Unit u;
        for (int i = 0; S.next(i, u); ++i) { unsigned w = 0u; XB_SPIN(((w = xb_ld(&cnt[u.pm])) & 15u) < 4u, bar); if (x >= 8u || ((w >> (4 + 3 * x)) & 7u) != 4u) mixed = true; }
        if (mixed) {
            __builtin_amdgcn_fence(__ATOMIC_RELEASE, "agent");
            asm volatile("s_waitcnt vmcnt(0)" ::: "memory");
            for (int i = 0; S.next(i, u); ++i) { const unsigned w = xb_ld(&cnt[u.pm]); if (x >= 8u || ((w >> (4 + 3 * x)) & 7u) != 4u) xb_add(&cnt[6 * 64 + u.pm], 1u); }
            for (int i = 0; S.next(i, u); ++i) { const unsigned w = xb_ld(&cnt[u.pm]); if (x >= 8u || ((w >> (4 + 3 * x)) & 7u) != 4u) XB_SPIN(xb_ld(&cnt[6 * 64 + u.pm]) < 4u, bar); }
        }
        __builtin_amdgcn_fence(__ATOMIC_ACQUIRE, "agent");
        asm volatile("s_waitcnt vmcnt(0)" ::: "memory");
    }
    __syncthreads();
}
template <int FLAGS>
__device__ __forceinline__ void norm_phase(Frame& F, const void* xin, void* xout, const float* gain, bf16* H, int fprev, int f,
                                           const float* Wf  , const float* bf  , const float* Wr  ,
                                           const pg8::DenseOrder* PS = nullptr, unsigned* pcnt = nullptr) {
    constexpr int NC = (FLAGS & 2) ? 16 : (FLAGS & 4) ? 8 : 0;
    const bf16* Y = (const bf16*)(F.ws + WS_R2);
    const int* tok_prev = (const int*)(F.ws + WS_MISC + MS_TOK) + (size_t)fprev * M * 2;
    float* lgf = (float*)(F.ws + WS_MISC + MS_LOGF);
    LAS int* sel = (LAS int*)F.lds;
    LAS float* sg = (LAS float*)(F.lds + 512);
    LAS int* gb = (LAS int*)(F.lds + 1536);
    LAS f32x4* WL = (LAS f32x4*)(F.lds + 4096);
    int tb[NE + 1];
    if (FLAGS & 1) moe_bases(F, fprev, tb);
    if (NC) {
        const float* Wsrc = (FLAGS & 2) ? Wf + 3072 : Wr; const int ldw = (FLAGS & 2) ? 3088 : 8;
        for (int idx = F.tid; idx < 16 * (NC / 4) * 64; idx += NTHR) {
            const int ln = idx & 63, cq = (idx >> 6) % (NC / 4), jq = idx / (64 * (NC / 4)), k = 4 * (ln + 64 * (jq >> 2)) + (jq & 3);
            WL[idx] = *(const GAS f32x4*)(Wsrc + (size_t)k * ldw + 4 * cq) * gain[k];
        }
        __syncthreads();
    }
    if (NC == 0 && !(FLAGS & 1)) {
        if (FLAGS & 64) panel_sync(F, *PS, pcnt);
        for (int it = 0;; ++it) {
            int chunk;
            if (FLAGS & 64) { pg8::Unit pu; if (!PS->next(it, pu)) break; chunk = pu.pm * 4 + pu.pn; }
            else { chunk = blockIdx.x + it * F.G; if (chunk >= M / 64) break; }
#pragma unroll 1
            for (int i = 0; i < 8; i += 4) {
                const int m0 = chunk * 64 + F.wave * 8 + i;
                int ln = F.lane; asm volatile("" : "+v"(ln));
                f32x4 v[4][4];
#pragma unroll
                for (int r = 0; r < 4; ++r) {
                    if (FLAGS & 16) { const GAS v2u* xr = (const GAS v2u*)((const bf16*)xin + (size_t)(m0 + r) * DM) + ln;
#pragma unroll
                        for (int j = 0; j < 4; ++j) { const v2u a = xr[64 * j]; v[r][j] = (f32x4){bflo(a.x), bfhi(a.x), bflo(a.y), bfhi(a.y)}; } }
                    else { const GAS f32x4* xr = (const GAS f32x4*)((const float*)xin + (size_t)(m0 + r) * DM) + ln;
#pragma unroll
                        for (int j = 0; j < 4; ++j) v[r][j] = xr[64 * j]; }
                }
                f32x4 g[4];
#pragma unroll
                for (int j = 0; j < 4; ++j) g[j] = ((const GAS f32x4*)gain + ln)[64 * j];
#pragma unroll
                for (int r = 0; r < 4; ++r) {
                    const int m = m0 + r;
                    if (FLAGS & 32) {
#pragma unroll
                        for (int j = 0; j < 4; ++j) ((GAS v2u*)((bf16*)xout + (size_t)m * DM) + ln)[64 * j] = (v2u){pk2(v[r][j].x, v[r][j].y), pk2(v[r][j].z, v[r][j].w)}; }
                    float s = 0.f;
#pragma unroll
                    for (int j = 0; j < 4; ++j) s += (v[r][j].x * v[r][j].x + v[r][j].y * v[r][j].y) + (v[r][j].z * v[r][j].z + v[r][j].w * v[r][j].w);
                    const float inv = 1.0f / sqrtf(wave_sum(s) * (1.f / DM) + RMS_EPS);
                    GAS unsigned long long* o8 = (GAS unsigned long long*)(H + (size_t)m * DM) + ln;
                    GAS unsigned* h8 = (GAS unsigned*)(F.ws + WS_R2 + 104 * MiB + (size_t)m * DM) + ln;
#pragma unroll
                    for (int j = 0; j < 4; ++j) { const f32x4 hv = v[r][j] * inv * g[j];
                        if (FLAGS & 8) h8[64 * j] = pg8::cvt4_fp8(hv.x, hv.y, hv.z, hv.w);
                        else o8[64 * j] = (unsigned long long)pk2(hv.x, hv.y) | ((unsigned long long)pk2(hv.z, hv.w) << 32); }
                }
            }
        }
        return;
    }
    if (FLAGS & 64) panel_sync(F, *PS, pcnt);
    for (int it = 0;; ++it) {
        int chunk;
        if (FLAGS & 64) { pg8::Unit pu; if (!PS->next(it, pu)) break; chunk = pu.pm * 4 + pu.pn; }
        else { chunk = blockIdx.x + it * F.G; if (chunk >= M / 64) break; }
        for (int i = 0; i < 8; ++i) {
            const int m = chunk * 64 + F.wave * 8 + i;
            int ln = F.lane; asm volatile("" : "+v"(ln));
            f32x4 v[4];
            if (FLAGS & 16) { const GAS v2u* xr = (const GAS v2u*)((const bf16*)xin + (size_t)m * DM) + ln;
#pragma unroll
                for (int j = 0; j < 4; ++j) { const v2u a = xr[64 * j]; v[j] = (f32x4){bflo(a.x), bfhi(a.x), bflo(a.y), bfhi(a.y)}; } }
            else { const GAS f32x4* xr = (const GAS f32x4*)((const float*)xin + (size_t)m * DM) + ln;
#pragma unroll
                for (int j = 0; j < 4; ++j) v[j] = xr[64 * j]; }
            if (FLAGS & 1) {
                const int s0 = tok_prev[m * 2], s1 = tok_prev[m * 2 + 1];
                int r0 = 0, r1 = 0;
#pragma unroll
                for (int e = 0; e < NE; ++e) { if ((s0 >> 14) == e) r0 = tb[e] * 256 + (s0 & 16383); if ((s1 >> 14) == e) r1 = tb[e] * 256 + (s1 & 16383); }
#pragma unroll
                for (int j = 0; j < 4; ++j) { v[j] = v[j] + moe_yrow(F, r0, ln + 64 * j) + moe_yrow(F, r1, ln + 64 * j);
                    ((GAS v2u*)((bf16*)xout + (size_t)m * DM) + ln)[64 * j] = (v2u){pk2(v[j].x, v[j].y), pk2(v[j].z, v[j].w)}; }
            }
            if (FLAGS & 32) {
#pragma unroll
                for (int j = 0; j < 4; ++j) ((GAS v2u*)((bf16*)xout + (size_t)m * DM) + ln)[64 * j] = (v2u){pk2(v[j].x, v[j].y), pk2(v[j].z, v[j].w)}; }
            float s = 0.f;
#pragma unroll
            for (int j = 0; j < 4; ++j) s += (v[j].x * v[j].x + v[j].y * v[j].y) + (v[j].z * v[j].z + v[j].w * v[j].w);
            const float inv = 1.0f / sqrtf(wave_sum(s) * (1.f / DM) + RMS_EPS);
            float colv = 0.f;
            if (NC) {
                float part[NC ? NC : 1];
#pragma unroll
                for (int c = 0; c < NC; ++c) part[c] = 0.f;
                const int woff = ln;
#pragma unroll
                for (int j = 0; j < 4; ++j) {
#pragma unroll
                    for (int q = 0; q < 4; ++q) { const float xv = v[j][q];
#pragma unroll
                        for (int cq = 0; cq < NC / 4; ++cq) { const f32x4 w = WL[((j * 4 + q) * (NC / 4) + cq) * 64 + woff];
                            part[cq * 4 + 0] += xv * w.x; part[cq * 4 + 1] += xv * w.y; part[cq * 4 + 2] += xv * w.z; part[cq * 4 + 3] += xv * w.w; }
                        if ((q & 1) == 1) asm volatile("" ::: "memory"); } }
                colv = wave_reduce_cols<NC ? NC : 2>(reinterpret_cast<float (&)[NC ? NC : 2]>(part), ln) * inv;
            }
            if (H) {
                GAS unsigned long long* o8 = (GAS unsigned long long*)(H + (size_t)m * DM) + ln;
                GAS unsigned* h8 = (GAS unsigned*)(F.ws + WS_R2 + 104 * MiB + (size_t)m * DM) + ln;
#pragma unroll
                for (int j = 0; j < 4; ++j) { const f32x4 g = ((const GAS f32x4*)gain + ln)[64 * j]; const f32x4 hv = v[j] * inv * g;
                    if (((FLAGS & 4) && MOE_FP8) || (FLAGS & 8)) h8[64 * j] = pg8::cvt4_fp8(hv.x, hv.y, hv.z, hv.w);
                    else o8[64 * j] = (unsigned long long)pk2(hv.x, hv.y) | ((unsigned long long)pk2(hv.z, hv.w) << 32); }
            }
            if (FLAGS & 2) {
                if (ln < 16) { const int l = ln; const int c = ((l & 1) << 3) | ((l & 2) << 1) | ((l & 4) >> 1) | ((l & 8) >> 3);
                    const float z = colv + bf[c]; const float ls = fminf(z, 0.f) - log1pf(expf(-fabsf(z))); lgf[(size_t)m * 16 + c] = ls * LOG2E; }
            }
            if (FLAGS & 4) {
                float lg[8];
#pragma unroll
                for (int c = 0; c < 8; ++c) lg[c] = __builtin_bit_cast(float, __builtin_amdgcn_readlane(__builtin_bit_cast(int, colv), lane_of_col<8>(c)));
                int e0 = 0; float l0 = lg[0];
#pragma unroll
                for (int c = 1; c < 8; ++c) if (lg[c] > l0) { l0 = lg[c]; e0 = c; }
                int e1 = -1; float l1 = -INFINITY;
#pragma unroll
                for (int c = 0; c < 8; ++c) if (c != e0 && lg[c] > l1) { l1 = lg[c]; e1 = c; }
                const float g0 = 1.0f / (1.0f + expf(l1 - l0)), g1 = 1.0f - g0;
                if (ln == 0) { const int r = F.wave * 8 + i; sel[r * 2] = e0; sel[r * 2 + 1] = e1; sg[r * 2] = g0; sg[r * 2 + 1] = g1; }
            }
        }
        if (FLAGS & 4) {
            int* selg = (int*)(F.ws + WS_MISC + MS_SEL) + (size_t)f * M * 2;
            float* sgg = (float*)(F.ws + WS_MISC + MS_SG) + (size_t)f * M * 2;
            int* lcn = (int*)(F.ws + WS_MISC + MS_LC) + (size_t)f * 256 * 8;
            __syncthreads();
            if (F.tid < 128) { selg[chunk * 128 + F.tid] = sel[F.tid]; sgg[chunk * 128 + F.tid] = sg[F.tid]; }
            if (F.tid >= 128 && F.tid < 136) { const int e = F.tid - 128; int c = 0;
                for (int q = 0; q < 128; ++q) c += (sel[q] == e) ? 1 : 0;
                lcn[chunk * 8 + e] = c; }
            __syncthreads();
        }
    }
}

__device__ __forceinline__ void moe_finalize(Frame& F, int f) {
    const int* selg = (const int*)(F.ws + WS_MISC + MS_SEL) + (size_t)f * M * 2;
    const float* sgg = (const float*)(F.ws + WS_MISC + MS_SG) + (size_t)f * M * 2;
    const int* lcn = (const int*)(F.ws + WS_MISC + MS_LC) + (size_t)f * 256 * 8;
    int* list = (int*)(F.ws + WS_MISC + MS_LIST) + (size_t)f * NE * LCAP;
    float* gw = (float*)(F.ws + WS_MISC + MS_GW) + (size_t)f * NE * LCAP;
    int* tok = (int*)(F.ws + WS_MISC + MS_TOK) + (size_t)f * M * 2;
    LAS int* arr = (LAS int*)F.lds;
    LAS int* sel = (LAS int*)(F.lds + 8192);
    LAS int* pb = (LAS int*)(F.lds + 8192 + 512);
    LAS int* pt = (LAS int*)(F.lds + 8192 + 1536);
    LAS int* base = (LAS int*)(F.lds + 8192 + 2560);
    LAS int* tot = (LAS int*)(F.lds + 8192 + 2592);
    for (int chunk = blockIdx.x; chunk < M / 64; chunk += F.G) {
        if (F.tid < 256) { const v4u a = *(const GAS v4u*)(lcn + F.tid * 8), b = *(const GAS v4u*)(lcn + F.tid * 8 + 4);
            *(LAS v4u*)(arr + F.tid * 8) = a; *(LAS v4u*)(arr + F.tid * 8 + 4) = b; }
        if (F.tid < 128) sel[F.tid] = selg[chunk * 128 + F.tid];
        __syncthreads();
        if (F.tid < 256) { const int e = F.tid & 7, seg = F.tid >> 3; int b = 0, t = 0;
#pragma unroll
            for (int i = 0; i < 8; ++i) { const int c = seg * 8 + i; const int v = arr[c * 8 + e]; t += v; b += (c < chunk) ? v : 0; }
            pb[seg * 8 + e] = b; pt[seg * 8 + e] = t; }
        __syncthreads();
        if (F.tid < 8) { int b = 0, t = 0;
            for (int sgm = 0; sgm < 32; ++sgm) { b += pb[sgm * 8 + F.tid]; t += pt[sgm * 8 + F.tid]; }
            base[F.tid] = b; tot[F.tid] = t; }
        __syncthreads();
        if (F.tid < 128) { const int mye = sel[F.tid]; int lp = 0;
            for (int q = 0; q < 128; ++q) lp += (q < F.tid && sel[q] == mye) ? 1 : 0;
            const int q = F.tid, row = chunk * 64 + (q >> 1), pos = base[mye] + lp;
            list[mye * LCAP + pos] = row; gw[mye * LCAP + pos] = sgg[chunk * 128 + q]; tok[row * 2 + (q & 1)] = mye * LCAP + pos; }
        if (chunk == 0 && F.tid < 2) { unsigned long long w = 0ull;
#pragma unroll
            for (int i = 0; i < 4; ++i) w |= (unsigned long long)(unsigned)tot[4 * F.tid + i] << (16 * i);
            __hip_atomic_store((GAS unsigned long long*)(F.ctl + CW_CNT + f * 64 + 16 * F.tid), w, RLX_AGENT); }
        __syncthreads();
    }
}

__device__ __forceinline__ void final_combine(Frame& F, int f) {
    const bf16* Y = (const bf16*)(F.ws + WS_R2);
    const int* tok = (const int*)(F.ws + WS_MISC + MS_TOK) + (size_t)f * M * 2;
    int tb[NE + 1]; moe_bases(F, f, tb);
    for (int m = blockIdx.x * NWAVES + F.wave; m < M; m += F.G * NWAVES) {
        const int s0 = tok[m * 2], s1 = tok[m * 2 + 1]; int r0 = 0, r1 = 0;
#pragma unroll
        for (int e = 0; e < NE; ++e) { if ((s0 >> 14) == e) r0 = tb[e] * 256 + (s0 & 16383); if ((s1 >> 14) == e) r1 = tb[e] * 256 + (s1 & 16383); }
        GAS f32x4* xo = (GAS f32x4*)(F.out + (size_t)m * DM) + F.lane;
        const GAS v2u* xr = (const GAS v2u*)((const bf16*)(F.ws + WS_XB) + (size_t)m * DM) + F.lane;
#pragma unroll
        for (int j = 0; j < 4; ++j) { const v2u a = xr[64 * j]; xo[64 * j] = (f32x4){bflo(a.x), bfhi(a.x), bflo(a.y), bfhi(a.y)} + moe_yrow(F, r0, F.lane + 64 * j) + moe_yrow(F, r1, F.lane + 64 * j); }
    }
}

template <int NB> __device__ __forceinline__ void stagger_convert(Frame& F) {
    if ((((int)blockIdx.x >> 3) & 1) == 0) return;
    volatile LAS int* cw = (volatile LAS int*)(F.lds + MISC_OFF) + 16;
    unsigned* nxt = (unsigned*)(F.ctl + CW_CVQ);
    for (int r = 0; r < NB; ++r) {
        __syncthreads();
        if (F.tid == 0) { int b = -1; if ((int)xb_ld(nxt) < CV_TOTAL) b = (int)xb_add(nxt, 8u); cw[0] = b; }
        __syncthreads();
        const int base = cw[0];
        if (base < 0) break;
        if (base + F.wave < CV_TOTAL) cv_run_item(F, base + F.wave);
    }
    __syncthreads();
}
template <class Epi, bool FP8 = false>
__device__ __forceinline__ void dense_gemm(Frame& F, const bf16* A, const bf16* Bt, int N, int K, const Epi& E) {
    pg8::DenseOrder S; S.init(A, Bt, M, N, K, F.G, (int)blockIdx.x);
    pg8::gemm_phase<Epi, pg8::DenseOrder, false, FP8>(F.lds, K, S, E);
}
template <int NFLAGS, class Epi, bool FP8 = false>
__device__ __forceinline__ void resid_gemm_norm(Frame& F, int site, const bf16* A, const bf16* Bt, int K, const Epi& E, const void* X, const float* gain, bf16* H, int f, const float* Wr) {
    pg8::DenseOrder S; S.init(A, Bt, M, DM, K, F.G, (int)blockIdx.x);
    pg8::gemm_phase<Epi, pg8::DenseOrder, false, FP8>(F.lds, K, S, E);
    unsigned* cnt = (unsigned*)(F.ctl + CW_PANEL + site * 64);
    asm volatile("s_waitcnt vmcnt(0)" ::: "memory");
    __syncthreads();
    if (F.tid == 0) {
        const unsigned x = xb_xcc_id(); pg8::Unit u;
        for (int i = 0; S.next(i, u); ++i) xb_add(&cnt[u.pm], 1u + (x < 8u ? (1u << (4 + 3 * x)) : 0u));
    }
    norm_phase<NFLAGS | 16 | 64>(F, X, nullptr, gain, H, 0, f, nullptr, nullptr, Wr, &S, cnt);
}
__device__ __forceinline__ void moe_order_init(Frame& F, int f, pg8::MoeOrder& S) {
    int acc = 0, t[NE];
#pragma unroll
    for (int e = 0; e < NE; ++e) { const int c = moe_cnt(F, f, e); acc += (c + 255) >> 8; t[e] = acc; }
    S.t1 = t[0]; S.t2 = t[1]; S.t3 = t[2]; S.t4 = t[3]; S.t5 = t[4]; S.t6 = t[5]; S.t7 = t[6]; S.t8 = t[7];
    S.G = F.G; S.c = (int)blockIdx.x;
}
__device__ __forceinline__ void moe_gu_fast(Frame& F, int f, const bf16* H, bf16* ACT) {
    pg8::MoeOrder S; moe_order_init(F, f, S);
    S.list = (const int*)(F.ws + WS_MISC + MS_LIST) + (size_t)f * NE * LCAP; S.gather = true; S.splitk = 0; S.xcdperm = false; S.nN = 2 * FF / 256;
    if (MOE_FP8) {
        S.K = DM / 2; S.A = (const char*)(F.ws + WS_R2 + 104 * MiB); S.Bt = (const char*)((const bf16*)(F.ws + WS_W) + WE_MGU) + (size_t)f * NE * 2 * FF * DM;
        S.tstepA = (size_t)256 * DM; S.tstepB = (size_t)256 * DM; S.estepB = (size_t)2 * FF * DM;
        pg8::EpiSwigluF8 E{(unsigned char*)ACT};
        pg8::gemm_phase<pg8::EpiSwigluF8, pg8::MoeOrder, true, true>(F.lds, DM / 2, S, E);
    } else {
        S.K = DM; S.A = (const char*)H; S.Bt = (const char*)((const bf16*)(F.ws + WS_W) + WE_MGU + (size_t)f * NE * 2 * FF * DM);
        S.tstepA = (size_t)256 * DM * 2; S.tstepB = (size_t)256 * DM * 2; S.estepB = (size_t)2 * FF * DM * 2;
        pg8::EpiSwiglu E{ACT};
        pg8::gemm_phase<pg8::EpiSwiglu, pg8::MoeOrder, true>(F.lds, DM, S, E);
    }
}
__device__ __forceinline__ void moe_down_fast(Frame& F, int f, const bf16* ACT, bf16* Y) {
    pg8::MoeOrder S; moe_order_init(F, f, S);
    S.nN = DM / 256; S.list = nullptr; S.gather = false; S.xcdperm = (F.G == 256); S.splitk = (MOE_SPLITK && F.G == 256) ? MOE_NSPLIT : 0;
    const float* gwp = (const float*)(F.ws + WS_MISC + MS_GW) + (size_t)f * NE * LCAP; bf16* P = (bf16*)(F.ws + WS_R2 + 72 * MiB);
    if (MOE_FP8) {
        S.K = FF / 2; S.A = (const char*)ACT; S.Bt = (const char*)((const bf16*)(F.ws + WS_W) + WE_MD) + (size_t)f * NE * DM * FF;
        S.tstepA = (size_t)256 * FF; S.tstepB = (size_t)256 * FF; S.estepB = (size_t)DM * FF;
        pg8::EpiMoeDown E{Y, gwp, P, 1.0f / (W8S * A8S)};
        pg8::gemm_phase<pg8::EpiMoeDown, pg8::MoeOrder, false, true>(F.lds, FF / 2, S, E);
    } else {
        S.K = FF; S.A = (const char*)ACT; S.Bt = (const char*)((const bf16*)(F.ws + WS_W) + WE_MD + (size_t)f * NE * DM * FF);
        S.tstepA = (size_t)256 * FF * 2; S.tstepB = (size_t)256 * FF * 2; S.estepB = (size_t)DM * FF * 2;
        pg8::EpiMoeDown E{Y, gwp, P, 1.0f};
        pg8::gemm_phase<pg8::EpiMoeDown, pg8::MoeOrder, false>(F.lds, FF, S, E);
    }
}

struct Args { const float* in[22]; float* out; unsigned char* ws; int ph_lo, ph_hi; };
constexpr int N_PHASES = 26;

__global__ void __launch_bounds__(NTHR, 2) trunk_fwd(Args args) {
    extern __shared__ __attribute__((aligned(16))) unsigned char lds[];
    Frame F;
    F.lds = (LAS unsigned char*)lds;
    F.tid = threadIdx.x; F.lane = F.tid & 63; F.wave = __builtin_amdgcn_readfirstlane(F.tid >> 6); F.G = gridDim.x;
    F.ws = args.ws; F.ctl = (gu32*)(args.ws + WS_CTL); F.out = args.out;
    if (F.tid == 0) {
#pragma unroll
        for (int i = 0; i < 22; ++i) ((LAS unsigned long long*)(F.lds + PTR_OFF))[i] = (unsigned long long)args.in[i];
    }
    volatile LAS unsigned* MISC = (volatile LAS unsigned*)(F.lds + MISC_OFF);
    if (F.tid < 32) MISC[F.tid] = 0u;
    __syncthreads();
    XcdBarrier bar; bar.bar = (unsigned*)(F.ctl + CW_BAR); bar.x = 0; bar.st = nullptr;
    const int lo = args.ph_lo, hi = args.ph_hi;
    if (hi - lo > 1) bar = xcd_barrier_post((unsigned*)(F.ctl + CW_BAR), MISC + 8);
#ifndef PHSEL
#define PHSEL 0xFFFFFFFFFFFFFFFFull
#endif
#define IN(k) (lo <= (k) && (k) < hi && ((PHSEL >> (k)) & 1ull) && relaunder(F))
#define SEAM(k) do { if (IN((k) + 1) && IN(k)) xcd_barrier_steal(bar, F); } while (0)
#ifndef DUPMASK
#define DUPMASK 0ull
#endif
#define DUP(k) (((DUPMASK >> (k)) & 1ull) != 0ull)

    bf16* H = (bf16*)(F.ws + WS_H);
    bf16* PROJ = (bf16*)(F.ws + WS_R1);
    bf16* ACT = (bf16*)(F.ws + WS_R1);
    bf16* O = (bf16*)(F.ws + WS_R2);
    bf16* Y = (bf16*)(F.ws + WS_R2);
    bf16* OG = (bf16*)(F.ws + WS_R2 + 32 * MiB);
    float* ST = (float*)(F.ws + WS_R2 + 128 * MiB);
    bf16* X = (bf16*)(F.ws + WS_XB);
    const bf16* H8 = (const bf16*)(F.ws + WS_R2 + 104 * MiB);
    float* DUMMY = (float*)(F.ws + WS_R2 + 32 * MiB);
    const float* cum = (const float*)(F.ws + WS_MISC + MS_LOGF);

    const bf16* WB = (const bf16*)(F.ws + WS_W);
    enum { PH_BASE = __COUNTER__ + 1 };
#define PHASE(...) { constexpr int k_ = __COUNTER__ - PH_BASE; if (IN(k_)) { __VA_ARGS__; cv_drain(F, cv_need(k_ + 1)); SEAM(k_); } }
    PHASE({ unsigned* z = (unsigned*)(F.ws + WS_MISC + MS_LIST);
            for (int i = blockIdx.x * NTHR + F.tid; i < (int)(2 * MiB / 4); i += F.G * NTHR) z[i] = 0u;
            norm_phase<32>(F, INP(0), X, INP(13) + 0 * DM, H, 0, 0, nullptr, nullptr, nullptr); })
    PHASE({ stagger_convert<1>(F); pg8::EpiPlanes E{PROJ, C2, 1.0f}; dense_gemm(F, H, WB + WE_QKV, 3 * DM, DM, E); })
    PHASE(att::causal_phase<0>((att::lptr)F.lds, F.G, PROJ, PROJ + PLANE, PROJ + 2 * PLANE, O, nullptr, false))
    PHASE({ pg8::EpiResid<false> E{X, X, 1.0f}; resid_gemm_norm<(DENSE_FP8_L0 ? 8 : 0)>(F, 0, O, WB + WE_WO_SB, DM, E, X, INP(14) + 0 * DM, H, 0, nullptr); })
    PHASE({ stagger_convert<1>(F);
            if (DENSE_FP8_L0) { pg8::EpiSwigluF8 E{(unsigned char*)ACT}; dense_gemm<pg8::EpiSwigluF8, true>(F, H8, (const bf16*)((const unsigned char*)(WB + WE_GU)), 2 * FF, DM / 2, E); }
            else { pg8::EpiSwiglu E{ACT}; dense_gemm(F, H, WB + WE_GU, 2 * FF, DM, E); } })
    PHASE({ if (DENSE_FP8_L0) { pg8::EpiResid<false> E{X, X, 1.0f / (W8S * A8S)}; resid_gemm_norm<(DILIN_FP8 ? 8 : 0), pg8::EpiResid<false>, true>(F, 1, ACT, (const bf16*)((const unsigned char*)(WB + WE_D)), FF / 2, E, X, INP(13) + 1 * DM, H, 0, nullptr); }
            else { pg8::EpiResid<false> E{X, X, 1.0f}; resid_gemm_norm<(DILIN_FP8 ? 8 : 0)>(F, 1, ACT, WB + WE_D, FF, E, X, INP(13) + 1 * DM, H, 0, nullptr); } })
    PHASE({ stagger_convert<1>(F);
            if (DILIN_FP8) { pg8::EpiQKNorm E{PROJ, INP(4), INP(5), 6, 1.0f / W8S}; dense_gemm<pg8::EpiQKNorm, true>(F, H8, WB + WE_IN_DIL, 7 * DM, DM / 2, E); }
            else { pg8::EpiQKNorm E{PROJ, INP(4), INP(5), 6, 1.0f}; dense_gemm(F, H, WB + WE_IN_DIL, 7 * DM, DM, E); } })
    PHASE(att::dil_phase((att::lptr)F.lds, F.G, PROJ, OG, ST, INP(12), 0, O))
    PHASE(att::dil_phase((att::lptr)F.lds, F.G, PROJ, OG, ST, INP(12), 1, O))
    PHASE({ if (WO_FP8) { pg8::EpiResid<false> E{X, X, 1.0f / (W8S * A8S)}; resid_gemm_norm<4, pg8::EpiResid<false>, true>(F, 2, O, WB + WE_WO_DIL, DM / 2, E, X, INP(14) + 1 * DM, H, 0, INP(18) + 0 * DM * NE); }
            else { pg8::EpiResid<false> E{X, X, 1.0f}; resid_gemm_norm<4>(F, 2, O, WB + WE_WO_DIL, DM, E, X, INP(14) + 1 * DM, H, 0, INP(18) + 0 * DM * NE); } })
    PHASE(moe_finalize(F, 0))
    PHASE({ stagger_convert<1>(F); moe_gu_fast(F, 0, H, ACT); })
    PHASE(moe_down_fast(F, 0, ACT, Y))
    PHASE(norm_phase<(1 | 2 | (FOXIN_FP8 ? 8 : 0)) | 16>(F, X, X, INP(13) + 2 * DM, H, 0, 0, INP(7), INP(8), nullptr))
    PHASE({ stagger_convert<1>(F);
            if (FOXIN_FP8) { pg8::EpiQKNorm E{PROJ, INP(9), INP(10), 2, 1.0f / W8S}; dense_gemm<pg8::EpiQKNorm, true>(F, H8, WB + WE_IN_FOX, 3 * DM, DM / 2, E); }
            else { pg8::EpiQKNorm E{PROJ, INP(9), INP(10), 2, 1.0f}; dense_gemm(F, H, WB + WE_IN_FOX, 3 * DM, DM, E); } })
    PHASE(att::causal_phase<2>((att::lptr)F.lds, F.G, PROJ, PROJ + PLANE, PROJ + 2 * PLANE, O, cum, WO_FP8))
    PHASE({ if (WO_FP8) { pg8::EpiResid<false> E{X, X, 1.0f / (W8S * A8S)}; resid_gemm_norm<(DENSE_FP8_L2 ? 8 : 0), pg8::EpiResid<false>, true>(F, 3, O, WB + WE_WO_FOX, DM / 2, E, X, INP(14) + 2 * DM, H, 0, nullptr); }
            else { pg8::EpiResid<false> E{X, X, 1.0f}; resid_gemm_norm<(DENSE_FP8_L2 ? 8 : 0)>(F, 3, O, WB + WE_WO_FOX, DM, E, X, INP(14) + 2 * DM, H, 0, nullptr); } })
    PHASE({ stagger_convert<1>(F);
            if (DENSE_FP8_L2) { pg8::EpiSwigluF8 E{(unsigned char*)ACT}; dense_gemm<pg8::EpiSwigluF8, true>(F, H8, WB + WE_GU + (size_t)2 * FF * DM, 2 * FF, DM / 2, E); }
            else { pg8::EpiSwiglu E{ACT}; dense_gemm(F, H, WB + WE_GU + (size_t)2 * FF * DM, 2 * FF, DM, E); } })
    PHASE({ if (DENSE_FP8_L2) { pg8::EpiResid<false> E{X, X, 1.0f / (W8S * A8S)}; resid_gemm_norm<(QKV3_FP8 ? 8 : 0), pg8::EpiResid<false>, true>(F, 4, ACT, WB + WE_D + (size_t)DM * FF, FF / 2, E, X, INP(13) + 3 * DM, H, 0, nullptr); }
            else { pg8::EpiResid<false> E{X, X, 1.0f}; resid_gemm_norm<(QKV3_FP8 ? 8 : 0)>(F, 4, ACT, WB + WE_D + (size_t)DM * FF, FF, E, X, INP(13) + 3 * DM, H, 0, nullptr); } })
    PHASE({ stagger_convert<1>(F);
            if (QKV3_FP8) { pg8::EpiPlanes E{PROJ, C2, 1.0f / W8S}; dense_gemm<pg8::EpiPlanes, true>(F, H8, WB + WE_QKV + (size_t)3 * DM * DM, 3 * DM, DM / 2, E); }
            else { pg8::EpiPlanes E{PROJ, C2, 1.0f}; dense_gemm(F, H, WB + WE_QKV + (size_t)3 * DM * DM, 3 * DM, DM, E); } })
    PHASE(att::causal_phase<0>((att::lptr)F.lds, F.G, PROJ, PROJ + PLANE, PROJ + 2 * PLANE, O, nullptr, WO_FP8))
    PHASE({ if (WO_FP8) { pg8::EpiResid<false> E{X, X, 1.0f / (W8S * A8S)}; resid_gemm_norm<4, pg8::EpiResid<false>, true>(F, 5, O, WB + WE_WO_SB + (size_t)DM * DM, DM / 2, E, X, INP(14) + 3 * DM, H, 1, INP(18) + 1 * DM * NE); }
            else { pg8::EpiResid<false> E{X, X, 1.0f}; resid_gemm_norm<4>(F, 5, O, WB + WE_WO_SB + (size_t)DM * DM, DM, E, X, INP(14) + 3 * DM, H, 1, INP(18) + 1 * DM * NE); } })
    PHASE(moe_finalize(F, 1))
    PHASE({ stagger_convert<1>(F); moe_gu_fast(F, 1, H, ACT); })
    PHASE(moe_down_fast(F, 1, ACT, Y))
    PHASE(final_combine(F, 1))
    static_assert(__COUNTER__ - PH_BASE == N_PHASES, "N_PHASES must equal the number of PHASE() sites");
#undef PHASE
#undef IN
#undef SEAM
}

extern "C" void kernel_launch(void* const* d_in, const int* in_sizes, int n_in, void* d_out, int out_size, void* d_ws, size_t ws_size, hipStream_t stream) {
    static int grid = 0;
    if (grid == 0) {
        if (n_in != 22 || out_size != M * DM || ws_size < WS_END) { fprintf(stderr, "kernel_launch: unexpected shapes (n_in %d out %d ws %zu)\n", n_in, out_size, ws_size); grid = -1; return; }
        int dev = 0, cus = 0, per_cu = 0;
        if (hipGetDevice(&dev) != hipSuccess || hipDeviceGetAttribute(&cus, hipDeviceAttributeMultiprocessorCount, dev) != hipSuccess) { grid = -1; return; }
        if (hipFuncSetAttribute((const void*)trunk_fwd, hipFuncAttributeMaxDynamicSharedMemorySize, LDS_BYTES) != hipSuccess) { fprintf(stderr, "kernel_launch: hipFuncSetAttribute failed\n"); grid = -1; return; }
        if (hipOccupancyMaxActiveBlocksPerMultiprocessor(&per_cu, (const void*)trunk_fwd, NTHR, LDS_BYTES) != hipSuccess || per_cu < 1) fprintf(stderr, "kernel_launch: occupancy query says %d\n", per_cu);
        (void)hipGetLastError();
        grid = cus;
    }
    if (grid < 0) return;
    (void)hipMemsetAsync((char*)d_ws + WS_CTL, 0, CTL_ZERO_BYTES, stream);
    Args a{};
    for (int i = 0; i < 22; ++i) a.in[i] = (const float*)d_in[i];
    a.out = (float*)d_out; a.ws = (unsigned char*)d_ws;
#if MK_MULTI
    for (int p = 0; p < N_PHASES; ++p) { a.ph_lo = p; a.ph_hi = p + 1; hipLaunchKernelGGL(trunk_fwd, dim3(grid), dim3(NTHR), LDS_BYTES, stream, a); }
#else
    a.ph_lo = 0; a.ph_hi = N_PHASES;
    hipLaunchKernelGGL(trunk_fwd, dim3(grid), dim3(NTHR), LDS_BYTES, stream, a);
#endif
}
```

```cpp
#include <hip/hip_runtime.h>
#include <cstdio>
#include <cstdint>

#ifndef MK_MULTI
#define MK_MULTI 0
#endif

constexpr int BATCH = 8, SEQ = 2048, DM = 1024, NH = 16, HD = 64, FF = 3584, NE = 8;
constexpr int M = BATCH * SEQ;
constexpr float RMS_EPS = 1e-6f;
constexpr float LOG2E = 1.4426950408889634f;
constexpr float C2 = 0.125f * LOG2E;
constexpr int NWAVES = 8, NTHR = 512;
constexpr int LCAP = 16384;
constexpr int MAXROWS = 34816;
constexpr bool MOE_SPLITK = true;
constexpr bool MOE_FP8 = true;
constexpr bool DILIN_FP8 = true;
constexpr bool FOXIN_FP8 = true;
constexpr bool QKV3_FP8 = true;
constexpr bool DENSE_FP8_L0 = false, DENSE_FP8_L2 = true;
constexpr float W8S = 32.0f, A8S = 4.0f;
constexpr int MOE_NSPLIT = MOE_FP8 ? 2 : 4;
constexpr int SPLIT_ROW0 = 32768, SPLIT_ROWS = MAXROWS - SPLIT_ROW0;

constexpr size_t MiB = 1u << 20;
constexpr size_t WS_CTL = 0, CTL_ZERO_BYTES = 1 * MiB;
constexpr size_t WS_MISC = 1 * MiB;
constexpr size_t WS_H = 6 * MiB;
constexpr size_t WS_R1 = 38 * MiB;
constexpr size_t WS_R2 = 278 * MiB;
constexpr size_t WS_W = 414 * MiB;
constexpr size_t WS_XB = 832 * MiB;
constexpr size_t WS_END = 864 * MiB;
constexpr size_t PLANE = (size_t)M * DM;
constexpr size_t WE_QKV = 0;
constexpr size_t WE_WO_SB = WE_QKV + 2ull * 3072 * 1024;
constexpr size_t WE_WO_DIL = WE_WO_SB + 2ull * 1024 * 1024;
constexpr size_t WE_WO_FOX = WE_WO_DIL + 1024ull * 1024;
constexpr size_t WE_IN_DIL = WE_WO_FOX + 1024ull * 1024;
constexpr size_t WE_IN_FOX = WE_IN_DIL + 7168ull * 1024;
constexpr size_t WE_GU = WE_IN_FOX + 3072ull * 1024;
constexpr size_t WE_D = WE_GU + 2ull * 7168 * 1024;
constexpr size_t WE_MGU = WE_D + 2ull * 1024 * 3584;
constexpr size_t WE_MD = WE_MGU + 16ull * 7168 * 1024;
constexpr size_t WE_END = WE_MD + 16ull * 1024 * 3584;
static_assert(WS_W + WE_END * 2 <= WS_END, "weight copies fit");
constexpr size_t MS_LIST = 0;
constexpr size_t MS_GW = 1 * MiB;
constexpr size_t MS_TOK = 2 * MiB;
constexpr size_t MS_LOGF = 2 * MiB + 256 * 1024;
constexpr size_t MS_CUM = 3 * MiB + 256 * 1024;
constexpr size_t MS_SEL = 4 * MiB + 256 * 1024;
constexpr size_t MS_SG = MS_SEL + 256 * 1024;
constexpr size_t MS_LC = MS_SG + 256 * 1024;
constexpr int CW_BAR = 4096;
constexpr int CW_PANEL = 1024;
constexpr bool MOE_Y_FP8 = true;
constexpr float Y8S = 16.0f;
constexpr bool WO_FP8 = true;
constexpr int CW_CVQ = 2048;
constexpr int CW_CNT = 64;

#define GAS __attribute__((address_space(1)))
#define LAS __attribute__((address_space(3)))
typedef unsigned short bf16;
typedef unsigned v4u __attribute__((ext_vector_type(4)));
typedef unsigned v2u __attribute__((ext_vector_type(2)));
typedef float f32x4 __attribute__((ext_vector_type(4)));
typedef float f32x2 __attribute__((ext_vector_type(2)));
typedef GAS unsigned gu32;
#define RLX_AGENT __ATOMIC_RELAXED, __HIP_MEMORY_SCOPE_AGENT
__device__ __forceinline__ unsigned f2bf(float f) { unsigned u = __builtin_bit_cast(unsigned, f); return (u + 0x7fffu + ((u >> 16) & 1u)) >> 16; }
__device__ __forceinline__ unsigned pk2(float lo, float hi) { return f2bf(lo) | (f2bf(hi) << 16); }
__device__ __forceinline__ float bflo(unsigned u) { return __builtin_bit_cast(float, u << 16); }
__device__ __forceinline__ float bfhi(unsigned u) { return __builtin_bit_cast(float, u & 0xffff0000u); }

#define XB_TMO      128
#define XB_XCNT(j)  (256  + 64 * (j))
#define XB_XSUB(j)  (1280 + 64 * (j))
#define XB_XGEN(j)  (2304 + 64 * (j))
#define XB_TOP      3328
#define XB_TOPGEN   3392
#define XCD_BAR_WORDS 3456
#define XB_SPIN_CAP (1u << 22)
__device__ __forceinline__ unsigned xb_ld(unsigned* p)              { return __hip_atomic_load(p, __ATOMIC_RELAXED, __HIP_MEMORY_SCOPE_AGENT); }
__device__ __forceinline__ unsigned xb_add(unsigned* p, unsigned v) { return __hip_atomic_fetch_add(p, v, __ATOMIC_RELAXED, __HIP_MEMORY_SCOPE_AGENT); }
__device__ __forceinline__ unsigned xb_xcc_id() { return (unsigned)__builtin_amdgcn_s_getreg((3 << 11) | 20) & 0xFu; }
#define XB_SPIN(cond, bar) do { unsigned _sp = 0; while (cond) { __builtin_amdgcn_s_sleep(1); \
    if ((++_sp & 255u) == 0u) { if (xb_ld(&(bar)[XB_TMO])) break; if (_sp > XB_SPIN_CAP) { atomicAdd(&(bar)[XB_TMO], 1u); break; } } } } while (0)
struct XcdBarrier { unsigned* bar; unsigned x; volatile LAS unsigned* st; };
__device__ __forceinline__ XcdBarrier xcd_barrier_post(unsigned* bar, volatile LAS unsigned* st) {
    XcdBarrier b; b.bar = bar; b.x = xb_xcc_id(); b.st = st;
    if (threadIdx.x == 0) (void)xb_add(&bar[XB_XCNT(b.x)], 1u);
    return b;
}
__device__ __forceinline__ void xcd_barrier_complete(unsigned* bar, unsigned x, unsigned& nloc, unsigned& nx) {
    const unsigned G = gridDim.x * gridDim.y * gridDim.z;
    unsigned sum, cnt, mine, sp = 0u;
    for (;;) {
        sum = 0u; cnt = 0u; mine = 0u;
#pragma unroll
        for (unsigned j = 0; j < 16; ++j) { const unsigned c = xb_ld(&bar[XB_XCNT(j)]); sum += c; cnt += (c > 0u) ? 1u : 0u; mine = (j == x) ? c : mine; }
        if (sum == G) break;
        __builtin_amdgcn_s_sleep(1);
        if ((++sp & 255u) == 0u) { if (xb_ld(&bar[XB_TMO])) break; if (sp > XB_SPIN_CAP) { atomicAdd(&bar[XB_TMO], 1u); break; } }
    }
    nloc = mine > 0u ? mine : 1u; nx = cnt > 0u ? cnt : 1u;
}
__device__ __forceinline__ void xcd_barrier(const XcdBarrier& b) {
    asm volatile("s_waitcnt vmcnt(0)" ::: "memory");
    __syncthreads();
    if (threadIdx.x == 0) {
        unsigned* bar = b.bar;
        __builtin_amdgcn_s_waitcnt(0);
        unsigned nloc = b.st[0], nx = b.st[1];
        if (nloc == 0u) { xcd_barrier_complete(bar, b.x, nloc, nx); b.st[0] = nloc; b.st[1] = nx; }
        const unsigned old = xb_add(&bar[XB_XSUB(b.x)], 1u);
        const unsigned gen = old / nloc;
        if (old + 1u == (gen + 1u) * nloc) {
            __builtin_amdgcn_fence(__ATOMIC_RELEASE, "agent");
            asm volatile("s_waitcnt vmcnt(0)" ::: "memory");
            const unsigned og = xb_add(&bar[XB_TOP], 1u);
            const unsigned tg = og / nx;
            if (og + 1u == (tg + 1u) * nx) xb_add(&bar[XB_TOPGEN], 1u);
            else XB_SPIN(xb_ld(&bar[XB_TOPGEN]) == tg, bar);
            xb_add(&bar[XB_XGEN(b.x)], 1u);
            __builtin_amdgcn_fence(__ATOMIC_ACQUIRE, "agent");
            asm volatile("s_waitcnt vmcnt(0)" ::: "memory");
        } else {
            XB_SPIN(xb_ld(&bar[XB_XGEN(b.x)]) == gen, bar);
            __builtin_amdgcn_fence(__ATOMIC_ACQUIRE, "agent");
            asm volatile("s_waitcnt vmcnt(0)" ::: "memory");
        }
    }
    __syncthreads();
}

constexpr int LDS_BYTES = 147456;
constexpr int ATT_LDS_MAX = 143360;
constexpr int MISC_OFF = ATT_LDS_MAX + 64;
struct Frame {
    LAS unsigned char* lds;
    int tid, lane, wave, G;
    unsigned char* ws; gu32* ctl;
    float* out;
};
__device__ __forceinline__ float wave_sum(float v) {
#pragma unroll
    for (int o = 1; o < 64; o <<= 1) v += __shfl_xor(v, o);
    return v;
}

constexpr int PTR_OFF = ATT_LDS_MAX + 512;
__device__ __forceinline__ const float* inp_ptr(Frame& F, int k) {
    const LAS unsigned* t = (const LAS unsigned*)(F.lds + PTR_OFF) + 2 * k;
    const unsigned lo = __builtin_amdgcn_readfirstlane(t[0]), hi = __builtin_amdgcn_readfirstlane(t[1]);
    return (const float*)(((unsigned long long)hi << 32) | lo);
}
#define INP(k) inp_ptr(F, (k))
__device__ __forceinline__ bool relaunder(Frame& F) { int t_ = threadIdx.x; asm volatile("" : "+v"(t_)); F.tid = t_; F.lane = t_ & 63; F.wave = __builtin_amdgcn_readfirstlane(t_ >> 6); return true; }
namespace pg8 {
#define PG8_LAS __attribute__((address_space(3)))
typedef unsigned short bf16_t;
typedef short bf16x8 __attribute__((ext_vector_type(8)));
typedef unsigned u32x4 __attribute__((ext_vector_type(4)));
constexpr int BM = 256, BK = 64, HALF = 128, HTB = HALF * BK * 2, STAGE_BYTES = 8 * HTB, NXCD = 8, WGM = 8;
__host__ __device__ __forceinline__ int lds_byte(int r, int c) { const int st = (r >> 4) * 2 + (c >> 5), rr = r & 15, cc = c & 31, ob = rr * 64 + cc * 2; return st * 1024 + (ob ^ (((ob >> 9) & 1) << 5)); }
__host__ __device__ __forceinline__ void stage_rc(int b, int& R, int& C) { const int st = b / 1024, sb = b % 1024, swz = sb ^ (((sb >> 9) & 1) << 5); R = (st >> 1) * 16 + swz / 64; C = (st & 1) * 32 + (swz % 64) / 2; }
__host__ __device__ __forceinline__ int perm32(int rho) { const int n = rho >> 4, i = rho & 15; return 8 * (i >> 2) + 4 * n + (i & 3); }
struct Unit { int pm, pn, e, mt, nt, koff, kq; };

struct DenseOrder {
    int nM, nN, nwg, G, c, ntk; const char* A; const char* Bt; size_t tstep;
    __device__ __forceinline__ void init(const bf16_t* A_, const bf16_t* Bt_, int M_, int N_, int K_, int G_, int c_) { nM = M_ / BM; nN = N_ / BM; nwg = nM * nN; G = G_; c = c_; ntk = K_ / BK; A = (const char*)A_; Bt = (const char*)Bt_; tstep = (size_t)BM * K_ * 2; }
    __device__ __forceinline__ bool next(int i, Unit& u) const {
        const long L = (long)i * G + c; if (L >= nwg) return false;
        int wgid = (int)L; { const int q = nwg / NXCD, r = nwg % NXCD, xcd = wgid % NXCD, off = wgid / NXCD; wgid = (xcd < r ? xcd * (q + 1) : r * (q + 1) + (xcd - r) * q) + off; }
        const int nig = WGM * nN, gid = wgid / nig, fm = gid * WGM, gsz = (nM - fm) < WGM ? (nM - fm) : WGM;
        u.pm = fm + ((wgid % nig) % gsz); u.pn = (wgid % nig) / gsz; u.e = 0; u.mt = u.pm; u.nt = ntk; u.koff = 0; u.kq = -1; return true;
    }
    __device__ __forceinline__ const char* a_base(const Unit& u) const { return A + (size_t)u.pm * tstep; }
    __device__ __forceinline__ const char* b_base(const Unit& u) const { return Bt + (size_t)u.pn * tstep; }
    __device__ __forceinline__ void a_voff(const Unit&, const int (&)[2], const int (&)[2], unsigned (&)[2][2]) const {}
};
struct MoeOrder {
    int t1, t2, t3, t4, t5, t6, t7, t8, nN, G, c, K; const char* A; const char* Bt; size_t tstepA, tstepB, estepB; const int* list; bool gather; int splitk; bool xcdperm;
    __device__ __forceinline__ bool next(int i, Unit& u) const {
        const int X = i * G + c, U = t8 * nN; int L = X; u.nt = K / BK; u.koff = 0; u.kq = -1;
        if (splitk) { const int nfull = (U / G) * G;
            if (X >= nfull) { const int q = X - nfull; if (q >= splitk * (U - nfull)) return false; L = nfull + q / splitk; u.kq = q % splitk; u.nt = K / BK / splitk; u.koff = u.kq * (K / splitk) * 2; } }
        else if (X >= U) return false;
        if (xcdperm && u.kq < 0) {
            const int rnd = L / G, q = L - rnd * G, j = q >> 3, x = q & 7; L = rnd * G + (((j >> 2) * 8 + x) << 2) + (j & 3); }
        const int mt = L / nN; u.pm = mt; u.pn = L - mt * nN;
        const int e = (mt >= t1) + (mt >= t2) + (mt >= t3) + (mt >= t4) + (mt >= t5) + (mt >= t6) + (mt >= t7);
        const int tb = e == 0 ? 0 : e == 1 ? t1 : e == 2 ? t2 : e == 3 ? t3 : e == 4 ? t4 : e == 5 ? t5 : e == 6 ? t6 : t7;
        u.e = e; u.mt = mt - tb; return true;
    }
    __device__ __forceinline__ const char* a_base(const Unit& u) const { return (gather ? A : A + (size_t)u.pm * tstepA) + u.koff; }
    __device__ __forceinline__ const char* b_base(const Unit& u) const { return Bt + (size_t)u.e * estepB + (size_t)u.pn * tstepB + u.koff; }
    __device__ __forceinline__ void a_voff(const Unit& u, const int (&sR)[2], const int (&sC)[2], unsigned (&v)[2][2]) const {
        const int* lp = list + u.e * LCAP + u.mt * 256;
#pragma unroll
        for (int h = 0; h < 2; ++h)
#pragma unroll
            for (int i = 0; i < 2; ++i) v[h][i] = (unsigned)lp[h * 128 + sR[i]] * (unsigned)(K * 2) + (unsigned)(sC[i] * 2);
    }
};

typedef int v8i32 __attribute__((ext_vector_type(8)));
typedef int v4i32 __attribute__((ext_vector_type(4)));
__device__ __forceinline__ v8i32 cat8(bf16x8 a, bf16x8 b) { const v4i32 x = __builtin_bit_cast(v4i32, a), y = __builtin_bit_cast(v4i32, b); return (v8i32){x[0], x[1], x[2], x[3], y[0], y[1], y[2], y[3]}; }
__device__ __forceinline__ unsigned cvt4_fp8(float a, float b, float c, float d) { int w = 0; w = __builtin_amdgcn_cvt_pk_fp8_f32(a, b, w, false); w = __builtin_amdgcn_cvt_pk_fp8_f32(c, d, w, true); return (unsigned)w; }
__device__ __forceinline__ const char* uniptr(const char* p) { const unsigned long long v = (unsigned long long)p; const unsigned lo = __builtin_amdgcn_readfirstlane((unsigned)v), hi = __builtin_amdgcn_readfirstlane((unsigned)(v >> 32)); return (const char*)(((unsigned long long)hi << 32) | lo); }
__device__ __forceinline__ void glds16_s(const char* sbase, unsigned voff, unsigned lds_dst) { unsigned keep;
    asm volatile("s_mov_b32 %0, m0\n\ts_mov_b32 m0, %3\n\ts_nop 0\n\tglobal_load_lds_dwordx4 %2, %1\n\ts_mov_b32 m0, %0" : "=&s"(keep) : "s"(sbase), "v"(voff), "s"(lds_dst) : "memory"); }
__device__ __forceinline__ unsigned cvt_pk_bf16(float lo, float hi) { unsigned r; asm volatile("v_cvt_pk_bf16_f32 %0, %1, %2" : "=v"(r) : "v"(lo), "v"(hi)); return r; }

struct EpiPlanes {
    static constexpr bool PERM = true;
    bf16_t* O; float scale0; float oscale;
    __device__ __forceinline__ void operator()(const f32x4 (&acc)[2][2][4][2], const Unit& u, int wr, int wc, int fr, int fq) const {
        const int plane = u.pn >> 2; const float sc = (plane == 0 ? scale0 : 1.f) * oscale;
        bf16_t* base = O + (size_t)plane * PLANE + (size_t)(u.pm * BM + wr * 64 + fr) * DM + (u.pn & 3) * 256 + wc * 32 + 8 * fq;
#pragma unroll
        for (int ai = 0; ai < 2; ++ai)
#pragma unroll
            for (int m = 0; m < 4; ++m) { bf16_t* rowp = base + (size_t)(ai * HALF + m * 16) * DM;
#pragma unroll
                for (int bj = 0; bj < 2; ++bj) { const f32x4 v0 = acc[ai][bj][m][0] * sc, v1 = acc[ai][bj][m][1] * sc;
                    u32x4 w; w.x = cvt_pk_bf16(v0[0], v0[1]); w.y = cvt_pk_bf16(v0[2], v0[3]); w.z = cvt_pk_bf16(v1[0], v1[1]); w.w = cvt_pk_bf16(v1[2], v1[3]);
                    *(u32x4*)(rowp + bj * HALF) = w; } }
    }
};
struct EpiQKNorm {
    static constexpr bool PERM = true;
    bf16_t* O; const float* qg; const float* kg; int vplane; float iscale;
    __device__ __forceinline__ void operator()(const f32x4 (&acc)[2][2][4][2], const Unit& u, int wr, int wc, int fr, int fq) const {
        const int plane = u.pn >> 2; const bool isv = plane == vplane; const bool isq = !isv && ((plane & 1) == 0); const int grp = plane >> 1;
        const float* g = (isq ? qg : kg) + grp * 64 + 8 * fq;
        f32x4 gv[2][2];
#pragma unroll
        for (int bj = 0; bj < 2; ++bj)
#pragma unroll
            for (int n = 0; n < 2; ++n) gv[bj][n] = isv ? (f32x4){1.f, 1.f, 1.f, 1.f} : *(const f32x4*)(g + 32 * bj + 4 * n);
        const float mul = isq ? C2 : 1.f;
        bf16_t* base = O + (size_t)plane * PLANE + (size_t)(u.pm * BM + wr * 64 + fr) * DM + (u.pn & 3) * 256 + wc * 64 + 8 * fq;
#pragma unroll
        for (int ai = 0; ai < 2; ++ai)
#pragma unroll
            for (int m = 0; m < 4; ++m) { bf16_t* rowp = base + (size_t)(ai * HALF + m * 16) * DM;
                float ss = 0.f;
#pragma unroll
                for (int bj = 0; bj < 2; ++bj)
#pragma unroll
                    for (int n = 0; n < 2; ++n) { const f32x4 x = acc[ai][bj][m][n] * iscale; ss += (x[0] * x[0] + x[1] * x[1]) + (x[2] * x[2] + x[3] * x[3]); }
                ss += __shfl_xor(ss, 16); ss += __shfl_xor(ss, 32);
                const float inv = (isv ? 1.f : mul * __builtin_amdgcn_rsqf(ss * (1.f / 64.f) + RMS_EPS)) * iscale;
#pragma unroll
                for (int bj = 0; bj < 2; ++bj) { const f32x4 v0 = acc[ai][bj][m][0] * inv * gv[bj][0], v1 = acc[ai][bj][m][1] * inv * gv[bj][1];
                    u32x4 w; w.x = cvt_pk_bf16(v0[0], v0[1]); w.y = cvt_pk_bf16(v0[2], v0[3]); w.z = cvt_pk_bf16(v1[0], v1[1]); w.w = cvt_pk_bf16(v1[2], v1[3]);
                    *(u32x4*)(rowp + bj * 32) = w; } }
    }
};
struct EpiSwiglu {
    static constexpr bool PERM = true;
    bf16_t* O;
    __device__ __forceinline__ void operator()(const f32x4 (&acc)[2][2][4][2], const Unit& u, int wr, int wc, int fr, int fq) const {
        bf16_t* base = O + (size_t)(u.pm * BM + wr * 64 + fr) * FF + u.pn * 128 + wc * 32 + 8 * fq;
#pragma unroll
        for (int ai = 0; ai < 2; ++ai)
#pragma unroll
            for (int m = 0; m < 4; ++m) { bf16_t* rowp = base + (size_t)(ai * HALF + m * 16) * FF;
                f32x2 o[4];
#pragma unroll
                for (int n = 0; n < 2; ++n)
#pragma unroll
                    for (int hh = 0; hh < 2; ++hh) { const f32x2 ga = {acc[ai][0][m][n][2 * hh], acc[ai][0][m][n][2 * hh + 1]}, ua = {acc[ai][1][m][n][2 * hh], acc[ai][1][m][n][2 * hh + 1]};
                        const f32x2 m1 = ga * (-LOG2E); f32x2 e; e.x = __builtin_amdgcn_exp2f(m1.x); e.y = __builtin_amdgcn_exp2f(m1.y);
                        const f32x2 sden = e + 1.0f; f32x2 r; r.x = __builtin_amdgcn_rcpf(sden.x); r.y = __builtin_amdgcn_rcpf(sden.y);
                        o[n * 2 + hh] = (ga * ua) * r; }
                u32x4 w; w.x = cvt_pk_bf16(o[0].x, o[0].y); w.y = cvt_pk_bf16(o[1].x, o[1].y); w.z = cvt_pk_bf16(o[2].x, o[2].y); w.w = cvt_pk_bf16(o[3].x, o[3].y);
                *(u32x4*)rowp = w; }
    }
};
struct EpiSwigluF8 {
    static constexpr bool PERM = true;
    unsigned char* O;
    __device__ __forceinline__ void operator()(const f32x4 (&acc)[2][2][4][2], const Unit& u, int wr, int wc, int fr, int fq) const {
        unsigned char* base = O + (size_t)(u.pm * BM + wr * 64 + fr) * FF + u.pn * 128 + wc * 32 + 8 * fq;
        constexpr float k1 = -LOG2E / W8S, ik2 = W8S * W8S / A8S;
#pragma unroll
        for (int ai = 0; ai < 2; ++ai)
#pragma unroll
            for (int m = 0; m < 4; ++m) { unsigned char* rowp = base + (size_t)(ai * HALF + m * 16) * FF;
                f32x2 o[4];
#pragma unroll
                for (int n = 0; n < 2; ++n)
#pragma unroll
                    for (int hh = 0; hh < 2; ++hh) { const f32x2 ga = {acc[ai][0][m][n][2 * hh], acc[ai][0][m][n][2 * hh + 1]}, ua = {acc[ai][1][m][n][2 * hh], acc[ai][1][m][n][2 * hh + 1]};
                        const f32x2 m1 = ga * k1; f32x2 e; e.x = __builtin_amdgcn_exp2f(m1.x); e.y = __builtin_amdgcn_exp2f(m1.y);
                        const f32x2 sden = e * ik2 + ik2; f32x2 r; r.x = __builtin_amdgcn_rcpf(sden.x); r.y = __builtin_amdgcn_rcpf(sden.y);
                        const f32x2 t = (ga * ua) * r; o[n * 2 + hh] = (f32x2){__builtin_amdgcn_fmed3f(t.x, -448.f, 448.f), __builtin_amdgcn_fmed3f(t.y, -448.f, 448.f)}; }
                v2u w; w.x = cvt4_fp8(o[0].x, o[0].y, o[1].x, o[1].y); w.y = cvt4_fp8(o[2].x, o[2].y, o[3].x, o[3].y);
                *(v2u*)rowp = w; }
    }
};
template <bool BASE_F32>
struct EpiResid {
    static constexpr bool PERM = true;
    const void* base; bf16_t* out; float oscale;
    __device__ __forceinline__ void operator()(const f32x4 (&acc)[2][2][4][2], const Unit& u, int wr, int wc, int fr, int fq) const {
        const size_t off0 = (size_t)(u.pm * BM + wr * 64 + fr) * DM + u.pn * BM + wc * 32 + 8 * fq;
#pragma unroll
        for (int ai = 0; ai < 2; ++ai)
#pragma unroll
            for (int m = 0; m < 4; ++m) { const size_t off = off0 + (size_t)(ai * HALF + m * 16) * DM;
#pragma unroll
                for (int bj = 0; bj < 2; ++bj) { f32x4 b0, b1;
                    if (BASE_F32) { b0 = *(const f32x4*)((const float*)base + off + bj * HALF); b1 = *(const f32x4*)((const float*)base + off + bj * HALF + 4); }
                    else { const u32x4 w = *(const u32x4*)((const bf16_t*)base + off + bj * HALF);
                        b0 = (f32x4){__builtin_bit_cast(float, w.x << 16), __builtin_bit_cast(float, w.x & 0xffff0000u), __builtin_bit_cast(float, w.y << 16), __builtin_bit_cast(float, w.y & 0xffff0000u)};
                        b1 = (f32x4){__builtin_bit_cast(float, w.z << 16), __builtin_bit_cast(float, w.z & 0xffff0000u), __builtin_bit_cast(float, w.w << 16), __builtin_bit_cast(float, w.w & 0xffff0000u)}; }
                    const f32x4 v0 = b0 + acc[ai][bj][m][0] * oscale, v1 = b1 + acc[ai][bj][m][1] * oscale;
                    u32x4 o; o.x = cvt_pk_bf16(v0[0], v0[1]); o.y = cvt_pk_bf16(v0[2], v0[3]); o.z = cvt_pk_bf16(v1[0], v1[1]); o.w = cvt_pk_bf16(v1[2], v1[3]);
                    *(u32x4*)(out + off + bj * HALF) = o; } }
    }
};
struct EpiMoeDown {
    static constexpr bool PERM = true;
    bf16_t* Y; const float* gw; bf16_t* P; float oscale;
    __device__ __forceinline__ void operator()(const f32x4 (&acc)[2][2][4][2], const Unit& u, int wr, int wc, int fr, int fq) const {
        const float* gp = gw + u.e * LCAP + u.mt * 256 + wr * 64 + fr;
        if (MOE_Y_FP8 && u.kq < 0) {
            unsigned char* base8 = (unsigned char*)Y + (size_t)(u.pm * BM + wr * 64 + fr) * DM + u.pn * BM + wc * 32 + 8 * fq;
#pragma unroll
            for (int ai = 0; ai < 2; ++ai)
#pragma unroll
                for (int m = 0; m < 4; ++m) { unsigned char* rowp = base8 + (size_t)(ai * HALF + m * 16) * DM; const float g = gp[ai * HALF + m * 16] * oscale * Y8S;
#pragma unroll
                    for (int bj = 0; bj < 2; ++bj) { f32x4 v0 = acc[ai][bj][m][0] * g, v1 = acc[ai][bj][m][1] * g;
#pragma unroll
                        for (int q = 0; q < 4; ++q) { v0[q] = __builtin_amdgcn_fmed3f(v0[q], -448.f, 448.f); v1[q] = __builtin_amdgcn_fmed3f(v1[q], -448.f, 448.f); }
                        v2u w; w.x = cvt4_fp8(v0[0], v0[1], v0[2], v0[3]); w.y = cvt4_fp8(v1[0], v1[1], v1[2], v1[3]);
                        *(v2u*)(rowp + bj * HALF) = w; } }
            return;
        }
        bf16_t* base = (u.kq < 0 ? Y + (size_t)(u.pm * BM) * DM : P + ((size_t)u.kq * SPLIT_ROWS + (size_t)(u.pm * BM - SPLIT_ROW0)) * DM) + (size_t)(wr * 64 + fr) * DM + u.pn * BM + wc * 32 + 8 * fq;
#pragma unroll
        for (int ai = 0; ai < 2; ++ai)
#pragma unroll
            for (int m = 0; m < 4; ++m) { bf16_t* rowp = base + (size_t)(ai * HALF + m * 16) * DM; const float g = gp[ai * HALF + m * 16] * oscale;
#pragma unroll
                for (int bj = 0; bj < 2; ++bj) { const f32x4 v0 = acc[ai][bj][m][0] * g, v1 = acc[ai][bj][m][1] * g;
                    u32x4 w; w.x = cvt_pk_bf16(v0[0], v0[1]); w.y = cvt_pk_bf16(v0[2], v0[3]); w.z = cvt_pk_bf16(v1[0], v1[1]); w.w = cvt_pk_bf16(v1[2], v1[3]);
                    *(u32x4*)(rowp + bj * HALF) = w; } }
    }
};

template <class Epi, class Sched, bool GATHER, bool FP8 = false>
__device__ __forceinline__ void gemm_phase(PG8_LAS unsigned char* lds, const int K, const Sched& S, const Epi& E) {
    const int tid = threadIdx.x, wid = __builtin_amdgcn_readfirstlane(tid >> 6), lane = tid & 63, wr = wid >> 2, wc = wid & 3, fr = lane & 15, fq = lane >> 4;
    unsigned voffA[2], voffB[2]; int sR[2], sC[2];
#pragma unroll
    for (int i = 0; i < 2; ++i) { int R, C; stage_rc(tid * 16 + i * 8192, R, C); const int Rb = Epi::PERM ? ((R & ~31) + perm32(R & 31)) : R;
        voffA[i] = (unsigned)(R * K + C) * 2u; voffB[i] = (unsigned)(Rb * K + C) * 2u; sR[i] = R; sC[i] = C; }
    const size_t kstep = (size_t)(BK * 2);
    const size_t hstep = (size_t)HALF * K * 2;
    const unsigned ldsw = (unsigned)wid * 1024u, lds0 = (unsigned)(uintptr_t)lds;
    const int aoff = lds_byte(wr * 64 + fr, fq * 8), boff = lds_byte(wc * 32 + fr, fq * 8);

#define PG8_SA(b, h) (((b) * 2 + (h)) * HTB)
#define PG8_SB(b, h) ((4 + (b) * 2 + (h)) * HTB)
#define PG8_STAGE(bufoff, gbase, voff) do { const char* gb_ = uniptr((const char*)(gbase)); _Pragma("unroll") for (int _i = 0; _i < 2; ++_i) \
        glds16_s(gb_, (voff)[_i], (unsigned)__builtin_amdgcn_readfirstlane(lds0 + (unsigned)(bufoff) + ldsw + (unsigned)(_i * 8192))); } while (0)
#define PG8_STAGE_A(bufoff, p, h, VG) do { if (GATHER) { PG8_STAGE(bufoff, p, VG[h]); } else { PG8_STAGE(bufoff, (p) + ((h) ? hstep : 0), voffA); } } while (0)
#define PG8_LDA(dst, b, h) do { _Pragma("unroll") for (int m = 0; m < 4; ++m) { if constexpr (FP8) { const v4i32 x_ = *(const PG8_LAS v4i32*)(lds + PG8_SA(b, h) + aoff + m * 2048), y_ = *(const PG8_LAS v4i32*)(lds + PG8_SA(b, h) + aoff + m * 2048 + 1024); dst##8[m] = __builtin_shufflevector(x_, y_, 0, 1, 2, 3, 4, 5, 6, 7); } \
        else { _Pragma("unroll") for (int k = 0; k < 2; ++k) dst[m][k] = *(const PG8_LAS bf16x8*)(lds + PG8_SA(b, h) + aoff + m * 2048 + k * 1024); } } } while (0)
#define PG8_LDB(dst, b, h) do { _Pragma("unroll") for (int n = 0; n < 2; ++n) { if constexpr (FP8) { const v4i32 x_ = *(const PG8_LAS v4i32*)(lds + PG8_SB(b, h) + boff + n * 2048), y_ = *(const PG8_LAS v4i32*)(lds + PG8_SB(b, h) + boff + n * 2048 + 1024); dst##8[n] = __builtin_shufflevector(x_, y_, 0, 1, 2, 3, 4, 5, 6, 7); } \
        else { _Pragma("unroll") for (int k = 0; k < 2; ++k) dst[n][k] = *(const PG8_LAS bf16x8*)(lds + PG8_SB(b, h) + boff + n * 2048 + k * 1024); } } } while (0)
#define PG8_MMA(ai, bj, At, Bt) do { __builtin_amdgcn_s_setprio(1); _Pragma("unroll") for (int m = 0; m < 4; ++m) _Pragma("unroll") for (int n = 0; n < 2; ++n) { \
        if constexpr (FP8) asm volatile("v_mfma_scale_f32_16x16x128_f8f6f4 %0, %1, %2, %0, %3, %3 op_sel_hi:[0,0,0]" : "+v"(acc[ai][bj][m][n]) : "v"(Bt##8[n]), "v"(At##8[m]), "v"(sc8));   \
        else { _Pragma("unroll") for (int k = 0; k < 2; ++k) acc[ai][bj][m][n] = __builtin_amdgcn_mfma_f32_16x16x32_bf16(Bt[n][k], At[m][k], acc[ai][bj][m][n], 0, 0, 0); } } \
        __builtin_amdgcn_s_setprio(0); } while (0)
#define PG8_WAIT_V(n) asm volatile("s_waitcnt vmcnt(" #n ")" ::: "memory")
#define PG8_WAIT_L(n) asm volatile("s_waitcnt lgkmcnt(" #n ")" ::: "memory")
#define PG8_BAR __builtin_amdgcn_s_barrier()
#define PG8_SCHED __builtin_amdgcn_sched_barrier(0)
    Unit cur, nxt; int ui = 0;
    if (!S.next(0, cur)) return;
    f32x4 acc[2][2][4][2];
#pragma unroll
    for (int a = 0; a < 2; ++a)
#pragma unroll
        for (int b = 0; b < 2; ++b)
#pragma unroll
            for (int m = 0; m < 4; ++m)
#pragma unroll
                for (int n = 0; n < 2; ++n) acc[a][b][m][n] = (f32x4){0.f, 0.f, 0.f, 0.f};
    bf16x8 At[4][2], B0[2][2], B1[2][2];
    v8i32 At8[4], B08[2], B18[2];
    int sc8 = 0x7F7F7F7F; asm volatile("" : "+v"(sc8));
    const char* cA = S.a_base(cur); const char* cB = S.b_base(cur);
    unsigned vc[2][2] = {{0u, 0u}, {0u, 0u}}, vn[2][2] = {{0u, 0u}, {0u, 0u}};
    if (GATHER) { S.a_voff(cur, sR, sC, vc); asm volatile("s_waitcnt vmcnt(0)" : "+v"(vc[0][0]), "+v"(vc[0][1]), "+v"(vc[1][0]), "+v"(vc[1][1]) :: "memory"); }
    PG8_STAGE(PG8_SB(0, 0), cB, voffB); PG8_STAGE(PG8_SB(0, 1), cB + hstep, voffB); PG8_STAGE_A(PG8_SA(0, 0), cA, 0, vc); PG8_STAGE_A(PG8_SA(0, 1), cA, 1, vc);
    if (wr == 1) PG8_BAR;
    PG8_WAIT_V(2); PG8_BAR;
    PG8_STAGE(PG8_SB(1, 0), cB + kstep, voffB); PG8_STAGE_A(PG8_SA(1, 0), cA + kstep, 0, vc); PG8_STAGE(PG8_SB(1, 1), cB + hstep + kstep, voffB);
    PG8_WAIT_V(6); PG8_BAR;
    for (;;) {
        const bool has_next = S.next(ui + 1, nxt);
        const char* nA = has_next ? S.a_base(nxt) : cA; const char* nB = has_next ? S.b_base(nxt) : cB;
        if (GATHER) {
            if (has_next) { S.a_voff(nxt, sR, sC, vn); asm volatile("s_waitcnt vmcnt(0)" : "+v"(vn[0][0]), "+v"(vn[0][1]), "+v"(vn[1][0]), "+v"(vn[1][1]) :: "memory"); }
            else { vn[0][0] = vc[0][0]; vn[0][1] = vc[0][1]; vn[1][0] = vc[1][0]; vn[1][1] = vc[1][1]; }
        }
        const int nt = cur.nt;
        for (int t = 0; t < nt; t += 2) {
            const bool last = (t == nt - 2);
            const char* a1 = cA + (size_t)(t + 1) * kstep;
            const char* a2 = last ? nA : cA + (size_t)(t + 2) * kstep; const char* b2 = last ? nB : cB + (size_t)(t + 2) * kstep;
            const char* a3 = a2 + kstep; const char* b3 = b2 + kstep;
            unsigned v2[2][2];
#pragma unroll
            for (int h = 0; h < 2; ++h)
#pragma unroll
                for (int i = 0; i < 2; ++i) v2[h][i] = last ? vn[h][i] : vc[h][i];
            PG8_LDB(B0, 0, 0); PG8_LDB(B1, 0, 1); PG8_SCHED; PG8_LDA(At, 0, 0); PG8_STAGE_A(PG8_SA(1, 1), a1, 1, vc);
            PG8_WAIT_V(8); PG8_WAIT_L(0); PG8_BAR; PG8_MMA(0, 0, At, B0); PG8_MMA(0, 1, At, B1); PG8_BAR; PG8_SCHED;
            PG8_LDA(At, 0, 1); PG8_STAGE(PG8_SB(0, 0), b2, voffB); PG8_STAGE(PG8_SB(0, 1), b2 + hstep, voffB); PG8_STAGE_A(PG8_SA(0, 0), a2, 0, v2);
            PG8_WAIT_V(8); PG8_WAIT_L(0); PG8_BAR; PG8_MMA(1, 0, At, B0); PG8_MMA(1, 1, At, B1); PG8_BAR; PG8_SCHED;
            PG8_LDB(B0, 1, 0); PG8_LDB(B1, 1, 1); PG8_SCHED; PG8_LDA(At, 1, 0); PG8_STAGE_A(PG8_SA(0, 1), a2, 1, v2);
            PG8_WAIT_V(8); PG8_WAIT_L(0); PG8_BAR; PG8_MMA(0, 0, At, B0); PG8_MMA(0, 1, At, B1); PG8_BAR; PG8_SCHED;
            PG8_LDA(At, 1, 1); PG8_STAGE(PG8_SB(1, 0), b3, voffB); PG8_STAGE(PG8_SB(1, 1), b3 + hstep, voffB); PG8_STAGE_A(PG8_SA(1, 0), a3, 0, v2);
            PG8_WAIT_V(8); PG8_WAIT_L(0); PG8_BAR; PG8_MMA(1, 0, At, B0); PG8_MMA(1, 1, At, B1); PG8_BAR; PG8_SCHED;
        }
        if (wr == 0) PG8_BAR;
        if constexpr (FP8) asm volatile("s_nop 15\n\ts_nop 15" ::: "memory");
        { int fr_ = fr, fq_ = fq; asm volatile("" : "+v"(fr_), "+v"(fq_)); E(acc, cur, wr, wc, fr_, fq_); }
        if (!has_next) break;
#pragma unroll
        for (int a = 0; a < 2; ++a)
#pragma unroll
            for (int b = 0; b < 2; ++b)
#pragma unroll
                for (int m = 0; m < 4; ++m)
#pragma unroll
                    for (int n = 0; n < 2; ++n) acc[a][b][m][n] = (f32x4){0.f, 0.f, 0.f, 0.f};
        cur = nxt; cA = nA; cB = nB; ++ui;
        if (GATHER) { vc[0][0] = vn[0][0]; vc[0][1] = vn[0][1]; vc[1][0] = vn[1][0]; vc[1][1] = vn[1][1]; }
        if (wr == 1) PG8_BAR;
    }
    PG8_WAIT_V(0);
    PG8_BAR;
#undef PG8_SA
#undef PG8_SB
#undef PG8_STAGE
#undef PG8_STAGE_A
#undef PG8_LDA
#undef PG8_LDB
#undef PG8_MMA
#undef PG8_WAIT_V
#undef PG8_WAIT_L
#undef PG8_BAR
#undef PG8_SCHED
}
}

namespace att {
typedef short bf16x8 __attribute__((ext_vector_type(8)));
typedef short s16x4 __attribute__((ext_vector_type(4)));
typedef float f32x16 __attribute__((ext_vector_type(16)));
typedef unsigned u32x4 __attribute__((ext_vector_type(4)));
typedef LAS char* lptr;
constexpr int SLOTB = 8192, NSLOT = 6, AHEAD = 4;
constexpr int L_K = 0, L_V = NSLOT * SLOTB, L_WS = 2 * NSLOT * SLOTB, L_OST = L_WS + 8 * 256, L_KB = L_OST + 8 * 4096, L_FLG = L_KB + 8192, L_END = L_FLG + 256;
static_assert(L_END <= ATT_LDS_MAX, "attention LDS map");
constexpr float THR = 8.0f;
__device__ __forceinline__ int crow(int r, int hi) { return (r & 3) + 8 * (r >> 2) + 4 * hi; }
__device__ __forceinline__ void glds16(const void* gsrc, unsigned lds_dst) { unsigned keep;
    asm volatile("s_mov_b32 %0, m0\n\ts_mov_b32 m0, %2\n\ts_nop 0\n\tglobal_load_lds_dwordx4 %1, off\n\ts_mov_b32 m0, %0" : "=&s"(keep) : "v"(gsrc), "s"(lds_dst) : "memory"); }
typedef float f32x2_t __attribute__((ext_vector_type(2))); typedef __bf16 bf16x2_t __attribute__((ext_vector_type(2)));
__device__ __forceinline__ unsigned cvtpk(float lo, float hi) { f32x2_t v = {lo, hi}; bf16x2_t b = __builtin_convertvector(v, bf16x2_t); return __builtin_bit_cast(unsigned, b); }
__device__ __forceinline__ bf16x8 gload16(const void* p) { bf16x8 v; asm volatile("global_load_dwordx4 %0, %1, off" : "=v"(v) : "v"(p) : "memory"); return v; }
__device__ __forceinline__ float max3f(float a, float b, float c) { return __builtin_fmaxf(__builtin_fmaxf(a, b), c); }
__device__ __forceinline__ void wait_bar(int n) {
    if (n >= 6) asm volatile("s_waitcnt vmcnt(6) lgkmcnt(0)\n\ts_barrier" ::: "memory");
    else if (n >= 4) asm volatile("s_waitcnt vmcnt(4) lgkmcnt(0)\n\ts_barrier" ::: "memory");
    else if (n >= 2) asm volatile("s_waitcnt vmcnt(2) lgkmcnt(0)\n\ts_barrier" ::: "memory");
    else asm volatile("s_waitcnt vmcnt(0) lgkmcnt(0)\n\ts_barrier" ::: "memory");
}
__device__ __forceinline__ float other_half(float x, int hi) {
    auto rr = __builtin_amdgcn_permlane32_swap(__float_as_uint(x), __float_as_uint(x), false, false);
    return __uint_as_float(hi ? rr[0] : rr[1]);
}
__device__ __forceinline__ void qkt(f32x16& p0, f32x16& p1, lptr Kslot, const bf16x8* qr, const f32x16& c0, const f32x16& c1, int r32, int hi) {
    lptr kb = Kslot + hi * 1024 + r32 * 16;
#pragma unroll
    for (int d0 = 0; d0 < 4; ++d0) {
        const bf16x8 b0 = *(const LAS bf16x8*)(kb + d0 * 2048);
        const bf16x8 b1 = *(const LAS bf16x8*)(kb + d0 * 2048 + 512);
        if (d0 == 0) { p0 = __builtin_amdgcn_mfma_f32_32x32x16_bf16(b0, qr[0], c0, 0, 0, 0); p1 = __builtin_amdgcn_mfma_f32_32x32x16_bf16(b1, qr[0], c1, 0, 0, 0); }
        else { p0 = __builtin_amdgcn_mfma_f32_32x32x16_bf16(b0, qr[d0], p0, 0, 0, 0); p1 = __builtin_amdgcn_mfma_f32_32x32x16_bf16(b1, qr[d0], p1, 0, 0, 0); } }
}
__device__ __forceinline__ void pv(f32x16* o, int vb, bf16x8 pa0, bf16x8 pa1, bf16x8 pa2, bf16x8 pa3) {
#pragma unroll
    for (int d0 = 0; d0 < 2; ++d0) { s16x4 lo[4], hi[4];
#pragma unroll
        for (int ks = 0; ks < 4; ++ks) {
            asm volatile("ds_read_b64_tr_b16 %0,%1 offset:%c2" : "=&v"(lo[ks]) : "v"(vb), "i"(d0 * 4096 + ks * 1024) : "memory");
            asm volatile("ds_read_b64_tr_b16 %0,%1 offset:%c2" : "=&v"(hi[ks]) : "v"(vb), "i"(d0 * 4096 + ks * 1024 + 512) : "memory"); }
        asm volatile("s_waitcnt lgkmcnt(0)" ::: "memory"); __builtin_amdgcn_sched_barrier(0);
#define ATT_PK(k) (bf16x8){lo[k][0], lo[k][1], lo[k][2], lo[k][3], hi[k][0], hi[k][1], hi[k][2], hi[k][3]}
        o[d0] = __builtin_amdgcn_mfma_f32_32x32x16_bf16(pa0, ATT_PK(0), o[d0], 0, 0, 0);
        o[d0] = __builtin_amdgcn_mfma_f32_32x32x16_bf16(pa1, ATT_PK(1), o[d0], 0, 0, 0);
        o[d0] = __builtin_amdgcn_mfma_f32_32x32x16_bf16(pa2, ATT_PK(2), o[d0], 0, 0, 0);
        o[d0] = __builtin_amdgcn_mfma_f32_32x32x16_bf16(pa3, ATT_PK(3), o[d0], 0, 0, 0);
#undef ATT_PK
    }
}
__device__ __forceinline__ void pack_pv(f32x16* o, int vb, const f32x16& p0, const f32x16& p1) {
    u32x4 w0, w1, w2, w3;
#pragma unroll
    for (int j = 0; j < 4; ++j) { w0[j] = cvtpk(p0[2 * j], p0[2 * j + 1]); w1[j] = cvtpk(p0[8 + 2 * j], p0[8 + 2 * j + 1]); w2[j] = cvtpk(p1[2 * j], p1[2 * j + 1]); w3[j] = cvtpk(p1[8 + 2 * j], p1[8 + 2 * j + 1]); }
    pv(o, vb, __builtin_bit_cast(bf16x8, w0), __builtin_bit_cast(bf16x8, w1), __builtin_bit_cast(bf16x8, w2), __builtin_bit_cast(bf16x8, w3));
}
__device__ __forceinline__ float rowmax32(const f32x16& p0, const f32x16& p1, int hi) {
    float a = max3f(p0[0], p0[1], p1[0]), b = max3f(p0[2], p0[3], p1[1]); a = max3f(a, p1[2], p1[3]);
#pragma unroll
    for (int r = 4; r < 16; r += 4) { a = max3f(a, p0[r], p0[r + 1]); b = max3f(b, p0[r + 2], p0[r + 3]); a = max3f(a, p1[r], p1[r + 1]); b = max3f(b, p1[r + 2], p1[r + 3]); }
    a = fmaxf(a, b);
    return fmaxf(a, other_half(a, hi));
}
__device__ __forceinline__ void store_o(const f32x16* o, const float* sc, lptr stgb, bf16* Ow, long rpitch, int lane, int r32, int hi) {
    LAS bf16* stg = (LAS bf16*)stgb;
#pragma unroll
    for (int r = 0; r < 16; ++r) { const int orow = crow(r, hi);
#pragma unroll
        for (int d0 = 0; d0 < 2; ++d0) stg[orow * 64 + d0 * 32 + r32] = (bf16)f2bf(o[d0][r] * sc[r]); }
    asm volatile("s_waitcnt lgkmcnt(0)" ::: "memory");
#pragma unroll
    for (int i = 0; i < 4; ++i) { const int row = i * 8 + (lane >> 3), ch = lane & 7; const u32x4 v = *(const LAS u32x4*)(stg + row * 64 + ch * 8); *(u32x4*)(Ow + (long)row * rpitch + ch * 8) = v; }
}
__device__ __forceinline__ void store_o8(const f32x16* o, const float* sc, lptr stgb, unsigned char* O8w, long rpitch, int lane, int r32, int hi) {
    LAS unsigned char* stg = (LAS unsigned char*)stgb;
#pragma unroll
    for (int r = 0; r < 16; ++r) { const int orow = crow(r, hi); const float s4 = sc[r] * (float)A8S;
        const int pk = __builtin_amdgcn_cvt_pk_fp8_f32(__builtin_amdgcn_fmed3f(o[0][r] * s4, -448.f, 448.f), __builtin_amdgcn_fmed3f(o[1][r] * s4, -448.f, 448.f), 0, false);
        stg[orow * 64 + r32] = (unsigned char)(pk & 0xff); stg[orow * 64 + 32 + r32] = (unsigned char)((pk >> 8) & 0xff); }
    asm volatile("s_waitcnt lgkmcnt(0)" ::: "memory");
#pragma unroll
    for (int i = 0; i < 2; ++i) { const int row = i * 16 + (lane >> 2), ch = lane & 3; const u32x4 v = *(const LAS u32x4*)(stg + row * 64 + ch * 16); *(u32x4*)(O8w + (long)row * rpitch + ch * 16) = v; }
}
__device__ __forceinline__ void softmax_step(f32x16& p0, f32x16& p1, float& mref, float& lsum, f32x16* o, LAS float* wsf, int r32, int hi) {
    const float rm = rowmax32(p0, p1, hi);
    const bool fresh = mref <= -1e30f;
    const bool want = !fresh && (rm > mref + THR);
    if (fresh) mref = fmaxf(rm, -1e30f);
    if (__any(want)) {
        const float dl = want ? rm - mref : 0.f; mref += dl; const float f = __builtin_amdgcn_exp2f(-dl); lsum *= f;
        if (hi == 0) wsf[r32] = f;
        asm volatile("s_waitcnt lgkmcnt(0)" ::: "memory");
#pragma unroll
        for (int r = 0; r < 16; ++r) { const float fr = wsf[crow(r, hi)]; o[0][r] *= fr; o[1][r] *= fr; }
    }
    float sa = 0.f, sb = 0.f;
#pragma unroll
    for (int r = 0; r < 16; ++r) { p0[r] = __builtin_amdgcn_exp2f(p0[r] - mref); p1[r] = __builtin_amdgcn_exp2f(p1[r] - mref); sa += p0[r]; sb += p1[r]; }
    lsum += sa + sb;
}

struct WaveCtx { int lane, r32, hi, wid; unsigned lds0; int vb0; lptr shm; };
struct UnitD { int NT; int b, h, qb, g, x; };

template <int MODE> struct CausalMode {
    const bf16* Q; const bf16* K; const bf16* V; bf16* O; int b, h, p; bool f8;
    float carry, mref, lsum; int done;
    __device__ __forceinline__ int units() const { return 4; }
    __device__ __forceinline__ void desc(int j, UnitD& d) const { d.b = b; d.h = h; d.qb = (j == 0) ? 7 - p : (j == 1) ? 5 - p : (j == 2) ? 2 + p : p; d.NT = 4 * (d.qb + 1); d.g = 0; d.x = 0; }
    __device__ __forceinline__ int tile_of(const UnitD& d, int k) const { return MODE == 0 ? d.NT - 1 - k : k; }
    __device__ __forceinline__ void q_load(const UnitD& d, const WaveCtx& w, bf16x8 (&q)[4]) const {
        const bf16* Qw = Q + ((long)d.b * SEQ + d.qb * 256 + w.wid * 32 + w.r32) * DM + d.h * 64 + w.hi * 8;
#pragma unroll
        for (int d0 = 0; d0 < 4; ++d0) q[d0] = gload16(Qw + d0 * 16);
    }
    __device__ __forceinline__ void dma(const UnitD& d, int k, int slot, const WaveCtx& w) const {
        const long row0 = (long)d.b * SEQ + 64 * tile_of(d, k);
        glds16(K + (row0 + w.lane) * DM + d.h * 64 + w.wid * 8, (unsigned)__builtin_amdgcn_readfirstlane(w.lds0 + L_K + slot * SLOTB + w.wid * 1024));
        glds16(V + (row0 + 16 * (w.wid & 3) + (w.lane >> 2)) * DM + d.h * 64 + (w.wid >> 2) * 32 + (w.lane & 3) * 8, (unsigned)__builtin_amdgcn_readfirstlane(w.lds0 + L_V + slot * SLOTB + w.wid * 1024));
    }
    __device__ __forceinline__ void begin(const UnitD&, const WaveCtx&) { carry = 1.0f; mref = -1e30f; lsum = 0.f; done = 0; }
    __device__ __forceinline__ int wave_done() const { return done; }
    __device__ __forceinline__ void compute(const UnitD& d, int k, int slot, const WaveCtx& w, const bf16x8* qr, f32x16* o) {
        const int T = tile_of(d, k), qfirst = d.qb * 256 + w.wid * 32, qpos = qfirst + w.r32;
        if (MODE == 0) {
            if (done || 64 * T >= qfirst + 31) return;
            f32x16 p0, p1; const f32x16 z = {}; qkt(p0, p1, w.shm + L_K + slot * SLOTB, qr, z, z, w.r32, w.hi);
            const bool diag = 64 * T + 63 >= qfirst;
            float ga[8];
#pragma unroll
            for (int a = 0; a < 8; ++a) {
                float rr[4];
#pragma unroll
                for (int i = 0; i < 4; ++i) { const int r = 4 * (a & 3) + i; const float zz = (a < 4) ? p0[r] : p1[r];
                    const float e = __builtin_amdgcn_exp2f(fminf(zz, 120.f)); float rv = __builtin_amdgcn_rcpf(1.0f + e);
                    if (diag) { const int kv = 64 * T + crow(r, w.hi) + ((a < 4) ? 0 : 32); if (kv >= qpos) rv = 1.0f; }
                    rr[i] = rv; if (a < 4) p0[r] = rv; else p1[r] = rv; }
                ga[a] = (rr[0] * rr[1]) * (rr[2] * rr[3]);
            }
            float oth[8], Ts[8];
#pragma unroll
            for (int a = 0; a < 8; ++a) oth[a] = other_half(ga[a], w.hi);
            float run = 1.0f;
#pragma unroll
            for (int a = 7; a >= 0; --a) { Ts[a] = run; run *= ga[a] * oth[a]; }
#pragma unroll
            for (int a = 0; a < 8; ++a) {
                float E = carry * Ts[a] * (w.hi ? 1.0f : oth[a]);
#pragma unroll
                for (int i = 3; i >= 0; --i) { const int r = 4 * (a & 3) + i; const float rv = (a < 4) ? p0[r] : p1[r]; const float wt = (1.0f - rv) * E; E *= rv; if (a < 4) p0[r] = wt; else p1[r] = wt; }
            }
            carry *= run;
            pack_pv(o, w.vb0 + slot * SLOTB, p0, p1);
            if (__all(carry < 1e-30f)) done = 1;
        } else {
            if (64 * T > qfirst + 31) return;
            LAS float* kbl = (LAS float*)(w.shm + L_KB);
            f32x16 c0, c1;
#pragma unroll
            for (int g = 0; g < 4; ++g) { const f32x4 k0 = *(const LAS f32x4*)(kbl + 64 * T + 8 * g + 4 * w.hi), k1 = *(const LAS f32x4*)(kbl + 64 * T + 32 + 8 * g + 4 * w.hi);
#pragma unroll
                for (int i = 0; i < 4; ++i) { c0[4 * g + i] = k0[i]; c1[4 * g + i] = k1[i]; } }
            f32x16 p0, p1; qkt(p0, p1, w.shm + L_K + slot * SLOTB, qr, c0, c1, w.r32, w.hi);
            if (64 * T + 63 > qfirst) {
#pragma unroll
                for (int r = 0; r < 16; ++r) { const int kv = 64 * T + crow(r, w.hi); if (kv > qpos) p0[r] = -INFINITY; if (kv + 32 > qpos) p1[r] = -INFINITY; } }
            softmax_step(p0, p1, mref, lsum, o, (LAS float*)(w.shm + L_WS) + w.wid * 64, w.r32, w.hi);
            pack_pv(o, w.vb0 + slot * SLOTB, p0, p1);
        }
    }
    __device__ __forceinline__ void finish(const UnitD& d, const WaveCtx& w, const f32x16* o) {
        LAS float* wsf = (LAS float*)(w.shm + L_WS) + w.wid * 64;
        float sc[16];
        if (MODE == 0) {
#pragma unroll
            for (int r = 0; r < 16; ++r) sc[r] = 1.0f;
        } else {
            float lt = lsum + other_half(lsum, w.hi);
            if (w.hi == 0) wsf[32 + w.r32] = lt;
            asm volatile("s_waitcnt lgkmcnt(0)" ::: "memory");
#pragma unroll
            for (int r = 0; r < 16; ++r) sc[r] = __builtin_amdgcn_rcpf(wsf[32 + crow(r, w.hi)]);
        }
        if (f8) store_o8(o, sc, w.shm + L_OST + w.wid * 4096, (unsigned char*)O + ((long)d.b * SEQ + d.qb * 256 + w.wid * 32) * DM + d.h * 64, DM, w.lane, w.r32, w.hi);
        else store_o(o, sc, w.shm + L_OST + w.wid * 4096, O + ((long)d.b * SEQ + d.qb * 256 + w.wid * 32) * DM + d.h * 64, DM, w.lane, w.r32, w.hi);
    }
};

struct DilMode {
    const bf16* PROJ; bf16* OG; float* ST; bf16* Of; int b, h, p, pass;
    float mref, lsum;
    __device__ __forceinline__ int units() const { return pass == 0 ? 8 : 4; }
    __device__ __forceinline__ void desc(int j, UnitD& d) const {
        const int g = pass == 0 ? (j >> 2) : 2, i = j & 3; d.g = g; d.b = b; d.h = h; d.qb = 0;
        d.x = (g == 1) ? ((2 * (i >> 1) + p) << 1) + (i & 1) : 2 * i + p;
        const int i0 = (g == 0) ? 256 * d.x : (g == 1) ? 256 * (d.x & 1) : 0;
        d.NT = (g == 2) ? 4 : ((i0 >> 6) + 4 - t_lo(g, i0));
    }
    static __device__ __forceinline__ int t_lo(int g, int i0) { return (g == 2) ? 0 : ((i0 >> 6) >= 2 ? (i0 >> 6) - 2 : 0); }
    static __device__ __forceinline__ int dil_of(int g) { return (g == 0) ? 1 : (g == 1) ? 4 : 16; }
    static __device__ __forceinline__ int cls0_of(int g, int x) { return (g == 0) ? 0 : (g == 1) ? (x >> 1) : 2 * x; }
    static __device__ __forceinline__ int i0_of(int g, int x) { return (g == 0) ? 256 * x : (g == 1) ? 256 * (x & 1) : 0; }
    static __device__ __forceinline__ int tcls(int g, int x, int k) { return cls0_of(g, x) + ((g == 2) ? (k >> 1) : 0); }
    static __device__ __forceinline__ int kbase(int g, int x, int k) { return (g == 2) ? 64 * (k & 1) : 64 * (t_lo(g, i0_of(g, x)) + k); }
    __device__ __forceinline__ void q_load(const UnitD& d, const WaveCtx& w, bf16x8 (&q)[4]) const {
        const int dil = dil_of(d.g), clsw = cls0_of(d.g, d.x) + ((d.g == 2) ? (w.wid >> 2) : 0), qi0w = (d.g == 2) ? 32 * (w.wid & 3) : i0_of(d.g, d.x) + 32 * w.wid;
        const bf16* Qw = PROJ + (size_t)(2 * d.g) * PLANE + ((long)d.b * SEQ + clsw + (long)(qi0w + w.r32) * dil) * DM + d.h * 64 + w.hi * 8;
#pragma unroll
        for (int d0 = 0; d0 < 4; ++d0) q[d0] = gload16(Qw + d0 * 16);
    }
    __device__ __forceinline__ void dma(const UnitD& d, int k, int slot, const WaveCtx& w) const {
        const int dil = dil_of(d.g); const long tok0 = (long)d.b * SEQ + tcls(d.g, d.x, k) + (long)kbase(d.g, d.x, k) * dil;
        glds16(PROJ + (size_t)(2 * d.g + 1) * PLANE + (tok0 + (long)w.lane * dil) * DM + d.h * 64 + w.wid * 8, (unsigned)__builtin_amdgcn_readfirstlane(w.lds0 + L_K + slot * SLOTB + w.wid * 1024));
        glds16(PROJ + (size_t)6 * PLANE + (tok0 + (long)(16 * (w.wid & 3) + (w.lane >> 2)) * dil) * DM + d.h * 64 + (w.wid >> 2) * 32 + (w.lane & 3) * 8, (unsigned)__builtin_amdgcn_readfirstlane(w.lds0 + L_V + slot * SLOTB + w.wid * 1024));
    }
    __device__ __forceinline__ void begin(const UnitD&, const WaveCtx&) { mref = -1e30f; lsum = 0.f; }
    __device__ __forceinline__ int wave_done() const { return 0; }
    __device__ __forceinline__ void compute(const UnitD& d, int k, int slot, const WaveCtx& w, const bf16x8* qr, f32x16* o) {
        const int clsw = cls0_of(d.g, d.x) + ((d.g == 2) ? (w.wid >> 2) : 0), qi0w = (d.g == 2) ? 32 * (w.wid & 3) : i0_of(d.g, d.x) + 32 * w.wid;
        const int kb = kbase(d.g, d.x, k);
        if (tcls(d.g, d.x, k) != clsw || kb > qi0w + 31 || kb < qi0w - 191) return;
        LAS float* tbl = (LAS float*)(w.shm + L_KB) + d.g * 640 + 256;
        const int dbase = qi0w + w.r32 - kb - 4 * w.hi;
        f32x16 c0, c1;
#pragma unroll
        for (int r = 0; r < 16; ++r) { const int cr = (r & 3) + 8 * (r >> 2); c0[r] = tbl[dbase - cr]; c1[r] = tbl[dbase - cr - 32]; }
        f32x16 p0, p1; qkt(p0, p1, w.shm + L_K + slot * SLOTB, qr, c0, c1, w.r32, w.hi);
        softmax_step(p0, p1, mref, lsum, o, (LAS float*)(w.shm + L_WS) + w.wid * 64, w.r32, w.hi);
        pack_pv(o, w.vb0 + slot * SLOTB, p0, p1);
    }
    __device__ __forceinline__ void finish(const UnitD& d, const WaveCtx& w, const f32x16* o) {
        const int dil = dil_of(d.g), clsw = cls0_of(d.g, d.x) + ((d.g == 2) ? (w.wid >> 2) : 0), qi0w = (d.g == 2) ? 32 * (w.wid & 3) : i0_of(d.g, d.x) + 32 * w.wid;
        LAS float* wsf = (LAS float*)(w.shm + L_WS) + w.wid * 64;
        const float lt = lsum + other_half(lsum, w.hi);
        if (w.hi == 0) { wsf[32 + w.r32] = lt; wsf[w.r32] = mref;
            if (pass == 0) { const long tok = (long)d.b * SEQ + clsw + (long)(qi0w + w.r32) * dil;
                *(f32x2*)(ST + ((size_t)d.g * M * NH + (size_t)tok * NH + d.h) * 2) = (f32x2){mref, lt}; } }
        asm volatile("s_waitcnt lgkmcnt(0)" ::: "memory");
        float sc[16];
#pragma unroll
        for (int r = 0; r < 16; ++r) sc[r] = __builtin_amdgcn_rcpf(wsf[32 + crow(r, w.hi)]);
        if (pass == 0) { store_o(o, sc, w.shm + L_OST + w.wid * 4096, OG + (size_t)d.g * PLANE + ((long)d.b * SEQ + clsw + (long)qi0w * dil) * DM + d.h * 64, (long)dil * DM, w.lane, w.r32, w.hi); return; }
        LAS bf16* stg = (LAS bf16*)(w.shm + L_OST + w.wid * 4096);
#pragma unroll
        for (int r = 0; r < 16; ++r) { const int orow = crow(r, w.hi);
#pragma unroll
            for (int d0 = 0; d0 < 2; ++d0) stg[orow * 64 + d0 * 32 + w.r32] = (bf16)f2bf(o[d0][r] * sc[r]); }
        asm volatile("s_waitcnt lgkmcnt(0)" ::: "memory");
#pragma unroll
        for (int i = 0; i < 4; ++i) { const int row = i * 8 + (w.lane >> 3), ch = w.lane & 7;
            const long tok = (long)d.b * SEQ + clsw + (long)(qi0w + row) * dil;
            const f32x2 s0 = *(const f32x2*)(ST + ((size_t)0 * M * NH + (size_t)tok * NH + d.h) * 2), s1 = *(const f32x2*)(ST + ((size_t)1 * M * NH + (size_t)tok * NH + d.h) * 2);
            const float m2 = wsf[row], l2 = wsf[32 + row];
            const float mx = fmaxf(s0.x, fmaxf(s1.x, m2));
            float w0 = __builtin_amdgcn_exp2f(s0.x - mx) * s0.y, w1 = __builtin_amdgcn_exp2f(s1.x - mx) * s1.y, w2 = __builtin_amdgcn_exp2f(m2 - mx) * l2;
            const float inv = __builtin_amdgcn_rcpf(w0 + w1 + w2); w0 *= inv; w1 *= inv; w2 *= inv;
            const v4u x0 = *(const GAS v4u*)(OG + (size_t)tok * DM + d.h * 64 + ch * 8), x1 = *(const GAS v4u*)(OG + PLANE + (size_t)tok * DM + d.h * 64 + ch * 8);
            const v4u x2 = *(const LAS v4u*)(stg + row * 64 + ch * 8); v4u rr;
#pragma unroll
            for (int q = 0; q < 4; ++q) { const float lo = w0 * bflo(x0[q]) + w1 * bflo(x1[q]) + w2 * bflo(x2[q]), hi2 = w0 * bfhi(x0[q]) + w1 * bfhi(x1[q]) + w2 * bfhi(x2[q]);
                if (WO_FP8) rr[q] = (unsigned)__builtin_amdgcn_cvt_pk_fp8_f32(__builtin_amdgcn_fmed3f(lo * (float)A8S, -448.f, 448.f), __builtin_amdgcn_fmed3f(hi2 * (float)A8S, -448.f, 448.f), 0, false) & 0xffffu;
                else rr[q] = pk2(lo, hi2); }
            if (WO_FP8) *(GAS v2u*)((GAS unsigned char*)Of + (size_t)tok * DM + d.h * 64 + ch * 8) = (v2u){rr[0] | (rr[1] << 16), rr[2] | (rr[3] << 16)};
            else *(GAS v4u*)(Of + (size_t)tok * DM + d.h * 64 + ch * 8) = rr; }
    }
};

template <class Mode, bool EARLY_EXIT>
__device__ __forceinline__ void stream_units(Mode& Mo, const WaveCtx& w) {
    LAS int* flg = (LAS int*)(w.shm + L_FLG);
    const int nun = Mo.units();
    int pj = 0, pk = 0, pseq = 0, cseq = 0;
    UnitD pd; Mo.desc(0, pd);
    bf16x8 qn[4];
    if (EARLY_EXIT && w.wid == 0 && w.lane < 4) flg[w.lane] = 0;
    asm volatile("s_waitcnt vmcnt(0)" ::: "memory");
#define ATT_PRODUCE() do { if (pj < nun) { if (pk == 0) Mo.q_load(pd, w, qn); Mo.dma(pd, pk, pseq % NSLOT, w); ++pseq; if (++pk == pd.NT) { pk = 0; if (++pj < nun) Mo.desc(pj, pd); } } } while (0)
#pragma unroll 1
    for (int i = 0; i < AHEAD; ++i) ATT_PRODUCE();
#pragma unroll 1
    for (int cj = 0; cj < nun; ++cj) {
        UnitD d; Mo.desc(cj, d);
        bf16x8 qr[4];
        f32x16 o[2]; o[0] = f32x16{}; o[1] = f32x16{};
        Mo.begin(d, w);
        const int useq0 = cseq;
        int rep = 0;
#pragma unroll 1
        while (pseq - cseq < AHEAD && pj < nun) ATT_PRODUCE();
#pragma unroll 1
        for (int ck = 0; ck < d.NT; ++ck) {
            wait_bar(2 * (pseq - cseq - 1));
            if (ck == 0) { asm volatile("" : "+v"(qn[0]), "+v"(qn[1]), "+v"(qn[2]), "+v"(qn[3])); qr[0] = qn[0]; qr[1] = qn[1]; qr[2] = qn[2]; qr[3] = qn[3]; }
            if (EARLY_EXIT && ck == 1 && w.wid == 0 && w.lane < 2) flg[((cj + 1) & 1) * 2 + w.lane] = 0;
            if (EARLY_EXIT && ck > 0) {
                if (__builtin_amdgcn_readfirstlane(flg[(cj & 1) * 2 + ((ck - 1) & 1)]) == 8) {
                    const int uend = useq0 + d.NT;
                    if (pj == cj) { pk = 0; if (++pj < nun) Mo.desc(pj, pd); }
                    cseq = uend < pseq ? uend : pseq;
                    break; } }
            if (pseq - cseq < AHEAD) ATT_PRODUCE();
            Mo.compute(d, ck, cseq % NSLOT, w, qr, o);
            if (EARLY_EXIT && Mo.wave_done() && rep < 2) { if (w.lane == 0) __hip_atomic_fetch_add(&flg[(cj & 1) * 2 + (ck & 1)], 1, __ATOMIC_RELAXED, __HIP_MEMORY_SCOPE_WORKGROUP); ++rep; }
            ++cseq;
        }
        Mo.finish(d, w, o);
    }
    asm volatile("s_waitcnt vmcnt(0) lgkmcnt(0)\n\ts_barrier" ::: "memory");
#undef ATT_PRODUCE
}
__device__ __forceinline__ WaveCtx make_ctx(lptr shm) {
    WaveCtx w; const int tid = threadIdx.x; w.lane = tid & 63; w.r32 = w.lane & 31; w.hi = w.lane >> 5; w.wid = __builtin_amdgcn_readfirstlane(tid >> 6);
    w.shm = shm; w.lds0 = (unsigned)(uintptr_t)shm;
    w.vb0 = (int)(w.lds0 + L_V) + ((w.lane >> 4) & 1) * 32 + (w.lane & 3) * 8 + (4 * w.hi + ((w.lane & 15) >> 2)) * 64;
    return w;
}
template <int MODE>
__device__ __forceinline__ void causal_phase(lptr shm, int G, const bf16* Q, const bf16* K, const bf16* V, bf16* O, const float* cum, bool f8) {
    const int bx = blockIdx.x; const int vcu = (G % 8 == 0) ? (bx % 8) * (G / 8) + bx / 8 : bx;
    const WaveCtx w = make_ctx(shm);
    for (int u = vcu; u < BATCH * NH * 2; u += G) {
        CausalMode<MODE> Mo; Mo.Q = Q; Mo.K = K; Mo.V = V; Mo.O = O; Mo.f8 = f8; Mo.b = u >> 5; Mo.h = (u >> 1) & 15; Mo.p = u & 1;
        if (MODE == 2) {
            LAS float* kbl = (LAS float*)(shm + L_KB); LAS float* wtot = (LAS float*)(shm + L_FLG + 64);
            const int t4 = threadIdx.x * 4; float v0, v1, v2, v3;
            { const float* lp = cum + ((long)Mo.b * SEQ + t4) * 16 + Mo.h; v0 = lp[0]; v1 = lp[16]; v2 = lp[32]; v3 = lp[48]; }
            v1 += v0; v2 += v1; v3 += v2;
            float incl = v3;
#pragma unroll
            for (int o = 1; o < 64; o <<= 1) { const float t = __shfl_up(incl, o); if (w.lane >= o) incl += t; }
            if (w.lane == 63) wtot[w.wid] = incl;
            __syncthreads();
            float off = incl - v3;
#pragma unroll
            for (int x = 0; x < 8; ++x) off += (x < w.wid) ? wtot[x] : 0.f;
            *(LAS f32x4*)(kbl + t4) = (f32x4){-(off + v0), -(off + v1), -(off + v2), -(off + v3)};
        }
        stream_units<CausalMode<MODE>, MODE == 0>(Mo, w);
    }
}
__device__ __forceinline__ int t5_bucket_f(int dist) {
    if (dist < 16) return dist;
    int lb = 16 + (int)(logf((float)dist / 16.0f) / logf(128.0f) * 16.0f);
    return lb < 31 ? lb : 31;
}
__device__ __forceinline__ void dil_phase(lptr shm, int G, const bf16* PROJ, bf16* OG, float* ST, const float* rel_bias, int pass, bf16* Of) {
    const int bx = blockIdx.x; const int vcu = (G % 8 == 0) ? (bx % 8) * (G / 8) + bx / 8 : bx;
    const WaveCtx w = make_ctx(shm);
    for (int u = vcu; u < BATCH * NH * 2; u += G) {
        DilMode Mo; Mo.PROJ = PROJ; Mo.OG = OG; Mo.ST = ST; Mo.Of = Of; Mo.pass = pass; Mo.b = u >> 5; Mo.h = (u >> 1) & 15; Mo.p = u & 1;
        LAS float* tb = (LAS float*)(shm + L_KB);
        for (int i = threadIdx.x; i < 3 * 640; i += NTHR) { const int gg = i / 640, dl = i - gg * 640 - 256; const int dil = (gg == 0) ? 1 : (gg == 1) ? 4 : 16;
            tb[i] = (dl >= 0 && dl <= 128) ? rel_bias[t5_bucket_f(dl * dil) * 16 + Mo.h] * LOG2E : -INFINITY; }
        stream_units<DilMode, false>(Mo, w);
    }
}
__device__ __forceinline__ void dil_merge(int G, const bf16* OG, const float* ST, bf16* O) {
    for (int idx = blockIdx.x * NTHR + threadIdx.x; idx < M * NH; idx += G * NTHR) {
        const f32x2 s0 = *(const f32x2*)(ST + ((size_t)0 * M * NH + idx) * 2), s1 = *(const f32x2*)(ST + ((size_t)1 * M * NH + idx) * 2), s2 = *(const f32x2*)(ST + ((size_t)2 * M * NH + idx) * 2);
        const float mx = fmaxf(s0.x, fmaxf(s1.x, s2.x));
        float w0 = __builtin_amdgcn_exp2f(s0.x - mx) * s0.y, w1 = __builtin_amdgcn_exp2f(s1.x - mx) * s1.y, w2 = __builtin_amdgcn_exp2f(s2.x - mx) * s2.y;
        const float inv = 1.0f / (w0 + w1 + w2); w0 *= inv; w1 *= inv; w2 *= inv;
        const GAS v4u* a0 = (const GAS v4u*)(OG + (size_t)idx * 64); const GAS v4u* a1 = (const GAS v4u*)(OG + PLANE + (size_t)idx * 64); const GAS v4u* a2 = (const GAS v4u*)(OG + 2 * PLANE + (size_t)idx * 64);
        GAS v4u* op = (GAS v4u*)(O + (size_t)idx * 64);
#pragma unroll
        for (int c = 0; c < 8; ++c) { const v4u x0 = a0[c], x1 = a1[c], x2 = a2[c]; v4u r;
#pragma unroll
            for (int q = 0; q < 4; ++q) r[q] = pk2(w0 * bflo(x0[q]) + w1 * bflo(x1[q]) + w2 * bflo(x2[q]), w0 * bfhi(x0[q]) + w1 * bfhi(x1[q]) + w2 * bfhi(x2[q]));
            op[c] = r; }
    }
}
}

enum { CV_PLAIN = 0, CV_QKN = 1, CV_GATE = 2, CV_UP = 3 };
__device__ __forceinline__ int cv_dst_row(int mode, int n) {
    if (mode == CV_QKN) return (n & ~255) + 128 * ((n >> 5) & 1) + 32 * ((n >> 6) & 3) + (n & 31);
    if (mode == CV_GATE) return 256 * (n >> 7) + (n & 127);
    if (mode == CV_UP) return 256 * (n >> 7) + 128 + (n & 127);
    return n;
}
__device__ __forceinline__ void conv_item(const float* W, int ldw, int K, bf16* WT, int mode, LAS unsigned char* scr, int item, int nblk, int lane) {
    const int kb = item / nblk, nb = item - kb * nblk, k0 = 64 * kb, n0 = 64 * nb;
    const GAS float* src = (const GAS float*)(W + (size_t)k0 * ldw + n0 + lane);
#pragma unroll
    for (int kc = 0; kc < 8; ++kc) {
        float v[8];
#pragma unroll
        for (int j = 0; j < 8; ++j) v[j] = src[(size_t)(kc * 8 + j) * ldw];
        v4u w; w.x = pk2(v[0], v[1]); w.y = pk2(v[2], v[3]); w.z = pk2(v[4], v[5]); w.w = pk2(v[6], v[7]);
        *(LAS v4u*)(scr + lane * 144 + kc * 16) = w;
    }
    asm volatile("s_waitcnt lgkmcnt(0)" ::: "memory");
#pragma unroll
    for (int j = 0; j < 8; ++j) { const int n = 8 * j + (lane >> 3), ch = lane & 7;
        const v4u w = *(const LAS v4u*)(scr + n * 144 + ch * 16);
        *(GAS v4u*)(WT + (size_t)cv_dst_row(mode, n0 + n) * K + k0 + 8 * ch) = w; }
    asm volatile("s_waitcnt lgkmcnt(0)" ::: "memory");
}
__device__ __forceinline__ void conv_item8(const float* W, int ldw, int K, unsigned char* WT8, int mode, LAS unsigned char* scr, int item, int nblk, int lane) {
    const int kb = item / nblk, nb = item - kb * nblk, k0 = 128 * kb, n0 = 64 * nb;
    const GAS float* src = (const GAS float*)(W + (size_t)k0 * ldw + n0 + lane);
#pragma unroll 8
    for (int kc = 0; kc < 16; ++kc) {
        float v[8];
#pragma unroll
        for (int j = 0; j < 8; ++j) v[j] = src[(size_t)(kc * 8 + j) * ldw] * W8S;
        v2u w; w.x = pg8::cvt4_fp8(v[0], v[1], v[2], v[3]); w.y = pg8::cvt4_fp8(v[4], v[5], v[6], v[7]);
        *(LAS v2u*)(scr + lane * 144 + kc * 8) = w;
    }
    asm volatile("s_waitcnt lgkmcnt(0)" ::: "memory");
#pragma unroll
    for (int j = 0; j < 8; ++j) { const int n = 8 * j + (lane >> 3), ch = lane & 7;
        const v4u w = *(const LAS v4u*)(scr + n * 144 + ch * 16);
        *(GAS v4u*)(WT8 + (size_t)cv_dst_row(mode, n0 + n) * K + k0 + 16 * ch) = w; }
    asm volatile("s_waitcnt lgkmcnt(0)" ::: "memory");
}
static_assert(MOE_FP8 && DILIN_FP8 && FOXIN_FP8 && QKV3_FP8 && DENSE_FP8_L2 && !DENSE_FP8_L0, "the conversion queue is laid out for this precision plan");
constexpr int CV_TOTAL = 28608;
static_assert(WO_FP8, "the conversion queue below holds e4m3 Wo weights for layers 1-3");
constexpr int cv_need(int p) {
    return p >= 24 ? 28608 : p >= 23 ? 25024 : p >= 21 ? 17856 : p >= 19 ? 17728 : p >= 18 ? 17344 : p >= 17 ? 16896 : p >= 16 ? 16000 : p >= 14 ? 15872 : p >= 12 ? 15488
         : p >= 11 ? 11904 : p >= 9 ? 4736 : p >= 6 ? 4608 : p >= 5 ? 3712 : p >= 4 ? 2816 : p >= 3 ? 1024 : p >= 1 ? 768 : 0;
}
__device__ __forceinline__ void cv_run_item(Frame& F, int idx) {
    LAS unsigned char* scr = F.lds + F.wave * 9216;
    unsigned char* WB8 = F.ws + WS_W;
    int inp, ldw, K, N, mode = CV_PLAIN, it; size_t soff = 0, doff; bool f8 = false;
    if (idx < 768)        { it = idx;         inp = 1;  ldw = 3 * DM; K = DM; N = 3 * DM; doff = WE_QKV * 2; }
    else if (idx < 1024)  { it = idx - 768;   inp = 2;  ldw = DM; K = DM; N = DM; doff = WE_WO_SB * 2; }
    else if (idx < 2816)  { const int l = idx - 1024, u = l >= 896; it = l - 896 * u; inp = 15 + u; ldw = FF; K = DM; N = FF; doff = WE_GU * 2; mode = u ? CV_UP : CV_GATE; }
    else if (idx < 3712)  { it = idx - 2816;  inp = 17; ldw = DM; K = FF; N = DM; doff = WE_D * 2; }
    else if (idx < 4608)  { it = idx - 3712;  inp = 3;  ldw = 7 * DM; K = DM; N = 7 * DM; doff = WE_IN_DIL * 2; mode = CV_QKN; f8 = true; }
    else if (idx < 4736)  { it = idx - 4608;  inp = 6;  ldw = DM; K = DM; N = DM; doff = WE_WO_DIL * 2; f8 = true; }
    else if (idx < 15872) {
        if (idx < 11904)      { const int l = idx - 4736, fe = l / 896, r = l - fe * 896, u = r >= 448; it = r - 448 * u; inp = 19 + u; ldw = FF; K = DM; N = FF; soff = (size_t)fe * DM * FF;
                                doff = WE_MGU * 2 + (size_t)fe * 2 * FF * DM; mode = u ? CV_UP : CV_GATE; f8 = true; }
        else if (idx < 15488) { const int l = idx - 11904, fe = l / 448; it = l - fe * 448; inp = 21; ldw = DM; K = FF; N = DM; soff = (size_t)fe * FF * DM; doff = WE_MD * 2 + (size_t)fe * DM * FF; f8 = true; }
        else                  { it = idx - 15488; inp = 7; ldw = 3088; K = DM; N = 3 * DM; doff = WE_IN_FOX * 2; mode = CV_QKN; f8 = true; }
    }
    else if (idx < 16000) { it = idx - 15872; inp = 11; ldw = DM; K = DM; N = DM; doff = WE_WO_FOX * 2; f8 = true; }
    else if (idx < 16896) { const int l = idx - 16000, u = l >= 448; it = l - 448 * u; inp = 15 + u; ldw = FF; K = DM; N = FF; soff = (size_t)DM * FF; doff = (WE_GU + (size_t)2 * FF * DM) * 2; mode = u ? CV_UP : CV_GATE; f8 = true; }
    else if (idx < 17344) { it = idx - 16896; inp = 17; ldw = DM; K = FF; N = DM; soff = (size_t)FF * DM; doff = (WE_D + (size_t)DM * FF) * 2; f8 = true; }
    else if (idx < 17728) { it = idx - 17344; inp = 1;  ldw = 3 * DM; K = DM; N = 3 * DM; soff = (size_t)DM * 3 * DM; doff = (WE_QKV + (size_t)3 * DM * DM) * 2; f8 = true; }
    else if (idx < 17856) { it = idx - 17728; inp = 2;  ldw = DM; K = DM; N = DM; soff = (size_t)DM * DM; doff = (WE_WO_SB + (size_t)DM * DM) * 2; f8 = true; }
    else if (idx < 25024) { const int l = idx - 17856, fe = 8 + l / 896, r = l - (fe - 8) * 896, u = r >= 448; it = r - 448 * u; inp = 19 + u; ldw = FF; K = DM; N = FF; soff = (size_t)fe * DM * FF;
                            doff = WE_MGU * 2 + (size_t)fe * 2 * FF * DM; mode = u ? CV_UP : CV_GATE; f8 = true; }
    else                  { const int l = idx - 25024, fe = 8 + l / 448; it = l - (fe - 8) * 448; inp = 21; ldw = DM; K = FF; N = DM; soff = (size_t)fe * FF * DM; doff = WE_MD * 2 + (size_t)fe * DM * FF; f8 = true; }
    const float* src = inp_ptr(F, inp) + soff;
    if (f8) conv_item8(src, ldw, K, WB8 + doff, mode, scr, it, N / 64, F.lane);
    else conv_item(src, ldw, K, (bf16*)(WB8 + doff), mode, scr, it, N / 64, F.lane);
}
__device__ __forceinline__ void cv_drain(Frame& F, int need) {
    if (need <= 0) return;
    volatile LAS int* cw = (volatile LAS int*)(F.lds + MISC_OFF) + 16;
    unsigned* nxt = (unsigned*)(F.ctl + CW_CVQ);
    asm volatile("s_waitcnt vmcnt(0)" ::: "memory");
    for (;;) {
        __syncthreads();
        if (F.tid == 0) { int b = -1; if ((int)xb_ld(nxt) < need) b = (int)xb_add(nxt, 8u); cw[0] = b; }
        __syncthreads();
        const int base = cw[0];
        if (base < 0) break;
        if (base + F.wave < CV_TOTAL) cv_run_item(F, base + F.wave);
    }
}
__device__ __forceinline__ void xcd_barrier_steal(const XcdBarrier& b, Frame& F) {
    asm volatile("s_waitcnt vmcnt(0)" ::: "memory");
    __syncthreads();
    volatile LAS int* cw = (volatile LAS int*)(F.lds + MISC_OFF) + 16;
    unsigned* bar = b.bar; unsigned* nxt = (unsigned*)(F.ctl + CW_CVQ);
    unsigned gen = 0u, tg = 0u; int role = 0;
    if (threadIdx.x == 0) {
        __builtin_amdgcn_s_waitcnt(0);
        unsigned nloc = b.st[0], nx = b.st[1];
        if (nloc == 0u) { xcd_barrier_complete(bar, b.x, nloc, nx); b.st[0] = nloc; b.st[1] = nx; }
        const unsigned old = xb_add(&bar[XB_XSUB(b.x)], 1u);
        gen = old / nloc;
        if (old + 1u == (gen + 1u) * nloc) {
            __builtin_amdgcn_fence(__ATOMIC_RELEASE, "agent");
            asm volatile("s_waitcnt vmcnt(0)" ::: "memory");
            const unsigned og = xb_add(&bar[XB_TOP], 1u);
            tg = og / nx;
            if (og + 1u == (tg + 1u) * nx) { xb_add(&bar[XB_TOPGEN], 1u); xb_add(&bar[XB_XGEN(b.x)], 1u); role = 0; }
            else role = 1;
        } else role = 2;
    }
    for (;;) {
        if (threadIdx.x == 0) {
            int rel = 1, base = -1;
            if (role == 1) { XB_SPIN(xb_ld(&bar[XB_TOPGEN]) == tg, bar); xb_add(&bar[XB_XGEN(b.x)], 1u); role = 0; }
            else if (role == 2) { if (xb_ld(&bar[XB_XGEN(b.x)]) == gen) rel = 0; }
            if (!rel) {
                if ((int)xb_ld(nxt) < CV_TOTAL) base = (int)xb_add(nxt, 8u);
                else { XB_SPIN(xb_ld(&bar[XB_XGEN(b.x)]) == gen, bar); rel = 1; }
            }
            cw[0] = rel; cw[1] = base;
        }
        __syncthreads();
        const int rel = cw[0], base = cw[1];
        __syncthreads();
        if (rel) break;
        if (base >= 0 && base + F.wave < CV_TOTAL) cv_run_item(F, base + F.wave);
    }
    if (threadIdx.x == 0) { __builtin_amdgcn_fence(__ATOMIC_ACQUIRE, "agent"); asm volatile("s_waitcnt vmcnt(0)" ::: "memory"); }
    __syncthreads();
}

__device__ __forceinline__ int moe_cnt(Frame& F, int f, int e) {
    const unsigned long long w = __hip_atomic_load((GAS unsigned long long*)(F.ctl + CW_CNT + f * 64 + 16 * (e >> 2)), RLX_AGENT);
    return (int)((w >> (16 * (e & 3))) & 0xffffull);
}
__device__ __forceinline__ f32x4 moe_yrow(Frame& F, int r, int q4) {
    const bf16* Y = (const bf16*)(F.ws + WS_R2); const bf16* P = (const bf16*)(F.ws + WS_R2 + 72 * MiB);
    if (r < SPLIT_ROW0 || F.G != 256 || !MOE_SPLITK) {
        if (MOE_Y_FP8) { const int a = ((const GAS int*)((const unsigned char*)Y + (size_t)r * DM))[q4]; const f32x2 lo = __builtin_amdgcn_cvt_pk_f32_fp8(a, false), hi = __builtin_amdgcn_cvt_pk_f32_fp8(a, true);
            return (f32x4){lo.x, lo.y, hi.x, hi.y} * (1.0f / Y8S); }
        const v2u a = ((const GAS v2u*)(Y + (size_t)r * DM))[q4]; return (f32x4){bflo(a.x), bfhi(a.x), bflo(a.y), bfhi(a.y)}; }
    f32x4 s = (f32x4){0.f, 0.f, 0.f, 0.f};
#pragma unroll
    for (int k = 0; k < MOE_NSPLIT; ++k) { const v2u a = ((const GAS v2u*)(P + ((size_t)k * SPLIT_ROWS + (size_t)(r - SPLIT_ROW0)) * DM))[q4]; s = s + (f32x4){bflo(a.x), bfhi(a.x), bflo(a.y), bfhi(a.y)}; }
    return s;
}
__device__ __forceinline__ void moe_bases(Frame& F, int f, int (&tb)[NE + 1]) {
    int acc = 0;
#pragma unroll
    for (int e = 0; e < NE; ++e) { tb[e] = acc; const int c = moe_cnt(F, f, e); acc += (c + 255) >> 8; }
    tb[NE] = acc;
}

template <int NC>
__device__ __forceinline__ float wave_reduce_cols(float (&part)[NC], int lane) {
#pragma unroll
    for (int st = 0, n = NC / 2; n >= 1; ++st, n >>= 1) {
        const bool up = (lane >> st) & 1;
#pragma unroll
        for (int i = 0; i < n; ++i) { const float keep = up ? part[i + n] : part[i], send = up ? part[i] : part[i + n]; part[i] = keep + __shfl_xor(send, 1 << st); }
    }
    float v = part[0];
#pragma unroll
    for (int o = NC; o < 64; o <<= 1) v += __shfl_xor(v, o);
    return v;
}
template <int NC> __device__ __forceinline__ int lane_of_col(int c) {
    int l = 0;
#pragma unroll
    for (int st = 0, n = NC / 2; n >= 1; ++st, n >>= 1) { if (c & n) l |= 1 << st; }
    return l;
}
__device__ __forceinline__ void panel_sync(Frame& F, const pg8::DenseOrder& S, unsigned* cnt) {
    if (F.tid == 0) {
        unsigned* bar = (unsigned*)(F.ctl + CW_BAR);
        const unsigned x = xb_xcc_id();
        bool mixed = false; pg8::Unit u;
        for (int i = 0; S.next(i, u); ++i) { unsigned w = 0u; XB_SPIN(((w = xb_ld(&cnt[u.pm])) & 15u) < 4u, bar); if (x >= 8u || ((w >> (4 + 3 * x)) & 7u) != 4u) mixed = true; }
        if (mixed) {
            __builtin_amdgcn_fence(__ATOMIC_RELEASE, "agent");
            asm volatile("s_waitcnt vmcnt(0)" ::: "memory");
            for (int i = 0; S.next(i, u); ++i) { const unsigned w = xb_ld(&cnt[u.pm]); if (x >= 8u || ((w >> (4 + 3 * x)) & 7u) != 4u) xb_add(&cnt[6 * 64 + u.pm], 1u); }
            for (int i = 0; S.next(i, u); ++i) { const unsigned w = xb_ld(&cnt[u.pm]); if (x >= 8u || ((w >> (4 + 3 * x)) & 7u) != 4u) XB_SPIN(xb_ld(&cnt[6 * 64 + u.pm]) < 4u, bar); }
        }
        __builtin_amdgcn_fence(__ATOMIC_ACQUIRE, "agent");
        asm volatile("s_waitcnt vmcnt(0)" ::: "memory");
    }
    __syncthreads();
}
template <int FLAGS>
__device__ __forceinline__ void norm_phase(Frame& F, const void* xin, void* xout, const float* gain, bf16* H, int fprev, int f,
                                           const float* Wf  , const float* bf  , const float* Wr  ,
                                           const pg8::DenseOrder* PS = nullptr, unsigned* pcnt = nullptr) {
    constexpr int NC = (FLAGS & 2) ? 16 : (FLAGS & 4) ? 8 : 0;
    const bf16* Y = (const bf16*)(F.ws + WS_R2);
    const int* tok_prev = (const int*)(F.ws + WS_MISC + MS_TOK) + (size_t)fprev * M * 2;
    float* lgf = (float*)(F.ws + WS_MISC + MS_LOGF);
    LAS int* sel = (LAS int*)F.lds;
    LAS float* sg = (LAS float*)(F.lds + 512);
    LAS int* gb = (LAS int*)(F.lds + 1536);
    LAS f32x4* WL = (LAS f32x4*)(F.lds + 4096);
    int tb[NE + 1];
    if (FLAGS & 1) moe_bases(F, fprev, tb);
    if (NC) {
        const float* Wsrc = (FLAGS & 2) ? Wf + 3072 : Wr; const int ldw = (FLAGS & 2) ? 3088 : 8;
        for (int idx = F.tid; idx < 16 * (NC / 4) * 64; idx += NTHR) {
            const int ln = idx & 63, cq = (idx >> 6) % (NC / 4), jq = idx / (64 * (NC / 4)), k = 4 * (ln + 64 * (jq >> 2)) + (jq & 3);
            WL[idx] = *(const GAS f32x4*)(Wsrc + (size_t)k * ldw + 4 * cq) * gain[k];
        }
        __syncthreads();
    }
    if (NC == 0 && !(FLAGS & 1)) {
        if (FLAGS & 64) panel_sync(F, *PS, pcnt);
        for (int it = 0;; ++it) {
            int chunk;
            if (FLAGS & 64) { pg8::Unit pu; if (!PS->next(it, pu)) break; chunk = pu.pm * 4 + pu.pn; }
            else { chunk = blockIdx.x + it * F.G; if (chunk >= M / 64) break; }
#pragma unroll 1
            for (int i = 0; i < 8; i += 4) {
                const int m0 = chunk * 64 + F.wave * 8 + i;
                int ln = F.lane; asm volatile("" : "+v"(ln));
                f32x4 v[4][4];
#pragma unroll
                for (int r = 0; r < 4; ++r) {
                    if (FLAGS & 16) { const GAS v2u* xr = (const GAS v2u*)((const bf16*)xin + (size_t)(m0 + r) * DM) + ln;
#pragma unroll
                        for (int j = 0; j < 4; ++j) { const v2u a = xr[64 * j]; v[r][j] = (f32x4){bflo(a.x), bfhi(a.x), bflo(a.y), bfhi(a.y)}; } }
                    else { const GAS f32x4* xr = (const GAS f32x4*)((const float*)xin + (size_t)(m0 + r) * DM) + ln;
#pragma unroll
                        for (int j = 0; j < 4; ++j) v[r][j] = xr[64 * j]; }
                }
                f32x4 g[4];
#pragma unroll
                for (int j = 0; j < 4; ++j) g[j] = ((const GAS f32x4*)gain + ln)[64 * j];
#pragma unroll
                for (int r = 0; r < 4; ++r) {
                    const int m = m0 + r;
                    if (FLAGS & 32) {
#pragma unroll
                        for (int j = 0; j < 4; ++j) ((GAS v2u*)((bf16*)xout + (size_t)m * DM) + ln)[64 * j] = (v2u){pk2(v[r][j].x, v[r][j].y), pk2(v[r][j].z, v[r][j].w)}; }
                    float s = 0.f;
#pragma unroll
                    for (int j = 0; j < 4; ++j) s += (v[r][j].x * v[r][j].x + v[r][j].y * v[r][j].y) + (v[r][j].z * v[r][j].z + v[r][j].w * v[r][j].w);
                    const float inv = 1.0f / sqrtf(wave_sum(s) * (1.f / DM) + RMS_EPS);
                    GAS unsigned long long* o8 = (GAS unsigned long long*)(H + (size_t)m * DM) + ln;
                    GAS unsigned* h8 = (GAS unsigned*)(F.ws + WS_R2 + 104 * MiB + (size_t)m * DM) + ln;
#pragma unroll
                    for (int j = 0; j < 4; ++j) { const f32x4 hv = v[r][j] * inv * g[j];
                        if (FLAGS & 8) h8[64 * j] = pg8::cvt4_fp8(hv.x, hv.y, hv.z, hv.w);
                        else o8[64 * j] = (unsigned long long)pk2(hv.x, hv.y) | ((unsigned long long)pk2(hv.z, hv.w) << 32); }
                }
            }
        }
        return;
    }
    if (FLAGS & 64) panel_sync(F, *PS, pcnt);
    for (int it = 0;; ++it) {
        int chunk;
        if (FLAGS & 64) { pg8::Unit pu; if (!PS->next(it, pu)) break; chunk = pu.pm * 4 + pu.pn; }
        else { chunk = blockIdx.x + it * F.G; if (chunk >= M / 64) break; }
        for (int i = 0; i < 8; ++i) {
            const int m = chunk * 64 + F.wave * 8 + i;
            int ln = F.lane; asm volatile("" : "+v"(ln));
            f32x4 v[4];
            if (FLAGS & 16) { const GAS v2u* xr = (const GAS v2u*)((const bf16*)xin + (size_t)m * DM) + ln;
#pragma unroll
                for (int j = 0; j < 4; ++j) { const v2u a = xr[64 * j]; v[j] = (f32x4){bflo(a.x), bfhi(a.x), bflo(a.y), bfhi(a.y)}; } }
            else { const GAS f32x4* xr = (const GAS f32x4*)((const float*)xin + (size_t)m * DM) + ln;
#pragma unroll
                for (int j = 0; j < 4; ++j) v[j] = xr[64 * j]; }
            if (FLAGS & 1) {
                const int s0 = tok_prev[m * 2], s1 = tok_prev[m * 2 + 1];
                int r0 = 0, r1 = 0;
#pragma unroll
                for (int e = 0; e < NE; ++e) { if ((s0 >> 14) == e) r0 = tb[e] * 256 + (s0 & 16383); if ((s1 >> 14) == e) r1 = tb[e] * 256 + (s1 & 16383); }
#pragma unroll
                for (int j = 0; j < 4; ++j) { v[j] = v[j] + moe_yrow(F, r0, ln + 64 * j) + moe_yrow(F, r1, ln + 64 * j);
                    ((GAS v2u*)((bf16*)xout + (size_t)m * DM) + ln)[64 * j] = (v2u){pk2(v[j].x, v[j].y), pk2(v[j].z, v[j].w)}; }
            }
            if (FLAGS & 32) {
#pragma unroll
                for (int j = 0; j < 4; ++j) ((GAS v2u*)((bf16*)xout + (size_t)m * DM) + ln)[64 * j] = (v2u){pk2(v[j].x, v[j].y), pk2(v[j].z, v[j].w)}; }
            float s = 0.f;
#pragma unroll
            for (int j = 0; j < 4; ++j) s += (v[j].x * v[j].x + v[j].y * v[j].y) + (v[j].z * v[j].z + v[j].w * v[j].w);
            const float inv = 1.0f / sqrtf(wave_sum(s) * (1.f / DM) + RMS_EPS);
            float colv = 0.f;
            if (NC) {
                float part[NC ? NC : 1];
#pragma unroll
                for (int c = 0; c < NC; ++c) part[c] = 0.f;
                const int woff = ln;
#pragma unroll
                for (int j = 0; j < 4; ++j) {
#pragma unroll
                    for (int q = 0; q < 4; ++q) { const float xv = v[j][q];
#pragma unroll
                        for (int cq = 0; cq < NC / 4; ++cq) { const f32x4 w = WL[((j * 4 + q) * (NC / 4) + cq) * 64 + woff];
                            part[cq * 4 + 0] += xv * w.x; part[cq * 4 + 1] += xv * w.y; part[cq * 4 + 2] += xv * w.z; part[cq * 4 + 3] += xv * w.w; }
                        if ((q & 1) == 1) asm volatile("" ::: "memory"); } }
                colv = wave_reduce_cols<NC ? NC : 2>(reinterpret_cast<float (&)[NC ? NC : 2]>(part), ln) * inv;
            }
            if (H) {
                GAS unsigned long long* o8 = (GAS unsigned long long*)(H + (size_t)m * DM) + ln;
                GAS unsigned* h8 = (GAS unsigned*)(F.ws + WS_R2 + 104 * MiB + (size_t)m * DM) + ln;
#pragma unroll
                for (int j = 0; j < 4; ++j) { const f32x4 g = ((const GAS f32x4*)gain + ln)[64 * j]; const f32x4 hv = v[j] * inv * g;
                    if (((FLAGS & 4) && MOE_FP8) || (FLAGS & 8)) h8[64 * j] = pg8::cvt4_fp8(hv.x, hv.y, hv.z, hv.w);
                    else o8[64 * j] = (unsigned long long)pk2(hv.x, hv.y) | ((unsigned long long)pk2(hv.z, hv.w) << 32); }
            }
            if (FLAGS & 2) {
                if (ln < 16) { const int l = ln; const int c = ((l & 1) << 3) | ((l & 2) << 1) | ((l & 4) >> 1) | ((l & 8) >> 3);
                    const float z = colv + bf[c]; const float ls = fminf(z, 0.f) - log1pf(expf(-fabsf(z))); lgf[(size_t)m * 16 + c] = ls * LOG2E; }
            }
            if (FLAGS & 4) {
                float lg[8];
#pragma unroll
                for (int c = 0; c < 8; ++c) lg[c] = __builtin_bit_cast(float, __builtin_amdgcn_readlane(__builtin_bit_cast(int, colv), lane_of_col<8>(c)));
                int e0 = 0; float l0 = lg[0];
#pragma unroll
                for (int c = 1; c < 8; ++c) if (lg[c] > l0) { l0 = lg[c]; e0 = c; }
                int e1 = -1; float l1 = -INFINITY;
#pragma unroll
                for (int c = 0; c < 8; ++c) if (c != e0 && lg[c] > l1) { l1 = lg[c]; e1 = c; }
                const float g0 = 1.0f / (1.0f + expf(l1 - l0)), g1 = 1.0f - g0;
                if (ln == 0) { const int r = F.wave * 8 + i; sel[r * 2] = e0; sel[r * 2 + 1] = e1; sg[r * 2] = g0; sg[r * 2 + 1] = g1; }
            }
        }
        if (FLAGS & 4) {
            int* selg = (int*)(F.ws + WS_MISC + MS_SEL) + (size_t)f * M * 2;
            float* sgg = (float*)(F.ws + WS_MISC + MS_SG) + (size_t)f * M * 2;
            int* lcn = (int*)(F.ws + WS_MISC + MS_LC) + (size_t)f * 256 * 8;
            __syncthreads();
            if (F.tid < 128) { selg[chunk * 128 + F.tid] = sel[F.tid]; sgg[chunk * 128 + F.tid] = sg[F.tid]; }
            if (F.tid >= 128 && F.tid < 136) { const int e = F.tid - 128; int c = 0;
                for (int q = 0; q < 128; ++q) c += (sel[q] == e) ? 1 : 0;
                lcn[chunk * 8 + e] = c; }
            __syncthreads();
        }
    }
}

__device__ __forceinline__ void moe_finalize(Frame& F, int f) {
    const int* selg = (const int*)(F.ws + WS_MISC + MS_SEL) + (size_t)f * M * 2;
    const float* sgg = (const float*)(F.ws + WS_MISC + MS_SG) + (size_t)f * M * 2;
    const int* lcn = (const int*)(F.ws + WS_MISC + MS_LC) + (size_t)f * 256 * 8;
    int* list = (int*)(F.ws + WS_MISC + MS_LIST) + (size_t)f * NE * LCAP;
    float* gw = (float*)(F.ws + WS_MISC + MS_GW) + (size_t)f * NE * LCAP;
    int* tok = (int*)(F.ws + WS_MISC + MS_TOK) + (size_t)f * M * 2;
    LAS int* arr = (LAS int*)F.lds;
    LAS int* sel = (LAS int*)(F.lds + 8192);
    LAS int* pb = (LAS int*)(F.lds + 8192 + 512);
    LAS int* pt = (LAS int*)(F.lds + 8192 + 1536);
    LAS int* base = (LAS int*)(F.lds + 8192 + 2560);
    LAS int* tot = (LAS int*)(F.lds + 8192 + 2592);
    for (int chunk = blockIdx.x; chunk < M / 64; chunk += F.G) {
        if (F.tid < 256) { const v4u a = *(const GAS v4u*)(lcn + F.tid * 8), b = *(const GAS v4u*)(lcn + F.tid * 8 + 4);
            *(LAS v4u*)(arr + F.tid * 8) = a; *(LAS v4u*)(arr + F.tid * 8 + 4) = b; }
        if (F.tid < 128) sel[F.tid] = selg[chunk * 128 + F.tid];
        __syncthreads();
        if (F.tid < 256) { const int e = F.tid & 7, seg = F.tid >> 3; int b = 0, t = 0;
#pragma unroll
            for (int i = 0; i < 8; ++i) { const int c = seg * 8 + i; const int v = arr[c * 8 + e]; t += v; b += (c < chunk) ? v : 0; }
            pb[seg * 8 + e] = b; pt[seg * 8 + e] = t; }
        __syncthreads();
        if (F.tid < 8) { int b = 0, t = 0;
            for (int sgm = 0; sgm < 32; ++sgm) { b += pb[sgm * 8 + F.tid]; t += pt[sgm * 8 + F.tid]; }
            base[F.tid] = b; tot[F.tid] = t; }
        __syncthreads();
        if (F.tid < 128) { const int mye = sel[F.tid]; int lp = 0;
            for (int q = 0; q < 128; ++q) lp += (q < F.tid && sel[q] == mye) ? 1 : 0;
            const int q = F.tid, row = chunk * 64 + (q >> 1), pos = base[mye] + lp;
            list[mye * LCAP + pos] = row; gw[mye * LCAP + pos] = sgg[chunk * 128 + q]; tok[row * 2 + (q & 1)] = mye * LCAP + pos; }
        if (chunk == 0 && F.tid < 2) { unsigned long long w = 0ull;
#pragma unroll
            for (int i = 0; i < 4; ++i) w |= (unsigned long long)(unsigned)tot[4 * F.tid + i] << (16 * i);
            __hip_atomic_store((GAS unsigned long long*)(F.ctl + CW_CNT + f * 64 + 16 * F.tid), w, RLX_AGENT); }
        __syncthreads();
    }
}

__device__ __forceinline__ void final_combine(Frame& F, int f) {
    const bf16* Y = (const bf16*)(F.ws + WS_R2);
    const int* tok = (const int*)(F.ws + WS_MISC + MS_TOK) + (size_t)f * M * 2;
    int tb[NE + 1]; moe_bases(F, f, tb);
    for (int m = blockIdx.x * NWAVES + F.wave; m < M; m += F.G * NWAVES) {
        const int s0 = tok[m * 2], s1 = tok[m * 2 + 1]; int r0 = 0, r1 = 0;
#pragma unroll
        for (int e = 0; e < NE; ++e) { if ((s0 >> 14) == e) r0 = tb[e] * 256 + (s0 & 16383); if ((s1 >> 14) == e) r1 = tb[e] * 256 + (s1 & 16383); }
        GAS f32x4* xo = (GAS f32x4*)(F.out + (size_t)m * DM) + F.lane;
        const GAS v2u* xr = (const GAS v2u*)((const bf16*)(F.ws + WS_XB) + (size_t)m * DM) + F.lane;
#pragma unroll
        for (int j = 0; j < 4; ++j) { const v2u a = xr[64 * j]; xo[64 * j] = (f32x4){bflo(a.x), bfhi(a.x), bflo(a.y), bfhi(a.y)} + moe_yrow(F, r0, F.lane + 64 * j) + moe_yrow(F, r1, F.lane + 64 * j); }
    }
}

template <int NB> __device__ __forceinline__ void stagger_convert(Frame& F) {
    if ((((int)blockIdx.x >> 3) & 1) == 0) return;
    volatile LAS int* cw = (volatile LAS int*)(F.lds + MISC_OFF) + 16;
    unsigned* nxt = (unsigned*)(F.ctl + CW_CVQ);
    for (int r = 0; r < NB; ++r) {
        __syncthreads();
        if (F.tid == 0) { int b = -1; if ((int)xb_ld(nxt) < CV_TOTAL) b = (int)xb_add(nxt, 8u); cw[0] = b; }
        __syncthreads();
        const int base = cw[0];
        if (base < 0) break;
        if (base + F.wave < CV_TOTAL) cv_run_item(F, base + F.wave);
    }
    __syncthreads();
}
template <class Epi, bool FP8 = false>
__device__ __forceinline__ void dense_gemm(Frame& F, const bf16* A, const bf16* Bt, int N, int K, const Epi& E) {
    pg8::DenseOrder S; S.init(A, Bt, M, N, K, F.G, (int)blockIdx.x);
    pg8::gemm_phase<Epi, pg8::DenseOrder, false, FP8>(F.lds, K, S, E);
}
template <int NFLAGS, class Epi, bool FP8 = false>
__device__ __forceinline__ void resid_gemm_norm(Frame& F, int site, const bf16* A, const bf16* Bt, int K, const Epi& E, const void* X, const float* gain, bf16* H, int f, const float* Wr) {
    pg8::DenseOrder S; S.init(A, Bt, M, DM, K, F.G, (int)blockIdx.x);
    pg8::gemm_phase<Epi, pg8::DenseOrder, false, FP8>(F.lds, K, S, E);
    unsigned* cnt = (unsigned*)(F.ctl + CW_PANEL + site * 64);
    asm volatile("s_waitcnt vmcnt(0)" ::: "memory");
    __syncthreads();
    if (F.tid == 0) {
        const unsigned x = xb_xcc_id(); pg8::Unit u;
        for (int i = 0; S.next(i, u); ++i) xb_add(&cnt[u.pm], 1u + (x < 8u ? (1u << (4 + 3 * x)) : 0u));
    }
    norm_phase<NFLAGS | 16 | 64>(F, X, nullptr, gain, H, 0, f, nullptr, nullptr, Wr, &S, cnt);
}
__device__ __forceinline__ void moe_order_init(Frame& F, int f, pg8::MoeOrder& S) {
    int acc = 0, t[NE];
#pragma unroll
    for (int e = 0; e < NE; ++e) { const int c = moe_cnt(F, f, e); acc += (c + 255) >> 8; t[e] = acc; }
    S.t1 = t[0]; S.t2 = t[1]; S.t3 = t[2]; S.t4 = t[3]; S.t5 = t[4]; S.t6 = t[5]; S.t7 = t[6]; S.t8 = t[7];
    S.G = F.G; S.c = (int)blockIdx.x;
}
__device__ __forceinline__ void moe_gu_fast(Frame& F, int f, const bf16* H, bf16* ACT) {
    pg8::MoeOrder S; moe_order_init(F, f, S);
    S.list = (const int*)(F.ws + WS_MISC + MS_LIST) + (size_t)f * NE * LCAP; S.gather = true; S.splitk = 0; S.xcdperm = false; S.nN = 2 * FF / 256;
    if (MOE_FP8) {
        S.K = DM / 2; S.A = (const char*)(F.ws + WS_R2 + 104 * MiB); S.Bt = (const char*)((const bf16*)(F.ws + WS_W) + WE_MGU) + (size_t)f * NE * 2 * FF * DM;
        S.tstepA = (size_t)256 * DM; S.tstepB = (size_t)256 * DM; S.estepB = (size_t)2 * FF * DM;
        pg8::EpiSwigluF8 E{(unsigned char*)ACT};
        pg8::gemm_phase<pg8::EpiSwigluF8, pg8::MoeOrder, true, true>(F.lds, DM / 2, S, E);
    } else {
        S.K = DM; S.A = (const char*)H; S.Bt = (const char*)((const bf16*)(F.ws + WS_W) + WE_MGU + (size_t)f * NE * 2 * FF * DM);
        S.tstepA = (size_t)256 * DM * 2; S.tstepB = (size_t)256 * DM * 2; S.estepB = (size_t)2 * FF * DM * 2;
        pg8::EpiSwiglu E{ACT};
        pg8::gemm_phase<pg8::EpiSwiglu, pg8::MoeOrder, true>(F.lds, DM, S, E);
    }
}
__device__ __forceinline__ void moe_down_fast(Frame& F, int f, const bf16* ACT, bf16* Y) {
    pg8::MoeOrder S; moe_order_init(F, f, S);
    S.nN = DM / 256; S.list = nullptr; S.gather = false; S.xcdperm = (F.G == 256); S.splitk = (MOE_SPLITK && F.G == 256) ? MOE_NSPLIT : 0;
    const float* gwp = (const float*)(F.ws + WS_MISC + MS_GW) + (size_t)f * NE * LCAP; bf16* P = (bf16*)(F.ws + WS_R2 + 72 * MiB);
    if (MOE_FP8) {
        S.K = FF / 2; S.A = (const char*)ACT; S.Bt = (const char*)((const bf16*)(F.ws + WS_W) + WE_MD) + (size_t)f * NE * DM * FF;
        S.tstepA = (size_t)256 * FF; S.tstepB = (size_t)256 * FF; S.estepB = (size_t)DM * FF;
        pg8::EpiMoeDown E{Y, gwp, P, 1.0f / (W8S * A8S)};
        pg8::gemm_phase<pg8::EpiMoeDown, pg8::MoeOrder, false, true>(F.lds, FF / 2, S, E);
    } else {
        S.K = FF; S.A = (const char*)ACT; S.Bt = (const char*)((const bf16*)(F.ws + WS_W) + WE_MD + (size_t)f * NE * DM * FF);
        S.tstepA = (size_t)256 * FF * 2; S.tstepB = (size_t)256 * FF * 2; S.estepB = (size_t)DM * FF * 2;
        pg8::EpiMoeDown E{Y, gwp, P, 1.0f};
        pg8::gemm_phase<pg8::EpiMoeDown, pg8::MoeOrder, false>(F.lds, FF, S, E);
    }
}

struct Args { const float* in[22]; float* out; unsigned char* ws; int ph_lo, ph_hi; };
constexpr int N_PHASES = 26;

__global__ void __launch_bounds__(NTHR, 2) trunk_fwd(Args args) {
    extern __shared__ __attribute__((aligned(16))) unsigned char lds[];
    Frame F;
    F.lds = (LAS unsigned char*)lds;
    F.tid = threadIdx.x; F.lane = F.tid & 63; F.wave = __builtin_amdgcn_readfirstlane(F.tid >> 6); F.G = gridDim.x;
    F.ws = args.ws; F.ctl = (gu32*)(args.ws + WS_CTL); F.out = args.out;
    if (F.tid == 0) {
#pragma unroll
        for (int i = 0; i < 22; ++i) ((LAS unsigned long long*)(F.lds + PTR_OFF))[i] = (unsigned long long)args.in[i];
    }
    volatile LAS unsigned* MISC = (volatile LAS unsigned*)(F.lds + MISC_OFF);
    if (F.tid < 32) MISC[F.tid] = 0u;
    __syncthreads();
    XcdBarrier bar; bar.bar = (unsigned*)(F.ctl + CW_BAR); bar.x = 0; bar.st = nullptr;
    const int lo = args.ph_lo, hi = args.ph_hi;
    if (hi - lo > 1) bar = xcd_barrier_post((unsigned*)(F.ctl + CW_BAR), MISC + 8);
#ifndef PHSEL
#define PHSEL 0xFFFFFFFFFFFFFFFFull
#endif
#define IN(k) (lo <= (k) && (k) < hi && ((PHSEL >> (k)) & 1ull) && relaunder(F))
#define SEAM(k) do { if (IN((k) + 1) && IN(k)) xcd_barrier_steal(bar, F); } while (0)
#ifndef DUPMASK
#define DUPMASK 0ull
#endif
#define DUP(k) (((DUPMASK >> (k)) & 1ull) != 0ull)

    bf16* H = (bf16*)(F.ws + WS_H);
    bf16* PROJ = (bf16*)(F.ws + WS_R1);
    bf16* ACT = (bf16*)(F.ws + WS_R1);
    bf16* O = (bf16*)(F.ws + WS_R2);
    bf16* Y = (bf16*)(F.ws + WS_R2);
    bf16* OG = (bf16*)(F.ws + WS_R2 + 32 * MiB);
    float* ST = (float*)(F.ws + WS_R2 + 128 * MiB);
    bf16* X = (bf16*)(F.ws + WS_XB);
    const bf16* H8 = (const bf16*)(F.ws + WS_R2 + 104 * MiB);
    float* DUMMY = (float*)(F.ws + WS_R2 + 32 * MiB);
    const float* cum = (const float*)(F.ws + WS_MISC + MS_LOGF);

    const bf16* WB = (const bf16*)(F.ws + WS_W);
    enum { PH_BASE = __COUNTER__ + 1 };
#define PHASE(...) { constexpr int k_ = __COUNTER__ - PH_BASE; if (IN(k_)) { __VA_ARGS__; cv_drain(F, cv_need(k_ + 1)); SEAM(k_); } }
    PHASE({ unsigned* z = (unsigned*)(F.ws + WS_MISC + MS_LIST);
            for (int i = blockIdx.x * NTHR + F.tid; i < (int)(2 * MiB / 4); i += F.G * NTHR) z[i] = 0u;
            norm_phase<32>(F, INP(0), X, INP(13) + 0 * DM, H, 0, 0, nullptr, nullptr, nullptr); })
    PHASE({ stagger_convert<1>(F); pg8::EpiPlanes E{PROJ, C2, 1.0f}; dense_gemm(F, H, WB + WE_QKV, 3 * DM, DM, E); })
    PHASE(att::causal_phase<0>((att::lptr)F.lds, F.G, PROJ, PROJ + PLANE, PROJ + 2 * PLANE, O, nullptr, false))
    PHASE({ pg8::EpiResid<false> E{X, X, 1.0f}; resid_gemm_norm<(DENSE_FP8_L0 ? 8 : 0)>(F, 0, O, WB + WE_WO_SB, DM, E, X, INP(14) + 0 * DM, H, 0, nullptr); })
    PHASE({ stagger_convert<1>(F);
            if (DENSE_FP8_L0) { pg8::EpiSwigluF8 E{(unsigned char*)ACT}; dense_gemm<pg8::EpiSwigluF8, true>(F, H8, (const bf16*)((const unsigned char*)(WB + WE_GU)), 2 * FF, DM / 2, E); }
            else { pg8::EpiSwiglu E{ACT}; dense_gemm(F, H, WB + WE_GU, 2 * FF, DM, E); } })
    PHASE({ if (DENSE_FP8_L0) { pg8::EpiResid<false> E{X, X, 1.0f / (W8S * A8S)}; resid_gemm_norm<(DILIN_FP8 ? 8 : 0), pg8::EpiResid<false>, true>(F, 1, ACT, (const bf16*)((const unsigned char*)(WB + WE_D)), FF / 2, E, X, INP(13) + 1 * DM, H, 0, nullptr); }
            else { pg8::EpiResid<false> E{X, X, 1.0f}; resid_gemm_norm<(DILIN_FP8 ? 8 : 0)>(F, 1, ACT, WB + WE_D, FF, E, X, INP(13) + 1 * DM, H, 0, nullptr); } })
    PHASE({ stagger_convert<1>(F);
            if (DILIN_FP8) { pg8::EpiQKNorm E{PROJ, INP(4), INP(5), 6, 1.0f / W8S}; dense_gemm<pg8::EpiQKNorm, true>(F, H8, WB + WE_IN_DIL, 7 * DM, DM / 2, E); }
            else { pg8::EpiQKNorm E{PROJ, INP(4), INP(5), 6, 1.0f}; dense_gemm(F, H, WB + WE_IN_DIL, 7 * DM, DM, E); } })
    PHASE(att::dil_phase((att::lptr)F.lds, F.G, PROJ, OG, ST, INP(12), 0, O))
    PHASE(att::dil_phase((att::lptr)F.lds, F.G, PROJ, OG, ST, INP(12), 1, O))
    PHASE({ if (WO_FP8) { pg8::EpiResid<false> E{X, X, 1.0f / (W8S * A8S)}; resid_gemm_norm<4, pg8::EpiResid<false>, true>(F, 2, O, WB + WE_WO_DIL, DM / 2, E, X, INP(14) + 1 * DM, H, 0, INP(18) + 0 * DM * NE); }
            else { pg8::EpiResid<false> E{X, X, 1.0f}; resid_gemm_norm<4>(F, 2, O, WB + WE_WO_DIL, DM, E, X, INP(14) + 1 * DM, H, 0, INP(18) + 0 * DM * NE); } })
    PHASE(moe_finalize(F, 0))
    PHASE({ stagger_convert<1>(F); moe_gu_fast(F, 0, H, ACT); })
    PHASE(moe_down_fast(F, 0, ACT, Y))
    PHASE(norm_phase<(1 | 2 | (FOXIN_FP8 ? 8 : 0)) | 16>(F, X, X, INP(13) + 2 * DM, H, 0, 0, INP(7), INP(8), nullptr))
    PHASE({ stagger_convert<1>(F);
            if (FOXIN_FP8) { pg8::EpiQKNorm E{PROJ, INP(9), INP(10), 2, 1.0f / W8S}; dense_gemm<pg8::EpiQKNorm, true>(F, H8, WB + WE_IN_FOX, 3 * DM, DM / 2, E); }
            else { pg8::EpiQKNorm E{PROJ, INP(9), INP(10), 2, 1.0f}; dense_gemm(F, H, WB + WE_IN_FOX, 3 * DM, DM, E); } })
    PHASE(att::causal_phase<2>((att::lptr)F.lds, F.G, PROJ, PROJ + PLANE, PROJ + 2 * PLANE, O, cum, WO_FP8))
    PHASE({ if (WO_FP8) { pg8::EpiResid<false> E{X, X, 1.0f / (W8S * A8S)}; resid_gemm_norm<(DENSE_FP8_L2 ? 8 : 0), pg8::EpiResid<false>, true>(F, 3, O, WB + WE_WO_FOX, DM / 2, E, X, INP(14) + 2 * DM, H, 0, nullptr); }
            else { pg8::EpiResid<false> E{X, X, 1.0f}; resid_gemm_norm<(DENSE_FP8_L2 ? 8 : 0)>(F, 3, O, WB + WE_WO_FOX, DM, E, X, INP(14) + 2 * DM, H, 0, nullptr); } })
    PHASE({ stagger_convert<1>(F);
            if (DENSE_FP8_L2) { pg8::EpiSwigluF8 E{(unsigned char*)ACT}; dense_gemm<pg8::EpiSwigluF8, true>(F, H8, WB + WE_GU + (size_t)2 * FF * DM, 2 * FF, DM / 2, E); }
            else { pg8::EpiSwiglu E{ACT}; dense_gemm(F, H, WB + WE_GU + (size_t)2 * FF * DM, 2 * FF, DM, E); } })
    PHASE({ if (DENSE_FP8_L2) { pg8::EpiResid<false> E{X, X, 1.0f / (W8S * A8S)}; resid_gemm_norm<(QKV3_FP8 ? 8 : 0), pg8::EpiResid<false>, true>(F, 4, ACT, WB + WE_D + (size_t)DM * FF, FF / 2, E, X, INP(13) + 3 * DM, H, 0, nullptr); }
            else { pg8::EpiResid<false> E{X, X, 1.0f}; resid_gemm_norm<(QKV3_FP8 ? 8 : 0)>(F, 4, ACT, WB + WE_D + (size_t)DM * FF, FF, E, X, INP(13) + 3 * DM, H, 0, nullptr); } })
    PHASE({ stagger_convert<1>(F);
            if (QKV3_FP8) { pg8::EpiPlanes E{PROJ, C2, 1.0f / W8S}; dense_gemm<pg8::EpiPlanes, true>(F, H8, WB + WE_QKV + (size_t)3 * DM * DM, 3 * DM, DM / 2, E); }
            else { pg8::EpiPlanes E{PROJ, C2, 1.0f}; dense_gemm(F, H, WB + WE_QKV + (size_t)3 * DM * DM, 3 * DM, DM, E); } })
    PHASE(att::causal_phase<0>((att::lptr)F.lds, F.G, PROJ, PROJ + PLANE, PROJ + 2 * PLANE, O, nullptr, WO_FP8))
    PHASE({ if (WO_FP8) { pg8::EpiResid<false> E{X, X, 1.0f / (W8S * A8S)}; resid_gemm_norm<4, pg8::EpiResid<false>, true>(F, 5, O, WB + WE_WO_SB + (size_t)DM * DM, DM / 2, E, X, INP(14) + 3 * DM, H, 1, INP(18) + 1 * DM * NE); }
            else { pg8::EpiResid<false> E{X, X, 1.0f}; resid_gemm_norm<4>(F, 5, O, WB + WE_WO_SB + (size_t)DM * DM, DM, E, X, INP(14) + 3 * DM, H, 1, INP(18) + 1 * DM * NE); } })
    PHASE(moe_finalize(F, 1))
    PHASE({ stagger_convert<1>(F); moe_gu_fast(F, 1, H, ACT); })
    PHASE(moe_down_fast(F, 1, ACT, Y))
    PHASE(final_combine(F, 1))
    static_assert(__COUNTER__ - PH_BASE == N_PHASES, "N_PHASES must equal the number of PHASE() sites");
#undef PHASE
#undef IN
#undef SEAM
}

extern "C" void kernel_launch(void* const* d_in, const int* in_sizes, int n_in, void* d_out, int out_size, void* d_ws, size_t ws_size, hipStream_t stream) {
    static int grid = 0;
    if (grid == 0) {
        if (n_in != 22 || out_size != M * DM || ws_size < WS_END) { fprintf(stderr, "kernel_launch: unexpected shapes (n_in %d out %d ws %zu)\n", n_in, out_size, ws_size); grid = -1; return; }
        int dev = 0, cus = 0, per_cu = 0;
        if (hipGetDevice(&dev) != hipSuccess || hipDeviceGetAttribute(&cus, hipDeviceAttributeMultiprocessorCount, dev) != hipSuccess) { grid = -1; return; }
        if (hipFuncSetAttribute((const void*)trunk_fwd, hipFuncAttributeMaxDynamicSharedMemorySize, LDS_BYTES) != hipSuccess) { fprintf(stderr, "kernel_launch: hipFuncSetAttribute failed\n"); grid = -1; return; }
        if (hipOccupancyMaxActiveBlocksPerMultiprocessor(&per_cu, (const void*)trunk_fwd, NTHR, LDS_BYTES) != hipSuccess || per_cu < 1) fprintf(stderr, "kernel_launch: occupancy query says %d\n", per_cu);
        (void)hipGetLastError();
        grid = cus;
    }
    if (grid < 0) return;
    (void)hipMemsetAsync((char*)d_ws + WS_CTL, 0, CTL_ZERO_BYTES, stream);
    Args a{};
    for (int i = 0; i < 22; ++i) a.in[i] = (const float*)d_in[i];
    a.out = (float*)d_out; a.ws = (unsigned char*)d_ws;
#if MK_MULTI
    for (int p = 0; p < N_PHASES; ++p) { a.ph_lo = p; a.ph_hi = p + 1; hipLaunchKernelGGL(trunk_fwd, dim3(grid), dim3(NTHR), LDS_BYTES, stream, a); }
#else
    a.ph_lo = 0; a.ph_hi = N_PHASES;
    hipLaunchKernelGGL(trunk_fwd, dim3(grid), dim3(NTHR), LDS_BYTES, stream, a);
#endif
}
```

```cpp
#include <hip/hip_runtime.h>
#include <cstdio>
#include <cstdint>

#ifndef MK_MULTI
#define MK_MULTI 0
#endif

constexpr int BATCH = 8, SEQ = 2048, DM = 1024, NH = 16, HD = 64, FF = 3584, NE = 8;
constexpr int M = BATCH * SEQ;
constexpr float RMS_EPS = 1e-6f;
constexpr float LOG2E = 1.4426950408889634f;
constexpr float C2 = 0.125f * LOG2E;
constexpr int NWAVES = 8, NTHR = 512;
constexpr int LCAP = 16384;
constexpr int MAXROWS = 34816;
constexpr bool MOE_SPLITK = true;
constexpr bool MOE_FP8 = true;
constexpr bool DILIN_FP8 = true;
constexpr bool FOXIN_FP8 = true;
constexpr bool QKV3_FP8 = true;
constexpr bool DENSE_FP8_L0 = false, DENSE_FP8_L2 = true;
constexpr float W8S = 32.0f, A8S = 4.0f;
constexpr int MOE_NSPLIT = MOE_FP8 ? 2 : 4;
constexpr int SPLIT_ROW0 = 32768, SPLIT_ROWS = MAXROWS - SPLIT_ROW0;

constexpr size_t MiB = 1u << 20;
constexpr size_t WS_CTL = 0, CTL_ZERO_BYTES = 1 * MiB;
constexpr size_t WS_MISC = 1 * MiB;
constexpr size_t WS_H = 6 * MiB;
constexpr size_t WS_R1 = 38 * MiB;
constexpr size_t WS_R2 = 278 * MiB;
constexpr size_t WS_W = 414 * MiB;
constexpr size_t WS_XB = 832 * MiB;
constexpr size_t WS_END = 864 * MiB;
constexpr size_t PLANE = (size_t)M * DM;
constexpr size_t WE_QKV = 0;
constexpr size_t WE_WO_SB = WE_QKV + 2ull * 3072 * 1024;
constexpr size_t WE_WO_DIL = WE_WO_SB + 2ull * 1024 * 1024;
constexpr size_t WE_WO_FOX = WE_WO_DIL + 1024ull * 1024;
constexpr size_t WE_IN_DIL = WE_WO_FOX + 1024ull * 1024;
constexpr size_t WE_IN_FOX = WE_IN_DIL + 7168ull * 1024;
constexpr size_t WE_GU = WE_IN_FOX + 3072ull * 1024;
constexpr size_t WE_D = WE_GU + 2ull * 7168 * 1024;
constexpr size_t WE_MGU = WE_D + 2ull * 1024 * 3584;
constexpr size_t WE_MD = WE_MGU + 16ull * 7168 * 1024;
constexpr size_t WE_END = WE_MD + 16ull * 1024 * 3584;
static_assert(WS_W + WE_END * 2 <= WS_END, "weight copies fit");
constexpr size_t MS_LIST = 0;
constexpr size_t MS_GW = 1 * MiB;
constexpr size_t MS_TOK = 2 * MiB;
constexpr size_t MS_LOGF = 2 * MiB + 256 * 1024;
constexpr size_t MS_CUM = 3 * MiB + 256 * 1024;
constexpr size_t MS_SEL = 4 * MiB + 256 * 1024;
constexpr size_t MS_SG = MS_SEL + 256 * 1024;
constexpr size_t MS_LC = MS_SG + 256 * 1024;
constexpr int CW_BAR = 4096;
constexpr int CW_PANEL = 1024;
constexpr bool MOE_Y_FP8 = true;
constexpr float Y8S = 16.0f;
constexpr bool WO_FP8 = true;
constexpr int CW_CVQ = 2048;
constexpr int CW_CNT = 64;

#define GAS __attribute__((address_space(1)))
#define LAS __attribute__((address_space(3)))
typedef unsigned short bf16;
typedef unsigned v4u __attribute__((ext_vector_type(4)));
typedef unsigned v2u __attribute__((ext_vector_type(2)));
typedef float f32x4 __attribute__((ext_vector_type(4)));
typedef float f32x2 __attribute__((ext_vector_type(2)));
typedef GAS unsigned gu32;
#define RLX_AGENT __ATOMIC_RELAXED, __HIP_MEMORY_SCOPE_AGENT
__device__ __forceinline__ unsigned f2bf(float f) { unsigned u = __builtin_bit_cast(unsigned, f); return (u + 0x7fffu + ((u >> 16) & 1u)) >> 16; }
__device__ __forceinline__ unsigned pk2(float lo, float hi) { return f2bf(lo) | (f2bf(hi) << 16); }
__device__ __forceinline__ float bflo(unsigned u) { return __builtin_bit_cast(float, u << 16); }
__device__ __forceinline__ float bfhi(unsigned u) { return __builtin_bit_cast(float, u & 0xffff0000u); }

#define XB_TMO      128
#define XB_XCNT(j)  (256  + 64 * (j))
#define XB_XSUB(j)  (1280 + 64 * (j))
#define XB_XGEN(j)  (2304 + 64 * (j))
#define XB_TOP      3328
#define XB_TOPGEN   3392
#define XCD_BAR_WORDS 3456
#define XB_SPIN_CAP (1u << 22)
__device__ __forceinline__ unsigned xb_ld(unsigned* p)              { return __hip_atomic_load(p, __ATOMIC_RELAXED, __HIP_MEMORY_SCOPE_AGENT); }
__device__ __forceinline__ unsigned xb_add(unsigned* p, unsigned v) { return __hip_atomic_fetch_add(p, v, __ATOMIC_RELAXED, __HIP_MEMORY_SCOPE_AGENT); }
__device__ __forceinline__ unsigned xb_xcc_id() { return (unsigned)__builtin_amdgcn_s_getreg((3 << 11) | 20) & 0xFu; }
#define XB_SPIN(cond, bar) do { unsigned _sp = 0; while (cond) { __builtin_amdgcn_s_sleep(1); \
    if ((++_sp & 255u) == 0u) { if (xb_ld(&(bar)[XB_TMO])) break; if (_sp > XB_SPIN_CAP) { atomicAdd(&(bar)[XB_TMO], 1u); break; } } } } while (0)
struct XcdBarrier { unsigned* bar; unsigned x; volatile LAS unsigned* st; };
__device__ __forceinline__ XcdBarrier xcd_barrier_post(unsigned* bar, volatile LAS unsigned* st) {
    XcdBarrier b; b.bar = bar; b.x = xb_xcc_id(); b.st = st;
    if (threadIdx.x == 0) (void)xb_add(&bar[XB_XCNT(b.x)], 1u);
    return b;
}
__device__ __forceinline__ void xcd_barrier_complete(unsigned* bar, unsigned x, unsigned& nloc, unsigned& nx) {
    const unsigned G = gridDim.x * gridDim.y * gridDim.z;
    unsigned sum, cnt, mine, sp = 0u;
    for (;;) {
        sum = 0u; cnt = 0u; mine = 0u;
#pragma unroll
        for (unsigned j = 0; j < 16; ++j) { const unsigned c = xb_ld(&bar[XB_XCNT(j)]); sum += c; cnt += (c > 0u) ? 1u : 0u; mine = (j == x) ? c : mine; }
        if (sum == G) break;
        __builtin_amdgcn_s_sleep(1);
        if ((++sp & 255u) == 0u) { if (xb_ld(&bar[XB_TMO])) break; if (sp > XB_SPIN_CAP) { atomicAdd(&bar[XB_TMO], 1u); break; } }
    }
    nloc = mine > 0u ? mine : 1u; nx = cnt > 0u ? cnt : 1u;
}
__device__ __forceinline__ void xcd_barrier(const XcdBarrier& b) {
    asm volatile("s_waitcnt vmcnt(0)" ::: "memory");
    __syncthreads();
    if (threadIdx.x == 0) {
        unsigned* bar = b.bar;
        __builtin_amdgcn_s_waitcnt(0);
        unsigned nloc = b.st[0], nx = b.st[1];
        if (nloc == 0u) { xcd_barrier_complete(bar, b.x, nloc, nx); b.st[0] = nloc; b.st[1] = nx; }
        const unsigned old = xb_add(&bar[XB_XSUB(b.x)], 1u);
        const unsigned gen = old / nloc;
        if (old + 1u == (gen + 1u) * nloc) {
            __builtin_amdgcn_fence(__ATOMIC_RELEASE, "agent");
            asm volatile("s_waitcnt vmcnt(0)" ::: "memory");
            const unsigned og = xb_add(&bar[XB_TOP], 1u);
            const unsigned tg = og / nx;
            if (og + 1u == (tg + 1u) * nx) xb_add(&bar[XB_TOPGEN], 1u);
            else XB_SPIN(xb_ld(&bar[XB_TOPGEN]) == tg, bar);
            xb_add(&bar[XB_XGEN(b.x)], 1u);
            __builtin_amdgcn_fence(__ATOMIC_ACQUIRE, "agent");
            asm volatile("s_waitcnt vmcnt(0)" ::: "memory");
        } else {
            XB_SPIN(xb_ld(&bar[XB_XGEN(b.x)]) == gen, bar);
            __builtin_amdgcn_fence(__ATOMIC_ACQUIRE, "agent");
            asm volatile("s_waitcnt vmcnt(0)" ::: "memory");
        }
    }
    __syncthreads();
}

constexpr int LDS_BYTES = 147456;
constexpr int ATT_LDS_MAX = 143360;
constexpr int MISC_OFF = ATT_LDS_MAX + 64;
struct Frame {
    LAS unsigned char* lds;
    int tid, lane, wave, G;
    unsigned char* ws; gu32* ctl;
    float* out;
};
__device__ __forceinline__ float wave_sum(float v) {
#pragma unroll
    for (int o = 1; o < 64; o <<= 1) v += __shfl_xor(v, o);
    return v;
}

constexpr int PTR_OFF = ATT_LDS_MAX + 512;
__device__ __forceinline__ const float* inp_ptr(Frame& F, int k) {
    const LAS unsigned* t = (const LAS unsigned*)(F.lds + PTR_OFF) + 2 * k;
    const unsigned lo = __builtin_amdgcn_readfirstlane(t[0]), hi = __builtin_amdgcn_readfirstlane(t[1]);
    return (const float*)(((unsigned long long)hi << 32) | lo);
}
#define INP(k) inp_ptr(F, (k))
__device__ __forceinline__ bool relaunder(Frame& F) { int t_ = threadIdx.x; asm volatile("" : "+v"(t_)); F.tid = t_; F.lane = t_ & 63; F.wave = __builtin_amdgcn_readfirstlane(t_ >> 6); return true; }
namespace pg8 {
#define PG8_LAS __attribute__((address_space(3)))
typedef unsigned short bf16_t;
typedef short bf16x8 __attribute__((ext_vector_type(8)));
typedef unsigned u32x4 __attribute__((ext_vector_type(4)));
constexpr int BM = 256, BK = 64, HALF = 128, HTB = HALF * BK * 2, STAGE_BYTES = 8 * HTB, NXCD = 8, WGM = 8;
__host__ __device__ __forceinline__ int lds_byte(int r, int c) { const int st = (r >> 4) * 2 + (c >> 5), rr = r & 15, cc = c & 31, ob = rr * 64 + cc * 2; return st * 1024 + (ob ^ (((ob >> 9) & 1) << 5)); }
__host__ __device__ __forceinline__ void stage_rc(int b, int& R, int& C) { const int st = b / 1024, sb = b % 1024, swz = sb ^ (((sb >> 9) & 1) << 5); R = (st >> 1) * 16 + swz / 64; C = (st & 1) * 32 + (swz % 64) / 2; }
__host__ __device__ __forceinline__ int perm32(int rho) { const int n = rho >> 4, i = rho & 15; return 8 * (i >> 2) + 4 * n + (i & 3); }
struct Unit { int pm, pn, e, mt, nt, koff, kq; };

struct DenseOrder {
    int nM, nN, nwg, G, c, ntk; const char* A; const char* Bt; size_t tstep;
    __device__ __forceinline__ void init(const bf16_t* A_, const bf16_t* Bt_, int M_, int N_, int K_, int G_, int c_) { nM = M_ / BM; nN = N_ / BM; nwg = nM * nN; G = G_; c = c_; ntk = K_ / BK; A = (const char*)A_; Bt = (const char*)Bt_; tstep = (size_t)BM * K_ * 2; }
    __device__ __forceinline__ bool next(int i, Unit& u) const {
        const long L = (long)i * G + c; if (L >= nwg) return false;
        int wgid = (int)L; { const int q = nwg / NXCD, r = nwg % NXCD, xcd = wgid % NXCD, off = wgid / NXCD; wgid = (xcd < r ? xcd * (q + 1) : r * (q + 1) + (xcd - r) * q) + off; }
        const int nig = WGM * nN, gid = wgid / nig, fm = gid * WGM, gsz = (nM - fm) < WGM ? (nM - fm) : WGM;
        u.pm = fm + ((wgid % nig) % gsz); u.pn = (wgid % nig) / gsz; u.e = 0; u.mt = u.pm; u.nt = ntk; u.koff = 0; u.kq = -1; return true;
    }
    __device__ __forceinline__ const char* a_base(const Unit& u) const { return A + (size_t)u.pm * tstep; }
    __device__ __forceinline__ const char* b_base(const Unit& u) const { return Bt + (size_t)u.pn * tstep; }
    __device__ __forceinline__ void a_voff(const Unit&, const int (&)[2], const int (&)[2], unsigned (&)[2][2]) const {}
};
struct MoeOrder {
    int t1, t2, t3, t4, t5, t6, t7, t8, nN, G, c, K; const char* A; const char* Bt; size_t tstepA, tstepB, estepB; const int* list; bool gather; int splitk; bool xcdperm;
    __device__ __forceinline__ bool next(int i, Unit& u) const {
        const int X = i * G + c, U = t8 * nN; int L = X; u.nt = K / BK; u.koff = 0; u.kq = -1;
        if (splitk) { const int nfull = (U / G) * G;
            if (X >= nfull) { const int q = X - nfull; if (q >= splitk * (U - nfull)) return false; L = nfull + q / splitk; u.kq = q % splitk; u.nt = K / BK / splitk; u.koff = u.kq * (K / splitk) * 2; } }
        else if (X >= U) return false;
        if (xcdperm && u.kq < 0) {
            const int rnd = L / G, q = L - rnd * G, j = q >> 3, x = q & 7; L = rnd * G + (((j >> 2) * 8 + x) << 2) + (j & 3); }
        const int mt = L / nN; u.pm = mt; u.pn = L - mt * nN;
        const int e = (mt >= t1) + (mt >= t2) + (mt >= t3) + (mt >= t4) + (mt >= t5) + (mt >= t6) + (mt >= t7);
        const int tb = e == 0 ? 0 : e == 1 ? t1 : e == 2 ? t2 : e == 3 ? t3 : e == 4 ? t4 : e == 5 ? t5 : e == 6 ? t6 : t7;
        u.e = e; u.mt = mt - tb; return true;
    }
    __device__ __forceinline__ const char* a_base(const Unit& u) const { return (gather ? A : A + (size_t)u.pm * tstepA) + u.koff; }
    __device__ __forceinline__ const char* b_base(const Unit& u) const { return Bt + (size_t)u.e * estepB + (size_t)u.pn * tstepB + u.koff; }
    __device__ __forceinline__ void a_voff(const Unit& u, const int (&sR)[2], const int (&sC)[2], unsigned (&v)[2][2]) const {
        const int* lp = list + u.e * LCAP + u.mt * 256;
#pragma unroll
        for (int h = 0; h < 2; ++h)
#pragma unroll
            for (int i = 0; i < 2; ++i) v[h][i] = (unsigned)lp[h * 128 + sR[i]] * (unsigned)(K * 2) + (unsigned)(sC[i] * 2);
    }
};

typedef int v8i32 __attribute__((ext_vector_type(8)));
typedef int v4i32 __attribute__((ext_vector_type(4)));
__device__ __forceinline__ v8i32 cat8(bf16x8 a, bf16x8 b) { const v4i32 x = __builtin_bit_cast(v4i32, a), y = __builtin_bit_cast(v4i32, b); return (v8i32){x[0], x[1], x[2], x[3], y[0], y[1], y[2], y[3]}; }
__device__ __forceinline__ unsigned cvt4_fp8(float a, float b, float c, float d) { int w = 0; w = __builtin_amdgcn_cvt_pk_fp8_f32(a, b, w, false); w = __builtin_amdgcn_cvt_pk_fp8_f32(c, d, w, true); return (unsigned)w; }
__device__ __forceinline__ const char* uniptr(const char* p) { const unsigned long long v = (unsigned long long)p; const unsigned lo = __builtin_amdgcn_readfirstlane((unsigned)v), hi = __builtin_amdgcn_readfirstlane((unsigned)(v >> 32)); return (const char*)(((unsigned long long)hi << 32) | lo); }
__device__ __forceinline__ void glds16_s(const char* sbase, unsigned voff, unsigned lds_dst) { unsigned keep;
    asm volatile("s_mov_b32 %0, m0\n\ts_mov_b32 m0, %3\n\ts_nop 0\n\tglobal_load_lds_dwordx4 %2, %1\n\ts_mov_b32 m0, %0" : "=&s"(keep) : "s"(sbase), "v"(voff), "s"(lds_dst) : "memory"); }
__device__ __forceinline__ unsigned cvt_pk_bf16(float lo, float hi) { unsigned r; asm volatile("v_cvt_pk_bf16_f32 %0, %1, %2" : "=v"(r) : "v"(lo), "v"(hi)); return r; }

struct EpiPlanes {
    static constexpr bool PERM = true;
    bf16_t* O; float scale0; float oscale;
    __device__ __forceinline__ void operator()(const f32x4 (&acc)[2][2][4][2], const Unit& u, int wr, int wc, int fr, int fq) const {
        const int plane = u.pn >> 2; const float sc = (plane == 0 ? scale0 : 1.f) * oscale;
        bf16_t* base = O + (size_t)plane * PLANE + (size_t)(u.pm * BM + wr * 64 + fr) * DM + (u.pn & 3) * 256 + wc * 32 + 8 * fq;
#pragma unroll
        for (int ai = 0; ai < 2; ++ai)
#pragma unroll
            for (int m = 0; m < 4; ++m) { bf16_t* rowp = base + (size_t)(ai * HALF + m * 16) * DM;
#pragma unroll
                for (int bj = 0; bj < 2; ++bj) { const f32x4 v0 = acc[ai][bj][m][0] * sc, v1 = acc[ai][bj][m][1] * sc;
                    u32x4 w; w.x = cvt_pk_bf16(v0[0], v0[1]); w.y = cvt_pk_bf16(v0[2], v0[3]); w.z = cvt_pk_bf16(v1[0], v1[1]); w.w = cvt_pk_bf16(v1[2], v1[3]);
                    *(u32x4*)(rowp + bj * HALF) = w; } }
    }
};
struct EpiQKNorm {
    static constexpr bool PERM = true;
    bf16_t* O; const float* qg; const float* kg; int vplane; float iscale;
    __device__ __forceinline__ void operator()(const f32x4 (&acc)[2][2][4][2], const Unit& u, int wr, int wc, int fr, int fq) const {
        const int plane = u.pn >> 2; const bool isv = plane == vplane; const bool isq = !isv && ((plane & 1) == 0); const int grp = plane >> 1;
        const float* g = (isq ? qg : kg) + grp * 64 + 8 * fq;
        f32x4 gv[2][2];
#pragma unroll
        for (int bj = 0; bj < 2; ++bj)
#pragma unroll
            for (int n = 0; n < 2; ++n) gv[bj][n] = isv ? (f32x4){1.f, 1.f, 1.f, 1.f} : *(const f32x4*)(g + 32 * bj + 4 * n);
        const float mul = isq ? C2 : 1.f;
        bf16_t* base = O + (size_t)plane * PLANE + (size_t)(u.pm * BM + wr * 64 + fr) * DM + (u.pn & 3) * 256 + wc * 64 + 8 * fq;
#pragma unroll
        for (int ai = 0; ai < 2; ++ai)
#pragma unroll
            for (int m = 0; m < 4; ++m) { bf16_t* rowp = base + (size_t)(ai * HALF + m * 16) * DM;
                float ss = 0.f;
#pragma unroll
                for (int bj = 0; bj < 2; ++bj)
#pragma unroll
                    for (int n = 0; n < 2; ++n) { const f32x4 x = acc[ai][bj][m][n] * iscale; ss += (x[0] * x[0] + x[1] * x[1]) + (x[2] * x[2] + x[3] * x[3]); }
                ss += __shfl_xor(ss, 16); ss += __shfl_xor(ss, 32);
                const float inv = (isv ? 1.f : mul * __builtin_amdgcn_rsqf(ss * (1.f / 64.f) + RMS_EPS)) * iscale;
#pragma unroll
                for (int bj = 0; bj < 2; ++bj) { const f32x4 v0 = acc[ai][bj][m][0] * inv * gv[bj][0], v1 = acc[ai][bj][m][1] * inv * gv[bj][1];
                    u32x4 w; w.x = cvt_pk_bf16(v0[0], v0[1]); w.y = cvt_pk_bf16(v0[2], v0[3]); w.z = cvt_pk_bf16(v1[0], v1[1]); w.w = cvt_pk_bf16(v1[2], v1[3]);
                    *(u32x4*)(rowp + bj * 32) = w; } }
    }
};
struct EpiSwiglu {
    static constexpr bool PERM = true;
    bf16_t* O;
    __device__ __forceinline__ void operator()(const f32x4 (&acc)[2][2][4][2], const Unit& u, int wr, int wc, int fr, int fq) const {
        bf16_t* base = O + (size_t)(u.pm * BM + wr * 64 + fr) * FF + u.pn * 128 + wc * 32 + 8 * fq;
#pragma unroll
        for (int ai = 0; ai < 2; ++ai)
#pragma unroll
            for (int m = 0; m < 4; ++m) { bf16_t* rowp = base + (size_t)(ai * HALF + m * 16) * FF;
                f32x2 o[4];
#pragma unroll
                for (int n = 0; n < 2; ++n)
#pragma unroll
                    for (int hh = 0; hh < 2; ++hh) { const f32x2 ga = {acc[ai][0][m][n][2 * hh], acc[ai][0][m][n][2 * hh + 1]}, ua = {acc[ai][1][m][n][2 * hh], acc[ai][1][m][n][2 * hh + 1]};
                        const f32x2 m1 = ga * (-LOG2E); f32x2 e; e.x = __builtin_amdgcn_exp2f(m1.x); e.y = __builtin_amdgcn_exp2f(m1.y);
                        const f32x2 sden = e + 1.0f; f32x2 r; r.x = __builtin_amdgcn_rcpf(sden.x); r.y = __builtin_amdgcn_rcpf(sden.y);
                        o[n * 2 + hh] = (ga * ua) * r; }
                u32x4 w; w.x = cvt_pk_bf16(o[0].x, o[0].y); w.y = cvt_pk_bf16(o[1].x, o[1].y); w.z = cvt_pk_bf16(o[2].x, o[2].y); w.w = cvt_pk_bf16(o[3].x, o[3].y);
                *(u32x4*)rowp = w; }
    }
};
struct EpiSwigluF8 {
    static constexpr bool PERM = true;
    unsigned char* O;
    __device__ __forceinline__ void operator()(const f32x4 (&acc)[2][2][4][2], const Unit& u, int wr, int wc, int fr, int fq) const {
        unsigned char* base = O + (size_t)(u.pm * BM + wr * 64 + fr) * FF + u.pn * 128 + wc * 32 + 8 * fq;
        constexpr float k1 = -LOG2E / W8S, ik2 = W8S * W8S / A8S;
#pragma unroll
        for (int ai = 0; ai < 2; ++ai)
#pragma unroll
            for (int m = 0; m < 4; ++m) { unsigned char* rowp = base + (size_t)(ai * HALF + m * 16) * FF;
                f32x2 o[4];
#pragma unroll
                for (int n = 0; n < 2; ++n)
#pragma unroll
                    for (int hh = 0; hh < 2; ++hh) { const f32x2 ga = {acc[ai][0][m][n][2 * hh], acc[ai][0][m][n][2 * hh + 1]}, ua = {acc[ai][1][m][n][2 * hh], acc[ai][1][m][n][2 * hh + 1]};
                        const f32x2 m1 = ga * k1; f32x2 e; e.x = __builtin_amdgcn_exp2f(m1.x); e.y = __builtin_amdgcn_exp2f(m1.y);
                        const f32x2 sden = e * ik2 + ik2; f32x2 r; r.x = __builtin_amdgcn_rcpf(sden.x); r.y = __builtin_amdgcn_rcpf(sden.y);
                        const f32x2 t = (ga * ua) * r; o[n * 2 + hh] = (f32x2){__builtin_amdgcn_fmed3f(t.x, -448.f, 448.f), __builtin_amdgcn_fmed3f(t.y, -448.f, 448.f)}; }
                v2u w; w.x = cvt4_fp8(o[0].x, o[0].y, o[1].x, o[1].y); w.y = cvt4_fp8(o[2].x, o[2].y, o[3].x, o[3].y);
                *(v2u*)rowp = w; }
    }
};
template <bool BASE_F32>
struct EpiResid {
    static constexpr bool PERM = true;
    const void* base; bf16_t* out; float oscale;
    __device__ __forceinline__ void operator()(const f32x4 (&acc)[2][2][4][2], const Unit& u, int wr, int wc, int fr, int fq) const {
        const size_t off0 = (size_t)(u.pm * BM + wr * 64 + fr) * DM + u.pn * BM + wc * 32 + 8 * fq;
#pragma unroll
        for (int ai = 0; ai < 2; ++ai)
#pragma unroll
            for (int m = 0; m < 4; ++m) { const size_t off = off0 + (size_t)(ai * HALF + m * 16) * DM;
#pragma unroll
                for (int bj = 0; bj < 2; ++bj) { f32x4 b0, b1;
                    if (BASE_F32) { b0 = *(const f32x4*)((const float*)base + off + bj * HALF); b1 = *(const f32x4*)((const float*)base + off + bj * HALF + 4); }
                    else { const u32x4 w = *(const u32x4*)((const bf16_t*)base + off + bj * HALF);
                        b0 = (f32x4){__builtin_bit_cast(float, w.x << 16), __builtin_bit_cast(float, w.x & 0xffff0000u), __builtin_bit_cast(float, w.y << 16), __builtin_bit_cast(float, w.y & 0xffff0000u)};
                        b1 = (f32x4){__builtin_bit_cast(float, w.z << 16), __builtin_bit_cast(float, w.z & 0xffff0000u), __builtin_bit_cast(float, w.w << 16), __builtin_bit_cast(float, w.w & 0xffff0000u)}; }
                    const f32x4 v0 = b0 + acc[ai][bj][m][0] * oscale, v1 = b1 + acc[ai][bj][m][1] * oscale;
                    u32x4 o; o.x = cvt_pk_bf16(v0[0], v0[1]); o.y = cvt_pk_bf16(v0[2], v0[3]); o.z = cvt_pk_bf16(v1[0], v1[1]); o.w = cvt_pk_bf16(v1[2], v1[3]);
                    *(u32x4*)(out + off + bj * HALF) = o; } }
    }
};
struct EpiMoeDown {
    static constexpr bool PERM = true;
    bf16_t* Y; const float* gw; bf16_t* P; float oscale;
    __device__ __forceinline__ void operator()(const f32x4 (&acc)[2][2][4][2], const Unit& u, int wr, int wc, int fr, int fq) const {
        const float* gp = gw + u.e * LCAP + u.mt * 256 + wr * 64 + fr;
        if (MOE_Y_FP8 && u.kq < 0) {
            unsigned char* base8 = (unsigned char*)Y + (size_t)(u.pm * BM + wr * 64 + fr) * DM + u.pn * BM + wc * 32 + 8 * fq;
#pragma unroll
            for (int ai = 0; ai < 2; ++ai)
#pragma unroll
                for (int m = 0; m < 4; ++m) { unsigned char* rowp = base8 + (size_t)(ai * HALF + m * 16) * DM; const float g = gp[ai * HALF + m * 16] * oscale * Y8S;
#pragma unroll
                    for (int bj = 0; bj < 2; ++bj) { f32x4 v0 = acc[ai][bj][m][0] * g, v1 = acc[ai][bj][m][1] * g;
#pragma unroll
                        for (int q = 0; q < 4; ++q) { v0[q] = __builtin_amdgcn_fmed3f(v0[q], -448.f, 448.f); v1[q] = __builtin_amdgcn_fmed3f(v1[q], -448.f, 448.f); }
                        v2u w; w.x = cvt4_fp8(v0[0], v0[1], v0[2], v0[3]); w.y = cvt4_fp8(v1[0], v1[1], v1[2], v1[3]);
                        *(v2u*)(rowp + bj * HALF) = w; } }
            return;
        }
        bf16_t* base = (u.kq < 0 ? Y + (size_t)(u.pm * BM) * DM : P + ((size_t)u.kq * SPLIT_ROWS + (size_t)(u.pm * BM - SPLIT_ROW0)) * DM) + (size_t)(wr * 64 + fr) * DM + u.pn * BM + wc * 32 + 8 * fq;
#pragma unroll
        for (int ai = 0; ai < 2; ++ai)
#pragma unroll
            for (int m = 0; m < 4; ++m) { bf16_t* rowp = base + (size_t)(ai * HALF + m * 16) * DM; const float g = gp[ai * HALF + m * 16] * oscale;
#pragma unroll
                for (int bj = 0; bj < 2; ++bj) { const f32x4 v0 = acc[ai][bj][m][0] * g, v1 = acc[ai][bj][m][1] * g;
                    u32x4 w; w.x = cvt_pk_bf16(v0[0], v0[1]); w.y = cvt_pk_bf16(v0[2], v0[3]); w.z = cvt_pk_bf16(v1[0], v1[1]); w.w = cvt_pk_bf16(v1[2], v1[3]);
                    *(u32x4*)(rowp + bj * HALF) = w; } }
    }
};

template <class Epi, class Sched, bool GATHER, bool FP8 = false>
__device__ __forceinline__ void gemm_phase(PG8_LAS unsigned char* lds, const int K, const Sched& S, const Epi& E) {
    const int tid = threadIdx.x, wid = __builtin_amdgcn_readfirstlane(tid >> 6), lane = tid & 63, wr = wid >> 2, wc = wid & 3, fr = lane & 15, fq = lane >> 4;
    unsigned voffA[2], voffB[2]; int sR[2], sC[2];
#pragma unroll
    for (int i = 0; i < 2; ++i) { int R, C; stage_rc(tid * 16 + i * 8192, R, C); const int Rb = Epi::PERM ? ((R & ~31) + perm32(R & 31)) : R;
        voffA[i] = (unsigned)(R * K + C) * 2u; voffB[i] = (unsigned)(Rb * K + C) * 2u; sR[i] = R; sC[i] = C; }
    const size_t kstep = (size_t)(BK * 2);
    const size_t hstep = (size_t)HALF * K * 2;
    const unsigned ldsw = (unsigned)wid * 1024u, lds0 = (unsigned)(uintptr_t)lds;
    const int aoff = lds_byte(wr * 64 + fr, fq * 8), boff = lds_byte(wc * 32 + fr, fq * 8);

#define PG8_SA(b, h) (((b) * 2 + (h)) * HTB)
#define PG8_SB(b, h) ((4 + (b) * 2 + (h)) * HTB)
#define PG8_STAGE(bufoff, gbase, voff) do { const char* gb_ = uniptr((const char*)(gbase)); _Pragma("unroll") for (int _i = 0; _i < 2; ++_i) \
        glds16_s(gb_, (voff)[_i], (unsigned)__builtin_amdgcn_readfirstlane(lds0 + (unsigned)(bufoff) + ldsw + (unsigned)(_i * 8192))); } while (0)
#define PG8_STAGE_A(bufoff, p, h, VG) do { if (GATHER) { PG8_STAGE(bufoff, p, VG[h]); } else { PG8_STAGE(bufoff, (p) + ((h) ? hstep : 0), voffA); } } while (0)
#define PG8_LDA(dst, b, h) do { _Pragma("unroll") for (int m = 0; m < 4; ++m) { if constexpr (FP8) { const v4i32 x_ = *(const PG8_LAS v4i32*)(lds + PG8_SA(b, h) + aoff + m * 2048), y_ = *(const PG8_LAS v4i32*)(lds + PG8_SA(b, h) + aoff + m * 2048 + 1024); dst##8[m] = __builtin_shufflevector(x_, y_, 0, 1, 2, 3, 4, 5, 6, 7); } \
        else { _Pragma("unroll") for (int k = 0; k < 2; ++k) dst[m][k] = *(const PG8_LAS bf16x8*)(lds + PG8_SA(b, h) + aoff + m * 2048 + k * 1024); } } } while (0)
#define PG8_LDB(dst, b, h) do { _Pragma("unroll") for (int n = 0; n < 2; ++n) { if constexpr (FP8) { const v4i32 x_ = *(const PG8_LAS v4i32*)(lds + PG8_SB(b, h) + boff + n * 2048), y_ = *(const PG8_LAS v4i32*)(lds + PG8_SB(b, h) + boff + n * 2048 + 1024); dst##8[n] = __builtin_shufflevector(x_, y_, 0, 1, 2, 3, 4, 5, 6, 7); } \
        else { _Pragma("unroll") for (int k = 0; k < 2; ++k) dst[n][k] = *(const PG8_LAS bf16x8*)(lds + PG8_SB(b, h) + boff + n * 2048 + k * 1024); } } } while (0)
#define PG8_MMA(ai, bj, At, Bt) do { __builtin_amdgcn_s_setprio(1); _Pragma("unroll") for (int m = 0; m < 4; ++m) _Pragma("unroll") for (int n = 0; n < 2; ++n) { \
        if constexpr (FP8) asm volatile("v_mfma_scale_f32_16x16x128_f8f6f4 %0, %1, %2, %0, %3, %3 op_sel_hi:[0,0,0]" : "+v"(acc[ai][bj][m][n]) : "v"(Bt##8[n]), "v"(At##8[m]), "v"(sc8));   \
        else { _Pragma("unroll") for (int k = 0; k < 2; ++k) acc[ai][bj][m][n] = __builtin_amdgcn_mfma_f32_16x16x32_bf16(Bt[n][k], At[m][k], acc[ai][bj][m][n], 0, 0, 0); } } \
        __builtin_amdgcn_s_setprio(0); } while (0)
#define PG8_WAIT_V(n) asm volatile("s_waitcnt vmcnt(" #n ")" ::: "memory")
#define PG8_WAIT_L(n) asm volatile("s_waitcnt lgkmcnt(" #n ")" ::: "memory")
#define PG8_BAR __builtin_amdgcn_s_barrier()
#define PG8_SCHED __builtin_amdgcn_sched_barrier(0)
    Unit cur, nxt; int ui = 0;
    if (!S.next(0, cur)) return;
    f32x4 acc[2][2][4][2];
#pragma unroll
    for (int a = 0; a < 2; ++a)
#pragma unroll
        for (int b = 0; b < 2; ++b)
#pragma unroll
            for (int m = 0; m < 4; ++m)
#pragma unroll
                for (int n = 0; n < 2; ++n) acc[a][b][m][n] = (f32x4){0.f, 0.f, 0.f, 0.f};
    bf16x8 At[4][2], B0[2][2], B1[2][2];
    v8i32 At8[4], B08[2], B18[2];
    int sc8 = 0x7F7F7F7F; asm volatile("" : "+v"(sc8));
    const char* cA = S.a_base(cur); const char* cB = S.b_base(cur);
    unsigned vc[2][2] = {{0u, 0u}, {0u, 0u}}, vn[2][2] = {{0u, 0u}, {0u, 0u}};
    if (GATHER) { S.a_voff(cur, sR, sC, vc); asm volatile("s_waitcnt vmcnt(0)" : "+v"(vc[0][0]), "+v"(vc[0][1]), "+v"(vc[1][0]), "+v"(vc[1][1]) :: "memory"); }
    PG8_STAGE(PG8_SB(0, 0), cB, voffB); PG8_STAGE(PG8_SB(0, 1), cB + hstep, voffB); PG8_STAGE_A(PG8_SA(0, 0), cA, 0, vc); PG8_STAGE_A(PG8_SA(0, 1), cA, 1, vc);
    if (wr == 1) PG8_BAR;
    PG8_WAIT_V(2); PG8_BAR;
    PG8_STAGE(PG8_SB(1, 0), cB + kstep, voffB); PG8_STAGE_A(PG8_SA(1, 0), cA + kstep, 0, vc); PG8_STAGE(PG8_SB(1, 1), cB + hstep + kstep, voffB);
    PG8_WAIT_V(6); PG8_BAR;
    for (;;) {
        const bool has_next = S.next(ui + 1, nxt);
        const char* nA = has_next ? S.a_base(nxt) : cA; const char* nB = has_next ? S.b_base(nxt) : cB;
        if (GATHER) {
            if (has_next) { S.a_voff(nxt, sR, sC, vn); asm volatile("s_waitcnt vmcnt(0)" : "+v"(vn[0][0]), "+v"(vn[0][1]), "+v"(vn[1][0]), "+v"(vn[1][1]) :: "memory"); }
            else { vn[0][0] = vc[0][0]; vn[0][1] = vc[0][1]; vn[1][0] = vc[1][0]; vn[1][1] = vc[1][1]; }
        }
        const int nt = cur.nt;
        for (int t = 0; t < nt; t += 2) {
            const bool last = (t == nt - 2);
            const char* a1 = cA + (size_t)(t + 1) * kstep;
            const char* a2 = last ? nA : cA + (size_t)(t + 2) * kstep; const char* b2 = last ? nB : cB + (size_t)(t + 2) * kstep;
            const char* a3 = a2 + kstep; const char* b3 = b2 + kstep;
            unsigned v2[2][2];
#pragma unroll
            for (int h = 0; h < 2; ++h)
#pragma unroll
                for (int i = 0; i < 2; ++i) v2[h][i] = last ? vn[h][i] : vc[h][i];
            PG8_LDB(B0, 0, 0); PG8_LDB(B1, 0, 1); PG8_SCHED; PG8_LDA(At, 0, 0); PG8_STAGE_A(PG8_SA(1, 1), a1, 1, vc);
            PG8_WAIT_V(8); PG8_WAIT_L(0); PG8_BAR; PG8_MMA(0, 0, At, B0); PG8_MMA(0, 1, At, B1); PG8_BAR; PG8_SCHED;
            PG8_LDA(At, 0, 1); PG8_STAGE(PG8_SB(0, 0), b2, voffB); PG8_STAGE(PG8_SB(0, 1), b2 + hstep, voffB); PG8_STAGE_A(PG8_SA(0, 0), a2, 0, v2);
            PG8_WAIT_V(8); PG8_WAIT_L(0); PG8_BAR; PG8_MMA(1, 0, At, B0); PG8_MMA(1, 1, At, B1); PG8_BAR; PG8_SCHED;
            PG8_LDB(B0, 1, 0); PG8_LDB(B1, 1, 1); PG8_SCHED; PG8_LDA(At, 1, 0); PG8_STAGE_A(PG8_SA(0, 1), a2, 1, v2);
            PG8_WAIT_V(8); PG8_WAIT_L(0); PG8_BAR; PG8_MMA(0, 0, At, B0); PG8_MMA(0, 1, At, B1); PG8_BAR; PG8_SCHED;
            PG8_LDA(At, 1, 1); PG8_STAGE(PG8_SB(1, 0), b3, voffB); PG8_STAGE(PG8_SB(1, 1), b3 + hstep, voffB); PG8_STAGE_A(PG8_SA(1, 0), a3, 0, v2);
            PG8_WAIT_V(8); PG8_WAIT_L(0); PG8_BAR; PG8_MMA(1, 0, At, B0); PG8_MMA(1, 1, At, B1); PG8_BAR; PG8_SCHED;
        }
        if (wr == 0) PG8_BAR;
        if constexpr (FP8) asm volatile("s_nop 15\n\ts_nop 15" ::: "memory");
        { int fr_ = fr, fq_ = fq; asm volatile("" : "+v"(fr_), "+v"(fq_)); E(acc, cur, wr, wc, fr_, fq_); }
        if (!has_next) break;
#pragma unroll
        for (int a = 0; a < 2; ++a)
#pragma unroll
            for (int b = 0; b < 2; ++b)
#pragma unroll
                for (int m = 0; m < 4; ++m)
#pragma unroll
                    for (int n = 0; n < 2; ++n) acc[a][b][m][n] = (f32x4){0.f, 0.f, 0.f, 0.f};
        cur = nxt; cA = nA; cB = nB; ++ui;
        if (GATHER) { vc[0][0] = vn[0][0]; vc[0][1] = vn[0][1]; vc[1][0] = vn[1][0]; vc[1][1] = vn[1][1]; }
        if (wr == 1) PG8_BAR;
    }
    PG8_WAIT_V(0);
    PG8_BAR;
#undef PG8_SA
#undef PG8_SB
#undef PG8_STAGE
#undef PG8_STAGE_A
#undef PG8_LDA
#undef PG8_LDB
#undef PG8_MMA
#undef PG8_WAIT_V
#undef PG8_WAIT_L
#undef PG8_BAR
#undef PG8_SCHED
}
}

namespace att {
typedef short bf16x8 __attribute__((ext_vector_type(8)));
typedef short s16x4 __attribute__((ext_vector_type(4)));
typedef float f32x16 __attribute__((ext_vector_type(16)));
typedef unsigned u32x4 __attribute__((ext_vector_type(4)));
typedef LAS char* lptr;
constexpr int SLOTB = 8192, NSLOT = 6, AHEAD = 4;
constexpr int L_K = 0, L_V = NSLOT * SLOTB, L_WS = 2 * NSLOT * SLOTB, L_OST = L_WS + 8 * 256, L_KB = L_OST + 8 * 4096, L_FLG = L_KB + 8192, L_END = L_FLG + 256;
static_assert(L_END <= ATT_LDS_MAX, "attention LDS map");
constexpr float THR = 8.0f;
__device__ __forceinline__ int crow(int r, int hi) { return (r & 3) + 8 * (r >> 2) + 4 * hi; }
__device__ __forceinline__ void glds16(const void* gsrc, unsigned lds_dst) { unsigned keep;
    asm volatile("s_mov_b32 %0, m0\n\ts_mov_b32 m0, %2\n\ts_nop 0\n\tglobal_load_lds_dwordx4 %1, off\n\ts_mov_b32 m0, %0" : "=&s"(keep) : "v"(gsrc), "s"(lds_dst) : "memory"); }
typedef float f32x2_t __attribute__((ext_vector_type(2))); typedef __bf16 bf16x2_t __attribute__((ext_vector_type(2)));
__device__ __forceinline__ unsigned cvtpk(float lo, float hi) { f32x2_t v = {lo, hi}; bf16x2_t b = __builtin_convertvector(v, bf16x2_t); return __builtin_bit_cast(unsigned, b); }
__device__ __forceinline__ bf16x8 gload16(const void* p) { bf16x8 v; asm volatile("global_load_dwordx4 %0, %1, off" : "=v"(v) : "v"(p) : "memory"); return v; }
__device__ __forceinline__ float max3f(float a, float b, float c) { return __builtin_fmaxf(__builtin_fmaxf(a, b), c); }
__device__ __forceinline__ void wait_bar(int n) {
    if (n >= 6) asm volatile("s_waitcnt vmcnt(6) lgkmcnt(0)\n\ts_barrier" ::: "memory");
    else if (n >= 4) asm volatile("s_waitcnt vmcnt(4) lgkmcnt(0)\n\ts_barrier" ::: "memory");
    else if (n >= 2) asm volatile("s_waitcnt vmcnt(2) lgkmcnt(0)\n\ts_barrier" ::: "memory");
    else asm volatile("s_waitcnt vmcnt(0) lgkmcnt(0)\n\ts_barrier" ::: "memory");
}
__device__ __forceinline__ float other_half(float x, int hi) {
    auto rr = __builtin_amdgcn_permlane32_swap(__float_as_uint(x), __float_as_uint(x), false, false);
    return __uint_as_float(hi ? rr[0] : rr[1]);
}
__device__ __forceinline__ void qkt(f32x16& p0, f32x16& p1, lptr Kslot, const bf16x8* qr, const f32x16& c0, const f32x16& c1, int r32, int hi) {
    lptr kb = Kslot + hi * 1024 + r32 * 16;
#pragma unroll
    for (int d0 = 0; d0 < 4; ++d0) {
        const bf16x8 b0 = *(const LAS bf16x8*)(kb + d0 * 2048);
        const bf16x8 b1 = *(const LAS bf16x8*)(kb + d0 * 2048 + 512);
        if (d0 == 0) { p0 = __builtin_amdgcn_mfma_f32_32x32x16_bf16(b0, qr[0], c0, 0, 0, 0); p1 = __builtin_amdgcn_mfma_f32_32x32x16_bf16(b1, qr[0], c1, 0, 0, 0); }
        else { p0 = __builtin_amdgcn_mfma_f32_32x32x16_bf16(b0, qr[d0], p0, 0, 0, 0); p1 = __builtin_amdgcn_mfma_f32_32x32x16_bf16(b1, qr[d0], p1, 0, 0, 0); } }
}
__device__ __forceinline__ void pv(f32x16* o, int vb, bf16x8 pa0, bf16x8 pa1, bf16x8 pa2, bf16x8 pa3) {
#pragma unroll
    for (int d0 = 0; d0 < 2; ++d0) { s16x4 lo[4], hi[4];
#pragma unroll
        for (int ks = 0; ks < 4; ++ks) {
            asm volatile("ds_read_b64_tr_b16 %0,%1 offset:%c2" : "=&v"(lo[ks]) : "v"(vb), "i"(d0 * 4096 + ks * 1024) : "memory");
            asm volatile("ds_read_b64_tr_b16 %0,%1 offset:%c2" : "=&v"(hi[ks]) : "v"(vb), "i"(d0 * 4096 + ks * 1024 + 512) : "memory"); }
        asm volatile("s_waitcnt lgkmcnt(0)" ::: "memory"); __builtin_amdgcn_sched_barrier(0);
#define ATT_PK(k) (bf16x8){lo[k][0], lo[k][1], lo[k][2], lo[k][3], hi[k][0], hi[k][1], hi[k][2], hi[k][3]}
        o[d0] = __builtin_amdgcn_mfma_f32_32x32x16_bf16(pa0, ATT_PK(0), o[d0], 0, 0, 0);
        o[d0] = __builtin_amdgcn_mfma_f32_32x32x16_bf16(pa1, ATT_PK(1), o[d0], 0, 0, 0);
        o[d0] = __builtin_amdgcn_mfma_f32_32x32x16_bf16(pa2, ATT_PK(2), o[d0], 0, 0, 0);
        o[d0] = __builtin_amdgcn_mfma_f32_32x32x16_bf16(pa3, ATT_PK(3), o[d0], 0, 0, 0);
#undef ATT_PK
    }
}
__device__ __forceinline__ void pack_pv(f32x16* o, int vb, const f32x16& p0, const f32x16& p1) {
    u32x4 w0, w1, w2, w3;
#pragma unroll
    for (int j = 0; j < 4; ++j) { w0[j] = cvtpk(p0[2 * j], p0[2 * j + 1]); w1[j] = cvtpk(p0[8 + 2 * j], p0[8 + 2 * j + 1]); w2[j] = cvtpk(p1[2 * j], p1[2 * j + 1]); w3[j] = cvtpk(p1[8 + 2 * j], p1[8 + 2 * j + 1]); }
    pv(o, vb, __builtin_bit_cast(bf16x8, w0), __builtin_bit_cast(bf16x8, w1), __builtin_bit_cast(bf16x8, w2), __builtin_bit_cast(bf16x8, w3));
}
__device__ __forceinline__ float rowmax32(const f32x16& p0, const f32x16& p1, int hi) {
    float a = max3f(p0[0], p0[1], p1[0]), b = max3f(p0[2], p0[3], p1[1]); a = max3f(a, p1[2], p1[3]);
#pragma unroll
    for (int r = 4; r < 16; r += 4) { a = max3f(a, p0[r], p0[r + 1]); b = max3f(b, p0[r + 2], p0[r + 3]); a = max3f(a, p1[r], p1[r + 1]); b = max3f(b, p1[r + 2], p1[r + 3]); }
    a = fmaxf(a, b);
    return fmaxf(a, other_half(a, hi));
}
__device__ __forceinline__ void store_o(const f32x16* o, const float* sc, lptr stgb, bf16* Ow, long rpitch, int lane, int r32, int hi) {
    LAS bf16* stg = (LAS bf16*)stgb;
#pragma unroll
    for (int r = 0; r < 16; ++r) { const int orow = crow(r, hi);
#pragma unroll
        for (int d0 = 0; d0 < 2; ++d0) stg[orow * 64 + d0 * 32 + r32] = (bf16)f2bf(o[d0][r] * sc[r]); }
    asm volatile("s_waitcnt lgkmcnt(0)" ::: "memory");
#pragma unroll
    for (int i = 0; i < 4; ++i) { const int row = i * 8 + (lane >> 3), ch = lane & 7; const u32x4 v = *(const LAS u32x4*)(stg + row * 64 + ch * 8); *(u32x4*)(Ow + (long)row * rpitch + ch * 8) = v; }
}
__device__ __forceinline__ void store_o8(const f32x16* o, const float* sc, lptr stgb, unsigned char* O8w, long rpitch, int lane, int r32, int hi) {
    LAS unsigned char* stg = (LAS unsigned char*)stgb;
#pragma unroll
    for (int r = 0; r < 16; ++r) { const int orow = crow(r, hi); const float s4 = sc[r] * (float)A8S;
        const int pk = __builtin_amdgcn_cvt_pk_fp8_f32(__builtin_amdgcn_fmed3f(o[0][r] * s4, -448.f, 448.f), __builtin_amdgcn_fmed3f(o[1][r] * s4, -448.f, 448.f), 0, false);
        stg[orow * 64 + r32] = (unsigned char)(pk & 0xff); stg[orow * 64 + 32 + r32] = (unsigned char)((pk >> 8) & 0xff); }
    asm volatile("s_waitcnt lgkmcnt(0)" ::: "memory");
#pragma unroll
    for (int i = 0; i < 2; ++i) { const int row = i * 16 + (lane >> 2), ch = lane & 3; const u32x4 v = *(const LAS u32x4*)(stg + row * 64 + ch * 16); *(u32x4*)(O8w + (long)row * rpitch + ch * 16) = v; }
}
__device__ __forceinline__ void softmax_step(f32x16& p0, f32x16& p1, float& mref, float& lsum, f32x16* o, LAS float* wsf, int r32, int hi) {
    const float rm = rowmax32(p0, p1, hi);
    const bool fresh = mref <= -1e30f;
    const bool want = !fresh && (rm > mref + THR);
    if (fresh) mref = fmaxf(rm, -1e30f);
    if (__any(want)) {
        const float dl = want ? rm - mref : 0.f; mref += dl; const float f = __builtin_amdgcn_exp2f(-dl); lsum *= f;
        if (hi == 0) wsf[r32] = f;
        asm volatile("s_waitcnt lgkmcnt(0)" ::: "memory");
#pragma unroll
        for (int r = 0; r < 16; ++r) { const float fr = wsf[crow(r, hi)]; o[0][r] *= fr; o[1][r] *= fr; }
    }
    float sa = 0.f, sb = 0.f;
#pragma unroll
    for (int r = 0; r < 16; ++r) { p0[r] = __builtin_amdgcn_exp2f(p0[r] - mref); p1[r] = __builtin_amdgcn_exp2f(p1[r] - mref); sa += p0[r]; sb += p1[r]; }
    lsum += sa + sb;
}

struct WaveCtx { int lane, r32, hi, wid; unsigned lds0; int vb0; lptr shm; };
struct UnitD { int NT; int b, h, qb, g, x; };

template <int MODE> struct CausalMode {
    const bf16* Q; const bf16* K; const bf16* V; bf16* O; int b, h, p; bool f8;
    float carry, mref, lsum; int done;
    static constexpr int AH = (MODE == 0) ? 6 : 4, SK = (MODE == 0) ? 3 : 0;
    __device__ __forceinline__ int skew(const WaveCtx& w) const { return MODE == 0 ? 3 - (w.wid >> 1) : 0; }
    __device__ __forceinline__ int units() const { return 4; }
    __device__ __forceinline__ void desc(int j, UnitD& d) const { d.b = b; d.h = h; d.qb = (j == 0) ? 7 - p : (j == 1) ? 5 - p : (j == 2) ? 2 + p : p; d.NT = 4 * (d.qb + 1); d.g = 0; d.x = 0; }
    __device__ __forceinline__ int tile_of(const UnitD& d, int k) const { return MODE == 0 ? d.NT - 1 - k : k; }
    __device__ __forceinline__ void q_load(const UnitD& d, const WaveCtx& w, bf16x8 (&q)[4]) const {
        const bf16* Qw = Q + ((long)d.b * SEQ + d.qb * 256 + w.wid * 32 + w.r32) * DM + d.h * 64 + w.hi * 8;
#pragma unroll
        for (int d0 = 0; d0 < 4; ++d0) q[d0] = gload16(Qw + d0 * 16);
    }
    __device__ __forceinline__ void dma(const UnitD& d, int k, int slot, const WaveCtx& w) const {
        const long row0 = (long)d.b * SEQ + 64 * tile_of(d, k);
        glds16(K + (row0 + w.lane) * DM + d.h * 64 + w.wid * 8, (unsigned)__builtin_amdgcn_readfirstlane(w.lds0 + L_K + slot * SLOTB + w.wid * 1024));
        glds16(V + (row0 + 16 * (w.wid & 3) + (w.lane >> 2)) * DM + d.h * 64 + (w.wid >> 2) * 32 + (w.lane & 3) * 8, (unsigned)__builtin_amdgcn_readfirstlane(w.lds0 + L_V + slot * SLOTB + w.wid * 1024));
    }
    __device__ __forceinline__ void begin(const UnitD&, const WaveCtx&) { carry = 1.0f; mref = -1e30f; lsum = 0.f; done = 0; }
    __device__ __forceinline__ int wave_done() const { return done; }
    __device__ __forceinline__ void compute(const UnitD& d, int k, int slot, const WaveCtx& w, const bf16x8* qr, f32x16* o) {
        const int T = tile_of(d, k), qfirst = d.qb * 256 + w.wid * 32, qpos = qfirst + w.r32;
        if (MODE == 0) {
            if (done || 64 * T >= qfirst + 31) return;
            f32x16 p0, p1; const f32x16 z = {}; qkt(p0, p1, w.shm + L_K + slot * SLOTB, qr, z, z, w.r32, w.hi);
            const bool diag = 64 * T + 63 >= qfirst;
            float ga[8];
#pragma unroll
            for (int a = 0; a < 8; ++a) {
                float rr[4];
#pragma unroll
                for (int i = 0; i < 4; ++i) { const int r = 4 * (a & 3) + i; const float zz = (a < 4) ? p0[r] : p1[r];
                    const float e = __builtin_amdgcn_exp2f(fminf(zz, 120.f)); float rv = __builtin_amdgcn_rcpf(1.0f + e);
                    if (diag) { const int kv = 64 * T + crow(r, w.hi) + ((a < 4) ? 0 : 32); if (kv >= qpos) rv = 1.0f; }
                    rr[i] = rv; if (a < 4) p0[r] = rv; else p1[r] = rv; }
                ga[a] = (rr[0] * rr[1]) * (rr[2] * rr[3]);
            }
            float oth[8], Ts[8];
#pragma unroll
            for (int a = 0; a < 8; ++a) oth[a] = other_half(ga[a], w.hi);
            float run = 1.0f;
#pragma unroll
            for (int a = 7; a >= 0; --a) { Ts[a] = run; run *= ga[a] * oth[a]; }
#pragma unroll
            for (int a = 0; a < 8; ++a) {
                float E = carry * Ts[a] * (w.hi ? 1.0f : oth[a]);
#pragma unroll
                for (int i = 3; i >= 0; --i) { const int r = 4 * (a & 3) + i; const float rv = (a < 4) ? p0[r] : p1[r]; const float wt = (1.0f - rv) * E; E *= rv; if (a < 4) p0[r] = wt; else p1[r] = wt; }
            }
            carry *= run;
            pack_pv(o, w.vb0 + slot * SLOTB, p0, p1);
            if (__all(carry < 1e-30f)) done = 1;
        } else {
            if (64 * T > qfirst + 31) return;
            LAS float* kbl = (LAS float*)(w.shm + L_KB);
            f32x16 c0, c1;
#pragma unroll
            for (int g = 0; g < 4; ++g) { const f32x4 k0 = *(const LAS f32x4*)(kbl + 64 * T + 8 * g + 4 * w.hi), k1 = *(const LAS f32x4*)(kbl + 64 * T + 32 + 8 * g + 4 * w.hi);
#pragma unroll
                for (int i = 0; i < 4; ++i) { c0[4 * g + i] = k0[i]; c1[4 * g + i] = k1[i]; } }
            f32x16 p0, p1; qkt(p0, p1, w.shm + L_K + slot * SLOTB, qr, c0, c1, w.r32, w.hi);
            if (64 * T + 63 > qfirst) {
#pragma unroll
                for (int r = 0; r < 16; ++r) { const int kv = 64 * T + crow(r, w.hi); if (kv > qpos) p0[r] = -INFINITY; if (kv + 32 > qpos) p1[r] = -INFINITY; } }
            softmax_step(p0, p1, mref, lsum, o, (LAS float*)(w.shm + L_WS) + w.wid * 64, w.r32, w.hi);
            pack_pv(o, w.vb0 + slot * SLOTB, p0, p1);
        }
    }
    __device__ __forceinline__ void finish(const UnitD& d, const WaveCtx& w, const f32x16* o) {
        LAS float* wsf = (LAS float*)(w.shm + L_WS) + w.wid * 64;
        float sc[16];
        if (MODE == 0) {
#pragma unroll
            for (int r = 0; r < 16; ++r) sc[r] = 1.0f;
        } else {
            float lt = lsum + other_half(lsum, w.hi);
            if (w.hi == 0) wsf[32 + w.r32] = lt;
            asm volatile("s_waitcnt lgkmcnt(0)" ::: "memory");
#pragma unroll
            for (int r = 0; r < 16; ++r) sc[r] = __builtin_amdgcn_rcpf(wsf[32 + crow(r, w.hi)]);
        }
        if (f8) store_o8(o, sc, w.shm + L_OST + w.wid * 4096, (unsigned char*)O + ((long)d.b * SEQ + d.qb * 256 + w.wid * 32) * DM + d.h * 64, DM, w.lane, w.r32, w.hi);
        else store_o(o, sc, w.shm + L_OST + w.wid * 4096, O + ((long)d.b * SEQ + d.qb * 256 + w.wid * 32) * DM + d.h * 64, DM, w.lane, w.r32, w.hi);
    }
};

struct DilMode {
    const bf16* PROJ; bf16* OG; float* ST; bf16* Of; int b, h, p, pass;
    float mref, lsum;
    static constexpr int AH = 4, SK = 0;
    __device__ __forceinline__ int skew(const WaveCtx&) const { return 0; }
    __device__ __forceinline__ int units() const { return pass == 0 ? 8 : 4; }
    __device__ __forceinline__ void desc(int j, UnitD& d) const {
        const int g = pass == 0 ? (j >> 2) : 2, i = j & 3; d.g = g; d.b = b; d.h = h; d.qb = 0;
        d.x = (g == 1) ? ((2 * (i >> 1) + p) << 1) + (i & 1) : 2 * i + p;
        const int i0 = (g == 0) ? 256 * d.x : (g == 1) ? 256 * (d.x & 1) : 0;
        d.NT = (g == 2) ? 4 : ((i0 >> 6) + 4 - t_lo(g, i0));
    }
    static __device__ __forceinline__ int t_lo(int g, int i0) { return (g == 2) ? 0 : ((i0 >> 6) >= 2 ? (i0 >> 6) - 2 : 0); }
    static __device__ __forceinline__ int dil_of(int g) { return (g == 0) ? 1 : (g == 1) ? 4 : 16; }
    static __device__ __forceinline__ int cls0_of(int g, int x) { return (g == 0) ? 0 : (g == 1) ? (x >> 1) : 2 * x; }
    static __device__ __forceinline__ int i0_of(int g, int x) { return (g == 0) ? 256 * x : (g == 1) ? 256 * (x & 1) : 0; }
    static __device__ __forceinline__ int tcls(int g, int x, int k) { return cls0_of(g, x) + ((g == 2) ? (k >> 1) : 0); }
    static __device__ __forceinline__ int kbase(int g, int x, int k) { return (g == 2) ? 64 * (k & 1) : 64 * (t_lo(g, i0_of(g, x)) + k); }
    __device__ __forceinline__ void q_load(const UnitD& d, const WaveCtx& w, bf16x8 (&q)[4]) const {
        const int dil = dil_of(d.g), clsw = cls0_of(d.g, d.x) + ((d.g == 2) ? (w.wid >> 2) : 0), qi0w = (d.g == 2) ? 32 * (w.wid & 3) : i0_of(d.g, d.x) + 32 * w.wid;
        const bf16* Qw = PROJ + (size_t)(2 * d.g) * PLANE + ((long)d.b * SEQ + clsw + (long)(qi0w + w.r32) * dil) * DM + d.h * 64 + w.hi * 8;
#pragma unroll
        for (int d0 = 0; d0 < 4; ++d0) q[d0] = gload16(Qw + d0 * 16);
    }
    __device__ __forceinline__ void dma(const UnitD& d, int k, int slot, const WaveCtx& w) const {
        const int dil = dil_of(d.g); const long tok0 = (long)d.b * SEQ + tcls(d.g, d.x, k) + (long)kbase(d.g, d.x, k) * dil;
        glds16(PROJ + (size_t)(2 * d.g + 1) * PLANE + (tok0 + (long)w.lane * dil) * DM + d.h * 64 + w.wid * 8, (unsigned)__builtin_amdgcn_readfirstlane(w.lds0 + L_K + slot * SLOTB + w.wid * 1024));
        glds16(PROJ + (size_t)6 * PLANE + (tok0 + (long)(16 * (w.wid & 3) + (w.lane >> 2)) * dil) * DM + d.h * 64 + (w.wid >> 2) * 32 + (w.lane & 3) * 8, (unsigned)__builtin_amdgcn_readfirstlane(w.lds0 + L_V + slot * SLOTB + w.wid * 1024));
    }
    __device__ __forceinline__ void begin(const UnitD&, const WaveCtx&) { mref = -1e30f; lsum = 0.f; }
    __device__ __forceinline__ int wave_done() const { return 0; }
    __device__ __forceinline__ void compute(const UnitD& d, int k, int slot, const WaveCtx& w, const bf16x8* qr, f32x16* o) {
        const int clsw = cls0_of(d.g, d.x) + ((d.g == 2) ? (w.wid >> 2) : 0), qi0w = (d.g == 2) ? 32 * (w.wid & 3) : i0_of(d.g, d.x) + 32 * w.wid;
        const int kb = kbase(d.g, d.x, k);
        if (tcls(d.g, d.x, k) != clsw || kb > qi0w + 31 || kb < qi0w - 191) return;
        LAS float* tbl = (LAS float*)(w.shm + L_KB) + d.g * 640 + 256;
        const int dbase = qi0w + w.r32 - kb - 4 * w.hi;
        f32x16 c0, c1;
#pragma unroll
        for (int r = 0; r < 16; ++r) { const int cr = (r & 3) + 8 * (r >> 2); c0[r] = tbl[dbase - cr]; c1[r] = tbl[dbase - cr - 32]; }
        f32x16 p0, p1; qkt(p0, p1, w.shm + L_K + slot * SLOTB, qr, c0, c1, w.r32, w.hi);
        softmax_step(p0, p1, mref, lsum, o, (LAS float*)(w.shm + L_WS) + w.wid * 64, w.r32, w.hi);
        pack_pv(o, w.vb0 + slot * SLOTB, p0, p1);
    }
    __device__ __forceinline__ void finish(const UnitD& d, const WaveCtx& w, const f32x16* o) {
        const int dil = dil_of(d.g), clsw = cls0_of(d.g, d.x) + ((d.g == 2) ? (w.wid >> 2) : 0), qi0w = (d.g == 2) ? 32 * (w.wid & 3) : i0_of(d.g, d.x) + 32 * w.wid;
        LAS float* wsf = (LAS float*)(w.shm + L_WS) + w.wid * 64;
        const float lt = lsum + other_half(lsum, w.hi);
        if (w.hi == 0) { wsf[32 + w.r32] = lt; wsf[w.r32] = mref;
            if (pass == 0) { const long tok = (long)d.b * SEQ + clsw + (long)(qi0w + w.r32) * dil;
                *(f32x2*)(ST + ((size_t)d.g * M * NH + (size_t)tok * NH + d.h) * 2) = (f32x2){mref, lt}; } }
        asm volatile("s_waitcnt lgkmcnt(0)" ::: "memory");
        float sc[16];
#pragma unroll
        for (int r = 0; r < 16; ++r) sc[r] = __builtin_amdgcn_rcpf(wsf[32 + crow(r, w.hi)]);
        if (pass == 0) { store_o(o, sc, w.shm + L_OST + w.wid * 4096, OG + (size_t)d.g * PLANE + ((long)d.b * SEQ + clsw + (long)qi0w * dil) * DM + d.h * 64, (long)dil * DM, w.lane, w.r32, w.hi); return; }
        LAS bf16* stg = (LAS bf16*)(w.shm + L_OST + w.wid * 4096);
#pragma unroll
        for (int r = 0; r < 16; ++r) { const int orow = crow(r, w.hi);
#pragma unroll
            for (int d0 = 0; d0 < 2; ++d0) stg[orow * 64 + d0 * 32 + w.r32] = (bf16)f2bf(o[d0][r] * sc[r]); }
        asm volatile("s_waitcnt lgkmcnt(0)" ::: "memory");
#pragma unroll
        for (int i = 0; i < 4; ++i) { const int row = i * 8 + (w.lane >> 3), ch = w.lane & 7;
            const long tok = (long)d.b * SEQ + clsw + (long)(qi0w + row) * dil;
            const f32x2 s0 = *(const f32x2*)(ST + ((size_t)0 * M * NH + (size_t)tok * NH + d.h) * 2), s1 = *(const f32x2*)(ST + ((size_t)1 * M * NH + (size_t)tok * NH + d.h) * 2);
            const float m2 = wsf[row], l2 = wsf[32 + row];
            const float mx = fmaxf(s0.x, fmaxf(s1.x, m2));
            float w0 = __builtin_amdgcn_exp2f(s0.x - mx) * s0.y, w1 = __builtin_amdgcn_exp2f(s1.x - mx) * s1.y, w2 = __builtin_amdgcn_exp2f(m2 - mx) * l2;
            const float inv = __builtin_amdgcn_rcpf(w0 + w1 + w2); w0 *= inv; w1 *= inv; w2 *= inv;
            const v4u x0 = *(const GAS v4u*)(OG + (size_t)tok * DM + d.h * 64 + ch * 8), x1 = *(const GAS v4u*)(OG + PLANE + (size_t)tok * DM + d.h * 64 + ch * 8);
            const v4u x2 = *(const LAS v4u*)(stg + row * 64 + ch * 8); v4u rr;
#pragma unroll
            for (int q = 0; q < 4; ++q) { const float lo = w0 * bflo(x0[q]) + w1 * bflo(x1[q]) + w2 * bflo(x2[q]), hi2 = w0 * bfhi(x0[q]) + w1 * bfhi(x1[q]) + w2 * bfhi(x2[q]);
                if (WO_FP8) rr[q] = (unsigned)__builtin_amdgcn_cvt_pk_fp8_f32(__builtin_amdgcn_fmed3f(lo * (float)A8S, -448.f, 448.f), __builtin_amdgcn_fmed3f(hi2 * (float)A8S, -448.f, 448.f), 0, false) & 0xffffu;
                else rr[q] = pk2(lo, hi2); }
            if (WO_FP8) *(GAS v2u*)((GAS unsigned char*)Of + (size_t)tok * DM + d.h * 64 + ch * 8) = (v2u){rr[0] | (rr[1] << 16), rr[2] | (rr[3] << 16)};
            else *(GAS v4u*)(Of + (size_t)tok * DM + d.h * 64 + ch * 8) = rr; }
    }
};

template <class Mode, bool EARLY_EXIT>
__device__ __forceinline__ void stream_units(Mode& Mo, const WaveCtx& w) {
    LAS int* flg = (LAS int*)(w.shm + L_FLG);
    const int nun = Mo.units();
    int pj = 0, pk = 0, pseq = 0, cseq = 0;
    UnitD pd; Mo.desc(0, pd);
    bf16x8 qn[4];
    if (EARLY_EXIT && w.wid == 0 && w.lane < 4) flg[w.lane] = 0;
    asm volatile("s_waitcnt vmcnt(0)" ::: "memory");
#define ATT_PRODUCE() do { if (pj < nun) { if (pk == 0) Mo.q_load(pd, w, qn); Mo.dma(pd, pk, pseq % NSLOT, w); ++pseq; if (++pk == pd.NT) { pk = 0; if (++pj < nun) Mo.desc(pj, pd); } } } while (0)
#pragma unroll 1
    for (int i = 0; i < Mode::AH; ++i) ATT_PRODUCE();
#pragma unroll 1
    for (int cj = 0; cj < nun; ++cj) {
        UnitD d; Mo.desc(cj, d);
        bf16x8 qr[4];
        f32x16 o[2]; o[0] = f32x16{}; o[1] = f32x16{};
        Mo.begin(d, w);
        const int useq0 = cseq;
        int rep = 0;
#pragma unroll 1
        while (pseq - cseq < Mode::AH && pj < nun) ATT_PRODUCE();
#pragma unroll 1
        for (int ck = 0; ck < d.NT; ++ck) {
            { int tt = cseq + Mode::SK; const int ul = useq0 + d.NT - 1; tt = tt > ul ? ul : tt; tt = tt > pseq - 1 ? pseq - 1 : tt; wait_bar(2 * (pseq - tt - 1)); }
            if (ck == 0) { asm volatile("" : "+v"(qn[0]), "+v"(qn[1]), "+v"(qn[2]), "+v"(qn[3])); qr[0] = qn[0]; qr[1] = qn[1]; qr[2] = qn[2]; qr[3] = qn[3]; }
            if (EARLY_EXIT && ck == 1 && w.wid == 0 && w.lane < 2) flg[((cj + 1) & 1) * 2 + w.lane] = 0;
            if (EARLY_EXIT && ck > 0) {
                if (__builtin_amdgcn_readfirstlane(flg[(cj & 1) * 2 + ((ck - 1) & 1)]) == 8) {
                    const int uend = useq0 + d.NT;
                    if (pj == cj) { pk = 0; if (++pj < nun) Mo.desc(pj, pd); }
                    cseq = uend < pseq ? uend : pseq;
                    break; } }
            if (pseq - cseq < Mode::AH) ATT_PRODUCE();
            { const int sk = Mo.skew(w); if (ck + sk < d.NT) Mo.compute(d, ck + sk, (cseq + sk) % NSLOT, w, qr, o); }
            if (EARLY_EXIT && Mo.wave_done() && rep < 2) { if (w.lane == 0) __hip_atomic_fetch_add(&flg[(cj & 1) * 2 + (ck & 1)], 1, __ATOMIC_RELAXED, __HIP_MEMORY_SCOPE_WORKGROUP); ++rep; }
            ++cseq;
        }
        Mo.finish(d, w, o);
    }
    asm volatile("s_waitcnt vmcnt(0) lgkmcnt(0)\n\ts_barrier" ::: "memory");
#undef ATT_PRODUCE
}
__device__ __forceinline__ WaveCtx make_ctx(lptr shm) {
    WaveCtx w; const int tid = threadIdx.x; w.lane = tid & 63; w.r32 = w.lane & 31; w.hi = w.lane >> 5; w.wid = __builtin_amdgcn_readfirstlane(tid >> 6);
    w.shm = shm; w.lds0 = (unsigned)(uintptr_t)shm;
    w.vb0 = (int)(w.lds0 + L_V) + ((w.lane >> 4) & 1) * 32 + (w.lane & 3) * 8 + (4 * w.hi + ((w.lane & 15) >> 2)) * 64;
    return w;
}
template <int MODE>
__device__ __forceinline__ void causal_phase(lptr shm, int G, const bf16* Q, const bf16* K, const bf16* V, bf16* O, const float* cum, bool f8) {
    const int bx = blockIdx.x; const int vcu = (G % 8 == 0) ? (bx % 8) * (G / 8) + bx / 8 : bx;
    const WaveCtx w = make_ctx(shm);
    for (int u = vcu; u < BATCH * NH * 2; u += G) {
        CausalMode<MODE> Mo; Mo.Q = Q; Mo.K = K; Mo.V = V; Mo.O = O; Mo.f8 = f8; Mo.b = u >> 5; Mo.h = (u >> 1) & 15; Mo.p = u & 1;
        if (MODE == 2) {
            LAS float* kbl = (LAS float*)(shm + L_KB); LAS float* wtot = (LAS float*)(shm + L_FLG + 64);
            const int t4 = threadIdx.x * 4; float v0, v1, v2, v3;
            { const float* lp = cum + ((long)Mo.b * SEQ + t4) * 16 + Mo.h; v0 = lp[0]; v1 = lp[16]; v2 = lp[32]; v3 = lp[48]; }
            v1 += v0; v2 += v1; v3 += v2;
            float incl = v3;
#pragma unroll
            for (int o = 1; o < 64; o <<= 1) { const float t = __shfl_up(incl, o); if (w.lane >= o) incl += t; }
            if (w.lane == 63) wtot[w.wid] = incl;
            __syncthreads();
            float off = incl - v3;
#pragma unroll
            for (int x = 0; x < 8; ++x) off += (x < w.wid) ? wtot[x] : 0.f;
            *(LAS f32x4*)(kbl + t4) = (f32x4){-(off + v0), -(off + v1), -(off + v2), -(off + v3)};
        }
        stream_units<CausalMode<MODE>, MODE == 0>(Mo, w);
    }
}
__device__ __forceinline__ int t5_bucket_f(int dist) {
    if (dist < 16) return dist;
    int lb = 16 + (int)(logf((float)dist / 16.0f) / logf(128.0f) * 16.0f);
    return lb < 31 ? lb : 31;
}
__device__ __forceinline__ void dil_phase(lptr shm, int G, const bf16* PROJ, bf16* OG, float* ST, const float* rel_bias, int pass, bf16* Of) {
    const int bx = blockIdx.x; const int vcu = (G % 8 == 0) ? (bx % 8) * (G / 8) + bx / 8 : bx;
    const WaveCtx w = make_ctx(shm);
    for (int u = vcu; u < BATCH * NH * 2; u += G) {
        DilMode Mo; Mo.PROJ = PROJ; Mo.OG = OG; Mo.ST = ST; Mo.Of = Of; Mo.pass = pass; Mo.b = u >> 5; Mo.h = (u >> 1) & 15; Mo.p = u & 1;
        LAS float* tb = (LAS float*)(shm + L_KB);
        for (int i = threadIdx.x; i < 3 * 640; i += NTHR) { const int gg = i / 640, dl = i - gg * 640 - 256; const int dil = (gg == 0) ? 1 : (gg == 1) ? 4 : 16;
            tb[i] = (dl >= 0 && dl <= 128) ? rel_bias[t5_bucket_f(dl * dil) * 16 + Mo.h] * LOG2E : -INFINITY; }
        stream_units<DilMode, false>(Mo, w);
    }
}
__device__ __forceinline__ void dil_merge(int G, const bf16* OG, const float* ST, bf16* O) {
    for (int idx = blockIdx.x * NTHR + threadIdx.x; idx < M * NH; idx += G * NTHR) {
        const f32x2 s0 = *(const f32x2*)(ST + ((size_t)0 * M * NH + idx) * 2), s1 = *(const f32x2*)(ST + ((size_t)1 * M * NH + idx) * 2), s2 = *(const f32x2*)(ST + ((size_t)2 * M * NH + idx) * 2);
        const float mx = fmaxf(s0.x, fmaxf(s1.x, s2.x));
        float w0 = __builtin_amdgcn_exp2f(s0.x - mx) * s0.y, w1 = __builtin_amdgcn_exp2f(s1.x - mx) * s1.y, w2 = __builtin_amdgcn_exp2f(s2.x - mx) * s2.y;
        const float inv = 1.0f / (w0 + w1 + w2); w0 *= inv; w1 *= inv; w2 *= inv;
        const GAS v4u* a0 = (const GAS v4u*)(OG + (size_t)idx * 64); const GAS v4u* a1 = (const GAS v4u*)(OG + PLANE + (size_t)idx * 64); const GAS v4u* a2 = (const GAS v4u*)(OG + 2 * PLANE + (size_t)idx * 64);
        GAS v4u* op = (GAS v4u*)(O + (size_t)idx * 64);
#pragma unroll
        for (int c = 0; c < 8; ++c) { const v4u x0 = a0[c], x1 = a1[c], x2 = a2[c]; v4u r;
#pragma unroll
            for (int q = 0; q < 4; ++q) r[q] = pk2(w0 * bflo(x0[q]) + w1 * bflo(x1[q]) + w2 * bflo(x2[q]), w0 * bfhi(x0[q]) + w1 * bfhi(x1[q]) + w2 * bfhi(x2[q]));
            op[c] = r; }
    }
}
}

enum { CV_PLAIN = 0, CV_QKN = 1, CV_GATE = 2, CV_UP = 3 };
__device__ __forceinline__ int cv_dst_row(int mode, int n) {
    if (mode == CV_QKN) return (n & ~255) + 128 * ((n >> 5) & 1) + 32 * ((n >> 6) & 3) + (n & 31);
    if (mode == CV_GATE) return 256 * (n >> 7) + (n & 127);
    if (mode == CV_UP) return 256 * (n >> 7) + 128 + (n & 127);
    return n;
}
__device__ __forceinline__ void conv_item(const float* W, int ldw, int K, bf16* WT, int mode, LAS unsigned char* scr, int item, int nblk, int lane) {
    const int kb = item / nblk, nb = item - kb * nblk, k0 = 64 * kb, n0 = 64 * nb;
    const GAS float* src = (const GAS float*)(W + (size_t)k0 * ldw + n0 + lane);
#pragma unroll
    for (int kc = 0; kc < 8; ++kc) {
        float v[8];
#pragma unroll
        for (int j = 0; j < 8; ++j) v[j] = src[(size_t)(kc * 8 + j) * ldw];
        v4u w; w.x = pk2(v[0], v[1]); w.y = pk2(v[2], v[3]); w.z = pk2(v[4], v[5]); w.w = pk2(v[6], v[7]);
        *(LAS v4u*)(scr + lane * 144 + kc * 16) = w;
    }
    asm volatile("s_waitcnt lgkmcnt(0)" ::: "memory");
#pragma unroll
    for (int j = 0; j < 8; ++j) { const int n = 8 * j + (lane >> 3), ch = lane & 7;
        const v4u w = *(const LAS v4u*)(scr + n * 144 + ch * 16);
        *(GAS v4u*)(WT + (size_t)cv_dst_row(mode, n0 + n) * K + k0 + 8 * ch) = w; }
    asm volatile("s_waitcnt lgkmcnt(0)" ::: "memory");
}
__device__ __forceinline__ void conv_item8(const float* W, int ldw, int K, unsigned char* WT8, int mode, LAS unsigned char* scr, int item, int nblk, int lane) {
    const int kb = item / nblk, nb = item - kb * nblk, k0 = 128 * kb, n0 = 64 * nb;
    const GAS float* src = (const GAS float*)(W + (size_t)k0 * ldw + n0 + lane);
#pragma unroll 4
    for (int kc = 0; kc < 16; ++kc) {
        float v[8];
#pragma unroll
        for (int j = 0; j < 8; ++j) v[j] = src[(size_t)(kc * 8 + j) * ldw] * W8S;
        v2u w; w.x = pg8::cvt4_fp8(v[0], v[1], v[2], v[3]); w.y = pg8::cvt4_fp8(v[4], v[5], v[6], v[7]);
        *(LAS v2u*)(scr + lane * 144 + kc * 8) = w;
    }
    asm volatile("s_waitcnt lgkmcnt(0)" ::: "memory");
#pragma unroll
    for (int j = 0; j < 8; ++j) { const int n = 8 * j + (lane >> 3), ch = lane & 7;
        const v4u w = *(const LAS v4u*)(scr + n * 144 + ch * 16);
        *(GAS v4u*)(WT8 + (size_t)cv_dst_row(mode, n0 + n) * K + k0 + 16 * ch) = w; }
    asm volatile("s_waitcnt lgkmcnt(0)" ::: "memory");
}
static_assert(MOE_FP8 && DILIN_FP8 && FOXIN_FP8 && QKV3_FP8 && DENSE_FP8_L2 && !DENSE_FP8_L0, "the conversion queue is laid out for this precision plan");
constexpr int CV_TOTAL = 28608;
static_assert(WO_FP8, "the conversion queue below holds e4m3 Wo weights for layers 1-3");
constexpr int cv_need(int p) {
    return p >= 24 ? 28608 : p >= 23 ? 25024 : p >= 21 ? 17856 : p >= 19 ? 17728 : p >= 18 ? 17344 : p >= 17 ? 16896 : p >= 16 ? 16000 : p >= 14 ? 15872 : p >= 12 ? 15488
         : p >= 11 ? 11904 : p >= 9 ? 4736 : p >= 6 ? 4608 : p >= 5 ? 3712 : p >= 4 ? 2816 : p >= 3 ? 1024 : p >= 1 ? 768 : 0;
}
__device__ __forceinline__ void cv_run_item(Frame& F, int idx) {
    LAS unsigned char* scr = F.lds + F.wave * 9216;
    unsigned char* WB8 = F.ws + WS_W;
    int inp, ldw, K, N, mode = CV_PLAIN, it; size_t soff = 0, doff; bool f8 = false;
    if (idx < 768)        { it = idx;         inp = 1;  ldw = 3 * DM; K = DM; N = 3 * DM; doff = WE_QKV * 2; }
    else if (idx < 1024)  { it = idx - 768;   inp = 2;  ldw = DM; K = DM; N = DM; doff = WE_WO_SB * 2; }
    else if (idx < 2816)  { const int l = idx - 1024, u = l >= 896; it = l - 896 * u; inp = 15 + u; ldw = FF; K = DM; N = FF; doff = WE_GU * 2; mode = u ? CV_UP : CV_GATE; }
    else if (idx < 3712)  { it = idx - 2816;  inp = 17; ldw = DM; K = FF; N = DM; doff = WE_D * 2; }
    else if (idx < 4608)  { it = idx - 3712;  inp = 3;  ldw = 7 * DM; K = DM; N = 7 * DM; doff = WE_IN_DIL * 2; mode = CV_QKN; f8 = true; }
    else if (idx < 4736)  { it = idx - 4608;  inp = 6;  ldw = DM; K = DM; N = DM; doff = WE_WO_DIL * 2; f8 = true; }
    else if (idx < 15872) {
        if (idx < 11904)      { const int l = idx - 4736, fe = l / 896, r = l - fe * 896, u = r >= 448; it = r - 448 * u; inp = 19 + u; ldw = FF; K = DM; N = FF; soff = (size_t)fe * DM * FF;
                                doff = WE_MGU * 2 + (size_t)fe * 2 * FF * DM; mode = u ? CV_UP : CV_GATE; f8 = true; }
        else if (idx < 15488) { const int l = idx - 11904, fe = l / 448; it = l - fe * 448; inp = 21; ldw = DM; K = FF; N = DM; soff = (size_t)fe * FF * DM; doff = WE_MD * 2 + (size_t)fe * DM * FF; f8 = true; }
        else                  { it = idx - 15488; inp = 7; ldw = 3088; K = DM; N = 3 * DM; doff = WE_IN_FOX * 2; mode = CV_QKN; f8 = true; }
    }
    else if (idx < 16000) { it = idx - 15872; inp = 11; ldw = DM; K = DM; N = DM; doff = WE_WO_FOX * 2; f8 = true; }
    else if (idx < 16896) { const int l = idx - 16000, u = l >= 448; it = l - 448 * u; inp = 15 + u; ldw = FF; K = DM; N = FF; soff = (size_t)DM * FF; doff = (WE_GU + (size_t)2 * FF * DM) * 2; mode = u ? CV_UP : CV_GATE; f8 = true; }
    else if (idx < 17344) { it = idx - 16896; inp = 17; ldw = DM; K = FF; N = DM; soff = (size_t)FF * DM; doff = (WE_D + (size_t)DM * FF) * 2; f8 = true; }
    else if (idx < 17728) { it = idx - 17344; inp = 1;  ldw = 3 * DM; K = DM; N = 3 * DM; soff = (size_t)DM * 3 * DM; doff = (WE_QKV + (size_t)3 * DM * DM) * 2; f8 = true; }
    else if (idx < 17856) { it = idx - 17728; inp = 2;  ldw = DM; K = DM; N = DM; soff = (size_t)DM * DM; doff = (WE_WO_SB + (size_t)DM * DM) * 2; f8 = true; }
    else if (idx < 25024) { const int l = idx - 17856, fe = 8 + l / 896, r = l - (fe - 8) * 896, u = r >= 448; it = r - 448 * u; inp = 19 + u; ldw = FF; K = DM; N = FF; soff = (size_t)fe * DM * FF;
                            doff = WE_MGU * 2 + (size_t)fe * 2 * FF * DM; mode = u ? CV_UP : CV_GATE; f8 = true; }
    else                  { const int l = idx - 25024, fe = 8 + l / 448; it = l - (fe - 8) * 448; inp = 21; ldw = DM; K = FF; N = DM; soff = (size_t)fe * FF * DM; doff = WE_MD * 2 + (size_t)fe * DM * FF; f8 = true; }
    const float* src = inp_ptr(F, inp) + soff;
    if (f8) conv_item8(src, ldw, K, WB8 + doff, mode, scr, it, N / 64, F.lane);
    else conv_item(src, ldw, K, (bf16*)(WB8 + doff), mode, scr, it, N / 64, F.lane);
}
__device__ __forceinline__ void cv_drain(Frame& F, int need) {
    if (need <= 0) return;
    volatile LAS int* cw = (volatile LAS int*)(F.lds + MISC_OFF) + 16;
    unsigned* nxt = (unsigned*)(F.ctl + CW_CVQ);
    asm volatile("s_waitcnt vmcnt(0)" ::: "memory");
    for (;;) {
        __syncthreads();
        if (F.tid == 0) { int b = -1; if ((int)xb_ld(nxt) < need) b = (int)xb_add(nxt, 8u); cw[0] = b; }
        __syncthreads();
        const int base = cw[0];
        if (base < 0) break;
        if (base + F.wave < CV_TOTAL) cv_run_item(F, base + F.wave);
    }
}
__device__ __forceinline__ void xcd_barrier_steal(const XcdBarrier& b, Frame& F) {
    asm volatile("s_waitcnt vmcnt(0)" ::: "memory");
    __syncthreads();
    volatile LAS int* cw = (volatile LAS int*)(F.lds + MISC_OFF) + 16;
    unsigned* bar = b.bar; unsigned* nxt = (unsigned*)(F.ctl + CW_CVQ);
    unsigned gen = 0u, tg = 0u; int role = 0;
    if (threadIdx.x == 0) {
        __builtin_amdgcn_s_waitcnt(0);
        unsigned nloc = b.st[0], nx = b.st[1];
        if (nloc == 0u) { xcd_barrier_complete(bar, b.x, nloc, nx); b.st[0] = nloc; b.st[1] = nx; }
        const unsigned old = xb_add(&bar[XB_XSUB(b.x)], 1u);
        gen = old / nloc;
        if (old + 1u == (gen + 1u) * nloc) {
            __builtin_amdgcn_fence(__ATOMIC_RELEASE, "agent");
            asm volatile("s_waitcnt vmcnt(0)" ::: "memory");
            const unsigned og = xb_add(&bar[XB_TOP], 1u);
            tg = og / nx;
            if (og + 1u == (tg + 1u) * nx) { xb_add(&bar[XB_TOPGEN], 1u); xb_add(&bar[XB_XGEN(b.x)], 1u); role = 0; }
            else role = 1;
        } else role = 2;
    }
    for (;;) {
        if (threadIdx.x == 0) {
            int rel = 1, base = -1;
            if (role == 1) { XB_SPIN(xb_ld(&bar[XB_TOPGEN]) == tg, bar); xb_add(&bar[XB_XGEN(b.x)], 1u); role = 0; }
            else if (role == 2) { if (xb_ld(&bar[XB_XGEN(b.x)]) == gen) rel = 0; }
            if (!rel) {
                if ((int)xb_ld(nxt) < CV_TOTAL) base = (int)xb_add(nxt, 8u);
                else { XB_SPIN(xb_ld(&bar[XB_XGEN(b.x)]) == gen, bar); rel = 1; }
            }
            cw[0] = rel; cw[1] = base;
        }
        __syncthreads();
        const int rel = cw[0], base = cw[1];
        __syncthreads();
        if (rel) break;
        if (base >= 0 && base + F.wave < CV_TOTAL) cv_run_item(F, base + F.wave);
    }
    if (threadIdx.x == 0) { __builtin_amdgcn_fence(__ATOMIC_ACQUIRE, "agent"); asm volatile("s_waitcnt vmcnt(0)" ::: "memory"); }
    __syncthreads();
}

__device__ __forceinline__ int moe_cnt(Frame& F, int f, int e) {
    const unsigned long long w = __hip_atomic_load((GAS unsigned long long*)(F.ctl + CW_CNT + f * 64 + 16 * (e >> 2)), RLX_AGENT);
    return (int)((w >> (16 * (e & 3))) & 0xffffull);
}
__device__ __forceinline__ f32x4 moe_yrow(Frame& F, int r, int q4) {
    const bf16* Y = (const bf16*)(F.ws + WS_R2); const bf16* P = (const bf16*)(F.ws + WS_R2 + 72 * MiB);
    if (r < SPLIT_ROW0 || F.G != 256 || !MOE_SPLITK) {
        if (MOE_Y_FP8) { const int a = ((const GAS int*)((const unsigned char*)Y + (size_t)r * DM))[q4]; const f32x2 lo = __builtin_amdgcn_cvt_pk_f32_fp8(a, false), hi = __builtin_amdgcn_cvt_pk_f32_fp8(a, true);
            return (f32x4){lo.x, lo.y, hi.x, hi.y} * (1.0f / Y8S); }
        const v2u a = ((const GAS v2u*)(Y + (size_t)r * DM))[q4]; return (f32x4){bflo(a.x), bfhi(a.x), bflo(a.y), bfhi(a.y)}; }
    f32x4 s = (f32x4){0.f, 0.f, 0.f, 0.f};
#pragma unroll
    for (int k = 0; k < MOE_NSPLIT; ++k) { const v2u a = ((const GAS v2u*)(P + ((size_t)k * SPLIT_ROWS + (size_t)(r - SPLIT_ROW0)) * DM))[q4]; s = s + (f32x4){bflo(a.x), bfhi(a.x), bflo(a.y), bfhi(a.y)}; }
    return s;
}
__device__ __forceinline__ void moe_bases(Frame& F, int f, int (&tb)[NE + 1]) {
    int acc = 0;
#pragma unroll
    for (int e = 0; e < NE; ++e) { tb[e] = acc; const int c = moe_cnt(F, f, e); acc += (c + 255) >> 8; }
    tb[NE] = acc;
}

template <int NC>
__device__ __forceinline__ float wave_reduce_cols(float (&part)[NC], int lane) {
#pragma unroll
    for (int st = 0, n = NC / 2; n >= 1; ++st, n >>= 1) {
        const bool up = (lane >> st) & 1;
#pragma unroll
        for (int i = 0; i < n; ++i) { const float keep = up ? part[i + n] : part[i], send = up ? part[i] : part[i + n]; part[i] = keep + __shfl_xor(send, 1 << st); }
    }
    float v = part[0];
#pragma unroll
    for (int o = NC; o < 64; o <<= 1) v += __shfl_xor(v, o);
    return v;
}
template <int NC> __device__ __forceinline__ int lane_of_col(int c) {
    int l = 0;
#pragma unroll
    for (int st = 0, n = NC / 2; n >= 1; ++st, n >>= 1) { if (c & n) l |= 1 << st; }
    return l;
}
__device__ __forceinline__ void panel_sync(Frame& F, const pg8::DenseOrder& S, unsigned* cnt) {
    if (F.tid == 0) {
        unsigned* bar = (unsigned*)(F.ctl + CW_BAR);
        const unsigned x = xb_xcc_id();
        bool mixed = false; pg8::Unit u;
        for (int i = 0; S.next(i, u); ++i) { unsigned w = 0u; XB_SPIN(((w = xb_ld(&cnt[u.pm])) & 15u) < 4u, bar); if (x >= 8u || ((w >> (4 + 3 * x)) & 7u) != 4u) mixed = true; }
        if (mixed) {
            __builtin_amdgcn_fence(__ATOMIC_RELEASE, "agent");
            asm volatile("s_waitcnt vmcnt(0)" ::: "memory");
            for (int i = 0; S.next(i, u); ++i) { const unsigned w = xb_ld(&cnt[u.pm]); if (x >= 8u || ((w >> (4 + 3 * x)) & 7u) != 4u) xb_add(&cnt[6 * 64 + u.pm], 1u); }
            for (int i = 0; S.next(i, u); ++i) { const unsigned w = xb_ld(&cnt[u.pm]); if (x >= 8u || ((w >> (4 + 3 * x)) & 7u) != 4u) XB_SPIN(xb_ld(&cnt[6 * 64 + u.pm]) < 4u, bar); }
        }
        __builtin_amdgcn_fence(__ATOMIC_ACQUIRE, "agent");
        asm volatile("s_waitcnt vmcnt(0)" ::: "memory");
    }
    __syncthreads();
}
template <int FLAGS>
__device__ __forceinline__ void norm_phase(Frame& F, const void* xin, void* xout, const float* gain, bf16* H, int fprev, int f,
                                           const float* Wf  , const float* bf  , const float* Wr  ,
                                           const pg8::DenseOrder* PS = nullptr, unsigned* pcnt = nullptr) {
    constexpr int NC = (FLAGS & 2) ? 16 : (FLAGS & 4) ? 8 : 0;
    const bf16* Y = (const bf16*)(F.ws + WS_R2);
    const int* tok_prev = (const int*)(F.ws + WS_MISC + MS_TOK) + (size_t)fprev * M * 2;
    float* lgf = (float*)(F.ws + WS_MISC + MS_LOGF);
    LAS int* sel = (LAS int*)F.lds;
    LAS float* sg = (LAS float*)(F.lds + 512);
    LAS int* gb = (LAS int*)(F.lds + 1536);
    LAS f32x4* WL = (LAS f32x4*)(F.lds + 4096);
    int tb[NE + 1];
    if (FLAGS & 1) moe_bases(F, fprev, tb);
    if (NC) {
        const float* Wsrc = (FLAGS & 2) ? Wf + 3072 : Wr; const int ldw = (FLAGS & 2) ? 3088 : 8;
        for (int idx = F.tid; idx < 16 * (NC / 4) * 64; idx += NTHR) {
            const int ln = idx & 63, cq = (idx >> 6) % (NC / 4), jq = idx / (64 * (NC / 4)), k = 4 * (ln + 64 * (jq >> 2)) + (jq & 3);
            WL[idx] = *(const GAS f32x4*)(Wsrc + (size_t)k * ldw + 4 * cq) * gain[k];
        }
        __syncthreads();
    }
    if (NC == 0 && !(FLAGS & 1)) {
        if (FLAGS & 64) panel_sync(F, *PS, pcnt);
        for (int it = 0;; ++it) {
            int chunk;
            if (FLAGS & 64) { pg8::Unit pu; if (!PS->next(it, pu)) break; chunk = pu.pm * 4 + pu.pn; }
            else { chunk = blockIdx.x + it * F.G; if (chunk >= M / 64) break; }
#pragma unroll 1
            for (int i = 0; i < 8; i += 4) {
                const int m0 = chunk * 64 + F.wave * 8 + i;
                int ln = F.lane; asm volatile("" : "+v"(ln));
                f32x4 v[4][4];
#pragma unroll
                for (int r = 0; r < 4; ++r) {
                    if (FLAGS & 16) { const GAS v2u* xr = (const GAS v2u*)((const bf16*)xin + (size_t)(m0 + r) * DM) + ln;
#pragma unroll
                        for (int j = 0; j < 4; ++j) { const v2u a = xr[64 * j]; v[r][j] = (f32x4){bflo(a.x), bfhi(a.x), bflo(a.y), bfhi(a.y)}; } }
                    else { const GAS f32x4* xr = (const GAS f32x4*)((const float*)xin + (size_t)(m0 + r) * DM) + ln;
#pragma unroll
                        for (int j = 0; j < 4; ++j) v[r][j] = xr[64 * j]; }
                }
                f32x4 g[4];
#pragma unroll
                for (int j = 0; j < 4; ++j) g[j] = ((const GAS f32x4*)gain + ln)[64 * j];
#pragma unroll
                for (int r = 0; r < 4; ++r) {
                    const int m = m0 + r;
                    if (FLAGS & 32) {
#pragma unroll
                        for (int j = 0; j < 4; ++j) ((GAS v2u*)((bf16*)xout + (size_t)m * DM) + ln)[64 * j] = (v2u){pk2(v[r][j].x, v[r][j].y), pk2(v[r][j].z, v[r][j].w)}; }
                    float s = 0.f;
#pragma unroll
                    for (int j = 0; j < 4; ++j) s += (v[r][j].x * v[r][j].x + v[r][j].y * v[r][j].y) + (v[r][j].z * v[r][j].z + v[r][j].w * v[r][j].w);
                    const float inv = 1.0f / sqrtf(wave_sum(s) * (1.f / DM) + RMS_EPS);
                    GAS unsigned long long* o8 = (GAS unsigned long long*)(H + (size_t)m * DM) + ln;
                    GAS unsigned* h8 = (GAS unsigned*)(F.ws + WS_R2 + 104 * MiB + (size_t)m * DM) + ln;
#pragma unroll
                    for (int j = 0; j < 4; ++j) { const f32x4 hv = v[r][j] * inv * g[j];
                        if (FLAGS & 8) h8[64 * j] = pg8::cvt4_fp8(hv.x, hv.y, hv.z, hv.w);
                        else o8[64 * j] = (unsigned long long)pk2(hv.x, hv.y) | ((unsigned long long)pk2(hv.z, hv.w) << 32); }
                }
            }
        }
        return;
    }
    if (FLAGS & 64) panel_sync(F, *PS, pcnt);
    for (int it = 0;; ++it) {
        int chunk;
        if (FLAGS & 64) { pg8::Unit pu; if (!PS->next(it, pu)) break; chunk = pu.pm * 4 + pu.pn; }
        else { chunk = blockIdx.x + it * F.G; if (chunk >= M / 64) break; }
        for (int i = 0; i < 8; ++i) {
            const int m = chunk * 64 + F.wave * 8 + i;
            int ln = F.lane; asm volatile("" : "+v"(ln));
            f32x4 v[4];
            if (FLAGS & 16) { const GAS v2u* xr = (const GAS v2u*)((const bf16*)xin + (size_t)m * DM) + ln;
#pragma unroll
                for (int j = 0; j < 4; ++j) { const v2u a = xr[64 * j]; v[j] = (f32x4){bflo(a.x), bfhi(a.x), bflo(a.y), bfhi(a.y)}; } }
            else { const GAS f32x4* xr = (const GAS f32x4*)((const float*)xin + (size_t)m * DM) + ln;
#pragma unroll
                for (int j = 0; j < 4; ++j) v[j] = xr[64 * j]; }
            if (FLAGS & 1) {
                const int s0 = tok_prev[m * 2], s1 = tok_prev[m * 2 + 1];
                int r0 = 0, r1 = 0;
#pragma unroll
                for (int e = 0; e < NE; ++e) { if ((s0 >> 14) == e) r0 = tb[e] * 256 + (s0 & 16383); if ((s1 >> 14) == e) r1 = tb[e] * 256 + (s1 & 16383); }
#pragma unroll
                for (int j = 0; j < 4; ++j) { v[j] = v[j] + moe_yrow(F, r0, ln + 64 * j) + moe_yrow(F, r1, ln + 64 * j);
                    ((GAS v2u*)((bf16*)xout + (size_t)m * DM) + ln)[64 * j] = (v2u){pk2(v[j].x, v[j].y), pk2(v[j].z, v[j].w)}; }
            }
            if (FLAGS & 32) {
#pragma unroll
                for (int j = 0; j < 4; ++j) ((GAS v2u*)((bf16*)xout + (size_t)m * DM) + ln)[64 * j] = (v2u){pk2(v[j].x, v[j].y), pk2(v[j].z, v[j].w)}; }
            float s = 0.f;
#pragma unroll
            for (int j = 0; j < 4; ++j) s += (v[j].x * v[j].x + v[j].y * v[j].y) + (v[j].z * v[j].z + v[j].w * v[j].w);
            const float inv = 1.0f / sqrtf(wave_sum(s) * (1.f / DM) + RMS_EPS);
            float colv = 0.f;
            if (NC) {
                float part[NC ? NC : 1];
#pragma unroll
                for (int c = 0; c < NC; ++c) part[c] = 0.f;
                const int woff = ln;
#pragma unroll
                for (int j = 0; j < 4; ++j) {
#pragma unroll
                    for (int q = 0; q < 4; ++q) { const float xv = v[j][q];
#pragma unroll
                        for (int cq = 0; cq < NC / 4; ++cq) { const f32x4 w = WL[((j * 4 + q) * (NC / 4) + cq) * 64 + woff];
                            part[cq * 4 + 0] += xv * w.x; part[cq * 4 + 1] += xv * w.y; part[cq * 4 + 2] += xv * w.z; part[cq * 4 + 3] += xv * w.w; }
                        if ((q & 1) == 1) asm volatile("" ::: "memory"); } }
                colv = wave_reduce_cols<NC ? NC : 2>(reinterpret_cast<float (&)[NC ? NC : 2]>(part), ln) * inv;
            }
            if (H) {
                GAS unsigned long long* o8 = (GAS unsigned long long*)(H + (size_t)m * DM) + ln;
                GAS unsigned* h8 = (GAS unsigned*)(F.ws + WS_R2 + 104 * MiB + (size_t)m * DM) + ln;
#pragma unroll
                for (int j = 0; j < 4; ++j) { const f32x4 g = ((const GAS f32x4*)gain + ln)[64 * j]; const f32x4 hv = v[j] * inv * g;
                    if (((FLAGS & 4) && MOE_FP8) || (FLAGS & 8)) h8[64 * j] = pg8::cvt4_fp8(hv.x, hv.y, hv.z, hv.w);
                    else o8[64 * j] = (unsigned long long)pk2(hv.x, hv.y) | ((unsigned long long)pk2(hv.z, hv.w) << 32); }
            }
            if (FLAGS & 2) {
                if (ln < 16) { const int l = ln; const int c = ((l & 1) << 3) | ((l & 2) << 1) | ((l & 4) >> 1) | ((l & 8) >> 3);
                    const float z = colv + bf[c]; const float ls = fminf(z, 0.f) - log1pf(expf(-fabsf(z))); lgf[(size_t)m * 16 + c] = ls * LOG2E; }
            }
            if (FLAGS & 4) {
                float lg[8];
#pragma unroll
                for (int c = 0; c < 8; ++c) lg[c] = __builtin_bit_cast(float, __builtin_amdgcn_readlane(__builtin_bit_cast(int, colv), lane_of_col<8>(c)));
                int e0 = 0; float l0 = lg[0];
#pragma unroll
                for (int c = 1; c < 8; ++c) if (lg[c] > l0) { l0 = lg[c]; e0 = c; }
                int e1 = -1; float l1 = -INFINITY;
#pragma unroll
                for (int c = 0; c < 8; ++c) if (c != e0 && lg[c] > l1) { l1 = lg[c]; e1 = c; }
                const float g0 = 1.0f / (1.0f + expf(l1 - l0)), g1 = 1.0f - g0;
                if (ln == 0) { const int r = F.wave * 8 + i; sel[r * 2] = e0; sel[r * 2 + 1] = e1; sg[r * 2] = g0; sg[r * 2 + 1] = g1; }
            }
        }
        if (FLAGS & 4) {
            int* selg = (int*)(F.ws + WS_MISC + MS_SEL) + (size_t)f * M * 2;
            float* sgg = (float*)(F.ws + WS_MISC + MS_SG) + (size_t)f * M * 2;
            int* lcn = (int*)(F.ws + WS_MISC + MS_LC) + (size_t)f * 256 * 8;
            __syncthreads();
            if (F.tid < 128) { selg[chunk * 128 + F.tid] = sel[F.tid]; sgg[chunk * 128 + F.tid] = sg[F.tid]; }
            if (F.tid >= 128 && F.tid < 136) { const int e = F.tid - 128; int c = 0;
                for (int q = 0; q < 128; ++q) c += (sel[q] == e) ? 1 : 0;
                lcn[chunk * 8 + e] = c; }
            __syncthreads();
        }
    }
}

__device__ __forceinline__ void moe_finalize(Frame& F, int f) {
    const int* selg = (const int*)(F.ws + WS_MISC + MS_SEL) + (size_t)f * M * 2;
    const float* sgg = (const float*)(F.ws + WS_MISC + MS_SG) + (size_t)f * M * 2;
    const int* lcn = (const int*)(F.ws + WS_MISC + MS_LC) + (size_t)f * 256 * 8;
    int* list = (int*)(F.ws + WS_MISC + MS_LIST) + (size_t)f * NE * LCAP;
    float* gw = (float*)(F.ws + WS_MISC + MS_GW) + (size_t)f * NE * LCAP;
    int* tok = (int*)(F.ws + WS_MISC + MS_TOK) + (size_t)f * M * 2;
    LAS int* arr = (LAS int*)F.lds;
    LAS int* sel = (LAS int*)(F.lds + 8192);
    LAS int* pb = (LAS int*)(F.lds + 8192 + 512);
    LAS int* pt = (LAS int*)(F.lds + 8192 + 1536);
    LAS int* base = (LAS int*)(F.lds + 8192 + 2560);
    LAS int* tot = (LAS int*)(F.lds + 8192 + 2592);
    for (int chunk = blockIdx.x; chunk < M / 64; chunk += F.G) {
        if (F.tid < 256) { const v4u a = *(const GAS v4u*)(lcn + F.tid * 8), b = *(const GAS v4u*)(lcn + F.tid * 8 + 4);
            *(LAS v4u*)(arr + F.tid * 8) = a; *(LAS v4u*)(arr + F.tid * 8 + 4) = b; }
        if (F.tid < 128) sel[F.tid] = selg[chunk * 128 + F.tid];
        __syncthreads();
        if (F.tid < 256) { const int e = F.tid & 7, seg = F.tid >> 3; int b = 0, t = 0;
#pragma unroll
            for (int i = 0; i < 8; ++i) { const int c = seg * 8 + i; const int v = arr[c * 8 + e]; t += v; b += (c < chunk) ? v : 0; }
            pb[seg * 8 + e] = b; pt[seg * 8 + e] = t; }
        __syncthreads();
        if (F.tid < 8) { int b = 0, t = 0;
            for (int sgm = 0; sgm < 32; ++sgm) { b += pb[sgm * 8 + F.tid]; t += pt[sgm * 8 + F.tid]; }
            base[F.tid] = b; tot[F.tid] = t; }
        __syncthreads();
        if (F.tid < 128) { const int mye = sel[F.tid]; int lp = 0;
            for (int q = 0; q < 128; ++q) lp += (q < F.tid && sel[q] == mye) ? 1 : 0;
            const int q = F.tid, row = chunk * 64 + (q >> 1), pos = base[mye] + lp;
            list[mye * LCAP + pos] = row; gw[mye * LCAP + pos] = sgg[chunk * 128 + q]; tok[row * 2 + (q & 1)] = mye * LCAP + pos; }
        if (chunk == 0 && F.tid < 2) { unsigned long long w = 0ull;
#pragma unroll
            for (int i = 0; i < 4; ++i) w |= (unsigned long long)(unsigned)tot[4 * F.tid + i] << (16 * i);
            __hip_atomic_store((GAS unsigned long long*)(F.ctl + CW_CNT + f * 64 + 16 * F.tid), w, RLX_AGENT); }
        __syncthreads();
    }
}

__device__ __forceinline__ void final_combine(Frame& F, int f) {
    const bf16* Y = (const bf16*)(F.ws + WS_R2);
    const int* tok = (const int*)(F.ws + WS_MISC + MS_TOK) + (size_t)f * M * 2;
    int tb[NE + 1]; moe_bases(F, f, tb);
    for (int m = blockIdx.x * NWAVES + F.wave; m < M; m += F.G * NWAVES) {
        const int s0 = tok[m * 2], s1 = tok[m * 2 + 1]; int r0 = 0, r1 = 0;
#pragma unroll
        for (int e = 0; e < NE; ++e) { if ((s0 >> 14) == e) r0 = tb[e] * 256 + (s0 & 16383); if ((s1 >> 14) == e) r1 = tb[e] * 256 + (s1 & 16383); }
        GAS f32x4* xo = (GAS f32x4*)(F.out + (size_t)m * DM) + F.lane;
        const GAS v2u* xr = (const GAS v2u*)((const bf16*)(F.ws + WS_XB) + (size_t)m * DM) + F.lane;
#pragma unroll
        for (int j = 0; j < 4; ++j) { const v2u a = xr[64 * j]; xo[64 * j] = (f32x4){bflo(a.x), bfhi(a.x), bflo(a.y), bfhi(a.y)} + moe_yrow(F, r0, F.lane + 64 * j) + moe_yrow(F, r1, F.lane + 64 * j); }
    }
}

template <int NB> __device__ __forceinline__ void stagger_convert(Frame& F) {
    if ((((int)blockIdx.x >> 3) & 1) == 0) return;
    volatile LAS int* cw = (volatile LAS int*)(F.lds + MISC_OFF) + 16;
    unsigned* nxt = (unsigned*)(F.ctl + CW_CVQ);
    for (int r = 0; r < NB; ++r) {
        __syncthreads();
        if (F.tid == 0) { int b = -1; if ((int)xb_ld(nxt) < CV_TOTAL) b = (int)xb_add(nxt, 8u); cw[0] = b; }
        __syncthreads();
        const int base = cw[0];
        if (base < 0) break;
        if (base + F.wave < CV_TOTAL) cv_run_item(F, base + F.wave);
    }
    __syncthreads();
}
template <class Epi, bool FP8 = false>
__device__ __forceinline__ void dense_gemm(Frame& F, const bf16* A, const bf16* Bt, int N, int K, const Epi& E) {
    pg8::DenseOrder S; S.init(A, Bt, M, N, K, F.G, (int)blockIdx.x);
    pg8::gemm_phase<Epi, pg8::DenseOrder, false, FP8>(F.lds, K, S, E);
}
template <int NFLAGS, class Epi, bool FP8 = false>
__device__ __forceinline__ void resid_gemm_norm(Frame& F, int site, const bf16* A, const bf16* Bt, int K, const Epi& E, const void* X, const float* gain, bf16* H, int f, const float* Wr) {
    pg8::DenseOrder S; S.init(A, Bt, M, DM, K, F.G, (int)blockIdx.x);
    pg8::gemm_phase<Epi, pg8::DenseOrder, false, FP8>(F.lds, K, S, E);
    unsigned* cnt = (unsigned*)(F.ctl + CW_PANEL + site * 64);
    asm volatile("s_waitcnt vmcnt(0)" ::: "memory");
    __syncthreads();
    if (F.tid == 0) {
        const unsigned x = xb_xcc_id(); pg8::Unit u;
        for (int i = 0; S.next(i, u); ++i) xb_add(&cnt[u.pm], 1u + (x < 8u ? (1u << (4 + 3 * x)) : 0u));
    }
    norm_phase<NFLAGS | 16 | 64>(F, X, nullptr, gain, H, 0, f, nullptr, nullptr, Wr, &S, cnt);
}
__device__ __forceinline__ void moe_order_init(Frame& F, int f, pg8::MoeOrder& S) {
    int acc = 0, t[NE];
#pragma unroll
    for (int e = 0; e < NE; ++e) { const int c = moe_cnt(F, f, e); acc += (c + 255) >> 8; t[e] = acc; }
    S.t1 = t[0]; S.t2 = t[1]; S.t3 = t[2]; S.t4 = t[3]; S.t5 = t[4]; S.t6 = t[5]; S.t7 = t[6]; S.t8 = t[7];
    S.G = F.G; S.c = (int)blockIdx.x;
}
__device__ __forceinline__ void moe_gu_fast(Frame& F, int f, const bf16* H, bf16* ACT) {
    pg8::MoeOrder S; moe_order_init(F, f, S);
    S.list = (const int*)(F.ws + WS_MISC + MS_LIST) + (size_t)f * NE * LCAP; S.gather = true; S.splitk = 0; S.xcdperm = false; S.nN = 2 * FF / 256;
    if (MOE_FP8) {
        S.K = DM / 2; S.A = (const char*)(F.ws + WS_R2 + 104 * MiB); S.Bt = (const char*)((const bf16*)(F.ws + WS_W) + WE_MGU) + (size_t)f * NE * 2 * FF * DM;
        S.tstepA = (size_t)256 * DM; S.tstepB = (size_t)256 * DM; S.estepB = (size_t)2 * FF * DM;
        pg8::EpiSwigluF8 E{(unsigned char*)ACT};
        pg8::gemm_phase<pg8::EpiSwigluF8, pg8::MoeOrder, true, true>(F.lds, DM / 2, S, E);
    } else {
        S.K = DM; S.A = (const char*)H; S.Bt = (const char*)((const bf16*)(F.ws + WS_W) + WE_MGU + (size_t)f * NE * 2 * FF * DM);
        S.tstepA = (size_t)256 * DM * 2; S.tstepB = (size_t)256 * DM * 2; S.estepB = (size_t)2 * FF * DM * 2;
        pg8::EpiSwiglu E{ACT};
        pg8::gemm_phase<pg8::EpiSwiglu, pg8::MoeOrder, true>(F.lds, DM, S, E);
    }
}
__device__ __forceinline__ void moe_down_fast(Frame& F, int f, const bf16* ACT, bf16* Y) {
    pg8::MoeOrder S; moe_order_init(F, f, S);
    S.nN = DM / 256; S.list = nullptr; S.gather = false; S.xcdperm = (F.G == 256); S.splitk = (MOE_SPLITK && F.G == 256) ? MOE_NSPLIT : 0;
    const float* gwp = (const float*)(F.ws + WS_MISC + MS_GW) + (size_t)f * NE * LCAP; bf16* P = (bf16*)(F.ws + WS_R2 + 72 * MiB);
    if (MOE_FP8) {
        S.K = FF / 2; S.A = (const char*)ACT; S.Bt = (const char*)((const bf16*)(F.ws + WS_W) + WE_MD) + (size_t)f * NE * DM * FF;
        S.tstepA = (size_t)256 * FF; S.tstepB = (size_t)256 * FF; S.estepB = (size_t)DM * FF;
        pg8::EpiMoeDown E{Y, gwp, P, 1.0f / (W8S * A8S)};
        pg8::gemm_phase<pg8::EpiMoeDown, pg8::MoeOrder, false, true>(F.lds, FF / 2, S, E);
    } else {
        S.K = FF; S.A = (const char*)ACT; S.Bt = (const char*)((const bf16*)(F.ws + WS_W) + WE_MD + (size_t)f * NE * DM * FF);
        S.tstepA = (size_t)256 * FF * 2; S.tstepB = (size_t)256 * FF * 2; S.estepB = (size_t)DM * FF * 2;
        pg8::EpiMoeDown E{Y, gwp, P, 1.0f};
        pg8::gemm_phase<pg8::EpiMoeDown, pg8::MoeOrder, false>(F.lds, FF, S, E);
    }
}

struct Args { const float* in[22]; float* out; unsigned char* ws; int ph_lo, ph_hi; };
constexpr int N_PHASES = 26;

__global__ void __launch_bounds__(NTHR, 2) trunk_fwd(Args args) {
    extern __shared__ __attribute__((aligned(16))) unsigned char lds[];
    Frame F;
    F.lds = (LAS unsigned char*)lds;
    F.tid = threadIdx.x; F.lane = F.tid & 63; F.wave = __builtin_amdgcn_readfirstlane(F.tid >> 6); F.G = gridDim.x;
    F.ws = args.ws; F.ctl = (gu32*)(args.ws + WS_CTL); F.out = args.out;
    if (F.tid == 0) {
#pragma unroll
        for (int i = 0; i < 22; ++i) ((LAS unsigned long long*)(F.lds + PTR_OFF))[i] = (unsigned long long)args.in[i];
    }
    volatile LAS unsigned* MISC = (volatile LAS unsigned*)(F.lds + MISC_OFF);
    if (F.tid < 32) MISC[F.tid] = 0u;
    __syncthreads();
    XcdBarrier bar; bar.bar = (unsigned*)(F.ctl + CW_BAR); bar.x = 0; bar.st = nullptr;
    const int lo = args.ph_lo, hi = args.ph_hi;
    if (hi - lo > 1) bar = xcd_barrier_post((unsigned*)(F.ctl + CW_BAR), MISC + 8);
#ifndef PHSEL
#define PHSEL 0xFFFFFFFFFFFFFFFFull
#endif
#define IN(k) (lo <= (k) && (k) < hi && ((PHSEL >> (k)) & 1ull) && relaunder(F))
#define SEAM(k) do { if (IN((k) + 1) && IN(k)) xcd_barrier_steal(bar, F); } while (0)
#ifndef DUPMASK
#define DUPMASK 0ull
#endif
#define DUP(k) (((DUPMASK >> (k)) & 1ull) != 0ull)

    bf16* H = (bf16*)(F.ws + WS_H);
    bf16* PROJ = (bf16*)(F.ws + WS_R1);
    bf16* ACT = (bf16*)(F.ws + WS_R1);
    bf16* O = (bf16*)(F.ws + WS_R2);
    bf16* Y = (bf16*)(F.ws + WS_R2);
    bf16* OG = (bf16*)(F.ws + WS_R2 + 32 * MiB);
    float* ST = (float*)(F.ws + WS_R2 + 128 * MiB);
    bf16* X = (bf16*)(F.ws + WS_XB);
    const bf16* H8 = (const bf16*)(F.ws + WS_R2 + 104 * MiB);
    float* DUMMY = (float*)(F.ws + WS_R2 + 32 * MiB);
    const float* cum = (const float*)(F.ws + WS_MISC + MS_LOGF);

    const bf16* WB = (const bf16*)(F.ws + WS_W);
    enum { PH_BASE = __COUNTER__ + 1 };
#define PHASE(...) { constexpr int k_ = __COUNTER__ - PH_BASE; if (IN(k_)) { __VA_ARGS__; cv_drain(F, cv_need(k_ + 1)); SEAM(k_); } }
    PHASE({ unsigned* z = (unsigned*)(F.ws + WS_MISC + MS_LIST);
            for (int i = blockIdx.x * NTHR + F.tid; i < (int)(2 * MiB / 4); i += F.G * NTHR) z[i] = 0u;
            norm_phase<32>(F, INP(0), X, INP(13) + 0 * DM, H, 0, 0, nullptr, nullptr, nullptr); })
    PHASE({ stagger_convert<1>(F); pg8::EpiPlanes E{PROJ, C2, 1.0f}; dense_gemm(F, H, WB + WE_QKV, 3 * DM, DM, E); })
    PHASE(att::causal_phase<0>((att::lptr)F.lds, F.G, PROJ, PROJ + PLANE, PROJ + 2 * PLANE, O, nullptr, false))
    PHASE({ pg8::EpiResid<false> E{X, X, 1.0f}; resid_gemm_norm<(DENSE_FP8_L0 ? 8 : 0)>(F, 0, O, WB + WE_WO_SB, DM, E, X, INP(14) + 0 * DM, H, 0, nullptr); })
    PHASE({ stagger_convert<1>(F);
            if (DENSE_FP8_L0) { pg8::EpiSwigluF8 E{(unsigned char*)ACT}; dense_gemm<pg8::EpiSwigluF8, true>(F, H8, (const bf16*)((const unsigned char*)(WB + WE_GU)), 2 * FF, DM / 2, E); }
            else { pg8::EpiSwiglu E{ACT}; dense_gemm(F, H, WB + WE_GU, 2 * FF, DM, E); } })
    PHASE({ if (DENSE_FP8_L0) { pg8::EpiResid<false> E{X, X, 1.0f / (W8S * A8S)}; resid_gemm_norm<(DILIN_FP8 ? 8 : 0), pg8::EpiResid<false>, true>(F, 1, ACT, (const bf16*)((const unsigned char*)(WB + WE_D)), FF / 2, E, X, INP(13) + 1 * DM, H, 0, nullptr); }
            else { pg8::EpiResid<false> E{X, X, 1.0f}; resid_gemm_norm<(DILIN_FP8 ? 8 : 0)>(F, 1, ACT, WB + WE_D, FF, E, X, INP(13) + 1 * DM, H, 0, nullptr); } })
    PHASE({ stagger_convert<1>(F);
            if (DILIN_FP8) { pg8::EpiQKNorm E{PROJ, INP(4), INP(5), 6, 1.0f / W8S}; dense_gemm<pg8::EpiQKNorm, true>(F, H8, WB + WE_IN_DIL, 7 * DM, DM / 2, E); }
            else { pg8::EpiQKNorm E{PROJ, INP(4), INP(5), 6, 1.0f}; dense_gemm(F, H, WB + WE_IN_DIL, 7 * DM, DM, E); } })
    PHASE(att::dil_phase((att::lptr)F.lds, F.G, PROJ, OG, ST, INP(12), 0, O))
    PHASE(att::dil_phase((att::lptr)F.lds, F.G, PROJ, OG, ST, INP(12), 1, O))
    PHASE({ if (WO_FP8) { pg8::EpiResid<false> E{X, X, 1.0f / (W8S * A8S)}; resid_gemm_norm<4, pg8::EpiResid<false>, true>(F, 2, O, WB + WE_WO_DIL, DM / 2, E, X, INP(14) + 1 * DM, H, 0, INP(18) + 0 * DM * NE); }
            else { pg8::EpiResid<false> E{X, X, 1.0f}; resid_gemm_norm<4>(F, 2, O, WB + WE_WO_DIL, DM, E, X, INP(14) + 1 * DM, H, 0, INP(18) + 0 * DM * NE); } })
    PHASE(moe_finalize(F, 0))
    PHASE({ stagger_convert<1>(F); moe_gu_fast(F, 0, H, ACT); })
    PHASE(moe_down_fast(F, 0, ACT, Y))
    PHASE(norm_phase<(1 | 2 | (FOXIN_FP8 ? 8 : 0)) | 16>(F, X, X, INP(13) + 2 * DM, H, 0, 0, INP(7), INP(8), nullptr))
    PHASE({ stagger_convert<1>(F);
            if (FOXIN_FP8) { pg8::EpiQKNorm E{PROJ, INP(9), INP(10), 2, 1.0f / W8S}; dense_gemm<pg8::EpiQKNorm, true>(F, H8, WB + WE_IN_FOX, 3 * DM, DM / 2, E); }
            else { pg8::EpiQKNorm E{PROJ, INP(9), INP(10), 2, 1.0f}; dense_gemm(F, H, WB + WE_IN_FOX, 3 * DM, DM, E); } })
    PHASE(att::causal_phase<2>((att::lptr)F.lds, F.G, PROJ, PROJ + PLANE, PROJ + 2 * PLANE, O, cum, WO_FP8))
    PHASE({ if (WO_FP8) { pg8::EpiResid<false> E{X, X, 1.0f / (W8S * A8S)}; resid_gemm_norm<(DENSE_FP8_L2 ? 8 : 0), pg8::EpiResid<false>, true>(F, 3, O, WB + WE_WO_FOX, DM / 2, E, X, INP(14) + 2 * DM, H, 0, nullptr); }
            else { pg8::EpiResid<false> E{X, X, 1.0f}; resid_gemm_norm<(DENSE_FP8_L2 ? 8 : 0)>(F, 3, O, WB + WE_WO_FOX, DM, E, X, INP(14) + 2 * DM, H, 0, nullptr); } })
    PHASE({ stagger_convert<1>(F);
            if (DENSE_FP8_L2) { pg8::EpiSwigluF8 E{(unsigned char*)ACT}; dense_gemm<pg8::EpiSwigluF8, true>(F, H8, WB + WE_GU + (size_t)2 * FF * DM, 2 * FF, DM / 2, E); }
            else { pg8::EpiSwiglu E{ACT}; dense_gemm(F, H, WB + WE_GU + (size_t)2 * FF * DM, 2 * FF, DM, E); } })
    PHASE({ if (DENSE_FP8_L2) { pg8::EpiResid<false> E{X, X, 1.0f / (W8S * A8S)}; resid_gemm_norm<(QKV3_FP8 ? 8 : 0), pg8::EpiResid<false>, true>(F, 4, ACT, WB + WE_D + (size_t)DM * FF, FF / 2, E, X, INP(13) + 3 * DM, H, 0, nullptr); }
            else { pg8::EpiResid<false> E{X, X, 1.0f}; resid_gemm_norm<(QKV3_FP8 ? 8 : 0)>(F, 4, ACT, WB + WE_D + (size_t)DM * FF, FF, E, X, INP(13) + 3 * DM, H, 0, nullptr); } })
    PHASE({ stagger_convert<1>(F);
            if (QKV3_FP8) { pg8::EpiPlanes E{PROJ, C2, 1.0f / W8S}; dense_gemm<pg8::EpiPlanes, true>(F, H8, WB + WE_QKV + (size_t)3 * DM * DM, 3 * DM, DM / 2, E); }
            else { pg8::EpiPlanes E{PROJ, C2, 1.0f}; dense_gemm(F, H, WB + WE_QKV + (size_t)3 * DM * DM, 3 * DM, DM, E); } })
    PHASE(att::causal_phase<0>((att::lptr)F.lds, F.G, PROJ, PROJ + PLANE, PROJ + 2 * PLANE, O, nullptr, WO_FP8))
    PHASE({ if (WO_FP8) { pg8::EpiResid<false> E{X, X, 1.0f / (W8S * A8S)}; resid_gemm_norm<4, pg8::EpiResid<false>, true>(F, 5, O, WB + WE_WO_SB + (size_t)DM * DM, DM / 2, E, X, INP(14) + 3 * DM, H, 1, INP(18) + 1 * DM * NE); }
            else { pg8::EpiResid<false> E{X, X, 1.0f}; resid_gemm_norm<4>(F, 5, O, WB + WE_WO_SB + (size_t)DM * DM, DM, E, X, INP(14) + 3 * DM, H, 1, INP(18) + 1 * DM * NE); } })
    PHASE(moe_finalize(F, 1))
    PHASE({ stagger_convert<1>(F); moe_gu_fast(F, 1, H, ACT); })
    PHASE(moe_down_fast(F, 1, ACT, Y))
    PHASE(final_combine(F, 1))
    static_assert(__COUNTER__ - PH_BASE == N_PHASES, "N_PHASES must equal the number of PHASE() sites");
#undef PHASE
#undef IN
#undef SEAM
}

extern "C" void kernel_launch(void* const* d_in, const int* in_sizes, int n_in, void* d_out, int out_size, void* d_ws, size_t ws_size, hipStream_t stream) {
    static int grid = 0;
    if (grid == 0) {
        if (n_in != 22 || out_size != M * DM || ws_size < WS_END) { fprintf(stderr, "kernel_launch: unexpected shapes (n_in %d out %d ws %zu)\n", n_in, out_size, ws_size); grid = -1; return; }
        int dev = 0, cus = 0, per_cu = 0;
        if (hipGetDevice(&dev) != hipSuccess || hipDeviceGetAttribute(&cus, hipDeviceAttributeMultiprocessorCount, dev) != hipSuccess) { grid = -1; return; }
        if (hipFuncSetAttribute((const void*)trunk_fwd, hipFuncAttributeMaxDynamicSharedMemorySize, LDS_BYTES) != hipSuccess) { fprintf(stderr, "kernel_launch: hipFuncSetAttribute failed\n"); grid = -1; return; }
        if (hipOccupancyMaxActiveBlocksPerMultiprocessor(&per_cu, (const void*)trunk_fwd, NTHR, LDS_BYTES) != hipSuccess || per_cu < 1) fprintf(stderr, "kernel_launch: occupancy query says %d\n", per_cu);
        (void)hipGetLastError();
        grid = cus;
    }
    if (grid < 0) return;
    (void)hipMemsetAsync((char*)d_ws + WS_CTL, 0, CTL_ZERO_BYTES, stream);
    Args a{};
    for (int i = 0; i < 22; ++i) a.in[i] = (const float*)d_in[i];
    a.out = (float*)d_out; a.ws = (unsigned char*)d_ws;
#if MK_MULTI
    for (int p = 0; p < N_PHASES; ++p) { a.ph_lo = p; a.ph_hi = p + 1; hipLaunchKernelGGL(trunk_fwd, dim3(grid), dim3(NTHR), LDS_BYTES, stream, a); }
#else
    a.ph_lo = 0; a.ph_hi = N_PHASES;
    hipLaunchKernelGGL(trunk_fwd, dim3(grid), dim3(NTHR), LDS_BYTES, stream, a);
#endif
}
```

```cpp
#include <hip/hip_runtime.h>
#include <cstdio>
#include <cstdint>

#ifndef MK_MULTI
#define MK_MULTI 0
#endif

constexpr int BATCH = 8, SEQ = 2048, DM = 1024, NH = 16, HD = 64, FF = 3584, NE = 8;
constexpr int M = BATCH * SEQ;
constexpr float RMS_EPS = 1e-6f;
constexpr float LOG2E = 1.4426950408889634f;
constexpr float C2 = 0.125f * LOG2E;
constexpr int NWAVES = 8, NTHR = 512;
constexpr int LCAP = 16384;
constexpr int MAXROWS = 34816;
constexpr bool MOE_SPLITK = true;
constexpr bool MOE_FP8 = true;
constexpr bool DILIN_FP8 = true;
constexpr bool FOXIN_FP8 = true;
constexpr bool QKV3_FP8 = true;
constexpr bool DENSE_FP8_L0 = false, DENSE_FP8_L2 = true;
constexpr float W8S = 32.0f, A8S = 4.0f;
constexpr int MOE_NSPLIT = MOE_FP8 ? 2 : 4;
constexpr int SPLIT_ROW0 = 32768, SPLIT_ROWS = MAXROWS - SPLIT_ROW0;

constexpr size_t MiB = 1u << 20;
constexpr size_t WS_CTL = 0, CTL_ZERO_BYTES = 1 * MiB;
constexpr size_t WS_MISC = 1 * MiB;
constexpr size_t WS_H = 6 * MiB;
constexpr size_t WS_R1 = 38 * MiB;
constexpr size_t WS_R2 = 278 * MiB;
constexpr size_t WS_W = 414 * MiB;
constexpr size_t WS_XB = 832 * MiB;
constexpr size_t WS_END = 864 * MiB;
constexpr size_t PLANE = (size_t)M * DM;
constexpr size_t WE_QKV = 0;
constexpr size_t WE_WO_SB = WE_QKV + 2ull * 3072 * 1024;
constexpr size_t WE_WO_DIL = WE_WO_SB + 2ull * 1024 * 1024;
constexpr size_t WE_WO_FOX = WE_WO_DIL + 1024ull * 1024;
constexpr size_t WE_IN_DIL = WE_WO_FOX + 1024ull * 1024;
constexpr size_t WE_IN_FOX = WE_IN_DIL + 7168ull * 1024;
constexpr size_t WE_GU = WE_IN_FOX + 3072ull * 1024;
constexpr size_t WE_D = WE_GU + 2ull * 7168 * 1024;
constexpr size_t WE_MGU = WE_D + 2ull * 1024 * 3584;
constexpr size_t WE_MD = WE_MGU + 16ull * 7168 * 1024;
constexpr size_t WE_END = WE_MD + 16ull * 1024 * 3584;
static_assert(WS_W + WE_END * 2 <= WS_END, "weight copies fit");
constexpr size_t MS_LIST = 0;
constexpr size_t MS_GW = 1 * MiB;
constexpr size_t MS_TOK = 2 * MiB;
constexpr size_t MS_LOGF = 2 * MiB + 256 * 1024;
constexpr size_t MS_CUM = 3 * MiB + 256 * 1024;
constexpr size_t MS_SEL = 4 * MiB + 256 * 1024;
constexpr size_t MS_SG = MS_SEL + 256 * 1024;
constexpr size_t MS_LC = MS_SG + 256 * 1024;
constexpr int CW_BAR = 4096;
constexpr int CW_PANEL = 1024;
constexpr bool MOE_Y_FP8 = true;
constexpr float Y8S = 16.0f;
constexpr bool WO_FP8 = true;
constexpr int CW_XMASK = 2112;
constexpr int CW_LBAR = 2176;
constexpr int CW_CVQ = 2048;
constexpr int CW_CNT = 64;

#define GAS __attribute__((address_space(1)))
#define LAS __attribute__((address_space(3)))
typedef unsigned short bf16;
typedef unsigned v4u __attribute__((ext_vector_type(4)));
typedef unsigned v2u __attribute__((ext_vector_type(2)));
typedef float f32x4 __attribute__((ext_vector_type(4)));
typedef float f32x2 __attribute__((ext_vector_type(2)));
typedef GAS unsigned gu32;
#define RLX_AGENT __ATOMIC_RELAXED, __HIP_MEMORY_SCOPE_AGENT
__device__ __forceinline__ unsigned f2bf(float f) { unsigned u = __builtin_bit_cast(unsigned, f); return (u + 0x7fffu + ((u >> 16) & 1u)) >> 16; }
__device__ __forceinline__ unsigned pk2(float lo, float hi) { return f2bf(lo) | (f2bf(hi) << 16); }
__device__ __forceinline__ float bflo(unsigned u) { return __builtin_bit_cast(float, u << 16); }
__device__ __forceinline__ float bfhi(unsigned u) { return __builtin_bit_cast(float, u & 0xffff0000u); }

#define XB_TMO      128
#define XB_XCNT(j)  (256  + 64 * (j))
#define XB_XSUB(j)  (1280 + 64 * (j))
#define XB_XGEN(j)  (2304 + 64 * (j))
#define XB_TOP      3328
#define XB_TOPGEN   3392
#define XCD_BAR_WORDS 3456
#define XB_SPIN_CAP (1u << 22)
__device__ __forceinline__ unsigned xb_ld(unsigned* p)              { return __hip_atomic_load(p, __ATOMIC_RELAXED, __HIP_MEMORY_SCOPE_AGENT); }
__device__ __forceinline__ unsigned xb_add(unsigned* p, unsigned v) { return __hip_atomic_fetch_add(p, v, __ATOMIC_RELAXED, __HIP_MEMORY_SCOPE_AGENT); }
__device__ __forceinline__ unsigned xb_xcc_id() { return (unsigned)__builtin_amdgcn_s_getreg((3 << 11) | 20) & 0xFu; }
#define XB_SPIN(cond, bar) do { unsigned _sp = 0; while (cond) { __builtin_amdgcn_s_sleep(1); \
    if ((++_sp & 255u) == 0u) { if (xb_ld(&(bar)[XB_TMO])) break; if (_sp > XB_SPIN_CAP) { atomicAdd(&(bar)[XB_TMO], 1u); break; } } } } while (0)
struct XcdBarrier { unsigned* bar; unsigned x; volatile LAS unsigned* st; };
__device__ __forceinline__ XcdBarrier xcd_barrier_post(unsigned* bar, volatile LAS unsigned* st) {
    XcdBarrier b; b.bar = bar; b.x = xb_xcc_id(); b.st = st;
    if (threadIdx.x == 0) (void)xb_add(&bar[XB_XCNT(b.x)], 1u);
    return b;
}
__device__ __forceinline__ void xcd_barrier_complete(unsigned* bar, unsigned x, unsigned& nloc, unsigned& nx) {
    const unsigned G = gridDim.x * gridDim.y * gridDim.z;
    unsigned sum, cnt, mine, sp = 0u;
    for (;;) {
        sum = 0u; cnt = 0u; mine = 0u;
#pragma unroll
        for (unsigned j = 0; j < 16; ++j) { const unsigned c = xb_ld(&bar[XB_XCNT(j)]); sum += c; cnt += (c > 0u) ? 1u : 0u; mine = (j == x) ? c : mine; }
        if (sum == G) break;
        __builtin_amdgcn_s_sleep(1);
        if ((++sp & 255u) == 0u) { if (xb_ld(&bar[XB_TMO])) break; if (sp > XB_SPIN_CAP) { atomicAdd(&bar[XB_TMO], 1u); break; } }
    }
    nloc = mine > 0u ? mine : 1u; nx = cnt > 0u ? cnt : 1u;
}
__device__ __forceinline__ void xcd_barrier(const XcdBarrier& b) {
    asm volatile("s_waitcnt vmcnt(0)" ::: "memory");
    __syncthreads();
    if (threadIdx.x == 0) {
        unsigned* bar = b.bar;
        __builtin_amdgcn_s_waitcnt(0);
        unsigned nloc = b.st[0], nx = b.st[1];
        if (nloc == 0u) { xcd_barrier_complete(bar, b.x, nloc, nx); b.st[0] = nloc; b.st[1] = nx; }
        const unsigned old = xb_add(&bar[XB_XSUB(b.x)], 1u);
        const unsigned gen = old / nloc;
        if (old + 1u == (gen + 1u) * nloc) {
            __builtin_amdgcn_fence(__ATOMIC_RELEASE, "agent");
            asm volatile("s_waitcnt vmcnt(0)" ::: "memory");
            const unsigned og = xb_add(&bar[XB_TOP], 1u);
            const unsigned tg = og / nx;
            if (og + 1u == (tg + 1u) * nx) xb_add(&bar[XB_TOPGEN], 1u);
            else XB_SPIN(xb_ld(&bar[XB_TOPGEN]) == tg, bar);
            xb_add(&bar[XB_XGEN(b.x)], 1u);
            __builtin_amdgcn_fence(__ATOMIC_ACQUIRE, "agent");
            asm volatile("s_waitcnt vmcnt(0)" ::: "memory");
        } else {
            XB_SPIN(xb_ld(&bar[XB_XGEN(b.x)]) == gen, bar);
            __builtin_amdgcn_fence(__ATOMIC_ACQUIRE, "agent");
            asm volatile("s_waitcnt vmcnt(0)" ::: "memory");
        }
    }
    __syncthreads();
}

constexpr int LDS_BYTES = 147456;
constexpr int ATT_LDS_MAX = 143360;
constexpr int MISC_OFF = ATT_LDS_MAX + 64;
struct Frame {
    LAS unsigned char* lds;
    int tid, lane, wave, G;
    unsigned char* ws; gu32* ctl;
    float* out;
};
__device__ __forceinline__ float wave_sum(float v) {
#pragma unroll
    for (int o = 1; o < 64; o <<= 1) v += __shfl_xor(v, o);
    return v;
}

constexpr int PTR_OFF = ATT_LDS_MAX + 512;
__device__ __forceinline__ const float* inp_ptr(Frame& F, int k) {
    const LAS unsigned* t = (const LAS unsigned*)(F.lds + PTR_OFF) + 2 * k;
    const unsigned lo = __builtin_amdgcn_readfirstlane(t[0]), hi = __builtin_amdgcn_readfirstlane(t[1]);
    return (const float*)(((unsigned long long)hi << 32) | lo);
}
#define INP(k) inp_ptr(F, (k))
__device__ __forceinline__ bool relaunder(Frame& F) { int t_ = threadIdx.x; asm volatile("" : "+v"(t_)); F.tid = t_; F.lane = t_ & 63; F.wave = __builtin_amdgcn_readfirstlane(t_ >> 6); return true; }
namespace pg8 {
#define PG8_LAS __attribute__((address_space(3)))
typedef unsigned short bf16_t;
typedef short bf16x8 __attribute__((ext_vector_type(8)));
typedef unsigned u32x4 __attribute__((ext_vector_type(4)));
constexpr int BM = 256, BK = 64, HALF = 128, HTB = HALF * BK * 2, STAGE_BYTES = 8 * HTB, NXCD = 8, WGM = 8;
__host__ __device__ __forceinline__ int lds_byte(int r, int c) { const int st = (r >> 4) * 2 + (c >> 5), rr = r & 15, cc = c & 31, ob = rr * 64 + cc * 2; return st * 1024 + (ob ^ (((ob >> 9) & 1) << 5)); }
__host__ __device__ __forceinline__ void stage_rc(int b, int& R, int& C) { const int st = b / 1024, sb = b % 1024, swz = sb ^ (((sb >> 9) & 1) << 5); R = (st >> 1) * 16 + swz / 64; C = (st & 1) * 32 + (swz % 64) / 2; }
__host__ __device__ __forceinline__ int perm32(int rho) { const int n = rho >> 4, i = rho & 15; return 8 * (i >> 2) + 4 * n + (i & 3); }
struct Unit { int pm, pn, e, mt, nt, koff, kq; };

struct DenseOrder {
    int nM, nN, nwg, G, c, ntk; const char* A; const char* Bt; size_t tstep;
    __device__ __forceinline__ void init(const bf16_t* A_, const bf16_t* Bt_, int M_, int N_, int K_, int G_, int c_) { nM = M_ / BM; nN = N_ / BM; nwg = nM * nN; G = G_; c = c_; ntk = K_ / BK; A = (const char*)A_; Bt = (const char*)Bt_; tstep = (size_t)BM * K_ * 2; }
    __device__ __forceinline__ bool next(int i, Unit& u) const {
        const long L = (long)i * G + c; if (L >= nwg) return false;
        int wgid = (int)L; { const int q = nwg / NXCD, r = nwg % NXCD, xcd = wgid % NXCD, off = wgid / NXCD; wgid = (xcd < r ? xcd * (q + 1) : r * (q + 1) + (xcd - r) * q) + off; }
        const int nig = WGM * nN, gid = wgid / nig, fm = gid * WGM, gsz = (nM - fm) < WGM ? (nM - fm) : WGM;
        u.pm = fm + ((wgid % nig) % gsz); u.pn = (wgid % nig) / gsz; u.e = 0; u.mt = u.pm; u.nt = ntk; u.koff = 0; u.kq = -1; return true;
    }
    __device__ __forceinline__ const char* a_base(const Unit& u) const { return A + (size_t)u.pm * tstep; }
    __device__ __forceinline__ const char* b_base(const Unit& u) const { return Bt + (size_t)u.pn * tstep; }
    __device__ __forceinline__ void a_voff(const Unit&, const int (&)[2], const int (&)[2], unsigned (&)[2][2]) const {}
};
struct MoeOrder {
    int t1, t2, t3, t4, t5, t6, t7, t8, nN, G, c, K; const char* A; const char* Bt; size_t tstepA, tstepB, estepB; const int* list; bool gather; int splitk; bool xcdperm;
    __device__ __forceinline__ bool next(int i, Unit& u) const {
        const int X = i * G + c, U = t8 * nN; int L = X; u.nt = K / BK; u.koff = 0; u.kq = -1;
        if (splitk) { const int nfull = (U / G) * G;
            if (X >= nfull) { const int q = X - nfull; if (q >= splitk * (U - nfull)) return false; L = nfull + q / splitk; u.kq = q % splitk; u.nt = K / BK / splitk; u.koff = u.kq * (K / splitk) * 2; } }
        else if (X >= U) return false;
        if (xcdperm && u.kq < 0) {
            const int rnd = L / G, q = L - rnd * G, j = q >> 3, x = q & 7; L = rnd * G + (((j >> 2) * 8 + x) << 2) + (j & 3); }
        const int mt = L / nN; u.pm = mt; u.pn = L - mt * nN;
        const int e = (mt >= t1) + (mt >= t2) + (mt >= t3) + (mt >= t4) + (mt >= t5) + (mt >= t6) + (mt >= t7);
        const int tb = e == 0 ? 0 : e == 1 ? t1 : e == 2 ? t2 : e == 3 ? t3 : e == 4 ? t4 : e == 5 ? t5 : e == 6 ? t6 : t7;
        u.e = e; u.mt = mt - tb; return true;
    }
    __device__ __forceinline__ const char* a_base(const Unit& u) const { return (gather ? A : A + (size_t)u.pm * tstepA) + u.koff; }
    __device__ __forceinline__ const char* b_base(const Unit& u) const { return Bt + (size_t)u.e * estepB + (size_t)u.pn * tstepB + u.koff; }
    __device__ __forceinline__ void a_voff(const Unit& u, const int (&sR)[2], const int (&sC)[2], unsigned (&v)[2][2]) const {
        const int* lp = list + u.e * LCAP + u.mt * 256;
#pragma unroll
        for (int h = 0; h < 2; ++h)
#pragma unroll
            for (int i = 0; i < 2; ++i) v[h][i] = (unsigned)lp[h * 128 + sR[i]] * (unsigned)(K * 2) + (unsigned)(sC[i] * 2);
    }
};

typedef int v8i32 __attribute__((ext_vector_type(8)));
typedef int v4i32 __attribute__((ext_vector_type(4)));
__device__ __forceinline__ v8i32 cat8(bf16x8 a, bf16x8 b) { const v4i32 x = __builtin_bit_cast(v4i32, a), y = __builtin_bit_cast(v4i32, b); return (v8i32){x[0], x[1], x[2], x[3], y[0], y[1], y[2], y[3]}; }
__device__ __forceinline__ unsigned cvt4_fp8(float a, float b, float c, float d) { int w = 0; w = __builtin_amdgcn_cvt_pk_fp8_f32(a, b, w, false); w = __builtin_amdgcn_cvt_pk_fp8_f32(c, d, w, true); return (unsigned)w; }
__device__ __forceinline__ const char* uniptr(const char* p) { const unsigned long long v = (unsigned long long)p; const unsigned lo = __builtin_amdgcn_readfirstlane((unsigned)v), hi = __builtin_amdgcn_readfirstlane((unsigned)(v >> 32)); return (const char*)(((unsigned long long)hi << 32) | lo); }
__device__ __forceinline__ void glds16_s(const char* sbase, unsigned voff, unsigned lds_dst) { unsigned keep;
    asm volatile("s_mov_b32 %0, m0\n\ts_mov_b32 m0, %3\n\ts_nop 0\n\tglobal_load_lds_dwordx4 %2, %1\n\ts_mov_b32 m0, %0" : "=&s"(keep) : "s"(sbase), "v"(voff), "s"(lds_dst) : "memory"); }
__device__ __forceinline__ unsigned cvt_pk_bf16(float lo, float hi) { unsigned r; asm volatile("v_cvt_pk_bf16_f32 %0, %1, %2" : "=v"(r) : "v"(lo), "v"(hi)); return r; }

struct EpiPlanes {
    static constexpr bool PERM = true;
    bf16_t* O; float scale0; float oscale;
    __device__ __forceinline__ void operator()(const f32x4 (&acc)[2][2][4][2], const Unit& u, int wr, int wc, int fr, int fq) const {
        const int plane = u.pn >> 2; const float sc = (plane == 0 ? scale0 : 1.f) * oscale;
        bf16_t* base = O + (size_t)plane * PLANE + (size_t)(u.pm * BM + wr * 64 + fr) * DM + (u.pn & 3) * 256 + wc * 32 + 8 * fq;
#pragma unroll
        for (int ai = 0; ai < 2; ++ai)
#pragma unroll
            for (int m = 0; m < 4; ++m) { bf16_t* rowp = base + (size_t)(ai * HALF + m * 16) * DM;
#pragma unroll
                for (int bj = 0; bj < 2; ++bj) { const f32x4 v0 = acc[ai][bj][m][0] * sc, v1 = acc[ai][bj][m][1] * sc;
                    u32x4 w; w.x = cvt_pk_bf16(v0[0], v0[1]); w.y = cvt_pk_bf16(v0[2], v0[3]); w.z = cvt_pk_bf16(v1[0], v1[1]); w.w = cvt_pk_bf16(v1[2], v1[3]);
                    *(u32x4*)(rowp + bj * HALF) = w; } }
    }
};
struct EpiQKNorm {
    static constexpr bool PERM = true;
    bf16_t* O; const float* qg; const float* kg; int vplane; float iscale;
    __device__ __forceinline__ void operator()(const f32x4 (&acc)[2][2][4][2], const Unit& u, int wr, int wc, int fr, int fq) const {
        const int plane = u.pn >> 2; const bool isv = plane == vplane; const bool isq = !isv && ((plane & 1) == 0); const int grp = plane >> 1;
        const float* g = (isq ? qg : kg) + grp * 64 + 8 * fq;
        f32x4 gv[2][2];
#pragma unroll
        for (int bj = 0; bj < 2; ++bj)
#pragma unroll
            for (int n = 0; n < 2; ++n) gv[bj][n] = isv ? (f32x4){1.f, 1.f, 1.f, 1.f} : *(const f32x4*)(g + 32 * bj + 4 * n);
        const float mul = isq ? C2 : 1.f;
        bf16_t* base = O + (size_t)plane * PLANE + (size_t)(u.pm * BM + wr * 64 + fr) * DM + (u.pn & 3) * 256 + wc * 64 + 8 * fq;
#pragma unroll
        for (int ai = 0; ai < 2; ++ai)
#pragma unroll
            for (int m = 0; m < 4; ++m) { bf16_t* rowp = base + (size_t)(ai * HALF + m * 16) * DM;
                float ss = 0.f;
#pragma unroll
                for (int bj = 0; bj < 2; ++bj)
#pragma unroll
                    for (int n = 0; n < 2; ++n) { const f32x4 x = acc[ai][bj][m][n] * iscale; ss += (x[0] * x[0] + x[1] * x[1]) + (x[2] * x[2] + x[3] * x[3]); }
                ss += __shfl_xor(ss, 16); ss += __shfl_xor(ss, 32);
                const float inv = (isv ? 1.f : mul * __builtin_amdgcn_rsqf(ss * (1.f / 64.f) + RMS_EPS)) * iscale;
#pragma unroll
                for (int bj = 0; bj < 2; ++bj) { const f32x4 v0 = acc[ai][bj][m][0] * inv * gv[bj][0], v1 = acc[ai][bj][m][1] * inv * gv[bj][1];
                    u32x4 w; w.x = cvt_pk_bf16(v0[0], v0[1]); w.y = cvt_pk_bf16(v0[2], v0[3]); w.z = cvt_pk_bf16(v1[0], v1[1]); w.w = cvt_pk_bf16(v1[2], v1[3]);
                    *(u32x4*)(rowp + bj * 32) = w; } }
    }
};
struct EpiSwiglu {
    static constexpr bool PERM = true;
    bf16_t* O;
    __device__ __forceinline__ void operator()(const f32x4 (&acc)[2][2][4][2], const Unit& u, int wr, int wc, int fr, int fq) const {
        bf16_t* base = O + (size_t)(u.pm * BM + wr * 64 + fr) * FF + u.pn * 128 + wc * 32 + 8 * fq;
#pragma unroll
        for (int ai = 0; ai < 2; ++ai)
#pragma unroll
            for (int m = 0; m < 4; ++m) { bf16_t* rowp = base + (size_t)(ai * HALF + m * 16) * FF;
                f32x2 o[4];
#pragma unroll
                for (int n = 0; n < 2; ++n)
#pragma unroll
                    for (int hh = 0; hh < 2; ++hh) { const f32x2 ga = {acc[ai][0][m][n][2 * hh], acc[ai][0][m][n][2 * hh + 1]}, ua = {acc[ai][1][m][n][2 * hh], acc[ai][1][m][n][2 * hh + 1]};
                        const f32x2 m1 = ga * (-LOG2E); f32x2 e; e.x = __builtin_amdgcn_exp2f(m1.x); e.y = __builtin_amdgcn_exp2f(m1.y);
                        const f32x2 sden = e + 1.0f; f32x2 r; r.x = __builtin_amdgcn_rcpf(sden.x); r.y = __builtin_amdgcn_rcpf(sden.y);
                        o[n * 2 + hh] = (ga * ua) * r; }
                u32x4 w; w.x = cvt_pk_bf16(o[0].x, o[0].y); w.y = cvt_pk_bf16(o[1].x, o[1].y); w.z = cvt_pk_bf16(o[2].x, o[2].y); w.w = cvt_pk_bf16(o[3].x, o[3].y);
                *(u32x4*)rowp = w; }
    }
};
struct EpiSwigluF8 {
    static constexpr bool PERM = true;
    unsigned char* O;
    __device__ __forceinline__ void operator()(const f32x4 (&acc)[2][2][4][2], const Unit& u, int wr, int wc, int fr, int fq) const {
        unsigned char* base = O + (size_t)(u.pm * BM + wr * 64 + fr) * FF + u.pn * 128 + wc * 32 + 8 * fq;
        constexpr float k1 = -LOG2E / W8S, ik2 = W8S * W8S / A8S;
#pragma unroll
        for (int ai = 0; ai < 2; ++ai)
#pragma unroll
            for (int m = 0; m < 4; ++m) { unsigned char* rowp = base + (size_t)(ai * HALF + m * 16) * FF;
                f32x2 o[4];
#pragma unroll
                for (int n = 0; n < 2; ++n)
#pragma unroll
                    for (int hh = 0; hh < 2; ++hh) { const f32x2 ga = {acc[ai][0][m][n][2 * hh], acc[ai][0][m][n][2 * hh + 1]}, ua = {acc[ai][1][m][n][2 * hh], acc[ai][1][m][n][2 * hh + 1]};
                        const f32x2 m1 = ga * k1; f32x2 e; e.x = __builtin_amdgcn_exp2f(m1.x); e.y = __builtin_amdgcn_exp2f(m1.y);
                        const f32x2 sden = e * ik2 + ik2; f32x2 r; r.x = __builtin_amdgcn_rcpf(sden.x); r.y = __builtin_amdgcn_rcpf(sden.y);
                        const f32x2 t = (ga * ua) * r; o[n * 2 + hh] = (f32x2){__builtin_amdgcn_fmed3f(t.x, -448.f, 448.f), __builtin_amdgcn_fmed3f(t.y, -448.f, 448.f)}; }
                v2u w; w.x = cvt4_fp8(o[0].x, o[0].y, o[1].x, o[1].y); w.y = cvt4_fp8(o[2].x, o[2].y, o[3].x, o[3].y);
                *(v2u*)rowp = w; }
    }
};
template <bool BASE_F32>
struct EpiResid {
    static constexpr bool PERM = true;
    const void* base; bf16_t* out; float oscale;
    __device__ __forceinline__ void operator()(const f32x4 (&acc)[2][2][4][2], const Unit& u, int wr, int wc, int fr, int fq) const {
        const size_t off0 = (size_t)(u.pm * BM + wr * 64 + fr) * DM + u.pn * BM + wc * 32 + 8 * fq;
#pragma unroll
        for (int ai = 0; ai < 2; ++ai)
#pragma unroll
            for (int m = 0; m < 4; ++m) { const size_t off = off0 + (size_t)(ai * HALF + m * 16) * DM;
#pragma unroll
                for (int bj = 0; bj < 2; ++bj) { f32x4 b0, b1;
                    if (BASE_F32) { b0 = *(const f32x4*)((const float*)base + off + bj * HALF); b1 = *(const f32x4*)((const float*)base + off + bj * HALF + 4); }
                    else { const u32x4 w = *(const u32x4*)((const bf16_t*)base + off + bj * HALF);
                        b0 = (f32x4){__builtin_bit_cast(float, w.x << 16), __builtin_bit_cast(float, w.x & 0xffff0000u), __builtin_bit_cast(float, w.y << 16), __builtin_bit_cast(float, w.y & 0xffff0000u)};
                        b1 = (f32x4){__builtin_bit_cast(float, w.z << 16), __builtin_bit_cast(float, w.z & 0xffff0000u), __builtin_bit_cast(float, w.w << 16), __builtin_bit_cast(float, w.w & 0xffff0000u)}; }
                    const f32x4 v0 = b0 + acc[ai][bj][m][0] * oscale, v1 = b1 + acc[ai][bj][m][1] * oscale;
                    u32x4 o; o.x = cvt_pk_bf16(v0[0], v0[1]); o.y = cvt_pk_bf16(v0[2], v0[3]); o.z = cvt_pk_bf16(v1[0], v1[1]); o.w = cvt_pk_bf16(v1[2], v1[3]);
                    *(u32x4*)(out + off + bj * HALF) = o; } }
    }
};
struct EpiMoeDown {
    static constexpr bool PERM = true;
    bf16_t* Y; const float* gw; bf16_t* P; float oscale;
    __device__ __forceinline__ void operator()(const f32x4 (&acc)[2][2][4][2], const Unit& u, int wr, int wc, int fr, int fq) const {
        const float* gp = gw + u.e * LCAP + u.mt * 256 + wr * 64 + fr;
        if (MOE_Y_FP8 && u.kq < 0) {
            unsigned char* base8 = (unsigned char*)Y + (size_t)(u.pm * BM + wr * 64 + fr) * DM + u.pn * BM + wc * 32 + 8 * fq;
#pragma unroll
            for (int ai = 0; ai < 2; ++ai)
#pragma unroll
                for (int m = 0; m < 4; ++m) { unsigned char* rowp = base8 + (size_t)(ai * HALF + m * 16) * DM; const float g = gp[ai * HALF + m * 16] * oscale * Y8S;
#pragma unroll
                    for (int bj = 0; bj < 2; ++bj) { f32x4 v0 = acc[ai][bj][m][0] * g, v1 = acc[ai][bj][m][1] * g;
#pragma unroll
                        for (int q = 0; q < 4; ++q) { v0[q] = __builtin_amdgcn_fmed3f(v0[q], -448.f, 448.f); v1[q] = __builtin_amdgcn_fmed3f(v1[q], -448.f, 448.f); }
                        v2u w; w.x = cvt4_fp8(v0[0], v0[1], v0[2], v0[3]); w.y = cvt4_fp8(v1[0], v1[1], v1[2], v1[3]);
                        *(v2u*)(rowp + bj * HALF) = w; } }
            return;
        }
        bf16_t* base = (u.kq < 0 ? Y + (size_t)(u.pm * BM) * DM : P + ((size_t)u.kq * SPLIT_ROWS + (size_t)(u.pm * BM - SPLIT_ROW0)) * DM) + (size_t)(wr * 64 + fr) * DM + u.pn * BM + wc * 32 + 8 * fq;
#pragma unroll
        for (int ai = 0; ai < 2; ++ai)
#pragma unroll
            for (int m = 0; m < 4; ++m) { bf16_t* rowp = base + (size_t)(ai * HALF + m * 16) * DM; const float g = gp[ai * HALF + m * 16] * oscale;
#pragma unroll
                for (int bj = 0; bj < 2; ++bj) { const f32x4 v0 = acc[ai][bj][m][0] * g, v1 = acc[ai][bj][m][1] * g;
                    u32x4 w; w.x = cvt_pk_bf16(v0[0], v0[1]); w.y = cvt_pk_bf16(v0[2], v0[3]); w.z = cvt_pk_bf16(v1[0], v1[1]); w.w = cvt_pk_bf16(v1[2], v1[3]);
                    *(u32x4*)(rowp + bj * HALF) = w; } }
    }
};

template <class Epi, class Sched, bool GATHER, bool FP8 = false>
__device__ __forceinline__ void gemm_phase(PG8_LAS unsigned char* lds, const int K, const Sched& S, const Epi& E) {
    const int tid = threadIdx.x, wid = __builtin_amdgcn_readfirstlane(tid >> 6), lane = tid & 63, wr = wid >> 2, wc = wid & 3, fr = lane & 15, fq = lane >> 4;
    unsigned voffA[2], voffB[2]; int sR[2], sC[2];
#pragma unroll
    for (int i = 0; i < 2; ++i) { int R, C; stage_rc(tid * 16 + i * 8192, R, C); const int Rb = Epi::PERM ? ((R & ~31) + perm32(R & 31)) : R;
        voffA[i] = (unsigned)(R * K + C) * 2u; voffB[i] = (unsigned)(Rb * K + C) * 2u; sR[i] = R; sC[i] = C; }
    const size_t kstep = (size_t)(BK * 2);
    const size_t hstep = (size_t)HALF * K * 2;
    const unsigned ldsw = (unsigned)wid * 1024u, lds0 = (unsigned)(uintptr_t)lds;
    const int aoff = lds_byte(wr * 64 + fr, fq * 8), boff = lds_byte(wc * 32 + fr, fq * 8);

#define PG8_SA(b, h) (((b) * 2 + (h)) * HTB)
#define PG8_SB(b, h) ((4 + (b) * 2 + (h)) * HTB)
#define PG8_STAGE(bufoff, gbase, voff) do { const char* gb_ = uniptr((const char*)(gbase)); _Pragma("unroll") for (int _i = 0; _i < 2; ++_i) \
        glds16_s(gb_, (voff)[_i], (unsigned)__builtin_amdgcn_readfirstlane(lds0 + (unsigned)(bufoff) + ldsw + (unsigned)(_i * 8192))); } while (0)
#define PG8_STAGE_A(bufoff, p, h, VG) do { if (GATHER) { PG8_STAGE(bufoff, p, VG[h]); } else { PG8_STAGE(bufoff, (p) + ((h) ? hstep : 0), voffA); } } while (0)
#define PG8_LDA(dst, b, h) do { _Pragma("unroll") for (int m = 0; m < 4; ++m) { if constexpr (FP8) { const v4i32 x_ = *(const PG8_LAS v4i32*)(lds + PG8_SA(b, h) + aoff + m * 2048), y_ = *(const PG8_LAS v4i32*)(lds + PG8_SA(b, h) + aoff + m * 2048 + 1024); dst##8[m] = __builtin_shufflevector(x_, y_, 0, 1, 2, 3, 4, 5, 6, 7); } \
        else { _Pragma("unroll") for (int k = 0; k < 2; ++k) dst[m][k] = *(const PG8_LAS bf16x8*)(lds + PG8_SA(b, h) + aoff + m * 2048 + k * 1024); } } } while (0)
#define PG8_LDB(dst, b, h) do { _Pragma("unroll") for (int n = 0; n < 2; ++n) { if constexpr (FP8) { const v4i32 x_ = *(const PG8_LAS v4i32*)(lds + PG8_SB(b, h) + boff + n * 2048), y_ = *(const PG8_LAS v4i32*)(lds + PG8_SB(b, h) + boff + n * 2048 + 1024); dst##8[n] = __builtin_shufflevector(x_, y_, 0, 1, 2, 3, 4, 5, 6, 7); } \
        else { _Pragma("unroll") for (int k = 0; k < 2; ++k) dst[n][k] = *(const PG8_LAS bf16x8*)(lds + PG8_SB(b, h) + boff + n * 2048 + k * 1024); } } } while (0)
#define PG8_MMA(ai, bj, At, Bt) do { __builtin_amdgcn_s_setprio(1); _Pragma("unroll") for (int m = 0; m < 4; ++m) _Pragma("unroll") for (int n = 0; n < 2; ++n) { \
        if constexpr (FP8) asm volatile("v_mfma_scale_f32_16x16x128_f8f6f4 %0, %1, %2, %0, %3, %3 op_sel_hi:[0,0,0]" : "+v"(acc[ai][bj][m][n]) : "v"(Bt##8[n]), "v"(At##8[m]), "v"(sc8));   \
        else { _Pragma("unroll") for (int k = 0; k < 2; ++k) acc[ai][bj][m][n] = __builtin_amdgcn_mfma_f32_16x16x32_bf16(Bt[n][k], At[m][k], acc[ai][bj][m][n], 0, 0, 0); } } \
        __builtin_amdgcn_s_setprio(0); } while (0)
#define PG8_WAIT_V(n) asm volatile("s_waitcnt vmcnt(" #n ")" ::: "memory")
#define PG8_WAIT_L(n) asm volatile("s_waitcnt lgkmcnt(" #n ")" ::: "memory")
#define PG8_BAR __builtin_amdgcn_s_barrier()
#define PG8_SCHED __builtin_amdgcn_sched_barrier(0)
    Unit cur, nxt; int ui = 0;
    if (!S.next(0, cur)) return;
    f32x4 acc[2][2][4][2];
#pragma unroll
    for (int a = 0; a < 2; ++a)
#pragma unroll
        for (int b = 0; b < 2; ++b)
#pragma unroll
            for (int m = 0; m < 4; ++m)
#pragma unroll
                for (int n = 0; n < 2; ++n) acc[a][b][m][n] = (f32x4){0.f, 0.f, 0.f, 0.f};
    bf16x8 At[4][2], B0[2][2], B1[2][2];
    v8i32 At8[4], B08[2], B18[2];
    int sc8 = 0x7F7F7F7F; asm volatile("" : "+v"(sc8));
    const char* cA = S.a_base(cur); const char* cB = S.b_base(cur);
    unsigned vc[2][2] = {{0u, 0u}, {0u, 0u}}, vn[2][2] = {{0u, 0u}, {0u, 0u}};
    if (GATHER) { S.a_voff(cur, sR, sC, vc); asm volatile("s_waitcnt vmcnt(0)" : "+v"(vc[0][0]), "+v"(vc[0][1]), "+v"(vc[1][0]), "+v"(vc[1][1]) :: "memory"); }
    PG8_STAGE(PG8_SB(0, 0), cB, voffB); PG8_STAGE(PG8_SB(0, 1), cB + hstep, voffB); PG8_STAGE_A(PG8_SA(0, 0), cA, 0, vc); PG8_STAGE_A(PG8_SA(0, 1), cA, 1, vc);
    if (wr == 1) PG8_BAR;
    PG8_WAIT_V(2); PG8_BAR;
    PG8_STAGE(PG8_SB(1, 0), cB + kstep, voffB); PG8_STAGE_A(PG8_SA(1, 0), cA + kstep, 0, vc); PG8_STAGE(PG8_SB(1, 1), cB + hstep + kstep, voffB);
    PG8_WAIT_V(6); PG8_BAR;
    for (;;) {
        const bool has_next = S.next(ui + 1, nxt);
        const char* nA = has_next ? S.a_base(nxt) : cA; const char* nB = has_next ? S.b_base(nxt) : cB;
        if (GATHER) {
            if (has_next) { S.a_voff(nxt, sR, sC, vn); asm volatile("s_waitcnt vmcnt(0)" : "+v"(vn[0][0]), "+v"(vn[0][1]), "+v"(vn[1][0]), "+v"(vn[1][1]) :: "memory"); }
            else { vn[0][0] = vc[0][0]; vn[0][1] = vc[0][1]; vn[1][0] = vc[1][0]; vn[1][1] = vc[1][1]; }
        }
        const int nt = cur.nt;
        for (int t = 0; t < nt; t += 2) {
            const bool last = (t == nt - 2);
            const char* a1 = cA + (size_t)(t + 1) * kstep;
            const char* a2 = last ? nA : cA + (size_t)(t + 2) * kstep; const char* b2 = last ? nB : cB + (size_t)(t + 2) * kstep;
            const char* a3 = a2 + kstep; const char* b3 = b2 + kstep;
            unsigned v2[2][2];
#pragma unroll
            for (int h = 0; h < 2; ++h)
#pragma unroll
                for (int i = 0; i < 2; ++i) v2[h][i] = last ? vn[h][i] : vc[h][i];
            PG8_LDB(B0, 0, 0); PG8_LDB(B1, 0, 1); PG8_SCHED; PG8_LDA(At, 0, 0); PG8_STAGE_A(PG8_SA(1, 1), a1, 1, vc);
            PG8_WAIT_V(8); PG8_WAIT_L(0); PG8_BAR; PG8_MMA(0, 0, At, B0); PG8_MMA(0, 1, At, B1); PG8_BAR; PG8_SCHED;
            PG8_LDA(At, 0, 1); PG8_STAGE(PG8_SB(0, 0), b2, voffB); PG8_STAGE(PG8_SB(0, 1), b2 + hstep, voffB); PG8_STAGE_A(PG8_SA(0, 0), a2, 0, v2);
            PG8_WAIT_V(8); PG8_WAIT_L(0); PG8_BAR; PG8_MMA(1, 0, At, B0); PG8_MMA(1, 1, At, B1); PG8_BAR; PG8_SCHED;
            PG8_LDB(B0, 1, 0); PG8_LDB(B1, 1, 1); PG8_SCHED; PG8_LDA(At, 1, 0); PG8_STAGE_A(PG8_SA(0, 1), a2, 1, v2);
            PG8_WAIT_V(8); PG8_WAIT_L(0); PG8_BAR; PG8_MMA(0, 0, At, B0); PG8_MMA(0, 1, At, B1); PG8_BAR; PG8_SCHED;
            PG8_LDA(At, 1, 1); PG8_STAGE(PG8_SB(1, 0), b3, voffB); PG8_STAGE(PG8_SB(1, 1), b3 + hstep, voffB); PG8_STAGE_A(PG8_SA(1, 0), a3, 0, v2);
            PG8_WAIT_V(8); PG8_WAIT_L(0); PG8_BAR; PG8_MMA(1, 0, At, B0); PG8_MMA(1, 1, At, B1); PG8_BAR; PG8_SCHED;
        }
        if (wr == 0) PG8_BAR;
        if constexpr (FP8) asm volatile("s_nop 15\n\ts_nop 15" ::: "memory");
        { int fr_ = fr, fq_ = fq; asm volatile("" : "+v"(fr_), "+v"(fq_)); E(acc, cur, wr, wc, fr_, fq_); }
        if (!has_next) break;
#pragma unroll
        for (int a = 0; a < 2; ++a)
#pragma unroll
            for (int b = 0; b < 2; ++b)
#pragma unroll
                for (int m = 0; m < 4; ++m)
#pragma unroll
                    for (int n = 0; n < 2; ++n) acc[a][b][m][n] = (f32x4){0.f, 0.f, 0.f, 0.f};
        cur = nxt; cA = nA; cB = nB; ++ui;
        if (GATHER) { vc[0][0] = vn[0][0]; vc[0][1] = vn[0][1]; vc[1][0] = vn[1][0]; vc[1][1] = vn[1][1]; }
        if (wr == 1) PG8_BAR;
    }
    PG8_WAIT_V(0);
    PG8_BAR;
#undef PG8_SA
#undef PG8_SB
#undef PG8_STAGE
#undef PG8_STAGE_A
#undef PG8_LDA
#undef PG8_LDB
#undef PG8_MMA
#undef PG8_WAIT_V
#undef PG8_WAIT_L
#undef PG8_BAR
#undef PG8_SCHED
}
}

namespace att {
typedef short bf16x8 __attribute__((ext_vector_type(8)));
typedef short s16x4 __attribute__((ext_vector_type(4)));
typedef float f32x16 __attribute__((ext_vector_type(16)));
typedef unsigned u32x4 __attribute__((ext_vector_type(4)));
typedef LAS char* lptr;
constexpr int SLOTB = 8192, NSLOT = 6, AHEAD = 4;
constexpr int L_K = 0, L_V = NSLOT * SLOTB, L_WS = 2 * NSLOT * SLOTB, L_OST = L_WS + 8 * 256, L_KB = L_OST + 8 * 4096, L_FLG = L_KB + 8192, L_END = L_FLG + 256;
static_assert(L_END <= ATT_LDS_MAX, "attention LDS map");
constexpr float THR = 8.0f;
__device__ __forceinline__ int crow(int r, int hi) { return (r & 3) + 8 * (r >> 2) + 4 * hi; }
__device__ __forceinline__ void glds16(const void* gsrc, unsigned lds_dst) { unsigned keep;
    asm volatile("s_mov_b32 %0, m0\n\ts_mov_b32 m0, %2\n\ts_nop 0\n\tglobal_load_lds_dwordx4 %1, off\n\ts_mov_b32 m0, %0" : "=&s"(keep) : "v"(gsrc), "s"(lds_dst) : "memory"); }
typedef float f32x2_t __attribute__((ext_vector_type(2))); typedef __bf16 bf16x2_t __attribute__((ext_vector_type(2)));
__device__ __forceinline__ unsigned cvtpk(float lo, float hi) { f32x2_t v = {lo, hi}; bf16x2_t b = __builtin_convertvector(v, bf16x2_t); return __builtin_bit_cast(unsigned, b); }
__device__ __forceinline__ bf16x8 gload16(const void* p) { bf16x8 v; asm volatile("global_load_dwordx4 %0, %1, off" : "=v"(v) : "v"(p) : "memory"); return v; }
__device__ __forceinline__ float max3f(float a, float b, float c) { return __builtin_fmaxf(__builtin_fmaxf(a, b), c); }
__device__ __forceinline__ void wait_bar(int n) {
    if (n >= 6) asm volatile("s_waitcnt vmcnt(6) lgkmcnt(0)\n\ts_barrier" ::: "memory");
    else if (n >= 4) asm volatile("s_waitcnt vmcnt(4) lgkmcnt(0)\n\ts_barrier" ::: "memory");
    else if (n >= 2) asm volatile("s_waitcnt vmcnt(2) lgkmcnt(0)\n\ts_barrier" ::: "memory");
    else asm volatile("s_waitcnt vmcnt(0) lgkmcnt(0)\n\ts_barrier" ::: "memory");
}
__device__ __forceinline__ float other_half(float x, int hi) {
    auto rr = __builtin_amdgcn_permlane32_swap(__float_as_uint(x), __float_as_uint(x), false, false);
    return __uint_as_float(hi ? rr[0] : rr[1]);
}
__device__ __forceinline__ void qkt(f32x16& p0, f32x16& p1, lptr Kslot, const bf16x8* qr, const f32x16& c0, const f32x16& c1, int r32, int hi) {
    lptr kb = Kslot + hi * 1024 + r32 * 16;
#pragma unroll
    for (int d0 = 0; d0 < 4; ++d0) {
        const bf16x8 b0 = *(const LAS bf16x8*)(kb + d0 * 2048);
        const bf16x8 b1 = *(const LAS bf16x8*)(kb + d0 * 2048 + 512);
        if (d0 == 0) { p0 = __builtin_amdgcn_mfma_f32_32x32x16_bf16(b0, qr[0], c0, 0, 0, 0); p1 = __builtin_amdgcn_mfma_f32_32x32x16_bf16(b1, qr[0], c1, 0, 0, 0); }
        else { p0 = __builtin_amdgcn_mfma_f32_32x32x16_bf16(b0, qr[d0], p0, 0, 0, 0); p1 = __builtin_amdgcn_mfma_f32_32x32x16_bf16(b1, qr[d0], p1, 0, 0, 0); } }
}
__device__ __forceinline__ void pv(f32x16* o, int vb, bf16x8 pa0, bf16x8 pa1, bf16x8 pa2, bf16x8 pa3) {
#pragma unroll
    for (int d0 = 0; d0 < 2; ++d0) { s16x4 lo[4], hi[4];
#pragma unroll
        for (int ks = 0; ks < 4; ++ks) {
            asm volatile("ds_read_b64_tr_b16 %0,%1 offset:%c2" : "=&v"(lo[ks]) : "v"(vb), "i"(d0 * 4096 + ks * 1024) : "memory");
            asm volatile("ds_read_b64_tr_b16 %0,%1 offset:%c2" : "=&v"(hi[ks]) : "v"(vb), "i"(d0 * 4096 + ks * 1024 + 512) : "memory"); }
        asm volatile("s_waitcnt lgkmcnt(0)" ::: "memory"); __builtin_amdgcn_sched_barrier(0);
#define ATT_PK(k) (bf16x8){lo[k][0], lo[k][1], lo[k][2], lo[k][3], hi[k][0], hi[k][1], hi[k][2], hi[k][3]}
        o[d0] = __builtin_amdgcn_mfma_f32_32x32x16_bf16(pa0, ATT_PK(0), o[d0], 0, 0, 0);
        o[d0] = __builtin_amdgcn_mfma_f32_32x32x16_bf16(pa1, ATT_PK(1), o[d0], 0, 0, 0);
        o[d0] = __builtin_amdgcn_mfma_f32_32x32x16_bf16(pa2, ATT_PK(2), o[d0], 0, 0, 0);
        o[d0] = __builtin_amdgcn_mfma_f32_32x32x16_bf16(pa3, ATT_PK(3), o[d0], 0, 0, 0);
#undef ATT_PK
    }
}
__device__ __forceinline__ void pack_pv(f32x16* o, int vb, const f32x16& p0, const f32x16& p1) {
    u32x4 w0, w1, w2, w3;
#pragma unroll
    for (int j = 0; j < 4; ++j) { w0[j] = cvtpk(p0[2 * j], p0[2 * j + 1]); w1[j] = cvtpk(p0[8 + 2 * j], p0[8 + 2 * j + 1]); w2[j] = cvtpk(p1[2 * j], p1[2 * j + 1]); w3[j] = cvtpk(p1[8 + 2 * j], p1[8 + 2 * j + 1]); }
    pv(o, vb, __builtin_bit_cast(bf16x8, w0), __builtin_bit_cast(bf16x8, w1), __builtin_bit_cast(bf16x8, w2), __builtin_bit_cast(bf16x8, w3));
}
__device__ __forceinline__ float rowmax32(const f32x16& p0, const f32x16& p1, int hi) {
    float a = max3f(p0[0], p0[1], p1[0]), b = max3f(p0[2], p0[3], p1[1]); a = max3f(a, p1[2], p1[3]);
#pragma unroll
    for (int r = 4; r < 16; r += 4) { a = max3f(a, p0[r], p0[r + 1]); b = max3f(b, p0[r + 2], p0[r + 3]); a = max3f(a, p1[r], p1[r + 1]); b = max3f(b, p1[r + 2], p1[r + 3]); }
    a = fmaxf(a, b);
    return fmaxf(a, other_half(a, hi));
}
__device__ __forceinline__ void store_o(const f32x16* o, const float* sc, lptr stgb, bf16* Ow, long rpitch, int lane, int r32, int hi) {
    LAS bf16* stg = (LAS bf16*)stgb;
#pragma unroll
    for (int r = 0; r < 16; ++r) { const int orow = crow(r, hi);
#pragma unroll
        for (int d0 = 0; d0 < 2; ++d0) stg[orow * 64 + d0 * 32 + r32] = (bf16)f2bf(o[d0][r] * sc[r]); }
    asm volatile("s_waitcnt lgkmcnt(0)" ::: "memory");
#pragma unroll
    for (int i = 0; i < 4; ++i) { const int row = i * 8 + (lane >> 3), ch = lane & 7; const u32x4 v = *(const LAS u32x4*)(stg + row * 64 + ch * 8); *(u32x4*)(Ow + (long)row * rpitch + ch * 8) = v; }
}
__device__ __forceinline__ void store_o8(const f32x16* o, const float* sc, lptr stgb, unsigned char* O8w, long rpitch, int lane, int r32, int hi) {
    LAS unsigned char* stg = (LAS unsigned char*)stgb;
#pragma unroll
    for (int r = 0; r < 16; ++r) { const int orow = crow(r, hi); const float s4 = sc[r] * (float)A8S;
        const int pk = __builtin_amdgcn_cvt_pk_fp8_f32(__builtin_amdgcn_fmed3f(o[0][r] * s4, -448.f, 448.f), __builtin_amdgcn_fmed3f(o[1][r] * s4, -448.f, 448.f), 0, false);
        stg[orow * 64 + r32] = (unsigned char)(pk & 0xff); stg[orow * 64 + 32 + r32] = (unsigned char)((pk >> 8) & 0xff); }
    asm volatile("s_waitcnt lgkmcnt(0)" ::: "memory");
#pragma unroll
    for (int i = 0; i < 2; ++i) { const int row = i * 16 + (lane >> 2), ch = lane & 3; const u32x4 v = *(const LAS u32x4*)(stg + row * 64 + ch * 16); *(u32x4*)(O8w + (long)row * rpitch + ch * 16) = v; }
}
__device__ __forceinline__ void softmax_step(f32x16& p0, f32x16& p1, float& mref, float& lsum, f32x16* o, LAS float* wsf, int r32, int hi) {
    const float rm = rowmax32(p0, p1, hi);
    const bool fresh = mref <= -1e30f;
    const bool want = !fresh && (rm > mref + THR);
    if (fresh) mref = fmaxf(rm, -1e30f);
    if (__any(want)) {
        const float dl = want ? rm - mref : 0.f; mref += dl; const float f = __builtin_amdgcn_exp2f(-dl); lsum *= f;
        if (hi == 0) wsf[r32] = f;
        asm volatile("s_waitcnt lgkmcnt(0)" ::: "memory");
#pragma unroll
        for (int r = 0; r < 16; ++r) { const float fr = wsf[crow(r, hi)]; o[0][r] *= fr; o[1][r] *= fr; }
    }
    float sa = 0.f, sb = 0.f;
#pragma unroll
    for (int r = 0; r < 16; ++r) { p0[r] = __builtin_amdgcn_exp2f(p0[r] - mref); p1[r] = __builtin_amdgcn_exp2f(p1[r] - mref); sa += p0[r]; sb += p1[r]; }
    lsum += sa + sb;
}

struct WaveCtx { int lane, r32, hi, wid; unsigned lds0; int vb0; lptr shm; };
struct UnitD { int NT; int b, h, qb, g, x; };

template <int MODE> struct CausalMode {
    const bf16* Q; const bf16* K; const bf16* V; bf16* O; int b, h, p; bool f8;
    const LAS float* kblp; float foxT;
    float carry, mref, lsum; int done;
    static constexpr int AH = (MODE == 0) ? 6 : 4, SK = (MODE == 0) ? 3 : 0;
    __device__ __forceinline__ int skew(const WaveCtx& w) const { return MODE == 0 ? 3 - (w.wid >> 1) : 0; }
    __device__ __forceinline__ int units() const { return 4; }
    __device__ __forceinline__ void desc(int j, UnitD& d) const { d.b = b; d.h = h; d.qb = (j == 0) ? 7 - p : (j == 1) ? 5 - p : (j == 2) ? 2 + p : p; d.NT = 4 * (d.qb + 1); d.g = 0; d.x = 0;
        if (MODE == 2) {
            const int lane = (int)(threadIdx.x & 63), nb = 4 * d.qb;
            const float thr = kblp[256 * d.qb] - foxT, v = kblp[64 * (lane & 31) + 63];
            d.x = (int)__builtin_popcountll(__builtin_amdgcn_ballot_w64(lane < nb && v < thr)); d.NT -= d.x; }
    }
    __device__ __forceinline__ int tile_of(const UnitD& d, int k) const { return MODE == 0 ? d.NT - 1 - k : k + d.x; }
    __device__ __forceinline__ void q_load(const UnitD& d, const WaveCtx& w, bf16x8 (&q)[4]) const {
        const bf16* Qw = Q + ((long)d.b * SEQ + d.qb * 256 + w.wid * 32 + w.r32) * DM + d.h * 64 + w.hi * 8;
#pragma unroll
        for (int d0 = 0; d0 < 4; ++d0) q[d0] = gload16(Qw + d0 * 16);
    }
    __device__ __forceinline__ void dma(const UnitD& d, int k, int slot, const WaveCtx& w) const {
        const long row0 = (long)d.b * SEQ + 64 * tile_of(d, k);
        glds16(K + (row0 + w.lane) * DM + d.h * 64 + w.wid * 8, (unsigned)__builtin_amdgcn_readfirstlane(w.lds0 + L_K + slot * SLOTB + w.wid * 1024));
        glds16(V + (row0 + 16 * (w.wid & 3) + (w.lane >> 2)) * DM + d.h * 64 + (w.wid >> 2) * 32 + (w.lane & 3) * 8, (unsigned)__builtin_amdgcn_readfirstlane(w.lds0 + L_V + slot * SLOTB + w.wid * 1024));
    }
    __device__ __forceinline__ void begin(const UnitD&, const WaveCtx&) { carry = 1.0f; mref = -1e30f; lsum = 0.f; done = 0; }
    __device__ __forceinline__ int wave_done() const { return done; }
    __device__ __forceinline__ void compute(const UnitD& d, int k, int slot, const WaveCtx& w, const bf16x8* qr, f32x16* o) {
        const int T = tile_of(d, k), qfirst = d.qb * 256 + w.wid * 32, qpos = qfirst + w.r32;
        if (MODE == 0) {
            if (done || 64 * T >= qfirst + 31) return;
            f32x16 p0, p1; const f32x16 z = {}; qkt(p0, p1, w.shm + L_K + slot * SLOTB, qr, z, z, w.r32, w.hi);
            const bool diag = 64 * T + 63 >= qfirst;
            float ga[8];
#pragma unroll
            for (int a = 0; a < 8; ++a) {
                float rr[4];
#pragma unroll
                for (int i = 0; i < 4; ++i) { const int r = 4 * (a & 3) + i; const float zz = (a < 4) ? p0[r] : p1[r];
                    const float e = __builtin_amdgcn_exp2f(fminf(zz, 120.f)); float rv = __builtin_amdgcn_rcpf(1.0f + e);
                    if (diag) { const int kv = 64 * T + crow(r, w.hi) + ((a < 4) ? 0 : 32); if (kv >= qpos) rv = 1.0f; }
                    rr[i] = rv; if (a < 4) p0[r] = rv; else p1[r] = rv; }
                ga[a] = (rr[0] * rr[1]) * (rr[2] * rr[3]);
            }
            float oth[8], Ts[8];
#pragma unroll
            for (int a = 0; a < 8; ++a) oth[a] = other_half(ga[a], w.hi);
            float run = 1.0f;
#pragma unroll
            for (int a = 7; a >= 0; --a) { Ts[a] = run; run *= ga[a] * oth[a]; }
#pragma unroll
            for (int a = 0; a < 8; ++a) {
                float E = carry * Ts[a] * (w.hi ? 1.0f : oth[a]);
#pragma unroll
                for (int i = 3; i >= 0; --i) { const int r = 4 * (a & 3) + i; const float rv = (a < 4) ? p0[r] : p1[r]; const float wt = (1.0f - rv) * E; E *= rv; if (a < 4) p0[r] = wt; else p1[r] = wt; }
            }
            carry *= run;
            pack_pv(o, w.vb0 + slot * SLOTB, p0, p1);
            if (__all(carry < 9.0e-13f)) done = 1;
        } else {
            if (64 * T > qfirst + 31) return;
            LAS float* kbl = (LAS float*)(w.shm + L_KB);
            f32x16 c0, c1;
#pragma unroll
            for (int g = 0; g < 4; ++g) { const f32x4 k0 = *(const LAS f32x4*)(kbl + 64 * T + 8 * g + 4 * w.hi), k1 = *(const LAS f32x4*)(kbl + 64 * T + 32 + 8 * g + 4 * w.hi);
#pragma unroll
                for (int i = 0; i < 4; ++i) { c0[4 * g + i] = k0[i]; c1[4 * g + i] = k1[i]; } }
            f32x16 p0, p1; qkt(p0, p1, w.shm + L_K + slot * SLOTB, qr, c0, c1, w.r32, w.hi);
            if (64 * T + 63 > qfirst) {
#pragma unroll
                for (int r = 0; r < 16; ++r) { const int kv = 64 * T + crow(r, w.hi); if (kv > qpos) p0[r] = -INFINITY; if (kv + 32 > qpos) p1[r] = -INFINITY; } }
            softmax_step(p0, p1, mref, lsum, o, (LAS float*)(w.shm + L_WS) + w.wid * 64, w.r32, w.hi);
            pack_pv(o, w.vb0 + slot * SLOTB, p0, p1);
        }
    }
    __device__ __forceinline__ void finish(const UnitD& d, const WaveCtx& w, const f32x16* o) {
        LAS float* wsf = (LAS float*)(w.shm + L_WS) + w.wid * 64;
        float sc[16];
        if (MODE == 0) {
#pragma unroll
            for (int r = 0; r < 16; ++r) sc[r] = 1.0f;
        } else {
            float lt = lsum + other_half(lsum, w.hi);
            if (w.hi == 0) wsf[32 + w.r32] = lt;
            asm volatile("s_waitcnt lgkmcnt(0)" ::: "memory");
#pragma unroll
            for (int r = 0; r < 16; ++r) sc[r] = __builtin_amdgcn_rcpf(wsf[32 + crow(r, w.hi)]);
        }
        if (f8) store_o8(o, sc, w.shm + L_OST + w.wid * 4096, (unsigned char*)O + ((long)d.b * SEQ + d.qb * 256 + w.wid * 32) * DM + d.h * 64, DM, w.lane, w.r32, w.hi);
        else store_o(o, sc, w.shm + L_OST + w.wid * 4096, O + ((long)d.b * SEQ + d.qb * 256 + w.wid * 32) * DM + d.h * 64, DM, w.lane, w.r32, w.hi);
    }
};

struct DilMode {
    const bf16* PROJ; bf16* OG; float* ST; bf16* Of; int b, h, p, pass;
    float mref, lsum;
    static constexpr int AH = 4, SK = 0;
    __device__ __forceinline__ int skew(const WaveCtx&) const { return 0; }
    __device__ __forceinline__ int units() const { return pass == 0 ? 8 : 4; }
    __device__ __forceinline__ void desc(int j, UnitD& d) const {
        const int g = pass == 0 ? (j >> 2) : 2, i = j & 3; d.g = g; d.b = b; d.h = h; d.qb = 0;
        d.x = (g == 1) ? ((2 * (i >> 1) + p) << 1) + (i & 1) : 2 * i + p;
        const int i0 = (g == 0) ? 256 * d.x : (g == 1) ? 256 * (d.x & 1) : 0;
        d.NT = (g == 2) ? 4 : ((i0 >> 6) + 4 - t_lo(g, i0));
    }
    static __device__ __forceinline__ int t_lo(int g, int i0) { return (g == 2) ? 0 : ((i0 >> 6) >= 2 ? (i0 >> 6) - 2 : 0); }
    static __device__ __forceinline__ int dil_of(int g) { return (g == 0) ? 1 : (g == 1) ? 4 : 16; }
    static __device__ __forceinline__ int cls0_of(int g, int x) { return (g == 0) ? 0 : (g == 1) ? (x >> 1) : 2 * x; }
    static __device__ __forceinline__ int i0_of(int g, int x) { return (g == 0) ? 256 * x : (g == 1) ? 256 * (x & 1) : 0; }
    static __device__ __forceinline__ int tcls(int g, int x, int k) { return cls0_of(g, x) + ((g == 2) ? (k >> 1) : 0); }
    static __device__ __forceinline__ int kbase(int g, int x, int k) { return (g == 2) ? 64 * (k & 1) : 64 * (t_lo(g, i0_of(g, x)) + k); }
    __device__ __forceinline__ void q_load(const UnitD& d, const WaveCtx& w, bf16x8 (&q)[4]) const {
        const int dil = dil_of(d.g), clsw = cls0_of(d.g, d.x) + ((d.g == 2) ? (w.wid >> 2) : 0), qi0w = (d.g == 2) ? 32 * (w.wid & 3) : i0_of(d.g, d.x) + 32 * w.wid;
        const bf16* Qw = PROJ + (size_t)(2 * d.g) * PLANE + ((long)d.b * SEQ + clsw + (long)(qi0w + w.r32) * dil) * DM + d.h * 64 + w.hi * 8;
#pragma unroll
        for (int d0 = 0; d0 < 4; ++d0) q[d0] = gload16(Qw + d0 * 16);
    }
    __device__ __forceinline__ void dma(const UnitD& d, int k, int slot, const WaveCtx& w) const {
        const int dil = dil_of(d.g); const long tok0 = (long)d.b * SEQ + tcls(d.g, d.x, k) + (long)kbase(d.g, d.x, k) * dil;
        glds16(PROJ + (size_t)(2 * d.g + 1) * PLANE + (tok0 + (long)w.lane * dil) * DM + d.h * 64 + w.wid * 8, (unsigned)__builtin_amdgcn_readfirstlane(w.lds0 + L_K + slot * SLOTB + w.wid * 1024));
        glds16(PROJ + (size_t)6 * PLANE + (tok0 + (long)(16 * (w.wid & 3) + (w.lane >> 2)) * dil) * DM + d.h * 64 + (w.wid >> 2) * 32 + (w.lane & 3) * 8, (unsigned)__builtin_amdgcn_readfirstlane(w.lds0 + L_V + slot * SLOTB + w.wid * 1024));
    }
    __device__ __forceinline__ void begin(const UnitD&, const WaveCtx&) { mref = -1e30f; lsum = 0.f; }
    __device__ __forceinline__ int wave_done() const { return 0; }
    __device__ __forceinline__ void compute(const UnitD& d, int k, int slot, const WaveCtx& w, const bf16x8* qr, f32x16* o) {
        const int clsw = cls0_of(d.g, d.x) + ((d.g == 2) ? (w.wid >> 2) : 0), qi0w = (d.g == 2) ? 32 * (w.wid & 3) : i0_of(d.g, d.x) + 32 * w.wid;
        const int kb = kbase(d.g, d.x, k);
        if (tcls(d.g, d.x, k) != clsw || kb > qi0w + 31 || kb < qi0w - 191) return;
        LAS float* tbl = (LAS float*)(w.shm + L_KB) + d.g * 640 + 256;
        const int dbase = qi0w + w.r32 - kb - 4 * w.hi;
        f32x16 c0, c1;
#pragma unroll
        for (int r = 0; r < 16; ++r) { const int cr = (r & 3) + 8 * (r >> 2); c0[r] = tbl[dbase - cr]; c1[r] = tbl[dbase - cr - 32]; }
        f32x16 p0, p1; qkt(p0, p1, w.shm + L_K + slot * SLOTB, qr, c0, c1, w.r32, w.hi);
        softmax_step(p0, p1, mref, lsum, o, (LAS float*)(w.shm + L_WS) + w.wid * 64, w.r32, w.hi);
        pack_pv(o, w.vb0 + slot * SLOTB, p0, p1);
    }
    __device__ __forceinline__ void finish(const UnitD& d, const WaveCtx& w, const f32x16* o) {
        const int dil = dil_of(d.g), clsw = cls0_of(d.g, d.x) + ((d.g == 2) ? (w.wid >> 2) : 0), qi0w = (d.g == 2) ? 32 * (w.wid & 3) : i0_of(d.g, d.x) + 32 * w.wid;
        LAS float* wsf = (LAS float*)(w.shm + L_WS) + w.wid * 64;
        const float lt = lsum + other_half(lsum, w.hi);
        if (w.hi == 0) { wsf[32 + w.r32] = lt; wsf[w.r32] = mref;
            if (pass == 0) { const long tok = (long)d.b * SEQ + clsw + (long)(qi0w + w.r32) * dil;
                *(f32x2*)(ST + ((size_t)d.g * M * NH + (size_t)tok * NH + d.h) * 2) = (f32x2){mref, lt}; } }
        asm volatile("s_waitcnt lgkmcnt(0)" ::: "memory");
        float sc[16];
#pragma unroll
        for (int r = 0; r < 16; ++r) sc[r] = __builtin_amdgcn_rcpf(wsf[32 + crow(r, w.hi)]);
        if (pass == 0) { store_o(o, sc, w.shm + L_OST + w.wid * 4096, OG + (size_t)d.g * PLANE + ((long)d.b * SEQ + clsw + (long)qi0w * dil) * DM + d.h * 64, (long)dil * DM, w.lane, w.r32, w.hi); return; }
        LAS bf16* stg = (LAS bf16*)(w.shm + L_OST + w.wid * 4096);
#pragma unroll
        for (int r = 0; r < 16; ++r) { const int orow = crow(r, w.hi);
#pragma unroll
            for (int d0 = 0; d0 < 2; ++d0) stg[orow * 64 + d0 * 32 + w.r32] = (bf16)f2bf(o[d0][r] * sc[r]); }
        asm volatile("s_waitcnt lgkmcnt(0)" ::: "memory");
#pragma unroll
        for (int i = 0; i < 4; ++i) { const int row = i * 8 + (w.lane >> 3), ch = w.lane & 7;
            const long tok = (long)d.b * SEQ + clsw + (long)(qi0w + row) * dil;
            const f32x2 s0 = *(const f32x2*)(ST + ((size_t)0 * M * NH + (size_t)tok * NH + d.h) * 2), s1 = *(const f32x2*)(ST + ((size_t)1 * M * NH + (size_t)tok * NH + d.h) * 2);
            const float m2 = wsf[row], l2 = wsf[32 + row];
            const float mx = fmaxf(s0.x, fmaxf(s1.x, m2));
            float w0 = __builtin_amdgcn_exp2f(s0.x - mx) * s0.y, w1 = __builtin_amdgcn_exp2f(s1.x - mx) * s1.y, w2 = __builtin_amdgcn_exp2f(m2 - mx) * l2;
            const float inv = __builtin_amdgcn_rcpf(w0 + w1 + w2); w0 *= inv; w1 *= inv; w2 *= inv;
            const v4u x0 = *(const GAS v4u*)(OG + (size_t)tok * DM + d.h * 64 + ch * 8), x1 = *(const GAS v4u*)(OG + PLANE + (size_t)tok * DM + d.h * 64 + ch * 8);
            const v4u x2 = *(const LAS v4u*)(stg + row * 64 + ch * 8); v4u rr;
#pragma unroll
            for (int q = 0; q < 4; ++q) { const float lo = w0 * bflo(x0[q]) + w1 * bflo(x1[q]) + w2 * bflo(x2[q]), hi2 = w0 * bfhi(x0[q]) + w1 * bfhi(x1[q]) + w2 * bfhi(x2[q]);
                if (WO_FP8) rr[q] = (unsigned)__builtin_amdgcn_cvt_pk_fp8_f32(__builtin_amdgcn_fmed3f(lo * (float)A8S, -448.f, 448.f), __builtin_amdgcn_fmed3f(hi2 * (float)A8S, -448.f, 448.f), 0, false) & 0xffffu;
                else rr[q] = pk2(lo, hi2); }
            if (WO_FP8) *(GAS v2u*)((GAS unsigned char*)Of + (size_t)tok * DM + d.h * 64 + ch * 8) = (v2u){rr[0] | (rr[1] << 16), rr[2] | (rr[3] << 16)};
            else *(GAS v4u*)(Of + (size_t)tok * DM + d.h * 64 + ch * 8) = rr; }
    }
};

template <class Mode, bool EARLY_EXIT>
__device__ __forceinline__ void stream_units(Mode& Mo, const WaveCtx& w) {
    LAS int* flg = (LAS int*)(w.shm + L_FLG);
    const int nun = Mo.units();
    int pj = 0, pk = 0, pseq = 0, cseq = 0;
    UnitD pd; Mo.desc(0, pd);
    bf16x8 qn[4];
    if (EARLY_EXIT && w.wid == 0 && w.lane < 4) flg[w.lane] = 0;
    asm volatile("s_waitcnt vmcnt(0)" ::: "memory");
#define ATT_PRODUCE() do { if (pj < nun) { if (pk == 0) Mo.q_load(pd, w, qn); Mo.dma(pd, pk, pseq % NSLOT, w); ++pseq; if (++pk == pd.NT) { pk = 0; if (++pj < nun) Mo.desc(pj, pd); } } } while (0)
#pragma unroll 1
    for (int i = 0; i < Mode::AH; ++i) ATT_PRODUCE();
#pragma unroll 1
    for (int cj = 0; cj < nun; ++cj) {
        UnitD d; Mo.desc(cj, d);
        bf16x8 qr[4];
        f32x16 o[2]; o[0] = f32x16{}; o[1] = f32x16{};
        Mo.begin(d, w);
        const int useq0 = cseq;
        int rep = 0;
#pragma unroll 1
        while (pseq - cseq < Mode::AH && pj < nun) ATT_PRODUCE();
#pragma unroll 1
        for (int ck = 0; ck < d.NT; ++ck) {
            { int tt = cseq + Mode::SK; const int ul = useq0 + d.NT - 1; tt = tt > ul ? ul : tt; tt = tt > pseq - 1 ? pseq - 1 : tt; wait_bar(2 * (pseq - tt - 1)); }
            if (ck == 0) { asm volatile("" : "+v"(qn[0]), "+v"(qn[1]), "+v"(qn[2]), "+v"(qn[3])); qr[0] = qn[0]; qr[1] = qn[1]; qr[2] = qn[2]; qr[3] = qn[3]; }
            if (EARLY_EXIT && ck == 1 && w.wid == 0 && w.lane < 2) flg[((cj + 1) & 1) * 2 + w.lane] = 0;
            if (EARLY_EXIT && ck > 0) {
                if (__builtin_amdgcn_readfirstlane(flg[(cj & 1) * 2 + ((ck - 1) & 1)]) == 8) {
                    const int uend = useq0 + d.NT;
                    if (pj == cj) { pk = 0; if (++pj < nun) Mo.desc(pj, pd); }
                    cseq = uend < pseq ? uend : pseq;
                    break; } }
            if (pseq - cseq < Mode::AH) ATT_PRODUCE();
            { const int sk = Mo.skew(w); if (ck + sk < d.NT) Mo.compute(d, ck + sk, (cseq + sk) % NSLOT, w, qr, o); }
            if (EARLY_EXIT && Mo.wave_done() && rep < 2) { if (w.lane == 0) __hip_atomic_fetch_add(&flg[(cj & 1) * 2 + (ck & 1)], 1, __ATOMIC_RELAXED, __HIP_MEMORY_SCOPE_WORKGROUP); ++rep; }
            ++cseq;
        }
        Mo.finish(d, w, o);
    }
    asm volatile("s_waitcnt vmcnt(0) lgkmcnt(0)\n\ts_barrier" ::: "memory");
#undef ATT_PRODUCE
}
__device__ __forceinline__ WaveCtx make_ctx(lptr shm) {
    WaveCtx w; const int tid = threadIdx.x; w.lane = tid & 63; w.r32 = w.lane & 31; w.hi = w.lane >> 5; w.wid = __builtin_amdgcn_readfirstlane(tid >> 6);
    w.shm = shm; w.lds0 = (unsigned)(uintptr_t)shm;
    w.vb0 = (int)(w.lds0 + L_V) + ((w.lane >> 4) & 1) * 32 + (w.lane & 3) * 8 + (4 * w.hi + ((w.lane & 15) >> 2)) * 64;
    return w;
}
template <int MODE>
__device__ __forceinline__ void causal_phase(lptr shm, int G, const bf16* Q, const bf16* K, const bf16* V, bf16* O, const float* cum, bool f8, const float* gq = nullptr, const float* gk = nullptr) {
    const int bx = blockIdx.x; const int vcu = (G % 8 == 0) ? (bx % 8) * (G / 8) + bx / 8 : bx;
    const WaveCtx w = make_ctx(shm);
    for (int u = vcu; u < BATCH * NH * 2; u += G) {
        CausalMode<MODE> Mo; Mo.Q = Q; Mo.K = K; Mo.V = V; Mo.O = O; Mo.f8 = f8; Mo.b = u >> 5; Mo.h = (u >> 1) & 15; Mo.p = u & 1; Mo.kblp = (const LAS float*)(shm + L_KB); Mo.foxT = 0.f;
        if (MODE == 2) {
            LAS float* kbl = (LAS float*)(shm + L_KB); LAS float* wtot = (LAS float*)(shm + L_FLG + 64);
            const int t4 = threadIdx.x * 4; float v0, v1, v2, v3;
            { const float* lp = cum + ((long)Mo.b * SEQ + t4) * 16 + Mo.h; v0 = lp[0]; v1 = lp[16]; v2 = lp[32]; v3 = lp[48]; }
            v1 += v0; v2 += v1; v3 += v2;
            float incl = v3;
#pragma unroll
            for (int o = 1; o < 64; o <<= 1) { const float t = __shfl_up(incl, o); if (w.lane >= o) incl += t; }
            if (w.lane == 63) wtot[w.wid] = incl;
            __syncthreads();
            float off = incl - v3;
#pragma unroll
            for (int x = 0; x < 8; ++x) off += (x < w.wid) ? wtot[x] : 0.f;
            *(LAS f32x4*)(kbl + t4) = (f32x4){-(off + v0), -(off + v1), -(off + v2), -(off + v3)};
            float ga = fabsf(gq[w.lane]), gb = fabsf(gk[w.lane]);
#pragma unroll
            for (int o = 1; o < 64; o <<= 1) { ga = fmaxf(ga, __shfl_xor(ga, o)); gb = fmaxf(gb, __shfl_xor(gb, o)); }
            Mo.foxT = 2.0f * (64.0f * C2 * 1.06f * ga * gb) + 40.0f;
            asm volatile("s_waitcnt lgkmcnt(0)" ::: "memory");
            __syncthreads();
        }
        stream_units<CausalMode<MODE>, MODE == 0>(Mo, w);
    }
}
__device__ __forceinline__ int t5_bucket_f(int dist) {
    if (dist < 16) return dist;
    int lb = 16 + (int)(logf((float)dist / 16.0f) / logf(128.0f) * 16.0f);
    return lb < 31 ? lb : 31;
}
__device__ __forceinline__ void dil_phase(lptr shm, int G, const bf16* PROJ, bf16* OG, float* ST, const float* rel_bias, int pass, bf16* Of) {
    const int bx = blockIdx.x; const int vcu = (G % 8 == 0) ? (bx % 8) * (G / 8) + bx / 8 : bx;
    const WaveCtx w = make_ctx(shm);
    for (int u = vcu; u < BATCH * NH * 2; u += G) {
        DilMode Mo; Mo.PROJ = PROJ; Mo.OG = OG; Mo.ST = ST; Mo.Of = Of; Mo.pass = pass; Mo.b = u >> 5; Mo.h = (u >> 1) & 15; Mo.p = u & 1;
        LAS float* tb = (LAS float*)(shm + L_KB);
        for (int i = threadIdx.x; i < 3 * 640; i += NTHR) { const int gg = i / 640, dl = i - gg * 640 - 256; const int dil = (gg == 0) ? 1 : (gg == 1) ? 4 : 16;
            tb[i] = (dl >= 0 && dl <= 128) ? rel_bias[t5_bucket_f(dl * dil) * 16 + Mo.h] * LOG2E : -INFINITY; }
        stream_units<DilMode, false>(Mo, w);
    }
}
__device__ __forceinline__ void dil_merge(int G, const bf16* OG, const float* ST, bf16* O) {
    for (int idx = blockIdx.x * NTHR + threadIdx.x; idx < M * NH; idx += G * NTHR) {
        const f32x2 s0 = *(const f32x2*)(ST + ((size_t)0 * M * NH + idx) * 2), s1 = *(const f32x2*)(ST + ((size_t)1 * M * NH + idx) * 2), s2 = *(const f32x2*)(ST + ((size_t)2 * M * NH + idx) * 2);
        const float mx = fmaxf(s0.x, fmaxf(s1.x, s2.x));
        float w0 = __builtin_amdgcn_exp2f(s0.x - mx) * s0.y, w1 = __builtin_amdgcn_exp2f(s1.x - mx) * s1.y, w2 = __builtin_amdgcn_exp2f(s2.x - mx) * s2.y;
        const float inv = 1.0f / (w0 + w1 + w2); w0 *= inv; w1 *= inv; w2 *= inv;
        const GAS v4u* a0 = (const GAS v4u*)(OG + (size_t)idx * 64); const GAS v4u* a1 = (const GAS v4u*)(OG + PLANE + (size_t)idx * 64); const GAS v4u* a2 = (const GAS v4u*)(OG + 2 * PLANE + (size_t)idx * 64);
        GAS v4u* op = (GAS v4u*)(O + (size_t)idx * 64);
#pragma unroll
        for (int c = 0; c < 8; ++c) { const v4u x0 = a0[c], x1 = a1[c], x2 = a2[c]; v4u r;
#pragma unroll
            for (int q = 0; q < 4; ++q) r[q] = pk2(w0 * bflo(x0[q]) + w1 * bflo(x1[q]) + w2 * bflo(x2[q]), w0 * bfhi(x0[q]) + w1 * bfhi(x1[q]) + w2 * bfhi(x2[q]));
            op[c] = r; }
    }
}
}

enum { CV_PLAIN = 0, CV_QKN = 1, CV_GATE = 2, CV_UP = 3 };
__device__ __forceinline__ int cv_dst_row(int mode, int n) {
    if (mode == CV_QKN) return (n & ~255) + 128 * ((n >> 5) & 1) + 32 * ((n >> 6) & 3) + (n & 31);
    if (mode == CV_GATE) return 256 * (n >> 7) + (n & 127);
    if (mode == CV_UP) return 256 * (n >> 7) + 128 + (n & 127);
    return n;
}
__device__ __forceinline__ void conv_item(const float* W, int ldw, int K, bf16* WT, int mode, LAS unsigned char* scr, int item, int nblk, int lane) {
    const int kb = item / nblk, nb = item - kb * nblk, k0 = 64 * kb, n0 = 64 * nb;
    const GAS float* src = (const GAS float*)(W + (size_t)k0 * ldw + n0 + lane);
#pragma unroll
    for (int kc = 0; kc < 8; ++kc) {
        float v[8];
#pragma unroll
        for (int j = 0; j < 8; ++j) v[j] = __builtin_nontemporal_load(&src[(size_t)(kc * 8 + j) * ldw]);
        v4u w; w.x = pk2(v[0], v[1]); w.y = pk2(v[2], v[3]); w.z = pk2(v[4], v[5]); w.w = pk2(v[6], v[7]);
        *(LAS v4u*)(scr + lane * 144 + kc * 16) = w;
    }
    asm volatile("s_waitcnt lgkmcnt(0)" ::: "memory");
#pragma unroll
    for (int j = 0; j < 8; ++j) { const int n = 8 * j + (lane >> 3), ch = lane & 7;
        const v4u w = *(const LAS v4u*)(scr + n * 144 + ch * 16);
        __builtin_nontemporal_store(w, (GAS v4u*)(WT + (size_t)cv_dst_row(mode, n0 + n) * K + k0 + 8 * ch)); }
    asm volatile("s_waitcnt lgkmcnt(0)" ::: "memory");
}
__device__ __forceinline__ void conv_item8(const float* W, int ldw, int K, unsigned char* WT8, int mode, LAS unsigned char* scr, int item, int nblk, int lane) {
    const int kb = item / nblk, nb = item - kb * nblk, k0 = 128 * kb, n0 = 64 * nb;
    const GAS float* src = (const GAS float*)(W + (size_t)k0 * ldw + n0 + lane);
#pragma unroll 4
    for (int kc = 0; kc < 16; ++kc) {
        float v[8];
#pragma unroll
        for (int j = 0; j < 8; ++j) v[j] = __builtin_nontemporal_load(&src[(size_t)(kc * 8 + j) * ldw]) * W8S;
        v2u w; w.x = pg8::cvt4_fp8(v[0], v[1], v[2], v[3]); w.y = pg8::cvt4_fp8(v[4], v[5], v[6], v[7]);
        *(LAS v2u*)(scr + lane * 144 + kc * 8) = w;
    }
    asm volatile("s_waitcnt lgkmcnt(0)" ::: "memory");
#pragma unroll
    for (int j = 0; j < 8; ++j) { const int n = 8 * j + (lane >> 3), ch = lane & 7;
        const v4u w = *(const LAS v4u*)(scr + n * 144 + ch * 16);
        __builtin_nontemporal_store(w, (GAS v4u*)(WT8 + (size_t)cv_dst_row(mode, n0 + n) * K + k0 + 16 * ch)); }
    asm volatile("s_waitcnt lgkmcnt(0)" ::: "memory");
}
static_assert(MOE_FP8 && DILIN_FP8 && FOXIN_FP8 && QKV3_FP8 && DENSE_FP8_L2 && !DENSE_FP8_L0, "the conversion queue is laid out for this precision plan");
constexpr int CV_TOTAL = 28608;
static_assert(WO_FP8, "the conversion queue below holds e4m3 Wo weights for layers 1-3");
constexpr int cv_need(int p) {
    return p >= 24 ? 28608 : p >= 23 ? 25024 : p >= 21 ? 17856 : p >= 19 ? 17728 : p >= 18 ? 17344 : p >= 17 ? 16896 : p >= 16 ? 16000 : p >= 14 ? 15872 : p >= 12 ? 15488
         : p >= 11 ? 11904 : p >= 9 ? 4736 : p >= 6 ? 4608 : p >= 5 ? 3712 : p >= 4 ? 2816 : p >= 3 ? 1024 : p >= 1 ? 768 : 0;
}
__device__ __forceinline__ void cv_run_item(Frame& F, int idx) {
    LAS unsigned char* scr = F.lds + F.wave * 9216;
    unsigned char* WB8 = F.ws + WS_W;
    int inp, ldw, K, N, mode = CV_PLAIN, it; size_t soff = 0, doff; bool f8 = false;
    if (idx < 768)        { it = idx;         inp = 1;  ldw = 3 * DM; K = DM; N = 3 * DM; doff = WE_QKV * 2; }
    else if (idx < 1024)  { it = idx - 768;   inp = 2;  ldw = DM; K = DM; N = DM; doff = WE_WO_SB * 2; }
    else if (idx < 2816)  { const int l = idx - 1024, u = l >= 896; it = l - 896 * u; inp = 15 + u; ldw = FF; K = DM; N = FF; doff = WE_GU * 2; mode = u ? CV_UP : CV_GATE; }
    else if (idx < 3712)  { it = idx - 2816;  inp = 17; ldw = DM; K = FF; N = DM; doff = WE_D * 2; }
    else if (idx < 4608)  { it = idx - 3712;  inp = 3;  ldw = 7 * DM; K = DM; N = 7 * DM; doff = WE_IN_DIL * 2; mode = CV_QKN; f8 = true; }
    else if (idx < 4736)  { it = idx - 4608;  inp = 6;  ldw = DM; K = DM; N = DM; doff = WE_WO_DIL * 2; f8 = true; }
    else if (idx < 15872) {
        if (idx < 11904)      { const int l = idx - 4736, fe = l / 896, r = l - fe * 896, u = r >= 448; it = r - 448 * u; inp = 19 + u; ldw = FF; K = DM; N = FF; soff = (size_t)fe * DM * FF;
                                doff = WE_MGU * 2 + (size_t)fe * 2 * FF * DM; mode = u ? CV_UP : CV_GATE; f8 = true; }
        else if (idx < 15488) { const int l = idx - 11904, fe = l / 448; it = l - fe * 448; inp = 21; ldw = DM; K = FF; N = DM; soff = (size_t)fe * FF * DM; doff = WE_MD * 2 + (size_t)fe * DM * FF; f8 = true; }
        else                  { it = idx - 15488; inp = 7; ldw = 3088; K = DM; N = 3 * DM; doff = WE_IN_FOX * 2; mode = CV_QKN; f8 = true; }
    }
    else if (idx < 16000) { it = idx - 15872; inp = 11; ldw = DM; K = DM; N = DM; doff = WE_WO_FOX * 2; f8 = true; }
    else if (idx < 16896) { const int l = idx - 16000, u = l >= 448; it = l - 448 * u; inp = 15 + u; ldw = FF; K = DM; N = FF; soff = (size_t)DM * FF; doff = (WE_GU + (size_t)2 * FF * DM) * 2; mode = u ? CV_UP : CV_GATE; f8 = true; }
    else if (idx < 17344) { it = idx - 16896; inp = 17; ldw = DM; K = FF; N = DM; soff = (size_t)FF * DM; doff = (WE_D + (size_t)DM * FF) * 2; f8 = true; }
    else if (idx < 17728) { it = idx - 17344; inp = 1;  ldw = 3 * DM; K = DM; N = 3 * DM; soff = (size_t)DM * 3 * DM; doff = (WE_QKV + (size_t)3 * DM * DM) * 2; f8 = true; }
    else if (idx < 17856) { it = idx - 17728; inp = 2;  ldw = DM; K = DM; N = DM; soff = (size_t)DM * DM; doff = (WE_WO_SB + (size_t)DM * DM) * 2; f8 = true; }
    else if (idx < 25024) { const int l = idx - 17856, fe = 8 + l / 896, r = l - (fe - 8) * 896, u = r >= 448; it = r - 448 * u; inp = 19 + u; ldw = FF; K = DM; N = FF; soff = (size_t)fe * DM * FF;
                            doff = WE_MGU * 2 + (size_t)fe * 2 * FF * DM; mode = u ? CV_UP : CV_GATE; f8 = true; }
    else                  { const int l = idx - 25024, fe = 8 + l / 448; it = l - (fe - 8) * 448; inp = 21; ldw = DM; K = FF; N = DM; soff = (size_t)fe * FF * DM; doff = WE_MD * 2 + (size_t)fe * DM * FF; f8 = true; }
    const float* src = inp_ptr(F, inp) + soff;
    if (f8) conv_item8(src, ldw, K, WB8 + doff, mode, scr, it, N / 64, F.lane);
    else conv_item(src, ldw, K, (bf16*)(WB8 + doff), mode, scr, it, N / 64, F.lane);
}
__device__ __forceinline__ void cv_drain(Frame& F, int need) {
    if (need <= 0) return;
    volatile LAS int* cw = (volatile LAS int*)(F.lds + MISC_OFF) + 16;
    if (cw[4]) return;
    unsigned* nxt = (unsigned*)(F.ctl + CW_CVQ);
    asm volatile("s_waitcnt vmcnt(0)" ::: "memory");
    for (;;) {
        __syncthreads();
        if (F.tid == 0) { int b = -1; const int h = (int)xb_ld(nxt); if (h < need) b = (int)xb_add(nxt, 8u); else if (h >= CV_TOTAL) cw[4] = 1; cw[0] = b; }
        __syncthreads();
        const int base = cw[0];
        if (base < 0) break;
        if (base + F.wave < CV_TOTAL) cv_run_item(F, base + F.wave);
    }
}
__device__ __forceinline__ void xcd_barrier_steal(const XcdBarrier& b, Frame& F) {
    asm volatile("s_waitcnt vmcnt(0)" ::: "memory");
    __syncthreads();
    volatile LAS int* cw = (volatile LAS int*)(F.lds + MISC_OFF) + 16;
    unsigned* bar = b.bar; unsigned* nxt = (unsigned*)(F.ctl + CW_CVQ);
    unsigned gen = 0u, tg = 0u; int role = 0, stealok = 0;
    if (threadIdx.x == 0) {
        __builtin_amdgcn_s_waitcnt(0);
        unsigned nloc = b.st[0], nx = b.st[1];
        if (nloc == 0u) { xcd_barrier_complete(bar, b.x, nloc, nx); b.st[0] = nloc; b.st[1] = nx; }
        const unsigned old = xb_add(&bar[XB_XSUB(b.x)], 1u);
        gen = old / nloc;
        if (old + 1u == (gen + 1u) * nloc) {
            __builtin_amdgcn_fence(__ATOMIC_RELEASE, "agent");
            asm volatile("s_waitcnt vmcnt(0)" ::: "memory");
            const unsigned og = xb_add(&bar[XB_TOP], 1u);
            tg = og / nx;
            if (og + 1u == (tg + 1u) * nx) { xb_add(&bar[XB_TOPGEN], 1u); xb_add(&bar[XB_XGEN(b.x)], 1u); role = 0; }
            else role = 1;
        } else { role = 2; stealok = (old - gen * nloc + 1u + (3u * nloc) / 4u <= nloc); }
    }
    for (;;) {
        if (threadIdx.x == 0) {
            int rel = 1, base = -1;
            if (role == 1) { XB_SPIN(xb_ld(&bar[XB_TOPGEN]) == tg, bar); xb_add(&bar[XB_XGEN(b.x)], 1u); role = 0; }
            else if (role == 2) { if (xb_ld(&bar[XB_XGEN(b.x)]) == gen) rel = 0; }
            if (!rel) {
                if (stealok && !cw[4] && (int)xb_ld(nxt) < CV_TOTAL) base = (int)xb_add(nxt, 8u);
                else { if (stealok) cw[4] = 1; XB_SPIN(xb_ld(&bar[XB_XGEN(b.x)]) == gen, bar); rel = 1; }
            }
            cw[0] = rel; cw[1] = base;
        }
        __syncthreads();
        const int rel = cw[0], base = cw[1];
        __syncthreads();
        if (rel) break;
        if (base >= 0 && base + F.wave < CV_TOTAL) cv_run_item(F, base + F.wave);
    }
    if (threadIdx.x == 0) { __builtin_amdgcn_fence(__ATOMIC_ACQUIRE, "agent"); asm volatile("s_waitcnt vmcnt(0)" ::: "memory"); }
    __syncthreads();
}

__device__ __forceinline__ int moe_cnt(Frame& F, int f, int e) {
    const unsigned long long w = __hip_atomic_load((GAS unsigned long long*)(F.ctl + CW_CNT + f * 64 + 16 * (e >> 2)), RLX_AGENT);
    return (int)((w >> (16 * (e & 3))) & 0xffffull);
}
__device__ __forceinline__ f32x4 moe_yrow(Frame& F, int r, int q4) {
    const bf16* Y = (const bf16*)(F.ws + WS_R2); const bf16* P = (const bf16*)(F.ws + WS_R2 + 72 * MiB);
    if (r < SPLIT_ROW0 || F.G != 256 || !MOE_SPLITK) {
        if (MOE_Y_FP8) { const int a = ((const GAS int*)((const unsigned char*)Y + (size_t)r * DM))[q4]; const f32x2 lo = __builtin_amdgcn_cvt_pk_f32_fp8(a, false), hi = __builtin_amdgcn_cvt_pk_f32_fp8(a, true);
            return (f32x4){lo.x, lo.y, hi.x, hi.y} * (1.0f / Y8S); }
        const v2u a = ((const GAS v2u*)(Y + (size_t)r * DM))[q4]; return (f32x4){bflo(a.x), bfhi(a.x), bflo(a.y), bfhi(a.y)}; }
    f32x4 s = (f32x4){0.f, 0.f, 0.f, 0.f};
#pragma unroll
    for (int k = 0; k < MOE_NSPLIT; ++k) { const v2u a = ((const GAS v2u*)(P + ((size_t)k * SPLIT_ROWS + (size_t)(r - SPLIT_ROW0)) * DM))[q4]; s = s + (f32x4){bflo(a.x), bfhi(a.x), bflo(a.y), bfhi(a.y)}; }
    return s;
}
__device__ __forceinline__ void moe_bases(Frame& F, int f, int (&tb)[NE + 1]) {
    int acc = 0;
#pragma unroll
    for (int e = 0; e < NE; ++e) { tb[e] = acc; const int c = moe_cnt(F, f, e); acc += (c + 255) >> 8; }
    tb[NE] = acc;
}

template <int NC>
__device__ __forceinline__ float wave_reduce_cols(float (&part)[NC], int lane) {
#pragma unroll
    for (int st = 0, n = NC / 2; n >= 1; ++st, n >>= 1) {
        const bool up = (lane >> st) & 1;
#pragma unroll
        for (int i = 0; i < n; ++i) { const float keep = up ? part[i + n] : part[i], send = up ? part[i] : part[i + n]; part[i] = keep + __shfl_xor(send, 1 << st); }
    }
    float v = part[0];
#pragma unroll
    for (int o = NC; o < 64; o <<= 1) v += __shfl_xor(v, o);
    return v;
}
template <int NC> __device__ __forceinline__ int lane_of_col(int c) {
    int l = 0;
#pragma unroll
    for (int st = 0, n = NC / 2; n >= 1; ++st, n >>= 1) { if (c & n) l |= 1 << st; }
    return l;
}
__device__ __forceinline__ void panel_sync(Frame& F, const pg8::DenseOrder& S, unsigned* cnt) {
    if (F.tid == 0) {
        unsigned* bar = (unsigned*)(F.ctl + CW_BAR);
        const unsigned x = xb_xcc_id();
        bool mixed = false; pg8::Unit u;
        for (int i = 0; S.next(i, u); ++i) { unsigned w = 0u; XB_SPIN(((w = xb_ld(&cnt[u.pm])) & 15u) < 4u, bar); if (x >= 8u || ((w >> (4 + 3 * x)) & 7u) != 4u) mixed = true; }
        if (mixed) {
            __builtin_amdgcn_fence(__ATOMIC_RELEASE, "agent");
            asm volatile("s_waitcnt vmcnt(0)" ::: "memory");
            for (int i = 0; S.next(i, u); ++i) { const unsigned w = xb_ld(&cnt[u.pm]); if (x >= 8u || ((w >> (4 + 3 * x)) & 7u) != 4u) xb_add(&cnt[6 * 64 + u.pm], 1u); }
            for (int i = 0; S.next(i, u); ++i) { const unsigned w = xb_ld(&cnt[u.pm]); if (x >= 8u || ((w >> (4 + 3 * x)) & 7u) != 4u) XB_SPIN(xb_ld(&cnt[6 * 64 + u.pm]) < 4u, bar); }
        }
        __builtin_amdgcn_fence(__ATOMIC_ACQUIRE, "agent");
        asm volatile("s_waitcnt vmcnt(0)" ::: "memory");
    }
    __syncthreads();
}
template <int FLAGS>
__device__ __forceinline__ void norm_phase(Frame& F, const void* xin, void* xout, const float* gain, bf16* H, int fprev, int f,
                                           const float* Wf  , const float* bf  , const float* Wr  ,
                                           const pg8::DenseOrder* PS = nullptr, unsigned* pcnt = nullptr) {
    constexpr int NC = (FLAGS & 2) ? 16 : (FLAGS & 4) ? 8 : 0;
    const bf16* Y = (const bf16*)(F.ws + WS_R2);
    const int* tok_prev = (const int*)(F.ws + WS_MISC + MS_TOK) + (size_t)fprev * M * 2;
    float* lgf = (float*)(F.ws + WS_MISC + MS_LOGF);
    LAS int* sel = (LAS int*)F.lds;
    LAS float* sg = (LAS float*)(F.lds + 512);
    LAS int* gb = (LAS int*)(F.lds + 1536);
    LAS f32x4* WL = (LAS f32x4*)(F.lds + 4096);
    int tb[NE + 1];
    if (FLAGS & 1) moe_bases(F, fprev, tb);
    if (NC) {
        const float* Wsrc = (FLAGS & 2) ? Wf + 3072 : Wr; const int ldw = (FLAGS & 2) ? 3088 : 8;
        for (int idx = F.tid; idx < 16 * (NC / 4) * 64; idx += NTHR) {
            const int ln = idx & 63, cq = (idx >> 6) % (NC / 4), jq = idx / (64 * (NC / 4)), k = 4 * (ln + 64 * (jq >> 2)) + (jq & 3);
            WL[idx] = *(const GAS f32x4*)(Wsrc + (size_t)k * ldw + 4 * cq) * gain[k];
        }
        __syncthreads();
    }
    if (NC == 0 && !(FLAGS & 1)) {
        if (FLAGS & 64) panel_sync(F, *PS, pcnt);
        for (int it = 0;; ++it) {
            int chunk;
            if (FLAGS & 64) { pg8::Unit pu; if (!PS->next(it, pu)) break; chunk = pu.pm * 4 + pu.pn; }
            else { chunk = blockIdx.x + it * F.G; if (chunk >= M / 64) break; }
#pragma unroll 1
            for (int i = 0; i < 8; i += 4) {
                const int m0 = chunk * 64 + F.wave * 8 + i;
                int ln = F.lane; asm volatile("" : "+v"(ln));
                f32x4 v[4][4];
#pragma unroll
                for (int r = 0; r < 4; ++r) {
                    if (FLAGS & 16) { const GAS v2u* xr = (const GAS v2u*)((const bf16*)xin + (size_t)(m0 + r) * DM) + ln;
#pragma unroll
                        for (int j = 0; j < 4; ++j) { const v2u a = xr[64 * j]; v[r][j] = (f32x4){bflo(a.x), bfhi(a.x), bflo(a.y), bfhi(a.y)}; } }
                    else { const GAS f32x4* xr = (const GAS f32x4*)((const float*)xin + (size_t)(m0 + r) * DM) + ln;
#pragma unroll
                        for (int j = 0; j < 4; ++j) v[r][j] = __builtin_nontemporal_load(&xr[64 * j]); }
                }
                f32x4 g[4];
#pragma unroll
                for (int j = 0; j < 4; ++j) g[j] = ((const GAS f32x4*)gain + ln)[64 * j];
#pragma unroll
                for (int r = 0; r < 4; ++r) {
                    const int m = m0 + r;
                    if (FLAGS & 32) {
#pragma unroll
                        for (int j = 0; j < 4; ++j) ((GAS v2u*)((bf16*)xout + (size_t)m * DM) + ln)[64 * j] = (v2u){pk2(v[r][j].x, v[r][j].y), pk2(v[r][j].z, v[r][j].w)}; }
                    float s = 0.f;
#pragma unroll
                    for (int j = 0; j < 4; ++j) s += (v[r][j].x * v[r][j].x + v[r][j].y * v[r][j].y) + (v[r][j].z * v[r][j].z + v[r][j].w * v[r][j].w);
                    const float inv = 1.0f / sqrtf(wave_sum(s) * (1.f / DM) + RMS_EPS);
                    GAS unsigned long long* o8 = (GAS unsigned long long*)(H + (size_t)m * DM) + ln;
                    GAS unsigned* h8 = (GAS unsigned*)(F.ws + WS_R2 + 104 * MiB + (size_t)m * DM) + ln;
#pragma unroll
                    for (int j = 0; j < 4; ++j) { const f32x4 hv = v[r][j] * inv * g[j];
                        if (FLAGS & 8) h8[64 * j] = pg8::cvt4_fp8(hv.x, hv.y, hv.z, hv.w);
                        else o8[64 * j] = (unsigned long long)pk2(hv.x, hv.y) | ((unsigned long long)pk2(hv.z, hv.w) << 32); }
                }
            }
        }
        return;
    }
    if (FLAGS & 64) panel_sync(F, *PS, pcnt);
    for (int it = 0;; ++it) {
        int chunk;
        if (FLAGS & 64) { pg8::Unit pu; if (!PS->next(it, pu)) break; chunk = pu.pm * 4 + pu.pn; }
        else { chunk = blockIdx.x + it * F.G; if (chunk >= M / 64) break; }
        constexpr bool PIPE = (FLAGS & 1) && (FLAGS & 16) && MOE_Y_FP8;
        const bool splitrows = (F.G == 256) && MOE_SPLITK;
        v2u px[4]; int pya[4], pyb[4], pr0 = 0, pr1 = 0, qs0 = 0, qs1 = 0;
        if (PIPE) {
            const int mf = chunk * 64 + F.wave * 8; int l0 = F.lane; asm volatile("" : "+v"(l0));
            const int s0 = tok_prev[mf * 2], s1 = tok_prev[mf * 2 + 1]; qs0 = tok_prev[mf * 2 + 2]; qs1 = tok_prev[mf * 2 + 3];
#pragma unroll
            for (int e = 0; e < NE; ++e) { if ((s0 >> 14) == e) pr0 = tb[e] * 256 + (s0 & 16383); if ((s1 >> 14) == e) pr1 = tb[e] * 256 + (s1 & 16383); }
            const GAS v2u* xr = (const GAS v2u*)((const bf16*)xin + (size_t)mf * DM) + l0;
            const GAS int* y0 = (const GAS int*)((const unsigned char*)Y + (size_t)pr0 * DM) + l0; const GAS int* y1 = (const GAS int*)((const unsigned char*)Y + (size_t)pr1 * DM) + l0;
#pragma unroll
            for (int j = 0; j < 4; ++j) { px[j] = xr[64 * j]; pya[j] = y0[64 * j]; pyb[j] = y1[64 * j]; }
        }
        for (int i = 0; i < 8; ++i) {
            const int m = chunk * 64 + F.wave * 8 + i;
            int ln = F.lane; asm volatile("" : "+v"(ln));
            f32x4 v[4];
            if (PIPE) {
                const int r0 = pr0, r1 = pr1;
                v2u cx[4]; int ca[4], cb[4];
#pragma unroll
                for (int j = 0; j < 4; ++j) { cx[j] = px[j]; ca[j] = pya[j]; cb[j] = pyb[j]; }
                if (i < 7) {
                    int n0 = 0, n1 = 0;
#pragma unroll
                    for (int e = 0; e < NE; ++e) { if ((qs0 >> 14) == e) n0 = tb[e] * 256 + (qs0 & 16383); if ((qs1 >> 14) == e) n1 = tb[e] * 256 + (qs1 & 16383); }
                    pr0 = n0; pr1 = n1;
                    const GAS v2u* xr = (const GAS v2u*)((const bf16*)xin + (size_t)(m + 1) * DM) + ln;
                    const GAS int* y0 = (const GAS int*)((const unsigned char*)Y + (size_t)n0 * DM) + ln; const GAS int* y1 = (const GAS int*)((const unsigned char*)Y + (size_t)n1 * DM) + ln;
#pragma unroll
                    for (int j = 0; j < 4; ++j) { px[j] = xr[64 * j]; pya[j] = y0[64 * j]; pyb[j] = y1[64 * j]; }
                    if (i < 6) { qs0 = tok_prev[(m + 2) * 2]; qs1 = tok_prev[(m + 2) * 2 + 1]; }
                }
                const bool t0 = splitrows && r0 >= SPLIT_ROW0, t1 = splitrows && r1 >= SPLIT_ROW0;
#pragma unroll
                for (int j = 0; j < 4; ++j) { f32x4 o = (f32x4){bflo(cx[j].x), bfhi(cx[j].x), bflo(cx[j].y), bfhi(cx[j].y)};
                    if (t0) o = o + moe_yrow(F, r0, ln + 64 * j);
                    else { const f32x2 lo = __builtin_amdgcn_cvt_pk_f32_fp8(ca[j], false), hi = __builtin_amdgcn_cvt_pk_f32_fp8(ca[j], true); o = o + (f32x4){lo.x, lo.y, hi.x, hi.y} * (1.0f / Y8S); }
                    if (t1) o = o + moe_yrow(F, r1, ln + 64 * j);
                    else { const f32x2 lo = __builtin_amdgcn_cvt_pk_f32_fp8(cb[j], false), hi = __builtin_amdgcn_cvt_pk_f32_fp8(cb[j], true); o = o + (f32x4){lo.x, lo.y, hi.x, hi.y} * (1.0f / Y8S); }
                    v[j] = o;
                    ((GAS v2u*)((bf16*)xout + (size_t)m * DM) + ln)[64 * j] = (v2u){pk2(o.x, o.y), pk2(o.z, o.w)}; }
            } else {
            if (FLAGS & 16) { const GAS v2u* xr = (const GAS v2u*)((const bf16*)xin + (size_t)m * DM) + ln;
#pragma unroll
                for (int j = 0; j < 4; ++j) { const v2u a = xr[64 * j]; v[j] = (f32x4){bflo(a.x), bfhi(a.x), bflo(a.y), bfhi(a.y)}; } }
            else { const GAS f32x4* xr = (const GAS f32x4*)((const float*)xin + (size_t)m * DM) + ln;
#pragma unroll
                for (int j = 0; j < 4; ++j) v[j] = xr[64 * j]; }
            if (FLAGS & 1) {
                const int s0 = tok_prev[m * 2], s1 = tok_prev[m * 2 + 1];
                int r0 = 0, r1 = 0;
#pragma unroll
                for (int e = 0; e < NE; ++e) { if ((s0 >> 14) == e) r0 = tb[e] * 256 + (s0 & 16383); if ((s1 >> 14) == e) r1 = tb[e] * 256 + (s1 & 16383); }
#pragma unroll
                for (int j = 0; j < 4; ++j) { v[j] = v[j] + moe_yrow(F, r0, ln + 64 * j) + moe_yrow(F, r1, ln + 64 * j);
                    ((GAS v2u*)((bf16*)xout + (size_t)m * DM) + ln)[64 * j] = (v2u){pk2(v[j].x, v[j].y), pk2(v[j].z, v[j].w)}; }
            }
            }
            if (FLAGS & 32) {
#pragma unroll
                for (int j = 0; j < 4; ++j) ((GAS v2u*)((bf16*)xout + (size_t)m * DM) + ln)[64 * j] = (v2u){pk2(v[j].x, v[j].y), pk2(v[j].z, v[j].w)}; }
            float s = 0.f;
#pragma unroll
            for (int j = 0; j < 4; ++j) s += (v[j].x * v[j].x + v[j].y * v[j].y) + (v[j].z * v[j].z + v[j].w * v[j].w);
            const float inv = 1.0f / sqrtf(wave_sum(s) * (1.f / DM) + RMS_EPS);
            float colv = 0.f;
            if (NC) {
                float part[NC ? NC : 1];
#pragma unroll
                for (int c = 0; c < NC; ++c) part[c] = 0.f;
                const int woff = ln;
#pragma unroll
                for (int j = 0; j < 4; ++j) {
#pragma unroll
                    for (int q = 0; q < 4; ++q) { const float xv = v[j][q];
#pragma unroll
                        for (int cq = 0; cq < NC / 4; ++cq) { const f32x4 w = WL[((j * 4 + q) * (NC / 4) + cq) * 64 + woff];
                            part[cq * 4 + 0] += xv * w.x; part[cq * 4 + 1] += xv * w.y; part[cq * 4 + 2] += xv * w.z; part[cq * 4 + 3] += xv * w.w; }
                        if ((q & 1) == 1) asm volatile("" ::: "memory"); } }
                colv = wave_reduce_cols<NC ? NC : 2>(reinterpret_cast<float (&)[NC ? NC : 2]>(part), ln) * inv;
            }
            if (H) {
                GAS unsigned long long* o8 = (GAS unsigned long long*)(H + (size_t)m * DM) + ln;
                GAS unsigned* h8 = (GAS unsigned*)(F.ws + WS_R2 + 104 * MiB + (size_t)m * DM) + ln;
#pragma unroll
                for (int j = 0; j < 4; ++j) { const f32x4 g = ((const GAS f32x4*)gain + ln)[64 * j]; const f32x4 hv = v[j] * inv * g;
                    if (((FLAGS & 4) && MOE_FP8) || (FLAGS & 8)) h8[64 * j] = pg8::cvt4_fp8(hv.x, hv.y, hv.z, hv.w);
                    else o8[64 * j] = (unsigned long long)pk2(hv.x, hv.y) | ((unsigned long long)pk2(hv.z, hv.w) << 32); }
            }
            if (FLAGS & 2) {
                if (ln < 16) { const int l = ln; const int c = ((l & 1) << 3) | ((l & 2) << 1) | ((l & 4) >> 1) | ((l & 8) >> 3);
                    const float z = colv + bf[c]; const float ls = fminf(z, 0.f) - log1pf(expf(-fabsf(z))); lgf[(size_t)m * 16 + c] = ls * LOG2E; }
            }
            if (FLAGS & 4) {
                float lg[8];
#pragma unroll
                for (int c = 0; c < 8; ++c) lg[c] = __builtin_bit_cast(float, __builtin_amdgcn_readlane(__builtin_bit_cast(int, colv), lane_of_col<8>(c)));
                int e0 = 0; float l0 = lg[0];
#pragma unroll
                for (int c = 1; c < 8; ++c) if (lg[c] > l0) { l0 = lg[c]; e0 = c; }
                int e1 = -1; float l1 = -INFINITY;
#pragma unroll
                for (int c = 0; c < 8; ++c) if (c != e0 && lg[c] > l1) { l1 = lg[c]; e1 = c; }
                const float g0 = 1.0f / (1.0f + expf(l1 - l0)), g1 = 1.0f - g0;
                if (ln == 0) { const int r = F.wave * 8 + i; sel[r * 2] = e0; sel[r * 2 + 1] = e1; sg[r * 2] = g0; sg[r * 2 + 1] = g1; }
            }
        }
        if (FLAGS & 4) {
            int* selg = (int*)(F.ws + WS_MISC + MS_SEL) + (size_t)f * M * 2;
            float* sgg = (float*)(F.ws + WS_MISC + MS_SG) + (size_t)f * M * 2;
            int* lcn = (int*)(F.ws + WS_MISC + MS_LC) + (size_t)f * 256 * 8;
            __syncthreads();
            if (F.tid < 128) { selg[chunk * 128 + F.tid] = sel[F.tid]; sgg[chunk * 128 + F.tid] = sg[F.tid]; }
            if (F.tid >= 128 && F.tid < 136) { const int e = F.tid - 128; int c = 0;
                for (int q = 0; q < 128; ++q) c += (sel[q] == e) ? 1 : 0;
                lcn[chunk * 8 + e] = c; }
            __syncthreads();
        }
    }
}

__device__ __forceinline__ void moe_finalize(Frame& F, int f) {
    const int* selg = (const int*)(F.ws + WS_MISC + MS_SEL) + (size_t)f * M * 2;
    const float* sgg = (const float*)(F.ws + WS_MISC + MS_SG) + (size_t)f * M * 2;
    const int* lcn = (const int*)(F.ws + WS_MISC + MS_LC) + (size_t)f * 256 * 8;
    int* list = (int*)(F.ws + WS_MISC + MS_LIST) + (size_t)f * NE * LCAP;
    float* gw = (float*)(F.ws + WS_MISC + MS_GW) + (size_t)f * NE * LCAP;
    int* tok = (int*)(F.ws + WS_MISC + MS_TOK) + (size_t)f * M * 2;
    LAS int* arr = (LAS int*)F.lds;
    LAS int* sel = (LAS int*)(F.lds + 8192);
    LAS int* pb = (LAS int*)(F.lds + 8192 + 512);
    LAS int* pt = (LAS int*)(F.lds + 8192 + 1536);
    LAS int* base = (LAS int*)(F.lds + 8192 + 2560);
    LAS int* tot = (LAS int*)(F.lds + 8192 + 2592);
    for (int chunk = blockIdx.x; chunk < M / 64; chunk += F.G) {
        if (F.tid < 256) { const v4u a = *(const GAS v4u*)(lcn + F.tid * 8), b = *(const GAS v4u*)(lcn + F.tid * 8 + 4);
            *(LAS v4u*)(arr + F.tid * 8) = a; *(LAS v4u*)(arr + F.tid * 8 + 4) = b; }
        if (F.tid < 128) sel[F.tid] = selg[chunk * 128 + F.tid];
        __syncthreads();
        if (F.tid < 256) { const int e = F.tid & 7, seg = F.tid >> 3; int b = 0, t = 0;
#pragma unroll
            for (int i = 0; i < 8; ++i) { const int c = seg * 8 + i; const int v = arr[c * 8 + e]; t += v; b += (c < chunk) ? v : 0; }
            pb[seg * 8 + e] = b; pt[seg * 8 + e] = t; }
        __syncthreads();
        if (F.tid < 8) { int b = 0, t = 0;
            for (int sgm = 0; sgm < 32; ++sgm) { b += pb[sgm * 8 + F.tid]; t += pt[sgm * 8 + F.tid]; }
            base[F.tid] = b; tot[F.tid] = t; }
        __syncthreads();
        if (F.tid < 128) { const int mye = sel[F.tid]; int lp = 0;
            for (int q = 0; q < 128; ++q) lp += (q < F.tid && sel[q] == mye) ? 1 : 0;
            const int q = F.tid, row = chunk * 64 + (q >> 1), pos = base[mye] + lp;
            list[mye * LCAP + pos] = row; gw[mye * LCAP + pos] = sgg[chunk * 128 + q]; tok[row * 2 + (q & 1)] = mye * LCAP + pos; }
        if (chunk == 0 && F.tid < 2) { unsigned long long w = 0ull;
#pragma unroll
            for (int i = 0; i < 4; ++i) w |= (unsigned long long)(unsigned)tot[4 * F.tid + i] << (16 * i);
            __hip_atomic_store((GAS unsigned long long*)(F.ctl + CW_CNT + f * 64 + 16 * F.tid), w, RLX_AGENT); }
        __syncthreads();
    }
}

__device__ __forceinline__ void final_combine(Frame& F, int f) {
    static_assert(MOE_Y_FP8, "final_combine reads e4m3 y rows");
    const unsigned char* Y8 = (const unsigned char*)(F.ws + WS_R2);
    const int* tok = (const int*)(F.ws + WS_MISC + MS_TOK) + (size_t)f * M * 2;
    int tb[NE + 1]; moe_bases(F, f, tb);
    const bool split = (F.G == 256) && MOE_SPLITK;
    const int stride = F.G * NWAVES;
    for (int m0 = blockIdx.x * NWAVES + F.wave; m0 < M; m0 += 4 * stride) {
        int r0[4], r1[4];
#pragma unroll
        for (int q = 0; q < 4; ++q) { const int m = m0 + q * stride; int s0 = 0, s1 = 0; if (m < M) { s0 = tok[m * 2]; s1 = tok[m * 2 + 1]; }
            int a0 = 0, a1 = 0;
#pragma unroll
            for (int e = 0; e < NE; ++e) { if ((s0 >> 14) == e) a0 = tb[e] * 256 + (s0 & 16383); if ((s1 >> 14) == e) a1 = tb[e] * 256 + (s1 & 16383); }
            r0[q] = a0; r1[q] = a1; }
        v2u xv[4][4]; int ya[4][4], yb[4][4];
#pragma unroll
        for (int q = 0; q < 4; ++q) { const int m = m0 + q * stride; if (m < M) {
            const GAS v2u* xr = (const GAS v2u*)((const bf16*)(F.ws + WS_XB) + (size_t)m * DM) + F.lane;
            const GAS int* y0 = (const GAS int*)(Y8 + (size_t)r0[q] * DM) + F.lane; const GAS int* y1 = (const GAS int*)(Y8 + (size_t)r1[q] * DM) + F.lane;
#pragma unroll
            for (int j = 0; j < 4; ++j) { xv[q][j] = __builtin_nontemporal_load(&xr[64 * j]); ya[q][j] = __builtin_nontemporal_load(&y0[64 * j]); yb[q][j] = __builtin_nontemporal_load(&y1[64 * j]); } } }
#pragma unroll
        for (int q = 0; q < 4; ++q) { const int m = m0 + q * stride; if (m < M) {
            GAS f32x4* xo = (GAS f32x4*)(F.out + (size_t)m * DM) + F.lane;
            const bool t0 = split && r0[q] >= SPLIT_ROW0, t1 = split && r1[q] >= SPLIT_ROW0;
#pragma unroll
            for (int j = 0; j < 4; ++j) { const v2u a = xv[q][j]; f32x4 o = (f32x4){bflo(a.x), bfhi(a.x), bflo(a.y), bfhi(a.y)};
                if (t0) o = o + moe_yrow(F, r0[q], F.lane + 64 * j);
                else { const f32x2 lo = __builtin_amdgcn_cvt_pk_f32_fp8(ya[q][j], false), hi = __builtin_amdgcn_cvt_pk_f32_fp8(ya[q][j], true); o = o + (f32x4){lo.x, lo.y, hi.x, hi.y} * (1.0f / Y8S); }
                if (t1) o = o + moe_yrow(F, r1[q], F.lane + 64 * j);
                else { const f32x2 lo = __builtin_amdgcn_cvt_pk_f32_fp8(yb[q][j], false), hi = __builtin_amdgcn_cvt_pk_f32_fp8(yb[q][j], true); o = o + (f32x4){lo.x, lo.y, hi.x, hi.y} * (1.0f / Y8S); }
                __builtin_nontemporal_store(o, &xo[64 * j]); } } }
    }
}

constexpr bool seam_local(int k) { return k == 1 || k == 2 || k == 4 || k == 6 || k == 7 || k == 8 || (k >= 14 && k <= 20); }
constexpr int seam_next_grid(int k) { int j = k + 1; while (j < 25 && seam_local(j)) ++j; return j; }
constexpr int seam_need(int k) { return cv_need(seam_next_grid(k) < 25 ? seam_next_grid(k) : 25); }
constexpr int seam_prev_need(int k) { int j = k - 1; while (j >= 0 && seam_local(j)) --j; return j < 0 ? 0 : seam_need(j); }
__device__ __forceinline__ void xcd_local_barrier(Frame& F, const XcdBarrier& b) {
    volatile LAS int* cw = (volatile LAS int*)(F.lds + MISC_OFF) + 16;
    int mode = cw[5];
    if (mode == 0) {
        __syncthreads();
        if (F.tid == 0) { bool ok = (F.G == 256);
            for (int g = 0; g < 8; ++g) { const unsigned m = xb_ld((unsigned*)(F.ctl + CW_XMASK + g)); ok = ok && m != 0u && (m & (m - 1u)) == 0u; }
            cw[5] = ok ? 1 : 2; }
        __syncthreads();
        mode = cw[5];
    }
    if (mode != 1) { xcd_barrier_steal(b, F); return; }
    asm volatile("s_waitcnt vmcnt(0)" ::: "memory");
    __syncthreads();
    unsigned* bar = b.bar; unsigned* lb = (unsigned*)(F.ctl + CW_LBAR + 64 * (int)(blockIdx.x & 7)); unsigned* nxt = (unsigned*)(F.ctl + CW_CVQ);
    unsigned target = 0u; int early = 0;
    if (F.tid == 0) {
        const unsigned n = ((unsigned)F.G - (blockIdx.x & 7) + 7u) / 8u;
        const unsigned old = xb_add(lb, 1u); target = (old / n + 1u) * n;
        early = (old + 1u + n / 4u <= target) && !cw[4];
    }
    for (;;) {
        if (F.tid == 0) {
            int rel = 1, base = -1;
            if (early && xb_ld(lb) < target) {
                if ((int)xb_ld(nxt) < CV_TOTAL) { base = (int)xb_add(nxt, 8u); rel = 0; }
                else { cw[4] = 1; early = 0; }
            }
            if (rel) XB_SPIN(xb_ld(lb) < target, bar);
            cw[0] = rel; cw[1] = base;
        }
        __syncthreads();
        const int rel = cw[0], base = cw[1];
        __syncthreads();
        if (rel) break;
        if (base >= 0 && base + F.wave < CV_TOTAL) cv_run_item(F, base + F.wave);
    }
    if (F.tid == 0) { __builtin_amdgcn_fence(__ATOMIC_ACQUIRE, "agent"); asm volatile("s_waitcnt vmcnt(0)" ::: "memory"); }
    __syncthreads();
}

template <int NB> __device__ __forceinline__ void stagger_convert(Frame& F) {
    if ((((int)blockIdx.x >> 3) & 1) == 0) return;
    volatile LAS int* cw = (volatile LAS int*)(F.lds + MISC_OFF) + 16;
    if (cw[4]) return;
    unsigned* nxt = (unsigned*)(F.ctl + CW_CVQ);
    for (int r = 0; r < NB; ++r) {
        __syncthreads();
        if (F.tid == 0) { int b = -1; if ((int)xb_ld(nxt) < CV_TOTAL) b = (int)xb_add(nxt, 8u); cw[0] = b; }
        __syncthreads();
        const int base = cw[0];
        if (base < 0) break;
        if (base + F.wave < CV_TOTAL) cv_run_item(F, base + F.wave);
    }
    __syncthreads();
}
template <class Epi, bool FP8 = false>
__device__ __forceinline__ void dense_gemm(Frame& F, const bf16* A, const bf16* Bt, int N, int K, const Epi& E) {
    pg8::DenseOrder S; S.init(A, Bt, M, N, K, F.G, (int)blockIdx.x);
    pg8::gemm_phase<Epi, pg8::DenseOrder, false, FP8>(F.lds, K, S, E);
}
template <int NFLAGS, class Epi, bool FP8 = false>
__device__ __forceinline__ void resid_gemm_norm(Frame& F, int site, const bf16* A, const bf16* Bt, int K, const Epi& E, const void* X, const float* gain, bf16* H, int f, const float* Wr) {
    pg8::DenseOrder S; S.init(A, Bt, M, DM, K, F.G, (int)blockIdx.x);
    pg8::gemm_phase<Epi, pg8::DenseOrder, false, FP8>(F.lds, K, S, E);
    unsigned* cnt = (unsigned*)(F.ctl + CW_PANEL + site * 64);
    asm volatile("s_waitcnt vmcnt(0)" ::: "memory");
    __syncthreads();
    if (F.tid == 0) {
        const unsigned x = xb_xcc_id(); pg8::Unit u;
        for (int i = 0; S.next(i, u); ++i) xb_add(&cnt[u.pm], 1u + (x < 8u ? (1u << (4 + 3 * x)) : 0u));
    }
    norm_phase<NFLAGS | 16 | 64>(F, X, nullptr, gain, H, 0, f, nullptr, nullptr, Wr, &S, cnt);
}
__device__ __forceinline__ void moe_order_init(Frame& F, int f, pg8::MoeOrder& S) {
    int acc = 0, t[NE];
#pragma unroll
    for (int e = 0; e < NE; ++e) { const int c = moe_cnt(F, f, e); acc += (c + 255) >> 8; t[e] = acc; }
    S.t1 = t[0]; S.t2 = t[1]; S.t3 = t[2]; S.t4 = t[3]; S.t5 = t[4]; S.t6 = t[5]; S.t7 = t[6]; S.t8 = t[7];
    S.G = F.G; S.c = (int)blockIdx.x;
}
__device__ __forceinline__ void moe_gu_fast(Frame& F, int f, const bf16* H, bf16* ACT) {
    pg8::MoeOrder S; moe_order_init(F, f, S);
    S.list = (const int*)(F.ws + WS_MISC + MS_LIST) + (size_t)f * NE * LCAP; S.gather = true; S.splitk = 0; S.xcdperm = false; S.nN = 2 * FF / 256;
    if (MOE_FP8) {
        S.K = DM / 2; S.A = (const char*)(F.ws + WS_R2 + 104 * MiB); S.Bt = (const char*)((const bf16*)(F.ws + WS_W) + WE_MGU) + (size_t)f * NE * 2 * FF * DM;
        S.tstepA = (size_t)256 * DM; S.tstepB = (size_t)256 * DM; S.estepB = (size_t)2 * FF * DM;
        pg8::EpiSwigluF8 E{(unsigned char*)ACT};
        pg8::gemm_phase<pg8::EpiSwigluF8, pg8::MoeOrder, true, true>(F.lds, DM / 2, S, E);
    } else {
        S.K = DM; S.A = (const char*)H; S.Bt = (const char*)((const bf16*)(F.ws + WS_W) + WE_MGU + (size_t)f * NE * 2 * FF * DM);
        S.tstepA = (size_t)256 * DM * 2; S.tstepB = (size_t)256 * DM * 2; S.estepB = (size_t)2 * FF * DM * 2;
        pg8::EpiSwiglu E{ACT};
        pg8::gemm_phase<pg8::EpiSwiglu, pg8::MoeOrder, true>(F.lds, DM, S, E);
    }
}
__device__ __forceinline__ void moe_down_fast(Frame& F, int f, const bf16* ACT, bf16* Y) {
    pg8::MoeOrder S; moe_order_init(F, f, S);
    S.nN = DM / 256; S.list = nullptr; S.gather = false; S.xcdperm = (F.G == 256); S.splitk = (MOE_SPLITK && F.G == 256) ? MOE_NSPLIT : 0;
    const float* gwp = (const float*)(F.ws + WS_MISC + MS_GW) + (size_t)f * NE * LCAP; bf16* P = (bf16*)(F.ws + WS_R2 + 72 * MiB);
    if (MOE_FP8) {
        S.K = FF / 2; S.A = (const char*)ACT; S.Bt = (const char*)((const bf16*)(F.ws + WS_W) + WE_MD) + (size_t)f * NE * DM * FF;
        S.tstepA = (size_t)256 * FF; S.tstepB = (size_t)256 * FF; S.estepB = (size_t)DM * FF;
        pg8::EpiMoeDown E{Y, gwp, P, 1.0f / (W8S * A8S)};
        pg8::gemm_phase<pg8::EpiMoeDown, pg8::MoeOrder, false, true>(F.lds, FF / 2, S, E);
    } else {
        S.K = FF; S.A = (const char*)ACT; S.Bt = (const char*)((const bf16*)(F.ws + WS_W) + WE_MD + (size_t)f * NE * DM * FF);
        S.tstepA = (size_t)256 * FF * 2; S.tstepB = (size_t)256 * FF * 2; S.estepB = (size_t)DM * FF * 2;
        pg8::EpiMoeDown E{Y, gwp, P, 1.0f};
        pg8::gemm_phase<pg8::EpiMoeDown, pg8::MoeOrder, false>(F.lds, FF, S, E);
    }
}

struct Args { const float* in[22]; float* out; unsigned char* ws; int ph_lo, ph_hi; };
constexpr int N_PHASES = 26;

__global__ void __launch_bounds__(NTHR, 2) trunk_fwd(Args args) {
    extern __shared__ __attribute__((aligned(16))) unsigned char lds[];
    Frame F;
    F.lds = (LAS unsigned char*)lds;
    F.tid = threadIdx.x; F.lane = F.tid & 63; F.wave = __builtin_amdgcn_readfirstlane(F.tid >> 6); F.G = gridDim.x;
    F.ws = args.ws; F.ctl = (gu32*)(args.ws + WS_CTL); F.out = args.out;
    if (F.tid == 0) {
#pragma unroll
        for (int i = 0; i < 22; ++i) ((LAS unsigned long long*)(F.lds + PTR_OFF))[i] = (unsigned long long)args.in[i];
    }
    volatile LAS unsigned* MISC = (volatile LAS unsigned*)(F.lds + MISC_OFF);
    if (F.tid < 32) MISC[F.tid] = 0u;
    __syncthreads();
    XcdBarrier bar; bar.bar = (unsigned*)(F.ctl + CW_BAR); bar.x = 0; bar.st = nullptr;
    const int lo = args.ph_lo, hi = args.ph_hi;
    if (hi - lo > 1) bar = xcd_barrier_post((unsigned*)(F.ctl + CW_BAR), MISC + 8);
    if (F.tid == 0) (void)__hip_atomic_fetch_or((unsigned*)(F.ctl + CW_XMASK + (int)(blockIdx.x & 7)), 1u << (xb_xcc_id() & 31u), __ATOMIC_RELAXED, __HIP_MEMORY_SCOPE_AGENT);
#ifndef PHSEL
#define PHSEL 0xFFFFFFFFFFFFFFFFull
#endif
#define IN(k) (lo <= (k) && (k) < hi && ((PHSEL >> (k)) & 1ull) && relaunder(F))
#define SEAM(k) do { if (IN((k) + 1) && IN(k)) { if (seam_local(k) && !MK_MULTI) xcd_local_barrier(F, bar); else xcd_barrier_steal(bar, F); } } while (0)
#ifndef DUPMASK
#define DUPMASK 0ull
#endif
#define DUP(k) (((DUPMASK >> (k)) & 1ull) != 0ull)

    bf16* H = (bf16*)(F.ws + WS_H);
    bf16* PROJ = (bf16*)(F.ws + WS_R1);
    bf16* ACT = (bf16*)(F.ws + WS_R1);
    bf16* ACT2 = (bf16*)(F.ws + WS_R1 + 96 * MiB);
    bf16* O = (bf16*)(F.ws + WS_R2);
    bf16* Y = (bf16*)(F.ws + WS_R2);
    bf16* OG = (bf16*)(F.ws + WS_R2 + 32 * MiB);
    float* ST = (float*)(F.ws + WS_R2 + 128 * MiB);
    bf16* X = (bf16*)(F.ws + WS_XB);
    const bf16* H8 = (const bf16*)(F.ws + WS_R2 + 104 * MiB);
    float* DUMMY = (float*)(F.ws + WS_R2 + 32 * MiB);
    const float* cum = (const float*)(F.ws + WS_MISC + MS_LOGF);

    const bf16* WB = (const bf16*)(F.ws + WS_W);
    enum { PH_BASE = __COUNTER__ + 1 };
#define PHASE(...) { constexpr int k_ = __COUNTER__ - PH_BASE; if (IN(k_)) { __VA_ARGS__; if (MK_MULTI) cv_drain(F, cv_need(k_ + 1)); else if (!seam_local(k_) && seam_need(k_) != seam_prev_need(k_)) cv_drain(F, seam_need(k_)); SEAM(k_); } }
    PHASE({ unsigned* z = (unsigned*)(F.ws + WS_MISC + MS_LIST);
            for (int i = blockIdx.x * NTHR + F.tid; i < (int)(2 * MiB / 4); i += F.G * NTHR) z[i] = 0u;
            norm_phase<32>(F, INP(0), X, INP(13) + 0 * DM, H, 0, 0, nullptr, nullptr, nullptr); })
    PHASE({ stagger_convert<1>(F); pg8::EpiPlanes E{PROJ, C2, 1.0f}; dense_gemm(F, H, WB + WE_QKV, 3 * DM, DM, E); })
    PHASE(att::causal_phase<0>((att::lptr)F.lds, F.G, PROJ, PROJ + PLANE, PROJ + 2 * PLANE, O, nullptr, false))
    PHASE({ pg8::EpiResid<false> E{X, X, 1.0f}; resid_gemm_norm<(DENSE_FP8_L0 ? 8 : 0)>(F, 0, O, WB + WE_WO_SB, DM, E, X, INP(14) + 0 * DM, H, 0, nullptr); })
    PHASE({ stagger_convert<1>(F);
            if (DENSE_FP8_L0) { pg8::EpiSwigluF8 E{(unsigned char*)ACT}; dense_gemm<pg8::EpiSwigluF8, true>(F, H8, (const bf16*)((const unsigned char*)(WB + WE_GU)), 2 * FF, DM / 2, E); }
            else { pg8::EpiSwiglu E{ACT}; dense_gemm(F, H, WB + WE_GU, 2 * FF, DM, E); } })
    PHASE({ if (DENSE_FP8_L0) { pg8::EpiResid<false> E{X, X, 1.0f / (W8S * A8S)}; resid_gemm_norm<(DILIN_FP8 ? 8 : 0), pg8::EpiResid<false>, true>(F, 1, ACT, (const bf16*)((const unsigned char*)(WB + WE_D)), FF / 2, E, X, INP(13) + 1 * DM, H, 0, nullptr); }
            else { pg8::EpiResid<false> E{X, X, 1.0f}; resid_gemm_norm<(DILIN_FP8 ? 8 : 0)>(F, 1, ACT, WB + WE_D, FF, E, X, INP(13) + 1 * DM, H, 0, nullptr); } })
    PHASE({ stagger_convert<1>(F);
            if (DILIN_FP8) { pg8::EpiQKNorm E{PROJ, INP(4), INP(5), 6, 1.0f / W8S}; dense_gemm<pg8::EpiQKNorm, true>(F, H8, WB + WE_IN_DIL, 7 * DM, DM / 2, E); }
            else { pg8::EpiQKNorm E{PROJ, INP(4), INP(5), 6, 1.0f}; dense_gemm(F, H, WB + WE_IN_DIL, 7 * DM, DM, E); } })
    PHASE(att::dil_phase((att::lptr)F.lds, F.G, PROJ, OG, ST, INP(12), 0, O))
    PHASE(att::dil_phase((att::lptr)F.lds, F.G, PROJ, OG, ST, INP(12), 1, O))
    PHASE({ if (WO_FP8) { pg8::EpiResid<false> E{X, X, 1.0f / (W8S * A8S)}; resid_gemm_norm<4, pg8::EpiResid<false>, true>(F, 2, O, WB + WE_WO_DIL, DM / 2, E, X, INP(14) + 1 * DM, H, 0, INP(18) + 0 * DM * NE); }
            else { pg8::EpiResid<false> E{X, X, 1.0f}; resid_gemm_norm<4>(F, 2, O, WB + WE_WO_DIL, DM, E, X, INP(14) + 1 * DM, H, 0, INP(18) + 0 * DM * NE); } })
    PHASE(moe_finalize(F, 0))
    PHASE({ stagger_convert<1>(F); moe_gu_fast(F, 0, H, ACT); })
    PHASE(moe_down_fast(F, 0, ACT, Y))
    PHASE(norm_phase<(1 | 2 | (FOXIN_FP8 ? 8 : 0)) | 16>(F, X, X, INP(13) + 2 * DM, H, 0, 0, INP(7), INP(8), nullptr))
    PHASE({ stagger_convert<1>(F);
            if (FOXIN_FP8) { pg8::EpiQKNorm E{PROJ, INP(9), INP(10), 2, 1.0f / W8S}; dense_gemm<pg8::EpiQKNorm, true>(F, H8, WB + WE_IN_FOX, 3 * DM, DM / 2, E); }
            else { pg8::EpiQKNorm E{PROJ, INP(9), INP(10), 2, 1.0f}; dense_gemm(F, H, WB + WE_IN_FOX, 3 * DM, DM, E); } })
    PHASE(att::causal_phase<2>((att::lptr)F.lds, F.G, PROJ, PROJ + PLANE, PROJ + 2 * PLANE, O, cum, WO_FP8, INP(9), INP(10)))
    PHASE({ if (WO_FP8) { pg8::EpiResid<false> E{X, X, 1.0f / (W8S * A8S)}; resid_gemm_norm<(DENSE_FP8_L2 ? 8 : 0), pg8::EpiResid<false>, true>(F, 3, O, WB + WE_WO_FOX, DM / 2, E, X, INP(14) + 2 * DM, H, 0, nullptr); }
            else { pg8::EpiResid<false> E{X, X, 1.0f}; resid_gemm_norm<(DENSE_FP8_L2 ? 8 : 0)>(F, 3, O, WB + WE_WO_FOX, DM, E, X, INP(14) + 2 * DM, H, 0, nullptr); } })
    PHASE({ stagger_convert<1>(F);
            if (DENSE_FP8_L2) { pg8::EpiSwigluF8 E{(unsigned char*)ACT2}; dense_gemm<pg8::EpiSwigluF8, true>(F, H8, WB + WE_GU + (size_t)2 * FF * DM, 2 * FF, DM / 2, E); }
            else { pg8::EpiSwiglu E{ACT}; dense_gemm(F, H, WB + WE_GU + (size_t)2 * FF * DM, 2 * FF, DM, E); } })
    PHASE({ if (DENSE_FP8_L2) { pg8::EpiResid<false> E{X, X, 1.0f / (W8S * A8S)}; resid_gemm_norm<(QKV3_FP8 ? 8 : 0), pg8::EpiResid<false>, true>(F, 4, ACT2, WB + WE_D + (size_t)DM * FF, FF / 2, E, X, INP(13) + 3 * DM, H, 0, nullptr); }
            else { pg8::EpiResid<false> E{X, X, 1.0f}; resid_gemm_norm<(QKV3_FP8 ? 8 : 0)>(F, 4, ACT, WB + WE_D + (size_t)DM * FF, FF, E, X, INP(13) + 3 * DM, H, 0, nullptr); } })
    PHASE({ stagger_convert<1>(F);
            if (QKV3_FP8) { pg8::EpiPlanes E{PROJ, C2, 1.0f / W8S}; dense_gemm<pg8::EpiPlanes, true>(F, H8, WB + WE_QKV + (size_t)3 * DM * DM, 3 * DM, DM / 2, E); }
            else { pg8::EpiPlanes E{PROJ, C2, 1.0f}; dense_gemm(F, H, WB + WE_QKV + (size_t)3 * DM * DM, 3 * DM, DM, E); } })
    PHASE(att::causal_phase<0>((att::lptr)F.lds, F.G, PROJ, PROJ + PLANE, PROJ + 2 * PLANE, O, nullptr, WO_FP8))
    PHASE({ if (WO_FP8) { pg8::EpiResid<false> E{X, X, 1.0f / (W8S * A8S)}; resid_gemm_norm<4, pg8::EpiResid<false>, true>(F, 5, O, WB + WE_WO_SB + (size_t)DM * DM, DM / 2, E, X, INP(14) + 3 * DM, H, 1, INP(18) + 1 * DM * NE); }
            else { pg8::EpiResid<false> E{X, X, 1.0f}; resid_gemm_norm<4>(F, 5, O, WB + WE_WO_SB + (size_t)DM * DM, DM, E, X, INP(14) + 3 * DM, H, 1, INP(18) + 1 * DM * NE); } })
    PHASE(moe_finalize(F, 1))
    PHASE({ stagger_convert<1>(F); moe_gu_fast(F, 1, H, ACT); })
    PHASE(moe_down_fast(F, 1, ACT, Y))
    PHASE(final_combine(F, 1))
    static_assert(__COUNTER__ - PH_BASE == N_PHASES, "N_PHASES must equal the number of PHASE() sites");
#undef PHASE
#undef IN
#undef SEAM
}

extern "C" void kernel_launch(void* const* d_in, const int* in_sizes, int n_in, void* d_out, int out_size, void* d_ws, size_t ws_size, hipStream_t stream) {
    static int grid = 0;
    if (grid == 0) {
        if (n_in != 22 || out_size != M * DM || ws_size < WS_END) { fprintf(stderr, "kernel_launch: unexpected shapes (n_in %d out %d ws %zu)\n", n_in, out_size, ws_size); grid = -1; return; }
        int dev = 0, cus = 0, per_cu = 0;
        if (hipGetDevice(&dev) != hipSuccess || hipDeviceGetAttribute(&cus, hipDeviceAttributeMultiprocessorCount, dev) != hipSuccess) { grid = -1; return; }
        if (hipFuncSetAttribute((const void*)trunk_fwd, hipFuncAttributeMaxDynamicSharedMemorySize, LDS_BYTES) != hipSuccess) { fprintf(stderr, "kernel_launch: hipFuncSetAttribute failed\n"); grid = -1; return; }
        if (hipOccupancyMaxActiveBlocksPerMultiprocessor(&per_cu, (const void*)trunk_fwd, NTHR, LDS_BYTES) != hipSuccess || per_cu < 1) fprintf(stderr, "kernel_launch: occupancy query says %d\n", per_cu);
        (void)hipGetLastError();
        grid = cus;
    }
    if (grid < 0) return;
    (void)hipMemsetAsync((char*)d_ws + WS_CTL, 0, CTL_ZERO_BYTES, stream);
    Args a{};
    for (int i = 0; i < 22; ++i) a.in[i] = (const float*)d_in[i];
    a.out = (float*)d_out; a.ws = (unsigned char*)d_ws;
#if MK_MULTI
    for (int p = 0; p < N_PHASES; ++p) { a.ph_lo = p; a.ph_hi = p + 1; hipLaunchKernelGGL(trunk_fwd, dim3(grid), dim3(NTHR), LDS_BYTES, stream, a); }
#else
    a.ph_lo = 0; a.ph_hi = N_PHASES;
    hipLaunchKernelGGL(trunk_fwd, dim3(grid), dim3(NTHR), LDS_BYTES, stream, a);
#endif
}
```
